# Optimizing an MI355X kernel written in HIP

```python
import math
import jax, jax.numpy as jnp
from jax import lax
import numpy as np

D_MODEL = 1024
BATCH = 16
SEQ = 4096
DEPTH = 4

GRID_W = 64
CTX_LEN = 256
HEAD_DIM = 64
FOURIER_W = D_MODEL // 2
FOURIER_GROUPS = 4
FOURIER_GROUP_W = FOURIER_W // FOURIER_GROUPS
ATT_HEADS = (D_MODEL - FOURIER_W) // HEAD_DIM
ATT_KV_HEADS = ATT_HEADS // 4
ATT_GROUP = ATT_HEADS // ATT_KV_HEADS
Q_W = ATT_HEADS * HEAD_DIM
KV_W = ATT_KV_HEADS * HEAD_DIM
WINDOW = 128
ATT_BLOCK = 128
ROPE_BASE = 10000.0
EVEN_IN_W = FOURIER_W + Q_W + 2 * KV_W
SSM_W = D_MODEL // 2
SSM_GROUP = 16
SSM_GROUPS = SSM_W // SSM_GROUP
SSM_STATE = 64
GMLP_W = D_MODEL - SSM_W
GMLP_GROUPS = 4
GMLP_GROUP_W = GMLP_W // GMLP_GROUPS
CHUNK = 128
ODD_IN_W = SSM_W + 2 * GMLP_W
MIX_W = D_MODEL
FFN_HIDDEN = D_MODEL * 11 // 4
N_EXPERTS = 8
TOP_K = 2
EXPERT_HIDDEN = D_MODEL * 7 // 2
N_EVEN = (DEPTH + 1) // 2
N_ODD = DEPTH // 2
ALPHA = (2 * DEPTH) ** 0.25
BETA = (8 * DEPTH) ** -0.25
LN_EPS = 1e-5
NEG_INF = -1e30

kernel_name = "hybrid_fourier_swa_s5_gmlp_moe_diffusion_trunk"


def _standardize(x):
    xf = x.astype(jnp.float32)
    mu = jnp.mean(xf, axis=-1, keepdims=True)
    var = jnp.mean(jnp.square(xf - mu), axis=-1, keepdims=True)
    return ((xf - mu) * lax.rsqrt(var + LN_EPS)).astype(x.dtype)


def layer_norm(x, g, b):
    return _standardize(x) * g + b


def _rope_axis(x, pos):
    half = x.shape[-1] // 2
    inv = ROPE_BASE ** (-jnp.arange(half, dtype=jnp.float32) / half)
    ang = pos.astype(jnp.float32)[:, None] * inv[None, :]
    cos, sin = jnp.cos(ang)[:, None, :], jnp.sin(ang)[:, None, :]
    xf = x.astype(jnp.float32)
    x1, x2 = xf[..., :half], xf[..., half:]
    return jnp.concatenate([x1 * cos - x2 * sin, x1 * sin + x2 * cos], axis=-1).astype(x.dtype)


def rope_2d(x, rows, cols):
    d2 = x.shape[-1] // 2
    return jnp.concatenate([_rope_axis(x[..., :d2], rows), _rope_axis(x[..., d2:], cols)], axis=-1)


def fourier_mix(a):
    bsz, n, _ = a.shape
    a4 = a.astype(jnp.float32).reshape(bsz, n, FOURIER_GROUPS, FOURIER_GROUP_W)
    y = jnp.fft.fftn(a4, axes=(1, 3), norm='ortho').real
    return y.reshape(bsz, n, FOURIER_W).astype(a.dtype)


def window_attention(q, k, v, k_ctx, v_ctx, sink):
    bsz, n, _, _ = q.shape
    n_blk = n // ATT_BLOCK
    n_band = 3 * ATT_BLOCK
    n_ctx = k_ctx.shape[1]
    scale = HEAD_DIM ** -0.5
    qg = q.reshape(bsz, n, ATT_KV_HEADS, ATT_GROUP, HEAD_DIM)
    pad = ((0, 0), (ATT_BLOCK, ATT_BLOCK), (0, 0), (0, 0))
    k_pad, v_pad = jnp.pad(k, pad), jnp.pad(v, pad)
    sink_g = sink.astype(jnp.float32).reshape(ATT_KV_HEADS, ATT_GROUP)[None, :, :, None, None]
    offs_q = jnp.arange(ATT_BLOCK)
    offs_k = jnp.arange(n_band) - ATT_BLOCK

    def one_block(blk):
        start = blk * ATT_BLOCK
        qb = lax.dynamic_slice_in_dim(qg, start, ATT_BLOCK, axis=1)
        kb = lax.dynamic_slice_in_dim(k_pad, start, n_band, axis=1)
        vb = lax.dynamic_slice_in_dim(v_pad, start, n_band, axis=1)
        qpos = start + offs_q
        kpos = start + offs_k
        valid = (jnp.abs(qpos[:, None] - kpos[None, :]) <= WINDOW) & (kpos[None, :] >= 0) & (kpos[None, :] < n)
        s_loc = jnp.einsum('bqhgd,bkhd->bhgqk', qb, kb, preferred_element_type=jnp.float32) * scale
        s_loc = jnp.where(valid, s_loc, NEG_INF)
        s_ctx = jnp.einsum('bqhgd,bkhd->bhgqk', qb, k_ctx, preferred_element_type=jnp.float32) * scale
        s_sink = jnp.broadcast_to(sink_g, s_loc.shape[:-1] + (1,))
        p = jax.nn.softmax(jnp.concatenate([s_loc, s_ctx, s_sink], axis=-1), axis=-1)
        p_loc = p[..., :n_band].astype(v.dtype)
        p_ctx = p[..., n_band:n_band + n_ctx].astype(v.dtype)
        return (jnp.einsum('bhgqk,bkhd->bqhgd', p_loc, vb)
                + jnp.einsum('bhgqk,bkhd->bqhgd', p_ctx, v_ctx))

    out = lax.map(one_block, jnp.arange(n_blk))
    return jnp.moveaxis(out, 0, 1).reshape(bsz, n, Q_W)


def context_attention(q, k, v, sink):
    bsz, n_ctx, _, _ = q.shape
    qg = q.reshape(bsz, n_ctx, ATT_KV_HEADS, ATT_GROUP, HEAD_DIM)
    s = jnp.einsum('bqhgd,bkhd->bhgqk', qg, k, preferred_element_type=jnp.float32) * HEAD_DIM ** -0.5
    sink_g = sink.astype(jnp.float32).reshape(ATT_KV_HEADS, ATT_GROUP)[None, :, :, None, None]
    s_sink = jnp.broadcast_to(sink_g, s.shape[:-1] + (1,))
    p = jax.nn.softmax(jnp.concatenate([s, s_sink], axis=-1), axis=-1)[..., :n_ctx].astype(v.dtype)
    return jnp.einsum('bhgqk,bkhd->bqhgd', p, v).reshape(bsz, n_ctx, Q_W)


def even_mixer(h_lat, h_ctx, w_in, w_out, sink, rows, cols, need_ctx):
    bsz, n, _ = h_lat.shape
    n_ctx = h_ctx.shape[1]
    o_q, o_k, o_v = FOURIER_W, FOURIER_W + Q_W, FOURIER_W + Q_W + KV_W
    p_lat = h_lat @ w_in
    p_ctx = h_ctx @ (w_in if need_ctx else w_in[:, o_k:])
    p_kv_ctx = p_ctx[..., o_k:] if need_ctx else p_ctx
    k_ctx = p_kv_ctx[..., :KV_W].reshape(bsz, n_ctx, ATT_KV_HEADS, HEAD_DIM)
    v_ctx = p_kv_ctx[..., KV_W:].reshape(bsz, n_ctx, ATT_KV_HEADS, HEAD_DIM)
    q_lat = rope_2d(p_lat[..., o_q:o_k].reshape(bsz, n, ATT_HEADS, HEAD_DIM), rows, cols)
    k_lat = rope_2d(p_lat[..., o_k:o_v].reshape(bsz, n, ATT_KV_HEADS, HEAD_DIM), rows, cols)
    v_lat = p_lat[..., o_v:].reshape(bsz, n, ATT_KV_HEADS, HEAD_DIM)
    y_lat = jnp.concatenate([fourier_mix(p_lat[..., :o_q]),
                             window_attention(q_lat, k_lat, v_lat, k_ctx, v_ctx, sink)], axis=-1) @ w_out
    y_ctx = None
    if need_ctx:
        q_ctx = p_ctx[..., o_q:o_k].reshape(bsz, n_ctx, ATT_HEADS, HEAD_DIM)
        y_ctx = jnp.concatenate([fourier_mix(p_ctx[..., :o_q]),
                                 context_attention(q_ctx, k_ctx, v_ctx, sink)], axis=-1) @ w_out
    return y_lat, y_ctx


def _zoh(a_re, a_im, log_dt, b_re, b_im):
    lam = lax.complex(a_re.astype(jnp.float32), a_im.astype(jnp.float32))
    dt = jnp.exp(log_dt.astype(jnp.float32))[:, None]
    lam_bar = jnp.exp(lam * dt)
    b_c = lax.complex(b_re.astype(jnp.float32), b_im.astype(jnp.float32))
    return lam_bar, ((lam_bar - 1.0) / lam)[..., None] * b_c


def _lin_combine(e1, e2):
    a1, b1 = e1
    a2, b2 = e2
    return a1 * a2, a2 * b1 + b2


def _diag_scan(lam_bar, bu, reverse):
    a = jnp.broadcast_to(lam_bar, bu.shape)
    _, h = lax.associative_scan(_lin_combine, (a, bu), reverse=reverse, axis=1)
    return h


def bidirectional_s5(u_lat, u_ctx, a_re, a_im, log_dt, b_re, b_im, c_re, c_im, d_skip, need_ctx):
    bsz, n, _ = u_lat.shape
    n_ctx = u_ctx.shape[1]
    ul = u_lat.astype(jnp.float32).reshape(bsz, n, SSM_GROUPS, SSM_GROUP).astype(jnp.complex64)
    uc = u_ctx.astype(jnp.float32).reshape(bsz, n_ctx, SSM_GROUPS, SSM_GROUP).astype(jnp.complex64)
    y_lat = (d_skip * u_lat).astype(jnp.float32)
    y_ctx = (d_skip * u_ctx).astype(jnp.float32) if need_ctx else None
    for direction in range(2):
        reverse = direction == 1
        lam_bar, b_bar = _zoh(a_re[direction], a_im[direction], log_dt[direction],
                              b_re[direction], b_im[direction])
        c_mat = lax.complex(c_re[direction].astype(jnp.float32), c_im[direction].astype(jnp.float32))
        h_ctx = _diag_scan(lam_bar, jnp.einsum('gps,bngs->bngp', b_bar, uc), reverse)
        h_carry = h_ctx[:, 0] if reverse else h_ctx[:, -1]
        bu_lat = jnp.einsum('gps,bngs->bngp', b_bar, ul)
        bu_lat = bu_lat.at[:, -1 if reverse else 0].add(lam_bar * h_carry)
        h_lat = _diag_scan(lam_bar, bu_lat, reverse)
        y_lat = y_lat + jnp.einsum('gsp,bngp->bngs', c_mat, h_lat).real.reshape(bsz, n, SSM_W)
        if need_ctx:
            y_ctx = y_ctx + jnp.einsum('gsp,bngp->bngs', c_mat, h_ctx).real.reshape(bsz, n_ctx, SSM_W)
    return y_lat.astype(u_lat.dtype), (y_ctx.astype(u_ctx.dtype) if need_ctx else None)


def s5_glu(y, w_glu, b_glu):
    g = jax.nn.gelu(y)
    return g * jax.nn.sigmoid(g @ w_glu + b_glu)


def chunk_gmlp(p, w_s, b_s):
    bsz, n, _ = p.shape
    uv = jax.nn.gelu(p)
    u, v = uv[..., :GMLP_W], _standardize(uv[..., GMLP_W:])
    v = v.reshape(bsz, n // CHUNK, CHUNK, GMLP_GROUPS, GMLP_GROUP_W)
    vs = jnp.einsum('hij,bcjhe->bcihe', w_s, v) + jnp.transpose(b_s)[None, None, :, :, None]
    return u * vs.reshape(bsz, n, GMLP_W)


def odd_mixer(h_lat, h_ctx, w_in, a_re, a_im, log_dt, b_re, b_im, c_re, c_im, d_skip,
              w_glu, b_glu, w_s, b_s, w_out, need_ctx):
    p_lat = h_lat @ w_in
    p_ctx = h_ctx @ (w_in if need_ctx else w_in[:, :SSM_W])
    s_lat, s_ctx = bidirectional_s5(p_lat[..., :SSM_W], p_ctx[..., :SSM_W], a_re, a_im, log_dt,
                                    b_re, b_im, c_re, c_im, d_skip, need_ctx)
    y_lat = jnp.concatenate([s5_glu(s_lat, w_glu, b_glu),
                             chunk_gmlp(p_lat[..., SSM_W:], w_s, b_s)], axis=-1) @ w_out
    y_ctx = None
    if need_ctx:
        y_ctx = jnp.concatenate([s5_glu(s_ctx, w_glu, b_glu),
                                 chunk_gmlp(p_ctx[..., SSM_W:], w_s, b_s)], axis=-1) @ w_out
    return y_lat, y_ctx


def dense_swiglu(h, w1, w3, w2):
    return (jax.nn.silu(h @ w1) * (h @ w3)) @ w2


def moe_swiglu(h, w_router, w1, w3, w2):
    logits = (h @ w_router).astype(jnp.float32)
    top_v, top_i = lax.top_k(logits, TOP_K)
    top_w = jax.nn.softmax(top_v, axis=-1)
    gates = jnp.sum(jax.nn.one_hot(top_i, N_EXPERTS, dtype=jnp.float32) * top_w[..., None], axis=-2)
    gates = gates.astype(h.dtype)
    out = jnp.zeros_like(h)
    for e in range(N_EXPERTS):
        he = jax.nn.silu(h @ w1[e]) * (h @ w3[e])
        out = out + gates[..., e:e + 1] * (he @ w2[e])
    return out


def setup_inputs(seed: int = 0) -> dict:
    key = jax.random.key(seed)
    ks = jax.random.split(key, 32)
    f32 = jnp.float32
    d = D_MODEL

    def nrm(i, shape, scale):
        return jax.random.normal(ks[i], shape, f32) * scale

    ssm_shape = (N_ODD, 2, SSM_GROUPS, SSM_STATE)
    a_im_base = math.pi * jnp.arange(SSM_STATE, dtype=f32)
    return {
        'x': nrm(0, (BATCH, SEQ, d), 1.0),
        'c': nrm(1, (BATCH, d), 1.0),
        'ctx': nrm(2, (BATCH, CTX_LEN, d), 1.0),
        'c_ctx': nrm(3, (d,), 1.0),
        'w_mod': nrm(4, (DEPTH, d, 6 * d), d ** -0.5),
        'b_mod': nrm(5, (DEPTH, 6 * d), 0.02),
        'ln_g': 1.0 + nrm(6, (DEPTH, 2, d), 0.05),
        'ln_b': nrm(7, (DEPTH, 2, d), 0.02),
        'ev_w_in': nrm(8, (N_EVEN, d, EVEN_IN_W), d ** -0.5),
        'ev_w_out': nrm(9, (N_EVEN, MIX_W, d), BETA * MIX_W ** -0.5),
        'ev_sink': nrm(10, (N_EVEN, ATT_HEADS), 0.5),
        'ev_w1': nrm(11, (N_EVEN, d, FFN_HIDDEN), d ** -0.5),
        'ev_w3': nrm(12, (N_EVEN, d, FFN_HIDDEN), d ** -0.5),
        'ev_w2': nrm(13, (N_EVEN, FFN_HIDDEN, d), BETA * FFN_HIDDEN ** -0.5),
        'od_w_in': nrm(14, (N_ODD, d, ODD_IN_W), d ** -0.5),
        'ssm_a_re': -0.5 + nrm(15, ssm_shape, 0.01),
        'ssm_a_im': a_im_base + nrm(16, ssm_shape, 0.01),
        'ssm_log_dt': jax.random.uniform(ks[17], (N_ODD, 2, SSM_GROUPS), f32,
                                         math.log(1e-3), math.log(1e-1)),
        'ssm_b_re': nrm(18, (N_ODD, 2, SSM_GROUPS, SSM_STATE, SSM_GROUP), (2 * SSM_GROUP) ** -0.5),
        'ssm_b_im': nrm(19, (N_ODD, 2, SSM_GROUPS, SSM_STATE, SSM_GROUP), (2 * SSM_GROUP) ** -0.5),
        'ssm_c_re': nrm(20, (N_ODD, 2, SSM_GROUPS, SSM_GROUP, SSM_STATE), (2 * SSM_STATE) ** -0.5),
        'ssm_c_im': nrm(21, (N_ODD, 2, SSM_GROUPS, SSM_GROUP, SSM_STATE), (2 * SSM_STATE) ** -0.5),
        'ssm_d': nrm(22, (N_ODD, SSM_W), 0.5),
        'ssm_w_glu': nrm(23, (N_ODD, SSM_W, SSM_W), SSM_W ** -0.5),
        'ssm_b_glu': nrm(24, (N_ODD, SSM_W), 0.02),
        'gmlp_w_s': nrm(25, (N_ODD, GMLP_GROUPS, CHUNK, CHUNK), 0.5 * CHUNK ** -0.5),
        'gmlp_b_s': 1.0 + nrm(26, (N_ODD, GMLP_GROUPS, CHUNK), 0.02),
        'od_w_out': nrm(27, (N_ODD, MIX_W, d), BETA * MIX_W ** -0.5),
        'moe_w_router': nrm(28, (N_ODD, d, N_EXPERTS), d ** -0.5),
        'moe_w1': nrm(29, (N_ODD, N_EXPERTS, d, EXPERT_HIDDEN), d ** -0.5),
        'moe_w3': nrm(30, (N_ODD, N_EXPERTS, d, EXPERT_HIDDEN), d ** -0.5),
        'moe_w2': nrm(31, (N_ODD, N_EXPERTS, EXPERT_HIDDEN, d), BETA * EXPERT_HIDDEN ** -0.5),
    }


def reference(x, c, ctx, c_ctx, w_mod, b_mod, ln_g, ln_b, ev_w_in, ev_w_out, ev_sink,
              ev_w1, ev_w3, ev_w2, od_w_in, ssm_a_re, ssm_a_im, ssm_log_dt, ssm_b_re, ssm_b_im,
              ssm_c_re, ssm_c_im, ssm_d, ssm_w_glu, ssm_b_glu, gmlp_w_s, gmlp_b_s, od_w_out,
              moe_w_router, moe_w1, moe_w3, moe_w2):
    n_lat = x.shape[1]
    n_rows = n_lat // GRID_W
    rows = jnp.broadcast_to(jnp.arange(n_rows)[:, None], (n_rows, GRID_W)).reshape(-1)
    cols = jnp.broadcast_to(jnp.arange(GRID_W)[None, :], (n_rows, GRID_W)).reshape(-1)
    silu_c = jax.nn.silu(c)
    silu_cc = jax.nn.silu(c_ctx)[None, :]
    x_lat, x_ctx = x, ctx
    for layer in range(DEPTH):
        need_ctx = layer < DEPTH - 1
        li = layer // 2
        mod_l = (silu_c @ w_mod[layer] + b_mod[layer])[:, None, :]
        mod_c = (silu_cc @ w_mod[layer] + b_mod[layer])[:, None, :]
        sh1, sc1, g1, sh2, sc2, g2 = jnp.split(mod_l, 6, axis=-1)
        csh1, csc1, cg1, csh2, csc2, cg2 = jnp.split(mod_c, 6, axis=-1)
        h_lat = x_lat * (1.0 + sc1) + sh1
        h_ctx = x_ctx * (1.0 + csc1) + csh1
        if layer % 2 == 0:
            y_lat, y_ctx = even_mixer(h_lat, h_ctx, ev_w_in[li], ev_w_out[li], ev_sink[li],
                                      rows, cols, need_ctx)
        else:
            y_lat, y_ctx = odd_mixer(h_lat, h_ctx, od_w_in[li], ssm_a_re[li], ssm_a_im[li],
                                     ssm_log_dt[li], ssm_b_re[li], ssm_b_im[li], ssm_c_re[li],
                                     ssm_c_im[li], ssm_d[li], ssm_w_glu[li], ssm_b_glu[li],
                                     gmlp_w_s[li], gmlp_b_s[li], od_w_out[li], need_ctx)
        x_lat = layer_norm(ALPHA * x_lat + g1 * y_lat, ln_g[layer, 0], ln_b[layer, 0])
        h2_lat = x_lat * (1.0 + sc2) + sh2
        if need_ctx:
            x_ctx = layer_norm(ALPHA * x_ctx + cg1 * y_ctx, ln_g[layer, 0], ln_b[layer, 0])
            h2 = jnp.concatenate([h2_lat, x_ctx * (1.0 + csc2) + csh2], axis=1)
        else:
            h2 = h2_lat
        if layer % 2 == 0:
            f2 = dense_swiglu(h2, ev_w1[li], ev_w3[li], ev_w2[li])
        else:
            f2 = moe_swiglu(h2, moe_w_router[li], moe_w1[li], moe_w3[li], moe_w2[li])
        x_lat = layer_norm(ALPHA * x_lat + g2 * f2[:, :n_lat], ln_g[layer, 1], ln_b[layer, 1])
        if need_ctx:
            x_ctx = layer_norm(ALPHA * x_ctx + cg2 * f2[:, n_lat:], ln_g[layer, 1], ln_b[layer, 1])
    return x_lat
```

```cpp
#include <hip/hip_runtime.h>
#include <cstdio>
#include <cstdint>

#ifndef MK_SPLIT
#define MK_SPLIT 0
#endif

#define GAS __attribute__((address_space(1)))
#define LAS __attribute__((address_space(3)))
typedef unsigned short bf16;
typedef unsigned v4u __attribute__((ext_vector_type(4)));
typedef unsigned v2u __attribute__((ext_vector_type(2)));
typedef float f32x4 __attribute__((ext_vector_type(4)));
typedef float f32x2 __attribute__((ext_vector_type(2)));
typedef short bf16x8 __attribute__((ext_vector_type(8)));

constexpr int D = 1024, NBATCH = 16, SEQ = 4096, NCTX = 256, DEPTH = 4;
constexpr int TL = NBATCH * SEQ, TC = NBATCH * NCTX, T = TL + TC;
constexpr int FFH = 2816, EH = 3584, NEXP = 8;
constexpr int MOE_CHUNK_TILES = 64, MOE_NCHUNK = 9;
constexpr float ALPHA = 1.6817928305074290860622509524664f;
constexpr float LN_EPS = 1e-5f;

constexpr size_t MiB = (size_t)1 << 20;
constexpr size_t WS_CTL = 0, CTL_ZERO_BYTES = 1 * MiB;
constexpr size_t WS_MOD = 1 * MiB;
constexpr size_t WS_TOK = 3 * MiB;
constexpr size_t WS_XC = 5 * MiB;
constexpr size_t WS_F256 = 21 * MiB;
constexpr size_t WS_F4096 = 22 * MiB;
constexpr size_t WS_EV = 86 * MiB, EV_STRIDE = 22 * MiB;
constexpr size_t EV_WQKV = 0, EV_WPQ = 3 * MiB / 2, EV_WOUT = 7 * MiB / 2, EV_W13 = 11 * MiB / 2, EV_W2 = 33 * MiB / 2;
constexpr size_t WS_OD = 130 * MiB, OD_STRIDE = 174 * MiB;
constexpr size_t OD_WIN = 0, OD_WGLU = 3 * MiB, OD_WOUT = 7 * MiB / 2, OD_MW13 = 11 * MiB / 2, OD_MW2 = 235 * MiB / 2;
constexpr size_t WS_H = 478 * MiB;
constexpr size_t WS_BIG = 614 * MiB;
constexpr size_t BIG_PQT = 0, BIG_PQTC = 128 * MiB, BIG_QKV = 136 * MiB, BIG_MIX = 238 * MiB, BIG_HID = 0, BIG_P = 0, BIG_HS = 0;
constexpr size_t WS_END = 994 * MiB;
constexpr int CW_BAR = 4096, CW_CNT = 16384;

#define LDS_WAIT() asm volatile("s_waitcnt lgkmcnt(0)" ::: "memory")
#define VM_WAIT() asm volatile("s_waitcnt vmcnt(0)" ::: "memory")
__device__ __forceinline__ unsigned cvt_pk_bf16(float lo, float hi) { unsigned r; asm volatile("v_cvt_pk_bf16_f32 %0, %1, %2" : "=v"(r) : "v"(lo), "v"(hi)); return r; }
__device__ __forceinline__ float bflo(unsigned w) { return __uint_as_float(w << 16); }
__device__ __forceinline__ float bfhi(unsigned w) { return __uint_as_float(w & 0xffff0000u); }
__device__ __forceinline__ float bf2f(bf16 b) { return __uint_as_float(((unsigned)b) << 16); }
__device__ __forceinline__ bf16 f2bf(float f) { return (bf16)(cvt_pk_bf16(f, 0.f) & 0xffffu); }
__device__ __forceinline__ float wave_sum(float v) {
#pragma unroll
    for (int o = 1; o < 64; o <<= 1) v += __shfl_xor(v, o);
    return v;
}
__device__ __forceinline__ float wave_max(float v) {
#pragma unroll
    for (int o = 1; o < 64; o <<= 1) v = fmaxf(v, __shfl_xor(v, o));
    return v;
}
__device__ __forceinline__ float silu_f(float x) { return x / (1.f + __expf(-x)); }
__device__ __forceinline__ float sigmoid_f(float x) { return 1.f / (1.f + __expf(-x)); }
__device__ __forceinline__ float gelu_tanh_f(float x) { const float z = 0.7978845608028654f * (x + 0.044715f * x * x * x); return x / (1.f + __expf(-2.f * z)); }

#define XB_TMO      128
#define XB_XCNT(j)  (256  + 64 * (j))
#define XB_XSUB(j)  (1280 + 64 * (j))
#define XB_XGEN(j)  (2304 + 64 * (j))
#define XB_TOP      3328
#define XB_TOPGEN   3392
#define XCD_BAR_WORDS 3456
#define XB_SPIN_CAP (1u << 25)
__device__ __forceinline__ unsigned xb_ld(unsigned* p)              { return __hip_atomic_load(p, __ATOMIC_RELAXED, __HIP_MEMORY_SCOPE_AGENT); }
__device__ __forceinline__ unsigned xb_add(unsigned* p, unsigned v) { return __hip_atomic_fetch_add(p, v, __ATOMIC_RELAXED, __HIP_MEMORY_SCOPE_AGENT); }
__device__ __forceinline__ unsigned xb_xcc_id() { return (unsigned)__builtin_amdgcn_s_getreg((3 << 11) | 20) & 0xFu; }
#define XB_SPIN(cond, bar) do { unsigned _sp = 0; while (cond) { __builtin_amdgcn_s_sleep(1); \
    if ((++_sp & 255u) == 0u) { if (xb_ld(&(bar)[XB_TMO])) break; if (_sp > XB_SPIN_CAP) { atomicAdd(&(bar)[XB_TMO], 1u); break; } } } } while (0)
struct XcdBarrier { unsigned* bar; unsigned x; volatile LAS unsigned* st; };
__device__ __forceinline__ XcdBarrier xcd_barrier_post(unsigned* bar, volatile LAS unsigned* st) {
    XcdBarrier b; b.bar = bar; b.x = xb_xcc_id(); b.st = st;
    if (threadIdx.x == 0) (void)xb_add(&bar[XB_XCNT(b.x)], 1u);
    return b;
}
__device__ __forceinline__ void xcd_barrier_complete(unsigned* bar, unsigned x, unsigned& nloc, unsigned& nx) {
    const unsigned G = gridDim.x * gridDim.y * gridDim.z;
    unsigned sum, cnt, mine, sp = 0u;
    for (;;) {
        sum = 0u; cnt = 0u; mine = 0u;
#pragma unroll
        for (unsigned j = 0; j < 16; ++j) { const unsigned c = xb_ld(&bar[XB_XCNT(j)]); sum += c; cnt += (c > 0u) ? 1u : 0u; mine = (j == x) ? c : mine; }
        if (sum == G) break;
        __builtin_amdgcn_s_sleep(1);
        if ((++sp & 255u) == 0u) { if (xb_ld(&bar[XB_TMO])) break; if (sp > XB_SPIN_CAP) { atomicAdd(&bar[XB_TMO], 1u); break; } }
    }
    nloc = mine > 0u ? mine : 1u; nx = cnt > 0u ? cnt : 1u;
}
__device__ __forceinline__ void xcd_barrier(const XcdBarrier& b) {
    asm volatile("s_waitcnt vmcnt(0)" ::: "memory");
    __syncthreads();
    if (threadIdx.x == 0) {
        unsigned* bar = b.bar;
        __builtin_amdgcn_s_waitcnt(0);
        unsigned nloc = b.st[0], nx = b.st[1];
        if (nloc == 0u) { xcd_barrier_complete(bar, b.x, nloc, nx); b.st[0] = nloc; b.st[1] = nx; }
        const unsigned old = xb_add(&bar[XB_XSUB(b.x)], 1u);
        const unsigned gen = old / nloc;
        if (old + 1u == (gen + 1u) * nloc) {
            __builtin_amdgcn_fence(__ATOMIC_RELEASE, "agent");
            asm volatile("s_waitcnt vmcnt(0)" ::: "memory");
            const unsigned og = xb_add(&bar[XB_TOP], 1u);
            const unsigned tg = og / nx;
            if (og + 1u == (tg + 1u) * nx) xb_add(&bar[XB_TOPGEN], 1u);
            else XB_SPIN(xb_ld(&bar[XB_TOPGEN]) == tg, bar);
            __builtin_amdgcn_fence(__ATOMIC_ACQUIRE, "agent");
            xb_add(&bar[XB_XGEN(b.x)], 1u);
            asm volatile("s_waitcnt vmcnt(0)" ::: "memory");
        } else {
            XB_SPIN(xb_ld(&bar[XB_XGEN(b.x)]) == gen, bar);
            __builtin_amdgcn_fence(__ATOMIC_ACQUIRE, "agent");
            asm volatile("s_waitcnt vmcnt(0)" ::: "memory");
        }
    }
    __syncthreads();
}

namespace pg8 {
constexpr int BM = 256, BK = 64, HALF = 128, HTB = HALF * BK * 2, STAGE_BYTES = 8 * HTB;
__host__ __device__ __forceinline__ int lds_byte(int r, int c) { const int st = (r >> 4) * 2 + (c >> 5), rr = r & 15, cc = c & 31, ob = rr * 64 + cc * 2; return st * 1024 + (ob ^ (((ob >> 9) & 1) << 5)); }
__host__ __device__ __forceinline__ void stage_rc(int b, int& R, int& C) { const int st = b / 1024, sb = b % 1024, swz = sb ^ (((sb >> 9) & 1) << 5); R = (st >> 1) * 16 + swz / 64; C = (st & 1) * 32 + (swz % 64) / 2; }
__host__ __device__ __forceinline__ int perm32(int rho) { const int n = rho >> 4, i = rho & 15; return 8 * (i >> 2) + 4 * n + (i & 3); }

struct Unit { const char* a; const char* b; char* o; const char* p0; const char* p1; int ldo; int x0; };
struct Dims { int K, lda, ldb; };

template <class Epi, class Sched, bool ALIGN_EPI = false, bool SP2 = false>
__device__ __forceinline__ void gemm_phase(LAS unsigned char* lds, const int tid, const Dims g, const Sched& S, const Epi& E) {
    const int wid = __builtin_amdgcn_readfirstlane(tid >> 6), lane = tid & 63, wr = wid >> 2, wc = wid & 3, fr = lane & 15, fq = lane >> 4;
    const int K = g.K, nt = K / BK;
    unsigned voffA[2], voffB[2];
#pragma unroll
    for (int i = 0; i < 2; ++i) { int R, C; stage_rc(tid * 16 + i * 8192, R, C); const int Rb = Epi::PERM ? ((R & ~31) + perm32(R & 31)) : R;
        voffA[i] = (unsigned)(R * g.lda + C) * 2u; voffB[i] = (unsigned)(Rb * g.ldb + C) * 2u; }
    const size_t kstep = (size_t)(BK * 2);
    const size_t hsA = (size_t)HALF * g.lda * 2, hsB = (size_t)HALF * g.ldb * 2;
    const unsigned ldsw = (unsigned)wid * 1024u;
    const int aoff = lds_byte(wr * 64 + fr, fq * 8), boff = lds_byte(wc * 32 + fr, fq * 8);
#define PG8_SA(b, h) (((b) * 2 + (h)) * HTB)
#define PG8_SB(b, h) ((4 + (b) * 2 + (h)) * HTB)
#define PG8_STAGE(bufoff, gbase, voff) do { _Pragma("unroll") for (int _i = 0; _i < 2; ++_i) \
        __builtin_amdgcn_global_load_lds((const unsigned*)((const char*)(gbase) + (voff)[_i]), (LAS unsigned*)(lds + (bufoff) + ldsw + _i * 8192), 16, 0, 0); } while (0)
#define PG8_LDA(dst, b, h) do { _Pragma("unroll") for (int m = 0; m < 4; ++m) _Pragma("unroll") for (int k = 0; k < 2; ++k) dst[m][k] = *(const LAS bf16x8*)(lds + PG8_SA(b, h) + aoff + m * 2048 + k * 1024); } while (0)
#define PG8_LDB(dst, b, h) do { _Pragma("unroll") for (int n = 0; n < 2; ++n) _Pragma("unroll") for (int k = 0; k < 2; ++k) dst[n][k] = *(const LAS bf16x8*)(lds + PG8_SB(b, h) + boff + n * 2048 + k * 1024); } while (0)
#define PG8_MMA(ai, bj, At, Bt) do { __builtin_amdgcn_s_setprio(1); _Pragma("unroll") for (int m = 0; m < 4; ++m) _Pragma("unroll") for (int n = 0; n < 2; ++n) _Pragma("unroll") for (int k = 0; k < 2; ++k) \
        acc[ai][bj][m][n] = __builtin_amdgcn_mfma_f32_16x16x32_bf16(Bt[n][k], At[m][k], acc[ai][bj][m][n], 0, 0, 0); __builtin_amdgcn_s_setprio(0); } while (0)
#define PG8_WAIT_V(n) asm volatile("s_waitcnt vmcnt(" #n ")" ::: "memory")
#define PG8_WAIT_L(n) asm volatile("s_waitcnt lgkmcnt(" #n ")" ::: "memory")
#define PG8_BAR __builtin_amdgcn_s_barrier()
#define PG8_SCHED __builtin_amdgcn_sched_barrier(0)
    int ui = 0;
    const char* cA; const char* cB;
    { Unit u0; if (!S.next(0, u0)) return; cA = u0.a; cB = u0.b; }
    f32x4 acc[2][2][4][2];
#pragma unroll
    for (int a = 0; a < 2; ++a)
#pragma unroll
        for (int b = 0; b < 2; ++b)
#pragma unroll
            for (int m = 0; m < 4; ++m)
#pragma unroll
                for (int n = 0; n < 2; ++n) acc[a][b][m][n] = (f32x4){0.f, 0.f, 0.f, 0.f};
    bf16x8 At[4][2], B0[2][2], B1[2][2];
    if constexpr (SP2) {
        PG8_STAGE(PG8_SB(0, 0), cB, voffB); PG8_STAGE(PG8_SB(0, 1), cB + hsB, voffB); PG8_STAGE(PG8_SA(0, 0), cA, voffA); PG8_STAGE(PG8_SA(0, 1), cA + hsA, voffA);
        if (wr == 1) PG8_BAR;
        PG8_WAIT_V(2); PG8_BAR;
        PG8_STAGE(PG8_SB(1, 0), cB + kstep, voffB); PG8_STAGE(PG8_SA(1, 0), cA + kstep, voffA); PG8_STAGE(PG8_SB(1, 1), cB + hsB + kstep, voffB);
        PG8_WAIT_V(6); PG8_BAR;
    } else {
        PG8_STAGE(PG8_SB(0, 0), cB, voffB); PG8_STAGE(PG8_SA(0, 0), cA, voffA); PG8_STAGE(PG8_SB(0, 1), cB + hsB, voffB); PG8_STAGE(PG8_SA(0, 1), cA + hsA, voffA);
        if (wr == 1) PG8_BAR;
        PG8_WAIT_V(4); PG8_BAR;
        PG8_STAGE(PG8_SB(1, 0), cB + kstep, voffB); PG8_STAGE(PG8_SA(1, 0), cA + kstep, voffA); PG8_STAGE(PG8_SB(1, 1), cB + hsB + kstep, voffB);
        PG8_WAIT_V(6); PG8_BAR;
    }
    for (;;) {
        const char* nA = cA; const char* nB = cB; bool has_next;
        { Unit un; has_next = S.next(ui + 1, un); if (has_next) { nA = un.a; nB = un.b; } }
        for (int t = 0; t < nt; t += 2) {
            const bool last = (t == nt - 2);
            const char* a1 = cA + (size_t)(t + 1) * kstep;
            const char* a2 = last ? nA : cA + (size_t)(t + 2) * kstep; const char* b2 = last ? nB : cB + (size_t)(t + 2) * kstep;
            const char* a3 = a2 + kstep; const char* b3 = b2 + kstep;
            if constexpr (SP2) {
            PG8_LDB(B0, 0, 0); PG8_LDB(B1, 0, 1); PG8_SCHED; PG8_LDA(At, 0, 0); PG8_STAGE(PG8_SA(1, 1), a1 + hsA, voffA);
            PG8_WAIT_V(8); PG8_WAIT_L(0); PG8_BAR; PG8_MMA(0, 0, At, B0); PG8_MMA(0, 1, At, B1); PG8_BAR; PG8_SCHED;
            PG8_LDA(At, 0, 1); PG8_STAGE(PG8_SB(0, 0), b2, voffB); PG8_STAGE(PG8_SB(0, 1), b2 + hsB, voffB); PG8_STAGE(PG8_SA(0, 0), a2, voffA);
            PG8_WAIT_V(8); PG8_WAIT_L(0); PG8_BAR; PG8_MMA(1, 0, At, B0); PG8_MMA(1, 1, At, B1); PG8_BAR; PG8_SCHED;
            PG8_LDB(B0, 1, 0); PG8_LDB(B1, 1, 1); PG8_SCHED; PG8_LDA(At, 1, 0); PG8_STAGE(PG8_SA(0, 1), a2 + hsA, voffA);
            PG8_WAIT_V(8); PG8_WAIT_L(0); PG8_BAR; PG8_MMA(0, 0, At, B0); PG8_MMA(0, 1, At, B1); PG8_BAR; PG8_SCHED;
            PG8_LDA(At, 1, 1); PG8_STAGE(PG8_SB(1, 0), b3, voffB); PG8_STAGE(PG8_SB(1, 1), b3 + hsB, voffB); PG8_STAGE(PG8_SA(1, 0), a3, voffA);
            PG8_WAIT_V(8); PG8_WAIT_L(0); PG8_BAR; PG8_MMA(1, 0, At, B0); PG8_MMA(1, 1, At, B1); PG8_BAR; PG8_SCHED;
            } else {
            PG8_LDB(B0, 0, 0); PG8_SCHED; PG8_LDA(At, 0, 0); PG8_STAGE(PG8_SA(1, 1), a1 + hsA, voffA);
            PG8_WAIT_L(8); PG8_BAR; PG8_WAIT_L(0); PG8_MMA(0, 0, At, B0); PG8_BAR; PG8_SCHED;
            PG8_LDB(B1, 0, 1); PG8_STAGE(PG8_SB(0, 0), b2, voffB);
            PG8_BAR; PG8_WAIT_L(0); PG8_MMA(0, 1, At, B1); PG8_BAR;
            PG8_LDA(At, 0, 1); PG8_STAGE(PG8_SA(0, 0), a2, voffA);
            PG8_BAR; PG8_WAIT_L(0); PG8_MMA(1, 0, At, B0); PG8_BAR; PG8_SCHED;
            PG8_STAGE(PG8_SB(0, 1), b2 + hsB, voffB);
            PG8_WAIT_V(6); PG8_BAR; PG8_MMA(1, 1, At, B1); PG8_BAR;
            PG8_LDB(B0, 1, 0); PG8_SCHED; PG8_LDA(At, 1, 0); PG8_STAGE(PG8_SA(0, 1), a2 + hsA, voffA);
            PG8_WAIT_L(8); PG8_BAR; PG8_WAIT_L(0); PG8_MMA(0, 0, At, B0); PG8_BAR; PG8_SCHED;
            PG8_LDB(B1, 1, 1); PG8_STAGE(PG8_SB(1, 0), b3, voffB);
            PG8_BAR; PG8_WAIT_L(0); PG8_MMA(0, 1, At, B1); PG8_BAR;
            PG8_LDA(At, 1, 1); PG8_STAGE(PG8_SA(1, 0), a3, voffA);
            PG8_BAR; PG8_WAIT_L(0); PG8_MMA(1, 0, At, B0); PG8_BAR; PG8_SCHED;
            PG8_STAGE(PG8_SB(1, 1), b3 + hsB, voffB);
            PG8_WAIT_V(6); PG8_BAR; PG8_MMA(1, 1, At, B1); PG8_BAR;
            }
        }
        if constexpr (ALIGN_EPI) { if (wr == 0) PG8_BAR; }
        { Unit uc; (void)S.next(ui, uc); E(acc, uc, wr, wc, fr, fq); }
        if (!has_next) break;
#pragma unroll
        for (int a = 0; a < 2; ++a)
#pragma unroll
            for (int b = 0; b < 2; ++b)
#pragma unroll
                for (int m = 0; m < 4; ++m)
#pragma unroll
                    for (int n = 0; n < 2; ++n) acc[a][b][m][n] = (f32x4){0.f, 0.f, 0.f, 0.f};
        cA = nA; cB = nB; ++ui;
        if constexpr (ALIGN_EPI) { if (wr == 1) PG8_BAR; }
    }
    PG8_WAIT_V(0);
    if constexpr (!ALIGN_EPI) { if (wr == 0) PG8_BAR; }
    PG8_BAR;
#undef PG8_SA
#undef PG8_SB
#undef PG8_STAGE
#undef PG8_LDA
#undef PG8_LDB
#undef PG8_MMA
#undef PG8_WAIT_V
#undef PG8_WAIT_L
#undef PG8_BAR
#undef PG8_SCHED
}

struct EpiStore {
    static constexpr bool PERM = true;
    __device__ __forceinline__ void operator()(const f32x4 (&acc)[2][2][4][2], const Unit& u, int wr, int wc, int fr, int fq) const {
        bf16* base = (bf16*)u.o; int row0 = wr * 64 + fr, col0 = wc * 32 + 8 * fq; asm volatile("" : "+v"(row0), "+v"(col0)); const bool act = u.x0 != 0;
#pragma unroll
        for (int ai = 0; ai < 2; ++ai)
#pragma unroll
            for (int m = 0; m < 4; ++m) { bf16* rowp = base + (size_t)(row0 + ai * HALF + m * 16) * u.ldo + col0;
#pragma unroll
                for (int bj = 0; bj < 2; ++bj) { f32x4 v0 = acc[ai][bj][m][0], v1 = acc[ai][bj][m][1];
                    if (act) {
#pragma unroll
                        for (int j = 0; j < 4; ++j) { v0[j] = gelu_tanh_f(v0[j]); v1[j] = gelu_tanh_f(v1[j]); } }
                    v4u w; w.x = cvt_pk_bf16(v0[0], v0[1]); w.y = cvt_pk_bf16(v0[2], v0[3]); w.z = cvt_pk_bf16(v1[0], v1[1]); w.w = cvt_pk_bf16(v1[2], v1[3]);
                    *(v4u*)(rowp + bj * HALF) = w; } }
    }
};
struct EpiSwiGLU {
    static constexpr bool PERM = true;
    __device__ __forceinline__ void operator()(const f32x4 (&acc)[2][2][4][2], const Unit& u, int wr, int wc, int fr, int fq) const {
        bf16* base = (bf16*)u.o; int row0 = wr * 64 + fr, col0 = wc * 32 + 8 * fq; asm volatile("" : "+v"(row0), "+v"(col0));
#pragma unroll
        for (int ai = 0; ai < 2; ++ai)
#pragma unroll
            for (int m = 0; m < 4; ++m) { bf16* rowp = base + (size_t)(row0 + ai * HALF + m * 16) * u.ldo + col0;
                f32x4 h0, h1;
#pragma unroll
                for (int j = 0; j < 4; ++j) { h0[j] = silu_f(acc[ai][0][m][0][j]) * acc[ai][1][m][0][j]; h1[j] = silu_f(acc[ai][0][m][1][j]) * acc[ai][1][m][1][j]; }
                v4u w; w.x = cvt_pk_bf16(h0[0], h0[1]); w.y = cvt_pk_bf16(h0[2], h0[3]); w.z = cvt_pk_bf16(h1[0], h1[1]); w.w = cvt_pk_bf16(h1[2], h1[3]);
                *(v4u*)rowp = w; }
    }
};
struct EpiResid {
    static constexpr bool PERM = false;
    __device__ __forceinline__ void operator()(const f32x4 (&acc)[2][2][4][2], const Unit& u, int wr, int wc, int fr, int fq) const {
        const float* xs = (const float*)u.p0; float* zo = (float*)u.o; const float* gv = (const float*)u.p1;
        int row0 = wr * 64 + fr, col0 = wc * 32 + 4 * fq; asm volatile("" : "+v"(row0), "+v"(col0));
#pragma unroll
        for (int ai = 0; ai < 2; ++ai)
#pragma unroll
            for (int m = 0; m < 4; ++m) { const size_t off = (size_t)(row0 + ai * HALF + m * 16) * D + col0;
#pragma unroll
                for (int bj = 0; bj < 2; ++bj)
#pragma unroll
                    for (int n = 0; n < 2; ++n) { const f32x4 xv = *(const f32x4*)(xs + off + bj * HALF + n * 16); const f32x4 gvv = *(const f32x4*)(gv + col0 + bj * HALF + n * 16);
                        *(f32x4*)(zo + off + bj * HALF + n * 16) = xv * ALPHA + gvv * acc[ai][bj][m][n]; }
                asm volatile("" ::: "memory"); }
    }
};
struct EpiGLU {
    static constexpr bool PERM = true;
    __device__ __forceinline__ void operator()(const f32x4 (&acc)[2][2][4][2], const Unit& u, int wr, int wc, int fr, int fq) const {
        bf16* base = (bf16*)u.o; const bf16* gp = (const bf16*)u.p0; const float* bias = (const float*)u.p1;
        int row0 = wr * 64 + fr, col0 = wc * 32 + 8 * fq; asm volatile("" : "+v"(row0), "+v"(col0));
#pragma unroll
        for (int ai = 0; ai < 2; ++ai)
#pragma unroll
            for (int m = 0; m < 4; ++m) { const int r = row0 + ai * HALF + m * 16;
#pragma unroll
                for (int bj = 0; bj < 2; ++bj) { const v4u gw = *(const v4u*)(gp + (size_t)r * u.x0 + col0 + bj * HALF);
                    const f32x4 b0 = *(const f32x4*)(bias + col0 + bj * HALF), b1 = *(const f32x4*)(bias + col0 + bj * HALF + 4);
                    const f32x4 a0 = acc[ai][bj][m][0] + b0, a1 = acc[ai][bj][m][1] + b1;
                    const float o0 = bflo(gw.x) * sigmoid_f(a0[0]), o1 = bfhi(gw.x) * sigmoid_f(a0[1]), o2 = bflo(gw.y) * sigmoid_f(a0[2]), o3 = bfhi(gw.y) * sigmoid_f(a0[3]);
                    const float o4 = bflo(gw.z) * sigmoid_f(a1[0]), o5 = bfhi(gw.z) * sigmoid_f(a1[1]), o6 = bflo(gw.w) * sigmoid_f(a1[2]), o7 = bfhi(gw.w) * sigmoid_f(a1[3]);
                    v4u w; w.x = cvt_pk_bf16(o0, o1); w.y = cvt_pk_bf16(o2, o3); w.z = cvt_pk_bf16(o4, o5); w.w = cvt_pk_bf16(o6, o7);
                    *(v4u*)(base + (size_t)r * u.ldo + col0 + bj * HALF) = w; }
                asm volatile("" ::: "memory"); }
    }
};
}

struct Params { const float* in[32]; float* out; unsigned char* ws; int ph_lo, ph_hi; };
enum { I_X = 0, I_C, I_CTX, I_CCTX, I_WMOD, I_BMOD, I_LNG, I_LNB, I_EV_WIN, I_EV_WOUT, I_EV_SINK, I_EV_W1, I_EV_W3, I_EV_W2, I_OD_WIN, I_A_RE, I_A_IM, I_LOG_DT,
       I_B_RE, I_B_IM, I_C_RE, I_C_IM, I_SSM_D, I_WGLU, I_BGLU, I_WS, I_BS, I_OD_WOUT, I_ROUTER, I_MW1, I_MW3, I_MW2 };

constexpr int LDS_RING = 131072, LDS_MISC = LDS_RING + 320, LDS_BYTES = 147456;
constexpr int NWAVES = 8, NTHREADS = 512;

struct Frame {
    LAS unsigned char* lds;
    int tid, lane, wave, G, bid, gw, NGW;
    unsigned char* ws;
    unsigned* ctl;
};

using pg8::Unit;
struct SchedStd {
    int nN, nUnits, G, c; const char* A; const char* B; char* O; size_t aStep, bStep, oRow, oCol; int ldo, act_from;
    __device__ __forceinline__ bool next(int i, Unit& u) const {
        const int L = i * G + c; if (L >= nUnits) return false;
        const int pm = L / nN, pn = L - pm * nN;
        u.a = A + (size_t)pm * aStep; u.b = B + (size_t)pn * bStep; u.o = O + (size_t)pm * oRow + (size_t)pn * oCol; u.p0 = nullptr; u.p1 = nullptr; u.ldo = ldo; u.x0 = (pn >= act_from) ? 1 : 0; return true;
    }
};
struct SchedEvIn {
    int G, c; const char* H; const char* Wqkv; const char* Wpq; char* QKV; char* PQT; char* PQTC;
    __device__ __forceinline__ bool next(int i, Unit& u) const {
        int L = i * G + c; u.p0 = nullptr; u.p1 = nullptr; u.x0 = 0;
        constexpr int NQ = (T / 256) * 3, NP = 4 * (TL / 256), NPC = 4 * (TC / 256);
        if (L < NQ) { const int pm = L / 3, pn = L - pm * 3;
            u.a = H + (size_t)pm * 256 * D * 2; u.b = Wqkv + (size_t)pn * 256 * D * 2; u.o = QKV + ((size_t)pm * 256 * 768 + pn * 256) * 2; u.ldo = 768; return true; }
        L -= NQ;
        if (L < NP) { const int tt = L >> 2, pm = L & 3, b = tt >> 4, n0 = (tt & 15) * 256, isq = pm >> 1, ch0 = (pm & 1) * 256;
            u.a = Wpq + (size_t)pm * 256 * D * 2; u.b = H + (size_t)tt * 256 * D * 2;
            u.o = PQT + ((((size_t)b * 512 + ch0) * 2 + isq) * 4096 + n0) * 2; u.ldo = 8192; return true; }
        L -= NP;
        if (L < NPC) { const int b = L >> 2, pm = L & 3, isq = pm >> 1, ch0 = (pm & 1) * 256;
            u.a = Wpq + (size_t)pm * 256 * D * 2; u.b = H + ((size_t)TL + (size_t)b * 256) * D * 2;
            u.o = PQTC + (((size_t)b * 512 + ch0) * 2 + isq) * 256 * 2; u.ldo = 512; return true; }
        return false;
    }
};
struct SchedDft {
    int G, c; const char* F; const char* PQT; char* MIX;
    __device__ __forceinline__ bool next(int i, Unit& u) const {
        const int L = i * G + c; if (L >= 512) return false;
        const int b = L >> 5, r = L & 31, pm = r >> 1, pn = r & 1;
        u.a = F + (size_t)pm * 256 * 8192 * 2; u.b = PQT + ((size_t)b * 512 + pn * 256) * 8192 * 2;
        u.o = MIX + (((size_t)b * 4096 + pm * 256) * D + pn * 256) * 2; u.p0 = nullptr; u.p1 = nullptr; u.ldo = D; u.x0 = 0; return true;
    }
};
struct SchedDftC {
    int G, c; const char* F; const char* PQTC; char* MIX;
    __device__ __forceinline__ bool next(int i, Unit& u) const {
        const int L = i * G + (G - 1 - c); if (L >= 32) return false;
        const int b = L >> 1, pn = L & 1;
        u.a = F; u.b = PQTC + ((size_t)b * 512 + pn * 256) * 512 * 2;
        u.o = MIX + (((size_t)TL + (size_t)b * 256) * D + pn * 256) * 2; u.p0 = nullptr; u.p1 = nullptr; u.ldo = D; u.x0 = 0; return true;
    }
};
struct SchedResid {
    int G, c, nUnits; const char* A; size_t aStep; const char* W; size_t bStep; const float* xl; const float* xc; float* zl; float* zc; const float* gate;
    __device__ __forceinline__ bool next(int i, Unit& u) const {
        const int L = i * G + c; if (L >= nUnits) return false;
        const int pm = L >> 2, pn = L & 3;
        u.a = A + (size_t)pm * aStep; u.b = W + (size_t)pn * bStep;
        const bool isc = pm >= TL / 256; const int pr = isc ? pm - TL / 256 : pm; const int mrow = isc ? 16 : (pm >> 4);
        const size_t off = ((size_t)pr * 256 * D + pn * 256);
        u.p0 = (const char*)((isc ? xc : xl) + off); u.o = (char*)((isc ? zc : zl) + off); u.p1 = (const char*)(gate + (size_t)mrow * 6144 + pn * 256); u.ldo = D; u.x0 = 0; return true;
    }
};
struct SchedGlu {
    int G, c; const char* P; const char* W; char* MIX; const float* bias;
    __device__ __forceinline__ bool next(int i, Unit& u) const {
        const int L = i * G + c; if (L >= (T / 256) * 2) return false;
        const int pm = L >> 1, pn = L & 1;
        u.a = P + (size_t)pm * 256 * 1536 * 2; u.b = W + (size_t)pn * 256 * 512 * 2; u.o = MIX + ((size_t)pm * 256 * D + pn * 256) * 2;
        u.p0 = P + ((size_t)pm * 256 * 1536 + pn * 256) * 2; u.p1 = (const char*)(bias + pn * 256); u.ldo = D; u.x0 = 1536; return true;
    }
};
struct SchedMoeUp {
    int G, c, nUnits, rt0; int toff[9]; const char* HS; const char* W; char* HID;
    __device__ __forceinline__ bool next(int i, Unit& u) const {
        const int L = i * G + c; if (L >= nUnits) return false;
        const int rl = L / 28, pn = L - rl * 28, rt = rt0 + rl; int e = 0;
#pragma unroll
        for (int k = 1; k < 8; ++k) e += (rt >= toff[k]) ? 1 : 0;
        u.a = HS + (size_t)rt * 256 * D * 2; u.b = W + ((size_t)e * 7168 + pn * 256) * D * 2; u.o = HID + ((size_t)rl * 256 * EH + pn * 128) * 2;
        u.p0 = nullptr; u.p1 = nullptr; u.ldo = EH; u.x0 = 0; return true;
    }
};
struct SchedMoeDown {
    int G, c, nUnits, rt0; int toff[9]; const char* HID; const char* W; char* Y;
    __device__ __forceinline__ bool next(int i, Unit& u) const {
        const int L = i * G + c; if (L >= nUnits) return false;
        const int rl = L >> 2, pn = L & 3, rt = rt0 + rl; int e = 0;
#pragma unroll
        for (int k = 1; k < 8; ++k) e += (rt >= toff[k]) ? 1 : 0;
        u.a = HID + (size_t)rl * 256 * EH * 2; u.b = W + ((size_t)e * 1024 + pn * 256) * EH * 2; u.o = Y + ((size_t)rt * 256 * D + pn * 256) * 2;
        u.p0 = nullptr; u.p1 = nullptr; u.ldo = D; u.x0 = 0; return true;
    }
};

__device__ __forceinline__ void tr_item(const float* W, int ldn, bf16* WT, int ldk, int k0, int n0, int drow0, LAS float* scr, int lane) {
#pragma unroll 8
    for (int i = 0; i < 32; ++i) { const int kk = 2 * i + (lane >> 5); scr[kk * 33 + (lane & 31)] = W[(size_t)(k0 + kk) * ldn + n0 + (lane & 31)]; }
    LDS_WAIT(); asm volatile("" ::: "memory");
    const int c = lane & 7;
#pragma unroll
    for (int j = 0; j < 4; ++j) { const int n = (lane >> 3) + 8 * j; const LAS float* s = scr + (8 * c) * 33 + n;
        v4u o; o.x = cvt_pk_bf16(s[0 * 33], s[1 * 33]); o.y = cvt_pk_bf16(s[2 * 33], s[3 * 33]); o.z = cvt_pk_bf16(s[4 * 33], s[5 * 33]); o.w = cvt_pk_bf16(s[6 * 33], s[7 * 33]);
        *(v4u*)(WT + (size_t)(drow0 + n) * ldk + k0 + 8 * c) = o; }
    LDS_WAIT(); asm volatile("" ::: "memory");
}
__device__ __forceinline__ void tr_job(const float* W, int ldn, int N, bf16* WT, int ldk, int mode, int roff, int item, LAS float* scr, int lane) {
    const int nblk = N / 32, kb = item / nblk, nb = item - kb * nblk, n0 = nb * 32;
    const int drow0 = mode ? ((n0 >> 7) * 256 + (n0 & 127) + roff) : (roff + n0);
    tr_item(W, ldn, WT, ldk, kb * 64, n0, drow0, scr, lane);
}
__device__ __forceinline__ void cvt_item(const Params& p, int r, LAS float* scr, int lane) {
    unsigned char* ws = p.ws;
    constexpr int EV_ITEMS = 384 + 512 + 3 * 1408;
    constexpr int ODS_ITEMS = 768 + 128 + 512;
    constexpr int EXP_ITEMS = 3 * 1792, MOE_ITEMS = 8 * EXP_ITEMS;
    if (r < 2 * EV_ITEMS) { const int li = r / EV_ITEMS; r -= li * EV_ITEMS; unsigned char* base = ws + WS_EV + li * EV_STRIDE;
        if (r < 384) { tr_job(p.in[I_EV_WIN] + (size_t)li * D * 1280 + 512, 1280, 768, (bf16*)(base + EV_WQKV), D, 0, 0, r, scr, lane); return; } r -= 384;
        if (r < 512) { tr_job(p.in[I_EV_WOUT] + (size_t)li * D * D, D, D, (bf16*)(base + EV_WOUT), D, 0, 0, r, scr, lane); return; } r -= 512;
        if (r < 1408) { tr_job(p.in[I_EV_W1] + (size_t)li * D * FFH, FFH, FFH, (bf16*)(base + EV_W13), D, 1, 0, r, scr, lane); return; } r -= 1408;
        if (r < 1408) { tr_job(p.in[I_EV_W3] + (size_t)li * D * FFH, FFH, FFH, (bf16*)(base + EV_W13), D, 1, 128, r, scr, lane); return; } r -= 1408;
        tr_job(p.in[I_EV_W2] + (size_t)li * FFH * D, D, D, (bf16*)(base + EV_W2), FFH, 0, 0, r, scr, lane); return; }
    r -= 2 * EV_ITEMS;
    if (r < 2 * ODS_ITEMS) { const int li = r / ODS_ITEMS; r -= li * ODS_ITEMS; unsigned char* base = ws + WS_OD + li * OD_STRIDE;
        if (r < 768) { tr_job(p.in[I_OD_WIN] + (size_t)li * D * 1536, 1536, 1536, (bf16*)(base + OD_WIN), D, 0, 0, r, scr, lane); return; } r -= 768;
        if (r < 128) { tr_job(p.in[I_WGLU] + (size_t)li * 512 * 512, 512, 512, (bf16*)(base + OD_WGLU), 512, 0, 0, r, scr, lane); return; } r -= 128;
        tr_job(p.in[I_OD_WOUT] + (size_t)li * D * D, D, D, (bf16*)(base + OD_WOUT), D, 0, 0, r, scr, lane); return; }
    r -= 2 * ODS_ITEMS;
    { const int li = r / MOE_ITEMS; r -= li * MOE_ITEMS; const int e = r / EXP_ITEMS; r -= e * EXP_ITEMS; unsigned char* base = ws + WS_OD + li * OD_STRIDE;
        const size_t we = (size_t)li * NEXP + e;
        if (r < 1792) { tr_job(p.in[I_MW1] + we * D * EH, EH, EH, (bf16*)(base + OD_MW13) + (size_t)e * 7168 * D, D, 1, 0, r, scr, lane); return; } r -= 1792;
        if (r < 1792) { tr_job(p.in[I_MW3] + we * D * EH, EH, EH, (bf16*)(base + OD_MW13) + (size_t)e * 7168 * D, D, 1, 128, r, scr, lane); return; } r -= 1792;
        tr_job(p.in[I_MW2] + we * EH * D, D, D, (bf16*)(base + OD_MW2) + (size_t)e * D * EH, EH, 0, 0, r, scr, lane); }
}
constexpr int CVT_ITEMS = 2 * 5120 + 2 * 1408 + 2 * 8 * 3 * 1792;

__device__ __forceinline__ void fold_unit(const Params& p, Frame& F, int unit) {
    const int li = unit >> 6, g = (unit >> 4) & 3, k0 = (unit & 15) * 64;
    LAS float* tile = (LAS float*)F.lds;
    LAS float* trig = tile + 64 * 129;
    const float* W = p.in[I_EV_WIN] + (size_t)li * D * 1280;
    for (int e = F.tid; e < 64 * 128; e += NTHREADS) { const int k = e >> 7, c = e & 127; tile[k * 129 + c] = W[(size_t)(k0 + k) * 1280 + g * 128 + c]; }
    if (F.tid < 128) { float s, c; sincospif((float)F.tid / 64.0f, &s, &c); trig[F.tid] = c * 0.08838834764831845f; trig[128 + F.tid] = s * 0.08838834764831845f; }
    __syncthreads();
    bf16* WT = (bf16*)(p.ws + WS_EV + li * EV_STRIDE + EV_WPQ);
    const int k = F.lane, mg = F.wave;
    for (int mm = 0; mm < 16; ++mm) { const int m = mg * 16 + mm; float sp = 0.f, sq = 0.f;
        for (int c = 0; c < 128; ++c) { const float w = tile[k * 129 + c]; const int ph = (m * c) & 127; sp += w * trig[ph]; sq += w * trig[128 + ph]; }
        WT[(size_t)(g * 128 + m) * D + k0 + k] = f2bf(sp); WT[(size_t)(512 + g * 128 + m) * D + k0 + k] = f2bf(sq); }
    __syncthreads();
}

__device__ __forceinline__ void row_load(const float* row, int lane, f32x4 (&v)[4]) {
#pragma unroll
    for (int j = 0; j < 4; ++j) v[j] = *(const f32x4*)(row + 256 * j + 4 * lane);
}
__device__ __forceinline__ void row_store(float* row, int lane, const f32x4 (&v)[4]) {
#pragma unroll
    for (int j = 0; j < 4; ++j) *(f32x4*)(row + 256 * j + 4 * lane) = v[j];
}
__device__ __forceinline__ void row_store_bf16(bf16* row, int lane, const f32x4 (&v)[4]) {
#pragma unroll
    for (int j = 0; j < 4; ++j) { v2u w; w.x = cvt_pk_bf16(v[j][0], v[j][1]); w.y = cvt_pk_bf16(v[j][2], v[j][3]); *(v2u*)(row + 256 * j + 4 * lane) = w; }
}
__device__ __forceinline__ void row_layernorm(f32x4 (&v)[4], const float* g, const float* b, int lane) {
    float s = 0.f;
#pragma unroll
    for (int j = 0; j < 4; ++j) s += (v[j][0] + v[j][1]) + (v[j][2] + v[j][3]);
    const float mean = wave_sum(s) * (1.f / D); float q = 0.f;
#pragma unroll
    for (int j = 0; j < 4; ++j) { v[j] = v[j] - mean; q += (v[j][0] * v[j][0] + v[j][1] * v[j][1]) + (v[j][2] * v[j][2] + v[j][3] * v[j][3]); }
    const float rstd = rsqrtf(wave_sum(q) * (1.f / D) + LN_EPS);
#pragma unroll
    for (int j = 0; j < 4; ++j) { const f32x4 gg = *(const f32x4*)(g + 256 * j + 4 * lane), bb = *(const f32x4*)(b + 256 * j + 4 * lane); v[j] = v[j] * rstd * gg + bb; }
}
__device__ __forceinline__ void row_modulate(f32x4 (&h)[4], const f32x4 (&v)[4], const float* sc, const float* sh, int lane) {
#pragma unroll
    for (int j = 0; j < 4; ++j) { const f32x4 s = *(const f32x4*)(sc + 256 * j + 4 * lane), t = *(const f32x4*)(sh + 256 * j + 4 * lane); h[j] = v[j] * (s + 1.0f) + t; }
}

typedef const __attribute__((address_space(4))) Params* PP;
#define PIN(i) ((const float*)pp->in[i])
#define DECL_LDS extern __shared__ __attribute__((aligned(16))) unsigned char lds_raw[]
#define PHASE_FN static __device__ __forceinline__ void

__device__ __forceinline__ Frame make_frame(PP pp, unsigned char* lds_generic) {
    Frame F;
    F.lds = (LAS unsigned char*)lds_generic;
    { int t_ = threadIdx.x; asm volatile("" : "+v"(t_)); F.tid = t_; }
    F.lane = F.tid & 63; F.wave = __builtin_amdgcn_readfirstlane(F.tid >> 6);
    F.G = gridDim.x; F.bid = blockIdx.x; F.gw = F.bid * NWAVES + F.wave; F.NGW = F.G * NWAVES;
    F.ws = (unsigned char*)pp->ws; F.ctl = (unsigned*)(F.ws + WS_CTL);
    return F;
}
#define FRAME() DECL_LDS; asm volatile("" : "+s"(pp)); Frame F = make_frame(pp, lds_raw); unsigned char* ws = F.ws; (void)ws

PHASE_FN grid_bar(PP pp) {
    FRAME();
    XcdBarrier bar; bar.bar = F.ctl + CW_BAR; bar.x = xb_xcc_id(); bar.st = (volatile LAS unsigned*)(F.lds + LDS_MISC) + 8;
    xcd_barrier(bar);
}

PHASE_FN ph_fold(PP pp) {
    FRAME();
    Params p; p.ws = ws; p.in[I_EV_WIN] = PIN(I_EV_WIN);
    for (int u = F.bid; u < 128; u += F.G) fold_unit(p, F, u);
}
PHASE_FN ph_mod(PP pp) {
    FRAME();
    float* MOD = (float*)(ws + WS_MOD);
    LAS float* sc = (LAS float*)F.lds;
    const float* cin = PIN(I_C); const float* ccin = PIN(I_CCTX);
    for (int e = F.tid; e < 17 * D; e += NTHREADS) { const int r = e >> 10, k = e & 1023; const float v = (r < 16) ? cin[r * D + k] : ccin[k]; sc[e] = silu_f(v); }
    __syncthreads();
    for (int grp = F.gw; grp < DEPTH * 6144 / 64; grp += F.NGW) {
        const int col = grp * 64 + F.lane, l = col / 6144, j = col - l * 6144;
        const float* W = PIN(I_WMOD) + (size_t)l * D * 6144 + j;
        float acc[17];
#pragma unroll
        for (int r = 0; r < 17; ++r) acc[r] = 0.f;
        for (int k = 0; k < D; k += 4) {
            const float w0 = W[(size_t)(k + 0) * 6144], w1 = W[(size_t)(k + 1) * 6144], w2 = W[(size_t)(k + 2) * 6144], w3 = W[(size_t)(k + 3) * 6144];
#pragma unroll
            for (int r = 0; r < 17; ++r) { const f32x4 s = *(const LAS f32x4*)(sc + r * D + k); acc[r] += s[0] * w0 + s[1] * w1 + s[2] * w2 + s[3] * w3; }
        }
        const float bm = PIN(I_BMOD)[l * 6144 + j];
#pragma unroll
        for (int r = 0; r < 17; ++r) MOD[((size_t)l * 17 + r) * 6144 + j] = acc[r] + bm;
    }
    __syncthreads();
}
PHASE_FN ph_cvt(PP pp) {
    FRAME();
    Params p; p.ws = ws;
    p.in[I_EV_WIN] = PIN(I_EV_WIN); p.in[I_EV_WOUT] = PIN(I_EV_WOUT); p.in[I_EV_W1] = PIN(I_EV_W1); p.in[I_EV_W3] = PIN(I_EV_W3); p.in[I_EV_W2] = PIN(I_EV_W2);
    p.in[I_OD_WIN] = PIN(I_OD_WIN); p.in[I_WGLU] = PIN(I_WGLU); p.in[I_OD_WOUT] = PIN(I_OD_WOUT); p.in[I_MW1] = PIN(I_MW1); p.in[I_MW3] = PIN(I_MW3); p.in[I_MW2] = PIN(I_MW2);
    LAS float* scr = (LAS float*)(F.lds + F.wave * 16384);
    for (int it = F.gw; it < CVT_ITEMS; it += F.NGW) cvt_item(p, it, scr, F.lane);
}
PHASE_FN ph_dftmat(PP pp) {
    FRAME();
    bf16* F4 = (bf16*)(ws + WS_F4096);
    for (int it = F.bid * NTHREADS + F.tid; it < 4096 * 1024; it += F.G * NTHREADS) {
        const int k = it >> 10, n0 = (it & 1023) * 8; const bool isq = n0 >= 4096; const int nb = n0 & 4095;
        float v[8];
#pragma unroll
        for (int j = 0; j < 8; ++j) { const int phs = (k * (nb + j)) & 4095; float s, c; sincospif((float)phs * (1.0f / 2048.0f), &s, &c); v[j] = isq ? -s * (1.f / 64.f) : c * (1.f / 64.f); }
        v4u w; w.x = cvt_pk_bf16(v[0], v[1]); w.y = cvt_pk_bf16(v[2], v[3]); w.z = cvt_pk_bf16(v[4], v[5]); w.w = cvt_pk_bf16(v[6], v[7]);
        *(v4u*)(F4 + (size_t)k * 8192 + n0) = w;
    }
    bf16* F2 = (bf16*)(ws + WS_F256);
    for (int it = F.bid * NTHREADS + F.tid; it < 256 * 64; it += F.G * NTHREADS) {
        const int k = it >> 6, n0 = (it & 63) * 8; const bool isq = n0 >= 256; const int nb = n0 & 255;
        float v[8];
#pragma unroll
        for (int j = 0; j < 8; ++j) { const int phs = (k * (nb + j)) & 255; float s, c; sincospif((float)phs * (1.0f / 128.0f), &s, &c); v[j] = isq ? -s * (1.f / 16.f) : c * (1.f / 16.f); }
        v4u w; w.x = cvt_pk_bf16(v[0], v[1]); w.y = cvt_pk_bf16(v[2], v[3]); w.z = cvt_pk_bf16(v[4], v[5]); w.w = cvt_pk_bf16(v[6], v[7]);
        *(v4u*)(F2 + (size_t)k * 512 + n0) = w;
    }
}
PHASE_FN ph_pro_b(PP pp) {
    FRAME();
    const float* MOD = (const float*)(ws + WS_MOD); bf16* Hb = (bf16*)(ws + WS_H);
    const float* xin = PIN(I_X); const float* cin = PIN(I_CTX);
    for (int r = F.gw; r < T; r += F.NGW) {
        const bool isc = r >= TL; const float* xr = isc ? cin + (size_t)(r - TL) * D : xin + (size_t)r * D;
        const float* m = MOD + (size_t)(isc ? 16 : (r >> 12)) * 6144;
        f32x4 v[4], h[4]; row_load(xr, F.lane, v); row_modulate(h, v, m + 1024, m, F.lane); row_store_bf16(Hb + (size_t)r * D, F.lane, h);
    }
}

PHASE_FN ph_e1(PP pp, int layer) {
    FRAME();
    unsigned char* evw = ws + WS_EV + (layer >> 1) * EV_STRIDE; unsigned char* BIG = ws + WS_BIG;
    SchedEvIn S{F.G, F.bid, (const char*)(ws + WS_H), (const char*)(evw + EV_WQKV), (const char*)(evw + EV_WPQ), (char*)(BIG + BIG_QKV), (char*)(BIG + BIG_PQT), (char*)(BIG + BIG_PQTC)};
    pg8::gemm_phase<pg8::EpiStore, SchedEvIn, true, true>(F.lds, F.tid, pg8::Dims{D, D, D}, S, pg8::EpiStore{});
}
PHASE_FN ph_e2_dft(PP pp) {
    FRAME();
    unsigned char* BIG = ws + WS_BIG;
    SchedDft S{F.G, F.bid, (const char*)(ws + WS_F4096), (const char*)(BIG + BIG_PQT), (char*)(BIG + BIG_MIX)};
    pg8::gemm_phase<pg8::EpiStore, SchedDft, true, true>(F.lds, F.tid, pg8::Dims{8192, 8192, 8192}, S, pg8::EpiStore{});
}
PHASE_FN ph_e2_dftc(PP pp) {
    FRAME();
    unsigned char* BIG = ws + WS_BIG;
    SchedDftC S{F.G, F.bid, (const char*)(ws + WS_F256), (const char*)(BIG + BIG_PQTC), (char*)(BIG + BIG_MIX)};
    pg8::gemm_phase<pg8::EpiStore, SchedDftC, true, true>(F.lds, F.tid, pg8::Dims{512, 512, 512}, S, pg8::EpiStore{});
}
PHASE_FN ph_e2_rope(PP pp) {
    FRAME();
    bf16* QKV = (bf16*)(ws + WS_BIG + BIG_QKV);
    LAS f32x2* cs = (LAS f32x2*)F.lds;
    __syncthreads();
    for (int e = F.tid; e < 1024; e += NTHREADS) { const int pos = e >> 4, i = e & 15; const float inv = powf(10000.0f, -(float)i / 16.0f); float s, c; sincosf((float)pos * inv, &s, &c); cs[e] = (f32x2){c, s}; }
    __syncthreads();
    for (int it = F.bid * NTHREADS + F.tid; it < TL * 80; it += F.G * NTHREADS) {
        const int r = it / 80, q = it - r * 80, hh = q >> 3, ax = (q >> 2) & 1, i0 = (q & 3) * 4;
        const int n = r & 4095, pos = ax ? (n & 63) : (n >> 6);
        bf16* base = QKV + (size_t)r * 768 + hh * 64 + ax * 32 + i0;
        const v2u a = *(const v2u*)base, b = *(const v2u*)(base + 16);
        const float x1[4] = {bflo(a.x), bfhi(a.x), bflo(a.y), bfhi(a.y)}, x2[4] = {bflo(b.x), bfhi(b.x), bflo(b.y), bfhi(b.y)};
        float o1[4], o2[4];
#pragma unroll
        for (int j = 0; j < 4; ++j) { const f32x2 t = cs[pos * 16 + i0 + j]; o1[j] = x1[j] * t.x - x2[j] * t.y; o2[j] = x1[j] * t.y + x2[j] * t.x; }
        v2u wa, wb; wa.x = cvt_pk_bf16(o1[0], o1[1]); wa.y = cvt_pk_bf16(o1[2], o1[3]); wb.x = cvt_pk_bf16(o2[0], o2[1]); wb.y = cvt_pk_bf16(o2[2], o2[3]);
        *(v2u*)base = wa; *(v2u*)(base + 16) = wb;
    }
    __syncthreads();
}
PHASE_FN ph_e3_attn(PP pp, int layer) {
    FRAME();
    const bf16* QKV = (const bf16*)(ws + WS_BIG + BIG_QKV); bf16* MIX = (bf16*)(ws + WS_BIG + BIG_MIX);
    LAS float* qs = (LAS float*)(F.lds + F.wave * 12288);
    LAS f32x4* pb = (LAS f32x4*)(F.lds + F.wave * 12288 + 1024);
    const float* sinkp = PIN(I_EV_SINK) + (layer >> 1) * 8;
    for (int task = F.gw; task < T * 2; task += F.NGW) {
        const int r = task >> 1, hkv = task & 1; const bool isc = r >= TL;
        const int b = isc ? ((r - TL) >> 8) : (r >> 12), n = r & 4095;
        const int klo = isc ? 0 : (n - 128 < 0 ? 0 : n - 128), khi = isc ? -1 : (n + 128 > 4095 ? 4095 : n + 128);
        const int nloc = khi - klo + 1, nk = nloc + 256;
        const size_t lat0 = (size_t)b * 4096 + klo, ctx0 = (size_t)TL + (size_t)b * 256;
#pragma unroll
        for (int g = 0; g < 4; ++g) qs[g * 64 + F.lane] = bf2f(QKV[(size_t)r * 768 + (hkv * 4 + g) * 64 + F.lane]) * 0.125f;
        LDS_WAIT(); asm volatile("" ::: "memory");
        float sreg[9][4];
#pragma unroll
        for (int c = 0; c < 9; ++c) {
            const int kk = c * 64 + F.lane; const bool valid = kk < nk;
            float s0 = 0.f, s1 = 0.f, s2 = 0.f, s3 = 0.f;
            if (c * 64 < nk) {
                const int kc = valid ? kk : 0;
                const size_t krow = (kc < nloc) ? lat0 + kc : ctx0 + (kc - nloc);
                const v4u* kp = (const v4u*)(QKV + krow * 768 + 512 + hkv * 64);
#pragma unroll
                for (int d8 = 0; d8 < 8; ++d8) { const v4u kw = kp[d8];
                    const float kf[8] = {bflo(kw.x), bfhi(kw.x), bflo(kw.y), bfhi(kw.y), bflo(kw.z), bfhi(kw.z), bflo(kw.w), bfhi(kw.w)};
#pragma unroll
                    for (int hq = 0; hq < 2; ++hq) { const f32x4 q0 = *(const LAS f32x4*)(qs + 0 * 64 + d8 * 8 + hq * 4), q1 = *(const LAS f32x4*)(qs + 1 * 64 + d8 * 8 + hq * 4), q2 = *(const LAS f32x4*)(qs + 2 * 64 + d8 * 8 + hq * 4), q3 = *(const LAS f32x4*)(qs + 3 * 64 + d8 * 8 + hq * 4);
#pragma unroll
                        for (int j = 0; j < 4; ++j) { const float kv = kf[hq * 4 + j]; s0 += q0[j] * kv; s1 += q1[j] * kv; s2 += q2[j] * kv; s3 += q3[j] * kv; } } }
            }
            sreg[c][0] = valid ? s0 : -1e30f; sreg[c][1] = valid ? s1 : -1e30f; sreg[c][2] = valid ? s2 : -1e30f; sreg[c][3] = valid ? s3 : -1e30f;
        }
        float den[4];
#pragma unroll
        for (int g = 0; g < 4; ++g) { float m = sreg[0][g];
#pragma unroll
            for (int c = 1; c < 9; ++c) m = fmaxf(m, sreg[c][g]);
            const float sk = sinkp[hkv * 4 + g]; m = fmaxf(wave_max(m), sk); float l = 0.f;
#pragma unroll
            for (int c = 0; c < 9; ++c) { sreg[c][g] = __expf(sreg[c][g] - m); l += sreg[c][g]; }
            den[g] = 1.0f / (wave_sum(l) + __expf(sk - m)); }
#pragma unroll
        for (int c = 0; c < 9; ++c) pb[c * 64 + F.lane] = (f32x4){sreg[c][0] * den[0], sreg[c][1] * den[1], sreg[c][2] * den[2], sreg[c][3] * den[3]};
        LDS_WAIT(); asm volatile("" ::: "memory");
        float o0 = 0.f, o1 = 0.f, o2 = 0.f, o3 = 0.f;
        const bf16* vb = QKV + 640 + hkv * 64 + F.lane;
        for (int kk = 0; kk < nk; ++kk) {
            const size_t krow = (kk < nloc) ? lat0 + kk : ctx0 + (kk - nloc);
            const float vv = bf2f(vb[krow * 768]); const f32x4 pv = pb[kk];
            o0 += pv[0] * vv; o1 += pv[1] * vv; o2 += pv[2] * vv; o3 += pv[3] * vv;
        }
        bf16* orow = MIX + (size_t)r * D + 512 + hkv * 256 + F.lane;
        orow[0] = f2bf(o0); orow[64] = f2bf(o1); orow[128] = f2bf(o2); orow[192] = f2bf(o3);
        LDS_WAIT(); asm volatile("" ::: "memory");
    }
}
PHASE_FN ph_outproj(PP pp, int layer) {
    FRAME();
    const int li = layer >> 1; const bool odd = (layer & 1) != 0;
    const int TR = (layer == DEPTH - 1) ? TL : T;
    const char* W = odd ? (const char*)(ws + WS_OD + li * OD_STRIDE + OD_WOUT) : (const char*)(ws + WS_EV + li * EV_STRIDE + EV_WOUT);
    float* XC = (float*)(ws + WS_XC); float* out = (float*)pp->out;
    const float* xl_src = (layer == 0) ? PIN(I_X) : out; const float* xc_src = (layer == 0) ? PIN(I_CTX) : XC;
    const float* modl = (const float*)(ws + WS_MOD) + (size_t)layer * 17 * 6144;
    SchedResid S{F.G, F.bid, (TR / 256) * 4, (const char*)(ws + WS_BIG + BIG_MIX), (size_t)256 * D * 2, W, (size_t)256 * D * 2, xl_src, xc_src, out, XC, modl + 2048};
    pg8::gemm_phase<pg8::EpiResid, SchedResid, true, true>(F.lds, F.tid, pg8::Dims{D, D, D}, S, pg8::EpiResid{});
}
PHASE_FN ph_ln_mid(PP pp, int layer) {
    FRAME();
    float* XC = (float*)(ws + WS_XC); float* out = (float*)pp->out; bf16* Hb = (bf16*)(ws + WS_H);
    const float* modl = (const float*)(ws + WS_MOD) + (size_t)layer * 17 * 6144;
    const float* lng0 = PIN(I_LNG) + (size_t)(layer * 2) * D; const float* lnb0 = PIN(I_LNB) + (size_t)(layer * 2) * D;
    for (int r = F.gw; r < T; r += F.NGW) {
        const bool isc = r >= TL; float* xr = isc ? XC + (size_t)(r - TL) * D : out + (size_t)r * D;
        const float* m = modl + (size_t)(isc ? 16 : (r >> 12)) * 6144;
        f32x4 v[4], h[4]; row_load(xr, F.lane, v); row_layernorm(v, lng0, lnb0, F.lane); row_store(xr, F.lane, v);
        row_modulate(h, v, m + 4096, m + 3072, F.lane); row_store_bf16(Hb + (size_t)r * D, F.lane, h);
    }
}
PHASE_FN ph_e6(PP pp, int layer) {
    FRAME();
    unsigned char* evw = ws + WS_EV + (layer >> 1) * EV_STRIDE;
    SchedStd S{22, (T / 256) * 22, F.G, F.bid, (const char*)(ws + WS_H), (const char*)(evw + EV_W13), (char*)(ws + WS_BIG + BIG_HID), (size_t)256 * D * 2, (size_t)256 * D * 2, (size_t)256 * FFH * 2, (size_t)128 * 2, FFH, 1 << 30};
    pg8::gemm_phase<pg8::EpiSwiGLU, SchedStd, true, true>(F.lds, F.tid, pg8::Dims{D, D, D}, S, pg8::EpiSwiGLU{});
}
PHASE_FN ph_e7(PP pp, int layer) {
    FRAME();
    unsigned char* evw = ws + WS_EV + (layer >> 1) * EV_STRIDE;
    float* XC = (float*)(ws + WS_XC); float* out = (float*)pp->out;
    const float* modl = (const float*)(ws + WS_MOD) + (size_t)layer * 17 * 6144;
    SchedResid S{F.G, F.bid, (T / 256) * 4, (const char*)(ws + WS_BIG + BIG_HID), (size_t)256 * FFH * 2, (const char*)(evw + EV_W2), (size_t)256 * FFH * 2, out, XC, out, XC, modl + 5120};
    pg8::gemm_phase<pg8::EpiResid, SchedResid, true, true>(F.lds, F.tid, pg8::Dims{FFH, FFH, FFH}, S, pg8::EpiResid{});
}
PHASE_FN ph_ln_end(PP pp, int layer) {
    FRAME();
    float* XC = (float*)(ws + WS_XC); float* out = (float*)pp->out; bf16* Hb = (bf16*)(ws + WS_H);
    const float* modn = (const float*)(ws + WS_MOD) + (size_t)(layer + 1) * 17 * 6144;
    const float* lng1 = PIN(I_LNG) + (size_t)(layer * 2 + 1) * D; const float* lnb1 = PIN(I_LNB) + (size_t)(layer * 2 + 1) * D;
    for (int r = F.gw; r < T; r += F.NGW) {
        const bool isc = r >= TL; float* xr = isc ? XC + (size_t)(r - TL) * D : out + (size_t)r * D;
        const float* m = modn + (size_t)(isc ? 16 : (r >> 12)) * 6144;
        f32x4 v[4], h[4]; row_load(xr, F.lane, v); row_layernorm(v, lng1, lnb1, F.lane); row_store(xr, F.lane, v);
        row_modulate(h, v, m + 1024, m, F.lane); row_store_bf16(Hb + (size_t)r * D, F.lane, h);
    }
}

PHASE_FN ph_o1(PP pp, int layer) {
    FRAME();
    unsigned char* odw = ws + WS_OD + (layer >> 1) * OD_STRIDE;
    SchedStd S{6, (T / 256) * 6, F.G, F.bid, (const char*)(ws + WS_H), (const char*)(odw + OD_WIN), (char*)(ws + WS_BIG + BIG_P), (size_t)256 * D * 2, (size_t)256 * D * 2, (size_t)256 * 1536 * 2, (size_t)256 * 2, 1536, 2};
    pg8::gemm_phase<pg8::EpiStore, SchedStd, true, true>(F.lds, F.tid, pg8::Dims{D, D, D}, S, pg8::EpiStore{});
}
PHASE_FN ph_o2_s5(PP pp, int layer) {
    FRAME();
    const int li = layer >> 1;
    const bf16* P = (const bf16*)(ws + WS_BIG + BIG_P);
    bf16* YS0 = (bf16*)(ws + WS_H); bf16* YS1 = YS0 + (size_t)T * 512;
    if (F.wave < 4) {
        const int task = F.bid * 4 + F.wave;
        if (task < NBATCH * 2 * 32) {
            const int b = task >> 6, dir = (task >> 5) & 1, g = task & 31, pl = F.lane;
            const int sidx = ((li * 2 + dir) * 32 + g);
            const float are = PIN(I_A_RE)[sidx * 64 + pl], aim = PIN(I_A_IM)[sidx * 64 + pl], dt = expf(PIN(I_LOG_DT)[sidx]);
            const float mag = expf(are * dt); float sn, cn; sincosf(aim * dt, &sn, &cn);
            const float lre = mag * cn, lim = mag * sn;
            const float den = 1.0f / (are * are + aim * aim);
            const float fre = ((lre - 1.0f) * are + lim * aim) * den, fim = (lim * are - (lre - 1.0f) * aim) * den;
            float bre[16], bim[16], cre[16], cim[16];
            const float* Bre = PIN(I_B_RE); const float* Bim = PIN(I_B_IM); const float* Cre = PIN(I_C_RE); const float* Cim = PIN(I_C_IM);
#pragma unroll
            for (int s = 0; s < 16; ++s) { const float br = Bre[((size_t)sidx * 64 + pl) * 16 + s], bi = Bim[((size_t)sidx * 64 + pl) * 16 + s];
                bre[s] = fre * br - fim * bi; bim[s] = fre * bi + fim * br;
                cre[s] = Cre[((size_t)sidx * 16 + s) * 64 + pl]; cim[s] = Cim[((size_t)sidx * 16 + s) * 64 + pl]; }
            bf16* YS = dir ? YS1 : YS0;
            float hre = 0.f, him = 0.f;
            const int nsteps = NCTX + SEQ;
#define S5_ROW(st_) ((st_) < NCTX ? (TL + b * NCTX + (dir ? (NCTX - 1 - (st_)) : (st_))) : (b * SEQ + (dir ? (SEQ - 1 - ((st_) - NCTX)) : ((st_) - NCTX))))
            v4u pa0, pb0, pa1, pb1;
            { const v4u* q0 = (const v4u*)(P + (size_t)S5_ROW(0) * 1536 + g * 16); pa0 = q0[0]; pb0 = q0[1];
              const v4u* q1 = (const v4u*)(P + (size_t)S5_ROW(1) * 1536 + g * 16); pa1 = q1[0]; pb1 = q1[1]; }
            for (int st = 0; st < nsteps; ++st) {
                const int row = S5_ROW(st);
                const v4u ua = pa0, ub = pb0; pa0 = pa1; pb0 = pb1;
                { const int st2 = (st + 2 < nsteps) ? st + 2 : nsteps - 1; const v4u* q2 = (const v4u*)(P + (size_t)S5_ROW(st2) * 1536 + g * 16); pa1 = q2[0]; pb1 = q2[1]; }
                const float uf[16] = {bflo(ua.x), bfhi(ua.x), bflo(ua.y), bfhi(ua.y), bflo(ua.z), bfhi(ua.z), bflo(ua.w), bfhi(ua.w),
                                      bflo(ub.x), bfhi(ub.x), bflo(ub.y), bfhi(ub.y), bflo(ub.z), bfhi(ub.z), bflo(ub.w), bfhi(ub.w)};
                float ure = 0.f, uim = 0.f;
#pragma unroll
                for (int s = 0; s < 16; ++s) { ure += bre[s] * uf[s]; uim += bim[s] * uf[s]; }
                const float nre = lre * hre - lim * him + ure, nim = lre * him + lim * hre + uim;
                hre = nre; him = nim;
                float y[16];
#pragma unroll
                for (int s = 0; s < 16; ++s) y[s] = cre[s] * hre - cim[s] * him;
                float y8[8], y4[4], y2[2], y1;
                { const bool up_ = (F.lane & 32) != 0;
#pragma unroll
                  for (int k = 0; k < 8; ++k) { const float send = up_ ? y[k] : y[8 + k], keep = up_ ? y[8 + k] : y[k]; y8[k] = keep + __shfl_xor(send, 32); } }
                { const bool up_ = (F.lane & 16) != 0;
#pragma unroll
                  for (int k = 0; k < 4; ++k) { const float send = up_ ? y8[k] : y8[4 + k], keep = up_ ? y8[4 + k] : y8[k]; y4[k] = keep + __shfl_xor(send, 16); } }
                { const bool up_ = (F.lane & 8) != 0;
#pragma unroll
                  for (int k = 0; k < 2; ++k) { const float send = up_ ? y4[k] : y4[2 + k], keep = up_ ? y4[2 + k] : y4[k]; y2[k] = keep + __shfl_xor(send, 8); } }
                { const bool up_ = (F.lane & 4) != 0; const float send = up_ ? y2[0] : y2[1], keep = up_ ? y2[1] : y2[0]; y1 = keep + __shfl_xor(send, 4); }
                y1 += __shfl_xor(y1, 2); y1 += __shfl_xor(y1, 1);
                if ((F.lane & 3) == 0) { const int s = ((F.lane >> 5) & 1) * 8 + ((F.lane >> 4) & 1) * 4 + ((F.lane >> 3) & 1) * 2 + ((F.lane >> 2) & 1);
                    YS[(size_t)row * 512 + g * 16 + s] = f2bf(y1); }
            }
#undef S5_ROW
        }
    }
}
PHASE_FN ph_o2_gmlp(PP pp, int layer) {
    FRAME();
    const int li = layer >> 1; const int TR = (layer == DEPTH - 1) ? TL : T;
    const bf16* P = (const bf16*)(ws + WS_BIG + BIG_P); bf16* MIX = (bf16*)(ws + WS_BIG + BIG_MIX);
    LAS float* Wn = (LAS float*)F.lds;
    LAS float* Vs = (LAS float*)(F.lds + 65536);
    const int nchunk = TR / 128;
    const float* ws_w = PIN(I_WS) + (size_t)li * 4 * 128 * 128; const float* bs = PIN(I_BS) + (size_t)li * 4 * 128;
    __syncthreads();
    for (int ch = F.bid; ch < nchunk; ch += F.G) {
        const size_t row0 = (size_t)ch * 128;
        float mu_r[16], rs_r[16];
#pragma unroll
        for (int t = 0; t < 16; ++t) { const v4u w = *(const v4u*)(P + (row0 + F.wave * 16 + t) * 1536 + 1024 + F.lane * 8);
            const float f[8] = {bflo(w.x), bfhi(w.x), bflo(w.y), bfhi(w.y), bflo(w.z), bfhi(w.z), bflo(w.w), bfhi(w.w)};
            float s = 0.f;
#pragma unroll
            for (int j = 0; j < 8; ++j) s += f[j];
            const float mu = wave_sum(s) * (1.f / 512.f); float q = 0.f;
#pragma unroll
            for (int j = 0; j < 8; ++j) q += (f[j] - mu) * (f[j] - mu);
            mu_r[t] = mu; rs_r[t] = rsqrtf(wave_sum(q) * (1.f / 512.f) + LN_EPS); }
        for (int h = 0; h < 4; ++h) {
            __syncthreads();
            for (int e = F.tid; e < 128 * 128; e += NTHREADS) Wn[e] = ws_w[(size_t)h * 16384 + e];
#pragma unroll
            for (int t = 0; t < 16; ++t) { const int j = F.wave * 16 + t; const unsigned w = *(const unsigned*)(P + (row0 + j) * 1536 + 1024 + h * 128 + F.lane * 2);
                Vs[j * 128 + F.lane * 2] = (bflo(w) - mu_r[t]) * rs_r[t]; Vs[j * 128 + F.lane * 2 + 1] = (bfhi(w) - mu_r[t]) * rs_r[t]; }
            __syncthreads();
            const int ti = F.tid >> 5, te = F.tid & 31;
            f32x4 acc[8];
#pragma unroll
            for (int k = 0; k < 8; ++k) acc[k] = (f32x4){0.f, 0.f, 0.f, 0.f};
            for (int j = 0; j < 128; ++j) {
                const f32x4 vv = *(const LAS f32x4*)(Vs + j * 128 + te * 4);
#pragma unroll
                for (int k = 0; k < 8; ++k) acc[k] += vv * Wn[(ti * 8 + k) * 128 + j];
            }
#pragma unroll
            for (int k = 0; k < 8; ++k) { const int i = ti * 8 + k; const float bb = bs[h * 128 + i];
                const v2u uw = *(const v2u*)(P + (row0 + i) * 1536 + 512 + h * 128 + te * 4);
                v2u o; o.x = cvt_pk_bf16(bflo(uw.x) * (acc[k][0] + bb), bfhi(uw.x) * (acc[k][1] + bb)); o.y = cvt_pk_bf16(bflo(uw.y) * (acc[k][2] + bb), bfhi(uw.y) * (acc[k][3] + bb));
                *(v2u*)(MIX + (row0 + i) * D + 512 + h * 128 + te * 4) = o; }
        }
    }
    __syncthreads();
}
PHASE_FN ph_o3(PP pp, int layer) {
    FRAME();
    const int li = layer >> 1; const int TR = (layer == DEPTH - 1) ? TL : T;
    bf16* P = (bf16*)(ws + WS_BIG + BIG_P);
    const bf16* YS0 = (const bf16*)(ws + WS_H); const bf16* YS1 = YS0 + (size_t)T * 512;
    const float* dsk = PIN(I_SSM_D) + (size_t)li * 512;
    for (int it = F.bid * NTHREADS + F.tid; it < TR * 64; it += F.G * NTHREADS) {
        const int r = it >> 6, c0 = (it & 63) * 8;
        bf16* up = P + (size_t)r * 1536 + c0;
        const v4u uw = *(const v4u*)up, a = *(const v4u*)(YS0 + (size_t)r * 512 + c0), b = *(const v4u*)(YS1 + (size_t)r * 512 + c0);
        const f32x4 d0 = *(const f32x4*)(dsk + c0), d1 = *(const f32x4*)(dsk + c0 + 4);
        float s[8];
        s[0] = bflo(a.x) + bflo(b.x) + d0[0] * bflo(uw.x); s[1] = bfhi(a.x) + bfhi(b.x) + d0[1] * bfhi(uw.x);
        s[2] = bflo(a.y) + bflo(b.y) + d0[2] * bflo(uw.y); s[3] = bfhi(a.y) + bfhi(b.y) + d0[3] * bfhi(uw.y);
        s[4] = bflo(a.z) + bflo(b.z) + d1[0] * bflo(uw.z); s[5] = bfhi(a.z) + bfhi(b.z) + d1[1] * bfhi(uw.z);
        s[6] = bflo(a.w) + bflo(b.w) + d1[2] * bflo(uw.w); s[7] = bfhi(a.w) + bfhi(b.w) + d1[3] * bfhi(uw.w);
#pragma unroll
        for (int j = 0; j < 8; ++j) s[j] = gelu_tanh_f(s[j]);
        v4u w; w.x = cvt_pk_bf16(s[0], s[1]); w.y = cvt_pk_bf16(s[2], s[3]); w.z = cvt_pk_bf16(s[4], s[5]); w.w = cvt_pk_bf16(s[6], s[7]);
        *(v4u*)up = w;
    }
}
PHASE_FN ph_o4(PP pp, int layer) {
    FRAME();
    const int li = layer >> 1;
    unsigned char* odw = ws + WS_OD + li * OD_STRIDE;
    SchedGlu S{F.G, F.bid, (const char*)(ws + WS_BIG + BIG_P), (const char*)(odw + OD_WGLU), (char*)(ws + WS_BIG + BIG_MIX), PIN(I_BGLU) + (size_t)li * 512};
    pg8::gemm_phase<pg8::EpiGLU, SchedGlu, true, true>(F.lds, F.tid, pg8::Dims{512, 1536, 512}, S, pg8::EpiGLU{});
}
PHASE_FN ph_o6(PP pp, int layer) {
    FRAME();
    const int li = layer >> 1; const int TR = (layer == DEPTH - 1) ? TL : T;
    float* XC = (float*)(ws + WS_XC); float* out = (float*)pp->out; bf16* Hb = (bf16*)(ws + WS_H);
    const float* modl = (const float*)(ws + WS_MOD) + (size_t)layer * 17 * 6144;
    const float* lng0 = PIN(I_LNG) + (size_t)(layer * 2) * D; const float* lnb0 = PIN(I_LNB) + (size_t)(layer * 2) * D;
    int* tokE = (int*)(ws + WS_TOK); int* tokS0 = tokE + T; int* tokS1 = tokS0 + T; float* tokG0 = (float*)(tokS1 + T);
    unsigned* ecnt = F.ctl + CW_CNT + li * 64;
    LAS float* wr_s = (LAS float*)F.lds;
    const float* rw = PIN(I_ROUTER) + (size_t)li * D * 8;
    __syncthreads();
    for (int e = F.tid; e < D * 8; e += NTHREADS) wr_s[e] = rw[e];
    __syncthreads();
    for (int r = F.gw; r < TR; r += F.NGW) {
        const bool isc = r >= TL; float* xr = isc ? XC + (size_t)(r - TL) * D : out + (size_t)r * D;
        const float* m = modl + (size_t)(isc ? 16 : (r >> 12)) * 6144;
        f32x4 v[4], h[4]; row_load(xr, F.lane, v); row_layernorm(v, lng0, lnb0, F.lane); row_store(xr, F.lane, v);
        row_modulate(h, v, m + 4096, m + 3072, F.lane); row_store_bf16(Hb + (size_t)r * D, F.lane, h);
        float lg[8];
#pragma unroll
        for (int e = 0; e < 8; ++e) lg[e] = 0.f;
#pragma unroll
        for (int j = 0; j < 4; ++j)
#pragma unroll
            for (int q = 0; q < 4; ++q) { const int col = 256 * j + 4 * F.lane + q; const f32x4 w0 = *(const LAS f32x4*)(wr_s + col * 8), w1 = *(const LAS f32x4*)(wr_s + col * 8 + 4); const float hv = h[j][q];
                lg[0] += hv * w0[0]; lg[1] += hv * w0[1]; lg[2] += hv * w0[2]; lg[3] += hv * w0[3]; lg[4] += hv * w1[0]; lg[5] += hv * w1[1]; lg[6] += hv * w1[2]; lg[7] += hv * w1[3]; }
#pragma unroll
        for (int e = 0; e < 8; ++e) lg[e] = wave_sum(lg[e]);
        if (F.lane == 0) {
            int e0 = 0; float v0 = lg[0];
#pragma unroll
            for (int e = 1; e < 8; ++e) if (lg[e] > v0) { v0 = lg[e]; e0 = e; }
            int e1 = -1; float v1 = -3.0e38f;
#pragma unroll
            for (int e = 0; e < 8; ++e) if (e != e0 && lg[e] > v1) { v1 = lg[e]; e1 = e; }
            const float w0 = 1.0f / (1.0f + __expf(v1 - v0));
            const int s0 = (int)atomicAdd(ecnt + e0, 1u), s1 = (int)atomicAdd(ecnt + e1, 1u);
            tokE[r] = e0 | (e1 << 8); tokS0[r] = s0; tokS1[r] = s1; tokG0[r] = w0;
        }
    }
    __syncthreads();
}
PHASE_FN ph_o7(PP pp, int layer) {
    FRAME();
    const int li = layer >> 1; const int TR = (layer == DEPTH - 1) ? TL : T;
    const bf16* Hb = (const bf16*)(ws + WS_H); bf16* HS = (bf16*)(ws + WS_BIG + BIG_HS);
    int* tokE = (int*)(ws + WS_TOK); int* tokS0 = tokE + T; int* tokS1 = tokS0 + T; int* tokP0 = tokS1 + 2 * T; int* tokP1 = tokP0 + T;
    unsigned* ecnt = F.ctl + CW_CNT + li * 64;
    int roff[8]; { int acc = 0;
#pragma unroll
        for (int e = 0; e < 8; ++e) { roff[e] = acc * 256; acc += ((int)__hip_atomic_load(ecnt + e, __ATOMIC_RELAXED, __HIP_MEMORY_SCOPE_AGENT) + 255) >> 8; } }
    for (int r = F.gw; r < TR; r += F.NGW) {
        const int ee = tokE[r], e0 = ee & 255, e1 = ee >> 8;
        int p0 = tokS0[r], p1 = tokS1[r];
#pragma unroll
        for (int e = 0; e < 8; ++e) { p0 += (e == e0) ? roff[e] : 0; p1 += (e == e1) ? roff[e] : 0; }
        const v4u* src = (const v4u*)(Hb + (size_t)r * D); v4u* d0 = (v4u*)(HS + (size_t)p0 * D); v4u* d1 = (v4u*)(HS + (size_t)p1 * D);
        const v4u a = src[F.lane], b = src[64 + F.lane];
        d0[F.lane] = a; d0[64 + F.lane] = b; d1[F.lane] = a; d1[64 + F.lane] = b;
        if (F.lane == 0) { tokP0[r] = p0; tokP1[r] = p1; }
    }
}
PHASE_FN ph_moe_up(PP pp, int layer, int chn) {
    FRAME();
    const int li = layer >> 1; unsigned char* odw = ws + WS_OD + li * OD_STRIDE; unsigned* ecnt = F.ctl + CW_CNT + li * 64;
    SchedMoeUp S; S.G = F.G; S.c = F.bid; S.rt0 = chn * MOE_CHUNK_TILES; S.HS = (const char*)(ws + WS_BIG + BIG_HS); S.W = (const char*)(odw + OD_MW13); S.HID = (char*)(ws + WS_H);
    { int acc = 0; S.toff[0] = 0;
#pragma unroll
        for (int e = 0; e < 8; ++e) { acc += ((int)__hip_atomic_load(ecnt + e, __ATOMIC_RELAXED, __HIP_MEMORY_SCOPE_AGENT) + 255) >> 8; S.toff[e + 1] = acc; } }
    int nt_ = S.toff[8] - S.rt0; nt_ = nt_ < 0 ? 0 : (nt_ > MOE_CHUNK_TILES ? MOE_CHUNK_TILES : nt_); S.nUnits = nt_ * 28;
    pg8::gemm_phase<pg8::EpiSwiGLU, SchedMoeUp, true, true>(F.lds, F.tid, pg8::Dims{D, D, D}, S, pg8::EpiSwiGLU{});
}
PHASE_FN ph_moe_down(PP pp, int layer, int chn) {
    FRAME();
    const int li = layer >> 1; unsigned char* odw = ws + WS_OD + li * OD_STRIDE; unsigned* ecnt = F.ctl + CW_CNT + li * 64;
    SchedMoeDown S; S.G = F.G; S.c = F.bid; S.rt0 = chn * MOE_CHUNK_TILES; S.HID = (const char*)(ws + WS_H); S.W = (const char*)(odw + OD_MW2); S.Y = (char*)(ws + WS_BIG + BIG_HS);
    { int acc = 0; S.toff[0] = 0;
#pragma unroll
        for (int e = 0; e < 8; ++e) { acc += ((int)__hip_atomic_load(ecnt + e, __ATOMIC_RELAXED, __HIP_MEMORY_SCOPE_AGENT) + 255) >> 8; S.toff[e + 1] = acc; } }
    int nt_ = S.toff[8] - S.rt0; nt_ = nt_ < 0 ? 0 : (nt_ > MOE_CHUNK_TILES ? MOE_CHUNK_TILES : nt_); S.nUnits = nt_ * 4;
    pg8::gemm_phase<pg8::EpiStore, SchedMoeDown, true, true>(F.lds, F.tid, pg8::Dims{EH, EH, EH}, S, pg8::EpiStore{});
}
PHASE_FN ph_o9(PP pp, int layer) {
    FRAME();
    const int TR = (layer == DEPTH - 1) ? TL : T; const bool last = layer == DEPTH - 1;
    float* XC = (float*)(ws + WS_XC); float* out = (float*)pp->out; bf16* Hb = (bf16*)(ws + WS_H); const bf16* HS = (const bf16*)(ws + WS_BIG + BIG_HS);
    const float* modl = (const float*)(ws + WS_MOD) + (size_t)layer * 17 * 6144;
    const float* modn = (const float*)(ws + WS_MOD) + (size_t)(last ? layer : layer + 1) * 17 * 6144;
    const float* lng1 = PIN(I_LNG) + (size_t)(layer * 2 + 1) * D; const float* lnb1 = PIN(I_LNB) + (size_t)(layer * 2 + 1) * D;
    const int* tokE = (const int*)(ws + WS_TOK); const float* tokG0 = (const float*)(tokE + 3 * T); const int* tokP0 = tokE + 4 * T; const int* tokP1 = tokP0 + T;
    for (int r = F.gw; r < TR; r += F.NGW) {
        const bool isc = r >= TL; float* xr = isc ? XC + (size_t)(r - TL) * D : out + (size_t)r * D;
        const int mrow = isc ? 16 : (r >> 12);
        const float* g2 = modl + (size_t)mrow * 6144 + 5120;
        const int p0 = tokP0[r], p1 = tokP1[r]; const float w0 = tokG0[r], w1 = 1.0f - w0;
        const bf16* y0 = HS + (size_t)p0 * D; const bf16* y1 = HS + (size_t)p1 * D;
        f32x4 v[4], h[4]; row_load(xr, F.lane, v);
#pragma unroll
        for (int j = 0; j < 4; ++j) { const v2u a = *(const v2u*)(y0 + 256 * j + 4 * F.lane), b = *(const v2u*)(y1 + 256 * j + 4 * F.lane); const f32x4 gg = *(const f32x4*)(g2 + 256 * j + 4 * F.lane);
            f32x4 f; f[0] = w0 * bflo(a.x) + w1 * bflo(b.x); f[1] = w0 * bfhi(a.x) + w1 * bfhi(b.x); f[2] = w0 * bflo(a.y) + w1 * bflo(b.y); f[3] = w0 * bfhi(a.y) + w1 * bfhi(b.y);
            v[j] = v[j] * ALPHA + gg * f; }
        row_layernorm(v, lng1, lnb1, F.lane); row_store(xr, F.lane, v);
        if (!last) { const float* m = modn + (size_t)mrow * 6144; row_modulate(h, v, m + 1024, m, F.lane); row_store_bf16(Hb + (size_t)r * D, F.lane, h); }
    }
}

constexpr int N_PHASES = 2 + 2 * (8 + 8 + 2 * MOE_NCHUNK);
__global__ void __launch_bounds__(NTHREADS, 2) fwd_kernel(Params p_unused) {
    DECL_LDS;
    PP pp = (PP)__builtin_amdgcn_kernarg_segment_ptr();
    {
        LAS unsigned char* lds = (LAS unsigned char*)lds_raw;
        for (int u = threadIdx.x; u < (LDS_BYTES - LDS_RING) / 4; u += NTHREADS) ((LAS unsigned*)(lds + LDS_RING))[u] = 0u;
        __syncthreads();
#if !MK_SPLIT
        (void)xcd_barrier_post((unsigned*)((unsigned char*)pp->ws + WS_CTL) + CW_BAR, (volatile LAS unsigned*)(lds + LDS_MISC) + 8);
#endif
    }
    const int lo = pp->ph_lo, hi = pp->ph_hi; int ph = 0;
#if MK_SPLIT
#define PHASE_END() do { ++ph; } while (0)
#else
#define PHASE_END() do { if (ph >= lo && ph + 1 < hi) grid_bar(pp); ++ph; } while (0)
#endif
#define PHASE_ON() (ph >= lo && ph < hi)

    if (PHASE_ON()) { ph_fold(pp); ph_mod(pp); ph_cvt(pp); ph_dftmat(pp); }
    PHASE_END();
    if (PHASE_ON()) ph_pro_b(pp);
    PHASE_END();
    for (int layer = 0; layer < DEPTH; ++layer) {
        if ((layer & 1) == 0) {
            if (PHASE_ON()) ph_e1(pp, layer);
            PHASE_END();
            if (PHASE_ON()) { ph_e2_dft(pp); ph_e2_dftc(pp); ph_e2_rope(pp); }
            PHASE_END();
            if (PHASE_ON()) ph_e3_attn(pp, layer);
            PHASE_END();
            if (PHASE_ON()) ph_outproj(pp, layer);
            PHASE_END();
            if (PHASE_ON()) ph_ln_mid(pp, layer);
            PHASE_END();
            if (PHASE_ON()) ph_e6(pp, layer);
            PHASE_END();
            if (PHASE_ON()) ph_e7(pp, layer);
            PHASE_END();
            if (PHASE_ON()) ph_ln_end(pp, layer);
            PHASE_END();
        } else {
            if (PHASE_ON()) ph_o1(pp, layer);
            PHASE_END();
            if (PHASE_ON()) { ph_o2_s5(pp, layer); ph_o2_gmlp(pp, layer); }
            PHASE_END();
            if (PHASE_ON()) ph_o3(pp, layer);
            PHASE_END();
            if (PHASE_ON()) ph_o4(pp, layer);
            PHASE_END();
            if (PHASE_ON()) ph_outproj(pp, layer);
            PHASE_END();
            if (PHASE_ON()) ph_o6(pp, layer);
            PHASE_END();
            if (PHASE_ON()) ph_o7(pp, layer);
            PHASE_END();
            for (int chn = 0; chn < MOE_NCHUNK; ++chn) {
                if (PHASE_ON()) ph_moe_up(pp, layer, chn);
                PHASE_END();
                if (PHASE_ON()) ph_moe_down(pp, layer, chn);
                PHASE_END();
            }
            if (PHASE_ON()) ph_o9(pp, layer);
            PHASE_END();
        }
    }
}

extern "C" void kernel_launch(void* const* d_in, const int* in_sizes, int n_in, void* d_out, int out_size, void* d_ws, size_t ws_size, hipStream_t stream) {
    static int grid = 0;
    if (grid == 0) {
        if (n_in != 32 || out_size != TL * D || ws_size < WS_END) { fprintf(stderr, "kernel_launch: unexpected shapes (n_in %d, out %d, ws %zu < %zu)\n", n_in, out_size, ws_size, (size_t)WS_END); grid = -1; return; }
        int dev = 0, cus = 0, per_cu = 0;
        if (hipGetDevice(&dev) != hipSuccess || hipDeviceGetAttribute(&cus, hipDeviceAttributeMultiprocessorCount, dev) != hipSuccess) { grid = -1; return; }
        if (hipFuncSetAttribute((const void*)fwd_kernel, hipFuncAttributeMaxDynamicSharedMemorySize, LDS_BYTES) != hipSuccess) { fprintf(stderr, "kernel_launch: hipFuncSetAttribute failed\n"); grid = -1; return; }
        if (hipOccupancyMaxActiveBlocksPerMultiprocessor(&per_cu, (const void*)fwd_kernel, NTHREADS, LDS_BYTES) != hipSuccess || per_cu < 1) { fprintf(stderr, "kernel_launch: occupancy query says %d\n", per_cu); }
        (void)hipGetLastError();
        grid = cus;
    }
    if (grid < 0) return;
    (void)in_sizes;
    (void)hipMemsetAsync((char*)d_ws + WS_CTL, 0, CTL_ZERO_BYTES, stream);
    Params p{};
    for (int i = 0; i < 32; ++i) p.in[i] = (const float*)d_in[i];
    p.out = (float*)d_out; p.ws = (unsigned char*)d_ws;
#if MK_SPLIT
    for (int ph = 0; ph < N_PHASES; ++ph) { p.ph_lo = ph; p.ph_hi = ph + 1; hipLaunchKernelGGL(fwd_kernel, dim3(grid), dim3(NTHREADS), LDS_BYTES, stream, p); }
#else
    p.ph_lo = 0; p.ph_hi = N_PHASES;
    hipLaunchKernelGGL(fwd_kernel, dim3(grid), dim3(NTHREADS), LDS_BYTES, stream, p);
#endif
}
```

```cpp
#include <hip/hip_runtime.h>
#include <cstdio>
#include <cstdint>

#ifndef MK_SPLIT
#define MK_SPLIT 0
#endif

#define GAS __attribute__((address_space(1)))
#define LAS __attribute__((address_space(3)))
typedef unsigned short bf16;
typedef unsigned v4u __attribute__((ext_vector_type(4)));
typedef unsigned v2u __attribute__((ext_vector_type(2)));
typedef float f32x4 __attribute__((ext_vector_type(4)));
typedef float f32x2 __attribute__((ext_vector_type(2)));
typedef short bf16x8 __attribute__((ext_vector_type(8)));

constexpr int D = 1024, NBATCH = 16, SEQ = 4096, NCTX = 256, DEPTH = 4;
constexpr int TL = NBATCH * SEQ, TC = NBATCH * NCTX, T = TL + TC;
constexpr int FFH = 2816, EH = 3584, NEXP = 8;
constexpr int MOE_CHUNK_TILES = 64, MOE_NCHUNK = 9;
constexpr float ALPHA = 1.6817928305074290860622509524664f;
constexpr float LN_EPS = 1e-5f;

constexpr size_t MiB = (size_t)1 << 20;
constexpr size_t WS_CTL = 0, CTL_ZERO_BYTES = 1 * MiB;
constexpr size_t WS_MOD = 1 * MiB;
constexpr size_t WS_TOK = 3 * MiB;
constexpr size_t WS_XC = 5 * MiB;
constexpr size_t WS_F256 = 21 * MiB;
constexpr size_t WS_F4096 = 22 * MiB;
constexpr size_t WS_EV = 86 * MiB, EV_STRIDE = 22 * MiB;
constexpr size_t EV_WQKV = 0, EV_WPQ = 3 * MiB / 2, EV_WOUT = 7 * MiB / 2, EV_W13 = 11 * MiB / 2, EV_W2 = 33 * MiB / 2;
constexpr size_t WS_OD = 130 * MiB, OD_STRIDE = 174 * MiB;
constexpr size_t OD_WIN = 0, OD_WGLU = 3 * MiB, OD_WOUT = 7 * MiB / 2, OD_MW13 = 11 * MiB / 2, OD_MW2 = 235 * MiB / 2;
constexpr size_t WS_H = 478 * MiB;
constexpr size_t WS_BIG = 614 * MiB;
constexpr size_t BIG_PQT = 0, BIG_PQTC = 128 * MiB, BIG_QKV = 136 * MiB, BIG_MIX = 238 * MiB, BIG_HID = 0, BIG_P = 0, BIG_HS = 0;
constexpr size_t WS_END = 994 * MiB;
constexpr int CW_BAR = 4096, CW_CNT = 16384;

#define LDS_WAIT() asm volatile("s_waitcnt lgkmcnt(0)" ::: "memory")
#define VM_WAIT() asm volatile("s_waitcnt vmcnt(0)" ::: "memory")
__device__ __forceinline__ unsigned cvt_pk_bf16(float lo, float hi) { unsigned r; asm volatile("v_cvt_pk_bf16_f32 %0, %1, %2" : "=v"(r) : "v"(lo), "v"(hi)); return r; }
__device__ __forceinline__ float bflo(unsigned w) { return __uint_as_float(w << 16); }
__device__ __forceinline__ float bfhi(unsigned w) { return __uint_as_float(w & 0xffff0000u); }
__device__ __forceinline__ float bf2f(bf16 b) { return __uint_as_float(((unsigned)b) << 16); }
__device__ __forceinline__ bf16 f2bf(float f) { return (bf16)(cvt_pk_bf16(f, 0.f) & 0xffffu); }
__device__ __forceinline__ float wave_sum(float v) {
#pragma unroll
    for (int o = 1; o < 64; o <<= 1) v += __shfl_xor(v, o);
    return v;
}
__device__ __forceinline__ float wave_max(float v) {
#pragma unroll
    for (int o = 1; o < 64; o <<= 1) v = fmaxf(v, __shfl_xor(v, o));
    return v;
}
__device__ __forceinline__ float silu_f(float x) { return x / (1.f + __expf(-x)); }
__device__ __forceinline__ float sigmoid_f(float x) { return 1.f / (1.f + __expf(-x)); }
__device__ __forceinline__ float gelu_tanh_f(float x) { const float z = 0.7978845608028654f * (x + 0.044715f * x * x * x); return x / (1.f + __expf(-2.f * z)); }

#define XB_TMO      128
#define XB_XCNT(j)  (256  + 64 * (j))
#define XB_XSUB(j)  (1280 + 64 * (j))
#define XB_XGEN(j)  (2304 + 64 * (j))
#define XB_TOP      3328
#define XB_TOPGEN   3392
#define XCD_BAR_WORDS 3456
#define XB_SPIN_CAP (1u << 25)
__device__ __forceinline__ unsigned xb_ld(unsigned* p)              { return __hip_atomic_load(p, __ATOMIC_RELAXED, __HIP_MEMORY_SCOPE_AGENT); }
__device__ __forceinline__ unsigned xb_add(unsigned* p, unsigned v) { return __hip_atomic_fetch_add(p, v, __ATOMIC_RELAXED, __HIP_MEMORY_SCOPE_AGENT); }
__device__ __forceinline__ unsigned xb_xcc_id() { return (unsigned)__builtin_amdgcn_s_getreg((3 << 11) | 20) & 0xFu; }
#define XB_SPIN(cond, bar) do { unsigned _sp = 0; while (cond) { __builtin_amdgcn_s_sleep(1); \
    if ((++_sp & 255u) == 0u) { if (xb_ld(&(bar)[XB_TMO])) break; if (_sp > XB_SPIN_CAP) { atomicAdd(&(bar)[XB_TMO], 1u); break; } } } } while (0)
struct XcdBarrier { unsigned* bar; unsigned x; volatile LAS unsigned* st; };
__device__ __forceinline__ XcdBarrier xcd_barrier_post(unsigned* bar, volatile LAS unsigned* st) {
    XcdBarrier b; b.bar = bar; b.x = xb_xcc_id(); b.st = st;
    if (threadIdx.x == 0) (void)xb_add(&bar[XB_XCNT(b.x)], 1u);
    return b;
}
__device__ __forceinline__ void xcd_barrier_complete(unsigned* bar, unsigned x, unsigned& nloc, unsigned& nx) {
    const unsigned G = gridDim.x * gridDim.y * gridDim.z;
    unsigned sum, cnt, mine, sp = 0u;
    for (;;) {
        sum = 0u; cnt = 0u; mine = 0u;
#pragma unroll
        for (unsigned j = 0; j < 16; ++j) { const unsigned c = xb_ld(&bar[XB_XCNT(j)]); sum += c; cnt += (c > 0u) ? 1u : 0u; mine = (j == x) ? c : mine; }
        if (sum == G) break;
        __builtin_amdgcn_s_sleep(1);
        if ((++sp & 255u) == 0u) { if (xb_ld(&bar[XB_TMO])) break; if (sp > XB_SPIN_CAP) { atomicAdd(&bar[XB_TMO], 1u); break; } }
    }
    nloc = mine > 0u ? mine : 1u; nx = cnt > 0u ? cnt : 1u;
}
__device__ __forceinline__ void xcd_barrier(const XcdBarrier& b) {
    asm volatile("s_waitcnt vmcnt(0)" ::: "memory");
    __syncthreads();
    if (threadIdx.x == 0) {
        unsigned* bar = b.bar;
        __builtin_amdgcn_s_waitcnt(0);
        unsigned nloc = b.st[0], nx = b.st[1];
        if (nloc == 0u) { xcd_barrier_complete(bar, b.x, nloc, nx); b.st[0] = nloc; b.st[1] = nx; }
        const unsigned old = xb_add(&bar[XB_XSUB(b.x)], 1u);
        const unsigned gen = old / nloc;
        if (old + 1u == (gen + 1u) * nloc) {
            __builtin_amdgcn_fence(__ATOMIC_RELEASE, "agent");
            asm volatile("s_waitcnt vmcnt(0)" ::: "memory");
            const unsigned og = xb_add(&bar[XB_TOP], 1u);
            const unsigned tg = og / nx;
            if (og + 1u == (tg + 1u) * nx) xb_add(&bar[XB_TOPGEN], 1u);
            else XB_SPIN(xb_ld(&bar[XB_TOPGEN]) == tg, bar);
            __builtin_amdgcn_fence(__ATOMIC_ACQUIRE, "agent");
            xb_add(&bar[XB_XGEN(b.x)], 1u);
            asm volatile("s_waitcnt vmcnt(0)" ::: "memory");
        } else {
            XB_SPIN(xb_ld(&bar[XB_XGEN(b.x)]) == gen, bar);
            __builtin_amdgcn_fence(__ATOMIC_ACQUIRE, "agent");
            asm volatile("s_waitcnt vmcnt(0)" ::: "memory");
        }
    }
    __syncthreads();
}

namespace pg8 {
constexpr int BM = 256, BK = 64, HALF = 128, HTB = HALF * BK * 2, STAGE_BYTES = 8 * HTB;
__host__ __device__ __forceinline__ int lds_byte(int r, int c) { const int st = (r >> 4) * 2 + (c >> 5), rr = r & 15, cc = c & 31, ob = rr * 64 + cc * 2; return st * 1024 + (ob ^ (((ob >> 9) & 1) << 5)); }
__host__ __device__ __forceinline__ void stage_rc(int b, int& R, int& C) { const int st = b / 1024, sb = b % 1024, swz = sb ^ (((sb >> 9) & 1) << 5); R = (st >> 1) * 16 + swz / 64; C = (st & 1) * 32 + (swz % 64) / 2; }
__host__ __device__ __forceinline__ int perm32(int rho) { const int n = rho >> 4, i = rho & 15; return 8 * (i >> 2) + 4 * n + (i & 3); }

struct Unit { const char* a; const char* b; char* o; const char* p0; const char* p1; int ldo; int x0; };
struct Dims { int K, lda, ldb; };

template <class Epi, class Sched, bool ALIGN_EPI = false, bool SP2 = false>
__device__ __forceinline__ void gemm_phase(LAS unsigned char* lds, const int tid, const Dims g, const Sched& S, const Epi& E) {
    const int wid = __builtin_amdgcn_readfirstlane(tid >> 6), lane = tid & 63, wr = wid >> 2, wc = wid & 3, fr = lane & 15, fq = lane >> 4;
    const int K = g.K, nt = K / BK;
    unsigned voffA[2], voffB[2];
#pragma unroll
    for (int i = 0; i < 2; ++i) { int R, C; stage_rc(tid * 16 + i * 8192, R, C); const int Rb = Epi::PERM ? ((R & ~31) + perm32(R & 31)) : R;
        voffA[i] = (unsigned)(R * g.lda + C) * 2u; voffB[i] = (unsigned)(Rb * g.ldb + C) * 2u; }
    const size_t kstep = (size_t)(BK * 2);
    const size_t hsA = (size_t)HALF * g.lda * 2, hsB = (size_t)HALF * g.ldb * 2;
    const unsigned ldsw = (unsigned)wid * 1024u;
    const int aoff = lds_byte(wr * 64 + fr, fq * 8), boff = lds_byte(wc * 32 + fr, fq * 8);
#define PG8_SA(b, h) (((b) * 2 + (h)) * HTB)
#define PG8_SB(b, h) ((4 + (b) * 2 + (h)) * HTB)
#define PG8_STAGE(bufoff, gbase, voff) do { _Pragma("unroll") for (int _i = 0; _i < 2; ++_i) \
        __builtin_amdgcn_global_load_lds((const unsigned*)((const char*)(gbase) + (voff)[_i]), (LAS unsigned*)(lds + (bufoff) + ldsw + _i * 8192), 16, 0, 0); } while (0)
#define PG8_LDA(dst, b, h) do { _Pragma("unroll") for (int m = 0; m < 4; ++m) _Pragma("unroll") for (int k = 0; k < 2; ++k) dst[m][k] = *(const LAS bf16x8*)(lds + PG8_SA(b, h) + aoff + m * 2048 + k * 1024); } while (0)
#define PG8_LDB(dst, b, h) do { _Pragma("unroll") for (int n = 0; n < 2; ++n) _Pragma("unroll") for (int k = 0; k < 2; ++k) dst[n][k] = *(const LAS bf16x8*)(lds + PG8_SB(b, h) + boff + n * 2048 + k * 1024); } while (0)
#define PG8_MMA(ai, bj, At, Bt) do { __builtin_amdgcn_s_setprio(1); _Pragma("unroll") for (int m = 0; m < 4; ++m) _Pragma("unroll") for (int n = 0; n < 2; ++n) _Pragma("unroll") for (int k = 0; k < 2; ++k) \
        acc[ai][bj][m][n] = __builtin_amdgcn_mfma_f32_16x16x32_bf16(Bt[n][k], At[m][k], acc[ai][bj][m][n], 0, 0, 0); __builtin_amdgcn_s_setprio(0); } while (0)
#define PG8_WAIT_V(n) asm volatile("s_waitcnt vmcnt(" #n ")" ::: "memory")
#define PG8_WAIT_L(n) asm volatile("s_waitcnt lgkmcnt(" #n ")" ::: "memory")
#define PG8_BAR __builtin_amdgcn_s_barrier()
#define PG8_SCHED __builtin_amdgcn_sched_barrier(0)
    int ui = 0;
    const char* cA; const char* cB;
    { Unit u0; if (!S.next(0, u0)) return; cA = u0.a; cB = u0.b; }
    f32x4 acc[2][2][4][2];
#pragma unroll
    for (int a = 0; a < 2; ++a)
#pragma unroll
        for (int b = 0; b < 2; ++b)
#pragma unroll
            for (int m = 0; m < 4; ++m)
#pragma unroll
                for (int n = 0; n < 2; ++n) acc[a][b][m][n] = (f32x4){0.f, 0.f, 0.f, 0.f};
    bf16x8 At[4][2], B0[2][2], B1[2][2];
    if constexpr (SP2) {
        PG8_STAGE(PG8_SB(0, 0), cB, voffB); PG8_STAGE(PG8_SB(0, 1), cB + hsB, voffB); PG8_STAGE(PG8_SA(0, 0), cA, voffA); PG8_STAGE(PG8_SA(0, 1), cA + hsA, voffA);
        if (wr == 1) PG8_BAR;
        PG8_WAIT_V(2); PG8_BAR;
        PG8_STAGE(PG8_SB(1, 0), cB + kstep, voffB); PG8_STAGE(PG8_SA(1, 0), cA + kstep, voffA); PG8_STAGE(PG8_SB(1, 1), cB + hsB + kstep, voffB);
        PG8_WAIT_V(6); PG8_BAR;
    } else {
        PG8_STAGE(PG8_SB(0, 0), cB, voffB); PG8_STAGE(PG8_SA(0, 0), cA, voffA); PG8_STAGE(PG8_SB(0, 1), cB + hsB, voffB); PG8_STAGE(PG8_SA(0, 1), cA + hsA, voffA);
        if (wr == 1) PG8_BAR;
        PG8_WAIT_V(4); PG8_BAR;
        PG8_STAGE(PG8_SB(1, 0), cB + kstep, voffB); PG8_STAGE(PG8_SA(1, 0), cA + kstep, voffA); PG8_STAGE(PG8_SB(1, 1), cB + hsB + kstep, voffB);
        PG8_WAIT_V(6); PG8_BAR;
    }
    for (;;) {
        const char* nA = cA; const char* nB = cB; bool has_next;
        { Unit un; has_next = S.next(ui + 1, un); if (has_next) { nA = un.a; nB = un.b; } }
        for (int t = 0; t < nt; t += 2) {
            const bool last = (t == nt - 2);
            const char* a1 = cA + (size_t)(t + 1) * kstep;
            const char* a2 = last ? nA : cA + (size_t)(t + 2) * kstep; const char* b2 = last ? nB : cB + (size_t)(t + 2) * kstep;
            const char* a3 = a2 + kstep; const char* b3 = b2 + kstep;
            if constexpr (SP2) {
            PG8_LDB(B0, 0, 0); PG8_LDB(B1, 0, 1); PG8_SCHED; PG8_LDA(At, 0, 0); PG8_STAGE(PG8_SA(1, 1), a1 + hsA, voffA);
            PG8_WAIT_V(8); PG8_WAIT_L(0); PG8_BAR; PG8_MMA(0, 0, At, B0); PG8_MMA(0, 1, At, B1); PG8_BAR; PG8_SCHED;
            PG8_LDA(At, 0, 1); PG8_STAGE(PG8_SB(0, 0), b2, voffB); PG8_STAGE(PG8_SB(0, 1), b2 + hsB, voffB); PG8_STAGE(PG8_SA(0, 0), a2, voffA);
            PG8_WAIT_V(8); PG8_WAIT_L(0); PG8_BAR; PG8_MMA(1, 0, At, B0); PG8_MMA(1, 1, At, B1); PG8_BAR; PG8_SCHED;
            PG8_LDB(B0, 1, 0); PG8_LDB(B1, 1, 1); PG8_SCHED; PG8_LDA(At, 1, 0); PG8_STAGE(PG8_SA(0, 1), a2 + hsA, voffA);
            PG8_WAIT_V(8); PG8_WAIT_L(0); PG8_BAR; PG8_MMA(0, 0, At, B0); PG8_MMA(0, 1, At, B1); PG8_BAR; PG8_SCHED;
            PG8_LDA(At, 1, 1); PG8_STAGE(PG8_SB(1, 0), b3, voffB); PG8_STAGE(PG8_SB(1, 1), b3 + hsB, voffB); PG8_STAGE(PG8_SA(1, 0), a3, voffA);
            PG8_WAIT_V(8); PG8_WAIT_L(0); PG8_BAR; PG8_MMA(1, 0, At, B0); PG8_MMA(1, 1, At, B1); PG8_BAR; PG8_SCHED;
            } else {
            PG8_LDB(B0, 0, 0); PG8_SCHED; PG8_LDA(At, 0, 0); PG8_STAGE(PG8_SA(1, 1), a1 + hsA, voffA);
            PG8_WAIT_L(8); PG8_BAR; PG8_WAIT_L(0); PG8_MMA(0, 0, At, B0); PG8_BAR; PG8_SCHED;
            PG8_LDB(B1, 0, 1); PG8_STAGE(PG8_SB(0, 0), b2, voffB);
            PG8_BAR; PG8_WAIT_L(0); PG8_MMA(0, 1, At, B1); PG8_BAR;
            PG8_LDA(At, 0, 1); PG8_STAGE(PG8_SA(0, 0), a2, voffA);
            PG8_BAR; PG8_WAIT_L(0); PG8_MMA(1, 0, At, B0); PG8_BAR; PG8_SCHED;
            PG8_STAGE(PG8_SB(0, 1), b2 + hsB, voffB);
            PG8_WAIT_V(6); PG8_BAR; PG8_MMA(1, 1, At, B1); PG8_BAR;
            PG8_LDB(B0, 1, 0); PG8_SCHED; PG8_LDA(At, 1, 0); PG8_STAGE(PG8_SA(0, 1), a2 + hsA, voffA);
            PG8_WAIT_L(8); PG8_BAR; PG8_WAIT_L(0); PG8_MMA(0, 0, At, B0); PG8_BAR; PG8_SCHED;
            PG8_LDB(B1, 1, 1); PG8_STAGE(PG8_SB(1, 0), b3, voffB);
            PG8_BAR; PG8_WAIT_L(0); PG8_MMA(0, 1, At, B1); PG8_BAR;
            PG8_LDA(At, 1, 1); PG8_STAGE(PG8_SA(1, 0), a3, voffA);
            PG8_BAR; PG8_WAIT_L(0); PG8_MMA(1, 0, At, B0); PG8_BAR; PG8_SCHED;
            PG8_STAGE(PG8_SB(1, 1), b3 + hsB, voffB);
            PG8_WAIT_V(6); PG8_BAR; PG8_MMA(1, 1, At, B1); PG8_BAR;
            }
        }
        if constexpr (ALIGN_EPI) { if (wr == 0) PG8_BAR; }
        { Unit uc; (void)S.next(ui, uc); E(acc, uc, wr, wc, fr, fq); }
        if (!has_next) break;
#pragma unroll
        for (int a = 0; a < 2; ++a)
#pragma unroll
            for (int b = 0; b < 2; ++b)
#pragma unroll
                for (int m = 0; m < 4; ++m)
#pragma unroll
                    for (int n = 0; n < 2; ++n) acc[a][b][m][n] = (f32x4){0.f, 0.f, 0.f, 0.f};
        cA = nA; cB = nB; ++ui;
        if constexpr (ALIGN_EPI) { if (wr == 1) PG8_BAR; }
    }
    PG8_WAIT_V(0);
    if constexpr (!ALIGN_EPI) { if (wr == 0) PG8_BAR; }
    PG8_BAR;
#undef PG8_SA
#undef PG8_SB
#undef PG8_STAGE
#undef PG8_LDA
#undef PG8_LDB
#undef PG8_MMA
#undef PG8_WAIT_V
#undef PG8_WAIT_L
#undef PG8_BAR
#undef PG8_SCHED
}

struct EpiStore {
    static constexpr bool PERM = true;
    __device__ __forceinline__ void operator()(const f32x4 (&acc)[2][2][4][2], const Unit& u, int wr, int wc, int fr, int fq) const {
        bf16* base = (bf16*)u.o; int row0 = wr * 64 + fr, col0 = wc * 32 + 8 * fq; asm volatile("" : "+v"(row0), "+v"(col0)); const bool act = u.x0 != 0;
#pragma unroll
        for (int ai = 0; ai < 2; ++ai)
#pragma unroll
            for (int m = 0; m < 4; ++m) { bf16* rowp = base + (size_t)(row0 + ai * HALF + m * 16) * u.ldo + col0;
#pragma unroll
                for (int bj = 0; bj < 2; ++bj) { f32x4 v0 = acc[ai][bj][m][0], v1 = acc[ai][bj][m][1];
                    if (act) {
#pragma unroll
                        for (int j = 0; j < 4; ++j) { v0[j] = gelu_tanh_f(v0[j]); v1[j] = gelu_tanh_f(v1[j]); } }
                    v4u w; w.x = cvt_pk_bf16(v0[0], v0[1]); w.y = cvt_pk_bf16(v0[2], v0[3]); w.z = cvt_pk_bf16(v1[0], v1[1]); w.w = cvt_pk_bf16(v1[2], v1[3]);
                    *(v4u*)(rowp + bj * HALF) = w; } }
    }
};
struct EpiSwiGLU {
    static constexpr bool PERM = true;
    __device__ __forceinline__ void operator()(const f32x4 (&acc)[2][2][4][2], const Unit& u, int wr, int wc, int fr, int fq) const {
        bf16* base = (bf16*)u.o; int row0 = wr * 64 + fr, col0 = wc * 32 + 8 * fq; asm volatile("" : "+v"(row0), "+v"(col0));
#pragma unroll
        for (int ai = 0; ai < 2; ++ai)
#pragma unroll
            for (int m = 0; m < 4; ++m) { bf16* rowp = base + (size_t)(row0 + ai * HALF + m * 16) * u.ldo + col0;
                f32x4 h0, h1;
#pragma unroll
                for (int j = 0; j < 4; ++j) { h0[j] = silu_f(acc[ai][0][m][0][j]) * acc[ai][1][m][0][j]; h1[j] = silu_f(acc[ai][0][m][1][j]) * acc[ai][1][m][1][j]; }
                v4u w; w.x = cvt_pk_bf16(h0[0], h0[1]); w.y = cvt_pk_bf16(h0[2], h0[3]); w.z = cvt_pk_bf16(h1[0], h1[1]); w.w = cvt_pk_bf16(h1[2], h1[3]);
                *(v4u*)rowp = w; }
    }
};
struct EpiResid {
    static constexpr bool PERM = false;
    __device__ __forceinline__ void operator()(const f32x4 (&acc)[2][2][4][2], const Unit& u, int wr, int wc, int fr, int fq) const {
        const float* xs = (const float*)u.p0; float* zo = (float*)u.o; const float* gv = (const float*)u.p1;
        int row0 = wr * 64 + fr, col0 = wc * 32 + 4 * fq; asm volatile("" : "+v"(row0), "+v"(col0));
#pragma unroll
        for (int ai = 0; ai < 2; ++ai)
#pragma unroll
            for (int m = 0; m < 4; ++m) { const size_t off = (size_t)(row0 + ai * HALF + m * 16) * D + col0;
#pragma unroll
                for (int bj = 0; bj < 2; ++bj)
#pragma unroll
                    for (int n = 0; n < 2; ++n) { const f32x4 xv = *(const f32x4*)(xs + off + bj * HALF + n * 16); const f32x4 gvv = *(const f32x4*)(gv + col0 + bj * HALF + n * 16);
                        *(f32x4*)(zo + off + bj * HALF + n * 16) = xv * ALPHA + gvv * acc[ai][bj][m][n]; }
                asm volatile("" ::: "memory"); }
    }
};
struct EpiGLU {
    static constexpr bool PERM = true;
    __device__ __forceinline__ void operator()(const f32x4 (&acc)[2][2][4][2], const Unit& u, int wr, int wc, int fr, int fq) const {
        bf16* base = (bf16*)u.o; const bf16* gp = (const bf16*)u.p0; const float* bias = (const float*)u.p1;
        int row0 = wr * 64 + fr, col0 = wc * 32 + 8 * fq; asm volatile("" : "+v"(row0), "+v"(col0));
#pragma unroll
        for (int ai = 0; ai < 2; ++ai)
#pragma unroll
            for (int m = 0; m < 4; ++m) { const int r = row0 + ai * HALF + m * 16;
#pragma unroll
                for (int bj = 0; bj < 2; ++bj) { const v4u gw = *(const v4u*)(gp + (size_t)r * u.x0 + col0 + bj * HALF);
                    const f32x4 b0 = *(const f32x4*)(bias + col0 + bj * HALF), b1 = *(const f32x4*)(bias + col0 + bj * HALF + 4);
                    const f32x4 a0 = acc[ai][bj][m][0] + b0, a1 = acc[ai][bj][m][1] + b1;
                    const float o0 = bflo(gw.x) * sigmoid_f(a0[0]), o1 = bfhi(gw.x) * sigmoid_f(a0[1]), o2 = bflo(gw.y) * sigmoid_f(a0[2]), o3 = bfhi(gw.y) * sigmoid_f(a0[3]);
                    const float o4 = bflo(gw.z) * sigmoid_f(a1[0]), o5 = bfhi(gw.z) * sigmoid_f(a1[1]), o6 = bflo(gw.w) * sigmoid_f(a1[2]), o7 = bfhi(gw.w) * sigmoid_f(a1[3]);
                    v4u w; w.x = cvt_pk_bf16(o0, o1); w.y = cvt_pk_bf16(o2, o3); w.z = cvt_pk_bf16(o4, o5); w.w = cvt_pk_bf16(o6, o7);
                    *(v4u*)(base + (size_t)r * u.ldo + col0 + bj * HALF) = w; }
                asm volatile("" ::: "memory"); }
    }
};
}

struct Params { const float* in[32]; float* out; unsigned char* ws; int ph_lo, ph_hi; };
enum { I_X = 0, I_C, I_CTX, I_CCTX, I_WMOD, I_BMOD, I_LNG, I_LNB, I_EV_WIN, I_EV_WOUT, I_EV_SINK, I_EV_W1, I_EV_W3, I_EV_W2, I_OD_WIN, I_A_RE, I_A_IM, I_LOG_DT,
       I_B_RE, I_B_IM, I_C_RE, I_C_IM, I_SSM_D, I_WGLU, I_BGLU, I_WS, I_BS, I_OD_WOUT, I_ROUTER, I_MW1, I_MW3, I_MW2 };

constexpr int LDS_RING = 131072, LDS_MISC = LDS_RING + 320, LDS_BYTES = 147456;
constexpr int NWAVES = 8, NTHREADS = 512;

struct Frame {
    LAS unsigned char* lds;
    int tid, lane, wave, G, bid, gw, NGW;
    unsigned char* ws;
    unsigned* ctl;
};

using pg8::Unit;
struct SchedStd {
    int nN, nUnits, G, c; const char* A; const char* B; char* O; size_t aStep, bStep, oRow, oCol; int ldo, act_from;
    __device__ __forceinline__ bool next(int i, Unit& u) const {
        const int L = i * G + c; if (L >= nUnits) return false;
        const int pm = L / nN, pn = L - pm * nN;
        u.a = A + (size_t)pm * aStep; u.b = B + (size_t)pn * bStep; u.o = O + (size_t)pm * oRow + (size_t)pn * oCol; u.p0 = nullptr; u.p1 = nullptr; u.ldo = ldo; u.x0 = (pn >= act_from) ? 1 : 0; return true;
    }
};
struct SchedEvIn {
    int G, c; const char* H; const char* Wqkv; const char* Wpq; char* QKV; char* PQT; char* PQTC;
    __device__ __forceinline__ bool next(int i, Unit& u) const {
        int L = i * G + c; u.p0 = nullptr; u.p1 = nullptr; u.x0 = 0;
        constexpr int NQ = (T / 256) * 3, NP = 4 * (TL / 256), NPC = 4 * (TC / 256);
        if (L < NQ) { const int pm = L / 3, pn = L - pm * 3;
            u.a = H + (size_t)pm * 256 * D * 2; u.b = Wqkv + (size_t)pn * 256 * D * 2; u.o = QKV + ((size_t)pm * 256 * 768 + pn * 256) * 2; u.ldo = 768; return true; }
        L -= NQ;
        if (L < NP) { const int tt = L >> 2, pm = L & 3, b = tt >> 4, n0 = (tt & 15) * 256, isq = pm >> 1, ch0 = (pm & 1) * 256;
            u.a = Wpq + (size_t)pm * 256 * D * 2; u.b = H + (size_t)tt * 256 * D * 2;
            u.o = PQT + ((((size_t)b * 512 + ch0) * 2 + isq) * 4096 + n0) * 2; u.ldo = 8192; return true; }
        L -= NP;
        if (L < NPC) { const int b = L >> 2, pm = L & 3, isq = pm >> 1, ch0 = (pm & 1) * 256;
            u.a = Wpq + (size_t)pm * 256 * D * 2; u.b = H + ((size_t)TL + (size_t)b * 256) * D * 2;
            u.o = PQTC + (((size_t)b * 512 + ch0) * 2 + isq) * 256 * 2; u.ldo = 512; return true; }
        return false;
    }
};
struct SchedDft {
    int G, c; const char* F; const char* PQT; char* MIX;
    __device__ __forceinline__ bool next(int i, Unit& u) const {
        const int L = i * G + c; if (L >= 512) return false;
        const int b = L >> 5, r = L & 31, pm = r >> 1, pn = r & 1;
        u.a = F + (size_t)pm * 256 * 8192 * 2; u.b = PQT + ((size_t)b * 512 + pn * 256) * 8192 * 2;
        u.o = MIX + (((size_t)b * 4096 + pm * 256) * D + pn * 256) * 2; u.p0 = nullptr; u.p1 = nullptr; u.ldo = D; u.x0 = 0; return true;
    }
};
struct SchedDftC {
    int G, c; const char* F; const char* PQTC; char* MIX;
    __device__ __forceinline__ bool next(int i, Unit& u) const {
        const int L = i * G + (G - 1 - c); if (L >= 32) return false;
        const int b = L >> 1, pn = L & 1;
        u.a = F; u.b = PQTC + ((size_t)b * 512 + pn * 256) * 512 * 2;
        u.o = MIX + (((size_t)TL + (size_t)b * 256) * D + pn * 256) * 2; u.p0 = nullptr; u.p1 = nullptr; u.ldo = D; u.x0 = 0; return true;
    }
};
struct SchedResid {
    int G, c, nUnits; const char* A; size_t aStep; const char* W; size_t bStep; const float* xl; const float* xc; float* zl; float* zc; const float* gate;
    __device__ __forceinline__ bool next(int i, Unit& u) const {
        const int L = i * G + c; if (L >= nUnits) return false;
        const int pm = L >> 2, pn = L & 3;
        u.a = A + (size_t)pm * aStep; u.b = W + (size_t)pn * bStep;
        const bool isc = pm >= TL / 256; const int pr = isc ? pm - TL / 256 : pm; const int mrow = isc ? 16 : (pm >> 4);
        const size_t off = ((size_t)pr * 256 * D + pn * 256);
        u.p0 = (const char*)((isc ? xc : xl) + off); u.o = (char*)((isc ? zc : zl) + off); u.p1 = (const char*)(gate + (size_t)mrow * 6144 + pn * 256); u.ldo = D; u.x0 = 0; return true;
    }
};
struct SchedGlu {
    int G, c; const char* P; const char* W; char* MIX; const float* bias;
    __device__ __forceinline__ bool next(int i, Unit& u) const {
        const int L = i * G + c; if (L >= (T / 256) * 2) return false;
        const int pm = L >> 1, pn = L & 1;
        u.a = P + (size_t)pm * 256 * 1536 * 2; u.b = W + (size_t)pn * 256 * 512 * 2; u.o = MIX + ((size_t)pm * 256 * D + pn * 256) * 2;
        u.p0 = P + ((size_t)pm * 256 * 1536 + pn * 256) * 2; u.p1 = (const char*)(bias + pn * 256); u.ldo = D; u.x0 = 1536; return true;
    }
};
struct SchedMoeUp {
    int G, c, nUnits, rt0; int toff[9]; const char* HS; const char* W; char* HID;
    __device__ __forceinline__ bool next(int i, Unit& u) const {
        const int L = i * G + c; if (L >= nUnits) return false;
        const int rl = L / 28, pn = L - rl * 28, rt = rt0 + rl; int e = 0;
#pragma unroll
        for (int k = 1; k < 8; ++k) e += (rt >= toff[k]) ? 1 : 0;
        u.a = HS + (size_t)rt * 256 * D * 2; u.b = W + ((size_t)e * 7168 + pn * 256) * D * 2; u.o = HID + ((size_t)rl * 256 * EH + pn * 128) * 2;
        u.p0 = nullptr; u.p1 = nullptr; u.ldo = EH; u.x0 = 0; return true;
    }
};
struct SchedMoeDown {
    int G, c, nUnits, rt0; int toff[9]; const char* HID; const char* W; char* Y;
    __device__ __forceinline__ bool next(int i, Unit& u) const {
        const int L = i * G + c; if (L >= nUnits) return false;
        const int rl = L >> 2, pn = L & 3, rt = rt0 + rl; int e = 0;
#pragma unroll
        for (int k = 1; k < 8; ++k) e += (rt >= toff[k]) ? 1 : 0;
        u.a = HID + (size_t)rl * 256 * EH * 2; u.b = W + ((size_t)e * 1024 + pn * 256) * EH * 2; u.o = Y + ((size_t)rt * 256 * D + pn * 256) * 2;
        u.p0 = nullptr; u.p1 = nullptr; u.ldo = D; u.x0 = 0; return true;
    }
};

__device__ __forceinline__ void tr_item(const float* W, int ldn, bf16* WT, int ldk, int k0, int n0, int drow0, LAS float* scr, int lane) {
#pragma unroll 8
    for (int i = 0; i < 32; ++i) { const int kk = 2 * i + (lane >> 5); scr[kk * 33 + (lane & 31)] = W[(size_t)(k0 + kk) * ldn + n0 + (lane & 31)]; }
    LDS_WAIT(); asm volatile("" ::: "memory");
    const int c = lane & 7;
#pragma unroll
    for (int j = 0; j < 4; ++j) { const int n = (lane >> 3) + 8 * j; const LAS float* s = scr + (8 * c) * 33 + n;
        v4u o; o.x = cvt_pk_bf16(s[0 * 33], s[1 * 33]); o.y = cvt_pk_bf16(s[2 * 33], s[3 * 33]); o.z = cvt_pk_bf16(s[4 * 33], s[5 * 33]); o.w = cvt_pk_bf16(s[6 * 33], s[7 * 33]);
        *(v4u*)(WT + (size_t)(drow0 + n) * ldk + k0 + 8 * c) = o; }
    LDS_WAIT(); asm volatile("" ::: "memory");
}
__device__ __forceinline__ void tr_job(const float* W, int ldn, int N, bf16* WT, int ldk, int mode, int roff, int item, LAS float* scr, int lane) {
    const int nblk = N / 32, kb = item / nblk, nb = item - kb * nblk, n0 = nb * 32;
    const int drow0 = mode ? ((n0 >> 7) * 256 + (n0 & 127) + roff) : (roff + n0);
    tr_item(W, ldn, WT, ldk, kb * 64, n0, drow0, scr, lane);
}
__device__ __forceinline__ void cvt_item(const Params& p, int r, LAS float* scr, int lane) {
    unsigned char* ws = p.ws;
    constexpr int EV_ITEMS = 384 + 512 + 3 * 1408;
    constexpr int ODS_ITEMS = 768 + 128 + 512;
    constexpr int EXP_ITEMS = 3 * 1792, MOE_ITEMS = 8 * EXP_ITEMS;
    if (r < 2 * EV_ITEMS) { const int li = r / EV_ITEMS; r -= li * EV_ITEMS; unsigned char* base = ws + WS_EV + li * EV_STRIDE;
        if (r < 384) { tr_job(p.in[I_EV_WIN] + (size_t)li * D * 1280 + 512, 1280, 768, (bf16*)(base + EV_WQKV), D, 0, 0, r, scr, lane); return; } r -= 384;
        if (r < 512) { tr_job(p.in[I_EV_WOUT] + (size_t)li * D * D, D, D, (bf16*)(base + EV_WOUT), D, 0, 0, r, scr, lane); return; } r -= 512;
        if (r < 1408) { tr_job(p.in[I_EV_W1] + (size_t)li * D * FFH, FFH, FFH, (bf16*)(base + EV_W13), D, 1, 0, r, scr, lane); return; } r -= 1408;
        if (r < 1408) { tr_job(p.in[I_EV_W3] + (size_t)li * D * FFH, FFH, FFH, (bf16*)(base + EV_W13), D, 1, 128, r, scr, lane); return; } r -= 1408;
        tr_job(p.in[I_EV_W2] + (size_t)li * FFH * D, D, D, (bf16*)(base + EV_W2), FFH, 0, 0, r, scr, lane); return; }
    r -= 2 * EV_ITEMS;
    if (r < 2 * ODS_ITEMS) { const int li = r / ODS_ITEMS; r -= li * ODS_ITEMS; unsigned char* base = ws + WS_OD + li * OD_STRIDE;
        if (r < 768) { tr_job(p.in[I_OD_WIN] + (size_t)li * D * 1536, 1536, 1536, (bf16*)(base + OD_WIN), D, 0, 0, r, scr, lane); return; } r -= 768;
        if (r < 128) { tr_job(p.in[I_WGLU] + (size_t)li * 512 * 512, 512, 512, (bf16*)(base + OD_WGLU), 512, 0, 0, r, scr, lane); return; } r -= 128;
        tr_job(p.in[I_OD_WOUT] + (size_t)li * D * D, D, D, (bf16*)(base + OD_WOUT), D, 0, 0, r, scr, lane); return; }
    r -= 2 * ODS_ITEMS;
    { const int li = r / MOE_ITEMS; r -= li * MOE_ITEMS; const int e = r / EXP_ITEMS; r -= e * EXP_ITEMS; unsigned char* base = ws + WS_OD + li * OD_STRIDE;
        const size_t we = (size_t)li * NEXP + e;
        if (r < 1792) { tr_job(p.in[I_MW1] + we * D * EH, EH, EH, (bf16*)(base + OD_MW13) + (size_t)e * 7168 * D, D, 1, 0, r, scr, lane); return; } r -= 1792;
        if (r < 1792) { tr_job(p.in[I_MW3] + we * D * EH, EH, EH, (bf16*)(base + OD_MW13) + (size_t)e * 7168 * D, D, 1, 128, r, scr, lane); return; } r -= 1792;
        tr_job(p.in[I_MW2] + we * EH * D, D, D, (bf16*)(base + OD_MW2) + (size_t)e * D * EH, EH, 0, 0, r, scr, lane); }
}
constexpr int CVT_ITEMS = 2 * 5120 + 2 * 1408 + 2 * 8 * 3 * 1792;

__device__ __forceinline__ void fold_unit(const Params& p, Frame& F, int unit) {
    const int li = unit >> 6, g = (unit >> 4) & 3, k0 = (unit & 15) * 64;
    LAS float* tile = (LAS float*)F.lds;
    LAS float* trig = tile + 64 * 129;
    const float* W = p.in[I_EV_WIN] + (size_t)li * D * 1280;
    for (int e = F.tid; e < 64 * 128; e += NTHREADS) { const int k = e >> 7, c = e & 127; tile[k * 129 + c] = W[(size_t)(k0 + k) * 1280 + g * 128 + c]; }
    if (F.tid < 128) { float s, c; sincospif((float)F.tid / 64.0f, &s, &c); trig[F.tid] = c * 0.08838834764831845f; trig[128 + F.tid] = s * 0.08838834764831845f; }
    __syncthreads();
    bf16* WT = (bf16*)(p.ws + WS_EV + li * EV_STRIDE + EV_WPQ);
    const int k = F.lane, mg = F.wave;
    for (int mm = 0; mm < 16; ++mm) { const int m = mg * 16 + mm; float sp = 0.f, sq = 0.f;
        for (int c = 0; c < 128; ++c) { const float w = tile[k * 129 + c]; const int ph = (m * c) & 127; sp += w * trig[ph]; sq += w * trig[128 + ph]; }
        WT[(size_t)(g * 128 + m) * D + k0 + k] = f2bf(sp); WT[(size_t)(512 + g * 128 + m) * D + k0 + k] = f2bf(sq); }
    __syncthreads();
}

__device__ __forceinline__ void row_load(const float* row, int lane, f32x4 (&v)[4]) {
#pragma unroll
    for (int j = 0; j < 4; ++j) v[j] = *(const f32x4*)(row + 256 * j + 4 * lane);
}
__device__ __forceinline__ void row_store(float* row, int lane, const f32x4 (&v)[4]) {
#pragma unroll
    for (int j = 0; j < 4; ++j) *(f32x4*)(row + 256 * j + 4 * lane) = v[j];
}
__device__ __forceinline__ void row_store_bf16(bf16* row, int lane, const f32x4 (&v)[4]) {
#pragma unroll
    for (int j = 0; j < 4; ++j) { v2u w; w.x = cvt_pk_bf16(v[j][0], v[j][1]); w.y = cvt_pk_bf16(v[j][2], v[j][3]); *(v2u*)(row + 256 * j + 4 * lane) = w; }
}
__device__ __forceinline__ void row_layernorm(f32x4 (&v)[4], const float* g, const float* b, int lane) {
    float s = 0.f;
#pragma unroll
    for (int j = 0; j < 4; ++j) s += (v[j][0] + v[j][1]) + (v[j][2] + v[j][3]);
    const float mean = wave_sum(s) * (1.f / D); float q = 0.f;
#pragma unroll
    for (int j = 0; j < 4; ++j) { v[j] = v[j] - mean; q += (v[j][0] * v[j][0] + v[j][1] * v[j][1]) + (v[j][2] * v[j][2] + v[j][3] * v[j][3]); }
    const float rstd = rsqrtf(wave_sum(q) * (1.f / D) + LN_EPS);
#pragma unroll
    for (int j = 0; j < 4; ++j) { const f32x4 gg = *(const f32x4*)(g + 256 * j + 4 * lane), bb = *(const f32x4*)(b + 256 * j + 4 * lane); v[j] = v[j] * rstd * gg + bb; }
}
__device__ __forceinline__ void row_modulate(f32x4 (&h)[4], const f32x4 (&v)[4], const float* sc, const float* sh, int lane) {
#pragma unroll
    for (int j = 0; j < 4; ++j) { const f32x4 s = *(const f32x4*)(sc + 256 * j + 4 * lane), t = *(const f32x4*)(sh + 256 * j + 4 * lane); h[j] = v[j] * (s + 1.0f) + t; }
}

typedef const __attribute__((address_space(4))) Params* PP;
#define PIN(i) ((const float*)pp->in[i])
#define DECL_LDS extern __shared__ __attribute__((aligned(16))) unsigned char lds_raw[]
#define PHASE_FN static __device__ __forceinline__ void

__device__ __forceinline__ Frame make_frame(PP pp, unsigned char* lds_generic) {
    Frame F;
    F.lds = (LAS unsigned char*)lds_generic;
    { int t_ = threadIdx.x; asm volatile("" : "+v"(t_)); F.tid = t_; }
    F.lane = F.tid & 63; F.wave = __builtin_amdgcn_readfirstlane(F.tid >> 6);
    F.G = gridDim.x; F.bid = blockIdx.x; F.gw = F.bid * NWAVES + F.wave; F.NGW = F.G * NWAVES;
    F.ws = (unsigned char*)pp->ws; F.ctl = (unsigned*)(F.ws + WS_CTL);
    return F;
}
#define FRAME() DECL_LDS; asm volatile("" : "+s"(pp)); Frame F = make_frame(pp, lds_raw); unsigned char* ws = F.ws; (void)ws

PHASE_FN grid_bar(PP pp) {
    FRAME();
    XcdBarrier bar; bar.bar = F.ctl + CW_BAR; bar.x = xb_xcc_id(); bar.st = (volatile LAS unsigned*)(F.lds + LDS_MISC) + 8;
    xcd_barrier(bar);
}

PHASE_FN ph_fold(PP pp) {
    FRAME();
    Params p; p.ws = ws; p.in[I_EV_WIN] = PIN(I_EV_WIN);
    for (int u = F.bid; u < 128; u += F.G) fold_unit(p, F, u);
}
PHASE_FN ph_mod(PP pp) {
    FRAME();
    float* MOD = (float*)(ws + WS_MOD);
    LAS float* sc = (LAS float*)F.lds;
    const float* cin = PIN(I_C); const float* ccin = PIN(I_CCTX);
    for (int e = F.tid; e < 17 * D; e += NTHREADS) { const int r = e >> 10, k = e & 1023; const float v = (r < 16) ? cin[r * D + k] : ccin[k]; sc[e] = silu_f(v); }
    __syncthreads();
    for (int grp = F.gw; grp < DEPTH * 6144 / 64; grp += F.NGW) {
        const int col = grp * 64 + F.lane, l = col / 6144, j = col - l * 6144;
        const float* W = PIN(I_WMOD) + (size_t)l * D * 6144 + j;
        float acc[17];
#pragma unroll
        for (int r = 0; r < 17; ++r) acc[r] = 0.f;
        for (int k = 0; k < D; k += 4) {
            const float w0 = W[(size_t)(k + 0) * 6144], w1 = W[(size_t)(k + 1) * 6144], w2 = W[(size_t)(k + 2) * 6144], w3 = W[(size_t)(k + 3) * 6144];
#pragma unroll
            for (int r = 0; r < 17; ++r) { const f32x4 s = *(const LAS f32x4*)(sc + r * D + k); acc[r] += s[0] * w0 + s[1] * w1 + s[2] * w2 + s[3] * w3; }
        }
        const float bm = PIN(I_BMOD)[l * 6144 + j];
#pragma unroll
        for (int r = 0; r < 17; ++r) MOD[((size_t)l * 17 + r) * 6144 + j] = acc[r] + bm;
    }
    __syncthreads();
}
PHASE_FN ph_cvt(PP pp) {
    FRAME();
    Params p; p.ws = ws;
    p.in[I_EV_WIN] = PIN(I_EV_WIN); p.in[I_EV_WOUT] = PIN(I_EV_WOUT); p.in[I_EV_W1] = PIN(I_EV_W1); p.in[I_EV_W3] = PIN(I_EV_W3); p.in[I_EV_W2] = PIN(I_EV_W2);
    p.in[I_OD_WIN] = PIN(I_OD_WIN); p.in[I_WGLU] = PIN(I_WGLU); p.in[I_OD_WOUT] = PIN(I_OD_WOUT); p.in[I_MW1] = PIN(I_MW1); p.in[I_MW3] = PIN(I_MW3); p.in[I_MW2] = PIN(I_MW2);
    LAS float* scr = (LAS float*)(F.lds + F.wave * 16384);
    for (int it = F.gw; it < CVT_ITEMS; it += F.NGW) cvt_item(p, it, scr, F.lane);
}
PHASE_FN ph_dftmat(PP pp) {
    FRAME();
    bf16* F4 = (bf16*)(ws + WS_F4096);
    for (int it = F.bid * NTHREADS + F.tid; it < 4096 * 1024; it += F.G * NTHREADS) {
        const int k = it >> 10, n0 = (it & 1023) * 8; const bool isq = n0 >= 4096; const int nb = n0 & 4095;
        float v[8];
#pragma unroll
        for (int j = 0; j < 8; ++j) { const int phs = (k * (nb + j)) & 4095; float s, c; sincospif((float)phs * (1.0f / 2048.0f), &s, &c); v[j] = isq ? -s * (1.f / 64.f) : c * (1.f / 64.f); }
        v4u w; w.x = cvt_pk_bf16(v[0], v[1]); w.y = cvt_pk_bf16(v[2], v[3]); w.z = cvt_pk_bf16(v[4], v[5]); w.w = cvt_pk_bf16(v[6], v[7]);
        *(v4u*)(F4 + (size_t)k * 8192 + n0) = w;
    }
    bf16* F2 = (bf16*)(ws + WS_F256);
    for (int it = F.bid * NTHREADS + F.tid; it < 256 * 64; it += F.G * NTHREADS) {
        const int k = it >> 6, n0 = (it & 63) * 8; const bool isq = n0 >= 256; const int nb = n0 & 255;
        float v[8];
#pragma unroll
        for (int j = 0; j < 8; ++j) { const int phs = (k * (nb + j)) & 255; float s, c; sincospif((float)phs * (1.0f / 128.0f), &s, &c); v[j] = isq ? -s * (1.f / 16.f) : c * (1.f / 16.f); }
        v4u w; w.x = cvt_pk_bf16(v[0], v[1]); w.y = cvt_pk_bf16(v[2], v[3]); w.z = cvt_pk_bf16(v[4], v[5]); w.w = cvt_pk_bf16(v[6], v[7]);
        *(v4u*)(F2 + (size_t)k * 512 + n0) = w;
    }
}
PHASE_FN ph_pro_b(PP pp) {
    FRAME();
    const float* MOD = (const float*)(ws + WS_MOD); bf16* Hb = (bf16*)(ws + WS_H);
    const float* xin = PIN(I_X); const float* cin = PIN(I_CTX);
    for (int r = F.gw; r < T; r += F.NGW) {
        const bool isc = r >= TL; const float* xr = isc ? cin + (size_t)(r - TL) * D : xin + (size_t)r * D;
        const float* m = MOD + (size_t)(isc ? 16 : (r >> 12)) * 6144;
        f32x4 v[4], h[4]; row_load(xr, F.lane, v); row_modulate(h, v, m + 1024, m, F.lane); row_store_bf16(Hb + (size_t)r * D, F.lane, h);
    }
}

PHASE_FN ph_e1(PP pp, int layer) {
    FRAME();
    unsigned char* evw = ws + WS_EV + (layer >> 1) * EV_STRIDE; unsigned char* BIG = ws + WS_BIG;
    SchedEvIn S{F.G, F.bid, (const char*)(ws + WS_H), (const char*)(evw + EV_WQKV), (const char*)(evw + EV_WPQ), (char*)(BIG + BIG_QKV), (char*)(BIG + BIG_PQT), (char*)(BIG + BIG_PQTC)};
    pg8::gemm_phase<pg8::EpiStore, SchedEvIn, true, true>(F.lds, F.tid, pg8::Dims{D, D, D}, S, pg8::EpiStore{});
}
PHASE_FN ph_e2_dft(PP pp) {
    FRAME();
    unsigned char* BIG = ws + WS_BIG;
    SchedDft S{F.G, F.bid, (const char*)(ws + WS_F4096), (const char*)(BIG + BIG_PQT), (char*)(BIG + BIG_MIX)};
    pg8::gemm_phase<pg8::EpiStore, SchedDft, true, true>(F.lds, F.tid, pg8::Dims{8192, 8192, 8192}, S, pg8::EpiStore{});
}
PHASE_FN ph_e2_dftc(PP pp) {
    FRAME();
    unsigned char* BIG = ws + WS_BIG;
    SchedDftC S{F.G, F.bid, (const char*)(ws + WS_F256), (const char*)(BIG + BIG_PQTC), (char*)(BIG + BIG_MIX)};
    pg8::gemm_phase<pg8::EpiStore, SchedDftC, true, true>(F.lds, F.tid, pg8::Dims{512, 512, 512}, S, pg8::EpiStore{});
}
PHASE_FN ph_e2_rope(PP pp) {
    FRAME();
    bf16* QKV = (bf16*)(ws + WS_BIG + BIG_QKV);
    LAS f32x2* cs = (LAS f32x2*)F.lds;
    __syncthreads();
    for (int e = F.tid; e < 1024; e += NTHREADS) { const int pos = e >> 4, i = e & 15; const float inv = powf(10000.0f, -(float)i / 16.0f); float s, c; sincosf((float)pos * inv, &s, &c); cs[e] = (f32x2){c, s}; }
    __syncthreads();
    for (int it = F.bid * NTHREADS + F.tid; it < TL * 80; it += F.G * NTHREADS) {
        const int r = it / 80, q = it - r * 80, hh = q >> 3, ax = (q >> 2) & 1, i0 = (q & 3) * 4;
        const int n = r & 4095, pos = ax ? (n & 63) : (n >> 6);
        bf16* base = QKV + (size_t)r * 768 + hh * 64 + ax * 32 + i0;
        const v2u a = *(const v2u*)base, b = *(const v2u*)(base + 16);
        const float x1[4] = {bflo(a.x), bfhi(a.x), bflo(a.y), bfhi(a.y)}, x2[4] = {bflo(b.x), bfhi(b.x), bflo(b.y), bfhi(b.y)};
        float o1[4], o2[4];
#pragma unroll
        for (int j = 0; j < 4; ++j) { const f32x2 t = cs[pos * 16 + i0 + j]; o1[j] = x1[j] * t.x - x2[j] * t.y; o2[j] = x1[j] * t.y + x2[j] * t.x; }
        v2u wa, wb; wa.x = cvt_pk_bf16(o1[0], o1[1]); wa.y = cvt_pk_bf16(o1[2], o1[3]); wb.x = cvt_pk_bf16(o2[0], o2[1]); wb.y = cvt_pk_bf16(o2[2], o2[3]);
        *(v2u*)base = wa; *(v2u*)(base + 16) = wb;
    }
    bf16* VT = (bf16*)(ws + WS_H);
    for (int it = F.bid * NTHREADS + F.tid; it < NBATCH * 2 * 544 * 64; it += F.G * NTHREADS) {
        const int d = it & 63, kg = (it >> 6) % 544, bh = (it >> 6) / 544, b = bh >> 1, hkv = bh & 1;
        const int key0 = kg * 8; const size_t row0 = (key0 < 256) ? ((size_t)TL + (size_t)b * 256 + key0) : ((size_t)b * 4096 + (key0 - 256));
        const bf16* src = QKV + row0 * 768 + 640 + hkv * 64 + d;
        unsigned short v[8];
#pragma unroll
        for (int j = 0; j < 8; ++j) v[j] = src[(size_t)j * 768];
        v4u w; w.x = v[0] | ((unsigned)v[1] << 16); w.y = v[2] | ((unsigned)v[3] << 16); w.z = v[4] | ((unsigned)v[5] << 16); w.w = v[6] | ((unsigned)v[7] << 16);
        *(v4u*)(VT + ((size_t)bh * 64 + d) * 4352 + key0) = w;
    }
    __syncthreads();
}
typedef float f32x16 __attribute__((ext_vector_type(16)));
typedef __bf16 bf16x2v __attribute__((ext_vector_type(2)));
__device__ __forceinline__ unsigned pk_bf16(float a, float b) { const bf16x2v t = __builtin_convertvector((f32x2){a, b}, bf16x2v); return __builtin_bit_cast(unsigned, t); }
constexpr int AT_KP = 144, AT_VP1 = 648, AT_VP2 = 520, AT_VOFF = 320 * AT_KP;
template <bool MASKED>
__device__ __forceinline__ void attn_tile(const LAS unsigned char* Ks, const LAS unsigned char* Vs, const int vpitch, const int kl_base, const bf16x8 (&qf)[4], f32x16& o0, f32x16& o1, float& m, float& l,
                                          const int r, const int h, const int kj0, const int qi) {
    f32x16 x;
#pragma unroll
    for (int i = 0; i < 16; ++i) x[i] = 0.f;
#pragma unroll
    for (int s = 0; s < 4; ++s) { const bf16x8 kf = *(const LAS bf16x8*)(Ks + (kl_base + r) * AT_KP + (16 * s + 8 * h) * 2); x = __builtin_amdgcn_mfma_f32_32x32x16_bf16(kf, qf[s], x, 0, 0, 0); }
    float sc[16]; float mt = -1e30f;
#pragma unroll
    for (int i = 0; i < 16; ++i) { float v = x[i] * 0.125f;
        if (MASKED) { const int kj = kj0 + (i & 3) + 8 * (i >> 2) + 4 * h; const bool ok = (kj >= 0) && (kj < SEQ) && (kj - qi <= 128) && (qi - kj <= 128); v = ok ? v : -1e30f; }
        sc[i] = v; mt = fmaxf(mt, v); }
    mt = fmaxf(mt, __shfl_xor(mt, 32));
    const float mn = fmaxf(m, mt), alpha = __expf(m - mn); m = mn;
    float ps = 0.f;
#pragma unroll
    for (int i = 0; i < 16; ++i) { sc[i] = __expf(sc[i] - mn); ps += sc[i]; }
    l = l * alpha + ps;
#pragma unroll
    for (int i = 0; i < 16; ++i) { o0[i] *= alpha; o1[i] *= alpha; }
#pragma unroll
    for (int s2 = 0; s2 < 2; ++s2) {
        v4u pw; pw.x = pk_bf16(sc[8 * s2 + 0], sc[8 * s2 + 1]); pw.y = pk_bf16(sc[8 * s2 + 2], sc[8 * s2 + 3]); pw.z = pk_bf16(sc[8 * s2 + 4], sc[8 * s2 + 5]); pw.w = pk_bf16(sc[8 * s2 + 6], sc[8 * s2 + 7]);
        const bf16x8 pk = __builtin_bit_cast(bf16x8, pw);
        { const LAS unsigned char* vp = Vs + r * vpitch + (kl_base + 16 * s2 + 4 * h) * 2; const v2u lo = *(const LAS v2u*)vp, hi = *(const LAS v2u*)(vp + 16);
          v4u vw; vw.x = lo.x; vw.y = lo.y; vw.z = hi.x; vw.w = hi.y; o0 = __builtin_amdgcn_mfma_f32_32x32x16_bf16(__builtin_bit_cast(bf16x8, vw), pk, o0, 0, 0, 0); }
        { const LAS unsigned char* vp = Vs + (32 + r) * vpitch + (kl_base + 16 * s2 + 4 * h) * 2; const v2u lo = *(const LAS v2u*)vp, hi = *(const LAS v2u*)(vp + 16);
          v4u vw; vw.x = lo.x; vw.y = lo.y; vw.z = hi.x; vw.w = hi.y; o1 = __builtin_amdgcn_mfma_f32_32x32x16_bf16(__builtin_bit_cast(bf16x8, vw), pk, o1, 0, 0, 0); }
    }
}
PHASE_FN ph_e3_attn(PP pp, int layer) {
    FRAME();
    const bf16* QKV = (const bf16*)(ws + WS_BIG + BIG_QKV); bf16* MIX = (bf16*)(ws + WS_BIG + BIG_MIX); const bf16* VT = (const bf16*)(ws + WS_H);
    const float* sinkp = PIN(I_EV_SINK) + (layer >> 1) * 8;
    LAS unsigned char* Ks = F.lds; LAS unsigned char* Vs = F.lds + AT_VOFF;
    const int r = F.lane & 31, h = F.lane >> 5, g = F.wave >> 1, th = F.wave & 1;
    for (int u = F.bid; u < 2048 + 128; u += F.G) {
        const bool isc = u >= 2048;
        int b, hkv, qb; if (!isc) { b = u >> 7; hkv = (u >> 6) & 1; qb = u & 63; } else { const int v = u - 2048; b = v >> 3; hkv = (v >> 2) & 1; qb = v & 3; }
        const int n0 = qb * 64, bh = b * 2 + hkv;
        const size_t qrow = isc ? ((size_t)TL + (size_t)b * 256 + n0 + 32 * th + r) : ((size_t)b * 4096 + n0 + 32 * th + r);
        bf16x8 qf[4];
#pragma unroll
        for (int s = 0; s < 4; ++s) qf[s] = *(const bf16x8*)(QKV + qrow * 768 + (hkv * 4 + g) * 64 + 16 * s + 8 * h);
        float m = sinkp[hkv * 4 + g], l = (h == 0) ? 1.0f : 0.0f;
        f32x16 o0, o1;
#pragma unroll
        for (int i = 0; i < 16; ++i) { o0[i] = 0.f; o1[i] = 0.f; }
        __syncthreads();
        if (!isc) {
            for (int pc = F.tid; pc < 2560; pc += NTHREADS) { const int kl = pc >> 3, c8 = pc & 7, kj = n0 - 128 + kl;
                v4u v = (v4u){0u, 0u, 0u, 0u}; if (kj >= 0 && kj < SEQ) v = *(const v4u*)(QKV + ((size_t)b * 4096 + kj) * 768 + 512 + hkv * 64 + c8 * 8);
                *(LAS v4u*)(Ks + kl * AT_KP + c8 * 16) = v; }
            for (int pc = F.tid; pc < 2560; pc += NTHREADS) { const int d = pc / 40, c = pc - d * 40, kj = n0 - 128 + c * 8;
                v4u v = (v4u){0u, 0u, 0u, 0u}; if (kj >= 0 && kj < SEQ) v = *(const v4u*)(VT + ((size_t)bh * 64 + d) * 4352 + 256 + kj);
                LAS v2u* dst = (LAS v2u*)(Vs + d * AT_VP1 + c * 16); dst[0] = (v2u){v.x, v.y}; dst[1] = (v2u){v.z, v.w}; }
            __syncthreads();
            const int qi = n0 + 32 * th + r;
#pragma unroll 1
            for (int t = 0; t < 9; ++t) { const int klb = 32 * th + 32 * t; attn_tile<true>(Ks, Vs, AT_VP1, klb, qf, o0, o1, m, l, r, h, n0 - 128 + klb, qi); }
            __syncthreads();
        }
        for (int pc = F.tid; pc < 2048; pc += NTHREADS) { const int j = pc >> 3, c8 = pc & 7;
            *(LAS v4u*)(Ks + j * AT_KP + c8 * 16) = *(const v4u*)(QKV + ((size_t)TL + (size_t)b * 256 + j) * 768 + 512 + hkv * 64 + c8 * 8); }
        for (int pc = F.tid; pc < 2048; pc += NTHREADS) { const int d = pc >> 5, c = pc & 31; const v4u v = *(const v4u*)(VT + ((size_t)bh * 64 + d) * 4352 + c * 8);
            LAS v2u* dst = (LAS v2u*)(Vs + d * AT_VP2 + c * 16); dst[0] = (v2u){v.x, v.y}; dst[1] = (v2u){v.z, v.w}; }
        __syncthreads();
#pragma unroll 1
        for (int t = 0; t < 8; ++t) attn_tile<false>(Ks, Vs, AT_VP2, 32 * t, qf, o0, o1, m, l, r, h, 0, 0);
        const float inv = 1.0f / (l + __shfl_xor(l, 32));
        bf16* orow = MIX + qrow * D + 512 + (hkv * 4 + g) * 64 + 4 * h;
#pragma unroll
        for (int q4 = 0; q4 < 4; ++q4) {
            v2u w0; w0.x = pk_bf16(o0[4 * q4 + 0] * inv, o0[4 * q4 + 1] * inv); w0.y = pk_bf16(o0[4 * q4 + 2] * inv, o0[4 * q4 + 3] * inv); *(v2u*)(orow + 8 * q4) = w0;
            v2u w1; w1.x = pk_bf16(o1[4 * q4 + 0] * inv, o1[4 * q4 + 1] * inv); w1.y = pk_bf16(o1[4 * q4 + 2] * inv, o1[4 * q4 + 3] * inv); *(v2u*)(orow + 32 + 8 * q4) = w1;
        }
    }
    __syncthreads();
}
PHASE_FN ph_outproj(PP pp, int layer) {
    FRAME();
    const int li = layer >> 1; const bool odd = (layer & 1) != 0;
    const int TR = (layer == DEPTH - 1) ? TL : T;
    const char* W = odd ? (const char*)(ws + WS_OD + li * OD_STRIDE + OD_WOUT) : (const char*)(ws + WS_EV + li * EV_STRIDE + EV_WOUT);
    float* XC = (float*)(ws + WS_XC); float* out = (float*)pp->out;
    const float* xl_src = (layer == 0) ? PIN(I_X) : out; const float* xc_src = (layer == 0) ? PIN(I_CTX) : XC;
    const float* modl = (const float*)(ws + WS_MOD) + (size_t)layer * 17 * 6144;
    SchedResid S{F.G, F.bid, (TR / 256) * 4, (const char*)(ws + WS_BIG + BIG_MIX), (size_t)256 * D * 2, W, (size_t)256 * D * 2, xl_src, xc_src, out, XC, modl + 2048};
    pg8::gemm_phase<pg8::EpiResid, SchedResid, true, true>(F.lds, F.tid, pg8::Dims{D, D, D}, S, pg8::EpiResid{});
}
PHASE_FN ph_ln_mid(PP pp, int layer) {
    FRAME();
    float* XC = (float*)(ws + WS_XC); float* out = (float*)pp->out; bf16* Hb = (bf16*)(ws + WS_H);
    const float* modl = (const float*)(ws + WS_MOD) + (size_t)layer * 17 * 6144;
    const float* lng0 = PIN(I_LNG) + (size_t)(layer * 2) * D; const float* lnb0 = PIN(I_LNB) + (size_t)(layer * 2) * D;
    for (int r = F.gw; r < T; r += F.NGW) {
        const bool isc = r >= TL; float* xr = isc ? XC + (size_t)(r - TL) * D : out + (size_t)r * D;
        const float* m = modl + (size_t)(isc ? 16 : (r >> 12)) * 6144;
        f32x4 v[4], h[4]; row_load(xr, F.lane, v); row_layernorm(v, lng0, lnb0, F.lane); row_store(xr, F.lane, v);
        row_modulate(h, v, m + 4096, m + 3072, F.lane); row_store_bf16(Hb + (size_t)r * D, F.lane, h);
    }
}
PHASE_FN ph_e6(PP pp, int layer) {
    FRAME();
    unsigned char* evw = ws + WS_EV + (layer >> 1) * EV_STRIDE;
    SchedStd S{22, (T / 256) * 22, F.G, F.bid, (const char*)(ws + WS_H), (const char*)(evw + EV_W13), (char*)(ws + WS_BIG + BIG_HID), (size_t)256 * D * 2, (size_t)256 * D * 2, (size_t)256 * FFH * 2, (size_t)128 * 2, FFH, 1 << 30};
    pg8::gemm_phase<pg8::EpiSwiGLU, SchedStd, true, true>(F.lds, F.tid, pg8::Dims{D, D, D}, S, pg8::EpiSwiGLU{});
}
PHASE_FN ph_e7(PP pp, int layer) {
    FRAME();
    unsigned char* evw = ws + WS_EV + (layer >> 1) * EV_STRIDE;
    float* XC = (float*)(ws + WS_XC); float* out = (float*)pp->out;
    const float* modl = (const float*)(ws + WS_MOD) + (size_t)layer * 17 * 6144;
    SchedResid S{F.G, F.bid, (T / 256) * 4, (const char*)(ws + WS_BIG + BIG_HID), (size_t)256 * FFH * 2, (const char*)(evw + EV_W2), (size_t)256 * FFH * 2, out, XC, out, XC, modl + 5120};
    pg8::gemm_phase<pg8::EpiResid, SchedResid, true, true>(F.lds, F.tid, pg8::Dims{FFH, FFH, FFH}, S, pg8::EpiResid{});
}
PHASE_FN ph_ln_end(PP pp, int layer) {
    FRAME();
    float* XC = (float*)(ws + WS_XC); float* out = (float*)pp->out; bf16* Hb = (bf16*)(ws + WS_H);
    const float* modn = (const float*)(ws + WS_MOD) + (size_t)(layer + 1) * 17 * 6144;
    const float* lng1 = PIN(I_LNG) + (size_t)(layer * 2 + 1) * D; const float* lnb1 = PIN(I_LNB) + (size_t)(layer * 2 + 1) * D;
    for (int r = F.gw; r < T; r += F.NGW) {
        const bool isc = r >= TL; float* xr = isc ? XC + (size_t)(r - TL) * D : out + (size_t)r * D;
        const float* m = modn + (size_t)(isc ? 16 : (r >> 12)) * 6144;
        f32x4 v[4], h[4]; row_load(xr, F.lane, v); row_layernorm(v, lng1, lnb1, F.lane); row_store(xr, F.lane, v);
        row_modulate(h, v, m + 1024, m, F.lane); row_store_bf16(Hb + (size_t)r * D, F.lane, h);
    }
}

PHASE_FN ph_o1(PP pp, int layer) {
    FRAME();
    unsigned char* odw = ws + WS_OD + (layer >> 1) * OD_STRIDE;
    SchedStd S{6, (T / 256) * 6, F.G, F.bid, (const char*)(ws + WS_H), (const char*)(odw + OD_WIN), (char*)(ws + WS_BIG + BIG_P), (size_t)256 * D * 2, (size_t)256 * D * 2, (size_t)256 * 1536 * 2, (size_t)256 * 2, 1536, 2};
    pg8::gemm_phase<pg8::EpiStore, SchedStd, true, true>(F.lds, F.tid, pg8::Dims{D, D, D}, S, pg8::EpiStore{});
}
PHASE_FN ph_o2_s5(PP pp, int layer) {
    FRAME();
    const int li = layer >> 1;
    const bf16* P = (const bf16*)(ws + WS_BIG + BIG_P);
    bf16* YS0 = (bf16*)(ws + WS_H); bf16* YS1 = YS0 + (size_t)T * 512;
    if (F.wave < 4) {
        const int task = F.bid * 4 + F.wave;
        if (task < NBATCH * 2 * 32) {
            const int b = task >> 6, dir = (task >> 5) & 1, g = task & 31, pl = F.lane;
            const int sidx = ((li * 2 + dir) * 32 + g);
            const float are = PIN(I_A_RE)[sidx * 64 + pl], aim = PIN(I_A_IM)[sidx * 64 + pl], dt = expf(PIN(I_LOG_DT)[sidx]);
            const float mag = expf(are * dt); float sn, cn; sincosf(aim * dt, &sn, &cn);
            const float lre = mag * cn, lim = mag * sn;
            const float den = 1.0f / (are * are + aim * aim);
            const float fre = ((lre - 1.0f) * are + lim * aim) * den, fim = (lim * are - (lre - 1.0f) * aim) * den;
            float bre[16], bim[16], cre[16], cim[16];
            const float* Bre = PIN(I_B_RE); const float* Bim = PIN(I_B_IM); const float* Cre = PIN(I_C_RE); const float* Cim = PIN(I_C_IM);
#pragma unroll
            for (int s = 0; s < 16; ++s) { const float br = Bre[((size_t)sidx * 64 + pl) * 16 + s], bi = Bim[((size_t)sidx * 64 + pl) * 16 + s];
                bre[s] = fre * br - fim * bi; bim[s] = fre * bi + fim * br;
                cre[s] = Cre[((size_t)sidx * 16 + s) * 64 + pl]; cim[s] = Cim[((size_t)sidx * 16 + s) * 64 + pl]; }
            bf16* YS = dir ? YS1 : YS0;
            float hre = 0.f, him = 0.f;
            const int nsteps = NCTX + SEQ;
#define S5_ROW(st_) ((st_) < NCTX ? (TL + b * NCTX + (dir ? (NCTX - 1 - (st_)) : (st_))) : (b * SEQ + (dir ? (SEQ - 1 - ((st_) - NCTX)) : ((st_) - NCTX))))
            v4u pa0, pb0, pa1, pb1;
            { const v4u* q0 = (const v4u*)(P + (size_t)S5_ROW(0) * 1536 + g * 16); pa0 = q0[0]; pb0 = q0[1];
              const v4u* q1 = (const v4u*)(P + (size_t)S5_ROW(1) * 1536 + g * 16); pa1 = q1[0]; pb1 = q1[1]; }
            for (int st = 0; st < nsteps; ++st) {
                const int row = S5_ROW(st);
                const v4u ua = pa0, ub = pb0; pa0 = pa1; pb0 = pb1;
                { const int st2 = (st + 2 < nsteps) ? st + 2 : nsteps - 1; const v4u* q2 = (const v4u*)(P + (size_t)S5_ROW(st2) * 1536 + g * 16); pa1 = q2[0]; pb1 = q2[1]; }
                const float uf[16] = {bflo(ua.x), bfhi(ua.x), bflo(ua.y), bfhi(ua.y), bflo(ua.z), bfhi(ua.z), bflo(ua.w), bfhi(ua.w),
                                      bflo(ub.x), bfhi(ub.x), bflo(ub.y), bfhi(ub.y), bflo(ub.z), bfhi(ub.z), bflo(ub.w), bfhi(ub.w)};
                float ure = 0.f, uim = 0.f;
#pragma unroll
                for (int s = 0; s < 16; ++s) { ure += bre[s] * uf[s]; uim += bim[s] * uf[s]; }
                const float nre = lre * hre - lim * him + ure, nim = lre * him + lim * hre + uim;
                hre = nre; him = nim;
                float y[16];
#pragma unroll
                for (int s = 0; s < 16; ++s) y[s] = cre[s] * hre - cim[s] * him;
                float y8[8], y4[4], y2[2], y1;
                { const bool up_ = (F.lane & 32) != 0;
#pragma unroll
                  for (int k = 0; k < 8; ++k) { const float send = up_ ? y[k] : y[8 + k], keep = up_ ? y[8 + k] : y[k]; y8[k] = keep + __shfl_xor(send, 32); } }
                { const bool up_ = (F.lane & 16) != 0;
#pragma unroll
                  for (int k = 0; k < 4; ++k) { const float send = up_ ? y8[k] : y8[4 + k], keep = up_ ? y8[4 + k] : y8[k]; y4[k] = keep + __shfl_xor(send, 16); } }
                { const bool up_ = (F.lane & 8) != 0;
#pragma unroll
                  for (int k = 0; k < 2; ++k) { const float send = up_ ? y4[k] : y4[2 + k], keep = up_ ? y4[2 + k] : y4[k]; y2[k] = keep + __shfl_xor(send, 8); } }
                { const bool up_ = (F.lane & 4) != 0; const float send = up_ ? y2[0] : y2[1], keep = up_ ? y2[1] : y2[0]; y1 = keep + __shfl_xor(send, 4); }
                y1 += __shfl_xor(y1, 2); y1 += __shfl_xor(y1, 1);
                if ((F.lane & 3) == 0) { const int s = ((F.lane >> 5) & 1) * 8 + ((F.lane >> 4) & 1) * 4 + ((F.lane >> 3) & 1) * 2 + ((F.lane >> 2) & 1);
                    YS[(size_t)row * 512 + g * 16 + s] = f2bf(y1); }
            }
#undef S5_ROW
        }
    }
}
PHASE_FN ph_o2_gmlp(PP pp, int layer) {
    FRAME();
    const int li = layer >> 1; const int TR = (layer == DEPTH - 1) ? TL : T;
    const bf16* P = (const bf16*)(ws + WS_BIG + BIG_P); bf16* MIX = (bf16*)(ws + WS_BIG + BIG_MIX);
    LAS float* Wn = (LAS float*)F.lds;
    LAS float* Vs = (LAS float*)(F.lds + 65536);
    const int nchunk = TR / 128;
    const float* ws_w = PIN(I_WS) + (size_t)li * 4 * 128 * 128; const float* bs = PIN(I_BS) + (size_t)li * 4 * 128;
    __syncthreads();
    for (int ch = F.bid; ch < nchunk; ch += F.G) {
        const size_t row0 = (size_t)ch * 128;
        float mu_r[16], rs_r[16];
#pragma unroll
        for (int t = 0; t < 16; ++t) { const v4u w = *(const v4u*)(P + (row0 + F.wave * 16 + t) * 1536 + 1024 + F.lane * 8);
            const float f[8] = {bflo(w.x), bfhi(w.x), bflo(w.y), bfhi(w.y), bflo(w.z), bfhi(w.z), bflo(w.w), bfhi(w.w)};
            float s = 0.f;
#pragma unroll
            for (int j = 0; j < 8; ++j) s += f[j];
            const float mu = wave_sum(s) * (1.f / 512.f); float q = 0.f;
#pragma unroll
            for (int j = 0; j < 8; ++j) q += (f[j] - mu) * (f[j] - mu);
            mu_r[t] = mu; rs_r[t] = rsqrtf(wave_sum(q) * (1.f / 512.f) + LN_EPS); }
        for (int h = 0; h < 4; ++h) {
            __syncthreads();
            for (int e = F.tid; e < 128 * 128; e += NTHREADS) Wn[e] = ws_w[(size_t)h * 16384 + e];
#pragma unroll
            for (int t = 0; t < 16; ++t) { const int j = F.wave * 16 + t; const unsigned w = *(const unsigned*)(P + (row0 + j) * 1536 + 1024 + h * 128 + F.lane * 2);
                Vs[j * 128 + F.lane * 2] = (bflo(w) - mu_r[t]) * rs_r[t]; Vs[j * 128 + F.lane * 2 + 1] = (bfhi(w) - mu_r[t]) * rs_r[t]; }
            __syncthreads();
            const int ti = F.tid >> 5, te = F.tid & 31;
            f32x4 acc[8];
#pragma unroll
            for (int k = 0; k < 8; ++k) acc[k] = (f32x4){0.f, 0.f, 0.f, 0.f};
            for (int j = 0; j < 128; ++j) {
                const f32x4 vv = *(const LAS f32x4*)(Vs + j * 128 + te * 4);
#pragma unroll
                for (int k = 0; k < 8; ++k) acc[k] += vv * Wn[(ti * 8 + k) * 128 + j];
            }
#pragma unroll
            for (int k = 0; k < 8; ++k) { const int i = ti * 8 + k; const float bb = bs[h * 128 + i];
                const v2u uw = *(const v2u*)(P + (row0 + i) * 1536 + 512 + h * 128 + te * 4);
                v2u o; o.x = cvt_pk_bf16(bflo(uw.x) * (acc[k][0] + bb), bfhi(uw.x) * (acc[k][1] + bb)); o.y = cvt_pk_bf16(bflo(uw.y) * (acc[k][2] + bb), bfhi(uw.y) * (acc[k][3] + bb));
                *(v2u*)(MIX + (row0 + i) * D + 512 + h * 128 + te * 4) = o; }
        }
    }
    __syncthreads();
}
PHASE_FN ph_o3(PP pp, int layer) {
    FRAME();
    const int li = layer >> 1; const int TR = (layer == DEPTH - 1) ? TL : T;
    bf16* P = (bf16*)(ws + WS_BIG + BIG_P);
    const bf16* YS0 = (const bf16*)(ws + WS_H); const bf16* YS1 = YS0 + (size_t)T * 512;
    const float* dsk = PIN(I_SSM_D) + (size_t)li * 512;
    for (int it = F.bid * NTHREADS + F.tid; it < TR * 64; it += F.G * NTHREADS) {
        const int r = it >> 6, c0 = (it & 63) * 8;
        bf16* up = P + (size_t)r * 1536 + c0;
        const v4u uw = *(const v4u*)up, a = *(const v4u*)(YS0 + (size_t)r * 512 + c0), b = *(const v4u*)(YS1 + (size_t)r * 512 + c0);
        const f32x4 d0 = *(const f32x4*)(dsk + c0), d1 = *(const f32x4*)(dsk + c0 + 4);
        float s[8];
        s[0] = bflo(a.x) + bflo(b.x) + d0[0] * bflo(uw.x); s[1] = bfhi(a.x) + bfhi(b.x) + d0[1] * bfhi(uw.x);
        s[2] = bflo(a.y) + bflo(b.y) + d0[2] * bflo(uw.y); s[3] = bfhi(a.y) + bfhi(b.y) + d0[3] * bfhi(uw.y);
        s[4] = bflo(a.z) + bflo(b.z) + d1[0] * bflo(uw.z); s[5] = bfhi(a.z) + bfhi(b.z) + d1[1] * bfhi(uw.z);
        s[6] = bflo(a.w) + bflo(b.w) + d1[2] * bflo(uw.w); s[7] = bfhi(a.w) + bfhi(b.w) + d1[3] * bfhi(uw.w);
#pragma unroll
        for (int j = 0; j < 8; ++j) s[j] = gelu_tanh_f(s[j]);
        v4u w; w.x = cvt_pk_bf16(s[0], s[1]); w.y = cvt_pk_bf16(s[2], s[3]); w.z = cvt_pk_bf16(s[4], s[5]); w.w = cvt_pk_bf16(s[6], s[7]);
        *(v4u*)up = w;
    }
}
PHASE_FN ph_o4(PP pp, int layer) {
    FRAME();
    const int li = layer >> 1;
    unsigned char* odw = ws + WS_OD + li * OD_STRIDE;
    SchedGlu S{F.G, F.bid, (const char*)(ws + WS_BIG + BIG_P), (const char*)(odw + OD_WGLU), (char*)(ws + WS_BIG + BIG_MIX), PIN(I_BGLU) + (size_t)li * 512};
    pg8::gemm_phase<pg8::EpiGLU, SchedGlu, true, true>(F.lds, F.tid, pg8::Dims{512, 1536, 512}, S, pg8::EpiGLU{});
}
PHASE_FN ph_o6(PP pp, int layer) {
    FRAME();
    const int li = layer >> 1; const int TR = (layer == DEPTH - 1) ? TL : T;
    float* XC = (float*)(ws + WS_XC); float* out = (float*)pp->out; bf16* Hb = (bf16*)(ws + WS_H);
    const float* modl = (const float*)(ws + WS_MOD) + (size_t)layer * 17 * 6144;
    const float* lng0 = PIN(I_LNG) + (size_t)(layer * 2) * D; const float* lnb0 = PIN(I_LNB) + (size_t)(layer * 2) * D;
    int* tokE = (int*)(ws + WS_TOK); int* tokS0 = tokE + T; int* tokS1 = tokS0 + T; float* tokG0 = (float*)(tokS1 + T);
    unsigned* ecnt = F.ctl + CW_CNT + li * 64;
    LAS float* wr_s = (LAS float*)F.lds;
    const float* rw = PIN(I_ROUTER) + (size_t)li * D * 8;
    __syncthreads();
    for (int e = F.tid; e < D * 8; e += NTHREADS) wr_s[e] = rw[e];
    __syncthreads();
    for (int r = F.gw; r < TR; r += F.NGW) {
        const bool isc = r >= TL; float* xr = isc ? XC + (size_t)(r - TL) * D : out + (size_t)r * D;
        const float* m = modl + (size_t)(isc ? 16 : (r >> 12)) * 6144;
        f32x4 v[4], h[4]; row_load(xr, F.lane, v); row_layernorm(v, lng0, lnb0, F.lane); row_store(xr, F.lane, v);
        row_modulate(h, v, m + 4096, m + 3072, F.lane); row_store_bf16(Hb + (size_t)r * D, F.lane, h);
        float lg[8];
#pragma unroll
        for (int e = 0; e < 8; ++e) lg[e] = 0.f;
#pragma unroll
        for (int j = 0; j < 4; ++j)
#pragma unroll
            for (int q = 0; q < 4; ++q) { const int col = 256 * j + 4 * F.lane + q; const f32x4 w0 = *(const LAS f32x4*)(wr_s + col * 8), w1 = *(const LAS f32x4*)(wr_s + col * 8 + 4); const float hv = h[j][q];
                lg[0] += hv * w0[0]; lg[1] += hv * w0[1]; lg[2] += hv * w0[2]; lg[3] += hv * w0[3]; lg[4] += hv * w1[0]; lg[5] += hv * w1[1]; lg[6] += hv * w1[2]; lg[7] += hv * w1[3]; }
#pragma unroll
        for (int e = 0; e < 8; ++e) lg[e] = wave_sum(lg[e]);
        if (F.lane == 0) {
            int e0 = 0; float v0 = lg[0];
#pragma unroll
            for (int e = 1; e < 8; ++e) if (lg[e] > v0) { v0 = lg[e]; e0 = e; }
            int e1 = -1; float v1 = -3.0e38f;
#pragma unroll
            for (int e = 0; e < 8; ++e) if (e != e0 && lg[e] > v1) { v1 = lg[e]; e1 = e; }
            const float w0 = 1.0f / (1.0f + __expf(v1 - v0));
            const int s0 = (int)atomicAdd(ecnt + e0, 1u), s1 = (int)atomicAdd(ecnt + e1, 1u);
            tokE[r] = e0 | (e1 << 8); tokS0[r] = s0; tokS1[r] = s1; tokG0[r] = w0;
        }
    }
    __syncthreads();
}
PHASE_FN ph_o7(PP pp, int layer) {
    FRAME();
    const int li = layer >> 1; const int TR = (layer == DEPTH - 1) ? TL : T;
    const bf16* Hb = (const bf16*)(ws + WS_H); bf16* HS = (bf16*)(ws + WS_BIG + BIG_HS);
    int* tokE = (int*)(ws + WS_TOK); int* tokS0 = tokE + T; int* tokS1 = tokS0 + T; int* tokP0 = tokS1 + 2 * T; int* tokP1 = tokP0 + T;
    unsigned* ecnt = F.ctl + CW_CNT + li * 64;
    int roff[8]; { int acc = 0;
#pragma unroll
        for (int e = 0; e < 8; ++e) { roff[e] = acc * 256; acc += ((int)__hip_atomic_load(ecnt + e, __ATOMIC_RELAXED, __HIP_MEMORY_SCOPE_AGENT) + 255) >> 8; } }
    for (int r = F.gw; r < TR; r += F.NGW) {
        const int ee = tokE[r], e0 = ee & 255, e1 = ee >> 8;
        int p0 = tokS0[r], p1 = tokS1[r];
#pragma unroll
        for (int e = 0; e < 8; ++e) { p0 += (e == e0) ? roff[e] : 0; p1 += (e == e1) ? roff[e] : 0; }
        const v4u* src = (const v4u*)(Hb + (size_t)r * D); v4u* d0 = (v4u*)(HS + (size_t)p0 * D); v4u* d1 = (v4u*)(HS + (size_t)p1 * D);
        const v4u a = src[F.lane], b = src[64 + F.lane];
        d0[F.lane] = a; d0[64 + F.lane] = b; d1[F.lane] = a; d1[64 + F.lane] = b;
        if (F.lane == 0) { tokP0[r] = p0; tokP1[r] = p1; }
    }
}
PHASE_FN ph_moe_up(PP pp, int layer, int chn) {
    FRAME();
    const int li = layer >> 1; unsigned char* odw = ws + WS_OD + li * OD_STRIDE; unsigned* ecnt = F.ctl + CW_CNT + li * 64;
    SchedMoeUp S; S.G = F.G; S.c = F.bid; S.rt0 = chn * MOE_CHUNK_TILES; S.HS = (const char*)(ws + WS_BIG + BIG_HS); S.W = (const char*)(odw + OD_MW13); S.HID = (char*)(ws + WS_H);
    { int acc = 0; S.toff[0] = 0;
#pragma unroll
        for (int e = 0; e < 8; ++e) { acc += ((int)__hip_atomic_load(ecnt + e, __ATOMIC_RELAXED, __HIP_MEMORY_SCOPE_AGENT) + 255) >> 8; S.toff[e + 1] = acc; } }
    int nt_ = S.toff[8] - S.rt0; nt_ = nt_ < 0 ? 0 : (nt_ > MOE_CHUNK_TILES ? MOE_CHUNK_TILES : nt_); S.nUnits = nt_ * 28;
    pg8::gemm_phase<pg8::EpiSwiGLU, SchedMoeUp, true, true>(F.lds, F.tid, pg8::Dims{D, D, D}, S, pg8::EpiSwiGLU{});
}
PHASE_FN ph_moe_down(PP pp, int layer, int chn) {
    FRAME();
    const int li = layer >> 1; unsigned char* odw = ws + WS_OD + li * OD_STRIDE; unsigned* ecnt = F.ctl + CW_CNT + li * 64;
    SchedMoeDown S; S.G = F.G; S.c = F.bid; S.rt0 = chn * MOE_CHUNK_TILES; S.HID = (const char*)(ws + WS_H); S.W = (const char*)(odw + OD_MW2); S.Y = (char*)(ws + WS_BIG + BIG_HS);
    { int acc = 0; S.toff[0] = 0;
#pragma unroll
        for (int e = 0; e < 8; ++e) { acc += ((int)__hip_atomic_load(ecnt + e, __ATOMIC_RELAXED, __HIP_MEMORY_SCOPE_AGENT) + 255) >> 8; S.toff[e + 1] = acc; } }
    int nt_ = S.toff[8] - S.rt0; nt_ = nt_ < 0 ? 0 : (nt_ > MOE_CHUNK_TILES ? MOE_CHUNK_TILES : nt_); S.nUnits = nt_ * 4;
    pg8::gemm_phase<pg8::EpiStore, SchedMoeDown, true, true>(F.lds, F.tid, pg8::Dims{EH, EH, EH}, S, pg8::EpiStore{});
}
PHASE_FN ph_o9(PP pp, int layer) {
    FRAME();
    const int TR = (layer == DEPTH - 1) ? TL : T; const bool last = layer == DEPTH - 1;
    float* XC = (float*)(ws + WS_XC); float* out = (float*)pp->out; bf16* Hb = (bf16*)(ws + WS_H); const bf16* HS = (const bf16*)(ws + WS_BIG + BIG_HS);
    const float* modl = (const float*)(ws + WS_MOD) + (size_t)layer * 17 * 6144;
    const float* modn = (const float*)(ws + WS_MOD) + (size_t)(last ? layer : layer + 1) * 17 * 6144;
    const float* lng1 = PIN(I_LNG) + (size_t)(layer * 2 + 1) * D; const float* lnb1 = PIN(I_LNB) + (size_t)(layer * 2 + 1) * D;
    const int* tokE = (const int*)(ws + WS_TOK); const float* tokG0 = (const float*)(tokE + 3 * T); const int* tokP0 = tokE + 4 * T; const int* tokP1 = tokP0 + T;
    for (int r = F.gw; r < TR; r += F.NGW) {
        const bool isc = r >= TL; float* xr = isc ? XC + (size_t)(r - TL) * D : out + (size_t)r * D;
        const int mrow = isc ? 16 : (r >> 12);
        const float* g2 = modl + (size_t)mrow * 6144 + 5120;
        const int p0 = tokP0[r], p1 = tokP1[r]; const float w0 = tokG0[r], w1 = 1.0f - w0;
        const bf16* y0 = HS + (size_t)p0 * D; const bf16* y1 = HS + (size_t)p1 * D;
        f32x4 v[4], h[4]; row_load(xr, F.lane, v);
#pragma unroll
        for (int j = 0; j < 4; ++j) { const v2u a = *(const v2u*)(y0 + 256 * j + 4 * F.lane), b = *(const v2u*)(y1 + 256 * j + 4 * F.lane); const f32x4 gg = *(const f32x4*)(g2 + 256 * j + 4 * F.lane);
            f32x4 f; f[0] = w0 * bflo(a.x) + w1 * bflo(b.x); f[1] = w0 * bfhi(a.x) + w1 * bfhi(b.x); f[2] = w0 * bflo(a.y) + w1 * bflo(b.y); f[3] = w0 * bfhi(a.y) + w1 * bfhi(b.y);
            v[j] = v[j] * ALPHA + gg * f; }
        row_layernorm(v, lng1, lnb1, F.lane); row_store(xr, F.lane, v);
        if (!last) { const float* m = modn + (size_t)mrow * 6144; row_modulate(h, v, m + 1024, m, F.lane); row_store_bf16(Hb + (size_t)r * D, F.lane, h); }
    }
}

constexpr int N_PHASES = 2 + 2 * (8 + 8 + 2 * MOE_NCHUNK);
__global__ void __launch_bounds__(NTHREADS, 2) fwd_kernel(Params p_unused) {
    DECL_LDS;
    PP pp = (PP)__builtin_amdgcn_kernarg_segment_ptr();
    {
        LAS unsigned char* lds = (LAS unsigned char*)lds_raw;
        for (int u = threadIdx.x; u < (LDS_BYTES - LDS_RING) / 4; u += NTHREADS) ((LAS unsigned*)(lds + LDS_RING))[u] = 0u;
        __syncthreads();
#if !MK_SPLIT
        (void)xcd_barrier_post((unsigned*)((unsigned char*)pp->ws + WS_CTL) + CW_BAR, (volatile LAS unsigned*)(lds + LDS_MISC) + 8);
#endif
    }
    const int lo = pp->ph_lo, hi = pp->ph_hi; int ph = 0;
#if MK_SPLIT
#define PHASE_END() do { ++ph; } while (0)
#else
#define PHASE_END() do { if (ph >= lo && ph + 1 < hi) grid_bar(pp); ++ph; } while (0)
#endif
#define PHASE_ON() (ph >= lo && ph < hi)

    if (PHASE_ON()) { ph_fold(pp); ph_mod(pp); ph_cvt(pp); ph_dftmat(pp); }
    PHASE_END();
    if (PHASE_ON()) ph_pro_b(pp);
    PHASE_END();
    for (int layer = 0; layer < DEPTH; ++layer) {
        if ((layer & 1) == 0) {
            if (PHASE_ON()) ph_e1(pp, layer);
            PHASE_END();
            if (PHASE_ON()) { ph_e2_dft(pp); ph_e2_dftc(pp); ph_e2_rope(pp); }
            PHASE_END();
            if (PHASE_ON()) ph_e3_attn(pp, layer);
            PHASE_END();
            if (PHASE_ON()) ph_outproj(pp, layer);
            PHASE_END();
            if (PHASE_ON()) ph_ln_mid(pp, layer);
            PHASE_END();
            if (PHASE_ON()) ph_e6(pp, layer);
            PHASE_END();
            if (PHASE_ON()) ph_e7(pp, layer);
            PHASE_END();
            if (PHASE_ON()) ph_ln_end(pp, layer);
            PHASE_END();
        } else {
            if (PHASE_ON()) ph_o1(pp, layer);
            PHASE_END();
            if (PHASE_ON()) { ph_o2_s5(pp, layer); ph_o2_gmlp(pp, layer); }
            PHASE_END();
            if (PHASE_ON()) ph_o3(pp, layer);
            PHASE_END();
            if (PHASE_ON()) ph_o4(pp, layer);
            PHASE_END();
            if (PHASE_ON()) ph_outproj(pp, layer);
            PHASE_END();
            if (PHASE_ON()) ph_o6(pp, layer);
            PHASE_END();
            if (PHASE_ON()) ph_o7(pp, layer);
            PHASE_END();
            for (int chn = 0; chn < MOE_NCHUNK; ++chn) {
                if (PHASE_ON()) ph_moe_up(pp, layer, chn);
                PHASE_END();
                if (PHASE_ON()) ph_moe_down(pp, layer, chn);
                PHASE_END();
            }
            if (PHASE_ON()) ph_o9(pp, layer);
            PHASE_END();
        }
    }
}

extern "C" void kernel_launch(void* const* d_in, const int* in_sizes, int n_in, void* d_out, int out_size, void* d_ws, size_t ws_size, hipStream_t stream) {
    static int grid = 0;
    if (grid == 0) {
        if (n_in != 32 || out_size != TL * D || ws_size < WS_END) { fprintf(stderr, "kernel_launch: unexpected shapes (n_in %d, out %d, ws %zu < %zu)\n", n_in, out_size, ws_size, (size_t)WS_END); grid = -1; return; }
        int dev = 0, cus = 0, per_cu = 0;
        if (hipGetDevice(&dev) != hipSuccess || hipDeviceGetAttribute(&cus, hipDeviceAttributeMultiprocessorCount, dev) != hipSuccess) { grid = -1; return; }
        if (hipFuncSetAttribute((const void*)fwd_kernel, hipFuncAttributeMaxDynamicSharedMemorySize, LDS_BYTES) != hipSuccess) { fprintf(stderr, "kernel_launch: hipFuncSetAttribute failed\n"); grid = -1; return; }
        if (hipOccupancyMaxActiveBlocksPerMultiprocessor(&per_cu, (const void*)fwd_kernel, NTHREADS, LDS_BYTES) != hipSuccess || per_cu < 1) { fprintf(stderr, "kernel_launch: occupancy query says %d\n", per_cu); }
        (void)hipGetLastError();
        grid = cus;
    }
    if (grid < 0) return;
    (void)in_sizes;
    (void)hipMemsetAsync((char*)d_ws + WS_CTL, 0, CTL_ZERO_BYTES, stream);
    Params p{};
    for (int i = 0; i < 32; ++i) p.in[i] = (const float*)d_in[i];
    p.out = (float*)d_out; p.ws = (unsigned char*)d_ws;
#if MK_SPLIT
    for (int ph = 0; ph < N_PHASES; ++ph) { p.ph_lo = ph; p.ph_hi = ph + 1; hipLaunchKernelGGL(fwd_kernel, dim3(grid), dim3(NTHREADS), LDS_BYTES, stream, p); }
#else
    p.ph_lo = 0; p.ph_hi = N_PHASES;
    hipLaunchKernelGGL(fwd_kernel, dim3(grid), dim3(NTHREADS), LDS_BYTES, stream, p);
#endif
}
```

```cpp
#include <hip/hip_runtime.h>
#include <cstdio>
#include <cstdint>

#ifndef MK_SPLIT
#define MK_SPLIT 0
#endif

#define GAS __attribute__((address_space(1)))
#define LAS __attribute__((address_space(3)))
typedef unsigned short bf16;
typedef unsigned v4u __attribute__((ext_vector_type(4)));
typedef unsigned v2u __attribute__((ext_vector_type(2)));
typedef float f32x4 __attribute__((ext_vector_type(4)));
typedef float f32x2 __attribute__((ext_vector_type(2)));
typedef short bf16x8 __attribute__((ext_vector_type(8)));

constexpr int D = 1024, NBATCH = 16, SEQ = 4096, NCTX = 256, DEPTH = 4;
constexpr int TL = NBATCH * SEQ, TC = NBATCH * NCTX, T = TL + TC;
constexpr int FFH = 2816, EH = 3584, NEXP = 8;
constexpr int MOE_CHUNK_TILES = 64, MOE_NCHUNK = 9;
constexpr float ALPHA = 1.6817928305074290860622509524664f;
constexpr float LN_EPS = 1e-5f;

constexpr size_t MiB = (size_t)1 << 20;
constexpr size_t WS_CTL = 0, CTL_ZERO_BYTES = 1 * MiB;
constexpr size_t WS_MOD = 1 * MiB;
constexpr size_t WS_TOK = 3 * MiB;
constexpr size_t WS_XC = 5 * MiB;
constexpr size_t WS_F256 = 21 * MiB;
constexpr size_t WS_F4096 = 22 * MiB;
constexpr size_t WS_EV = 86 * MiB, EV_STRIDE = 22 * MiB;
constexpr size_t EV_WQKV = 0, EV_WPQ = 3 * MiB / 2, EV_WOUT = 7 * MiB / 2, EV_W13 = 11 * MiB / 2, EV_W2 = 33 * MiB / 2;
constexpr size_t WS_OD = 130 * MiB, OD_STRIDE = 174 * MiB;
constexpr size_t OD_WIN = 0, OD_WGLU = 3 * MiB, OD_WOUT = 7 * MiB / 2, OD_MW13 = 11 * MiB / 2, OD_MW2 = 235 * MiB / 2;
constexpr size_t WS_H = 478 * MiB;
constexpr size_t WS_BIG = 614 * MiB;
constexpr size_t BIG_PQT = 0, BIG_PQTC = 128 * MiB, BIG_QKV = 136 * MiB, BIG_MIX = 238 * MiB, BIG_HID = 0, BIG_P = 0, BIG_HS = 0;
constexpr size_t WS_S5M = 994 * MiB, S5M_STRIDE = 384 * 1024;
constexpr size_t WS_END = 1018 * MiB;
constexpr int CW_BAR = 4096, CW_CNT = 16384;

#define LDS_WAIT() asm volatile("s_waitcnt lgkmcnt(0)" ::: "memory")
#define VM_WAIT() asm volatile("s_waitcnt vmcnt(0)" ::: "memory")
__device__ __forceinline__ unsigned cvt_pk_bf16(float lo, float hi) { unsigned r; asm volatile("v_cvt_pk_bf16_f32 %0, %1, %2" : "=v"(r) : "v"(lo), "v"(hi)); return r; }
__device__ __forceinline__ float bflo(unsigned w) { return __uint_as_float(w << 16); }
__device__ __forceinline__ float bfhi(unsigned w) { return __uint_as_float(w & 0xffff0000u); }
__device__ __forceinline__ float bf2f(bf16 b) { return __uint_as_float(((unsigned)b) << 16); }
__device__ __forceinline__ bf16 f2bf(float f) { return (bf16)(cvt_pk_bf16(f, 0.f) & 0xffffu); }
__device__ __forceinline__ float wave_sum(float v) {
#pragma unroll
    for (int o = 1; o < 64; o <<= 1) v += __shfl_xor(v, o);
    return v;
}
__device__ __forceinline__ float wave_max(float v) {
#pragma unroll
    for (int o = 1; o < 64; o <<= 1) v = fmaxf(v, __shfl_xor(v, o));
    return v;
}
__device__ __forceinline__ float silu_f(float x) { return x / (1.f + __expf(-x)); }
__device__ __forceinline__ float sigmoid_f(float x) { return 1.f / (1.f + __expf(-x)); }
__device__ __forceinline__ float gelu_tanh_f(float x) { const float z = 0.7978845608028654f * (x + 0.044715f * x * x * x); return x / (1.f + __expf(-2.f * z)); }

#define XB_TMO      128
#define XB_XCNT(j)  (256  + 64 * (j))
#define XB_XSUB(j)  (1280 + 64 * (j))
#define XB_XGEN(j)  (2304 + 64 * (j))
#define XB_TOP      3328
#define XB_TOPGEN   3392
#define XCD_BAR_WORDS 3456
#define XB_SPIN_CAP (1u << 25)
__device__ __forceinline__ unsigned xb_ld(unsigned* p)              { return __hip_atomic_load(p, __ATOMIC_RELAXED, __HIP_MEMORY_SCOPE_AGENT); }
__device__ __forceinline__ unsigned xb_add(unsigned* p, unsigned v) { return __hip_atomic_fetch_add(p, v, __ATOMIC_RELAXED, __HIP_MEMORY_SCOPE_AGENT); }
__device__ __forceinline__ unsigned xb_xcc_id() { return (unsigned)__builtin_amdgcn_s_getreg((3 << 11) | 20) & 0xFu; }
#define XB_SPIN(cond, bar) do { unsigned _sp = 0; while (cond) { __builtin_amdgcn_s_sleep(1); \
    if ((++_sp & 255u) == 0u) { if (xb_ld(&(bar)[XB_TMO])) break; if (_sp > XB_SPIN_CAP) { atomicAdd(&(bar)[XB_TMO], 1u); break; } } } } while (0)
struct XcdBarrier { unsigned* bar; unsigned x; volatile LAS unsigned* st; };
__device__ __forceinline__ XcdBarrier xcd_barrier_post(unsigned* bar, volatile LAS unsigned* st) {
    XcdBarrier b; b.bar = bar; b.x = xb_xcc_id(); b.st = st;
    if (threadIdx.x == 0) (void)xb_add(&bar[XB_XCNT(b.x)], 1u);
    return b;
}
__device__ __forceinline__ void xcd_barrier_complete(unsigned* bar, unsigned x, unsigned& nloc, unsigned& nx) {
    const unsigned G = gridDim.x * gridDim.y * gridDim.z;
    unsigned sum, cnt, mine, sp = 0u;
    for (;;) {
        sum = 0u; cnt = 0u; mine = 0u;
#pragma unroll
        for (unsigned j = 0; j < 16; ++j) { const unsigned c = xb_ld(&bar[XB_XCNT(j)]); sum += c; cnt += (c > 0u) ? 1u : 0u; mine = (j == x) ? c : mine; }
        if (sum == G) break;
        __builtin_amdgcn_s_sleep(1);
        if ((++sp & 255u) == 0u) { if (xb_ld(&bar[XB_TMO])) break; if (sp > XB_SPIN_CAP) { atomicAdd(&bar[XB_TMO], 1u); break; } }
    }
    nloc = mine > 0u ? mine : 1u; nx = cnt > 0u ? cnt : 1u;
}
__device__ __forceinline__ void xcd_barrier(const XcdBarrier& b) {
    asm volatile("s_waitcnt vmcnt(0)" ::: "memory");
    __syncthreads();
    if (threadIdx.x == 0) {
        unsigned* bar = b.bar;
        __builtin_amdgcn_s_waitcnt(0);
        unsigned nloc = b.st[0], nx = b.st[1];
        if (nloc == 0u) { xcd_barrier_complete(bar, b.x, nloc, nx); b.st[0] = nloc; b.st[1] = nx; }
        const unsigned old = xb_add(&bar[XB_XSUB(b.x)], 1u);
        const unsigned gen = old / nloc;
        if (old + 1u == (gen + 1u) * nloc) {
            __builtin_amdgcn_fence(__ATOMIC_RELEASE, "agent");
            asm volatile("s_waitcnt vmcnt(0)" ::: "memory");
            const unsigned og = xb_add(&bar[XB_TOP], 1u);
            const unsigned tg = og / nx;
            if (og + 1u == (tg + 1u) * nx) xb_add(&bar[XB_TOPGEN], 1u);
            else XB_SPIN(xb_ld(&bar[XB_TOPGEN]) == tg, bar);
            __builtin_amdgcn_fence(__ATOMIC_ACQUIRE, "agent");
            xb_add(&bar[XB_XGEN(b.x)], 1u);
            asm volatile("s_waitcnt vmcnt(0)" ::: "memory");
        } else {
            XB_SPIN(xb_ld(&bar[XB_XGEN(b.x)]) == gen, bar);
            __builtin_amdgcn_fence(__ATOMIC_ACQUIRE, "agent");
            asm volatile("s_waitcnt vmcnt(0)" ::: "memory");
        }
    }
    __syncthreads();
}

namespace pg8 {
constexpr int BM = 256, BK = 64, HALF = 128, HTB = HALF * BK * 2, STAGE_BYTES = 8 * HTB;
__host__ __device__ __forceinline__ int lds_byte(int r, int c) { const int st = (r >> 4) * 2 + (c >> 5), rr = r & 15, cc = c & 31, ob = rr * 64 + cc * 2; return st * 1024 + (ob ^ (((ob >> 9) & 1) << 5)); }
__host__ __device__ __forceinline__ void stage_rc(int b, int& R, int& C) { const int st = b / 1024, sb = b % 1024, swz = sb ^ (((sb >> 9) & 1) << 5); R = (st >> 1) * 16 + swz / 64; C = (st & 1) * 32 + (swz % 64) / 2; }
__host__ __device__ __forceinline__ int perm32(int rho) { const int n = rho >> 4, i = rho & 15; return 8 * (i >> 2) + 4 * n + (i & 3); }

struct Unit { const char* a; const char* b; char* o; const char* p0; const char* p1; int ldo; int x0; };
struct Dims { int K, lda, ldb; };
struct AMapStd { int lda = 0; __device__ __forceinline__ unsigned voff(int R, int C) const { return (unsigned)(R * lda + C) * 2u; } __device__ __forceinline__ size_t kstep() const { return 128; } __device__ __forceinline__ size_t hs() const { return (size_t)HALF * lda * 2; } };
struct AMapS5 { __device__ __forceinline__ unsigned voff(int R, int C) const { return (unsigned)(R * 49152 + (C >> 4) * 3072 + (C & 15) * 2); } __device__ __forceinline__ size_t kstep() const { return 12288; } __device__ __forceinline__ size_t hs() const { return (size_t)HALF * 49152; } };

template <class Epi, class Sched, bool ALIGN_EPI = false, bool SP2 = false, class AMap = AMapStd>
__device__ __forceinline__ void gemm_phase(LAS unsigned char* lds, const int tid, const Dims g, const Sched& S, const Epi& E, const AMap am_in = AMap{}) {
    AMap am = am_in; if constexpr (__is_same(AMap, AMapStd)) am.lda = g.lda;
    const int wid = __builtin_amdgcn_readfirstlane(tid >> 6), lane = tid & 63, wr = wid >> 2, wc = wid & 3, fr = lane & 15, fq = lane >> 4;
    const int K = g.K, nt = K / BK;
    unsigned voffA[2], voffB[2];
#pragma unroll
    for (int i = 0; i < 2; ++i) { int R, C; stage_rc(tid * 16 + i * 8192, R, C); const int Rb = Epi::PERM ? ((R & ~31) + perm32(R & 31)) : R;
        voffA[i] = am.voff(R, C); voffB[i] = (unsigned)(Rb * g.ldb + C) * 2u; }
    const size_t kstep = (size_t)(BK * 2), kstepA = am.kstep();
    const size_t hsA = am.hs(), hsB = (size_t)HALF * g.ldb * 2;
    const unsigned ldsw = (unsigned)wid * 1024u;
    const int aoff = lds_byte(wr * 64 + fr, fq * 8), boff = lds_byte(wc * 32 + fr, fq * 8);
#define PG8_SA(b, h) (((b) * 2 + (h)) * HTB)
#define PG8_SB(b, h) ((4 + (b) * 2 + (h)) * HTB)
#define PG8_STAGE(bufoff, gbase, voff) do { _Pragma("unroll") for (int _i = 0; _i < 2; ++_i) \
        __builtin_amdgcn_global_load_lds((const unsigned*)((const char*)(gbase) + (voff)[_i]), (LAS unsigned*)(lds + (bufoff) + ldsw + _i * 8192), 16, 0, 0); } while (0)
#define PG8_LDA(dst, b, h) do { _Pragma("unroll") for (int m = 0; m < 4; ++m) _Pragma("unroll") for (int k = 0; k < 2; ++k) dst[m][k] = *(const LAS bf16x8*)(lds + PG8_SA(b, h) + aoff + m * 2048 + k * 1024); } while (0)
#define PG8_LDB(dst, b, h) do { _Pragma("unroll") for (int n = 0; n < 2; ++n) _Pragma("unroll") for (int k = 0; k < 2; ++k) dst[n][k] = *(const LAS bf16x8*)(lds + PG8_SB(b, h) + boff + n * 2048 + k * 1024); } while (0)
#define PG8_MMA(ai, bj, At, Bt) do { __builtin_amdgcn_s_setprio(1); _Pragma("unroll") for (int m = 0; m < 4; ++m) _Pragma("unroll") for (int n = 0; n < 2; ++n) _Pragma("unroll") for (int k = 0; k < 2; ++k) \
        acc[ai][bj][m][n] = __builtin_amdgcn_mfma_f32_16x16x32_bf16(Bt[n][k], At[m][k], acc[ai][bj][m][n], 0, 0, 0); __builtin_amdgcn_s_setprio(0); } while (0)
#define PG8_WAIT_V(n) asm volatile("s_waitcnt vmcnt(" #n ")" ::: "memory")
#define PG8_WAIT_L(n) asm volatile("s_waitcnt lgkmcnt(" #n ")" ::: "memory")
#define PG8_BAR __builtin_amdgcn_s_barrier()
#define PG8_SCHED __builtin_amdgcn_sched_barrier(0)
    int ui = 0;
    const char* cA; const char* cB;
    { Unit u0; if (!S.next(0, u0)) return; cA = u0.a; cB = u0.b; }
    f32x4 acc[2][2][4][2];
#pragma unroll
    for (int a = 0; a < 2; ++a)
#pragma unroll
        for (int b = 0; b < 2; ++b)
#pragma unroll
            for (int m = 0; m < 4; ++m)
#pragma unroll
                for (int n = 0; n < 2; ++n) acc[a][b][m][n] = (f32x4){0.f, 0.f, 0.f, 0.f};
    bf16x8 At[4][2], B0[2][2], B1[2][2];
    if constexpr (SP2) {
        PG8_STAGE(PG8_SB(0, 0), cB, voffB); PG8_STAGE(PG8_SB(0, 1), cB + hsB, voffB); PG8_STAGE(PG8_SA(0, 0), cA, voffA); PG8_STAGE(PG8_SA(0, 1), cA + hsA, voffA);
        if (wr == 1) PG8_BAR;
        PG8_WAIT_V(2); PG8_BAR;
        PG8_STAGE(PG8_SB(1, 0), cB + kstep, voffB); PG8_STAGE(PG8_SA(1, 0), cA + kstepA, voffA); PG8_STAGE(PG8_SB(1, 1), cB + hsB + kstep, voffB);
        PG8_WAIT_V(6); PG8_BAR;
    } else {
        PG8_STAGE(PG8_SB(0, 0), cB, voffB); PG8_STAGE(PG8_SA(0, 0), cA, voffA); PG8_STAGE(PG8_SB(0, 1), cB + hsB, voffB); PG8_STAGE(PG8_SA(0, 1), cA + hsA, voffA);
        if (wr == 1) PG8_BAR;
        PG8_WAIT_V(4); PG8_BAR;
        PG8_STAGE(PG8_SB(1, 0), cB + kstep, voffB); PG8_STAGE(PG8_SA(1, 0), cA + kstepA, voffA); PG8_STAGE(PG8_SB(1, 1), cB + hsB + kstep, voffB);
        PG8_WAIT_V(6); PG8_BAR;
    }
    for (;;) {
        const char* nA = cA; const char* nB = cB; bool has_next;
        { Unit un; has_next = S.next(ui + 1, un); if (has_next) { nA = un.a; nB = un.b; } }
        for (int t = 0; t < nt; t += 2) {
            const bool last = (t == nt - 2);
            const char* a1 = cA + (size_t)(t + 1) * kstepA;
            const char* a2 = last ? nA : cA + (size_t)(t + 2) * kstepA; const char* b2 = last ? nB : cB + (size_t)(t + 2) * kstep;
            const char* a3 = a2 + kstepA; const char* b3 = b2 + kstep;
            if constexpr (SP2) {
            PG8_LDB(B0, 0, 0); PG8_LDB(B1, 0, 1); PG8_SCHED; PG8_LDA(At, 0, 0); PG8_STAGE(PG8_SA(1, 1), a1 + hsA, voffA);
            PG8_WAIT_V(8); PG8_WAIT_L(0); PG8_BAR; PG8_MMA(0, 0, At, B0); PG8_MMA(0, 1, At, B1); PG8_BAR; PG8_SCHED;
            PG8_LDA(At, 0, 1); PG8_STAGE(PG8_SB(0, 0), b2, voffB); PG8_STAGE(PG8_SB(0, 1), b2 + hsB, voffB); PG8_STAGE(PG8_SA(0, 0), a2, voffA);
            PG8_WAIT_V(8); PG8_WAIT_L(0); PG8_BAR; PG8_MMA(1, 0, At, B0); PG8_MMA(1, 1, At, B1); PG8_BAR; PG8_SCHED;
            PG8_LDB(B0, 1, 0); PG8_LDB(B1, 1, 1); PG8_SCHED; PG8_LDA(At, 1, 0); PG8_STAGE(PG8_SA(0, 1), a2 + hsA, voffA);
            PG8_WAIT_V(8); PG8_WAIT_L(0); PG8_BAR; PG8_MMA(0, 0, At, B0); PG8_MMA(0, 1, At, B1); PG8_BAR; PG8_SCHED;
            PG8_LDA(At, 1, 1); PG8_STAGE(PG8_SB(1, 0), b3, voffB); PG8_STAGE(PG8_SB(1, 1), b3 + hsB, voffB); PG8_STAGE(PG8_SA(1, 0), a3, voffA);
            PG8_WAIT_V(8); PG8_WAIT_L(0); PG8_BAR; PG8_MMA(1, 0, At, B0); PG8_MMA(1, 1, At, B1); PG8_BAR; PG8_SCHED;
            } else {
            PG8_LDB(B0, 0, 0); PG8_SCHED; PG8_LDA(At, 0, 0); PG8_STAGE(PG8_SA(1, 1), a1 + hsA, voffA);
            PG8_WAIT_L(8); PG8_BAR; PG8_WAIT_L(0); PG8_MMA(0, 0, At, B0); PG8_BAR; PG8_SCHED;
            PG8_LDB(B1, 0, 1); PG8_STAGE(PG8_SB(0, 0), b2, voffB);
            PG8_BAR; PG8_WAIT_L(0); PG8_MMA(0, 1, At, B1); PG8_BAR;
            PG8_LDA(At, 0, 1); PG8_STAGE(PG8_SA(0, 0), a2, voffA);
            PG8_BAR; PG8_WAIT_L(0); PG8_MMA(1, 0, At, B0); PG8_BAR; PG8_SCHED;
            PG8_STAGE(PG8_SB(0, 1), b2 + hsB, voffB);
            PG8_WAIT_V(6); PG8_BAR; PG8_MMA(1, 1, At, B1); PG8_BAR;
            PG8_LDB(B0, 1, 0); PG8_SCHED; PG8_LDA(At, 1, 0); PG8_STAGE(PG8_SA(0, 1), a2 + hsA, voffA);
            PG8_WAIT_L(8); PG8_BAR; PG8_WAIT_L(0); PG8_MMA(0, 0, At, B0); PG8_BAR; PG8_SCHED;
            PG8_LDB(B1, 1, 1); PG8_STAGE(PG8_SB(1, 0), b3, voffB);
            PG8_BAR; PG8_WAIT_L(0); PG8_MMA(0, 1, At, B1); PG8_BAR;
            PG8_LDA(At, 1, 1); PG8_STAGE(PG8_SA(1, 0), a3, voffA);
            PG8_BAR; PG8_WAIT_L(0); PG8_MMA(1, 0, At, B0); PG8_BAR; PG8_SCHED;
            PG8_STAGE(PG8_SB(1, 1), b3 + hsB, voffB);
            PG8_WAIT_V(6); PG8_BAR; PG8_MMA(1, 1, At, B1); PG8_BAR;
            }
        }
        if constexpr (ALIGN_EPI) { if (wr == 0) PG8_BAR; }
        { Unit uc; (void)S.next(ui, uc); E(acc, uc, wr, wc, fr, fq); }
        if (!has_next) break;
#pragma unroll
        for (int a = 0; a < 2; ++a)
#pragma unroll
            for (int b = 0; b < 2; ++b)
#pragma unroll
                for (int m = 0; m < 4; ++m)
#pragma unroll
                    for (int n = 0; n < 2; ++n) acc[a][b][m][n] = (f32x4){0.f, 0.f, 0.f, 0.f};
        cA = nA; cB = nB; ++ui;
        if constexpr (ALIGN_EPI) { if (wr == 1) PG8_BAR; }
    }
    PG8_WAIT_V(0);
    if constexpr (!ALIGN_EPI) { if (wr == 0) PG8_BAR; }
    PG8_BAR;
#undef PG8_SA
#undef PG8_SB
#undef PG8_STAGE
#undef PG8_LDA
#undef PG8_LDB
#undef PG8_MMA
#undef PG8_WAIT_V
#undef PG8_WAIT_L
#undef PG8_BAR
#undef PG8_SCHED
}

struct EpiStore {
    static constexpr bool PERM = true;
    __device__ __forceinline__ void operator()(const f32x4 (&acc)[2][2][4][2], const Unit& u, int wr, int wc, int fr, int fq) const {
        bf16* base = (bf16*)u.o; int row0 = wr * 64 + fr, col0 = wc * 32 + 8 * fq; asm volatile("" : "+v"(row0), "+v"(col0)); const bool act = u.x0 != 0;
#pragma unroll
        for (int ai = 0; ai < 2; ++ai)
#pragma unroll
            for (int m = 0; m < 4; ++m) { bf16* rowp = base + (size_t)(row0 + ai * HALF + m * 16) * u.ldo + col0;
#pragma unroll
                for (int bj = 0; bj < 2; ++bj) { f32x4 v0 = acc[ai][bj][m][0], v1 = acc[ai][bj][m][1];
                    if (act) {
#pragma unroll
                        for (int j = 0; j < 4; ++j) { v0[j] = gelu_tanh_f(v0[j]); v1[j] = gelu_tanh_f(v1[j]); } }
                    v4u w; w.x = cvt_pk_bf16(v0[0], v0[1]); w.y = cvt_pk_bf16(v0[2], v0[3]); w.z = cvt_pk_bf16(v1[0], v1[1]); w.w = cvt_pk_bf16(v1[2], v1[3]);
                    *(v4u*)(rowp + bj * HALF) = w; } }
    }
};
struct EpiSwiGLU {
    static constexpr bool PERM = true;
    __device__ __forceinline__ void operator()(const f32x4 (&acc)[2][2][4][2], const Unit& u, int wr, int wc, int fr, int fq) const {
        bf16* base = (bf16*)u.o; int row0 = wr * 64 + fr, col0 = wc * 32 + 8 * fq; asm volatile("" : "+v"(row0), "+v"(col0));
#pragma unroll
        for (int ai = 0; ai < 2; ++ai)
#pragma unroll
            for (int m = 0; m < 4; ++m) { bf16* rowp = base + (size_t)(row0 + ai * HALF + m * 16) * u.ldo + col0;
                f32x4 h0, h1;
#pragma unroll
                for (int j = 0; j < 4; ++j) { h0[j] = silu_f(acc[ai][0][m][0][j]) * acc[ai][1][m][0][j]; h1[j] = silu_f(acc[ai][0][m][1][j]) * acc[ai][1][m][1][j]; }
                v4u w; w.x = cvt_pk_bf16(h0[0], h0[1]); w.y = cvt_pk_bf16(h0[2], h0[3]); w.z = cvt_pk_bf16(h1[0], h1[1]); w.w = cvt_pk_bf16(h1[2], h1[3]);
                *(v4u*)rowp = w; }
    }
};
struct EpiResid {
    static constexpr bool PERM = false;
    __device__ __forceinline__ void operator()(const f32x4 (&acc)[2][2][4][2], const Unit& u, int wr, int wc, int fr, int fq) const {
        const float* xs = (const float*)u.p0; float* zo = (float*)u.o; const float* gv = (const float*)u.p1;
        int row0 = wr * 64 + fr, col0 = wc * 32 + 4 * fq; asm volatile("" : "+v"(row0), "+v"(col0));
#pragma unroll
        for (int ai = 0; ai < 2; ++ai)
#pragma unroll
            for (int m = 0; m < 4; ++m) { const size_t off = (size_t)(row0 + ai * HALF + m * 16) * D + col0;
#pragma unroll
                for (int bj = 0; bj < 2; ++bj)
#pragma unroll
                    for (int n = 0; n < 2; ++n) { const f32x4 xv = *(const f32x4*)(xs + off + bj * HALF + n * 16); const f32x4 gvv = *(const f32x4*)(gv + col0 + bj * HALF + n * 16);
                        *(f32x4*)(zo + off + bj * HALF + n * 16) = xv * ALPHA + gvv * acc[ai][bj][m][n]; }
                asm volatile("" ::: "memory"); }
    }
};
struct EpiGLU {
    static constexpr bool PERM = true;
    __device__ __forceinline__ void operator()(const f32x4 (&acc)[2][2][4][2], const Unit& u, int wr, int wc, int fr, int fq) const {
        bf16* base = (bf16*)u.o; const bf16* gp = (const bf16*)u.p0; const float* bias = (const float*)u.p1;
        int row0 = wr * 64 + fr, col0 = wc * 32 + 8 * fq; asm volatile("" : "+v"(row0), "+v"(col0));
#pragma unroll
        for (int ai = 0; ai < 2; ++ai)
#pragma unroll
            for (int m = 0; m < 4; ++m) { const int r = row0 + ai * HALF + m * 16;
#pragma unroll
                for (int bj = 0; bj < 2; ++bj) { const v4u gw = *(const v4u*)(gp + (size_t)r * u.x0 + col0 + bj * HALF);
                    const f32x4 b0 = *(const f32x4*)(bias + col0 + bj * HALF), b1 = *(const f32x4*)(bias + col0 + bj * HALF + 4);
                    const f32x4 a0 = acc[ai][bj][m][0] + b0, a1 = acc[ai][bj][m][1] + b1;
                    const float o0 = bflo(gw.x) * sigmoid_f(a0[0]), o1 = bfhi(gw.x) * sigmoid_f(a0[1]), o2 = bflo(gw.y) * sigmoid_f(a0[2]), o3 = bfhi(gw.y) * sigmoid_f(a0[3]);
                    const float o4 = bflo(gw.z) * sigmoid_f(a1[0]), o5 = bfhi(gw.z) * sigmoid_f(a1[1]), o6 = bflo(gw.w) * sigmoid_f(a1[2]), o7 = bfhi(gw.w) * sigmoid_f(a1[3]);
                    v4u w; w.x = cvt_pk_bf16(o0, o1); w.y = cvt_pk_bf16(o2, o3); w.z = cvt_pk_bf16(o4, o5); w.w = cvt_pk_bf16(o6, o7);
                    *(v4u*)(base + (size_t)r * u.ldo + col0 + bj * HALF) = w; }
                asm volatile("" ::: "memory"); }
    }
};
struct EpiS5B {
    static constexpr bool PERM = true;
    __device__ __forceinline__ void operator()(const f32x4 (&acc)[2][2][4][2], const Unit& u, int wr, int wc, int fr, int fq) const {
        bf16* base = (bf16*)u.o; const bf16* y1 = (const bf16*)u.p0;
        int row0 = wr * 64 + fr, col0 = wc * 32 + 8 * fq; asm volatile("" : "+v"(row0), "+v"(col0));
#pragma unroll
        for (int ai = 0; ai < 2; ++ai)
#pragma unroll
            for (int m = 0; m < 4; ++m) { const int r = row0 + ai * HALF + m * 16;
#pragma unroll
                for (int bj = 0; bj < 2; ++bj) { const int c = col0 + bj * HALF; const v4u yw = *(const v4u*)(y1 + (size_t)r * 8192 + c);
                    const f32x4 a0 = acc[ai][bj][m][0], a1 = acc[ai][bj][m][1];
                    const float o0 = gelu_tanh_f(a0[0] + bflo(yw.x)), o1 = gelu_tanh_f(a0[1] + bfhi(yw.x)), o2 = gelu_tanh_f(a0[2] + bflo(yw.y)), o3 = gelu_tanh_f(a0[3] + bfhi(yw.y));
                    const float o4 = gelu_tanh_f(a1[0] + bflo(yw.z)), o5 = gelu_tanh_f(a1[1] + bfhi(yw.z)), o6 = gelu_tanh_f(a1[2] + bflo(yw.w)), o7 = gelu_tanh_f(a1[3] + bfhi(yw.w));
                    v4u w; w.x = cvt_pk_bf16(o0, o1); w.y = cvt_pk_bf16(o2, o3); w.z = cvt_pk_bf16(o4, o5); w.w = cvt_pk_bf16(o6, o7);
                    *(v4u*)(base + ((size_t)r * 16 + (c >> 4)) * 1536 + (c & 15)) = w; }
                asm volatile("" ::: "memory"); }
    }
};
}

struct Params { const float* in[32]; float* out; unsigned char* ws; int ph_lo, ph_hi; };
enum { I_X = 0, I_C, I_CTX, I_CCTX, I_WMOD, I_BMOD, I_LNG, I_LNB, I_EV_WIN, I_EV_WOUT, I_EV_SINK, I_EV_W1, I_EV_W3, I_EV_W2, I_OD_WIN, I_A_RE, I_A_IM, I_LOG_DT,
       I_B_RE, I_B_IM, I_C_RE, I_C_IM, I_SSM_D, I_WGLU, I_BGLU, I_WS, I_BS, I_OD_WOUT, I_ROUTER, I_MW1, I_MW3, I_MW2 };

constexpr int LDS_RING = 131072, LDS_MISC = LDS_RING + 320, LDS_BYTES = 147456;
constexpr int NWAVES = 8, NTHREADS = 512;

struct Frame {
    LAS unsigned char* lds;
    int tid, lane, wave, G, bid, gw, NGW;
    unsigned char* ws;
    unsigned* ctl;
};

using pg8::Unit;
struct SchedStd {
    int nN, nUnits, G, c; const char* A; const char* B; char* O; size_t aStep, bStep, oRow, oCol; int ldo, act_from;
    __device__ __forceinline__ bool next(int i, Unit& u) const {
        const int L = i * G + c; if (L >= nUnits) return false;
        const int pm = L / nN, pn = L - pm * nN;
        u.a = A + (size_t)pm * aStep; u.b = B + (size_t)pn * bStep; u.o = O + (size_t)pm * oRow + (size_t)pn * oCol; u.p0 = nullptr; u.p1 = nullptr; u.ldo = ldo; u.x0 = (pn >= act_from) ? 1 : 0; return true;
    }
};
struct SchedEvIn {
    int G, c; const char* H; const char* Wqkv; const char* Wpq; char* QKV; char* PQT; char* PQTC;
    __device__ __forceinline__ bool next(int i, Unit& u) const {
        int L = i * G + c; u.p0 = nullptr; u.p1 = nullptr; u.x0 = 0;
        constexpr int NQ = (T / 256) * 3, NP = 4 * (TL / 256), NPC = 4 * (TC / 256);
        if (L < NQ) { const int pm = L / 3, pn = L - pm * 3;
            u.a = H + (size_t)pm * 256 * D * 2; u.b = Wqkv + (size_t)pn * 256 * D * 2; u.o = QKV + ((size_t)pm * 256 * 768 + pn * 256) * 2; u.ldo = 768; return true; }
        L -= NQ;
        if (L < NP) { const int tt = L >> 2, pm = L & 3, b = tt >> 4, n0 = (tt & 15) * 256, isq = pm >> 1, ch0 = (pm & 1) * 256;
            u.a = Wpq + (size_t)pm * 256 * D * 2; u.b = H + (size_t)tt * 256 * D * 2;
            u.o = PQT + ((((size_t)b * 512 + ch0) * 2 + isq) * 4096 + n0) * 2; u.ldo = 8192; return true; }
        L -= NP;
        if (L < NPC) { const int b = L >> 2, pm = L & 3, isq = pm >> 1, ch0 = (pm & 1) * 256;
            u.a = Wpq + (size_t)pm * 256 * D * 2; u.b = H + ((size_t)TL + (size_t)b * 256) * D * 2;
            u.o = PQTC + (((size_t)b * 512 + ch0) * 2 + isq) * 256 * 2; u.ldo = 512; return true; }
        return false;
    }
};
struct SchedDft {
    int G, c; const char* F; const char* PQT; char* MIX;
    __device__ __forceinline__ bool next(int i, Unit& u) const {
        const int L = i * G + c; if (L >= 512) return false;
        const int b = L >> 5, r = L & 31, pm = r >> 1, pn = r & 1;
        u.a = F + (size_t)pm * 256 * 8192 * 2; u.b = PQT + ((size_t)b * 512 + pn * 256) * 8192 * 2;
        u.o = MIX + (((size_t)b * 4096 + pm * 256) * D + pn * 256) * 2; u.p0 = nullptr; u.p1 = nullptr; u.ldo = D; u.x0 = 0; return true;
    }
};
struct SchedDftC {
    int G, c; const char* F; const char* PQTC; char* MIX;
    __device__ __forceinline__ bool next(int i, Unit& u) const {
        const int L = i * G + (G - 1 - c); if (L >= 32) return false;
        const int b = L >> 1, pn = L & 1;
        u.a = F; u.b = PQTC + ((size_t)b * 512 + pn * 256) * 512 * 2;
        u.o = MIX + (((size_t)TL + (size_t)b * 256) * D + pn * 256) * 2; u.p0 = nullptr; u.p1 = nullptr; u.ldo = D; u.x0 = 0; return true;
    }
};
struct SchedResid {
    int G, c, nUnits; const char* A; size_t aStep; const char* W; size_t bStep; const float* xl; const float* xc; float* zl; float* zc; const float* gate;
    __device__ __forceinline__ bool next(int i, Unit& u) const {
        const int L = i * G + c; if (L >= nUnits) return false;
        const int pm = L >> 2, pn = L & 3;
        u.a = A + (size_t)pm * aStep; u.b = W + (size_t)pn * bStep;
        const bool isc = pm >= TL / 256; const int pr = isc ? pm - TL / 256 : pm; const int mrow = isc ? 16 : (pm >> 4);
        const size_t off = ((size_t)pr * 256 * D + pn * 256);
        u.p0 = (const char*)((isc ? xc : xl) + off); u.o = (char*)((isc ? zc : zl) + off); u.p1 = (const char*)(gate + (size_t)mrow * 6144 + pn * 256); u.ldo = D; u.x0 = 0; return true;
    }
};
struct SchedGlu {
    int G, c; const char* P; const char* W; char* MIX; const float* bias;
    __device__ __forceinline__ bool next(int i, Unit& u) const {
        const int L = i * G + c; if (L >= (T / 256) * 2) return false;
        const int pm = L >> 1, pn = L & 1;
        u.a = P + (size_t)pm * 256 * 1536 * 2; u.b = W + (size_t)pn * 256 * 512 * 2; u.o = MIX + ((size_t)pm * 256 * D + pn * 256) * 2;
        u.p0 = P + ((size_t)pm * 256 * 1536 + pn * 256) * 2; u.p1 = (const char*)(bias + pn * 256); u.ldo = D; u.x0 = 1536; return true;
    }
};
struct SchedS5A {
    int G, c; const char* P; const char* WA; char* Y1; char* HB;
    __device__ __forceinline__ bool next(int i, Unit& u) const {
        const int L = i * G + c; if (L >= 32 * 34) return false;
        const int g = L / 34, rem = L - g * 34, pm = rem >> 1, pn = rem & 1;
        u.a = P + ((size_t)pm * 256 * 16 * 1536 + g * 16) * 2; u.b = WA + (size_t)g * S5M_STRIDE + (size_t)pn * 256 * 256 * 2;
        u.o = (pn ? HB : Y1) + (((size_t)pm * 256 * 32 + g) * 256) * 2; u.p0 = nullptr; u.p1 = nullptr; u.ldo = 8192; u.x0 = 0; return true;
    }
};
struct SchedS5B {
    int G, c; const char* HB; const char* CL; const char* Y1; char* P;
    __device__ __forceinline__ bool next(int i, Unit& u) const {
        const int L = i * G + c; if (L >= 32 * 17) return false;
        const int g = L / 17, pm = L - g * 17;
        const size_t toff = (((size_t)pm * 256 * 32 + g) * 256) * 2;
        u.a = HB + toff; u.b = CL + (size_t)g * S5M_STRIDE; u.p0 = Y1 + toff; u.o = P + ((size_t)pm * 256 * 16 * 1536 + g * 16) * 2; u.p1 = nullptr; u.ldo = 0; u.x0 = 0; return true;
    }
};
struct SchedMoeUp {
    int G, c, nUnits, rt0; int toff[9]; const char* HS; const char* W; char* HID;
    __device__ __forceinline__ bool next(int i, Unit& u) const {
        const int L = i * G + c; if (L >= nUnits) return false;
        const int rl = L / 28, pn = L - rl * 28, rt = rt0 + rl; int e = 0;
#pragma unroll
        for (int k = 1; k < 8; ++k) e += (rt >= toff[k]) ? 1 : 0;
        u.a = HS + (size_t)rt * 256 * D * 2; u.b = W + ((size_t)e * 7168 + pn * 256) * D * 2; u.o = HID + ((size_t)rl * 256 * EH + pn * 128) * 2;
        u.p0 = nullptr; u.p1 = nullptr; u.ldo = EH; u.x0 = 0; return true;
    }
};
struct SchedMoeDown {
    int G, c, nUnits, rt0; int toff[9]; const char* HID; const char* W; char* Y;
    __device__ __forceinline__ bool next(int i, Unit& u) const {
        const int L = i * G + c; if (L >= nUnits) return false;
        const int rl = L >> 2, pn = L & 3, rt = rt0 + rl; int e = 0;
#pragma unroll
        for (int k = 1; k < 8; ++k) e += (rt >= toff[k]) ? 1 : 0;
        u.a = HID + (size_t)rl * 256 * EH * 2; u.b = W + ((size_t)e * 1024 + pn * 256) * EH * 2; u.o = Y + ((size_t)rt * 256 * D + pn * 256) * 2;
        u.p0 = nullptr; u.p1 = nullptr; u.ldo = D; u.x0 = 0; return true;
    }
};

__device__ __forceinline__ void tr_item(const float* W, int ldn, bf16* WT, int ldk, int k0, int n0, int drow0, LAS float* scr, int lane) {
#pragma unroll 8
    for (int i = 0; i < 32; ++i) { const int kk = 2 * i + (lane >> 5); scr[kk * 33 + (lane & 31)] = W[(size_t)(k0 + kk) * ldn + n0 + (lane & 31)]; }
    LDS_WAIT(); asm volatile("" ::: "memory");
    const int c = lane & 7;
#pragma unroll
    for (int j = 0; j < 4; ++j) { const int n = (lane >> 3) + 8 * j; const LAS float* s = scr + (8 * c) * 33 + n;
        v4u o; o.x = cvt_pk_bf16(s[0 * 33], s[1 * 33]); o.y = cvt_pk_bf16(s[2 * 33], s[3 * 33]); o.z = cvt_pk_bf16(s[4 * 33], s[5 * 33]); o.w = cvt_pk_bf16(s[6 * 33], s[7 * 33]);
        *(v4u*)(WT + (size_t)(drow0 + n) * ldk + k0 + 8 * c) = o; }
    LDS_WAIT(); asm volatile("" ::: "memory");
}
__device__ __forceinline__ void tr_job(const float* W, int ldn, int N, bf16* WT, int ldk, int mode, int roff, int item, LAS float* scr, int lane) {
    const int nblk = N / 32, kb = item / nblk, nb = item - kb * nblk, n0 = nb * 32;
    const int drow0 = mode ? ((n0 >> 7) * 256 + (n0 & 127) + roff) : (roff + n0);
    tr_item(W, ldn, WT, ldk, kb * 64, n0, drow0, scr, lane);
}
__device__ __forceinline__ void cvt_item(const Params& p, int r, LAS float* scr, int lane) {
    unsigned char* ws = p.ws;
    constexpr int EV_ITEMS = 384 + 512 + 3 * 1408;
    constexpr int ODS_ITEMS = 768 + 128 + 512;
    constexpr int EXP_ITEMS = 3 * 1792, MOE_ITEMS = 8 * EXP_ITEMS;
    if (r < 2 * EV_ITEMS) { const int li = r / EV_ITEMS; r -= li * EV_ITEMS; unsigned char* base = ws + WS_EV + li * EV_STRIDE;
        if (r < 384) { tr_job(p.in[I_EV_WIN] + (size_t)li * D * 1280 + 512, 1280, 768, (bf16*)(base + EV_WQKV), D, 0, 0, r, scr, lane); return; } r -= 384;
        if (r < 512) { tr_job(p.in[I_EV_WOUT] + (size_t)li * D * D, D, D, (bf16*)(base + EV_WOUT), D, 0, 0, r, scr, lane); return; } r -= 512;
        if (r < 1408) { tr_job(p.in[I_EV_W1] + (size_t)li * D * FFH, FFH, FFH, (bf16*)(base + EV_W13), D, 1, 0, r, scr, lane); return; } r -= 1408;
        if (r < 1408) { tr_job(p.in[I_EV_W3] + (size_t)li * D * FFH, FFH, FFH, (bf16*)(base + EV_W13), D, 1, 128, r, scr, lane); return; } r -= 1408;
        tr_job(p.in[I_EV_W2] + (size_t)li * FFH * D, D, D, (bf16*)(base + EV_W2), FFH, 0, 0, r, scr, lane); return; }
    r -= 2 * EV_ITEMS;
    if (r < 2 * ODS_ITEMS) { const int li = r / ODS_ITEMS; r -= li * ODS_ITEMS; unsigned char* base = ws + WS_OD + li * OD_STRIDE;
        if (r < 768) { tr_job(p.in[I_OD_WIN] + (size_t)li * D * 1536, 1536, 1536, (bf16*)(base + OD_WIN), D, 0, 0, r, scr, lane); return; } r -= 768;
        if (r < 128) { tr_job(p.in[I_WGLU] + (size_t)li * 512 * 512, 512, 512, (bf16*)(base + OD_WGLU), 512, 0, 0, r, scr, lane); return; } r -= 128;
        tr_job(p.in[I_OD_WOUT] + (size_t)li * D * D, D, D, (bf16*)(base + OD_WOUT), D, 0, 0, r, scr, lane); return; }
    r -= 2 * ODS_ITEMS;
    { const int li = r / MOE_ITEMS; r -= li * MOE_ITEMS; const int e = r / EXP_ITEMS; r -= e * EXP_ITEMS; unsigned char* base = ws + WS_OD + li * OD_STRIDE;
        const size_t we = (size_t)li * NEXP + e;
        if (r < 1792) { tr_job(p.in[I_MW1] + we * D * EH, EH, EH, (bf16*)(base + OD_MW13) + (size_t)e * 7168 * D, D, 1, 0, r, scr, lane); return; } r -= 1792;
        if (r < 1792) { tr_job(p.in[I_MW3] + we * D * EH, EH, EH, (bf16*)(base + OD_MW13) + (size_t)e * 7168 * D, D, 1, 128, r, scr, lane); return; } r -= 1792;
        tr_job(p.in[I_MW2] + we * EH * D, D, D, (bf16*)(base + OD_MW2) + (size_t)e * D * EH, EH, 0, 0, r, scr, lane); }
}
constexpr int CVT_ITEMS = 2 * 5120 + 2 * 1408 + 2 * 8 * 3 * 1792;

__device__ __forceinline__ void fold_unit(const Params& p, Frame& F, int unit) {
    const int li = unit >> 6, g = (unit >> 4) & 3, k0 = (unit & 15) * 64;
    LAS float* tile = (LAS float*)F.lds;
    LAS float* trig = tile + 64 * 129;
    const float* W = p.in[I_EV_WIN] + (size_t)li * D * 1280;
    for (int e = F.tid; e < 64 * 128; e += NTHREADS) { const int k = e >> 7, c = e & 127; tile[k * 129 + c] = W[(size_t)(k0 + k) * 1280 + g * 128 + c]; }
    if (F.tid < 128) { float s, c; sincospif((float)F.tid / 64.0f, &s, &c); trig[F.tid] = c * 0.08838834764831845f; trig[128 + F.tid] = s * 0.08838834764831845f; }
    __syncthreads();
    bf16* WT = (bf16*)(p.ws + WS_EV + li * EV_STRIDE + EV_WPQ);
    const int k = F.lane, mg = F.wave;
    for (int mm = 0; mm < 16; ++mm) { const int m = mg * 16 + mm; float sp = 0.f, sq = 0.f;
        for (int c = 0; c < 128; ++c) { const float w = tile[k * 129 + c]; const int ph = (m * c) & 127; sp += w * trig[ph]; sq += w * trig[128 + ph]; }
        WT[(size_t)(g * 128 + m) * D + k0 + k] = f2bf(sp); WT[(size_t)(512 + g * 128 + m) * D + k0 + k] = f2bf(sq); }
    __syncthreads();
}

__device__ __forceinline__ void row_load(const float* row, int lane, f32x4 (&v)[4]) {
#pragma unroll
    for (int j = 0; j < 4; ++j) v[j] = *(const f32x4*)(row + 256 * j + 4 * lane);
}
__device__ __forceinline__ void row_store(float* row, int lane, const f32x4 (&v)[4]) {
#pragma unroll
    for (int j = 0; j < 4; ++j) *(f32x4*)(row + 256 * j + 4 * lane) = v[j];
}
__device__ __forceinline__ void row_store_bf16(bf16* row, int lane, const f32x4 (&v)[4]) {
#pragma unroll
    for (int j = 0; j < 4; ++j) { v2u w; w.x = cvt_pk_bf16(v[j][0], v[j][1]); w.y = cvt_pk_bf16(v[j][2], v[j][3]); *(v2u*)(row + 256 * j + 4 * lane) = w; }
}
__device__ __forceinline__ void row_layernorm(f32x4 (&v)[4], const float* g, const float* b, int lane) {
    float s = 0.f;
#pragma unroll
    for (int j = 0; j < 4; ++j) s += (v[j][0] + v[j][1]) + (v[j][2] + v[j][3]);
    const float mean = wave_sum(s) * (1.f / D); float q = 0.f;
#pragma unroll
    for (int j = 0; j < 4; ++j) { v[j] = v[j] - mean; q += (v[j][0] * v[j][0] + v[j][1] * v[j][1]) + (v[j][2] * v[j][2] + v[j][3] * v[j][3]); }
    const float rstd = rsqrtf(wave_sum(q) * (1.f / D) + LN_EPS);
#pragma unroll
    for (int j = 0; j < 4; ++j) { const f32x4 gg = *(const f32x4*)(g + 256 * j + 4 * lane), bb = *(const f32x4*)(b + 256 * j + 4 * lane); v[j] = v[j] * rstd * gg + bb; }
}
__device__ __forceinline__ void row_modulate(f32x4 (&h)[4], const f32x4 (&v)[4], const float* sc, const float* sh, int lane) {
#pragma unroll
    for (int j = 0; j < 4; ++j) { const f32x4 s = *(const f32x4*)(sc + 256 * j + 4 * lane), t = *(const f32x4*)(sh + 256 * j + 4 * lane); h[j] = v[j] * (s + 1.0f) + t; }
}

typedef const __attribute__((address_space(4))) Params* PP;
#define PIN(i) ((const float*)pp->in[i])
#define DECL_LDS extern __shared__ __attribute__((aligned(16))) unsigned char lds_raw[]
#define PHASE_FN static __device__ __forceinline__ void

__device__ __forceinline__ Frame make_frame(PP pp, unsigned char* lds_generic) {
    Frame F;
    F.lds = (LAS unsigned char*)lds_generic;
    { int t_ = threadIdx.x; asm volatile("" : "+v"(t_)); F.tid = t_; }
    F.lane = F.tid & 63; F.wave = __builtin_amdgcn_readfirstlane(F.tid >> 6);
    F.G = gridDim.x; F.bid = blockIdx.x; F.gw = F.bid * NWAVES + F.wave; F.NGW = F.G * NWAVES;
    F.ws = (unsigned char*)pp->ws; F.ctl = (unsigned*)(F.ws + WS_CTL);
    return F;
}
#define FRAME() DECL_LDS; asm volatile("" : "+s"(pp)); Frame F = make_frame(pp, lds_raw); unsigned char* ws = F.ws; (void)ws

PHASE_FN grid_bar(PP pp) {
    FRAME();
    XcdBarrier bar; bar.bar = F.ctl + CW_BAR; bar.x = xb_xcc_id(); bar.st = (volatile LAS unsigned*)(F.lds + LDS_MISC) + 8;
    xcd_barrier(bar);
}

PHASE_FN ph_fold(PP pp) {
    FRAME();
    Params p; p.ws = ws; p.in[I_EV_WIN] = PIN(I_EV_WIN);
    for (int u = F.bid; u < 128; u += F.G) fold_unit(p, F, u);
}
PHASE_FN ph_mod(PP pp) {
    FRAME();
    float* MOD = (float*)(ws + WS_MOD);
    LAS float* sc = (LAS float*)F.lds;
    const float* cin = PIN(I_C); const float* ccin = PIN(I_CCTX);
    for (int e = F.tid; e < 17 * D; e += NTHREADS) { const int r = e >> 10, k = e & 1023; const float v = (r < 16) ? cin[r * D + k] : ccin[k]; sc[e] = silu_f(v); }
    __syncthreads();
    for (int grp = F.gw; grp < DEPTH * 6144 / 64; grp += F.NGW) {
        const int col = grp * 64 + F.lane, l = col / 6144, j = col - l * 6144;
        const float* W = PIN(I_WMOD) + (size_t)l * D * 6144 + j;
        float acc[17];
#pragma unroll
        for (int r = 0; r < 17; ++r) acc[r] = 0.f;
        for (int k = 0; k < D; k += 4) {
            const float w0 = W[(size_t)(k + 0) * 6144], w1 = W[(size_t)(k + 1) * 6144], w2 = W[(size_t)(k + 2) * 6144], w3 = W[(size_t)(k + 3) * 6144];
#pragma unroll
            for (int r = 0; r < 17; ++r) { const f32x4 s = *(const LAS f32x4*)(sc + r * D + k); acc[r] += s[0] * w0 + s[1] * w1 + s[2] * w2 + s[3] * w3; }
        }
        const float bm = PIN(I_BMOD)[l * 6144 + j];
#pragma unroll
        for (int r = 0; r < 17; ++r) MOD[((size_t)l * 17 + r) * 6144 + j] = acc[r] + bm;
    }
    __syncthreads();
}
PHASE_FN ph_cvt(PP pp) {
    FRAME();
    Params p; p.ws = ws;
    p.in[I_EV_WIN] = PIN(I_EV_WIN); p.in[I_EV_WOUT] = PIN(I_EV_WOUT); p.in[I_EV_W1] = PIN(I_EV_W1); p.in[I_EV_W3] = PIN(I_EV_W3); p.in[I_EV_W2] = PIN(I_EV_W2);
    p.in[I_OD_WIN] = PIN(I_OD_WIN); p.in[I_WGLU] = PIN(I_WGLU); p.in[I_OD_WOUT] = PIN(I_OD_WOUT); p.in[I_MW1] = PIN(I_MW1); p.in[I_MW3] = PIN(I_MW3); p.in[I_MW2] = PIN(I_MW2);
    LAS float* scr = (LAS float*)(F.lds + F.wave * 16384);
    for (int it = F.gw; it < CVT_ITEMS; it += F.NGW) cvt_item(p, it, scr, F.lane);
}
PHASE_FN ph_dftmat(PP pp) {
    FRAME();
    bf16* F4 = (bf16*)(ws + WS_F4096);
    for (int it = F.bid * NTHREADS + F.tid; it < 4096 * 1024; it += F.G * NTHREADS) {
        const int k = it >> 10, n0 = (it & 1023) * 8; const bool isq = n0 >= 4096; const int nb = n0 & 4095;
        float v[8];
#pragma unroll
        for (int j = 0; j < 8; ++j) { const int phs = (k * (nb + j)) & 4095; float s, c; sincospif((float)phs * (1.0f / 2048.0f), &s, &c); v[j] = isq ? -s * (1.f / 64.f) : c * (1.f / 64.f); }
        v4u w; w.x = cvt_pk_bf16(v[0], v[1]); w.y = cvt_pk_bf16(v[2], v[3]); w.z = cvt_pk_bf16(v[4], v[5]); w.w = cvt_pk_bf16(v[6], v[7]);
        *(v4u*)(F4 + (size_t)k * 8192 + n0) = w;
    }
    bf16* F2 = (bf16*)(ws + WS_F256);
    for (int it = F.bid * NTHREADS + F.tid; it < 256 * 64; it += F.G * NTHREADS) {
        const int k = it >> 6, n0 = (it & 63) * 8; const bool isq = n0 >= 256; const int nb = n0 & 255;
        float v[8];
#pragma unroll
        for (int j = 0; j < 8; ++j) { const int phs = (k * (nb + j)) & 255; float s, c; sincospif((float)phs * (1.0f / 128.0f), &s, &c); v[j] = isq ? -s * (1.f / 16.f) : c * (1.f / 16.f); }
        v4u w; w.x = cvt_pk_bf16(v[0], v[1]); w.y = cvt_pk_bf16(v[2], v[3]); w.z = cvt_pk_bf16(v[4], v[5]); w.w = cvt_pk_bf16(v[6], v[7]);
        *(v4u*)(F2 + (size_t)k * 512 + n0) = w;
    }
}
PHASE_FN ph_s5mat(PP pp) {
    FRAME();
    LAS float* lam = (LAS float*)F.lds;
    LAS float* bb = lam + 2 * 64 * 17 * 2;
    LAS float* cc = bb + 2 * 64 * 16 * 2;
    LAS float* kt = cc + 2 * 16 * 64 * 2;
    for (int unit = F.bid; unit < 64; unit += F.G) {
        const int li = unit >> 5, g = unit & 31;
        __syncthreads();
        if (F.tid < 128) { const int d = F.tid >> 6, pl = F.tid & 63; const int sidx = ((li * 2 + d) * 32 + g);
            const float are = PIN(I_A_RE)[sidx * 64 + pl], aim = PIN(I_A_IM)[sidx * 64 + pl], dt = expf(PIN(I_LOG_DT)[sidx]);
            for (int e = 0; e <= 16; ++e) { const float mag = expf(are * dt * (float)e); float sn, cn; sincosf(aim * dt * (float)e, &sn, &cn); lam[((d * 64 + pl) * 17 + e) * 2] = mag * cn; lam[((d * 64 + pl) * 17 + e) * 2 + 1] = mag * sn; } }
        __syncthreads();
        for (int e = F.tid; e < 2048; e += NTHREADS) { const int d = e >> 10, pl = (e >> 4) & 63, sp = e & 15; const int sidx = ((li * 2 + d) * 32 + g);
            const float are = PIN(I_A_RE)[sidx * 64 + pl], aim = PIN(I_A_IM)[sidx * 64 + pl];
            const float lre = lam[((d * 64 + pl) * 17 + 1) * 2], lim = lam[((d * 64 + pl) * 17 + 1) * 2 + 1];
            const float den = 1.0f / (are * are + aim * aim);
            const float fre = ((lre - 1.0f) * are + lim * aim) * den, fim = (lim * are - (lre - 1.0f) * aim) * den;
            const float br = PIN(I_B_RE)[((size_t)sidx * 64 + pl) * 16 + sp], bi = PIN(I_B_IM)[((size_t)sidx * 64 + pl) * 16 + sp];
            bb[e * 2] = fre * br - fim * bi; bb[e * 2 + 1] = fre * bi + fim * br; }
        for (int e = F.tid; e < 2048; e += NTHREADS) { const int d = e >> 10, sq = (e >> 6) & 15, pl = e & 63; const int sidx = ((li * 2 + d) * 32 + g);
            cc[e * 2] = PIN(I_C_RE)[((size_t)sidx * 16 + sq) * 64 + pl]; cc[e * 2 + 1] = PIN(I_C_IM)[((size_t)sidx * 16 + sq) * 64 + pl]; }
        __syncthreads();
        for (int e = F.tid; e < 8192; e += NTHREADS) { const int d = e >> 12, tau = (e >> 8) & 15, sq = (e >> 4) & 15, sp = e & 15; float acc = 0.f;
            for (int pl = 0; pl < 64; ++pl) { const float cr = cc[((d * 16 + sq) * 64 + pl) * 2], ci = cc[((d * 16 + sq) * 64 + pl) * 2 + 1];
                const float lr = lam[((d * 64 + pl) * 17 + tau) * 2], lj = lam[((d * 64 + pl) * 17 + tau) * 2 + 1];
                const float br = bb[((d * 64 + pl) * 16 + sp) * 2], bi = bb[((d * 64 + pl) * 16 + sp) * 2 + 1];
                const float tr = cr * lr - ci * lj, ti = cr * lj + ci * lr;
                acc += tr * br - ti * bi; }
            kt[e] = acc; }
        __syncthreads();
        bf16* WA = (bf16*)(ws + WS_S5M + (size_t)unit * S5M_STRIDE); bf16* CLm = WA + 512 * 256;
        const float* dsk = PIN(I_SSM_D) + (size_t)li * 512 + g * 16;
        for (int it = F.tid; it < 8192; it += NTHREADS) { const int row = it >> 5, c0 = (it & 31) * 8;
            float v[8];
            { const int i = row >> 4, sq = row & 15, j = c0 >> 4, sp0 = c0 & 15;
#pragma unroll
              for (int q = 0; q < 8; ++q) { const int sp = sp0 + q; float a = 0.f; if (i >= j) a += kt[((0 * 16 + (i - j)) * 16 + sq) * 16 + sp]; if (j >= i) a += kt[((1 * 16 + (j - i)) * 16 + sq) * 16 + sp]; if (i == j && sq == sp) a += dsk[sq]; v[q] = a; }
              v4u w; w.x = cvt_pk_bf16(v[0], v[1]); w.y = cvt_pk_bf16(v[2], v[3]); w.z = cvt_pk_bf16(v[4], v[5]); w.w = cvt_pk_bf16(v[6], v[7]); *(v4u*)(WA + (size_t)row * 256 + c0) = w; }
            { const int d = row >> 7, pl = (row >> 1) & 63, ri = row & 1, j = c0 >> 4, sp0 = c0 & 15, e = d ? j : 15 - j;
              const float lr = lam[((d * 64 + pl) * 17 + e) * 2], lj = lam[((d * 64 + pl) * 17 + e) * 2 + 1];
#pragma unroll
              for (int q = 0; q < 8; ++q) { const float br = bb[((d * 64 + pl) * 16 + sp0 + q) * 2], bi = bb[((d * 64 + pl) * 16 + sp0 + q) * 2 + 1]; v[q] = ri ? (lr * bi + lj * br) : (lr * br - lj * bi); }
              v4u w; w.x = cvt_pk_bf16(v[0], v[1]); w.y = cvt_pk_bf16(v[2], v[3]); w.z = cvt_pk_bf16(v[4], v[5]); w.w = cvt_pk_bf16(v[6], v[7]); *(v4u*)(WA + (size_t)(256 + row) * 256 + c0) = w; }
            { const int i = row >> 4, sq = row & 15, d = c0 >> 7, pl0 = (c0 >> 1) & 63, e = d ? 16 - i : i + 1;
#pragma unroll
              for (int q = 0; q < 4; ++q) { const int pl = pl0 + q; const float cr = cc[((d * 16 + sq) * 64 + pl) * 2], ci = cc[((d * 16 + sq) * 64 + pl) * 2 + 1];
                  const float lr = lam[((d * 64 + pl) * 17 + e) * 2], lj = lam[((d * 64 + pl) * 17 + e) * 2 + 1];
                  v[2 * q] = cr * lr - ci * lj; v[2 * q + 1] = -(cr * lj + ci * lr); }
              v4u w; w.x = cvt_pk_bf16(v[0], v[1]); w.y = cvt_pk_bf16(v[2], v[3]); w.z = cvt_pk_bf16(v[4], v[5]); w.w = cvt_pk_bf16(v[6], v[7]); *(v4u*)(CLm + (size_t)row * 256 + c0) = w; }
        }
    }
    __syncthreads();
}
PHASE_FN ph_pro_b(PP pp) {
    FRAME();
    const float* MOD = (const float*)(ws + WS_MOD); bf16* Hb = (bf16*)(ws + WS_H);
    const float* xin = PIN(I_X); const float* cin = PIN(I_CTX);
    for (int r = F.gw; r < T; r += F.NGW) {
        const bool isc = r >= TL; const float* xr = isc ? cin + (size_t)(r - TL) * D : xin + (size_t)r * D;
        const float* m = MOD + (size_t)(isc ? 16 : (r >> 12)) * 6144;
        f32x4 v[4], h[4]; row_load(xr, F.lane, v); row_modulate(h, v, m + 1024, m, F.lane); row_store_bf16(Hb + (size_t)r * D, F.lane, h);
    }
}

PHASE_FN ph_e1(PP pp, int layer) {
    FRAME();
    unsigned char* evw = ws + WS_EV + (layer >> 1) * EV_STRIDE; unsigned char* BIG = ws + WS_BIG;
    SchedEvIn S{F.G, F.bid, (const char*)(ws + WS_H), (const char*)(evw + EV_WQKV), (const char*)(evw + EV_WPQ), (char*)(BIG + BIG_QKV), (char*)(BIG + BIG_PQT), (char*)(BIG + BIG_PQTC)};
    pg8::gemm_phase<pg8::EpiStore, SchedEvIn, true, true>(F.lds, F.tid, pg8::Dims{D, D, D}, S, pg8::EpiStore{});
}
PHASE_FN ph_e2_dft(PP pp) {
    FRAME();
    unsigned char* BIG = ws + WS_BIG;
    SchedDft S{F.G, F.bid, (const char*)(ws + WS_F4096), (const char*)(BIG + BIG_PQT), (char*)(BIG + BIG_MIX)};
    pg8::gemm_phase<pg8::EpiStore, SchedDft, true, true>(F.lds, F.tid, pg8::Dims{8192, 8192, 8192}, S, pg8::EpiStore{});
}
PHASE_FN ph_e2_dftc(PP pp) {
    FRAME();
    unsigned char* BIG = ws + WS_BIG;
    SchedDftC S{F.G, F.bid, (const char*)(ws + WS_F256), (const char*)(BIG + BIG_PQTC), (char*)(BIG + BIG_MIX)};
    pg8::gemm_phase<pg8::EpiStore, SchedDftC, true, true>(F.lds, F.tid, pg8::Dims{512, 512, 512}, S, pg8::EpiStore{});
}
PHASE_FN ph_e2_rope(PP pp) {
    FRAME();
    bf16* QKV = (bf16*)(ws + WS_BIG + BIG_QKV);
    LAS f32x2* cs = (LAS f32x2*)F.lds;
    __syncthreads();
    for (int e = F.tid; e < 1024; e += NTHREADS) { const int pos = e >> 4, i = e & 15; const float inv = powf(10000.0f, -(float)i / 16.0f); float s, c; sincosf((float)pos * inv, &s, &c); cs[e] = (f32x2){c, s}; }
    __syncthreads();
    for (int it = F.bid * NTHREADS + F.tid; it < TL * 80; it += F.G * NTHREADS) {
        const int r = it / 80, q = it - r * 80, hh = q >> 3, ax = (q >> 2) & 1, i0 = (q & 3) * 4;
        const int n = r & 4095, pos = ax ? (n & 63) : (n >> 6);
        bf16* base = QKV + (size_t)r * 768 + hh * 64 + ax * 32 + i0;
        const v2u a = *(const v2u*)base, b = *(const v2u*)(base + 16);
        const float x1[4] = {bflo(a.x), bfhi(a.x), bflo(a.y), bfhi(a.y)}, x2[4] = {bflo(b.x), bfhi(b.x), bflo(b.y), bfhi(b.y)};
        float o1[4], o2[4];
#pragma unroll
        for (int j = 0; j < 4; ++j) { const f32x2 t = cs[pos * 16 + i0 + j]; o1[j] = x1[j] * t.x - x2[j] * t.y; o2[j] = x1[j] * t.y + x2[j] * t.x; }
        v2u wa, wb; wa.x = cvt_pk_bf16(o1[0], o1[1]); wa.y = cvt_pk_bf16(o1[2], o1[3]); wb.x = cvt_pk_bf16(o2[0], o2[1]); wb.y = cvt_pk_bf16(o2[2], o2[3]);
        *(v2u*)base = wa; *(v2u*)(base + 16) = wb;
    }
    bf16* VT = (bf16*)(ws + WS_H);
    for (int it = F.bid * NTHREADS + F.tid; it < NBATCH * 2 * 544 * 64; it += F.G * NTHREADS) {
        const int d = it & 63, kg = (it >> 6) % 544, bh = (it >> 6) / 544, b = bh >> 1, hkv = bh & 1;
        const int key0 = kg * 8; const size_t row0 = (key0 < 256) ? ((size_t)TL + (size_t)b * 256 + key0) : ((size_t)b * 4096 + (key0 - 256));
        const bf16* src = QKV + row0 * 768 + 640 + hkv * 64 + d;
        unsigned short v[8];
#pragma unroll
        for (int j = 0; j < 8; ++j) v[j] = src[(size_t)j * 768];
        v4u w; w.x = v[0] | ((unsigned)v[1] << 16); w.y = v[2] | ((unsigned)v[3] << 16); w.z = v[4] | ((unsigned)v[5] << 16); w.w = v[6] | ((unsigned)v[7] << 16);
        *(v4u*)(VT + ((size_t)bh * 64 + d) * 4352 + key0) = w;
    }
    __syncthreads();
}
typedef float f32x16 __attribute__((ext_vector_type(16)));
typedef __bf16 bf16x2v __attribute__((ext_vector_type(2)));
__device__ __forceinline__ unsigned pk_bf16(float a, float b) { const bf16x2v t = __builtin_convertvector((f32x2){a, b}, bf16x2v); return __builtin_bit_cast(unsigned, t); }
constexpr int AT_KP = 144, AT_VP1 = 648, AT_VP2 = 520, AT_VOFF = 320 * AT_KP;
template <bool MASKED>
__device__ __forceinline__ void attn_tile(const LAS unsigned char* Ks, const LAS unsigned char* Vs, const int vpitch, const int kl_base, const bf16x8 (&qf)[4], f32x16& o0, f32x16& o1, float& m, float& l,
                                          const int r, const int h, const int kj0, const int qi) {
    f32x16 x;
#pragma unroll
    for (int i = 0; i < 16; ++i) x[i] = 0.f;
#pragma unroll
    for (int s = 0; s < 4; ++s) { const bf16x8 kf = *(const LAS bf16x8*)(Ks + (kl_base + r) * AT_KP + (16 * s + 8 * h) * 2); x = __builtin_amdgcn_mfma_f32_32x32x16_bf16(kf, qf[s], x, 0, 0, 0); }
    float sc[16]; float mt = -1e30f;
#pragma unroll
    for (int i = 0; i < 16; ++i) { float v = x[i] * 0.125f;
        if (MASKED) { const int kj = kj0 + (i & 3) + 8 * (i >> 2) + 4 * h; const bool ok = (kj >= 0) && (kj < SEQ) && (kj - qi <= 128) && (qi - kj <= 128); v = ok ? v : -1e30f; }
        sc[i] = v; mt = fmaxf(mt, v); }
    mt = fmaxf(mt, __shfl_xor(mt, 32));
    const float mn = fmaxf(m, mt), alpha = __expf(m - mn); m = mn;
    float ps = 0.f;
#pragma unroll
    for (int i = 0; i < 16; ++i) { sc[i] = __expf(sc[i] - mn); ps += sc[i]; }
    l = l * alpha + ps;
#pragma unroll
    for (int i = 0; i < 16; ++i) { o0[i] *= alpha; o1[i] *= alpha; }
#pragma unroll
    for (int s2 = 0; s2 < 2; ++s2) {
        v4u pw; pw.x = pk_bf16(sc[8 * s2 + 0], sc[8 * s2 + 1]); pw.y = pk_bf16(sc[8 * s2 + 2], sc[8 * s2 + 3]); pw.z = pk_bf16(sc[8 * s2 + 4], sc[8 * s2 + 5]); pw.w = pk_bf16(sc[8 * s2 + 6], sc[8 * s2 + 7]);
        const bf16x8 pk = __builtin_bit_cast(bf16x8, pw);
        { const LAS unsigned char* vp = Vs + r * vpitch + (kl_base + 16 * s2 + 4 * h) * 2; const v2u lo = *(const LAS v2u*)vp, hi = *(const LAS v2u*)(vp + 16);
          v4u vw; vw.x = lo.x; vw.y = lo.y; vw.z = hi.x; vw.w = hi.y; o0 = __builtin_amdgcn_mfma_f32_32x32x16_bf16(__builtin_bit_cast(bf16x8, vw), pk, o0, 0, 0, 0); }
        { const LAS unsigned char* vp = Vs + (32 + r) * vpitch + (kl_base + 16 * s2 + 4 * h) * 2; const v2u lo = *(const LAS v2u*)vp, hi = *(const LAS v2u*)(vp + 16);
          v4u vw; vw.x = lo.x; vw.y = lo.y; vw.z = hi.x; vw.w = hi.y; o1 = __builtin_amdgcn_mfma_f32_32x32x16_bf16(__builtin_bit_cast(bf16x8, vw), pk, o1, 0, 0, 0); }
    }
}
PHASE_FN ph_e3_attn(PP pp, int layer) {
    FRAME();
    const bf16* QKV = (const bf16*)(ws + WS_BIG + BIG_QKV); bf16* MIX = (bf16*)(ws + WS_BIG + BIG_MIX); const bf16* VT = (const bf16*)(ws + WS_H);
    const float* sinkp = PIN(I_EV_SINK) + (layer >> 1) * 8;
    LAS unsigned char* Ks = F.lds; LAS unsigned char* Vs = F.lds + AT_VOFF;
    const int r = F.lane & 31, h = F.lane >> 5, g = F.wave >> 1, th = F.wave & 1;
    for (int u = F.bid; u < 2048 + 128; u += F.G) {
        const bool isc = u >= 2048;
        int b, hkv, qb; if (!isc) { b = u >> 7; hkv = (u >> 6) & 1; qb = u & 63; } else { const int v = u - 2048; b = v >> 3; hkv = (v >> 2) & 1; qb = v & 3; }
        const int n0 = qb * 64, bh = b * 2 + hkv;
        const size_t qrow = isc ? ((size_t)TL + (size_t)b * 256 + n0 + 32 * th + r) : ((size_t)b * 4096 + n0 + 32 * th + r);
        bf16x8 qf[4];
#pragma unroll
        for (int s = 0; s < 4; ++s) qf[s] = *(const bf16x8*)(QKV + qrow * 768 + (hkv * 4 + g) * 64 + 16 * s + 8 * h);
        float m = sinkp[hkv * 4 + g], l = (h == 0) ? 1.0f : 0.0f;
        f32x16 o0, o1;
#pragma unroll
        for (int i = 0; i < 16; ++i) { o0[i] = 0.f; o1[i] = 0.f; }
        __syncthreads();
        if (!isc) {
            for (int pc = F.tid; pc < 2560; pc += NTHREADS) { const int kl = pc >> 3, c8 = pc & 7, kj = n0 - 128 + kl;
                v4u v = (v4u){0u, 0u, 0u, 0u}; if (kj >= 0 && kj < SEQ) v = *(const v4u*)(QKV + ((size_t)b * 4096 + kj) * 768 + 512 + hkv * 64 + c8 * 8);
                *(LAS v4u*)(Ks + kl * AT_KP + c8 * 16) = v; }
            for (int pc = F.tid; pc < 2560; pc += NTHREADS) { const int d = pc / 40, c = pc - d * 40, kj = n0 - 128 + c * 8;
                v4u v = (v4u){0u, 0u, 0u, 0u}; if (kj >= 0 && kj < SEQ) v = *(const v4u*)(VT + ((size_t)bh * 64 + d) * 4352 + 256 + kj);
                LAS v2u* dst = (LAS v2u*)(Vs + d * AT_VP1 + c * 16); dst[0] = (v2u){v.x, v.y}; dst[1] = (v2u){v.z, v.w}; }
            __syncthreads();
            const int qi = n0 + 32 * th + r;
#pragma unroll 1
            for (int t = 0; t < 9; ++t) { const int klb = 32 * th + 32 * t; attn_tile<true>(Ks, Vs, AT_VP1, klb, qf, o0, o1, m, l, r, h, n0 - 128 + klb, qi); }
            __syncthreads();
        }
        for (int pc = F.tid; pc < 2048; pc += NTHREADS) { const int j = pc >> 3, c8 = pc & 7;
            *(LAS v4u*)(Ks + j * AT_KP + c8 * 16) = *(const v4u*)(QKV + ((size_t)TL + (size_t)b * 256 + j) * 768 + 512 + hkv * 64 + c8 * 8); }
        for (int pc = F.tid; pc < 2048; pc += NTHREADS) { const int d = pc >> 5, c = pc & 31; const v4u v = *(const v4u*)(VT + ((size_t)bh * 64 + d) * 4352 + c * 8);
            LAS v2u* dst = (LAS v2u*)(Vs + d * AT_VP2 + c * 16); dst[0] = (v2u){v.x, v.y}; dst[1] = (v2u){v.z, v.w}; }
        __syncthreads();
#pragma unroll 1
        for (int t = 0; t < 8; ++t) attn_tile<false>(Ks, Vs, AT_VP2, 32 * t, qf, o0, o1, m, l, r, h, 0, 0);
        const float inv = 1.0f / (l + __shfl_xor(l, 32));
        bf16* orow = MIX + qrow * D + 512 + (hkv * 4 + g) * 64 + 4 * h;
#pragma unroll
        for (int q4 = 0; q4 < 4; ++q4) {
            v2u w0; w0.x = pk_bf16(o0[4 * q4 + 0] * inv, o0[4 * q4 + 1] * inv); w0.y = pk_bf16(o0[4 * q4 + 2] * inv, o0[4 * q4 + 3] * inv); *(v2u*)(orow + 8 * q4) = w0;
            v2u w1; w1.x = pk_bf16(o1[4 * q4 + 0] * inv, o1[4 * q4 + 1] * inv); w1.y = pk_bf16(o1[4 * q4 + 2] * inv, o1[4 * q4 + 3] * inv); *(v2u*)(orow + 32 + 8 * q4) = w1;
        }
    }
    __syncthreads();
}
PHASE_FN ph_outproj(PP pp, int layer) {
    FRAME();
    const int li = layer >> 1; const bool odd = (layer & 1) != 0;
    const int TR = (layer == DEPTH - 1) ? TL : T;
    const char* W = odd ? (const char*)(ws + WS_OD + li * OD_STRIDE + OD_WOUT) : (const char*)(ws + WS_EV + li * EV_STRIDE + EV_WOUT);
    float* XC = (float*)(ws + WS_XC); float* out = (float*)pp->out;
    const float* xl_src = (layer == 0) ? PIN(I_X) : out; const float* xc_src = (layer == 0) ? PIN(I_CTX) : XC;
    const float* modl = (const float*)(ws + WS_MOD) + (size_t)layer * 17 * 6144;
    SchedResid S{F.G, F.bid, (TR / 256) * 4, (const char*)(ws + WS_BIG + BIG_MIX), (size_t)256 * D * 2, W, (size_t)256 * D * 2, xl_src, xc_src, out, XC, modl + 2048};
    pg8::gemm_phase<pg8::EpiResid, SchedResid, true, true>(F.lds, F.tid, pg8::Dims{D, D, D}, S, pg8::EpiResid{});
}
PHASE_FN ph_ln_mid(PP pp, int layer) {
    FRAME();
    float* XC = (float*)(ws + WS_XC); float* out = (float*)pp->out; bf16* Hb = (bf16*)(ws + WS_H);
    const float* modl = (const float*)(ws + WS_MOD) + (size_t)layer * 17 * 6144;
    const float* lng0 = PIN(I_LNG) + (size_t)(layer * 2) * D; const float* lnb0 = PIN(I_LNB) + (size_t)(layer * 2) * D;
    for (int r = F.gw; r < T; r += F.NGW) {
        const bool isc = r >= TL; float* xr = isc ? XC + (size_t)(r - TL) * D : out + (size_t)r * D;
        const float* m = modl + (size_t)(isc ? 16 : (r >> 12)) * 6144;
        f32x4 v[4], h[4]; row_load(xr, F.lane, v); row_layernorm(v, lng0, lnb0, F.lane); row_store(xr, F.lane, v);
        row_modulate(h, v, m + 4096, m + 3072, F.lane); row_store_bf16(Hb + (size_t)r * D, F.lane, h);
    }
}
PHASE_FN ph_e6(PP pp, int layer) {
    FRAME();
    unsigned char* evw = ws + WS_EV + (layer >> 1) * EV_STRIDE;
    SchedStd S{22, (T / 256) * 22, F.G, F.bid, (const char*)(ws + WS_H), (const char*)(evw + EV_W13), (char*)(ws + WS_BIG + BIG_HID), (size_t)256 * D * 2, (size_t)256 * D * 2, (size_t)256 * FFH * 2, (size_t)128 * 2, FFH, 1 << 30};
    pg8::gemm_phase<pg8::EpiSwiGLU, SchedStd, true, true>(F.lds, F.tid, pg8::Dims{D, D, D}, S, pg8::EpiSwiGLU{});
}
PHASE_FN ph_e7(PP pp, int layer) {
    FRAME();
    unsigned char* evw = ws + WS_EV + (layer >> 1) * EV_STRIDE;
    float* XC = (float*)(ws + WS_XC); float* out = (float*)pp->out;
    const float* modl = (const float*)(ws + WS_MOD) + (size_t)layer * 17 * 6144;
    SchedResid S{F.G, F.bid, (T / 256) * 4, (const char*)(ws + WS_BIG + BIG_HID), (size_t)256 * FFH * 2, (const char*)(evw + EV_W2), (size_t)256 * FFH * 2, out, XC, out, XC, modl + 5120};
    pg8::gemm_phase<pg8::EpiResid, SchedResid, true, true>(F.lds, F.tid, pg8::Dims{FFH, FFH, FFH}, S, pg8::EpiResid{});
}
PHASE_FN ph_ln_end(PP pp, int layer) {
    FRAME();
    float* XC = (float*)(ws + WS_XC); float* out = (float*)pp->out; bf16* Hb = (bf16*)(ws + WS_H);
    const float* modn = (const float*)(ws + WS_MOD) + (size_t)(layer + 1) * 17 * 6144;
    const float* lng1 = PIN(I_LNG) + (size_t)(layer * 2 + 1) * D; const float* lnb1 = PIN(I_LNB) + (size_t)(layer * 2 + 1) * D;
    for (int r = F.gw; r < T; r += F.NGW) {
        const bool isc = r >= TL; float* xr = isc ? XC + (size_t)(r - TL) * D : out + (size_t)r * D;
        const float* m = modn + (size_t)(isc ? 16 : (r >> 12)) * 6144;
        f32x4 v[4], h[4]; row_load(xr, F.lane, v); row_layernorm(v, lng1, lnb1, F.lane); row_store(xr, F.lane, v);
        row_modulate(h, v, m + 1024, m, F.lane); row_store_bf16(Hb + (size_t)r * D, F.lane, h);
    }
}

PHASE_FN ph_o1(PP pp, int layer) {
    FRAME();
    unsigned char* odw = ws + WS_OD + (layer >> 1) * OD_STRIDE;
    SchedStd S{6, (T / 256) * 6, F.G, F.bid, (const char*)(ws + WS_H), (const char*)(odw + OD_WIN), (char*)(ws + WS_BIG + BIG_P), (size_t)256 * D * 2, (size_t)256 * D * 2, (size_t)256 * 1536 * 2, (size_t)256 * 2, 1536, 2};
    pg8::gemm_phase<pg8::EpiStore, SchedStd, true, true>(F.lds, F.tid, pg8::Dims{D, D, D}, S, pg8::EpiStore{});
}
PHASE_FN ph_o2_s5a(PP pp, int layer) {
    FRAME();
    const int li = layer >> 1;
    SchedS5A S{F.G, F.bid, (const char*)(ws + WS_BIG + BIG_P), (const char*)(ws + WS_S5M + (size_t)li * 32 * S5M_STRIDE), (char*)(ws + WS_H + 68 * MiB), (char*)(ws + WS_H)};
    pg8::gemm_phase<pg8::EpiStore, SchedS5A, true, true, pg8::AMapS5>(F.lds, F.tid, pg8::Dims{256, 0, 256}, S, pg8::EpiStore{}, pg8::AMapS5{});
}
PHASE_FN ph_o2_scan(PP pp, int layer) {
    FRAME();
    const int li = layer >> 1;
    if (F.tid < 256) {
        const int t = F.bid * 256 + F.tid;
        if (t < NBATCH * 32 * 2 * 64) {
            const int pl = t & 63, d = (t >> 6) & 1, g = (t >> 7) & 31, b = t >> 12;
            const int sidx = ((li * 2 + d) * 32 + g);
            const float are = PIN(I_A_RE)[sidx * 64 + pl], aim = PIN(I_A_IM)[sidx * 64 + pl], dt = expf(PIN(I_LOG_DT)[sidx]);
            const float mag = expf(16.0f * are * dt); float sn, cn; sincosf(16.0f * aim * dt, &sn, &cn);
            const float lre = mag * cn, lim = mag * sn;
            unsigned* HB = (unsigned*)(ws + WS_H) + (g * 256 + d * 128 + pl * 2) / 2;
            float cre = 0.f, cim = 0.f;
#define S5_CROW(k_) ((k_) < 16 ? (4096 + b * 16 + (d ? 15 - (k_) : (k_))) : (b * 256 + (d ? 255 - ((k_) - 16) : ((k_) - 16))))
            for (int k0 = 0; k0 < 272; k0 += 8) {
                unsigned w[8];
#pragma unroll
                for (int j = 0; j < 8; ++j) w[j] = HB[(size_t)S5_CROW(k0 + j) * 4096];
#pragma unroll
                for (int j = 0; j < 8; ++j) { HB[(size_t)S5_CROW(k0 + j) * 4096] = cvt_pk_bf16(cre, cim);
                    const float sr = bflo(w[j]), si = bfhi(w[j]); const float nr = lre * cre - lim * cim + sr, ni = lre * cim + lim * cre + si; cre = nr; cim = ni; }
            }
#undef S5_CROW
        }
    }
}
PHASE_FN ph_o3(PP pp, int layer) {
    FRAME();
    const int li = layer >> 1;
    SchedS5B S{F.G, F.bid, (const char*)(ws + WS_H), (const char*)(ws + WS_S5M + (size_t)li * 32 * S5M_STRIDE + 256 * 1024), (const char*)(ws + WS_H + 68 * MiB), (char*)(ws + WS_BIG + BIG_P)};
    pg8::gemm_phase<pg8::EpiS5B, SchedS5B, true, true>(F.lds, F.tid, pg8::Dims{256, 8192, 256}, S, pg8::EpiS5B{});
}
PHASE_FN ph_o2_gmlp(PP pp, int layer) {
    FRAME();
    const int li = layer >> 1; const int TR = (layer == DEPTH - 1) ? TL : T;
    const bf16* P = (const bf16*)(ws + WS_BIG + BIG_P); bf16* MIX = (bf16*)(ws + WS_BIG + BIG_MIX);
    LAS float* Wn = (LAS float*)F.lds;
    LAS float* Vs = (LAS float*)(F.lds + 65536);
    const int nchunk = TR / 128;
    const float* ws_w = PIN(I_WS) + (size_t)li * 4 * 128 * 128; const float* bs = PIN(I_BS) + (size_t)li * 4 * 128;
    __syncthreads();
    for (int ch = F.bid; ch < nchunk; ch += F.G) {
        const size_t row0 = (size_t)ch * 128;
        float mu_r[16], rs_r[16];
#pragma unroll
        for (int t = 0; t < 16; ++t) { const v4u w = *(const v4u*)(P + (row0 + F.wave * 16 + t) * 1536 + 1024 + F.lane * 8);
            const float f[8] = {bflo(w.x), bfhi(w.x), bflo(w.y), bfhi(w.y), bflo(w.z), bfhi(w.z), bflo(w.w), bfhi(w.w)};
            float s = 0.f;
#pragma unroll
            for (int j = 0; j < 8; ++j) s += f[j];
            const float mu = wave_sum(s) * (1.f / 512.f); float q = 0.f;
#pragma unroll
            for (int j = 0; j < 8; ++j) q += (f[j] - mu) * (f[j] - mu);
            mu_r[t] = mu; rs_r[t] = rsqrtf(wave_sum(q) * (1.f / 512.f) + LN_EPS); }
        for (int h = 0; h < 4; ++h) {
            __syncthreads();
            for (int e = F.tid; e < 128 * 128; e += NTHREADS) Wn[e] = ws_w[(size_t)h * 16384 + e];
#pragma unroll
            for (int t = 0; t < 16; ++t) { const int j = F.wave * 16 + t; const unsigned w = *(const unsigned*)(P + (row0 + j) * 1536 + 1024 + h * 128 + F.lane * 2);
                Vs[j * 128 + F.lane * 2] = (bflo(w) - mu_r[t]) * rs_r[t]; Vs[j * 128 + F.lane * 2 + 1] = (bfhi(w) - mu_r[t]) * rs_r[t]; }
            __syncthreads();
            const int ti = F.tid >> 5, te = F.tid & 31;
            f32x4 acc[8];
#pragma unroll
            for (int k = 0; k < 8; ++k) acc[k] = (f32x4){0.f, 0.f, 0.f, 0.f};
            for (int j = 0; j < 128; ++j) {
                const f32x4 vv = *(const LAS f32x4*)(Vs + j * 128 + te * 4);
#pragma unroll
                for (int k = 0; k < 8; ++k) acc[k] += vv * Wn[(ti * 8 + k) * 128 + j];
            }
#pragma unroll
            for (int k = 0; k < 8; ++k) { const int i = ti * 8 + k; const float bb = bs[h * 128 + i];
                const v2u uw = *(const v2u*)(P + (row0 + i) * 1536 + 512 + h * 128 + te * 4);
                v2u o; o.x = cvt_pk_bf16(bflo(uw.x) * (acc[k][0] + bb), bfhi(uw.x) * (acc[k][1] + bb)); o.y = cvt_pk_bf16(bflo(uw.y) * (acc[k][2] + bb), bfhi(uw.y) * (acc[k][3] + bb));
                *(v2u*)(MIX + (row0 + i) * D + 512 + h * 128 + te * 4) = o; }
        }
    }
    __syncthreads();
}
PHASE_FN ph_o4(PP pp, int layer) {
    FRAME();
    const int li = layer >> 1;
    unsigned char* odw = ws + WS_OD + li * OD_STRIDE;
    SchedGlu S{F.G, F.bid, (const char*)(ws + WS_BIG + BIG_P), (const char*)(odw + OD_WGLU), (char*)(ws + WS_BIG + BIG_MIX), PIN(I_BGLU) + (size_t)li * 512};
    pg8::gemm_phase<pg8::EpiGLU, SchedGlu, true, true>(F.lds, F.tid, pg8::Dims{512, 1536, 512}, S, pg8::EpiGLU{});
}
PHASE_FN ph_o6(PP pp, int layer) {
    FRAME();
    const int li = layer >> 1; const int TR = (layer == DEPTH - 1) ? TL : T;
    float* XC = (float*)(ws + WS_XC); float* out = (float*)pp->out; bf16* Hb = (bf16*)(ws + WS_H);
    const float* modl = (const float*)(ws + WS_MOD) + (size_t)layer * 17 * 6144;
    const float* lng0 = PIN(I_LNG) + (size_t)(layer * 2) * D; const float* lnb0 = PIN(I_LNB) + (size_t)(layer * 2) * D;
    int* tokE = (int*)(ws + WS_TOK); int* tokS0 = tokE + T; int* tokS1 = tokS0 + T; float* tokG0 = (float*)(tokS1 + T);
    unsigned* ecnt = F.ctl + CW_CNT + li * 64;
    LAS float* wr_s = (LAS float*)F.lds;
    const float* rw = PIN(I_ROUTER) + (size_t)li * D * 8;
    __syncthreads();
    for (int e = F.tid; e < D * 8; e += NTHREADS) wr_s[e] = rw[e];
    __syncthreads();
    for (int r = F.gw; r < TR; r += F.NGW) {
        const bool isc = r >= TL; float* xr = isc ? XC + (size_t)(r - TL) * D : out + (size_t)r * D;
        const float* m = modl + (size_t)(isc ? 16 : (r >> 12)) * 6144;
        f32x4 v[4], h[4]; row_load(xr, F.lane, v); row_layernorm(v, lng0, lnb0, F.lane); row_store(xr, F.lane, v);
        row_modulate(h, v, m + 4096, m + 3072, F.lane); row_store_bf16(Hb + (size_t)r * D, F.lane, h);
        float lg[8];
#pragma unroll
        for (int e = 0; e < 8; ++e) lg[e] = 0.f;
#pragma unroll
        for (int j = 0; j < 4; ++j)
#pragma unroll
            for (int q = 0; q < 4; ++q) { const int col = 256 * j + 4 * F.lane + q; const f32x4 w0 = *(const LAS f32x4*)(wr_s + col * 8), w1 = *(const LAS f32x4*)(wr_s + col * 8 + 4); const float hv = h[j][q];
                lg[0] += hv * w0[0]; lg[1] += hv * w0[1]; lg[2] += hv * w0[2]; lg[3] += hv * w0[3]; lg[4] += hv * w1[0]; lg[5] += hv * w1[1]; lg[6] += hv * w1[2]; lg[7] += hv * w1[3]; }
#pragma unroll
        for (int e = 0; e < 8; ++e) lg[e] = wave_sum(lg[e]);
        if (F.lane == 0) {
            int e0 = 0; float v0 = lg[0];
#pragma unroll
            for (int e = 1; e < 8; ++e) if (lg[e] > v0) { v0 = lg[e]; e0 = e; }
            int e1 = -1; float v1 = -3.0e38f;
#pragma unroll
            for (int e = 0; e < 8; ++e) if (e != e0 && lg[e] > v1) { v1 = lg[e]; e1 = e; }
            const float w0 = 1.0f / (1.0f + __expf(v1 - v0));
            const int s0 = (int)atomicAdd(ecnt + e0, 1u), s1 = (int)atomicAdd(ecnt + e1, 1u);
            tokE[r] = e0 | (e1 << 8); tokS0[r] = s0; tokS1[r] = s1; tokG0[r] = w0;
        }
    }
    __syncthreads();
}
PHASE_FN ph_o7(PP pp, int layer) {
    FRAME();
    const int li = layer >> 1; const int TR = (layer == DEPTH - 1) ? TL : T;
    const bf16* Hb = (const bf16*)(ws + WS_H); bf16* HS = (bf16*)(ws + WS_BIG + BIG_HS);
    int* tokE = (int*)(ws + WS_TOK); int* tokS0 = tokE + T; int* tokS1 = tokS0 + T; int* tokP0 = tokS1 + 2 * T; int* tokP1 = tokP0 + T;
    unsigned* ecnt = F.ctl + CW_CNT + li * 64;
    int roff[8]; { int acc = 0;
#pragma unroll
        for (int e = 0; e < 8; ++e) { roff[e] = acc * 256; acc += ((int)__hip_atomic_load(ecnt + e, __ATOMIC_RELAXED, __HIP_MEMORY_SCOPE_AGENT) + 255) >> 8; } }
    for (int r = F.gw; r < TR; r += F.NGW) {
        const int ee = tokE[r], e0 = ee & 255, e1 = ee >> 8;
        int p0 = tokS0[r], p1 = tokS1[r];
#pragma unroll
        for (int e = 0; e < 8; ++e) { p0 += (e == e0) ? roff[e] : 0; p1 += (e == e1) ? roff[e] : 0; }
        const v4u* src = (const v4u*)(Hb + (size_t)r * D); v4u* d0 = (v4u*)(HS + (size_t)p0 * D); v4u* d1 = (v4u*)(HS + (size_t)p1 * D);
        const v4u a = src[F.lane], b = src[64 + F.lane];
        d0[F.lane] = a; d0[64 + F.lane] = b; d1[F.lane] = a; d1[64 + F.lane] = b;
        if (F.lane == 0) { tokP0[r] = p0; tokP1[r] = p1; }
    }
}
PHASE_FN ph_moe_up(PP pp, int layer, int chn) {
    FRAME();
    const int li = layer >> 1; unsigned char* odw = ws + WS_OD + li * OD_STRIDE; unsigned* ecnt = F.ctl + CW_CNT + li * 64;
    SchedMoeUp S; S.G = F.G; S.c = F.bid; S.rt0 = chn * MOE_CHUNK_TILES; S.HS = (const char*)(ws + WS_BIG + BIG_HS); S.W = (const char*)(odw + OD_MW13); S.HID = (char*)(ws + WS_H);
    { int acc = 0; S.toff[0] = 0;
#pragma unroll
        for (int e = 0; e < 8; ++e) { acc += ((int)__hip_atomic_load(ecnt + e, __ATOMIC_RELAXED, __HIP_MEMORY_SCOPE_AGENT) + 255) >> 8; S.toff[e + 1] = acc; } }
    int nt_ = S.toff[8] - S.rt0; nt_ = nt_ < 0 ? 0 : (nt_ > MOE_CHUNK_TILES ? MOE_CHUNK_TILES : nt_); S.nUnits = nt_ * 28;
    pg8::gemm_phase<pg8::EpiSwiGLU, SchedMoeUp, true, true>(F.lds, F.tid, pg8::Dims{D, D, D}, S, pg8::EpiSwiGLU{});
}
PHASE_FN ph_moe_down(PP pp, int layer, int chn) {
    FRAME();
    const int li = layer >> 1; unsigned char* odw = ws + WS_OD + li * OD_STRIDE; unsigned* ecnt = F.ctl + CW_CNT + li * 64;
    SchedMoeDown S; S.G = F.G; S.c = F.bid; S.rt0 = chn * MOE_CHUNK_TILES; S.HID = (const char*)(ws + WS_H); S.W = (const char*)(odw + OD_MW2); S.Y = (char*)(ws + WS_BIG + BIG_HS);
    { int acc = 0; S.toff[0] = 0;
#pragma unroll
        for (int e = 0; e < 8; ++e) { acc += ((int)__hip_atomic_load(ecnt + e, __ATOMIC_RELAXED, __HIP_MEMORY_SCOPE_AGENT) + 255) >> 8; S.toff[e + 1] = acc; } }
    int nt_ = S.toff[8] - S.rt0; nt_ = nt_ < 0 ? 0 : (nt_ > MOE_CHUNK_TILES ? MOE_CHUNK_TILES : nt_); S.nUnits = nt_ * 4;
    pg8::gemm_phase<pg8::EpiStore, SchedMoeDown, true, true>(F.lds, F.tid, pg8::Dims{EH, EH, EH}, S, pg8::EpiStore{});
}
PHASE_FN ph_o9(PP pp, int layer) {
    FRAME();
    const int TR = (layer == DEPTH - 1) ? TL : T; const bool last = layer == DEPTH - 1;
    float* XC = (float*)(ws + WS_XC); float* out = (float*)pp->out; bf16* Hb = (bf16*)(ws + WS_H); const bf16* HS = (const bf16*)(ws + WS_BIG + BIG_HS);
    const float* modl = (const float*)(ws + WS_MOD) + (size_t)layer * 17 * 6144;
    const float* modn = (const float*)(ws + WS_MOD) + (size_t)(last ? layer : layer + 1) * 17 * 6144;
    const float* lng1 = PIN(I_LNG) + (size_t)(layer * 2 + 1) * D; const float* lnb1 = PIN(I_LNB) + (size_t)(layer * 2 + 1) * D;
    const int* tokE = (const int*)(ws + WS_TOK); const float* tokG0 = (const float*)(tokE + 3 * T); const int* tokP0 = tokE + 4 * T; const int* tokP1 = tokP0 + T;
    for (int r = F.gw; r < TR; r += F.NGW) {
        const bool isc = r >= TL; float* xr = isc ? XC + (size_t)(r - TL) * D : out + (size_t)r * D;
        const int mrow = isc ? 16 : (r >> 12);
        const float* g2 = modl + (size_t)mrow * 6144 + 5120;
        const int p0 = tokP0[r], p1 = tokP1[r]; const float w0 = tokG0[r], w1 = 1.0f - w0;
        const bf16* y0 = HS + (size_t)p0 * D; const bf16* y1 = HS + (size_t)p1 * D;
        f32x4 v[4], h[4]; row_load(xr, F.lane, v);
#pragma unroll
        for (int j = 0; j < 4; ++j) { const v2u a = *(const v2u*)(y0 + 256 * j + 4 * F.lane), b = *(const v2u*)(y1 + 256 * j + 4 * F.lane); const f32x4 gg = *(const f32x4*)(g2 + 256 * j + 4 * F.lane);
            f32x4 f; f[0] = w0 * bflo(a.x) + w1 * bflo(b.x); f[1] = w0 * bfhi(a.x) + w1 * bfhi(b.x); f[2] = w0 * bflo(a.y) + w1 * bflo(b.y); f[3] = w0 * bfhi(a.y) + w1 * bfhi(b.y);
            v[j] = v[j] * ALPHA + gg * f; }
        row_layernorm(v, lng1, lnb1, F.lane); row_store(xr, F.lane, v);
        if (!last) { const float* m = modn + (size_t)mrow * 6144; row_modulate(h, v, m + 1024, m, F.lane); row_store_bf16(Hb + (size_t)r * D, F.lane, h); }
    }
}

#if MK_SPLIT
#define PHASE_END() do { ++ph; } while (0)
#else
#define PHASE_END() do { if (ph >= lo && ph + 1 < hi) grid_bar(pp); ++ph; } while (0)
#endif
#define PHASE_ON() (ph >= lo && ph < hi)
static __device__ __forceinline__ void even_layer(PP pp, const int layer, const int lo, const int hi, int& ph) {
    if (PHASE_ON()) ph_e1(pp, layer);
    PHASE_END();
    if (PHASE_ON()) { ph_e2_dft(pp); ph_e2_dftc(pp); ph_e2_rope(pp); }
    PHASE_END();
    if (PHASE_ON()) ph_e3_attn(pp, layer);
    PHASE_END();
    if (PHASE_ON()) ph_outproj(pp, layer);
    PHASE_END();
    if (PHASE_ON()) ph_ln_mid(pp, layer);
    PHASE_END();
    if (PHASE_ON()) ph_e6(pp, layer);
    PHASE_END();
    if (PHASE_ON()) ph_e7(pp, layer);
    PHASE_END();
    if (PHASE_ON()) ph_ln_end(pp, layer);
    PHASE_END();
}
static __device__ __forceinline__ void odd_layer(PP pp, const int layer, const int lo, const int hi, int& ph) {
    if (PHASE_ON()) ph_o1(pp, layer);
    PHASE_END();
    if (PHASE_ON()) { ph_o2_s5a(pp, layer); ph_o2_gmlp(pp, layer); }
    PHASE_END();
    if (PHASE_ON()) ph_o2_scan(pp, layer);
    PHASE_END();
    if (PHASE_ON()) ph_o3(pp, layer);
    PHASE_END();
    if (PHASE_ON()) ph_o4(pp, layer);
    PHASE_END();
    if (PHASE_ON()) ph_outproj(pp, layer);
    PHASE_END();
    if (PHASE_ON()) ph_o6(pp, layer);
    PHASE_END();
    if (PHASE_ON()) ph_o7(pp, layer);
    PHASE_END();
    for (int chn = 0; chn < MOE_NCHUNK; ++chn) {
        if (PHASE_ON()) ph_moe_up(pp, layer, chn);
        PHASE_END();
        if (PHASE_ON()) ph_moe_down(pp, layer, chn);
        PHASE_END();
    }
    if (PHASE_ON()) ph_o9(pp, layer);
    PHASE_END();
}
constexpr int N_PHASES = 2 + 2 * (8 + 9 + 2 * MOE_NCHUNK);
__global__ void __launch_bounds__(NTHREADS, 2) fwd_kernel(Params p_unused) {
    DECL_LDS;
    PP pp = (PP)__builtin_amdgcn_kernarg_segment_ptr();
    {
        LAS unsigned char* lds = (LAS unsigned char*)lds_raw;
        for (int u = threadIdx.x; u < (LDS_BYTES - LDS_RING) / 4; u += NTHREADS) ((LAS unsigned*)(lds + LDS_RING))[u] = 0u;
        __syncthreads();
#if !MK_SPLIT
        (void)xcd_barrier_post((unsigned*)((unsigned char*)pp->ws + WS_CTL) + CW_BAR, (volatile LAS unsigned*)(lds + LDS_MISC) + 8);
#endif
    }
    const int lo = pp->ph_lo, hi = pp->ph_hi; int ph = 0;

    if (PHASE_ON()) { ph_fold(pp); ph_mod(pp); ph_s5mat(pp); ph_cvt(pp); ph_dftmat(pp); }
    PHASE_END();
    if (PHASE_ON()) ph_pro_b(pp);
    PHASE_END();
    even_layer(pp, 0, lo, hi, ph);
    odd_layer(pp, 1, lo, hi, ph);
    even_layer(pp, 2, lo, hi, ph);
    odd_layer(pp, 3, lo, hi, ph);
}

extern "C" void kernel_launch(void* const* d_in, const int* in_sizes, int n_in, void* d_out, int out_size, void* d_ws, size_t ws_size, hipStream_t stream) {
    static int grid = 0;
    if (grid == 0) {
        if (n_in != 32 || out_size != TL * D || ws_size < WS_END) { fprintf(stderr, "kernel_launch: unexpected shapes (n_in %d, out %d, ws %zu < %zu)\n", n_in, out_size, ws_size, (size_t)WS_END); grid = -1; return; }
        int dev = 0, cus = 0, per_cu = 0;
        if (hipGetDevice(&dev) != hipSuccess || hipDeviceGetAttribute(&cus, hipDeviceAttributeMultiprocessorCount, dev) != hipSuccess) { grid = -1; return; }
        if (hipFuncSetAttribute((const void*)fwd_kernel, hipFuncAttributeMaxDynamicSharedMemorySize, LDS_BYTES) != hipSuccess) { fprintf(stderr, "kernel_launch: hipFuncSetAttribute failed\n"); grid = -1; return; }
        if (hipOccupancyMaxActiveBlocksPerMultiprocessor(&per_cu, (const void*)fwd_kernel, NTHREADS, LDS_BYTES) != hipSuccess || per_cu < 1) { fprintf(stderr, "kernel_launch: occupancy query says %d\n", per_cu); }
        (void)hipGetLastError();
        grid = cus;
    }
    if (grid < 0) return;
    (void)in_sizes;
    (void)hipMemsetAsync((char*)d_ws + WS_CTL, 0, CTL_ZERO_BYTES, stream);
    Params p{};
    for (int i = 0; i < 32; ++i) p.in[i] = (const float*)d_in[i];
    p.out = (float*)d_out; p.ws = (unsigned char*)d_ws;
#if MK_SPLIT
    for (int ph = 0; ph < N_PHASES; ++ph) { p.ph_lo = ph; p.ph_hi = ph + 1; hipLaunchKernelGGL(fwd_kernel, dim3(grid), dim3(NTHREADS), LDS_BYTES, stream, p); }
#else
    p.ph_lo = 0; p.ph_hi = N_PHASES;
    hipLaunchKernelGGL(fwd_kernel, dim3(grid), dim3(NTHREADS), LDS_BYTES, stream, p);
#endif
}
```

```cpp
#include <hip/hip_runtime.h>
#include <cstdio>
#include <cstdint>

#ifndef MK_SPLIT
#define MK_SPLIT 0
#endif

#define GAS __attribute__((address_space(1)))
#define LAS __attribute__((address_space(3)))
typedef unsigned short bf16;
typedef unsigned v4u __attribute__((ext_vector_type(4)));
typedef unsigned v2u __attribute__((ext_vector_type(2)));
typedef float f32x4 __attribute__((ext_vector_type(4)));
typedef float f32x2 __attribute__((ext_vector_type(2)));
typedef short bf16x8 __attribute__((ext_vector_type(8)));

constexpr int D = 1024, NBATCH = 16, SEQ = 4096, NCTX = 256, DEPTH = 4;
constexpr int TL = NBATCH * SEQ, TC = NBATCH * NCTX, T = TL + TC;
constexpr int FFH = 2816, EH = 3584, NEXP = 8;
constexpr int MOE_CHUNK_TILES = 64, MOE_NCHUNK = 9;
constexpr float ALPHA = 1.6817928305074290860622509524664f;
constexpr float LN_EPS = 1e-5f;

constexpr size_t MiB = (size_t)1 << 20;
constexpr size_t WS_CTL = 0, CTL_ZERO_BYTES = 1 * MiB;
constexpr size_t WS_MOD = 1 * MiB;
constexpr size_t WS_TOK = 3 * MiB;
constexpr size_t WS_XC = 5 * MiB;
constexpr size_t WS_F256 = 21 * MiB;
constexpr size_t WS_F4096 = 22 * MiB;
constexpr size_t WS_EV = 86 * MiB, EV_STRIDE = 22 * MiB;
constexpr size_t EV_WQKV = 0, EV_WPQ = 3 * MiB / 2, EV_WOUT = 7 * MiB / 2, EV_W13 = 11 * MiB / 2, EV_W2 = 33 * MiB / 2;
constexpr size_t WS_OD = 130 * MiB, OD_STRIDE = 174 * MiB;
constexpr size_t OD_WIN = 0, OD_WGLU = 3 * MiB, OD_WOUT = 7 * MiB / 2, OD_MW13 = 11 * MiB / 2, OD_MW2 = 235 * MiB / 2;
constexpr size_t WS_H = 478 * MiB;
constexpr size_t WS_BIG = 614 * MiB;
constexpr size_t BIG_PQT = 0, BIG_PQTC = 128 * MiB, BIG_QKV = 136 * MiB, BIG_MIX = 238 * MiB, BIG_HID = 0, BIG_P = 0, BIG_HS = 0;
constexpr size_t WS_S5M = 994 * MiB, S5M_STRIDE = 384 * 1024;
constexpr size_t WS_END = 1018 * MiB;
constexpr int CW_BAR = 4096, CW_CNT = 16384;

#define LDS_WAIT() asm volatile("s_waitcnt lgkmcnt(0)" ::: "memory")
#define VM_WAIT() asm volatile("s_waitcnt vmcnt(0)" ::: "memory")
__device__ __forceinline__ unsigned cvt_pk_bf16(float lo, float hi) { unsigned r; asm volatile("v_cvt_pk_bf16_f32 %0, %1, %2" : "=v"(r) : "v"(lo), "v"(hi)); return r; }
__device__ __forceinline__ float bflo(unsigned w) { return __uint_as_float(w << 16); }
__device__ __forceinline__ float bfhi(unsigned w) { return __uint_as_float(w & 0xffff0000u); }
__device__ __forceinline__ float bf2f(bf16 b) { return __uint_as_float(((unsigned)b) << 16); }
__device__ __forceinline__ bf16 f2bf(float f) { return (bf16)(cvt_pk_bf16(f, 0.f) & 0xffffu); }
__device__ __forceinline__ float wave_sum(float v) {
#pragma unroll
    for (int o = 1; o < 64; o <<= 1) v += __shfl_xor(v, o);
    return v;
}
__device__ __forceinline__ float wave_max(float v) {
#pragma unroll
    for (int o = 1; o < 64; o <<= 1) v = fmaxf(v, __shfl_xor(v, o));
    return v;
}
__device__ __forceinline__ float silu_f(float x) { return x / (1.f + __expf(-x)); }
__device__ __forceinline__ float sigmoid_f(float x) { return 1.f / (1.f + __expf(-x)); }
__device__ __forceinline__ float gelu_tanh_f(float x) { const float z = 0.7978845608028654f * (x + 0.044715f * x * x * x); return x / (1.f + __expf(-2.f * z)); }

#define XB_TMO      128
#define XB_XCNT(j)  (256  + 64 * (j))
#define XB_XSUB(j)  (1280 + 64 * (j))
#define XB_XGEN(j)  (2304 + 64 * (j))
#define XB_TOP      3328
#define XB_TOPGEN   3392
#define XCD_BAR_WORDS 3456
#define XB_SPIN_CAP (1u << 25)
__device__ __forceinline__ unsigned xb_ld(unsigned* p)              { return __hip_atomic_load(p, __ATOMIC_RELAXED, __HIP_MEMORY_SCOPE_AGENT); }
__device__ __forceinline__ unsigned xb_add(unsigned* p, unsigned v) { return __hip_atomic_fetch_add(p, v, __ATOMIC_RELAXED, __HIP_MEMORY_SCOPE_AGENT); }
__device__ __forceinline__ unsigned xb_xcc_id() { return (unsigned)__builtin_amdgcn_s_getreg((3 << 11) | 20) & 0xFu; }
#define XB_SPIN(cond, bar) do { unsigned _sp = 0; while (cond) { __builtin_amdgcn_s_sleep(1); \
    if ((++_sp & 255u) == 0u) { if (xb_ld(&(bar)[XB_TMO])) break; if (_sp > XB_SPIN_CAP) { atomicAdd(&(bar)[XB_TMO], 1u); break; } } } } while (0)
struct XcdBarrier { unsigned* bar; unsigned x; volatile LAS unsigned* st; };
__device__ __forceinline__ XcdBarrier xcd_barrier_post(unsigned* bar, volatile LAS unsigned* st) {
    XcdBarrier b; b.bar = bar; b.x = xb_xcc_id(); b.st = st;
    if (threadIdx.x == 0) (void)xb_add(&bar[XB_XCNT(b.x)], 1u);
    return b;
}
__device__ __forceinline__ void xcd_barrier_complete(unsigned* bar, unsigned x, unsigned& nloc, unsigned& nx) {
    const unsigned G = gridDim.x * gridDim.y * gridDim.z;
    unsigned sum, cnt, mine, sp = 0u;
    for (;;) {
        sum = 0u; cnt = 0u; mine = 0u;
#pragma unroll
        for (unsigned j = 0; j < 16; ++j) { const unsigned c = xb_ld(&bar[XB_XCNT(j)]); sum += c; cnt += (c > 0u) ? 1u : 0u; mine = (j == x) ? c : mine; }
        if (sum == G) break;
        __builtin_amdgcn_s_sleep(1);
        if ((++sp & 255u) == 0u) { if (xb_ld(&bar[XB_TMO])) break; if (sp > XB_SPIN_CAP) { atomicAdd(&bar[XB_TMO], 1u); break; } }
    }
    nloc = mine > 0u ? mine : 1u; nx = cnt > 0u ? cnt : 1u;
}
__device__ __forceinline__ void xcd_barrier(const XcdBarrier& b) {
    asm volatile("s_waitcnt vmcnt(0)" ::: "memory");
    __syncthreads();
    if (threadIdx.x == 0) {
        unsigned* bar = b.bar;
        __builtin_amdgcn_s_waitcnt(0);
        unsigned nloc = b.st[0], nx = b.st[1];
        if (nloc == 0u) { xcd_barrier_complete(bar, b.x, nloc, nx); b.st[0] = nloc; b.st[1] = nx; }
        const unsigned old = xb_add(&bar[XB_XSUB(b.x)], 1u);
        const unsigned gen = old / nloc;
        if (old + 1u == (gen + 1u) * nloc) {
            __builtin_amdgcn_fence(__ATOMIC_RELEASE, "agent");
            asm volatile("s_waitcnt vmcnt(0)" ::: "memory");
            const unsigned og = xb_add(&bar[XB_TOP], 1u);
            const unsigned tg = og / nx;
            if (og + 1u == (tg + 1u) * nx) xb_add(&bar[XB_TOPGEN], 1u);
            else XB_SPIN(xb_ld(&bar[XB_TOPGEN]) == tg, bar);
            __builtin_amdgcn_fence(__ATOMIC_ACQUIRE, "agent");
            xb_add(&bar[XB_XGEN(b.x)], 1u);
            asm volatile("s_waitcnt vmcnt(0)" ::: "memory");
        } else {
            XB_SPIN(xb_ld(&bar[XB_XGEN(b.x)]) == gen, bar);
            __builtin_amdgcn_fence(__ATOMIC_ACQUIRE, "agent");
            asm volatile("s_waitcnt vmcnt(0)" ::: "memory");
        }
    }
    __syncthreads();
}

namespace pg8 {
constexpr int BM = 256, BK = 64, HALF = 128, HTB = HALF * BK * 2, STAGE_BYTES = 8 * HTB;
__host__ __device__ __forceinline__ int lds_byte(int r, int c) { const int st = (r >> 4) * 2 + (c >> 5), rr = r & 15, cc = c & 31, ob = rr * 64 + cc * 2; return st * 1024 + (ob ^ (((ob >> 9) & 1) << 5)); }
__host__ __device__ __forceinline__ void stage_rc(int b, int& R, int& C) { const int st = b / 1024, sb = b % 1024, swz = sb ^ (((sb >> 9) & 1) << 5); R = (st >> 1) * 16 + swz / 64; C = (st & 1) * 32 + (swz % 64) / 2; }
__host__ __device__ __forceinline__ int perm32(int rho) { const int n = rho >> 4, i = rho & 15; return 8 * (i >> 2) + 4 * n + (i & 3); }

struct Unit { const char* a; const char* b; char* o; const char* p0; const char* p1; int ldo; int x0; };
struct Dims { int K, lda, ldb; };
struct AMapStd { int lda = 0; __device__ __forceinline__ unsigned voff(int R, int C) const { return (unsigned)(R * lda + C) * 2u; } __device__ __forceinline__ size_t kstep() const { return 128; } __device__ __forceinline__ size_t hs() const { return (size_t)HALF * lda * 2; } };
struct AMapS5 { __device__ __forceinline__ unsigned voff(int R, int C) const { return (unsigned)(R * 49152 + (C >> 4) * 3072 + (C & 15) * 2); } __device__ __forceinline__ size_t kstep() const { return 12288; } __device__ __forceinline__ size_t hs() const { return (size_t)HALF * 49152; } };

template <class Epi, class Sched, bool ALIGN_EPI = false, bool SP2 = false, class AMap = AMapStd>
__device__ __forceinline__ void gemm_phase(LAS unsigned char* lds, const int tid, const Dims g, const Sched& S, const Epi& E, const AMap am_in = AMap{}) {
    AMap am = am_in; if constexpr (__is_same(AMap, AMapStd)) am.lda = g.lda;
    const int wid = __builtin_amdgcn_readfirstlane(tid >> 6), lane = tid & 63, wr = wid >> 2, wc = wid & 3, fr = lane & 15, fq = lane >> 4;
    const int K = g.K, nt = K / BK;
    unsigned voffA[2], voffB[2];
#pragma unroll
    for (int i = 0; i < 2; ++i) { int R, C; stage_rc(tid * 16 + i * 8192, R, C); const int Rb = Epi::PERM ? ((R & ~31) + perm32(R & 31)) : R;
        voffA[i] = am.voff(R, C); voffB[i] = (unsigned)(Rb * g.ldb + C) * 2u; }
    const size_t kstep = (size_t)(BK * 2), kstepA = am.kstep();
    const size_t hsA = am.hs(), hsB = (size_t)HALF * g.ldb * 2;
    const unsigned ldsw = (unsigned)wid * 1024u;
    const int aoff = lds_byte(wr * 64 + fr, fq * 8), boff = lds_byte(wc * 32 + fr, fq * 8);
#define PG8_SA(b, h) (((b) * 2 + (h)) * HTB)
#define PG8_SB(b, h) ((4 + (b) * 2 + (h)) * HTB)
#define PG8_STAGE(bufoff, gbase, voff) do { _Pragma("unroll") for (int _i = 0; _i < 2; ++_i) \
        __builtin_amdgcn_global_load_lds((const unsigned*)((const char*)(gbase) + (voff)[_i]), (LAS unsigned*)(lds + (bufoff) + ldsw + _i * 8192), 16, 0, 0); } while (0)
#define PG8_LDA(dst, b, h) do { _Pragma("unroll") for (int m = 0; m < 4; ++m) _Pragma("unroll") for (int k = 0; k < 2; ++k) dst[m][k] = *(const LAS bf16x8*)(lds + PG8_SA(b, h) + aoff + m * 2048 + k * 1024); } while (0)
#define PG8_LDB(dst, b, h) do { _Pragma("unroll") for (int n = 0; n < 2; ++n) _Pragma("unroll") for (int k = 0; k < 2; ++k) dst[n][k] = *(const LAS bf16x8*)(lds + PG8_SB(b, h) + boff + n * 2048 + k * 1024); } while (0)
#define PG8_MMA(ai, bj, At, Bt) do { __builtin_amdgcn_s_setprio(1); _Pragma("unroll") for (int m = 0; m < 4; ++m) _Pragma("unroll") for (int n = 0; n < 2; ++n) _Pragma("unroll") for (int k = 0; k < 2; ++k) \
        acc[ai][bj][m][n] = __builtin_amdgcn_mfma_f32_16x16x32_bf16(Bt[n][k], At[m][k], acc[ai][bj][m][n], 0, 0, 0); __builtin_amdgcn_s_setprio(0); } while (0)
#define PG8_WAIT_V(n) asm volatile("s_waitcnt vmcnt(" #n ")" ::: "memory")
#define PG8_WAIT_L(n) asm volatile("s_waitcnt lgkmcnt(" #n ")" ::: "memory")
#define PG8_BAR __builtin_amdgcn_s_barrier()
#define PG8_SCHED __builtin_amdgcn_sched_barrier(0)
    int ui = 0;
    const char* cA; const char* cB;
    { Unit u0; if (!S.next(0, u0)) return; cA = u0.a; cB = u0.b; }
    f32x4 acc[2][2][4][2];
#pragma unroll
    for (int a = 0; a < 2; ++a)
#pragma unroll
        for (int b = 0; b < 2; ++b)
#pragma unroll
            for (int m = 0; m < 4; ++m)
#pragma unroll
                for (int n = 0; n < 2; ++n) acc[a][b][m][n] = (f32x4){0.f, 0.f, 0.f, 0.f};
    bf16x8 At[4][2], B0[2][2], B1[2][2];
    if constexpr (SP2) {
        PG8_STAGE(PG8_SB(0, 0), cB, voffB); PG8_STAGE(PG8_SB(0, 1), cB + hsB, voffB); PG8_STAGE(PG8_SA(0, 0), cA, voffA); PG8_STAGE(PG8_SA(0, 1), cA + hsA, voffA);
        if (wr == 1) PG8_BAR;
        PG8_WAIT_V(2); PG8_BAR;
        PG8_STAGE(PG8_SB(1, 0), cB + kstep, voffB); PG8_STAGE(PG8_SA(1, 0), cA + kstepA, voffA); PG8_STAGE(PG8_SB(1, 1), cB + hsB + kstep, voffB);
        PG8_WAIT_V(6); PG8_BAR;
    } else {
        PG8_STAGE(PG8_SB(0, 0), cB, voffB); PG8_STAGE(PG8_SA(0, 0), cA, voffA); PG8_STAGE(PG8_SB(0, 1), cB + hsB, voffB); PG8_STAGE(PG8_SA(0, 1), cA + hsA, voffA);
        if (wr == 1) PG8_BAR;
        PG8_WAIT_V(4); PG8_BAR;
        PG8_STAGE(PG8_SB(1, 0), cB + kstep, voffB); PG8_STAGE(PG8_SA(1, 0), cA + kstepA, voffA); PG8_STAGE(PG8_SB(1, 1), cB + hsB + kstep, voffB);
        PG8_WAIT_V(6); PG8_BAR;
    }
    for (;;) {
        const char* nA = cA; const char* nB = cB; bool has_next;
        { Unit un; has_next = S.next(ui + 1, un); if (has_next) { nA = un.a; nB = un.b; } }
        for (int t = 0; t < nt; t += 2) {
            const bool last = (t == nt - 2);
            const char* a1 = cA + (size_t)(t + 1) * kstepA;
            const char* a2 = last ? nA : cA + (size_t)(t + 2) * kstepA; const char* b2 = last ? nB : cB + (size_t)(t + 2) * kstep;
            const char* a3 = a2 + kstepA; const char* b3 = b2 + kstep;
            if constexpr (SP2) {
            PG8_LDB(B0, 0, 0); PG8_LDB(B1, 0, 1); PG8_SCHED; PG8_LDA(At, 0, 0); PG8_STAGE(PG8_SA(1, 1), a1 + hsA, voffA);
            PG8_WAIT_V(8); PG8_WAIT_L(0); PG8_BAR; PG8_MMA(0, 0, At, B0); PG8_MMA(0, 1, At, B1); PG8_BAR; PG8_SCHED;
            PG8_LDA(At, 0, 1); PG8_STAGE(PG8_SB(0, 0), b2, voffB); PG8_STAGE(PG8_SB(0, 1), b2 + hsB, voffB); PG8_STAGE(PG8_SA(0, 0), a2, voffA);
            PG8_WAIT_V(8); PG8_WAIT_L(0); PG8_BAR; PG8_MMA(1, 0, At, B0); PG8_MMA(1, 1, At, B1); PG8_BAR; PG8_SCHED;
            PG8_LDB(B0, 1, 0); PG8_LDB(B1, 1, 1); PG8_SCHED; PG8_LDA(At, 1, 0); PG8_STAGE(PG8_SA(0, 1), a2 + hsA, voffA);
            PG8_WAIT_V(8); PG8_WAIT_L(0); PG8_BAR; PG8_MMA(0, 0, At, B0); PG8_MMA(0, 1, At, B1); PG8_BAR; PG8_SCHED;
            PG8_LDA(At, 1, 1); PG8_STAGE(PG8_SB(1, 0), b3, voffB); PG8_STAGE(PG8_SB(1, 1), b3 + hsB, voffB); PG8_STAGE(PG8_SA(1, 0), a3, voffA);
            PG8_WAIT_V(8); PG8_WAIT_L(0); PG8_BAR; PG8_MMA(1, 0, At, B0); PG8_MMA(1, 1, At, B1); PG8_BAR; PG8_SCHED;
            } else {
            PG8_LDB(B0, 0, 0); PG8_SCHED; PG8_LDA(At, 0, 0); PG8_STAGE(PG8_SA(1, 1), a1 + hsA, voffA);
            PG8_WAIT_L(8); PG8_BAR; PG8_WAIT_L(0); PG8_MMA(0, 0, At, B0); PG8_BAR; PG8_SCHED;
            PG8_LDB(B1, 0, 1); PG8_STAGE(PG8_SB(0, 0), b2, voffB);
            PG8_BAR; PG8_WAIT_L(0); PG8_MMA(0, 1, At, B1); PG8_BAR;
            PG8_LDA(At, 0, 1); PG8_STAGE(PG8_SA(0, 0), a2, voffA);
            PG8_BAR; PG8_WAIT_L(0); PG8_MMA(1, 0, At, B0); PG8_BAR; PG8_SCHED;
            PG8_STAGE(PG8_SB(0, 1), b2 + hsB, voffB);
            PG8_WAIT_V(6); PG8_BAR; PG8_MMA(1, 1, At, B1); PG8_BAR;
            PG8_LDB(B0, 1, 0); PG8_SCHED; PG8_LDA(At, 1, 0); PG8_STAGE(PG8_SA(0, 1), a2 + hsA, voffA);
            PG8_WAIT_L(8); PG8_BAR; PG8_WAIT_L(0); PG8_MMA(0, 0, At, B0); PG8_BAR; PG8_SCHED;
            PG8_LDB(B1, 1, 1); PG8_STAGE(PG8_SB(1, 0), b3, voffB);
            PG8_BAR; PG8_WAIT_L(0); PG8_MMA(0, 1, At, B1); PG8_BAR;
            PG8_LDA(At, 1, 1); PG8_STAGE(PG8_SA(1, 0), a3, voffA);
            PG8_BAR; PG8_WAIT_L(0); PG8_MMA(1, 0, At, B0); PG8_BAR; PG8_SCHED;
            PG8_STAGE(PG8_SB(1, 1), b3 + hsB, voffB);
            PG8_WAIT_V(6); PG8_BAR; PG8_MMA(1, 1, At, B1); PG8_BAR;
            }
        }
        if constexpr (ALIGN_EPI) { if (wr == 0) PG8_BAR; }
        { Unit uc; (void)S.next(ui, uc); E(acc, uc, wr, wc, fr, fq); }
        if (!has_next) break;
#pragma unroll
        for (int a = 0; a < 2; ++a)
#pragma unroll
            for (int b = 0; b < 2; ++b)
#pragma unroll
                for (int m = 0; m < 4; ++m)
#pragma unroll
                    for (int n = 0; n < 2; ++n) acc[a][b][m][n] = (f32x4){0.f, 0.f, 0.f, 0.f};
        cA = nA; cB = nB; ++ui;
        if constexpr (ALIGN_EPI) { if (wr == 1) PG8_BAR; }
    }
    PG8_WAIT_V(0);
    if constexpr (!ALIGN_EPI) { if (wr == 0) PG8_BAR; }
    PG8_BAR;
#undef PG8_SA
#undef PG8_SB
#undef PG8_STAGE
#undef PG8_LDA
#undef PG8_LDB
#undef PG8_MMA
#undef PG8_WAIT_V
#undef PG8_WAIT_L
#undef PG8_BAR
#undef PG8_SCHED
}

struct EpiStore {
    static constexpr bool PERM = true;
    __device__ __forceinline__ void operator()(const f32x4 (&acc)[2][2][4][2], const Unit& u, int wr, int wc, int fr, int fq) const {
        bf16* base = (bf16*)u.o; int row0 = wr * 64 + fr, col0 = wc * 32 + 8 * fq; asm volatile("" : "+v"(row0), "+v"(col0)); const bool act = u.x0 != 0;
#pragma unroll
        for (int ai = 0; ai < 2; ++ai)
#pragma unroll
            for (int m = 0; m < 4; ++m) { bf16* rowp = base + (size_t)(row0 + ai * HALF + m * 16) * u.ldo + col0;
#pragma unroll
                for (int bj = 0; bj < 2; ++bj) { f32x4 v0 = acc[ai][bj][m][0], v1 = acc[ai][bj][m][1];
                    if (act) {
#pragma unroll
                        for (int j = 0; j < 4; ++j) { v0[j] = gelu_tanh_f(v0[j]); v1[j] = gelu_tanh_f(v1[j]); } }
                    v4u w; w.x = cvt_pk_bf16(v0[0], v0[1]); w.y = cvt_pk_bf16(v0[2], v0[3]); w.z = cvt_pk_bf16(v1[0], v1[1]); w.w = cvt_pk_bf16(v1[2], v1[3]);
                    *(v4u*)(rowp + bj * HALF) = w; } }
    }
};
struct EpiSwiGLU {
    static constexpr bool PERM = true;
    __device__ __forceinline__ void operator()(const f32x4 (&acc)[2][2][4][2], const Unit& u, int wr, int wc, int fr, int fq) const {
        bf16* base = (bf16*)u.o; int row0 = wr * 64 + fr, col0 = wc * 32 + 8 * fq; asm volatile("" : "+v"(row0), "+v"(col0));
#pragma unroll
        for (int ai = 0; ai < 2; ++ai)
#pragma unroll
            for (int m = 0; m < 4; ++m) { bf16* rowp = base + (size_t)(row0 + ai * HALF + m * 16) * u.ldo + col0;
                f32x4 h0, h1;
#pragma unroll
                for (int j = 0; j < 4; ++j) { h0[j] = silu_f(acc[ai][0][m][0][j]) * acc[ai][1][m][0][j]; h1[j] = silu_f(acc[ai][0][m][1][j]) * acc[ai][1][m][1][j]; }
                v4u w; w.x = cvt_pk_bf16(h0[0], h0[1]); w.y = cvt_pk_bf16(h0[2], h0[3]); w.z = cvt_pk_bf16(h1[0], h1[1]); w.w = cvt_pk_bf16(h1[2], h1[3]);
                *(v4u*)rowp = w; }
    }
};
struct EpiResid {
    static constexpr bool PERM = false;
    __device__ __forceinline__ void operator()(const f32x4 (&acc)[2][2][4][2], const Unit& u, int wr, int wc, int fr, int fq) const {
        const float* xs = (const float*)u.p0; float* zo = (float*)u.o; const float* gv = (const float*)u.p1;
        int row0 = wr * 64 + fr, col0 = wc * 32 + 4 * fq; asm volatile("" : "+v"(row0), "+v"(col0));
#pragma unroll
        for (int ai = 0; ai < 2; ++ai)
#pragma unroll
            for (int m = 0; m < 4; ++m) { const size_t off = (size_t)(row0 + ai * HALF + m * 16) * D + col0;
#pragma unroll
                for (int bj = 0; bj < 2; ++bj)
#pragma unroll
                    for (int n = 0; n < 2; ++n) { const f32x4 xv = *(const f32x4*)(xs + off + bj * HALF + n * 16); const f32x4 gvv = *(const f32x4*)(gv + col0 + bj * HALF + n * 16);
                        *(f32x4*)(zo + off + bj * HALF + n * 16) = xv * ALPHA + gvv * acc[ai][bj][m][n]; }
                asm volatile("" ::: "memory"); }
    }
};
struct EpiGLU {
    static constexpr bool PERM = true;
    __device__ __forceinline__ void operator()(const f32x4 (&acc)[2][2][4][2], const Unit& u, int wr, int wc, int fr, int fq) const {
        bf16* base = (bf16*)u.o; const bf16* gp = (const bf16*)u.p0; const float* bias = (const float*)u.p1;
        int row0 = wr * 64 + fr, col0 = wc * 32 + 8 * fq; asm volatile("" : "+v"(row0), "+v"(col0));
#pragma unroll
        for (int ai = 0; ai < 2; ++ai)
#pragma unroll
            for (int m = 0; m < 4; ++m) { const int r = row0 + ai * HALF + m * 16;
#pragma unroll
                for (int bj = 0; bj < 2; ++bj) { const v4u gw = *(const v4u*)(gp + (size_t)r * u.x0 + col0 + bj * HALF);
                    const f32x4 b0 = *(const f32x4*)(bias + col0 + bj * HALF), b1 = *(const f32x4*)(bias + col0 + bj * HALF + 4);
                    const f32x4 a0 = acc[ai][bj][m][0] + b0, a1 = acc[ai][bj][m][1] + b1;
                    const float o0 = bflo(gw.x) * sigmoid_f(a0[0]), o1 = bfhi(gw.x) * sigmoid_f(a0[1]), o2 = bflo(gw.y) * sigmoid_f(a0[2]), o3 = bfhi(gw.y) * sigmoid_f(a0[3]);
                    const float o4 = bflo(gw.z) * sigmoid_f(a1[0]), o5 = bfhi(gw.z) * sigmoid_f(a1[1]), o6 = bflo(gw.w) * sigmoid_f(a1[2]), o7 = bfhi(gw.w) * sigmoid_f(a1[3]);
                    v4u w; w.x = cvt_pk_bf16(o0, o1); w.y = cvt_pk_bf16(o2, o3); w.z = cvt_pk_bf16(o4, o5); w.w = cvt_pk_bf16(o6, o7);
                    *(v4u*)(base + (size_t)r * u.ldo + col0 + bj * HALF) = w; }
                asm volatile("" ::: "memory"); }
    }
};
struct EpiS5B {
    static constexpr bool PERM = true;
    __device__ __forceinline__ void operator()(const f32x4 (&acc)[2][2][4][2], const Unit& u, int wr, int wc, int fr, int fq) const {
        bf16* base = (bf16*)u.o; const bf16* y1 = (const bf16*)u.p0;
        int row0 = wr * 64 + fr, col0 = wc * 32 + 8 * fq; asm volatile("" : "+v"(row0), "+v"(col0));
#pragma unroll
        for (int ai = 0; ai < 2; ++ai)
#pragma unroll
            for (int m = 0; m < 4; ++m) { const int r = row0 + ai * HALF + m * 16;
#pragma unroll
                for (int bj = 0; bj < 2; ++bj) { const int c = col0 + bj * HALF; const v4u yw = *(const v4u*)(y1 + (size_t)r * 8192 + c);
                    const f32x4 a0 = acc[ai][bj][m][0], a1 = acc[ai][bj][m][1];
                    const float o0 = gelu_tanh_f(a0[0] + bflo(yw.x)), o1 = gelu_tanh_f(a0[1] + bfhi(yw.x)), o2 = gelu_tanh_f(a0[2] + bflo(yw.y)), o3 = gelu_tanh_f(a0[3] + bfhi(yw.y));
                    const float o4 = gelu_tanh_f(a1[0] + bflo(yw.z)), o5 = gelu_tanh_f(a1[1] + bfhi(yw.z)), o6 = gelu_tanh_f(a1[2] + bflo(yw.w)), o7 = gelu_tanh_f(a1[3] + bfhi(yw.w));
                    v4u w; w.x = cvt_pk_bf16(o0, o1); w.y = cvt_pk_bf16(o2, o3); w.z = cvt_pk_bf16(o4, o5); w.w = cvt_pk_bf16(o6, o7);
                    *(v4u*)(base + ((size_t)r * 16 + (c >> 4)) * 1536 + (c & 15)) = w; }
                asm volatile("" ::: "memory"); }
    }
};
}

struct Params { const float* in[32]; float* out; unsigned char* ws; int ph_lo, ph_hi; };
enum { I_X = 0, I_C, I_CTX, I_CCTX, I_WMOD, I_BMOD, I_LNG, I_LNB, I_EV_WIN, I_EV_WOUT, I_EV_SINK, I_EV_W1, I_EV_W3, I_EV_W2, I_OD_WIN, I_A_RE, I_A_IM, I_LOG_DT,
       I_B_RE, I_B_IM, I_C_RE, I_C_IM, I_SSM_D, I_WGLU, I_BGLU, I_WS, I_BS, I_OD_WOUT, I_ROUTER, I_MW1, I_MW3, I_MW2 };

constexpr int LDS_RING = 131072, LDS_MISC = LDS_RING + 320, LDS_BYTES = 147456;
constexpr int NWAVES = 8, NTHREADS = 512;

struct Frame {
    LAS unsigned char* lds;
    int tid, lane, wave, G, bid, gw, NGW;
    unsigned char* ws;
    unsigned* ctl;
};

using pg8::Unit;
struct SchedStd {
    int nN, nUnits, G, c; const char* A; const char* B; char* O; size_t aStep, bStep, oRow, oCol; int ldo, act_from;
    __device__ __forceinline__ bool next(int i, Unit& u) const {
        const int L = i * G + c; if (L >= nUnits) return false;
        const int pm = L / nN, pn = L - pm * nN;
        u.a = A + (size_t)pm * aStep; u.b = B + (size_t)pn * bStep; u.o = O + (size_t)pm * oRow + (size_t)pn * oCol; u.p0 = nullptr; u.p1 = nullptr; u.ldo = ldo; u.x0 = (pn >= act_from) ? 1 : 0; return true;
    }
};
struct SchedEvIn {
    int G, c; const char* H; const char* Wqkv; const char* Wpq; char* QKV; char* PQT; char* PQTC;
    __device__ __forceinline__ bool next(int i, Unit& u) const {
        int L = i * G + c; u.p0 = nullptr; u.p1 = nullptr; u.x0 = 0;
        constexpr int NQ = (T / 256) * 3, NP = 4 * (TL / 256), NPC = 4 * (TC / 256);
        if (L < NQ) { const int pm = L / 3, pn = L - pm * 3;
            u.a = H + (size_t)pm * 256 * D * 2; u.b = Wqkv + (size_t)pn * 256 * D * 2; u.o = QKV + ((size_t)pm * 256 * 768 + pn * 256) * 2; u.ldo = 768; return true; }
        L -= NQ;
        if (L < NP) { const int tt = L >> 2, pm = L & 3, b = tt >> 4, n0 = (tt & 15) * 256, isq = pm >> 1, ch0 = (pm & 1) * 256;
            u.a = Wpq + (size_t)pm * 256 * D * 2; u.b = H + (size_t)tt * 256 * D * 2;
            u.o = PQT + ((((size_t)b * 512 + ch0) * 2 + isq) * 4096 + n0) * 2; u.ldo = 8192; return true; }
        L -= NP;
        if (L < NPC) { const int b = L >> 2, pm = L & 3, isq = pm >> 1, ch0 = (pm & 1) * 256;
            u.a = Wpq + (size_t)pm * 256 * D * 2; u.b = H + ((size_t)TL + (size_t)b * 256) * D * 2;
            u.o = PQTC + (((size_t)b * 512 + ch0) * 2 + isq) * 256 * 2; u.ldo = 512; return true; }
        return false;
    }
};
struct SchedDft {
    int G, c; const char* F; const char* PQT; char* MIX;
    __device__ __forceinline__ bool next(int i, Unit& u) const {
        const int L = i * G + c; if (L >= 512) return false;
        const int b = L >> 5, r = L & 31, pm = r >> 1, pn = r & 1;
        u.a = F + (size_t)pm * 256 * 8192 * 2; u.b = PQT + ((size_t)b * 512 + pn * 256) * 8192 * 2;
        u.o = MIX + (((size_t)b * 4096 + pm * 256) * D + pn * 256) * 2; u.p0 = nullptr; u.p1 = nullptr; u.ldo = D; u.x0 = 0; return true;
    }
};
struct SchedDftC {
    int G, c; const char* F; const char* PQTC; char* MIX;
    __device__ __forceinline__ bool next(int i, Unit& u) const {
        const int L = i * G + (G - 1 - c); if (L >= 32) return false;
        const int b = L >> 1, pn = L & 1;
        u.a = F; u.b = PQTC + ((size_t)b * 512 + pn * 256) * 512 * 2;
        u.o = MIX + (((size_t)TL + (size_t)b * 256) * D + pn * 256) * 2; u.p0 = nullptr; u.p1 = nullptr; u.ldo = D; u.x0 = 0; return true;
    }
};
struct SchedResid {
    int G, c, nUnits; const char* A; size_t aStep; const char* W; size_t bStep; const float* xl; const float* xc; float* zl; float* zc; const float* gate;
    __device__ __forceinline__ bool next(int i, Unit& u) const {
        const int L = i * G + c; if (L >= nUnits) return false;
        const int pm = L >> 2, pn = L & 3;
        u.a = A + (size_t)pm * aStep; u.b = W + (size_t)pn * bStep;
        const bool isc = pm >= TL / 256; const int pr = isc ? pm - TL / 256 : pm; const int mrow = isc ? 16 : (pm >> 4);
        const size_t off = ((size_t)pr * 256 * D + pn * 256);
        u.p0 = (const char*)((isc ? xc : xl) + off); u.o = (char*)((isc ? zc : zl) + off); u.p1 = (const char*)(gate + (size_t)mrow * 6144 + pn * 256); u.ldo = D; u.x0 = 0; return true;
    }
};
struct SchedGlu {
    int G, c; const char* P; const char* W; char* MIX; const float* bias;
    __device__ __forceinline__ bool next(int i, Unit& u) const {
        const int L = i * G + c; if (L >= (T / 256) * 2) return false;
        const int pm = L >> 1, pn = L & 1;
        u.a = P + (size_t)pm * 256 * 1536 * 2; u.b = W + (size_t)pn * 256 * 512 * 2; u.o = MIX + ((size_t)pm * 256 * D + pn * 256) * 2;
        u.p0 = P + ((size_t)pm * 256 * 1536 + pn * 256) * 2; u.p1 = (const char*)(bias + pn * 256); u.ldo = D; u.x0 = 1536; return true;
    }
};
struct SchedS5A {
    int G, c; const char* P; const char* WA; char* Y1; char* HB;
    __device__ __forceinline__ bool next(int i, Unit& u) const {
        const int L = i * G + c; if (L >= 32 * 34) return false;
        const int g = L / 34, rem = L - g * 34, pm = rem >> 1, pn = rem & 1;
        u.a = P + ((size_t)pm * 256 * 16 * 1536 + g * 16) * 2; u.b = WA + (size_t)g * S5M_STRIDE + (size_t)pn * 256 * 256 * 2;
        u.o = (pn ? HB : Y1) + (((size_t)pm * 256 * 32 + g) * 256) * 2; u.p0 = nullptr; u.p1 = nullptr; u.ldo = 8192; u.x0 = 0; return true;
    }
};
struct SchedS5B {
    int G, c; const char* HB; const char* CL; const char* Y1; char* P;
    __device__ __forceinline__ bool next(int i, Unit& u) const {
        const int L = i * G + c; if (L >= 32 * 17) return false;
        const int g = L / 17, pm = L - g * 17;
        const size_t toff = (((size_t)pm * 256 * 32 + g) * 256) * 2;
        u.a = HB + toff; u.b = CL + (size_t)g * S5M_STRIDE; u.p0 = Y1 + toff; u.o = P + ((size_t)pm * 256 * 16 * 1536 + g * 16) * 2; u.p1 = nullptr; u.ldo = 0; u.x0 = 0; return true;
    }
};
struct SchedMoeUp {
    int G, c, nUnits, rt0; int toff[9]; const char* HS; const char* W; char* HID;
    __device__ __forceinline__ bool next(int i, Unit& u) const {
        const int L = i * G + c; if (L >= nUnits) return false;
        const int rl = L / 28, pn = L - rl * 28, rt = rt0 + rl; int e = 0;
#pragma unroll
        for (int k = 1; k < 8; ++k) e += (rt >= toff[k]) ? 1 : 0;
        u.a = HS + (size_t)rt * 256 * D * 2; u.b = W + ((size_t)e * 7168 + pn * 256) * D * 2; u.o = HID + ((size_t)rl * 256 * EH + pn * 128) * 2;
        u.p0 = nullptr; u.p1 = nullptr; u.ldo = EH; u.x0 = 0; return true;
    }
};
struct SchedMoeDown {
    int G, c, nUnits, rt0; int toff[9]; const char* HID; const char* W; char* Y;
    __device__ __forceinline__ bool next(int i, Unit& u) const {
        const int L = i * G + c; if (L >= nUnits) return false;
        const int rl = L >> 2, pn = L & 3, rt = rt0 + rl; int e = 0;
#pragma unroll
        for (int k = 1; k < 8; ++k) e += (rt >= toff[k]) ? 1 : 0;
        u.a = HID + (size_t)rl * 256 * EH * 2; u.b = W + ((size_t)e * 1024 + pn * 256) * EH * 2; u.o = Y + ((size_t)rt * 256 * D + pn * 256) * 2;
        u.p0 = nullptr; u.p1 = nullptr; u.ldo = D; u.x0 = 0; return true;
    }
};

__device__ __forceinline__ void tr_item(const float* W, int ldn, bf16* WT, int ldk, int k0, int n0, int drow0, LAS float* scr, int lane) {
#pragma unroll 8
    for (int i = 0; i < 32; ++i) { const int kk = 2 * i + (lane >> 5); scr[kk * 33 + (lane & 31)] = W[(size_t)(k0 + kk) * ldn + n0 + (lane & 31)]; }
    LDS_WAIT(); asm volatile("" ::: "memory");
    const int c = lane & 7;
#pragma unroll
    for (int j = 0; j < 4; ++j) { const int n = (lane >> 3) + 8 * j; const LAS float* s = scr + (8 * c) * 33 + n;
        v4u o; o.x = cvt_pk_bf16(s[0 * 33], s[1 * 33]); o.y = cvt_pk_bf16(s[2 * 33], s[3 * 33]); o.z = cvt_pk_bf16(s[4 * 33], s[5 * 33]); o.w = cvt_pk_bf16(s[6 * 33], s[7 * 33]);
        *(v4u*)(WT + (size_t)(drow0 + n) * ldk + k0 + 8 * c) = o; }
    LDS_WAIT(); asm volatile("" ::: "memory");
}
__device__ __forceinline__ void tr_job(const float* W, int ldn, int N, bf16* WT, int ldk, int mode, int roff, int item, LAS float* scr, int lane) {
    const int nblk = N / 32, kb = item / nblk, nb = item - kb * nblk, n0 = nb * 32;
    const int drow0 = mode ? ((n0 >> 7) * 256 + (n0 & 127) + roff) : (roff + n0);
    tr_item(W, ldn, WT, ldk, kb * 64, n0, drow0, scr, lane);
}
__device__ __forceinline__ void cvt_item(const Params& p, int r, LAS float* scr, int lane) {
    unsigned char* ws = p.ws;
    constexpr int EV_ITEMS = 384 + 512 + 3 * 1408;
    constexpr int ODS_ITEMS = 768 + 128 + 512;
    constexpr int EXP_ITEMS = 3 * 1792, MOE_ITEMS = 8 * EXP_ITEMS;
    if (r < 2 * EV_ITEMS) { const int li = r / EV_ITEMS; r -= li * EV_ITEMS; unsigned char* base = ws + WS_EV + li * EV_STRIDE;
        if (r < 384) { tr_job(p.in[I_EV_WIN] + (size_t)li * D * 1280 + 512, 1280, 768, (bf16*)(base + EV_WQKV), D, 0, 0, r, scr, lane); return; } r -= 384;
        if (r < 512) { tr_job(p.in[I_EV_WOUT] + (size_t)li * D * D, D, D, (bf16*)(base + EV_WOUT), D, 0, 0, r, scr, lane); return; } r -= 512;
        if (r < 1408) { tr_job(p.in[I_EV_W1] + (size_t)li * D * FFH, FFH, FFH, (bf16*)(base + EV_W13), D, 1, 0, r, scr, lane); return; } r -= 1408;
        if (r < 1408) { tr_job(p.in[I_EV_W3] + (size_t)li * D * FFH, FFH, FFH, (bf16*)(base + EV_W13), D, 1, 128, r, scr, lane); return; } r -= 1408;
        tr_job(p.in[I_EV_W2] + (size_t)li * FFH * D, D, D, (bf16*)(base + EV_W2), FFH, 0, 0, r, scr, lane); return; }
    r -= 2 * EV_ITEMS;
    if (r < 2 * ODS_ITEMS) { const int li = r / ODS_ITEMS; r -= li * ODS_ITEMS; unsigned char* base = ws + WS_OD + li * OD_STRIDE;
        if (r < 768) { tr_job(p.in[I_OD_WIN] + (size_t)li * D * 1536, 1536, 1536, (bf16*)(base + OD_WIN), D, 0, 0, r, scr, lane); return; } r -= 768;
        if (r < 128) { tr_job(p.in[I_WGLU] + (size_t)li * 512 * 512, 512, 512, (bf16*)(base + OD_WGLU), 512, 0, 0, r, scr, lane); return; } r -= 128;
        tr_job(p.in[I_OD_WOUT] + (size_t)li * D * D, D, D, (bf16*)(base + OD_WOUT), D, 0, 0, r, scr, lane); return; }
    r -= 2 * ODS_ITEMS;
    { const int li = r / MOE_ITEMS; r -= li * MOE_ITEMS; const int e = r / EXP_ITEMS; r -= e * EXP_ITEMS; unsigned char* base = ws + WS_OD + li * OD_STRIDE;
        const size_t we = (size_t)li * NEXP + e;
        if (r < 1792) { tr_job(p.in[I_MW1] + we * D * EH, EH, EH, (bf16*)(base + OD_MW13) + (size_t)e * 7168 * D, D, 1, 0, r, scr, lane); return; } r -= 1792;
        if (r < 1792) { tr_job(p.in[I_MW3] + we * D * EH, EH, EH, (bf16*)(base + OD_MW13) + (size_t)e * 7168 * D, D, 1, 128, r, scr, lane); return; } r -= 1792;
        tr_job(p.in[I_MW2] + we * EH * D, D, D, (bf16*)(base + OD_MW2) + (size_t)e * D * EH, EH, 0, 0, r, scr, lane); }
}
constexpr int CVT_ITEMS = 2 * 5120 + 2 * 1408 + 2 * 8 * 3 * 1792;

__device__ __forceinline__ void fold_unit(const Params& p, Frame& F, int unit) {
    const int li = unit >> 6, g = (unit >> 4) & 3, k0 = (unit & 15) * 64;
    LAS float* tile = (LAS float*)F.lds;
    LAS float* trig = tile + 64 * 129;
    const float* W = p.in[I_EV_WIN] + (size_t)li * D * 1280;
    for (int e = F.tid; e < 64 * 128; e += NTHREADS) { const int k = e >> 7, c = e & 127; tile[k * 129 + c] = W[(size_t)(k0 + k) * 1280 + g * 128 + c]; }
    if (F.tid < 128) { float s, c; sincospif((float)F.tid / 64.0f, &s, &c); trig[F.tid] = c * 0.08838834764831845f; trig[128 + F.tid] = s * 0.08838834764831845f; }
    __syncthreads();
    bf16* WT = (bf16*)(p.ws + WS_EV + li * EV_STRIDE + EV_WPQ);
    const int k = F.lane, mg = F.wave;
    for (int mm = 0; mm < 16; ++mm) { const int m = mg * 16 + mm; float sp = 0.f, sq = 0.f;
        for (int c = 0; c < 128; ++c) { const float w = tile[k * 129 + c]; const int ph = (m * c) & 127; sp += w * trig[ph]; sq += w * trig[128 + ph]; }
        WT[(size_t)(g * 128 + m) * D + k0 + k] = f2bf(sp); WT[(size_t)(512 + g * 128 + m) * D + k0 + k] = f2bf(sq); }
    __syncthreads();
}

__device__ __forceinline__ void row_load(const float* row, int lane, f32x4 (&v)[4]) {
#pragma unroll
    for (int j = 0; j < 4; ++j) v[j] = *(const f32x4*)(row + 256 * j + 4 * lane);
}
__device__ __forceinline__ void row_store(float* row, int lane, const f32x4 (&v)[4]) {
#pragma unroll
    for (int j = 0; j < 4; ++j) *(f32x4*)(row + 256 * j + 4 * lane) = v[j];
}
__device__ __forceinline__ void row_store_bf16(bf16* row, int lane, const f32x4 (&v)[4]) {
#pragma unroll
    for (int j = 0; j < 4; ++j) { v2u w; w.x = cvt_pk_bf16(v[j][0], v[j][1]); w.y = cvt_pk_bf16(v[j][2], v[j][3]); *(v2u*)(row + 256 * j + 4 * lane) = w; }
}
__device__ __forceinline__ void row_layernorm(f32x4 (&v)[4], const float* g, const float* b, int lane) {
    float s = 0.f;
#pragma unroll
    for (int j = 0; j < 4; ++j) s += (v[j][0] + v[j][1]) + (v[j][2] + v[j][3]);
    const float mean = wave_sum(s) * (1.f / D); float q = 0.f;
#pragma unroll
    for (int j = 0; j < 4; ++j) { v[j] = v[j] - mean; q += (v[j][0] * v[j][0] + v[j][1] * v[j][1]) + (v[j][2] * v[j][2] + v[j][3] * v[j][3]); }
    const float rstd = rsqrtf(wave_sum(q) * (1.f / D) + LN_EPS);
#pragma unroll
    for (int j = 0; j < 4; ++j) { const f32x4 gg = *(const f32x4*)(g + 256 * j + 4 * lane), bb = *(const f32x4*)(b + 256 * j + 4 * lane); v[j] = v[j] * rstd * gg + bb; }
}
__device__ __forceinline__ void row_modulate(f32x4 (&h)[4], const f32x4 (&v)[4], const float* sc, const float* sh, int lane) {
#pragma unroll
    for (int j = 0; j < 4; ++j) { const f32x4 s = *(const f32x4*)(sc + 256 * j + 4 * lane), t = *(const f32x4*)(sh + 256 * j + 4 * lane); h[j] = v[j] * (s + 1.0f) + t; }
}

__device__ __forceinline__ void row_ln_pre(f32x4 (&v)[4], const f32x4 (&gg)[4], const f32x4 (&bb)[4]) {
    float s = 0.f;
#pragma unroll
    for (int j = 0; j < 4; ++j) s += (v[j][0] + v[j][1]) + (v[j][2] + v[j][3]);
    const float mean = wave_sum(s) * (1.f / D); float q = 0.f;
#pragma unroll
    for (int j = 0; j < 4; ++j) { v[j] = v[j] - mean; q += (v[j][0] * v[j][0] + v[j][1] * v[j][1]) + (v[j][2] * v[j][2] + v[j][3] * v[j][3]); }
    const float rstd = rsqrtf(wave_sum(q) * (1.f / D) + LN_EPS);
#pragma unroll
    for (int j = 0; j < 4; ++j) v[j] = v[j] * rstd * gg[j] + bb[j];
}
__device__ __forceinline__ void row_load_mod(const float* sc, const float* sh, int lane, f32x4 (&s)[4], f32x4 (&t)[4]) {
#pragma unroll
    for (int j = 0; j < 4; ++j) { s[j] = *(const f32x4*)(sc + 256 * j + 4 * lane); t[j] = *(const f32x4*)(sh + 256 * j + 4 * lane); }
}
typedef const __attribute__((address_space(4))) Params* PP;
#define PIN(i) ((const float*)pp->in[i])
#define DECL_LDS extern __shared__ __attribute__((aligned(16))) unsigned char lds_raw[]
#define PHASE_FN static __device__ __forceinline__ void

__device__ __forceinline__ Frame make_frame(PP pp, unsigned char* lds_generic) {
    Frame F;
    F.lds = (LAS unsigned char*)lds_generic;
    { int t_ = threadIdx.x; asm volatile("" : "+v"(t_)); F.tid = t_; }
    F.lane = F.tid & 63; F.wave = __builtin_amdgcn_readfirstlane(F.tid >> 6);
    F.G = gridDim.x; F.bid = blockIdx.x; F.gw = F.bid * NWAVES + F.wave; F.NGW = F.G * NWAVES;
    F.ws = (unsigned char*)pp->ws; F.ctl = (unsigned*)(F.ws + WS_CTL);
    return F;
}
#define FRAME() DECL_LDS; asm volatile("" : "+s"(pp)); Frame F = make_frame(pp, lds_raw); unsigned char* ws = F.ws; (void)ws

PHASE_FN grid_bar(PP pp) {
    FRAME();
    XcdBarrier bar; bar.bar = F.ctl + CW_BAR; bar.x = xb_xcc_id(); bar.st = (volatile LAS unsigned*)(F.lds + LDS_MISC) + 8;
    xcd_barrier(bar);
}

static __device__ __forceinline__ void ln_pass(const Frame& F, float* out, float* XC, bf16* Hb, const float* lng, const float* lnb, const float* modv, const int sc_off, const int sh_off, const int TR) {
    f32x4 gg[4], bb[4];
#pragma unroll
    for (int j = 0; j < 4; ++j) { gg[j] = *(const f32x4*)(lng + 256 * j + 4 * F.lane); bb[j] = *(const f32x4*)(lnb + 256 * j + 4 * F.lane); }
    for (int r0 = F.gw; r0 < TR; r0 += 2 * F.NGW) {
        const int r1 = r0 + F.NGW; const bool two = r1 < TR;
        const bool c0 = r0 >= TL, c1 = r1 >= TL;
        float* x0 = c0 ? XC + (size_t)(r0 - TL) * D : out + (size_t)r0 * D; float* x1 = two ? (c1 ? XC + (size_t)(r1 - TL) * D : out + (size_t)r1 * D) : x0;
        const float* m0 = modv + (size_t)(c0 ? 16 : (r0 >> 12)) * 6144; const float* m1 = modv + (size_t)((two && !c1) ? (r1 >> 12) : 16) * 6144;
        f32x4 v0[4], v1[4], s0[4], t0[4], s1[4], t1[4];
        row_load(x0, F.lane, v0); row_load(x1, F.lane, v1);
        row_load_mod(m0 + sc_off, m0 + sh_off, F.lane, s0, t0); row_load_mod(m1 + sc_off, m1 + sh_off, F.lane, s1, t1);
        row_ln_pre(v0, gg, bb); row_ln_pre(v1, gg, bb);
        row_store(x0, F.lane, v0);
#pragma unroll
        for (int j = 0; j < 4; ++j) s0[j] = v0[j] * (s0[j] + 1.0f) + t0[j];
        row_store_bf16(Hb + (size_t)r0 * D, F.lane, s0);
        if (two) { row_store(x1, F.lane, v1);
#pragma unroll
            for (int j = 0; j < 4; ++j) s1[j] = v1[j] * (s1[j] + 1.0f) + t1[j];
            row_store_bf16(Hb + (size_t)r1 * D, F.lane, s1); }
    }
}
PHASE_FN ph_fold(PP pp) {
    FRAME();
    Params p; p.ws = ws; p.in[I_EV_WIN] = PIN(I_EV_WIN);
    for (int u = F.bid; u < 128; u += F.G) fold_unit(p, F, u);
}
PHASE_FN ph_mod(PP pp) {
    FRAME();
    float* MOD = (float*)(ws + WS_MOD);
    LAS float* sc = (LAS float*)F.lds;
    const float* cin = PIN(I_C); const float* ccin = PIN(I_CCTX);
    for (int e = F.tid; e < 17 * D; e += NTHREADS) { const int r = e >> 10, k = e & 1023; const float v = (r < 16) ? cin[r * D + k] : ccin[k]; sc[e] = silu_f(v); }
    __syncthreads();
    for (int grp = F.gw; grp < DEPTH * 6144 / 64; grp += F.NGW) {
        const int col = grp * 64 + F.lane, l = col / 6144, j = col - l * 6144;
        const float* W = PIN(I_WMOD) + (size_t)l * D * 6144 + j;
        float acc[17];
#pragma unroll
        for (int r = 0; r < 17; ++r) acc[r] = 0.f;
        for (int k = 0; k < D; k += 4) {
            const float w0 = W[(size_t)(k + 0) * 6144], w1 = W[(size_t)(k + 1) * 6144], w2 = W[(size_t)(k + 2) * 6144], w3 = W[(size_t)(k + 3) * 6144];
#pragma unroll
            for (int r = 0; r < 17; ++r) { const f32x4 s = *(const LAS f32x4*)(sc + r * D + k); acc[r] += s[0] * w0 + s[1] * w1 + s[2] * w2 + s[3] * w3; }
        }
        const float bm = PIN(I_BMOD)[l * 6144 + j];
#pragma unroll
        for (int r = 0; r < 17; ++r) MOD[((size_t)l * 17 + r) * 6144 + j] = acc[r] + bm;
    }
    __syncthreads();
}
PHASE_FN ph_cvt(PP pp) {
    FRAME();
    Params p; p.ws = ws;
    p.in[I_EV_WIN] = PIN(I_EV_WIN); p.in[I_EV_WOUT] = PIN(I_EV_WOUT); p.in[I_EV_W1] = PIN(I_EV_W1); p.in[I_EV_W3] = PIN(I_EV_W3); p.in[I_EV_W2] = PIN(I_EV_W2);
    p.in[I_OD_WIN] = PIN(I_OD_WIN); p.in[I_WGLU] = PIN(I_WGLU); p.in[I_OD_WOUT] = PIN(I_OD_WOUT); p.in[I_MW1] = PIN(I_MW1); p.in[I_MW3] = PIN(I_MW3); p.in[I_MW2] = PIN(I_MW2);
    LAS float* scr = (LAS float*)(F.lds + F.wave * 16384);
    for (int it = F.gw; it < CVT_ITEMS; it += F.NGW) cvt_item(p, it, scr, F.lane);
}
PHASE_FN ph_dftmat(PP pp) {
    FRAME();
    bf16* F4 = (bf16*)(ws + WS_F4096);
    for (int it = F.bid * NTHREADS + F.tid; it < 4096 * 1024; it += F.G * NTHREADS) {
        const int k = it >> 10, n0 = (it & 1023) * 8; const bool isq = n0 >= 4096; const int nb = n0 & 4095;
        float v[8];
#pragma unroll
        for (int j = 0; j < 8; ++j) { const int phs = (k * (nb + j)) & 4095; float s, c; sincospif((float)phs * (1.0f / 2048.0f), &s, &c); v[j] = isq ? -s * (1.f / 64.f) : c * (1.f / 64.f); }
        v4u w; w.x = cvt_pk_bf16(v[0], v[1]); w.y = cvt_pk_bf16(v[2], v[3]); w.z = cvt_pk_bf16(v[4], v[5]); w.w = cvt_pk_bf16(v[6], v[7]);
        *(v4u*)(F4 + (size_t)k * 8192 + n0) = w;
    }
    bf16* F2 = (bf16*)(ws + WS_F256);
    for (int it = F.bid * NTHREADS + F.tid; it < 256 * 64; it += F.G * NTHREADS) {
        const int k = it >> 6, n0 = (it & 63) * 8; const bool isq = n0 >= 256; const int nb = n0 & 255;
        float v[8];
#pragma unroll
        for (int j = 0; j < 8; ++j) { const int phs = (k * (nb + j)) & 255; float s, c; sincospif((float)phs * (1.0f / 128.0f), &s, &c); v[j] = isq ? -s * (1.f / 16.f) : c * (1.f / 16.f); }
        v4u w; w.x = cvt_pk_bf16(v[0], v[1]); w.y = cvt_pk_bf16(v[2], v[3]); w.z = cvt_pk_bf16(v[4], v[5]); w.w = cvt_pk_bf16(v[6], v[7]);
        *(v4u*)(F2 + (size_t)k * 512 + n0) = w;
    }
}
PHASE_FN ph_s5mat(PP pp) {
    FRAME();
    LAS float* lam = (LAS float*)F.lds;
    LAS float* bb = lam + 2 * 64 * 17 * 2;
    LAS float* cc = bb + 2 * 64 * 16 * 2;
    LAS float* kt = cc + 2 * 16 * 64 * 2;
    for (int unit = F.bid; unit < 64; unit += F.G) {
        const int li = unit >> 5, g = unit & 31;
        __syncthreads();
        if (F.tid < 128) { const int d = F.tid >> 6, pl = F.tid & 63; const int sidx = ((li * 2 + d) * 32 + g);
            const float are = PIN(I_A_RE)[sidx * 64 + pl], aim = PIN(I_A_IM)[sidx * 64 + pl], dt = expf(PIN(I_LOG_DT)[sidx]);
            for (int e = 0; e <= 16; ++e) { const float mag = expf(are * dt * (float)e); float sn, cn; sincosf(aim * dt * (float)e, &sn, &cn); lam[((d * 64 + pl) * 17 + e) * 2] = mag * cn; lam[((d * 64 + pl) * 17 + e) * 2 + 1] = mag * sn; } }
        __syncthreads();
        for (int e = F.tid; e < 2048; e += NTHREADS) { const int d = e >> 10, pl = (e >> 4) & 63, sp = e & 15; const int sidx = ((li * 2 + d) * 32 + g);
            const float are = PIN(I_A_RE)[sidx * 64 + pl], aim = PIN(I_A_IM)[sidx * 64 + pl];
            const float lre = lam[((d * 64 + pl) * 17 + 1) * 2], lim = lam[((d * 64 + pl) * 17 + 1) * 2 + 1];
            const float den = 1.0f / (are * are + aim * aim);
            const float fre = ((lre - 1.0f) * are + lim * aim) * den, fim = (lim * are - (lre - 1.0f) * aim) * den;
            const float br = PIN(I_B_RE)[((size_t)sidx * 64 + pl) * 16 + sp], bi = PIN(I_B_IM)[((size_t)sidx * 64 + pl) * 16 + sp];
            bb[e * 2] = fre * br - fim * bi; bb[e * 2 + 1] = fre * bi + fim * br; }
        for (int e = F.tid; e < 2048; e += NTHREADS) { const int d = e >> 10, sq = (e >> 6) & 15, pl = e & 63; const int sidx = ((li * 2 + d) * 32 + g);
            cc[e * 2] = PIN(I_C_RE)[((size_t)sidx * 16 + sq) * 64 + pl]; cc[e * 2 + 1] = PIN(I_C_IM)[((size_t)sidx * 16 + sq) * 64 + pl]; }
        __syncthreads();
        for (int e = F.tid; e < 8192; e += NTHREADS) { const int d = e >> 12, tau = (e >> 8) & 15, sq = (e >> 4) & 15, sp = e & 15; float acc = 0.f;
            for (int pl = 0; pl < 64; ++pl) { const float cr = cc[((d * 16 + sq) * 64 + pl) * 2], ci = cc[((d * 16 + sq) * 64 + pl) * 2 + 1];
                const float lr = lam[((d * 64 + pl) * 17 + tau) * 2], lj = lam[((d * 64 + pl) * 17 + tau) * 2 + 1];
                const float br = bb[((d * 64 + pl) * 16 + sp) * 2], bi = bb[((d * 64 + pl) * 16 + sp) * 2 + 1];
                const float tr = cr * lr - ci * lj, ti = cr * lj + ci * lr;
                acc += tr * br - ti * bi; }
            kt[e] = acc; }
        __syncthreads();
        bf16* WA = (bf16*)(ws + WS_S5M + (size_t)unit * S5M_STRIDE); bf16* CLm = WA + 512 * 256;
        const float* dsk = PIN(I_SSM_D) + (size_t)li * 512 + g * 16;
        for (int it = F.tid; it < 8192; it += NTHREADS) { const int row = it >> 5, c0 = (it & 31) * 8;
            float v[8];
            { const int i = row >> 4, sq = row & 15, j = c0 >> 4, sp0 = c0 & 15;
#pragma unroll
              for (int q = 0; q < 8; ++q) { const int sp = sp0 + q; float a = 0.f; if (i >= j) a += kt[((0 * 16 + (i - j)) * 16 + sq) * 16 + sp]; if (j >= i) a += kt[((1 * 16 + (j - i)) * 16 + sq) * 16 + sp]; if (i == j && sq == sp) a += dsk[sq]; v[q] = a; }
              v4u w; w.x = cvt_pk_bf16(v[0], v[1]); w.y = cvt_pk_bf16(v[2], v[3]); w.z = cvt_pk_bf16(v[4], v[5]); w.w = cvt_pk_bf16(v[6], v[7]); *(v4u*)(WA + (size_t)row * 256 + c0) = w; }
            { const int d = row >> 7, pl = (row >> 1) & 63, ri = row & 1, j = c0 >> 4, sp0 = c0 & 15, e = d ? j : 15 - j;
              const float lr = lam[((d * 64 + pl) * 17 + e) * 2], lj = lam[((d * 64 + pl) * 17 + e) * 2 + 1];
#pragma unroll
              for (int q = 0; q < 8; ++q) { const float br = bb[((d * 64 + pl) * 16 + sp0 + q) * 2], bi = bb[((d * 64 + pl) * 16 + sp0 + q) * 2 + 1]; v[q] = ri ? (lr * bi + lj * br) : (lr * br - lj * bi); }
              v4u w; w.x = cvt_pk_bf16(v[0], v[1]); w.y = cvt_pk_bf16(v[2], v[3]); w.z = cvt_pk_bf16(v[4], v[5]); w.w = cvt_pk_bf16(v[6], v[7]); *(v4u*)(WA + (size_t)(256 + row) * 256 + c0) = w; }
            { const int i = row >> 4, sq = row & 15, d = c0 >> 7, pl0 = (c0 >> 1) & 63, e = d ? 16 - i : i + 1;
#pragma unroll
              for (int q = 0; q < 4; ++q) { const int pl = pl0 + q; const float cr = cc[((d * 16 + sq) * 64 + pl) * 2], ci = cc[((d * 16 + sq) * 64 + pl) * 2 + 1];
                  const float lr = lam[((d * 64 + pl) * 17 + e) * 2], lj = lam[((d * 64 + pl) * 17 + e) * 2 + 1];
                  v[2 * q] = cr * lr - ci * lj; v[2 * q + 1] = -(cr * lj + ci * lr); }
              v4u w; w.x = cvt_pk_bf16(v[0], v[1]); w.y = cvt_pk_bf16(v[2], v[3]); w.z = cvt_pk_bf16(v[4], v[5]); w.w = cvt_pk_bf16(v[6], v[7]); *(v4u*)(CLm + (size_t)row * 256 + c0) = w; }
        }
    }
    __syncthreads();
}
PHASE_FN ph_pro_b(PP pp) {
    FRAME();
    const float* MOD = (const float*)(ws + WS_MOD); bf16* Hb = (bf16*)(ws + WS_H);
    const float* xin = PIN(I_X); const float* cin = PIN(I_CTX);
    for (int r = F.gw; r < T; r += F.NGW) {
        const bool isc = r >= TL; const float* xr = isc ? cin + (size_t)(r - TL) * D : xin + (size_t)r * D;
        const float* m = MOD + (size_t)(isc ? 16 : (r >> 12)) * 6144;
        f32x4 v[4], h[4]; row_load(xr, F.lane, v); row_modulate(h, v, m + 1024, m, F.lane); row_store_bf16(Hb + (size_t)r * D, F.lane, h);
    }
}

PHASE_FN ph_e1(PP pp, int layer) {
    FRAME();
    unsigned char* evw = ws + WS_EV + (layer >> 1) * EV_STRIDE; unsigned char* BIG = ws + WS_BIG;
    SchedEvIn S{F.G, F.bid, (const char*)(ws + WS_H), (const char*)(evw + EV_WQKV), (const char*)(evw + EV_WPQ), (char*)(BIG + BIG_QKV), (char*)(BIG + BIG_PQT), (char*)(BIG + BIG_PQTC)};
    pg8::gemm_phase<pg8::EpiStore, SchedEvIn, true, true>(F.lds, F.tid, pg8::Dims{D, D, D}, S, pg8::EpiStore{});
}
PHASE_FN ph_e2_dft(PP pp) {
    FRAME();
    unsigned char* BIG = ws + WS_BIG;
    SchedDft S{F.G, F.bid, (const char*)(ws + WS_F4096), (const char*)(BIG + BIG_PQT), (char*)(BIG + BIG_MIX)};
    pg8::gemm_phase<pg8::EpiStore, SchedDft, true, true>(F.lds, F.tid, pg8::Dims{8192, 8192, 8192}, S, pg8::EpiStore{});
}
PHASE_FN ph_e2_dftc(PP pp) {
    FRAME();
    unsigned char* BIG = ws + WS_BIG;
    SchedDftC S{F.G, F.bid, (const char*)(ws + WS_F256), (const char*)(BIG + BIG_PQTC), (char*)(BIG + BIG_MIX)};
    pg8::gemm_phase<pg8::EpiStore, SchedDftC, true, true>(F.lds, F.tid, pg8::Dims{512, 512, 512}, S, pg8::EpiStore{});
}
PHASE_FN ph_e2_rope(PP pp) {
    FRAME();
    bf16* QKV = (bf16*)(ws + WS_BIG + BIG_QKV);
    LAS f32x2* cs = (LAS f32x2*)F.lds;
    __syncthreads();
    for (int e = F.tid; e < 1024; e += NTHREADS) { const int pos = e >> 4, i = e & 15; const float inv = powf(10000.0f, -(float)i / 16.0f); float s, c; sincosf((float)pos * inv, &s, &c); cs[e] = (f32x2){c, s}; }
    __syncthreads();
    for (int it = F.bid * NTHREADS + F.tid; it < TL * 80; it += F.G * NTHREADS) {
        const int r = it / 80, q = it - r * 80, hh = q >> 3, ax = (q >> 2) & 1, i0 = (q & 3) * 4;
        const int n = r & 4095, pos = ax ? (n & 63) : (n >> 6);
        bf16* base = QKV + (size_t)r * 768 + hh * 64 + ax * 32 + i0;
        const v2u a = *(const v2u*)base, b = *(const v2u*)(base + 16);
        const float x1[4] = {bflo(a.x), bfhi(a.x), bflo(a.y), bfhi(a.y)}, x2[4] = {bflo(b.x), bfhi(b.x), bflo(b.y), bfhi(b.y)};
        float o1[4], o2[4];
#pragma unroll
        for (int j = 0; j < 4; ++j) { const f32x2 t = cs[pos * 16 + i0 + j]; o1[j] = x1[j] * t.x - x2[j] * t.y; o2[j] = x1[j] * t.y + x2[j] * t.x; }
        v2u wa, wb; wa.x = cvt_pk_bf16(o1[0], o1[1]); wa.y = cvt_pk_bf16(o1[2], o1[3]); wb.x = cvt_pk_bf16(o2[0], o2[1]); wb.y = cvt_pk_bf16(o2[2], o2[3]);
        *(v2u*)base = wa; *(v2u*)(base + 16) = wb;
    }
    bf16* VT = (bf16*)(ws + WS_H);
    for (int it = F.bid * NTHREADS + F.tid; it < NBATCH * 2 * 544 * 64; it += F.G * NTHREADS) {
        const int d = it & 63, kg = (it >> 6) % 544, bh = (it >> 6) / 544, b = bh >> 1, hkv = bh & 1;
        const int key0 = kg * 8; const size_t row0 = (key0 < 256) ? ((size_t)TL + (size_t)b * 256 + key0) : ((size_t)b * 4096 + (key0 - 256));
        const bf16* src = QKV + row0 * 768 + 640 + hkv * 64 + d;
        unsigned short v[8];
#pragma unroll
        for (int j = 0; j < 8; ++j) v[j] = src[(size_t)j * 768];
        v4u w; w.x = v[0] | ((unsigned)v[1] << 16); w.y = v[2] | ((unsigned)v[3] << 16); w.z = v[4] | ((unsigned)v[5] << 16); w.w = v[6] | ((unsigned)v[7] << 16);
        *(v4u*)(VT + ((size_t)bh * 64 + d) * 4352 + key0) = w;
    }
    __syncthreads();
}
typedef float f32x16 __attribute__((ext_vector_type(16)));
typedef __bf16 bf16x2v __attribute__((ext_vector_type(2)));
__device__ __forceinline__ unsigned pk_bf16(float a, float b) { const bf16x2v t = __builtin_convertvector((f32x2){a, b}, bf16x2v); return __builtin_bit_cast(unsigned, t); }
constexpr int AT_KP = 144, AT_VP1 = 648, AT_VP2 = 520, AT_VOFF = 320 * AT_KP;
template <bool MASKED>
__device__ __forceinline__ void attn_tile(const LAS unsigned char* Ks, const LAS unsigned char* Vs, const int vpitch, const int kl_base, const bf16x8 (&qf)[4], f32x16& o0, f32x16& o1, float& m, float& l,
                                          const int r, const int h, const int kj0, const int qi) {
    f32x16 x;
#pragma unroll
    for (int i = 0; i < 16; ++i) x[i] = 0.f;
#pragma unroll
    for (int s = 0; s < 4; ++s) { const bf16x8 kf = *(const LAS bf16x8*)(Ks + (kl_base + r) * AT_KP + (16 * s + 8 * h) * 2); x = __builtin_amdgcn_mfma_f32_32x32x16_bf16(kf, qf[s], x, 0, 0, 0); }
    float sc[16]; float mt = -1e30f;
#pragma unroll
    for (int i = 0; i < 16; ++i) { float v = x[i] * 0.125f;
        if (MASKED) { const int kj = kj0 + (i & 3) + 8 * (i >> 2) + 4 * h; const bool ok = (kj >= 0) && (kj < SEQ) && (kj - qi <= 128) && (qi - kj <= 128); v = ok ? v : -1e30f; }
        sc[i] = v; mt = fmaxf(mt, v); }
    mt = fmaxf(mt, __shfl_xor(mt, 32));
    const float mn = fmaxf(m, mt), alpha = __expf(m - mn); m = mn;
    float ps = 0.f;
#pragma unroll
    for (int i = 0; i < 16; ++i) { sc[i] = __expf(sc[i] - mn); ps += sc[i]; }
    l = l * alpha + ps;
#pragma unroll
    for (int i = 0; i < 16; ++i) { o0[i] *= alpha; o1[i] *= alpha; }
#pragma unroll
    for (int s2 = 0; s2 < 2; ++s2) {
        v4u pw; pw.x = pk_bf16(sc[8 * s2 + 0], sc[8 * s2 + 1]); pw.y = pk_bf16(sc[8 * s2 + 2], sc[8 * s2 + 3]); pw.z = pk_bf16(sc[8 * s2 + 4], sc[8 * s2 + 5]); pw.w = pk_bf16(sc[8 * s2 + 6], sc[8 * s2 + 7]);
        const bf16x8 pk = __builtin_bit_cast(bf16x8, pw);
        { const LAS unsigned char* vp = Vs + r * vpitch + (kl_base + 16 * s2 + 4 * h) * 2; const v2u lo = *(const LAS v2u*)vp, hi = *(const LAS v2u*)(vp + 16);
          v4u vw; vw.x = lo.x; vw.y = lo.y; vw.z = hi.x; vw.w = hi.y; o0 = __builtin_amdgcn_mfma_f32_32x32x16_bf16(__builtin_bit_cast(bf16x8, vw), pk, o0, 0, 0, 0); }
        { const LAS unsigned char* vp = Vs + (32 + r) * vpitch + (kl_base + 16 * s2 + 4 * h) * 2; const v2u lo = *(const LAS v2u*)vp, hi = *(const LAS v2u*)(vp + 16);
          v4u vw; vw.x = lo.x; vw.y = lo.y; vw.z = hi.x; vw.w = hi.y; o1 = __builtin_amdgcn_mfma_f32_32x32x16_bf16(__builtin_bit_cast(bf16x8, vw), pk, o1, 0, 0, 0); }
    }
}
PHASE_FN ph_e3_attn(PP pp, int layer) {
    FRAME();
    const bf16* QKV = (const bf16*)(ws + WS_BIG + BIG_QKV); bf16* MIX = (bf16*)(ws + WS_BIG + BIG_MIX); const bf16* VT = (const bf16*)(ws + WS_H);
    const float* sinkp = PIN(I_EV_SINK) + (layer >> 1) * 8;
    LAS unsigned char* Ks = F.lds; LAS unsigned char* Vs = F.lds + AT_VOFF;
    const int r = F.lane & 31, h = F.lane >> 5, g = F.wave >> 1, th = F.wave & 1;
    for (int u = F.bid; u < 2048 + 128; u += F.G) {
        const bool isc = u >= 2048;
        int b, hkv, qb; if (!isc) { b = u >> 7; hkv = (u >> 6) & 1; qb = u & 63; } else { const int v = u - 2048; b = v >> 3; hkv = (v >> 2) & 1; qb = v & 3; }
        const int n0 = qb * 64, bh = b * 2 + hkv;
        const size_t qrow = isc ? ((size_t)TL + (size_t)b * 256 + n0 + 32 * th + r) : ((size_t)b * 4096 + n0 + 32 * th + r);
        bf16x8 qf[4];
#pragma unroll
        for (int s = 0; s < 4; ++s) qf[s] = *(const bf16x8*)(QKV + qrow * 768 + (hkv * 4 + g) * 64 + 16 * s + 8 * h);
        float m = sinkp[hkv * 4 + g], l = (h == 0) ? 1.0f : 0.0f;
        f32x16 o0, o1;
#pragma unroll
        for (int i = 0; i < 16; ++i) { o0[i] = 0.f; o1[i] = 0.f; }
        __syncthreads();
        if (!isc) {
            for (int pc = F.tid; pc < 2560; pc += NTHREADS) { const int kl = pc >> 3, c8 = pc & 7, kj = n0 - 128 + kl;
                v4u v = (v4u){0u, 0u, 0u, 0u}; if (kj >= 0 && kj < SEQ) v = *(const v4u*)(QKV + ((size_t)b * 4096 + kj) * 768 + 512 + hkv * 64 + c8 * 8);
                *(LAS v4u*)(Ks + kl * AT_KP + c8 * 16) = v; }
            for (int pc = F.tid; pc < 2560; pc += NTHREADS) { const int d = pc / 40, c = pc - d * 40, kj = n0 - 128 + c * 8;
                v4u v = (v4u){0u, 0u, 0u, 0u}; if (kj >= 0 && kj < SEQ) v = *(const v4u*)(VT + ((size_t)bh * 64 + d) * 4352 + 256 + kj);
                LAS v2u* dst = (LAS v2u*)(Vs + d * AT_VP1 + c * 16); dst[0] = (v2u){v.x, v.y}; dst[1] = (v2u){v.z, v.w}; }
            __syncthreads();
            const int qi = n0 + 32 * th + r;
#pragma unroll 1
            for (int t = 0; t < 9; ++t) { const int klb = 32 * th + 32 * t; attn_tile<true>(Ks, Vs, AT_VP1, klb, qf, o0, o1, m, l, r, h, n0 - 128 + klb, qi); }
            __syncthreads();
        }
        for (int pc = F.tid; pc < 2048; pc += NTHREADS) { const int j = pc >> 3, c8 = pc & 7;
            *(LAS v4u*)(Ks + j * AT_KP + c8 * 16) = *(const v4u*)(QKV + ((size_t)TL + (size_t)b * 256 + j) * 768 + 512 + hkv * 64 + c8 * 8); }
        for (int pc = F.tid; pc < 2048; pc += NTHREADS) { const int d = pc >> 5, c = pc & 31; const v4u v = *(const v4u*)(VT + ((size_t)bh * 64 + d) * 4352 + c * 8);
            LAS v2u* dst = (LAS v2u*)(Vs + d * AT_VP2 + c * 16); dst[0] = (v2u){v.x, v.y}; dst[1] = (v2u){v.z, v.w}; }
        __syncthreads();
#pragma unroll 1
        for (int t = 0; t < 8; ++t) attn_tile<false>(Ks, Vs, AT_VP2, 32 * t, qf, o0, o1, m, l, r, h, 0, 0);
        const float inv = 1.0f / (l + __shfl_xor(l, 32));
        bf16* orow = MIX + qrow * D + 512 + (hkv * 4 + g) * 64 + 4 * h;
#pragma unroll
        for (int q4 = 0; q4 < 4; ++q4) {
            v2u w0; w0.x = pk_bf16(o0[4 * q4 + 0] * inv, o0[4 * q4 + 1] * inv); w0.y = pk_bf16(o0[4 * q4 + 2] * inv, o0[4 * q4 + 3] * inv); *(v2u*)(orow + 8 * q4) = w0;
            v2u w1; w1.x = pk_bf16(o1[4 * q4 + 0] * inv, o1[4 * q4 + 1] * inv); w1.y = pk_bf16(o1[4 * q4 + 2] * inv, o1[4 * q4 + 3] * inv); *(v2u*)(orow + 32 + 8 * q4) = w1;
        }
    }
    __syncthreads();
}
PHASE_FN ph_outproj(PP pp, int layer) {
    FRAME();
    const int li = layer >> 1; const bool odd = (layer & 1) != 0;
    const int TR = (layer == DEPTH - 1) ? TL : T;
    const char* W = odd ? (const char*)(ws + WS_OD + li * OD_STRIDE + OD_WOUT) : (const char*)(ws + WS_EV + li * EV_STRIDE + EV_WOUT);
    float* XC = (float*)(ws + WS_XC); float* out = (float*)pp->out;
    const float* xl_src = (layer == 0) ? PIN(I_X) : out; const float* xc_src = (layer == 0) ? PIN(I_CTX) : XC;
    const float* modl = (const float*)(ws + WS_MOD) + (size_t)layer * 17 * 6144;
    SchedResid S{F.G, F.bid, (TR / 256) * 4, (const char*)(ws + WS_BIG + BIG_MIX), (size_t)256 * D * 2, W, (size_t)256 * D * 2, xl_src, xc_src, out, XC, modl + 2048};
    pg8::gemm_phase<pg8::EpiResid, SchedResid, true, true>(F.lds, F.tid, pg8::Dims{D, D, D}, S, pg8::EpiResid{});
}
PHASE_FN ph_ln_mid(PP pp, int layer) {
    FRAME();
    ln_pass(F, (float*)pp->out, (float*)(ws + WS_XC), (bf16*)(ws + WS_H), PIN(I_LNG) + (size_t)(layer * 2) * D, PIN(I_LNB) + (size_t)(layer * 2) * D,
            (const float*)(ws + WS_MOD) + (size_t)layer * 17 * 6144, 4096, 3072, T);
}
PHASE_FN ph_e6(PP pp, int layer) {
    FRAME();
    unsigned char* evw = ws + WS_EV + (layer >> 1) * EV_STRIDE;
    SchedStd S{22, (T / 256) * 22, F.G, F.bid, (const char*)(ws + WS_H), (const char*)(evw + EV_W13), (char*)(ws + WS_BIG + BIG_HID), (size_t)256 * D * 2, (size_t)256 * D * 2, (size_t)256 * FFH * 2, (size_t)128 * 2, FFH, 1 << 30};
    pg8::gemm_phase<pg8::EpiSwiGLU, SchedStd, true, true>(F.lds, F.tid, pg8::Dims{D, D, D}, S, pg8::EpiSwiGLU{});
}
PHASE_FN ph_e7(PP pp, int layer) {
    FRAME();
    unsigned char* evw = ws + WS_EV + (layer >> 1) * EV_STRIDE;
    float* XC = (float*)(ws + WS_XC); float* out = (float*)pp->out;
    const float* modl = (const float*)(ws + WS_MOD) + (size_t)layer * 17 * 6144;
    SchedResid S{F.G, F.bid, (T / 256) * 4, (const char*)(ws + WS_BIG + BIG_HID), (size_t)256 * FFH * 2, (const char*)(evw + EV_W2), (size_t)256 * FFH * 2, out, XC, out, XC, modl + 5120};
    pg8::gemm_phase<pg8::EpiResid, SchedResid, true, true>(F.lds, F.tid, pg8::Dims{FFH, FFH, FFH}, S, pg8::EpiResid{});
}
PHASE_FN ph_ln_end(PP pp, int layer) {
    FRAME();
    ln_pass(F, (float*)pp->out, (float*)(ws + WS_XC), (bf16*)(ws + WS_H), PIN(I_LNG) + (size_t)(layer * 2 + 1) * D, PIN(I_LNB) + (size_t)(layer * 2 + 1) * D,
            (const float*)(ws + WS_MOD) + (size_t)(layer + 1) * 17 * 6144, 1024, 0, T);
}

PHASE_FN ph_o1(PP pp, int layer) {
    FRAME();
    unsigned char* odw = ws + WS_OD + (layer >> 1) * OD_STRIDE;
    SchedStd S{6, (T / 256) * 6, F.G, F.bid, (const char*)(ws + WS_H), (const char*)(odw + OD_WIN), (char*)(ws + WS_BIG + BIG_P), (size_t)256 * D * 2, (size_t)256 * D * 2, (size_t)256 * 1536 * 2, (size_t)256 * 2, 1536, 2};
    pg8::gemm_phase<pg8::EpiStore, SchedStd, true, true>(F.lds, F.tid, pg8::Dims{D, D, D}, S, pg8::EpiStore{});
}
PHASE_FN ph_o2_s5a(PP pp, int layer) {
    FRAME();
    const int li = layer >> 1;
    SchedS5A S{F.G, F.bid, (const char*)(ws + WS_BIG + BIG_P), (const char*)(ws + WS_S5M + (size_t)li * 32 * S5M_STRIDE), (char*)(ws + WS_H + 68 * MiB), (char*)(ws + WS_H)};
    pg8::gemm_phase<pg8::EpiStore, SchedS5A, true, true, pg8::AMapS5>(F.lds, F.tid, pg8::Dims{256, 0, 256}, S, pg8::EpiStore{}, pg8::AMapS5{});
}
PHASE_FN ph_o2_scan(PP pp, int layer) {
    FRAME();
    const int li = layer >> 1;
    if (F.tid < 256) {
        const int t = F.bid * 256 + F.tid;
        if (t < NBATCH * 32 * 2 * 64) {
            const int pl = t & 63, d = (t >> 6) & 1, g = (t >> 7) & 31, b = t >> 12;
            const int sidx = ((li * 2 + d) * 32 + g);
            const float are = PIN(I_A_RE)[sidx * 64 + pl], aim = PIN(I_A_IM)[sidx * 64 + pl], dt = expf(PIN(I_LOG_DT)[sidx]);
            const float mag = expf(16.0f * are * dt); float sn, cn; sincosf(16.0f * aim * dt, &sn, &cn);
            const float lre = mag * cn, lim = mag * sn;
            unsigned* HB = (unsigned*)(ws + WS_H) + (g * 256 + d * 128 + pl * 2) / 2;
            float cre = 0.f, cim = 0.f;
#define S5_CROW(k_) ((k_) < 16 ? (4096 + b * 16 + (d ? 15 - (k_) : (k_))) : (b * 256 + (d ? 255 - ((k_) - 16) : ((k_) - 16))))
            for (int k0 = 0; k0 < 272; k0 += 8) {
                unsigned w[8];
#pragma unroll
                for (int j = 0; j < 8; ++j) w[j] = HB[(size_t)S5_CROW(k0 + j) * 4096];
#pragma unroll
                for (int j = 0; j < 8; ++j) { HB[(size_t)S5_CROW(k0 + j) * 4096] = cvt_pk_bf16(cre, cim);
                    const float sr = bflo(w[j]), si = bfhi(w[j]); const float nr = lre * cre - lim * cim + sr, ni = lre * cim + lim * cre + si; cre = nr; cim = ni; }
            }
#undef S5_CROW
        }
    }
}
PHASE_FN ph_o3(PP pp, int layer) {
    FRAME();
    const int li = layer >> 1;
    SchedS5B S{F.G, F.bid, (const char*)(ws + WS_H), (const char*)(ws + WS_S5M + (size_t)li * 32 * S5M_STRIDE + 256 * 1024), (const char*)(ws + WS_H + 68 * MiB), (char*)(ws + WS_BIG + BIG_P)};
    pg8::gemm_phase<pg8::EpiS5B, SchedS5B, true, true>(F.lds, F.tid, pg8::Dims{256, 8192, 256}, S, pg8::EpiS5B{});
}
PHASE_FN ph_o2_gmlp(PP pp, int layer) {
    FRAME();
    const int li = layer >> 1; const int TR = (layer == DEPTH - 1) ? TL : T;
    const bf16* P = (const bf16*)(ws + WS_BIG + BIG_P); bf16* MIX = (bf16*)(ws + WS_BIG + BIG_MIX);
    LAS float* Wn = (LAS float*)F.lds;
    LAS float* Vs = (LAS float*)(F.lds + 65536);
    const int nchunk = TR / 128;
    const float* ws_w = PIN(I_WS) + (size_t)li * 4 * 128 * 128; const float* bs = PIN(I_BS) + (size_t)li * 4 * 128;
    __syncthreads();
    for (int ch = F.bid; ch < nchunk; ch += F.G) {
        const size_t row0 = (size_t)ch * 128;
        float mu_r[16], rs_r[16];
#pragma unroll
        for (int t = 0; t < 16; ++t) { const v4u w = *(const v4u*)(P + (row0 + F.wave * 16 + t) * 1536 + 1024 + F.lane * 8);
            const float f[8] = {bflo(w.x), bfhi(w.x), bflo(w.y), bfhi(w.y), bflo(w.z), bfhi(w.z), bflo(w.w), bfhi(w.w)};
            float s = 0.f;
#pragma unroll
            for (int j = 0; j < 8; ++j) s += f[j];
            const float mu = wave_sum(s) * (1.f / 512.f); float q = 0.f;
#pragma unroll
            for (int j = 0; j < 8; ++j) q += (f[j] - mu) * (f[j] - mu);
            mu_r[t] = mu; rs_r[t] = rsqrtf(wave_sum(q) * (1.f / 512.f) + LN_EPS); }
        for (int h = 0; h < 4; ++h) {
            __syncthreads();
            for (int e = F.tid; e < 128 * 128; e += NTHREADS) Wn[e] = ws_w[(size_t)h * 16384 + e];
#pragma unroll
            for (int t = 0; t < 16; ++t) { const int j = F.wave * 16 + t; const unsigned w = *(const unsigned*)(P + (row0 + j) * 1536 + 1024 + h * 128 + F.lane * 2);
                Vs[j * 128 + F.lane * 2] = (bflo(w) - mu_r[t]) * rs_r[t]; Vs[j * 128 + F.lane * 2 + 1] = (bfhi(w) - mu_r[t]) * rs_r[t]; }
            __syncthreads();
            const int ti = F.tid >> 5, te = F.tid & 31;
            f32x4 acc[8];
#pragma unroll
            for (int k = 0; k < 8; ++k) acc[k] = (f32x4){0.f, 0.f, 0.f, 0.f};
            for (int j = 0; j < 128; ++j) {
                const f32x4 vv = *(const LAS f32x4*)(Vs + j * 128 + te * 4);
#pragma unroll
                for (int k = 0; k < 8; ++k) acc[k] += vv * Wn[(ti * 8 + k) * 128 + j];
            }
#pragma unroll
            for (int k = 0; k < 8; ++k) { const int i = ti * 8 + k; const float bb = bs[h * 128 + i];
                const v2u uw = *(const v2u*)(P + (row0 + i) * 1536 + 512 + h * 128 + te * 4);
                v2u o; o.x = cvt_pk_bf16(bflo(uw.x) * (acc[k][0] + bb), bfhi(uw.x) * (acc[k][1] + bb)); o.y = cvt_pk_bf16(bflo(uw.y) * (acc[k][2] + bb), bfhi(uw.y) * (acc[k][3] + bb));
                *(v2u*)(MIX + (row0 + i) * D + 512 + h * 128 + te * 4) = o; }
        }
    }
    __syncthreads();
}
PHASE_FN ph_o4(PP pp, int layer) {
    FRAME();
    const int li = layer >> 1;
    unsigned char* odw = ws + WS_OD + li * OD_STRIDE;
    SchedGlu S{F.G, F.bid, (const char*)(ws + WS_BIG + BIG_P), (const char*)(odw + OD_WGLU), (char*)(ws + WS_BIG + BIG_MIX), PIN(I_BGLU) + (size_t)li * 512};
    pg8::gemm_phase<pg8::EpiGLU, SchedGlu, true, true>(F.lds, F.tid, pg8::Dims{512, 1536, 512}, S, pg8::EpiGLU{});
}
PHASE_FN ph_o6(PP pp, int layer) {
    FRAME();
    const int li = layer >> 1; const int TR = (layer == DEPTH - 1) ? TL : T;
    float* XC = (float*)(ws + WS_XC); float* out = (float*)pp->out; bf16* Hb = (bf16*)(ws + WS_H);
    const float* modl = (const float*)(ws + WS_MOD) + (size_t)layer * 17 * 6144;
    const float* lng0 = PIN(I_LNG) + (size_t)(layer * 2) * D; const float* lnb0 = PIN(I_LNB) + (size_t)(layer * 2) * D;
    int* tokE = (int*)(ws + WS_TOK); int* tokS0 = tokE + T; int* tokS1 = tokS0 + T; float* tokG0 = (float*)(tokS1 + T);
    unsigned* ecnt = F.ctl + CW_CNT + li * 64;
    LAS float* wr_s = (LAS float*)F.lds;
    LAS unsigned* lcnt = (LAS unsigned*)(F.lds + 32768);
    const float* rw = PIN(I_ROUTER) + (size_t)li * D * 8;
    __syncthreads();
    for (int e = F.tid; e < D * 8; e += NTHREADS) wr_s[e] = rw[e];
    if (F.tid < 16) lcnt[F.tid] = 0u;
    __syncthreads();
    f32x4 gg[4], bb[4];
#pragma unroll
    for (int j = 0; j < 4; ++j) { gg[j] = *(const f32x4*)(lng0 + 256 * j + 4 * F.lane); bb[j] = *(const f32x4*)(lnb0 + 256 * j + 4 * F.lane); }
    for (int r = F.gw; r < TR; r += F.NGW) {
        const bool isc = r >= TL; float* xr = isc ? XC + (size_t)(r - TL) * D : out + (size_t)r * D;
        const float* m = modl + (size_t)(isc ? 16 : (r >> 12)) * 6144;
        f32x4 v[4], h[4], sv[4], tv[4]; row_load(xr, F.lane, v); row_load_mod(m + 4096, m + 3072, F.lane, sv, tv);
        row_ln_pre(v, gg, bb); row_store(xr, F.lane, v);
#pragma unroll
        for (int j = 0; j < 4; ++j) h[j] = v[j] * (sv[j] + 1.0f) + tv[j];
        row_store_bf16(Hb + (size_t)r * D, F.lane, h);
        float lg[8];
#pragma unroll
        for (int e = 0; e < 8; ++e) lg[e] = 0.f;
#pragma unroll
        for (int j = 0; j < 4; ++j)
#pragma unroll
            for (int q = 0; q < 4; ++q) { const int col = 256 * j + 4 * F.lane + q; const f32x4 w0 = *(const LAS f32x4*)(wr_s + col * 8), w1 = *(const LAS f32x4*)(wr_s + col * 8 + 4); const float hv = h[j][q];
                lg[0] += hv * w0[0]; lg[1] += hv * w0[1]; lg[2] += hv * w0[2]; lg[3] += hv * w0[3]; lg[4] += hv * w1[0]; lg[5] += hv * w1[1]; lg[6] += hv * w1[2]; lg[7] += hv * w1[3]; }
#pragma unroll
        for (int e = 0; e < 8; ++e) lg[e] = wave_sum(lg[e]);
        if (F.lane == 0) {
            int e0 = 0; float v0 = lg[0];
#pragma unroll
            for (int e = 1; e < 8; ++e) if (lg[e] > v0) { v0 = lg[e]; e0 = e; }
            int e1 = -1; float v1 = -3.0e38f;
#pragma unroll
            for (int e = 0; e < 8; ++e) if (e != e0 && lg[e] > v1) { v1 = lg[e]; e1 = e; }
            const float w0 = 1.0f / (1.0f + __expf(v1 - v0));
            const int s0 = (int)__hip_atomic_fetch_add(lcnt + e0, 1u, __ATOMIC_RELAXED, __HIP_MEMORY_SCOPE_WORKGROUP), s1 = (int)__hip_atomic_fetch_add(lcnt + e1, 1u, __ATOMIC_RELAXED, __HIP_MEMORY_SCOPE_WORKGROUP);
            tokE[r] = e0 | (e1 << 8); tokS0[r] = s0; tokS1[r] = s1; tokG0[r] = w0;
        }
    }
    __syncthreads();
    if (F.tid < 8) lcnt[8 + F.tid] = atomicAdd(ecnt + F.tid, lcnt[F.tid]);
    VM_WAIT();
    __syncthreads();
    { const int r = F.gw + F.lane * F.NGW;
      if (r < TR) { const int ee = tokE[r]; tokS0[r] += (int)lcnt[8 + (ee & 255)]; tokS1[r] += (int)lcnt[8 + (ee >> 8)]; } }
    __syncthreads();
}
PHASE_FN ph_o7(PP pp, int layer) {
    FRAME();
    const int li = layer >> 1; const int TR = (layer == DEPTH - 1) ? TL : T;
    const bf16* Hb = (const bf16*)(ws + WS_H); bf16* HS = (bf16*)(ws + WS_BIG + BIG_HS);
    int* tokE = (int*)(ws + WS_TOK); int* tokS0 = tokE + T; int* tokS1 = tokS0 + T; int* tokP0 = tokS1 + 2 * T; int* tokP1 = tokP0 + T;
    unsigned* ecnt = F.ctl + CW_CNT + li * 64;
    int roff[8]; { int acc = 0;
#pragma unroll
        for (int e = 0; e < 8; ++e) { roff[e] = acc * 256; acc += ((int)__hip_atomic_load(ecnt + e, __ATOMIC_RELAXED, __HIP_MEMORY_SCOPE_AGENT) + 255) >> 8; } }
    for (int r = F.gw; r < TR; r += F.NGW) {
        const int ee = tokE[r], e0 = ee & 255, e1 = ee >> 8;
        int p0 = tokS0[r], p1 = tokS1[r];
#pragma unroll
        for (int e = 0; e < 8; ++e) { p0 += (e == e0) ? roff[e] : 0; p1 += (e == e1) ? roff[e] : 0; }
        const v4u* src = (const v4u*)(Hb + (size_t)r * D); v4u* d0 = (v4u*)(HS + (size_t)p0 * D); v4u* d1 = (v4u*)(HS + (size_t)p1 * D);
        const v4u a = src[F.lane], b = src[64 + F.lane];
        d0[F.lane] = a; d0[64 + F.lane] = b; d1[F.lane] = a; d1[64 + F.lane] = b;
        if (F.lane == 0) { tokP0[r] = p0; tokP1[r] = p1; }
    }
}
PHASE_FN ph_moe_up(PP pp, int layer, int chn) {
    FRAME();
    const int li = layer >> 1; unsigned char* odw = ws + WS_OD + li * OD_STRIDE; unsigned* ecnt = F.ctl + CW_CNT + li * 64;
    SchedMoeUp S; S.G = F.G; S.c = F.bid; S.rt0 = chn * MOE_CHUNK_TILES; S.HS = (const char*)(ws + WS_BIG + BIG_HS); S.W = (const char*)(odw + OD_MW13); S.HID = (char*)(ws + WS_H);
    { int acc = 0; S.toff[0] = 0;
#pragma unroll
        for (int e = 0; e < 8; ++e) { acc += ((int)__hip_atomic_load(ecnt + e, __ATOMIC_RELAXED, __HIP_MEMORY_SCOPE_AGENT) + 255) >> 8; S.toff[e + 1] = acc; } }
    int nt_ = S.toff[8] - S.rt0; nt_ = nt_ < 0 ? 0 : (nt_ > MOE_CHUNK_TILES ? MOE_CHUNK_TILES : nt_); S.nUnits = nt_ * 28;
    pg8::gemm_phase<pg8::EpiSwiGLU, SchedMoeUp, true, true>(F.lds, F.tid, pg8::Dims{D, D, D}, S, pg8::EpiSwiGLU{});
}
PHASE_FN ph_moe_down(PP pp, int layer, int chn) {
    FRAME();
    const int li = layer >> 1; unsigned char* odw = ws + WS_OD + li * OD_STRIDE; unsigned* ecnt = F.ctl + CW_CNT + li * 64;
    SchedMoeDown S; S.G = F.G; S.c = F.bid; S.rt0 = chn * MOE_CHUNK_TILES; S.HID = (const char*)(ws + WS_H); S.W = (const char*)(odw + OD_MW2); S.Y = (char*)(ws + WS_BIG + BIG_HS);
    { int acc = 0; S.toff[0] = 0;
#pragma unroll
        for (int e = 0; e < 8; ++e) { acc += ((int)__hip_atomic_load(ecnt + e, __ATOMIC_RELAXED, __HIP_MEMORY_SCOPE_AGENT) + 255) >> 8; S.toff[e + 1] = acc; } }
    int nt_ = S.toff[8] - S.rt0; nt_ = nt_ < 0 ? 0 : (nt_ > MOE_CHUNK_TILES ? MOE_CHUNK_TILES : nt_); S.nUnits = nt_ * 4;
    pg8::gemm_phase<pg8::EpiStore, SchedMoeDown, true, true>(F.lds, F.tid, pg8::Dims{EH, EH, EH}, S, pg8::EpiStore{});
}
PHASE_FN ph_o9(PP pp, int layer) {
    FRAME();
    const int TR = (layer == DEPTH - 1) ? TL : T; const bool last = layer == DEPTH - 1;
    float* XC = (float*)(ws + WS_XC); float* out = (float*)pp->out; bf16* Hb = (bf16*)(ws + WS_H); const bf16* HS = (const bf16*)(ws + WS_BIG + BIG_HS);
    const float* modl = (const float*)(ws + WS_MOD) + (size_t)layer * 17 * 6144;
    const float* modn = (const float*)(ws + WS_MOD) + (size_t)(last ? layer : layer + 1) * 17 * 6144;
    const float* lng1 = PIN(I_LNG) + (size_t)(layer * 2 + 1) * D; const float* lnb1 = PIN(I_LNB) + (size_t)(layer * 2 + 1) * D;
    const int* tokE = (const int*)(ws + WS_TOK); const float* tokG0 = (const float*)(tokE + 3 * T); const int* tokP0 = tokE + 4 * T; const int* tokP1 = tokP0 + T;
    f32x4 gg9[4], bb9[4];
#pragma unroll
    for (int j = 0; j < 4; ++j) { gg9[j] = *(const f32x4*)(lng1 + 256 * j + 4 * F.lane); bb9[j] = *(const f32x4*)(lnb1 + 256 * j + 4 * F.lane); }
    for (int r = F.gw; r < TR; r += F.NGW) {
        const bool isc = r >= TL; float* xr = isc ? XC + (size_t)(r - TL) * D : out + (size_t)r * D;
        const int mrow = isc ? 16 : (r >> 12);
        const float* g2 = modl + (size_t)mrow * 6144 + 5120;
        const int p0 = tokP0[r], p1 = tokP1[r]; const float w0 = tokG0[r], w1 = 1.0f - w0;
        const bf16* y0 = HS + (size_t)p0 * D; const bf16* y1 = HS + (size_t)p1 * D;
        f32x4 v[4], h[4]; row_load(xr, F.lane, v);
#pragma unroll
        for (int j = 0; j < 4; ++j) { const v2u a = *(const v2u*)(y0 + 256 * j + 4 * F.lane), b = *(const v2u*)(y1 + 256 * j + 4 * F.lane); const f32x4 gg = *(const f32x4*)(g2 + 256 * j + 4 * F.lane);
            f32x4 f; f[0] = w0 * bflo(a.x) + w1 * bflo(b.x); f[1] = w0 * bfhi(a.x) + w1 * bfhi(b.x); f[2] = w0 * bflo(a.y) + w1 * bflo(b.y); f[3] = w0 * bfhi(a.y) + w1 * bfhi(b.y);
            v[j] = v[j] * ALPHA + gg * f; }
        row_ln_pre(v, gg9, bb9); row_store(xr, F.lane, v);
        if (!last) { const float* m = modn + (size_t)mrow * 6144; row_modulate(h, v, m + 1024, m, F.lane); row_store_bf16(Hb + (size_t)r * D, F.lane, h); }
    }
}

#if MK_SPLIT
#define PHASE_END() do { ++ph; } while (0)
#else
#define PHASE_END() do { if (ph >= lo && ph + 1 < hi) grid_bar(pp); ++ph; } while (0)
#endif
#define PHASE_ON() (ph >= lo && ph < hi)
static __device__ __forceinline__ void even_layer(PP pp, const int layer, const int lo, const int hi, int& ph) {
    if (PHASE_ON()) ph_e1(pp, layer);
    PHASE_END();
    if (PHASE_ON()) { ph_e2_dft(pp); ph_e2_dftc(pp); ph_e2_rope(pp); }
    PHASE_END();
    if (PHASE_ON()) ph_e3_attn(pp, layer);
    PHASE_END();
    if (PHASE_ON()) ph_outproj(pp, layer);
    PHASE_END();
    if (PHASE_ON()) ph_ln_mid(pp, layer);
    PHASE_END();
    if (PHASE_ON()) ph_e6(pp, layer);
    PHASE_END();
    if (PHASE_ON()) ph_e7(pp, layer);
    PHASE_END();
    if (PHASE_ON()) ph_ln_end(pp, layer);
    PHASE_END();
}
static __device__ __forceinline__ void odd_layer(PP pp, const int layer, const int lo, const int hi, int& ph) {
    if (PHASE_ON()) ph_o1(pp, layer);
    PHASE_END();
    if (PHASE_ON()) { ph_o2_s5a(pp, layer); ph_o2_gmlp(pp, layer); }
    PHASE_END();
    if (PHASE_ON()) ph_o2_scan(pp, layer);
    PHASE_END();
    if (PHASE_ON()) ph_o3(pp, layer);
    PHASE_END();
    if (PHASE_ON()) ph_o4(pp, layer);
    PHASE_END();
    if (PHASE_ON()) ph_outproj(pp, layer);
    PHASE_END();
    if (PHASE_ON()) ph_o6(pp, layer);
    PHASE_END();
    if (PHASE_ON()) ph_o7(pp, layer);
    PHASE_END();
    for (int chn = 0; chn < MOE_NCHUNK; ++chn) {
        if (PHASE_ON()) ph_moe_up(pp, layer, chn);
        PHASE_END();
        if (PHASE_ON()) ph_moe_down(pp, layer, chn);
        PHASE_END();
    }
    if (PHASE_ON()) ph_o9(pp, layer);
    PHASE_END();
}
constexpr int N_PHASES = 2 + 2 * (8 + 9 + 2 * MOE_NCHUNK);
__global__ void __launch_bounds__(NTHREADS, 2) fwd_kernel(Params p_unused) {
    DECL_LDS;
    PP pp = (PP)__builtin_amdgcn_kernarg_segment_ptr();
    {
        LAS unsigned char* lds = (LAS unsigned char*)lds_raw;
        for (int u = threadIdx.x; u < (LDS_BYTES - LDS_RING) / 4; u += NTHREADS) ((LAS unsigned*)(lds + LDS_RING))[u] = 0u;
        __syncthreads();
#if !MK_SPLIT
        (void)xcd_barrier_post((unsigned*)((unsigned char*)pp->ws + WS_CTL) + CW_BAR, (volatile LAS unsigned*)(lds + LDS_MISC) + 8);
#endif
    }
    const int lo = pp->ph_lo, hi = pp->ph_hi; int ph = 0;

    if (PHASE_ON()) { ph_fold(pp); ph_mod(pp); ph_s5mat(pp); ph_cvt(pp); ph_dftmat(pp); }
    PHASE_END();
    if (PHASE_ON()) ph_pro_b(pp);
    PHASE_END();
    even_layer(pp, 0, lo, hi, ph);
    odd_layer(pp, 1, lo, hi, ph);
    even_layer(pp, 2, lo, hi, ph);
    odd_layer(pp, 3, lo, hi, ph);
}

extern "C" void kernel_launch(void* const* d_in, const int* in_sizes, int n_in, void* d_out, int out_size, void* d_ws, size_t ws_size, hipStream_t stream) {
    static int grid = 0;
    if (grid == 0) {
        if (n_in != 32 || out_size != TL * D || ws_size < WS_END) { fprintf(stderr, "kernel_launch: unexpected shapes (n_in %d, out %d, ws %zu < %zu)\n", n_in, out_size, ws_size, (size_t)WS_END); grid = -1; return; }
        int dev = 0, cus = 0, per_cu = 0;
        if (hipGetDevice(&dev) != hipSuccess || hipDeviceGetAttribute(&cus, hipDeviceAttributeMultiprocessorCount, dev) != hipSuccess) { grid = -1; return; }
        if (hipFuncSetAttribute((const void*)fwd_kernel, hipFuncAttributeMaxDynamicSharedMemorySize, LDS_BYTES) != hipSuccess) { fprintf(stderr, "kernel_launch: hipFuncSetAttribute failed\n"); grid = -1; return; }
        if (hipOccupancyMaxActiveBlocksPerMultiprocessor(&per_cu, (const void*)fwd_kernel, NTHREADS, LDS_BYTES) != hipSuccess || per_cu < 1) { fprintf(stderr, "kernel_launch: occupancy query says %d\n", per_cu); }
        (void)hipGetLastError();
        grid = cus;
    }
    if (grid < 0) return;
    (void)in_sizes;
    (void)hipMemsetAsync((char*)d_ws + WS_CTL, 0, CTL_ZERO_BYTES, stream);
    Params p{};
    for (int i = 0; i < 32; ++i) p.in[i] = (const float*)d_in[i];
    p.out = (float*)d_out; p.ws = (unsigned char*)d_ws;
#if MK_SPLIT
    for (int ph = 0; ph < N_PHASES; ++ph) { p.ph_lo = ph; p.ph_hi = ph + 1; hipLaunchKernelGGL(fwd_kernel, dim3(grid), dim3(NTHREADS), LDS_BYTES, stream, p); }
#else
    p.ph_lo = 0; p.ph_hi = N_PHASES;
    hipLaunchKernelGGL(fwd_kernel, dim3(grid), dim3(NTHREADS), LDS_BYTES, stream, p);
#endif
}
```

```cpp
#include <hip/hip_runtime.h>
#include <cstdio>
#include <cstdint>

#ifndef MK_SPLIT
#define MK_SPLIT 0
#endif

#define GAS __attribute__((address_space(1)))
#define LAS __attribute__((address_space(3)))
typedef unsigned short bf16;
typedef unsigned v4u __attribute__((ext_vector_type(4)));
typedef unsigned v2u __attribute__((ext_vector_type(2)));
typedef float f32x4 __attribute__((ext_vector_type(4)));
typedef float f32x2 __attribute__((ext_vector_type(2)));
typedef short bf16x8 __attribute__((ext_vector_type(8)));

constexpr int D = 1024, NBATCH = 16, SEQ = 4096, NCTX = 256, DEPTH = 4;
constexpr int TL = NBATCH * SEQ, TC = NBATCH * NCTX, T = TL + TC;
constexpr int FFH = 2816, EH = 3584, NEXP = 8;
constexpr int MOE_CHUNK_TILES = 128, MOE_NCHUNK = 5;
constexpr float Q_H = 16.f, Q_W = 1024.f, Q_HID = 8.f;
constexpr float ALPHA = 1.6817928305074290860622509524664f;
constexpr float LN_EPS = 1e-5f;

constexpr size_t MiB = (size_t)1 << 20;
constexpr size_t WS_CTL = 0, CTL_ZERO_BYTES = 1 * MiB;
constexpr size_t WS_MOD = 1 * MiB;
constexpr size_t WS_TOK = 3 * MiB;
constexpr size_t WS_XC = 5 * MiB;
constexpr size_t WS_F256 = 21 * MiB;
constexpr size_t WS_F4096 = 22 * MiB;
constexpr size_t WS_EV = 86 * MiB, EV_STRIDE = 22 * MiB;
constexpr size_t EV_WQKV = 0, EV_WPQ = 3 * MiB / 2, EV_WOUT = 7 * MiB / 2, EV_W13 = 11 * MiB / 2, EV_W2 = 33 * MiB / 2;
constexpr size_t WS_OD = 130 * MiB, OD_STRIDE = 174 * MiB;
constexpr size_t OD_WIN = 0, OD_WGLU = 3 * MiB, OD_WOUT = 7 * MiB / 2, OD_MW13 = 11 * MiB / 2, OD_MW2 = 235 * MiB / 2;
constexpr size_t WS_H = 478 * MiB;
constexpr size_t WS_BIG = 614 * MiB;
constexpr size_t BIG_PQT = 0, BIG_PQTC = 128 * MiB, BIG_QKV = 136 * MiB, BIG_MIX = 238 * MiB, BIG_HID = 0, BIG_P = 0, BIG_Y = 0, BIG_HSQ = 276 * MiB;
constexpr size_t WS_S5M = 1030 * MiB, S5M_STRIDE = 384 * 1024;
constexpr size_t WS_END = 1054 * MiB;
constexpr int CW_BAR = 4096, CW_CNT = 16384;

#define LDS_WAIT() asm volatile("s_waitcnt lgkmcnt(0)" ::: "memory")
#define VM_WAIT() asm volatile("s_waitcnt vmcnt(0)" ::: "memory")
__device__ __forceinline__ unsigned cvt_pk_bf16(float lo, float hi) { unsigned r; asm volatile("v_cvt_pk_bf16_f32 %0, %1, %2" : "=v"(r) : "v"(lo), "v"(hi)); return r; }
__device__ __forceinline__ float bflo(unsigned w) { return __uint_as_float(w << 16); }
__device__ __forceinline__ float bfhi(unsigned w) { return __uint_as_float(w & 0xffff0000u); }
__device__ __forceinline__ float bf2f(bf16 b) { return __uint_as_float(((unsigned)b) << 16); }
__device__ __forceinline__ bf16 f2bf(float f) { return (bf16)(cvt_pk_bf16(f, 0.f) & 0xffffu); }
__device__ __forceinline__ unsigned pk_fp8x4(float a, float b, float c, float d) {
    a = __builtin_amdgcn_fmed3f(a, -448.f, 448.f); b = __builtin_amdgcn_fmed3f(b, -448.f, 448.f); c = __builtin_amdgcn_fmed3f(c, -448.f, 448.f); d = __builtin_amdgcn_fmed3f(d, -448.f, 448.f);
    int w = 0; w = __builtin_amdgcn_cvt_pk_fp8_f32(a, b, w, false); w = __builtin_amdgcn_cvt_pk_fp8_f32(c, d, w, true); return (unsigned)w; }
__device__ __forceinline__ float wave_sum(float v) {
#pragma unroll
    for (int o = 1; o < 64; o <<= 1) v += __shfl_xor(v, o);
    return v;
}
__device__ __forceinline__ float wave_max(float v) {
#pragma unroll
    for (int o = 1; o < 64; o <<= 1) v = fmaxf(v, __shfl_xor(v, o));
    return v;
}
__device__ __forceinline__ float silu_f(float x) { return x / (1.f + __expf(-x)); }
__device__ __forceinline__ float sigmoid_f(float x) { return 1.f / (1.f + __expf(-x)); }
__device__ __forceinline__ float gelu_tanh_f(float x) { const float z = 0.7978845608028654f * (x + 0.044715f * x * x * x); return x / (1.f + __expf(-2.f * z)); }

#define XB_TMO      128
#define XB_XCNT(j)  (256  + 64 * (j))
#define XB_XSUB(j)  (1280 + 64 * (j))
#define XB_XGEN(j)  (2304 + 64 * (j))
#define XB_TOP      3328
#define XB_TOPGEN   3392
#define XCD_BAR_WORDS 3456
#define XB_SPIN_CAP (1u << 25)
__device__ __forceinline__ unsigned xb_ld(unsigned* p)              { return __hip_atomic_load(p, __ATOMIC_RELAXED, __HIP_MEMORY_SCOPE_AGENT); }
__device__ __forceinline__ unsigned xb_add(unsigned* p, unsigned v) { return __hip_atomic_fetch_add(p, v, __ATOMIC_RELAXED, __HIP_MEMORY_SCOPE_AGENT); }
__device__ __forceinline__ unsigned xb_xcc_id() { return (unsigned)__builtin_amdgcn_s_getreg((3 << 11) | 20) & 0xFu; }
#define XB_SPIN(cond, bar) do { unsigned _sp = 0; while (cond) { __builtin_amdgcn_s_sleep(1); \
    if ((++_sp & 255u) == 0u) { if (xb_ld(&(bar)[XB_TMO])) break; if (_sp > XB_SPIN_CAP) { atomicAdd(&(bar)[XB_TMO], 1u); break; } } } } while (0)
struct XcdBarrier { unsigned* bar; unsigned x; volatile LAS unsigned* st; };
__device__ __forceinline__ XcdBarrier xcd_barrier_post(unsigned* bar, volatile LAS unsigned* st) {
    XcdBarrier b; b.bar = bar; b.x = xb_xcc_id(); b.st = st;
    if (threadIdx.x == 0) (void)xb_add(&bar[XB_XCNT(b.x)], 1u);
    return b;
}
__device__ __forceinline__ void xcd_barrier_complete(unsigned* bar, unsigned x, unsigned& nloc, unsigned& nx) {
    const unsigned G = gridDim.x * gridDim.y * gridDim.z;
    unsigned sum, cnt, mine, sp = 0u;
    for (;;) {
        sum = 0u; cnt = 0u; mine = 0u;
#pragma unroll
        for (unsigned j = 0; j < 16; ++j) { const unsigned c = xb_ld(&bar[XB_XCNT(j)]); sum += c; cnt += (c > 0u) ? 1u : 0u; mine = (j == x) ? c : mine; }
        if (sum == G) break;
        __builtin_amdgcn_s_sleep(1);
        if ((++sp & 255u) == 0u) { if (xb_ld(&bar[XB_TMO])) break; if (sp > XB_SPIN_CAP) { atomicAdd(&bar[XB_TMO], 1u); break; } }
    }
    nloc = mine > 0u ? mine : 1u; nx = cnt > 0u ? cnt : 1u;
}
__device__ __forceinline__ void xcd_barrier(const XcdBarrier& b) {
    asm volatile("s_waitcnt vmcnt(0)" ::: "memory");
    __syncthreads();
    if (threadIdx.x == 0) {
        unsigned* bar = b.bar;
        __builtin_amdgcn_s_waitcnt(0);
        unsigned nloc = b.st[0], nx = b.st[1];
        if (nloc == 0u) { xcd_barrier_complete(bar, b.x, nloc, nx); b.st[0] = nloc; b.st[1] = nx; }
        const unsigned old = xb_add(&bar[XB_XSUB(b.x)], 1u);
        const unsigned gen = old / nloc;
        if (old + 1u == (gen + 1u) * nloc) {
            __builtin_amdgcn_fence(__ATOMIC_RELEASE, "agent");
            asm volatile("s_waitcnt vmcnt(0)" ::: "memory");
            const unsigned og = xb_add(&bar[XB_TOP], 1u);
            const unsigned tg = og / nx;
            if (og + 1u == (tg + 1u) * nx) xb_add(&bar[XB_TOPGEN], 1u);
            else XB_SPIN(xb_ld(&bar[XB_TOPGEN]) == tg, bar);
            __builtin_amdgcn_fence(__ATOMIC_ACQUIRE, "agent");
            xb_add(&bar[XB_XGEN(b.x)], 1u);
            asm volatile("s_waitcnt vmcnt(0)" ::: "memory");
        } else {
            XB_SPIN(xb_ld(&bar[XB_XGEN(b.x)]) == gen, bar);
            __builtin_amdgcn_fence(__ATOMIC_ACQUIRE, "agent");
            asm volatile("s_waitcnt vmcnt(0)" ::: "memory");
        }
    }
    __syncthreads();
}

namespace pg8 {
constexpr int BM = 256, BK = 64, HALF = 128, HTB = HALF * BK * 2, STAGE_BYTES = 8 * HTB;
__host__ __device__ __forceinline__ int lds_byte(int r, int c) { const int st = (r >> 4) * 2 + (c >> 5), rr = r & 15, cc = c & 31, ob = rr * 64 + cc * 2; return st * 1024 + (ob ^ (((ob >> 9) & 1) << 5)); }
__host__ __device__ __forceinline__ void stage_rc(int b, int& R, int& C) { const int st = b / 1024, sb = b % 1024, swz = sb ^ (((sb >> 9) & 1) << 5); R = (st >> 1) * 16 + swz / 64; C = (st & 1) * 32 + (swz % 64) / 2; }
__host__ __device__ __forceinline__ int perm32(int rho) { const int n = rho >> 4, i = rho & 15; return 8 * (i >> 2) + 4 * n + (i & 3); }

struct Unit { const char* a; const char* b; char* o; const char* p0; const char* p1; int ldo; int x0; };
struct Dims { int K, lda, ldb; };
typedef int v4i __attribute__((ext_vector_type(4)));
typedef int v8i __attribute__((ext_vector_type(8)));
struct AMapStd { int ldab = 0;   __device__ __forceinline__ unsigned voff(int R, int C) const { return (unsigned)(R * ldab + C * 2); } __device__ __forceinline__ size_t kstep() const { return 128; } __device__ __forceinline__ size_t hs() const { return (size_t)HALF * ldab; } };
struct AMapS5 { __device__ __forceinline__ unsigned voff(int R, int C) const { return (unsigned)(R * 49152 + (C >> 4) * 3072 + (C & 15) * 2); } __device__ __forceinline__ size_t kstep() const { return 12288; } __device__ __forceinline__ size_t hs() const { return (size_t)HALF * 49152; } };

__device__ __forceinline__ const char* uni_ptr(const char* p) {
    const unsigned long long v = (unsigned long long)p; const unsigned lo = __builtin_amdgcn_readfirstlane((unsigned)v), hi = __builtin_amdgcn_readfirstlane((unsigned)(v >> 32));
    return (const char*)(((unsigned long long)hi << 32) | lo); }
template <class Epi, class Sched, bool ALIGN_EPI = false, bool SP2 = false, class AMap = AMapStd, bool FP8 = false>
__device__ __forceinline__ void gemm_phase(LAS unsigned char* lds, const int tid, const Dims g, const Sched& S, const Epi& E, const AMap am_in = AMap{}) {
    constexpr int ES = FP8 ? 1 : 2;
    AMap am = am_in; if constexpr (__is_same(AMap, AMapStd)) am.ldab = g.lda * ES;
    const int wid = __builtin_amdgcn_readfirstlane(tid >> 6), lane = tid & 63, wr = wid >> 2, wc = wid & 3, fr = lane & 15, fq = lane >> 4;
    const int K = g.K, nt = (K * (FP8 ? 1 : 2)) / 128;
    unsigned voffA, voffB;
    { int R, C; stage_rc(tid * 16, R, C); const int Rb = Epi::PERM ? ((R & ~31) + perm32(R & 31)) : R;
        voffA = am.voff(R, C); voffB = (unsigned)(Rb * g.ldb * ES + C * 2); }
    const size_t d64voffA = am.voff(64, 0), d64voffB = (size_t)64 * g.ldb * ES;
    const size_t kstep = (size_t)(BK * 2), kstepA = am.kstep();
    const size_t hsA = am.hs(), hsB = (size_t)HALF * g.ldb * ES;
    const unsigned ldsw = (unsigned)wid * 1024u;
    const int aoff = lds_byte(wr * 64 + fr, fq * 8), boff = lds_byte(wc * 32 + fr, fq * 8);
#define PG8_SA(b, h) (((b) * 2 + (h)) * HTB)
#define PG8_SB(b, h) ((4 + (b) * 2 + (h)) * HTB)
#define PG8_STAGE(bufoff, gbase, voff) do { unsigned _vo = (voff); asm volatile("" : "+v"(_vo));   \
        __builtin_amdgcn_global_load_lds((const unsigned*)((const char*)(gbase) + _vo), (LAS unsigned*)(lds + (bufoff) + ldsw), 16, 0, 0); \
        __builtin_amdgcn_global_load_lds((const unsigned*)((const char*)(gbase) + d64##voff + _vo), (LAS unsigned*)(lds + (bufoff) + ldsw + 8192), 16, 0, 0); } while (0)
#define PG8_LD8(p) __builtin_shufflevector(*(const LAS v4i*)(p), *(const LAS v4i*)((p) + 1024), 0, 1, 2, 3, 4, 5, 6, 7)
#define PG8_LDA(dst, b, h) do { if constexpr (FP8) { _Pragma("unroll") for (int m = 0; m < 4; ++m) dst##8[m] = PG8_LD8(lds + PG8_SA(b, h) + aoff + m * 2048); } \
        else { _Pragma("unroll") for (int m = 0; m < 4; ++m) _Pragma("unroll") for (int k = 0; k < 2; ++k) dst[m][k] = *(const LAS bf16x8*)(lds + PG8_SA(b, h) + aoff + m * 2048 + k * 1024); } } while (0)
#define PG8_LDB(dst, b, h) do { if constexpr (FP8) { _Pragma("unroll") for (int n = 0; n < 2; ++n) dst##8[n] = PG8_LD8(lds + PG8_SB(b, h) + boff + n * 2048); } \
        else { _Pragma("unroll") for (int n = 0; n < 2; ++n) _Pragma("unroll") for (int k = 0; k < 2; ++k) dst[n][k] = *(const LAS bf16x8*)(lds + PG8_SB(b, h) + boff + n * 2048 + k * 1024); } } while (0)
#define PG8_MMA(ai, bj, At, Bt) do { __builtin_amdgcn_s_setprio(1); \
        if constexpr (FP8) { _Pragma("unroll") for (int m = 0; m < 4; ++m) _Pragma("unroll") for (int n = 0; n < 2; ++n) \
            acc[ai][bj][m][n] = __builtin_amdgcn_mfma_scale_f32_16x16x128_f8f6f4(Bt##8[n], At##8[m], acc[ai][bj][m][n], 0, 0, 0, 0, 0, 0); } \
        else { _Pragma("unroll") for (int m = 0; m < 4; ++m) _Pragma("unroll") for (int n = 0; n < 2; ++n) _Pragma("unroll") for (int k = 0; k < 2; ++k) \
            acc[ai][bj][m][n] = __builtin_amdgcn_mfma_f32_16x16x32_bf16(Bt[n][k], At[m][k], acc[ai][bj][m][n], 0, 0, 0); } \
        __builtin_amdgcn_s_setprio(0); } while (0)
#define PG8_WAIT_V(n) asm volatile("s_waitcnt vmcnt(" #n ")" ::: "memory")
#define PG8_WAIT_L(n) asm volatile("s_waitcnt lgkmcnt(" #n ")" ::: "memory")
#define PG8_BAR __builtin_amdgcn_s_barrier()
#define PG8_SCHED __builtin_amdgcn_sched_barrier(0)
    int ui = 0;
    const char* cA; const char* cB;
    { Unit u0; if (!S.next(0, u0)) return; cA = uni_ptr(u0.a); cB = uni_ptr(u0.b); }
    f32x4 acc[2][2][4][2];
#pragma unroll
    for (int a = 0; a < 2; ++a)
#pragma unroll
        for (int b = 0; b < 2; ++b)
#pragma unroll
            for (int m = 0; m < 4; ++m)
#pragma unroll
                for (int n = 0; n < 2; ++n) acc[a][b][m][n] = (f32x4){0.f, 0.f, 0.f, 0.f};
    bf16x8 At[4][2], B0[2][2], B1[2][2];
    v8i At8[4], B08[2], B18[2];
    if constexpr (SP2) {
        PG8_STAGE(PG8_SB(0, 0), cB, voffB); PG8_STAGE(PG8_SB(0, 1), cB + hsB, voffB); PG8_STAGE(PG8_SA(0, 0), cA, voffA); PG8_STAGE(PG8_SA(0, 1), cA + hsA, voffA);
        if (wr == 1) PG8_BAR;
        PG8_WAIT_V(2); PG8_BAR;
        PG8_STAGE(PG8_SB(1, 0), cB + kstep, voffB); PG8_STAGE(PG8_SA(1, 0), cA + kstepA, voffA); PG8_STAGE(PG8_SB(1, 1), cB + hsB + kstep, voffB);
        PG8_WAIT_V(6); PG8_BAR;
    } else {
        PG8_STAGE(PG8_SB(0, 0), cB, voffB); PG8_STAGE(PG8_SA(0, 0), cA, voffA); PG8_STAGE(PG8_SB(0, 1), cB + hsB, voffB); PG8_STAGE(PG8_SA(0, 1), cA + hsA, voffA);
        if (wr == 1) PG8_BAR;
        PG8_WAIT_V(4); PG8_BAR;
        PG8_STAGE(PG8_SB(1, 0), cB + kstep, voffB); PG8_STAGE(PG8_SA(1, 0), cA + kstepA, voffA); PG8_STAGE(PG8_SB(1, 1), cB + hsB + kstep, voffB);
        PG8_WAIT_V(6); PG8_BAR;
    }
    for (;;) {
        const char* nA = cA; const char* nB = cB; bool has_next;
        { Unit un; has_next = S.next(ui + 1, un); if (has_next) { nA = uni_ptr(un.a); nB = uni_ptr(un.b); } }
#pragma unroll 1
        for (int t = 0; t < nt; t += 2) {
            const bool last = (t == nt - 2);
            const char* a1 = cA + (size_t)(t + 1) * kstepA;
            const char* a2 = last ? nA : cA + (size_t)(t + 2) * kstepA; const char* b2 = last ? nB : cB + (size_t)(t + 2) * kstep;
            const char* a3 = a2 + kstepA; const char* b3 = b2 + kstep;
            if constexpr (SP2) {
            PG8_LDB(B0, 0, 0); PG8_LDB(B1, 0, 1); PG8_SCHED; PG8_LDA(At, 0, 0); PG8_STAGE(PG8_SA(1, 1), a1 + hsA, voffA);
            PG8_WAIT_V(8); PG8_WAIT_L(0); PG8_BAR; PG8_MMA(0, 0, At, B0); PG8_MMA(0, 1, At, B1); PG8_BAR; PG8_SCHED;
            PG8_LDA(At, 0, 1); PG8_STAGE(PG8_SB(0, 0), b2, voffB); PG8_STAGE(PG8_SB(0, 1), b2 + hsB, voffB); PG8_STAGE(PG8_SA(0, 0), a2, voffA);
            PG8_WAIT_V(8); PG8_WAIT_L(0); PG8_BAR; PG8_MMA(1, 0, At, B0); PG8_MMA(1, 1, At, B1); PG8_BAR; PG8_SCHED;
            PG8_LDB(B0, 1, 0); PG8_LDB(B1, 1, 1); PG8_SCHED; PG8_LDA(At, 1, 0); PG8_STAGE(PG8_SA(0, 1), a2 + hsA, voffA);
            PG8_WAIT_V(8); PG8_WAIT_L(0); PG8_BAR; PG8_MMA(0, 0, At, B0); PG8_MMA(0, 1, At, B1); PG8_BAR; PG8_SCHED;
            PG8_LDA(At, 1, 1); PG8_STAGE(PG8_SB(1, 0), b3, voffB); PG8_STAGE(PG8_SB(1, 1), b3 + hsB, voffB); PG8_STAGE(PG8_SA(1, 0), a3, voffA);
            PG8_WAIT_V(8); PG8_WAIT_L(0); PG8_BAR; PG8_MMA(1, 0, At, B0); PG8_MMA(1, 1, At, B1); PG8_BAR; PG8_SCHED;
            } else {
            PG8_LDB(B0, 0, 0); PG8_SCHED; PG8_LDA(At, 0, 0); PG8_STAGE(PG8_SA(1, 1), a1 + hsA, voffA);
            PG8_WAIT_L(8); PG8_BAR; PG8_WAIT_L(0); PG8_MMA(0, 0, At, B0); PG8_BAR; PG8_SCHED;
            PG8_LDB(B1, 0, 1); PG8_STAGE(PG8_SB(0, 0), b2, voffB);
            PG8_BAR; PG8_WAIT_L(0); PG8_MMA(0, 1, At, B1); PG8_BAR;
            PG8_LDA(At, 0, 1); PG8_STAGE(PG8_SA(0, 0), a2, voffA);
            PG8_BAR; PG8_WAIT_L(0); PG8_MMA(1, 0, At, B0); PG8_BAR; PG8_SCHED;
            PG8_STAGE(PG8_SB(0, 1), b2 + hsB, voffB);
            PG8_WAIT_V(6); PG8_BAR; PG8_MMA(1, 1, At, B1); PG8_BAR;
            PG8_LDB(B0, 1, 0); PG8_SCHED; PG8_LDA(At, 1, 0); PG8_STAGE(PG8_SA(0, 1), a2 + hsA, voffA);
            PG8_WAIT_L(8); PG8_BAR; PG8_WAIT_L(0); PG8_MMA(0, 0, At, B0); PG8_BAR; PG8_SCHED;
            PG8_LDB(B1, 1, 1); PG8_STAGE(PG8_SB(1, 0), b3, voffB);
            PG8_BAR; PG8_WAIT_L(0); PG8_MMA(0, 1, At, B1); PG8_BAR;
            PG8_LDA(At, 1, 1); PG8_STAGE(PG8_SA(1, 0), a3, voffA);
            PG8_BAR; PG8_WAIT_L(0); PG8_MMA(1, 0, At, B0); PG8_BAR; PG8_SCHED;
            PG8_STAGE(PG8_SB(1, 1), b3 + hsB, voffB);
            PG8_WAIT_V(6); PG8_BAR; PG8_MMA(1, 1, At, B1); PG8_BAR;
            }
        }
        if constexpr (ALIGN_EPI) { if (wr == 0) PG8_BAR; }
        { Unit uc; (void)S.next(ui, uc); E(acc, uc, wid); }
        if (!has_next) break;
#pragma unroll
        for (int a = 0; a < 2; ++a)
#pragma unroll
            for (int b = 0; b < 2; ++b)
#pragma unroll
                for (int m = 0; m < 4; ++m)
#pragma unroll
                    for (int n = 0; n < 2; ++n) acc[a][b][m][n] = (f32x4){0.f, 0.f, 0.f, 0.f};
        cA = nA; cB = nB; ++ui;
        if constexpr (ALIGN_EPI) { if (wr == 1) PG8_BAR; }
    }
    PG8_WAIT_V(0);
    if constexpr (!ALIGN_EPI) { if (wr == 0) PG8_BAR; }
    PG8_BAR;
#undef PG8_SA
#undef PG8_SB
#undef PG8_STAGE
#undef PG8_LDA
#undef PG8_LDB
#undef PG8_MMA
#undef PG8_LD8
#undef PG8_WAIT_V
#undef PG8_WAIT_L
#undef PG8_BAR
#undef PG8_SCHED
}

struct EpiStore {
    static constexpr bool PERM = true;
    __device__ __forceinline__ void operator()(const f32x4 (&acc)[2][2][4][2], const Unit& u, const int wid) const {
        int lane_; asm volatile("v_mbcnt_lo_u32_b32 %0, -1, 0\n\tv_mbcnt_hi_u32_b32 %0, -1, %0" : "=v"(lane_));
        const int wr = wid >> 2, wc = wid & 3, fr = lane_ & 15, fq = lane_ >> 4;
        bf16* base = (bf16*)u.o; int row0 = wr * 64 + fr, col0 = wc * 32 + 8 * fq; asm volatile("" : "+v"(row0), "+v"(col0)); const bool act = u.x0 != 0;
#pragma unroll
        for (int ai = 0; ai < 2; ++ai)
#pragma unroll
            for (int m = 0; m < 4; ++m) { bf16* rowp = base + (size_t)(row0 + ai * HALF + m * 16) * u.ldo + col0;
#pragma unroll
                for (int bj = 0; bj < 2; ++bj) { f32x4 v0 = acc[ai][bj][m][0], v1 = acc[ai][bj][m][1];
                    if (act) {
#pragma unroll
                        for (int j = 0; j < 4; ++j) { v0[j] = gelu_tanh_f(v0[j]); v1[j] = gelu_tanh_f(v1[j]); } }
                    v4u w; w.x = cvt_pk_bf16(v0[0], v0[1]); w.y = cvt_pk_bf16(v0[2], v0[3]); w.z = cvt_pk_bf16(v1[0], v1[1]); w.w = cvt_pk_bf16(v1[2], v1[3]);
                    *(v4u*)(rowp + bj * HALF) = w; } }
    }
};
struct EpiSwiGLU {
    static constexpr bool PERM = true;
    __device__ __forceinline__ void operator()(const f32x4 (&acc)[2][2][4][2], const Unit& u, const int wid) const {
        int lane_; asm volatile("v_mbcnt_lo_u32_b32 %0, -1, 0\n\tv_mbcnt_hi_u32_b32 %0, -1, %0" : "=v"(lane_));
        const int wr = wid >> 2, wc = wid & 3, fr = lane_ & 15, fq = lane_ >> 4;
        bf16* base = (bf16*)u.o; int row0 = wr * 64 + fr, col0 = wc * 32 + 8 * fq; asm volatile("" : "+v"(row0), "+v"(col0));
#pragma unroll
        for (int ai = 0; ai < 2; ++ai)
#pragma unroll
            for (int m = 0; m < 4; ++m) { bf16* rowp = base + (size_t)(row0 + ai * HALF + m * 16) * u.ldo + col0;
                f32x4 h0, h1;
#pragma unroll
                for (int j = 0; j < 4; ++j) { h0[j] = silu_f(acc[ai][0][m][0][j]) * acc[ai][1][m][0][j]; h1[j] = silu_f(acc[ai][0][m][1][j]) * acc[ai][1][m][1][j]; }
                v4u w; w.x = cvt_pk_bf16(h0[0], h0[1]); w.y = cvt_pk_bf16(h0[2], h0[3]); w.z = cvt_pk_bf16(h1[0], h1[1]); w.w = cvt_pk_bf16(h1[2], h1[3]);
                *(v4u*)rowp = w; }
    }
};
struct EpiSwiGLU8 {
    static constexpr bool PERM = true;
    __device__ __forceinline__ void operator()(const f32x4 (&acc)[2][2][4][2], const Unit& u, const int wid) const {
        int lane_; asm volatile("v_mbcnt_lo_u32_b32 %0, -1, 0\n\tv_mbcnt_hi_u32_b32 %0, -1, %0" : "=v"(lane_));
        const int wr = wid >> 2, wc = wid & 3, fr = lane_ & 15, fq = lane_ >> 4;
        unsigned char* base = (unsigned char*)u.o; int row0 = wr * 64 + fr, col0 = wc * 32 + 8 * fq; asm volatile("" : "+v"(row0), "+v"(col0));
        constexpr float SA = 1.0f / (Q_H * Q_W);
#pragma unroll
        for (int ai = 0; ai < 2; ++ai)
#pragma unroll
            for (int m = 0; m < 4; ++m) { unsigned char* rowp = base + (size_t)(row0 + ai * HALF + m * 16) * u.ldo + col0;
                float h0[4], h1[4];
#pragma unroll
                for (int j = 0; j < 4; ++j) { h0[j] = silu_f(acc[ai][0][m][0][j] * SA) * (acc[ai][1][m][0][j] * (SA * Q_HID)); h1[j] = silu_f(acc[ai][0][m][1][j] * SA) * (acc[ai][1][m][1][j] * (SA * Q_HID)); }
                v2u w; w.x = pk_fp8x4(h0[0], h0[1], h0[2], h0[3]); w.y = pk_fp8x4(h1[0], h1[1], h1[2], h1[3]);
                *(v2u*)rowp = w; }
    }
};
struct EpiStoreQ {
    static constexpr bool PERM = true;
    __device__ __forceinline__ void operator()(const f32x4 (&acc)[2][2][4][2], const Unit& u, const int wid) const {
        int lane_; asm volatile("v_mbcnt_lo_u32_b32 %0, -1, 0\n\tv_mbcnt_hi_u32_b32 %0, -1, %0" : "=v"(lane_));
        const int wr = wid >> 2, wc = wid & 3, fr = lane_ & 15, fq = lane_ >> 4;
        bf16* base = (bf16*)u.o; int row0 = wr * 64 + fr, col0 = wc * 32 + 8 * fq; asm volatile("" : "+v"(row0), "+v"(col0));
        constexpr float SA = 1.0f / (Q_HID * Q_W);
#pragma unroll
        for (int ai = 0; ai < 2; ++ai)
#pragma unroll
            for (int m = 0; m < 4; ++m) { bf16* rowp = base + (size_t)(row0 + ai * HALF + m * 16) * u.ldo + col0;
#pragma unroll
                for (int bj = 0; bj < 2; ++bj) { const f32x4 v0 = acc[ai][bj][m][0] * SA, v1 = acc[ai][bj][m][1] * SA;
                    v4u w; w.x = cvt_pk_bf16(v0[0], v0[1]); w.y = cvt_pk_bf16(v0[2], v0[3]); w.z = cvt_pk_bf16(v1[0], v1[1]); w.w = cvt_pk_bf16(v1[2], v1[3]);
                    *(v4u*)(rowp + bj * HALF) = w; } }
    }
};
struct EpiResid {
    static constexpr bool PERM = false;
    __device__ __forceinline__ void operator()(const f32x4 (&acc)[2][2][4][2], const Unit& u, const int wid) const {
        int lane_; asm volatile("v_mbcnt_lo_u32_b32 %0, -1, 0\n\tv_mbcnt_hi_u32_b32 %0, -1, %0" : "=v"(lane_));
        const int wr = wid >> 2, wc = wid & 3, fr = lane_ & 15, fq = lane_ >> 4;
        const float* xs = (const float*)u.p0; float* zo = (float*)u.o; const float* gv = (const float*)u.p1;
        int row0 = wr * 64 + fr, col0 = wc * 32 + 4 * fq; asm volatile("" : "+v"(row0), "+v"(col0));
#pragma unroll
        for (int ai = 0; ai < 2; ++ai)
#pragma unroll
            for (int m = 0; m < 4; ++m) { const size_t off = (size_t)(row0 + ai * HALF + m * 16) * D + col0;
#pragma unroll
                for (int bj = 0; bj < 2; ++bj)
#pragma unroll
                    for (int n = 0; n < 2; ++n) { const f32x4 xv = *(const f32x4*)(xs + off + bj * HALF + n * 16); const f32x4 gvv = *(const f32x4*)(gv + col0 + bj * HALF + n * 16);
                        *(f32x4*)(zo + off + bj * HALF + n * 16) = xv * ALPHA + gvv * acc[ai][bj][m][n]; }
                asm volatile("" ::: "memory"); }
    }
};
struct EpiGLU {
    static constexpr bool PERM = true;
    __device__ __forceinline__ void operator()(const f32x4 (&acc)[2][2][4][2], const Unit& u, const int wid) const {
        int lane_; asm volatile("v_mbcnt_lo_u32_b32 %0, -1, 0\n\tv_mbcnt_hi_u32_b32 %0, -1, %0" : "=v"(lane_));
        const int wr = wid >> 2, wc = wid & 3, fr = lane_ & 15, fq = lane_ >> 4;
        bf16* base = (bf16*)u.o; const bf16* gp = (const bf16*)u.p0; const float* bias = (const float*)u.p1;
        int row0 = wr * 64 + fr, col0 = wc * 32 + 8 * fq; asm volatile("" : "+v"(row0), "+v"(col0));
#pragma unroll
        for (int ai = 0; ai < 2; ++ai)
#pragma unroll
            for (int m = 0; m < 4; ++m) { const int r = row0 + ai * HALF + m * 16;
#pragma unroll
                for (int bj = 0; bj < 2; ++bj) { const v4u gw = *(const v4u*)(gp + (size_t)r * u.x0 + col0 + bj * HALF);
                    const f32x4 b0 = *(const f32x4*)(bias + col0 + bj * HALF), b1 = *(const f32x4*)(bias + col0 + bj * HALF + 4);
                    const f32x4 a0 = acc[ai][bj][m][0] + b0, a1 = acc[ai][bj][m][1] + b1;
                    const float o0 = bflo(gw.x) * sigmoid_f(a0[0]), o1 = bfhi(gw.x) * sigmoid_f(a0[1]), o2 = bflo(gw.y) * sigmoid_f(a0[2]), o3 = bfhi(gw.y) * sigmoid_f(a0[3]);
                    const float o4 = bflo(gw.z) * sigmoid_f(a1[0]), o5 = bfhi(gw.z) * sigmoid_f(a1[1]), o6 = bflo(gw.w) * sigmoid_f(a1[2]), o7 = bfhi(gw.w) * sigmoid_f(a1[3]);
                    v4u w; w.x = cvt_pk_bf16(o0, o1); w.y = cvt_pk_bf16(o2, o3); w.z = cvt_pk_bf16(o4, o5); w.w = cvt_pk_bf16(o6, o7);
                    *(v4u*)(base + (size_t)r * u.ldo + col0 + bj * HALF) = w; }
                asm volatile("" ::: "memory"); }
    }
};
struct EpiS5B {
    static constexpr bool PERM = true;
    __device__ __forceinline__ void operator()(const f32x4 (&acc)[2][2][4][2], const Unit& u, const int wid) const {
        int lane_; asm volatile("v_mbcnt_lo_u32_b32 %0, -1, 0\n\tv_mbcnt_hi_u32_b32 %0, -1, %0" : "=v"(lane_));
        const int wr = wid >> 2, wc = wid & 3, fr = lane_ & 15, fq = lane_ >> 4;
        bf16* base = (bf16*)u.o; const bf16* y1 = (const bf16*)u.p0;
        int row0 = wr * 64 + fr, col0 = wc * 32 + 8 * fq; asm volatile("" : "+v"(row0), "+v"(col0));
#pragma unroll
        for (int ai = 0; ai < 2; ++ai)
#pragma unroll
            for (int m = 0; m < 4; ++m) { const int r = row0 + ai * HALF + m * 16;
#pragma unroll
                for (int bj = 0; bj < 2; ++bj) { const int c = col0 + bj * HALF; const v4u yw = *(const v4u*)(y1 + (size_t)r * 8192 + c);
                    const f32x4 a0 = acc[ai][bj][m][0], a1 = acc[ai][bj][m][1];
                    const float o0 = gelu_tanh_f(a0[0] + bflo(yw.x)), o1 = gelu_tanh_f(a0[1] + bfhi(yw.x)), o2 = gelu_tanh_f(a0[2] + bflo(yw.y)), o3 = gelu_tanh_f(a0[3] + bfhi(yw.y));
                    const float o4 = gelu_tanh_f(a1[0] + bflo(yw.z)), o5 = gelu_tanh_f(a1[1] + bfhi(yw.z)), o6 = gelu_tanh_f(a1[2] + bflo(yw.w)), o7 = gelu_tanh_f(a1[3] + bfhi(yw.w));
                    v4u w; w.x = cvt_pk_bf16(o0, o1); w.y = cvt_pk_bf16(o2, o3); w.z = cvt_pk_bf16(o4, o5); w.w = cvt_pk_bf16(o6, o7);
                    *(v4u*)(base + ((size_t)r * 16 + (c >> 4)) * 1536 + (c & 15)) = w; }
                asm volatile("" ::: "memory"); }
    }
};
}

struct Params { const float* in[32]; float* out; unsigned char* ws; int ph_lo, ph_hi; };
enum { I_X = 0, I_C, I_CTX, I_CCTX, I_WMOD, I_BMOD, I_LNG, I_LNB, I_EV_WIN, I_EV_WOUT, I_EV_SINK, I_EV_W1, I_EV_W3, I_EV_W2, I_OD_WIN, I_A_RE, I_A_IM, I_LOG_DT,
       I_B_RE, I_B_IM, I_C_RE, I_C_IM, I_SSM_D, I_WGLU, I_BGLU, I_WS, I_BS, I_OD_WOUT, I_ROUTER, I_MW1, I_MW3, I_MW2 };

constexpr int LDS_RING = 131072, LDS_MISC = LDS_RING + 320, LDS_BYTES = 147456;
constexpr int NWAVES = 8, NTHREADS = 512;

struct Frame {
    LAS unsigned char* lds;
    int tid, lane, wave, G, bid, gw, NGW;
    unsigned char* ws;
    unsigned* ctl;
};

using pg8::Unit;
struct SchedStd {
    int nN, nUnits, G, c; const char* A; const char* B; char* O; size_t aStep, bStep, oRow, oCol; int ldo, act_from;
    __device__ __forceinline__ bool next(int i, Unit& u) const {
        const int L = i * G + c; if (L >= nUnits) return false;
        const int pm = L / nN, pn = L - pm * nN;
        u.a = A + (size_t)pm * aStep; u.b = B + (size_t)pn * bStep; u.o = O + (size_t)pm * oRow + (size_t)pn * oCol; u.p0 = nullptr; u.p1 = nullptr; u.ldo = ldo; u.x0 = (pn >= act_from) ? 1 : 0; return true;
    }
};
struct SchedEvIn {
    int G, c; const char* H; const char* Wqkv; const char* Wpq; char* QKV; char* PQT; char* PQTC;
    __device__ __forceinline__ bool next(int i, Unit& u) const {
        int L = i * G + c; u.p0 = nullptr; u.p1 = nullptr; u.x0 = 0;
        constexpr int NQ = (T / 256) * 3, NP = 4 * (TL / 256), NPC = 4 * (TC / 256);
        if (L < NQ) { const int pm = L / 3, pn = L - pm * 3;
            u.a = H + (size_t)pm * 256 * D * 2; u.b = Wqkv + (size_t)pn * 256 * D * 2; u.o = QKV + ((size_t)pm * 256 * 768 + pn * 256) * 2; u.ldo = 768; return true; }
        L -= NQ;
        if (L < NP) { const int tt = L >> 2, pm = L & 3, b = tt >> 4, n0 = (tt & 15) * 256, isq = pm >> 1, ch0 = (pm & 1) * 256;
            u.a = Wpq + (size_t)pm * 256 * D * 2; u.b = H + (size_t)tt * 256 * D * 2;
            u.o = PQT + ((((size_t)b * 512 + ch0) * 2 + isq) * 4096 + n0) * 2; u.ldo = 8192; return true; }
        L -= NP;
        if (L < NPC) { const int b = L >> 2, pm = L & 3, isq = pm >> 1, ch0 = (pm & 1) * 256;
            u.a = Wpq + (size_t)pm * 256 * D * 2; u.b = H + ((size_t)TL + (size_t)b * 256) * D * 2;
            u.o = PQTC + (((size_t)b * 512 + ch0) * 2 + isq) * 256 * 2; u.ldo = 512; return true; }
        return false;
    }
};
struct SchedDft {
    int G, c; const char* F; const char* PQT; char* MIX;
    __device__ __forceinline__ bool next(int i, Unit& u) const {
        const int L = i * G + c; if (L >= 512) return false;
        const int b = L >> 5, r = L & 31, pm = r >> 1, pn = r & 1;
        u.a = F + (size_t)pm * 256 * 8192 * 2; u.b = PQT + ((size_t)b * 512 + pn * 256) * 8192 * 2;
        u.o = MIX + (((size_t)b * 4096 + pm * 256) * D + pn * 256) * 2; u.p0 = nullptr; u.p1 = nullptr; u.ldo = D; u.x0 = 0; return true;
    }
};
struct SchedDftC {
    int G, c; const char* F; const char* PQTC; char* MIX;
    __device__ __forceinline__ bool next(int i, Unit& u) const {
        const int L = i * G + (G - 1 - c); if (L >= 32) return false;
        const int b = L >> 1, pn = L & 1;
        u.a = F; u.b = PQTC + ((size_t)b * 512 + pn * 256) * 512 * 2;
        u.o = MIX + (((size_t)TL + (size_t)b * 256) * D + pn * 256) * 2; u.p0 = nullptr; u.p1 = nullptr; u.ldo = D; u.x0 = 0; return true;
    }
};
struct SchedResid {
    int G, c, nUnits; const char* A; size_t aStep; const char* W; size_t bStep; const float* xl; const float* xc; float* zl; float* zc; const float* gate;
    __device__ __forceinline__ bool next(int i, Unit& u) const {
        const int L = i * G + c; if (L >= nUnits) return false;
        const int pm = L >> 2, pn = L & 3;
        u.a = A + (size_t)pm * aStep; u.b = W + (size_t)pn * bStep;
        const bool isc = pm >= TL / 256; const int pr = isc ? pm - TL / 256 : pm; const int mrow = isc ? 16 : (pm >> 4);
        const size_t off = ((size_t)pr * 256 * D + pn * 256);
        u.p0 = (const char*)((isc ? xc : xl) + off); u.o = (char*)((isc ? zc : zl) + off); u.p1 = (const char*)(gate + (size_t)mrow * 6144 + pn * 256); u.ldo = D; u.x0 = 0; return true;
    }
};
struct SchedGlu {
    int G, c; const char* P; const char* W; char* MIX; const float* bias;
    __device__ __forceinline__ bool next(int i, Unit& u) const {
        const int L = i * G + c; if (L >= (T / 256) * 2) return false;
        const int pm = L >> 1, pn = L & 1;
        u.a = P + (size_t)pm * 256 * 1536 * 2; u.b = W + (size_t)pn * 256 * 512 * 2; u.o = MIX + ((size_t)pm * 256 * D + pn * 256) * 2;
        u.p0 = P + ((size_t)pm * 256 * 1536 + pn * 256) * 2; u.p1 = (const char*)(bias + pn * 256); u.ldo = D; u.x0 = 1536; return true;
    }
};
struct SchedS5A {
    int G, c; const char* P; const char* WA; char* Y1; char* HB;
    __device__ __forceinline__ bool next(int i, Unit& u) const {
        const int L = i * G + c; if (L >= 32 * 34) return false;
        const int g = L / 34, rem = L - g * 34, pm = rem >> 1, pn = rem & 1;
        u.a = P + ((size_t)pm * 256 * 16 * 1536 + g * 16) * 2; u.b = WA + (size_t)g * S5M_STRIDE + (size_t)pn * 256 * 256 * 2;
        u.o = (pn ? HB : Y1) + (((size_t)pm * 256 * 32 + g) * 256) * 2; u.p0 = nullptr; u.p1 = nullptr; u.ldo = 8192; u.x0 = 0; return true;
    }
};
struct SchedS5B {
    int G, c; const char* HB; const char* CL; const char* Y1; char* P;
    __device__ __forceinline__ bool next(int i, Unit& u) const {
        const int L = i * G + c; if (L >= 32 * 17) return false;
        const int g = L / 17, pm = L - g * 17;
        const size_t toff = (((size_t)pm * 256 * 32 + g) * 256) * 2;
        u.a = HB + toff; u.b = CL + (size_t)g * S5M_STRIDE; u.p0 = Y1 + toff; u.o = P + ((size_t)pm * 256 * 16 * 1536 + g * 16) * 2; u.p1 = nullptr; u.ldo = 0; u.x0 = 0; return true;
    }
};
struct SchedMoeUp {
    int G, c, nUnits, rt0; int toff[9]; const char* HS; const char* W; char* HID;
    __device__ __forceinline__ bool next(int i, Unit& u) const {
        const int L = i * G + c; if (L >= nUnits) return false;
        const int rl = L / 28, pn = L - rl * 28, rt = rt0 + rl; int e = 0;
#pragma unroll
        for (int k = 1; k < 8; ++k) e += (rt >= toff[k]) ? 1 : 0;
        u.a = HS + (size_t)rt * 256 * D; u.b = W + ((size_t)e * 7168 + pn * 256) * D; u.o = HID + ((size_t)rl * 256 * EH + pn * 128);
        u.p0 = nullptr; u.p1 = nullptr; u.ldo = EH; u.x0 = 0; return true;
    }
};
struct SchedMoeDown {
    int G, c, nUnits, rt0; int toff[9]; const char* HID; const char* W; char* Y;
    __device__ __forceinline__ bool next(int i, Unit& u) const {
        const int L = i * G + c; if (L >= nUnits) return false;
        const int rl = L >> 2, pn = L & 3, rt = rt0 + rl; int e = 0;
#pragma unroll
        for (int k = 1; k < 8; ++k) e += (rt >= toff[k]) ? 1 : 0;
        u.a = HID + (size_t)rl * 256 * EH; u.b = W + ((size_t)e * 1024 + pn * 256) * EH; u.o = Y + ((size_t)rt * 256 * D + pn * 256) * 2;
        u.p0 = nullptr; u.p1 = nullptr; u.ldo = D; u.x0 = 0; return true;
    }
};

__device__ __forceinline__ void tr_item(const float* W, int ldn, bf16* WT, int ldk, int k0, int n0, int drow0, LAS float* scr, int lane) {
#pragma unroll 8
    for (int i = 0; i < 32; ++i) { const int kk = 2 * i + (lane >> 5); scr[kk * 33 + (lane & 31)] = W[(size_t)(k0 + kk) * ldn + n0 + (lane & 31)]; }
    LDS_WAIT(); asm volatile("" ::: "memory");
    const int c = lane & 7;
#pragma unroll
    for (int j = 0; j < 4; ++j) { const int n = (lane >> 3) + 8 * j; const LAS float* s = scr + (8 * c) * 33 + n;
        v4u o; o.x = cvt_pk_bf16(s[0 * 33], s[1 * 33]); o.y = cvt_pk_bf16(s[2 * 33], s[3 * 33]); o.z = cvt_pk_bf16(s[4 * 33], s[5 * 33]); o.w = cvt_pk_bf16(s[6 * 33], s[7 * 33]);
        *(v4u*)(WT + (size_t)(drow0 + n) * ldk + k0 + 8 * c) = o; }
    LDS_WAIT(); asm volatile("" ::: "memory");
}
__device__ __forceinline__ void tr_item8(const float* W, int ldn, unsigned char* WT, int ldk, int k0, int n0, int drow0, LAS float* scr, int lane, float qs) {
#pragma unroll 8
    for (int i = 0; i < 32; ++i) { const int kk = 2 * i + (lane >> 5); scr[kk * 33 + (lane & 31)] = W[(size_t)(k0 + kk) * ldn + n0 + (lane & 31)] * qs; }
    LDS_WAIT(); asm volatile("" ::: "memory");
    const int c = lane & 7;
#pragma unroll
    for (int j = 0; j < 4; ++j) { const int n = (lane >> 3) + 8 * j; const LAS float* sp = scr + (8 * c) * 33 + n;
        v2u o; o.x = pk_fp8x4(sp[0 * 33], sp[1 * 33], sp[2 * 33], sp[3 * 33]); o.y = pk_fp8x4(sp[4 * 33], sp[5 * 33], sp[6 * 33], sp[7 * 33]);
        *(v2u*)(WT + (size_t)(drow0 + n) * ldk + k0 + 8 * c) = o; }
    LDS_WAIT(); asm volatile("" ::: "memory");
}
__device__ __forceinline__ void tr_job8(const float* W, int ldn, int N, unsigned char* WT, int ldk, int mode, int roff, int item, LAS float* scr, int lane) {
    const int nblk = N / 32, kb = item / nblk, nb = item - kb * nblk, n0 = nb * 32;
    const int drow0 = mode ? ((n0 >> 7) * 256 + (n0 & 127) + roff) : (roff + n0);
    tr_item8(W, ldn, WT, ldk, kb * 64, n0, drow0, scr, lane, Q_W);
}
__device__ __forceinline__ void tr_job(const float* W, int ldn, int N, bf16* WT, int ldk, int mode, int roff, int item, LAS float* scr, int lane) {
    const int nblk = N / 32, kb = item / nblk, nb = item - kb * nblk, n0 = nb * 32;
    const int drow0 = mode ? ((n0 >> 7) * 256 + (n0 & 127) + roff) : (roff + n0);
    tr_item(W, ldn, WT, ldk, kb * 64, n0, drow0, scr, lane);
}
__device__ __forceinline__ void cvt_item(const Params& p, int r, LAS float* scr, int lane) {
    unsigned char* ws = p.ws;
    constexpr int EV_ITEMS = 384 + 512 + 3 * 1408;
    constexpr int ODS_ITEMS = 768 + 128 + 512;
    constexpr int EXP_ITEMS = 3 * 1792, MOE_ITEMS = 8 * EXP_ITEMS;
    if (r < 2 * EV_ITEMS) { const int li = r / EV_ITEMS; r -= li * EV_ITEMS; unsigned char* base = ws + WS_EV + li * EV_STRIDE;
        if (r < 384) { tr_job(p.in[I_EV_WIN] + (size_t)li * D * 1280 + 512, 1280, 768, (bf16*)(base + EV_WQKV), D, 0, 0, r, scr, lane); return; } r -= 384;
        if (r < 512) { tr_job(p.in[I_EV_WOUT] + (size_t)li * D * D, D, D, (bf16*)(base + EV_WOUT), D, 0, 0, r, scr, lane); return; } r -= 512;
        if (r < 1408) { tr_job(p.in[I_EV_W1] + (size_t)li * D * FFH, FFH, FFH, (bf16*)(base + EV_W13), D, 1, 0, r, scr, lane); return; } r -= 1408;
        if (r < 1408) { tr_job(p.in[I_EV_W3] + (size_t)li * D * FFH, FFH, FFH, (bf16*)(base + EV_W13), D, 1, 128, r, scr, lane); return; } r -= 1408;
        tr_job(p.in[I_EV_W2] + (size_t)li * FFH * D, D, D, (bf16*)(base + EV_W2), FFH, 0, 0, r, scr, lane); return; }
    r -= 2 * EV_ITEMS;
    if (r < 2 * ODS_ITEMS) { const int li = r / ODS_ITEMS; r -= li * ODS_ITEMS; unsigned char* base = ws + WS_OD + li * OD_STRIDE;
        if (r < 768) { tr_job(p.in[I_OD_WIN] + (size_t)li * D * 1536, 1536, 1536, (bf16*)(base + OD_WIN), D, 0, 0, r, scr, lane); return; } r -= 768;
        if (r < 128) { tr_job(p.in[I_WGLU] + (size_t)li * 512 * 512, 512, 512, (bf16*)(base + OD_WGLU), 512, 0, 0, r, scr, lane); return; } r -= 128;
        tr_job(p.in[I_OD_WOUT] + (size_t)li * D * D, D, D, (bf16*)(base + OD_WOUT), D, 0, 0, r, scr, lane); return; }
    r -= 2 * ODS_ITEMS;
    { const int li = r / MOE_ITEMS; r -= li * MOE_ITEMS; const int e = r / EXP_ITEMS; r -= e * EXP_ITEMS; unsigned char* base = ws + WS_OD + li * OD_STRIDE;
        const size_t we = (size_t)li * NEXP + e;
        if (r < 1792) { tr_job8(p.in[I_MW1] + we * D * EH, EH, EH, (unsigned char*)(base + OD_MW13) + (size_t)e * 7168 * D, D, 1, 0, r, scr, lane); return; } r -= 1792;
        if (r < 1792) { tr_job8(p.in[I_MW3] + we * D * EH, EH, EH, (unsigned char*)(base + OD_MW13) + (size_t)e * 7168 * D, D, 1, 128, r, scr, lane); return; } r -= 1792;
        tr_job8(p.in[I_MW2] + we * EH * D, D, D, (unsigned char*)(base + OD_MW2) + (size_t)e * D * EH, EH, 0, 0, r, scr, lane); }
}
constexpr int CVT_ITEMS = 2 * 5120 + 2 * 1408 + 2 * 8 * 3 * 1792;

__device__ __forceinline__ void fold_unit(const Params& p, Frame& F, int unit) {
    const int li = unit >> 6, g = (unit >> 4) & 3, k0 = (unit & 15) * 64;
    LAS float* tile = (LAS float*)F.lds;
    LAS float* trig = tile + 64 * 129;
    const float* W = p.in[I_EV_WIN] + (size_t)li * D * 1280;
    for (int e = F.tid; e < 64 * 128; e += NTHREADS) { const int k = e >> 7, c = e & 127; tile[k * 129 + c] = W[(size_t)(k0 + k) * 1280 + g * 128 + c]; }
    if (F.tid < 128) { float s, c; sincospif((float)F.tid / 64.0f, &s, &c); trig[F.tid] = c * 0.08838834764831845f; trig[128 + F.tid] = s * 0.08838834764831845f; }
    __syncthreads();
    bf16* WT = (bf16*)(p.ws + WS_EV + li * EV_STRIDE + EV_WPQ);
    const int k = F.lane, mg = F.wave;
    for (int mm = 0; mm < 16; ++mm) { const int m = mg * 16 + mm; float sp = 0.f, sq = 0.f;
        for (int c = 0; c < 128; ++c) { const float w = tile[k * 129 + c]; const int ph = (m * c) & 127; sp += w * trig[ph]; sq += w * trig[128 + ph]; }
        WT[(size_t)(g * 128 + m) * D + k0 + k] = f2bf(sp); WT[(size_t)(512 + g * 128 + m) * D + k0 + k] = f2bf(sq); }
    __syncthreads();
}

__device__ __forceinline__ void row_load(const float* row, int lane, f32x4 (&v)[4]) {
#pragma unroll
    for (int j = 0; j < 4; ++j) v[j] = *(const f32x4*)(row + 256 * j + 4 * lane);
}
__device__ __forceinline__ void row_store(float* row, int lane, const f32x4 (&v)[4]) {
#pragma unroll
    for (int j = 0; j < 4; ++j) *(f32x4*)(row + 256 * j + 4 * lane) = v[j];
}
__device__ __forceinline__ void row_store_bf16(bf16* row, int lane, const f32x4 (&v)[4]) {
#pragma unroll
    for (int j = 0; j < 4; ++j) { v2u w; w.x = cvt_pk_bf16(v[j][0], v[j][1]); w.y = cvt_pk_bf16(v[j][2], v[j][3]); *(v2u*)(row + 256 * j + 4 * lane) = w; }
}
__device__ __forceinline__ void row_layernorm(f32x4 (&v)[4], const float* g, const float* b, int lane) {
    float s = 0.f;
#pragma unroll
    for (int j = 0; j < 4; ++j) s += (v[j][0] + v[j][1]) + (v[j][2] + v[j][3]);
    const float mean = wave_sum(s) * (1.f / D); float q = 0.f;
#pragma unroll
    for (int j = 0; j < 4; ++j) { v[j] = v[j] - mean; q += (v[j][0] * v[j][0] + v[j][1] * v[j][1]) + (v[j][2] * v[j][2] + v[j][3] * v[j][3]); }
    const float rstd = rsqrtf(wave_sum(q) * (1.f / D) + LN_EPS);
#pragma unroll
    for (int j = 0; j < 4; ++j) { const f32x4 gg = *(const f32x4*)(g + 256 * j + 4 * lane), bb = *(const f32x4*)(b + 256 * j + 4 * lane); v[j] = v[j] * rstd * gg + bb; }
}
__device__ __forceinline__ void row_modulate(f32x4 (&h)[4], const f32x4 (&v)[4], const float* sc, const float* sh, int lane) {
#pragma unroll
    for (int j = 0; j < 4; ++j) { const f32x4 s = *(const f32x4*)(sc + 256 * j + 4 * lane), t = *(const f32x4*)(sh + 256 * j + 4 * lane); h[j] = v[j] * (s + 1.0f) + t; }
}

__device__ __forceinline__ void row_ln_pre(f32x4 (&v)[4], const f32x4 (&gg)[4], const f32x4 (&bb)[4]) {
    float s = 0.f;
#pragma unroll
    for (int j = 0; j < 4; ++j) s += (v[j][0] + v[j][1]) + (v[j][2] + v[j][3]);
    const float mean = wave_sum(s) * (1.f / D); float q = 0.f;
#pragma unroll
    for (int j = 0; j < 4; ++j) { v[j] = v[j] - mean; q += (v[j][0] * v[j][0] + v[j][1] * v[j][1]) + (v[j][2] * v[j][2] + v[j][3] * v[j][3]); }
    const float rstd = rsqrtf(wave_sum(q) * (1.f / D) + LN_EPS);
#pragma unroll
    for (int j = 0; j < 4; ++j) v[j] = v[j] * rstd * gg[j] + bb[j];
}
__device__ __forceinline__ void row_load_mod(const float* sc, const float* sh, int lane, f32x4 (&s)[4], f32x4 (&t)[4]) {
#pragma unroll
    for (int j = 0; j < 4; ++j) { s[j] = *(const f32x4*)(sc + 256 * j + 4 * lane); t[j] = *(const f32x4*)(sh + 256 * j + 4 * lane); }
}
typedef const __attribute__((address_space(4))) Params* PP;
#define PIN(i) ((const float*)pp->in[i])
#define DECL_LDS extern __shared__ __attribute__((aligned(16))) unsigned char lds_raw[]
#define PHASE_FN static __device__ __forceinline__ void

__device__ __forceinline__ Frame make_frame(PP pp, unsigned char* lds_generic) {
    Frame F;
    F.lds = (LAS unsigned char*)lds_generic;
    { int t_ = threadIdx.x; asm volatile("" : "+v"(t_)); F.tid = t_; }
    F.lane = F.tid & 63; F.wave = __builtin_amdgcn_readfirstlane(F.tid >> 6);
    F.G = gridDim.x; F.bid = blockIdx.x; F.gw = F.bid * NWAVES + F.wave; F.NGW = F.G * NWAVES;
    F.ws = (unsigned char*)pp->ws; F.ctl = (unsigned*)(F.ws + WS_CTL);
    return F;
}
#define FRAME() DECL_LDS; asm volatile("" : "+s"(pp)); Frame F = make_frame(pp, lds_raw); unsigned char* ws = F.ws; (void)ws

PHASE_FN grid_bar(PP pp) {
    FRAME();
    XcdBarrier bar; bar.bar = F.ctl + CW_BAR; bar.x = xb_xcc_id(); bar.st = (volatile LAS unsigned*)(F.lds + LDS_MISC) + 8;
    xcd_barrier(bar);
}

static __device__ __forceinline__ void ln_pass(const Frame& F, float* out, float* XC, bf16* Hb, const float* lng, const float* lnb, const float* modv, const int sc_off, const int sh_off, const int TR) {
    f32x4 gg[4], bb[4];
#pragma unroll
    for (int j = 0; j < 4; ++j) { gg[j] = *(const f32x4*)(lng + 256 * j + 4 * F.lane); bb[j] = *(const f32x4*)(lnb + 256 * j + 4 * F.lane); }
    for (int r0 = F.gw; r0 < TR; r0 += 2 * F.NGW) {
        const int r1 = r0 + F.NGW; const bool two = r1 < TR;
        const bool c0 = r0 >= TL, c1 = r1 >= TL;
        float* x0 = c0 ? XC + (size_t)(r0 - TL) * D : out + (size_t)r0 * D; float* x1 = two ? (c1 ? XC + (size_t)(r1 - TL) * D : out + (size_t)r1 * D) : x0;
        const float* m0 = modv + (size_t)(c0 ? 16 : (r0 >> 12)) * 6144; const float* m1 = modv + (size_t)((two && !c1) ? (r1 >> 12) : 16) * 6144;
        f32x4 v0[4], v1[4], s0[4], t0[4], s1[4], t1[4];
        row_load(x0, F.lane, v0); row_load(x1, F.lane, v1);
        row_load_mod(m0 + sc_off, m0 + sh_off, F.lane, s0, t0); row_load_mod(m1 + sc_off, m1 + sh_off, F.lane, s1, t1);
        row_ln_pre(v0, gg, bb); row_ln_pre(v1, gg, bb);
        row_store(x0, F.lane, v0);
#pragma unroll
        for (int j = 0; j < 4; ++j) s0[j] = v0[j] * (s0[j] + 1.0f) + t0[j];
        row_store_bf16(Hb + (size_t)r0 * D, F.lane, s0);
        if (two) { row_store(x1, F.lane, v1);
#pragma unroll
            for (int j = 0; j < 4; ++j) s1[j] = v1[j] * (s1[j] + 1.0f) + t1[j];
            row_store_bf16(Hb + (size_t)r1 * D, F.lane, s1); }
    }
}
PHASE_FN ph_fold(PP pp) {
    FRAME();
    Params p; p.ws = ws; p.in[I_EV_WIN] = PIN(I_EV_WIN);
    for (int u = F.bid; u < 128; u += F.G) fold_unit(p, F, u);
}
PHASE_FN ph_mod(PP pp) {
    FRAME();
    float* MOD = (float*)(ws + WS_MOD);
    LAS float* sc = (LAS float*)F.lds;
    const float* cin = PIN(I_C); const float* ccin = PIN(I_CCTX);
    for (int e = F.tid; e < 17 * D; e += NTHREADS) { const int r = e >> 10, k = e & 1023; const float v = (r < 16) ? cin[r * D + k] : ccin[k]; sc[e] = silu_f(v); }
    __syncthreads();
    for (int grp = F.gw; grp < DEPTH * 6144 / 64; grp += F.NGW) {
        const int col = grp * 64 + F.lane, l = col / 6144, j = col - l * 6144;
        const float* W = PIN(I_WMOD) + (size_t)l * D * 6144 + j;
        float acc[17];
#pragma unroll
        for (int r = 0; r < 17; ++r) acc[r] = 0.f;
        for (int k = 0; k < D; k += 4) {
            const float w0 = W[(size_t)(k + 0) * 6144], w1 = W[(size_t)(k + 1) * 6144], w2 = W[(size_t)(k + 2) * 6144], w3 = W[(size_t)(k + 3) * 6144];
#pragma unroll
            for (int r = 0; r < 17; ++r) { const f32x4 s = *(const LAS f32x4*)(sc + r * D + k); acc[r] += s[0] * w0 + s[1] * w1 + s[2] * w2 + s[3] * w3; }
        }
        const float bm = PIN(I_BMOD)[l * 6144 + j];
#pragma unroll
        for (int r = 0; r < 17; ++r) MOD[((size_t)l * 17 + r) * 6144 + j] = acc[r] + bm;
    }
    __syncthreads();
}
PHASE_FN ph_cvt(PP pp) {
    FRAME();
    Params p; p.ws = ws;
    p.in[I_EV_WIN] = PIN(I_EV_WIN); p.in[I_EV_WOUT] = PIN(I_EV_WOUT); p.in[I_EV_W1] = PIN(I_EV_W1); p.in[I_EV_W3] = PIN(I_EV_W3); p.in[I_EV_W2] = PIN(I_EV_W2);
    p.in[I_OD_WIN] = PIN(I_OD_WIN); p.in[I_WGLU] = PIN(I_WGLU); p.in[I_OD_WOUT] = PIN(I_OD_WOUT); p.in[I_MW1] = PIN(I_MW1); p.in[I_MW3] = PIN(I_MW3); p.in[I_MW2] = PIN(I_MW2);
    LAS float* scr = (LAS float*)(F.lds + F.wave * 16384);
    for (int it = F.gw; it < CVT_ITEMS; it += F.NGW) cvt_item(p, it, scr, F.lane);
}
PHASE_FN ph_dftmat(PP pp) {
    FRAME();
    bf16* F4 = (bf16*)(ws + WS_F4096);
    for (int it = F.bid * NTHREADS + F.tid; it < 4096 * 1024; it += F.G * NTHREADS) {
        const int k = it >> 10, n0 = (it & 1023) * 8; const bool isq = n0 >= 4096; const int nb = n0 & 4095;
        float v[8];
#pragma unroll
        for (int j = 0; j < 8; ++j) { const int phs = (k * (nb + j)) & 4095; float s, c; sincospif((float)phs * (1.0f / 2048.0f), &s, &c); v[j] = isq ? -s * (1.f / 64.f) : c * (1.f / 64.f); }
        v4u w; w.x = cvt_pk_bf16(v[0], v[1]); w.y = cvt_pk_bf16(v[2], v[3]); w.z = cvt_pk_bf16(v[4], v[5]); w.w = cvt_pk_bf16(v[6], v[7]);
        *(v4u*)(F4 + (size_t)k * 8192 + n0) = w;
    }
    bf16* F2 = (bf16*)(ws + WS_F256);
    for (int it = F.bid * NTHREADS + F.tid; it < 256 * 64; it += F.G * NTHREADS) {
        const int k = it >> 6, n0 = (it & 63) * 8; const bool isq = n0 >= 256; const int nb = n0 & 255;
        float v[8];
#pragma unroll
        for (int j = 0; j < 8; ++j) { const int phs = (k * (nb + j)) & 255; float s, c; sincospif((float)phs * (1.0f / 128.0f), &s, &c); v[j] = isq ? -s * (1.f / 16.f) : c * (1.f / 16.f); }
        v4u w; w.x = cvt_pk_bf16(v[0], v[1]); w.y = cvt_pk_bf16(v[2], v[3]); w.z = cvt_pk_bf16(v[4], v[5]); w.w = cvt_pk_bf16(v[6], v[7]);
        *(v4u*)(F2 + (size_t)k * 512 + n0) = w;
    }
}
PHASE_FN ph_s5mat(PP pp) {
    FRAME();
    LAS float* lam = (LAS float*)F.lds;
    LAS float* bb = lam + 2 * 64 * 17 * 2;
    LAS float* cc = bb + 2 * 64 * 16 * 2;
    LAS float* kt = cc + 2 * 16 * 64 * 2;
    for (int unit = F.bid; unit < 64; unit += F.G) {
        const int li = unit >> 5, g = unit & 31;
        __syncthreads();
        if (F.tid < 128) { const int d = F.tid >> 6, pl = F.tid & 63; const int sidx = ((li * 2 + d) * 32 + g);
            const float are = PIN(I_A_RE)[sidx * 64 + pl], aim = PIN(I_A_IM)[sidx * 64 + pl], dt = expf(PIN(I_LOG_DT)[sidx]);
            for (int e = 0; e <= 16; ++e) { const float mag = expf(are * dt * (float)e); float sn, cn; sincosf(aim * dt * (float)e, &sn, &cn); lam[((d * 64 + pl) * 17 + e) * 2] = mag * cn; lam[((d * 64 + pl) * 17 + e) * 2 + 1] = mag * sn; } }
        __syncthreads();
        for (int e = F.tid; e < 2048; e += NTHREADS) { const int d = e >> 10, pl = (e >> 4) & 63, sp = e & 15; const int sidx = ((li * 2 + d) * 32 + g);
            const float are = PIN(I_A_RE)[sidx * 64 + pl], aim = PIN(I_A_IM)[sidx * 64 + pl];
            const float lre = lam[((d * 64 + pl) * 17 + 1) * 2], lim = lam[((d * 64 + pl) * 17 + 1) * 2 + 1];
            const float den = 1.0f / (are * are + aim * aim);
            const float fre = ((lre - 1.0f) * are + lim * aim) * den, fim = (lim * are - (lre - 1.0f) * aim) * den;
            const float br = PIN(I_B_RE)[((size_t)sidx * 64 + pl) * 16 + sp], bi = PIN(I_B_IM)[((size_t)sidx * 64 + pl) * 16 + sp];
            bb[e * 2] = fre * br - fim * bi; bb[e * 2 + 1] = fre * bi + fim * br; }
        for (int e = F.tid; e < 2048; e += NTHREADS) { const int d = e >> 10, sq = (e >> 6) & 15, pl = e & 63; const int sidx = ((li * 2 + d) * 32 + g);
            cc[e * 2] = PIN(I_C_RE)[((size_t)sidx * 16 + sq) * 64 + pl]; cc[e * 2 + 1] = PIN(I_C_IM)[((size_t)sidx * 16 + sq) * 64 + pl]; }
        __syncthreads();
        for (int e = F.tid; e < 8192; e += NTHREADS) { const int d = e >> 12, tau = (e >> 8) & 15, sq = (e >> 4) & 15, sp = e & 15; float acc = 0.f;
            for (int pl = 0; pl < 64; ++pl) { const float cr = cc[((d * 16 + sq) * 64 + pl) * 2], ci = cc[((d * 16 + sq) * 64 + pl) * 2 + 1];
                const float lr = lam[((d * 64 + pl) * 17 + tau) * 2], lj = lam[((d * 64 + pl) * 17 + tau) * 2 + 1];
                const float br = bb[((d * 64 + pl) * 16 + sp) * 2], bi = bb[((d * 64 + pl) * 16 + sp) * 2 + 1];
                const float tr = cr * lr - ci * lj, ti = cr * lj + ci * lr;
                acc += tr * br - ti * bi; }
            kt[e] = acc; }
        __syncthreads();
        bf16* WA = (bf16*)(ws + WS_S5M + (size_t)unit * S5M_STRIDE); bf16* CLm = WA + 512 * 256;
        const float* dsk = PIN(I_SSM_D) + (size_t)li * 512 + g * 16;
        for (int it = F.tid; it < 8192; it += NTHREADS) { const int row = it >> 5, c0 = (it & 31) * 8;
            float v[8];
            { const int i = row >> 4, sq = row & 15, j = c0 >> 4, sp0 = c0 & 15;
#pragma unroll
              for (int q = 0; q < 8; ++q) { const int sp = sp0 + q; float a = 0.f; if (i >= j) a += kt[((0 * 16 + (i - j)) * 16 + sq) * 16 + sp]; if (j >= i) a += kt[((1 * 16 + (j - i)) * 16 + sq) * 16 + sp]; if (i == j && sq == sp) a += dsk[sq]; v[q] = a; }
              v4u w; w.x = cvt_pk_bf16(v[0], v[1]); w.y = cvt_pk_bf16(v[2], v[3]); w.z = cvt_pk_bf16(v[4], v[5]); w.w = cvt_pk_bf16(v[6], v[7]); *(v4u*)(WA + (size_t)row * 256 + c0) = w; }
            { const int d = row >> 7, pl = (row >> 1) & 63, ri = row & 1, j = c0 >> 4, sp0 = c0 & 15, e = d ? j : 15 - j;
              const float lr = lam[((d * 64 + pl) * 17 + e) * 2], lj = lam[((d * 64 + pl) * 17 + e) * 2 + 1];
#pragma unroll
              for (int q = 0; q < 8; ++q) { const float br = bb[((d * 64 + pl) * 16 + sp0 + q) * 2], bi = bb[((d * 64 + pl) * 16 + sp0 + q) * 2 + 1]; v[q] = ri ? (lr * bi + lj * br) : (lr * br - lj * bi); }
              v4u w; w.x = cvt_pk_bf16(v[0], v[1]); w.y = cvt_pk_bf16(v[2], v[3]); w.z = cvt_pk_bf16(v[4], v[5]); w.w = cvt_pk_bf16(v[6], v[7]); *(v4u*)(WA + (size_t)(256 + row) * 256 + c0) = w; }
            { const int i = row >> 4, sq = row & 15, d = c0 >> 7, pl0 = (c0 >> 1) & 63, e = d ? 16 - i : i + 1;
#pragma unroll
              for (int q = 0; q < 4; ++q) { const int pl = pl0 + q; const float cr = cc[((d * 16 + sq) * 64 + pl) * 2], ci = cc[((d * 16 + sq) * 64 + pl) * 2 + 1];
                  const float lr = lam[((d * 64 + pl) * 17 + e) * 2], lj = lam[((d * 64 + pl) * 17 + e) * 2 + 1];
                  v[2 * q] = cr * lr - ci * lj; v[2 * q + 1] = -(cr * lj + ci * lr); }
              v4u w; w.x = cvt_pk_bf16(v[0], v[1]); w.y = cvt_pk_bf16(v[2], v[3]); w.z = cvt_pk_bf16(v[4], v[5]); w.w = cvt_pk_bf16(v[6], v[7]); *(v4u*)(CLm + (size_t)row * 256 + c0) = w; }
        }
    }
    __syncthreads();
}
PHASE_FN ph_pro_b(PP pp) {
    FRAME();
    const float* MOD = (const float*)(ws + WS_MOD); bf16* Hb = (bf16*)(ws + WS_H);
    const float* xin = PIN(I_X); const float* cin = PIN(I_CTX);
    for (int r = F.gw; r < T; r += F.NGW) {
        const bool isc = r >= TL; const float* xr = isc ? cin + (size_t)(r - TL) * D : xin + (size_t)r * D;
        const float* m = MOD + (size_t)(isc ? 16 : (r >> 12)) * 6144;
        f32x4 v[4], h[4]; row_load(xr, F.lane, v); row_modulate(h, v, m + 1024, m, F.lane); row_store_bf16(Hb + (size_t)r * D, F.lane, h);
    }
}

PHASE_FN ph_e1(PP pp, int layer) {
    FRAME();
    unsigned char* evw = ws + WS_EV + (layer >> 1) * EV_STRIDE; unsigned char* BIG = ws + WS_BIG;
    SchedEvIn S{F.G, F.bid, (const char*)(ws + WS_H), (const char*)(evw + EV_WQKV), (const char*)(evw + EV_WPQ), (char*)(BIG + BIG_QKV), (char*)(BIG + BIG_PQT), (char*)(BIG + BIG_PQTC)};
    pg8::gemm_phase<pg8::EpiStore, SchedEvIn, true, true>(F.lds, F.tid, pg8::Dims{D, D, D}, S, pg8::EpiStore{});
}
PHASE_FN ph_e2_dft(PP pp) {
    FRAME();
    unsigned char* BIG = ws + WS_BIG;
    SchedDft S{F.G, F.bid, (const char*)(ws + WS_F4096), (const char*)(BIG + BIG_PQT), (char*)(BIG + BIG_MIX)};
    pg8::gemm_phase<pg8::EpiStore, SchedDft, true, true>(F.lds, F.tid, pg8::Dims{8192, 8192, 8192}, S, pg8::EpiStore{});
}
PHASE_FN ph_e2_dftc(PP pp) {
    FRAME();
    unsigned char* BIG = ws + WS_BIG;
    SchedDftC S{F.G, F.bid, (const char*)(ws + WS_F256), (const char*)(BIG + BIG_PQTC), (char*)(BIG + BIG_MIX)};
    pg8::gemm_phase<pg8::EpiStore, SchedDftC, true, true>(F.lds, F.tid, pg8::Dims{512, 512, 512}, S, pg8::EpiStore{});
}
PHASE_FN ph_e2_rope(PP pp) {
    FRAME();
    bf16* QKV = (bf16*)(ws + WS_BIG + BIG_QKV);
    LAS f32x2* cs = (LAS f32x2*)F.lds;
    __syncthreads();
    for (int e = F.tid; e < 1024; e += NTHREADS) { const int pos = e >> 4, i = e & 15; const float inv = powf(10000.0f, -(float)i / 16.0f); float s, c; sincosf((float)pos * inv, &s, &c); cs[e] = (f32x2){c, s}; }
    __syncthreads();
    for (int it = F.bid * NTHREADS + F.tid; it < TL * 80; it += F.G * NTHREADS) {
        const int r = it / 80, q = it - r * 80, hh = q >> 3, ax = (q >> 2) & 1, i0 = (q & 3) * 4;
        const int n = r & 4095, pos = ax ? (n & 63) : (n >> 6);
        bf16* base = QKV + (size_t)r * 768 + hh * 64 + ax * 32 + i0;
        const v2u a = *(const v2u*)base, b = *(const v2u*)(base + 16);
        const float x1[4] = {bflo(a.x), bfhi(a.x), bflo(a.y), bfhi(a.y)}, x2[4] = {bflo(b.x), bfhi(b.x), bflo(b.y), bfhi(b.y)};
        float o1[4], o2[4];
#pragma unroll
        for (int j = 0; j < 4; ++j) { const f32x2 t = cs[pos * 16 + i0 + j]; o1[j] = x1[j] * t.x - x2[j] * t.y; o2[j] = x1[j] * t.y + x2[j] * t.x; }
        v2u wa, wb; wa.x = cvt_pk_bf16(o1[0], o1[1]); wa.y = cvt_pk_bf16(o1[2], o1[3]); wb.x = cvt_pk_bf16(o2[0], o2[1]); wb.y = cvt_pk_bf16(o2[2], o2[3]);
        *(v2u*)base = wa; *(v2u*)(base + 16) = wb;
    }
    bf16* VT = (bf16*)(ws + WS_H);
    for (int it = F.bid * NTHREADS + F.tid; it < NBATCH * 2 * 544 * 64; it += F.G * NTHREADS) {
        const int d = it & 63, kg = (it >> 6) % 544, bh = (it >> 6) / 544, b = bh >> 1, hkv = bh & 1;
        const int key0 = kg * 8; const size_t row0 = (key0 < 256) ? ((size_t)TL + (size_t)b * 256 + key0) : ((size_t)b * 4096 + (key0 - 256));
        const bf16* src = QKV + row0 * 768 + 640 + hkv * 64 + d;
        unsigned short v[8];
#pragma unroll
        for (int j = 0; j < 8; ++j) v[j] = src[(size_t)j * 768];
        v4u w; w.x = v[0] | ((unsigned)v[1] << 16); w.y = v[2] | ((unsigned)v[3] << 16); w.z = v[4] | ((unsigned)v[5] << 16); w.w = v[6] | ((unsigned)v[7] << 16);
        *(v4u*)(VT + ((size_t)bh * 64 + d) * 4352 + key0) = w;
    }
    __syncthreads();
}
typedef float f32x16 __attribute__((ext_vector_type(16)));
typedef __bf16 bf16x2v __attribute__((ext_vector_type(2)));
__device__ __forceinline__ unsigned pk_bf16(float a, float b) { const bf16x2v t = __builtin_convertvector((f32x2){a, b}, bf16x2v); return __builtin_bit_cast(unsigned, t); }
constexpr int AT_KP = 144, AT_VP1 = 648, AT_VP2 = 520, AT_VOFF = 320 * AT_KP;
template <bool MASKED>
__device__ __forceinline__ void attn_tile(const LAS unsigned char* Ks, const LAS unsigned char* Vs, const int vpitch, const int kl_base, const bf16x8 (&qf)[4], f32x16& o0, f32x16& o1, float& m, float& l,
                                          const int r, const int h, const int kj0, const int qi) {
    f32x16 x;
#pragma unroll
    for (int i = 0; i < 16; ++i) x[i] = 0.f;
#pragma unroll
    for (int s = 0; s < 4; ++s) { const bf16x8 kf = *(const LAS bf16x8*)(Ks + (kl_base + r) * AT_KP + (16 * s + 8 * h) * 2); x = __builtin_amdgcn_mfma_f32_32x32x16_bf16(kf, qf[s], x, 0, 0, 0); }
    float sc[16]; float mt = -1e30f;
#pragma unroll
    for (int i = 0; i < 16; ++i) { float v = x[i] * 0.125f;
        if (MASKED) { const int kj = kj0 + (i & 3) + 8 * (i >> 2) + 4 * h; const bool ok = (kj >= 0) && (kj < SEQ) && (kj - qi <= 128) && (qi - kj <= 128); v = ok ? v : -1e30f; }
        sc[i] = v; mt = fmaxf(mt, v); }
    mt = fmaxf(mt, __shfl_xor(mt, 32));
    const float mn = fmaxf(m, mt), alpha = __expf(m - mn); m = mn;
    float ps = 0.f;
#pragma unroll
    for (int i = 0; i < 16; ++i) { sc[i] = __expf(sc[i] - mn); ps += sc[i]; }
    l = l * alpha + ps;
#pragma unroll
    for (int i = 0; i < 16; ++i) { o0[i] *= alpha; o1[i] *= alpha; }
#pragma unroll
    for (int s2 = 0; s2 < 2; ++s2) {
        v4u pw; pw.x = pk_bf16(sc[8 * s2 + 0], sc[8 * s2 + 1]); pw.y = pk_bf16(sc[8 * s2 + 2], sc[8 * s2 + 3]); pw.z = pk_bf16(sc[8 * s2 + 4], sc[8 * s2 + 5]); pw.w = pk_bf16(sc[8 * s2 + 6], sc[8 * s2 + 7]);
        const bf16x8 pk = __builtin_bit_cast(bf16x8, pw);
        { const LAS unsigned char* vp = Vs + r * vpitch + (kl_base + 16 * s2 + 4 * h) * 2; const v2u lo = *(const LAS v2u*)vp, hi = *(const LAS v2u*)(vp + 16);
          v4u vw; vw.x = lo.x; vw.y = lo.y; vw.z = hi.x; vw.w = hi.y; o0 = __builtin_amdgcn_mfma_f32_32x32x16_bf16(__builtin_bit_cast(bf16x8, vw), pk, o0, 0, 0, 0); }
        { const LAS unsigned char* vp = Vs + (32 + r) * vpitch + (kl_base + 16 * s2 + 4 * h) * 2; const v2u lo = *(const LAS v2u*)vp, hi = *(const LAS v2u*)(vp + 16);
          v4u vw; vw.x = lo.x; vw.y = lo.y; vw.z = hi.x; vw.w = hi.y; o1 = __builtin_amdgcn_mfma_f32_32x32x16_bf16(__builtin_bit_cast(bf16x8, vw), pk, o1, 0, 0, 0); }
    }
}
PHASE_FN ph_e3_attn(PP pp, int layer) {
    FRAME();
    const bf16* QKV = (const bf16*)(ws + WS_BIG + BIG_QKV); bf16* MIX = (bf16*)(ws + WS_BIG + BIG_MIX); const bf16* VT = (const bf16*)(ws + WS_H);
    const float* sinkp = PIN(I_EV_SINK) + (layer >> 1) * 8;
    LAS unsigned char* Ks = F.lds; LAS unsigned char* Vs = F.lds + AT_VOFF;
    const int r = F.lane & 31, h = F.lane >> 5, g = F.wave >> 1, th = F.wave & 1;
    for (int u = F.bid; u < 2048 + 128; u += F.G) {
        const bool isc = u >= 2048;
        int b, hkv, qb; if (!isc) { b = u >> 7; hkv = (u >> 6) & 1; qb = u & 63; } else { const int v = u - 2048; b = v >> 3; hkv = (v >> 2) & 1; qb = v & 3; }
        const int n0 = qb * 64, bh = b * 2 + hkv;
        const size_t qrow = isc ? ((size_t)TL + (size_t)b * 256 + n0 + 32 * th + r) : ((size_t)b * 4096 + n0 + 32 * th + r);
        bf16x8 qf[4];
#pragma unroll
        for (int s = 0; s < 4; ++s) qf[s] = *(const bf16x8*)(QKV + qrow * 768 + (hkv * 4 + g) * 64 + 16 * s + 8 * h);
        float m = sinkp[hkv * 4 + g], l = (h == 0) ? 1.0f : 0.0f;
        f32x16 o0, o1;
#pragma unroll
        for (int i = 0; i < 16; ++i) { o0[i] = 0.f; o1[i] = 0.f; }
        __syncthreads();
        if (!isc) {
            for (int pc = F.tid; pc < 2560; pc += NTHREADS) { const int kl = pc >> 3, c8 = pc & 7, kj = n0 - 128 + kl;
                v4u v = (v4u){0u, 0u, 0u, 0u}; if (kj >= 0 && kj < SEQ) v = *(const v4u*)(QKV + ((size_t)b * 4096 + kj) * 768 + 512 + hkv * 64 + c8 * 8);
                *(LAS v4u*)(Ks + kl * AT_KP + c8 * 16) = v; }
            for (int pc = F.tid; pc < 2560; pc += NTHREADS) { const int d = pc / 40, c = pc - d * 40, kj = n0 - 128 + c * 8;
                v4u v = (v4u){0u, 0u, 0u, 0u}; if (kj >= 0 && kj < SEQ) v = *(const v4u*)(VT + ((size_t)bh * 64 + d) * 4352 + 256 + kj);
                LAS v2u* dst = (LAS v2u*)(Vs + d * AT_VP1 + c * 16); dst[0] = (v2u){v.x, v.y}; dst[1] = (v2u){v.z, v.w}; }
            __syncthreads();
            const int qi = n0 + 32 * th + r;
#pragma unroll 1
            for (int t = 0; t < 9; ++t) { const int klb = 32 * th + 32 * t; attn_tile<true>(Ks, Vs, AT_VP1, klb, qf, o0, o1, m, l, r, h, n0 - 128 + klb, qi); }
            __syncthreads();
        }
        for (int pc = F.tid; pc < 2048; pc += NTHREADS) { const int j = pc >> 3, c8 = pc & 7;
            *(LAS v4u*)(Ks + j * AT_KP + c8 * 16) = *(const v4u*)(QKV + ((size_t)TL + (size_t)b * 256 + j) * 768 + 512 + hkv * 64 + c8 * 8); }
        for (int pc = F.tid; pc < 2048; pc += NTHREADS) { const int d = pc >> 5, c = pc & 31; const v4u v = *(const v4u*)(VT + ((size_t)bh * 64 + d) * 4352 + c * 8);
            LAS v2u* dst = (LAS v2u*)(Vs + d * AT_VP2 + c * 16); dst[0] = (v2u){v.x, v.y}; dst[1] = (v2u){v.z, v.w}; }
        __syncthreads();
#pragma unroll 1
        for (int t = 0; t < 8; ++t) attn_tile<false>(Ks, Vs, AT_VP2, 32 * t, qf, o0, o1, m, l, r, h, 0, 0);
        const float inv = 1.0f / (l + __shfl_xor(l, 32));
        bf16* orow = MIX + qrow * D + 512 + (hkv * 4 + g) * 64 + 4 * h;
#pragma unroll
        for (int q4 = 0; q4 < 4; ++q4) {
            v2u w0; w0.x = pk_bf16(o0[4 * q4 + 0] * inv, o0[4 * q4 + 1] * inv); w0.y = pk_bf16(o0[4 * q4 + 2] * inv, o0[4 * q4 + 3] * inv); *(v2u*)(orow + 8 * q4) = w0;
            v2u w1; w1.x = pk_bf16(o1[4 * q4 + 0] * inv, o1[4 * q4 + 1] * inv); w1.y = pk_bf16(o1[4 * q4 + 2] * inv, o1[4 * q4 + 3] * inv); *(v2u*)(orow + 32 + 8 * q4) = w1;
        }
    }
    __syncthreads();
}
PHASE_FN ph_outproj(PP pp, int layer) {
    FRAME();
    const int li = layer >> 1; const bool odd = (layer & 1) != 0;
    const int TR = (layer == DEPTH - 1) ? TL : T;
    const char* W = odd ? (const char*)(ws + WS_OD + li * OD_STRIDE + OD_WOUT) : (const char*)(ws + WS_EV + li * EV_STRIDE + EV_WOUT);
    float* XC = (float*)(ws + WS_XC); float* out = (float*)pp->out;
    const float* xl_src = (layer == 0) ? PIN(I_X) : out; const float* xc_src = (layer == 0) ? PIN(I_CTX) : XC;
    const float* modl = (const float*)(ws + WS_MOD) + (size_t)layer * 17 * 6144;
    SchedResid S{F.G, F.bid, (TR / 256) * 4, (const char*)(ws + WS_BIG + BIG_MIX), (size_t)256 * D * 2, W, (size_t)256 * D * 2, xl_src, xc_src, out, XC, modl + 2048};
    pg8::gemm_phase<pg8::EpiResid, SchedResid, true, true>(F.lds, F.tid, pg8::Dims{D, D, D}, S, pg8::EpiResid{});
}
PHASE_FN ph_ln_mid(PP pp, int layer) {
    FRAME();
    ln_pass(F, (float*)pp->out, (float*)(ws + WS_XC), (bf16*)(ws + WS_H), PIN(I_LNG) + (size_t)(layer * 2) * D, PIN(I_LNB) + (size_t)(layer * 2) * D,
            (const float*)(ws + WS_MOD) + (size_t)layer * 17 * 6144, 4096, 3072, T);
}
PHASE_FN ph_e6(PP pp, int layer) {
    FRAME();
    unsigned char* evw = ws + WS_EV + (layer >> 1) * EV_STRIDE;
    SchedStd S{22, (T / 256) * 22, F.G, F.bid, (const char*)(ws + WS_H), (const char*)(evw + EV_W13), (char*)(ws + WS_BIG + BIG_HID), (size_t)256 * D * 2, (size_t)256 * D * 2, (size_t)256 * FFH * 2, (size_t)128 * 2, FFH, 1 << 30};
    pg8::gemm_phase<pg8::EpiSwiGLU, SchedStd, true, true>(F.lds, F.tid, pg8::Dims{D, D, D}, S, pg8::EpiSwiGLU{});
}
PHASE_FN ph_e7(PP pp, int layer) {
    FRAME();
    unsigned char* evw = ws + WS_EV + (layer >> 1) * EV_STRIDE;
    float* XC = (float*)(ws + WS_XC); float* out = (float*)pp->out;
    const float* modl = (const float*)(ws + WS_MOD) + (size_t)layer * 17 * 6144;
    SchedResid S{F.G, F.bid, (T / 256) * 4, (const char*)(ws + WS_BIG + BIG_HID), (size_t)256 * FFH * 2, (const char*)(evw + EV_W2), (size_t)256 * FFH * 2, out, XC, out, XC, modl + 5120};
    pg8::gemm_phase<pg8::EpiResid, SchedResid, true, true>(F.lds, F.tid, pg8::Dims{FFH, FFH, FFH}, S, pg8::EpiResid{});
}
PHASE_FN ph_ln_end(PP pp, int layer) {
    FRAME();
    ln_pass(F, (float*)pp->out, (float*)(ws + WS_XC), (bf16*)(ws + WS_H), PIN(I_LNG) + (size_t)(layer * 2 + 1) * D, PIN(I_LNB) + (size_t)(layer * 2 + 1) * D,
            (const float*)(ws + WS_MOD) + (size_t)(layer + 1) * 17 * 6144, 1024, 0, T);
}

PHASE_FN ph_o1(PP pp, int layer) {
    FRAME();
    unsigned char* odw = ws + WS_OD + (layer >> 1) * OD_STRIDE;
    SchedStd S{6, (T / 256) * 6, F.G, F.bid, (const char*)(ws + WS_H), (const char*)(odw + OD_WIN), (char*)(ws + WS_BIG + BIG_P), (size_t)256 * D * 2, (size_t)256 * D * 2, (size_t)256 * 1536 * 2, (size_t)256 * 2, 1536, 2};
    pg8::gemm_phase<pg8::EpiStore, SchedStd, true, true>(F.lds, F.tid, pg8::Dims{D, D, D}, S, pg8::EpiStore{});
}
PHASE_FN ph_o2_s5a(PP pp, int layer) {
    FRAME();
    const int li = layer >> 1;
    SchedS5A S{F.G, F.bid, (const char*)(ws + WS_BIG + BIG_P), (const char*)(ws + WS_S5M + (size_t)li * 32 * S5M_STRIDE), (char*)(ws + WS_H + 68 * MiB), (char*)(ws + WS_H)};
    pg8::gemm_phase<pg8::EpiStore, SchedS5A, true, true, pg8::AMapS5>(F.lds, F.tid, pg8::Dims{256, 0, 256}, S, pg8::EpiStore{}, pg8::AMapS5{});
}
PHASE_FN ph_o2_scan(PP pp, int layer) {
    FRAME();
    const int li = layer >> 1;
    if (F.tid < 256) {
        const int t = F.bid * 256 + F.tid;
        if (t < NBATCH * 32 * 2 * 64) {
            const int pl = t & 63, d = (t >> 6) & 1, g = (t >> 7) & 31, b = t >> 12;
            const int sidx = ((li * 2 + d) * 32 + g);
            const float are = PIN(I_A_RE)[sidx * 64 + pl], aim = PIN(I_A_IM)[sidx * 64 + pl], dt = expf(PIN(I_LOG_DT)[sidx]);
            const float mag = expf(16.0f * are * dt); float sn, cn; sincosf(16.0f * aim * dt, &sn, &cn);
            const float lre = mag * cn, lim = mag * sn;
            unsigned* HB = (unsigned*)(ws + WS_H) + (g * 256 + d * 128 + pl * 2) / 2;
            float cre = 0.f, cim = 0.f;
#define S5_CROW(k_) ((k_) < 16 ? (4096 + b * 16 + (d ? 15 - (k_) : (k_))) : (b * 256 + (d ? 255 - ((k_) - 16) : ((k_) - 16))))
            for (int k0 = 0; k0 < 272; k0 += 8) {
                unsigned w[8];
#pragma unroll
                for (int j = 0; j < 8; ++j) w[j] = HB[(size_t)S5_CROW(k0 + j) * 4096];
#pragma unroll
                for (int j = 0; j < 8; ++j) { HB[(size_t)S5_CROW(k0 + j) * 4096] = cvt_pk_bf16(cre, cim);
                    const float sr = bflo(w[j]), si = bfhi(w[j]); const float nr = lre * cre - lim * cim + sr, ni = lre * cim + lim * cre + si; cre = nr; cim = ni; }
            }
#undef S5_CROW
        }
    }
}
PHASE_FN ph_o3(PP pp, int layer) {
    FRAME();
    const int li = layer >> 1;
    SchedS5B S{F.G, F.bid, (const char*)(ws + WS_H), (const char*)(ws + WS_S5M + (size_t)li * 32 * S5M_STRIDE + 256 * 1024), (const char*)(ws + WS_H + 68 * MiB), (char*)(ws + WS_BIG + BIG_P)};
    pg8::gemm_phase<pg8::EpiS5B, SchedS5B, true, true>(F.lds, F.tid, pg8::Dims{256, 8192, 256}, S, pg8::EpiS5B{});
}
PHASE_FN ph_o2_gmlp(PP pp, int layer) {
    FRAME();
    const int li = layer >> 1; const int TR = (layer == DEPTH - 1) ? TL : T;
    const bf16* P = (const bf16*)(ws + WS_BIG + BIG_P); bf16* MIX = (bf16*)(ws + WS_BIG + BIG_MIX);
    LAS float* Wn = (LAS float*)F.lds;
    LAS float* Vs = (LAS float*)(F.lds + 65536);
    const int nchunk = TR / 128;
    const float* ws_w = PIN(I_WS) + (size_t)li * 4 * 128 * 128; const float* bs = PIN(I_BS) + (size_t)li * 4 * 128;
    __syncthreads();
    for (int ch = F.bid; ch < nchunk; ch += F.G) {
        const size_t row0 = (size_t)ch * 128;
        float mu_r[16], rs_r[16];
#pragma unroll
        for (int t = 0; t < 16; ++t) { const v4u w = *(const v4u*)(P + (row0 + F.wave * 16 + t) * 1536 + 1024 + F.lane * 8);
            const float f[8] = {bflo(w.x), bfhi(w.x), bflo(w.y), bfhi(w.y), bflo(w.z), bfhi(w.z), bflo(w.w), bfhi(w.w)};
            float s = 0.f;
#pragma unroll
            for (int j = 0; j < 8; ++j) s += f[j];
            const float mu = wave_sum(s) * (1.f / 512.f); float q = 0.f;
#pragma unroll
            for (int j = 0; j < 8; ++j) q += (f[j] - mu) * (f[j] - mu);
            mu_r[t] = mu; rs_r[t] = rsqrtf(wave_sum(q) * (1.f / 512.f) + LN_EPS); }
        for (int h = 0; h < 4; ++h) {
            __syncthreads();
            for (int e = F.tid; e < 128 * 128; e += NTHREADS) Wn[e] = ws_w[(size_t)h * 16384 + e];
#pragma unroll
            for (int t = 0; t < 16; ++t) { const int j = F.wave * 16 + t; const unsigned w = *(const unsigned*)(P + (row0 + j) * 1536 + 1024 + h * 128 + F.lane * 2);
                Vs[j * 128 + F.lane * 2] = (bflo(w) - mu_r[t]) * rs_r[t]; Vs[j * 128 + F.lane * 2 + 1] = (bfhi(w) - mu_r[t]) * rs_r[t]; }
            __syncthreads();
            const int ti = F.tid >> 5, te = F.tid & 31;
            f32x4 acc[8];
#pragma unroll
            for (int k = 0; k < 8; ++k) acc[k] = (f32x4){0.f, 0.f, 0.f, 0.f};
            for (int j = 0; j < 128; ++j) {
                const f32x4 vv = *(const LAS f32x4*)(Vs + j * 128 + te * 4);
#pragma unroll
                for (int k = 0; k < 8; ++k) acc[k] += vv * Wn[(ti * 8 + k) * 128 + j];
            }
#pragma unroll
            for (int k = 0; k < 8; ++k) { const int i = ti * 8 + k; const float bb = bs[h * 128 + i];
                const v2u uw = *(const v2u*)(P + (row0 + i) * 1536 + 512 + h * 128 + te * 4);
                v2u o; o.x = cvt_pk_bf16(bflo(uw.x) * (acc[k][0] + bb), bfhi(uw.x) * (acc[k][1] + bb)); o.y = cvt_pk_bf16(bflo(uw.y) * (acc[k][2] + bb), bfhi(uw.y) * (acc[k][3] + bb));
                *(v2u*)(MIX + (row0 + i) * D + 512 + h * 128 + te * 4) = o; }
        }
    }
    __syncthreads();
}
PHASE_FN ph_o4(PP pp, int layer) {
    FRAME();
    const int li = layer >> 1;
    unsigned char* odw = ws + WS_OD + li * OD_STRIDE;
    SchedGlu S{F.G, F.bid, (const char*)(ws + WS_BIG + BIG_P), (const char*)(odw + OD_WGLU), (char*)(ws + WS_BIG + BIG_MIX), PIN(I_BGLU) + (size_t)li * 512};
    pg8::gemm_phase<pg8::EpiGLU, SchedGlu, true, true>(F.lds, F.tid, pg8::Dims{512, 1536, 512}, S, pg8::EpiGLU{});
}
PHASE_FN ph_o6(PP pp, int layer) {
    FRAME();
    const int li = layer >> 1; const int TR = (layer == DEPTH - 1) ? TL : T;
    float* XC = (float*)(ws + WS_XC); float* out = (float*)pp->out; bf16* Hb = (bf16*)(ws + WS_H);
    const float* modl = (const float*)(ws + WS_MOD) + (size_t)layer * 17 * 6144;
    const float* lng0 = PIN(I_LNG) + (size_t)(layer * 2) * D; const float* lnb0 = PIN(I_LNB) + (size_t)(layer * 2) * D;
    int* tokE = (int*)(ws + WS_TOK); int* tokS0 = tokE + T; int* tokS1 = tokS0 + T; float* tokG0 = (float*)(tokS1 + T);
    unsigned* ecnt = F.ctl + CW_CNT + li * 64;
    LAS float* wr_s = (LAS float*)F.lds;
    LAS unsigned* lcnt = (LAS unsigned*)(F.lds + 32768);
    const float* rw = PIN(I_ROUTER) + (size_t)li * D * 8;
    __syncthreads();
    for (int e = F.tid; e < D * 8; e += NTHREADS) wr_s[e] = rw[e];
    if (F.tid < 16) lcnt[F.tid] = 0u;
    __syncthreads();
    f32x4 gg[4], bb[4];
#pragma unroll
    for (int j = 0; j < 4; ++j) { gg[j] = *(const f32x4*)(lng0 + 256 * j + 4 * F.lane); bb[j] = *(const f32x4*)(lnb0 + 256 * j + 4 * F.lane); }
    for (int r = F.gw; r < TR; r += F.NGW) {
        const bool isc = r >= TL; float* xr = isc ? XC + (size_t)(r - TL) * D : out + (size_t)r * D;
        const float* m = modl + (size_t)(isc ? 16 : (r >> 12)) * 6144;
        f32x4 v[4], h[4], sv[4], tv[4]; row_load(xr, F.lane, v); row_load_mod(m + 4096, m + 3072, F.lane, sv, tv);
        row_ln_pre(v, gg, bb); row_store(xr, F.lane, v);
#pragma unroll
        for (int j = 0; j < 4; ++j) h[j] = v[j] * (sv[j] + 1.0f) + tv[j];
        row_store_bf16(Hb + (size_t)r * D, F.lane, h);
        float lg[8];
#pragma unroll
        for (int e = 0; e < 8; ++e) lg[e] = 0.f;
#pragma unroll
        for (int j = 0; j < 4; ++j)
#pragma unroll
            for (int q = 0; q < 4; ++q) { const int col = 256 * j + 4 * F.lane + q; const f32x4 w0 = *(const LAS f32x4*)(wr_s + col * 8), w1 = *(const LAS f32x4*)(wr_s + col * 8 + 4); const float hv = h[j][q];
                lg[0] += hv * w0[0]; lg[1] += hv * w0[1]; lg[2] += hv * w0[2]; lg[3] += hv * w0[3]; lg[4] += hv * w1[0]; lg[5] += hv * w1[1]; lg[6] += hv * w1[2]; lg[7] += hv * w1[3]; }
#pragma unroll
        for (int e = 0; e < 8; ++e) lg[e] = wave_sum(lg[e]);
        if (F.lane == 0) {
            int e0 = 0; float v0 = lg[0];
#pragma unroll
            for (int e = 1; e < 8; ++e) if (lg[e] > v0) { v0 = lg[e]; e0 = e; }
            int e1 = -1; float v1 = -3.0e38f;
#pragma unroll
            for (int e = 0; e < 8; ++e) if (e != e0 && lg[e] > v1) { v1 = lg[e]; e1 = e; }
            const float w0 = 1.0f / (1.0f + __expf(v1 - v0));
            const int s0 = (int)__hip_atomic_fetch_add(lcnt + e0, 1u, __ATOMIC_RELAXED, __HIP_MEMORY_SCOPE_WORKGROUP), s1 = (int)__hip_atomic_fetch_add(lcnt + e1, 1u, __ATOMIC_RELAXED, __HIP_MEMORY_SCOPE_WORKGROUP);
            tokE[r] = e0 | (e1 << 8); tokS0[r] = s0; tokS1[r] = s1; tokG0[r] = w0;
        }
    }
    __syncthreads();
    if (F.tid < 8) lcnt[8 + F.tid] = atomicAdd(ecnt + F.tid, lcnt[F.tid]);
    VM_WAIT();
    __syncthreads();
    { const int r = F.gw + F.lane * F.NGW;
      if (r < TR) { const int ee = tokE[r]; tokS0[r] += (int)lcnt[8 + (ee & 255)]; tokS1[r] += (int)lcnt[8 + (ee >> 8)]; } }
    __syncthreads();
}
PHASE_FN ph_o7(PP pp, int layer) {
    FRAME();
    const int li = layer >> 1; const int TR = (layer == DEPTH - 1) ? TL : T;
    const bf16* Hb = (const bf16*)(ws + WS_H); unsigned char* HSQ = ws + WS_BIG + BIG_HSQ;
    int* tokE = (int*)(ws + WS_TOK); int* tokS0 = tokE + T; int* tokS1 = tokS0 + T; int* tokP0 = tokS1 + 2 * T; int* tokP1 = tokP0 + T;
    unsigned* ecnt = F.ctl + CW_CNT + li * 64;
    int roff[8]; { int acc = 0;
#pragma unroll
        for (int e = 0; e < 8; ++e) { roff[e] = acc * 256; acc += (__builtin_amdgcn_readfirstlane((int)__hip_atomic_load(ecnt + e, __ATOMIC_RELAXED, __HIP_MEMORY_SCOPE_AGENT)) + 255) >> 8; } }
    for (int r = F.gw; r < TR; r += F.NGW) {
        const int ee = tokE[r], e0 = ee & 255, e1 = ee >> 8;
        int p0 = tokS0[r], p1 = tokS1[r];
#pragma unroll
        for (int e = 0; e < 8; ++e) { p0 += (e == e0) ? roff[e] : 0; p1 += (e == e1) ? roff[e] : 0; }
        const v4u* src = (const v4u*)(Hb + (size_t)r * D) + 2 * F.lane;
        const v4u a = src[0], b = src[1];
        v4u q; q.x = pk_fp8x4(bflo(a.x) * Q_H, bfhi(a.x) * Q_H, bflo(a.y) * Q_H, bfhi(a.y) * Q_H); q.y = pk_fp8x4(bflo(a.z) * Q_H, bfhi(a.z) * Q_H, bflo(a.w) * Q_H, bfhi(a.w) * Q_H);
        q.z = pk_fp8x4(bflo(b.x) * Q_H, bfhi(b.x) * Q_H, bflo(b.y) * Q_H, bfhi(b.y) * Q_H); q.w = pk_fp8x4(bflo(b.z) * Q_H, bfhi(b.z) * Q_H, bflo(b.w) * Q_H, bfhi(b.w) * Q_H);
        *((v4u*)(HSQ + (size_t)p0 * D) + F.lane) = q; *((v4u*)(HSQ + (size_t)p1 * D) + F.lane) = q;
        if (F.lane == 0) { tokP0[r] = p0; tokP1[r] = p1; }
    }
}
PHASE_FN ph_moe_up(PP pp, int layer, int chn) {
    FRAME();
    const int li = layer >> 1; unsigned char* odw = ws + WS_OD + li * OD_STRIDE; unsigned* ecnt = F.ctl + CW_CNT + li * 64;
    SchedMoeUp S; S.G = F.G; S.c = F.bid; S.rt0 = chn * MOE_CHUNK_TILES; S.HS = (const char*)(ws + WS_BIG + BIG_HSQ); S.W = (const char*)(odw + OD_MW13); S.HID = (char*)(ws + WS_H);
    { int acc = 0; S.toff[0] = 0;
#pragma unroll
        for (int e = 0; e < 8; ++e) { acc += (__builtin_amdgcn_readfirstlane((int)__hip_atomic_load(ecnt + e, __ATOMIC_RELAXED, __HIP_MEMORY_SCOPE_AGENT)) + 255) >> 8; S.toff[e + 1] = acc; } }
    int nt_ = S.toff[8] - S.rt0; nt_ = nt_ < 0 ? 0 : (nt_ > MOE_CHUNK_TILES ? MOE_CHUNK_TILES : nt_); S.nUnits = nt_ * 28;
    pg8::gemm_phase<pg8::EpiSwiGLU8, SchedMoeUp, true, true, pg8::AMapStd, true>(F.lds, F.tid, pg8::Dims{D, D, D}, S, pg8::EpiSwiGLU8{});
}
PHASE_FN ph_moe_down(PP pp, int layer, int chn) {
    FRAME();
    const int li = layer >> 1; unsigned char* odw = ws + WS_OD + li * OD_STRIDE; unsigned* ecnt = F.ctl + CW_CNT + li * 64;
    SchedMoeDown S; S.G = F.G; S.c = F.bid; S.rt0 = chn * MOE_CHUNK_TILES; S.HID = (const char*)(ws + WS_H); S.W = (const char*)(odw + OD_MW2); S.Y = (char*)(ws + WS_BIG + BIG_Y);
    { int acc = 0; S.toff[0] = 0;
#pragma unroll
        for (int e = 0; e < 8; ++e) { acc += (__builtin_amdgcn_readfirstlane((int)__hip_atomic_load(ecnt + e, __ATOMIC_RELAXED, __HIP_MEMORY_SCOPE_AGENT)) + 255) >> 8; S.toff[e + 1] = acc; } }
    int nt_ = S.toff[8] - S.rt0; nt_ = nt_ < 0 ? 0 : (nt_ > MOE_CHUNK_TILES ? MOE_CHUNK_TILES : nt_); S.nUnits = nt_ * 4;
    pg8::gemm_phase<pg8::EpiStoreQ, SchedMoeDown, true, true, pg8::AMapStd, true>(F.lds, F.tid, pg8::Dims{EH, EH, EH}, S, pg8::EpiStoreQ{});
}
PHASE_FN ph_o9(PP pp, int layer) {
    FRAME();
    const int TR = (layer == DEPTH - 1) ? TL : T; const bool last = layer == DEPTH - 1;
    float* XC = (float*)(ws + WS_XC); float* out = (float*)pp->out; bf16* Hb = (bf16*)(ws + WS_H); const bf16* HS = (const bf16*)(ws + WS_BIG + BIG_Y);
    const float* modl = (const float*)(ws + WS_MOD) + (size_t)layer * 17 * 6144;
    const float* modn = (const float*)(ws + WS_MOD) + (size_t)(last ? layer : layer + 1) * 17 * 6144;
    const float* lng1 = PIN(I_LNG) + (size_t)(layer * 2 + 1) * D; const float* lnb1 = PIN(I_LNB) + (size_t)(layer * 2 + 1) * D;
    const int* tokE = (const int*)(ws + WS_TOK); const float* tokG0 = (const float*)(tokE + 3 * T); const int* tokP0 = tokE + 4 * T; const int* tokP1 = tokP0 + T;
    f32x4 gg9[4], bb9[4];
#pragma unroll
    for (int j = 0; j < 4; ++j) { gg9[j] = *(const f32x4*)(lng1 + 256 * j + 4 * F.lane); bb9[j] = *(const f32x4*)(lnb1 + 256 * j + 4 * F.lane); }
    for (int r = F.gw; r < TR; r += F.NGW) {
        const bool isc = r >= TL; float* xr = isc ? XC + (size_t)(r - TL) * D : out + (size_t)r * D;
        const int mrow = isc ? 16 : (r >> 12);
        const float* g2 = modl + (size_t)mrow * 6144 + 5120;
        const int p0 = tokP0[r], p1 = tokP1[r]; const float w0 = tokG0[r], w1 = 1.0f - w0;
        const bf16* y0 = HS + (size_t)p0 * D; const bf16* y1 = HS + (size_t)p1 * D;
        f32x4 v[4], h[4]; row_load(xr, F.lane, v);
#pragma unroll
        for (int j = 0; j < 4; ++j) { const v2u a = *(const v2u*)(y0 + 256 * j + 4 * F.lane), b = *(const v2u*)(y1 + 256 * j + 4 * F.lane); const f32x4 gg = *(const f32x4*)(g2 + 256 * j + 4 * F.lane);
            f32x4 f; f[0] = w0 * bflo(a.x) + w1 * bflo(b.x); f[1] = w0 * bfhi(a.x) + w1 * bfhi(b.x); f[2] = w0 * bflo(a.y) + w1 * bflo(b.y); f[3] = w0 * bfhi(a.y) + w1 * bfhi(b.y);
            v[j] = v[j] * ALPHA + gg * f; }
        row_ln_pre(v, gg9, bb9); row_store(xr, F.lane, v);
        if (!last) { const float* m = modn + (size_t)mrow * 6144; row_modulate(h, v, m + 1024, m, F.lane); row_store_bf16(Hb + (size_t)r * D, F.lane, h); }
    }
}

#if MK_SPLIT
#define PHASE_END() do { ++ph; } while (0)
#else
#define PHASE_END() do { if (ph >= lo && ph + 1 < hi) grid_bar(pp); ++ph; } while (0)
#endif
#define PHASE_ON() (ph >= lo && ph < hi)
static __device__ __forceinline__ void even_layer(PP pp, const int layer, const int lo, const int hi, int& ph) {
    if (PHASE_ON()) ph_e1(pp, layer);
    PHASE_END();
    if (PHASE_ON()) { ph_e2_dft(pp); ph_e2_dftc(pp); ph_e2_rope(pp); }
    PHASE_END();
    if (PHASE_ON()) ph_e3_attn(pp, layer);
    PHASE_END();
    if (PHASE_ON()) ph_outproj(pp, layer);
    PHASE_END();
    if (PHASE_ON()) ph_ln_mid(pp, layer);
    PHASE_END();
    if (PHASE_ON()) ph_e6(pp, layer);
    PHASE_END();
    if (PHASE_ON()) ph_e7(pp, layer);
    PHASE_END();
    if (PHASE_ON()) ph_ln_end(pp, layer);
    PHASE_END();
}
static __device__ __forceinline__ void odd_layer(PP pp, const int layer, const int lo, const int hi, int& ph) {
    if (PHASE_ON()) ph_o1(pp, layer);
    PHASE_END();
    if (PHASE_ON()) { ph_o2_s5a(pp, layer); ph_o2_gmlp(pp, layer); }
    PHASE_END();
    if (PHASE_ON()) ph_o2_scan(pp, layer);
    PHASE_END();
    if (PHASE_ON()) ph_o3(pp, layer);
    PHASE_END();
    if (PHASE_ON()) ph_o4(pp, layer);
    PHASE_END();
    if (PHASE_ON()) ph_outproj(pp, layer);
    PHASE_END();
    if (PHASE_ON()) ph_o6(pp, layer);
    PHASE_END();
    if (PHASE_ON()) ph_o7(pp, layer);
    PHASE_END();
#define MOE_CHUNK(chn) do { if (PHASE_ON()) ph_moe_up(pp, layer, chn); PHASE_END(); if (PHASE_ON()) ph_moe_down(pp, layer, chn); PHASE_END(); } while (0)
    static_assert(MOE_NCHUNK == 5, "the chunk sites are written out: no loop around GEMM phase sites");
    MOE_CHUNK(0); MOE_CHUNK(1); MOE_CHUNK(2); MOE_CHUNK(3); MOE_CHUNK(4);
#undef MOE_CHUNK
    if (PHASE_ON()) ph_o9(pp, layer);
    PHASE_END();
}
constexpr int N_PHASES = 2 + 2 * (8 + 9 + 2 * MOE_NCHUNK);
__global__ void __launch_bounds__(NTHREADS, 2) fwd_kernel(Params p_unused) {
    DECL_LDS;
    PP pp = (PP)__builtin_amdgcn_kernarg_segment_ptr();
    {
        LAS unsigned char* lds = (LAS unsigned char*)lds_raw;
        for (int u = threadIdx.x; u < (LDS_BYTES - LDS_RING) / 4; u += NTHREADS) ((LAS unsigned*)(lds + LDS_RING))[u] = 0u;
        __syncthreads();
#if !MK_SPLIT
        (void)xcd_barrier_post((unsigned*)((unsigned char*)pp->ws + WS_CTL) + CW_BAR, (volatile LAS unsigned*)(lds + LDS_MISC) + 8);
#endif
    }
#if MK_SPLIT
    const int lo = pp->ph_lo, hi = pp->ph_hi;
#else
    constexpr int lo = 0, hi = N_PHASES;
#endif
    int ph = 0;

    if (PHASE_ON()) { ph_fold(pp); ph_mod(pp); ph_s5mat(pp); ph_cvt(pp); ph_dftmat(pp); }
    PHASE_END();
    if (PHASE_ON()) ph_pro_b(pp);
    PHASE_END();
    even_layer(pp, 0, lo, hi, ph);
    odd_layer(pp, 1, lo, hi, ph);
    even_layer(pp, 2, lo, hi, ph);
    odd_layer(pp, 3, lo, hi, ph);
}

extern "C" void kernel_launch(void* const* d_in, const int* in_sizes, int n_in, void* d_out, int out_size, void* d_ws, size_t ws_size, hipStream_t stream) {
    static int grid = 0;
    if (grid == 0) {
        if (n_in != 32 || out_size != TL * D || ws_size < WS_END) { fprintf(stderr, "kernel_launch: unexpected shapes (n_in %d, out %d, ws %zu < %zu)\n", n_in, out_size, ws_size, (size_t)WS_END); grid = -1; return; }
        int dev = 0, cus = 0, per_cu = 0;
        if (hipGetDevice(&dev) != hipSuccess || hipDeviceGetAttribute(&cus, hipDeviceAttributeMultiprocessorCount, dev) != hipSuccess) { grid = -1; return; }
        if (hipFuncSetAttribute((const void*)fwd_kernel, hipFuncAttributeMaxDynamicSharedMemorySize, LDS_BYTES) != hipSuccess) { fprintf(stderr, "kernel_launch: hipFuncSetAttribute failed\n"); grid = -1; return; }
        if (hipOccupancyMaxActiveBlocksPerMultiprocessor(&per_cu, (const void*)fwd_kernel, NTHREADS, LDS_BYTES) != hipSuccess || per_cu < 1) { fprintf(stderr, "kernel_launch: occupancy query says %d\n", per_cu); }
        (void)hipGetLastError();
        grid = cus;
    }
    if (grid < 0) return;
    (void)in_sizes;
    (void)hipMemsetAsync((char*)d_ws + WS_CTL, 0, CTL_ZERO_BYTES, stream);
    Params p{};
    for (int i = 0; i < 32; ++i) p.in[i] = (const float*)d_in[i];
    p.out = (float*)d_out; p.ws = (unsigned char*)d_ws;
#if MK_SPLIT
    for (int ph = 0; ph < N_PHASES; ++ph) { p.ph_lo = ph; p.ph_hi = ph + 1; hipLaunchKernelGGL(fwd_kernel, dim3(grid), dim3(NTHREADS), LDS_BYTES, stream, p); }
#else
    p.ph_lo = 0; p.ph_hi = N_PHASES;
    hipLaunchKernelGGL(fwd_kernel, dim3(grid), dim3(NTHREADS), LDS_BYTES, stream, p);
#endif
}
```

```cpp
#include <hip/hip_runtime.h>
#include <cstdio>
#include <cstdint>

#ifndef MK_SPLIT
#define MK_SPLIT 0
#endif

#define GAS __attribute__((address_space(1)))
#define LAS __attribute__((address_space(3)))
typedef unsigned short bf16;
typedef unsigned v4u __attribute__((ext_vector_type(4)));
typedef unsigned v2u __attribute__((ext_vector_type(2)));
typedef float f32x4 __attribute__((ext_vector_type(4)));
typedef float f32x2 __attribute__((ext_vector_type(2)));
typedef short bf16x8 __attribute__((ext_vector_type(8)));

constexpr int D = 1024, NBATCH = 16, SEQ = 4096, NCTX = 256, DEPTH = 4;
constexpr int TL = NBATCH * SEQ, TC = NBATCH * NCTX, T = TL + TC;
constexpr int FFH = 2816, EH = 3584, NEXP = 8;
constexpr int MOE_CHUNK_TILES = 128, MOE_NCHUNK = 5;
constexpr float Q_H = 16.f, Q_W = 1024.f, Q_HID = 8.f;
constexpr float ALPHA = 1.6817928305074290860622509524664f;
constexpr float LN_EPS = 1e-5f;

constexpr size_t MiB = (size_t)1 << 20;
constexpr size_t WS_CTL = 0, CTL_ZERO_BYTES = 1 * MiB;
constexpr size_t WS_MOD = 1 * MiB;
constexpr size_t WS_TOK = 3 * MiB;
constexpr size_t WS_XC = 5 * MiB;
constexpr size_t WS_F256 = 21 * MiB;
constexpr size_t WS_FD = 22 * MiB;
constexpr size_t WS_EV = 86 * MiB, EV_STRIDE = 22 * MiB;
constexpr size_t EV_WQKV = 0, EV_WPQ = 3 * MiB / 2, EV_WOUT = 7 * MiB / 2, EV_W13 = 11 * MiB / 2, EV_W2 = 33 * MiB / 2;
constexpr size_t WS_OD = 130 * MiB, OD_STRIDE = 174 * MiB;
constexpr size_t OD_WIN = 0, OD_WGLU = 3 * MiB, OD_WOUT = 7 * MiB / 2, OD_MW13 = 11 * MiB / 2, OD_MW2 = 235 * MiB / 2;
constexpr size_t WS_H = 478 * MiB;
constexpr size_t WS_BIG = 614 * MiB;
constexpr size_t BIG_PQT = 0, BIG_PQTC = 128 * MiB, BIG_QKV = 136 * MiB, BIG_MIX = 238 * MiB, BIG_VT = 374 * MiB, BIG_HID = 0, BIG_P = 0, BIG_Y = 0, BIG_HSQ = 276 * MiB;
constexpr size_t WS_S5M = 1030 * MiB, S5M_STRIDE = 384 * 1024;
constexpr size_t WS_END = 1054 * MiB;
constexpr int CW_BAR = 4096, CW_CNT = 16384;

#define LDS_WAIT() asm volatile("s_waitcnt lgkmcnt(0)" ::: "memory")
#define VM_WAIT() asm volatile("s_waitcnt vmcnt(0)" ::: "memory")
__device__ __forceinline__ unsigned cvt_pk_bf16(float lo, float hi) { unsigned r; asm volatile("v_cvt_pk_bf16_f32 %0, %1, %2" : "=v"(r) : "v"(lo), "v"(hi)); return r; }
__device__ __forceinline__ float bflo(unsigned w) { return __uint_as_float(w << 16); }
__device__ __forceinline__ float bfhi(unsigned w) { return __uint_as_float(w & 0xffff0000u); }
__device__ __forceinline__ float bf2f(bf16 b) { return __uint_as_float(((unsigned)b) << 16); }
__device__ __forceinline__ bf16 f2bf(float f) { return (bf16)(cvt_pk_bf16(f, 0.f) & 0xffffu); }
__device__ __forceinline__ unsigned pk_fp8x4(float a, float b, float c, float d) {
    a = __builtin_amdgcn_fmed3f(a, -448.f, 448.f); b = __builtin_amdgcn_fmed3f(b, -448.f, 448.f); c = __builtin_amdgcn_fmed3f(c, -448.f, 448.f); d = __builtin_amdgcn_fmed3f(d, -448.f, 448.f);
    int w = 0; w = __builtin_amdgcn_cvt_pk_fp8_f32(a, b, w, false); w = __builtin_amdgcn_cvt_pk_fp8_f32(c, d, w, true); return (unsigned)w; }
__device__ __forceinline__ float wave_sum(float v) {
#pragma unroll
    for (int o = 1; o < 64; o <<= 1) v += __shfl_xor(v, o);
    return v;
}
__device__ __forceinline__ float wave_max(float v) {
#pragma unroll
    for (int o = 1; o < 64; o <<= 1) v = fmaxf(v, __shfl_xor(v, o));
    return v;
}
__device__ __forceinline__ float silu_f(float x) { return x / (1.f + __expf(-x)); }
__device__ __forceinline__ float sigmoid_f(float x) { return 1.f / (1.f + __expf(-x)); }
__device__ __forceinline__ float gelu_tanh_f(float x) { const float z = 0.7978845608028654f * (x + 0.044715f * x * x * x); return x / (1.f + __expf(-2.f * z)); }

#define XB_TMO      128
#define XB_XCNT(j)  (256  + 64 * (j))
#define XB_XSUB(j)  (1280 + 64 * (j))
#define XB_XGEN(j)  (2304 + 64 * (j))
#define XB_TOP      3328
#define XB_TOPGEN   3392
#define XCD_BAR_WORDS 3456
#define XB_SPIN_CAP (1u << 25)
__device__ __forceinline__ unsigned xb_ld(unsigned* p)              { return __hip_atomic_load(p, __ATOMIC_RELAXED, __HIP_MEMORY_SCOPE_AGENT); }
__device__ __forceinline__ unsigned xb_add(unsigned* p, unsigned v) { return __hip_atomic_fetch_add(p, v, __ATOMIC_RELAXED, __HIP_MEMORY_SCOPE_AGENT); }
__device__ __forceinline__ unsigned xb_xcc_id() { return (unsigned)__builtin_amdgcn_s_getreg((3 << 11) | 20) & 0xFu; }
#define XB_SPIN(cond, bar) do { unsigned _sp = 0; while (cond) { __builtin_amdgcn_s_sleep(1); \
    if ((++_sp & 255u) == 0u) { if (xb_ld(&(bar)[XB_TMO])) break; if (_sp > XB_SPIN_CAP) { atomicAdd(&(bar)[XB_TMO], 1u); break; } } } } while (0)
struct XcdBarrier { unsigned* bar; unsigned x; volatile LAS unsigned* st; };
__device__ __forceinline__ XcdBarrier xcd_barrier_post(unsigned* bar, volatile LAS unsigned* st) {
    XcdBarrier b; b.bar = bar; b.x = xb_xcc_id(); b.st = st;
    if (threadIdx.x == 0) (void)xb_add(&bar[XB_XCNT(b.x)], 1u);
    return b;
}
__device__ __forceinline__ void xcd_barrier_complete(unsigned* bar, unsigned x, unsigned& nloc, unsigned& nx) {
    const unsigned G = gridDim.x * gridDim.y * gridDim.z;
    unsigned sum, cnt, mine, sp = 0u;
    for (;;) {
        sum = 0u; cnt = 0u; mine = 0u;
#pragma unroll
        for (unsigned j = 0; j < 16; ++j) { const unsigned c = xb_ld(&bar[XB_XCNT(j)]); sum += c; cnt += (c > 0u) ? 1u : 0u; mine = (j == x) ? c : mine; }
        if (sum == G) break;
        __builtin_amdgcn_s_sleep(1);
        if ((++sp & 255u) == 0u) { if (xb_ld(&bar[XB_TMO])) break; if (sp > XB_SPIN_CAP) { atomicAdd(&bar[XB_TMO], 1u); break; } }
    }
    nloc = mine > 0u ? mine : 1u; nx = cnt > 0u ? cnt : 1u;
}
__device__ __forceinline__ void xcd_barrier(const XcdBarrier& b) {
    asm volatile("s_waitcnt vmcnt(0)" ::: "memory");
    __syncthreads();
    if (threadIdx.x == 0) {
        unsigned* bar = b.bar;
        __builtin_amdgcn_s_waitcnt(0);
        unsigned nloc = b.st[0], nx = b.st[1];
        if (nloc == 0u) { xcd_barrier_complete(bar, b.x, nloc, nx); b.st[0] = nloc; b.st[1] = nx; }
        const unsigned old = xb_add(&bar[XB_XSUB(b.x)], 1u);
        const unsigned gen = old / nloc;
        if (old + 1u == (gen + 1u) * nloc) {
            __builtin_amdgcn_fence(__ATOMIC_RELEASE, "agent");
            asm volatile("s_waitcnt vmcnt(0)" ::: "memory");
            const unsigned og = xb_add(&bar[XB_TOP], 1u);
            const unsigned tg = og / nx;
            if (og + 1u == (tg + 1u) * nx) xb_add(&bar[XB_TOPGEN], 1u);
            else XB_SPIN(xb_ld(&bar[XB_TOPGEN]) == tg, bar);
            __builtin_amdgcn_fence(__ATOMIC_ACQUIRE, "agent");
            xb_add(&bar[XB_XGEN(b.x)], 1u);
            asm volatile("s_waitcnt vmcnt(0)" ::: "memory");
        } else {
            XB_SPIN(xb_ld(&bar[XB_XGEN(b.x)]) == gen, bar);
            __builtin_amdgcn_fence(__ATOMIC_ACQUIRE, "agent");
            asm volatile("s_waitcnt vmcnt(0)" ::: "memory");
        }
    }
    __syncthreads();
}

namespace pg8 {
constexpr int BM = 256, BK = 64, HALF = 128, HTB = HALF * BK * 2, STAGE_BYTES = 8 * HTB;
__host__ __device__ __forceinline__ int lds_byte(int r, int c) { const int st = (r >> 4) * 2 + (c >> 5), rr = r & 15, cc = c & 31, ob = rr * 64 + cc * 2; return st * 1024 + (ob ^ (((ob >> 9) & 1) << 5)); }
__host__ __device__ __forceinline__ void stage_rc(int b, int& R, int& C) { const int st = b / 1024, sb = b % 1024, swz = sb ^ (((sb >> 9) & 1) << 5); R = (st >> 1) * 16 + swz / 64; C = (st & 1) * 32 + (swz % 64) / 2; }
__host__ __device__ __forceinline__ int perm32(int rho) { const int n = rho >> 4, i = rho & 15; return 8 * (i >> 2) + 4 * n + (i & 3); }

struct Unit { const char* a; const char* b; char* o; const char* p0; const char* p1; int ldo; int x0; };
struct Dims { int K, lda, ldb; };
typedef int v4i __attribute__((ext_vector_type(4)));
typedef int v8i __attribute__((ext_vector_type(8)));
struct AMapStd { int ldab = 0;   __device__ __forceinline__ unsigned voff(int R, int C) const { return (unsigned)(R * ldab + C * 2); } __device__ __forceinline__ size_t kstep() const { return 128; } __device__ __forceinline__ size_t hs() const { return (size_t)HALF * ldab; } };
struct AMapS5 { __device__ __forceinline__ unsigned voff(int R, int C) const { return (unsigned)(R * 49152 + (C >> 4) * 3072 + (C & 15) * 2); } __device__ __forceinline__ size_t kstep() const { return 12288; } __device__ __forceinline__ size_t hs() const { return (size_t)HALF * 49152; } };

__device__ __forceinline__ const char* uni_ptr(const char* p) {
    const unsigned long long v = (unsigned long long)p; const unsigned lo = __builtin_amdgcn_readfirstlane((unsigned)v), hi = __builtin_amdgcn_readfirstlane((unsigned)(v >> 32));
    return (const char*)(((unsigned long long)hi << 32) | lo); }
template <class Epi, class Sched, bool ALIGN_EPI = false, bool SP2 = false, class AMap = AMapStd, bool FP8 = false>
__device__ __forceinline__ void gemm_phase(LAS unsigned char* lds, const int tid, const Dims g, const Sched& S, const Epi& E, const AMap am_in = AMap{}) {
    constexpr int ES = FP8 ? 1 : 2;
    AMap am = am_in; if constexpr (__is_same(AMap, AMapStd)) am.ldab = g.lda * ES;
    const int wid = __builtin_amdgcn_readfirstlane(tid >> 6), lane = tid & 63, wr = wid >> 2, wc = wid & 3, fr = lane & 15, fq = lane >> 4;
    const int K = g.K, nt = (K * (FP8 ? 1 : 2)) / 128;
    unsigned voffA, voffB;
    { int R, C; stage_rc(tid * 16, R, C); const int Rb = Epi::PERM ? ((R & ~31) + perm32(R & 31)) : R;
        voffA = am.voff(R, C); voffB = (unsigned)(Rb * g.ldb * ES + C * 2); }
    const size_t d64voffA = am.voff(64, 0), d64voffB = (size_t)64 * g.ldb * ES;
    const size_t kstep = (size_t)(BK * 2), kstepA = am.kstep();
    const size_t hsA = am.hs(), hsB = (size_t)HALF * g.ldb * ES;
    const unsigned ldsw = (unsigned)wid * 1024u;
    const int aoff = lds_byte(wr * 64 + fr, fq * 8), boff = lds_byte(wc * 32 + fr, fq * 8);
#define PG8_SA(b, h) (((b) * 2 + (h)) * HTB)
#define PG8_SB(b, h) ((4 + (b) * 2 + (h)) * HTB)
#define PG8_STAGE(bufoff, gbase, voff) do { unsigned _vo = (voff); asm volatile("" : "+v"(_vo));   \
        __builtin_amdgcn_global_load_lds((const unsigned*)((const char*)(gbase) + _vo), (LAS unsigned*)(lds + (bufoff) + ldsw), 16, 0, 0); \
        __builtin_amdgcn_global_load_lds((const unsigned*)((const char*)(gbase) + d64##voff + _vo), (LAS unsigned*)(lds + (bufoff) + ldsw + 8192), 16, 0, 0); } while (0)
#define PG8_LD8(p) __builtin_shufflevector(*(const LAS v4i*)(p), *(const LAS v4i*)((p) + 1024), 0, 1, 2, 3, 4, 5, 6, 7)
#define PG8_LDA(dst, b, h) do { if constexpr (FP8) { _Pragma("unroll") for (int m = 0; m < 4; ++m) dst##8[m] = PG8_LD8(lds + PG8_SA(b, h) + aoff + m * 2048); } \
        else { _Pragma("unroll") for (int m = 0; m < 4; ++m) _Pragma("unroll") for (int k = 0; k < 2; ++k) dst[m][k] = *(const LAS bf16x8*)(lds + PG8_SA(b, h) + aoff + m * 2048 + k * 1024); } } while (0)
#define PG8_LDB(dst, b, h) do { if constexpr (FP8) { _Pragma("unroll") for (int n = 0; n < 2; ++n) dst##8[n] = PG8_LD8(lds + PG8_SB(b, h) + boff + n * 2048); } \
        else { _Pragma("unroll") for (int n = 0; n < 2; ++n) _Pragma("unroll") for (int k = 0; k < 2; ++k) dst[n][k] = *(const LAS bf16x8*)(lds + PG8_SB(b, h) + boff + n * 2048 + k * 1024); } } while (0)
#define PG8_MMA(ai, bj, At, Bt) do { __builtin_amdgcn_s_setprio(1); \
        if constexpr (FP8) { _Pragma("unroll") for (int m = 0; m < 4; ++m) _Pragma("unroll") for (int n = 0; n < 2; ++n) \
            acc[ai][bj][m][n] = __builtin_amdgcn_mfma_scale_f32_16x16x128_f8f6f4(Bt##8[n], At##8[m], acc[ai][bj][m][n], 0, 0, 0, 0, 0, 0); } \
        else { _Pragma("unroll") for (int m = 0; m < 4; ++m) _Pragma("unroll") for (int n = 0; n < 2; ++n) _Pragma("unroll") for (int k = 0; k < 2; ++k) \
            acc[ai][bj][m][n] = __builtin_amdgcn_mfma_f32_16x16x32_bf16(Bt[n][k], At[m][k], acc[ai][bj][m][n], 0, 0, 0); } \
        __builtin_amdgcn_s_setprio(0); } while (0)
#define PG8_WAIT_V(n) asm volatile("s_waitcnt vmcnt(" #n ")" ::: "memory")
#define PG8_WAIT_L(n) asm volatile("s_waitcnt lgkmcnt(" #n ")" ::: "memory")
#define PG8_BAR __builtin_amdgcn_s_barrier()
#define PG8_SCHED __builtin_amdgcn_sched_barrier(0)
    int ui = 0;
    const char* cA; const char* cB;
    { Unit u0; if (!S.next(0, u0)) return; cA = uni_ptr(u0.a); cB = uni_ptr(u0.b); }
    f32x4 acc[2][2][4][2];
#pragma unroll
    for (int a = 0; a < 2; ++a)
#pragma unroll
        for (int b = 0; b < 2; ++b)
#pragma unroll
            for (int m = 0; m < 4; ++m)
#pragma unroll
                for (int n = 0; n < 2; ++n) acc[a][b][m][n] = (f32x4){0.f, 0.f, 0.f, 0.f};
    bf16x8 At[4][2], B0[2][2], B1[2][2];
    v8i At8[4], B08[2], B18[2];
    if constexpr (SP2) {
        PG8_STAGE(PG8_SB(0, 0), cB, voffB); PG8_STAGE(PG8_SB(0, 1), cB + hsB, voffB); PG8_STAGE(PG8_SA(0, 0), cA, voffA); PG8_STAGE(PG8_SA(0, 1), cA + hsA, voffA);
        if (wr == 1) PG8_BAR;
        PG8_WAIT_V(2); PG8_BAR;
        PG8_STAGE(PG8_SB(1, 0), cB + kstep, voffB); PG8_STAGE(PG8_SA(1, 0), cA + kstepA, voffA); PG8_STAGE(PG8_SB(1, 1), cB + hsB + kstep, voffB);
        PG8_WAIT_V(6); PG8_BAR;
    } else {
        PG8_STAGE(PG8_SB(0, 0), cB, voffB); PG8_STAGE(PG8_SA(0, 0), cA, voffA); PG8_STAGE(PG8_SB(0, 1), cB + hsB, voffB); PG8_STAGE(PG8_SA(0, 1), cA + hsA, voffA);
        if (wr == 1) PG8_BAR;
        PG8_WAIT_V(4); PG8_BAR;
        PG8_STAGE(PG8_SB(1, 0), cB + kstep, voffB); PG8_STAGE(PG8_SA(1, 0), cA + kstepA, voffA); PG8_STAGE(PG8_SB(1, 1), cB + hsB + kstep, voffB);
        PG8_WAIT_V(6); PG8_BAR;
    }
    for (;;) {
        const char* nA = cA; const char* nB = cB; bool has_next;
        { Unit un; has_next = S.next(ui + 1, un); if (has_next) { nA = uni_ptr(un.a); nB = uni_ptr(un.b); } }
#pragma unroll 1
        for (int t = 0; t < nt; t += 2) {
            const bool last = (t == nt - 2);
            const char* a1 = cA + (size_t)(t + 1) * kstepA;
            const char* a2 = last ? nA : cA + (size_t)(t + 2) * kstepA; const char* b2 = last ? nB : cB + (size_t)(t + 2) * kstep;
            const char* a3 = a2 + kstepA; const char* b3 = b2 + kstep;
            if constexpr (SP2) {
            PG8_LDB(B0, 0, 0); PG8_LDB(B1, 0, 1); PG8_SCHED; PG8_LDA(At, 0, 0); PG8_STAGE(PG8_SA(1, 1), a1 + hsA, voffA);
            PG8_WAIT_V(8); PG8_WAIT_L(0); PG8_BAR; PG8_MMA(0, 0, At, B0); PG8_MMA(0, 1, At, B1); PG8_BAR; PG8_SCHED;
            PG8_LDA(At, 0, 1); PG8_STAGE(PG8_SB(0, 0), b2, voffB); PG8_STAGE(PG8_SB(0, 1), b2 + hsB, voffB); PG8_STAGE(PG8_SA(0, 0), a2, voffA);
            PG8_WAIT_V(8); PG8_WAIT_L(0); PG8_BAR; PG8_MMA(1, 0, At, B0); PG8_MMA(1, 1, At, B1); PG8_BAR; PG8_SCHED;
            PG8_LDB(B0, 1, 0); PG8_LDB(B1, 1, 1); PG8_SCHED; PG8_LDA(At, 1, 0); PG8_STAGE(PG8_SA(0, 1), a2 + hsA, voffA);
            PG8_WAIT_V(8); PG8_WAIT_L(0); PG8_BAR; PG8_MMA(0, 0, At, B0); PG8_MMA(0, 1, At, B1); PG8_BAR; PG8_SCHED;
            PG8_LDA(At, 1, 1); PG8_STAGE(PG8_SB(1, 0), b3, voffB); PG8_STAGE(PG8_SB(1, 1), b3 + hsB, voffB); PG8_STAGE(PG8_SA(1, 0), a3, voffA);
            PG8_WAIT_V(8); PG8_WAIT_L(0); PG8_BAR; PG8_MMA(1, 0, At, B0); PG8_MMA(1, 1, At, B1); PG8_BAR; PG8_SCHED;
            } else {
            PG8_LDB(B0, 0, 0); PG8_SCHED; PG8_LDA(At, 0, 0); PG8_STAGE(PG8_SA(1, 1), a1 + hsA, voffA);
            PG8_WAIT_L(8); PG8_BAR; PG8_WAIT_L(0); PG8_MMA(0, 0, At, B0); PG8_BAR; PG8_SCHED;
            PG8_LDB(B1, 0, 1); PG8_STAGE(PG8_SB(0, 0), b2, voffB);
            PG8_BAR; PG8_WAIT_L(0); PG8_MMA(0, 1, At, B1); PG8_BAR;
            PG8_LDA(At, 0, 1); PG8_STAGE(PG8_SA(0, 0), a2, voffA);
            PG8_BAR; PG8_WAIT_L(0); PG8_MMA(1, 0, At, B0); PG8_BAR; PG8_SCHED;
            PG8_STAGE(PG8_SB(0, 1), b2 + hsB, voffB);
            PG8_WAIT_V(6); PG8_BAR; PG8_MMA(1, 1, At, B1); PG8_BAR;
            PG8_LDB(B0, 1, 0); PG8_SCHED; PG8_LDA(At, 1, 0); PG8_STAGE(PG8_SA(0, 1), a2 + hsA, voffA);
            PG8_WAIT_L(8); PG8_BAR; PG8_WAIT_L(0); PG8_MMA(0, 0, At, B0); PG8_BAR; PG8_SCHED;
            PG8_LDB(B1, 1, 1); PG8_STAGE(PG8_SB(1, 0), b3, voffB);
            PG8_BAR; PG8_WAIT_L(0); PG8_MMA(0, 1, At, B1); PG8_BAR;
            PG8_LDA(At, 1, 1); PG8_STAGE(PG8_SA(1, 0), a3, voffA);
            PG8_BAR; PG8_WAIT_L(0); PG8_MMA(1, 0, At, B0); PG8_BAR; PG8_SCHED;
            PG8_STAGE(PG8_SB(1, 1), b3 + hsB, voffB);
            PG8_WAIT_V(6); PG8_BAR; PG8_MMA(1, 1, At, B1); PG8_BAR;
            }
        }
        if constexpr (ALIGN_EPI) { if (wr == 0) PG8_BAR; }
        { Unit uc; (void)S.next(ui, uc); E(acc, uc, wid); }
        if (!has_next) break;
#pragma unroll
        for (int a = 0; a < 2; ++a)
#pragma unroll
            for (int b = 0; b < 2; ++b)
#pragma unroll
                for (int m = 0; m < 4; ++m)
#pragma unroll
                    for (int n = 0; n < 2; ++n) acc[a][b][m][n] = (f32x4){0.f, 0.f, 0.f, 0.f};
        cA = nA; cB = nB; ++ui;
        if constexpr (ALIGN_EPI) { if (wr == 1) PG8_BAR; }
    }
    PG8_WAIT_V(0);
    if constexpr (!ALIGN_EPI) { if (wr == 0) PG8_BAR; }
    PG8_BAR;
#undef PG8_SA
#undef PG8_SB
#undef PG8_STAGE
#undef PG8_LDA
#undef PG8_LDB
#undef PG8_MMA
#undef PG8_LD8
#undef PG8_WAIT_V
#undef PG8_WAIT_L
#undef PG8_BAR
#undef PG8_SCHED
}

struct EpiStore {
    static constexpr bool PERM = true;
    __device__ __forceinline__ void operator()(const f32x4 (&acc)[2][2][4][2], const Unit& u, const int wid) const {
        int lane_; asm volatile("v_mbcnt_lo_u32_b32 %0, -1, 0\n\tv_mbcnt_hi_u32_b32 %0, -1, %0" : "=v"(lane_));
        const int wr = wid >> 2, wc = wid & 3, fr = lane_ & 15, fq = lane_ >> 4;
        bf16* base = (bf16*)u.o; int row0 = wr * 64 + fr, col0 = wc * 32 + 8 * fq; asm volatile("" : "+v"(row0), "+v"(col0)); const bool act = u.x0 != 0;
#pragma unroll
        for (int ai = 0; ai < 2; ++ai)
#pragma unroll
            for (int m = 0; m < 4; ++m) { bf16* rowp = base + (size_t)(row0 + ai * HALF + m * 16) * u.ldo + col0;
#pragma unroll
                for (int bj = 0; bj < 2; ++bj) { f32x4 v0 = acc[ai][bj][m][0], v1 = acc[ai][bj][m][1];
                    if (act) {
#pragma unroll
                        for (int j = 0; j < 4; ++j) { v0[j] = gelu_tanh_f(v0[j]); v1[j] = gelu_tanh_f(v1[j]); } }
                    v4u w; w.x = cvt_pk_bf16(v0[0], v0[1]); w.y = cvt_pk_bf16(v0[2], v0[3]); w.z = cvt_pk_bf16(v1[0], v1[1]); w.w = cvt_pk_bf16(v1[2], v1[3]);
                    *(v4u*)(rowp + bj * HALF) = w; } }
    }
};
struct EpiSwiGLU {
    static constexpr bool PERM = true;
    __device__ __forceinline__ void operator()(const f32x4 (&acc)[2][2][4][2], const Unit& u, const int wid) const {
        int lane_; asm volatile("v_mbcnt_lo_u32_b32 %0, -1, 0\n\tv_mbcnt_hi_u32_b32 %0, -1, %0" : "=v"(lane_));
        const int wr = wid >> 2, wc = wid & 3, fr = lane_ & 15, fq = lane_ >> 4;
        bf16* base = (bf16*)u.o; int row0 = wr * 64 + fr, col0 = wc * 32 + 8 * fq; asm volatile("" : "+v"(row0), "+v"(col0));
#pragma unroll
        for (int ai = 0; ai < 2; ++ai)
#pragma unroll
            for (int m = 0; m < 4; ++m) { bf16* rowp = base + (size_t)(row0 + ai * HALF + m * 16) * u.ldo + col0;
                f32x4 h0, h1;
#pragma unroll
                for (int j = 0; j < 4; ++j) { h0[j] = silu_f(acc[ai][0][m][0][j]) * acc[ai][1][m][0][j]; h1[j] = silu_f(acc[ai][0][m][1][j]) * acc[ai][1][m][1][j]; }
                v4u w; w.x = cvt_pk_bf16(h0[0], h0[1]); w.y = cvt_pk_bf16(h0[2], h0[3]); w.z = cvt_pk_bf16(h1[0], h1[1]); w.w = cvt_pk_bf16(h1[2], h1[3]);
                *(v4u*)rowp = w; }
    }
};
struct EpiSwiGLU8 {
    static constexpr bool PERM = true;
    __device__ __forceinline__ void operator()(const f32x4 (&acc)[2][2][4][2], const Unit& u, const int wid) const {
        int lane_; asm volatile("v_mbcnt_lo_u32_b32 %0, -1, 0\n\tv_mbcnt_hi_u32_b32 %0, -1, %0" : "=v"(lane_));
        const int wr = wid >> 2, wc = wid & 3, fr = lane_ & 15, fq = lane_ >> 4;
        unsigned char* base = (unsigned char*)u.o; int row0 = wr * 64 + fr, col0 = wc * 32 + 8 * fq; asm volatile("" : "+v"(row0), "+v"(col0));
        constexpr float SA = 1.0f / (Q_H * Q_W);
#pragma unroll
        for (int ai = 0; ai < 2; ++ai)
#pragma unroll
            for (int m = 0; m < 4; ++m) { unsigned char* rowp = base + (size_t)(row0 + ai * HALF + m * 16) * u.ldo + col0;
                float h0[4], h1[4];
#pragma unroll
                for (int j = 0; j < 4; ++j) { h0[j] = silu_f(acc[ai][0][m][0][j] * SA) * (acc[ai][1][m][0][j] * (SA * Q_HID)); h1[j] = silu_f(acc[ai][0][m][1][j] * SA) * (acc[ai][1][m][1][j] * (SA * Q_HID)); }
                v2u w; w.x = pk_fp8x4(h0[0], h0[1], h0[2], h0[3]); w.y = pk_fp8x4(h1[0], h1[1], h1[2], h1[3]);
                *(v2u*)rowp = w; }
    }
};
struct EpiStoreQ {
    static constexpr bool PERM = true;
    __device__ __forceinline__ void operator()(const f32x4 (&acc)[2][2][4][2], const Unit& u, const int wid) const {
        int lane_; asm volatile("v_mbcnt_lo_u32_b32 %0, -1, 0\n\tv_mbcnt_hi_u32_b32 %0, -1, %0" : "=v"(lane_));
        const int wr = wid >> 2, wc = wid & 3, fr = lane_ & 15, fq = lane_ >> 4;
        bf16* base = (bf16*)u.o; int row0 = wr * 64 + fr, col0 = wc * 32 + 8 * fq; asm volatile("" : "+v"(row0), "+v"(col0));
        constexpr float SA = 1.0f / (Q_HID * Q_W);
#pragma unroll
        for (int ai = 0; ai < 2; ++ai)
#pragma unroll
            for (int m = 0; m < 4; ++m) { bf16* rowp = base + (size_t)(row0 + ai * HALF + m * 16) * u.ldo + col0;
#pragma unroll
                for (int bj = 0; bj < 2; ++bj) { const f32x4 v0 = acc[ai][bj][m][0] * SA, v1 = acc[ai][bj][m][1] * SA;
                    v4u w; w.x = cvt_pk_bf16(v0[0], v0[1]); w.y = cvt_pk_bf16(v0[2], v0[3]); w.z = cvt_pk_bf16(v1[0], v1[1]); w.w = cvt_pk_bf16(v1[2], v1[3]);
                    *(v4u*)(rowp + bj * HALF) = w; } }
    }
};
struct EpiResid {
    static constexpr bool PERM = false;
    __device__ __forceinline__ void operator()(const f32x4 (&acc)[2][2][4][2], const Unit& u, const int wid) const {
        int lane_; asm volatile("v_mbcnt_lo_u32_b32 %0, -1, 0\n\tv_mbcnt_hi_u32_b32 %0, -1, %0" : "=v"(lane_));
        const int wr = wid >> 2, wc = wid & 3, fr = lane_ & 15, fq = lane_ >> 4;
        const float* xs = (const float*)u.p0; float* zo = (float*)u.o; const float* gv = (const float*)u.p1;
        int row0 = wr * 64 + fr, col0 = wc * 32 + 4 * fq; asm volatile("" : "+v"(row0), "+v"(col0));
#pragma unroll
        for (int ai = 0; ai < 2; ++ai)
#pragma unroll
            for (int m = 0; m < 4; ++m) { const size_t off = (size_t)(row0 + ai * HALF + m * 16) * D + col0;
#pragma unroll
                for (int bj = 0; bj < 2; ++bj)
#pragma unroll
                    for (int n = 0; n < 2; ++n) { const f32x4 xv = *(const f32x4*)(xs + off + bj * HALF + n * 16); const f32x4 gvv = *(const f32x4*)(gv + col0 + bj * HALF + n * 16);
                        *(f32x4*)(zo + off + bj * HALF + n * 16) = xv * ALPHA + gvv * acc[ai][bj][m][n]; }
                asm volatile("" ::: "memory"); }
    }
};
struct EpiGLU {
    static constexpr bool PERM = true;
    __device__ __forceinline__ void operator()(const f32x4 (&acc)[2][2][4][2], const Unit& u, const int wid) const {
        int lane_; asm volatile("v_mbcnt_lo_u32_b32 %0, -1, 0\n\tv_mbcnt_hi_u32_b32 %0, -1, %0" : "=v"(lane_));
        const int wr = wid >> 2, wc = wid & 3, fr = lane_ & 15, fq = lane_ >> 4;
        bf16* base = (bf16*)u.o; const bf16* gp = (const bf16*)u.p0; const float* bias = (const float*)u.p1;
        int row0 = wr * 64 + fr, col0 = wc * 32 + 8 * fq; asm volatile("" : "+v"(row0), "+v"(col0));
#pragma unroll
        for (int ai = 0; ai < 2; ++ai)
#pragma unroll
            for (int m = 0; m < 4; ++m) { const int r = row0 + ai * HALF + m * 16;
#pragma unroll
                for (int bj = 0; bj < 2; ++bj) { const v4u gw = *(const v4u*)(gp + (size_t)r * u.x0 + col0 + bj * HALF);
                    const f32x4 b0 = *(const f32x4*)(bias + col0 + bj * HALF), b1 = *(const f32x4*)(bias + col0 + bj * HALF + 4);
                    const f32x4 a0 = acc[ai][bj][m][0] + b0, a1 = acc[ai][bj][m][1] + b1;
                    const float o0 = bflo(gw.x) * sigmoid_f(a0[0]), o1 = bfhi(gw.x) * sigmoid_f(a0[1]), o2 = bflo(gw.y) * sigmoid_f(a0[2]), o3 = bfhi(gw.y) * sigmoid_f(a0[3]);
                    const float o4 = bflo(gw.z) * sigmoid_f(a1[0]), o5 = bfhi(gw.z) * sigmoid_f(a1[1]), o6 = bflo(gw.w) * sigmoid_f(a1[2]), o7 = bfhi(gw.w) * sigmoid_f(a1[3]);
                    v4u w; w.x = cvt_pk_bf16(o0, o1); w.y = cvt_pk_bf16(o2, o3); w.z = cvt_pk_bf16(o4, o5); w.w = cvt_pk_bf16(o6, o7);
                    *(v4u*)(base + (size_t)r * u.ldo + col0 + bj * HALF) = w; }
                asm volatile("" ::: "memory"); }
    }
};
struct EpiS5B {
    static constexpr bool PERM = true;
    __device__ __forceinline__ void operator()(const f32x4 (&acc)[2][2][4][2], const Unit& u, const int wid) const {
        int lane_; asm volatile("v_mbcnt_lo_u32_b32 %0, -1, 0\n\tv_mbcnt_hi_u32_b32 %0, -1, %0" : "=v"(lane_));
        const int wr = wid >> 2, wc = wid & 3, fr = lane_ & 15, fq = lane_ >> 4;
        bf16* base = (bf16*)u.o; const bf16* y1 = (const bf16*)u.p0;
        int row0 = wr * 64 + fr, col0 = wc * 32 + 8 * fq; asm volatile("" : "+v"(row0), "+v"(col0));
#pragma unroll
        for (int ai = 0; ai < 2; ++ai)
#pragma unroll
            for (int m = 0; m < 4; ++m) { const int r = row0 + ai * HALF + m * 16;
#pragma unroll
                for (int bj = 0; bj < 2; ++bj) { const int c = col0 + bj * HALF; const v4u yw = *(const v4u*)(y1 + (size_t)r * 8192 + c);
                    const f32x4 a0 = acc[ai][bj][m][0], a1 = acc[ai][bj][m][1];
                    const float o0 = gelu_tanh_f(a0[0] + bflo(yw.x)), o1 = gelu_tanh_f(a0[1] + bfhi(yw.x)), o2 = gelu_tanh_f(a0[2] + bflo(yw.y)), o3 = gelu_tanh_f(a0[3] + bfhi(yw.y));
                    const float o4 = gelu_tanh_f(a1[0] + bflo(yw.z)), o5 = gelu_tanh_f(a1[1] + bfhi(yw.z)), o6 = gelu_tanh_f(a1[2] + bflo(yw.w)), o7 = gelu_tanh_f(a1[3] + bfhi(yw.w));
                    v4u w; w.x = cvt_pk_bf16(o0, o1); w.y = cvt_pk_bf16(o2, o3); w.z = cvt_pk_bf16(o4, o5); w.w = cvt_pk_bf16(o6, o7);
                    *(v4u*)(base + ((size_t)r * 16 + (c >> 4)) * 1536 + (c & 15)) = w; }
                asm volatile("" ::: "memory"); }
    }
};
}

struct Params { const float* in[32]; float* out; unsigned char* ws; int ph_lo, ph_hi; };
enum { I_X = 0, I_C, I_CTX, I_CCTX, I_WMOD, I_BMOD, I_LNG, I_LNB, I_EV_WIN, I_EV_WOUT, I_EV_SINK, I_EV_W1, I_EV_W3, I_EV_W2, I_OD_WIN, I_A_RE, I_A_IM, I_LOG_DT,
       I_B_RE, I_B_IM, I_C_RE, I_C_IM, I_SSM_D, I_WGLU, I_BGLU, I_WS, I_BS, I_OD_WOUT, I_ROUTER, I_MW1, I_MW3, I_MW2 };

constexpr int LDS_RING = 131072, LDS_MISC = LDS_RING + 320, LDS_BYTES = 147456;
constexpr int NWAVES = 8, NTHREADS = 512;

struct Frame {
    LAS unsigned char* lds;
    int tid, lane, wave, G, bid, gw, NGW;
    unsigned char* ws;
    unsigned* ctl;
};

using pg8::Unit;
struct SchedStd {
    int nN, nUnits, G, c; const char* A; const char* B; char* O; size_t aStep, bStep, oRow, oCol; int ldo, act_from;
    __device__ __forceinline__ bool next(int i, Unit& u) const {
        const int L = i * G + c; if (L >= nUnits) return false;
        const int pm = L / nN, pn = L - pm * nN;
        u.a = A + (size_t)pm * aStep; u.b = B + (size_t)pn * bStep; u.o = O + (size_t)pm * oRow + (size_t)pn * oCol; u.p0 = nullptr; u.p1 = nullptr; u.ldo = ldo; u.x0 = (pn >= act_from) ? 1 : 0; return true;
    }
};
struct SchedEvIn {
    int G, c; const char* H; const char* Wqkv; const char* Wpq; char* QKV; char* PQT; char* PQTC;
    __device__ __forceinline__ bool next(int i, Unit& u) const {
        int L = i * G + c; u.p0 = nullptr; u.p1 = nullptr; u.x0 = 0;
        constexpr int NQ = (T / 256) * 3, NP = 4 * (TL / 256), NPC = 4 * (TC / 256);
        if (L < NQ) { const int pm = L / 3, pn = L - pm * 3;
            u.a = H + (size_t)pm * 256 * D * 2; u.b = Wqkv + (size_t)pn * 256 * D * 2; u.o = QKV + ((size_t)pm * 256 * 768 + pn * 256) * 2; u.ldo = 768; return true; }
        L -= NQ;
        if (L < NP) { const int tt = L >> 2, pm = L & 3, b = tt >> 4, n0 = (tt & 15) * 256, isq = pm >> 1, ch0 = (pm & 1) * 256;
            u.a = Wpq + (size_t)pm * 256 * D * 2; u.b = H + (size_t)tt * 256 * D * 2;
            u.o = PQT + ((((size_t)b * 512 + ch0) * 2 + isq) * 4096 + n0) * 2; u.ldo = 8192; return true; }
        L -= NP;
        if (L < NPC) { const int b = L >> 2, pm = L & 3, isq = pm >> 1, ch0 = (pm & 1) * 256;
            u.a = Wpq + (size_t)pm * 256 * D * 2; u.b = H + ((size_t)TL + (size_t)b * 256) * D * 2;
            u.o = PQTC + (((size_t)b * 512 + ch0) * 2 + isq) * 256 * 2; u.ldo = 512; return true; }
        return false;
    }
};
struct SchedDft {
    int G, c; const char* FDm; const char* VB; const char* F2; const char* PQTC; char* MIX;
    __device__ __forceinline__ bool next(int i, Unit& u) const {
        int L = i * G + c; u.p0 = nullptr; u.p1 = nullptr; u.x0 = 0;
        if (L < 512) { const int b = L >> 5, pn = L & 31, k2 = pn >> 1, ch0 = (pn & 1) * 256;
            u.a = FDm; u.b = VB + ((((size_t)b * 16 + k2) * 512 + ch0) * 512) * 2; u.o = MIX + ((((size_t)b * 4096 + k2) * D) + ch0) * 2; u.ldo = 16 * D; return true; }
        L -= 512; if (L >= 32) return false;
        const int b = L >> 1, pn = L & 1;
        u.a = F2; u.b = PQTC + ((size_t)b * 512 + pn * 256) * 512 * 2; u.o = MIX + (((size_t)TL + (size_t)b * 256) * D + pn * 256) * 2; u.ldo = D; return true;
    }
};
struct SchedResid {
    int G, c, nUnits; const char* A; size_t aStep; const char* W; size_t bStep; const float* xl; const float* xc; float* zl; float* zc; const float* gate;
    __device__ __forceinline__ bool next(int i, Unit& u) const {
        const int L = i * G + c; if (L >= nUnits) return false;
        const int pm = L >> 2, pn = L & 3;
        u.a = A + (size_t)pm * aStep; u.b = W + (size_t)pn * bStep;
        const bool isc = pm >= TL / 256; const int pr = isc ? pm - TL / 256 : pm; const int mrow = isc ? 16 : (pm >> 4);
        const size_t off = ((size_t)pr * 256 * D + pn * 256);
        u.p0 = (const char*)((isc ? xc : xl) + off); u.o = (char*)((isc ? zc : zl) + off); u.p1 = (const char*)(gate + (size_t)mrow * 6144 + pn * 256); u.ldo = D; u.x0 = 0; return true;
    }
};
struct SchedGlu {
    int G, c; const char* P; const char* W; char* MIX; const float* bias;
    __device__ __forceinline__ bool next(int i, Unit& u) const {
        const int L = i * G + c; if (L >= (T / 256) * 2) return false;
        const int pm = L >> 1, pn = L & 1;
        u.a = P + (size_t)pm * 256 * 1536 * 2; u.b = W + (size_t)pn * 256 * 512 * 2; u.o = MIX + ((size_t)pm * 256 * D + pn * 256) * 2;
        u.p0 = P + ((size_t)pm * 256 * 1536 + pn * 256) * 2; u.p1 = (const char*)(bias + pn * 256); u.ldo = D; u.x0 = 1536; return true;
    }
};
struct SchedS5A {
    int G, c; const char* P; const char* WA; char* Y1; char* HB;
    __device__ __forceinline__ bool next(int i, Unit& u) const {
        const int L = i * G + c; if (L >= 32 * 34) return false;
        const int g = L / 34, rem = L - g * 34, pm = rem >> 1, pn = rem & 1;
        u.a = P + ((size_t)pm * 256 * 16 * 1536 + g * 16) * 2; u.b = WA + (size_t)g * S5M_STRIDE + (size_t)pn * 256 * 256 * 2;
        u.o = (pn ? HB : Y1) + (((size_t)pm * 256 * 32 + g) * 256) * 2; u.p0 = nullptr; u.p1 = nullptr; u.ldo = 8192; u.x0 = 0; return true;
    }
};
struct SchedS5B {
    int G, c; const char* HB; const char* CL; const char* Y1; char* P;
    __device__ __forceinline__ bool next(int i, Unit& u) const {
        const int L = i * G + c; if (L >= 32 * 17) return false;
        const int g = L / 17, pm = L - g * 17;
        const size_t toff = (((size_t)pm * 256 * 32 + g) * 256) * 2;
        u.a = HB + toff; u.b = CL + (size_t)g * S5M_STRIDE; u.p0 = Y1 + toff; u.o = P + ((size_t)pm * 256 * 16 * 1536 + g * 16) * 2; u.p1 = nullptr; u.ldo = 0; u.x0 = 0; return true;
    }
};
struct SchedMoeUp {
    int G, c, nUnits, rt0; int toff[9]; const char* HS; const char* W; char* HID;
    __device__ __forceinline__ bool next(int i, Unit& u) const {
        const int L = i * G + c; if (L >= nUnits) return false;
        const int rl = L / 28, pn = L - rl * 28, rt = rt0 + rl; int e = 0;
#pragma unroll
        for (int k = 1; k < 8; ++k) e += (rt >= toff[k]) ? 1 : 0;
        u.a = HS + (size_t)rt * 256 * D; u.b = W + ((size_t)e * 7168 + pn * 256) * D; u.o = HID + ((size_t)rl * 256 * EH + pn * 128);
        u.p0 = nullptr; u.p1 = nullptr; u.ldo = EH; u.x0 = 0; return true;
    }
};
struct SchedMoeDown {
    int G, c, nUnits, rt0; int toff[9]; const char* HID; const char* W; char* Y;
    __device__ __forceinline__ bool next(int i, Unit& u) const {
        const int L = i * G + c; if (L >= nUnits) return false;
        const int rl = L >> 2, pn = L & 3, rt = rt0 + rl; int e = 0;
#pragma unroll
        for (int k = 1; k < 8; ++k) e += (rt >= toff[k]) ? 1 : 0;
        u.a = HID + (size_t)rl * 256 * EH; u.b = W + ((size_t)e * 1024 + pn * 256) * EH; u.o = Y + ((size_t)rt * 256 * D + pn * 256) * 2;
        u.p0 = nullptr; u.p1 = nullptr; u.ldo = D; u.x0 = 0; return true;
    }
};

__device__ __forceinline__ void tr_item(const float* W, int ldn, bf16* WT, int ldk, int k0, int n0, int drow0, LAS float* scr, int lane) {
#pragma unroll 8
    for (int i = 0; i < 32; ++i) { const int kk = 2 * i + (lane >> 5); scr[kk * 33 + (lane & 31)] = W[(size_t)(k0 + kk) * ldn + n0 + (lane & 31)]; }
    LDS_WAIT(); asm volatile("" ::: "memory");
    const int c = lane & 7;
#pragma unroll
    for (int j = 0; j < 4; ++j) { const int n = (lane >> 3) + 8 * j; const LAS float* s = scr + (8 * c) * 33 + n;
        v4u o; o.x = cvt_pk_bf16(s[0 * 33], s[1 * 33]); o.y = cvt_pk_bf16(s[2 * 33], s[3 * 33]); o.z = cvt_pk_bf16(s[4 * 33], s[5 * 33]); o.w = cvt_pk_bf16(s[6 * 33], s[7 * 33]);
        *(v4u*)(WT + (size_t)(drow0 + n) * ldk + k0 + 8 * c) = o; }
    LDS_WAIT(); asm volatile("" ::: "memory");
}
__device__ __forceinline__ void tr_item8(const float* W, int ldn, unsigned char* WT, int ldk, int k0, int n0, int drow0, LAS float* scr, int lane, float qs) {
#pragma unroll 8
    for (int i = 0; i < 32; ++i) { const int kk = 2 * i + (lane >> 5); scr[kk * 33 + (lane & 31)] = W[(size_t)(k0 + kk) * ldn + n0 + (lane & 31)] * qs; }
    LDS_WAIT(); asm volatile("" ::: "memory");
    const int c = lane & 7;
#pragma unroll
    for (int j = 0; j < 4; ++j) { const int n = (lane >> 3) + 8 * j; const LAS float* sp = scr + (8 * c) * 33 + n;
        v2u o; o.x = pk_fp8x4(sp[0 * 33], sp[1 * 33], sp[2 * 33], sp[3 * 33]); o.y = pk_fp8x4(sp[4 * 33], sp[5 * 33], sp[6 * 33], sp[7 * 33]);
        *(v2u*)(WT + (size_t)(drow0 + n) * ldk + k0 + 8 * c) = o; }
    LDS_WAIT(); asm volatile("" ::: "memory");
}
__device__ __forceinline__ void tr_job8(const float* W, int ldn, int N, unsigned char* WT, int ldk, int mode, int roff, int item, LAS float* scr, int lane) {
    const int nblk = N / 32, kb = item / nblk, nb = item - kb * nblk, n0 = nb * 32;
    const int drow0 = mode ? ((n0 >> 7) * 256 + (n0 & 127) + roff) : (roff + n0);
    tr_item8(W, ldn, WT, ldk, kb * 64, n0, drow0, scr, lane, Q_W);
}
__device__ __forceinline__ void tr_job(const float* W, int ldn, int N, bf16* WT, int ldk, int mode, int roff, int item, LAS float* scr, int lane) {
    const int nblk = N / 32, kb = item / nblk, nb = item - kb * nblk, n0 = nb * 32;
    const int drow0 = mode ? ((n0 >> 7) * 256 + (n0 & 127) + roff) : (roff + n0);
    tr_item(W, ldn, WT, ldk, kb * 64, n0, drow0, scr, lane);
}
__device__ __forceinline__ void cvt_item(const Params& p, int r, LAS float* scr, int lane) {
    unsigned char* ws = p.ws;
    constexpr int EV_ITEMS = 384 + 512 + 3 * 1408;
    constexpr int ODS_ITEMS = 768 + 128 + 512;
    constexpr int EXP_ITEMS = 3 * 1792, MOE_ITEMS = 8 * EXP_ITEMS;
    if (r < 2 * EV_ITEMS) { const int li = r / EV_ITEMS; r -= li * EV_ITEMS; unsigned char* base = ws + WS_EV + li * EV_STRIDE;
        if (r < 384) { tr_job(p.in[I_EV_WIN] + (size_t)li * D * 1280 + 512, 1280, 768, (bf16*)(base + EV_WQKV), D, 0, 0, r, scr, lane); return; } r -= 384;
        if (r < 512) { tr_job(p.in[I_EV_WOUT] + (size_t)li * D * D, D, D, (bf16*)(base + EV_WOUT), D, 0, 0, r, scr, lane); return; } r -= 512;
        if (r < 1408) { tr_job(p.in[I_EV_W1] + (size_t)li * D * FFH, FFH, FFH, (bf16*)(base + EV_W13), D, 1, 0, r, scr, lane); return; } r -= 1408;
        if (r < 1408) { tr_job(p.in[I_EV_W3] + (size_t)li * D * FFH, FFH, FFH, (bf16*)(base + EV_W13), D, 1, 128, r, scr, lane); return; } r -= 1408;
        tr_job(p.in[I_EV_W2] + (size_t)li * FFH * D, D, D, (bf16*)(base + EV_W2), FFH, 0, 0, r, scr, lane); return; }
    r -= 2 * EV_ITEMS;
    if (r < 2 * ODS_ITEMS) { const int li = r / ODS_ITEMS; r -= li * ODS_ITEMS; unsigned char* base = ws + WS_OD + li * OD_STRIDE;
        if (r < 768) { tr_job(p.in[I_OD_WIN] + (size_t)li * D * 1536, 1536, 1536, (bf16*)(base + OD_WIN), D, 0, 0, r, scr, lane); return; } r -= 768;
        if (r < 128) { tr_job(p.in[I_WGLU] + (size_t)li * 512 * 512, 512, 512, (bf16*)(base + OD_WGLU), 512, 0, 0, r, scr, lane); return; } r -= 128;
        tr_job(p.in[I_OD_WOUT] + (size_t)li * D * D, D, D, (bf16*)(base + OD_WOUT), D, 0, 0, r, scr, lane); return; }
    r -= 2 * ODS_ITEMS;
    { const int li = r / MOE_ITEMS; r -= li * MOE_ITEMS; const int e = r / EXP_ITEMS; r -= e * EXP_ITEMS; unsigned char* base = ws + WS_OD + li * OD_STRIDE;
        const size_t we = (size_t)li * NEXP + e;
        if (r < 1792) { tr_job8(p.in[I_MW1] + we * D * EH, EH, EH, (unsigned char*)(base + OD_MW13) + (size_t)e * 7168 * D, D, 1, 0, r, scr, lane); return; } r -= 1792;
        if (r < 1792) { tr_job8(p.in[I_MW3] + we * D * EH, EH, EH, (unsigned char*)(base + OD_MW13) + (size_t)e * 7168 * D, D, 1, 128, r, scr, lane); return; } r -= 1792;
        tr_job8(p.in[I_MW2] + we * EH * D, D, D, (unsigned char*)(base + OD_MW2) + (size_t)e * D * EH, EH, 0, 0, r, scr, lane); }
}
constexpr int CVT_ITEMS = 2 * 5120 + 2 * 1408 + 2 * 8 * 3 * 1792;

__device__ __forceinline__ void fold_unit(const Params& p, Frame& F, int unit) {
    const int li = unit >> 6, g = (unit >> 4) & 3, k0 = (unit & 15) * 64;
    LAS float* tile = (LAS float*)F.lds;
    LAS float* trig = tile + 64 * 129;
    const float* W = p.in[I_EV_WIN] + (size_t)li * D * 1280;
    for (int e = F.tid; e < 64 * 128; e += NTHREADS) { const int k = e >> 7, c = e & 127; tile[k * 129 + c] = W[(size_t)(k0 + k) * 1280 + g * 128 + c]; }
    if (F.tid < 128) { float s, c; sincospif((float)F.tid / 64.0f, &s, &c); trig[F.tid] = c * 0.08838834764831845f; trig[128 + F.tid] = s * 0.08838834764831845f; }
    __syncthreads();
    bf16* WT = (bf16*)(p.ws + WS_EV + li * EV_STRIDE + EV_WPQ);
    const int k = F.lane, mg = F.wave;
    for (int mm = 0; mm < 16; ++mm) { const int m = mg * 16 + mm; float sp = 0.f, sq = 0.f;
        for (int c = 0; c < 128; ++c) { const float w = tile[k * 129 + c]; const int ph = (m * c) & 127; sp += w * trig[ph]; sq += w * trig[128 + ph]; }
        WT[(size_t)(g * 128 + m) * D + k0 + k] = f2bf(sp); WT[(size_t)(512 + g * 128 + m) * D + k0 + k] = f2bf(sq); }
    __syncthreads();
}

__device__ __forceinline__ void row_load(const float* row, int lane, f32x4 (&v)[4]) {
#pragma unroll
    for (int j = 0; j < 4; ++j) v[j] = *(const f32x4*)(row + 256 * j + 4 * lane);
}
__device__ __forceinline__ void row_store(float* row, int lane, const f32x4 (&v)[4]) {
#pragma unroll
    for (int j = 0; j < 4; ++j) *(f32x4*)(row + 256 * j + 4 * lane) = v[j];
}
__device__ __forceinline__ void row_store_bf16(bf16* row, int lane, const f32x4 (&v)[4]) {
#pragma unroll
    for (int j = 0; j < 4; ++j) { v2u w; w.x = cvt_pk_bf16(v[j][0], v[j][1]); w.y = cvt_pk_bf16(v[j][2], v[j][3]); *(v2u*)(row + 256 * j + 4 * lane) = w; }
}
__device__ __forceinline__ void row_layernorm(f32x4 (&v)[4], const float* g, const float* b, int lane) {
    float s = 0.f;
#pragma unroll
    for (int j = 0; j < 4; ++j) s += (v[j][0] + v[j][1]) + (v[j][2] + v[j][3]);
    const float mean = wave_sum(s) * (1.f / D); float q = 0.f;
#pragma unroll
    for (int j = 0; j < 4; ++j) { v[j] = v[j] - mean; q += (v[j][0] * v[j][0] + v[j][1] * v[j][1]) + (v[j][2] * v[j][2] + v[j][3] * v[j][3]); }
    const float rstd = rsqrtf(wave_sum(q) * (1.f / D) + LN_EPS);
#pragma unroll
    for (int j = 0; j < 4; ++j) { const f32x4 gg = *(const f32x4*)(g + 256 * j + 4 * lane), bb = *(const f32x4*)(b + 256 * j + 4 * lane); v[j] = v[j] * rstd * gg + bb; }
}
__device__ __forceinline__ void row_modulate(f32x4 (&h)[4], const f32x4 (&v)[4], const float* sc, const float* sh, int lane) {
#pragma unroll
    for (int j = 0; j < 4; ++j) { const f32x4 s = *(const f32x4*)(sc + 256 * j + 4 * lane), t = *(const f32x4*)(sh + 256 * j + 4 * lane); h[j] = v[j] * (s + 1.0f) + t; }
}

__device__ __forceinline__ void row_ln_pre(f32x4 (&v)[4], const f32x4 (&gg)[4], const f32x4 (&bb)[4]) {
    float s = 0.f;
#pragma unroll
    for (int j = 0; j < 4; ++j) s += (v[j][0] + v[j][1]) + (v[j][2] + v[j][3]);
    const float mean = wave_sum(s) * (1.f / D); float q = 0.f;
#pragma unroll
    for (int j = 0; j < 4; ++j) { v[j] = v[j] - mean; q += (v[j][0] * v[j][0] + v[j][1] * v[j][1]) + (v[j][2] * v[j][2] + v[j][3] * v[j][3]); }
    const float rstd = rsqrtf(wave_sum(q) * (1.f / D) + LN_EPS);
#pragma unroll
    for (int j = 0; j < 4; ++j) v[j] = v[j] * rstd * gg[j] + bb[j];
}
__device__ __forceinline__ void row_load_mod(const float* sc, const float* sh, int lane, f32x4 (&s)[4], f32x4 (&t)[4]) {
#pragma unroll
    for (int j = 0; j < 4; ++j) { s[j] = *(const f32x4*)(sc + 256 * j + 4 * lane); t[j] = *(const f32x4*)(sh + 256 * j + 4 * lane); }
}
typedef const __attribute__((address_space(4))) Params* PP;
#define PIN(i) ((const float*)pp->in[i])
#define DECL_LDS extern __shared__ __attribute__((aligned(16))) unsigned char lds_raw[]
#define PHASE_FN static __device__ __forceinline__ void

__device__ __forceinline__ Frame make_frame(PP pp, unsigned char* lds_generic) {
    Frame F;
    F.lds = (LAS unsigned char*)lds_generic;
    { int t_ = threadIdx.x; asm volatile("" : "+v"(t_)); F.tid = t_; }
    F.lane = F.tid & 63; F.wave = __builtin_amdgcn_readfirstlane(F.tid >> 6);
    F.G = gridDim.x; F.bid = blockIdx.x; F.gw = F.bid * NWAVES + F.wave; F.NGW = F.G * NWAVES;
    F.ws = (unsigned char*)pp->ws; F.ctl = (unsigned*)(F.ws + WS_CTL);
    return F;
}
#define FRAME() DECL_LDS; asm volatile("" : "+s"(pp)); Frame F = make_frame(pp, lds_raw); unsigned char* ws = F.ws; (void)ws

PHASE_FN grid_bar(PP pp) {
    FRAME();
    XcdBarrier bar; bar.bar = F.ctl + CW_BAR; bar.x = xb_xcc_id(); bar.st = (volatile LAS unsigned*)(F.lds + LDS_MISC) + 8;
    xcd_barrier(bar);
}

static __device__ __forceinline__ void ln_pass(const Frame& F, float* out, float* XC, bf16* Hb, const float* lng, const float* lnb, const float* modv, const int sc_off, const int sh_off, const int TR) {
    f32x4 gg[4], bb[4];
#pragma unroll
    for (int j = 0; j < 4; ++j) { gg[j] = *(const f32x4*)(lng + 256 * j + 4 * F.lane); bb[j] = *(const f32x4*)(lnb + 256 * j + 4 * F.lane); }
    for (int r0 = F.gw; r0 < TR; r0 += 2 * F.NGW) {
        const int r1 = r0 + F.NGW; const bool two = r1 < TR;
        const bool c0 = r0 >= TL, c1 = r1 >= TL;
        float* x0 = c0 ? XC + (size_t)(r0 - TL) * D : out + (size_t)r0 * D; float* x1 = two ? (c1 ? XC + (size_t)(r1 - TL) * D : out + (size_t)r1 * D) : x0;
        const float* m0 = modv + (size_t)(c0 ? 16 : (r0 >> 12)) * 6144; const float* m1 = modv + (size_t)((two && !c1) ? (r1 >> 12) : 16) * 6144;
        f32x4 v0[4], v1[4], s0[4], t0[4], s1[4], t1[4];
        row_load(x0, F.lane, v0); row_load(x1, F.lane, v1);
        row_load_mod(m0 + sc_off, m0 + sh_off, F.lane, s0, t0); row_load_mod(m1 + sc_off, m1 + sh_off, F.lane, s1, t1);
        row_ln_pre(v0, gg, bb); row_ln_pre(v1, gg, bb);
        row_store(x0, F.lane, v0);
#pragma unroll
        for (int j = 0; j < 4; ++j) s0[j] = v0[j] * (s0[j] + 1.0f) + t0[j];
        row_store_bf16(Hb + (size_t)r0 * D, F.lane, s0);
        if (two) { row_store(x1, F.lane, v1);
#pragma unroll
            for (int j = 0; j < 4; ++j) s1[j] = v1[j] * (s1[j] + 1.0f) + t1[j];
            row_store_bf16(Hb + (size_t)r1 * D, F.lane, s1); }
    }
}
PHASE_FN ph_fold(PP pp) {
    FRAME();
    Params p; p.ws = ws; p.in[I_EV_WIN] = PIN(I_EV_WIN);
    for (int u = F.bid; u < 128; u += F.G) fold_unit(p, F, u);
}
PHASE_FN ph_mod(PP pp) {
    FRAME();
    float* MOD = (float*)(ws + WS_MOD);
    LAS float* sc = (LAS float*)F.lds;
    const float* cin = PIN(I_C); const float* ccin = PIN(I_CCTX);
    for (int e = F.tid; e < 17 * D; e += NTHREADS) { const int r = e >> 10, k = e & 1023; const float v = (r < 16) ? cin[r * D + k] : ccin[k]; sc[e] = silu_f(v); }
    __syncthreads();
    for (int grp = F.gw; grp < DEPTH * 6144 / 64; grp += F.NGW) {
        const int col = grp * 64 + F.lane, l = col / 6144, j = col - l * 6144;
        const float* W = PIN(I_WMOD) + (size_t)l * D * 6144 + j;
        float acc[17];
#pragma unroll
        for (int r = 0; r < 17; ++r) acc[r] = 0.f;
        for (int k = 0; k < D; k += 4) {
            const float w0 = W[(size_t)(k + 0) * 6144], w1 = W[(size_t)(k + 1) * 6144], w2 = W[(size_t)(k + 2) * 6144], w3 = W[(size_t)(k + 3) * 6144];
#pragma unroll
            for (int r = 0; r < 17; ++r) { const f32x4 s = *(const LAS f32x4*)(sc + r * D + k); acc[r] += s[0] * w0 + s[1] * w1 + s[2] * w2 + s[3] * w3; }
        }
        const float bm = PIN(I_BMOD)[l * 6144 + j];
#pragma unroll
        for (int r = 0; r < 17; ++r) MOD[((size_t)l * 17 + r) * 6144 + j] = acc[r] + bm;
    }
    __syncthreads();
}
PHASE_FN ph_cvt(PP pp) {
    FRAME();
    Params p; p.ws = ws;
    p.in[I_EV_WIN] = PIN(I_EV_WIN); p.in[I_EV_WOUT] = PIN(I_EV_WOUT); p.in[I_EV_W1] = PIN(I_EV_W1); p.in[I_EV_W3] = PIN(I_EV_W3); p.in[I_EV_W2] = PIN(I_EV_W2);
    p.in[I_OD_WIN] = PIN(I_OD_WIN); p.in[I_WGLU] = PIN(I_WGLU); p.in[I_OD_WOUT] = PIN(I_OD_WOUT); p.in[I_MW1] = PIN(I_MW1); p.in[I_MW3] = PIN(I_MW3); p.in[I_MW2] = PIN(I_MW2);
    LAS float* scr = (LAS float*)(F.lds + F.wave * 16384);
    for (int it = F.gw; it < CVT_ITEMS; it += F.NGW) cvt_item(p, it, scr, F.lane);
}
PHASE_FN ph_dftmat(PP pp) {
    FRAME();
    bf16* FDm = (bf16*)(ws + WS_FD); bf16* F2 = (bf16*)(ws + WS_F256);
    for (int it = F.bid * NTHREADS + F.tid; it < 2 * 256 * 64; it += F.G * NTHREADS) {
        const int which = it >> 14, k = (it >> 6) & 255, n0 = (it & 63) * 8; const bool isq = n0 >= 256; const int nb = n0 & 255;
        float v[8];
#pragma unroll
        for (int j = 0; j < 8; ++j) { const int phs = (k * (nb + j)) & 255; float sn, cs; sincospif((float)phs * (1.0f / 128.0f), &sn, &cs);
            v[j] = which ? (isq ? -sn * (1.f / 16.f) : cs * (1.f / 16.f)) : (isq ? sn * (1.f / 64.f) : cs * (1.f / 64.f)); }
        v4u w; w.x = cvt_pk_bf16(v[0], v[1]); w.y = cvt_pk_bf16(v[2], v[3]); w.z = cvt_pk_bf16(v[4], v[5]); w.w = cvt_pk_bf16(v[6], v[7]);
        *(v4u*)((which ? F2 : FDm) + (size_t)k * 512 + n0) = w;
    }
}
PHASE_FN ph_s5mat(PP pp) {
    FRAME();
    LAS float* lam = (LAS float*)F.lds;
    LAS float* bb = lam + 2 * 64 * 17 * 2;
    LAS float* cc = bb + 2 * 64 * 16 * 2;
    LAS float* kt = cc + 2 * 16 * 64 * 2;
    for (int unit = F.bid; unit < 64; unit += F.G) {
        const int li = unit >> 5, g = unit & 31;
        __syncthreads();
        if (F.tid < 128) { const int d = F.tid >> 6, pl = F.tid & 63; const int sidx = ((li * 2 + d) * 32 + g);
            const float are = PIN(I_A_RE)[sidx * 64 + pl], aim = PIN(I_A_IM)[sidx * 64 + pl], dt = expf(PIN(I_LOG_DT)[sidx]);
            for (int e = 0; e <= 16; ++e) { const float mag = expf(are * dt * (float)e); float sn, cn; sincosf(aim * dt * (float)e, &sn, &cn); lam[((d * 64 + pl) * 17 + e) * 2] = mag * cn; lam[((d * 64 + pl) * 17 + e) * 2 + 1] = mag * sn; } }
        __syncthreads();
        for (int e = F.tid; e < 2048; e += NTHREADS) { const int d = e >> 10, pl = (e >> 4) & 63, sp = e & 15; const int sidx = ((li * 2 + d) * 32 + g);
            const float are = PIN(I_A_RE)[sidx * 64 + pl], aim = PIN(I_A_IM)[sidx * 64 + pl];
            const float lre = lam[((d * 64 + pl) * 17 + 1) * 2], lim = lam[((d * 64 + pl) * 17 + 1) * 2 + 1];
            const float den = 1.0f / (are * are + aim * aim);
            const float fre = ((lre - 1.0f) * are + lim * aim) * den, fim = (lim * are - (lre - 1.0f) * aim) * den;
            const float br = PIN(I_B_RE)[((size_t)sidx * 64 + pl) * 16 + sp], bi = PIN(I_B_IM)[((size_t)sidx * 64 + pl) * 16 + sp];
            bb[e * 2] = fre * br - fim * bi; bb[e * 2 + 1] = fre * bi + fim * br; }
        for (int e = F.tid; e < 2048; e += NTHREADS) { const int d = e >> 10, sq = (e >> 6) & 15, pl = e & 63; const int sidx = ((li * 2 + d) * 32 + g);
            cc[e * 2] = PIN(I_C_RE)[((size_t)sidx * 16 + sq) * 64 + pl]; cc[e * 2 + 1] = PIN(I_C_IM)[((size_t)sidx * 16 + sq) * 64 + pl]; }
        __syncthreads();
        for (int e = F.tid; e < 8192; e += NTHREADS) { const int d = e >> 12, tau = (e >> 8) & 15, sq = (e >> 4) & 15, sp = e & 15; float acc = 0.f;
            for (int pl = 0; pl < 64; ++pl) { const float cr = cc[((d * 16 + sq) * 64 + pl) * 2], ci = cc[((d * 16 + sq) * 64 + pl) * 2 + 1];
                const float lr = lam[((d * 64 + pl) * 17 + tau) * 2], lj = lam[((d * 64 + pl) * 17 + tau) * 2 + 1];
                const float br = bb[((d * 64 + pl) * 16 + sp) * 2], bi = bb[((d * 64 + pl) * 16 + sp) * 2 + 1];
                const float tr = cr * lr - ci * lj, ti = cr * lj + ci * lr;
                acc += tr * br - ti * bi; }
            kt[e] = acc; }
        __syncthreads();
        bf16* WA = (bf16*)(ws + WS_S5M + (size_t)unit * S5M_STRIDE); bf16* CLm = WA + 512 * 256;
        const float* dsk = PIN(I_SSM_D) + (size_t)li * 512 + g * 16;
        for (int it = F.tid; it < 8192; it += NTHREADS) { const int row = it >> 5, c0 = (it & 31) * 8;
            float v[8];
            { const int i = row >> 4, sq = row & 15, j = c0 >> 4, sp0 = c0 & 15;
#pragma unroll
              for (int q = 0; q < 8; ++q) { const int sp = sp0 + q; float a = 0.f; if (i >= j) a += kt[((0 * 16 + (i - j)) * 16 + sq) * 16 + sp]; if (j >= i) a += kt[((1 * 16 + (j - i)) * 16 + sq) * 16 + sp]; if (i == j && sq == sp) a += dsk[sq]; v[q] = a; }
              v4u w; w.x = cvt_pk_bf16(v[0], v[1]); w.y = cvt_pk_bf16(v[2], v[3]); w.z = cvt_pk_bf16(v[4], v[5]); w.w = cvt_pk_bf16(v[6], v[7]); *(v4u*)(WA + (size_t)row * 256 + c0) = w; }
            { const int d = row >> 7, pl = (row >> 1) & 63, ri = row & 1, j = c0 >> 4, sp0 = c0 & 15, e = d ? j : 15 - j;
              const float lr = lam[((d * 64 + pl) * 17 + e) * 2], lj = lam[((d * 64 + pl) * 17 + e) * 2 + 1];
#pragma unroll
              for (int q = 0; q < 8; ++q) { const float br = bb[((d * 64 + pl) * 16 + sp0 + q) * 2], bi = bb[((d * 64 + pl) * 16 + sp0 + q) * 2 + 1]; v[q] = ri ? (lr * bi + lj * br) : (lr * br - lj * bi); }
              v4u w; w.x = cvt_pk_bf16(v[0], v[1]); w.y = cvt_pk_bf16(v[2], v[3]); w.z = cvt_pk_bf16(v[4], v[5]); w.w = cvt_pk_bf16(v[6], v[7]); *(v4u*)(WA + (size_t)(256 + row) * 256 + c0) = w; }
            { const int i = row >> 4, sq = row & 15, d = c0 >> 7, pl0 = (c0 >> 1) & 63, e = d ? 16 - i : i + 1;
#pragma unroll
              for (int q = 0; q < 4; ++q) { const int pl = pl0 + q; const float cr = cc[((d * 16 + sq) * 64 + pl) * 2], ci = cc[((d * 16 + sq) * 64 + pl) * 2 + 1];
                  const float lr = lam[((d * 64 + pl) * 17 + e) * 2], lj = lam[((d * 64 + pl) * 17 + e) * 2 + 1];
                  v[2 * q] = cr * lr - ci * lj; v[2 * q + 1] = -(cr * lj + ci * lr); }
              v4u w; w.x = cvt_pk_bf16(v[0], v[1]); w.y = cvt_pk_bf16(v[2], v[3]); w.z = cvt_pk_bf16(v[4], v[5]); w.w = cvt_pk_bf16(v[6], v[7]); *(v4u*)(CLm + (size_t)row * 256 + c0) = w; }
        }
    }
    __syncthreads();
}
PHASE_FN ph_pro_b(PP pp) {
    FRAME();
    const float* MOD = (const float*)(ws + WS_MOD); bf16* Hb = (bf16*)(ws + WS_H);
    const float* xin = PIN(I_X); const float* cin = PIN(I_CTX);
    for (int r = F.gw; r < T; r += F.NGW) {
        const bool isc = r >= TL; const float* xr = isc ? cin + (size_t)(r - TL) * D : xin + (size_t)r * D;
        const float* m = MOD + (size_t)(isc ? 16 : (r >> 12)) * 6144;
        f32x4 v[4], h[4]; row_load(xr, F.lane, v); row_modulate(h, v, m + 1024, m, F.lane); row_store_bf16(Hb + (size_t)r * D, F.lane, h);
    }
}

PHASE_FN ph_e1(PP pp, int layer) {
    FRAME();
    unsigned char* evw = ws + WS_EV + (layer >> 1) * EV_STRIDE; unsigned char* BIG = ws + WS_BIG;
    SchedEvIn S{F.G, F.bid, (const char*)(ws + WS_H), (const char*)(evw + EV_WQKV), (const char*)(evw + EV_WPQ), (char*)(BIG + BIG_QKV), (char*)(BIG + BIG_PQT), (char*)(BIG + BIG_PQTC)};
    pg8::gemm_phase<pg8::EpiStore, SchedEvIn, true, true>(F.lds, F.tid, pg8::Dims{D, D, D}, S, pg8::EpiStore{});
}
struct cf { float r, i; };
__device__ __forceinline__ cf cmul(cf a, float wr, float wi) { return cf{a.r * wr - a.i * wi, a.r * wi + a.i * wr}; }
__device__ __forceinline__ void radix4(cf x0, cf x1, cf x2, cf x3, cf& y0, cf& y1, cf& y2, cf& y3) {
    const cf s02{x0.r + x2.r, x0.i + x2.i}, d02{x0.r - x2.r, x0.i - x2.i}, s13{x1.r + x3.r, x1.i + x3.i}, d13{x1.r - x3.r, x1.i - x3.i};
    y0 = cf{s02.r + s13.r, s02.i + s13.i}; y2 = cf{s02.r - s13.r, s02.i - s13.i}; y1 = cf{d02.r + d13.i, d02.i - d13.r}; y3 = cf{d02.r - d13.i, d02.i + d13.r};
}
__device__ __forceinline__ void fft16(cf (&x)[16]) {
    constexpr float C1 = 0.92387953251128674f, S1 = 0.38268343236508977f, C2 = 0.70710678118654752f;
    cf A[4][4];
#pragma unroll
    for (int b = 0; b < 4; ++b) radix4(x[b], x[4 + b], x[8 + b], x[12 + b], A[b][0], A[b][1], A[b][2], A[b][3]);
    A[1][1] = cmul(A[1][1], C1, -S1); A[1][2] = cmul(A[1][2], C2, -C2); A[1][3] = cmul(A[1][3], S1, -C1);
    A[2][1] = cmul(A[2][1], C2, -C2); A[2][2] = cf{A[2][2].i, -A[2][2].r}; A[2][3] = cmul(A[2][3], -C2, -C2);
    A[3][1] = cmul(A[3][1], S1, -C1); A[3][2] = cmul(A[3][2], -C2, -C2); A[3][3] = cmul(A[3][3], -C1, S1);
#pragma unroll
    for (int c = 0; c < 4; ++c) radix4(A[0][c], A[1][c], A[2][c], A[3][c], x[c], x[c + 4], x[c + 8], x[c + 12]);
}
PHASE_FN ph_e2_fft(PP pp) {
    FRAME();
    const bf16* PQT = (const bf16*)(ws + WS_BIG + BIG_PQT); bf16* VB = (bf16*)(ws + WS_H);
    for (int it = F.bid * NTHREADS + F.tid; it < NBATCH * 512 * 128; it += F.G * NTHREADS) {
        const int n1 = (it & 127) * 2, ch = (it >> 7) & 511, b = it >> 16;
        const bf16* pp_ = PQT + ((size_t)(b * 512 + ch) * 2) * 4096 + n1; const bf16* qq_ = pp_ + 4096;
        unsigned pw[16], qw[16];
#pragma unroll
        for (int n2 = 0; n2 < 16; ++n2) { pw[n2] = *(const unsigned*)(pp_ + 256 * n2); qw[n2] = *(const unsigned*)(qq_ + 256 * n2); }
        unsigned ore[16], oim[16];
#pragma unroll
        for (int e = 0; e < 2; ++e) {
            cf x[16];
#pragma unroll
            for (int n2 = 0; n2 < 16; ++n2) { x[n2].r = e ? bfhi(pw[n2]) : bflo(pw[n2]); x[n2].i = -(e ? bfhi(qw[n2]) : bflo(qw[n2])); }
            fft16(x);
            float sn, cs; sincospif((float)(n1 + e) * (1.0f / 2048.0f), &sn, &cs);
            cf wk{cs, -sn};
#pragma unroll
            for (int k2 = 1; k2 < 16; ++k2) { x[k2] = cmul(x[k2], wk.r, wk.i); wk = cmul(wk, cs, -sn); }
#pragma unroll
            for (int k2 = 0; k2 < 16; ++k2) { const unsigned rr = cvt_pk_bf16(x[k2].r, 0.f) & 0xffffu, ii = cvt_pk_bf16(x[k2].i, 0.f) & 0xffffu;
                if (e) { ore[k2] |= rr << 16; oim[k2] |= ii << 16; } else { ore[k2] = rr; oim[k2] = ii; } }
        }
#pragma unroll
        for (int k2 = 0; k2 < 16; ++k2) { bf16* dst = VB + (((size_t)b * 16 + k2) * 512 + ch) * 512 + n1; *(unsigned*)dst = ore[k2]; *(unsigned*)(dst + 256) = oim[k2]; }
    }
}
PHASE_FN ph_e2_dft(PP pp) {
    FRAME();
    unsigned char* BIG = ws + WS_BIG;
    SchedDft S{F.G, F.bid, (const char*)(ws + WS_FD), (const char*)(ws + WS_H), (const char*)(ws + WS_F256), (const char*)(BIG + BIG_PQTC), (char*)(BIG + BIG_MIX)};
    pg8::gemm_phase<pg8::EpiStore, SchedDft, true, true>(F.lds, F.tid, pg8::Dims{512, 512, 512}, S, pg8::EpiStore{});
}
PHASE_FN ph_e2_rope(PP pp) {
    FRAME();
    bf16* QKV = (bf16*)(ws + WS_BIG + BIG_QKV);
    LAS f32x2* cs = (LAS f32x2*)F.lds;
    __syncthreads();
    for (int e = F.tid; e < 1024; e += NTHREADS) { const int pos = e >> 4, i = e & 15; const float inv = powf(10000.0f, -(float)i / 16.0f); float s, c; sincosf((float)pos * inv, &s, &c); cs[e] = (f32x2){c, s}; }
    __syncthreads();
    for (int it = F.bid * NTHREADS + F.tid; it < TL * 80; it += F.G * NTHREADS) {
        const int r = it / 80, q = it - r * 80, hh = q >> 3, ax = (q >> 2) & 1, i0 = (q & 3) * 4;
        const int n = r & 4095, pos = ax ? (n & 63) : (n >> 6);
        bf16* base = QKV + (size_t)r * 768 + hh * 64 + ax * 32 + i0;
        const v2u a = *(const v2u*)base, b = *(const v2u*)(base + 16);
        const float x1[4] = {bflo(a.x), bfhi(a.x), bflo(a.y), bfhi(a.y)}, x2[4] = {bflo(b.x), bfhi(b.x), bflo(b.y), bfhi(b.y)};
        float o1[4], o2[4];
#pragma unroll
        for (int j = 0; j < 4; ++j) { const f32x2 t = cs[pos * 16 + i0 + j]; o1[j] = x1[j] * t.x - x2[j] * t.y; o2[j] = x1[j] * t.y + x2[j] * t.x; }
        v2u wa, wb; wa.x = cvt_pk_bf16(o1[0], o1[1]); wa.y = cvt_pk_bf16(o1[2], o1[3]); wb.x = cvt_pk_bf16(o2[0], o2[1]); wb.y = cvt_pk_bf16(o2[2], o2[3]);
        *(v2u*)base = wa; *(v2u*)(base + 16) = wb;
    }
    bf16* VT = (bf16*)(ws + WS_BIG + BIG_VT);
    for (int it = F.bid * NTHREADS + F.tid; it < NBATCH * 2 * 544 * 64; it += F.G * NTHREADS) {
        const int d = it & 63, kg = (it >> 6) % 544, bh = (it >> 6) / 544, b = bh >> 1, hkv = bh & 1;
        const int key0 = kg * 8; const size_t row0 = (key0 < 256) ? ((size_t)TL + (size_t)b * 256 + key0) : ((size_t)b * 4096 + (key0 - 256));
        const bf16* src = QKV + row0 * 768 + 640 + hkv * 64 + d;
        unsigned short v[8];
#pragma unroll
        for (int j = 0; j < 8; ++j) v[j] = src[(size_t)j * 768];
        v4u w; w.x = v[0] | ((unsigned)v[1] << 16); w.y = v[2] | ((unsigned)v[3] << 16); w.z = v[4] | ((unsigned)v[5] << 16); w.w = v[6] | ((unsigned)v[7] << 16);
        *(v4u*)(VT + ((size_t)bh * 64 + d) * 4352 + key0) = w;
    }
    __syncthreads();
}
typedef float f32x16 __attribute__((ext_vector_type(16)));
typedef __bf16 bf16x2v __attribute__((ext_vector_type(2)));
__device__ __forceinline__ unsigned pk_bf16(float a, float b) { const bf16x2v t = __builtin_convertvector((f32x2){a, b}, bf16x2v); return __builtin_bit_cast(unsigned, t); }
constexpr int AT_KP = 144, AT_VP1 = 648, AT_VP2 = 520, AT_VOFF = 320 * AT_KP;
template <bool MASKED>
__device__ __forceinline__ void attn_tile(const LAS unsigned char* Ks, const LAS unsigned char* Vs, const int vpitch, const int kl_base, const bf16x8 (&qf)[4], f32x16& o0, f32x16& o1, float& m, float& l,
                                          const int r, const int h, const int kj0, const int qi) {
    f32x16 x;
#pragma unroll
    for (int i = 0; i < 16; ++i) x[i] = 0.f;
#pragma unroll
    for (int s = 0; s < 4; ++s) { const bf16x8 kf = *(const LAS bf16x8*)(Ks + (kl_base + r) * AT_KP + (16 * s + 8 * h) * 2); x = __builtin_amdgcn_mfma_f32_32x32x16_bf16(kf, qf[s], x, 0, 0, 0); }
    float sc[16]; float mt = -1e30f;
#pragma unroll
    for (int i = 0; i < 16; ++i) { float v = x[i] * 0.125f;
        if (MASKED) { const int kj = kj0 + (i & 3) + 8 * (i >> 2) + 4 * h; const bool ok = (kj >= 0) && (kj < SEQ) && (kj - qi <= 128) && (qi - kj <= 128); v = ok ? v : -1e30f; }
        sc[i] = v; mt = fmaxf(mt, v); }
    mt = fmaxf(mt, __shfl_xor(mt, 32));
    const float mn = fmaxf(m, mt), alpha = __expf(m - mn); m = mn;
    float ps = 0.f;
#pragma unroll
    for (int i = 0; i < 16; ++i) { sc[i] = __expf(sc[i] - mn); ps += sc[i]; }
    l = l * alpha + ps;
#pragma unroll
    for (int i = 0; i < 16; ++i) { o0[i] *= alpha; o1[i] *= alpha; }
#pragma unroll
    for (int s2 = 0; s2 < 2; ++s2) {
        v4u pw; pw.x = pk_bf16(sc[8 * s2 + 0], sc[8 * s2 + 1]); pw.y = pk_bf16(sc[8 * s2 + 2], sc[8 * s2 + 3]); pw.z = pk_bf16(sc[8 * s2 + 4], sc[8 * s2 + 5]); pw.w = pk_bf16(sc[8 * s2 + 6], sc[8 * s2 + 7]);
        const bf16x8 pk = __builtin_bit_cast(bf16x8, pw);
        { const LAS unsigned char* vp = Vs + r * vpitch + (kl_base + 16 * s2 + 4 * h) * 2; const v2u lo = *(const LAS v2u*)vp, hi = *(const LAS v2u*)(vp + 16);
          v4u vw; vw.x = lo.x; vw.y = lo.y; vw.z = hi.x; vw.w = hi.y; o0 = __builtin_amdgcn_mfma_f32_32x32x16_bf16(__builtin_bit_cast(bf16x8, vw), pk, o0, 0, 0, 0); }
        { const LAS unsigned char* vp = Vs + (32 + r) * vpitch + (kl_base + 16 * s2 + 4 * h) * 2; const v2u lo = *(const LAS v2u*)vp, hi = *(const LAS v2u*)(vp + 16);
          v4u vw; vw.x = lo.x; vw.y = lo.y; vw.z = hi.x; vw.w = hi.y; o1 = __builtin_amdgcn_mfma_f32_32x32x16_bf16(__builtin_bit_cast(bf16x8, vw), pk, o1, 0, 0, 0); }
    }
}
PHASE_FN ph_e3_attn(PP pp, int layer) {
    FRAME();
    const bf16* QKV = (const bf16*)(ws + WS_BIG + BIG_QKV); bf16* MIX = (bf16*)(ws + WS_BIG + BIG_MIX); const bf16* VT = (const bf16*)(ws + WS_BIG + BIG_VT);
    const float* sinkp = PIN(I_EV_SINK) + (layer >> 1) * 8;
    LAS unsigned char* Ks = F.lds; LAS unsigned char* Vs = F.lds + AT_VOFF;
    const int r = F.lane & 31, h = F.lane >> 5, g = F.wave >> 1, th = F.wave & 1;
    for (int u = F.bid; u < 2048 + 128; u += F.G) {
        const bool isc = u >= 2048;
        int b, hkv, qb; if (!isc) { b = u >> 7; hkv = (u >> 6) & 1; qb = u & 63; } else { const int v = u - 2048; b = v >> 3; hkv = (v >> 2) & 1; qb = v & 3; }
        const int n0 = qb * 64, bh = b * 2 + hkv;
        const size_t qrow = isc ? ((size_t)TL + (size_t)b * 256 + n0 + 32 * th + r) : ((size_t)b * 4096 + n0 + 32 * th + r);
        bf16x8 qf[4];
#pragma unroll
        for (int s = 0; s < 4; ++s) qf[s] = *(const bf16x8*)(QKV + qrow * 768 + (hkv * 4 + g) * 64 + 16 * s + 8 * h);
        float m = sinkp[hkv * 4 + g], l = (h == 0) ? 1.0f : 0.0f;
        f32x16 o0, o1;
#pragma unroll
        for (int i = 0; i < 16; ++i) { o0[i] = 0.f; o1[i] = 0.f; }
        __syncthreads();
        if (!isc) {
            for (int pc = F.tid; pc < 2560; pc += NTHREADS) { const int kl = pc >> 3, c8 = pc & 7, kj = n0 - 128 + kl;
                v4u v = (v4u){0u, 0u, 0u, 0u}; if (kj >= 0 && kj < SEQ) v = *(const v4u*)(QKV + ((size_t)b * 4096 + kj) * 768 + 512 + hkv * 64 + c8 * 8);
                *(LAS v4u*)(Ks + kl * AT_KP + c8 * 16) = v; }
            for (int pc = F.tid; pc < 2560; pc += NTHREADS) { const int d = pc / 40, c = pc - d * 40, kj = n0 - 128 + c * 8;
                v4u v = (v4u){0u, 0u, 0u, 0u}; if (kj >= 0 && kj < SEQ) v = *(const v4u*)(VT + ((size_t)bh * 64 + d) * 4352 + 256 + kj);
                LAS v2u* dst = (LAS v2u*)(Vs + d * AT_VP1 + c * 16); dst[0] = (v2u){v.x, v.y}; dst[1] = (v2u){v.z, v.w}; }
            __syncthreads();
            const int qi = n0 + 32 * th + r;
#pragma unroll 1
            for (int t = 0; t < 9; ++t) { const int klb = 32 * th + 32 * t; attn_tile<true>(Ks, Vs, AT_VP1, klb, qf, o0, o1, m, l, r, h, n0 - 128 + klb, qi); }
            __syncthreads();
        }
        for (int pc = F.tid; pc < 2048; pc += NTHREADS) { const int j = pc >> 3, c8 = pc & 7;
            *(LAS v4u*)(Ks + j * AT_KP + c8 * 16) = *(const v4u*)(QKV + ((size_t)TL + (size_t)b * 256 + j) * 768 + 512 + hkv * 64 + c8 * 8); }
        for (int pc = F.tid; pc < 2048; pc += NTHREADS) { const int d = pc >> 5, c = pc & 31; const v4u v = *(const v4u*)(VT + ((size_t)bh * 64 + d) * 4352 + c * 8);
            LAS v2u* dst = (LAS v2u*)(Vs + d * AT_VP2 + c * 16); dst[0] = (v2u){v.x, v.y}; dst[1] = (v2u){v.z, v.w}; }
        __syncthreads();
#pragma unroll 1
        for (int t = 0; t < 8; ++t) attn_tile<false>(Ks, Vs, AT_VP2, 32 * t, qf, o0, o1, m, l, r, h, 0, 0);
        const float inv = 1.0f / (l + __shfl_xor(l, 32));
        bf16* orow = MIX + qrow * D + 512 + (hkv * 4 + g) * 64 + 4 * h;
#pragma unroll
        for (int q4 = 0; q4 < 4; ++q4) {
            v2u w0; w0.x = pk_bf16(o0[4 * q4 + 0] * inv, o0[4 * q4 + 1] * inv); w0.y = pk_bf16(o0[4 * q4 + 2] * inv, o0[4 * q4 + 3] * inv); *(v2u*)(orow + 8 * q4) = w0;
            v2u w1; w1.x = pk_bf16(o1[4 * q4 + 0] * inv, o1[4 * q4 + 1] * inv); w1.y = pk_bf16(o1[4 * q4 + 2] * inv, o1[4 * q4 + 3] * inv); *(v2u*)(orow + 32 + 8 * q4) = w1;
        }
    }
    __syncthreads();
}
PHASE_FN ph_outproj(PP pp, int layer) {
    FRAME();
    const int li = layer >> 1; const bool odd = (layer & 1) != 0;
    const int TR = (layer == DEPTH - 1) ? TL : T;
    const char* W = odd ? (const char*)(ws + WS_OD + li * OD_STRIDE + OD_WOUT) : (const char*)(ws + WS_EV + li * EV_STRIDE + EV_WOUT);
    float* XC = (float*)(ws + WS_XC); float* out = (float*)pp->out;
    const float* xl_src = (layer == 0) ? PIN(I_X) : out; const float* xc_src = (layer == 0) ? PIN(I_CTX) : XC;
    const float* modl = (const float*)(ws + WS_MOD) + (size_t)layer * 17 * 6144;
    SchedResid S{F.G, F.bid, (TR / 256) * 4, (const char*)(ws + WS_BIG + BIG_MIX), (size_t)256 * D * 2, W, (size_t)256 * D * 2, xl_src, xc_src, out, XC, modl + 2048};
    pg8::gemm_phase<pg8::EpiResid, SchedResid, true, true>(F.lds, F.tid, pg8::Dims{D, D, D}, S, pg8::EpiResid{});
}
PHASE_FN ph_ln_mid(PP pp, int layer) {
    FRAME();
    ln_pass(F, (float*)pp->out, (float*)(ws + WS_XC), (bf16*)(ws + WS_H), PIN(I_LNG) + (size_t)(layer * 2) * D, PIN(I_LNB) + (size_t)(layer * 2) * D,
            (const float*)(ws + WS_MOD) + (size_t)layer * 17 * 6144, 4096, 3072, T);
}
PHASE_FN ph_e6(PP pp, int layer) {
    FRAME();
    unsigned char* evw = ws + WS_EV + (layer >> 1) * EV_STRIDE;
    SchedStd S{22, (T / 256) * 22, F.G, F.bid, (const char*)(ws + WS_H), (const char*)(evw + EV_W13), (char*)(ws + WS_BIG + BIG_HID), (size_t)256 * D * 2, (size_t)256 * D * 2, (size_t)256 * FFH * 2, (size_t)128 * 2, FFH, 1 << 30};
    pg8::gemm_phase<pg8::EpiSwiGLU, SchedStd, true, true>(F.lds, F.tid, pg8::Dims{D, D, D}, S, pg8::EpiSwiGLU{});
}
PHASE_FN ph_e7(PP pp, int layer) {
    FRAME();
    unsigned char* evw = ws + WS_EV + (layer >> 1) * EV_STRIDE;
    float* XC = (float*)(ws + WS_XC); float* out = (float*)pp->out;
    const float* modl = (const float*)(ws + WS_MOD) + (size_t)layer * 17 * 6144;
    SchedResid S{F.G, F.bid, (T / 256) * 4, (const char*)(ws + WS_BIG + BIG_HID), (size_t)256 * FFH * 2, (const char*)(evw + EV_W2), (size_t)256 * FFH * 2, out, XC, out, XC, modl + 5120};
    pg8::gemm_phase<pg8::EpiResid, SchedResid, true, true>(F.lds, F.tid, pg8::Dims{FFH, FFH, FFH}, S, pg8::EpiResid{});
}
PHASE_FN ph_ln_end(PP pp, int layer) {
    FRAME();
    ln_pass(F, (float*)pp->out, (float*)(ws + WS_XC), (bf16*)(ws + WS_H), PIN(I_LNG) + (size_t)(layer * 2 + 1) * D, PIN(I_LNB) + (size_t)(layer * 2 + 1) * D,
            (const float*)(ws + WS_MOD) + (size_t)(layer + 1) * 17 * 6144, 1024, 0, T);
}

PHASE_FN ph_o1(PP pp, int layer) {
    FRAME();
    unsigned char* odw = ws + WS_OD + (layer >> 1) * OD_STRIDE;
    SchedStd S{6, (T / 256) * 6, F.G, F.bid, (const char*)(ws + WS_H), (const char*)(odw + OD_WIN), (char*)(ws + WS_BIG + BIG_P), (size_t)256 * D * 2, (size_t)256 * D * 2, (size_t)256 * 1536 * 2, (size_t)256 * 2, 1536, 2};
    pg8::gemm_phase<pg8::EpiStore, SchedStd, true, true>(F.lds, F.tid, pg8::Dims{D, D, D}, S, pg8::EpiStore{});
}
PHASE_FN ph_o2_s5a(PP pp, int layer) {
    FRAME();
    const int li = layer >> 1;
    SchedS5A S{F.G, F.bid, (const char*)(ws + WS_BIG + BIG_P), (const char*)(ws + WS_S5M + (size_t)li * 32 * S5M_STRIDE), (char*)(ws + WS_H + 68 * MiB), (char*)(ws + WS_H)};
    pg8::gemm_phase<pg8::EpiStore, SchedS5A, true, true, pg8::AMapS5>(F.lds, F.tid, pg8::Dims{256, 0, 256}, S, pg8::EpiStore{}, pg8::AMapS5{});
}
PHASE_FN ph_o2_scan(PP pp, int layer) {
    FRAME();
    const int li = layer >> 1;
    if (F.tid < 256) {
        const int t = F.bid * 256 + F.tid;
        if (t < NBATCH * 32 * 2 * 64) {
            const int pl = t & 63, d = (t >> 6) & 1, g = (t >> 7) & 31, b = t >> 12;
            const int sidx = ((li * 2 + d) * 32 + g);
            const float are = PIN(I_A_RE)[sidx * 64 + pl], aim = PIN(I_A_IM)[sidx * 64 + pl], dt = expf(PIN(I_LOG_DT)[sidx]);
            const float mag = expf(16.0f * are * dt); float sn, cn; sincosf(16.0f * aim * dt, &sn, &cn);
            const float lre = mag * cn, lim = mag * sn;
            unsigned* HB = (unsigned*)(ws + WS_H) + (g * 256 + d * 128 + pl * 2) / 2;
            float cre = 0.f, cim = 0.f;
#define S5_CROW(k_) ((k_) < 16 ? (4096 + b * 16 + (d ? 15 - (k_) : (k_))) : (b * 256 + (d ? 255 - ((k_) - 16) : ((k_) - 16))))
            for (int k0 = 0; k0 < 272; k0 += 8) {
                unsigned w[8];
#pragma unroll
                for (int j = 0; j < 8; ++j) w[j] = HB[(size_t)S5_CROW(k0 + j) * 4096];
#pragma unroll
                for (int j = 0; j < 8; ++j) { HB[(size_t)S5_CROW(k0 + j) * 4096] = cvt_pk_bf16(cre, cim);
                    const float sr = bflo(w[j]), si = bfhi(w[j]); const float nr = lre * cre - lim * cim + sr, ni = lre * cim + lim * cre + si; cre = nr; cim = ni; }
            }
#undef S5_CROW
        }
    }
}
PHASE_FN ph_o3(PP pp, int layer) {
    FRAME();
    const int li = layer >> 1;
    SchedS5B S{F.G, F.bid, (const char*)(ws + WS_H), (const char*)(ws + WS_S5M + (size_t)li * 32 * S5M_STRIDE + 256 * 1024), (const char*)(ws + WS_H + 68 * MiB), (char*)(ws + WS_BIG + BIG_P)};
    pg8::gemm_phase<pg8::EpiS5B, SchedS5B, true, true>(F.lds, F.tid, pg8::Dims{256, 8192, 256}, S, pg8::EpiS5B{});
}
PHASE_FN ph_o2_gmlp(PP pp, int layer) {
    FRAME();
    const int li = layer >> 1; const int TR = (layer == DEPTH - 1) ? TL : T;
    const bf16* P = (const bf16*)(ws + WS_BIG + BIG_P); bf16* MIX = (bf16*)(ws + WS_BIG + BIG_MIX);
    LAS float* Wn = (LAS float*)F.lds;
    LAS float* Vs = (LAS float*)(F.lds + 65536);
    const int nchunk = TR / 128;
    const float* ws_w = PIN(I_WS) + (size_t)li * 4 * 128 * 128; const float* bs = PIN(I_BS) + (size_t)li * 4 * 128;
    __syncthreads();
    for (int ch = F.bid; ch < nchunk; ch += F.G) {
        const size_t row0 = (size_t)ch * 128;
        float mu_r[16], rs_r[16];
#pragma unroll
        for (int t = 0; t < 16; ++t) { const v4u w = *(const v4u*)(P + (row0 + F.wave * 16 + t) * 1536 + 1024 + F.lane * 8);
            const float f[8] = {bflo(w.x), bfhi(w.x), bflo(w.y), bfhi(w.y), bflo(w.z), bfhi(w.z), bflo(w.w), bfhi(w.w)};
            float s = 0.f;
#pragma unroll
            for (int j = 0; j < 8; ++j) s += f[j];
            const float mu = wave_sum(s) * (1.f / 512.f); float q = 0.f;
#pragma unroll
            for (int j = 0; j < 8; ++j) q += (f[j] - mu) * (f[j] - mu);
            mu_r[t] = mu; rs_r[t] = rsqrtf(wave_sum(q) * (1.f / 512.f) + LN_EPS); }
        for (int h = 0; h < 4; ++h) {
            __syncthreads();
            for (int e = F.tid; e < 128 * 128; e += NTHREADS) Wn[e] = ws_w[(size_t)h * 16384 + e];
#pragma unroll
            for (int t = 0; t < 16; ++t) { const int j = F.wave * 16 + t; const unsigned w = *(const unsigned*)(P + (row0 + j) * 1536 + 1024 + h * 128 + F.lane * 2);
                Vs[j * 128 + F.lane * 2] = (bflo(w) - mu_r[t]) * rs_r[t]; Vs[j * 128 + F.lane * 2 + 1] = (bfhi(w) - mu_r[t]) * rs_r[t]; }
            __syncthreads();
            const int ti = F.tid >> 5, te = F.tid & 31;
            f32x4 acc[8];
#pragma unroll
            for (int k = 0; k < 8; ++k) acc[k] = (f32x4){0.f, 0.f, 0.f, 0.f};
            for (int j = 0; j < 128; ++j) {
                const f32x4 vv = *(const LAS f32x4*)(Vs + j * 128 + te * 4);
#pragma unroll
                for (int k = 0; k < 8; ++k) acc[k] += vv * Wn[(ti * 8 + k) * 128 + j];
            }
#pragma unroll
            for (int k = 0; k < 8; ++k) { const int i = ti * 8 + k; const float bb = bs[h * 128 + i];
                const v2u uw = *(const v2u*)(P + (row0 + i) * 1536 + 512 + h * 128 + te * 4);
                v2u o; o.x = cvt_pk_bf16(bflo(uw.x) * (acc[k][0] + bb), bfhi(uw.x) * (acc[k][1] + bb)); o.y = cvt_pk_bf16(bflo(uw.y) * (acc[k][2] + bb), bfhi(uw.y) * (acc[k][3] + bb));
                *(v2u*)(MIX + (row0 + i) * D + 512 + h * 128 + te * 4) = o; }
        }
    }
    __syncthreads();
}
PHASE_FN ph_o4(PP pp, int layer) {
    FRAME();
    const int li = layer >> 1;
    unsigned char* odw = ws + WS_OD + li * OD_STRIDE;
    SchedGlu S{F.G, F.bid, (const char*)(ws + WS_BIG + BIG_P), (const char*)(odw + OD_WGLU), (char*)(ws + WS_BIG + BIG_MIX), PIN(I_BGLU) + (size_t)li * 512};
    pg8::gemm_phase<pg8::EpiGLU, SchedGlu, true, true>(F.lds, F.tid, pg8::Dims{512, 1536, 512}, S, pg8::EpiGLU{});
}
PHASE_FN ph_o6(PP pp, int layer) {
    FRAME();
    const int li = layer >> 1; const int TR = (layer == DEPTH - 1) ? TL : T;
    float* XC = (float*)(ws + WS_XC); float* out = (float*)pp->out; bf16* Hb = (bf16*)(ws + WS_H);
    const float* modl = (const float*)(ws + WS_MOD) + (size_t)layer * 17 * 6144;
    const float* lng0 = PIN(I_LNG) + (size_t)(layer * 2) * D; const float* lnb0 = PIN(I_LNB) + (size_t)(layer * 2) * D;
    int* tokE = (int*)(ws + WS_TOK); int* tokS0 = tokE + T; int* tokS1 = tokS0 + T; float* tokG0 = (float*)(tokS1 + T);
    unsigned* ecnt = F.ctl + CW_CNT + li * 64;
    LAS float* wr_s = (LAS float*)F.lds;
    LAS unsigned* lcnt = (LAS unsigned*)(F.lds + 32768);
    const float* rw = PIN(I_ROUTER) + (size_t)li * D * 8;
    __syncthreads();
    for (int e = F.tid; e < D * 8; e += NTHREADS) wr_s[e] = rw[e];
    if (F.tid < 16) lcnt[F.tid] = 0u;
    __syncthreads();
    f32x4 gg[4], bb[4];
#pragma unroll
    for (int j = 0; j < 4; ++j) { gg[j] = *(const f32x4*)(lng0 + 256 * j + 4 * F.lane); bb[j] = *(const f32x4*)(lnb0 + 256 * j + 4 * F.lane); }
    for (int r = F.gw; r < TR; r += F.NGW) {
        const bool isc = r >= TL; float* xr = isc ? XC + (size_t)(r - TL) * D : out + (size_t)r * D;
        const float* m = modl + (size_t)(isc ? 16 : (r >> 12)) * 6144;
        f32x4 v[4], h[4], sv[4], tv[4]; row_load(xr, F.lane, v); row_load_mod(m + 4096, m + 3072, F.lane, sv, tv);
        row_ln_pre(v, gg, bb); row_store(xr, F.lane, v);
#pragma unroll
        for (int j = 0; j < 4; ++j) h[j] = v[j] * (sv[j] + 1.0f) + tv[j];
        row_store_bf16(Hb + (size_t)r * D, F.lane, h);
        float lg[8];
#pragma unroll
        for (int e = 0; e < 8; ++e) lg[e] = 0.f;
#pragma unroll
        for (int j = 0; j < 4; ++j)
#pragma unroll
            for (int q = 0; q < 4; ++q) { const int col = 256 * j + 4 * F.lane + q; const f32x4 w0 = *(const LAS f32x4*)(wr_s + col * 8), w1 = *(const LAS f32x4*)(wr_s + col * 8 + 4); const float hv = h[j][q];
                lg[0] += hv * w0[0]; lg[1] += hv * w0[1]; lg[2] += hv * w0[2]; lg[3] += hv * w0[3]; lg[4] += hv * w1[0]; lg[5] += hv * w1[1]; lg[6] += hv * w1[2]; lg[7] += hv * w1[3]; }
#pragma unroll
        for (int e = 0; e < 8; ++e) lg[e] = wave_sum(lg[e]);
        if (F.lane == 0) {
            int e0 = 0; float v0 = lg[0];
#pragma unroll
            for (int e = 1; e < 8; ++e) if (lg[e] > v0) { v0 = lg[e]; e0 = e; }
            int e1 = -1; float v1 = -3.0e38f;
#pragma unroll
            for (int e = 0; e < 8; ++e) if (e != e0 && lg[e] > v1) { v1 = lg[e]; e1 = e; }
            const float w0 = 1.0f / (1.0f + __expf(v1 - v0));
            const int s0 = (int)__hip_atomic_fetch_add(lcnt + e0, 1u, __ATOMIC_RELAXED, __HIP_MEMORY_SCOPE_WORKGROUP), s1 = (int)__hip_atomic_fetch_add(lcnt + e1, 1u, __ATOMIC_RELAXED, __HIP_MEMORY_SCOPE_WORKGROUP);
            tokE[r] = e0 | (e1 << 8); tokS0[r] = s0; tokS1[r] = s1; tokG0[r] = w0;
        }
    }
    __syncthreads();
    if (F.tid < 8) lcnt[8 + F.tid] = atomicAdd(ecnt + F.tid, lcnt[F.tid]);
    VM_WAIT();
    __syncthreads();
    { const int r = F.gw + F.lane * F.NGW;
      if (r < TR) { const int ee = tokE[r]; tokS0[r] += (int)lcnt[8 + (ee & 255)]; tokS1[r] += (int)lcnt[8 + (ee >> 8)]; } }
    __syncthreads();
}
PHASE_FN ph_o7(PP pp, int layer) {
    FRAME();
    const int li = layer >> 1; const int TR = (layer == DEPTH - 1) ? TL : T;
    const bf16* Hb = (const bf16*)(ws + WS_H); unsigned char* HSQ = ws + WS_BIG + BIG_HSQ;
    int* tokE = (int*)(ws + WS_TOK); int* tokS0 = tokE + T; int* tokS1 = tokS0 + T; int* tokP0 = tokS1 + 2 * T; int* tokP1 = tokP0 + T;
    unsigned* ecnt = F.ctl + CW_CNT + li * 64;
    int roff[8]; { int acc = 0;
#pragma unroll
        for (int e = 0; e < 8; ++e) { roff[e] = acc * 256; acc += (__builtin_amdgcn_readfirstlane((int)__hip_atomic_load(ecnt + e, __ATOMIC_RELAXED, __HIP_MEMORY_SCOPE_AGENT)) + 255) >> 8; } }
    for (int r = F.gw; r < TR; r += F.NGW) {
        const int ee = tokE[r], e0 = ee & 255, e1 = ee >> 8;
        int p0 = tokS0[r], p1 = tokS1[r];
#pragma unroll
        for (int e = 0; e < 8; ++e) { p0 += (e == e0) ? roff[e] : 0; p1 += (e == e1) ? roff[e] : 0; }
        const v4u* src = (const v4u*)(Hb + (size_t)r * D) + 2 * F.lane;
        const v4u a = src[0], b = src[1];
        v4u q; q.x = pk_fp8x4(bflo(a.x) * Q_H, bfhi(a.x) * Q_H, bflo(a.y) * Q_H, bfhi(a.y) * Q_H); q.y = pk_fp8x4(bflo(a.z) * Q_H, bfhi(a.z) * Q_H, bflo(a.w) * Q_H, bfhi(a.w) * Q_H);
        q.z = pk_fp8x4(bflo(b.x) * Q_H, bfhi(b.x) * Q_H, bflo(b.y) * Q_H, bfhi(b.y) * Q_H); q.w = pk_fp8x4(bflo(b.z) * Q_H, bfhi(b.z) * Q_H, bflo(b.w) * Q_H, bfhi(b.w) * Q_H);
        *((v4u*)(HSQ + (size_t)p0 * D) + F.lane) = q; *((v4u*)(HSQ + (size_t)p1 * D) + F.lane) = q;
        if (F.lane == 0) { tokP0[r] = p0; tokP1[r] = p1; }
    }
}
PHASE_FN ph_moe_up(PP pp, int layer, int chn) {
    FRAME();
    const int li = layer >> 1; unsigned char* odw = ws + WS_OD + li * OD_STRIDE; unsigned* ecnt = F.ctl + CW_CNT + li * 64;
    SchedMoeUp S; S.G = F.G; S.c = F.bid; S.rt0 = chn * MOE_CHUNK_TILES; S.HS = (const char*)(ws + WS_BIG + BIG_HSQ); S.W = (const char*)(odw + OD_MW13); S.HID = (char*)(ws + WS_H);
    { int acc = 0; S.toff[0] = 0;
#pragma unroll
        for (int e = 0; e < 8; ++e) { acc += (__builtin_amdgcn_readfirstlane((int)__hip_atomic_load(ecnt + e, __ATOMIC_RELAXED, __HIP_MEMORY_SCOPE_AGENT)) + 255) >> 8; S.toff[e + 1] = acc; } }
    int nt_ = S.toff[8] - S.rt0; nt_ = nt_ < 0 ? 0 : (nt_ > MOE_CHUNK_TILES ? MOE_CHUNK_TILES : nt_); S.nUnits = nt_ * 28;
    pg8::gemm_phase<pg8::EpiSwiGLU8, SchedMoeUp, true, true, pg8::AMapStd, true>(F.lds, F.tid, pg8::Dims{D, D, D}, S, pg8::EpiSwiGLU8{});
}
PHASE_FN ph_moe_down(PP pp, int layer, int chn) {
    FRAME();
    const int li = layer >> 1; unsigned char* odw = ws + WS_OD + li * OD_STRIDE; unsigned* ecnt = F.ctl + CW_CNT + li * 64;
    SchedMoeDown S; S.G = F.G; S.c = F.bid; S.rt0 = chn * MOE_CHUNK_TILES; S.HID = (const char*)(ws + WS_H); S.W = (const char*)(odw + OD_MW2); S.Y = (char*)(ws + WS_BIG + BIG_Y);
    { int acc = 0; S.toff[0] = 0;
#pragma unroll
        for (int e = 0; e < 8; ++e) { acc += (__builtin_amdgcn_readfirstlane((int)__hip_atomic_load(ecnt + e, __ATOMIC_RELAXED, __HIP_MEMORY_SCOPE_AGENT)) + 255) >> 8; S.toff[e + 1] = acc; } }
    int nt_ = S.toff[8] - S.rt0; nt_ = nt_ < 0 ? 0 : (nt_ > MOE_CHUNK_TILES ? MOE_CHUNK_TILES : nt_); S.nUnits = nt_ * 4;
    pg8::gemm_phase<pg8::EpiStoreQ, SchedMoeDown, true, true, pg8::AMapStd, true>(F.lds, F.tid, pg8::Dims{EH, EH, EH}, S, pg8::EpiStoreQ{});
}
PHASE_FN ph_o9(PP pp, int layer) {
    FRAME();
    const int TR = (layer == DEPTH - 1) ? TL : T; const bool last = layer == DEPTH - 1;
    float* XC = (float*)(ws + WS_XC); float* out = (float*)pp->out; bf16* Hb = (bf16*)(ws + WS_H); const bf16* HS = (const bf16*)(ws + WS_BIG + BIG_Y);
    const float* modl = (const float*)(ws + WS_MOD) + (size_t)layer * 17 * 6144;
    const float* modn = (const float*)(ws + WS_MOD) + (size_t)(last ? layer : layer + 1) * 17 * 6144;
    const float* lng1 = PIN(I_LNG) + (size_t)(layer * 2 + 1) * D; const float* lnb1 = PIN(I_LNB) + (size_t)(layer * 2 + 1) * D;
    const int* tokE = (const int*)(ws + WS_TOK); const float* tokG0 = (const float*)(tokE + 3 * T); const int* tokP0 = tokE + 4 * T; const int* tokP1 = tokP0 + T;
    f32x4 gg9[4], bb9[4];
#pragma unroll
    for (int j = 0; j < 4; ++j) { gg9[j] = *(const f32x4*)(lng1 + 256 * j + 4 * F.lane); bb9[j] = *(const f32x4*)(lnb1 + 256 * j + 4 * F.lane); }
    for (int r = F.gw; r < TR; r += F.NGW) {
        const bool isc = r >= TL; float* xr = isc ? XC + (size_t)(r - TL) * D : out + (size_t)r * D;
        const int mrow = isc ? 16 : (r >> 12);
        const float* g2 = modl + (size_t)mrow * 6144 + 5120;
        const int p0 = tokP0[r], p1 = tokP1[r]; const float w0 = tokG0[r], w1 = 1.0f - w0;
        const bf16* y0 = HS + (size_t)p0 * D; const bf16* y1 = HS + (size_t)p1 * D;
        f32x4 v[4], h[4]; row_load(xr, F.lane, v);
#pragma unroll
        for (int j = 0; j < 4; ++j) { const v2u a = *(const v2u*)(y0 + 256 * j + 4 * F.lane), b = *(const v2u*)(y1 + 256 * j + 4 * F.lane); const f32x4 gg = *(const f32x4*)(g2 + 256 * j + 4 * F.lane);
            f32x4 f; f[0] = w0 * bflo(a.x) + w1 * bflo(b.x); f[1] = w0 * bfhi(a.x) + w1 * bfhi(b.x); f[2] = w0 * bflo(a.y) + w1 * bflo(b.y); f[3] = w0 * bfhi(a.y) + w1 * bfhi(b.y);
            v[j] = v[j] * ALPHA + gg * f; }
        row_ln_pre(v, gg9, bb9); row_store(xr, F.lane, v);
        if (!last) { const float* m = modn + (size_t)mrow * 6144; row_modulate(h, v, m + 1024, m, F.lane); row_store_bf16(Hb + (size_t)r * D, F.lane, h); }
    }
}

#if MK_SPLIT
#define PHASE_END() do { ++ph; } while (0)
#else
#define PHASE_END() do { if (ph >= lo && ph + 1 < hi) grid_bar(pp); ++ph; } while (0)
#endif
#define PHASE_ON() (ph >= lo && ph < hi)
static __device__ __forceinline__ void even_layer(PP pp, const int layer, const int lo, const int hi, int& ph) {
    if (PHASE_ON()) ph_e1(pp, layer);
    PHASE_END();
    if (PHASE_ON()) { ph_e2_fft(pp); ph_e2_rope(pp); }
    PHASE_END();
    if (PHASE_ON()) { ph_e2_dft(pp); ph_e3_attn(pp, layer); }
    PHASE_END();
    if (PHASE_ON()) ph_outproj(pp, layer);
    PHASE_END();
    if (PHASE_ON()) ph_ln_mid(pp, layer);
    PHASE_END();
    if (PHASE_ON()) ph_e6(pp, layer);
    PHASE_END();
    if (PHASE_ON()) ph_e7(pp, layer);
    PHASE_END();
    if (PHASE_ON()) ph_ln_end(pp, layer);
    PHASE_END();
}
static __device__ __forceinline__ void odd_layer(PP pp, const int layer, const int lo, const int hi, int& ph) {
    if (PHASE_ON()) ph_o1(pp, layer);
    PHASE_END();
    if (PHASE_ON()) { ph_o2_s5a(pp, layer); ph_o2_gmlp(pp, layer); }
    PHASE_END();
    if (PHASE_ON()) ph_o2_scan(pp, layer);
    PHASE_END();
    if (PHASE_ON()) ph_o3(pp, layer);
    PHASE_END();
    if (PHASE_ON()) ph_o4(pp, layer);
    PHASE_END();
    if (PHASE_ON()) ph_outproj(pp, layer);
    PHASE_END();
    if (PHASE_ON()) ph_o6(pp, layer);
    PHASE_END();
    if (PHASE_ON()) ph_o7(pp, layer);
    PHASE_END();
#define MOE_CHUNK(chn) do { if (PHASE_ON()) ph_moe_up(pp, layer, chn); PHASE_END(); if (PHASE_ON()) ph_moe_down(pp, layer, chn); PHASE_END(); } while (0)
    static_assert(MOE_NCHUNK == 5, "the chunk sites are written out: no loop around GEMM phase sites");
    MOE_CHUNK(0); MOE_CHUNK(1); MOE_CHUNK(2); MOE_CHUNK(3); MOE_CHUNK(4);
#undef MOE_CHUNK
    if (PHASE_ON()) ph_o9(pp, layer);
    PHASE_END();
}
constexpr int N_PHASES = 2 + 2 * (8 + 9 + 2 * MOE_NCHUNK);
__global__ void __launch_bounds__(NTHREADS, 2) fwd_kernel(Params p_unused) {
    DECL_LDS;
    PP pp = (PP)__builtin_amdgcn_kernarg_segment_ptr();
    {
        LAS unsigned char* lds = (LAS unsigned char*)lds_raw;
        for (int u = threadIdx.x; u < (LDS_BYTES - LDS_RING) / 4; u += NTHREADS) ((LAS unsigned*)(lds + LDS_RING))[u] = 0u;
        __syncthreads();
#if !MK_SPLIT
        (void)xcd_barrier_post((unsigned*)((unsigned char*)pp->ws + WS_CTL) + CW_BAR, (volatile LAS unsigned*)(lds + LDS_MISC) + 8);
#endif
    }
#if MK_SPLIT
    const int lo = pp->ph_lo, hi = pp->ph_hi;
#else
    constexpr int lo = 0, hi = N_PHASES;
#endif
    int ph = 0;

    if (PHASE_ON()) { ph_fold(pp); ph_mod(pp); ph_s5mat(pp); ph_cvt(pp); ph_dftmat(pp); }
    PHASE_END();
    if (PHASE_ON()) ph_pro_b(pp);
    PHASE_END();
    even_layer(pp, 0, lo, hi, ph);
    odd_layer(pp, 1, lo, hi, ph);
    even_layer(pp, 2, lo, hi, ph);
    odd_layer(pp, 3, lo, hi, ph);
}

extern "C" void kernel_launch(void* const* d_in, const int* in_sizes, int n_in, void* d_out, int out_size, void* d_ws, size_t ws_size, hipStream_t stream) {
    static int grid = 0;
    if (grid == 0) {
        if (n_in != 32 || out_size != TL * D || ws_size < WS_END) { fprintf(stderr, "kernel_launch: unexpected shapes (n_in %d, out %d, ws %zu < %zu)\n", n_in, out_size, ws_size, (size_t)WS_END); grid = -1; return; }
        int dev = 0, cus = 0, per_cu = 0;
        if (hipGetDevice(&dev) != hipSuccess || hipDeviceGetAttribute(&cus, hipDeviceAttributeMultiprocessorCount, dev) != hipSuccess) { grid = -1; return; }
        if (hipFuncSetAttribute((const void*)fwd_kernel, hipFuncAttributeMaxDynamicSharedMemorySize, LDS_BYTES) != hipSuccess) { fprintf(stderr, "kernel_launch: hipFuncSetAttribute failed\n"); grid = -1; return; }
        if (hipOccupancyMaxActiveBlocksPerMultiprocessor(&per_cu, (const void*)fwd_kernel, NTHREADS, LDS_BYTES) != hipSuccess || per_cu < 1) { fprintf(stderr, "kernel_launch: occupancy query says %d\n", per_cu); }
        (void)hipGetLastError();
        grid = cus;
    }
    if (grid < 0) return;
    (void)in_sizes;
    (void)hipMemsetAsync((char*)d_ws + WS_CTL, 0, CTL_ZERO_BYTES, stream);
    Params p{};
    for (int i = 0; i < 32; ++i) p.in[i] = (const float*)d_in[i];
    p.out = (float*)d_out; p.ws = (unsigned char*)d_ws;
#if MK_SPLIT
    for (int ph = 0; ph < N_PHASES; ++ph) { p.ph_lo = ph; p.ph_hi = ph + 1; hipLaunchKernelGGL(fwd_kernel, dim3(grid), dim3(NTHREADS), LDS_BYTES, stream, p); }
#else
    p.ph_lo = 0; p.ph_hi = N_PHASES;
    hipLaunchKernelGGL(fwd_kernel, dim3(grid), dim3(NTHREADS), LDS_BYTES, stream, p);
#endif
}
```

```cpp
#include <hip/hip_runtime.h>
#include <cstdio>
#include <cstdint>

#ifndef MK_SPLIT
#define MK_SPLIT 0
#endif

#define GAS __attribute__((address_space(1)))
#define LAS __attribute__((address_space(3)))
typedef unsigned short bf16;
typedef unsigned v4u __attribute__((ext_vector_type(4)));
typedef unsigned v2u __attribute__((ext_vector_type(2)));
typedef float f32x4 __attribute__((ext_vector_type(4)));
typedef float f32x2 __attribute__((ext_vector_type(2)));
typedef short bf16x8 __attribute__((ext_vector_type(8)));

constexpr int D = 1024, NBATCH = 16, SEQ = 4096, NCTX = 256, DEPTH = 4;
constexpr int TL = NBATCH * SEQ, TC = NBATCH * NCTX, T = TL + TC;
constexpr int FFH = 2816, EH = 3584, NEXP = 8;
constexpr int MOE_CHUNK_TILES = 128, MOE_NCHUNK = 5;
constexpr float Q_H = 16.f, Q_W = 1024.f, Q_HID = 8.f;
constexpr float ALPHA = 1.6817928305074290860622509524664f;
constexpr float LN_EPS = 1e-5f;

constexpr size_t MiB = (size_t)1 << 20;
constexpr size_t WS_CTL = 0, CTL_ZERO_BYTES = 1 * MiB;
constexpr size_t WS_MOD = 1 * MiB;
constexpr size_t WS_TOK = 3 * MiB;
constexpr size_t WS_XC = 5 * MiB;
constexpr size_t WS_F256 = 21 * MiB;
constexpr size_t WS_FD = 22 * MiB;
constexpr size_t WS_EV = 86 * MiB, EV_STRIDE = 22 * MiB;
constexpr size_t EV_WQKV = 0, EV_WPQ = 3 * MiB / 2, EV_WOUT = 7 * MiB / 2, EV_W13 = 11 * MiB / 2, EV_W2 = 33 * MiB / 2;
constexpr size_t WS_OD = 130 * MiB, OD_STRIDE = 174 * MiB;
constexpr size_t OD_WIN = 0, OD_WGLU = 3 * MiB, OD_WOUT = 7 * MiB / 2, OD_MW13 = 11 * MiB / 2, OD_MW2 = 235 * MiB / 2;
constexpr size_t WS_H = 478 * MiB;
constexpr size_t WS_BIG = 614 * MiB;
constexpr size_t BIG_PQT = 0, BIG_PQTC = 128 * MiB, BIG_QKV = 136 * MiB, BIG_MIX = 238 * MiB, BIG_VT = 374 * MiB, BIG_HID = 0, BIG_P = 0, BIG_Y = 0, BIG_HSQ = 276 * MiB;
constexpr size_t WS_S5M = 1030 * MiB, S5M_STRIDE = 384 * 1024;
constexpr size_t WS_END = 1058 * MiB;
constexpr int CW_BAR = 4096, CW_CNT = 16384, CW_LN = 32768, LN_SITE_WORDS = 272 * 16;
constexpr size_t WS_XS = 1054 * MiB;

#define LDS_WAIT() asm volatile("s_waitcnt lgkmcnt(0)" ::: "memory")
#define VM_WAIT() asm volatile("s_waitcnt vmcnt(0)" ::: "memory")
__device__ __forceinline__ unsigned cvt_pk_bf16(float lo, float hi) { unsigned r; asm volatile("v_cvt_pk_bf16_f32 %0, %1, %2" : "=v"(r) : "v"(lo), "v"(hi)); return r; }
__device__ __forceinline__ float bflo(unsigned w) { return __uint_as_float(w << 16); }
__device__ __forceinline__ float bfhi(unsigned w) { return __uint_as_float(w & 0xffff0000u); }
__device__ __forceinline__ float bf2f(bf16 b) { return __uint_as_float(((unsigned)b) << 16); }
__device__ __forceinline__ bf16 f2bf(float f) { return (bf16)(cvt_pk_bf16(f, 0.f) & 0xffffu); }
__device__ __forceinline__ unsigned pk_fp8x4(float a, float b, float c, float d) {
    a = __builtin_amdgcn_fmed3f(a, -448.f, 448.f); b = __builtin_amdgcn_fmed3f(b, -448.f, 448.f); c = __builtin_amdgcn_fmed3f(c, -448.f, 448.f); d = __builtin_amdgcn_fmed3f(d, -448.f, 448.f);
    int w = 0; w = __builtin_amdgcn_cvt_pk_fp8_f32(a, b, w, false); w = __builtin_amdgcn_cvt_pk_fp8_f32(c, d, w, true); return (unsigned)w; }
__device__ __forceinline__ float wave_sum(float v) {
#pragma unroll
    for (int o = 1; o < 64; o <<= 1) v += __shfl_xor(v, o);
    return v;
}
__device__ __forceinline__ float wave_max(float v) {
#pragma unroll
    for (int o = 1; o < 64; o <<= 1) v = fmaxf(v, __shfl_xor(v, o));
    return v;
}
__device__ __forceinline__ float silu_f(float x) { return x / (1.f + __expf(-x)); }
__device__ __forceinline__ float sigmoid_f(float x) { return 1.f / (1.f + __expf(-x)); }
__device__ __forceinline__ float gelu_tanh_f(float x) { const float z = 0.7978845608028654f * (x + 0.044715f * x * x * x); return x / (1.f + __expf(-2.f * z)); }

#define XB_TMO      128
#define XB_XCNT(j)  (256  + 64 * (j))
#define XB_XSUB(j)  (1280 + 64 * (j))
#define XB_XGEN(j)  (2304 + 64 * (j))
#define XB_TOP      3328
#define XB_TOPGEN   3392
#define XCD_BAR_WORDS 3456
#define XB_SPIN_CAP (1u << 25)
__device__ __forceinline__ unsigned xb_ld(unsigned* p)              { return __hip_atomic_load(p, __ATOMIC_RELAXED, __HIP_MEMORY_SCOPE_AGENT); }
__device__ __forceinline__ unsigned xb_add(unsigned* p, unsigned v) { return __hip_atomic_fetch_add(p, v, __ATOMIC_RELAXED, __HIP_MEMORY_SCOPE_AGENT); }
__device__ __forceinline__ unsigned xb_xcc_id() { return (unsigned)__builtin_amdgcn_s_getreg((3 << 11) | 20) & 0xFu; }
#define XB_SPIN(cond, bar) do { unsigned _sp = 0; while (cond) { __builtin_amdgcn_s_sleep(1); \
    if ((++_sp & 255u) == 0u) { if (xb_ld(&(bar)[XB_TMO])) break; if (_sp > XB_SPIN_CAP) { atomicAdd(&(bar)[XB_TMO], 1u); break; } } } } while (0)
struct XcdBarrier { unsigned* bar; unsigned x; volatile LAS unsigned* st; };
__device__ __forceinline__ XcdBarrier xcd_barrier_post(unsigned* bar, volatile LAS unsigned* st) {
    XcdBarrier b; b.bar = bar; b.x = xb_xcc_id(); b.st = st;
    if (threadIdx.x == 0) (void)xb_add(&bar[XB_XCNT(b.x)], 1u);
    return b;
}
__device__ __forceinline__ void xcd_barrier_complete(unsigned* bar, unsigned x, unsigned& nloc, unsigned& nx) {
    const unsigned G = gridDim.x * gridDim.y * gridDim.z;
    unsigned sum, cnt, mine, sp = 0u;
    for (;;) {
        sum = 0u; cnt = 0u; mine = 0u;
#pragma unroll
        for (unsigned j = 0; j < 16; ++j) { const unsigned c = xb_ld(&bar[XB_XCNT(j)]); sum += c; cnt += (c > 0u) ? 1u : 0u; mine = (j == x) ? c : mine; }
        if (sum == G) break;
        __builtin_amdgcn_s_sleep(1);
        if ((++sp & 255u) == 0u) { if (xb_ld(&bar[XB_TMO])) break; if (sp > XB_SPIN_CAP) { atomicAdd(&bar[XB_TMO], 1u); break; } }
    }
    nloc = mine > 0u ? mine : 1u; nx = cnt > 0u ? cnt : 1u;
}
__device__ __forceinline__ void xcd_barrier(const XcdBarrier& b) {
    asm volatile("s_waitcnt vmcnt(0)" ::: "memory");
    __syncthreads();
    if (threadIdx.x == 0) {
        unsigned* bar = b.bar;
        __builtin_amdgcn_s_waitcnt(0);
        unsigned nloc = b.st[0], nx = b.st[1];
        if (nloc == 0u) { xcd_barrier_complete(bar, b.x, nloc, nx); b.st[0] = nloc; b.st[1] = nx; }
        const unsigned old = xb_add(&bar[XB_XSUB(b.x)], 1u);
        const unsigned gen = old / nloc;
        if (old + 1u == (gen + 1u) * nloc) {
            __builtin_amdgcn_fence(__ATOMIC_RELEASE, "agent");
            asm volatile("s_waitcnt vmcnt(0)" ::: "memory");
            const unsigned og = xb_add(&bar[XB_TOP], 1u);
            const unsigned tg = og / nx;
            if (og + 1u == (tg + 1u) * nx) xb_add(&bar[XB_TOPGEN], 1u);
            else XB_SPIN(xb_ld(&bar[XB_TOPGEN]) == tg, bar);
            __builtin_amdgcn_fence(__ATOMIC_ACQUIRE, "agent");
            xb_add(&bar[XB_XGEN(b.x)], 1u);
            asm volatile("s_waitcnt vmcnt(0)" ::: "memory");
        } else {
            XB_SPIN(xb_ld(&bar[XB_XGEN(b.x)]) == gen, bar);
            __builtin_amdgcn_fence(__ATOMIC_ACQUIRE, "agent");
            asm volatile("s_waitcnt vmcnt(0)" ::: "memory");
        }
    }
    __syncthreads();
}

namespace pg8 {
constexpr int BM = 256, BK = 64, HALF = 128, HTB = HALF * BK * 2, STAGE_BYTES = 8 * HTB;
__host__ __device__ __forceinline__ int lds_byte(int r, int c) { const int st = (r >> 4) * 2 + (c >> 5), rr = r & 15, cc = c & 31, ob = rr * 64 + cc * 2; return st * 1024 + (ob ^ (((ob >> 9) & 1) << 5)); }
__host__ __device__ __forceinline__ void stage_rc(int b, int& R, int& C) { const int st = b / 1024, sb = b % 1024, swz = sb ^ (((sb >> 9) & 1) << 5); R = (st >> 1) * 16 + swz / 64; C = (st & 1) * 32 + (swz % 64) / 2; }
__host__ __device__ __forceinline__ int perm32(int rho) { const int n = rho >> 4, i = rho & 15; return 8 * (i >> 2) + 4 * n + (i & 3); }

struct Unit { const char* a; const char* b; char* o; const char* p0; const char* p1; int ldo; int x0; };
struct Dims { int K, lda, ldb; };
typedef int v4i __attribute__((ext_vector_type(4)));
typedef int v8i __attribute__((ext_vector_type(8)));
struct AMapStd { int ldab = 0;   __device__ __forceinline__ unsigned voff(int R, int C) const { return (unsigned)(R * ldab + C * 2); } __device__ __forceinline__ size_t kstep() const { return 128; } __device__ __forceinline__ size_t hs() const { return (size_t)HALF * ldab; } };
struct AMapS5 { __device__ __forceinline__ unsigned voff(int R, int C) const { return (unsigned)(R * 49152 + (C >> 4) * 3072 + (C & 15) * 2); } __device__ __forceinline__ size_t kstep() const { return 12288; } __device__ __forceinline__ size_t hs() const { return (size_t)HALF * 49152; } };

__device__ __forceinline__ const char* uni_ptr(const char* p) {
    const unsigned long long v = (unsigned long long)p; const unsigned lo = __builtin_amdgcn_readfirstlane((unsigned)v), hi = __builtin_amdgcn_readfirstlane((unsigned)(v >> 32));
    return (const char*)(((unsigned long long)hi << 32) | lo); }
template <class Epi, class Sched, bool ALIGN_EPI = false, bool SP2 = false, class AMap = AMapStd, bool FP8 = false>
__device__ __forceinline__ void gemm_phase(LAS unsigned char* lds, const int tid, const Dims g, const Sched& S, const Epi& E, const AMap am_in = AMap{}) {
    constexpr int ES = FP8 ? 1 : 2;
    AMap am = am_in; if constexpr (__is_same(AMap, AMapStd)) am.ldab = g.lda * ES;
    const int wid = __builtin_amdgcn_readfirstlane(tid >> 6), lane = tid & 63, wr = wid >> 2, wc = wid & 3, fr = lane & 15, fq = lane >> 4;
    const int K = g.K, nt = (K * (FP8 ? 1 : 2)) / 128;
    unsigned voffA, voffB;
    { int R, C; stage_rc(tid * 16, R, C); const int Rb = Epi::PERM ? ((R & ~31) + perm32(R & 31)) : R;
        voffA = am.voff(R, C); voffB = (unsigned)(Rb * g.ldb * ES + C * 2); }
    const size_t d64voffA = am.voff(64, 0), d64voffB = (size_t)64 * g.ldb * ES;
    const size_t kstep = (size_t)(BK * 2), kstepA = am.kstep();
    const size_t hsA = am.hs(), hsB = (size_t)HALF * g.ldb * ES;
    const unsigned ldsw = (unsigned)wid * 1024u;
    const int aoff = lds_byte(wr * 64 + fr, fq * 8), boff = lds_byte(wc * 32 + fr, fq * 8);
#define PG8_SA(b, h) (((b) * 2 + (h)) * HTB)
#define PG8_SB(b, h) ((4 + (b) * 2 + (h)) * HTB)
#define PG8_STAGE(bufoff, gbase, voff) do { unsigned _vo = (voff); asm volatile("" : "+v"(_vo));   \
        __builtin_amdgcn_global_load_lds((const unsigned*)((const char*)(gbase) + _vo), (LAS unsigned*)(lds + (bufoff) + ldsw), 16, 0, 0); \
        __builtin_amdgcn_global_load_lds((const unsigned*)((const char*)(gbase) + d64##voff + _vo), (LAS unsigned*)(lds + (bufoff) + ldsw + 8192), 16, 0, 0); } while (0)
#define PG8_LD8(p) __builtin_shufflevector(*(const LAS v4i*)(p), *(const LAS v4i*)((p) + 1024), 0, 1, 2, 3, 4, 5, 6, 7)
#define PG8_LDA(dst, b, h) do { if constexpr (FP8) { _Pragma("unroll") for (int m = 0; m < 4; ++m) dst##8[m] = PG8_LD8(lds + PG8_SA(b, h) + aoff + m * 2048); } \
        else { _Pragma("unroll") for (int m = 0; m < 4; ++m) _Pragma("unroll") for (int k = 0; k < 2; ++k) dst[m][k] = *(const LAS bf16x8*)(lds + PG8_SA(b, h) + aoff + m * 2048 + k * 1024); } } while (0)
#define PG8_LDB(dst, b, h) do { if constexpr (FP8) { _Pragma("unroll") for (int n = 0; n < 2; ++n) dst##8[n] = PG8_LD8(lds + PG8_SB(b, h) + boff + n * 2048); } \
        else { _Pragma("unroll") for (int n = 0; n < 2; ++n) _Pragma("unroll") for (int k = 0; k < 2; ++k) dst[n][k] = *(const LAS bf16x8*)(lds + PG8_SB(b, h) + boff + n * 2048 + k * 1024); } } while (0)
#define PG8_MMA(ai, bj, At, Bt) do { __builtin_amdgcn_s_setprio(1); \
        if constexpr (FP8) { _Pragma("unroll") for (int m = 0; m < 4; ++m) _Pragma("unroll") for (int n = 0; n < 2; ++n) \
            acc[ai][bj][m][n] = __builtin_amdgcn_mfma_scale_f32_16x16x128_f8f6f4(Bt##8[n], At##8[m], acc[ai][bj][m][n], 0, 0, 0, 0, 0, 0); } \
        else { _Pragma("unroll") for (int m = 0; m < 4; ++m) _Pragma("unroll") for (int n = 0; n < 2; ++n) _Pragma("unroll") for (int k = 0; k < 2; ++k) \
            acc[ai][bj][m][n] = __builtin_amdgcn_mfma_f32_16x16x32_bf16(Bt[n][k], At[m][k], acc[ai][bj][m][n], 0, 0, 0); } \
        __builtin_amdgcn_s_setprio(0); } while (0)
#define PG8_WAIT_V(n) asm volatile("s_waitcnt vmcnt(" #n ")" ::: "memory")
#define PG8_WAIT_L(n) asm volatile("s_waitcnt lgkmcnt(" #n ")" ::: "memory")
#define PG8_BAR __builtin_amdgcn_s_barrier()
#define PG8_SCHED __builtin_amdgcn_sched_barrier(0)
    int ui = 0;
    const char* cA; const char* cB;
    { Unit u0; if (!S.next(0, u0)) return; cA = uni_ptr(u0.a); cB = uni_ptr(u0.b); }
    f32x4 acc[2][2][4][2];
#pragma unroll
    for (int a = 0; a < 2; ++a)
#pragma unroll
        for (int b = 0; b < 2; ++b)
#pragma unroll
            for (int m = 0; m < 4; ++m)
#pragma unroll
                for (int n = 0; n < 2; ++n) acc[a][b][m][n] = (f32x4){0.f, 0.f, 0.f, 0.f};
    bf16x8 At[4][2], B0[2][2], B1[2][2];
    v8i At8[4], B08[2], B18[2];
    if constexpr (SP2) {
        PG8_STAGE(PG8_SB(0, 0), cB, voffB); PG8_STAGE(PG8_SB(0, 1), cB + hsB, voffB); PG8_STAGE(PG8_SA(0, 0), cA, voffA); PG8_STAGE(PG8_SA(0, 1), cA + hsA, voffA);
        if (wr == 1) PG8_BAR;
        PG8_WAIT_V(2); PG8_BAR;
        PG8_STAGE(PG8_SB(1, 0), cB + kstep, voffB); PG8_STAGE(PG8_SA(1, 0), cA + kstepA, voffA); PG8_STAGE(PG8_SB(1, 1), cB + hsB + kstep, voffB);
        PG8_WAIT_V(6); PG8_BAR;
    } else {
        PG8_STAGE(PG8_SB(0, 0), cB, voffB); PG8_STAGE(PG8_SA(0, 0), cA, voffA); PG8_STAGE(PG8_SB(0, 1), cB + hsB, voffB); PG8_STAGE(PG8_SA(0, 1), cA + hsA, voffA);
        if (wr == 1) PG8_BAR;
        PG8_WAIT_V(4); PG8_BAR;
        PG8_STAGE(PG8_SB(1, 0), cB + kstep, voffB); PG8_STAGE(PG8_SA(1, 0), cA + kstepA, voffA); PG8_STAGE(PG8_SB(1, 1), cB + hsB + kstep, voffB);
        PG8_WAIT_V(6); PG8_BAR;
    }
    for (;;) {
        const char* nA = cA; const char* nB = cB; bool has_next;
        { Unit un; has_next = S.next(ui + 1, un); if (has_next) { nA = uni_ptr(un.a); nB = uni_ptr(un.b); } }
#pragma unroll 1
        for (int t = 0; t < nt; t += 2) {
            const bool last = (t == nt - 2);
            const char* a1 = cA + (size_t)(t + 1) * kstepA;
            const char* a2 = last ? nA : cA + (size_t)(t + 2) * kstepA; const char* b2 = last ? nB : cB + (size_t)(t + 2) * kstep;
            const char* a3 = a2 + kstepA; const char* b3 = b2 + kstep;
            if constexpr (SP2) {
            PG8_LDB(B0, 0, 0); PG8_LDB(B1, 0, 1); PG8_SCHED; PG8_LDA(At, 0, 0); PG8_STAGE(PG8_SA(1, 1), a1 + hsA, voffA);
            PG8_WAIT_V(8); PG8_WAIT_L(0); PG8_BAR; PG8_MMA(0, 0, At, B0); PG8_MMA(0, 1, At, B1); PG8_BAR; PG8_SCHED;
            PG8_LDA(At, 0, 1); PG8_STAGE(PG8_SB(0, 0), b2, voffB); PG8_STAGE(PG8_SB(0, 1), b2 + hsB, voffB); PG8_STAGE(PG8_SA(0, 0), a2, voffA);
            PG8_WAIT_V(8); PG8_WAIT_L(0); PG8_BAR; PG8_MMA(1, 0, At, B0); PG8_MMA(1, 1, At, B1); PG8_BAR; PG8_SCHED;
            PG8_LDB(B0, 1, 0); PG8_LDB(B1, 1, 1); PG8_SCHED; PG8_LDA(At, 1, 0); PG8_STAGE(PG8_SA(0, 1), a2 + hsA, voffA);
            PG8_WAIT_V(8); PG8_WAIT_L(0); PG8_BAR; PG8_MMA(0, 0, At, B0); PG8_MMA(0, 1, At, B1); PG8_BAR; PG8_SCHED;
            PG8_LDA(At, 1, 1); PG8_STAGE(PG8_SB(1, 0), b3, voffB); PG8_STAGE(PG8_SB(1, 1), b3 + hsB, voffB); PG8_STAGE(PG8_SA(1, 0), a3, voffA);
            PG8_WAIT_V(8); PG8_WAIT_L(0); PG8_BAR; PG8_MMA(1, 0, At, B0); PG8_MMA(1, 1, At, B1); PG8_BAR; PG8_SCHED;
            } else {
            PG8_LDB(B0, 0, 0); PG8_SCHED; PG8_LDA(At, 0, 0); PG8_STAGE(PG8_SA(1, 1), a1 + hsA, voffA);
            PG8_WAIT_L(8); PG8_BAR; PG8_WAIT_L(0); PG8_MMA(0, 0, At, B0); PG8_BAR; PG8_SCHED;
            PG8_LDB(B1, 0, 1); PG8_STAGE(PG8_SB(0, 0), b2, voffB);
            PG8_BAR; PG8_WAIT_L(0); PG8_MMA(0, 1, At, B1); PG8_BAR;
            PG8_LDA(At, 0, 1); PG8_STAGE(PG8_SA(0, 0), a2, voffA);
            PG8_BAR; PG8_WAIT_L(0); PG8_MMA(1, 0, At, B0); PG8_BAR; PG8_SCHED;
            PG8_STAGE(PG8_SB(0, 1), b2 + hsB, voffB);
            PG8_WAIT_V(6); PG8_BAR; PG8_MMA(1, 1, At, B1); PG8_BAR;
            PG8_LDB(B0, 1, 0); PG8_SCHED; PG8_LDA(At, 1, 0); PG8_STAGE(PG8_SA(0, 1), a2 + hsA, voffA);
            PG8_WAIT_L(8); PG8_BAR; PG8_WAIT_L(0); PG8_MMA(0, 0, At, B0); PG8_BAR; PG8_SCHED;
            PG8_LDB(B1, 1, 1); PG8_STAGE(PG8_SB(1, 0), b3, voffB);
            PG8_BAR; PG8_WAIT_L(0); PG8_MMA(0, 1, At, B1); PG8_BAR;
            PG8_LDA(At, 1, 1); PG8_STAGE(PG8_SA(1, 0), a3, voffA);
            PG8_BAR; PG8_WAIT_L(0); PG8_MMA(1, 0, At, B0); PG8_BAR; PG8_SCHED;
            PG8_STAGE(PG8_SB(1, 1), b3 + hsB, voffB);
            PG8_WAIT_V(6); PG8_BAR; PG8_MMA(1, 1, At, B1); PG8_BAR;
            }
        }
        if constexpr (ALIGN_EPI) { if (wr == 0) PG8_BAR; }
        { Unit uc; (void)S.next(ui, uc); E(acc, uc, wid); }
        if (!has_next) break;
#pragma unroll
        for (int a = 0; a < 2; ++a)
#pragma unroll
            for (int b = 0; b < 2; ++b)
#pragma unroll
                for (int m = 0; m < 4; ++m)
#pragma unroll
                    for (int n = 0; n < 2; ++n) acc[a][b][m][n] = (f32x4){0.f, 0.f, 0.f, 0.f};
        cA = nA; cB = nB; ++ui;
        if constexpr (ALIGN_EPI) { if (wr == 1) PG8_BAR; }
    }
    PG8_WAIT_V(0);
    if constexpr (!ALIGN_EPI) { if (wr == 0) PG8_BAR; }
    PG8_BAR;
#undef PG8_SA
#undef PG8_SB
#undef PG8_STAGE
#undef PG8_LDA
#undef PG8_LDB
#undef PG8_MMA
#undef PG8_LD8
#undef PG8_WAIT_V
#undef PG8_WAIT_L
#undef PG8_BAR
#undef PG8_SCHED
}

struct EpiStore {
    static constexpr bool PERM = true;
    __device__ __forceinline__ void operator()(const f32x4 (&acc)[2][2][4][2], const Unit& u, const int wid) const {
        int lane_; asm volatile("v_mbcnt_lo_u32_b32 %0, -1, 0\n\tv_mbcnt_hi_u32_b32 %0, -1, %0" : "=v"(lane_));
        const int wr = wid >> 2, wc = wid & 3, fr = lane_ & 15, fq = lane_ >> 4;
        bf16* base = (bf16*)u.o; int row0 = wr * 64 + fr, col0 = wc * 32 + 8 * fq; asm volatile("" : "+v"(row0), "+v"(col0)); const bool act = u.x0 != 0;
#pragma unroll
        for (int ai = 0; ai < 2; ++ai)
#pragma unroll
            for (int m = 0; m < 4; ++m) { bf16* rowp = base + (size_t)(row0 + ai * HALF + m * 16) * u.ldo + col0;
#pragma unroll
                for (int bj = 0; bj < 2; ++bj) { f32x4 v0 = acc[ai][bj][m][0], v1 = acc[ai][bj][m][1];
                    if (act) {
#pragma unroll
                        for (int j = 0; j < 4; ++j) { v0[j] = gelu_tanh_f(v0[j]); v1[j] = gelu_tanh_f(v1[j]); } }
                    v4u w; w.x = cvt_pk_bf16(v0[0], v0[1]); w.y = cvt_pk_bf16(v0[2], v0[3]); w.z = cvt_pk_bf16(v1[0], v1[1]); w.w = cvt_pk_bf16(v1[2], v1[3]);
                    *(v4u*)(rowp + bj * HALF) = w; } }
    }
};
struct EpiSwiGLU {
    static constexpr bool PERM = true;
    __device__ __forceinline__ void operator()(const f32x4 (&acc)[2][2][4][2], const Unit& u, const int wid) const {
        int lane_; asm volatile("v_mbcnt_lo_u32_b32 %0, -1, 0\n\tv_mbcnt_hi_u32_b32 %0, -1, %0" : "=v"(lane_));
        const int wr = wid >> 2, wc = wid & 3, fr = lane_ & 15, fq = lane_ >> 4;
        bf16* base = (bf16*)u.o; int row0 = wr * 64 + fr, col0 = wc * 32 + 8 * fq; asm volatile("" : "+v"(row0), "+v"(col0));
#pragma unroll
        for (int ai = 0; ai < 2; ++ai)
#pragma unroll
            for (int m = 0; m < 4; ++m) { bf16* rowp = base + (size_t)(row0 + ai * HALF + m * 16) * u.ldo + col0;
                f32x4 h0, h1;
#pragma unroll
                for (int j = 0; j < 4; ++j) { h0[j] = silu_f(acc[ai][0][m][0][j]) * acc[ai][1][m][0][j]; h1[j] = silu_f(acc[ai][0][m][1][j]) * acc[ai][1][m][1][j]; }
                v4u w; w.x = cvt_pk_bf16(h0[0], h0[1]); w.y = cvt_pk_bf16(h0[2], h0[3]); w.z = cvt_pk_bf16(h1[0], h1[1]); w.w = cvt_pk_bf16(h1[2], h1[3]);
                *(v4u*)rowp = w; }
    }
};
struct EpiSwiGLU8 {
    static constexpr bool PERM = true;
    __device__ __forceinline__ void operator()(const f32x4 (&acc)[2][2][4][2], const Unit& u, const int wid) const {
        int lane_; asm volatile("v_mbcnt_lo_u32_b32 %0, -1, 0\n\tv_mbcnt_hi_u32_b32 %0, -1, %0" : "=v"(lane_));
        const int wr = wid >> 2, wc = wid & 3, fr = lane_ & 15, fq = lane_ >> 4;
        unsigned char* base = (unsigned char*)u.o; int row0 = wr * 64 + fr, col0 = wc * 32 + 8 * fq; asm volatile("" : "+v"(row0), "+v"(col0));
        constexpr float SA = 1.0f / (Q_H * Q_W);
#pragma unroll
        for (int ai = 0; ai < 2; ++ai)
#pragma unroll
            for (int m = 0; m < 4; ++m) { unsigned char* rowp = base + (size_t)(row0 + ai * HALF + m * 16) * u.ldo + col0;
                float h0[4], h1[4];
#pragma unroll
                for (int j = 0; j < 4; ++j) { h0[j] = silu_f(acc[ai][0][m][0][j] * SA) * (acc[ai][1][m][0][j] * (SA * Q_HID)); h1[j] = silu_f(acc[ai][0][m][1][j] * SA) * (acc[ai][1][m][1][j] * (SA * Q_HID)); }
                v2u w; w.x = pk_fp8x4(h0[0], h0[1], h0[2], h0[3]); w.y = pk_fp8x4(h1[0], h1[1], h1[2], h1[3]);
                *(v2u*)rowp = w; }
    }
};
struct EpiStoreQ {
    static constexpr bool PERM = true;
    __device__ __forceinline__ void operator()(const f32x4 (&acc)[2][2][4][2], const Unit& u, const int wid) const {
        int lane_; asm volatile("v_mbcnt_lo_u32_b32 %0, -1, 0\n\tv_mbcnt_hi_u32_b32 %0, -1, %0" : "=v"(lane_));
        const int wr = wid >> 2, wc = wid & 3, fr = lane_ & 15, fq = lane_ >> 4;
        bf16* base = (bf16*)u.o; int row0 = wr * 64 + fr, col0 = wc * 32 + 8 * fq; asm volatile("" : "+v"(row0), "+v"(col0));
        constexpr float SA = 1.0f / (Q_HID * Q_W);
#pragma unroll
        for (int ai = 0; ai < 2; ++ai)
#pragma unroll
            for (int m = 0; m < 4; ++m) { bf16* rowp = base + (size_t)(row0 + ai * HALF + m * 16) * u.ldo + col0;
#pragma unroll
                for (int bj = 0; bj < 2; ++bj) { const f32x4 v0 = acc[ai][bj][m][0] * SA, v1 = acc[ai][bj][m][1] * SA;
                    v4u w; w.x = cvt_pk_bf16(v0[0], v0[1]); w.y = cvt_pk_bf16(v0[2], v0[3]); w.z = cvt_pk_bf16(v1[0], v1[1]); w.w = cvt_pk_bf16(v1[2], v1[3]);
                    *(v4u*)(rowp + bj * HALF) = w; } }
    }
};
struct EpiResid {
    static constexpr bool PERM = false;
    __device__ __forceinline__ void operator()(const f32x4 (&acc)[2][2][4][2], const Unit& u, const int wid) const {
        int lane_; asm volatile("v_mbcnt_lo_u32_b32 %0, -1, 0\n\tv_mbcnt_hi_u32_b32 %0, -1, %0" : "=v"(lane_));
        const int wr = wid >> 2, wc = wid & 3, fr = lane_ & 15, fq = lane_ >> 4;
        const float* xs = (const float*)u.p0; float* zo = (float*)u.o; const float* gv = (const float*)u.p1;
        int row0 = wr * 64 + fr, col0 = wc * 32 + 4 * fq; asm volatile("" : "+v"(row0), "+v"(col0));
#pragma unroll
        for (int ai = 0; ai < 2; ++ai)
#pragma unroll
            for (int m = 0; m < 4; ++m) { const size_t off = (size_t)(row0 + ai * HALF + m * 16) * D + col0;
#pragma unroll
                for (int bj = 0; bj < 2; ++bj)
#pragma unroll
                    for (int n = 0; n < 2; ++n) { const f32x4 xv = *(const f32x4*)(xs + off + bj * HALF + n * 16); const f32x4 gvv = *(const f32x4*)(gv + col0 + bj * HALF + n * 16);
                        *(f32x4*)(zo + off + bj * HALF + n * 16) = xv * ALPHA + gvv * acc[ai][bj][m][n]; }
                asm volatile("" ::: "memory"); }
    }
};
struct EpiResidLN {
    static constexpr bool PERM = false;
    const float* lng; const float* lnb; int sc_delta, sh_delta; bf16* H; unsigned* cnt; unsigned long long* xs; unsigned* tmo; LAS unsigned char* tab;
    __device__ __forceinline__ void operator()(f32x4 (&acc)[2][2][4][2], const Unit& u, const int wid) const {
        int lane_; asm volatile("v_mbcnt_lo_u32_b32 %0, -1, 0\n\tv_mbcnt_hi_u32_b32 %0, -1, %0" : "=v"(lane_));
        const int wr = wid >> 2, wc = wid & 3, fr = lane_ & 15, fq = lane_ >> 4, pm = u.x0 >> 2, pn = u.x0 & 3;
        const float* xsrc = (const float*)u.p0; float* xo = (float*)u.o; const float* gv = (const float*)u.p1;
        int row0 = wr * 64 + fr, col0 = wc * 32 + 4 * fq; asm volatile("" : "+v"(row0), "+v"(col0));
        LAS f32x2* Pt = (LAS f32x2*)tab; LAS f32x2* St = (LAS f32x2*)(tab + 8192);
        f32x4 gg[2][2];
#pragma unroll
        for (int bj = 0; bj < 2; ++bj)
#pragma unroll
            for (int n = 0; n < 2; ++n) gg[bj][n] = *(const f32x4*)(gv + col0 + bj * HALF + n * 16);
#pragma unroll
        for (int ai = 0; ai < 2; ++ai)
#pragma unroll
            for (int mh = 0; mh < 2; ++mh) {
                f32x4 xv[2][2][2];
#pragma unroll
                for (int ml = 0; ml < 2; ++ml)
#pragma unroll
                    for (int bj = 0; bj < 2; ++bj)
#pragma unroll
                        for (int n = 0; n < 2; ++n) xv[ml][bj][n] = *(const f32x4*)(xsrc + (size_t)(row0 + ai * HALF + (2 * mh + ml) * 16) * D + col0 + bj * HALF + n * 16);
#pragma unroll
                for (int ml = 0; ml < 2; ++ml) { const int m = 2 * mh + ml; float sm = 0.f, sq = 0.f;
#pragma unroll
                    for (int bj = 0; bj < 2; ++bj)
#pragma unroll
                        for (int n = 0; n < 2; ++n) { const f32x4 z = xv[ml][bj][n] * ALPHA + gg[bj][n] * acc[ai][bj][m][n]; acc[ai][bj][m][n] = z;
                            sm += (z[0] + z[1]) + (z[2] + z[3]); sq += (z[0] * z[0] + z[1] * z[1]) + (z[2] * z[2] + z[3] * z[3]); }
                    sm += __shfl_xor(sm, 16); sm += __shfl_xor(sm, 32); sq += __shfl_xor(sq, 16); sq += __shfl_xor(sq, 32);
                    if (fq == 0) Pt[(ai * HALF + wr * 64 + m * 16 + fr) * 4 + wc] = (f32x2){sm, sq}; }
                asm volatile("" ::: "memory"); }
        asm volatile("s_waitcnt lgkmcnt(0)" ::: "memory"); __builtin_amdgcn_s_barrier(); asm volatile("" ::: "memory");
        const int trow = wid * 64 + lane_;
        if (wid < 4) {
            const f32x2 a = Pt[trow * 4 + 0], b = Pt[trow * 4 + 1], c = Pt[trow * 4 + 2], d = Pt[trow * 4 + 3];
            const float ts = (a.x + b.x) + (c.x + d.x), tq = (a.y + b.y) + (c.y + d.y);
            __hip_atomic_store(xs + ((size_t)pm * 256 + trow) * 4 + pn, ((unsigned long long)__float_as_uint(tq) << 32) | __float_as_uint(ts), __ATOMIC_RELAXED, __HIP_MEMORY_SCOPE_AGENT);
            asm volatile("s_waitcnt vmcnt(0)" ::: "memory");
            if (lane_ == 0) __hip_atomic_fetch_add(cnt + pm * 16, 1u, __ATOMIC_RELAXED, __HIP_MEMORY_SCOPE_AGENT);
        }
        if (wid == 0) {
            unsigned sp = 0;
            while ((unsigned)__builtin_amdgcn_readfirstlane(__hip_atomic_load(cnt + pm * 16, __ATOMIC_RELAXED, __HIP_MEMORY_SCOPE_AGENT)) < 16u) {
                __builtin_amdgcn_s_sleep(1);
                if ((++sp & 1023u) == 0u && (sp > (1u << 24) || __hip_atomic_load(tmo, __ATOMIC_RELAXED, __HIP_MEMORY_SCOPE_AGENT) != 0u)) { if (lane_ == 0) __hip_atomic_store(tmo, 1u, __ATOMIC_RELAXED, __HIP_MEMORY_SCOPE_AGENT); break; } }
            __builtin_amdgcn_fence(__ATOMIC_ACQUIRE, "agent");
        }
        asm volatile("s_waitcnt vmcnt(0) lgkmcnt(0)" ::: "memory"); __builtin_amdgcn_s_barrier(); asm volatile("" ::: "memory");
        if (wid < 4) {
            const unsigned long long* sl = xs + ((size_t)pm * 256 + trow) * 4; float ts = 0.f, tq = 0.f;
#pragma unroll
            for (int t = 0; t < 4; ++t) { const unsigned long long w = __hip_atomic_load(sl + t, __ATOMIC_RELAXED, __HIP_MEMORY_SCOPE_AGENT); ts += __uint_as_float((unsigned)w); tq += __uint_as_float((unsigned)(w >> 32)); }
            const float mean = ts * (1.f / D), var = fmaxf(tq * (1.f / D) - mean * mean, 0.f);
            St[trow] = (f32x2){mean, rsqrtf(var + LN_EPS)};
        }
        asm volatile("s_waitcnt vmcnt(0) lgkmcnt(0)" ::: "memory"); __builtin_amdgcn_s_barrier(); asm volatile("" ::: "memory");
        const float* lg = lng + pn * 256; const float* lb = lnb + pn * 256; const float* scv = gv + sc_delta; const float* shv = gv + sh_delta;
        bf16* hb = H + ((size_t)pm * 256) * D + pn * 256;
        f32x4 g4[2][2], b4[2][2], s4[2][2], t4[2][2];
#pragma unroll
        for (int bj = 0; bj < 2; ++bj)
#pragma unroll
            for (int n = 0; n < 2; ++n) { const int c = col0 + bj * HALF + n * 16; g4[bj][n] = *(const f32x4*)(lg + c); b4[bj][n] = *(const f32x4*)(lb + c); s4[bj][n] = *(const f32x4*)(scv + c) + 1.0f; t4[bj][n] = *(const f32x4*)(shv + c); }
#pragma unroll
        for (int ai = 0; ai < 2; ++ai)
#pragma unroll
            for (int m = 0; m < 4; ++m) { const int r = row0 + ai * HALF + m * 16; const f32x2 ms = St[r]; const size_t off = (size_t)r * D + col0;
#pragma unroll
                for (int bj = 0; bj < 2; ++bj)
#pragma unroll
                    for (int n = 0; n < 2; ++n) {
                        const f32x4 xn = (acc[ai][bj][m][n] - ms.x) * ms.y * g4[bj][n] + b4[bj][n];
                        *(f32x4*)(xo + off + bj * HALF + n * 16) = xn;
                        const f32x4 hv = xn * s4[bj][n] + t4[bj][n];
                        v2u w; w.x = cvt_pk_bf16(hv[0], hv[1]); w.y = cvt_pk_bf16(hv[2], hv[3]); *(v2u*)(hb + off + bj * HALF + n * 16) = w; } }
    }
};
struct EpiGLU {
    static constexpr bool PERM = true;
    __device__ __forceinline__ void operator()(const f32x4 (&acc)[2][2][4][2], const Unit& u, const int wid) const {
        int lane_; asm volatile("v_mbcnt_lo_u32_b32 %0, -1, 0\n\tv_mbcnt_hi_u32_b32 %0, -1, %0" : "=v"(lane_));
        const int wr = wid >> 2, wc = wid & 3, fr = lane_ & 15, fq = lane_ >> 4;
        bf16* base = (bf16*)u.o; const bf16* gp = (const bf16*)u.p0; const float* bias = (const float*)u.p1;
        int row0 = wr * 64 + fr, col0 = wc * 32 + 8 * fq; asm volatile("" : "+v"(row0), "+v"(col0));
#pragma unroll
        for (int ai = 0; ai < 2; ++ai)
#pragma unroll
            for (int m = 0; m < 4; ++m) { const int r = row0 + ai * HALF + m * 16;
#pragma unroll
                for (int bj = 0; bj < 2; ++bj) { const v4u gw = *(const v4u*)(gp + (size_t)r * u.x0 + col0 + bj * HALF);
                    const f32x4 b0 = *(const f32x4*)(bias + col0 + bj * HALF), b1 = *(const f32x4*)(bias + col0 + bj * HALF + 4);
                    const f32x4 a0 = acc[ai][bj][m][0] + b0, a1 = acc[ai][bj][m][1] + b1;
                    const float o0 = bflo(gw.x) * sigmoid_f(a0[0]), o1 = bfhi(gw.x) * sigmoid_f(a0[1]), o2 = bflo(gw.y) * sigmoid_f(a0[2]), o3 = bfhi(gw.y) * sigmoid_f(a0[3]);
                    const float o4 = bflo(gw.z) * sigmoid_f(a1[0]), o5 = bfhi(gw.z) * sigmoid_f(a1[1]), o6 = bflo(gw.w) * sigmoid_f(a1[2]), o7 = bfhi(gw.w) * sigmoid_f(a1[3]);
                    v4u w; w.x = cvt_pk_bf16(o0, o1); w.y = cvt_pk_bf16(o2, o3); w.z = cvt_pk_bf16(o4, o5); w.w = cvt_pk_bf16(o6, o7);
                    *(v4u*)(base + (size_t)r * u.ldo + col0 + bj * HALF) = w; }
                asm volatile("" ::: "memory"); }
    }
};
struct EpiS5B {
    static constexpr bool PERM = true;
    __device__ __forceinline__ void operator()(const f32x4 (&acc)[2][2][4][2], const Unit& u, const int wid) const {
        int lane_; asm volatile("v_mbcnt_lo_u32_b32 %0, -1, 0\n\tv_mbcnt_hi_u32_b32 %0, -1, %0" : "=v"(lane_));
        const int wr = wid >> 2, wc = wid & 3, fr = lane_ & 15, fq = lane_ >> 4;
        bf16* base = (bf16*)u.o; const bf16* y1 = (const bf16*)u.p0;
        int row0 = wr * 64 + fr, col0 = wc * 32 + 8 * fq; asm volatile("" : "+v"(row0), "+v"(col0));
#pragma unroll
        for (int ai = 0; ai < 2; ++ai)
#pragma unroll
            for (int m = 0; m < 4; ++m) { const int r = row0 + ai * HALF + m * 16;
#pragma unroll
                for (int bj = 0; bj < 2; ++bj) { const int c = col0 + bj * HALF; const v4u yw = *(const v4u*)(y1 + (size_t)r * 8192 + c);
                    const f32x4 a0 = acc[ai][bj][m][0], a1 = acc[ai][bj][m][1];
                    const float o0 = gelu_tanh_f(a0[0] + bflo(yw.x)), o1 = gelu_tanh_f(a0[1] + bfhi(yw.x)), o2 = gelu_tanh_f(a0[2] + bflo(yw.y)), o3 = gelu_tanh_f(a0[3] + bfhi(yw.y));
                    const float o4 = gelu_tanh_f(a1[0] + bflo(yw.z)), o5 = gelu_tanh_f(a1[1] + bfhi(yw.z)), o6 = gelu_tanh_f(a1[2] + bflo(yw.w)), o7 = gelu_tanh_f(a1[3] + bfhi(yw.w));
                    v4u w; w.x = cvt_pk_bf16(o0, o1); w.y = cvt_pk_bf16(o2, o3); w.z = cvt_pk_bf16(o4, o5); w.w = cvt_pk_bf16(o6, o7);
                    *(v4u*)(base + ((size_t)r * 16 + (c >> 4)) * 1536 + (c & 15)) = w; }
                asm volatile("" ::: "memory"); }
    }
};
}

struct Params { const float* in[32]; float* out; unsigned char* ws; int ph_lo, ph_hi; };
enum { I_X = 0, I_C, I_CTX, I_CCTX, I_WMOD, I_BMOD, I_LNG, I_LNB, I_EV_WIN, I_EV_WOUT, I_EV_SINK, I_EV_W1, I_EV_W3, I_EV_W2, I_OD_WIN, I_A_RE, I_A_IM, I_LOG_DT,
       I_B_RE, I_B_IM, I_C_RE, I_C_IM, I_SSM_D, I_WGLU, I_BGLU, I_WS, I_BS, I_OD_WOUT, I_ROUTER, I_MW1, I_MW3, I_MW2 };

constexpr int LDS_RING = 131072, LDS_MISC = LDS_RING + 320, LDS_LNTAB = LDS_RING + 1024, LDS_BYTES = 147456;
constexpr int NWAVES = 8, NTHREADS = 512;

struct Frame {
    LAS unsigned char* lds;
    int tid, lane, wave, G, bid, gw, NGW;
    unsigned char* ws;
    unsigned* ctl;
};

using pg8::Unit;
struct SchedStd {
    int nN, nUnits, G, c; const char* A; const char* B; char* O; size_t aStep, bStep, oRow, oCol; int ldo, act_from;
    __device__ __forceinline__ bool next(int i, Unit& u) const {
        const int L = i * G + c; if (L >= nUnits) return false;
        const int pm = L / nN, pn = L - pm * nN;
        u.a = A + (size_t)pm * aStep; u.b = B + (size_t)pn * bStep; u.o = O + (size_t)pm * oRow + (size_t)pn * oCol; u.p0 = nullptr; u.p1 = nullptr; u.ldo = ldo; u.x0 = (pn >= act_from) ? 1 : 0; return true;
    }
};
struct SchedEvIn {
    int G, c; const char* H; const char* Wqkv; const char* Wpq; char* QKV; char* PQT; char* PQTC;
    __device__ __forceinline__ bool next(int i, Unit& u) const {
        int L = i * G + c; u.p0 = nullptr; u.p1 = nullptr; u.x0 = 0;
        constexpr int NQ = (T / 256) * 3, NP = 4 * (TL / 256), NPC = 4 * (TC / 256);
        if (L < NQ) { const int pm = L / 3, pn = L - pm * 3;
            u.a = H + (size_t)pm * 256 * D * 2; u.b = Wqkv + (size_t)pn * 256 * D * 2; u.o = QKV + ((size_t)pm * 256 * 768 + pn * 256) * 2; u.ldo = 768; return true; }
        L -= NQ;
        if (L < NP) { const int tt = L >> 2, pm = L & 3, b = tt >> 4, n0 = (tt & 15) * 256, isq = pm >> 1, ch0 = (pm & 1) * 256;
            u.a = Wpq + (size_t)pm * 256 * D * 2; u.b = H + (size_t)tt * 256 * D * 2;
            u.o = PQT + ((((size_t)b * 512 + ch0) * 2 + isq) * 4096 + n0) * 2; u.ldo = 8192; return true; }
        L -= NP;
        if (L < NPC) { const int b = L >> 2, pm = L & 3, isq = pm >> 1, ch0 = (pm & 1) * 256;
            u.a = Wpq + (size_t)pm * 256 * D * 2; u.b = H + ((size_t)TL + (size_t)b * 256) * D * 2;
            u.o = PQTC + (((size_t)b * 512 + ch0) * 2 + isq) * 256 * 2; u.ldo = 512; return true; }
        return false;
    }
};
struct SchedDft {
    int G, c; const char* FDm; const char* VB; const char* F2; const char* PQTC; char* MIX;
    __device__ __forceinline__ bool next(int i, Unit& u) const {
        int L = i * G + c; u.p0 = nullptr; u.p1 = nullptr; u.x0 = 0;
        if (L < 512) { const int b = L >> 5, pn = L & 31, k2 = pn >> 1, ch0 = (pn & 1) * 256;
            u.a = FDm; u.b = VB + ((((size_t)b * 16 + k2) * 512 + ch0) * 512) * 2; u.o = MIX + ((((size_t)b * 4096 + k2) * D) + ch0) * 2; u.ldo = 16 * D; return true; }
        L -= 512; if (L >= 32) return false;
        const int b = L >> 1, pn = L & 1;
        u.a = F2; u.b = PQTC + ((size_t)b * 512 + pn * 256) * 512 * 2; u.o = MIX + (((size_t)TL + (size_t)b * 256) * D + pn * 256) * 2; u.ldo = D; return true;
    }
};
struct SchedResid {
    int G, c, nUnits; const char* A; size_t aStep; const char* W; size_t bStep; const float* xl; const float* xc; float* zl; float* zc; const float* gate;
    __device__ __forceinline__ bool next(int i, Unit& u) const {
        const int L = i * G + c; if (L >= nUnits) return false;
        const int pm = L >> 2, pn = L & 3;
        u.a = A + (size_t)pm * aStep; u.b = W + (size_t)pn * bStep;
        const bool isc = pm >= TL / 256; const int pr = isc ? pm - TL / 256 : pm; const int mrow = isc ? 16 : (pm >> 4);
        const size_t off = ((size_t)pr * 256 * D + pn * 256);
        u.p0 = (const char*)((isc ? xc : xl) + off); u.o = (char*)((isc ? zc : zl) + off); u.p1 = (const char*)(gate + (size_t)mrow * 6144 + pn * 256); u.ldo = D; u.x0 = L; return true;
    }
};
struct SchedGlu {
    int G, c; const char* P; const char* W; char* MIX; const float* bias;
    __device__ __forceinline__ bool next(int i, Unit& u) const {
        const int L = i * G + c; if (L >= (T / 256) * 2) return false;
        const int pm = L >> 1, pn = L & 1;
        u.a = P + (size_t)pm * 256 * 1536 * 2; u.b = W + (size_t)pn * 256 * 512 * 2; u.o = MIX + ((size_t)pm * 256 * D + pn * 256) * 2;
        u.p0 = P + ((size_t)pm * 256 * 1536 + pn * 256) * 2; u.p1 = (const char*)(bias + pn * 256); u.ldo = D; u.x0 = 1536; return true;
    }
};
struct SchedS5A {
    int G, c; const char* P; const char* WA; char* Y1; char* HB;
    __device__ __forceinline__ bool next(int i, Unit& u) const {
        const int L = i * G + c; if (L >= 32 * 34) return false;
        const int g = L / 34, rem = L - g * 34, pm = rem >> 1, pn = rem & 1;
        u.a = P + ((size_t)pm * 256 * 16 * 1536 + g * 16) * 2; u.b = WA + (size_t)g * S5M_STRIDE + (size_t)pn * 256 * 256 * 2;
        u.o = (pn ? HB : Y1) + (((size_t)pm * 256 * 32 + g) * 256) * 2; u.p0 = nullptr; u.p1 = nullptr; u.ldo = 8192; u.x0 = 0; return true;
    }
};
struct SchedS5B {
    int G, c; const char* HB; const char* CL; const char* Y1; char* P;
    __device__ __forceinline__ bool next(int i, Unit& u) const {
        const int L = i * G + c; if (L >= 32 * 17) return false;
        const int g = L / 17, pm = L - g * 17;
        const size_t toff = (((size_t)pm * 256 * 32 + g) * 256) * 2;
        u.a = HB + toff; u.b = CL + (size_t)g * S5M_STRIDE; u.p0 = Y1 + toff; u.o = P + ((size_t)pm * 256 * 16 * 1536 + g * 16) * 2; u.p1 = nullptr; u.ldo = 0; u.x0 = 0; return true;
    }
};
struct SchedMoeUp {
    int G, c, nUnits, rt0; int toff[9]; const char* HS; const char* W; char* HID;
    __device__ __forceinline__ bool next(int i, Unit& u) const {
        const int L = i * G + c; if (L >= nUnits) return false;
        const int rl = L / 28, pn = L - rl * 28, rt = rt0 + rl; int e = 0;
#pragma unroll
        for (int k = 1; k < 8; ++k) e += (rt >= toff[k]) ? 1 : 0;
        u.a = HS + (size_t)rt * 256 * D; u.b = W + ((size_t)e * 7168 + pn * 256) * D; u.o = HID + ((size_t)rl * 256 * EH + pn * 128);
        u.p0 = nullptr; u.p1 = nullptr; u.ldo = EH; u.x0 = 0; return true;
    }
};
struct SchedMoeDown {
    int G, c, nUnits, rt0; int toff[9]; const char* HID; const char* W; char* Y;
    __device__ __forceinline__ bool next(int i, Unit& u) const {
        const int L = i * G + c; if (L >= nUnits) return false;
        const int rl = L >> 2, pn = L & 3, rt = rt0 + rl; int e = 0;
#pragma unroll
        for (int k = 1; k < 8; ++k) e += (rt >= toff[k]) ? 1 : 0;
        u.a = HID + (size_t)rl * 256 * EH; u.b = W + ((size_t)e * 1024 + pn * 256) * EH; u.o = Y + ((size_t)rt * 256 * D + pn * 256) * 2;
        u.p0 = nullptr; u.p1 = nullptr; u.ldo = D; u.x0 = 0; return true;
    }
};

__device__ __forceinline__ void tr_item(const float* W, int ldn, bf16* WT, int ldk, int k0, int n0, int drow0, LAS float* scr, int lane) {
#pragma unroll 8
    for (int i = 0; i < 32; ++i) { const int kk = 2 * i + (lane >> 5); scr[kk * 33 + (lane & 31)] = W[(size_t)(k0 + kk) * ldn + n0 + (lane & 31)]; }
    LDS_WAIT(); asm volatile("" ::: "memory");
    const int c = lane & 7;
#pragma unroll
    for (int j = 0; j < 4; ++j) { const int n = (lane >> 3) + 8 * j; const LAS float* s = scr + (8 * c) * 33 + n;
        v4u o; o.x = cvt_pk_bf16(s[0 * 33], s[1 * 33]); o.y = cvt_pk_bf16(s[2 * 33], s[3 * 33]); o.z = cvt_pk_bf16(s[4 * 33], s[5 * 33]); o.w = cvt_pk_bf16(s[6 * 33], s[7 * 33]);
        *(v4u*)(WT + (size_t)(drow0 + n) * ldk + k0 + 8 * c) = o; }
    LDS_WAIT(); asm volatile("" ::: "memory");
}
__device__ __forceinline__ void tr_item8(const float* W, int ldn, unsigned char* WT, int ldk, int k0, int n0, int drow0, LAS float* scr, int lane, float qs) {
#pragma unroll 8
    for (int i = 0; i < 32; ++i) { const int kk = 2 * i + (lane >> 5); scr[kk * 33 + (lane & 31)] = W[(size_t)(k0 + kk) * ldn + n0 + (lane & 31)] * qs; }
    LDS_WAIT(); asm volatile("" ::: "memory");
    const int c = lane & 7;
#pragma unroll
    for (int j = 0; j < 4; ++j) { const int n = (lane >> 3) + 8 * j; const LAS float* sp = scr + (8 * c) * 33 + n;
        v2u o; o.x = pk_fp8x4(sp[0 * 33], sp[1 * 33], sp[2 * 33], sp[3 * 33]); o.y = pk_fp8x4(sp[4 * 33], sp[5 * 33], sp[6 * 33], sp[7 * 33]);
        *(v2u*)(WT + (size_t)(drow0 + n) * ldk + k0 + 8 * c) = o; }
    LDS_WAIT(); asm volatile("" ::: "memory");
}
__device__ __forceinline__ void tr_job8(const float* W, int ldn, int N, unsigned char* WT, int ldk, int mode, int roff, int item, LAS float* scr, int lane) {
    const int nblk = N / 32, kb = item / nblk, nb = item - kb * nblk, n0 = nb * 32;
    const int drow0 = mode ? ((n0 >> 7) * 256 + (n0 & 127) + roff) : (roff + n0);
    tr_item8(W, ldn, WT, ldk, kb * 64, n0, drow0, scr, lane, Q_W);
}
__device__ __forceinline__ void tr_job(const float* W, int ldn, int N, bf16* WT, int ldk, int mode, int roff, int item, LAS float* scr, int lane) {
    const int nblk = N / 32, kb = item / nblk, nb = item - kb * nblk, n0 = nb * 32;
    const int drow0 = mode ? ((n0 >> 7) * 256 + (n0 & 127) + roff) : (roff + n0);
    tr_item(W, ldn, WT, ldk, kb * 64, n0, drow0, scr, lane);
}
__device__ __forceinline__ void cvt_item(const Params& p, int r, LAS float* scr, int lane) {
    unsigned char* ws = p.ws;
    constexpr int EV_ITEMS = 384 + 512 + 3 * 1408;
    constexpr int ODS_ITEMS = 768 + 128 + 512;
    constexpr int EXP_ITEMS = 3 * 1792, MOE_ITEMS = 8 * EXP_ITEMS;
    if (r < 2 * EV_ITEMS) { const int li = r / EV_ITEMS; r -= li * EV_ITEMS; unsigned char* base = ws + WS_EV + li * EV_STRIDE;
        if (r < 384) { tr_job(p.in[I_EV_WIN] + (size_t)li * D * 1280 + 512, 1280, 768, (bf16*)(base + EV_WQKV), D, 0, 0, r, scr, lane); return; } r -= 384;
        if (r < 512) { tr_job(p.in[I_EV_WOUT] + (size_t)li * D * D, D, D, (bf16*)(base + EV_WOUT), D, 0, 0, r, scr, lane); return; } r -= 512;
        if (r < 1408) { tr_job(p.in[I_EV_W1] + (size_t)li * D * FFH, FFH, FFH, (bf16*)(base + EV_W13), D, 1, 0, r, scr, lane); return; } r -= 1408;
        if (r < 1408) { tr_job(p.in[I_EV_W3] + (size_t)li * D * FFH, FFH, FFH, (bf16*)(base + EV_W13), D, 1, 128, r, scr, lane); return; } r -= 1408;
        tr_job(p.in[I_EV_W2] + (size_t)li * FFH * D, D, D, (bf16*)(base + EV_W2), FFH, 0, 0, r, scr, lane); return; }
    r -= 2 * EV_ITEMS;
    if (r < 2 * ODS_ITEMS) { const int li = r / ODS_ITEMS; r -= li * ODS_ITEMS; unsigned char* base = ws + WS_OD + li * OD_STRIDE;
        if (r < 768) { tr_job(p.in[I_OD_WIN] + (size_t)li * D * 1536, 1536, 1536, (bf16*)(base + OD_WIN), D, 0, 0, r, scr, lane); return; } r -= 768;
        if (r < 128) { tr_job(p.in[I_WGLU] + (size_t)li * 512 * 512, 512, 512, (bf16*)(base + OD_WGLU), 512, 0, 0, r, scr, lane); return; } r -= 128;
        tr_job(p.in[I_OD_WOUT] + (size_t)li * D * D, D, D, (bf16*)(base + OD_WOUT), D, 0, 0, r, scr, lane); return; }
    r -= 2 * ODS_ITEMS;
    { const int li = r / MOE_ITEMS; r -= li * MOE_ITEMS; const int e = r / EXP_ITEMS; r -= e * EXP_ITEMS; unsigned char* base = ws + WS_OD + li * OD_STRIDE;
        const size_t we = (size_t)li * NEXP + e;
        if (r < 1792) { tr_job8(p.in[I_MW1] + we * D * EH, EH, EH, (unsigned char*)(base + OD_MW13) + (size_t)e * 7168 * D, D, 1, 0, r, scr, lane); return; } r -= 1792;
        if (r < 1792) { tr_job8(p.in[I_MW3] + we * D * EH, EH, EH, (unsigned char*)(base + OD_MW13) + (size_t)e * 7168 * D, D, 1, 128, r, scr, lane); return; } r -= 1792;
        tr_job8(p.in[I_MW2] + we * EH * D, D, D, (unsigned char*)(base + OD_MW2) + (size_t)e * D * EH, EH, 0, 0, r, scr, lane); }
}
constexpr int CVT_ITEMS = 2 * 5120 + 2 * 1408 + 2 * 8 * 3 * 1792;

__device__ __forceinline__ void fold_unit(const Params& p, Frame& F, int unit) {
    const int li = unit >> 6, g = (unit >> 4) & 3, k0 = (unit & 15) * 64;
    LAS float* tile = (LAS float*)F.lds;
    LAS float* trig = tile + 64 * 129;
    const float* W = p.in[I_EV_WIN] + (size_t)li * D * 1280;
    for (int e = F.tid; e < 64 * 128; e += NTHREADS) { const int k = e >> 7, c = e & 127; tile[k * 129 + c] = W[(size_t)(k0 + k) * 1280 + g * 128 + c]; }
    if (F.tid < 128) { float s, c; sincospif((float)F.tid / 64.0f, &s, &c); trig[F.tid] = c * 0.08838834764831845f; trig[128 + F.tid] = s * 0.08838834764831845f; }
    __syncthreads();
    bf16* WT = (bf16*)(p.ws + WS_EV + li * EV_STRIDE + EV_WPQ);
    const int k = F.lane, mg = F.wave;
    for (int mm = 0; mm < 16; ++mm) { const int m = mg * 16 + mm; float sp = 0.f, sq = 0.f;
        for (int c = 0; c < 128; ++c) { const float w = tile[k * 129 + c]; const int ph = (m * c) & 127; sp += w * trig[ph]; sq += w * trig[128 + ph]; }
        WT[(size_t)(g * 128 + m) * D + k0 + k] = f2bf(sp); WT[(size_t)(512 + g * 128 + m) * D + k0 + k] = f2bf(sq); }
    __syncthreads();
}

__device__ __forceinline__ void row_load(const float* row, int lane, f32x4 (&v)[4]) {
#pragma unroll
    for (int j = 0; j < 4; ++j) v[j] = *(const f32x4*)(row + 256 * j + 4 * lane);
}
__device__ __forceinline__ void row_store(float* row, int lane, const f32x4 (&v)[4]) {
#pragma unroll
    for (int j = 0; j < 4; ++j) *(f32x4*)(row + 256 * j + 4 * lane) = v[j];
}
__device__ __forceinline__ void row_store_bf16(bf16* row, int lane, const f32x4 (&v)[4]) {
#pragma unroll
    for (int j = 0; j < 4; ++j) { v2u w; w.x = cvt_pk_bf16(v[j][0], v[j][1]); w.y = cvt_pk_bf16(v[j][2], v[j][3]); *(v2u*)(row + 256 * j + 4 * lane) = w; }
}
__device__ __forceinline__ void row_layernorm(f32x4 (&v)[4], const float* g, const float* b, int lane) {
    float s = 0.f;
#pragma unroll
    for (int j = 0; j < 4; ++j) s += (v[j][0] + v[j][1]) + (v[j][2] + v[j][3]);
    const float mean = wave_sum(s) * (1.f / D); float q = 0.f;
#pragma unroll
    for (int j = 0; j < 4; ++j) { v[j] = v[j] - mean; q += (v[j][0] * v[j][0] + v[j][1] * v[j][1]) + (v[j][2] * v[j][2] + v[j][3] * v[j][3]); }
    const float rstd = rsqrtf(wave_sum(q) * (1.f / D) + LN_EPS);
#pragma unroll
    for (int j = 0; j < 4; ++j) { const f32x4 gg = *(const f32x4*)(g + 256 * j + 4 * lane), bb = *(const f32x4*)(b + 256 * j + 4 * lane); v[j] = v[j] * rstd * gg + bb; }
}
__device__ __forceinline__ void row_modulate(f32x4 (&h)[4], const f32x4 (&v)[4], const float* sc, const float* sh, int lane) {
#pragma unroll
    for (int j = 0; j < 4; ++j) { const f32x4 s = *(const f32x4*)(sc + 256 * j + 4 * lane), t = *(const f32x4*)(sh + 256 * j + 4 * lane); h[j] = v[j] * (s + 1.0f) + t; }
}

__device__ __forceinline__ void row_ln_pre(f32x4 (&v)[4], const f32x4 (&gg)[4], const f32x4 (&bb)[4]) {
    float s = 0.f;
#pragma unroll
    for (int j = 0; j < 4; ++j) s += (v[j][0] + v[j][1]) + (v[j][2] + v[j][3]);
    const float mean = wave_sum(s) * (1.f / D); float q = 0.f;
#pragma unroll
    for (int j = 0; j < 4; ++j) { v[j] = v[j] - mean; q += (v[j][0] * v[j][0] + v[j][1] * v[j][1]) + (v[j][2] * v[j][2] + v[j][3] * v[j][3]); }
    const float rstd = rsqrtf(wave_sum(q) * (1.f / D) + LN_EPS);
#pragma unroll
    for (int j = 0; j < 4; ++j) v[j] = v[j] * rstd * gg[j] + bb[j];
}
__device__ __forceinline__ void row_load_mod(const float* sc, const float* sh, int lane, f32x4 (&s)[4], f32x4 (&t)[4]) {
#pragma unroll
    for (int j = 0; j < 4; ++j) { s[j] = *(const f32x4*)(sc + 256 * j + 4 * lane); t[j] = *(const f32x4*)(sh + 256 * j + 4 * lane); }
}
typedef const __attribute__((address_space(4))) Params* PP;
#define PIN(i) ((const float*)pp->in[i])
#define DECL_LDS extern __shared__ __attribute__((aligned(16))) unsigned char lds_raw[]
#define PHASE_FN static __device__ __forceinline__ void

__device__ __forceinline__ Frame make_frame(PP pp, unsigned char* lds_generic) {
    Frame F;
    F.lds = (LAS unsigned char*)lds_generic;
    { int t_ = threadIdx.x; asm volatile("" : "+v"(t_)); F.tid = t_; }
    F.lane = F.tid & 63; F.wave = __builtin_amdgcn_readfirstlane(F.tid >> 6);
    F.G = gridDim.x; F.bid = blockIdx.x; F.gw = F.bid * NWAVES + F.wave; F.NGW = F.G * NWAVES;
    F.ws = (unsigned char*)pp->ws; F.ctl = (unsigned*)(F.ws + WS_CTL);
    return F;
}
#define FRAME() DECL_LDS; asm volatile("" : "+s"(pp)); Frame F = make_frame(pp, lds_raw); unsigned char* ws = F.ws; (void)ws

PHASE_FN grid_bar(PP pp) {
    FRAME();
    XcdBarrier bar; bar.bar = F.ctl + CW_BAR; bar.x = xb_xcc_id(); bar.st = (volatile LAS unsigned*)(F.lds + LDS_MISC) + 8;
    xcd_barrier(bar);
}

static __device__ __forceinline__ void ln_pass(const Frame& F, float* out, float* XC, bf16* Hb, const float* lng, const float* lnb, const float* modv, const int sc_off, const int sh_off, const int TR) {
    f32x4 gg[4], bb[4];
#pragma unroll
    for (int j = 0; j < 4; ++j) { gg[j] = *(const f32x4*)(lng + 256 * j + 4 * F.lane); bb[j] = *(const f32x4*)(lnb + 256 * j + 4 * F.lane); }
    for (int r0 = F.gw; r0 < TR; r0 += 2 * F.NGW) {
        const int r1 = r0 + F.NGW; const bool two = r1 < TR;
        const bool c0 = r0 >= TL, c1 = r1 >= TL;
        float* x0 = c0 ? XC + (size_t)(r0 - TL) * D : out + (size_t)r0 * D; float* x1 = two ? (c1 ? XC + (size_t)(r1 - TL) * D : out + (size_t)r1 * D) : x0;
        const float* m0 = modv + (size_t)(c0 ? 16 : (r0 >> 12)) * 6144; const float* m1 = modv + (size_t)((two && !c1) ? (r1 >> 12) : 16) * 6144;
        f32x4 v0[4], v1[4], s0[4], t0[4], s1[4], t1[4];
        row_load(x0, F.lane, v0); row_load(x1, F.lane, v1);
        row_load_mod(m0 + sc_off, m0 + sh_off, F.lane, s0, t0); row_load_mod(m1 + sc_off, m1 + sh_off, F.lane, s1, t1);
        row_ln_pre(v0, gg, bb); row_ln_pre(v1, gg, bb);
        row_store(x0, F.lane, v0);
#pragma unroll
        for (int j = 0; j < 4; ++j) s0[j] = v0[j] * (s0[j] + 1.0f) + t0[j];
        row_store_bf16(Hb + (size_t)r0 * D, F.lane, s0);
        if (two) { row_store(x1, F.lane, v1);
#pragma unroll
            for (int j = 0; j < 4; ++j) s1[j] = v1[j] * (s1[j] + 1.0f) + t1[j];
            row_store_bf16(Hb + (size_t)r1 * D, F.lane, s1); }
    }
}
PHASE_FN ph_fold(PP pp) {
    FRAME();
    Params p; p.ws = ws; p.in[I_EV_WIN] = PIN(I_EV_WIN);
    for (int u = F.bid; u < 128; u += F.G) fold_unit(p, F, u);
}
PHASE_FN ph_mod(PP pp) {
    FRAME();
    float* MOD = (float*)(ws + WS_MOD);
    LAS float* sc = (LAS float*)F.lds;
    const float* cin = PIN(I_C); const float* ccin = PIN(I_CCTX);
    for (int e = F.tid; e < 17 * D; e += NTHREADS) { const int r = e >> 10, k = e & 1023; const float v = (r < 16) ? cin[r * D + k] : ccin[k]; sc[e] = silu_f(v); }
    __syncthreads();
    for (int grp = F.gw; grp < DEPTH * 6144 / 64; grp += F.NGW) {
        const int col = grp * 64 + F.lane, l = col / 6144, j = col - l * 6144;
        const float* W = PIN(I_WMOD) + (size_t)l * D * 6144 + j;
        float acc[17];
#pragma unroll
        for (int r = 0; r < 17; ++r) acc[r] = 0.f;
        for (int k = 0; k < D; k += 4) {
            const float w0 = W[(size_t)(k + 0) * 6144], w1 = W[(size_t)(k + 1) * 6144], w2 = W[(size_t)(k + 2) * 6144], w3 = W[(size_t)(k + 3) * 6144];
#pragma unroll
            for (int r = 0; r < 17; ++r) { const f32x4 s = *(const LAS f32x4*)(sc + r * D + k); acc[r] += s[0] * w0 + s[1] * w1 + s[2] * w2 + s[3] * w3; }
        }
        const float bm = PIN(I_BMOD)[l * 6144 + j];
#pragma unroll
        for (int r = 0; r < 17; ++r) MOD[((size_t)l * 17 + r) * 6144 + j] = acc[r] + bm;
    }
    __syncthreads();
}
PHASE_FN ph_cvt(PP pp) {
    FRAME();
    Params p; p.ws = ws;
    p.in[I_EV_WIN] = PIN(I_EV_WIN); p.in[I_EV_WOUT] = PIN(I_EV_WOUT); p.in[I_EV_W1] = PIN(I_EV_W1); p.in[I_EV_W3] = PIN(I_EV_W3); p.in[I_EV_W2] = PIN(I_EV_W2);
    p.in[I_OD_WIN] = PIN(I_OD_WIN); p.in[I_WGLU] = PIN(I_WGLU); p.in[I_OD_WOUT] = PIN(I_OD_WOUT); p.in[I_MW1] = PIN(I_MW1); p.in[I_MW3] = PIN(I_MW3); p.in[I_MW2] = PIN(I_MW2);
    LAS float* scr = (LAS float*)(F.lds + F.wave * 16384);
    for (int it = F.gw; it < CVT_ITEMS; it += F.NGW) cvt_item(p, it, scr, F.lane);
}
PHASE_FN ph_dftmat(PP pp) {
    FRAME();
    bf16* FDm = (bf16*)(ws + WS_FD); bf16* F2 = (bf16*)(ws + WS_F256);
    for (int it = F.bid * NTHREADS + F.tid; it < 2 * 256 * 64; it += F.G * NTHREADS) {
        const int which = it >> 14, k = (it >> 6) & 255, n0 = (it & 63) * 8; const bool isq = n0 >= 256; const int nb = n0 & 255;
        float v[8];
#pragma unroll
        for (int j = 0; j < 8; ++j) { const int phs = (k * (nb + j)) & 255; float sn, cs; sincospif((float)phs * (1.0f / 128.0f), &sn, &cs);
            v[j] = which ? (isq ? -sn * (1.f / 16.f) : cs * (1.f / 16.f)) : (isq ? sn * (1.f / 64.f) : cs * (1.f / 64.f)); }
        v4u w; w.x = cvt_pk_bf16(v[0], v[1]); w.y = cvt_pk_bf16(v[2], v[3]); w.z = cvt_pk_bf16(v[4], v[5]); w.w = cvt_pk_bf16(v[6], v[7]);
        *(v4u*)((which ? F2 : FDm) + (size_t)k * 512 + n0) = w;
    }
}
PHASE_FN ph_s5mat(PP pp) {
    FRAME();
    LAS float* lam = (LAS float*)F.lds;
    LAS float* bb = lam + 2 * 64 * 17 * 2;
    LAS float* cc = bb + 2 * 64 * 16 * 2;
    LAS float* kt = cc + 2 * 16 * 64 * 2;
    for (int unit = F.bid; unit < 64; unit += F.G) {
        const int li = unit >> 5, g = unit & 31;
        __syncthreads();
        if (F.tid < 128) { const int d = F.tid >> 6, pl = F.tid & 63; const int sidx = ((li * 2 + d) * 32 + g);
            const float are = PIN(I_A_RE)[sidx * 64 + pl], aim = PIN(I_A_IM)[sidx * 64 + pl], dt = expf(PIN(I_LOG_DT)[sidx]);
            for (int e = 0; e <= 16; ++e) { const float mag = expf(are * dt * (float)e); float sn, cn; sincosf(aim * dt * (float)e, &sn, &cn); lam[((d * 64 + pl) * 17 + e) * 2] = mag * cn; lam[((d * 64 + pl) * 17 + e) * 2 + 1] = mag * sn; } }
        __syncthreads();
        for (int e = F.tid; e < 2048; e += NTHREADS) { const int d = e >> 10, pl = (e >> 4) & 63, sp = e & 15; const int sidx = ((li * 2 + d) * 32 + g);
            const float are = PIN(I_A_RE)[sidx * 64 + pl], aim = PIN(I_A_IM)[sidx * 64 + pl];
            const float lre = lam[((d * 64 + pl) * 17 + 1) * 2], lim = lam[((d * 64 + pl) * 17 + 1) * 2 + 1];
            const float den = 1.0f / (are * are + aim * aim);
            const float fre = ((lre - 1.0f) * are + lim * aim) * den, fim = (lim * are - (lre - 1.0f) * aim) * den;
            const float br = PIN(I_B_RE)[((size_t)sidx * 64 + pl) * 16 + sp], bi = PIN(I_B_IM)[((size_t)sidx * 64 + pl) * 16 + sp];
            bb[e * 2] = fre * br - fim * bi; bb[e * 2 + 1] = fre * bi + fim * br; }
        for (int e = F.tid; e < 2048; e += NTHREADS) { const int d = e >> 10, sq = (e >> 6) & 15, pl = e & 63; const int sidx = ((li * 2 + d) * 32 + g);
            cc[e * 2] = PIN(I_C_RE)[((size_t)sidx * 16 + sq) * 64 + pl]; cc[e * 2 + 1] = PIN(I_C_IM)[((size_t)sidx * 16 + sq) * 64 + pl]; }
        __syncthreads();
        for (int e = F.tid; e < 8192; e += NTHREADS) { const int d = e >> 12, tau = (e >> 8) & 15, sq = (e >> 4) & 15, sp = e & 15; float acc = 0.f;
            for (int pl = 0; pl < 64; ++pl) { const float cr = cc[((d * 16 + sq) * 64 + pl) * 2], ci = cc[((d * 16 + sq) * 64 + pl) * 2 + 1];
                const float lr = lam[((d * 64 + pl) * 17 + tau) * 2], lj = lam[((d * 64 + pl) * 17 + tau) * 2 + 1];
                const float br = bb[((d * 64 + pl) * 16 + sp) * 2], bi = bb[((d * 64 + pl) * 16 + sp) * 2 + 1];
                const float tr = cr * lr - ci * lj, ti = cr * lj + ci * lr;
                acc += tr * br - ti * bi; }
            kt[e] = acc; }
        __syncthreads();
        bf16* WA = (bf16*)(ws + WS_S5M + (size_t)unit * S5M_STRIDE); bf16* CLm = WA + 512 * 256;
        const float* dsk = PIN(I_SSM_D) + (size_t)li * 512 + g * 16;
        for (int it = F.tid; it < 8192; it += NTHREADS) { const int row = it >> 5, c0 = (it & 31) * 8;
            float v[8];
            { const int i = row >> 4, sq = row & 15, j = c0 >> 4, sp0 = c0 & 15;
#pragma unroll
              for (int q = 0; q < 8; ++q) { const int sp = sp0 + q; float a = 0.f; if (i >= j) a += kt[((0 * 16 + (i - j)) * 16 + sq) * 16 + sp]; if (j >= i) a += kt[((1 * 16 + (j - i)) * 16 + sq) * 16 + sp]; if (i == j && sq == sp) a += dsk[sq]; v[q] = a; }
              v4u w; w.x = cvt_pk_bf16(v[0], v[1]); w.y = cvt_pk_bf16(v[2], v[3]); w.z = cvt_pk_bf16(v[4], v[5]); w.w = cvt_pk_bf16(v[6], v[7]); *(v4u*)(WA + (size_t)row * 256 + c0) = w; }
            { const int d = row >> 7, pl = (row >> 1) & 63, ri = row & 1, j = c0 >> 4, sp0 = c0 & 15, e = d ? j : 15 - j;
              const float lr = lam[((d * 64 + pl) * 17 + e) * 2], lj = lam[((d * 64 + pl) * 17 + e) * 2 + 1];
#pragma unroll
              for (int q = 0; q < 8; ++q) { const float br = bb[((d * 64 + pl) * 16 + sp0 + q) * 2], bi = bb[((d * 64 + pl) * 16 + sp0 + q) * 2 + 1]; v[q] = ri ? (lr * bi + lj * br) : (lr * br - lj * bi); }
              v4u w; w.x = cvt_pk_bf16(v[0], v[1]); w.y = cvt_pk_bf16(v[2], v[3]); w.z = cvt_pk_bf16(v[4], v[5]); w.w = cvt_pk_bf16(v[6], v[7]); *(v4u*)(WA + (size_t)(256 + row) * 256 + c0) = w; }
            { const int i = row >> 4, sq = row & 15, d = c0 >> 7, pl0 = (c0 >> 1) & 63, e = d ? 16 - i : i + 1;
#pragma unroll
              for (int q = 0; q < 4; ++q) { const int pl = pl0 + q; const float cr = cc[((d * 16 + sq) * 64 + pl) * 2], ci = cc[((d * 16 + sq) * 64 + pl) * 2 + 1];
                  const float lr = lam[((d * 64 + pl) * 17 + e) * 2], lj = lam[((d * 64 + pl) * 17 + e) * 2 + 1];
                  v[2 * q] = cr * lr - ci * lj; v[2 * q + 1] = -(cr * lj + ci * lr); }
              v4u w; w.x = cvt_pk_bf16(v[0], v[1]); w.y = cvt_pk_bf16(v[2], v[3]); w.z = cvt_pk_bf16(v[4], v[5]); w.w = cvt_pk_bf16(v[6], v[7]); *(v4u*)(CLm + (size_t)row * 256 + c0) = w; }
        }
    }
    __syncthreads();
}
PHASE_FN ph_pro_b(PP pp) {
    FRAME();
    const float* MOD = (const float*)(ws + WS_MOD); bf16* Hb = (bf16*)(ws + WS_H);
    const float* xin = PIN(I_X); const float* cin = PIN(I_CTX);
    for (int r = F.gw; r < T; r += F.NGW) {
        const bool isc = r >= TL; const float* xr = isc ? cin + (size_t)(r - TL) * D : xin + (size_t)r * D;
        const float* m = MOD + (size_t)(isc ? 16 : (r >> 12)) * 6144;
        f32x4 v[4], h[4]; row_load(xr, F.lane, v); row_modulate(h, v, m + 1024, m, F.lane); row_store_bf16(Hb + (size_t)r * D, F.lane, h);
    }
}

PHASE_FN ph_e1(PP pp, int layer) {
    FRAME();
    unsigned char* evw = ws + WS_EV + (layer >> 1) * EV_STRIDE; unsigned char* BIG = ws + WS_BIG;
    SchedEvIn S{F.G, F.bid, (const char*)(ws + WS_H), (const char*)(evw + EV_WQKV), (const char*)(evw + EV_WPQ), (char*)(BIG + BIG_QKV), (char*)(BIG + BIG_PQT), (char*)(BIG + BIG_PQTC)};
    pg8::gemm_phase<pg8::EpiStore, SchedEvIn, true, true>(F.lds, F.tid, pg8::Dims{D, D, D}, S, pg8::EpiStore{});
}
struct cf { float r, i; };
__device__ __forceinline__ cf cmul(cf a, float wr, float wi) { return cf{a.r * wr - a.i * wi, a.r * wi + a.i * wr}; }
__device__ __forceinline__ void radix4(cf x0, cf x1, cf x2, cf x3, cf& y0, cf& y1, cf& y2, cf& y3) {
    const cf s02{x0.r + x2.r, x0.i + x2.i}, d02{x0.r - x2.r, x0.i - x2.i}, s13{x1.r + x3.r, x1.i + x3.i}, d13{x1.r - x3.r, x1.i - x3.i};
    y0 = cf{s02.r + s13.r, s02.i + s13.i}; y2 = cf{s02.r - s13.r, s02.i - s13.i}; y1 = cf{d02.r + d13.i, d02.i - d13.r}; y3 = cf{d02.r - d13.i, d02.i + d13.r};
}
__device__ __forceinline__ void fft16(cf (&x)[16]) {
    constexpr float C1 = 0.92387953251128674f, S1 = 0.38268343236508977f, C2 = 0.70710678118654752f;
    cf A[4][4];
#pragma unroll
    for (int b = 0; b < 4; ++b) radix4(x[b], x[4 + b], x[8 + b], x[12 + b], A[b][0], A[b][1], A[b][2], A[b][3]);
    A[1][1] = cmul(A[1][1], C1, -S1); A[1][2] = cmul(A[1][2], C2, -C2); A[1][3] = cmul(A[1][3], S1, -C1);
    A[2][1] = cmul(A[2][1], C2, -C2); A[2][2] = cf{A[2][2].i, -A[2][2].r}; A[2][3] = cmul(A[2][3], -C2, -C2);
    A[3][1] = cmul(A[3][1], S1, -C1); A[3][2] = cmul(A[3][2], -C2, -C2); A[3][3] = cmul(A[3][3], -C1, S1);
#pragma unroll
    for (int c = 0; c < 4; ++c) radix4(A[0][c], A[1][c], A[2][c], A[3][c], x[c], x[c + 4], x[c + 8], x[c + 12]);
}
PHASE_FN ph_e2_fft(PP pp) {
    FRAME();
    const bf16* PQT = (const bf16*)(ws + WS_BIG + BIG_PQT); bf16* VB = (bf16*)(ws + WS_H);
    for (int it = F.bid * NTHREADS + F.tid; it < NBATCH * 512 * 128; it += F.G * NTHREADS) {
        const int n1 = (it & 127) * 2, ch = (it >> 7) & 511, b = it >> 16;
        const bf16* pp_ = PQT + ((size_t)(b * 512 + ch) * 2) * 4096 + n1; const bf16* qq_ = pp_ + 4096;
        unsigned pw[16], qw[16];
#pragma unroll
        for (int n2 = 0; n2 < 16; ++n2) { pw[n2] = *(const unsigned*)(pp_ + 256 * n2); qw[n2] = *(const unsigned*)(qq_ + 256 * n2); }
        unsigned ore[16], oim[16];
#pragma unroll
        for (int e = 0; e < 2; ++e) {
            cf x[16];
#pragma unroll
            for (int n2 = 0; n2 < 16; ++n2) { x[n2].r = e ? bfhi(pw[n2]) : bflo(pw[n2]); x[n2].i = -(e ? bfhi(qw[n2]) : bflo(qw[n2])); }
            fft16(x);
            float sn, cs; sincospif((float)(n1 + e) * (1.0f / 2048.0f), &sn, &cs);
            cf wk{cs, -sn};
#pragma unroll
            for (int k2 = 1; k2 < 16; ++k2) { x[k2] = cmul(x[k2], wk.r, wk.i); wk = cmul(wk, cs, -sn); }
#pragma unroll
            for (int k2 = 0; k2 < 16; ++k2) { const unsigned rr = cvt_pk_bf16(x[k2].r, 0.f) & 0xffffu, ii = cvt_pk_bf16(x[k2].i, 0.f) & 0xffffu;
                if (e) { ore[k2] |= rr << 16; oim[k2] |= ii << 16; } else { ore[k2] = rr; oim[k2] = ii; } }
        }
#pragma unroll
        for (int k2 = 0; k2 < 16; ++k2) { bf16* dst = VB + (((size_t)b * 16 + k2) * 512 + ch) * 512 + n1; *(unsigned*)dst = ore[k2]; *(unsigned*)(dst + 256) = oim[k2]; }
    }
}
PHASE_FN ph_e2_dft(PP pp) {
    FRAME();
    unsigned char* BIG = ws + WS_BIG;
    SchedDft S{F.G, F.bid, (const char*)(ws + WS_FD), (const char*)(ws + WS_H), (const char*)(ws + WS_F256), (const char*)(BIG + BIG_PQTC), (char*)(BIG + BIG_MIX)};
    pg8::gemm_phase<pg8::EpiStore, SchedDft, true, true>(F.lds, F.tid, pg8::Dims{512, 512, 512}, S, pg8::EpiStore{});
}
PHASE_FN ph_e2_rope(PP pp) {
    FRAME();
    bf16* QKV = (bf16*)(ws + WS_BIG + BIG_QKV);
    LAS f32x2* cs = (LAS f32x2*)F.lds;
    __syncthreads();
    for (int e = F.tid; e < 1024; e += NTHREADS) { const int pos = e >> 4, i = e & 15; const float inv = powf(10000.0f, -(float)i / 16.0f); float s, c; sincosf((float)pos * inv, &s, &c); cs[e] = (f32x2){c, s}; }
    __syncthreads();
    for (int it = F.bid * NTHREADS + F.tid; it < TL * 80; it += F.G * NTHREADS) {
        const int r = it / 80, q = it - r * 80, hh = q >> 3, ax = (q >> 2) & 1, i0 = (q & 3) * 4;
        const int n = r & 4095, pos = ax ? (n & 63) : (n >> 6);
        bf16* base = QKV + (size_t)r * 768 + hh * 64 + ax * 32 + i0;
        const v2u a = *(const v2u*)base, b = *(const v2u*)(base + 16);
        const float x1[4] = {bflo(a.x), bfhi(a.x), bflo(a.y), bfhi(a.y)}, x2[4] = {bflo(b.x), bfhi(b.x), bflo(b.y), bfhi(b.y)};
        float o1[4], o2[4];
#pragma unroll
        for (int j = 0; j < 4; ++j) { const f32x2 t = cs[pos * 16 + i0 + j]; o1[j] = x1[j] * t.x - x2[j] * t.y; o2[j] = x1[j] * t.y + x2[j] * t.x; }
        v2u wa, wb; wa.x = cvt_pk_bf16(o1[0], o1[1]); wa.y = cvt_pk_bf16(o1[2], o1[3]); wb.x = cvt_pk_bf16(o2[0], o2[1]); wb.y = cvt_pk_bf16(o2[2], o2[3]);
        *(v2u*)base = wa; *(v2u*)(base + 16) = wb;
    }
    bf16* VT = (bf16*)(ws + WS_BIG + BIG_VT);
    for (int it = F.bid * NTHREADS + F.tid; it < NBATCH * 2 * 544 * 64; it += F.G * NTHREADS) {
        const int d = it & 63, kg = (it >> 6) % 544, bh = (it >> 6) / 544, b = bh >> 1, hkv = bh & 1;
        const int key0 = kg * 8; const size_t row0 = (key0 < 256) ? ((size_t)TL + (size_t)b * 256 + key0) : ((size_t)b * 4096 + (key0 - 256));
        const bf16* src = QKV + row0 * 768 + 640 + hkv * 64 + d;
        unsigned short v[8];
#pragma unroll
        for (int j = 0; j < 8; ++j) v[j] = src[(size_t)j * 768];
        v4u w; w.x = v[0] | ((unsigned)v[1] << 16); w.y = v[2] | ((unsigned)v[3] << 16); w.z = v[4] | ((unsigned)v[5] << 16); w.w = v[6] | ((unsigned)v[7] << 16);
        *(v4u*)(VT + ((size_t)bh * 64 + d) * 4352 + key0) = w;
    }
    __syncthreads();
}
typedef float f32x16 __attribute__((ext_vector_type(16)));
typedef __bf16 bf16x2v __attribute__((ext_vector_type(2)));
__device__ __forceinline__ unsigned pk_bf16(float a, float b) { const bf16x2v t = __builtin_convertvector((f32x2){a, b}, bf16x2v); return __builtin_bit_cast(unsigned, t); }
constexpr int AT_KP = 144, AT_VP1 = 648, AT_VP2 = 520, AT_VOFF = 320 * AT_KP;
template <bool MASKED>
__device__ __forceinline__ void attn_tile(const LAS unsigned char* Ks, const LAS unsigned char* Vs, const int vpitch, const int kl_base, const bf16x8 (&qf)[4], f32x16& o0, f32x16& o1, float& m, float& l,
                                          const int r, const int h, const int kj0, const int qi) {
    f32x16 x;
#pragma unroll
    for (int i = 0; i < 16; ++i) x[i] = 0.f;
#pragma unroll
    for (int s = 0; s < 4; ++s) { const bf16x8 kf = *(const LAS bf16x8*)(Ks + (kl_base + r) * AT_KP + (16 * s + 8 * h) * 2); x = __builtin_amdgcn_mfma_f32_32x32x16_bf16(kf, qf[s], x, 0, 0, 0); }
    float sc[16]; float mt = -1e30f;
#pragma unroll
    for (int i = 0; i < 16; ++i) { float v = x[i] * 0.125f;
        if (MASKED) { const int kj = kj0 + (i & 3) + 8 * (i >> 2) + 4 * h; const bool ok = (kj >= 0) && (kj < SEQ) && (kj - qi <= 128) && (qi - kj <= 128); v = ok ? v : -1e30f; }
        sc[i] = v; mt = fmaxf(mt, v); }
    mt = fmaxf(mt, __shfl_xor(mt, 32));
    const float mn = fmaxf(m, mt), alpha = __expf(m - mn); m = mn;
    float ps = 0.f;
#pragma unroll
    for (int i = 0; i < 16; ++i) { sc[i] = __expf(sc[i] - mn); ps += sc[i]; }
    l = l * alpha + ps;
#pragma unroll
    for (int i = 0; i < 16; ++i) { o0[i] *= alpha; o1[i] *= alpha; }
#pragma unroll
    for (int s2 = 0; s2 < 2; ++s2) {
        v4u pw; pw.x = pk_bf16(sc[8 * s2 + 0], sc[8 * s2 + 1]); pw.y = pk_bf16(sc[8 * s2 + 2], sc[8 * s2 + 3]); pw.z = pk_bf16(sc[8 * s2 + 4], sc[8 * s2 + 5]); pw.w = pk_bf16(sc[8 * s2 + 6], sc[8 * s2 + 7]);
        const bf16x8 pk = __builtin_bit_cast(bf16x8, pw);
        { const LAS unsigned char* vp = Vs + r * vpitch + (kl_base + 16 * s2 + 4 * h) * 2; const v2u lo = *(const LAS v2u*)vp, hi = *(const LAS v2u*)(vp + 16);
          v4u vw; vw.x = lo.x; vw.y = lo.y; vw.z = hi.x; vw.w = hi.y; o0 = __builtin_amdgcn_mfma_f32_32x32x16_bf16(__builtin_bit_cast(bf16x8, vw), pk, o0, 0, 0, 0); }
        { const LAS unsigned char* vp = Vs + (32 + r) * vpitch + (kl_base + 16 * s2 + 4 * h) * 2; const v2u lo = *(const LAS v2u*)vp, hi = *(const LAS v2u*)(vp + 16);
          v4u vw; vw.x = lo.x; vw.y = lo.y; vw.z = hi.x; vw.w = hi.y; o1 = __builtin_amdgcn_mfma_f32_32x32x16_bf16(__builtin_bit_cast(bf16x8, vw), pk, o1, 0, 0, 0); }
    }
}
PHASE_FN ph_e3_attn(PP pp, int layer) {
    FRAME();
    const bf16* QKV = (const bf16*)(ws + WS_BIG + BIG_QKV); bf16* MIX = (bf16*)(ws + WS_BIG + BIG_MIX); const bf16* VT = (const bf16*)(ws + WS_BIG + BIG_VT);
    const float* sinkp = PIN(I_EV_SINK) + (layer >> 1) * 8;
    LAS unsigned char* Ks = F.lds; LAS unsigned char* Vs = F.lds + AT_VOFF;
    const int r = F.lane & 31, h = F.lane >> 5, g = F.wave >> 1, th = F.wave & 1;
    for (int u = F.bid; u < 2048 + 128; u += F.G) {
        const bool isc = u >= 2048;
        int b, hkv, qb; if (!isc) { b = u >> 7; hkv = (u >> 6) & 1; qb = u & 63; } else { const int v = u - 2048; b = v >> 3; hkv = (v >> 2) & 1; qb = v & 3; }
        const int n0 = qb * 64, bh = b * 2 + hkv;
        const size_t qrow = isc ? ((size_t)TL + (size_t)b * 256 + n0 + 32 * th + r) : ((size_t)b * 4096 + n0 + 32 * th + r);
        bf16x8 qf[4];
#pragma unroll
        for (int s = 0; s < 4; ++s) qf[s] = *(const bf16x8*)(QKV + qrow * 768 + (hkv * 4 + g) * 64 + 16 * s + 8 * h);
        float m = sinkp[hkv * 4 + g], l = (h == 0) ? 1.0f : 0.0f;
        f32x16 o0, o1;
#pragma unroll
        for (int i = 0; i < 16; ++i) { o0[i] = 0.f; o1[i] = 0.f; }
        __syncthreads();
        if (!isc) {
            for (int pc = F.tid; pc < 2560; pc += NTHREADS) { const int kl = pc >> 3, c8 = pc & 7, kj = n0 - 128 + kl;
                v4u v = (v4u){0u, 0u, 0u, 0u}; if (kj >= 0 && kj < SEQ) v = *(const v4u*)(QKV + ((size_t)b * 4096 + kj) * 768 + 512 + hkv * 64 + c8 * 8);
                *(LAS v4u*)(Ks + kl * AT_KP + c8 * 16) = v; }
            for (int pc = F.tid; pc < 2560; pc += NTHREADS) { const int d = pc / 40, c = pc - d * 40, kj = n0 - 128 + c * 8;
                v4u v = (v4u){0u, 0u, 0u, 0u}; if (kj >= 0 && kj < SEQ) v = *(const v4u*)(VT + ((size_t)bh * 64 + d) * 4352 + 256 + kj);
                LAS v2u* dst = (LAS v2u*)(Vs + d * AT_VP1 + c * 16); dst[0] = (v2u){v.x, v.y}; dst[1] = (v2u){v.z, v.w}; }
            __syncthreads();
            const int qi = n0 + 32 * th + r;
#pragma unroll 1
            for (int t = 0; t < 9; ++t) { const int klb = 32 * th + 32 * t; attn_tile<true>(Ks, Vs, AT_VP1, klb, qf, o0, o1, m, l, r, h, n0 - 128 + klb, qi); }
            __syncthreads();
        }
        for (int pc = F.tid; pc < 2048; pc += NTHREADS) { const int j = pc >> 3, c8 = pc & 7;
            *(LAS v4u*)(Ks + j * AT_KP + c8 * 16) = *(const v4u*)(QKV + ((size_t)TL + (size_t)b * 256 + j) * 768 + 512 + hkv * 64 + c8 * 8); }
        for (int pc = F.tid; pc < 2048; pc += NTHREADS) { const int d = pc >> 5, c = pc & 31; const v4u v = *(const v4u*)(VT + ((size_t)bh * 64 + d) * 4352 + c * 8);
            LAS v2u* dst = (LAS v2u*)(Vs + d * AT_VP2 + c * 16); dst[0] = (v2u){v.x, v.y}; dst[1] = (v2u){v.z, v.w}; }
        __syncthreads();
#pragma unroll 1
        for (int t = 0; t < 8; ++t) attn_tile<false>(Ks, Vs, AT_VP2, 32 * t, qf, o0, o1, m, l, r, h, 0, 0);
        const float inv = 1.0f / (l + __shfl_xor(l, 32));
        bf16* orow = MIX + qrow * D + 512 + (hkv * 4 + g) * 64 + 4 * h;
#pragma unroll
        for (int q4 = 0; q4 < 4; ++q4) {
            v2u w0; w0.x = pk_bf16(o0[4 * q4 + 0] * inv, o0[4 * q4 + 1] * inv); w0.y = pk_bf16(o0[4 * q4 + 2] * inv, o0[4 * q4 + 3] * inv); *(v2u*)(orow + 8 * q4) = w0;
            v2u w1; w1.x = pk_bf16(o1[4 * q4 + 0] * inv, o1[4 * q4 + 1] * inv); w1.y = pk_bf16(o1[4 * q4 + 2] * inv, o1[4 * q4 + 3] * inv); *(v2u*)(orow + 32 + 8 * q4) = w1;
        }
    }
    __syncthreads();
}
PHASE_FN ph_outproj(PP pp, int layer) {
    FRAME();
    const int li = layer >> 1; const bool odd = (layer & 1) != 0;
    const int TR = (layer == DEPTH - 1) ? TL : T;
    const char* W = odd ? (const char*)(ws + WS_OD + li * OD_STRIDE + OD_WOUT) : (const char*)(ws + WS_EV + li * EV_STRIDE + EV_WOUT);
    float* XC = (float*)(ws + WS_XC); float* out = (float*)pp->out;
    const float* xl_src = (layer == 0) ? PIN(I_X) : out; const float* xc_src = (layer == 0) ? PIN(I_CTX) : XC;
    const float* modl = (const float*)(ws + WS_MOD) + (size_t)layer * 17 * 6144;
    SchedResid S{F.G, F.bid, (TR / 256) * 4, (const char*)(ws + WS_BIG + BIG_MIX), (size_t)256 * D * 2, W, (size_t)256 * D * 2, xl_src, xc_src, out, XC, modl + 2048};
    pg8::EpiResidLN E{PIN(I_LNG) + (size_t)(layer * 2) * D, PIN(I_LNB) + (size_t)(layer * 2) * D, 2048, 1024, (bf16*)(ws + WS_H), F.ctl + CW_LN + (layer * 2) * LN_SITE_WORDS,
                      (unsigned long long*)(ws + WS_XS), F.ctl + 2, F.lds + LDS_LNTAB};
    pg8::gemm_phase<pg8::EpiResidLN, SchedResid, true, true>(F.lds, F.tid, pg8::Dims{D, D, D}, S, E);
}
PHASE_FN ph_e6(PP pp, int layer) {
    FRAME();
    unsigned char* evw = ws + WS_EV + (layer >> 1) * EV_STRIDE;
    SchedStd S{22, (T / 256) * 22, F.G, F.bid, (const char*)(ws + WS_H), (const char*)(evw + EV_W13), (char*)(ws + WS_BIG + BIG_HID), (size_t)256 * D * 2, (size_t)256 * D * 2, (size_t)256 * FFH * 2, (size_t)128 * 2, FFH, 1 << 30};
    pg8::gemm_phase<pg8::EpiSwiGLU, SchedStd, true, true>(F.lds, F.tid, pg8::Dims{D, D, D}, S, pg8::EpiSwiGLU{});
}
PHASE_FN ph_e7(PP pp, int layer) {
    FRAME();
    unsigned char* evw = ws + WS_EV + (layer >> 1) * EV_STRIDE;
    float* XC = (float*)(ws + WS_XC); float* out = (float*)pp->out;
    const float* modl = (const float*)(ws + WS_MOD) + (size_t)layer * 17 * 6144;
    SchedResid S{F.G, F.bid, (T / 256) * 4, (const char*)(ws + WS_BIG + BIG_HID), (size_t)256 * FFH * 2, (const char*)(evw + EV_W2), (size_t)256 * FFH * 2, out, XC, out, XC, modl + 5120};
    pg8::EpiResidLN E{PIN(I_LNG) + (size_t)(layer * 2 + 1) * D, PIN(I_LNB) + (size_t)(layer * 2 + 1) * D, 17 * 6144 + 1024 - 5120, 17 * 6144 - 5120, (bf16*)(ws + WS_H), F.ctl + CW_LN + (layer * 2 + 1) * LN_SITE_WORDS,
                      (unsigned long long*)(ws + WS_XS), F.ctl + 2, F.lds + LDS_LNTAB};
    pg8::gemm_phase<pg8::EpiResidLN, SchedResid, true, true>(F.lds, F.tid, pg8::Dims{FFH, FFH, FFH}, S, E);
}

PHASE_FN ph_o1(PP pp, int layer) {
    FRAME();
    unsigned char* odw = ws + WS_OD + (layer >> 1) * OD_STRIDE;
    SchedStd S{6, (T / 256) * 6, F.G, F.bid, (const char*)(ws + WS_H), (const char*)(odw + OD_WIN), (char*)(ws + WS_BIG + BIG_P), (size_t)256 * D * 2, (size_t)256 * D * 2, (size_t)256 * 1536 * 2, (size_t)256 * 2, 1536, 2};
    pg8::gemm_phase<pg8::EpiStore, SchedStd, true, true>(F.lds, F.tid, pg8::Dims{D, D, D}, S, pg8::EpiStore{});
}
PHASE_FN ph_o2_s5a(PP pp, int layer) {
    FRAME();
    const int li = layer >> 1;
    SchedS5A S{F.G, F.bid, (const char*)(ws + WS_BIG + BIG_P), (const char*)(ws + WS_S5M + (size_t)li * 32 * S5M_STRIDE), (char*)(ws + WS_H + 68 * MiB), (char*)(ws + WS_H)};
    pg8::gemm_phase<pg8::EpiStore, SchedS5A, true, true, pg8::AMapS5>(F.lds, F.tid, pg8::Dims{256, 0, 256}, S, pg8::EpiStore{}, pg8::AMapS5{});
}
PHASE_FN ph_o2_scan(PP pp, int layer) {
    FRAME();
    const int li = layer >> 1;
    if (F.tid < 256) {
        const int t = F.bid * 256 + F.tid;
        if (t < NBATCH * 32 * 2 * 64) {
            const int pl = t & 63, d = (t >> 6) & 1, g = (t >> 7) & 31, b = t >> 12;
            const int sidx = ((li * 2 + d) * 32 + g);
            const float are = PIN(I_A_RE)[sidx * 64 + pl], aim = PIN(I_A_IM)[sidx * 64 + pl], dt = expf(PIN(I_LOG_DT)[sidx]);
            const float mag = expf(16.0f * are * dt); float sn, cn; sincosf(16.0f * aim * dt, &sn, &cn);
            const float lre = mag * cn, lim = mag * sn;
            unsigned* HB = (unsigned*)(ws + WS_H) + (g * 256 + d * 128 + pl * 2) / 2;
            float cre = 0.f, cim = 0.f;
#define S5_CROW(k_) ((k_) < 16 ? (4096 + b * 16 + (d ? 15 - (k_) : (k_))) : (b * 256 + (d ? 255 - ((k_) - 16) : ((k_) - 16))))
            for (int k0 = 0; k0 < 272; k0 += 8) {
                unsigned w[8];
#pragma unroll
                for (int j = 0; j < 8; ++j) w[j] = HB[(size_t)S5_CROW(k0 + j) * 4096];
#pragma unroll
                for (int j = 0; j < 8; ++j) { HB[(size_t)S5_CROW(k0 + j) * 4096] = cvt_pk_bf16(cre, cim);
                    const float sr = bflo(w[j]), si = bfhi(w[j]); const float nr = lre * cre - lim * cim + sr, ni = lre * cim + lim * cre + si; cre = nr; cim = ni; }
            }
#undef S5_CROW
        }
    }
}
PHASE_FN ph_o3(PP pp, int layer) {
    FRAME();
    const int li = layer >> 1;
    SchedS5B S{F.G, F.bid, (const char*)(ws + WS_H), (const char*)(ws + WS_S5M + (size_t)li * 32 * S5M_STRIDE + 256 * 1024), (const char*)(ws + WS_H + 68 * MiB), (char*)(ws + WS_BIG + BIG_P)};
    pg8::gemm_phase<pg8::EpiS5B, SchedS5B, true, true>(F.lds, F.tid, pg8::Dims{256, 8192, 256}, S, pg8::EpiS5B{});
}
PHASE_FN ph_o2_gmlp(PP pp, int layer) {
    FRAME();
    const int li = layer >> 1; const int TR = (layer == DEPTH - 1) ? TL : T;
    const bf16* P = (const bf16*)(ws + WS_BIG + BIG_P); bf16* MIX = (bf16*)(ws + WS_BIG + BIG_MIX);
    constexpr int GP = 272;
    LAS unsigned char* Vt = F.lds;
    LAS unsigned char* Wt = F.lds + 128 * GP;
    LAS f32x2* stt = (LAS f32x2*)(F.lds + 2 * 128 * GP);
    const float* ws_w = PIN(I_WS) + (size_t)li * 4 * 128 * 128; const float* bs = PIN(I_BS) + (size_t)li * 4 * 128;
    const int r = F.lane & 31, hh = F.lane >> 5, et = F.wave >> 1, it0 = (F.wave & 1) * 2;
    const int nunits = (TR / 128) * 4;
    for (int u = F.bid; u < nunits; u += F.G) {
        const int ch = u >> 2, h = u & 3; const size_t row0 = (size_t)ch * 128;
        __syncthreads();
#pragma unroll 4
        for (int t = 0; t < 16; ++t) { const int j = F.wave * 16 + t; const v4u w = *(const v4u*)(P + (row0 + j) * 1536 + 1024 + F.lane * 8);
            const float f[8] = {bflo(w.x), bfhi(w.x), bflo(w.y), bfhi(w.y), bflo(w.z), bfhi(w.z), bflo(w.w), bfhi(w.w)};
            float sm = 0.f;
#pragma unroll
            for (int q = 0; q < 8; ++q) sm += f[q];
            const float mu = wave_sum(sm) * (1.f / 512.f); float qv = 0.f;
#pragma unroll
            for (int q = 0; q < 8; ++q) qv += (f[q] - mu) * (f[q] - mu);
            const float rs = rsqrtf(wave_sum(qv) * (1.f / 512.f) + LN_EPS);
            if (F.lane == 0) stt[j] = (f32x2){mu, rs}; }
        for (int pc = F.tid; pc < 2048; pc += NTHREADS) { const int i = pc >> 4, j8 = (pc & 15) * 8; const float* wp = ws_w + (size_t)h * 16384 + i * 128 + j8;
            const f32x4 a = *(const f32x4*)wp, b = *(const f32x4*)(wp + 4);
            v4u o; o.x = cvt_pk_bf16(a[0], a[1]); o.y = cvt_pk_bf16(a[2], a[3]); o.z = cvt_pk_bf16(b[0], b[1]); o.w = cvt_pk_bf16(b[2], b[3]);
            *(LAS v4u*)(Wt + i * GP + j8 * 2) = o; }
        __syncthreads();
        for (int pc = F.tid; pc < 2048; pc += NTHREADS) { const int eg = pc >> 7, j = pc & 127; const v4u w = *(const v4u*)(P + (row0 + j) * 1536 + 1024 + h * 128 + eg * 8);
            const f32x2 ms = stt[j];
            const float f[8] = {bflo(w.x), bfhi(w.x), bflo(w.y), bfhi(w.y), bflo(w.z), bfhi(w.z), bflo(w.w), bfhi(w.w)};
#pragma unroll
            for (int q = 0; q < 8; q += 2) { const unsigned pkd = cvt_pk_bf16((f[q] - ms.x) * ms.y, (f[q + 1] - ms.x) * ms.y);
                *(LAS unsigned short*)(Vt + (eg * 8 + q) * GP + j * 2) = (unsigned short)(pkd & 0xffffu); *(LAS unsigned short*)(Vt + (eg * 8 + q + 1) * GP + j * 2) = (unsigned short)(pkd >> 16); } }
        __syncthreads();
        f32x16 acc0, acc1;
#pragma unroll
        for (int q = 0; q < 16; ++q) { acc0[q] = 0.f; acc1[q] = 0.f; }
#pragma unroll
        for (int sk = 0; sk < 8; ++sk) {
            const bf16x8 a = *(const LAS bf16x8*)(Vt + (et * 32 + r) * GP + (16 * sk + 8 * hh) * 2);
            const bf16x8 b0 = *(const LAS bf16x8*)(Wt + (it0 * 32 + r) * GP + (16 * sk + 8 * hh) * 2), b1 = *(const LAS bf16x8*)(Wt + ((it0 + 1) * 32 + r) * GP + (16 * sk + 8 * hh) * 2);
            acc0 = __builtin_amdgcn_mfma_f32_32x32x16_bf16(a, b0, acc0, 0, 0, 0); acc1 = __builtin_amdgcn_mfma_f32_32x32x16_bf16(a, b1, acc1, 0, 0, 0);
        }
#pragma unroll
        for (int t = 0; t < 2; ++t) { const int i = (it0 + t) * 32 + r; const float bb = bs[h * 128 + i];
            const bf16* up = P + (row0 + i) * 1536 + 512 + h * 128 + et * 32 + 4 * hh; bf16* op = MIX + (row0 + i) * D + 512 + h * 128 + et * 32 + 4 * hh;
#pragma unroll
            for (int q4 = 0; q4 < 4; ++q4) { const v2u uw = *(const v2u*)(up + 8 * q4);
                const float a0 = (t ? acc1[4 * q4 + 0] : acc0[4 * q4 + 0]) + bb, a1 = (t ? acc1[4 * q4 + 1] : acc0[4 * q4 + 1]) + bb, a2 = (t ? acc1[4 * q4 + 2] : acc0[4 * q4 + 2]) + bb, a3 = (t ? acc1[4 * q4 + 3] : acc0[4 * q4 + 3]) + bb;
                v2u o; o.x = cvt_pk_bf16(bflo(uw.x) * a0, bfhi(uw.x) * a1); o.y = cvt_pk_bf16(bflo(uw.y) * a2, bfhi(uw.y) * a3);
                *(v2u*)(op + 8 * q4) = o; } }
    }
    __syncthreads();
}
PHASE_FN ph_o4(PP pp, int layer) {
    FRAME();
    const int li = layer >> 1;
    unsigned char* odw = ws + WS_OD + li * OD_STRIDE;
    SchedGlu S{F.G, F.bid, (const char*)(ws + WS_BIG + BIG_P), (const char*)(odw + OD_WGLU), (char*)(ws + WS_BIG + BIG_MIX), PIN(I_BGLU) + (size_t)li * 512};
    pg8::gemm_phase<pg8::EpiGLU, SchedGlu, true, true>(F.lds, F.tid, pg8::Dims{512, 1536, 512}, S, pg8::EpiGLU{});
}
PHASE_FN ph_o6(PP pp, int layer) {
    FRAME();
    const int li = layer >> 1; const int TR = (layer == DEPTH - 1) ? TL : T;
    const bf16* Hb = (const bf16*)(ws + WS_H);
    int* tokE = (int*)(ws + WS_TOK); int* tokS0 = tokE + T; int* tokS1 = tokS0 + T; float* tokG0 = (float*)(tokS1 + T);
    unsigned* ecnt = F.ctl + CW_CNT + li * 64;
    LAS float* wr_s = (LAS float*)F.lds;
    LAS unsigned* lcnt = (LAS unsigned*)(F.lds + 32768);
    const float* rw = PIN(I_ROUTER) + (size_t)li * D * 8;
    __syncthreads();
    for (int e = F.tid; e < D * 8; e += NTHREADS) wr_s[e] = rw[e];
    if (F.tid < 16) lcnt[F.tid] = 0u;
    __syncthreads();
    for (int r = F.gw; r < TR; r += F.NGW) {
        const v4u* src = (const v4u*)(Hb + (size_t)r * D) + 2 * F.lane;
        const v4u a = src[0], b = src[1];
        const float hv[16] = {bflo(a.x), bfhi(a.x), bflo(a.y), bfhi(a.y), bflo(a.z), bfhi(a.z), bflo(a.w), bfhi(a.w), bflo(b.x), bfhi(b.x), bflo(b.y), bfhi(b.y), bflo(b.z), bfhi(b.z), bflo(b.w), bfhi(b.w)};
        float lg[8];
#pragma unroll
        for (int e = 0; e < 8; ++e) lg[e] = 0.f;
#pragma unroll
        for (int q = 0; q < 16; ++q) { const int col = 16 * F.lane + q; const f32x4 w0 = *(const LAS f32x4*)(wr_s + col * 8), w1 = *(const LAS f32x4*)(wr_s + col * 8 + 4);
            lg[0] += hv[q] * w0[0]; lg[1] += hv[q] * w0[1]; lg[2] += hv[q] * w0[2]; lg[3] += hv[q] * w0[3]; lg[4] += hv[q] * w1[0]; lg[5] += hv[q] * w1[1]; lg[6] += hv[q] * w1[2]; lg[7] += hv[q] * w1[3]; }
#pragma unroll
        for (int e = 0; e < 8; ++e) lg[e] = wave_sum(lg[e]);
        if (F.lane == 0) {
            int e0 = 0; float v0 = lg[0];
#pragma unroll
            for (int e = 1; e < 8; ++e) if (lg[e] > v0) { v0 = lg[e]; e0 = e; }
            int e1 = -1; float v1 = -3.0e38f;
#pragma unroll
            for (int e = 0; e < 8; ++e) if (e != e0 && lg[e] > v1) { v1 = lg[e]; e1 = e; }
            const float w0 = 1.0f / (1.0f + __expf(v1 - v0));
            const int s0 = (int)__hip_atomic_fetch_add(lcnt + e0, 1u, __ATOMIC_RELAXED, __HIP_MEMORY_SCOPE_WORKGROUP), s1 = (int)__hip_atomic_fetch_add(lcnt + e1, 1u, __ATOMIC_RELAXED, __HIP_MEMORY_SCOPE_WORKGROUP);
            tokE[r] = e0 | (e1 << 8); tokS0[r] = s0; tokS1[r] = s1; tokG0[r] = w0;
        }
    }
    __syncthreads();
    if (F.tid < 8) lcnt[8 + F.tid] = atomicAdd(ecnt + F.tid, lcnt[F.tid]);
    VM_WAIT();
    __syncthreads();
    { const int r = F.gw + F.lane * F.NGW;
      if (r < TR) { const int ee = tokE[r]; tokS0[r] += (int)lcnt[8 + (ee & 255)]; tokS1[r] += (int)lcnt[8 + (ee >> 8)]; } }
    __syncthreads();
}
PHASE_FN ph_o7(PP pp, int layer) {
    FRAME();
    const int li = layer >> 1; const int TR = (layer == DEPTH - 1) ? TL : T;
    const bf16* Hb = (const bf16*)(ws + WS_H); unsigned char* HSQ = ws + WS_BIG + BIG_HSQ;
    int* tokE = (int*)(ws + WS_TOK); int* tokS0 = tokE + T; int* tokS1 = tokS0 + T; int* tokP0 = tokS1 + 2 * T; int* tokP1 = tokP0 + T;
    unsigned* ecnt = F.ctl + CW_CNT + li * 64;
    int roff[8]; { int acc = 0;
#pragma unroll
        for (int e = 0; e < 8; ++e) { roff[e] = acc * 256; acc += (__builtin_amdgcn_readfirstlane((int)__hip_atomic_load(ecnt + e, __ATOMIC_RELAXED, __HIP_MEMORY_SCOPE_AGENT)) + 255) >> 8; } }
    for (int r = F.gw; r < TR; r += F.NGW) {
        const int ee = tokE[r], e0 = ee & 255, e1 = ee >> 8;
        int p0 = tokS0[r], p1 = tokS1[r];
#pragma unroll
        for (int e = 0; e < 8; ++e) { p0 += (e == e0) ? roff[e] : 0; p1 += (e == e1) ? roff[e] : 0; }
        const v4u* src = (const v4u*)(Hb + (size_t)r * D) + 2 * F.lane;
        const v4u a = src[0], b = src[1];
        v4u q; q.x = pk_fp8x4(bflo(a.x) * Q_H, bfhi(a.x) * Q_H, bflo(a.y) * Q_H, bfhi(a.y) * Q_H); q.y = pk_fp8x4(bflo(a.z) * Q_H, bfhi(a.z) * Q_H, bflo(a.w) * Q_H, bfhi(a.w) * Q_H);
        q.z = pk_fp8x4(bflo(b.x) * Q_H, bfhi(b.x) * Q_H, bflo(b.y) * Q_H, bfhi(b.y) * Q_H); q.w = pk_fp8x4(bflo(b.z) * Q_H, bfhi(b.z) * Q_H, bflo(b.w) * Q_H, bfhi(b.w) * Q_H);
        *((v4u*)(HSQ + (size_t)p0 * D) + F.lane) = q; *((v4u*)(HSQ + (size_t)p1 * D) + F.lane) = q;
        if (F.lane == 0) { tokP0[r] = p0; tokP1[r] = p1; }
    }
}
PHASE_FN ph_moe_up(PP pp, int layer, int chn) {
    FRAME();
    const int li = layer >> 1; unsigned char* odw = ws + WS_OD + li * OD_STRIDE; unsigned* ecnt = F.ctl + CW_CNT + li * 64;
    SchedMoeUp S; S.G = F.G; S.c = F.bid; S.rt0 = chn * MOE_CHUNK_TILES; S.HS = (const char*)(ws + WS_BIG + BIG_HSQ); S.W = (const char*)(odw + OD_MW13); S.HID = (char*)(ws + WS_H);
    { int acc = 0; S.toff[0] = 0;
#pragma unroll
        for (int e = 0; e < 8; ++e) { acc += (__builtin_amdgcn_readfirstlane((int)__hip_atomic_load(ecnt + e, __ATOMIC_RELAXED, __HIP_MEMORY_SCOPE_AGENT)) + 255) >> 8; S.toff[e + 1] = acc; } }
    int nt_ = S.toff[8] - S.rt0; nt_ = nt_ < 0 ? 0 : (nt_ > MOE_CHUNK_TILES ? MOE_CHUNK_TILES : nt_); S.nUnits = nt_ * 28;
    pg8::gemm_phase<pg8::EpiSwiGLU8, SchedMoeUp, true, true, pg8::AMapStd, true>(F.lds, F.tid, pg8::Dims{D, D, D}, S, pg8::EpiSwiGLU8{});
}
PHASE_FN ph_moe_down(PP pp, int layer, int chn) {
    FRAME();
    const int li = layer >> 1; unsigned char* odw = ws + WS_OD + li * OD_STRIDE; unsigned* ecnt = F.ctl + CW_CNT + li * 64;
    SchedMoeDown S; S.G = F.G; S.c = F.bid; S.rt0 = chn * MOE_CHUNK_TILES; S.HID = (const char*)(ws + WS_H); S.W = (const char*)(odw + OD_MW2); S.Y = (char*)(ws + WS_BIG + BIG_Y);
    { int acc = 0; S.toff[0] = 0;
#pragma unroll
        for (int e = 0; e < 8; ++e) { acc += (__builtin_amdgcn_readfirstlane((int)__hip_atomic_load(ecnt + e, __ATOMIC_RELAXED, __HIP_MEMORY_SCOPE_AGENT)) + 255) >> 8; S.toff[e + 1] = acc; } }
    int nt_ = S.toff[8] - S.rt0; nt_ = nt_ < 0 ? 0 : (nt_ > MOE_CHUNK_TILES ? MOE_CHUNK_TILES : nt_); S.nUnits = nt_ * 4;
    pg8::gemm_phase<pg8::EpiStoreQ, SchedMoeDown, true, true, pg8::AMapStd, true>(F.lds, F.tid, pg8::Dims{EH, EH, EH}, S, pg8::EpiStoreQ{});
}
PHASE_FN ph_o9(PP pp, int layer) {
    FRAME();
    const int TR = (layer == DEPTH - 1) ? TL : T; const bool last = layer == DEPTH - 1;
    float* XC = (float*)(ws + WS_XC); float* out = (float*)pp->out; bf16* Hb = (bf16*)(ws + WS_H); const bf16* HS = (const bf16*)(ws + WS_BIG + BIG_Y);
    const float* modl = (const float*)(ws + WS_MOD) + (size_t)layer * 17 * 6144;
    const float* modn = (const float*)(ws + WS_MOD) + (size_t)(last ? layer : layer + 1) * 17 * 6144;
    const float* lng1 = PIN(I_LNG) + (size_t)(layer * 2 + 1) * D; const float* lnb1 = PIN(I_LNB) + (size_t)(layer * 2 + 1) * D;
    const int* tokE = (const int*)(ws + WS_TOK); const float* tokG0 = (const float*)(tokE + 3 * T); const int* tokP0 = tokE + 4 * T; const int* tokP1 = tokP0 + T;
    f32x4 gg9[4], bb9[4];
#pragma unroll
    for (int j = 0; j < 4; ++j) { gg9[j] = *(const f32x4*)(lng1 + 256 * j + 4 * F.lane); bb9[j] = *(const f32x4*)(lnb1 + 256 * j + 4 * F.lane); }
    for (int r = F.gw; r < TR; r += F.NGW) {
        const bool isc = r >= TL; float* xr = isc ? XC + (size_t)(r - TL) * D : out + (size_t)r * D;
        const int mrow = isc ? 16 : (r >> 12);
        const float* g2 = modl + (size_t)mrow * 6144 + 5120;
        const int p0 = tokP0[r], p1 = tokP1[r]; const float w0 = tokG0[r], w1 = 1.0f - w0;
        const bf16* y0 = HS + (size_t)p0 * D; const bf16* y1 = HS + (size_t)p1 * D;
        f32x4 v[4], h[4]; row_load(xr, F.lane, v);
#pragma unroll
        for (int j = 0; j < 4; ++j) { const v2u a = *(const v2u*)(y0 + 256 * j + 4 * F.lane), b = *(const v2u*)(y1 + 256 * j + 4 * F.lane); const f32x4 gg = *(const f32x4*)(g2 + 256 * j + 4 * F.lane);
            f32x4 f; f[0] = w0 * bflo(a.x) + w1 * bflo(b.x); f[1] = w0 * bfhi(a.x) + w1 * bfhi(b.x); f[2] = w0 * bflo(a.y) + w1 * bflo(b.y); f[3] = w0 * bfhi(a.y) + w1 * bfhi(b.y);
            v[j] = v[j] * ALPHA + gg * f; }
        row_ln_pre(v, gg9, bb9); row_store(xr, F.lane, v);
        if (!last) { const float* m = modn + (size_t)mrow * 6144; row_modulate(h, v, m + 1024, m, F.lane); row_store_bf16(Hb + (size_t)r * D, F.lane, h); }
    }
}

#if MK_SPLIT
#define PHASE_END() do { ++ph; } while (0)
#else
#define PHASE_END() do { if (ph >= lo && ph + 1 < hi) grid_bar(pp); ++ph; } while (0)
#endif
#define PHASE_ON() (ph >= lo && ph < hi)
static __device__ __forceinline__ void even_layer(PP pp, const int layer, const int lo, const int hi, int& ph) {
    if (PHASE_ON()) ph_e1(pp, layer);
    PHASE_END();
    if (PHASE_ON()) { ph_e2_fft(pp); ph_e2_rope(pp); }
    PHASE_END();
    if (PHASE_ON()) { ph_e2_dft(pp); ph_e3_attn(pp, layer); }
    PHASE_END();
    if (PHASE_ON()) ph_outproj(pp, layer);
    PHASE_END();
    if (PHASE_ON()) ph_e6(pp, layer);
    PHASE_END();
    if (PHASE_ON()) ph_e7(pp, layer);
    PHASE_END();
}
static __device__ __forceinline__ void odd_layer(PP pp, const int layer, const int lo, const int hi, int& ph) {
    if (PHASE_ON()) ph_o1(pp, layer);
    PHASE_END();
    if (PHASE_ON()) { ph_o2_s5a(pp, layer); ph_o2_gmlp(pp, layer); }
    PHASE_END();
    if (PHASE_ON()) ph_o2_scan(pp, layer);
    PHASE_END();
    if (PHASE_ON()) ph_o3(pp, layer);
    PHASE_END();
    if (PHASE_ON()) ph_o4(pp, layer);
    PHASE_END();
    if (PHASE_ON()) ph_outproj(pp, layer);
    PHASE_END();
    if (PHASE_ON()) ph_o6(pp, layer);
    PHASE_END();
    if (PHASE_ON()) ph_o7(pp, layer);
    PHASE_END();
#define MOE_CHUNK(chn) do { if (PHASE_ON()) ph_moe_up(pp, layer, chn); PHASE_END(); if (PHASE_ON()) ph_moe_down(pp, layer, chn); PHASE_END(); } while (0)
    static_assert(MOE_NCHUNK == 5, "the chunk sites are written out: no loop around GEMM phase sites");
    MOE_CHUNK(0); MOE_CHUNK(1); MOE_CHUNK(2); MOE_CHUNK(3); MOE_CHUNK(4);
#undef MOE_CHUNK
    if (PHASE_ON()) ph_o9(pp, layer);
    PHASE_END();
}
constexpr int N_PHASES = 2 + 2 * (6 + 9 + 2 * MOE_NCHUNK);
__global__ void __launch_bounds__(NTHREADS, 2) fwd_kernel(Params p_unused) {
    DECL_LDS;
    PP pp = (PP)__builtin_amdgcn_kernarg_segment_ptr();
    {
        LAS unsigned char* lds = (LAS unsigned char*)lds_raw;
        for (int u = threadIdx.x; u < (LDS_BYTES - LDS_RING) / 4; u += NTHREADS) ((LAS unsigned*)(lds + LDS_RING))[u] = 0u;
        __syncthreads();
#if !MK_SPLIT
        (void)xcd_barrier_post((unsigned*)((unsigned char*)pp->ws + WS_CTL) + CW_BAR, (volatile LAS unsigned*)(lds + LDS_MISC) + 8);
#endif
    }
#if MK_SPLIT
    const int lo = pp->ph_lo, hi = pp->ph_hi;
#else
    constexpr int lo = 0, hi = N_PHASES;
#endif
    int ph = 0;

    if (PHASE_ON()) { ph_fold(pp); ph_mod(pp); ph_s5mat(pp); ph_cvt(pp); ph_dftmat(pp); }
    PHASE_END();
    if (PHASE_ON()) ph_pro_b(pp);
    PHASE_END();
    even_layer(pp, 0, lo, hi, ph);
    odd_layer(pp, 1, lo, hi, ph);
    even_layer(pp, 2, lo, hi, ph);
    odd_layer(pp, 3, lo, hi, ph);
}

extern "C" void kernel_launch(void* const* d_in, const int* in_sizes, int n_in, void* d_out, int out_size, void* d_ws, size_t ws_size, hipStream_t stream) {
    static int grid = 0;
    if (grid == 0) {
        if (n_in != 32 || out_size != TL * D || ws_size < WS_END) { fprintf(stderr, "kernel_launch: unexpected shapes (n_in %d, out %d, ws %zu < %zu)\n", n_in, out_size, ws_size, (size_t)WS_END); grid = -1; return; }
        int dev = 0, cus = 0, per_cu = 0;
        if (hipGetDevice(&dev) != hipSuccess || hipDeviceGetAttribute(&cus, hipDeviceAttributeMultiprocessorCount, dev) != hipSuccess) { grid = -1; return; }
        if (hipFuncSetAttribute((const void*)fwd_kernel, hipFuncAttributeMaxDynamicSharedMemorySize, LDS_BYTES) != hipSuccess) { fprintf(stderr, "kernel_launch: hipFuncSetAttribute failed\n"); grid = -1; return; }
        if (hipOccupancyMaxActiveBlocksPerMultiprocessor(&per_cu, (const void*)fwd_kernel, NTHREADS, LDS_BYTES) != hipSuccess || per_cu < 1) { fprintf(stderr, "kernel_launch: occupancy query says %d\n", per_cu); }
        (void)hipGetLastError();
        grid = cus;
    }
    if (grid < 0) return;
    (void)in_sizes;
    (void)hipMemsetAsync((char*)d_ws + WS_CTL, 0, CTL_ZERO_BYTES, stream);
    Params p{};
    for (int i = 0; i < 32; ++i) p.in[i] = (const float*)d_in[i];
    p.out = (float*)d_out; p.ws = (unsigned char*)d_ws;
#if MK_SPLIT
    for (int ph = 0; ph < N_PHASES; ++ph) { p.ph_lo = ph; p.ph_hi = ph + 1; hipLaunchKernelGGL(fwd_kernel, dim3(grid), dim3(NTHREADS), LDS_BYTES, stream, p); }
#else
    p.ph_lo = 0; p.ph_hi = N_PHASES;
    hipLaunchKernelGGL(fwd_kernel, dim3(grid), dim3(NTHREADS), LDS_BYTES, stream, p);
#endif
}
```

```cpp
#include <hip/hip_runtime.h>
#include <cstdio>
#include <cstdint>

#ifndef MK_SPLIT
#define MK_SPLIT 0
#endif

#define GAS __attribute__((address_space(1)))
#define LAS __attribute__((address_space(3)))
typedef unsigned short bf16;
typedef unsigned v4u __attribute__((ext_vector_type(4)));
typedef unsigned v2u __attribute__((ext_vector_type(2)));
typedef float f32x4 __attribute__((ext_vector_type(4)));
typedef float f32x2 __attribute__((ext_vector_type(2)));
typedef short bf16x8 __attribute__((ext_vector_type(8)));

constexpr int D = 1024, NBATCH = 16, SEQ = 4096, NCTX = 256, DEPTH = 4;
constexpr int TL = NBATCH * SEQ, TC = NBATCH * NCTX, T = TL + TC;
constexpr int FFH = 2816, EH = 3584, NEXP = 8;
constexpr int MOE_CHUNK_TILES = 128, MOE_NCHUNK = 5;
constexpr float Q_H = 16.f, Q_W = 1024.f, Q_HID = 8.f;
constexpr float ALPHA = 1.6817928305074290860622509524664f;
constexpr float LN_EPS = 1e-5f;

constexpr size_t MiB = (size_t)1 << 20;
constexpr size_t WS_CTL = 0, CTL_ZERO_BYTES = 1 * MiB;
constexpr size_t WS_MOD = 1 * MiB;
constexpr size_t WS_TOK = 3 * MiB;
constexpr size_t WS_XC = 5 * MiB;
constexpr size_t WS_F256 = 21 * MiB;
constexpr size_t WS_FD = 22 * MiB;
constexpr size_t WS_EV = 86 * MiB, EV_STRIDE = 22 * MiB;
constexpr size_t EV_WQKV = 0, EV_WPQ = 3 * MiB / 2, EV_WOUT = 7 * MiB / 2, EV_W13 = 11 * MiB / 2, EV_W2 = 33 * MiB / 2;
constexpr size_t WS_OD = 130 * MiB, OD_STRIDE = 174 * MiB;
constexpr size_t OD_WIN = 0, OD_WGLU = 3 * MiB, OD_WOUT = 7 * MiB / 2, OD_MW13 = 11 * MiB / 2, OD_MW2 = 235 * MiB / 2;
constexpr size_t WS_H = 478 * MiB;
constexpr size_t WS_BIG = 614 * MiB;
constexpr size_t BIG_PQT = 0, BIG_PQTC = 128 * MiB, BIG_QKV = 136 * MiB, BIG_MIX = 238 * MiB, BIG_VT = 374 * MiB, BIG_HID = 0, BIG_P = 0, BIG_Y = 0, BIG_HSQ = 276 * MiB;
constexpr size_t WS_S5M = 1030 * MiB, S5M_STRIDE = 384 * 1024;
constexpr size_t WS_END = 1058 * MiB;
constexpr int CW_BAR = 4096, CW_CNT = 16384, CW_LN = 32768, LN_SITE_WORDS = 272 * 16;
constexpr size_t WS_XS = 1054 * MiB;

#define LDS_WAIT() asm volatile("s_waitcnt lgkmcnt(0)" ::: "memory")
#define VM_WAIT() asm volatile("s_waitcnt vmcnt(0)" ::: "memory")
__device__ __forceinline__ unsigned cvt_pk_bf16(float lo, float hi) { unsigned r; asm volatile("v_cvt_pk_bf16_f32 %0, %1, %2" : "=v"(r) : "v"(lo), "v"(hi)); return r; }
__device__ __forceinline__ float bflo(unsigned w) { return __uint_as_float(w << 16); }
__device__ __forceinline__ float bfhi(unsigned w) { return __uint_as_float(w & 0xffff0000u); }
__device__ __forceinline__ float bf2f(bf16 b) { return __uint_as_float(((unsigned)b) << 16); }
__device__ __forceinline__ bf16 f2bf(float f) { return (bf16)(cvt_pk_bf16(f, 0.f) & 0xffffu); }
__device__ __forceinline__ unsigned pk_fp8x4(float a, float b, float c, float d) {
    a = __builtin_amdgcn_fmed3f(a, -448.f, 448.f); b = __builtin_amdgcn_fmed3f(b, -448.f, 448.f); c = __builtin_amdgcn_fmed3f(c, -448.f, 448.f); d = __builtin_amdgcn_fmed3f(d, -448.f, 448.f);
    int w = 0; w = __builtin_amdgcn_cvt_pk_fp8_f32(a, b, w, false); w = __builtin_amdgcn_cvt_pk_fp8_f32(c, d, w, true); return (unsigned)w; }
__device__ __forceinline__ float wave_sum(float v) {
#pragma unroll
    for (int o = 1; o < 64; o <<= 1) v += __shfl_xor(v, o);
    return v;
}
__device__ __forceinline__ float wave_max(float v) {
#pragma unroll
    for (int o = 1; o < 64; o <<= 1) v = fmaxf(v, __shfl_xor(v, o));
    return v;
}
__device__ __forceinline__ float sigmoid_f(float x) { return __builtin_amdgcn_rcpf(1.f + __builtin_amdgcn_exp2f(-1.4426950408889634f * x)); }
__device__ __forceinline__ float silu_f(float x) { return x * sigmoid_f(x); }
__device__ __forceinline__ float gelu_tanh_f(float x) { const float z = x * (0.7978845608028654f + 0.035677408136300125f * x * x); return x * __builtin_amdgcn_rcpf(1.f + __builtin_amdgcn_exp2f(-2.8853900817779268f * z)); }

#define XB_TMO      128
#define XB_XCNT(j)  (256  + 64 * (j))
#define XB_XSUB(j)  (1280 + 64 * (j))
#define XB_XGEN(j)  (2304 + 64 * (j))
#define XB_TOP      3328
#define XB_TOPGEN   3392
#define XCD_BAR_WORDS 3456
#define XB_SPIN_CAP (1u << 25)
__device__ __forceinline__ unsigned xb_ld(unsigned* p)              { return __hip_atomic_load(p, __ATOMIC_RELAXED, __HIP_MEMORY_SCOPE_AGENT); }
__device__ __forceinline__ unsigned xb_add(unsigned* p, unsigned v) { return __hip_atomic_fetch_add(p, v, __ATOMIC_RELAXED, __HIP_MEMORY_SCOPE_AGENT); }
__device__ __forceinline__ unsigned xb_xcc_id() { return (unsigned)__builtin_amdgcn_s_getreg((3 << 11) | 20) & 0xFu; }
#define XB_SPIN(cond, bar) do { unsigned _sp = 0; while (cond) { __builtin_amdgcn_s_sleep(1); \
    if ((++_sp & 255u) == 0u) { if (xb_ld(&(bar)[XB_TMO])) break; if (_sp > XB_SPIN_CAP) { atomicAdd(&(bar)[XB_TMO], 1u); break; } } } } while (0)
struct XcdBarrier { unsigned* bar; unsigned x; volatile LAS unsigned* st; };
__device__ __forceinline__ XcdBarrier xcd_barrier_post(unsigned* bar, volatile LAS unsigned* st) {
    XcdBarrier b; b.bar = bar; b.x = xb_xcc_id(); b.st = st;
    if (threadIdx.x == 0) (void)xb_add(&bar[XB_XCNT(b.x)], 1u);
    return b;
}
__device__ __forceinline__ void xcd_barrier_complete(unsigned* bar, unsigned x, unsigned& nloc, unsigned& nx) {
    const unsigned G = gridDim.x * gridDim.y * gridDim.z;
    unsigned sum, cnt, mine, sp = 0u;
    for (;;) {
        sum = 0u; cnt = 0u; mine = 0u;
#pragma unroll
        for (unsigned j = 0; j < 16; ++j) { const unsigned c = xb_ld(&bar[XB_XCNT(j)]); sum += c; cnt += (c > 0u) ? 1u : 0u; mine = (j == x) ? c : mine; }
        if (sum == G) break;
        __builtin_amdgcn_s_sleep(1);
        if ((++sp & 255u) == 0u) { if (xb_ld(&bar[XB_TMO])) break; if (sp > XB_SPIN_CAP) { atomicAdd(&bar[XB_TMO], 1u); break; } }
    }
    nloc = mine > 0u ? mine : 1u; nx = cnt > 0u ? cnt : 1u;
}
__device__ __forceinline__ void xcd_barrier(const XcdBarrier& b) {
    asm volatile("s_waitcnt vmcnt(0)" ::: "memory");
    __syncthreads();
    if (threadIdx.x == 0) {
        unsigned* bar = b.bar;
        __builtin_amdgcn_s_waitcnt(0);
        unsigned nloc = b.st[0], nx = b.st[1];
        if (nloc == 0u) { xcd_barrier_complete(bar, b.x, nloc, nx); b.st[0] = nloc; b.st[1] = nx; }
        const unsigned old = xb_add(&bar[XB_XSUB(b.x)], 1u);
        const unsigned gen = old / nloc;
        if (old + 1u == (gen + 1u) * nloc) {
            __builtin_amdgcn_fence(__ATOMIC_RELEASE, "agent");
            asm volatile("s_waitcnt vmcnt(0)" ::: "memory");
            const unsigned og = xb_add(&bar[XB_TOP], 1u);
            const unsigned tg = og / nx;
            if (og + 1u == (tg + 1u) * nx) xb_add(&bar[XB_TOPGEN], 1u);
            else XB_SPIN(xb_ld(&bar[XB_TOPGEN]) == tg, bar);
            __builtin_amdgcn_fence(__ATOMIC_ACQUIRE, "agent");
            xb_add(&bar[XB_XGEN(b.x)], 1u);
            asm volatile("s_waitcnt vmcnt(0)" ::: "memory");
        } else {
            XB_SPIN(xb_ld(&bar[XB_XGEN(b.x)]) == gen, bar);
            __builtin_amdgcn_fence(__ATOMIC_ACQUIRE, "agent");
            asm volatile("s_waitcnt vmcnt(0)" ::: "memory");
        }
    }
    __syncthreads();
}

namespace pg8 {
constexpr int BM = 256, BK = 64, HALF = 128, HTB = HALF * BK * 2, STAGE_BYTES = 8 * HTB;
__host__ __device__ __forceinline__ int lds_byte(int r, int c) { const int st = (r >> 4) * 2 + (c >> 5), rr = r & 15, cc = c & 31, ob = rr * 64 + cc * 2; return st * 1024 + (ob ^ (((ob >> 9) & 1) << 5)); }
__host__ __device__ __forceinline__ void stage_rc(int b, int& R, int& C) { const int st = b / 1024, sb = b % 1024, swz = sb ^ (((sb >> 9) & 1) << 5); R = (st >> 1) * 16 + swz / 64; C = (st & 1) * 32 + (swz % 64) / 2; }
__host__ __device__ __forceinline__ int perm32(int rho) { const int n = rho >> 4, i = rho & 15; return 8 * (i >> 2) + 4 * n + (i & 3); }

struct Unit { const char* a; const char* b; char* o; const char* p0; const char* p1; int ldo; int x0; };
struct Dims { int K, lda, ldb; };
typedef int v4i __attribute__((ext_vector_type(4)));
typedef int v8i __attribute__((ext_vector_type(8)));
struct AMapStd { int ldab = 0;   __device__ __forceinline__ unsigned voff(int R, int C) const { return (unsigned)(R * ldab + C * 2); } __device__ __forceinline__ size_t kstep() const { return 128; } __device__ __forceinline__ size_t hs() const { return (size_t)HALF * ldab; } };
struct AMapS5 { __device__ __forceinline__ unsigned voff(int R, int C) const { return (unsigned)(R * 49152 + (C >> 4) * 3072 + (C & 15) * 2); } __device__ __forceinline__ size_t kstep() const { return 12288; } __device__ __forceinline__ size_t hs() const { return (size_t)HALF * 49152; } };

__device__ __forceinline__ const char* uni_ptr(const char* p) {
    const unsigned long long v = (unsigned long long)p; const unsigned lo = __builtin_amdgcn_readfirstlane((unsigned)v), hi = __builtin_amdgcn_readfirstlane((unsigned)(v >> 32));
    return (const char*)(((unsigned long long)hi << 32) | lo); }
template <class Epi, class Sched, bool ALIGN_EPI = false, bool SP2 = false, class AMap = AMapStd, bool FP8 = false>
__device__ __forceinline__ void gemm_phase(LAS unsigned char* lds, const int tid, const Dims g, const Sched& S, const Epi& E, const AMap am_in = AMap{}) {
    constexpr int ES = FP8 ? 1 : 2;
    AMap am = am_in; if constexpr (__is_same(AMap, AMapStd)) am.ldab = g.lda * ES;
    const int wid = __builtin_amdgcn_readfirstlane(tid >> 6), lane = tid & 63, wr = wid >> 2, wc = wid & 3, fr = lane & 15, fq = lane >> 4;
    const int K = g.K, nt = (K * (FP8 ? 1 : 2)) / 128;
    unsigned voffA, voffB;
    { int R, C; stage_rc(tid * 16, R, C); const int Rb = Epi::PERM ? ((R & ~31) + perm32(R & 31)) : R;
        voffA = am.voff(R, C); voffB = (unsigned)(Rb * g.ldb * ES + C * 2); }
    const size_t d64voffA = am.voff(64, 0), d64voffB = (size_t)64 * g.ldb * ES;
    const size_t kstep = (size_t)(BK * 2), kstepA = am.kstep();
    const size_t hsA = am.hs(), hsB = (size_t)HALF * g.ldb * ES;
    const unsigned ldsw = (unsigned)wid * 1024u;
    const int aoff = lds_byte(wr * 64 + fr, fq * 8), boff = lds_byte(wc * 32 + fr, fq * 8);
#define PG8_SA(b, h) (((b) * 2 + (h)) * HTB)
#define PG8_SB(b, h) ((4 + (b) * 2 + (h)) * HTB)
#define PG8_STAGE(bufoff, gbase, voff) do { unsigned _vo = (voff); asm volatile("" : "+v"(_vo));   \
        __builtin_amdgcn_global_load_lds((const unsigned*)((const char*)(gbase) + _vo), (LAS unsigned*)(lds + (bufoff) + ldsw), 16, 0, 0); \
        __builtin_amdgcn_global_load_lds((const unsigned*)((const char*)(gbase) + d64##voff + _vo), (LAS unsigned*)(lds + (bufoff) + ldsw + 8192), 16, 0, 0); } while (0)
#define PG8_LD8(p) __builtin_shufflevector(*(const LAS v4i*)(p), *(const LAS v4i*)((p) + 1024), 0, 1, 2, 3, 4, 5, 6, 7)
#define PG8_LDA(dst, b, h) do { if constexpr (FP8) { _Pragma("unroll") for (int m = 0; m < 4; ++m) dst##8[m] = PG8_LD8(lds + PG8_SA(b, h) + aoff + m * 2048); } \
        else { _Pragma("unroll") for (int m = 0; m < 4; ++m) _Pragma("unroll") for (int k = 0; k < 2; ++k) dst[m][k] = *(const LAS bf16x8*)(lds + PG8_SA(b, h) + aoff + m * 2048 + k * 1024); } } while (0)
#define PG8_LDB(dst, b, h) do { if constexpr (FP8) { _Pragma("unroll") for (int n = 0; n < 2; ++n) dst##8[n] = PG8_LD8(lds + PG8_SB(b, h) + boff + n * 2048); } \
        else { _Pragma("unroll") for (int n = 0; n < 2; ++n) _Pragma("unroll") for (int k = 0; k < 2; ++k) dst[n][k] = *(const LAS bf16x8*)(lds + PG8_SB(b, h) + boff + n * 2048 + k * 1024); } } while (0)
#define PG8_MMA(ai, bj, At, Bt) do { __builtin_amdgcn_s_setprio(1); \
        if constexpr (FP8) { _Pragma("unroll") for (int m = 0; m < 4; ++m) _Pragma("unroll") for (int n = 0; n < 2; ++n) \
            acc[ai][bj][m][n] = __builtin_amdgcn_mfma_scale_f32_16x16x128_f8f6f4(Bt##8[n], At##8[m], acc[ai][bj][m][n], 0, 0, 0, 0, 0, 0); } \
        else { _Pragma("unroll") for (int m = 0; m < 4; ++m) _Pragma("unroll") for (int n = 0; n < 2; ++n) _Pragma("unroll") for (int k = 0; k < 2; ++k) \
            acc[ai][bj][m][n] = __builtin_amdgcn_mfma_f32_16x16x32_bf16(Bt[n][k], At[m][k], acc[ai][bj][m][n], 0, 0, 0); } \
        __builtin_amdgcn_s_setprio(0); } while (0)
#define PG8_WAIT_V(n) asm volatile("s_waitcnt vmcnt(" #n ")" ::: "memory")
#define PG8_WAIT_L(n) asm volatile("s_waitcnt lgkmcnt(" #n ")" ::: "memory")
#define PG8_BAR __builtin_amdgcn_s_barrier()
#define PG8_SCHED __builtin_amdgcn_sched_barrier(0)
    int ui = 0;
    const char* cA; const char* cB;
    { Unit u0; if (!S.next(0, u0)) return; cA = uni_ptr(u0.a); cB = uni_ptr(u0.b); }
    f32x4 acc[2][2][4][2];
#pragma unroll
    for (int a = 0; a < 2; ++a)
#pragma unroll
        for (int b = 0; b < 2; ++b)
#pragma unroll
            for (int m = 0; m < 4; ++m)
#pragma unroll
                for (int n = 0; n < 2; ++n) acc[a][b][m][n] = (f32x4){0.f, 0.f, 0.f, 0.f};
    bf16x8 At[4][2], B0[2][2], B1[2][2];
    v8i At8[4], B08[2], B18[2];
    if constexpr (SP2) {
        PG8_STAGE(PG8_SB(0, 0), cB, voffB); PG8_STAGE(PG8_SB(0, 1), cB + hsB, voffB); PG8_STAGE(PG8_SA(0, 0), cA, voffA); PG8_STAGE(PG8_SA(0, 1), cA + hsA, voffA);
        if (wr == 1) PG8_BAR;
        PG8_WAIT_V(2); PG8_BAR;
        PG8_STAGE(PG8_SB(1, 0), cB + kstep, voffB); PG8_STAGE(PG8_SA(1, 0), cA + kstepA, voffA); PG8_STAGE(PG8_SB(1, 1), cB + hsB + kstep, voffB);
        PG8_WAIT_V(6); PG8_BAR;
    } else {
        PG8_STAGE(PG8_SB(0, 0), cB, voffB); PG8_STAGE(PG8_SA(0, 0), cA, voffA); PG8_STAGE(PG8_SB(0, 1), cB + hsB, voffB); PG8_STAGE(PG8_SA(0, 1), cA + hsA, voffA);
        if (wr == 1) PG8_BAR;
        PG8_WAIT_V(4); PG8_BAR;
        PG8_STAGE(PG8_SB(1, 0), cB + kstep, voffB); PG8_STAGE(PG8_SA(1, 0), cA + kstepA, voffA); PG8_STAGE(PG8_SB(1, 1), cB + hsB + kstep, voffB);
        PG8_WAIT_V(6); PG8_BAR;
    }
    for (;;) {
        const char* nA = cA; const char* nB = cB; bool has_next;
        { Unit un; has_next = S.next(ui + 1, un); if (has_next) { nA = uni_ptr(un.a); nB = uni_ptr(un.b); } }
#pragma unroll 1
        for (int t = 0; t < nt; t += 2) {
            const bool last = (t == nt - 2);
            const char* a1 = cA + (size_t)(t + 1) * kstepA;
            const char* a2 = last ? nA : cA + (size_t)(t + 2) * kstepA; const char* b2 = last ? nB : cB + (size_t)(t + 2) * kstep;
            const char* a3 = a2 + kstepA; const char* b3 = b2 + kstep;
            if constexpr (SP2) {
            PG8_LDB(B0, 0, 0); PG8_LDB(B1, 0, 1); PG8_SCHED; PG8_LDA(At, 0, 0); PG8_STAGE(PG8_SA(1, 1), a1 + hsA, voffA);
            PG8_WAIT_V(8); PG8_WAIT_L(0); PG8_BAR; PG8_MMA(0, 0, At, B0); PG8_MMA(0, 1, At, B1); PG8_BAR; PG8_SCHED;
            PG8_LDA(At, 0, 1); PG8_STAGE(PG8_SB(0, 0), b2, voffB); PG8_STAGE(PG8_SB(0, 1), b2 + hsB, voffB); PG8_STAGE(PG8_SA(0, 0), a2, voffA);
            PG8_WAIT_V(8); PG8_WAIT_L(0); PG8_BAR; PG8_MMA(1, 0, At, B0); PG8_MMA(1, 1, At, B1); PG8_BAR; PG8_SCHED;
            PG8_LDB(B0, 1, 0); PG8_LDB(B1, 1, 1); PG8_SCHED; PG8_LDA(At, 1, 0); PG8_STAGE(PG8_SA(0, 1), a2 + hsA, voffA);
            PG8_WAIT_V(8); PG8_WAIT_L(0); PG8_BAR; PG8_MMA(0, 0, At, B0); PG8_MMA(0, 1, At, B1); PG8_BAR; PG8_SCHED;
            PG8_LDA(At, 1, 1); PG8_STAGE(PG8_SB(1, 0), b3, voffB); PG8_STAGE(PG8_SB(1, 1), b3 + hsB, voffB); PG8_STAGE(PG8_SA(1, 0), a3, voffA);
            PG8_WAIT_V(8); PG8_WAIT_L(0); PG8_BAR; PG8_MMA(1, 0, At, B0); PG8_MMA(1, 1, At, B1); PG8_BAR; PG8_SCHED;
            } else {
            PG8_LDB(B0, 0, 0); PG8_SCHED; PG8_LDA(At, 0, 0); PG8_STAGE(PG8_SA(1, 1), a1 + hsA, voffA);
            PG8_WAIT_L(8); PG8_BAR; PG8_WAIT_L(0); PG8_MMA(0, 0, At, B0); PG8_BAR; PG8_SCHED;
            PG8_LDB(B1, 0, 1); PG8_STAGE(PG8_SB(0, 0), b2, voffB);
            PG8_BAR; PG8_WAIT_L(0); PG8_MMA(0, 1, At, B1); PG8_BAR;
            PG8_LDA(At, 0, 1); PG8_STAGE(PG8_SA(0, 0), a2, voffA);
            PG8_BAR; PG8_WAIT_L(0); PG8_MMA(1, 0, At, B0); PG8_BAR; PG8_SCHED;
            PG8_STAGE(PG8_SB(0, 1), b2 + hsB, voffB);
            PG8_WAIT_V(6); PG8_BAR; PG8_MMA(1, 1, At, B1); PG8_BAR;
            PG8_LDB(B0, 1, 0); PG8_SCHED; PG8_LDA(At, 1, 0); PG8_STAGE(PG8_SA(0, 1), a2 + hsA, voffA);
            PG8_WAIT_L(8); PG8_BAR; PG8_WAIT_L(0); PG8_MMA(0, 0, At, B0); PG8_BAR; PG8_SCHED;
            PG8_LDB(B1, 1, 1); PG8_STAGE(PG8_SB(1, 0), b3, voffB);
            PG8_BAR; PG8_WAIT_L(0); PG8_MMA(0, 1, At, B1); PG8_BAR;
            PG8_LDA(At, 1, 1); PG8_STAGE(PG8_SA(1, 0), a3, voffA);
            PG8_BAR; PG8_WAIT_L(0); PG8_MMA(1, 0, At, B0); PG8_BAR; PG8_SCHED;
            PG8_STAGE(PG8_SB(1, 1), b3 + hsB, voffB);
            PG8_WAIT_V(6); PG8_BAR; PG8_MMA(1, 1, At, B1); PG8_BAR;
            }
        }
        if constexpr (ALIGN_EPI) { if (wr == 0) PG8_BAR; }
        { Unit uc; (void)S.next(ui, uc); E(acc, uc, wid); }
        if (!has_next) break;
#pragma unroll
        for (int a = 0; a < 2; ++a)
#pragma unroll
            for (int b = 0; b < 2; ++b)
#pragma unroll
                for (int m = 0; m < 4; ++m)
#pragma unroll
                    for (int n = 0; n < 2; ++n) acc[a][b][m][n] = (f32x4){0.f, 0.f, 0.f, 0.f};
        cA = nA; cB = nB; ++ui;
        if constexpr (ALIGN_EPI) { if (wr == 1) PG8_BAR; }
    }
    PG8_WAIT_V(0);
    if constexpr (!ALIGN_EPI) { if (wr == 0) PG8_BAR; }
    PG8_BAR;
#undef PG8_SA
#undef PG8_SB
#undef PG8_STAGE
#undef PG8_LDA
#undef PG8_LDB
#undef PG8_MMA
#undef PG8_LD8
#undef PG8_WAIT_V
#undef PG8_WAIT_L
#undef PG8_BAR
#undef PG8_SCHED
}

struct EpiStore {
    static constexpr bool PERM = true;
    __device__ __forceinline__ void operator()(const f32x4 (&acc)[2][2][4][2], const Unit& u, const int wid) const {
        int lane_; asm volatile("v_mbcnt_lo_u32_b32 %0, -1, 0\n\tv_mbcnt_hi_u32_b32 %0, -1, %0" : "=v"(lane_));
        const int wr = wid >> 2, wc = wid & 3, fr = lane_ & 15, fq = lane_ >> 4;
        bf16* base = (bf16*)u.o; int row0 = wr * 64 + fr, col0 = wc * 32 + 8 * fq; asm volatile("" : "+v"(row0), "+v"(col0)); const bool act = u.x0 != 0;
#pragma unroll
        for (int ai = 0; ai < 2; ++ai)
#pragma unroll
            for (int m = 0; m < 4; ++m) { bf16* rowp = base + (size_t)(row0 + ai * HALF + m * 16) * u.ldo + col0;
#pragma unroll
                for (int bj = 0; bj < 2; ++bj) { f32x4 v0 = acc[ai][bj][m][0], v1 = acc[ai][bj][m][1];
                    if (act) {
#pragma unroll
                        for (int j = 0; j < 4; ++j) { v0[j] = gelu_tanh_f(v0[j]); v1[j] = gelu_tanh_f(v1[j]); } }
                    v4u w; w.x = cvt_pk_bf16(v0[0], v0[1]); w.y = cvt_pk_bf16(v0[2], v0[3]); w.z = cvt_pk_bf16(v1[0], v1[1]); w.w = cvt_pk_bf16(v1[2], v1[3]);
                    *(v4u*)(rowp + bj * HALF) = w; } }
    }
};
struct EpiSwiGLU {
    static constexpr bool PERM = true;
    __device__ __forceinline__ void operator()(const f32x4 (&acc)[2][2][4][2], const Unit& u, const int wid) const {
        int lane_; asm volatile("v_mbcnt_lo_u32_b32 %0, -1, 0\n\tv_mbcnt_hi_u32_b32 %0, -1, %0" : "=v"(lane_));
        const int wr = wid >> 2, wc = wid & 3, fr = lane_ & 15, fq = lane_ >> 4;
        bf16* base = (bf16*)u.o; int row0 = wr * 64 + fr, col0 = wc * 32 + 8 * fq; asm volatile("" : "+v"(row0), "+v"(col0));
#pragma unroll
        for (int ai = 0; ai < 2; ++ai)
#pragma unroll
            for (int m = 0; m < 4; ++m) { bf16* rowp = base + (size_t)(row0 + ai * HALF + m * 16) * u.ldo + col0;
                f32x4 h0, h1;
#pragma unroll
                for (int j = 0; j < 4; ++j) { h0[j] = silu_f(acc[ai][0][m][0][j]) * acc[ai][1][m][0][j]; h1[j] = silu_f(acc[ai][0][m][1][j]) * acc[ai][1][m][1][j]; }
                v4u w; w.x = cvt_pk_bf16(h0[0], h0[1]); w.y = cvt_pk_bf16(h0[2], h0[3]); w.z = cvt_pk_bf16(h1[0], h1[1]); w.w = cvt_pk_bf16(h1[2], h1[3]);
                *(v4u*)rowp = w; }
    }
};
struct EpiSwiGLU8 {
    static constexpr bool PERM = true;
    __device__ __forceinline__ void operator()(const f32x4 (&acc)[2][2][4][2], const Unit& u, const int wid) const {
        int lane_; asm volatile("v_mbcnt_lo_u32_b32 %0, -1, 0\n\tv_mbcnt_hi_u32_b32 %0, -1, %0" : "=v"(lane_));
        const int wr = wid >> 2, wc = wid & 3, fr = lane_ & 15, fq = lane_ >> 4;
        unsigned char* base = (unsigned char*)u.o; int row0 = wr * 64 + fr, col0 = wc * 32 + 8 * fq; asm volatile("" : "+v"(row0), "+v"(col0));
        constexpr float SA = 1.0f / (Q_H * Q_W);
#pragma unroll
        for (int ai = 0; ai < 2; ++ai)
#pragma unroll
            for (int m = 0; m < 4; ++m) { unsigned char* rowp = base + (size_t)(row0 + ai * HALF + m * 16) * u.ldo + col0;
                float h0[4], h1[4];
#pragma unroll
                for (int j = 0; j < 4; ++j) { h0[j] = silu_f(acc[ai][0][m][0][j] * SA) * (acc[ai][1][m][0][j] * (SA * Q_HID)); h1[j] = silu_f(acc[ai][0][m][1][j] * SA) * (acc[ai][1][m][1][j] * (SA * Q_HID)); }
                v2u w; w.x = pk_fp8x4(h0[0], h0[1], h0[2], h0[3]); w.y = pk_fp8x4(h1[0], h1[1], h1[2], h1[3]);
                *(v2u*)rowp = w; }
    }
};
struct EpiStoreQ {
    static constexpr bool PERM = true;
    __device__ __forceinline__ void operator()(const f32x4 (&acc)[2][2][4][2], const Unit& u, const int wid) const {
        int lane_; asm volatile("v_mbcnt_lo_u32_b32 %0, -1, 0\n\tv_mbcnt_hi_u32_b32 %0, -1, %0" : "=v"(lane_));
        const int wr = wid >> 2, wc = wid & 3, fr = lane_ & 15, fq = lane_ >> 4;
        bf16* base = (bf16*)u.o; int row0 = wr * 64 + fr, col0 = wc * 32 + 8 * fq; asm volatile("" : "+v"(row0), "+v"(col0));
        constexpr float SA = 1.0f / (Q_HID * Q_W);
#pragma unroll
        for (int ai = 0; ai < 2; ++ai)
#pragma unroll
            for (int m = 0; m < 4; ++m) { bf16* rowp = base + (size_t)(row0 + ai * HALF + m * 16) * u.ldo + col0;
#pragma unroll
                for (int bj = 0; bj < 2; ++bj) { const f32x4 v0 = acc[ai][bj][m][0] * SA, v1 = acc[ai][bj][m][1] * SA;
                    v4u w; w.x = cvt_pk_bf16(v0[0], v0[1]); w.y = cvt_pk_bf16(v0[2], v0[3]); w.z = cvt_pk_bf16(v1[0], v1[1]); w.w = cvt_pk_bf16(v1[2], v1[3]);
                    *(v4u*)(rowp + bj * HALF) = w; } }
    }
};
struct EpiResid {
    static constexpr bool PERM = false;
    __device__ __forceinline__ void operator()(const f32x4 (&acc)[2][2][4][2], const Unit& u, const int wid) const {
        int lane_; asm volatile("v_mbcnt_lo_u32_b32 %0, -1, 0\n\tv_mbcnt_hi_u32_b32 %0, -1, %0" : "=v"(lane_));
        const int wr = wid >> 2, wc = wid & 3, fr = lane_ & 15, fq = lane_ >> 4;
        const float* xs = (const float*)u.p0; float* zo = (float*)u.o; const float* gv = (const float*)u.p1;
        int row0 = wr * 64 + fr, col0 = wc * 32 + 4 * fq; asm volatile("" : "+v"(row0), "+v"(col0));
#pragma unroll
        for (int ai = 0; ai < 2; ++ai)
#pragma unroll
            for (int m = 0; m < 4; ++m) { const size_t off = (size_t)(row0 + ai * HALF + m * 16) * D + col0;
#pragma unroll
                for (int bj = 0; bj < 2; ++bj)
#pragma unroll
                    for (int n = 0; n < 2; ++n) { const f32x4 xv = *(const f32x4*)(xs + off + bj * HALF + n * 16); const f32x4 gvv = *(const f32x4*)(gv + col0 + bj * HALF + n * 16);
                        *(f32x4*)(zo + off + bj * HALF + n * 16) = xv * ALPHA + gvv * acc[ai][bj][m][n]; }
                asm volatile("" ::: "memory"); }
    }
};
struct EpiResidLN {
    static constexpr bool PERM = false;
    const float* lng; const float* lnb; int sc_delta, sh_delta; bf16* H; unsigned* cnt; unsigned long long* xs; unsigned* tmo; LAS unsigned char* tab;
    __device__ __forceinline__ void operator()(f32x4 (&acc)[2][2][4][2], const Unit& u, const int wid) const {
        int lane_; asm volatile("v_mbcnt_lo_u32_b32 %0, -1, 0\n\tv_mbcnt_hi_u32_b32 %0, -1, %0" : "=v"(lane_));
        const int wr = wid >> 2, wc = wid & 3, fr = lane_ & 15, fq = lane_ >> 4, pm = u.x0 >> 2, pn = u.x0 & 3;
        const float* xsrc = (const float*)u.p0; float* xo = (float*)u.o; const float* gv = (const float*)u.p1;
        int row0 = wr * 64 + fr, col0 = wc * 32 + 4 * fq; asm volatile("" : "+v"(row0), "+v"(col0));
        LAS f32x2* Pt = (LAS f32x2*)tab; LAS f32x2* St = (LAS f32x2*)(tab + 8192);
        f32x4 gg[2][2];
#pragma unroll
        for (int bj = 0; bj < 2; ++bj)
#pragma unroll
            for (int n = 0; n < 2; ++n) gg[bj][n] = *(const f32x4*)(gv + col0 + bj * HALF + n * 16);
#pragma unroll
        for (int ai = 0; ai < 2; ++ai)
#pragma unroll
            for (int mh = 0; mh < 2; ++mh) {
                f32x4 xv[2][2][2];
#pragma unroll
                for (int ml = 0; ml < 2; ++ml)
#pragma unroll
                    for (int bj = 0; bj < 2; ++bj)
#pragma unroll
                        for (int n = 0; n < 2; ++n) xv[ml][bj][n] = *(const f32x4*)(xsrc + (size_t)(row0 + ai * HALF + (2 * mh + ml) * 16) * D + col0 + bj * HALF + n * 16);
#pragma unroll
                for (int ml = 0; ml < 2; ++ml) { const int m = 2 * mh + ml; float sm = 0.f, sq = 0.f;
#pragma unroll
                    for (int bj = 0; bj < 2; ++bj)
#pragma unroll
                        for (int n = 0; n < 2; ++n) { const f32x4 z = xv[ml][bj][n] * ALPHA + gg[bj][n] * acc[ai][bj][m][n]; acc[ai][bj][m][n] = z;
                            sm += (z[0] + z[1]) + (z[2] + z[3]); sq += (z[0] * z[0] + z[1] * z[1]) + (z[2] * z[2] + z[3] * z[3]); }
                    sm += __shfl_xor(sm, 16); sm += __shfl_xor(sm, 32); sq += __shfl_xor(sq, 16); sq += __shfl_xor(sq, 32);
                    if (fq == 0) Pt[(ai * HALF + wr * 64 + m * 16 + fr) * 4 + wc] = (f32x2){sm, sq}; }
                asm volatile("" ::: "memory"); }
        asm volatile("s_waitcnt lgkmcnt(0)" ::: "memory"); __builtin_amdgcn_s_barrier(); asm volatile("" ::: "memory");
        const int trow = wid * 64 + lane_;
        if (wid < 4) {
            const f32x2 a = Pt[trow * 4 + 0], b = Pt[trow * 4 + 1], c = Pt[trow * 4 + 2], d = Pt[trow * 4 + 3];
            const float ts = (a.x + b.x) + (c.x + d.x), tq = (a.y + b.y) + (c.y + d.y);
            __hip_atomic_store(xs + ((size_t)pm * 256 + trow) * 4 + pn, ((unsigned long long)__float_as_uint(tq) << 32) | __float_as_uint(ts), __ATOMIC_RELAXED, __HIP_MEMORY_SCOPE_AGENT);
            asm volatile("s_waitcnt vmcnt(0)" ::: "memory");
            if (lane_ == 0) __hip_atomic_fetch_add(cnt + pm * 16, 1u, __ATOMIC_RELAXED, __HIP_MEMORY_SCOPE_AGENT);
        }
        if (wid == 0) {
            unsigned sp = 0;
            while ((unsigned)__builtin_amdgcn_readfirstlane(__hip_atomic_load(cnt + pm * 16, __ATOMIC_RELAXED, __HIP_MEMORY_SCOPE_AGENT)) < 16u) {
                __builtin_amdgcn_s_sleep(1);
                if ((++sp & 1023u) == 0u && (sp > (1u << 24) || __hip_atomic_load(tmo, __ATOMIC_RELAXED, __HIP_MEMORY_SCOPE_AGENT) != 0u)) { if (lane_ == 0) __hip_atomic_store(tmo, 1u, __ATOMIC_RELAXED, __HIP_MEMORY_SCOPE_AGENT); break; } }
            __builtin_amdgcn_fence(__ATOMIC_ACQUIRE, "agent");
        }
        asm volatile("s_waitcnt vmcnt(0) lgkmcnt(0)" ::: "memory"); __builtin_amdgcn_s_barrier(); asm volatile("" ::: "memory");
        if (wid < 4) {
            const unsigned long long* sl = xs + ((size_t)pm * 256 + trow) * 4; float ts = 0.f, tq = 0.f;
#pragma unroll
            for (int t = 0; t < 4; ++t) { const unsigned long long w = __hip_atomic_load(sl + t, __ATOMIC_RELAXED, __HIP_MEMORY_SCOPE_AGENT); ts += __uint_as_float((unsigned)w); tq += __uint_as_float((unsigned)(w >> 32)); }
            const float mean = ts * (1.f / D), var = fmaxf(tq * (1.f / D) - mean * mean, 0.f);
            St[trow] = (f32x2){mean, rsqrtf(var + LN_EPS)};
        }
        asm volatile("s_waitcnt vmcnt(0) lgkmcnt(0)" ::: "memory"); __builtin_amdgcn_s_barrier(); asm volatile("" ::: "memory");
        const float* lg = lng + pn * 256; const float* lb = lnb + pn * 256; const float* scv = gv + sc_delta; const float* shv = gv + sh_delta;
        bf16* hb = H + ((size_t)pm * 256) * D + pn * 256;
        f32x4 g4[2][2], b4[2][2], s4[2][2], t4[2][2];
#pragma unroll
        for (int bj = 0; bj < 2; ++bj)
#pragma unroll
            for (int n = 0; n < 2; ++n) { const int c = col0 + bj * HALF + n * 16; g4[bj][n] = *(const f32x4*)(lg + c); b4[bj][n] = *(const f32x4*)(lb + c); s4[bj][n] = *(const f32x4*)(scv + c) + 1.0f; t4[bj][n] = *(const f32x4*)(shv + c); }
#pragma unroll
        for (int ai = 0; ai < 2; ++ai)
#pragma unroll
            for (int m = 0; m < 4; ++m) { const int r = row0 + ai * HALF + m * 16; const f32x2 ms = St[r]; const size_t off = (size_t)r * D + col0;
#pragma unroll
                for (int bj = 0; bj < 2; ++bj)
#pragma unroll
                    for (int n = 0; n < 2; ++n) {
                        const f32x4 xn = (acc[ai][bj][m][n] - ms.x) * ms.y * g4[bj][n] + b4[bj][n];
                        *(f32x4*)(xo + off + bj * HALF + n * 16) = xn;
                        const f32x4 hv = xn * s4[bj][n] + t4[bj][n];
                        v2u w; w.x = cvt_pk_bf16(hv[0], hv[1]); w.y = cvt_pk_bf16(hv[2], hv[3]); *(v2u*)(hb + off + bj * HALF + n * 16) = w; } }
    }
};
struct EpiGLU {
    static constexpr bool PERM = true;
    __device__ __forceinline__ void operator()(const f32x4 (&acc)[2][2][4][2], const Unit& u, const int wid) const {
        int lane_; asm volatile("v_mbcnt_lo_u32_b32 %0, -1, 0\n\tv_mbcnt_hi_u32_b32 %0, -1, %0" : "=v"(lane_));
        const int wr = wid >> 2, wc = wid & 3, fr = lane_ & 15, fq = lane_ >> 4;
        bf16* base = (bf16*)u.o; const bf16* gp = (const bf16*)u.p0; const float* bias = (const float*)u.p1;
        int row0 = wr * 64 + fr, col0 = wc * 32 + 8 * fq; asm volatile("" : "+v"(row0), "+v"(col0));
#pragma unroll
        for (int ai = 0; ai < 2; ++ai)
#pragma unroll
            for (int m = 0; m < 4; ++m) { const int r = row0 + ai * HALF + m * 16;
#pragma unroll
                for (int bj = 0; bj < 2; ++bj) { const v4u gw = *(const v4u*)(gp + (size_t)r * u.x0 + col0 + bj * HALF);
                    const f32x4 b0 = *(const f32x4*)(bias + col0 + bj * HALF), b1 = *(const f32x4*)(bias + col0 + bj * HALF + 4);
                    const f32x4 a0 = acc[ai][bj][m][0] + b0, a1 = acc[ai][bj][m][1] + b1;
                    const float o0 = bflo(gw.x) * sigmoid_f(a0[0]), o1 = bfhi(gw.x) * sigmoid_f(a0[1]), o2 = bflo(gw.y) * sigmoid_f(a0[2]), o3 = bfhi(gw.y) * sigmoid_f(a0[3]);
                    const float o4 = bflo(gw.z) * sigmoid_f(a1[0]), o5 = bfhi(gw.z) * sigmoid_f(a1[1]), o6 = bflo(gw.w) * sigmoid_f(a1[2]), o7 = bfhi(gw.w) * sigmoid_f(a1[3]);
                    v4u w; w.x = cvt_pk_bf16(o0, o1); w.y = cvt_pk_bf16(o2, o3); w.z = cvt_pk_bf16(o4, o5); w.w = cvt_pk_bf16(o6, o7);
                    *(v4u*)(base + (size_t)r * u.ldo + col0 + bj * HALF) = w; }
                asm volatile("" ::: "memory"); }
    }
};
struct EpiS5B {
    static constexpr bool PERM = true;
    __device__ __forceinline__ void operator()(const f32x4 (&acc)[2][2][4][2], const Unit& u, const int wid) const {
        int lane_; asm volatile("v_mbcnt_lo_u32_b32 %0, -1, 0\n\tv_mbcnt_hi_u32_b32 %0, -1, %0" : "=v"(lane_));
        const int wr = wid >> 2, wc = wid & 3, fr = lane_ & 15, fq = lane_ >> 4;
        bf16* base = (bf16*)u.o; const bf16* y1 = (const bf16*)u.p0;
        int row0 = wr * 64 + fr, col0 = wc * 32 + 8 * fq; asm volatile("" : "+v"(row0), "+v"(col0));
#pragma unroll
        for (int ai = 0; ai < 2; ++ai)
#pragma unroll
            for (int m = 0; m < 4; ++m) { const int r = row0 + ai * HALF + m * 16;
#pragma unroll
                for (int bj = 0; bj < 2; ++bj) { const int c = col0 + bj * HALF; const v4u yw = *(const v4u*)(y1 + (size_t)r * 8192 + c);
                    const f32x4 a0 = acc[ai][bj][m][0], a1 = acc[ai][bj][m][1];
                    const float o0 = gelu_tanh_f(a0[0] + bflo(yw.x)), o1 = gelu_tanh_f(a0[1] + bfhi(yw.x)), o2 = gelu_tanh_f(a0[2] + bflo(yw.y)), o3 = gelu_tanh_f(a0[3] + bfhi(yw.y));
                    const float o4 = gelu_tanh_f(a1[0] + bflo(yw.z)), o5 = gelu_tanh_f(a1[1] + bfhi(yw.z)), o6 = gelu_tanh_f(a1[2] + bflo(yw.w)), o7 = gelu_tanh_f(a1[3] + bfhi(yw.w));
                    v4u w; w.x = cvt_pk_bf16(o0, o1); w.y = cvt_pk_bf16(o2, o3); w.z = cvt_pk_bf16(o4, o5); w.w = cvt_pk_bf16(o6, o7);
                    *(v4u*)(base + ((size_t)r * 16 + (c >> 4)) * 1536 + (c & 15)) = w; }
                asm volatile("" ::: "memory"); }
    }
};
}

struct Params { const float* in[32]; float* out; unsigned char* ws; int ph_lo, ph_hi; };
enum { I_X = 0, I_C, I_CTX, I_CCTX, I_WMOD, I_BMOD, I_LNG, I_LNB, I_EV_WIN, I_EV_WOUT, I_EV_SINK, I_EV_W1, I_EV_W3, I_EV_W2, I_OD_WIN, I_A_RE, I_A_IM, I_LOG_DT,
       I_B_RE, I_B_IM, I_C_RE, I_C_IM, I_SSM_D, I_WGLU, I_BGLU, I_WS, I_BS, I_OD_WOUT, I_ROUTER, I_MW1, I_MW3, I_MW2 };

constexpr int LDS_RING = 131072, LDS_MISC = LDS_RING + 320, LDS_LNTAB = LDS_RING + 1024, LDS_BYTES = 147456;
constexpr int NWAVES = 8, NTHREADS = 512;

struct Frame {
    LAS unsigned char* lds;
    int tid, lane, wave, G, bid, gw, NGW;
    unsigned char* ws;
    unsigned* ctl;
};

using pg8::Unit;
struct SchedStd {
    int nN, nUnits, G, c; const char* A; const char* B; char* O; size_t aStep, bStep, oRow, oCol; int ldo, act_from;
    __device__ __forceinline__ bool next(int i, Unit& u) const {
        const int L = i * G + c; if (L >= nUnits) return false;
        const int pm = L / nN, pn = L - pm * nN;
        u.a = A + (size_t)pm * aStep; u.b = B + (size_t)pn * bStep; u.o = O + (size_t)pm * oRow + (size_t)pn * oCol; u.p0 = nullptr; u.p1 = nullptr; u.ldo = ldo; u.x0 = (pn >= act_from) ? 1 : 0; return true;
    }
};
struct SchedEvIn {
    int G, c; const char* H; const char* Wqkv; const char* Wpq; char* QKV; char* PQT; char* PQTC;
    __device__ __forceinline__ bool next(int i, Unit& u) const {
        int L = i * G + c; u.p0 = nullptr; u.p1 = nullptr; u.x0 = 0;
        constexpr int NQ = (T / 256) * 3, NP = 4 * (TL / 256), NPC = 4 * (TC / 256);
        if (L < NQ) { const int pm = L / 3, pn = L - pm * 3;
            u.a = H + (size_t)pm * 256 * D * 2; u.b = Wqkv + (size_t)pn * 256 * D * 2; u.o = QKV + ((size_t)pm * 256 * 768 + pn * 256) * 2; u.ldo = 768; return true; }
        L -= NQ;
        if (L < NP) { const int tt = L >> 2, pm = L & 3, b = tt >> 4, n0 = (tt & 15) * 256, isq = pm >> 1, ch0 = (pm & 1) * 256;
            u.a = Wpq + (size_t)pm * 256 * D * 2; u.b = H + (size_t)tt * 256 * D * 2;
            u.o = PQT + ((((size_t)b * 512 + ch0) * 2 + isq) * 4096 + n0) * 2; u.ldo = 8192; return true; }
        L -= NP;
        if (L < NPC) { const int b = L >> 2, pm = L & 3, isq = pm >> 1, ch0 = (pm & 1) * 256;
            u.a = Wpq + (size_t)pm * 256 * D * 2; u.b = H + ((size_t)TL + (size_t)b * 256) * D * 2;
            u.o = PQTC + (((size_t)b * 512 + ch0) * 2 + isq) * 256 * 2; u.ldo = 512; return true; }
        return false;
    }
};
struct SchedDft {
    int G, c; const char* FDm; const char* VB; const char* F2; const char* PQTC; char* MIX;
    __device__ __forceinline__ bool next(int i, Unit& u) const {
        int L = i * G + c; u.p0 = nullptr; u.p1 = nullptr; u.x0 = 0;
        if (L < 512) { const int b = L >> 5, pn = L & 31, k2 = pn >> 1, ch0 = (pn & 1) * 256;
            u.a = FDm; u.b = VB + ((((size_t)b * 16 + k2) * 512 + ch0) * 512) * 2; u.o = MIX + ((((size_t)b * 4096 + k2) * D) + ch0) * 2; u.ldo = 16 * D; return true; }
        L -= 512; if (L >= 32) return false;
        const int b = L >> 1, pn = L & 1;
        u.a = F2; u.b = PQTC + ((size_t)b * 512 + pn * 256) * 512 * 2; u.o = MIX + (((size_t)TL + (size_t)b * 256) * D + pn * 256) * 2; u.ldo = D; return true;
    }
};
struct SchedResid {
    int G, c, nUnits; const char* A; size_t aStep; const char* W; size_t bStep; const float* xl; const float* xc; float* zl; float* zc; const float* gate;
    __device__ __forceinline__ bool next(int i, Unit& u) const {
        const int L = i * G + c; if (L >= nUnits) return false;
        const int pm = L >> 2, pn = L & 3;
        u.a = A + (size_t)pm * aStep; u.b = W + (size_t)pn * bStep;
        const bool isc = pm >= TL / 256; const int pr = isc ? pm - TL / 256 : pm; const int mrow = isc ? 16 : (pm >> 4);
        const size_t off = ((size_t)pr * 256 * D + pn * 256);
        u.p0 = (const char*)((isc ? xc : xl) + off); u.o = (char*)((isc ? zc : zl) + off); u.p1 = (const char*)(gate + (size_t)mrow * 6144 + pn * 256); u.ldo = D; u.x0 = L; return true;
    }
};
struct SchedGlu {
    int G, c; const char* P; const char* W; char* MIX; const float* bias;
    __device__ __forceinline__ bool next(int i, Unit& u) const {
        const int L = i * G + c; if (L >= (T / 256) * 2) return false;
        const int pm = L >> 1, pn = L & 1;
        u.a = P + (size_t)pm * 256 * 1536 * 2; u.b = W + (size_t)pn * 256 * 512 * 2; u.o = MIX + ((size_t)pm * 256 * D + pn * 256) * 2;
        u.p0 = P + ((size_t)pm * 256 * 1536 + pn * 256) * 2; u.p1 = (const char*)(bias + pn * 256); u.ldo = D; u.x0 = 1536; return true;
    }
};
struct SchedS5A {
    int G, c; const char* P; const char* WA; char* Y1; char* HB;
    __device__ __forceinline__ bool next(int i, Unit& u) const {
        const int L = i * G + c; if (L >= 32 * 34) return false;
        const int g = L / 34, rem = L - g * 34, pm = rem >> 1, pn = rem & 1;
        u.a = P + ((size_t)pm * 256 * 16 * 1536 + g * 16) * 2; u.b = WA + (size_t)g * S5M_STRIDE + (size_t)pn * 256 * 256 * 2;
        u.o = (pn ? HB : Y1) + (((size_t)pm * 256 * 32 + g) * 256) * 2; u.p0 = nullptr; u.p1 = nullptr; u.ldo = 8192; u.x0 = 0; return true;
    }
};
struct SchedS5B {
    int G, c; const char* HB; const char* CL; const char* Y1; char* P;
    __device__ __forceinline__ bool next(int i, Unit& u) const {
        const int L = i * G + c; if (L >= 32 * 17) return false;
        const int g = L / 17, pm = L - g * 17;
        const size_t toff = (((size_t)pm * 256 * 32 + g) * 256) * 2;
        u.a = HB + toff; u.b = CL + (size_t)g * S5M_STRIDE; u.p0 = Y1 + toff; u.o = P + ((size_t)pm * 256 * 16 * 1536 + g * 16) * 2; u.p1 = nullptr; u.ldo = 0; u.x0 = 0; return true;
    }
};
struct SchedMoeUp {
    int G, c, nUnits, rt0; int toff[9]; const char* HS; const char* W; char* HID;
    __device__ __forceinline__ bool next(int i, Unit& u) const {
        const int L = i * G + c; if (L >= nUnits) return false;
        const int rl = L / 28, pn = L - rl * 28, rt = rt0 + rl; int e = 0;
#pragma unroll
        for (int k = 1; k < 8; ++k) e += (rt >= toff[k]) ? 1 : 0;
        u.a = HS + (size_t)rt * 256 * D; u.b = W + ((size_t)e * 7168 + pn * 256) * D; u.o = HID + ((size_t)rl * 256 * EH + pn * 128);
        u.p0 = nullptr; u.p1 = nullptr; u.ldo = EH; u.x0 = 0; return true;
    }
};
struct SchedMoeDown {
    int G, c, nUnits, rt0; int toff[9]; const char* HID; const char* W; char* Y;
    __device__ __forceinline__ bool next(int i, Unit& u) const {
        const int L = i * G + c; if (L >= nUnits) return false;
        const int rl = L >> 2, pn = L & 3, rt = rt0 + rl; int e = 0;
#pragma unroll
        for (int k = 1; k < 8; ++k) e += (rt >= toff[k]) ? 1 : 0;
        u.a = HID + (size_t)rl * 256 * EH; u.b = W + ((size_t)e * 1024 + pn * 256) * EH; u.o = Y + ((size_t)rt * 256 * D + pn * 256) * 2;
        u.p0 = nullptr; u.p1 = nullptr; u.ldo = D; u.x0 = 0; return true;
    }
};

__device__ __forceinline__ void tr_item(const float* W, int ldn, bf16* WT, int ldk, int k0, int n0, int drow0, LAS float* scr, int lane) {
#pragma unroll 8
    for (int i = 0; i < 32; ++i) { const int kk = 2 * i + (lane >> 5); scr[kk * 33 + (lane & 31)] = W[(size_t)(k0 + kk) * ldn + n0 + (lane & 31)]; }
    LDS_WAIT(); asm volatile("" ::: "memory");
    const int c = lane & 7;
#pragma unroll
    for (int j = 0; j < 4; ++j) { const int n = (lane >> 3) + 8 * j; const LAS float* s = scr + (8 * c) * 33 + n;
        v4u o; o.x = cvt_pk_bf16(s[0 * 33], s[1 * 33]); o.y = cvt_pk_bf16(s[2 * 33], s[3 * 33]); o.z = cvt_pk_bf16(s[4 * 33], s[5 * 33]); o.w = cvt_pk_bf16(s[6 * 33], s[7 * 33]);
        *(v4u*)(WT + (size_t)(drow0 + n) * ldk + k0 + 8 * c) = o; }
    LDS_WAIT(); asm volatile("" ::: "memory");
}
__device__ __forceinline__ void tr_item8(const float* W, int ldn, unsigned char* WT, int ldk, int k0, int n0, int drow0, LAS float* scr, int lane, float qs) {
#pragma unroll 8
    for (int i = 0; i < 32; ++i) { const int kk = 2 * i + (lane >> 5); scr[kk * 33 + (lane & 31)] = W[(size_t)(k0 + kk) * ldn + n0 + (lane & 31)] * qs; }
    LDS_WAIT(); asm volatile("" ::: "memory");
    const int c = lane & 7;
#pragma unroll
    for (int j = 0; j < 4; ++j) { const int n = (lane >> 3) + 8 * j; const LAS float* sp = scr + (8 * c) * 33 + n;
        v2u o; o.x = pk_fp8x4(sp[0 * 33], sp[1 * 33], sp[2 * 33], sp[3 * 33]); o.y = pk_fp8x4(sp[4 * 33], sp[5 * 33], sp[6 * 33], sp[7 * 33]);
        *(v2u*)(WT + (size_t)(drow0 + n) * ldk + k0 + 8 * c) = o; }
    LDS_WAIT(); asm volatile("" ::: "memory");
}
__device__ __forceinline__ void tr_job8(const float* W, int ldn, int N, unsigned char* WT, int ldk, int mode, int roff, int item, LAS float* scr, int lane) {
    const int nblk = N / 32, kb = item / nblk, nb = item - kb * nblk, n0 = nb * 32;
    const int drow0 = mode ? ((n0 >> 7) * 256 + (n0 & 127) + roff) : (roff + n0);
    tr_item8(W, ldn, WT, ldk, kb * 64, n0, drow0, scr, lane, Q_W);
}
__device__ __forceinline__ void tr_job(const float* W, int ldn, int N, bf16* WT, int ldk, int mode, int roff, int item, LAS float* scr, int lane) {
    const int nblk = N / 32, kb = item / nblk, nb = item - kb * nblk, n0 = nb * 32;
    const int drow0 = mode ? ((n0 >> 7) * 256 + (n0 & 127) + roff) : (roff + n0);
    tr_item(W, ldn, WT, ldk, kb * 64, n0, drow0, scr, lane);
}
__device__ __forceinline__ void cvt_item(const Params& p, int r, LAS float* scr, int lane) {
    unsigned char* ws = p.ws;
    constexpr int EV_ITEMS = 384 + 512 + 3 * 1408;
    constexpr int ODS_ITEMS = 768 + 128 + 512;
    constexpr int EXP_ITEMS = 3 * 1792, MOE_ITEMS = 8 * EXP_ITEMS;
    if (r < 2 * EV_ITEMS) { const int li = r / EV_ITEMS; r -= li * EV_ITEMS; unsigned char* base = ws + WS_EV + li * EV_STRIDE;
        if (r < 384) { tr_job(p.in[I_EV_WIN] + (size_t)li * D * 1280 + 512, 1280, 768, (bf16*)(base + EV_WQKV), D, 0, 0, r, scr, lane); return; } r -= 384;
        if (r < 512) { tr_job(p.in[I_EV_WOUT] + (size_t)li * D * D, D, D, (bf16*)(base + EV_WOUT), D, 0, 0, r, scr, lane); return; } r -= 512;
        if (r < 1408) { tr_job(p.in[I_EV_W1] + (size_t)li * D * FFH, FFH, FFH, (bf16*)(base + EV_W13), D, 1, 0, r, scr, lane); return; } r -= 1408;
        if (r < 1408) { tr_job(p.in[I_EV_W3] + (size_t)li * D * FFH, FFH, FFH, (bf16*)(base + EV_W13), D, 1, 128, r, scr, lane); return; } r -= 1408;
        tr_job(p.in[I_EV_W2] + (size_t)li * FFH * D, D, D, (bf16*)(base + EV_W2), FFH, 0, 0, r, scr, lane); return; }
    r -= 2 * EV_ITEMS;
    if (r < 2 * ODS_ITEMS) { const int li = r / ODS_ITEMS; r -= li * ODS_ITEMS; unsigned char* base = ws + WS_OD + li * OD_STRIDE;
        if (r < 768) { tr_job(p.in[I_OD_WIN] + (size_t)li * D * 1536, 1536, 1536, (bf16*)(base + OD_WIN), D, 0, 0, r, scr, lane); return; } r -= 768;
        if (r < 128) { tr_job(p.in[I_WGLU] + (size_t)li * 512 * 512, 512, 512, (bf16*)(base + OD_WGLU), 512, 0, 0, r, scr, lane); return; } r -= 128;
        tr_job(p.in[I_OD_WOUT] + (size_t)li * D * D, D, D, (bf16*)(base + OD_WOUT), D, 0, 0, r, scr, lane); return; }
    r -= 2 * ODS_ITEMS;
    { const int li = r / MOE_ITEMS; r -= li * MOE_ITEMS; const int e = r / EXP_ITEMS; r -= e * EXP_ITEMS; unsigned char* base = ws + WS_OD + li * OD_STRIDE;
        const size_t we = (size_t)li * NEXP + e;
        if (r < 1792) { tr_job8(p.in[I_MW1] + we * D * EH, EH, EH, (unsigned char*)(base + OD_MW13) + (size_t)e * 7168 * D, D, 1, 0, r, scr, lane); return; } r -= 1792;
        if (r < 1792) { tr_job8(p.in[I_MW3] + we * D * EH, EH, EH, (unsigned char*)(base + OD_MW13) + (size_t)e * 7168 * D, D, 1, 128, r, scr, lane); return; } r -= 1792;
        tr_job8(p.in[I_MW2] + we * EH * D, D, D, (unsigned char*)(base + OD_MW2) + (size_t)e * D * EH, EH, 0, 0, r, scr, lane); }
}
constexpr int CVT_ITEMS = 2 * 5120 + 2 * 1408 + 2 * 8 * 3 * 1792;

__device__ __forceinline__ void fold_unit(const Params& p, Frame& F, int unit) {
    const int li = unit >> 6, g = (unit >> 4) & 3, k0 = (unit & 15) * 64;
    LAS float* tile = (LAS float*)F.lds;
    LAS float* trig = tile + 64 * 129;
    const float* W = p.in[I_EV_WIN] + (size_t)li * D * 1280;
    for (int e = F.tid; e < 64 * 128; e += NTHREADS) { const int k = e >> 7, c = e & 127; tile[k * 129 + c] = W[(size_t)(k0 + k) * 1280 + g * 128 + c]; }
    if (F.tid < 128) { float s, c; sincospif((float)F.tid / 64.0f, &s, &c); trig[F.tid] = c * 0.08838834764831845f; trig[128 + F.tid] = s * 0.08838834764831845f; }
    __syncthreads();
    bf16* WT = (bf16*)(p.ws + WS_EV + li * EV_STRIDE + EV_WPQ);
    const int k = F.lane, mg = F.wave;
    for (int mm = 0; mm < 16; ++mm) { const int m = mg * 16 + mm; float sp = 0.f, sq = 0.f;
        for (int c = 0; c < 128; ++c) { const float w = tile[k * 129 + c]; const int ph = (m * c) & 127; sp += w * trig[ph]; sq += w * trig[128 + ph]; }
        WT[(size_t)(g * 128 + m) * D + k0 + k] = f2bf(sp); WT[(size_t)(512 + g * 128 + m) * D + k0 + k] = f2bf(sq); }
    __syncthreads();
}

__device__ __forceinline__ void row_load(const float* row, int lane, f32x4 (&v)[4]) {
#pragma unroll
    for (int j = 0; j < 4; ++j) v[j] = *(const f32x4*)(row + 256 * j + 4 * lane);
}
__device__ __forceinline__ void row_store(float* row, int lane, const f32x4 (&v)[4]) {
#pragma unroll
    for (int j = 0; j < 4; ++j) *(f32x4*)(row + 256 * j + 4 * lane) = v[j];
}
__device__ __forceinline__ void row_store_bf16(bf16* row, int lane, const f32x4 (&v)[4]) {
#pragma unroll
    for (int j = 0; j < 4; ++j) { v2u w; w.x = cvt_pk_bf16(v[j][0], v[j][1]); w.y = cvt_pk_bf16(v[j][2], v[j][3]); *(v2u*)(row + 256 * j + 4 * lane) = w; }
}
__device__ __forceinline__ void row_layernorm(f32x4 (&v)[4], const float* g, const float* b, int lane) {
    float s = 0.f;
#pragma unroll
    for (int j = 0; j < 4; ++j) s += (v[j][0] + v[j][1]) + (v[j][2] + v[j][3]);
    const float mean = wave_sum(s) * (1.f / D); float q = 0.f;
#pragma unroll
    for (int j = 0; j < 4; ++j) { v[j] = v[j] - mean; q += (v[j][0] * v[j][0] + v[j][1] * v[j][1]) + (v[j][2] * v[j][2] + v[j][3] * v[j][3]); }
    const float rstd = rsqrtf(wave_sum(q) * (1.f / D) + LN_EPS);
#pragma unroll
    for (int j = 0; j < 4; ++j) { const f32x4 gg = *(const f32x4*)(g + 256 * j + 4 * lane), bb = *(const f32x4*)(b + 256 * j + 4 * lane); v[j] = v[j] * rstd * gg + bb; }
}
__device__ __forceinline__ void row_modulate(f32x4 (&h)[4], const f32x4 (&v)[4], const float* sc, const float* sh, int lane) {
#pragma unroll
    for (int j = 0; j < 4; ++j) { const f32x4 s = *(const f32x4*)(sc + 256 * j + 4 * lane), t = *(const f32x4*)(sh + 256 * j + 4 * lane); h[j] = v[j] * (s + 1.0f) + t; }
}

__device__ __forceinline__ void row_ln_pre(f32x4 (&v)[4], const f32x4 (&gg)[4], const f32x4 (&bb)[4]) {
    float s = 0.f;
#pragma unroll
    for (int j = 0; j < 4; ++j) s += (v[j][0] + v[j][1]) + (v[j][2] + v[j][3]);
    const float mean = wave_sum(s) * (1.f / D); float q = 0.f;
#pragma unroll
    for (int j = 0; j < 4; ++j) { v[j] = v[j] - mean; q += (v[j][0] * v[j][0] + v[j][1] * v[j][1]) + (v[j][2] * v[j][2] + v[j][3] * v[j][3]); }
    const float rstd = rsqrtf(wave_sum(q) * (1.f / D) + LN_EPS);
#pragma unroll
    for (int j = 0; j < 4; ++j) v[j] = v[j] * rstd * gg[j] + bb[j];
}
__device__ __forceinline__ void row_load_mod(const float* sc, const float* sh, int lane, f32x4 (&s)[4], f32x4 (&t)[4]) {
#pragma unroll
    for (int j = 0; j < 4; ++j) { s[j] = *(const f32x4*)(sc + 256 * j + 4 * lane); t[j] = *(const f32x4*)(sh + 256 * j + 4 * lane); }
}
typedef const __attribute__((address_space(4))) Params* PP;
#define PIN(i) ((const float*)pp->in[i])
#define DECL_LDS extern __shared__ __attribute__((aligned(16))) unsigned char lds_raw[]
#define PHASE_FN static __device__ __forceinline__ void

__device__ __forceinline__ Frame make_frame(PP pp, unsigned char* lds_generic) {
    Frame F;
    F.lds = (LAS unsigned char*)lds_generic;
    { int t_ = threadIdx.x; asm volatile("" : "+v"(t_)); F.tid = t_; }
    F.lane = F.tid & 63; F.wave = __builtin_amdgcn_readfirstlane(F.tid >> 6);
    F.G = gridDim.x; F.bid = blockIdx.x; F.gw = F.bid * NWAVES + F.wave; F.NGW = F.G * NWAVES;
    F.ws = (unsigned char*)pp->ws; F.ctl = (unsigned*)(F.ws + WS_CTL);
    return F;
}
#define FRAME() DECL_LDS; asm volatile("" : "+s"(pp)); Frame F = make_frame(pp, lds_raw); unsigned char* ws = F.ws; (void)ws

PHASE_FN grid_bar(PP pp) {
    FRAME();
    XcdBarrier bar; bar.bar = F.ctl + CW_BAR; bar.x = xb_xcc_id(); bar.st = (volatile LAS unsigned*)(F.lds + LDS_MISC) + 8;
    xcd_barrier(bar);
}

static __device__ __forceinline__ void ln_pass(const Frame& F, float* out, float* XC, bf16* Hb, const float* lng, const float* lnb, const float* modv, const int sc_off, const int sh_off, const int TR) {
    f32x4 gg[4], bb[4];
#pragma unroll
    for (int j = 0; j < 4; ++j) { gg[j] = *(const f32x4*)(lng + 256 * j + 4 * F.lane); bb[j] = *(const f32x4*)(lnb + 256 * j + 4 * F.lane); }
    for (int r0 = F.gw; r0 < TR; r0 += 2 * F.NGW) {
        const int r1 = r0 + F.NGW; const bool two = r1 < TR;
        const bool c0 = r0 >= TL, c1 = r1 >= TL;
        float* x0 = c0 ? XC + (size_t)(r0 - TL) * D : out + (size_t)r0 * D; float* x1 = two ? (c1 ? XC + (size_t)(r1 - TL) * D : out + (size_t)r1 * D) : x0;
        const float* m0 = modv + (size_t)(c0 ? 16 : (r0 >> 12)) * 6144; const float* m1 = modv + (size_t)((two && !c1) ? (r1 >> 12) : 16) * 6144;
        f32x4 v0[4], v1[4], s0[4], t0[4], s1[4], t1[4];
        row_load(x0, F.lane, v0); row_load(x1, F.lane, v1);
        row_load_mod(m0 + sc_off, m0 + sh_off, F.lane, s0, t0); row_load_mod(m1 + sc_off, m1 + sh_off, F.lane, s1, t1);
        row_ln_pre(v0, gg, bb); row_ln_pre(v1, gg, bb);
        row_store(x0, F.lane, v0);
#pragma unroll
        for (int j = 0; j < 4; ++j) s0[j] = v0[j] * (s0[j] + 1.0f) + t0[j];
        row_store_bf16(Hb + (size_t)r0 * D, F.lane, s0);
        if (two) { row_store(x1, F.lane, v1);
#pragma unroll
            for (int j = 0; j < 4; ++j) s1[j] = v1[j] * (s1[j] + 1.0f) + t1[j];
            row_store_bf16(Hb + (size_t)r1 * D, F.lane, s1); }
    }
}
PHASE_FN ph_fold(PP pp) {
    FRAME();
    Params p; p.ws = ws; p.in[I_EV_WIN] = PIN(I_EV_WIN);
    for (int u = F.bid; u < 128; u += F.G) fold_unit(p, F, u);
}
PHASE_FN ph_mod(PP pp) {
    FRAME();
    float* MOD = (float*)(ws + WS_MOD);
    LAS float* sc = (LAS float*)F.lds;
    const float* cin = PIN(I_C); const float* ccin = PIN(I_CCTX);
    __syncthreads();
    for (int e = F.tid; e < 17 * D; e += NTHREADS) { const int r = e >> 10, k = e & 1023; const float v = (r < 16) ? cin[r * D + k] : ccin[k]; sc[e] = silu_f(v); }
    __syncthreads();
    const int kq = F.lane >> 4, cl = F.lane & 15;
    for (int task = F.gw; task < DEPTH * 6144 / 16; task += F.NGW) {
        const int col = task * 16 + cl, l = col / 6144, j = col - l * 6144;
        const float* W = PIN(I_WMOD) + (size_t)l * D * 6144 + (size_t)(kq * 256) * 6144 + j;
        float acc[17];
#pragma unroll
        for (int r = 0; r < 17; ++r) acc[r] = 0.f;
        for (int k0 = 0; k0 < 256; k0 += 16) {
            float w[16];
#pragma unroll
            for (int q = 0; q < 16; ++q) w[q] = W[(size_t)(k0 + q) * 6144];
#pragma unroll
            for (int q4 = 0; q4 < 4; ++q4)
#pragma unroll
                for (int r = 0; r < 17; ++r) { const f32x4 sv = *(const LAS f32x4*)(sc + r * D + kq * 256 + k0 + 4 * q4); acc[r] += (sv[0] * w[4 * q4] + sv[1] * w[4 * q4 + 1]) + (sv[2] * w[4 * q4 + 2] + sv[3] * w[4 * q4 + 3]); }
        }
        const float bm = PIN(I_BMOD)[l * 6144 + j];
#pragma unroll
        for (int r = 0; r < 17; ++r) { float v = acc[r]; v += __shfl_xor(v, 16); v += __shfl_xor(v, 32); if (kq == 0) MOD[((size_t)l * 17 + r) * 6144 + j] = v + bm; }
    }
    __syncthreads();
}
PHASE_FN ph_cvt(PP pp) {
    FRAME();
    Params p; p.ws = ws;
    p.in[I_EV_WIN] = PIN(I_EV_WIN); p.in[I_EV_WOUT] = PIN(I_EV_WOUT); p.in[I_EV_W1] = PIN(I_EV_W1); p.in[I_EV_W3] = PIN(I_EV_W3); p.in[I_EV_W2] = PIN(I_EV_W2);
    p.in[I_OD_WIN] = PIN(I_OD_WIN); p.in[I_WGLU] = PIN(I_WGLU); p.in[I_OD_WOUT] = PIN(I_OD_WOUT); p.in[I_MW1] = PIN(I_MW1); p.in[I_MW3] = PIN(I_MW3); p.in[I_MW2] = PIN(I_MW2);
    LAS float* scr = (LAS float*)(F.lds + F.wave * 16384);
    for (int it = F.gw; it < CVT_ITEMS; it += F.NGW) cvt_item(p, it, scr, F.lane);
}
PHASE_FN ph_dftmat(PP pp) {
    FRAME();
    bf16* FDm = (bf16*)(ws + WS_FD); bf16* F2 = (bf16*)(ws + WS_F256);
    for (int it = F.bid * NTHREADS + F.tid; it < 2 * 256 * 64; it += F.G * NTHREADS) {
        const int which = it >> 14, k = (it >> 6) & 255, n0 = (it & 63) * 8; const bool isq = n0 >= 256; const int nb = n0 & 255;
        float v[8];
#pragma unroll
        for (int j = 0; j < 8; ++j) { const int phs = (k * (nb + j)) & 255; float sn, cs; sincospif((float)phs * (1.0f / 128.0f), &sn, &cs);
            v[j] = which ? (isq ? -sn * (1.f / 16.f) : cs * (1.f / 16.f)) : (isq ? sn * (1.f / 64.f) : cs * (1.f / 64.f)); }
        v4u w; w.x = cvt_pk_bf16(v[0], v[1]); w.y = cvt_pk_bf16(v[2], v[3]); w.z = cvt_pk_bf16(v[4], v[5]); w.w = cvt_pk_bf16(v[6], v[7]);
        *(v4u*)((which ? F2 : FDm) + (size_t)k * 512 + n0) = w;
    }
}
PHASE_FN ph_s5mat(PP pp) {
    FRAME();
    LAS float* lam = (LAS float*)F.lds;
    LAS float* bb = lam + 2 * 64 * 17 * 2;
    LAS float* cc = bb + 2 * 64 * 16 * 2;
    LAS float* kt = cc + 2 * 16 * 64 * 2;
    for (int unit = F.bid; unit < 64; unit += F.G) {
        const int li = unit >> 5, g = unit & 31;
        __syncthreads();
        if (F.tid < 128) { const int d = F.tid >> 6, pl = F.tid & 63; const int sidx = ((li * 2 + d) * 32 + g);
            const float are = PIN(I_A_RE)[sidx * 64 + pl], aim = PIN(I_A_IM)[sidx * 64 + pl], dt = expf(PIN(I_LOG_DT)[sidx]);
            for (int e = 0; e <= 16; ++e) { const float mag = expf(are * dt * (float)e); float sn, cn; sincosf(aim * dt * (float)e, &sn, &cn); lam[((d * 64 + pl) * 17 + e) * 2] = mag * cn; lam[((d * 64 + pl) * 17 + e) * 2 + 1] = mag * sn; } }
        __syncthreads();
        for (int e = F.tid; e < 2048; e += NTHREADS) { const int d = e >> 10, pl = (e >> 4) & 63, sp = e & 15; const int sidx = ((li * 2 + d) * 32 + g);
            const float are = PIN(I_A_RE)[sidx * 64 + pl], aim = PIN(I_A_IM)[sidx * 64 + pl];
            const float lre = lam[((d * 64 + pl) * 17 + 1) * 2], lim = lam[((d * 64 + pl) * 17 + 1) * 2 + 1];
            const float den = 1.0f / (are * are + aim * aim);
            const float fre = ((lre - 1.0f) * are + lim * aim) * den, fim = (lim * are - (lre - 1.0f) * aim) * den;
            const float br = PIN(I_B_RE)[((size_t)sidx * 64 + pl) * 16 + sp], bi = PIN(I_B_IM)[((size_t)sidx * 64 + pl) * 16 + sp];
            bb[e * 2] = fre * br - fim * bi; bb[e * 2 + 1] = fre * bi + fim * br; }
        for (int e = F.tid; e < 2048; e += NTHREADS) { const int d = e >> 10, sq = (e >> 6) & 15, pl = e & 63; const int sidx = ((li * 2 + d) * 32 + g);
            cc[e * 2] = PIN(I_C_RE)[((size_t)sidx * 16 + sq) * 64 + pl]; cc[e * 2 + 1] = PIN(I_C_IM)[((size_t)sidx * 16 + sq) * 64 + pl]; }
        __syncthreads();
        for (int e = F.tid; e < 8192; e += NTHREADS) { const int d = e >> 12, tau = (e >> 8) & 15, sq = (e >> 4) & 15, sp = e & 15; float acc = 0.f;
            for (int pl = 0; pl < 64; ++pl) { const float cr = cc[((d * 16 + sq) * 64 + pl) * 2], ci = cc[((d * 16 + sq) * 64 + pl) * 2 + 1];
                const float lr = lam[((d * 64 + pl) * 17 + tau) * 2], lj = lam[((d * 64 + pl) * 17 + tau) * 2 + 1];
                const float br = bb[((d * 64 + pl) * 16 + sp) * 2], bi = bb[((d * 64 + pl) * 16 + sp) * 2 + 1];
                const float tr = cr * lr - ci * lj, ti = cr * lj + ci * lr;
                acc += tr * br - ti * bi; }
            kt[e] = acc; }
        __syncthreads();
        bf16* WA = (bf16*)(ws + WS_S5M + (size_t)unit * S5M_STRIDE); bf16* CLm = WA + 512 * 256;
        const float* dsk = PIN(I_SSM_D) + (size_t)li * 512 + g * 16;
        for (int it = F.tid; it < 8192; it += NTHREADS) { const int row = it >> 5, c0 = (it & 31) * 8;
            float v[8];
            { const int i = row >> 4, sq = row & 15, j = c0 >> 4, sp0 = c0 & 15;
#pragma unroll
              for (int q = 0; q < 8; ++q) { const int sp = sp0 + q; float a = 0.f; if (i >= j) a += kt[((0 * 16 + (i - j)) * 16 + sq) * 16 + sp]; if (j >= i) a += kt[((1 * 16 + (j - i)) * 16 + sq) * 16 + sp]; if (i == j && sq == sp) a += dsk[sq]; v[q] = a; }
              v4u w; w.x = cvt_pk_bf16(v[0], v[1]); w.y = cvt_pk_bf16(v[2], v[3]); w.z = cvt_pk_bf16(v[4], v[5]); w.w = cvt_pk_bf16(v[6], v[7]); *(v4u*)(WA + (size_t)row * 256 + c0) = w; }
            { const int d = row >> 7, pl = (row >> 1) & 63, ri = row & 1, j = c0 >> 4, sp0 = c0 & 15, e = d ? j : 15 - j;
              const float lr = lam[((d * 64 + pl) * 17 + e) * 2], lj = lam[((d * 64 + pl) * 17 + e) * 2 + 1];
#pragma unroll
              for (int q = 0; q < 8; ++q) { const float br = bb[((d * 64 + pl) * 16 + sp0 + q) * 2], bi = bb[((d * 64 + pl) * 16 + sp0 + q) * 2 + 1]; v[q] = ri ? (lr * bi + lj * br) : (lr * br - lj * bi); }
              v4u w; w.x = cvt_pk_bf16(v[0], v[1]); w.y = cvt_pk_bf16(v[2], v[3]); w.z = cvt_pk_bf16(v[4], v[5]); w.w = cvt_pk_bf16(v[6], v[7]); *(v4u*)(WA + (size_t)(256 + row) * 256 + c0) = w; }
            { const int i = row >> 4, sq = row & 15, d = c0 >> 7, pl0 = (c0 >> 1) & 63, e = d ? 16 - i : i + 1;
#pragma unroll
              for (int q = 0; q < 4; ++q) { const int pl = pl0 + q; const float cr = cc[((d * 16 + sq) * 64 + pl) * 2], ci = cc[((d * 16 + sq) * 64 + pl) * 2 + 1];
                  const float lr = lam[((d * 64 + pl) * 17 + e) * 2], lj = lam[((d * 64 + pl) * 17 + e) * 2 + 1];
                  v[2 * q] = cr * lr - ci * lj; v[2 * q + 1] = -(cr * lj + ci * lr); }
              v4u w; w.x = cvt_pk_bf16(v[0], v[1]); w.y = cvt_pk_bf16(v[2], v[3]); w.z = cvt_pk_bf16(v[4], v[5]); w.w = cvt_pk_bf16(v[6], v[7]); *(v4u*)(CLm + (size_t)row * 256 + c0) = w; }
        }
    }
    __syncthreads();
}
PHASE_FN ph_pro_b(PP pp) {
    FRAME();
    const float* MOD = (const float*)(ws + WS_MOD); bf16* Hb = (bf16*)(ws + WS_H);
    const float* xin = PIN(I_X); const float* cin = PIN(I_CTX);
    for (int r = F.gw; r < T; r += F.NGW) {
        const bool isc = r >= TL; const float* xr = isc ? cin + (size_t)(r - TL) * D : xin + (size_t)r * D;
        const float* m = MOD + (size_t)(isc ? 16 : (r >> 12)) * 6144;
        f32x4 v[4], h[4]; row_load(xr, F.lane, v); row_modulate(h, v, m + 1024, m, F.lane); row_store_bf16(Hb + (size_t)r * D, F.lane, h);
    }
}

PHASE_FN ph_e1(PP pp, int layer) {
    FRAME();
    unsigned char* evw = ws + WS_EV + (layer >> 1) * EV_STRIDE; unsigned char* BIG = ws + WS_BIG;
    SchedEvIn S{F.G, F.bid, (const char*)(ws + WS_H), (const char*)(evw + EV_WQKV), (const char*)(evw + EV_WPQ), (char*)(BIG + BIG_QKV), (char*)(BIG + BIG_PQT), (char*)(BIG + BIG_PQTC)};
    pg8::gemm_phase<pg8::EpiStore, SchedEvIn, true, true>(F.lds, F.tid, pg8::Dims{D, D, D}, S, pg8::EpiStore{});
}
struct cf { float r, i; };
__device__ __forceinline__ cf cmul(cf a, float wr, float wi) { return cf{a.r * wr - a.i * wi, a.r * wi + a.i * wr}; }
__device__ __forceinline__ void radix4(cf x0, cf x1, cf x2, cf x3, cf& y0, cf& y1, cf& y2, cf& y3) {
    const cf s02{x0.r + x2.r, x0.i + x2.i}, d02{x0.r - x2.r, x0.i - x2.i}, s13{x1.r + x3.r, x1.i + x3.i}, d13{x1.r - x3.r, x1.i - x3.i};
    y0 = cf{s02.r + s13.r, s02.i + s13.i}; y2 = cf{s02.r - s13.r, s02.i - s13.i}; y1 = cf{d02.r + d13.i, d02.i - d13.r}; y3 = cf{d02.r - d13.i, d02.i + d13.r};
}
__device__ __forceinline__ void fft16(cf (&x)[16]) {
    constexpr float C1 = 0.92387953251128674f, S1 = 0.38268343236508977f, C2 = 0.70710678118654752f;
    cf A[4][4];
#pragma unroll
    for (int b = 0; b < 4; ++b) radix4(x[b], x[4 + b], x[8 + b], x[12 + b], A[b][0], A[b][1], A[b][2], A[b][3]);
    A[1][1] = cmul(A[1][1], C1, -S1); A[1][2] = cmul(A[1][2], C2, -C2); A[1][3] = cmul(A[1][3], S1, -C1);
    A[2][1] = cmul(A[2][1], C2, -C2); A[2][2] = cf{A[2][2].i, -A[2][2].r}; A[2][3] = cmul(A[2][3], -C2, -C2);
    A[3][1] = cmul(A[3][1], S1, -C1); A[3][2] = cmul(A[3][2], -C2, -C2); A[3][3] = cmul(A[3][3], -C1, S1);
#pragma unroll
    for (int c = 0; c < 4; ++c) radix4(A[0][c], A[1][c], A[2][c], A[3][c], x[c], x[c + 4], x[c + 8], x[c + 12]);
}
PHASE_FN ph_e2_fft(PP pp) {
    FRAME();
    const bf16* PQT = (const bf16*)(ws + WS_BIG + BIG_PQT); bf16* VB = (bf16*)(ws + WS_H);
    for (int it = F.bid * NTHREADS + F.tid; it < NBATCH * 512 * 128; it += F.G * NTHREADS) {
        const int n1 = (it & 127) * 2, ch = (it >> 7) & 511, b = it >> 16;
        const bf16* pp_ = PQT + ((size_t)(b * 512 + ch) * 2) * 4096 + n1; const bf16* qq_ = pp_ + 4096;
        unsigned pw[16], qw[16];
#pragma unroll
        for (int n2 = 0; n2 < 16; ++n2) { pw[n2] = *(const unsigned*)(pp_ + 256 * n2); qw[n2] = *(const unsigned*)(qq_ + 256 * n2); }
        unsigned ore[16], oim[16];
#pragma unroll
        for (int e = 0; e < 2; ++e) {
            cf x[16];
#pragma unroll
            for (int n2 = 0; n2 < 16; ++n2) { x[n2].r = e ? bfhi(pw[n2]) : bflo(pw[n2]); x[n2].i = -(e ? bfhi(qw[n2]) : bflo(qw[n2])); }
            fft16(x);
            float sn, cs; sincospif((float)(n1 + e) * (1.0f / 2048.0f), &sn, &cs);
            cf wk{cs, -sn};
#pragma unroll
            for (int k2 = 1; k2 < 16; ++k2) { x[k2] = cmul(x[k2], wk.r, wk.i); wk = cmul(wk, cs, -sn); }
#pragma unroll
            for (int k2 = 0; k2 < 16; ++k2) { const unsigned rr = cvt_pk_bf16(x[k2].r, 0.f) & 0xffffu, ii = cvt_pk_bf16(x[k2].i, 0.f) & 0xffffu;
                if (e) { ore[k2] |= rr << 16; oim[k2] |= ii << 16; } else { ore[k2] = rr; oim[k2] = ii; } }
        }
#pragma unroll
        for (int k2 = 0; k2 < 16; ++k2) { bf16* dst = VB + (((size_t)b * 16 + k2) * 512 + ch) * 512 + n1; *(unsigned*)dst = ore[k2]; *(unsigned*)(dst + 256) = oim[k2]; }
    }
}
PHASE_FN ph_e2_dft(PP pp) {
    FRAME();
    unsigned char* BIG = ws + WS_BIG;
    SchedDft S{F.G, F.bid, (const char*)(ws + WS_FD), (const char*)(ws + WS_H), (const char*)(ws + WS_F256), (const char*)(BIG + BIG_PQTC), (char*)(BIG + BIG_MIX)};
    pg8::gemm_phase<pg8::EpiStore, SchedDft, true, true>(F.lds, F.tid, pg8::Dims{512, 512, 512}, S, pg8::EpiStore{});
}
PHASE_FN ph_e2_rope(PP pp) {
    FRAME();
    bf16* QKV = (bf16*)(ws + WS_BIG + BIG_QKV);
    LAS f32x2* cs = (LAS f32x2*)F.lds;
    __syncthreads();
    for (int e = F.tid; e < 1024; e += NTHREADS) { const int pos = e >> 4, i = e & 15; const float inv = powf(10000.0f, -(float)i / 16.0f); float s, c; sincosf((float)pos * inv, &s, &c); cs[e] = (f32x2){c, s}; }
    __syncthreads();
    for (int it = F.bid * NTHREADS + F.tid; it < TL * 10; it += F.G * NTHREADS) {
        const int r = it / 10, hh = it - r * 10, n = r & 4095;
        v4u* base = (v4u*)(QKV + (size_t)r * 768 + hh * 64);
        v4u v[8];
#pragma unroll
        for (int k = 0; k < 8; ++k) v[k] = base[k];
#pragma unroll
        for (int ax = 0; ax < 2; ++ax) { const int pos = ax ? (n & 63) : (n >> 6);
#pragma unroll
            for (int k = 0; k < 2; ++k) { unsigned* a = (unsigned*)&v[4 * ax + k]; unsigned* b = (unsigned*)&v[4 * ax + 2 + k];
#pragma unroll
                for (int q = 0; q < 4; ++q) { const f32x2 t0 = cs[pos * 16 + 8 * k + 2 * q], t1 = cs[pos * 16 + 8 * k + 2 * q + 1];
                    const float x1l = bflo(a[q]), x1h = bfhi(a[q]), x2l = bflo(b[q]), x2h = bfhi(b[q]);
                    a[q] = cvt_pk_bf16(x1l * t0.x - x2l * t0.y, x1h * t1.x - x2h * t1.y); b[q] = cvt_pk_bf16(x1l * t0.y + x2l * t0.x, x1h * t1.y + x2h * t1.x); } } }
#pragma unroll
        for (int k = 0; k < 8; ++k) base[k] = v[k];
    }
    bf16* VT = (bf16*)(ws + WS_BIG + BIG_VT);
    for (int it = F.bid * NTHREADS + F.tid; it < NBATCH * 2 * 544 * 64; it += F.G * NTHREADS) {
        const int d = it & 63, kg = (it >> 6) % 544, bh = (it >> 6) / 544, b = bh >> 1, hkv = bh & 1;
        const int key0 = kg * 8; const size_t row0 = (key0 < 256) ? ((size_t)TL + (size_t)b * 256 + key0) : ((size_t)b * 4096 + (key0 - 256));
        const bf16* src = QKV + row0 * 768 + 640 + hkv * 64 + d;
        unsigned short v[8];
#pragma unroll
        for (int j = 0; j < 8; ++j) v[j] = src[(size_t)j * 768];
        v4u w; w.x = v[0] | ((unsigned)v[1] << 16); w.y = v[2] | ((unsigned)v[3] << 16); w.z = v[4] | ((unsigned)v[5] << 16); w.w = v[6] | ((unsigned)v[7] << 16);
        *(v4u*)(VT + ((size_t)bh * 64 + d) * 4352 + key0) = w;
    }
    __syncthreads();
}
typedef float f32x16 __attribute__((ext_vector_type(16)));
typedef __bf16 bf16x2v __attribute__((ext_vector_type(2)));
__device__ __forceinline__ unsigned pk_bf16(float a, float b) { const bf16x2v t = __builtin_convertvector((f32x2){a, b}, bf16x2v); return __builtin_bit_cast(unsigned, t); }
constexpr int AT_KP = 144, AT_VP1 = 648, AT_VP2 = 520, AT_VOFF = 320 * AT_KP;
template <bool MASKED>
__device__ __forceinline__ void attn_tile(const LAS unsigned char* Ks, const LAS unsigned char* Vs, const int vpitch, const int kl_base, const bf16x8 (&qf)[4], f32x16& o0, f32x16& o1, float& m, float& l,
                                          const int r, const int h, const int kj0, const int qi) {
    f32x16 x;
#pragma unroll
    for (int i = 0; i < 16; ++i) x[i] = 0.f;
#pragma unroll
    for (int s = 0; s < 4; ++s) { const bf16x8 kf = *(const LAS bf16x8*)(Ks + (kl_base + r) * AT_KP + (16 * s + 8 * h) * 2); x = __builtin_amdgcn_mfma_f32_32x32x16_bf16(kf, qf[s], x, 0, 0, 0); }
    float sc[16]; float mt = -1e30f;
#pragma unroll
    for (int i = 0; i < 16; ++i) { float v = x[i] * 0.125f;
        if (MASKED) { const int kj = kj0 + (i & 3) + 8 * (i >> 2) + 4 * h; const bool ok = (kj >= 0) && (kj < SEQ) && (kj - qi <= 128) && (qi - kj <= 128); v = ok ? v : -1e30f; }
        sc[i] = v; mt = fmaxf(mt, v); }
    mt = fmaxf(mt, __shfl_xor(mt, 32));
    const float mn = fmaxf(m, mt), alpha = __expf(m - mn); m = mn;
    float ps = 0.f;
#pragma unroll
    for (int i = 0; i < 16; ++i) { sc[i] = __expf(sc[i] - mn); ps += sc[i]; }
    l = l * alpha + ps;
    if (__any(alpha != 1.0f)) {
#pragma unroll
        for (int i = 0; i < 16; ++i) { o0[i] *= alpha; o1[i] *= alpha; } }
#pragma unroll
    for (int s2 = 0; s2 < 2; ++s2) {
        v4u pw; pw.x = pk_bf16(sc[8 * s2 + 0], sc[8 * s2 + 1]); pw.y = pk_bf16(sc[8 * s2 + 2], sc[8 * s2 + 3]); pw.z = pk_bf16(sc[8 * s2 + 4], sc[8 * s2 + 5]); pw.w = pk_bf16(sc[8 * s2 + 6], sc[8 * s2 + 7]);
        const bf16x8 pk = __builtin_bit_cast(bf16x8, pw);
        { const LAS unsigned char* vp = Vs + r * vpitch + (kl_base + 16 * s2 + 4 * h) * 2; const v2u lo = *(const LAS v2u*)vp, hi = *(const LAS v2u*)(vp + 16);
          v4u vw; vw.x = lo.x; vw.y = lo.y; vw.z = hi.x; vw.w = hi.y; o0 = __builtin_amdgcn_mfma_f32_32x32x16_bf16(__builtin_bit_cast(bf16x8, vw), pk, o0, 0, 0, 0); }
        { const LAS unsigned char* vp = Vs + (32 + r) * vpitch + (kl_base + 16 * s2 + 4 * h) * 2; const v2u lo = *(const LAS v2u*)vp, hi = *(const LAS v2u*)(vp + 16);
          v4u vw; vw.x = lo.x; vw.y = lo.y; vw.z = hi.x; vw.w = hi.y; o1 = __builtin_amdgcn_mfma_f32_32x32x16_bf16(__builtin_bit_cast(bf16x8, vw), pk, o1, 0, 0, 0); }
    }
}
PHASE_FN ph_e3_attn(PP pp, int layer) {
    FRAME();
    const bf16* QKV = (const bf16*)(ws + WS_BIG + BIG_QKV); bf16* MIX = (bf16*)(ws + WS_BIG + BIG_MIX); const bf16* VT = (const bf16*)(ws + WS_BIG + BIG_VT);
    const float* sinkp = PIN(I_EV_SINK) + (layer >> 1) * 8;
    LAS unsigned char* Ks = F.lds; LAS unsigned char* Vs = F.lds + AT_VOFF;
    const int r = F.lane & 31, h = F.lane >> 5, g = F.wave >> 1, th = F.wave & 1;
    for (int u = F.bid; u < 2048 + 128; u += F.G) {
        const bool isc = u >= 2048;
        int b, hkv, qb; if (!isc) { b = u >> 7; hkv = (u >> 6) & 1; qb = u & 63; } else { const int v = u - 2048; b = v >> 3; hkv = (v >> 2) & 1; qb = v & 3; }
        const int n0 = qb * 64, bh = b * 2 + hkv;
        const size_t qrow = isc ? ((size_t)TL + (size_t)b * 256 + n0 + 32 * th + r) : ((size_t)b * 4096 + n0 + 32 * th + r);
        bf16x8 qf[4];
#pragma unroll
        for (int s = 0; s < 4; ++s) qf[s] = *(const bf16x8*)(QKV + qrow * 768 + (hkv * 4 + g) * 64 + 16 * s + 8 * h);
        float m = sinkp[hkv * 4 + g], l = (h == 0) ? 1.0f : 0.0f;
        f32x16 o0, o1;
#pragma unroll
        for (int i = 0; i < 16; ++i) { o0[i] = 0.f; o1[i] = 0.f; }
        __syncthreads();
        if (!isc) {
            for (int pc = F.tid; pc < 2560; pc += NTHREADS) { const int kl = pc >> 3, c8 = pc & 7, kj = n0 - 128 + kl;
                v4u v = (v4u){0u, 0u, 0u, 0u}; if (kj >= 0 && kj < SEQ) v = *(const v4u*)(QKV + ((size_t)b * 4096 + kj) * 768 + 512 + hkv * 64 + c8 * 8);
                *(LAS v4u*)(Ks + kl * AT_KP + c8 * 16) = v; }
            for (int pc = F.tid; pc < 2560; pc += NTHREADS) { const int d = pc / 40, c = pc - d * 40, kj = n0 - 128 + c * 8;
                v4u v = (v4u){0u, 0u, 0u, 0u}; if (kj >= 0 && kj < SEQ) v = *(const v4u*)(VT + ((size_t)bh * 64 + d) * 4352 + 256 + kj);
                LAS v2u* dst = (LAS v2u*)(Vs + d * AT_VP1 + c * 16); dst[0] = (v2u){v.x, v.y}; dst[1] = (v2u){v.z, v.w}; }
            __syncthreads();
            const int qi = n0 + 32 * th + r;
#pragma unroll 1
            for (int t = 0; t < 9; ++t) { const int klb = 32 * th + 32 * t, kj0 = n0 - 128 + klb;
                if (t >= 1 && t <= 7 && kj0 >= 0 && kj0 + 31 < SEQ) attn_tile<false>(Ks, Vs, AT_VP1, klb, qf, o0, o1, m, l, r, h, 0, 0);
                else attn_tile<true>(Ks, Vs, AT_VP1, klb, qf, o0, o1, m, l, r, h, kj0, qi); }
            __syncthreads();
        }
        for (int pc = F.tid; pc < 2048; pc += NTHREADS) { const int j = pc >> 3, c8 = pc & 7;
            *(LAS v4u*)(Ks + j * AT_KP + c8 * 16) = *(const v4u*)(QKV + ((size_t)TL + (size_t)b * 256 + j) * 768 + 512 + hkv * 64 + c8 * 8); }
        for (int pc = F.tid; pc < 2048; pc += NTHREADS) { const int d = pc >> 5, c = pc & 31; const v4u v = *(const v4u*)(VT + ((size_t)bh * 64 + d) * 4352 + c * 8);
            LAS v2u* dst = (LAS v2u*)(Vs + d * AT_VP2 + c * 16); dst[0] = (v2u){v.x, v.y}; dst[1] = (v2u){v.z, v.w}; }
        __syncthreads();
#pragma unroll 1
        for (int t = 0; t < 8; ++t) attn_tile<false>(Ks, Vs, AT_VP2, 32 * t, qf, o0, o1, m, l, r, h, 0, 0);
        const float inv = 1.0f / (l + __shfl_xor(l, 32));
        bf16* orow = MIX + qrow * D + 512 + (hkv * 4 + g) * 64 + 4 * h;
#pragma unroll
        for (int q4 = 0; q4 < 4; ++q4) {
            v2u w0; w0.x = pk_bf16(o0[4 * q4 + 0] * inv, o0[4 * q4 + 1] * inv); w0.y = pk_bf16(o0[4 * q4 + 2] * inv, o0[4 * q4 + 3] * inv); *(v2u*)(orow + 8 * q4) = w0;
            v2u w1; w1.x = pk_bf16(o1[4 * q4 + 0] * inv, o1[4 * q4 + 1] * inv); w1.y = pk_bf16(o1[4 * q4 + 2] * inv, o1[4 * q4 + 3] * inv); *(v2u*)(orow + 32 + 8 * q4) = w1;
        }
    }
    __syncthreads();
}
PHASE_FN ph_outproj(PP pp, int layer) {
    FRAME();
    const int li = layer >> 1; const bool odd = (layer & 1) != 0;
    const int TR = (layer == DEPTH - 1) ? TL : T;
    const char* W = odd ? (const char*)(ws + WS_OD + li * OD_STRIDE + OD_WOUT) : (const char*)(ws + WS_EV + li * EV_STRIDE + EV_WOUT);
    float* XC = (float*)(ws + WS_XC); float* out = (float*)pp->out;
    const float* xl_src = (layer == 0) ? PIN(I_X) : out; const float* xc_src = (layer == 0) ? PIN(I_CTX) : XC;
    const float* modl = (const float*)(ws + WS_MOD) + (size_t)layer * 17 * 6144;
    SchedResid S{F.G, F.bid, (TR / 256) * 4, (const char*)(ws + WS_BIG + BIG_MIX), (size_t)256 * D * 2, W, (size_t)256 * D * 2, xl_src, xc_src, out, XC, modl + 2048};
    pg8::EpiResidLN E{PIN(I_LNG) + (size_t)(layer * 2) * D, PIN(I_LNB) + (size_t)(layer * 2) * D, 2048, 1024, (bf16*)(ws + WS_H), F.ctl + CW_LN + (layer * 2) * LN_SITE_WORDS,
                      (unsigned long long*)(ws + WS_XS), F.ctl + 2, F.lds + LDS_LNTAB};
    pg8::gemm_phase<pg8::EpiResidLN, SchedResid, true, true>(F.lds, F.tid, pg8::Dims{D, D, D}, S, E);
}
PHASE_FN ph_e6(PP pp, int layer) {
    FRAME();
    unsigned char* evw = ws + WS_EV + (layer >> 1) * EV_STRIDE;
    SchedStd S{22, (T / 256) * 22, F.G, F.bid, (const char*)(ws + WS_H), (const char*)(evw + EV_W13), (char*)(ws + WS_BIG + BIG_HID), (size_t)256 * D * 2, (size_t)256 * D * 2, (size_t)256 * FFH * 2, (size_t)128 * 2, FFH, 1 << 30};
    pg8::gemm_phase<pg8::EpiSwiGLU, SchedStd, true, true>(F.lds, F.tid, pg8::Dims{D, D, D}, S, pg8::EpiSwiGLU{});
}
PHASE_FN ph_e7(PP pp, int layer) {
    FRAME();
    unsigned char* evw = ws + WS_EV + (layer >> 1) * EV_STRIDE;
    float* XC = (float*)(ws + WS_XC); float* out = (float*)pp->out;
    const float* modl = (const float*)(ws + WS_MOD) + (size_t)layer * 17 * 6144;
    SchedResid S{F.G, F.bid, (T / 256) * 4, (const char*)(ws + WS_BIG + BIG_HID), (size_t)256 * FFH * 2, (const char*)(evw + EV_W2), (size_t)256 * FFH * 2, out, XC, out, XC, modl + 5120};
    pg8::EpiResidLN E{PIN(I_LNG) + (size_t)(layer * 2 + 1) * D, PIN(I_LNB) + (size_t)(layer * 2 + 1) * D, 17 * 6144 + 1024 - 5120, 17 * 6144 - 5120, (bf16*)(ws + WS_H), F.ctl + CW_LN + (layer * 2 + 1) * LN_SITE_WORDS,
                      (unsigned long long*)(ws + WS_XS), F.ctl + 2, F.lds + LDS_LNTAB};
    pg8::gemm_phase<pg8::EpiResidLN, SchedResid, true, true>(F.lds, F.tid, pg8::Dims{FFH, FFH, FFH}, S, E);
}

PHASE_FN ph_o1(PP pp, int layer) {
    FRAME();
    unsigned char* odw = ws + WS_OD + (layer >> 1) * OD_STRIDE;
    SchedStd S{6, (T / 256) * 6, F.G, F.bid, (const char*)(ws + WS_H), (const char*)(odw + OD_WIN), (char*)(ws + WS_BIG + BIG_P), (size_t)256 * D * 2, (size_t)256 * D * 2, (size_t)256 * 1536 * 2, (size_t)256 * 2, 1536, 2};
    pg8::gemm_phase<pg8::EpiStore, SchedStd, true, true>(F.lds, F.tid, pg8::Dims{D, D, D}, S, pg8::EpiStore{});
}
PHASE_FN ph_o2_s5a(PP pp, int layer) {
    FRAME();
    const int li = layer >> 1;
    SchedS5A S{F.G, F.bid, (const char*)(ws + WS_BIG + BIG_P), (const char*)(ws + WS_S5M + (size_t)li * 32 * S5M_STRIDE), (char*)(ws + WS_H + 68 * MiB), (char*)(ws + WS_H)};
    pg8::gemm_phase<pg8::EpiStore, SchedS5A, true, true, pg8::AMapS5>(F.lds, F.tid, pg8::Dims{256, 0, 256}, S, pg8::EpiStore{}, pg8::AMapS5{});
}
PHASE_FN ph_o2_scan(PP pp, int layer) {
    FRAME();
    const int li = layer >> 1;
    if (F.tid < 256) {
        const int t = F.bid * 256 + F.tid;
        if (t < NBATCH * 32 * 2 * 64) {
            const int pl = t & 63, d = (t >> 6) & 1, g = (t >> 7) & 31, b = t >> 12;
            const int sidx = ((li * 2 + d) * 32 + g);
            const float are = PIN(I_A_RE)[sidx * 64 + pl], aim = PIN(I_A_IM)[sidx * 64 + pl], dt = expf(PIN(I_LOG_DT)[sidx]);
            const float mag = expf(16.0f * are * dt); float sn, cn; sincosf(16.0f * aim * dt, &sn, &cn);
            const float lre = mag * cn, lim = mag * sn;
            unsigned* HB = (unsigned*)(ws + WS_H) + (g * 256 + d * 128 + pl * 2) / 2;
            float cre = 0.f, cim = 0.f;
#define S5_CROW(k_) ((k_) < 16 ? (4096 + b * 16 + (d ? 15 - (k_) : (k_))) : (b * 256 + (d ? 255 - ((k_) - 16) : ((k_) - 16))))
            for (int k0 = 0; k0 < 272; k0 += 8) {
                unsigned w[8];
#pragma unroll
                for (int j = 0; j < 8; ++j) w[j] = HB[(size_t)S5_CROW(k0 + j) * 4096];
#pragma unroll
                for (int j = 0; j < 8; ++j) { HB[(size_t)S5_CROW(k0 + j) * 4096] = cvt_pk_bf16(cre, cim);
                    const float sr = bflo(w[j]), si = bfhi(w[j]); const float nr = lre * cre - lim * cim + sr, ni = lre * cim + lim * cre + si; cre = nr; cim = ni; }
            }
#undef S5_CROW
        }
    }
}
PHASE_FN ph_o3(PP pp, int layer) {
    FRAME();
    const int li = layer >> 1;
    SchedS5B S{F.G, F.bid, (const char*)(ws + WS_H), (const char*)(ws + WS_S5M + (size_t)li * 32 * S5M_STRIDE + 256 * 1024), (const char*)(ws + WS_H + 68 * MiB), (char*)(ws + WS_BIG + BIG_P)};
    pg8::gemm_phase<pg8::EpiS5B, SchedS5B, true, true>(F.lds, F.tid, pg8::Dims{256, 8192, 256}, S, pg8::EpiS5B{});
}
PHASE_FN ph_o2_gmlp(PP pp, int layer) {
    FRAME();
    const int li = layer >> 1; const int TR = (layer == DEPTH - 1) ? TL : T;
    const bf16* P = (const bf16*)(ws + WS_BIG + BIG_P); bf16* MIX = (bf16*)(ws + WS_BIG + BIG_MIX);
    constexpr int GP = 272;
    LAS unsigned char* Vt = F.lds;
    LAS unsigned char* Wt = F.lds + 128 * GP;
    LAS f32x2* stt = (LAS f32x2*)(F.lds + 2 * 128 * GP);
    const float* ws_w = PIN(I_WS) + (size_t)li * 4 * 128 * 128; const float* bs = PIN(I_BS) + (size_t)li * 4 * 128;
    const int r = F.lane & 31, hh = F.lane >> 5, et = F.wave >> 1, it0 = (F.wave & 1) * 2;
    const int nunits = (TR / 128) * 4;
    for (int u = F.bid; u < nunits; u += F.G) {
        const int ch = u >> 2, h = u & 3; const size_t row0 = (size_t)ch * 128;
        __syncthreads();
#pragma unroll 4
        for (int t = 0; t < 16; ++t) { const int j = F.wave * 16 + t; const v4u w = *(const v4u*)(P + (row0 + j) * 1536 + 1024 + F.lane * 8);
            const float f[8] = {bflo(w.x), bfhi(w.x), bflo(w.y), bfhi(w.y), bflo(w.z), bfhi(w.z), bflo(w.w), bfhi(w.w)};
            float sm = 0.f;
#pragma unroll
            for (int q = 0; q < 8; ++q) sm += f[q];
            const float mu = wave_sum(sm) * (1.f / 512.f); float qv = 0.f;
#pragma unroll
            for (int q = 0; q < 8; ++q) qv += (f[q] - mu) * (f[q] - mu);
            const float rs = rsqrtf(wave_sum(qv) * (1.f / 512.f) + LN_EPS);
            if (F.lane == 0) stt[j] = (f32x2){mu, rs}; }
        for (int pc = F.tid; pc < 2048; pc += NTHREADS) { const int i = pc >> 4, j8 = (pc & 15) * 8; const float* wp = ws_w + (size_t)h * 16384 + i * 128 + j8;
            const f32x4 a = *(const f32x4*)wp, b = *(const f32x4*)(wp + 4);
            v4u o; o.x = cvt_pk_bf16(a[0], a[1]); o.y = cvt_pk_bf16(a[2], a[3]); o.z = cvt_pk_bf16(b[0], b[1]); o.w = cvt_pk_bf16(b[2], b[3]);
            *(LAS v4u*)(Wt + i * GP + j8 * 2) = o; }
        __syncthreads();
        for (int pc = F.tid; pc < 2048; pc += NTHREADS) { const int eg = pc >> 7, j = pc & 127; const v4u w = *(const v4u*)(P + (row0 + j) * 1536 + 1024 + h * 128 + eg * 8);
            const f32x2 ms = stt[j];
            const float f[8] = {bflo(w.x), bfhi(w.x), bflo(w.y), bfhi(w.y), bflo(w.z), bfhi(w.z), bflo(w.w), bfhi(w.w)};
#pragma unroll
            for (int q = 0; q < 8; q += 2) { const unsigned pkd = cvt_pk_bf16((f[q] - ms.x) * ms.y, (f[q + 1] - ms.x) * ms.y);
                *(LAS unsigned short*)(Vt + (eg * 8 + q) * GP + j * 2) = (unsigned short)(pkd & 0xffffu); *(LAS unsigned short*)(Vt + (eg * 8 + q + 1) * GP + j * 2) = (unsigned short)(pkd >> 16); } }
        __syncthreads();
        f32x16 acc0, acc1;
#pragma unroll
        for (int q = 0; q < 16; ++q) { acc0[q] = 0.f; acc1[q] = 0.f; }
#pragma unroll
        for (int sk = 0; sk < 8; ++sk) {
            const bf16x8 a = *(const LAS bf16x8*)(Vt + (et * 32 + r) * GP + (16 * sk + 8 * hh) * 2);
            const bf16x8 b0 = *(const LAS bf16x8*)(Wt + (it0 * 32 + r) * GP + (16 * sk + 8 * hh) * 2), b1 = *(const LAS bf16x8*)(Wt + ((it0 + 1) * 32 + r) * GP + (16 * sk + 8 * hh) * 2);
            acc0 = __builtin_amdgcn_mfma_f32_32x32x16_bf16(a, b0, acc0, 0, 0, 0); acc1 = __builtin_amdgcn_mfma_f32_32x32x16_bf16(a, b1, acc1, 0, 0, 0);
        }
#pragma unroll
        for (int t = 0; t < 2; ++t) { const int i = (it0 + t) * 32 + r; const float bb = bs[h * 128 + i];
            const bf16* up = P + (row0 + i) * 1536 + 512 + h * 128 + et * 32 + 4 * hh; bf16* op = MIX + (row0 + i) * D + 512 + h * 128 + et * 32 + 4 * hh;
#pragma unroll
            for (int q4 = 0; q4 < 4; ++q4) { const v2u uw = *(const v2u*)(up + 8 * q4);
                const float a0 = (t ? acc1[4 * q4 + 0] : acc0[4 * q4 + 0]) + bb, a1 = (t ? acc1[4 * q4 + 1] : acc0[4 * q4 + 1]) + bb, a2 = (t ? acc1[4 * q4 + 2] : acc0[4 * q4 + 2]) + bb, a3 = (t ? acc1[4 * q4 + 3] : acc0[4 * q4 + 3]) + bb;
                v2u o; o.x = cvt_pk_bf16(bflo(uw.x) * a0, bfhi(uw.x) * a1); o.y = cvt_pk_bf16(bflo(uw.y) * a2, bfhi(uw.y) * a3);
                *(v2u*)(op + 8 * q4) = o; } }
    }
    __syncthreads();
}
PHASE_FN ph_o4(PP pp, int layer) {
    FRAME();
    const int li = layer >> 1;
    unsigned char* odw = ws + WS_OD + li * OD_STRIDE;
    SchedGlu S{F.G, F.bid, (const char*)(ws + WS_BIG + BIG_P), (const char*)(odw + OD_WGLU), (char*)(ws + WS_BIG + BIG_MIX), PIN(I_BGLU) + (size_t)li * 512};
    pg8::gemm_phase<pg8::EpiGLU, SchedGlu, true, true>(F.lds, F.tid, pg8::Dims{512, 1536, 512}, S, pg8::EpiGLU{});
}
PHASE_FN ph_o6(PP pp, int layer) {
    FRAME();
    const int li = layer >> 1; const int TR = (layer == DEPTH - 1) ? TL : T;
    const bf16* Hb = (const bf16*)(ws + WS_H);
    int* tokE = (int*)(ws + WS_TOK); int* tokS0 = tokE + T; int* tokS1 = tokS0 + T; float* tokG0 = (float*)(tokS1 + T);
    unsigned* ecnt = F.ctl + CW_CNT + li * 64;
    LAS float* wr_s = (LAS float*)F.lds;
    LAS unsigned* lcnt = (LAS unsigned*)(F.lds + 32768);
    const float* rw = PIN(I_ROUTER) + (size_t)li * D * 8;
    __syncthreads();
    for (int e = F.tid; e < D * 8; e += NTHREADS) wr_s[e] = rw[e];
    if (F.tid < 16) lcnt[F.tid] = 0u;
    __syncthreads();
    for (int r = F.gw; r < TR; r += F.NGW) {
        const v4u* src = (const v4u*)(Hb + (size_t)r * D) + 2 * F.lane;
        const v4u a = src[0], b = src[1];
        const float hv[16] = {bflo(a.x), bfhi(a.x), bflo(a.y), bfhi(a.y), bflo(a.z), bfhi(a.z), bflo(a.w), bfhi(a.w), bflo(b.x), bfhi(b.x), bflo(b.y), bfhi(b.y), bflo(b.z), bfhi(b.z), bflo(b.w), bfhi(b.w)};
        float lg[8];
#pragma unroll
        for (int e = 0; e < 8; ++e) lg[e] = 0.f;
#pragma unroll
        for (int q = 0; q < 16; ++q) { const int col = 16 * F.lane + q; const f32x4 w0 = *(const LAS f32x4*)(wr_s + col * 8), w1 = *(const LAS f32x4*)(wr_s + col * 8 + 4);
            lg[0] += hv[q] * w0[0]; lg[1] += hv[q] * w0[1]; lg[2] += hv[q] * w0[2]; lg[3] += hv[q] * w0[3]; lg[4] += hv[q] * w1[0]; lg[5] += hv[q] * w1[1]; lg[6] += hv[q] * w1[2]; lg[7] += hv[q] * w1[3]; }
#pragma unroll
        for (int e = 0; e < 8; ++e) lg[e] = wave_sum(lg[e]);
        if (F.lane == 0) {
            int e0 = 0; float v0 = lg[0];
#pragma unroll
            for (int e = 1; e < 8; ++e) if (lg[e] > v0) { v0 = lg[e]; e0 = e; }
            int e1 = -1; float v1 = -3.0e38f;
#pragma unroll
            for (int e = 0; e < 8; ++e) if (e != e0 && lg[e] > v1) { v1 = lg[e]; e1 = e; }
            const float w0 = 1.0f / (1.0f + __expf(v1 - v0));
            const int s0 = (int)__hip_atomic_fetch_add(lcnt + e0, 1u, __ATOMIC_RELAXED, __HIP_MEMORY_SCOPE_WORKGROUP), s1 = (int)__hip_atomic_fetch_add(lcnt + e1, 1u, __ATOMIC_RELAXED, __HIP_MEMORY_SCOPE_WORKGROUP);
            tokE[r] = e0 | (e1 << 8); tokS0[r] = s0; tokS1[r] = s1; tokG0[r] = w0;
        }
    }
    __syncthreads();
    if (F.tid < 8) lcnt[8 + F.tid] = atomicAdd(ecnt + F.tid, lcnt[F.tid]);
    VM_WAIT();
    __syncthreads();
    { const int r = F.gw + F.lane * F.NGW;
      if (r < TR) { const int ee = tokE[r]; tokS0[r] += (int)lcnt[8 + (ee & 255)]; tokS1[r] += (int)lcnt[8 + (ee >> 8)]; } }
    __syncthreads();
}
PHASE_FN ph_o7(PP pp, int layer) {
    FRAME();
    const int li = layer >> 1; const int TR = (layer == DEPTH - 1) ? TL : T;
    const bf16* Hb = (const bf16*)(ws + WS_H); unsigned char* HSQ = ws + WS_BIG + BIG_HSQ;
    int* tokE = (int*)(ws + WS_TOK); int* tokS0 = tokE + T; int* tokS1 = tokS0 + T; int* tokP0 = tokS1 + 2 * T; int* tokP1 = tokP0 + T;
    unsigned* ecnt = F.ctl + CW_CNT + li * 64;
    int roff[8]; { int acc = 0;
#pragma unroll
        for (int e = 0; e < 8; ++e) { roff[e] = acc * 256; acc += (__builtin_amdgcn_readfirstlane((int)__hip_atomic_load(ecnt + e, __ATOMIC_RELAXED, __HIP_MEMORY_SCOPE_AGENT)) + 255) >> 8; } }
    for (int r = F.gw; r < TR; r += F.NGW) {
        const int ee = tokE[r], e0 = ee & 255, e1 = ee >> 8;
        int p0 = tokS0[r], p1 = tokS1[r];
#pragma unroll
        for (int e = 0; e < 8; ++e) { p0 += (e == e0) ? roff[e] : 0; p1 += (e == e1) ? roff[e] : 0; }
        const v4u* src = (const v4u*)(Hb + (size_t)r * D) + 2 * F.lane;
        const v4u a = src[0], b = src[1];
        v4u q; q.x = pk_fp8x4(bflo(a.x) * Q_H, bfhi(a.x) * Q_H, bflo(a.y) * Q_H, bfhi(a.y) * Q_H); q.y = pk_fp8x4(bflo(a.z) * Q_H, bfhi(a.z) * Q_H, bflo(a.w) * Q_H, bfhi(a.w) * Q_H);
        q.z = pk_fp8x4(bflo(b.x) * Q_H, bfhi(b.x) * Q_H, bflo(b.y) * Q_H, bfhi(b.y) * Q_H); q.w = pk_fp8x4(bflo(b.z) * Q_H, bfhi(b.z) * Q_H, bflo(b.w) * Q_H, bfhi(b.w) * Q_H);
        *((v4u*)(HSQ + (size_t)p0 * D) + F.lane) = q; *((v4u*)(HSQ + (size_t)p1 * D) + F.lane) = q;
        if (F.lane == 0) { tokP0[r] = p0; tokP1[r] = p1; }
    }
}
PHASE_FN ph_moe_up(PP pp, int layer, int chn) {
    FRAME();
    const int li = layer >> 1; unsigned char* odw = ws + WS_OD + li * OD_STRIDE; unsigned* ecnt = F.ctl + CW_CNT + li * 64;
    SchedMoeUp S; S.G = F.G; S.c = F.bid; S.rt0 = chn * MOE_CHUNK_TILES; S.HS = (const char*)(ws + WS_BIG + BIG_HSQ); S.W = (const char*)(odw + OD_MW13); S.HID = (char*)(ws + WS_H);
    { int acc = 0; S.toff[0] = 0;
#pragma unroll
        for (int e = 0; e < 8; ++e) { acc += (__builtin_amdgcn_readfirstlane((int)__hip_atomic_load(ecnt + e, __ATOMIC_RELAXED, __HIP_MEMORY_SCOPE_AGENT)) + 255) >> 8; S.toff[e + 1] = acc; } }
    int nt_ = S.toff[8] - S.rt0; nt_ = nt_ < 0 ? 0 : (nt_ > MOE_CHUNK_TILES ? MOE_CHUNK_TILES : nt_); S.nUnits = nt_ * 28;
    pg8::gemm_phase<pg8::EpiSwiGLU8, SchedMoeUp, true, true, pg8::AMapStd, true>(F.lds, F.tid, pg8::Dims{D, D, D}, S, pg8::EpiSwiGLU8{});
}
PHASE_FN ph_moe_down(PP pp, int layer, int chn) {
    FRAME();
    const int li = layer >> 1; unsigned char* odw = ws + WS_OD + li * OD_STRIDE; unsigned* ecnt = F.ctl + CW_CNT + li * 64;
    SchedMoeDown S; S.G = F.G; S.c = F.bid; S.rt0 = chn * MOE_CHUNK_TILES; S.HID = (const char*)(ws + WS_H); S.W = (const char*)(odw + OD_MW2); S.Y = (char*)(ws + WS_BIG + BIG_Y);
    { int acc = 0; S.toff[0] = 0;
#pragma unroll
        for (int e = 0; e < 8; ++e) { acc += (__builtin_amdgcn_readfirstlane((int)__hip_atomic_load(ecnt + e, __ATOMIC_RELAXED, __HIP_MEMORY_SCOPE_AGENT)) + 255) >> 8; S.toff[e + 1] = acc; } }
    int nt_ = S.toff[8] - S.rt0; nt_ = nt_ < 0 ? 0 : (nt_ > MOE_CHUNK_TILES ? MOE_CHUNK_TILES : nt_); S.nUnits = nt_ * 4;
    pg8::gemm_phase<pg8::EpiStoreQ, SchedMoeDown, true, true, pg8::AMapStd, true>(F.lds, F.tid, pg8::Dims{EH, EH, EH}, S, pg8::EpiStoreQ{});
}
PHASE_FN ph_o9(PP pp, int layer) {
    FRAME();
    const int TR = (layer == DEPTH - 1) ? TL : T; const bool last = layer == DEPTH - 1;
    float* XC = (float*)(ws + WS_XC); float* out = (float*)pp->out; bf16* Hb = (bf16*)(ws + WS_H); const bf16* HS = (const bf16*)(ws + WS_BIG + BIG_Y);
    const float* modl = (const float*)(ws + WS_MOD) + (size_t)layer * 17 * 6144;
    const float* modn = (const float*)(ws + WS_MOD) + (size_t)(last ? layer : layer + 1) * 17 * 6144;
    const float* lng1 = PIN(I_LNG) + (size_t)(layer * 2 + 1) * D; const float* lnb1 = PIN(I_LNB) + (size_t)(layer * 2 + 1) * D;
    const int* tokE = (const int*)(ws + WS_TOK); const float* tokG0 = (const float*)(tokE + 3 * T); const int* tokP0 = tokE + 4 * T; const int* tokP1 = tokP0 + T;
    f32x4 gg9[4], bb9[4];
#pragma unroll
    for (int j = 0; j < 4; ++j) { gg9[j] = *(const f32x4*)(lng1 + 256 * j + 4 * F.lane); bb9[j] = *(const f32x4*)(lnb1 + 256 * j + 4 * F.lane); }
    for (int r = F.gw; r < TR; r += F.NGW) {
        const bool isc = r >= TL; float* xr = isc ? XC + (size_t)(r - TL) * D : out + (size_t)r * D;
        const int mrow = isc ? 16 : (r >> 12);
        const float* g2 = modl + (size_t)mrow * 6144 + 5120;
        const int p0 = tokP0[r], p1 = tokP1[r]; const float w0 = tokG0[r], w1 = 1.0f - w0;
        const bf16* y0 = HS + (size_t)p0 * D; const bf16* y1 = HS + (size_t)p1 * D;
        f32x4 v[4], h[4]; row_load(xr, F.lane, v);
#pragma unroll
        for (int j = 0; j < 4; ++j) { const v2u a = *(const v2u*)(y0 + 256 * j + 4 * F.lane), b = *(const v2u*)(y1 + 256 * j + 4 * F.lane); const f32x4 gg = *(const f32x4*)(g2 + 256 * j + 4 * F.lane);
            f32x4 f; f[0] = w0 * bflo(a.x) + w1 * bflo(b.x); f[1] = w0 * bfhi(a.x) + w1 * bfhi(b.x); f[2] = w0 * bflo(a.y) + w1 * bflo(b.y); f[3] = w0 * bfhi(a.y) + w1 * bfhi(b.y);
            v[j] = v[j] * ALPHA + gg * f; }
        row_ln_pre(v, gg9, bb9); row_store(xr, F.lane, v);
        if (!last) { const float* m = modn + (size_t)mrow * 6144; row_modulate(h, v, m + 1024, m, F.lane); row_store_bf16(Hb + (size_t)r * D, F.lane, h); }
    }
}

#if MK_SPLIT
#define PHASE_END() do { ++ph; } while (0)
#else
#define PHASE_END() do { if (ph >= lo && ph + 1 < hi) grid_bar(pp); ++ph; } while (0)
#endif
#define PHASE_ON() (ph >= lo && ph < hi)
static __device__ __forceinline__ void even_layer(PP pp, const int layer, const int lo, const int hi, int& ph) {
    if (PHASE_ON()) ph_e1(pp, layer);
    PHASE_END();
    if (PHASE_ON()) { ph_e2_fft(pp); ph_e2_rope(pp); }
    PHASE_END();
    if (PHASE_ON()) { ph_e2_dft(pp); ph_e3_attn(pp, layer); }
    PHASE_END();
    if (PHASE_ON()) ph_outproj(pp, layer);
    PHASE_END();
    if (PHASE_ON()) ph_e6(pp, layer);
    PHASE_END();
    if (PHASE_ON()) ph_e7(pp, layer);
    PHASE_END();
}
static __device__ __forceinline__ void odd_layer(PP pp, const int layer, const int lo, const int hi, int& ph) {
    if (PHASE_ON()) ph_o1(pp, layer);
    PHASE_END();
    if (PHASE_ON()) { ph_o2_s5a(pp, layer); ph_o2_gmlp(pp, layer); }
    PHASE_END();
    if (PHASE_ON()) ph_o2_scan(pp, layer);
    PHASE_END();
    if (PHASE_ON()) ph_o3(pp, layer);
    PHASE_END();
    if (PHASE_ON()) ph_o4(pp, layer);
    PHASE_END();
    if (PHASE_ON()) ph_outproj(pp, layer);
    PHASE_END();
    if (PHASE_ON()) ph_o6(pp, layer);
    PHASE_END();
    if (PHASE_ON()) ph_o7(pp, layer);
    PHASE_END();
#define MOE_CHUNK(chn) do { if (PHASE_ON()) ph_moe_up(pp, layer, chn); PHASE_END(); if (PHASE_ON()) ph_moe_down(pp, layer, chn); PHASE_END(); } while (0)
    static_assert(MOE_NCHUNK == 5, "the chunk sites are written out: no loop around GEMM phase sites");
    MOE_CHUNK(0); MOE_CHUNK(1); MOE_CHUNK(2); MOE_CHUNK(3); MOE_CHUNK(4);
#undef MOE_CHUNK
    if (PHASE_ON()) ph_o9(pp, layer);
    PHASE_END();
}
constexpr int N_PHASES = 2 + 2 * (6 + 9 + 2 * MOE_NCHUNK);
__global__ void __launch_bounds__(NTHREADS, 2) fwd_kernel(Params p_unused) {
    DECL_LDS;
    PP pp = (PP)__builtin_amdgcn_kernarg_segment_ptr();
    {
        LAS unsigned char* lds = (LAS unsigned char*)lds_raw;
        for (int u = threadIdx.x; u < (LDS_BYTES - LDS_RING) / 4; u += NTHREADS) ((LAS unsigned*)(lds + LDS_RING))[u] = 0u;
        __syncthreads();
#if !MK_SPLIT
        (void)xcd_barrier_post((unsigned*)((unsigned char*)pp->ws + WS_CTL) + CW_BAR, (volatile LAS unsigned*)(lds + LDS_MISC) + 8);
#endif
    }
#if MK_SPLIT
    const int lo = pp->ph_lo, hi = pp->ph_hi;
#else
    constexpr int lo = 0, hi = N_PHASES;
#endif
    int ph = 0;

    if (PHASE_ON()) { ph_fold(pp); ph_mod(pp); ph_s5mat(pp); ph_cvt(pp); ph_dftmat(pp); }
    PHASE_END();
    if (PHASE_ON()) ph_pro_b(pp);
    PHASE_END();
    even_layer(pp, 0, lo, hi, ph);
    odd_layer(pp, 1, lo, hi, ph);
    even_layer(pp, 2, lo, hi, ph);
    odd_layer(pp, 3, lo, hi, ph);
}

extern "C" void kernel_launch(void* const* d_in, const int* in_sizes, int n_in, void* d_out, int out_size, void* d_ws, size_t ws_size, hipStream_t stream) {
    static int grid = 0;
    if (grid == 0) {
        if (n_in != 32 || out_size != TL * D || ws_size < WS_END) { fprintf(stderr, "kernel_launch: unexpected shapes (n_in %d, out %d, ws %zu < %zu)\n", n_in, out_size, ws_size, (size_t)WS_END); grid = -1; return; }
        int dev = 0, cus = 0, per_cu = 0;
        if (hipGetDevice(&dev) != hipSuccess || hipDeviceGetAttribute(&cus, hipDeviceAttributeMultiprocessorCount, dev) != hipSuccess) { grid = -1; return; }
        if (hipFuncSetAttribute((const void*)fwd_kernel, hipFuncAttributeMaxDynamicSharedMemorySize, LDS_BYTES) != hipSuccess) { fprintf(stderr, "kernel_launch: hipFuncSetAttribute failed\n"); grid = -1; return; }
        if (hipOccupancyMaxActiveBlocksPerMultiprocessor(&per_cu, (const void*)fwd_kernel, NTHREADS, LDS_BYTES) != hipSuccess || per_cu < 1) { fprintf(stderr, "kernel_launch: occupancy query says %d\n", per_cu); }
        (void)hipGetLastError();
        grid = cus;
    }
    if (grid < 0) return;
    (void)in_sizes;
    (void)hipMemsetAsync((char*)d_ws + WS_CTL, 0, CTL_ZERO_BYTES, stream);
    Params p{};
    for (int i = 0; i < 32; ++i) p.in[i] = (const float*)d_in[i];
    p.out = (float*)d_out; p.ws = (unsigned char*)d_ws;
#if MK_SPLIT
    for (int ph = 0; ph < N_PHASES; ++ph) { p.ph_lo = ph; p.ph_hi = ph + 1; hipLaunchKernelGGL(fwd_kernel, dim3(grid), dim3(NTHREADS), LDS_BYTES, stream, p); }
#else
    p.ph_lo = 0; p.ph_hi = N_PHASES;
    hipLaunchKernelGGL(fwd_kernel, dim3(grid), dim3(NTHREADS), LDS_BYTES, stream, p);
#endif
}
```

```cpp
#include <hip/hip_runtime.h>
#include <cstdio>
#include <cstdint>

#ifndef MK_SPLIT
#define MK_SPLIT 0
#endif

#define GAS __attribute__((address_space(1)))
#define LAS __attribute__((address_space(3)))
typedef unsigned short bf16;
typedef unsigned v4u __attribute__((ext_vector_type(4)));
typedef unsigned v2u __attribute__((ext_vector_type(2)));
typedef float f32x4 __attribute__((ext_vector_type(4)));
typedef float f32x2 __attribute__((ext_vector_type(2)));
typedef short bf16x8 __attribute__((ext_vector_type(8)));

constexpr int D = 1024, NBATCH = 16, SEQ = 4096, NCTX = 256, DEPTH = 4;
constexpr int TL = NBATCH * SEQ, TC = NBATCH * NCTX, T = TL + TC;
constexpr int FFH = 2816, EH = 3584, NEXP = 8;
constexpr int MOE_CHUNK_TILES = 128, MOE_NCHUNK = 5;
constexpr float Q_H = 16.f, Q_W = 1024.f, Q_HID = 8.f;
constexpr float ALPHA = 1.6817928305074290860622509524664f;
constexpr float LN_EPS = 1e-5f;

constexpr size_t MiB = (size_t)1 << 20;
constexpr size_t WS_CTL = 0, CTL_ZERO_BYTES = 1 * MiB;
constexpr size_t WS_MOD = 1 * MiB;
constexpr size_t WS_TOK = 3 * MiB;
constexpr size_t WS_XC = 5 * MiB;
constexpr size_t WS_F256 = 21 * MiB;
constexpr size_t WS_FD = 22 * MiB;
constexpr size_t WS_EV = 86 * MiB, EV_STRIDE = 22 * MiB;
constexpr size_t EV_WQKV = 0, EV_WPQ = 3 * MiB / 2, EV_WOUT = 7 * MiB / 2, EV_W13 = 11 * MiB / 2, EV_W2 = 33 * MiB / 2;
constexpr size_t WS_OD = 130 * MiB, OD_STRIDE = 174 * MiB;
constexpr size_t OD_WIN = 0, OD_WGLU = 3 * MiB, OD_WOUT = 7 * MiB / 2, OD_MW13 = 11 * MiB / 2, OD_MW2 = 235 * MiB / 2;
constexpr size_t WS_H = 478 * MiB;
constexpr size_t WS_BIG = 614 * MiB;
constexpr size_t BIG_PQT = 0, BIG_PQTC = 128 * MiB, BIG_QKV = 136 * MiB, BIG_MIX = 238 * MiB, BIG_VT = 374 * MiB, BIG_HID = 0, BIG_P = 0, BIG_Y = 0, BIG_HSQ = 276 * MiB;
constexpr size_t WS_S5M = 1030 * MiB, S5M_STRIDE = 384 * 1024;
constexpr size_t WS_END = 1058 * MiB;
constexpr int CW_BAR = 4096, CW_CNT = 16384, CW_LN = 32768, LN_SITE_WORDS = 272 * 16;
constexpr size_t WS_XS = 1054 * MiB;

#define LDS_WAIT() asm volatile("s_waitcnt lgkmcnt(0)" ::: "memory")
#define VM_WAIT() asm volatile("s_waitcnt vmcnt(0)" ::: "memory")
__device__ __forceinline__ unsigned cvt_pk_bf16(float lo, float hi) { unsigned r; asm volatile("v_cvt_pk_bf16_f32 %0, %1, %2" : "=v"(r) : "v"(lo), "v"(hi)); return r; }
__device__ __forceinline__ float bflo(unsigned w) { return __uint_as_float(w << 16); }
__device__ __forceinline__ float bfhi(unsigned w) { return __uint_as_float(w & 0xffff0000u); }
__device__ __forceinline__ float bf2f(bf16 b) { return __uint_as_float(((unsigned)b) << 16); }
__device__ __forceinline__ bf16 f2bf(float f) { return (bf16)(cvt_pk_bf16(f, 0.f) & 0xffffu); }
__device__ __forceinline__ unsigned pk_fp8x4(float a, float b, float c, float d) {
    a = __builtin_amdgcn_fmed3f(a, -448.f, 448.f); b = __builtin_amdgcn_fmed3f(b, -448.f, 448.f); c = __builtin_amdgcn_fmed3f(c, -448.f, 448.f); d = __builtin_amdgcn_fmed3f(d, -448.f, 448.f);
    int w = 0; w = __builtin_amdgcn_cvt_pk_fp8_f32(a, b, w, false); w = __builtin_amdgcn_cvt_pk_fp8_f32(c, d, w, true); return (unsigned)w; }
__device__ __forceinline__ float wave_sum(float v) {
#pragma unroll
    for (int o = 1; o < 64; o <<= 1) v += __shfl_xor(v, o);
    return v;
}
__device__ __forceinline__ float wave_max(float v) {
#pragma unroll
    for (int o = 1; o < 64; o <<= 1) v = fmaxf(v, __shfl_xor(v, o));
    return v;
}
__device__ __forceinline__ float sigmoid_f(float x) { return __builtin_amdgcn_rcpf(1.f + __builtin_amdgcn_exp2f(-1.4426950408889634f * x)); }
__device__ __forceinline__ float silu_f(float x) { return x * sigmoid_f(x); }
__device__ __forceinline__ float gelu_tanh_f(float x) { const float z = x * (0.7978845608028654f + 0.035677408136300125f * x * x); return x * __builtin_amdgcn_rcpf(1.f + __builtin_amdgcn_exp2f(-2.8853900817779268f * z)); }

#define XB_TMO      128
#define XB_XCNT(j)  (256  + 64 * (j))
#define XB_XSUB(j)  (1280 + 64 * (j))
#define XB_XGEN(j)  (2304 + 64 * (j))
#define XB_TOP      3328
#define XB_TOPGEN   3392
#define XCD_BAR_WORDS 3456
#define XB_SPIN_CAP (1u << 25)
__device__ __forceinline__ unsigned xb_ld(unsigned* p)              { return __hip_atomic_load(p, __ATOMIC_RELAXED, __HIP_MEMORY_SCOPE_AGENT); }
__device__ __forceinline__ unsigned xb_add(unsigned* p, unsigned v) { return __hip_atomic_fetch_add(p, v, __ATOMIC_RELAXED, __HIP_MEMORY_SCOPE_AGENT); }
__device__ __forceinline__ unsigned xb_xcc_id() { return (unsigned)__builtin_amdgcn_s_getreg((3 << 11) | 20) & 0xFu; }
#define XB_SPIN(cond, bar) do { unsigned _sp = 0; while (cond) { __builtin_amdgcn_s_sleep(1); \
    if ((++_sp & 255u) == 0u) { if (xb_ld(&(bar)[XB_TMO])) break; if (_sp > XB_SPIN_CAP) { atomicAdd(&(bar)[XB_TMO], 1u); break; } } } } while (0)
struct XcdBarrier { unsigned* bar; unsigned x; volatile LAS unsigned* st; };
__device__ __forceinline__ XcdBarrier xcd_barrier_post(unsigned* bar, volatile LAS unsigned* st) {
    XcdBarrier b; b.bar = bar; b.x = xb_xcc_id(); b.st = st;
    if (threadIdx.x == 0) (void)xb_add(&bar[XB_XCNT(b.x)], 1u);
    return b;
}
__device__ __forceinline__ void xcd_barrier_complete(unsigned* bar, unsigned x, unsigned& nloc, unsigned& nx) {
    const unsigned G = gridDim.x * gridDim.y * gridDim.z;
    unsigned sum, cnt, mine, sp = 0u;
    for (;;) {
        sum = 0u; cnt = 0u; mine = 0u;
#pragma unroll
        for (unsigned j = 0; j < 16; ++j) { const unsigned c = xb_ld(&bar[XB_XCNT(j)]); sum += c; cnt += (c > 0u) ? 1u : 0u; mine = (j == x) ? c : mine; }
        if (sum == G) break;
        __builtin_amdgcn_s_sleep(1);
        if ((++sp & 255u) == 0u) { if (xb_ld(&bar[XB_TMO])) break; if (sp > XB_SPIN_CAP) { atomicAdd(&bar[XB_TMO], 1u); break; } }
    }
    nloc = mine > 0u ? mine : 1u; nx = cnt > 0u ? cnt : 1u;
}
__device__ __forceinline__ void xcd_barrier(const XcdBarrier& b) {
    asm volatile("s_waitcnt vmcnt(0)" ::: "memory");
    __syncthreads();
    if (threadIdx.x == 0) {
        unsigned* bar = b.bar;
        __builtin_amdgcn_s_waitcnt(0);
        unsigned nloc = b.st[0], nx = b.st[1];
        if (nloc == 0u) { xcd_barrier_complete(bar, b.x, nloc, nx); b.st[0] = nloc; b.st[1] = nx; }
        const unsigned old = xb_add(&bar[XB_XSUB(b.x)], 1u);
        const unsigned gen = old / nloc;
        if (old + 1u == (gen + 1u) * nloc) {
            __builtin_amdgcn_fence(__ATOMIC_RELEASE, "agent");
            asm volatile("s_waitcnt vmcnt(0)" ::: "memory");
            const unsigned og = xb_add(&bar[XB_TOP], 1u);
            const unsigned tg = og / nx;
            if (og + 1u == (tg + 1u) * nx) xb_add(&bar[XB_TOPGEN], 1u);
            else XB_SPIN(xb_ld(&bar[XB_TOPGEN]) == tg, bar);
            __builtin_amdgcn_fence(__ATOMIC_ACQUIRE, "agent");
            xb_add(&bar[XB_XGEN(b.x)], 1u);
            asm volatile("s_waitcnt vmcnt(0)" ::: "memory");
        } else {
            XB_SPIN(xb_ld(&bar[XB_XGEN(b.x)]) == gen, bar);
            __builtin_amdgcn_fence(__ATOMIC_ACQUIRE, "agent");
            asm volatile("s_waitcnt vmcnt(0)" ::: "memory");
        }
    }
    __syncthreads();
}

namespace pg8 {
constexpr int BM = 256, BK = 64, HALF = 128, HTB = HALF * BK * 2, STAGE_BYTES = 8 * HTB;
__host__ __device__ __forceinline__ int lds_byte(int r, int c) { const int st = (r >> 4) * 2 + (c >> 5), rr = r & 15, cc = c & 31, ob = rr * 64 + cc * 2; return st * 1024 + (ob ^ (((ob >> 9) & 1) << 5)); }
__host__ __device__ __forceinline__ void stage_rc(int b, int& R, int& C) { const int st = b / 1024, sb = b % 1024, swz = sb ^ (((sb >> 9) & 1) << 5); R = (st >> 1) * 16 + swz / 64; C = (st & 1) * 32 + (swz % 64) / 2; }
__host__ __device__ __forceinline__ int perm32(int rho) { const int n = rho >> 4, i = rho & 15; return 8 * (i >> 2) + 4 * n + (i & 3); }

struct Unit { const char* a; const char* b; char* o; const char* p0; const char* p1; int ldo; int x0; };
struct Dims { int K, lda, ldb; };
typedef int v4i __attribute__((ext_vector_type(4)));
typedef int v8i __attribute__((ext_vector_type(8)));
struct AMapStd { int ldab = 0;   __device__ __forceinline__ unsigned voff(int R, int C) const { return (unsigned)(R * ldab + C * 2); } __device__ __forceinline__ size_t kstep() const { return 128; } __device__ __forceinline__ size_t hs() const { return (size_t)HALF * ldab; } };
struct AMapS5 { __device__ __forceinline__ unsigned voff(int R, int C) const { return (unsigned)(R * 49152 + (C >> 4) * 3072 + (C & 15) * 2); } __device__ __forceinline__ size_t kstep() const { return 12288; } __device__ __forceinline__ size_t hs() const { return (size_t)HALF * 49152; } };

__device__ __forceinline__ const char* uni_ptr(const char* p) {
    const unsigned long long v = (unsigned long long)p; const unsigned lo = __builtin_amdgcn_readfirstlane((unsigned)v), hi = __builtin_amdgcn_readfirstlane((unsigned)(v >> 32));
    return (const char*)(((unsigned long long)hi << 32) | lo); }
template <class Epi, class Sched, bool ALIGN_EPI = false, bool SP2 = false, class AMap = AMapStd, bool FP8 = false>
__device__ __forceinline__ void gemm_phase(LAS unsigned char* lds, const int tid, const Dims g, const Sched& S, const Epi& E, const AMap am_in = AMap{}) {
    constexpr int ES = FP8 ? 1 : 2;
    AMap am = am_in; if constexpr (__is_same(AMap, AMapStd)) am.ldab = g.lda * ES;
    const int wid = __builtin_amdgcn_readfirstlane(tid >> 6), lane = tid & 63, wr = wid >> 2, wc = wid & 3, fr = lane & 15, fq = lane >> 4;
    const int K = g.K, nt = (K * (FP8 ? 1 : 2)) / 128;
    unsigned voffA, voffB;
    { int R, C; stage_rc(tid * 16, R, C); const int Rb = Epi::PERM ? ((R & ~31) + perm32(R & 31)) : R;
        voffA = am.voff(R, C); voffB = (unsigned)(Rb * g.ldb * ES + C * 2); }
    const size_t d64voffA = am.voff(64, 0), d64voffB = (size_t)64 * g.ldb * ES;
    const size_t kstep = (size_t)(BK * 2), kstepA = am.kstep();
    const size_t hsA = am.hs(), hsB = (size_t)HALF * g.ldb * ES;
    const unsigned ldsw = (unsigned)wid * 1024u;
    const int aoff = lds_byte(wr * 64 + fr, fq * 8), boff = lds_byte(wc * 32 + fr, fq * 8);
#define PG8_SA(b, h) (((b) * 2 + (h)) * HTB)
#define PG8_SB(b, h) ((4 + (b) * 2 + (h)) * HTB)
#define PG8_STAGE(bufoff, gbase, voff) do { unsigned _vo = (voff); asm volatile("" : "+v"(_vo));   \
        __builtin_amdgcn_global_load_lds((const unsigned*)((const char*)(gbase) + _vo), (LAS unsigned*)(lds + (bufoff) + ldsw), 16, 0, 0); \
        __builtin_amdgcn_global_load_lds((const unsigned*)((const char*)(gbase) + d64##voff + _vo), (LAS unsigned*)(lds + (bufoff) + ldsw + 8192), 16, 0, 0); } while (0)
#define PG8_LD8(p) __builtin_shufflevector(*(const LAS v4i*)(p), *(const LAS v4i*)((p) + 1024), 0, 1, 2, 3, 4, 5, 6, 7)
#define PG8_LDA(dst, b, h) do { if constexpr (FP8) { _Pragma("unroll") for (int m = 0; m < 4; ++m) dst##8[m] = PG8_LD8(lds + PG8_SA(b, h) + aoff + m * 2048); } \
        else { _Pragma("unroll") for (int m = 0; m < 4; ++m) _Pragma("unroll") for (int k = 0; k < 2; ++k) dst[m][k] = *(const LAS bf16x8*)(lds + PG8_SA(b, h) + aoff + m * 2048 + k * 1024); } } while (0)
#define PG8_LDB(dst, b, h) do { if constexpr (FP8) { _Pragma("unroll") for (int n = 0; n < 2; ++n) dst##8[n] = PG8_LD8(lds + PG8_SB(b, h) + boff + n * 2048); } \
        else { _Pragma("unroll") for (int n = 0; n < 2; ++n) _Pragma("unroll") for (int k = 0; k < 2; ++k) dst[n][k] = *(const LAS bf16x8*)(lds + PG8_SB(b, h) + boff + n * 2048 + k * 1024); } } while (0)
#define PG8_MMA(ai, bj, At, Bt) do { __builtin_amdgcn_s_setprio(1); \
        if constexpr (FP8) { _Pragma("unroll") for (int m = 0; m < 4; ++m) _Pragma("unroll") for (int n = 0; n < 2; ++n) \
            acc[ai][bj][m][n] = __builtin_amdgcn_mfma_scale_f32_16x16x128_f8f6f4(Bt##8[n], At##8[m], acc[ai][bj][m][n], 0, 0, 0, 0, 0, 0); } \
        else { _Pragma("unroll") for (int m = 0; m < 4; ++m) _Pragma("unroll") for (int n = 0; n < 2; ++n) _Pragma("unroll") for (int k = 0; k < 2; ++k) \
            acc[ai][bj][m][n] = __builtin_amdgcn_mfma_f32_16x16x32_bf16(Bt[n][k], At[m][k], acc[ai][bj][m][n], 0, 0, 0); } \
        __builtin_amdgcn_s_setprio(0); } while (0)
#define PG8_WAIT_V(n) asm volatile("s_waitcnt vmcnt(" #n ")" ::: "memory")
#define PG8_WAIT_L(n) asm volatile("s_waitcnt lgkmcnt(" #n ")" ::: "memory")
#define PG8_BAR __builtin_amdgcn_s_barrier()
#define PG8_SCHED __builtin_amdgcn_sched_barrier(0)
    int ui = 0;
    const char* cA; const char* cB;
    { Unit u0; if (!S.next(0, u0)) return; cA = uni_ptr(u0.a); cB = uni_ptr(u0.b); }
    f32x4 acc[2][2][4][2];
#pragma unroll
    for (int a = 0; a < 2; ++a)
#pragma unroll
        for (int b = 0; b < 2; ++b)
#pragma unroll
            for (int m = 0; m < 4; ++m)
#pragma unroll
                for (int n = 0; n < 2; ++n) acc[a][b][m][n] = (f32x4){0.f, 0.f, 0.f, 0.f};
    bf16x8 At[4][2], B0[2][2], B1[2][2];
    v8i At8[4], B08[2], B18[2];
    if constexpr (SP2) {
        PG8_STAGE(PG8_SB(0, 0), cB, voffB); PG8_STAGE(PG8_SB(0, 1), cB + hsB, voffB); PG8_STAGE(PG8_SA(0, 0), cA, voffA); PG8_STAGE(PG8_SA(0, 1), cA + hsA, voffA);
        if (wr == 1) PG8_BAR;
        PG8_WAIT_V(2); PG8_BAR;
        PG8_STAGE(PG8_SB(1, 0), cB + kstep, voffB); PG8_STAGE(PG8_SA(1, 0), cA + kstepA, voffA); PG8_STAGE(PG8_SB(1, 1), cB + hsB + kstep, voffB);
        PG8_WAIT_V(6); PG8_BAR;
    } else {
        PG8_STAGE(PG8_SB(0, 0), cB, voffB); PG8_STAGE(PG8_SA(0, 0), cA, voffA); PG8_STAGE(PG8_SB(0, 1), cB + hsB, voffB); PG8_STAGE(PG8_SA(0, 1), cA + hsA, voffA);
        if (wr == 1) PG8_BAR;
        PG8_WAIT_V(4); PG8_BAR;
        PG8_STAGE(PG8_SB(1, 0), cB + kstep, voffB); PG8_STAGE(PG8_SA(1, 0), cA + kstepA, voffA); PG8_STAGE(PG8_SB(1, 1), cB + hsB + kstep, voffB);
        PG8_WAIT_V(6); PG8_BAR;
    }
    for (;;) {
        const char* nA = cA; const char* nB = cB; bool has_next;
        { Unit un; has_next = S.next(ui + 1, un); if (has_next) { nA = uni_ptr(un.a); nB = uni_ptr(un.b); } }
#pragma unroll 1
        for (int t = 0; t < nt; t += 2) {
            const bool last = (t == nt - 2);
            const char* a1 = cA + (size_t)(t + 1) * kstepA;
            const char* a2 = last ? nA : cA + (size_t)(t + 2) * kstepA; const char* b2 = last ? nB : cB + (size_t)(t + 2) * kstep;
            const char* a3 = a2 + kstepA; const char* b3 = b2 + kstep;
            if constexpr (SP2) {
            PG8_LDB(B0, 0, 0); PG8_LDB(B1, 0, 1); PG8_SCHED; PG8_LDA(At, 0, 0); PG8_STAGE(PG8_SA(1, 1), a1 + hsA, voffA);
            PG8_WAIT_V(8); PG8_WAIT_L(0); PG8_BAR; PG8_MMA(0, 0, At, B0); PG8_MMA(0, 1, At, B1); PG8_BAR; PG8_SCHED;
            PG8_LDA(At, 0, 1); PG8_STAGE(PG8_SB(0, 0), b2, voffB); PG8_STAGE(PG8_SB(0, 1), b2 + hsB, voffB); PG8_STAGE(PG8_SA(0, 0), a2, voffA);
            PG8_WAIT_V(8); PG8_WAIT_L(0); PG8_BAR; PG8_MMA(1, 0, At, B0); PG8_MMA(1, 1, At, B1); PG8_BAR; PG8_SCHED;
            PG8_LDB(B0, 1, 0); PG8_LDB(B1, 1, 1); PG8_SCHED; PG8_LDA(At, 1, 0); PG8_STAGE(PG8_SA(0, 1), a2 + hsA, voffA);
            PG8_WAIT_V(8); PG8_WAIT_L(0); PG8_BAR; PG8_MMA(0, 0, At, B0); PG8_MMA(0, 1, At, B1); PG8_BAR; PG8_SCHED;
            PG8_LDA(At, 1, 1); PG8_STAGE(PG8_SB(1, 0), b3, voffB); PG8_STAGE(PG8_SB(1, 1), b3 + hsB, voffB); PG8_STAGE(PG8_SA(1, 0), a3, voffA);
            PG8_WAIT_V(8); PG8_WAIT_L(0); PG8_BAR; PG8_MMA(1, 0, At, B0); PG8_MMA(1, 1, At, B1); PG8_BAR; PG8_SCHED;
            } else {
            PG8_LDB(B0, 0, 0); PG8_SCHED; PG8_LDA(At, 0, 0); PG8_STAGE(PG8_SA(1, 1), a1 + hsA, voffA);
            PG8_WAIT_L(8); PG8_BAR; PG8_WAIT_L(0); PG8_MMA(0, 0, At, B0); PG8_BAR; PG8_SCHED;
            PG8_LDB(B1, 0, 1); PG8_STAGE(PG8_SB(0, 0), b2, voffB);
            PG8_BAR; PG8_WAIT_L(0); PG8_MMA(0, 1, At, B1); PG8_BAR;
            PG8_LDA(At, 0, 1); PG8_STAGE(PG8_SA(0, 0), a2, voffA);
            PG8_BAR; PG8_WAIT_L(0); PG8_MMA(1, 0, At, B0); PG8_BAR; PG8_SCHED;
            PG8_STAGE(PG8_SB(0, 1), b2 + hsB, voffB);
            PG8_WAIT_V(6); PG8_BAR; PG8_MMA(1, 1, At, B1); PG8_BAR;
            PG8_LDB(B0, 1, 0); PG8_SCHED; PG8_LDA(At, 1, 0); PG8_STAGE(PG8_SA(0, 1), a2 + hsA, voffA);
            PG8_WAIT_L(8); PG8_BAR; PG8_WAIT_L(0); PG8_MMA(0, 0, At, B0); PG8_BAR; PG8_SCHED;
            PG8_LDB(B1, 1, 1); PG8_STAGE(PG8_SB(1, 0), b3, voffB);
            PG8_BAR; PG8_WAIT_L(0); PG8_MMA(0, 1, At, B1); PG8_BAR;
            PG8_LDA(At, 1, 1); PG8_STAGE(PG8_SA(1, 0), a3, voffA);
            PG8_BAR; PG8_WAIT_L(0); PG8_MMA(1, 0, At, B0); PG8_BAR; PG8_SCHED;
            PG8_STAGE(PG8_SB(1, 1), b3 + hsB, voffB);
            PG8_WAIT_V(6); PG8_BAR; PG8_MMA(1, 1, At, B1); PG8_BAR;
            }
        }
        if constexpr (ALIGN_EPI) { if (wr == 0) PG8_BAR; }
        { Unit uc; (void)S.next(ui, uc); E(acc, uc, wid); }
        if (!has_next) break;
#pragma unroll
        for (int a = 0; a < 2; ++a)
#pragma unroll
            for (int b = 0; b < 2; ++b)
#pragma unroll
                for (int m = 0; m < 4; ++m)
#pragma unroll
                    for (int n = 0; n < 2; ++n) acc[a][b][m][n] = (f32x4){0.f, 0.f, 0.f, 0.f};
        cA = nA; cB = nB; ++ui;
        if constexpr (ALIGN_EPI) { if (wr == 1) PG8_BAR; }
    }
    PG8_WAIT_V(0);
    if constexpr (!ALIGN_EPI) { if (wr == 0) PG8_BAR; }
    PG8_BAR;
#undef PG8_SA
#undef PG8_SB
#undef PG8_STAGE
#undef PG8_LDA
#undef PG8_LDB
#undef PG8_MMA
#undef PG8_LD8
#undef PG8_WAIT_V
#undef PG8_WAIT_L
#undef PG8_BAR
#undef PG8_SCHED
}

struct EpiStore {
    static constexpr bool PERM = true;
    __device__ __forceinline__ void operator()(const f32x4 (&acc)[2][2][4][2], const Unit& u, const int wid) const {
        int lane_; asm volatile("v_mbcnt_lo_u32_b32 %0, -1, 0\n\tv_mbcnt_hi_u32_b32 %0, -1, %0" : "=v"(lane_));
        const int wr = wid >> 2, wc = wid & 3, fr = lane_ & 15, fq = lane_ >> 4;
        bf16* base = (bf16*)u.o; int row0 = wr * 64 + fr, col0 = wc * 32 + 8 * fq; asm volatile("" : "+v"(row0), "+v"(col0)); const bool act = u.x0 != 0;
#pragma unroll
        for (int ai = 0; ai < 2; ++ai)
#pragma unroll
            for (int m = 0; m < 4; ++m) { bf16* rowp = base + (size_t)(row0 + ai * HALF + m * 16) * u.ldo + col0;
#pragma unroll
                for (int bj = 0; bj < 2; ++bj) { f32x4 v0 = acc[ai][bj][m][0], v1 = acc[ai][bj][m][1];
                    if (act) {
#pragma unroll
                        for (int j = 0; j < 4; ++j) { v0[j] = gelu_tanh_f(v0[j]); v1[j] = gelu_tanh_f(v1[j]); } }
                    v4u w; w.x = cvt_pk_bf16(v0[0], v0[1]); w.y = cvt_pk_bf16(v0[2], v0[3]); w.z = cvt_pk_bf16(v1[0], v1[1]); w.w = cvt_pk_bf16(v1[2], v1[3]);
                    *(v4u*)(rowp + bj * HALF) = w; } }
    }
};
struct EpiSwiGLU {
    static constexpr bool PERM = true;
    __device__ __forceinline__ void operator()(const f32x4 (&acc)[2][2][4][2], const Unit& u, const int wid) const {
        int lane_; asm volatile("v_mbcnt_lo_u32_b32 %0, -1, 0\n\tv_mbcnt_hi_u32_b32 %0, -1, %0" : "=v"(lane_));
        const int wr = wid >> 2, wc = wid & 3, fr = lane_ & 15, fq = lane_ >> 4;
        bf16* base = (bf16*)u.o; int row0 = wr * 64 + fr, col0 = wc * 32 + 8 * fq; asm volatile("" : "+v"(row0), "+v"(col0));
#pragma unroll
        for (int ai = 0; ai < 2; ++ai)
#pragma unroll
            for (int m = 0; m < 4; ++m) { bf16* rowp = base + (size_t)(row0 + ai * HALF + m * 16) * u.ldo + col0;
                f32x4 h0, h1;
#pragma unroll
                for (int j = 0; j < 4; ++j) { h0[j] = silu_f(acc[ai][0][m][0][j]) * acc[ai][1][m][0][j]; h1[j] = silu_f(acc[ai][0][m][1][j]) * acc[ai][1][m][1][j]; }
                v4u w; w.x = cvt_pk_bf16(h0[0], h0[1]); w.y = cvt_pk_bf16(h0[2], h0[3]); w.z = cvt_pk_bf16(h1[0], h1[1]); w.w = cvt_pk_bf16(h1[2], h1[3]);
                *(v4u*)rowp = w; }
    }
};
struct EpiSwiGLU8 {
    static constexpr bool PERM = true;
    __device__ __forceinline__ void operator()(const f32x4 (&acc)[2][2][4][2], const Unit& u, const int wid) const {
        int lane_; asm volatile("v_mbcnt_lo_u32_b32 %0, -1, 0\n\tv_mbcnt_hi_u32_b32 %0, -1, %0" : "=v"(lane_));
        const int wr = wid >> 2, wc = wid & 3, fr = lane_ & 15, fq = lane_ >> 4;
        unsigned char* base = (unsigned char*)u.o; int row0 = wr * 64 + fr, col0 = wc * 32 + 8 * fq; asm volatile("" : "+v"(row0), "+v"(col0));
        constexpr float SA = 1.0f / (Q_H * Q_W);
#pragma unroll
        for (int ai = 0; ai < 2; ++ai)
#pragma unroll
            for (int m = 0; m < 4; ++m) { unsigned char* rowp = base + (size_t)(row0 + ai * HALF + m * 16) * u.ldo + col0;
                float h0[4], h1[4];
#pragma unroll
                for (int j = 0; j < 4; ++j) { h0[j] = silu_f(acc[ai][0][m][0][j] * SA) * (acc[ai][1][m][0][j] * (SA * Q_HID)); h1[j] = silu_f(acc[ai][0][m][1][j] * SA) * (acc[ai][1][m][1][j] * (SA * Q_HID)); }
                v2u w; w.x = pk_fp8x4(h0[0], h0[1], h0[2], h0[3]); w.y = pk_fp8x4(h1[0], h1[1], h1[2], h1[3]);
                *(v2u*)rowp = w; }
    }
};
struct EpiStoreQ {
    static constexpr bool PERM = true;
    __device__ __forceinline__ void operator()(const f32x4 (&acc)[2][2][4][2], const Unit& u, const int wid) const {
        int lane_; asm volatile("v_mbcnt_lo_u32_b32 %0, -1, 0\n\tv_mbcnt_hi_u32_b32 %0, -1, %0" : "=v"(lane_));
        const int wr = wid >> 2, wc = wid & 3, fr = lane_ & 15, fq = lane_ >> 4;
        bf16* base = (bf16*)u.o; int row0 = wr * 64 + fr, col0 = wc * 32 + 8 * fq; asm volatile("" : "+v"(row0), "+v"(col0));
        constexpr float SA = 1.0f / (Q_HID * Q_W);
#pragma unroll
        for (int ai = 0; ai < 2; ++ai)
#pragma unroll
            for (int m = 0; m < 4; ++m) { bf16* rowp = base + (size_t)(row0 + ai * HALF + m * 16) * u.ldo + col0;
#pragma unroll
                for (int bj = 0; bj < 2; ++bj) { const f32x4 v0 = acc[ai][bj][m][0] * SA, v1 = acc[ai][bj][m][1] * SA;
                    v4u w; w.x = cvt_pk_bf16(v0[0], v0[1]); w.y = cvt_pk_bf16(v0[2], v0[3]); w.z = cvt_pk_bf16(v1[0], v1[1]); w.w = cvt_pk_bf16(v1[2], v1[3]);
                    *(v4u*)(rowp + bj * HALF) = w; } }
    }
};
struct EpiResid {
    static constexpr bool PERM = false;
    __device__ __forceinline__ void operator()(const f32x4 (&acc)[2][2][4][2], const Unit& u, const int wid) const {
        int lane_; asm volatile("v_mbcnt_lo_u32_b32 %0, -1, 0\n\tv_mbcnt_hi_u32_b32 %0, -1, %0" : "=v"(lane_));
        const int wr = wid >> 2, wc = wid & 3, fr = lane_ & 15, fq = lane_ >> 4;
        const float* xs = (const float*)u.p0; float* zo = (float*)u.o; const float* gv = (const float*)u.p1;
        int row0 = wr * 64 + fr, col0 = wc * 32 + 4 * fq; asm volatile("" : "+v"(row0), "+v"(col0));
#pragma unroll
        for (int ai = 0; ai < 2; ++ai)
#pragma unroll
            for (int m = 0; m < 4; ++m) { const size_t off = (size_t)(row0 + ai * HALF + m * 16) * D + col0;
#pragma unroll
                for (int bj = 0; bj < 2; ++bj)
#pragma unroll
                    for (int n = 0; n < 2; ++n) { const f32x4 xv = *(const f32x4*)(xs + off + bj * HALF + n * 16); const f32x4 gvv = *(const f32x4*)(gv + col0 + bj * HALF + n * 16);
                        *(f32x4*)(zo + off + bj * HALF + n * 16) = xv * ALPHA + gvv * acc[ai][bj][m][n]; }
                asm volatile("" ::: "memory"); }
    }
};
struct EpiResidLN {
    static constexpr bool PERM = false;
    const float* lng; const float* lnb; int sc_delta, sh_delta; bf16* H; unsigned* cnt; unsigned long long* xs; unsigned* tmo; LAS unsigned char* tab;
    __device__ __forceinline__ void operator()(f32x4 (&acc)[2][2][4][2], const Unit& u, const int wid) const {
        int lane_; asm volatile("v_mbcnt_lo_u32_b32 %0, -1, 0\n\tv_mbcnt_hi_u32_b32 %0, -1, %0" : "=v"(lane_));
        const int wr = wid >> 2, wc = wid & 3, fr = lane_ & 15, fq = lane_ >> 4, pm = u.x0 >> 2, pn = u.x0 & 3;
        const float* xsrc = (const float*)u.p0; float* xo = (float*)u.o; const float* gv = (const float*)u.p1;
        int row0 = wr * 64 + fr, col0 = wc * 32 + 4 * fq; asm volatile("" : "+v"(row0), "+v"(col0));
        LAS f32x2* Pt = (LAS f32x2*)tab; LAS f32x2* St = (LAS f32x2*)(tab + 8192);
        f32x4 gg[2][2];
#pragma unroll
        for (int bj = 0; bj < 2; ++bj)
#pragma unroll
            for (int n = 0; n < 2; ++n) gg[bj][n] = *(const f32x4*)(gv + col0 + bj * HALF + n * 16);
#pragma unroll
        for (int ai = 0; ai < 2; ++ai)
#pragma unroll
            for (int mh = 0; mh < 2; ++mh) {
                f32x4 xv[2][2][2];
#pragma unroll
                for (int ml = 0; ml < 2; ++ml)
#pragma unroll
                    for (int bj = 0; bj < 2; ++bj)
#pragma unroll
                        for (int n = 0; n < 2; ++n) xv[ml][bj][n] = *(const f32x4*)(xsrc + (size_t)(row0 + ai * HALF + (2 * mh + ml) * 16) * D + col0 + bj * HALF + n * 16);
#pragma unroll
                for (int ml = 0; ml < 2; ++ml) { const int m = 2 * mh + ml; float sm = 0.f, sq = 0.f;
#pragma unroll
                    for (int bj = 0; bj < 2; ++bj)
#pragma unroll
                        for (int n = 0; n < 2; ++n) { const f32x4 z = xv[ml][bj][n] * ALPHA + gg[bj][n] * acc[ai][bj][m][n]; acc[ai][bj][m][n] = z;
                            sm += (z[0] + z[1]) + (z[2] + z[3]); sq += (z[0] * z[0] + z[1] * z[1]) + (z[2] * z[2] + z[3] * z[3]); }
                    sm += __shfl_xor(sm, 16); sm += __shfl_xor(sm, 32); sq += __shfl_xor(sq, 16); sq += __shfl_xor(sq, 32);
                    if (fq == 0) Pt[(ai * HALF + wr * 64 + m * 16 + fr) * 4 + wc] = (f32x2){sm, sq}; }
                asm volatile("" ::: "memory"); }
        asm volatile("s_waitcnt lgkmcnt(0)" ::: "memory"); __builtin_amdgcn_s_barrier(); asm volatile("" ::: "memory");
        const int trow = wid * 64 + lane_;
        if (wid < 4) {
            const f32x2 a = Pt[trow * 4 + 0], b = Pt[trow * 4 + 1], c = Pt[trow * 4 + 2], d = Pt[trow * 4 + 3];
            const float ts = (a.x + b.x) + (c.x + d.x), tq = (a.y + b.y) + (c.y + d.y);
            __hip_atomic_store(xs + ((size_t)pm * 256 + trow) * 4 + pn, ((unsigned long long)__float_as_uint(tq) << 32) | __float_as_uint(ts), __ATOMIC_RELAXED, __HIP_MEMORY_SCOPE_AGENT);
            asm volatile("s_waitcnt vmcnt(0)" ::: "memory");
            if (lane_ == 0) __hip_atomic_fetch_add(cnt + pm * 16, 1u, __ATOMIC_RELAXED, __HIP_MEMORY_SCOPE_AGENT);
        }
        if (wid == 0) {
            unsigned sp = 0;
            while ((unsigned)__builtin_amdgcn_readfirstlane(__hip_atomic_load(cnt + pm * 16, __ATOMIC_RELAXED, __HIP_MEMORY_SCOPE_AGENT)) < 16u) {
                __builtin_amdgcn_s_sleep(1);
                if ((++sp & 1023u) == 0u && (sp > (1u << 24) || __hip_atomic_load(tmo, __ATOMIC_RELAXED, __HIP_MEMORY_SCOPE_AGENT) != 0u)) { if (lane_ == 0) __hip_atomic_store(tmo, 1u, __ATOMIC_RELAXED, __HIP_MEMORY_SCOPE_AGENT); break; } }
            __builtin_amdgcn_fence(__ATOMIC_ACQUIRE, "agent");
        }
        asm volatile("s_waitcnt vmcnt(0) lgkmcnt(0)" ::: "memory"); __builtin_amdgcn_s_barrier(); asm volatile("" ::: "memory");
        if (wid < 4) {
            const unsigned long long* sl = xs + ((size_t)pm * 256 + trow) * 4; float ts = 0.f, tq = 0.f;
#pragma unroll
            for (int t = 0; t < 4; ++t) { const unsigned long long w = __hip_atomic_load(sl + t, __ATOMIC_RELAXED, __HIP_MEMORY_SCOPE_AGENT); ts += __uint_as_float((unsigned)w); tq += __uint_as_float((unsigned)(w >> 32)); }
            const float mean = ts * (1.f / D), var = fmaxf(tq * (1.f / D) - mean * mean, 0.f);
            St[trow] = (f32x2){mean, rsqrtf(var + LN_EPS)};
        }
        asm volatile("s_waitcnt vmcnt(0) lgkmcnt(0)" ::: "memory"); __builtin_amdgcn_s_barrier(); asm volatile("" ::: "memory");
        const float* lg = lng + pn * 256; const float* lb = lnb + pn * 256; const float* scv = gv + sc_delta; const float* shv = gv + sh_delta;
        bf16* hb = H + ((size_t)pm * 256) * D + pn * 256;
        f32x4 g4[2][2], b4[2][2], s4[2][2], t4[2][2];
#pragma unroll
        for (int bj = 0; bj < 2; ++bj)
#pragma unroll
            for (int n = 0; n < 2; ++n) { const int c = col0 + bj * HALF + n * 16; g4[bj][n] = *(const f32x4*)(lg + c); b4[bj][n] = *(const f32x4*)(lb + c); s4[bj][n] = *(const f32x4*)(scv + c) + 1.0f; t4[bj][n] = *(const f32x4*)(shv + c); }
#pragma unroll
        for (int ai = 0; ai < 2; ++ai)
#pragma unroll
            for (int m = 0; m < 4; ++m) { const int r = row0 + ai * HALF + m * 16; const f32x2 ms = St[r]; const size_t off = (size_t)r * D + col0;
#pragma unroll
                for (int bj = 0; bj < 2; ++bj)
#pragma unroll
                    for (int n = 0; n < 2; ++n) {
                        const f32x4 xn = (acc[ai][bj][m][n] - ms.x) * ms.y * g4[bj][n] + b4[bj][n];
                        *(f32x4*)(xo + off + bj * HALF + n * 16) = xn;
                        const f32x4 hv = xn * s4[bj][n] + t4[bj][n];
                        v2u w; w.x = cvt_pk_bf16(hv[0], hv[1]); w.y = cvt_pk_bf16(hv[2], hv[3]); *(v2u*)(hb + off + bj * HALF + n * 16) = w; } }
    }
};
struct EpiGLU {
    static constexpr bool PERM = true;
    __device__ __forceinline__ void operator()(const f32x4 (&acc)[2][2][4][2], const Unit& u, const int wid) const {
        int lane_; asm volatile("v_mbcnt_lo_u32_b32 %0, -1, 0\n\tv_mbcnt_hi_u32_b32 %0, -1, %0" : "=v"(lane_));
        const int wr = wid >> 2, wc = wid & 3, fr = lane_ & 15, fq = lane_ >> 4;
        bf16* base = (bf16*)u.o; const bf16* gp = (const bf16*)u.p0; const float* bias = (const float*)u.p1;
        int row0 = wr * 64 + fr, col0 = wc * 32 + 8 * fq; asm volatile("" : "+v"(row0), "+v"(col0));
#pragma unroll
        for (int ai = 0; ai < 2; ++ai)
#pragma unroll
            for (int m = 0; m < 4; ++m) { const int r = row0 + ai * HALF + m * 16;
#pragma unroll
                for (int bj = 0; bj < 2; ++bj) { const v4u gw = *(const v4u*)(gp + (size_t)r * u.x0 + col0 + bj * HALF);
                    const f32x4 b0 = *(const f32x4*)(bias + col0 + bj * HALF), b1 = *(const f32x4*)(bias + col0 + bj * HALF + 4);
                    const f32x4 a0 = acc[ai][bj][m][0] + b0, a1 = acc[ai][bj][m][1] + b1;
                    const float o0 = bflo(gw.x) * sigmoid_f(a0[0]), o1 = bfhi(gw.x) * sigmoid_f(a0[1]), o2 = bflo(gw.y) * sigmoid_f(a0[2]), o3 = bfhi(gw.y) * sigmoid_f(a0[3]);
                    const float o4 = bflo(gw.z) * sigmoid_f(a1[0]), o5 = bfhi(gw.z) * sigmoid_f(a1[1]), o6 = bflo(gw.w) * sigmoid_f(a1[2]), o7 = bfhi(gw.w) * sigmoid_f(a1[3]);
                    v4u w; w.x = cvt_pk_bf16(o0, o1); w.y = cvt_pk_bf16(o2, o3); w.z = cvt_pk_bf16(o4, o5); w.w = cvt_pk_bf16(o6, o7);
                    *(v4u*)(base + (size_t)r * u.ldo + col0 + bj * HALF) = w; }
                asm volatile("" ::: "memory"); }
    }
};
struct EpiS5B {
    static constexpr bool PERM = true;
    __device__ __forceinline__ void operator()(const f32x4 (&acc)[2][2][4][2], const Unit& u, const int wid) const {
        int lane_; asm volatile("v_mbcnt_lo_u32_b32 %0, -1, 0\n\tv_mbcnt_hi_u32_b32 %0, -1, %0" : "=v"(lane_));
        const int wr = wid >> 2, wc = wid & 3, fr = lane_ & 15, fq = lane_ >> 4;
        bf16* base = (bf16*)u.o; const bf16* y1 = (const bf16*)u.p0;
        int row0 = wr * 64 + fr, col0 = wc * 32 + 8 * fq; asm volatile("" : "+v"(row0), "+v"(col0));
#pragma unroll
        for (int ai = 0; ai < 2; ++ai)
#pragma unroll
            for (int m = 0; m < 4; ++m) { const int r = row0 + ai * HALF + m * 16;
#pragma unroll
                for (int bj = 0; bj < 2; ++bj) { const int c = col0 + bj * HALF; const v4u yw = *(const v4u*)(y1 + (size_t)r * 8192 + c);
                    const f32x4 a0 = acc[ai][bj][m][0], a1 = acc[ai][bj][m][1];
                    const float o0 = gelu_tanh_f(a0[0] + bflo(yw.x)), o1 = gelu_tanh_f(a0[1] + bfhi(yw.x)), o2 = gelu_tanh_f(a0[2] + bflo(yw.y)), o3 = gelu_tanh_f(a0[3] + bfhi(yw.y));
                    const float o4 = gelu_tanh_f(a1[0] + bflo(yw.z)), o5 = gelu_tanh_f(a1[1] + bfhi(yw.z)), o6 = gelu_tanh_f(a1[2] + bflo(yw.w)), o7 = gelu_tanh_f(a1[3] + bfhi(yw.w));
                    v4u w; w.x = cvt_pk_bf16(o0, o1); w.y = cvt_pk_bf16(o2, o3); w.z = cvt_pk_bf16(o4, o5); w.w = cvt_pk_bf16(o6, o7);
                    *(v4u*)(base + ((size_t)r * 16 + (c >> 4)) * 1536 + (c & 15)) = w; }
                asm volatile("" ::: "memory"); }
    }
};
}

struct Params { const float* in[32]; float* out; unsigned char* ws; int ph_lo, ph_hi; };
enum { I_X = 0, I_C, I_CTX, I_CCTX, I_WMOD, I_BMOD, I_LNG, I_LNB, I_EV_WIN, I_EV_WOUT, I_EV_SINK, I_EV_W1, I_EV_W3, I_EV_W2, I_OD_WIN, I_A_RE, I_A_IM, I_LOG_DT,
       I_B_RE, I_B_IM, I_C_RE, I_C_IM, I_SSM_D, I_WGLU, I_BGLU, I_WS, I_BS, I_OD_WOUT, I_ROUTER, I_MW1, I_MW3, I_MW2 };

constexpr int LDS_RING = 131072, LDS_MISC = LDS_RING + 320, LDS_LNTAB = LDS_RING + 1024, LDS_BYTES = 147456;
constexpr int NWAVES = 8, NTHREADS = 512;

struct Frame {
    LAS unsigned char* lds;
    int tid, lane, wave, G, bid, gw, NGW;
    unsigned char* ws;
    unsigned* ctl;
};

using pg8::Unit;
__device__ __forceinline__ void xcd_rows(int c, int nM, int& r0, int& cnt) { const int x = c & 7, base = nM >> 3, extra = nM & 7; cnt = base + (x < extra ? 1 : 0); r0 = x * base + (x < extra ? x : extra); }
__device__ __forceinline__ void grp_unit(int q, int cnt, int nN, int RG, int& row_local, int& pn) {
    const int gfull = RG * nN, rg = q / gfull, rem = q - rg * gfull; int rows_here = cnt - rg * RG; rows_here = rows_here < RG ? rows_here : RG;
    pn = rem / rows_here; row_local = rg * RG + (rem - pn * rows_here);
}
__device__ __forceinline__ bool xcd_unit(int i, int G, int c, int nM, int nN, int RG, int& pm, int& pn) {
    int r0, cnt; xcd_rows(c, nM, r0, cnt); const int q = i * (G >> 3) + (c >> 3); if (q >= cnt * nN) return false;
    int rl; grp_unit(q, cnt, nN, RG, rl, pn); pm = r0 + rl; return true;
}
struct SchedStd {
    int nN, nUnits, G, c; const char* A; const char* B; char* O; size_t aStep, bStep, oRow, oCol; int ldo, act_from;
    __device__ __forceinline__ bool next(int i, Unit& u) const {
        int pm, pn; if (!xcd_unit(i, G, c, nUnits / nN, nN, 4, pm, pn)) return false;
        u.a = A + (size_t)pm * aStep; u.b = B + (size_t)pn * bStep; u.o = O + (size_t)pm * oRow + (size_t)pn * oCol; u.p0 = nullptr; u.p1 = nullptr; u.ldo = ldo; u.x0 = (pn >= act_from) ? 1 : 0; return true;
    }
};
struct SchedEvIn {
    int G, c; const char* H; const char* Wqkv; const char* Wpq; char* QKV; char* PQT; char* PQTC;
    __device__ __forceinline__ bool next(int i, Unit& u) const {
        u.p0 = nullptr; u.p1 = nullptr; u.x0 = 0;
        int r0, cnt; xcd_rows(c, T / 256, r0, cnt);
        int q = i * (G >> 3) + (c >> 3);
        if (q < cnt * 3) { int rl, pn; grp_unit(q, cnt, 3, 4, rl, pn); const int pm = r0 + rl;
            u.a = H + (size_t)pm * 256 * D * 2; u.b = Wqkv + (size_t)pn * 256 * D * 2; u.o = QKV + ((size_t)pm * 256 * 768 + pn * 256) * 2; u.ldo = 768; return true; }
        q -= cnt * 3; if (q >= cnt * 4) return false;
        int rl, pm; grp_unit(q, cnt, 4, 4, rl, pm); const int tt = r0 + rl, isq = pm >> 1, ch0 = (pm & 1) * 256;
        u.a = Wpq + (size_t)pm * 256 * D * 2; u.b = H + (size_t)tt * 256 * D * 2;
        if (tt < TL / 256) { const int b = tt >> 4, n0 = (tt & 15) * 256; u.o = PQT + ((((size_t)b * 512 + ch0) * 2 + isq) * 4096 + n0) * 2; u.ldo = 8192; }
        else { const int b = tt - TL / 256; u.o = PQTC + (((size_t)b * 512 + ch0) * 2 + isq) * 256 * 2; u.ldo = 512; }
        return true;
    }
};
struct SchedDft {
    int G, c; const char* FDm; const char* VB; const char* F2; const char* PQTC; char* MIX;
    __device__ __forceinline__ bool next(int i, Unit& u) const {
        int L = i * G + c; u.p0 = nullptr; u.p1 = nullptr; u.x0 = 0;
        if (L < 512) { const int b = L >> 5, pn = L & 31, k2 = pn >> 1, ch0 = (pn & 1) * 256;
            u.a = FDm; u.b = VB + ((((size_t)b * 16 + k2) * 512 + ch0) * 512) * 2; u.o = MIX + ((((size_t)b * 4096 + k2) * D) + ch0) * 2; u.ldo = 16 * D; return true; }
        L -= 512; if (L >= 32) return false;
        const int b = L >> 1, pn = L & 1;
        u.a = F2; u.b = PQTC + ((size_t)b * 512 + pn * 256) * 512 * 2; u.o = MIX + (((size_t)TL + (size_t)b * 256) * D + pn * 256) * 2; u.ldo = D; return true;
    }
};
struct SchedResid {
    int G, c, nUnits; const char* A; size_t aStep; const char* W; size_t bStep; const float* xl; const float* xc; float* zl; float* zc; const float* gate;
    __device__ __forceinline__ bool next(int i, Unit& u) const {
        int pm, pn; if (!xcd_unit(i, G, c, nUnits >> 2, 4, 1, pm, pn)) return false;
        const int L = pm * 4 + pn;
        u.a = A + (size_t)pm * aStep; u.b = W + (size_t)pn * bStep;
        const bool isc = pm >= TL / 256; const int pr = isc ? pm - TL / 256 : pm; const int mrow = isc ? 16 : (pm >> 4);
        const size_t off = ((size_t)pr * 256 * D + pn * 256);
        u.p0 = (const char*)((isc ? xc : xl) + off); u.o = (char*)((isc ? zc : zl) + off); u.p1 = (const char*)(gate + (size_t)mrow * 6144 + pn * 256); u.ldo = D; u.x0 = L; return true;
    }
};
struct SchedGlu {
    int G, c; const char* P; const char* W; char* MIX; const float* bias;
    __device__ __forceinline__ bool next(int i, Unit& u) const {
        const int L = i * G + c; if (L >= (T / 256) * 2) return false;
        const int pm = L >> 1, pn = L & 1;
        u.a = P + (size_t)pm * 256 * 1536 * 2; u.b = W + (size_t)pn * 256 * 512 * 2; u.o = MIX + ((size_t)pm * 256 * D + pn * 256) * 2;
        u.p0 = P + ((size_t)pm * 256 * 1536 + pn * 256) * 2; u.p1 = (const char*)(bias + pn * 256); u.ldo = D; u.x0 = 1536; return true;
    }
};
struct SchedS5A {
    int G, c; const char* P; const char* WA; char* Y1; char* HB;
    __device__ __forceinline__ bool next(int i, Unit& u) const {
        const int L = i * G + c; if (L >= 32 * 34) return false;
        const int g = L / 34, rem = L - g * 34, pm = rem >> 1, pn = rem & 1;
        u.a = P + ((size_t)pm * 256 * 16 * 1536 + g * 16) * 2; u.b = WA + (size_t)g * S5M_STRIDE + (size_t)pn * 256 * 256 * 2;
        u.o = (pn ? HB : Y1) + (((size_t)pm * 256 * 32 + g) * 256) * 2; u.p0 = nullptr; u.p1 = nullptr; u.ldo = 8192; u.x0 = 0; return true;
    }
};
struct SchedS5B {
    int G, c; const char* HB; const char* CL; const char* Y1; char* P;
    __device__ __forceinline__ bool next(int i, Unit& u) const {
        const int L = i * G + c; if (L >= 32 * 17) return false;
        const int g = L / 17, pm = L - g * 17;
        const size_t toff = (((size_t)pm * 256 * 32 + g) * 256) * 2;
        u.a = HB + toff; u.b = CL + (size_t)g * S5M_STRIDE; u.p0 = Y1 + toff; u.o = P + ((size_t)pm * 256 * 16 * 1536 + g * 16) * 2; u.p1 = nullptr; u.ldo = 0; u.x0 = 0; return true;
    }
};
struct SchedMoeUp {
    int G, c, nUnits, rt0; int toff[9]; const char* HS; const char* W; char* HID;
    __device__ __forceinline__ bool next(int i, Unit& u) const {
        int rl, pn; if (!xcd_unit(i, G, c, nUnits / 28, 28, 4, rl, pn)) return false;
        const int rt = rt0 + rl; int e = 0;
#pragma unroll
        for (int k = 1; k < 8; ++k) e += (rt >= toff[k]) ? 1 : 0;
        u.a = HS + (size_t)rt * 256 * D; u.b = W + ((size_t)e * 7168 + pn * 256) * D; u.o = HID + ((size_t)rl * 256 * EH + pn * 128);
        u.p0 = nullptr; u.p1 = nullptr; u.ldo = EH; u.x0 = 0; return true;
    }
};
struct SchedMoeDown {
    int G, c, nUnits, rt0; int toff[9]; const char* HID; const char* W; char* Y;
    __device__ __forceinline__ bool next(int i, Unit& u) const {
        int rl, pn; if (!xcd_unit(i, G, c, nUnits >> 2, 4, 8, rl, pn)) return false;
        const int rt = rt0 + rl; int e = 0;
#pragma unroll
        for (int k = 1; k < 8; ++k) e += (rt >= toff[k]) ? 1 : 0;
        u.a = HID + (size_t)rl * 256 * EH; u.b = W + ((size_t)e * 1024 + pn * 256) * EH; u.o = Y + ((size_t)rt * 256 * D + pn * 256) * 2;
        u.p0 = nullptr; u.p1 = nullptr; u.ldo = D; u.x0 = 0; return true;
    }
};

__device__ __forceinline__ void tr_item(const float* W, int ldn, bf16* WT, int ldk, int k0, int n0, int drow0, LAS float* scr, int lane) {
#pragma unroll 8
    for (int i = 0; i < 32; ++i) { const int kk = 2 * i + (lane >> 5); scr[kk * 33 + (lane & 31)] = W[(size_t)(k0 + kk) * ldn + n0 + (lane & 31)]; }
    LDS_WAIT(); asm volatile("" ::: "memory");
    const int c = lane & 7;
#pragma unroll
    for (int j = 0; j < 4; ++j) { const int n = (lane >> 3) + 8 * j; const LAS float* s = scr + (8 * c) * 33 + n;
        v4u o; o.x = cvt_pk_bf16(s[0 * 33], s[1 * 33]); o.y = cvt_pk_bf16(s[2 * 33], s[3 * 33]); o.z = cvt_pk_bf16(s[4 * 33], s[5 * 33]); o.w = cvt_pk_bf16(s[6 * 33], s[7 * 33]);
        *(v4u*)(WT + (size_t)(drow0 + n) * ldk + k0 + 8 * c) = o; }
    LDS_WAIT(); asm volatile("" ::: "memory");
}
__device__ __forceinline__ void tr_item8(const float* W, int ldn, unsigned char* WT, int ldk, int k0, int n0, int drow0, LAS float* scr, int lane, float qs) {
#pragma unroll 8
    for (int i = 0; i < 32; ++i) { const int kk = 2 * i + (lane >> 5); scr[kk * 33 + (lane & 31)] = W[(size_t)(k0 + kk) * ldn + n0 + (lane & 31)] * qs; }
    LDS_WAIT(); asm volatile("" ::: "memory");
    const int c = lane & 7;
#pragma unroll
    for (int j = 0; j < 4; ++j) { const int n = (lane >> 3) + 8 * j; const LAS float* sp = scr + (8 * c) * 33 + n;
        v2u o; o.x = pk_fp8x4(sp[0 * 33], sp[1 * 33], sp[2 * 33], sp[3 * 33]); o.y = pk_fp8x4(sp[4 * 33], sp[5 * 33], sp[6 * 33], sp[7 * 33]);
        *(v2u*)(WT + (size_t)(drow0 + n) * ldk + k0 + 8 * c) = o; }
    LDS_WAIT(); asm volatile("" ::: "memory");
}
__device__ __forceinline__ void tr_job8(const float* W, int ldn, int N, unsigned char* WT, int ldk, int mode, int roff, int item, LAS float* scr, int lane) {
    const int nblk = N / 32, kb = item / nblk, nb = item - kb * nblk, n0 = nb * 32;
    const int drow0 = mode ? ((n0 >> 7) * 256 + (n0 & 127) + roff) : (roff + n0);
    tr_item8(W, ldn, WT, ldk, kb * 64, n0, drow0, scr, lane, Q_W);
}
__device__ __forceinline__ void tr_job(const float* W, int ldn, int N, bf16* WT, int ldk, int mode, int roff, int item, LAS float* scr, int lane) {
    const int nblk = N / 32, kb = item / nblk, nb = item - kb * nblk, n0 = nb * 32;
    const int drow0 = mode ? ((n0 >> 7) * 256 + (n0 & 127) + roff) : (roff + n0);
    tr_item(W, ldn, WT, ldk, kb * 64, n0, drow0, scr, lane);
}
__device__ __forceinline__ void cvt_item(const Params& p, int r, LAS float* scr, int lane) {
    unsigned char* ws = p.ws;
    constexpr int EV_ITEMS = 384 + 512 + 3 * 1408;
    constexpr int ODS_ITEMS = 768 + 128 + 512;
    constexpr int EXP_ITEMS = 3 * 1792, MOE_ITEMS = 8 * EXP_ITEMS;
    if (r < 2 * EV_ITEMS) { const int li = r / EV_ITEMS; r -= li * EV_ITEMS; unsigned char* base = ws + WS_EV + li * EV_STRIDE;
        if (r < 384) { tr_job(p.in[I_EV_WIN] + (size_t)li * D * 1280 + 512, 1280, 768, (bf16*)(base + EV_WQKV), D, 0, 0, r, scr, lane); return; } r -= 384;
        if (r < 512) { tr_job(p.in[I_EV_WOUT] + (size_t)li * D * D, D, D, (bf16*)(base + EV_WOUT), D, 0, 0, r, scr, lane); return; } r -= 512;
        if (r < 1408) { tr_job(p.in[I_EV_W1] + (size_t)li * D * FFH, FFH, FFH, (bf16*)(base + EV_W13), D, 1, 0, r, scr, lane); return; } r -= 1408;
        if (r < 1408) { tr_job(p.in[I_EV_W3] + (size_t)li * D * FFH, FFH, FFH, (bf16*)(base + EV_W13), D, 1, 128, r, scr, lane); return; } r -= 1408;
        tr_job(p.in[I_EV_W2] + (size_t)li * FFH * D, D, D, (bf16*)(base + EV_W2), FFH, 0, 0, r, scr, lane); return; }
    r -= 2 * EV_ITEMS;
    if (r < 2 * ODS_ITEMS) { const int li = r / ODS_ITEMS; r -= li * ODS_ITEMS; unsigned char* base = ws + WS_OD + li * OD_STRIDE;
        if (r < 768) { tr_job(p.in[I_OD_WIN] + (size_t)li * D * 1536, 1536, 1536, (bf16*)(base + OD_WIN), D, 0, 0, r, scr, lane); return; } r -= 768;
        if (r < 128) { tr_job(p.in[I_WGLU] + (size_t)li * 512 * 512, 512, 512, (bf16*)(base + OD_WGLU), 512, 0, 0, r, scr, lane); return; } r -= 128;
        tr_job(p.in[I_OD_WOUT] + (size_t)li * D * D, D, D, (bf16*)(base + OD_WOUT), D, 0, 0, r, scr, lane); return; }
    r -= 2 * ODS_ITEMS;
    { const int li = r / MOE_ITEMS; r -= li * MOE_ITEMS; const int e = r / EXP_ITEMS; r -= e * EXP_ITEMS; unsigned char* base = ws + WS_OD + li * OD_STRIDE;
        const size_t we = (size_t)li * NEXP + e;
        if (r < 1792) { tr_job8(p.in[I_MW1] + we * D * EH, EH, EH, (unsigned char*)(base + OD_MW13) + (size_t)e * 7168 * D, D, 1, 0, r, scr, lane); return; } r -= 1792;
        if (r < 1792) { tr_job8(p.in[I_MW3] + we * D * EH, EH, EH, (unsigned char*)(base + OD_MW13) + (size_t)e * 7168 * D, D, 1, 128, r, scr, lane); return; } r -= 1792;
        tr_job8(p.in[I_MW2] + we * EH * D, D, D, (unsigned char*)(base + OD_MW2) + (size_t)e * D * EH, EH, 0, 0, r, scr, lane); }
}
constexpr int CVT_ITEMS = 2 * 5120 + 2 * 1408 + 2 * 8 * 3 * 1792;

__device__ __forceinline__ void fold_unit(const Params& p, Frame& F, int unit) {
    const int li = unit >> 6, g = (unit >> 4) & 3, k0 = (unit & 15) * 64;
    LAS float* tile = (LAS float*)F.lds;
    LAS float* trig = tile + 64 * 129;
    const float* W = p.in[I_EV_WIN] + (size_t)li * D * 1280;
    for (int e = F.tid; e < 64 * 128; e += NTHREADS) { const int k = e >> 7, c = e & 127; tile[k * 129 + c] = W[(size_t)(k0 + k) * 1280 + g * 128 + c]; }
    if (F.tid < 128) { float s, c; sincospif((float)F.tid / 64.0f, &s, &c); trig[F.tid] = c * 0.08838834764831845f; trig[128 + F.tid] = s * 0.08838834764831845f; }
    __syncthreads();
    bf16* WT = (bf16*)(p.ws + WS_EV + li * EV_STRIDE + EV_WPQ);
    const int k = F.lane, mg = F.wave;
    for (int mm = 0; mm < 16; ++mm) { const int m = mg * 16 + mm; float sp = 0.f, sq = 0.f;
        for (int c = 0; c < 128; ++c) { const float w = tile[k * 129 + c]; const int ph = (m * c) & 127; sp += w * trig[ph]; sq += w * trig[128 + ph]; }
        WT[(size_t)(g * 128 + m) * D + k0 + k] = f2bf(sp); WT[(size_t)(512 + g * 128 + m) * D + k0 + k] = f2bf(sq); }
    __syncthreads();
}

__device__ __forceinline__ void row_load(const float* row, int lane, f32x4 (&v)[4]) {
#pragma unroll
    for (int j = 0; j < 4; ++j) v[j] = *(const f32x4*)(row + 256 * j + 4 * lane);
}
__device__ __forceinline__ void row_store(float* row, int lane, const f32x4 (&v)[4]) {
#pragma unroll
    for (int j = 0; j < 4; ++j) *(f32x4*)(row + 256 * j + 4 * lane) = v[j];
}
__device__ __forceinline__ void row_store_bf16(bf16* row, int lane, const f32x4 (&v)[4]) {
#pragma unroll
    for (int j = 0; j < 4; ++j) { v2u w; w.x = cvt_pk_bf16(v[j][0], v[j][1]); w.y = cvt_pk_bf16(v[j][2], v[j][3]); *(v2u*)(row + 256 * j + 4 * lane) = w; }
}
__device__ __forceinline__ void row_layernorm(f32x4 (&v)[4], const float* g, const float* b, int lane) {
    float s = 0.f;
#pragma unroll
    for (int j = 0; j < 4; ++j) s += (v[j][0] + v[j][1]) + (v[j][2] + v[j][3]);
    const float mean = wave_sum(s) * (1.f / D); float q = 0.f;
#pragma unroll
    for (int j = 0; j < 4; ++j) { v[j] = v[j] - mean; q += (v[j][0] * v[j][0] + v[j][1] * v[j][1]) + (v[j][2] * v[j][2] + v[j][3] * v[j][3]); }
    const float rstd = rsqrtf(wave_sum(q) * (1.f / D) + LN_EPS);
#pragma unroll
    for (int j = 0; j < 4; ++j) { const f32x4 gg = *(const f32x4*)(g + 256 * j + 4 * lane), bb = *(const f32x4*)(b + 256 * j + 4 * lane); v[j] = v[j] * rstd * gg + bb; }
}
__device__ __forceinline__ void row_modulate(f32x4 (&h)[4], const f32x4 (&v)[4], const float* sc, const float* sh, int lane) {
#pragma unroll
    for (int j = 0; j < 4; ++j) { const f32x4 s = *(const f32x4*)(sc + 256 * j + 4 * lane), t = *(const f32x4*)(sh + 256 * j + 4 * lane); h[j] = v[j] * (s + 1.0f) + t; }
}

__device__ __forceinline__ void row_ln_pre(f32x4 (&v)[4], const f32x4 (&gg)[4], const f32x4 (&bb)[4]) {
    float s = 0.f;
#pragma unroll
    for (int j = 0; j < 4; ++j) s += (v[j][0] + v[j][1]) + (v[j][2] + v[j][3]);
    const float mean = wave_sum(s) * (1.f / D); float q = 0.f;
#pragma unroll
    for (int j = 0; j < 4; ++j) { v[j] = v[j] - mean; q += (v[j][0] * v[j][0] + v[j][1] * v[j][1]) + (v[j][2] * v[j][2] + v[j][3] * v[j][3]); }
    const float rstd = rsqrtf(wave_sum(q) * (1.f / D) + LN_EPS);
#pragma unroll
    for (int j = 0; j < 4; ++j) v[j] = v[j] * rstd * gg[j] + bb[j];
}
__device__ __forceinline__ void row_load_mod(const float* sc, const float* sh, int lane, f32x4 (&s)[4], f32x4 (&t)[4]) {
#pragma unroll
    for (int j = 0; j < 4; ++j) { s[j] = *(const f32x4*)(sc + 256 * j + 4 * lane); t[j] = *(const f32x4*)(sh + 256 * j + 4 * lane); }
}
typedef const __attribute__((address_space(4))) Params* PP;
#define PIN(i) ((const float*)pp->in[i])
#define DECL_LDS extern __shared__ __attribute__((aligned(16))) unsigned char lds_raw[]
#define PHASE_FN static __device__ __forceinline__ void

__device__ __forceinline__ Frame make_frame(PP pp, unsigned char* lds_generic) {
    Frame F;
    F.lds = (LAS unsigned char*)lds_generic;
    { int t_ = threadIdx.x; asm volatile("" : "+v"(t_)); F.tid = t_; }
    F.lane = F.tid & 63; F.wave = __builtin_amdgcn_readfirstlane(F.tid >> 6);
    F.G = gridDim.x; F.bid = blockIdx.x; F.gw = F.bid * NWAVES + F.wave; F.NGW = F.G * NWAVES;
    F.ws = (unsigned char*)pp->ws; F.ctl = (unsigned*)(F.ws + WS_CTL);
    return F;
}
#define FRAME() DECL_LDS; asm volatile("" : "+s"(pp)); Frame F = make_frame(pp, lds_raw); unsigned char* ws = F.ws; (void)ws

PHASE_FN grid_bar(PP pp) {
    FRAME();
    XcdBarrier bar; bar.bar = F.ctl + CW_BAR; bar.x = xb_xcc_id(); bar.st = (volatile LAS unsigned*)(F.lds + LDS_MISC) + 8;
    xcd_barrier(bar);
}

static __device__ __forceinline__ void ln_pass(const Frame& F, float* out, float* XC, bf16* Hb, const float* lng, const float* lnb, const float* modv, const int sc_off, const int sh_off, const int TR) {
    f32x4 gg[4], bb[4];
#pragma unroll
    for (int j = 0; j < 4; ++j) { gg[j] = *(const f32x4*)(lng + 256 * j + 4 * F.lane); bb[j] = *(const f32x4*)(lnb + 256 * j + 4 * F.lane); }
    for (int r0 = F.gw; r0 < TR; r0 += 2 * F.NGW) {
        const int r1 = r0 + F.NGW; const bool two = r1 < TR;
        const bool c0 = r0 >= TL, c1 = r1 >= TL;
        float* x0 = c0 ? XC + (size_t)(r0 - TL) * D : out + (size_t)r0 * D; float* x1 = two ? (c1 ? XC + (size_t)(r1 - TL) * D : out + (size_t)r1 * D) : x0;
        const float* m0 = modv + (size_t)(c0 ? 16 : (r0 >> 12)) * 6144; const float* m1 = modv + (size_t)((two && !c1) ? (r1 >> 12) : 16) * 6144;
        f32x4 v0[4], v1[4], s0[4], t0[4], s1[4], t1[4];
        row_load(x0, F.lane, v0); row_load(x1, F.lane, v1);
        row_load_mod(m0 + sc_off, m0 + sh_off, F.lane, s0, t0); row_load_mod(m1 + sc_off, m1 + sh_off, F.lane, s1, t1);
        row_ln_pre(v0, gg, bb); row_ln_pre(v1, gg, bb);
        row_store(x0, F.lane, v0);
#pragma unroll
        for (int j = 0; j < 4; ++j) s0[j] = v0[j] * (s0[j] + 1.0f) + t0[j];
        row_store_bf16(Hb + (size_t)r0 * D, F.lane, s0);
        if (two) { row_store(x1, F.lane, v1);
#pragma unroll
            for (int j = 0; j < 4; ++j) s1[j] = v1[j] * (s1[j] + 1.0f) + t1[j];
            row_store_bf16(Hb + (size_t)r1 * D, F.lane, s1); }
    }
}
PHASE_FN ph_fold(PP pp) {
    FRAME();
    Params p; p.ws = ws; p.in[I_EV_WIN] = PIN(I_EV_WIN);
    for (int u = F.bid; u < 128; u += F.G) fold_unit(p, F, u);
}
PHASE_FN ph_mod(PP pp) {
    FRAME();
    float* MOD = (float*)(ws + WS_MOD);
    LAS float* sc = (LAS float*)F.lds;
    const float* cin = PIN(I_C); const float* ccin = PIN(I_CCTX);
    __syncthreads();
    for (int e = F.tid; e < 17 * D; e += NTHREADS) { const int r = e >> 10, k = e & 1023; const float v = (r < 16) ? cin[r * D + k] : ccin[k]; sc[e] = silu_f(v); }
    __syncthreads();
    const int kq = F.lane >> 4, cl = F.lane & 15;
    for (int task = F.gw; task < DEPTH * 6144 / 16; task += F.NGW) {
        const int col = task * 16 + cl, l = col / 6144, j = col - l * 6144;
        const float* W = PIN(I_WMOD) + (size_t)l * D * 6144 + (size_t)(kq * 256) * 6144 + j;
        float acc[17];
#pragma unroll
        for (int r = 0; r < 17; ++r) acc[r] = 0.f;
        for (int k0 = 0; k0 < 256; k0 += 16) {
            float w[16];
#pragma unroll
            for (int q = 0; q < 16; ++q) w[q] = W[(size_t)(k0 + q) * 6144];
#pragma unroll
            for (int q4 = 0; q4 < 4; ++q4)
#pragma unroll
                for (int r = 0; r < 17; ++r) { const f32x4 sv = *(const LAS f32x4*)(sc + r * D + kq * 256 + k0 + 4 * q4); acc[r] += (sv[0] * w[4 * q4] + sv[1] * w[4 * q4 + 1]) + (sv[2] * w[4 * q4 + 2] + sv[3] * w[4 * q4 + 3]); }
        }
        const float bm = PIN(I_BMOD)[l * 6144 + j];
#pragma unroll
        for (int r = 0; r < 17; ++r) { float v = acc[r]; v += __shfl_xor(v, 16); v += __shfl_xor(v, 32); if (kq == 0) MOD[((size_t)l * 17 + r) * 6144 + j] = v + bm; }
    }
    __syncthreads();
}
PHASE_FN ph_cvt(PP pp) {
    FRAME();
    Params p; p.ws = ws;
    p.in[I_EV_WIN] = PIN(I_EV_WIN); p.in[I_EV_WOUT] = PIN(I_EV_WOUT); p.in[I_EV_W1] = PIN(I_EV_W1); p.in[I_EV_W3] = PIN(I_EV_W3); p.in[I_EV_W2] = PIN(I_EV_W2);
    p.in[I_OD_WIN] = PIN(I_OD_WIN); p.in[I_WGLU] = PIN(I_WGLU); p.in[I_OD_WOUT] = PIN(I_OD_WOUT); p.in[I_MW1] = PIN(I_MW1); p.in[I_MW3] = PIN(I_MW3); p.in[I_MW2] = PIN(I_MW2);
    LAS float* scr = (LAS float*)(F.lds + F.wave * 16384);
    for (int it = F.gw; it < CVT_ITEMS; it += F.NGW) cvt_item(p, it, scr, F.lane);
}
PHASE_FN ph_dftmat(PP pp) {
    FRAME();
    bf16* FDm = (bf16*)(ws + WS_FD); bf16* F2 = (bf16*)(ws + WS_F256);
    for (int it = F.bid * NTHREADS + F.tid; it < 2 * 256 * 64; it += F.G * NTHREADS) {
        const int which = it >> 14, k = (it >> 6) & 255, n0 = (it & 63) * 8; const bool isq = n0 >= 256; const int nb = n0 & 255;
        float v[8];
#pragma unroll
        for (int j = 0; j < 8; ++j) { const int phs = (k * (nb + j)) & 255; float sn, cs; sincospif((float)phs * (1.0f / 128.0f), &sn, &cs);
            v[j] = which ? (isq ? -sn * (1.f / 16.f) : cs * (1.f / 16.f)) : (isq ? sn * (1.f / 64.f) : cs * (1.f / 64.f)); }
        v4u w; w.x = cvt_pk_bf16(v[0], v[1]); w.y = cvt_pk_bf16(v[2], v[3]); w.z = cvt_pk_bf16(v[4], v[5]); w.w = cvt_pk_bf16(v[6], v[7]);
        *(v4u*)((which ? F2 : FDm) + (size_t)k * 512 + n0) = w;
    }
}
PHASE_FN ph_s5mat(PP pp) {
    FRAME();
    LAS float* lam = (LAS float*)F.lds;
    LAS float* bb = lam + 2 * 64 * 17 * 2;
    LAS float* cc = bb + 2 * 64 * 16 * 2;
    LAS float* kt = cc + 2 * 16 * 64 * 2;
    for (int unit = F.bid; unit < 64; unit += F.G) {
        const int li = unit >> 5, g = unit & 31;
        __syncthreads();
        if (F.tid < 128) { const int d = F.tid >> 6, pl = F.tid & 63; const int sidx = ((li * 2 + d) * 32 + g);
            const float are = PIN(I_A_RE)[sidx * 64 + pl], aim = PIN(I_A_IM)[sidx * 64 + pl], dt = expf(PIN(I_LOG_DT)[sidx]);
            for (int e = 0; e <= 16; ++e) { const float mag = expf(are * dt * (float)e); float sn, cn; sincosf(aim * dt * (float)e, &sn, &cn); lam[((d * 64 + pl) * 17 + e) * 2] = mag * cn; lam[((d * 64 + pl) * 17 + e) * 2 + 1] = mag * sn; } }
        __syncthreads();
        for (int e = F.tid; e < 2048; e += NTHREADS) { const int d = e >> 10, pl = (e >> 4) & 63, sp = e & 15; const int sidx = ((li * 2 + d) * 32 + g);
            const float are = PIN(I_A_RE)[sidx * 64 + pl], aim = PIN(I_A_IM)[sidx * 64 + pl];
            const float lre = lam[((d * 64 + pl) * 17 + 1) * 2], lim = lam[((d * 64 + pl) * 17 + 1) * 2 + 1];
            const float den = 1.0f / (are * are + aim * aim);
            const float fre = ((lre - 1.0f) * are + lim * aim) * den, fim = (lim * are - (lre - 1.0f) * aim) * den;
            const float br = PIN(I_B_RE)[((size_t)sidx * 64 + pl) * 16 + sp], bi = PIN(I_B_IM)[((size_t)sidx * 64 + pl) * 16 + sp];
            bb[e * 2] = fre * br - fim * bi; bb[e * 2 + 1] = fre * bi + fim * br; }
        for (int e = F.tid; e < 2048; e += NTHREADS) { const int d = e >> 10, sq = (e >> 6) & 15, pl = e & 63; const int sidx = ((li * 2 + d) * 32 + g);
            cc[e * 2] = PIN(I_C_RE)[((size_t)sidx * 16 + sq) * 64 + pl]; cc[e * 2 + 1] = PIN(I_C_IM)[((size_t)sidx * 16 + sq) * 64 + pl]; }
        __syncthreads();
        for (int e = F.tid; e < 8192; e += NTHREADS) { const int d = e >> 12, tau = (e >> 8) & 15, sq = (e >> 4) & 15, sp = e & 15; float acc = 0.f;
            for (int pl = 0; pl < 64; ++pl) { const float cr = cc[((d * 16 + sq) * 64 + pl) * 2], ci = cc[((d * 16 + sq) * 64 + pl) * 2 + 1];
                const float lr = lam[((d * 64 + pl) * 17 + tau) * 2], lj = lam[((d * 64 + pl) * 17 + tau) * 2 + 1];
                const float br = bb[((d * 64 + pl) * 16 + sp) * 2], bi = bb[((d * 64 + pl) * 16 + sp) * 2 + 1];
                const float tr = cr * lr - ci * lj, ti = cr * lj + ci * lr;
                acc += tr * br - ti * bi; }
            kt[e] = acc; }
        __syncthreads();
        bf16* WA = (bf16*)(ws + WS_S5M + (size_t)unit * S5M_STRIDE); bf16* CLm = WA + 512 * 256;
        const float* dsk = PIN(I_SSM_D) + (size_t)li * 512 + g * 16;
        for (int it = F.tid; it < 8192; it += NTHREADS) { const int row = it >> 5, c0 = (it & 31) * 8;
            float v[8];
            { const int i = row >> 4, sq = row & 15, j = c0 >> 4, sp0 = c0 & 15;
#pragma unroll
              for (int q = 0; q < 8; ++q) { const int sp = sp0 + q; float a = 0.f; if (i >= j) a += kt[((0 * 16 + (i - j)) * 16 + sq) * 16 + sp]; if (j >= i) a += kt[((1 * 16 + (j - i)) * 16 + sq) * 16 + sp]; if (i == j && sq == sp) a += dsk[sq]; v[q] = a; }
              v4u w; w.x = cvt_pk_bf16(v[0], v[1]); w.y = cvt_pk_bf16(v[2], v[3]); w.z = cvt_pk_bf16(v[4], v[5]); w.w = cvt_pk_bf16(v[6], v[7]); *(v4u*)(WA + (size_t)row * 256 + c0) = w; }
            { const int d = row >> 7, pl = (row >> 1) & 63, ri = row & 1, j = c0 >> 4, sp0 = c0 & 15, e = d ? j : 15 - j;
              const float lr = lam[((d * 64 + pl) * 17 + e) * 2], lj = lam[((d * 64 + pl) * 17 + e) * 2 + 1];
#pragma unroll
              for (int q = 0; q < 8; ++q) { const float br = bb[((d * 64 + pl) * 16 + sp0 + q) * 2], bi = bb[((d * 64 + pl) * 16 + sp0 + q) * 2 + 1]; v[q] = ri ? (lr * bi + lj * br) : (lr * br - lj * bi); }
              v4u w; w.x = cvt_pk_bf16(v[0], v[1]); w.y = cvt_pk_bf16(v[2], v[3]); w.z = cvt_pk_bf16(v[4], v[5]); w.w = cvt_pk_bf16(v[6], v[7]); *(v4u*)(WA + (size_t)(256 + row) * 256 + c0) = w; }
            { const int i = row >> 4, sq = row & 15, d = c0 >> 7, pl0 = (c0 >> 1) & 63, e = d ? 16 - i : i + 1;
#pragma unroll
              for (int q = 0; q < 4; ++q) { const int pl = pl0 + q; const float cr = cc[((d * 16 + sq) * 64 + pl) * 2], ci = cc[((d * 16 + sq) * 64 + pl) * 2 + 1];
                  const float lr = lam[((d * 64 + pl) * 17 + e) * 2], lj = lam[((d * 64 + pl) * 17 + e) * 2 + 1];
                  v[2 * q] = cr * lr - ci * lj; v[2 * q + 1] = -(cr * lj + ci * lr); }
              v4u w; w.x = cvt_pk_bf16(v[0], v[1]); w.y = cvt_pk_bf16(v[2], v[3]); w.z = cvt_pk_bf16(v[4], v[5]); w.w = cvt_pk_bf16(v[6], v[7]); *(v4u*)(CLm + (size_t)row * 256 + c0) = w; }
        }
    }
    __syncthreads();
}
PHASE_FN ph_pro_b(PP pp) {
    FRAME();
    const float* MOD = (const float*)(ws + WS_MOD); bf16* Hb = (bf16*)(ws + WS_H);
    const float* xin = PIN(I_X); const float* cin = PIN(I_CTX);
    for (int r = F.gw; r < T; r += F.NGW) {
        const bool isc = r >= TL; const float* xr = isc ? cin + (size_t)(r - TL) * D : xin + (size_t)r * D;
        const float* m = MOD + (size_t)(isc ? 16 : (r >> 12)) * 6144;
        f32x4 v[4], h[4]; row_load(xr, F.lane, v); row_modulate(h, v, m + 1024, m, F.lane); row_store_bf16(Hb + (size_t)r * D, F.lane, h);
    }
}

PHASE_FN ph_e1(PP pp, int layer) {
    FRAME();
    unsigned char* evw = ws + WS_EV + (layer >> 1) * EV_STRIDE; unsigned char* BIG = ws + WS_BIG;
    SchedEvIn S{F.G, F.bid, (const char*)(ws + WS_H), (const char*)(evw + EV_WQKV), (const char*)(evw + EV_WPQ), (char*)(BIG + BIG_QKV), (char*)(BIG + BIG_PQT), (char*)(BIG + BIG_PQTC)};
    pg8::gemm_phase<pg8::EpiStore, SchedEvIn, true, true>(F.lds, F.tid, pg8::Dims{D, D, D}, S, pg8::EpiStore{});
}
struct cf { float r, i; };
__device__ __forceinline__ cf cmul(cf a, float wr, float wi) { return cf{a.r * wr - a.i * wi, a.r * wi + a.i * wr}; }
__device__ __forceinline__ void radix4(cf x0, cf x1, cf x2, cf x3, cf& y0, cf& y1, cf& y2, cf& y3) {
    const cf s02{x0.r + x2.r, x0.i + x2.i}, d02{x0.r - x2.r, x0.i - x2.i}, s13{x1.r + x3.r, x1.i + x3.i}, d13{x1.r - x3.r, x1.i - x3.i};
    y0 = cf{s02.r + s13.r, s02.i + s13.i}; y2 = cf{s02.r - s13.r, s02.i - s13.i}; y1 = cf{d02.r + d13.i, d02.i - d13.r}; y3 = cf{d02.r - d13.i, d02.i + d13.r};
}
__device__ __forceinline__ void fft16(cf (&x)[16]) {
    constexpr float C1 = 0.92387953251128674f, S1 = 0.38268343236508977f, C2 = 0.70710678118654752f;
    cf A[4][4];
#pragma unroll
    for (int b = 0; b < 4; ++b) radix4(x[b], x[4 + b], x[8 + b], x[12 + b], A[b][0], A[b][1], A[b][2], A[b][3]);
    A[1][1] = cmul(A[1][1], C1, -S1); A[1][2] = cmul(A[1][2], C2, -C2); A[1][3] = cmul(A[1][3], S1, -C1);
    A[2][1] = cmul(A[2][1], C2, -C2); A[2][2] = cf{A[2][2].i, -A[2][2].r}; A[2][3] = cmul(A[2][3], -C2, -C2);
    A[3][1] = cmul(A[3][1], S1, -C1); A[3][2] = cmul(A[3][2], -C2, -C2); A[3][3] = cmul(A[3][3], -C1, S1);
#pragma unroll
    for (int c = 0; c < 4; ++c) radix4(A[0][c], A[1][c], A[2][c], A[3][c], x[c], x[c + 4], x[c + 8], x[c + 12]);
}
PHASE_FN ph_e2_fft(PP pp) {
    FRAME();
    const bf16* PQT = (const bf16*)(ws + WS_BIG + BIG_PQT); bf16* VB = (bf16*)(ws + WS_H);
    for (int it = F.bid * NTHREADS + F.tid; it < NBATCH * 512 * 128; it += F.G * NTHREADS) {
        const int n1 = (it & 127) * 2, ch = (it >> 7) & 511, b = it >> 16;
        const bf16* pp_ = PQT + ((size_t)(b * 512 + ch) * 2) * 4096 + n1; const bf16* qq_ = pp_ + 4096;
        unsigned pw[16], qw[16];
#pragma unroll
        for (int n2 = 0; n2 < 16; ++n2) { pw[n2] = *(const unsigned*)(pp_ + 256 * n2); qw[n2] = *(const unsigned*)(qq_ + 256 * n2); }
        unsigned ore[16], oim[16];
#pragma unroll
        for (int e = 0; e < 2; ++e) {
            cf x[16];
#pragma unroll
            for (int n2 = 0; n2 < 16; ++n2) { x[n2].r = e ? bfhi(pw[n2]) : bflo(pw[n2]); x[n2].i = -(e ? bfhi(qw[n2]) : bflo(qw[n2])); }
            fft16(x);
            float sn, cs; sincospif((float)(n1 + e) * (1.0f / 2048.0f), &sn, &cs);
            cf wk{cs, -sn};
#pragma unroll
            for (int k2 = 1; k2 < 16; ++k2) { x[k2] = cmul(x[k2], wk.r, wk.i); wk = cmul(wk, cs, -sn); }
#pragma unroll
            for (int k2 = 0; k2 < 16; ++k2) { const unsigned rr = cvt_pk_bf16(x[k2].r, 0.f) & 0xffffu, ii = cvt_pk_bf16(x[k2].i, 0.f) & 0xffffu;
                if (e) { ore[k2] |= rr << 16; oim[k2] |= ii << 16; } else { ore[k2] = rr; oim[k2] = ii; } }
        }
#pragma unroll
        for (int k2 = 0; k2 < 16; ++k2) { bf16* dst = VB + (((size_t)b * 16 + k2) * 512 + ch) * 512 + n1; *(unsigned*)dst = ore[k2]; *(unsigned*)(dst + 256) = oim[k2]; }
    }
}
PHASE_FN ph_e2_dft(PP pp) {
    FRAME();
    unsigned char* BIG = ws + WS_BIG;
    SchedDft S{F.G, F.bid, (const char*)(ws + WS_FD), (const char*)(ws + WS_H), (const char*)(ws + WS_F256), (const char*)(BIG + BIG_PQTC), (char*)(BIG + BIG_MIX)};
    pg8::gemm_phase<pg8::EpiStore, SchedDft, true, true>(F.lds, F.tid, pg8::Dims{512, 512, 512}, S, pg8::EpiStore{});
}
PHASE_FN ph_e2_rope(PP pp) {
    FRAME();
    bf16* QKV = (bf16*)(ws + WS_BIG + BIG_QKV);
    LAS f32x2* cs = (LAS f32x2*)F.lds;
    __syncthreads();
    for (int e = F.tid; e < 1024; e += NTHREADS) { const int pos = e >> 4, i = e & 15; const float inv = powf(10000.0f, -(float)i / 16.0f); float s, c; sincosf((float)pos * inv, &s, &c); cs[e] = (f32x2){c, s}; }
    __syncthreads();
    for (int it = F.bid * NTHREADS + F.tid; it < TL * 10; it += F.G * NTHREADS) {
        const int r = it / 10, hh = it - r * 10, n = r & 4095;
        v4u* base = (v4u*)(QKV + (size_t)r * 768 + hh * 64);
        v4u v[8];
#pragma unroll
        for (int k = 0; k < 8; ++k) v[k] = base[k];
#pragma unroll
        for (int ax = 0; ax < 2; ++ax) { const int pos = ax ? (n & 63) : (n >> 6);
#pragma unroll
            for (int k = 0; k < 2; ++k) { unsigned* a = (unsigned*)&v[4 * ax + k]; unsigned* b = (unsigned*)&v[4 * ax + 2 + k];
#pragma unroll
                for (int q = 0; q < 4; ++q) { const f32x2 t0 = cs[pos * 16 + 8 * k + 2 * q], t1 = cs[pos * 16 + 8 * k + 2 * q + 1];
                    const float x1l = bflo(a[q]), x1h = bfhi(a[q]), x2l = bflo(b[q]), x2h = bfhi(b[q]);
                    a[q] = cvt_pk_bf16(x1l * t0.x - x2l * t0.y, x1h * t1.x - x2h * t1.y); b[q] = cvt_pk_bf16(x1l * t0.y + x2l * t0.x, x1h * t1.y + x2h * t1.x); } } }
#pragma unroll
        for (int k = 0; k < 8; ++k) base[k] = v[k];
    }
    bf16* VT = (bf16*)(ws + WS_BIG + BIG_VT);
    for (int it = F.bid * NTHREADS + F.tid; it < NBATCH * 2 * 544 * 64; it += F.G * NTHREADS) {
        const int d = it & 63, kg = (it >> 6) % 544, bh = (it >> 6) / 544, b = bh >> 1, hkv = bh & 1;
        const int key0 = kg * 8; const size_t row0 = (key0 < 256) ? ((size_t)TL + (size_t)b * 256 + key0) : ((size_t)b * 4096 + (key0 - 256));
        const bf16* src = QKV + row0 * 768 + 640 + hkv * 64 + d;
        unsigned short v[8];
#pragma unroll
        for (int j = 0; j < 8; ++j) v[j] = src[(size_t)j * 768];
        v4u w; w.x = v[0] | ((unsigned)v[1] << 16); w.y = v[2] | ((unsigned)v[3] << 16); w.z = v[4] | ((unsigned)v[5] << 16); w.w = v[6] | ((unsigned)v[7] << 16);
        *(v4u*)(VT + ((size_t)bh * 64 + d) * 4352 + key0) = w;
    }
    __syncthreads();
}
typedef float f32x16 __attribute__((ext_vector_type(16)));
typedef __bf16 bf16x2v __attribute__((ext_vector_type(2)));
__device__ __forceinline__ unsigned pk_bf16(float a, float b) { const bf16x2v t = __builtin_convertvector((f32x2){a, b}, bf16x2v); return __builtin_bit_cast(unsigned, t); }
constexpr int AT_KP = 144, AT_VP1 = 648, AT_VP2 = 520, AT_VOFF = 320 * AT_KP;
template <bool MASKED>
__device__ __forceinline__ void attn_tile(const LAS unsigned char* Ks, const LAS unsigned char* Vs, const int vpitch, const int kl_base, const bf16x8 (&qf)[4], f32x16& o0, f32x16& o1, float& m, float& l,
                                          const int r, const int h, const int kj0, const int qi) {
    f32x16 x;
#pragma unroll
    for (int i = 0; i < 16; ++i) x[i] = 0.f;
#pragma unroll
    for (int s = 0; s < 4; ++s) { const bf16x8 kf = *(const LAS bf16x8*)(Ks + (kl_base + r) * AT_KP + (16 * s + 8 * h) * 2); x = __builtin_amdgcn_mfma_f32_32x32x16_bf16(kf, qf[s], x, 0, 0, 0); }
    float sc[16]; float mt = -1e30f;
#pragma unroll
    for (int i = 0; i < 16; ++i) { float v = x[i] * 0.125f;
        if (MASKED) { const int kj = kj0 + (i & 3) + 8 * (i >> 2) + 4 * h; const bool ok = (kj >= 0) && (kj < SEQ) && (kj - qi <= 128) && (qi - kj <= 128); v = ok ? v : -1e30f; }
        sc[i] = v; mt = fmaxf(mt, v); }
    mt = fmaxf(mt, __shfl_xor(mt, 32));
    const float mn = fmaxf(m, mt), alpha = __expf(m - mn); m = mn;
    float ps = 0.f;
#pragma unroll
    for (int i = 0; i < 16; ++i) { sc[i] = __expf(sc[i] - mn); ps += sc[i]; }
    l = l * alpha + ps;
    if (__any(alpha != 1.0f)) {
#pragma unroll
        for (int i = 0; i < 16; ++i) { o0[i] *= alpha; o1[i] *= alpha; } }
#pragma unroll
    for (int s2 = 0; s2 < 2; ++s2) {
        v4u pw; pw.x = pk_bf16(sc[8 * s2 + 0], sc[8 * s2 + 1]); pw.y = pk_bf16(sc[8 * s2 + 2], sc[8 * s2 + 3]); pw.z = pk_bf16(sc[8 * s2 + 4], sc[8 * s2 + 5]); pw.w = pk_bf16(sc[8 * s2 + 6], sc[8 * s2 + 7]);
        const bf16x8 pk = __builtin_bit_cast(bf16x8, pw);
        { const LAS unsigned char* vp = Vs + r * vpitch + (kl_base + 16 * s2 + 4 * h) * 2; const v2u lo = *(const LAS v2u*)vp, hi = *(const LAS v2u*)(vp + 16);
          v4u vw; vw.x = lo.x; vw.y = lo.y; vw.z = hi.x; vw.w = hi.y; o0 = __builtin_amdgcn_mfma_f32_32x32x16_bf16(__builtin_bit_cast(bf16x8, vw), pk, o0, 0, 0, 0); }
        { const LAS unsigned char* vp = Vs + (32 + r) * vpitch + (kl_base + 16 * s2 + 4 * h) * 2; const v2u lo = *(const LAS v2u*)vp, hi = *(const LAS v2u*)(vp + 16);
          v4u vw; vw.x = lo.x; vw.y = lo.y; vw.z = hi.x; vw.w = hi.y; o1 = __builtin_amdgcn_mfma_f32_32x32x16_bf16(__builtin_bit_cast(bf16x8, vw), pk, o1, 0, 0, 0); }
    }
}
PHASE_FN ph_e3_attn(PP pp, int layer) {
    FRAME();
    const bf16* QKV = (const bf16*)(ws + WS_BIG + BIG_QKV); bf16* MIX = (bf16*)(ws + WS_BIG + BIG_MIX); const bf16* VT = (const bf16*)(ws + WS_BIG + BIG_VT);
    const float* sinkp = PIN(I_EV_SINK) + (layer >> 1) * 8;
    LAS unsigned char* Ks = F.lds; LAS unsigned char* Vs = F.lds + AT_VOFF;
    const int r = F.lane & 31, h = F.lane >> 5, g = F.wave >> 1, th = F.wave & 1;
    for (int u = F.bid; u < 2048 + 128; u += F.G) {
        const bool isc = u >= 2048;
        int b, hkv, qb; if (!isc) { b = u >> 7; hkv = (u >> 6) & 1; qb = u & 63; } else { const int v = u - 2048; b = v >> 3; hkv = (v >> 2) & 1; qb = v & 3; }
        const int n0 = qb * 64, bh = b * 2 + hkv;
        const size_t qrow = isc ? ((size_t)TL + (size_t)b * 256 + n0 + 32 * th + r) : ((size_t)b * 4096 + n0 + 32 * th + r);
        bf16x8 qf[4];
#pragma unroll
        for (int s = 0; s < 4; ++s) qf[s] = *(const bf16x8*)(QKV + qrow * 768 + (hkv * 4 + g) * 64 + 16 * s + 8 * h);
        float m = sinkp[hkv * 4 + g], l = (h == 0) ? 1.0f : 0.0f;
        f32x16 o0, o1;
#pragma unroll
        for (int i = 0; i < 16; ++i) { o0[i] = 0.f; o1[i] = 0.f; }
        __syncthreads();
        if (!isc) {
            for (int pc = F.tid; pc < 2560; pc += NTHREADS) { const int kl = pc >> 3, c8 = pc & 7, kj = n0 - 128 + kl;
                v4u v = (v4u){0u, 0u, 0u, 0u}; if (kj >= 0 && kj < SEQ) v = *(const v4u*)(QKV + ((size_t)b * 4096 + kj) * 768 + 512 + hkv * 64 + c8 * 8);
                *(LAS v4u*)(Ks + kl * AT_KP + c8 * 16) = v; }
            for (int pc = F.tid; pc < 2560; pc += NTHREADS) { const int d = pc / 40, c = pc - d * 40, kj = n0 - 128 + c * 8;
                v4u v = (v4u){0u, 0u, 0u, 0u}; if (kj >= 0 && kj < SEQ) v = *(const v4u*)(VT + ((size_t)bh * 64 + d) * 4352 + 256 + kj);
                LAS v2u* dst = (LAS v2u*)(Vs + d * AT_VP1 + c * 16); dst[0] = (v2u){v.x, v.y}; dst[1] = (v2u){v.z, v.w}; }
            __syncthreads();
            const int qi = n0 + 32 * th + r;
#pragma unroll 1
            for (int t = 0; t < 9; ++t) { const int klb = 32 * th + 32 * t, kj0 = n0 - 128 + klb;
                if (t >= 1 && t <= 7 && kj0 >= 0 && kj0 + 31 < SEQ) attn_tile<false>(Ks, Vs, AT_VP1, klb, qf, o0, o1, m, l, r, h, 0, 0);
                else attn_tile<true>(Ks, Vs, AT_VP1, klb, qf, o0, o1, m, l, r, h, kj0, qi); }
            __syncthreads();
        }
        for (int pc = F.tid; pc < 2048; pc += NTHREADS) { const int j = pc >> 3, c8 = pc & 7;
            *(LAS v4u*)(Ks + j * AT_KP + c8 * 16) = *(const v4u*)(QKV + ((size_t)TL + (size_t)b * 256 + j) * 768 + 512 + hkv * 64 + c8 * 8); }
        for (int pc = F.tid; pc < 2048; pc += NTHREADS) { const int d = pc >> 5, c = pc & 31; const v4u v = *(const v4u*)(VT + ((size_t)bh * 64 + d) * 4352 + c * 8);
            LAS v2u* dst = (LAS v2u*)(Vs + d * AT_VP2 + c * 16); dst[0] = (v2u){v.x, v.y}; dst[1] = (v2u){v.z, v.w}; }
        __syncthreads();
#pragma unroll 1
        for (int t = 0; t < 8; ++t) attn_tile<false>(Ks, Vs, AT_VP2, 32 * t, qf, o0, o1, m, l, r, h, 0, 0);
        const float inv = 1.0f / (l + __shfl_xor(l, 32));
        bf16* orow = MIX + qrow * D + 512 + (hkv * 4 + g) * 64 + 4 * h;
#pragma unroll
        for (int q4 = 0; q4 < 4; ++q4) {
            v2u w0; w0.x = pk_bf16(o0[4 * q4 + 0] * inv, o0[4 * q4 + 1] * inv); w0.y = pk_bf16(o0[4 * q4 + 2] * inv, o0[4 * q4 + 3] * inv); *(v2u*)(orow + 8 * q4) = w0;
            v2u w1; w1.x = pk_bf16(o1[4 * q4 + 0] * inv, o1[4 * q4 + 1] * inv); w1.y = pk_bf16(o1[4 * q4 + 2] * inv, o1[4 * q4 + 3] * inv); *(v2u*)(orow + 32 + 8 * q4) = w1;
        }
    }
    __syncthreads();
}
PHASE_FN ph_outproj(PP pp, int layer) {
    FRAME();
    const int li = layer >> 1; const bool odd = (layer & 1) != 0;
    const int TR = (layer == DEPTH - 1) ? TL : T;
    const char* W = odd ? (const char*)(ws + WS_OD + li * OD_STRIDE + OD_WOUT) : (const char*)(ws + WS_EV + li * EV_STRIDE + EV_WOUT);
    float* XC = (float*)(ws + WS_XC); float* out = (float*)pp->out;
    const float* xl_src = (layer == 0) ? PIN(I_X) : out; const float* xc_src = (layer == 0) ? PIN(I_CTX) : XC;
    const float* modl = (const float*)(ws + WS_MOD) + (size_t)layer * 17 * 6144;
    SchedResid S{F.G, F.bid, (TR / 256) * 4, (const char*)(ws + WS_BIG + BIG_MIX), (size_t)256 * D * 2, W, (size_t)256 * D * 2, xl_src, xc_src, out, XC, modl + 2048};
    pg8::EpiResidLN E{PIN(I_LNG) + (size_t)(layer * 2) * D, PIN(I_LNB) + (size_t)(layer * 2) * D, 2048, 1024, (bf16*)(ws + WS_H), F.ctl + CW_LN + (layer * 2) * LN_SITE_WORDS,
                      (unsigned long long*)(ws + WS_XS), F.ctl + 2, F.lds + LDS_LNTAB};
    pg8::gemm_phase<pg8::EpiResidLN, SchedResid, true, true>(F.lds, F.tid, pg8::Dims{D, D, D}, S, E);
}
PHASE_FN ph_e6(PP pp, int layer) {
    FRAME();
    unsigned char* evw = ws + WS_EV + (layer >> 1) * EV_STRIDE;
    SchedStd S{22, (T / 256) * 22, F.G, F.bid, (const char*)(ws + WS_H), (const char*)(evw + EV_W13), (char*)(ws + WS_BIG + BIG_HID), (size_t)256 * D * 2, (size_t)256 * D * 2, (size_t)256 * FFH * 2, (size_t)128 * 2, FFH, 1 << 30};
    pg8::gemm_phase<pg8::EpiSwiGLU, SchedStd, true, true>(F.lds, F.tid, pg8::Dims{D, D, D}, S, pg8::EpiSwiGLU{});
}
PHASE_FN ph_e7(PP pp, int layer) {
    FRAME();
    unsigned char* evw = ws + WS_EV + (layer >> 1) * EV_STRIDE;
    float* XC = (float*)(ws + WS_XC); float* out = (float*)pp->out;
    const float* modl = (const float*)(ws + WS_MOD) + (size_t)layer * 17 * 6144;
    SchedResid S{F.G, F.bid, (T / 256) * 4, (const char*)(ws + WS_BIG + BIG_HID), (size_t)256 * FFH * 2, (const char*)(evw + EV_W2), (size_t)256 * FFH * 2, out, XC, out, XC, modl + 5120};
    pg8::EpiResidLN E{PIN(I_LNG) + (size_t)(layer * 2 + 1) * D, PIN(I_LNB) + (size_t)(layer * 2 + 1) * D, 17 * 6144 + 1024 - 5120, 17 * 6144 - 5120, (bf16*)(ws + WS_H), F.ctl + CW_LN + (layer * 2 + 1) * LN_SITE_WORDS,
                      (unsigned long long*)(ws + WS_XS), F.ctl + 2, F.lds + LDS_LNTAB};
    pg8::gemm_phase<pg8::EpiResidLN, SchedResid, true, true>(F.lds, F.tid, pg8::Dims{FFH, FFH, FFH}, S, E);
}

PHASE_FN ph_o1(PP pp, int layer) {
    FRAME();
    unsigned char* odw = ws + WS_OD + (layer >> 1) * OD_STRIDE;
    SchedStd S{6, (T / 256) * 6, F.G, F.bid, (const char*)(ws + WS_H), (const char*)(odw + OD_WIN), (char*)(ws + WS_BIG + BIG_P), (size_t)256 * D * 2, (size_t)256 * D * 2, (size_t)256 * 1536 * 2, (size_t)256 * 2, 1536, 2};
    pg8::gemm_phase<pg8::EpiStore, SchedStd, true, true>(F.lds, F.tid, pg8::Dims{D, D, D}, S, pg8::EpiStore{});
}
PHASE_FN ph_o2_s5a(PP pp, int layer) {
    FRAME();
    const int li = layer >> 1;
    SchedS5A S{F.G, F.bid, (const char*)(ws + WS_BIG + BIG_P), (const char*)(ws + WS_S5M + (size_t)li * 32 * S5M_STRIDE), (char*)(ws + WS_H + 68 * MiB), (char*)(ws + WS_H)};
    pg8::gemm_phase<pg8::EpiStore, SchedS5A, true, true, pg8::AMapS5>(F.lds, F.tid, pg8::Dims{256, 0, 256}, S, pg8::EpiStore{}, pg8::AMapS5{});
}
PHASE_FN ph_o2_scan(PP pp, int layer) {
    FRAME();
    const int li = layer >> 1;
    if (F.tid < 256) {
        const int t = F.bid * 256 + F.tid;
        if (t < NBATCH * 32 * 2 * 64) {
            const int pl = t & 63, d = (t >> 6) & 1, g = (t >> 7) & 31, b = t >> 12;
            const int sidx = ((li * 2 + d) * 32 + g);
            const float are = PIN(I_A_RE)[sidx * 64 + pl], aim = PIN(I_A_IM)[sidx * 64 + pl], dt = expf(PIN(I_LOG_DT)[sidx]);
            const float mag = expf(16.0f * are * dt); float sn, cn; sincosf(16.0f * aim * dt, &sn, &cn);
            const float lre = mag * cn, lim = mag * sn;
            unsigned* HB = (unsigned*)(ws + WS_H) + (g * 256 + d * 128 + pl * 2) / 2;
            float cre = 0.f, cim = 0.f;
#define S5_CROW(k_) ((k_) < 16 ? (4096 + b * 16 + (d ? 15 - (k_) : (k_))) : (b * 256 + (d ? 255 - ((k_) - 16) : ((k_) - 16))))
            for (int k0 = 0; k0 < 272; k0 += 8) {
                unsigned w[8];
#pragma unroll
                for (int j = 0; j < 8; ++j) w[j] = HB[(size_t)S5_CROW(k0 + j) * 4096];
#pragma unroll
                for (int j = 0; j < 8; ++j) { HB[(size_t)S5_CROW(k0 + j) * 4096] = cvt_pk_bf16(cre, cim);
                    const float sr = bflo(w[j]), si = bfhi(w[j]); const float nr = lre * cre - lim * cim + sr, ni = lre * cim + lim * cre + si; cre = nr; cim = ni; }
            }
#undef S5_CROW
        }
    }
}
PHASE_FN ph_o3(PP pp, int layer) {
    FRAME();
    const int li = layer >> 1;
    SchedS5B S{F.G, F.bid, (const char*)(ws + WS_H), (const char*)(ws + WS_S5M + (size_t)li * 32 * S5M_STRIDE + 256 * 1024), (const char*)(ws + WS_H + 68 * MiB), (char*)(ws + WS_BIG + BIG_P)};
    pg8::gemm_phase<pg8::EpiS5B, SchedS5B, true, true>(F.lds, F.tid, pg8::Dims{256, 8192, 256}, S, pg8::EpiS5B{});
}
PHASE_FN ph_o2_gmlp(PP pp, int layer) {
    FRAME();
    const int li = layer >> 1; const int TR = (layer == DEPTH - 1) ? TL : T;
    const bf16* P = (const bf16*)(ws + WS_BIG + BIG_P); bf16* MIX = (bf16*)(ws + WS_BIG + BIG_MIX);
    constexpr int GP = 272;
    LAS unsigned char* Vt = F.lds;
    LAS unsigned char* Wt = F.lds + 128 * GP;
    LAS f32x2* stt = (LAS f32x2*)(F.lds + 2 * 128 * GP);
    const float* ws_w = PIN(I_WS) + (size_t)li * 4 * 128 * 128; const float* bs = PIN(I_BS) + (size_t)li * 4 * 128;
    const int r = F.lane & 31, hh = F.lane >> 5, et = F.wave >> 1, it0 = (F.wave & 1) * 2;
    const int nunits = (TR / 128) * 4;
    for (int u = F.bid; u < nunits; u += F.G) {
        const int ch = u >> 2, h = u & 3; const size_t row0 = (size_t)ch * 128;
        __syncthreads();
#pragma unroll 4
        for (int t = 0; t < 16; ++t) { const int j = F.wave * 16 + t; const v4u w = *(const v4u*)(P + (row0 + j) * 1536 + 1024 + F.lane * 8);
            const float f[8] = {bflo(w.x), bfhi(w.x), bflo(w.y), bfhi(w.y), bflo(w.z), bfhi(w.z), bflo(w.w), bfhi(w.w)};
            float sm = 0.f;
#pragma unroll
            for (int q = 0; q < 8; ++q) sm += f[q];
            const float mu = wave_sum(sm) * (1.f / 512.f); float qv = 0.f;
#pragma unroll
            for (int q = 0; q < 8; ++q) qv += (f[q] - mu) * (f[q] - mu);
            const float rs = rsqrtf(wave_sum(qv) * (1.f / 512.f) + LN_EPS);
            if (F.lane == 0) stt[j] = (f32x2){mu, rs}; }
        for (int pc = F.tid; pc < 2048; pc += NTHREADS) { const int i = pc >> 4, j8 = (pc & 15) * 8; const float* wp = ws_w + (size_t)h * 16384 + i * 128 + j8;
            const f32x4 a = *(const f32x4*)wp, b = *(const f32x4*)(wp + 4);
            v4u o; o.x = cvt_pk_bf16(a[0], a[1]); o.y = cvt_pk_bf16(a[2], a[3]); o.z = cvt_pk_bf16(b[0], b[1]); o.w = cvt_pk_bf16(b[2], b[3]);
            *(LAS v4u*)(Wt + i * GP + j8 * 2) = o; }
        __syncthreads();
        for (int pc = F.tid; pc < 2048; pc += NTHREADS) { const int eg = pc >> 7, j = pc & 127; const v4u w = *(const v4u*)(P + (row0 + j) * 1536 + 1024 + h * 128 + eg * 8);
            const f32x2 ms = stt[j];
            const float f[8] = {bflo(w.x), bfhi(w.x), bflo(w.y), bfhi(w.y), bflo(w.z), bfhi(w.z), bflo(w.w), bfhi(w.w)};
#pragma unroll
            for (int q = 0; q < 8; q += 2) { const unsigned pkd = cvt_pk_bf16((f[q] - ms.x) * ms.y, (f[q + 1] - ms.x) * ms.y);
                *(LAS unsigned short*)(Vt + (eg * 8 + q) * GP + j * 2) = (unsigned short)(pkd & 0xffffu); *(LAS unsigned short*)(Vt + (eg * 8 + q + 1) * GP + j * 2) = (unsigned short)(pkd >> 16); } }
        __syncthreads();
        f32x16 acc0, acc1;
#pragma unroll
        for (int q = 0; q < 16; ++q) { acc0[q] = 0.f; acc1[q] = 0.f; }
#pragma unroll
        for (int sk = 0; sk < 8; ++sk) {
            const bf16x8 a = *(const LAS bf16x8*)(Vt + (et * 32 + r) * GP + (16 * sk + 8 * hh) * 2);
            const bf16x8 b0 = *(const LAS bf16x8*)(Wt + (it0 * 32 + r) * GP + (16 * sk + 8 * hh) * 2), b1 = *(const LAS bf16x8*)(Wt + ((it0 + 1) * 32 + r) * GP + (16 * sk + 8 * hh) * 2);
            acc0 = __builtin_amdgcn_mfma_f32_32x32x16_bf16(a, b0, acc0, 0, 0, 0); acc1 = __builtin_amdgcn_mfma_f32_32x32x16_bf16(a, b1, acc1, 0, 0, 0);
        }
#pragma unroll
        for (int t = 0; t < 2; ++t) { const int i = (it0 + t) * 32 + r; const float bb = bs[h * 128 + i];
            const bf16* up = P + (row0 + i) * 1536 + 512 + h * 128 + et * 32 + 4 * hh; bf16* op = MIX + (row0 + i) * D + 512 + h * 128 + et * 32 + 4 * hh;
#pragma unroll
            for (int q4 = 0; q4 < 4; ++q4) { const v2u uw = *(const v2u*)(up + 8 * q4);
                const float a0 = (t ? acc1[4 * q4 + 0] : acc0[4 * q4 + 0]) + bb, a1 = (t ? acc1[4 * q4 + 1] : acc0[4 * q4 + 1]) + bb, a2 = (t ? acc1[4 * q4 + 2] : acc0[4 * q4 + 2]) + bb, a3 = (t ? acc1[4 * q4 + 3] : acc0[4 * q4 + 3]) + bb;
                v2u o; o.x = cvt_pk_bf16(bflo(uw.x) * a0, bfhi(uw.x) * a1); o.y = cvt_pk_bf16(bflo(uw.y) * a2, bfhi(uw.y) * a3);
                *(v2u*)(op + 8 * q4) = o; } }
    }
    __syncthreads();
}
PHASE_FN ph_o4(PP pp, int layer) {
    FRAME();
    const int li = layer >> 1;
    unsigned char* odw = ws + WS_OD + li * OD_STRIDE;
    SchedGlu S{F.G, F.bid, (const char*)(ws + WS_BIG + BIG_P), (const char*)(odw + OD_WGLU), (char*)(ws + WS_BIG + BIG_MIX), PIN(I_BGLU) + (size_t)li * 512};
    pg8::gemm_phase<pg8::EpiGLU, SchedGlu, true, true>(F.lds, F.tid, pg8::Dims{512, 1536, 512}, S, pg8::EpiGLU{});
}
PHASE_FN ph_o6(PP pp, int layer) {
    FRAME();
    const int li = layer >> 1; const int TR = (layer == DEPTH - 1) ? TL : T;
    const bf16* Hb = (const bf16*)(ws + WS_H);
    int* tokE = (int*)(ws + WS_TOK); int* tokS0 = tokE + T; int* tokS1 = tokS0 + T; float* tokG0 = (float*)(tokS1 + T);
    unsigned* ecnt = F.ctl + CW_CNT + li * 64;
    LAS float* wr_s = (LAS float*)F.lds;
    LAS unsigned* lcnt = (LAS unsigned*)(F.lds + 32768);
    const float* rw = PIN(I_ROUTER) + (size_t)li * D * 8;
    __syncthreads();
    for (int e = F.tid; e < D * 8; e += NTHREADS) wr_s[e] = rw[e];
    if (F.tid < 16) lcnt[F.tid] = 0u;
    __syncthreads();
    for (int r = F.gw; r < TR; r += F.NGW) {
        const v4u* src = (const v4u*)(Hb + (size_t)r * D) + 2 * F.lane;
        const v4u a = src[0], b = src[1];
        const float hv[16] = {bflo(a.x), bfhi(a.x), bflo(a.y), bfhi(a.y), bflo(a.z), bfhi(a.z), bflo(a.w), bfhi(a.w), bflo(b.x), bfhi(b.x), bflo(b.y), bfhi(b.y), bflo(b.z), bfhi(b.z), bflo(b.w), bfhi(b.w)};
        float lg[8];
#pragma unroll
        for (int e = 0; e < 8; ++e) lg[e] = 0.f;
#pragma unroll
        for (int q = 0; q < 16; ++q) { const int col = 16 * F.lane + q; const f32x4 w0 = *(const LAS f32x4*)(wr_s + col * 8), w1 = *(const LAS f32x4*)(wr_s + col * 8 + 4);
            lg[0] += hv[q] * w0[0]; lg[1] += hv[q] * w0[1]; lg[2] += hv[q] * w0[2]; lg[3] += hv[q] * w0[3]; lg[4] += hv[q] * w1[0]; lg[5] += hv[q] * w1[1]; lg[6] += hv[q] * w1[2]; lg[7] += hv[q] * w1[3]; }
#pragma unroll
        for (int e = 0; e < 8; ++e) lg[e] = wave_sum(lg[e]);
        if (F.lane == 0) {
            int e0 = 0; float v0 = lg[0];
#pragma unroll
            for (int e = 1; e < 8; ++e) if (lg[e] > v0) { v0 = lg[e]; e0 = e; }
            int e1 = -1; float v1 = -3.0e38f;
#pragma unroll
            for (int e = 0; e < 8; ++e) if (e != e0 && lg[e] > v1) { v1 = lg[e]; e1 = e; }
            const float w0 = 1.0f / (1.0f + __expf(v1 - v0));
            const int s0 = (int)__hip_atomic_fetch_add(lcnt + e0, 1u, __ATOMIC_RELAXED, __HIP_MEMORY_SCOPE_WORKGROUP), s1 = (int)__hip_atomic_fetch_add(lcnt + e1, 1u, __ATOMIC_RELAXED, __HIP_MEMORY_SCOPE_WORKGROUP);
            tokE[r] = e0 | (e1 << 8); tokS0[r] = s0; tokS1[r] = s1; tokG0[r] = w0;
        }
    }
    __syncthreads();
    if (F.tid < 8) lcnt[8 + F.tid] = atomicAdd(ecnt + F.tid, lcnt[F.tid]);
    VM_WAIT();
    __syncthreads();
    { const int r = F.gw + F.lane * F.NGW;
      if (r < TR) { const int ee = tokE[r]; tokS0[r] += (int)lcnt[8 + (ee & 255)]; tokS1[r] += (int)lcnt[8 + (ee >> 8)]; } }
    __syncthreads();
}
PHASE_FN ph_o7(PP pp, int layer) {
    FRAME();
    const int li = layer >> 1; const int TR = (layer == DEPTH - 1) ? TL : T;
    const bf16* Hb = (const bf16*)(ws + WS_H); unsigned char* HSQ = ws + WS_BIG + BIG_HSQ;
    int* tokE = (int*)(ws + WS_TOK); int* tokS0 = tokE + T; int* tokS1 = tokS0 + T; int* tokP0 = tokS1 + 2 * T; int* tokP1 = tokP0 + T;
    unsigned* ecnt = F.ctl + CW_CNT + li * 64;
    int roff[8]; { int acc = 0;
#pragma unroll
        for (int e = 0; e < 8; ++e) { roff[e] = acc * 256; acc += (__builtin_amdgcn_readfirstlane((int)__hip_atomic_load(ecnt + e, __ATOMIC_RELAXED, __HIP_MEMORY_SCOPE_AGENT)) + 255) >> 8; } }
    for (int r = F.gw; r < TR; r += F.NGW) {
        const int ee = tokE[r], e0 = ee & 255, e1 = ee >> 8;
        int p0 = tokS0[r], p1 = tokS1[r];
#pragma unroll
        for (int e = 0; e < 8; ++e) { p0 += (e == e0) ? roff[e] : 0; p1 += (e == e1) ? roff[e] : 0; }
        const v4u* src = (const v4u*)(Hb + (size_t)r * D) + 2 * F.lane;
        const v4u a = src[0], b = src[1];
        v4u q; q.x = pk_fp8x4(bflo(a.x) * Q_H, bfhi(a.x) * Q_H, bflo(a.y) * Q_H, bfhi(a.y) * Q_H); q.y = pk_fp8x4(bflo(a.z) * Q_H, bfhi(a.z) * Q_H, bflo(a.w) * Q_H, bfhi(a.w) * Q_H);
        q.z = pk_fp8x4(bflo(b.x) * Q_H, bfhi(b.x) * Q_H, bflo(b.y) * Q_H, bfhi(b.y) * Q_H); q.w = pk_fp8x4(bflo(b.z) * Q_H, bfhi(b.z) * Q_H, bflo(b.w) * Q_H, bfhi(b.w) * Q_H);
        *((v4u*)(HSQ + (size_t)p0 * D) + F.lane) = q; *((v4u*)(HSQ + (size_t)p1 * D) + F.lane) = q;
        if (F.lane == 0) { tokP0[r] = p0; tokP1[r] = p1; }
    }
}
PHASE_FN ph_moe_up(PP pp, int layer, int chn) {
    FRAME();
    const int li = layer >> 1; unsigned char* odw = ws + WS_OD + li * OD_STRIDE; unsigned* ecnt = F.ctl + CW_CNT + li * 64;
    SchedMoeUp S; S.G = F.G; S.c = F.bid; S.rt0 = chn * MOE_CHUNK_TILES; S.HS = (const char*)(ws + WS_BIG + BIG_HSQ); S.W = (const char*)(odw + OD_MW13); S.HID = (char*)(ws + WS_H);
    { int acc = 0; S.toff[0] = 0;
#pragma unroll
        for (int e = 0; e < 8; ++e) { acc += (__builtin_amdgcn_readfirstlane((int)__hip_atomic_load(ecnt + e, __ATOMIC_RELAXED, __HIP_MEMORY_SCOPE_AGENT)) + 255) >> 8; S.toff[e + 1] = acc; } }
    int nt_ = S.toff[8] - S.rt0; nt_ = nt_ < 0 ? 0 : (nt_ > MOE_CHUNK_TILES ? MOE_CHUNK_TILES : nt_); S.nUnits = nt_ * 28;
    pg8::gemm_phase<pg8::EpiSwiGLU8, SchedMoeUp, true, true, pg8::AMapStd, true>(F.lds, F.tid, pg8::Dims{D, D, D}, S, pg8::EpiSwiGLU8{});
}
PHASE_FN ph_moe_down(PP pp, int layer, int chn) {
    FRAME();
    const int li = layer >> 1; unsigned char* odw = ws + WS_OD + li * OD_STRIDE; unsigned* ecnt = F.ctl + CW_CNT + li * 64;
    SchedMoeDown S; S.G = F.G; S.c = F.bid; S.rt0 = chn * MOE_CHUNK_TILES; S.HID = (const char*)(ws + WS_H); S.W = (const char*)(odw + OD_MW2); S.Y = (char*)(ws + WS_BIG + BIG_Y);
    { int acc = 0; S.toff[0] = 0;
#pragma unroll
        for (int e = 0; e < 8; ++e) { acc += (__builtin_amdgcn_readfirstlane((int)__hip_atomic_load(ecnt + e, __ATOMIC_RELAXED, __HIP_MEMORY_SCOPE_AGENT)) + 255) >> 8; S.toff[e + 1] = acc; } }
    int nt_ = S.toff[8] - S.rt0; nt_ = nt_ < 0 ? 0 : (nt_ > MOE_CHUNK_TILES ? MOE_CHUNK_TILES : nt_); S.nUnits = nt_ * 4;
    pg8::gemm_phase<pg8::EpiStoreQ, SchedMoeDown, true, true, pg8::AMapStd, true>(F.lds, F.tid, pg8::Dims{EH, EH, EH}, S, pg8::EpiStoreQ{});
}
PHASE_FN ph_o9(PP pp, int layer) {
    FRAME();
    const int TR = (layer == DEPTH - 1) ? TL : T; const bool last = layer == DEPTH - 1;
    float* XC = (float*)(ws + WS_XC); float* out = (float*)pp->out; bf16* Hb = (bf16*)(ws + WS_H); const bf16* HS = (const bf16*)(ws + WS_BIG + BIG_Y);
    const float* modl = (const float*)(ws + WS_MOD) + (size_t)layer * 17 * 6144;
    const float* modn = (const float*)(ws + WS_MOD) + (size_t)(last ? layer : layer + 1) * 17 * 6144;
    const float* lng1 = PIN(I_LNG) + (size_t)(layer * 2 + 1) * D; const float* lnb1 = PIN(I_LNB) + (size_t)(layer * 2 + 1) * D;
    const int* tokE = (const int*)(ws + WS_TOK); const float* tokG0 = (const float*)(tokE + 3 * T); const int* tokP0 = tokE + 4 * T; const int* tokP1 = tokP0 + T;
    f32x4 gg9[4], bb9[4];
#pragma unroll
    for (int j = 0; j < 4; ++j) { gg9[j] = *(const f32x4*)(lng1 + 256 * j + 4 * F.lane); bb9[j] = *(const f32x4*)(lnb1 + 256 * j + 4 * F.lane); }
    for (int r = F.gw; r < TR; r += F.NGW) {
        const bool isc = r >= TL; float* xr = isc ? XC + (size_t)(r - TL) * D : out + (size_t)r * D;
        const int mrow = isc ? 16 : (r >> 12);
        const float* g2 = modl + (size_t)mrow * 6144 + 5120;
        const int p0 = tokP0[r], p1 = tokP1[r]; const float w0 = tokG0[r], w1 = 1.0f - w0;
        const bf16* y0 = HS + (size_t)p0 * D; const bf16* y1 = HS + (size_t)p1 * D;
        f32x4 v[4], h[4]; row_load(xr, F.lane, v);
#pragma unroll
        for (int j = 0; j < 4; ++j) { const v2u a = *(const v2u*)(y0 + 256 * j + 4 * F.lane), b = *(const v2u*)(y1 + 256 * j + 4 * F.lane); const f32x4 gg = *(const f32x4*)(g2 + 256 * j + 4 * F.lane);
            f32x4 f; f[0] = w0 * bflo(a.x) + w1 * bflo(b.x); f[1] = w0 * bfhi(a.x) + w1 * bfhi(b.x); f[2] = w0 * bflo(a.y) + w1 * bflo(b.y); f[3] = w0 * bfhi(a.y) + w1 * bfhi(b.y);
            v[j] = v[j] * ALPHA + gg * f; }
        row_ln_pre(v, gg9, bb9); row_store(xr, F.lane, v);
        if (!last) { const float* m = modn + (size_t)mrow * 6144; row_modulate(h, v, m + 1024, m, F.lane); row_store_bf16(Hb + (size_t)r * D, F.lane, h); }
    }
}

#if MK_SPLIT
#define PHASE_END() do { ++ph; } while (0)
#else
#define PHASE_END() do { if (ph >= lo && ph + 1 < hi) grid_bar(pp); ++ph; } while (0)
#endif
#define PHASE_ON() (ph >= lo && ph < hi)
static __device__ __forceinline__ void even_layer(PP pp, const int layer, const int lo, const int hi, int& ph) {
    if (PHASE_ON()) ph_e1(pp, layer);
    PHASE_END();
    if (PHASE_ON()) { ph_e2_fft(pp); ph_e2_rope(pp); }
    PHASE_END();
    if (PHASE_ON()) { ph_e2_dft(pp); ph_e3_attn(pp, layer); }
    PHASE_END();
    if (PHASE_ON()) ph_outproj(pp, layer);
    PHASE_END();
    if (PHASE_ON()) ph_e6(pp, layer);
    PHASE_END();
    if (PHASE_ON()) ph_e7(pp, layer);
    PHASE_END();
}
static __device__ __forceinline__ void odd_layer(PP pp, const int layer, const int lo, const int hi, int& ph) {
    if (PHASE_ON()) ph_o1(pp, layer);
    PHASE_END();
    if (PHASE_ON()) { ph_o2_s5a(pp, layer); ph_o2_gmlp(pp, layer); }
    PHASE_END();
    if (PHASE_ON()) ph_o2_scan(pp, layer);
    PHASE_END();
    if (PHASE_ON()) ph_o3(pp, layer);
    PHASE_END();
    if (PHASE_ON()) ph_o4(pp, layer);
    PHASE_END();
    if (PHASE_ON()) ph_outproj(pp, layer);
    PHASE_END();
    if (PHASE_ON()) ph_o6(pp, layer);
    PHASE_END();
    if (PHASE_ON()) ph_o7(pp, layer);
    PHASE_END();
#define MOE_CHUNK(chn) do { if (PHASE_ON()) ph_moe_up(pp, layer, chn); PHASE_END(); if (PHASE_ON()) ph_moe_down(pp, layer, chn); PHASE_END(); } while (0)
    static_assert(MOE_NCHUNK == 5, "the chunk sites are written out: no loop around GEMM phase sites");
    MOE_CHUNK(0); MOE_CHUNK(1); MOE_CHUNK(2); MOE_CHUNK(3); MOE_CHUNK(4);
#undef MOE_CHUNK
    if (PHASE_ON()) ph_o9(pp, layer);
    PHASE_END();
}
constexpr int N_PHASES = 2 + 2 * (6 + 9 + 2 * MOE_NCHUNK);
__global__ void __launch_bounds__(NTHREADS, 2) fwd_kernel(Params p_unused) {
    DECL_LDS;
    PP pp = (PP)__builtin_amdgcn_kernarg_segment_ptr();
    {
        LAS unsigned char* lds = (LAS unsigned char*)lds_raw;
        for (int u = threadIdx.x; u < (LDS_BYTES - LDS_RING) / 4; u += NTHREADS) ((LAS unsigned*)(lds + LDS_RING))[u] = 0u;
        __syncthreads();
#if !MK_SPLIT
        (void)xcd_barrier_post((unsigned*)((unsigned char*)pp->ws + WS_CTL) + CW_BAR, (volatile LAS unsigned*)(lds + LDS_MISC) + 8);
#endif
    }
#if MK_SPLIT
    const int lo = pp->ph_lo, hi = pp->ph_hi;
#else
    constexpr int lo = 0, hi = N_PHASES;
#endif
    int ph = 0;

    if (PHASE_ON()) { ph_fold(pp); ph_mod(pp); ph_s5mat(pp); ph_cvt(pp); ph_dftmat(pp); }
    PHASE_END();
    if (PHASE_ON()) ph_pro_b(pp);
    PHASE_END();
    even_layer(pp, 0, lo, hi, ph);
    odd_layer(pp, 1, lo, hi, ph);
    even_layer(pp, 2, lo, hi, ph);
    odd_layer(pp, 3, lo, hi, ph);
}

extern "C" void kernel_launch(void* const* d_in, const int* in_sizes, int n_in, void* d_out, int out_size, void* d_ws, size_t ws_size, hipStream_t stream) {
    static int grid = 0;
    if (grid == 0) {
        if (n_in != 32 || out_size != TL * D || ws_size < WS_END) { fprintf(stderr, "kernel_launch: unexpected shapes (n_in %d, out %d, ws %zu < %zu)\n", n_in, out_size, ws_size, (size_t)WS_END); grid = -1; return; }
        int dev = 0, cus = 0, per_cu = 0;
        if (hipGetDevice(&dev) != hipSuccess || hipDeviceGetAttribute(&cus, hipDeviceAttributeMultiprocessorCount, dev) != hipSuccess) { grid = -1; return; }
        if (hipFuncSetAttribute((const void*)fwd_kernel, hipFuncAttributeMaxDynamicSharedMemorySize, LDS_BYTES) != hipSuccess) { fprintf(stderr, "kernel_launch: hipFuncSetAttribute failed\n"); grid = -1; return; }
        if (hipOccupancyMaxActiveBlocksPerMultiprocessor(&per_cu, (const void*)fwd_kernel, NTHREADS, LDS_BYTES) != hipSuccess || per_cu < 1) { fprintf(stderr, "kernel_launch: occupancy query says %d\n", per_cu); }
        (void)hipGetLastError();
        grid = cus;
    }
    if (grid < 0) return;
    (void)in_sizes;
    (void)hipMemsetAsync((char*)d_ws + WS_CTL, 0, CTL_ZERO_BYTES, stream);
    Params p{};
    for (int i = 0; i < 32; ++i) p.in[i] = (const float*)d_in[i];
    p.out = (float*)d_out; p.ws = (unsigned char*)d_ws;
#if MK_SPLIT
    for (int ph = 0; ph < N_PHASES; ++ph) { p.ph_lo = ph; p.ph_hi = ph + 1; hipLaunchKernelGGL(fwd_kernel, dim3(grid), dim3(NTHREADS), LDS_BYTES, stream, p); }
#else
    p.ph_lo = 0; p.ph_hi = N_PHASES;
    hipLaunchKernelGGL(fwd_kernel, dim3(grid), dim3(NTHREADS), LDS_BYTES, stream, p);
#endif
}
```

```cpp
#include <hip/hip_runtime.h>
#include <cstdio>
#include <cstdint>

#ifndef MK_SPLIT
#define MK_SPLIT 0
#endif

#define GAS __attribute__((address_space(1)))
#define LAS __attribute__((address_space(3)))
typedef unsigned short bf16;
typedef unsigned v4u __attribute__((ext_vector_type(4)));
typedef unsigned v2u __attribute__((ext_vector_type(2)));
typedef float f32x4 __attribute__((ext_vector_type(4)));
typedef float f32x2 __attribute__((ext_vector_type(2)));
typedef short bf16x8 __attribute__((ext_vector_type(8)));

constexpr int D = 1024, NBATCH = 16, SEQ = 4096, NCTX = 256, DEPTH = 4;
constexpr int TL = NBATCH * SEQ, TC = NBATCH * NCTX, T = TL + TC;
constexpr int FFH = 2816, EH = 3584, NEXP = 8;
constexpr int MOE_CHUNK_TILES = 128, MOE_NCHUNK = 5;
constexpr float Q_H = 16.f, Q_W = 1024.f, Q_HID = 8.f;
constexpr float ALPHA = 1.6817928305074290860622509524664f;
constexpr float LN_EPS = 1e-5f;

constexpr size_t MiB = (size_t)1 << 20;
constexpr size_t WS_CTL = 0, CTL_ZERO_BYTES = 1 * MiB;
constexpr size_t WS_MOD = 1 * MiB;
constexpr size_t WS_TOK = 3 * MiB;
constexpr size_t WS_XC = 5 * MiB;
constexpr size_t WS_F256 = 21 * MiB;
constexpr size_t WS_FD = 22 * MiB;
constexpr size_t WS_EV = 86 * MiB, EV_STRIDE = 22 * MiB;
constexpr size_t EV_WQKV = 0, EV_WPQ = 3 * MiB / 2, EV_WOUT = 7 * MiB / 2, EV_W13 = 11 * MiB / 2, EV_W2 = 33 * MiB / 2;
constexpr size_t WS_OD = 130 * MiB, OD_STRIDE = 174 * MiB;
constexpr size_t OD_WIN = 0, OD_WGLU = 3 * MiB, OD_WOUT = 7 * MiB / 2, OD_MW13 = 11 * MiB / 2, OD_MW2 = 235 * MiB / 2;
constexpr size_t WS_H = 478 * MiB;
constexpr size_t WS_BIG = 614 * MiB;
constexpr size_t BIG_PQT = 0, BIG_PQTC = 128 * MiB, BIG_QKV = 136 * MiB, BIG_MIX = 238 * MiB, BIG_VT = 374 * MiB, BIG_HID = 0, BIG_P = 0, BIG_Y = 0, BIG_HSQ = 276 * MiB;
constexpr size_t WS_S5M = 1030 * MiB, S5M_STRIDE = 384 * 1024;
constexpr size_t WS_END = 1058 * MiB;
constexpr int CW_BAR = 4096, CW_CNT = 16384, CW_LN = 32768, LN_SITE_WORDS = 272 * 16;
constexpr size_t WS_XS = 1054 * MiB;

#define LDS_WAIT() asm volatile("s_waitcnt lgkmcnt(0)" ::: "memory")
#define VM_WAIT() asm volatile("s_waitcnt vmcnt(0)" ::: "memory")
__device__ __forceinline__ unsigned cvt_pk_bf16(float lo, float hi) { unsigned r; asm volatile("v_cvt_pk_bf16_f32 %0, %1, %2" : "=v"(r) : "v"(lo), "v"(hi)); return r; }
__device__ __forceinline__ float bflo(unsigned w) { return __uint_as_float(w << 16); }
__device__ __forceinline__ float bfhi(unsigned w) { return __uint_as_float(w & 0xffff0000u); }
__device__ __forceinline__ float bf2f(bf16 b) { return __uint_as_float(((unsigned)b) << 16); }
__device__ __forceinline__ bf16 f2bf(float f) { return (bf16)(cvt_pk_bf16(f, 0.f) & 0xffffu); }
__device__ __forceinline__ unsigned pk_fp8x4(float a, float b, float c, float d) {
    a = __builtin_amdgcn_fmed3f(a, -448.f, 448.f); b = __builtin_amdgcn_fmed3f(b, -448.f, 448.f); c = __builtin_amdgcn_fmed3f(c, -448.f, 448.f); d = __builtin_amdgcn_fmed3f(d, -448.f, 448.f);
    int w = 0; w = __builtin_amdgcn_cvt_pk_fp8_f32(a, b, w, false); w = __builtin_amdgcn_cvt_pk_fp8_f32(c, d, w, true); return (unsigned)w; }
__device__ __forceinline__ float wave_sum(float v) {
#pragma unroll
    for (int o = 1; o < 64; o <<= 1) v += __shfl_xor(v, o);
    return v;
}
__device__ __forceinline__ float wave_max(float v) {
#pragma unroll
    for (int o = 1; o < 64; o <<= 1) v = fmaxf(v, __shfl_xor(v, o));
    return v;
}
__device__ __forceinline__ float sigmoid_f(float x) { return __builtin_amdgcn_rcpf(1.f + __builtin_amdgcn_exp2f(-1.4426950408889634f * x)); }
__device__ __forceinline__ float silu_f(float x) { return x * sigmoid_f(x); }
__device__ __forceinline__ float gelu_tanh_f(float x) { const float z = x * (0.7978845608028654f + 0.035677408136300125f * x * x); return x * __builtin_amdgcn_rcpf(1.f + __builtin_amdgcn_exp2f(-2.8853900817779268f * z)); }

#define XB_TMO      128
#define XB_XCNT(j)  (256  + 64 * (j))
#define XB_XSUB(j)  (1280 + 64 * (j))
#define XB_XGEN(j)  (2304 + 64 * (j))
#define XB_TOP      3328
#define XB_TOPGEN   3392
#define XCD_BAR_WORDS 3456
#define XB_SPIN_CAP (1u << 25)
__device__ __forceinline__ unsigned xb_ld(unsigned* p)              { return __hip_atomic_load(p, __ATOMIC_RELAXED, __HIP_MEMORY_SCOPE_AGENT); }
__device__ __forceinline__ unsigned xb_add(unsigned* p, unsigned v) { return __hip_atomic_fetch_add(p, v, __ATOMIC_RELAXED, __HIP_MEMORY_SCOPE_AGENT); }
__device__ __forceinline__ unsigned xb_xcc_id() { return (unsigned)__builtin_amdgcn_s_getreg((3 << 11) | 20) & 0xFu; }
#define XB_SPIN(cond, bar) do { unsigned _sp = 0; while (cond) { __builtin_amdgcn_s_sleep(1); \
    if ((++_sp & 255u) == 0u) { if (xb_ld(&(bar)[XB_TMO])) break; if (_sp > XB_SPIN_CAP) { atomicAdd(&(bar)[XB_TMO], 1u); break; } } } } while (0)
struct XcdBarrier { unsigned* bar; unsigned x; volatile LAS unsigned* st; };
__device__ __forceinline__ XcdBarrier xcd_barrier_post(unsigned* bar, volatile LAS unsigned* st) {
    XcdBarrier b; b.bar = bar; b.x = xb_xcc_id(); b.st = st;
    if (threadIdx.x == 0) (void)xb_add(&bar[XB_XCNT(b.x)], 1u);
    return b;
}
__device__ __forceinline__ void xcd_barrier_complete(unsigned* bar, unsigned x, unsigned& nloc, unsigned& nx) {
    const unsigned G = gridDim.x * gridDim.y * gridDim.z;
    unsigned sum, cnt, mine, sp = 0u;
    for (;;) {
        sum = 0u; cnt = 0u; mine = 0u;
#pragma unroll
        for (unsigned j = 0; j < 16; ++j) { const unsigned c = xb_ld(&bar[XB_XCNT(j)]); sum += c; cnt += (c > 0u) ? 1u : 0u; mine = (j == x) ? c : mine; }
        if (sum == G) break;
        __builtin_amdgcn_s_sleep(1);
        if ((++sp & 255u) == 0u) { if (xb_ld(&bar[XB_TMO])) break; if (sp > XB_SPIN_CAP) { atomicAdd(&bar[XB_TMO], 1u); break; } }
    }
    nloc = mine > 0u ? mine : 1u; nx = cnt > 0u ? cnt : 1u;
}
__device__ __forceinline__ void xcd_barrier(const XcdBarrier& b) {
    asm volatile("s_waitcnt vmcnt(0)" ::: "memory");
    __syncthreads();
    if (threadIdx.x == 0) {
        unsigned* bar = b.bar;
        __builtin_amdgcn_s_waitcnt(0);
        unsigned nloc = b.st[0], nx = b.st[1];
        if (nloc == 0u) { xcd_barrier_complete(bar, b.x, nloc, nx); b.st[0] = nloc; b.st[1] = nx; }
        const unsigned old = xb_add(&bar[XB_XSUB(b.x)], 1u);
        const unsigned gen = old / nloc;
        if (old + 1u == (gen + 1u) * nloc) {
            __builtin_amdgcn_fence(__ATOMIC_RELEASE, "agent");
            asm volatile("s_waitcnt vmcnt(0)" ::: "memory");
            const unsigned og = xb_add(&bar[XB_TOP], 1u);
            const unsigned tg = og / nx;
            if (og + 1u == (tg + 1u) * nx) xb_add(&bar[XB_TOPGEN], 1u);
            else XB_SPIN(xb_ld(&bar[XB_TOPGEN]) == tg, bar);
            __builtin_amdgcn_fence(__ATOMIC_ACQUIRE, "agent");
            xb_add(&bar[XB_XGEN(b.x)], 1u);
            asm volatile("s_waitcnt vmcnt(0)" ::: "memory");
        } else {
            XB_SPIN(xb_ld(&bar[XB_XGEN(b.x)]) == gen, bar);
            __builtin_amdgcn_fence(__ATOMIC_ACQUIRE, "agent");
            asm volatile("s_waitcnt vmcnt(0)" ::: "memory");
        }
    }
    __syncthreads();
}

namespace pg8 {
constexpr int BM = 256, BK = 64, HALF = 128, HTB = HALF * BK * 2, STAGE_BYTES = 8 * HTB;
__host__ __device__ __forceinline__ int lds_byte(int r, int c) { const int st = (r >> 4) * 2 + (c >> 5), rr = r & 15, cc = c & 31, ob = rr * 64 + cc * 2; return st * 1024 + (ob ^ (((ob >> 9) & 1) << 5)); }
__host__ __device__ __forceinline__ void stage_rc(int b, int& R, int& C) { const int st = b / 1024, sb = b % 1024, swz = sb ^ (((sb >> 9) & 1) << 5); R = (st >> 1) * 16 + swz / 64; C = (st & 1) * 32 + (swz % 64) / 2; }
__host__ __device__ __forceinline__ int perm32(int rho) { const int n = rho >> 4, i = rho & 15; return 8 * (i >> 2) + 4 * n + (i & 3); }

struct Unit { const char* a; const char* b; char* o; const char* p0; const char* p1; int ldo; int x0; };
struct Dims { int K, lda, ldb; };
typedef int v4i __attribute__((ext_vector_type(4)));
typedef int v8i __attribute__((ext_vector_type(8)));
struct AMapStd { int ldab = 0;   __device__ __forceinline__ unsigned voff(int R, int C) const { return (unsigned)(R * ldab + C * 2); } __device__ __forceinline__ size_t kstep() const { return 128; } __device__ __forceinline__ size_t hs() const { return (size_t)HALF * ldab; } };
struct AMapS5 { __device__ __forceinline__ unsigned voff(int R, int C) const { return (unsigned)(R * 49152 + (C >> 4) * 3072 + (C & 15) * 2); } __device__ __forceinline__ size_t kstep() const { return 12288; } __device__ __forceinline__ size_t hs() const { return (size_t)HALF * 49152; } };

__device__ __forceinline__ const char* uni_ptr(const char* p) {
    const unsigned long long v = (unsigned long long)p; const unsigned lo = __builtin_amdgcn_readfirstlane((unsigned)v), hi = __builtin_amdgcn_readfirstlane((unsigned)(v >> 32));
    return (const char*)(((unsigned long long)hi << 32) | lo); }
template <class Epi, class Sched, bool ALIGN_EPI = false, bool SP2 = false, class AMap = AMapStd, bool FP8 = false>
__device__ __forceinline__ void gemm_phase(LAS unsigned char* lds, const int tid, const Dims g, const Sched& S, const Epi& E, const AMap am_in = AMap{}) {
    constexpr int ES = FP8 ? 1 : 2;
    AMap am = am_in; if constexpr (__is_same(AMap, AMapStd)) am.ldab = g.lda * ES;
    const int wid = __builtin_amdgcn_readfirstlane(tid >> 6), lane = tid & 63, wr = wid >> 2, wc = wid & 3, fr = lane & 15, fq = lane >> 4;
    const int K = g.K, nt = (K * (FP8 ? 1 : 2)) / 128;
    unsigned voffA, voffB;
    { int R, C; stage_rc(tid * 16, R, C); const int Rb = Epi::PERM ? ((R & ~31) + perm32(R & 31)) : R;
        voffA = am.voff(R, C); voffB = (unsigned)(Rb * g.ldb * ES + C * 2); }
    const size_t d64voffA = am.voff(64, 0), d64voffB = (size_t)64 * g.ldb * ES;
    const size_t kstep = (size_t)(BK * 2), kstepA = am.kstep();
    const size_t hsA = am.hs(), hsB = (size_t)HALF * g.ldb * ES;
    const unsigned ldsw = (unsigned)wid * 1024u;
    const int aoff = lds_byte(wr * 64 + fr, fq * 8), boff = lds_byte(wc * 32 + fr, fq * 8);
#define PG8_SA(b, h) (((b) * 2 + (h)) * HTB)
#define PG8_SB(b, h) ((4 + (b) * 2 + (h)) * HTB)
#define PG8_STAGE(bufoff, gbase, voff) do { unsigned _vo = (voff); asm volatile("" : "+v"(_vo));   \
        __builtin_amdgcn_global_load_lds((const unsigned*)((const char*)(gbase) + _vo), (LAS unsigned*)(lds + (bufoff) + ldsw), 16, 0, 0); \
        __builtin_amdgcn_global_load_lds((const unsigned*)((const char*)(gbase) + d64##voff + _vo), (LAS unsigned*)(lds + (bufoff) + ldsw + 8192), 16, 0, 0); } while (0)
#define PG8_LD8(p) __builtin_shufflevector(*(const LAS v4i*)(p), *(const LAS v4i*)((p) + 1024), 0, 1, 2, 3, 4, 5, 6, 7)
#define PG8_LDA(dst, b, h) do { if constexpr (FP8) { _Pragma("unroll") for (int m = 0; m < 4; ++m) dst##8[m] = PG8_LD8(lds + PG8_SA(b, h) + aoff + m * 2048); } \
        else { _Pragma("unroll") for (int m = 0; m < 4; ++m) _Pragma("unroll") for (int k = 0; k < 2; ++k) dst[m][k] = *(const LAS bf16x8*)(lds + PG8_SA(b, h) + aoff + m * 2048 + k * 1024); } } while (0)
#define PG8_LDB(dst, b, h) do { if constexpr (FP8) { _Pragma("unroll") for (int n = 0; n < 2; ++n) dst##8[n] = PG8_LD8(lds + PG8_SB(b, h) + boff + n * 2048); } \
        else { _Pragma("unroll") for (int n = 0; n < 2; ++n) _Pragma("unroll") for (int k = 0; k < 2; ++k) dst[n][k] = *(const LAS bf16x8*)(lds + PG8_SB(b, h) + boff + n * 2048 + k * 1024); } } while (0)
#define PG8_MMA(ai, bj, At, Bt) do { __builtin_amdgcn_s_setprio(1); \
        if constexpr (FP8) { _Pragma("unroll") for (int m = 0; m < 4; ++m) _Pragma("unroll") for (int n = 0; n < 2; ++n) \
            acc[ai][bj][m][n] = __builtin_amdgcn_mfma_scale_f32_16x16x128_f8f6f4(Bt##8[n], At##8[m], acc[ai][bj][m][n], 0, 0, 0, 0, 0, 0); } \
        else { _Pragma("unroll") for (int m = 0; m < 4; ++m) _Pragma("unroll") for (int n = 0; n < 2; ++n) _Pragma("unroll") for (int k = 0; k < 2; ++k) \
            acc[ai][bj][m][n] = __builtin_amdgcn_mfma_f32_16x16x32_bf16(Bt[n][k], At[m][k], acc[ai][bj][m][n], 0, 0, 0); } \
        __builtin_amdgcn_s_setprio(0); } while (0)
#define PG8_WAIT_V(n) asm volatile("s_waitcnt vmcnt(" #n ")" ::: "memory")
#define PG8_WAIT_L(n) asm volatile("s_waitcnt lgkmcnt(" #n ")" ::: "memory")
#define PG8_BAR __builtin_amdgcn_s_barrier()
#define PG8_SCHED __builtin_amdgcn_sched_barrier(0)
    int ui = 0;
    const char* cA; const char* cB;
    { Unit u0; if (!S.next(0, u0)) return; cA = uni_ptr(u0.a); cB = uni_ptr(u0.b); }
    f32x4 acc[2][2][4][2];
#pragma unroll
    for (int a = 0; a < 2; ++a)
#pragma unroll
        for (int b = 0; b < 2; ++b)
#pragma unroll
            for (int m = 0; m < 4; ++m)
#pragma unroll
                for (int n = 0; n < 2; ++n) acc[a][b][m][n] = (f32x4){0.f, 0.f, 0.f, 0.f};
    bf16x8 At[4][2], B0[2][2], B1[2][2];
    v8i At8[4], B08[2], B18[2];
    if constexpr (SP2) {
        PG8_STAGE(PG8_SB(0, 0), cB, voffB); PG8_STAGE(PG8_SB(0, 1), cB + hsB, voffB); PG8_STAGE(PG8_SA(0, 0), cA, voffA); PG8_STAGE(PG8_SA(0, 1), cA + hsA, voffA);
        if (wr == 1) PG8_BAR;
        PG8_WAIT_V(2); PG8_BAR;
        PG8_STAGE(PG8_SB(1, 0), cB + kstep, voffB); PG8_STAGE(PG8_SA(1, 0), cA + kstepA, voffA); PG8_STAGE(PG8_SB(1, 1), cB + hsB + kstep, voffB);
        PG8_WAIT_V(6); PG8_BAR;
    } else {
        PG8_STAGE(PG8_SB(0, 0), cB, voffB); PG8_STAGE(PG8_SA(0, 0), cA, voffA); PG8_STAGE(PG8_SB(0, 1), cB + hsB, voffB); PG8_STAGE(PG8_SA(0, 1), cA + hsA, voffA);
        if (wr == 1) PG8_BAR;
        PG8_WAIT_V(4); PG8_BAR;
        PG8_STAGE(PG8_SB(1, 0), cB + kstep, voffB); PG8_STAGE(PG8_SA(1, 0), cA + kstepA, voffA); PG8_STAGE(PG8_SB(1, 1), cB + hsB + kstep, voffB);
        PG8_WAIT_V(6); PG8_BAR;
    }
    for (;;) {
        const char* nA = cA; const char* nB = cB; bool has_next;
        { Unit un; has_next = S.next(ui + 1, un); if (has_next) { nA = uni_ptr(un.a); nB = uni_ptr(un.b); } }
#pragma unroll 1
        for (int t = 0; t < nt; t += 2) {
            const bool last = (t == nt - 2);
            const char* a1 = cA + (size_t)(t + 1) * kstepA;
            const char* a2 = last ? nA : cA + (size_t)(t + 2) * kstepA; const char* b2 = last ? nB : cB + (size_t)(t + 2) * kstep;
            const char* a3 = a2 + kstepA; const char* b3 = b2 + kstep;
            if constexpr (SP2) {
            PG8_LDB(B0, 0, 0); PG8_LDB(B1, 0, 1); PG8_SCHED; PG8_LDA(At, 0, 0); PG8_STAGE(PG8_SA(1, 1), a1 + hsA, voffA);
            PG8_WAIT_V(8); PG8_WAIT_L(0); PG8_BAR; PG8_MMA(0, 0, At, B0); PG8_MMA(0, 1, At, B1); PG8_BAR; PG8_SCHED;
            PG8_LDA(At, 0, 1); PG8_STAGE(PG8_SB(0, 0), b2, voffB); PG8_STAGE(PG8_SB(0, 1), b2 + hsB, voffB); PG8_STAGE(PG8_SA(0, 0), a2, voffA);
            PG8_WAIT_V(8); PG8_WAIT_L(0); PG8_BAR; PG8_MMA(1, 0, At, B0); PG8_MMA(1, 1, At, B1); PG8_BAR; PG8_SCHED;
            PG8_LDB(B0, 1, 0); PG8_LDB(B1, 1, 1); PG8_SCHED; PG8_LDA(At, 1, 0); PG8_STAGE(PG8_SA(0, 1), a2 + hsA, voffA);
            PG8_WAIT_V(8); PG8_WAIT_L(0); PG8_BAR; PG8_MMA(0, 0, At, B0); PG8_MMA(0, 1, At, B1); PG8_BAR; PG8_SCHED;
            PG8_LDA(At, 1, 1); PG8_STAGE(PG8_SB(1, 0), b3, voffB); PG8_STAGE(PG8_SB(1, 1), b3 + hsB, voffB); PG8_STAGE(PG8_SA(1, 0), a3, voffA);
            PG8_WAIT_V(8); PG8_WAIT_L(0); PG8_BAR; PG8_MMA(1, 0, At, B0); PG8_MMA(1, 1, At, B1); PG8_BAR; PG8_SCHED;
            } else {
            PG8_LDB(B0, 0, 0); PG8_SCHED; PG8_LDA(At, 0, 0); PG8_STAGE(PG8_SA(1, 1), a1 + hsA, voffA);
            PG8_WAIT_L(8); PG8_BAR; PG8_WAIT_L(0); PG8_MMA(0, 0, At, B0); PG8_BAR; PG8_SCHED;
            PG8_LDB(B1, 0, 1); PG8_STAGE(PG8_SB(0, 0), b2, voffB);
            PG8_BAR; PG8_WAIT_L(0); PG8_MMA(0, 1, At, B1); PG8_BAR;
            PG8_LDA(At, 0, 1); PG8_STAGE(PG8_SA(0, 0), a2, voffA);
            PG8_BAR; PG8_WAIT_L(0); PG8_MMA(1, 0, At, B0); PG8_BAR; PG8_SCHED;
            PG8_STAGE(PG8_SB(0, 1), b2 + hsB, voffB);
            PG8_WAIT_V(6); PG8_BAR; PG8_MMA(1, 1, At, B1); PG8_BAR;
            PG8_LDB(B0, 1, 0); PG8_SCHED; PG8_LDA(At, 1, 0); PG8_STAGE(PG8_SA(0, 1), a2 + hsA, voffA);
            PG8_WAIT_L(8); PG8_BAR; PG8_WAIT_L(0); PG8_MMA(0, 0, At, B0); PG8_BAR; PG8_SCHED;
            PG8_LDB(B1, 1, 1); PG8_STAGE(PG8_SB(1, 0), b3, voffB);
            PG8_BAR; PG8_WAIT_L(0); PG8_MMA(0, 1, At, B1); PG8_BAR;
            PG8_LDA(At, 1, 1); PG8_STAGE(PG8_SA(1, 0), a3, voffA);
            PG8_BAR; PG8_WAIT_L(0); PG8_MMA(1, 0, At, B0); PG8_BAR; PG8_SCHED;
            PG8_STAGE(PG8_SB(1, 1), b3 + hsB, voffB);
            PG8_WAIT_V(6); PG8_BAR; PG8_MMA(1, 1, At, B1); PG8_BAR;
            }
        }
        if constexpr (ALIGN_EPI) { if (wr == 0) PG8_BAR; }
        { Unit uc; (void)S.next(ui, uc); E(acc, uc, wid); }
        if (!has_next) break;
#pragma unroll
        for (int a = 0; a < 2; ++a)
#pragma unroll
            for (int b = 0; b < 2; ++b)
#pragma unroll
                for (int m = 0; m < 4; ++m)
#pragma unroll
                    for (int n = 0; n < 2; ++n) acc[a][b][m][n] = (f32x4){0.f, 0.f, 0.f, 0.f};
        cA = nA; cB = nB; ++ui;
        if constexpr (ALIGN_EPI) { if (wr == 1) PG8_BAR; }
    }
    PG8_WAIT_V(0);
    if constexpr (!ALIGN_EPI) { if (wr == 0) PG8_BAR; }
    PG8_BAR;
#undef PG8_SA
#undef PG8_SB
#undef PG8_STAGE
#undef PG8_LDA
#undef PG8_LDB
#undef PG8_MMA
#undef PG8_LD8
#undef PG8_WAIT_V
#undef PG8_WAIT_L
#undef PG8_BAR
#undef PG8_SCHED
}

struct EpiStore {
    static constexpr bool PERM = true;
    __device__ __forceinline__ void operator()(const f32x4 (&acc)[2][2][4][2], const Unit& u, const int wid) const {
        int lane_; asm volatile("v_mbcnt_lo_u32_b32 %0, -1, 0\n\tv_mbcnt_hi_u32_b32 %0, -1, %0" : "=v"(lane_));
        const int wr = wid >> 2, wc = wid & 3, fr = lane_ & 15, fq = lane_ >> 4;
        bf16* base = (bf16*)u.o; int row0 = wr * 64 + fr, col0 = wc * 32 + 8 * fq; asm volatile("" : "+v"(row0), "+v"(col0)); const bool act = u.x0 != 0;
#pragma unroll
        for (int ai = 0; ai < 2; ++ai)
#pragma unroll
            for (int m = 0; m < 4; ++m) { bf16* rowp = base + (size_t)(row0 + ai * HALF + m * 16) * u.ldo + col0;
#pragma unroll
                for (int bj = 0; bj < 2; ++bj) { f32x4 v0 = acc[ai][bj][m][0], v1 = acc[ai][bj][m][1];
                    if (act) {
#pragma unroll
                        for (int j = 0; j < 4; ++j) { v0[j] = gelu_tanh_f(v0[j]); v1[j] = gelu_tanh_f(v1[j]); } }
                    v4u w; w.x = cvt_pk_bf16(v0[0], v0[1]); w.y = cvt_pk_bf16(v0[2], v0[3]); w.z = cvt_pk_bf16(v1[0], v1[1]); w.w = cvt_pk_bf16(v1[2], v1[3]);
                    *(v4u*)(rowp + bj * HALF) = w; } }
    }
};
struct EpiSwiGLU {
    static constexpr bool PERM = true;
    __device__ __forceinline__ void operator()(const f32x4 (&acc)[2][2][4][2], const Unit& u, const int wid) const {
        int lane_; asm volatile("v_mbcnt_lo_u32_b32 %0, -1, 0\n\tv_mbcnt_hi_u32_b32 %0, -1, %0" : "=v"(lane_));
        const int wr = wid >> 2, wc = wid & 3, fr = lane_ & 15, fq = lane_ >> 4;
        bf16* base = (bf16*)u.o; int row0 = wr * 64 + fr, col0 = wc * 32 + 8 * fq; asm volatile("" : "+v"(row0), "+v"(col0));
#pragma unroll
        for (int ai = 0; ai < 2; ++ai)
#pragma unroll
            for (int m = 0; m < 4; ++m) { bf16* rowp = base + (size_t)(row0 + ai * HALF + m * 16) * u.ldo + col0;
                f32x4 h0, h1;
#pragma unroll
                for (int j = 0; j < 4; ++j) { h0[j] = silu_f(acc[ai][0][m][0][j]) * acc[ai][1][m][0][j]; h1[j] = silu_f(acc[ai][0][m][1][j]) * acc[ai][1][m][1][j]; }
                v4u w; w.x = cvt_pk_bf16(h0[0], h0[1]); w.y = cvt_pk_bf16(h0[2], h0[3]); w.z = cvt_pk_bf16(h1[0], h1[1]); w.w = cvt_pk_bf16(h1[2], h1[3]);
                *(v4u*)rowp = w; }
    }
};
struct EpiSwiGLU8 {
    static constexpr bool PERM = true;
    __device__ __forceinline__ void operator()(const f32x4 (&acc)[2][2][4][2], const Unit& u, const int wid) const {
        int lane_; asm volatile("v_mbcnt_lo_u32_b32 %0, -1, 0\n\tv_mbcnt_hi_u32_b32 %0, -1, %0" : "=v"(lane_));
        const int wr = wid >> 2, wc = wid & 3, fr = lane_ & 15, fq = lane_ >> 4;
        unsigned char* base = (unsigned char*)u.o; int row0 = wr * 64 + fr, col0 = wc * 32 + 8 * fq; asm volatile("" : "+v"(row0), "+v"(col0));
        constexpr float SA = 1.0f / (Q_H * Q_W);
#pragma unroll
        for (int ai = 0; ai < 2; ++ai)
#pragma unroll
            for (int m = 0; m < 4; ++m) { unsigned char* rowp = base + (size_t)(row0 + ai * HALF + m * 16) * u.ldo + col0;
                float h0[4], h1[4];
#pragma unroll
                for (int j = 0; j < 4; ++j) { h0[j] = silu_f(acc[ai][0][m][0][j] * SA) * (acc[ai][1][m][0][j] * (SA * Q_HID)); h1[j] = silu_f(acc[ai][0][m][1][j] * SA) * (acc[ai][1][m][1][j] * (SA * Q_HID)); }
                v2u w; w.x = pk_fp8x4(h0[0], h0[1], h0[2], h0[3]); w.y = pk_fp8x4(h1[0], h1[1], h1[2], h1[3]);
                *(v2u*)rowp = w; }
    }
};
struct EpiStoreQ {
    static constexpr bool PERM = true;
    __device__ __forceinline__ void operator()(const f32x4 (&acc)[2][2][4][2], const Unit& u, const int wid) const {
        int lane_; asm volatile("v_mbcnt_lo_u32_b32 %0, -1, 0\n\tv_mbcnt_hi_u32_b32 %0, -1, %0" : "=v"(lane_));
        const int wr = wid >> 2, wc = wid & 3, fr = lane_ & 15, fq = lane_ >> 4;
        bf16* base = (bf16*)u.o; int row0 = wr * 64 + fr, col0 = wc * 32 + 8 * fq; asm volatile("" : "+v"(row0), "+v"(col0));
        constexpr float SA = 1.0f / (Q_HID * Q_W);
#pragma unroll
        for (int ai = 0; ai < 2; ++ai)
#pragma unroll
            for (int m = 0; m < 4; ++m) { bf16* rowp = base + (size_t)(row0 + ai * HALF + m * 16) * u.ldo + col0;
#pragma unroll
                for (int bj = 0; bj < 2; ++bj) { const f32x4 v0 = acc[ai][bj][m][0] * SA, v1 = acc[ai][bj][m][1] * SA;
                    v4u w; w.x = cvt_pk_bf16(v0[0], v0[1]); w.y = cvt_pk_bf16(v0[2], v0[3]); w.z = cvt_pk_bf16(v1[0], v1[1]); w.w = cvt_pk_bf16(v1[2], v1[3]);
                    *(v4u*)(rowp + bj * HALF) = w; } }
    }
};
struct EpiResid {
    static constexpr bool PERM = false;
    __device__ __forceinline__ void operator()(const f32x4 (&acc)[2][2][4][2], const Unit& u, const int wid) const {
        int lane_; asm volatile("v_mbcnt_lo_u32_b32 %0, -1, 0\n\tv_mbcnt_hi_u32_b32 %0, -1, %0" : "=v"(lane_));
        const int wr = wid >> 2, wc = wid & 3, fr = lane_ & 15, fq = lane_ >> 4;
        const float* xs = (const float*)u.p0; float* zo = (float*)u.o; const float* gv = (const float*)u.p1;
        int row0 = wr * 64 + fr, col0 = wc * 32 + 4 * fq; asm volatile("" : "+v"(row0), "+v"(col0));
#pragma unroll
        for (int ai = 0; ai < 2; ++ai)
#pragma unroll
            for (int m = 0; m < 4; ++m) { const size_t off = (size_t)(row0 + ai * HALF + m * 16) * D + col0;
#pragma unroll
                for (int bj = 0; bj < 2; ++bj)
#pragma unroll
                    for (int n = 0; n < 2; ++n) { const f32x4 xv = *(const f32x4*)(xs + off + bj * HALF + n * 16); const f32x4 gvv = *(const f32x4*)(gv + col0 + bj * HALF + n * 16);
                        *(f32x4*)(zo + off + bj * HALF + n * 16) = xv * ALPHA + gvv * acc[ai][bj][m][n]; }
                asm volatile("" ::: "memory"); }
    }
};
struct EpiResidLN {
    static constexpr bool PERM = false;
    const float* lng; const float* lnb; int sc_delta, sh_delta; bf16* H; unsigned* cnt; unsigned long long* xs; unsigned* tmo; LAS unsigned char* tab;
    __device__ __forceinline__ void operator()(f32x4 (&acc)[2][2][4][2], const Unit& u, const int wid) const {
        int lane_; asm volatile("v_mbcnt_lo_u32_b32 %0, -1, 0\n\tv_mbcnt_hi_u32_b32 %0, -1, %0" : "=v"(lane_));
        const int wr = wid >> 2, wc = wid & 3, fr = lane_ & 15, fq = lane_ >> 4, pm = u.x0 >> 2, pn = u.x0 & 3;
        const float* xsrc = (const float*)u.p0; float* xo = (float*)u.o; const float* gv = (const float*)u.p1;
        int row0 = wr * 64 + fr, col0 = wc * 32 + 4 * fq; asm volatile("" : "+v"(row0), "+v"(col0));
        LAS f32x2* Pt = (LAS f32x2*)tab; LAS f32x2* St = (LAS f32x2*)(tab + 8192);
        f32x4 gg[2][2];
#pragma unroll
        for (int bj = 0; bj < 2; ++bj)
#pragma unroll
            for (int n = 0; n < 2; ++n) gg[bj][n] = *(const f32x4*)(gv + col0 + bj * HALF + n * 16);
#pragma unroll
        for (int ai = 0; ai < 2; ++ai)
#pragma unroll
            for (int mh = 0; mh < 2; ++mh) {
                f32x4 xv[2][2][2];
#pragma unroll
                for (int ml = 0; ml < 2; ++ml)
#pragma unroll
                    for (int bj = 0; bj < 2; ++bj)
#pragma unroll
                        for (int n = 0; n < 2; ++n) xv[ml][bj][n] = *(const f32x4*)(xsrc + (size_t)(row0 + ai * HALF + (2 * mh + ml) * 16) * D + col0 + bj * HALF + n * 16);
#pragma unroll
                for (int ml = 0; ml < 2; ++ml) { const int m = 2 * mh + ml; float sm = 0.f, sq = 0.f;
#pragma unroll
                    for (int bj = 0; bj < 2; ++bj)
#pragma unroll
                        for (int n = 0; n < 2; ++n) { const f32x4 z = xv[ml][bj][n] * ALPHA + gg[bj][n] * acc[ai][bj][m][n]; acc[ai][bj][m][n] = z;
                            sm += (z[0] + z[1]) + (z[2] + z[3]); sq += (z[0] * z[0] + z[1] * z[1]) + (z[2] * z[2] + z[3] * z[3]); }
                    sm += __shfl_xor(sm, 16); sm += __shfl_xor(sm, 32); sq += __shfl_xor(sq, 16); sq += __shfl_xor(sq, 32);
                    if (fq == 0) Pt[(ai * HALF + wr * 64 + m * 16 + fr) * 4 + wc] = (f32x2){sm, sq}; }
                asm volatile("" ::: "memory"); }
        asm volatile("s_waitcnt lgkmcnt(0)" ::: "memory"); __builtin_amdgcn_s_barrier(); asm volatile("" ::: "memory");
        const int trow = wid * 64 + lane_;
        if (wid < 4) {
            const f32x2 a = Pt[trow * 4 + 0], b = Pt[trow * 4 + 1], c = Pt[trow * 4 + 2], d = Pt[trow * 4 + 3];
            const float ts = (a.x + b.x) + (c.x + d.x), tq = (a.y + b.y) + (c.y + d.y);
            __hip_atomic_store(xs + ((size_t)pm * 256 + trow) * 4 + pn, ((unsigned long long)__float_as_uint(tq) << 32) | __float_as_uint(ts), __ATOMIC_RELAXED, __HIP_MEMORY_SCOPE_AGENT);
            asm volatile("s_waitcnt vmcnt(0)" ::: "memory");
            if (lane_ == 0) __hip_atomic_fetch_add(cnt + pm * 16, 1u, __ATOMIC_RELAXED, __HIP_MEMORY_SCOPE_AGENT);
        }
        if (wid == 0) {
            unsigned sp = 0;
            while ((unsigned)__builtin_amdgcn_readfirstlane(__hip_atomic_load(cnt + pm * 16, __ATOMIC_RELAXED, __HIP_MEMORY_SCOPE_AGENT)) < 16u) {
                __builtin_amdgcn_s_sleep(1);
                if ((++sp & 1023u) == 0u && (sp > (1u << 24) || __hip_atomic_load(tmo, __ATOMIC_RELAXED, __HIP_MEMORY_SCOPE_AGENT) != 0u)) { if (lane_ == 0) __hip_atomic_store(tmo, 1u, __ATOMIC_RELAXED, __HIP_MEMORY_SCOPE_AGENT); break; } }
            __builtin_amdgcn_fence(__ATOMIC_ACQUIRE, "agent");
        }
        asm volatile("s_waitcnt vmcnt(0) lgkmcnt(0)" ::: "memory"); __builtin_amdgcn_s_barrier(); asm volatile("" ::: "memory");
        if (wid < 4) {
            const unsigned long long* sl = xs + ((size_t)pm * 256 + trow) * 4; float ts = 0.f, tq = 0.f;
#pragma unroll
            for (int t = 0; t < 4; ++t) { const unsigned long long w = __hip_atomic_load(sl + t, __ATOMIC_RELAXED, __HIP_MEMORY_SCOPE_AGENT); ts += __uint_as_float((unsigned)w); tq += __uint_as_float((unsigned)(w >> 32)); }
            const float mean = ts * (1.f / D), var = fmaxf(tq * (1.f / D) - mean * mean, 0.f);
            St[trow] = (f32x2){mean, rsqrtf(var + LN_EPS)};
        }
        asm volatile("s_waitcnt vmcnt(0) lgkmcnt(0)" ::: "memory"); __builtin_amdgcn_s_barrier(); asm volatile("" ::: "memory");
        const float* lg = lng + pn * 256; const float* lb = lnb + pn * 256; const float* scv = gv + sc_delta; const float* shv = gv + sh_delta;
        bf16* hb = H + ((size_t)pm * 256) * D + pn * 256;
        f32x4 g4[2][2], b4[2][2], s4[2][2], t4[2][2];
#pragma unroll
        for (int bj = 0; bj < 2; ++bj)
#pragma unroll
            for (int n = 0; n < 2; ++n) { const int c = col0 + bj * HALF + n * 16; g4[bj][n] = *(const f32x4*)(lg + c); b4[bj][n] = *(const f32x4*)(lb + c); s4[bj][n] = *(const f32x4*)(scv + c) + 1.0f; t4[bj][n] = *(const f32x4*)(shv + c); }
#pragma unroll
        for (int ai = 0; ai < 2; ++ai)
#pragma unroll
            for (int m = 0; m < 4; ++m) { const int r = row0 + ai * HALF + m * 16; const f32x2 ms = St[r]; const size_t off = (size_t)r * D + col0;
#pragma unroll
                for (int bj = 0; bj < 2; ++bj)
#pragma unroll
                    for (int n = 0; n < 2; ++n) {
                        const f32x4 xn = (acc[ai][bj][m][n] - ms.x) * ms.y * g4[bj][n] + b4[bj][n];
                        *(f32x4*)(xo + off + bj * HALF + n * 16) = xn;
                        const f32x4 hv = xn * s4[bj][n] + t4[bj][n];
                        v2u w; w.x = cvt_pk_bf16(hv[0], hv[1]); w.y = cvt_pk_bf16(hv[2], hv[3]); *(v2u*)(hb + off + bj * HALF + n * 16) = w; } }
    }
};
struct EpiGLU {
    static constexpr bool PERM = true;
    __device__ __forceinline__ void operator()(const f32x4 (&acc)[2][2][4][2], const Unit& u, const int wid) const {
        int lane_; asm volatile("v_mbcnt_lo_u32_b32 %0, -1, 0\n\tv_mbcnt_hi_u32_b32 %0, -1, %0" : "=v"(lane_));
        const int wr = wid >> 2, wc = wid & 3, fr = lane_ & 15, fq = lane_ >> 4;
        bf16* base = (bf16*)u.o; const bf16* gp = (const bf16*)u.p0; const float* bias = (const float*)u.p1;
        int row0 = wr * 64 + fr, col0 = wc * 32 + 8 * fq; asm volatile("" : "+v"(row0), "+v"(col0));
#pragma unroll
        for (int ai = 0; ai < 2; ++ai)
#pragma unroll
            for (int m = 0; m < 4; ++m) { const int r = row0 + ai * HALF + m * 16;
#pragma unroll
                for (int bj = 0; bj < 2; ++bj) { const v4u gw = *(const v4u*)(gp + (size_t)r * u.x0 + col0 + bj * HALF);
                    const f32x4 b0 = *(const f32x4*)(bias + col0 + bj * HALF), b1 = *(const f32x4*)(bias + col0 + bj * HALF + 4);
                    const f32x4 a0 = acc[ai][bj][m][0] + b0, a1 = acc[ai][bj][m][1] + b1;
                    const float o0 = bflo(gw.x) * sigmoid_f(a0[0]), o1 = bfhi(gw.x) * sigmoid_f(a0[1]), o2 = bflo(gw.y) * sigmoid_f(a0[2]), o3 = bfhi(gw.y) * sigmoid_f(a0[3]);
                    const float o4 = bflo(gw.z) * sigmoid_f(a1[0]), o5 = bfhi(gw.z) * sigmoid_f(a1[1]), o6 = bflo(gw.w) * sigmoid_f(a1[2]), o7 = bfhi(gw.w) * sigmoid_f(a1[3]);
                    v4u w; w.x = cvt_pk_bf16(o0, o1); w.y = cvt_pk_bf16(o2, o3); w.z = cvt_pk_bf16(o4, o5); w.w = cvt_pk_bf16(o6, o7);
                    *(v4u*)(base + (size_t)r * u.ldo + col0 + bj * HALF) = w; }
                asm volatile("" ::: "memory"); }
    }
};
struct EpiS5B {
    static constexpr bool PERM = true;
    __device__ __forceinline__ void operator()(const f32x4 (&acc)[2][2][4][2], const Unit& u, const int wid) const {
        int lane_; asm volatile("v_mbcnt_lo_u32_b32 %0, -1, 0\n\tv_mbcnt_hi_u32_b32 %0, -1, %0" : "=v"(lane_));
        const int wr = wid >> 2, wc = wid & 3, fr = lane_ & 15, fq = lane_ >> 4;
        bf16* base = (bf16*)u.o; const bf16* y1 = (const bf16*)u.p0;
        int row0 = wr * 64 + fr, col0 = wc * 32 + 8 * fq; asm volatile("" : "+v"(row0), "+v"(col0));
#pragma unroll
        for (int ai = 0; ai < 2; ++ai)
#pragma unroll
            for (int m = 0; m < 4; ++m) { const int r = row0 + ai * HALF + m * 16;
#pragma unroll
                for (int bj = 0; bj < 2; ++bj) { const int c = col0 + bj * HALF; const v4u yw = *(const v4u*)(y1 + (size_t)r * 8192 + c);
                    const f32x4 a0 = acc[ai][bj][m][0], a1 = acc[ai][bj][m][1];
                    const float o0 = gelu_tanh_f(a0[0] + bflo(yw.x)), o1 = gelu_tanh_f(a0[1] + bfhi(yw.x)), o2 = gelu_tanh_f(a0[2] + bflo(yw.y)), o3 = gelu_tanh_f(a0[3] + bfhi(yw.y));
                    const float o4 = gelu_tanh_f(a1[0] + bflo(yw.z)), o5 = gelu_tanh_f(a1[1] + bfhi(yw.z)), o6 = gelu_tanh_f(a1[2] + bflo(yw.w)), o7 = gelu_tanh_f(a1[3] + bfhi(yw.w));
                    v4u w; w.x = cvt_pk_bf16(o0, o1); w.y = cvt_pk_bf16(o2, o3); w.z = cvt_pk_bf16(o4, o5); w.w = cvt_pk_bf16(o6, o7);
                    *(v4u*)(base + ((size_t)r * 16 + (c >> 4)) * 1536 + (c & 15)) = w; }
                asm volatile("" ::: "memory"); }
    }
};
}

struct Params { const float* in[32]; float* out; unsigned char* ws; int ph_lo, ph_hi; };
enum { I_X = 0, I_C, I_CTX, I_CCTX, I_WMOD, I_BMOD, I_LNG, I_LNB, I_EV_WIN, I_EV_WOUT, I_EV_SINK, I_EV_W1, I_EV_W3, I_EV_W2, I_OD_WIN, I_A_RE, I_A_IM, I_LOG_DT,
       I_B_RE, I_B_IM, I_C_RE, I_C_IM, I_SSM_D, I_WGLU, I_BGLU, I_WS, I_BS, I_OD_WOUT, I_ROUTER, I_MW1, I_MW3, I_MW2 };

constexpr int LDS_RING = 131072, LDS_MISC = LDS_RING + 320, LDS_LNTAB = LDS_RING + 1024, LDS_BYTES = 147456;
constexpr int NWAVES = 8, NTHREADS = 512;

struct Frame {
    LAS unsigned char* lds;
    int tid, lane, wave, G, bid, gw, NGW;
    unsigned char* ws;
    unsigned* ctl;
};

using pg8::Unit;
__device__ __forceinline__ void xcd_rows(int c, int nM, int& r0, int& cnt) { const int x = c & 7, base = nM >> 3, extra = nM & 7; cnt = base + (x < extra ? 1 : 0); r0 = x * base + (x < extra ? x : extra); }
__device__ __forceinline__ void grp_unit(int q, int cnt, int nN, int RG, int& row_local, int& pn) {
    const int gfull = RG * nN, rg = q / gfull, rem = q - rg * gfull; int rows_here = cnt - rg * RG; rows_here = rows_here < RG ? rows_here : RG;
    pn = rem / rows_here; row_local = rg * RG + (rem - pn * rows_here);
}
__device__ __forceinline__ bool xcd_unit(int i, int G, int c, int nM, int nN, int RG, int& pm, int& pn) {
    int r0, cnt; xcd_rows(c, nM, r0, cnt); const int q = i * (G >> 3) + (c >> 3); if (q >= cnt * nN) return false;
    int rl; grp_unit(q, cnt, nN, RG, rl, pn); pm = r0 + rl; return true;
}
struct SchedStd {
    int nN, nUnits, G, c; const char* A; const char* B; char* O; size_t aStep, bStep, oRow, oCol; int ldo, act_from;
    __device__ __forceinline__ bool next(int i, Unit& u) const {
        int pm, pn; if (!xcd_unit(i, G, c, nUnits / nN, nN, 4, pm, pn)) return false;
        u.a = A + (size_t)pm * aStep; u.b = B + (size_t)pn * bStep; u.o = O + (size_t)pm * oRow + (size_t)pn * oCol; u.p0 = nullptr; u.p1 = nullptr; u.ldo = ldo; u.x0 = (pn >= act_from) ? 1 : 0; return true;
    }
};
struct SchedEvIn {
    int G, c; const char* H; const char* Wqkv; const char* Wpq; char* QKV; char* PQT; char* PQTC;
    __device__ __forceinline__ bool next(int i, Unit& u) const {
        u.p0 = nullptr; u.p1 = nullptr; u.x0 = 0;
        int r0, cnt; xcd_rows(c, T / 256, r0, cnt);
        int q = i * (G >> 3) + (c >> 3);
        if (q < cnt * 3) { int rl, pn; grp_unit(q, cnt, 3, 4, rl, pn); const int pm = r0 + rl;
            u.a = H + (size_t)pm * 256 * D * 2; u.b = Wqkv + (size_t)pn * 256 * D * 2; u.o = QKV + ((size_t)pm * 256 * 768 + pn * 256) * 2; u.ldo = 768; return true; }
        q -= cnt * 3; if (q >= cnt * 4) return false;
        int rl, pm; grp_unit(q, cnt, 4, 4, rl, pm); const int tt = r0 + rl, isq = pm >> 1, ch0 = (pm & 1) * 256;
        u.a = Wpq + (size_t)pm * 256 * D * 2; u.b = H + (size_t)tt * 256 * D * 2;
        if (tt < TL / 256) { const int b = tt >> 4, n0 = (tt & 15) * 256; u.o = PQT + ((((size_t)b * 512 + ch0) * 2 + isq) * 4096 + n0) * 2; u.ldo = 8192; }
        else { const int b = tt - TL / 256; u.o = PQTC + (((size_t)b * 512 + ch0) * 2 + isq) * 256 * 2; u.ldo = 512; }
        return true;
    }
};
struct SchedDft {
    int G, c; const char* FDm; const char* VB; const char* F2; const char* PQTC; char* MIX;
    __device__ __forceinline__ bool next(int i, Unit& u) const {
        int L = i * G + c; u.p0 = nullptr; u.p1 = nullptr; u.x0 = 0;
        if (L < 512) { const int b = L >> 5, pn = L & 31, k2 = pn >> 1, ch0 = (pn & 1) * 256;
            u.a = FDm; u.b = VB + ((((size_t)b * 16 + k2) * 512 + ch0) * 512) * 2; u.o = MIX + ((((size_t)b * 4096 + k2) * D) + ch0) * 2; u.ldo = 16 * D; return true; }
        L -= 512; if (L >= 32) return false;
        const int b = L >> 1, pn = L & 1;
        u.a = F2; u.b = PQTC + ((size_t)b * 512 + pn * 256) * 512 * 2; u.o = MIX + (((size_t)TL + (size_t)b * 256) * D + pn * 256) * 2; u.ldo = D; return true;
    }
};
struct SchedResid {
    int G, c, nUnits; const char* A; size_t aStep; const char* W; size_t bStep; const float* xl; const float* xc; float* zl; float* zc; const float* gate;
    __device__ __forceinline__ bool next(int i, Unit& u) const {
        int pm, pn; if (!xcd_unit(i, G, c, nUnits >> 2, 4, 1, pm, pn)) return false;
        const int L = pm * 4 + pn;
        u.a = A + (size_t)pm * aStep; u.b = W + (size_t)pn * bStep;
        const bool isc = pm >= TL / 256; const int pr = isc ? pm - TL / 256 : pm; const int mrow = isc ? 16 : (pm >> 4);
        const size_t off = ((size_t)pr * 256 * D + pn * 256);
        u.p0 = (const char*)((isc ? xc : xl) + off); u.o = (char*)((isc ? zc : zl) + off); u.p1 = (const char*)(gate + (size_t)mrow * 6144 + pn * 256); u.ldo = D; u.x0 = L; return true;
    }
};
struct SchedGlu {
    int G, c; const char* P; const char* W; char* MIX; const float* bias;
    __device__ __forceinline__ bool next(int i, Unit& u) const {
        const int L = i * G + c; if (L >= (T / 256) * 2) return false;
        const int pm = L >> 1, pn = L & 1;
        u.a = P + (size_t)pm * 256 * 1536 * 2; u.b = W + (size_t)pn * 256 * 512 * 2; u.o = MIX + ((size_t)pm * 256 * D + pn * 256) * 2;
        u.p0 = P + ((size_t)pm * 256 * 1536 + pn * 256) * 2; u.p1 = (const char*)(bias + pn * 256); u.ldo = D; u.x0 = 1536; return true;
    }
};
struct SchedS5A {
    int G, c; const char* P; const char* WA; char* Y1; char* HB;
    __device__ __forceinline__ bool next(int i, Unit& u) const {
        const int L = i * G + c; if (L >= 32 * 34) return false;
        const int g = L / 34, rem = L - g * 34, pm = rem >> 1, pn = rem & 1;
        u.a = P + ((size_t)pm * 256 * 16 * 1536 + g * 16) * 2; u.b = WA + (size_t)g * S5M_STRIDE + (size_t)pn * 256 * 256 * 2;
        u.o = (pn ? HB : Y1) + (((size_t)pm * 256 * 32 + g) * 256) * 2; u.p0 = nullptr; u.p1 = nullptr; u.ldo = 8192; u.x0 = 0; return true;
    }
};
struct SchedS5B {
    int G, c; const char* HB; const char* CL; const char* Y1; char* P;
    __device__ __forceinline__ bool next(int i, Unit& u) const {
        const int L = i * G + c; if (L >= 32 * 17) return false;
        const int g = L / 17, pm = L - g * 17;
        const size_t toff = (((size_t)pm * 256 * 32 + g) * 256) * 2;
        u.a = HB + toff; u.b = CL + (size_t)g * S5M_STRIDE; u.p0 = Y1 + toff; u.o = P + ((size_t)pm * 256 * 16 * 1536 + g * 16) * 2; u.p1 = nullptr; u.ldo = 0; u.x0 = 0; return true;
    }
};
struct SchedMoeUp {
    int G, c, nUnits, rt0; int toff[9]; const char* HS; const char* W; char* HID;
    __device__ __forceinline__ bool next(int i, Unit& u) const {
        int rl, pn; if (!xcd_unit(i, G, c, nUnits / 28, 28, 4, rl, pn)) return false;
        const int rt = rt0 + rl; int e = 0;
#pragma unroll
        for (int k = 1; k < 8; ++k) e += (rt >= toff[k]) ? 1 : 0;
        u.a = HS + (size_t)rt * 256 * D; u.b = W + ((size_t)e * 7168 + pn * 256) * D; u.o = HID + ((size_t)rl * 256 * EH + pn * 128);
        u.p0 = nullptr; u.p1 = nullptr; u.ldo = EH; u.x0 = 0; return true;
    }
};
struct SchedMoeDown {
    int G, c, nUnits, rt0; int toff[9]; const char* HID; const char* W; char* Y;
    __device__ __forceinline__ bool next(int i, Unit& u) const {
        int rl, pn; if (!xcd_unit(i, G, c, nUnits >> 2, 4, 8, rl, pn)) return false;
        const int rt = rt0 + rl; int e = 0;
#pragma unroll
        for (int k = 1; k < 8; ++k) e += (rt >= toff[k]) ? 1 : 0;
        u.a = HID + (size_t)rl * 256 * EH; u.b = W + ((size_t)e * 1024 + pn * 256) * EH; u.o = Y + ((size_t)rt * 256 * D + pn * 256) * 2;
        u.p0 = nullptr; u.p1 = nullptr; u.ldo = D; u.x0 = 0; return true;
    }
};

__device__ __forceinline__ void tr_item(const float* W, int ldn, bf16* WT, int ldk, int k0, int n0, int drow0, LAS float* scr, int lane) {
#pragma unroll 8
    for (int i = 0; i < 32; ++i) { const int kk = 2 * i + (lane >> 5); scr[kk * 33 + (lane & 31)] = W[(size_t)(k0 + kk) * ldn + n0 + (lane & 31)]; }
    LDS_WAIT(); asm volatile("" ::: "memory");
    const int c = lane & 7;
#pragma unroll
    for (int j = 0; j < 4; ++j) { const int n = (lane >> 3) + 8 * j; const LAS float* s = scr + (8 * c) * 33 + n;
        v4u o; o.x = cvt_pk_bf16(s[0 * 33], s[1 * 33]); o.y = cvt_pk_bf16(s[2 * 33], s[3 * 33]); o.z = cvt_pk_bf16(s[4 * 33], s[5 * 33]); o.w = cvt_pk_bf16(s[6 * 33], s[7 * 33]);
        *(v4u*)(WT + (size_t)(drow0 + n) * ldk + k0 + 8 * c) = o; }
    LDS_WAIT(); asm volatile("" ::: "memory");
}
__device__ __forceinline__ void tr_item8(const float* W, int ldn, unsigned char* WT, int ldk, int k0, int n0, int drow0, LAS float* scr, int lane, float qs) {
#pragma unroll 8
    for (int i = 0; i < 32; ++i) { const int kk = 2 * i + (lane >> 5); scr[kk * 33 + (lane & 31)] = W[(size_t)(k0 + kk) * ldn + n0 + (lane & 31)] * qs; }
    LDS_WAIT(); asm volatile("" ::: "memory");
    const int c = lane & 7;
#pragma unroll
    for (int j = 0; j < 4; ++j) { const int n = (lane >> 3) + 8 * j; const LAS float* sp = scr + (8 * c) * 33 + n;
        v2u o; o.x = pk_fp8x4(sp[0 * 33], sp[1 * 33], sp[2 * 33], sp[3 * 33]); o.y = pk_fp8x4(sp[4 * 33], sp[5 * 33], sp[6 * 33], sp[7 * 33]);
        *(v2u*)(WT + (size_t)(drow0 + n) * ldk + k0 + 8 * c) = o; }
    LDS_WAIT(); asm volatile("" ::: "memory");
}
__device__ __forceinline__ void tr_job8(const float* W, int ldn, int N, unsigned char* WT, int ldk, int mode, int roff, int item, LAS float* scr, int lane) {
    const int nblk = N / 32, kb = item / nblk, nb = item - kb * nblk, n0 = nb * 32;
    const int drow0 = mode ? ((n0 >> 7) * 256 + (n0 & 127) + roff) : (roff + n0);
    tr_item8(W, ldn, WT, ldk, kb * 64, n0, drow0, scr, lane, Q_W);
}
__device__ __forceinline__ void tr_job(const float* W, int ldn, int N, bf16* WT, int ldk, int mode, int roff, int item, LAS float* scr, int lane) {
    const int nblk = N / 32, kb = item / nblk, nb = item - kb * nblk, n0 = nb * 32;
    const int drow0 = mode ? ((n0 >> 7) * 256 + (n0 & 127) + roff) : (roff + n0);
    tr_item(W, ldn, WT, ldk, kb * 64, n0, drow0, scr, lane);
}
__device__ __forceinline__ void cvt_item(const Params& p, int r, LAS float* scr, int lane) {
    unsigned char* ws = p.ws;
    constexpr int EV_ITEMS = 384 + 512 + 3 * 1408;
    constexpr int ODS_ITEMS = 768 + 128 + 512;
    constexpr int EXP_ITEMS = 3 * 1792, MOE_ITEMS = 8 * EXP_ITEMS;
    if (r < 2 * EV_ITEMS) { const int li = r / EV_ITEMS; r -= li * EV_ITEMS; unsigned char* base = ws + WS_EV + li * EV_STRIDE;
        if (r < 384) { tr_job(p.in[I_EV_WIN] + (size_t)li * D * 1280 + 512, 1280, 768, (bf16*)(base + EV_WQKV), D, 0, 0, r, scr, lane); return; } r -= 384;
        if (r < 512) { tr_job(p.in[I_EV_WOUT] + (size_t)li * D * D, D, D, (bf16*)(base + EV_WOUT), D, 0, 0, r, scr, lane); return; } r -= 512;
        if (r < 1408) { tr_job(p.in[I_EV_W1] + (size_t)li * D * FFH, FFH, FFH, (bf16*)(base + EV_W13), D, 1, 0, r, scr, lane); return; } r -= 1408;
        if (r < 1408) { tr_job(p.in[I_EV_W3] + (size_t)li * D * FFH, FFH, FFH, (bf16*)(base + EV_W13), D, 1, 128, r, scr, lane); return; } r -= 1408;
        tr_job(p.in[I_EV_W2] + (size_t)li * FFH * D, D, D, (bf16*)(base + EV_W2), FFH, 0, 0, r, scr, lane); return; }
    r -= 2 * EV_ITEMS;
    if (r < 2 * ODS_ITEMS) { const int li = r / ODS_ITEMS; r -= li * ODS_ITEMS; unsigned char* base = ws + WS_OD + li * OD_STRIDE;
        if (r < 768) { tr_job(p.in[I_OD_WIN] + (size_t)li * D * 1536, 1536, 1536, (bf16*)(base + OD_WIN), D, 0, 0, r, scr, lane); return; } r -= 768;
        if (r < 128) { tr_job(p.in[I_WGLU] + (size_t)li * 512 * 512, 512, 512, (bf16*)(base + OD_WGLU), 512, 0, 0, r, scr, lane); return; } r -= 128;
        tr_job(p.in[I_OD_WOUT] + (size_t)li * D * D, D, D, (bf16*)(base + OD_WOUT), D, 0, 0, r, scr, lane); return; }
    r -= 2 * ODS_ITEMS;
    { const int li = r / MOE_ITEMS; r -= li * MOE_ITEMS; const int e = r / EXP_ITEMS; r -= e * EXP_ITEMS; unsigned char* base = ws + WS_OD + li * OD_STRIDE;
        const size_t we = (size_t)li * NEXP + e;
        if (r < 1792) { tr_job8(p.in[I_MW1] + we * D * EH, EH, EH, (unsigned char*)(base + OD_MW13) + (size_t)e * 7168 * D, D, 1, 0, r, scr, lane); return; } r -= 1792;
        if (r < 1792) { tr_job8(p.in[I_MW3] + we * D * EH, EH, EH, (unsigned char*)(base + OD_MW13) + (size_t)e * 7168 * D, D, 1, 128, r, scr, lane); return; } r -= 1792;
        tr_job8(p.in[I_MW2] + we * EH * D, D, D, (unsigned char*)(base + OD_MW2) + (size_t)e * D * EH, EH, 0, 0, r, scr, lane); }
}
constexpr int CVT_ITEMS = 2 * 5120 + 2 * 1408 + 2 * 8 * 3 * 1792;

__device__ __forceinline__ void fold_unit(const Params& p, Frame& F, int unit) {
    const int li = unit >> 6, g = (unit >> 4) & 3, k0 = (unit & 15) * 64;
    LAS float* tile = (LAS float*)F.lds;
    LAS float* trig = tile + 64 * 129;
    const float* W = p.in[I_EV_WIN] + (size_t)li * D * 1280;
    for (int e = F.tid; e < 64 * 128; e += NTHREADS) { const int k = e >> 7, c = e & 127; tile[k * 129 + c] = W[(size_t)(k0 + k) * 1280 + g * 128 + c]; }
    if (F.tid < 128) { float s, c; sincospif((float)F.tid / 64.0f, &s, &c); trig[F.tid] = c * 0.08838834764831845f; trig[128 + F.tid] = s * 0.08838834764831845f; }
    __syncthreads();
    bf16* WT = (bf16*)(p.ws + WS_EV + li * EV_STRIDE + EV_WPQ);
    const int k = F.lane, mg = F.wave;
    for (int mm = 0; mm < 16; ++mm) { const int m = mg * 16 + mm; float sp = 0.f, sq = 0.f;
        for (int c = 0; c < 128; ++c) { const float w = tile[k * 129 + c]; const int ph = (m * c) & 127; sp += w * trig[ph]; sq += w * trig[128 + ph]; }
        WT[(size_t)(g * 128 + m) * D + k0 + k] = f2bf(sp); WT[(size_t)(512 + g * 128 + m) * D + k0 + k] = f2bf(sq); }
    __syncthreads();
}

__device__ __forceinline__ void row_load(const float* row, int lane, f32x4 (&v)[4]) {
#pragma unroll
    for (int j = 0; j < 4; ++j) v[j] = *(const f32x4*)(row + 256 * j + 4 * lane);
}
__device__ __forceinline__ void row_store(float* row, int lane, const f32x4 (&v)[4]) {
#pragma unroll
    for (int j = 0; j < 4; ++j) *(f32x4*)(row + 256 * j + 4 * lane) = v[j];
}
__device__ __forceinline__ void row_store_bf16(bf16* row, int lane, const f32x4 (&v)[4]) {
#pragma unroll
    for (int j = 0; j < 4; ++j) { v2u w; w.x = cvt_pk_bf16(v[j][0], v[j][1]); w.y = cvt_pk_bf16(v[j][2], v[j][3]); *(v2u*)(row + 256 * j + 4 * lane) = w; }
}
__device__ __forceinline__ void row_layernorm(f32x4 (&v)[4], const float* g, const float* b, int lane) {
    float s = 0.f;
#pragma unroll
    for (int j = 0; j < 4; ++j) s += (v[j][0] + v[j][1]) + (v[j][2] + v[j][3]);
    const float mean = wave_sum(s) * (1.f / D); float q = 0.f;
#pragma unroll
    for (int j = 0; j < 4; ++j) { v[j] = v[j] - mean; q += (v[j][0] * v[j][0] + v[j][1] * v[j][1]) + (v[j][2] * v[j][2] + v[j][3] * v[j][3]); }
    const float rstd = rsqrtf(wave_sum(q) * (1.f / D) + LN_EPS);
#pragma unroll
    for (int j = 0; j < 4; ++j) { const f32x4 gg = *(const f32x4*)(g + 256 * j + 4 * lane), bb = *(const f32x4*)(b + 256 * j + 4 * lane); v[j] = v[j] * rstd * gg + bb; }
}
__device__ __forceinline__ void row_modulate(f32x4 (&h)[4], const f32x4 (&v)[4], const float* sc, const float* sh, int lane) {
#pragma unroll
    for (int j = 0; j < 4; ++j) { const f32x4 s = *(const f32x4*)(sc + 256 * j + 4 * lane), t = *(const f32x4*)(sh + 256 * j + 4 * lane); h[j] = v[j] * (s + 1.0f) + t; }
}

__device__ __forceinline__ void row_ln_pre(f32x4 (&v)[4], const f32x4 (&gg)[4], const f32x4 (&bb)[4]) {
    float s = 0.f;
#pragma unroll
    for (int j = 0; j < 4; ++j) s += (v[j][0] + v[j][1]) + (v[j][2] + v[j][3]);
    const float mean = wave_sum(s) * (1.f / D); float q = 0.f;
#pragma unroll
    for (int j = 0; j < 4; ++j) { v[j] = v[j] - mean; q += (v[j][0] * v[j][0] + v[j][1] * v[j][1]) + (v[j][2] * v[j][2] + v[j][3] * v[j][3]); }
    const float rstd = rsqrtf(wave_sum(q) * (1.f / D) + LN_EPS);
#pragma unroll
    for (int j = 0; j < 4; ++j) v[j] = v[j] * rstd * gg[j] + bb[j];
}
__device__ __forceinline__ void row_load_mod(const float* sc, const float* sh, int lane, f32x4 (&s)[4], f32x4 (&t)[4]) {
#pragma unroll
    for (int j = 0; j < 4; ++j) { s[j] = *(const f32x4*)(sc + 256 * j + 4 * lane); t[j] = *(const f32x4*)(sh + 256 * j + 4 * lane); }
}
typedef const __attribute__((address_space(4))) Params* PP;
#define PIN(i) ((const float*)pp->in[i])
#define DECL_LDS extern __shared__ __attribute__((aligned(16))) unsigned char lds_raw[]
#define PHASE_FN static __device__ __forceinline__ void

__device__ __forceinline__ Frame make_frame(PP pp, unsigned char* lds_generic) {
    Frame F;
    F.lds = (LAS unsigned char*)lds_generic;
    { int t_ = threadIdx.x; asm volatile("" : "+v"(t_)); F.tid = t_; }
    F.lane = F.tid & 63; F.wave = __builtin_amdgcn_readfirstlane(F.tid >> 6);
    F.G = gridDim.x; F.bid = blockIdx.x; F.gw = F.bid * NWAVES + F.wave; F.NGW = F.G * NWAVES;
    F.ws = (unsigned char*)pp->ws; F.ctl = (unsigned*)(F.ws + WS_CTL);
    return F;
}
#define FRAME() DECL_LDS; asm volatile("" : "+s"(pp)); Frame F = make_frame(pp, lds_raw); unsigned char* ws = F.ws; (void)ws

PHASE_FN grid_bar(PP pp) {
    FRAME();
    XcdBarrier bar; bar.bar = F.ctl + CW_BAR; bar.x = xb_xcc_id(); bar.st = (volatile LAS unsigned*)(F.lds + LDS_MISC) + 8;
    xcd_barrier(bar);
}

static __device__ __forceinline__ void ln_pass(const Frame& F, float* out, float* XC, bf16* Hb, const float* lng, const float* lnb, const float* modv, const int sc_off, const int sh_off, const int TR) {
    f32x4 gg[4], bb[4];
#pragma unroll
    for (int j = 0; j < 4; ++j) { gg[j] = *(const f32x4*)(lng + 256 * j + 4 * F.lane); bb[j] = *(const f32x4*)(lnb + 256 * j + 4 * F.lane); }
    for (int r0 = F.gw; r0 < TR; r0 += 2 * F.NGW) {
        const int r1 = r0 + F.NGW; const bool two = r1 < TR;
        const bool c0 = r0 >= TL, c1 = r1 >= TL;
        float* x0 = c0 ? XC + (size_t)(r0 - TL) * D : out + (size_t)r0 * D; float* x1 = two ? (c1 ? XC + (size_t)(r1 - TL) * D : out + (size_t)r1 * D) : x0;
        const float* m0 = modv + (size_t)(c0 ? 16 : (r0 >> 12)) * 6144; const float* m1 = modv + (size_t)((two && !c1) ? (r1 >> 12) : 16) * 6144;
        f32x4 v0[4], v1[4], s0[4], t0[4], s1[4], t1[4];
        row_load(x0, F.lane, v0); row_load(x1, F.lane, v1);
        row_load_mod(m0 + sc_off, m0 + sh_off, F.lane, s0, t0); row_load_mod(m1 + sc_off, m1 + sh_off, F.lane, s1, t1);
        row_ln_pre(v0, gg, bb); row_ln_pre(v1, gg, bb);
        row_store(x0, F.lane, v0);
#pragma unroll
        for (int j = 0; j < 4; ++j) s0[j] = v0[j] * (s0[j] + 1.0f) + t0[j];
        row_store_bf16(Hb + (size_t)r0 * D, F.lane, s0);
        if (two) { row_store(x1, F.lane, v1);
#pragma unroll
            for (int j = 0; j < 4; ++j) s1[j] = v1[j] * (s1[j] + 1.0f) + t1[j];
            row_store_bf16(Hb + (size_t)r1 * D, F.lane, s1); }
    }
}
PHASE_FN ph_fold(PP pp) {
    FRAME();
    Params p; p.ws = ws; p.in[I_EV_WIN] = PIN(I_EV_WIN);
    for (int u = F.bid; u < 128; u += F.G) fold_unit(p, F, u);
}
PHASE_FN ph_mod(PP pp) {
    FRAME();
    float* MOD = (float*)(ws + WS_MOD);
    LAS float* sc = (LAS float*)F.lds;
    const float* cin = PIN(I_C); const float* ccin = PIN(I_CCTX);
    __syncthreads();
    for (int e = F.tid; e < 17 * D; e += NTHREADS) { const int r = e >> 10, k = e & 1023; const float v = (r < 16) ? cin[r * D + k] : ccin[k]; sc[e] = silu_f(v); }
    __syncthreads();
    const int kq = F.lane >> 4, cl = F.lane & 15;
    for (int task = F.gw; task < DEPTH * 6144 / 16; task += F.NGW) {
        const int col = task * 16 + cl, l = col / 6144, j = col - l * 6144;
        const float* W = PIN(I_WMOD) + (size_t)l * D * 6144 + (size_t)(kq * 256) * 6144 + j;
        float acc[17];
#pragma unroll
        for (int r = 0; r < 17; ++r) acc[r] = 0.f;
        for (int k0 = 0; k0 < 256; k0 += 16) {
            float w[16];
#pragma unroll
            for (int q = 0; q < 16; ++q) w[q] = W[(size_t)(k0 + q) * 6144];
#pragma unroll
            for (int q4 = 0; q4 < 4; ++q4)
#pragma unroll
                for (int r = 0; r < 17; ++r) { const f32x4 sv = *(const LAS f32x4*)(sc + r * D + kq * 256 + k0 + 4 * q4); acc[r] += (sv[0] * w[4 * q4] + sv[1] * w[4 * q4 + 1]) + (sv[2] * w[4 * q4 + 2] + sv[3] * w[4 * q4 + 3]); }
        }
        const float bm = PIN(I_BMOD)[l * 6144 + j];
#pragma unroll
        for (int r = 0; r < 17; ++r) { float v = acc[r]; v += __shfl_xor(v, 16); v += __shfl_xor(v, 32); if (kq == 0) MOD[((size_t)l * 17 + r) * 6144 + j] = v + bm; }
    }
    __syncthreads();
}
PHASE_FN ph_cvt(PP pp) {
    FRAME();
    Params p; p.ws = ws;
    p.in[I_EV_WIN] = PIN(I_EV_WIN); p.in[I_EV_WOUT] = PIN(I_EV_WOUT); p.in[I_EV_W1] = PIN(I_EV_W1); p.in[I_EV_W3] = PIN(I_EV_W3); p.in[I_EV_W2] = PIN(I_EV_W2);
    p.in[I_OD_WIN] = PIN(I_OD_WIN); p.in[I_WGLU] = PIN(I_WGLU); p.in[I_OD_WOUT] = PIN(I_OD_WOUT); p.in[I_MW1] = PIN(I_MW1); p.in[I_MW3] = PIN(I_MW3); p.in[I_MW2] = PIN(I_MW2);
    LAS float* scr = (LAS float*)(F.lds + F.wave * 16384);
    for (int it = F.gw; it < CVT_ITEMS; it += F.NGW) cvt_item(p, it, scr, F.lane);
}
PHASE_FN ph_dftmat(PP pp) {
    FRAME();
    bf16* FDm = (bf16*)(ws + WS_FD); bf16* F2 = (bf16*)(ws + WS_F256);
    for (int it = F.bid * NTHREADS + F.tid; it < 2 * 256 * 64; it += F.G * NTHREADS) {
        const int which = it >> 14, k = (it >> 6) & 255, n0 = (it & 63) * 8; const bool isq = n0 >= 256; const int nb = n0 & 255;
        float v[8];
#pragma unroll
        for (int j = 0; j < 8; ++j) { const int phs = (k * (nb + j)) & 255; float sn, cs; sincospif((float)phs * (1.0f / 128.0f), &sn, &cs);
            v[j] = which ? (isq ? -sn * (1.f / 16.f) : cs * (1.f / 16.f)) : (isq ? sn * (1.f / 64.f) : cs * (1.f / 64.f)); }
        v4u w; w.x = cvt_pk_bf16(v[0], v[1]); w.y = cvt_pk_bf16(v[2], v[3]); w.z = cvt_pk_bf16(v[4], v[5]); w.w = cvt_pk_bf16(v[6], v[7]);
        *(v4u*)((which ? F2 : FDm) + (size_t)k * 512 + n0) = w;
    }
}
PHASE_FN ph_s5mat(PP pp) {
    FRAME();
    LAS float* lam = (LAS float*)F.lds;
    LAS float* bb = lam + 2 * 64 * 17 * 2;
    LAS float* cc = bb + 2 * 64 * 16 * 2;
    LAS float* kt = cc + 2 * 16 * 64 * 2;
    for (int unit = F.bid; unit < 64; unit += F.G) {
        const int li = unit >> 5, g = unit & 31;
        __syncthreads();
        if (F.tid < 128) { const int d = F.tid >> 6, pl = F.tid & 63; const int sidx = ((li * 2 + d) * 32 + g);
            const float are = PIN(I_A_RE)[sidx * 64 + pl], aim = PIN(I_A_IM)[sidx * 64 + pl], dt = expf(PIN(I_LOG_DT)[sidx]);
            for (int e = 0; e <= 16; ++e) { const float mag = expf(are * dt * (float)e); float sn, cn; sincosf(aim * dt * (float)e, &sn, &cn); lam[((d * 64 + pl) * 17 + e) * 2] = mag * cn; lam[((d * 64 + pl) * 17 + e) * 2 + 1] = mag * sn; } }
        __syncthreads();
        for (int e = F.tid; e < 2048; e += NTHREADS) { const int d = e >> 10, pl = (e >> 4) & 63, sp = e & 15; const int sidx = ((li * 2 + d) * 32 + g);
            const float are = PIN(I_A_RE)[sidx * 64 + pl], aim = PIN(I_A_IM)[sidx * 64 + pl];
            const float lre = lam[((d * 64 + pl) * 17 + 1) * 2], lim = lam[((d * 64 + pl) * 17 + 1) * 2 + 1];
            const float den = 1.0f / (are * are + aim * aim);
            const float fre = ((lre - 1.0f) * are + lim * aim) * den, fim = (lim * are - (lre - 1.0f) * aim) * den;
            const float br = PIN(I_B_RE)[((size_t)sidx * 64 + pl) * 16 + sp], bi = PIN(I_B_IM)[((size_t)sidx * 64 + pl) * 16 + sp];
            bb[e * 2] = fre * br - fim * bi; bb[e * 2 + 1] = fre * bi + fim * br; }
        for (int e = F.tid; e < 2048; e += NTHREADS) { const int d = e >> 10, sq = (e >> 6) & 15, pl = e & 63; const int sidx = ((li * 2 + d) * 32 + g);
            cc[e * 2] = PIN(I_C_RE)[((size_t)sidx * 16 + sq) * 64 + pl]; cc[e * 2 + 1] = PIN(I_C_IM)[((size_t)sidx * 16 + sq) * 64 + pl]; }
        __syncthreads();
        for (int e = F.tid; e < 8192; e += NTHREADS) { const int d = e >> 12, tau = (e >> 8) & 15, sq = (e >> 4) & 15, sp = e & 15; float acc = 0.f;
            for (int pl = 0; pl < 64; ++pl) { const float cr = cc[((d * 16 + sq) * 64 + pl) * 2], ci = cc[((d * 16 + sq) * 64 + pl) * 2 + 1];
                const float lr = lam[((d * 64 + pl) * 17 + tau) * 2], lj = lam[((d * 64 + pl) * 17 + tau) * 2 + 1];
                const float br = bb[((d * 64 + pl) * 16 + sp) * 2], bi = bb[((d * 64 + pl) * 16 + sp) * 2 + 1];
                const float tr = cr * lr - ci * lj, ti = cr * lj + ci * lr;
                acc += tr * br - ti * bi; }
            kt[e] = acc; }
        __syncthreads();
        bf16* WA = (bf16*)(ws + WS_S5M + (size_t)unit * S5M_STRIDE); bf16* CLm = WA + 512 * 256;
        const float* dsk = PIN(I_SSM_D) + (size_t)li * 512 + g * 16;
        for (int it = F.tid; it < 8192; it += NTHREADS) { const int row = it >> 5, c0 = (it & 31) * 8;
            float v[8];
            { const int i = row >> 4, sq = row & 15, j = c0 >> 4, sp0 = c0 & 15;
#pragma unroll
              for (int q = 0; q < 8; ++q) { const int sp = sp0 + q; float a = 0.f; if (i >= j) a += kt[((0 * 16 + (i - j)) * 16 + sq) * 16 + sp]; if (j >= i) a += kt[((1 * 16 + (j - i)) * 16 + sq) * 16 + sp]; if (i == j && sq == sp) a += dsk[sq]; v[q] = a; }
              v4u w; w.x = cvt_pk_bf16(v[0], v[1]); w.y = cvt_pk_bf16(v[2], v[3]); w.z = cvt_pk_bf16(v[4], v[5]); w.w = cvt_pk_bf16(v[6], v[7]); *(v4u*)(WA + (size_t)row * 256 + c0) = w; }
            { const int d = row >> 7, pl = (row >> 1) & 63, ri = row & 1, j = c0 >> 4, sp0 = c0 & 15, e = d ? j : 15 - j;
              const float lr = lam[((d * 64 + pl) * 17 + e) * 2], lj = lam[((d * 64 + pl) * 17 + e) * 2 + 1];
#pragma unroll
              for (int q = 0; q < 8; ++q) { const float br = bb[((d * 64 + pl) * 16 + sp0 + q) * 2], bi = bb[((d * 64 + pl) * 16 + sp0 + q) * 2 + 1]; v[q] = ri ? (lr * bi + lj * br) : (lr * br - lj * bi); }
              v4u w; w.x = cvt_pk_bf16(v[0], v[1]); w.y = cvt_pk_bf16(v[2], v[3]); w.z = cvt_pk_bf16(v[4], v[5]); w.w = cvt_pk_bf16(v[6], v[7]); *(v4u*)(WA + (size_t)(256 + row) * 256 + c0) = w; }
            { const int i = row >> 4, sq = row & 15, d = c0 >> 7, pl0 = (c0 >> 1) & 63, e = d ? 16 - i : i + 1;
#pragma unroll
              for (int q = 0; q < 4; ++q) { const int pl = pl0 + q; const float cr = cc[((d * 16 + sq) * 64 + pl) * 2], ci = cc[((d * 16 + sq) * 64 + pl) * 2 + 1];
                  const float lr = lam[((d * 64 + pl) * 17 + e) * 2], lj = lam[((d * 64 + pl) * 17 + e) * 2 + 1];
                  v[2 * q] = cr * lr - ci * lj; v[2 * q + 1] = -(cr * lj + ci * lr); }
              v4u w; w.x = cvt_pk_bf16(v[0], v[1]); w.y = cvt_pk_bf16(v[2], v[3]); w.z = cvt_pk_bf16(v[4], v[5]); w.w = cvt_pk_bf16(v[6], v[7]); *(v4u*)(CLm + (size_t)row * 256 + c0) = w; }
        }
    }
    __syncthreads();
}
PHASE_FN ph_pro_b(PP pp) {
    FRAME();
    const float* MOD = (const float*)(ws + WS_MOD); bf16* Hb = (bf16*)(ws + WS_H);
    const float* xin = PIN(I_X); const float* cin = PIN(I_CTX);
    static_assert(T % (2 * 256 * NWAVES) == 0 && TL % (2 * 256 * NWAVES) == 0, "row pairs");
    for (int r0 = F.gw; r0 < T; r0 += 2 * F.NGW) {
        const int r1 = r0 + F.NGW; const bool c0 = r0 >= TL, c1 = r1 >= TL;
        const float* x0 = c0 ? cin + (size_t)(r0 - TL) * D : xin + (size_t)r0 * D; const float* x1 = c1 ? cin + (size_t)(r1 - TL) * D : xin + (size_t)r1 * D;
        const float* m0 = MOD + (size_t)(c0 ? 16 : (r0 >> 12)) * 6144; const float* m1 = MOD + (size_t)(c1 ? 16 : (r1 >> 12)) * 6144;
        f32x4 v0[4], v1[4], s0[4], t0[4], s1[4], t1[4];
        row_load(x0, F.lane, v0); row_load(x1, F.lane, v1); row_load_mod(m0 + 1024, m0, F.lane, s0, t0); row_load_mod(m1 + 1024, m1, F.lane, s1, t1);
#pragma unroll
        for (int j = 0; j < 4; ++j) { s0[j] = v0[j] * (s0[j] + 1.0f) + t0[j]; s1[j] = v1[j] * (s1[j] + 1.0f) + t1[j]; }
        row_store_bf16(Hb + (size_t)r0 * D, F.lane, s0); row_store_bf16(Hb + (size_t)r1 * D, F.lane, s1);
    }
}

PHASE_FN ph_e1(PP pp, int layer) {
    FRAME();
    unsigned char* evw = ws + WS_EV + (layer >> 1) * EV_STRIDE; unsigned char* BIG = ws + WS_BIG;
    SchedEvIn S{F.G, F.bid, (const char*)(ws + WS_H), (const char*)(evw + EV_WQKV), (const char*)(evw + EV_WPQ), (char*)(BIG + BIG_QKV), (char*)(BIG + BIG_PQT), (char*)(BIG + BIG_PQTC)};
    pg8::gemm_phase<pg8::EpiStore, SchedEvIn, true, true>(F.lds, F.tid, pg8::Dims{D, D, D}, S, pg8::EpiStore{});
}
struct cf { float r, i; };
__device__ __forceinline__ cf cmul(cf a, float wr, float wi) { return cf{a.r * wr - a.i * wi, a.r * wi + a.i * wr}; }
__device__ __forceinline__ void radix4(cf x0, cf x1, cf x2, cf x3, cf& y0, cf& y1, cf& y2, cf& y3) {
    const cf s02{x0.r + x2.r, x0.i + x2.i}, d02{x0.r - x2.r, x0.i - x2.i}, s13{x1.r + x3.r, x1.i + x3.i}, d13{x1.r - x3.r, x1.i - x3.i};
    y0 = cf{s02.r + s13.r, s02.i + s13.i}; y2 = cf{s02.r - s13.r, s02.i - s13.i}; y1 = cf{d02.r + d13.i, d02.i - d13.r}; y3 = cf{d02.r - d13.i, d02.i + d13.r};
}
__device__ __forceinline__ void fft16(cf (&x)[16]) {
    constexpr float C1 = 0.92387953251128674f, S1 = 0.38268343236508977f, C2 = 0.70710678118654752f;
    cf A[4][4];
#pragma unroll
    for (int b = 0; b < 4; ++b) radix4(x[b], x[4 + b], x[8 + b], x[12 + b], A[b][0], A[b][1], A[b][2], A[b][3]);
    A[1][1] = cmul(A[1][1], C1, -S1); A[1][2] = cmul(A[1][2], C2, -C2); A[1][3] = cmul(A[1][3], S1, -C1);
    A[2][1] = cmul(A[2][1], C2, -C2); A[2][2] = cf{A[2][2].i, -A[2][2].r}; A[2][3] = cmul(A[2][3], -C2, -C2);
    A[3][1] = cmul(A[3][1], S1, -C1); A[3][2] = cmul(A[3][2], -C2, -C2); A[3][3] = cmul(A[3][3], -C1, S1);
#pragma unroll
    for (int c = 0; c < 4; ++c) radix4(A[0][c], A[1][c], A[2][c], A[3][c], x[c], x[c + 4], x[c + 8], x[c + 12]);
}
PHASE_FN ph_e2_fft(PP pp) {
    FRAME();
    const bf16* PQT = (const bf16*)(ws + WS_BIG + BIG_PQT); bf16* VB = (bf16*)(ws + WS_H);
    for (int it = F.bid * NTHREADS + F.tid; it < NBATCH * 512 * 128; it += F.G * NTHREADS) {
        const int n1 = (it & 127) * 2, ch = (it >> 7) & 511, b = it >> 16;
        const bf16* pp_ = PQT + ((size_t)(b * 512 + ch) * 2) * 4096 + n1; const bf16* qq_ = pp_ + 4096;
        unsigned pw[16], qw[16];
#pragma unroll
        for (int n2 = 0; n2 < 16; ++n2) { pw[n2] = *(const unsigned*)(pp_ + 256 * n2); qw[n2] = *(const unsigned*)(qq_ + 256 * n2); }
        unsigned ore[16], oim[16];
#pragma unroll
        for (int e = 0; e < 2; ++e) {
            cf x[16];
#pragma unroll
            for (int n2 = 0; n2 < 16; ++n2) { x[n2].r = e ? bfhi(pw[n2]) : bflo(pw[n2]); x[n2].i = -(e ? bfhi(qw[n2]) : bflo(qw[n2])); }
            fft16(x);
            float sn, cs; sincospif((float)(n1 + e) * (1.0f / 2048.0f), &sn, &cs);
            cf wk{cs, -sn};
#pragma unroll
            for (int k2 = 1; k2 < 16; ++k2) { x[k2] = cmul(x[k2], wk.r, wk.i); wk = cmul(wk, cs, -sn); }
#pragma unroll
            for (int k2 = 0; k2 < 16; ++k2) { const unsigned rr = cvt_pk_bf16(x[k2].r, 0.f) & 0xffffu, ii = cvt_pk_bf16(x[k2].i, 0.f) & 0xffffu;
                if (e) { ore[k2] |= rr << 16; oim[k2] |= ii << 16; } else { ore[k2] = rr; oim[k2] = ii; } }
        }
#pragma unroll
        for (int k2 = 0; k2 < 16; ++k2) { bf16* dst = VB + (((size_t)b * 16 + k2) * 512 + ch) * 512 + n1; *(unsigned*)dst = ore[k2]; *(unsigned*)(dst + 256) = oim[k2]; }
    }
}
PHASE_FN ph_e2_dft(PP pp) {
    FRAME();
    unsigned char* BIG = ws + WS_BIG;
    SchedDft S{F.G, F.bid, (const char*)(ws + WS_FD), (const char*)(ws + WS_H), (const char*)(ws + WS_F256), (const char*)(BIG + BIG_PQTC), (char*)(BIG + BIG_MIX)};
    pg8::gemm_phase<pg8::EpiStore, SchedDft, true, true>(F.lds, F.tid, pg8::Dims{512, 512, 512}, S, pg8::EpiStore{});
}
PHASE_FN ph_e2_rope(PP pp) {
    FRAME();
    bf16* QKV = (bf16*)(ws + WS_BIG + BIG_QKV);
    LAS f32x2* cs = (LAS f32x2*)F.lds;
    __syncthreads();
    for (int e = F.tid; e < 1024; e += NTHREADS) { const int pos = e >> 4, i = e & 15; const float inv = powf(10000.0f, -(float)i / 16.0f); float s, c; sincosf((float)pos * inv, &s, &c); cs[e] = (f32x2){c, s}; }
    __syncthreads();
    for (int it = F.bid * NTHREADS + F.tid; it < TL * 10; it += F.G * NTHREADS) {
        const int r = it / 10, hh = it - r * 10, n = r & 4095;
        v4u* base = (v4u*)(QKV + (size_t)r * 768 + hh * 64);
        v4u v[8];
#pragma unroll
        for (int k = 0; k < 8; ++k) v[k] = base[k];
#pragma unroll
        for (int ax = 0; ax < 2; ++ax) { const int pos = ax ? (n & 63) : (n >> 6);
#pragma unroll
            for (int k = 0; k < 2; ++k) { unsigned* a = (unsigned*)&v[4 * ax + k]; unsigned* b = (unsigned*)&v[4 * ax + 2 + k];
#pragma unroll
                for (int q = 0; q < 4; ++q) { const f32x2 t0 = cs[pos * 16 + 8 * k + 2 * q], t1 = cs[pos * 16 + 8 * k + 2 * q + 1];
                    const float x1l = bflo(a[q]), x1h = bfhi(a[q]), x2l = bflo(b[q]), x2h = bfhi(b[q]);
                    a[q] = cvt_pk_bf16(x1l * t0.x - x2l * t0.y, x1h * t1.x - x2h * t1.y); b[q] = cvt_pk_bf16(x1l * t0.y + x2l * t0.x, x1h * t1.y + x2h * t1.x); } } }
#pragma unroll
        for (int k = 0; k < 8; ++k) base[k] = v[k];
    }
    bf16* VT = (bf16*)(ws + WS_BIG + BIG_VT);
    for (int it = F.bid * NTHREADS + F.tid; it < NBATCH * 2 * 544 * 64; it += F.G * NTHREADS) {
        const int d = it & 63, kg = (it >> 6) % 544, bh = (it >> 6) / 544, b = bh >> 1, hkv = bh & 1;
        const int key0 = kg * 8; const size_t row0 = (key0 < 256) ? ((size_t)TL + (size_t)b * 256 + key0) : ((size_t)b * 4096 + (key0 - 256));
        const bf16* src = QKV + row0 * 768 + 640 + hkv * 64 + d;
        unsigned short v[8];
#pragma unroll
        for (int j = 0; j < 8; ++j) v[j] = src[(size_t)j * 768];
        v4u w; w.x = v[0] | ((unsigned)v[1] << 16); w.y = v[2] | ((unsigned)v[3] << 16); w.z = v[4] | ((unsigned)v[5] << 16); w.w = v[6] | ((unsigned)v[7] << 16);
        *(v4u*)(VT + ((size_t)bh * 64 + d) * 4352 + key0) = w;
    }
    __syncthreads();
}
typedef float f32x16 __attribute__((ext_vector_type(16)));
typedef __bf16 bf16x2v __attribute__((ext_vector_type(2)));
__device__ __forceinline__ unsigned pk_bf16(float a, float b) { const bf16x2v t = __builtin_convertvector((f32x2){a, b}, bf16x2v); return __builtin_bit_cast(unsigned, t); }
constexpr int AT_KP = 144, AT_VP1 = 648, AT_VP2 = 520, AT_VOFF = 320 * AT_KP;
template <bool MASKED>
__device__ __forceinline__ void attn_tile(const LAS unsigned char* Ks, const LAS unsigned char* Vs, const int vpitch, const int kl_base, const bf16x8 (&qf)[4], f32x16& o0, f32x16& o1, float& m, float& l,
                                          const int r, const int h, const int kj0, const int qi) {
    f32x16 x;
#pragma unroll
    for (int i = 0; i < 16; ++i) x[i] = 0.f;
#pragma unroll
    for (int s = 0; s < 4; ++s) { const bf16x8 kf = *(const LAS bf16x8*)(Ks + (kl_base + r) * AT_KP + (16 * s + 8 * h) * 2); x = __builtin_amdgcn_mfma_f32_32x32x16_bf16(kf, qf[s], x, 0, 0, 0); }
    float sc[16]; float mt = -1e30f;
#pragma unroll
    for (int i = 0; i < 16; ++i) { float v = x[i] * 0.125f;
        if (MASKED) { const int kj = kj0 + (i & 3) + 8 * (i >> 2) + 4 * h; const bool ok = (kj >= 0) && (kj < SEQ) && (kj - qi <= 128) && (qi - kj <= 128); v = ok ? v : -1e30f; }
        sc[i] = v; mt = fmaxf(mt, v); }
    mt = fmaxf(mt, __shfl_xor(mt, 32));
    const float mn = fmaxf(m, mt), alpha = __expf(m - mn); m = mn;
    float ps = 0.f;
#pragma unroll
    for (int i = 0; i < 16; ++i) { sc[i] = __expf(sc[i] - mn); ps += sc[i]; }
    l = l * alpha + ps;
    if (__any(alpha != 1.0f)) {
#pragma unroll
        for (int i = 0; i < 16; ++i) { o0[i] *= alpha; o1[i] *= alpha; } }
#pragma unroll
    for (int s2 = 0; s2 < 2; ++s2) {
        v4u pw; pw.x = pk_bf16(sc[8 * s2 + 0], sc[8 * s2 + 1]); pw.y = pk_bf16(sc[8 * s2 + 2], sc[8 * s2 + 3]); pw.z = pk_bf16(sc[8 * s2 + 4], sc[8 * s2 + 5]); pw.w = pk_bf16(sc[8 * s2 + 6], sc[8 * s2 + 7]);
        const bf16x8 pk = __builtin_bit_cast(bf16x8, pw);
        { const LAS unsigned char* vp = Vs + r * vpitch + (kl_base + 16 * s2 + 4 * h) * 2; const v2u lo = *(const LAS v2u*)vp, hi = *(const LAS v2u*)(vp + 16);
          v4u vw; vw.x = lo.x; vw.y = lo.y; vw.z = hi.x; vw.w = hi.y; o0 = __builtin_amdgcn_mfma_f32_32x32x16_bf16(__builtin_bit_cast(bf16x8, vw), pk, o0, 0, 0, 0); }
        { const LAS unsigned char* vp = Vs + (32 + r) * vpitch + (kl_base + 16 * s2 + 4 * h) * 2; const v2u lo = *(const LAS v2u*)vp, hi = *(const LAS v2u*)(vp + 16);
          v4u vw; vw.x = lo.x; vw.y = lo.y; vw.z = hi.x; vw.w = hi.y; o1 = __builtin_amdgcn_mfma_f32_32x32x16_bf16(__builtin_bit_cast(bf16x8, vw), pk, o1, 0, 0, 0); }
    }
}
PHASE_FN ph_e3_attn(PP pp, int layer) {
    FRAME();
    const bf16* QKV = (const bf16*)(ws + WS_BIG + BIG_QKV); bf16* MIX = (bf16*)(ws + WS_BIG + BIG_MIX); const bf16* VT = (const bf16*)(ws + WS_BIG + BIG_VT);
    const float* sinkp = PIN(I_EV_SINK) + (layer >> 1) * 8;
    LAS unsigned char* Ks = F.lds; LAS unsigned char* Vs = F.lds + AT_VOFF;
    const int r = F.lane & 31, h = F.lane >> 5, g = F.wave >> 1, th = F.wave & 1;
    constexpr int NU = 2048 + 128;
#define AT_DECODE(u_, isc_, b_, hkv_, n0_) do { isc_ = (u_) >= 2048; if (!isc_) { b_ = (u_) >> 7; hkv_ = ((u_) >> 6) & 1; n0_ = ((u_) & 63) * 64; } else { const int v_ = (u_) - 2048; b_ = v_ >> 3; hkv_ = (v_ >> 2) & 1; n0_ = (v_ & 3) * 64; } } while (0)
#define AT_LOAD1(b_, hkv_, n0_) do { int tl_ = F.tid; asm volatile("" : "+v"(tl_));   _Pragma("unroll") for (int k_ = 0; k_ < 5; ++k_) { const int pc = tl_ + k_ * NTHREADS; \
        { const int kl = pc >> 3, c8 = pc & 7, kj = (n0_) - 128 + kl; rk[k_] = (v4u){0u, 0u, 0u, 0u}; if (kj >= 0 && kj < SEQ) rk[k_] = *(const v4u*)(QKV + ((size_t)(b_) * 4096 + kj) * 768 + 512 + (hkv_) * 64 + c8 * 8); } \
        { const int d = pc / 40, c = pc - d * 40, kj = (n0_) - 128 + c * 8; rv[k_] = (v4u){0u, 0u, 0u, 0u}; if (kj >= 0 && kj < SEQ) rv[k_] = *(const v4u*)(VT + ((size_t)((b_) * 2 + (hkv_)) * 64 + d) * 4352 + 256 + kj); } } } while (0)
#define AT_STORE1() do { int tl_ = F.tid; asm volatile("" : "+v"(tl_));   _Pragma("unroll") for (int k_ = 0; k_ < 5; ++k_) { const int pc = tl_ + k_ * NTHREADS; \
        { const int kl = pc >> 3, c8 = pc & 7; *(LAS v4u*)(Ks + kl * AT_KP + c8 * 16) = rk[k_]; } \
        { const int d = pc / 40, c = pc - d * 40; LAS v2u* dst = (LAS v2u*)(Vs + d * AT_VP1 + c * 16); dst[0] = (v2u){rv[k_].x, rv[k_].y}; dst[1] = (v2u){rv[k_].z, rv[k_].w}; } } } while (0)
#define AT_LOAD2(b_, hkv_) do { int tl_ = F.tid; asm volatile("" : "+v"(tl_));   _Pragma("unroll") for (int k_ = 0; k_ < 4; ++k_) { const int pc = tl_ + k_ * NTHREADS; \
        { const int j = pc >> 3, c8 = pc & 7; ck[k_] = *(const v4u*)(QKV + ((size_t)TL + (size_t)(b_) * 256 + j) * 768 + 512 + (hkv_) * 64 + c8 * 8); } \
        { const int d = pc >> 5, c = pc & 31; cv[k_] = *(const v4u*)(VT + ((size_t)((b_) * 2 + (hkv_)) * 64 + d) * 4352 + c * 8); } } } while (0)
#define AT_STORE2() do { int tl_ = F.tid; asm volatile("" : "+v"(tl_));   _Pragma("unroll") for (int k_ = 0; k_ < 4; ++k_) { const int pc = tl_ + k_ * NTHREADS; \
        { const int j = pc >> 3, c8 = pc & 7; *(LAS v4u*)(Ks + j * AT_KP + c8 * 16) = ck[k_]; } \
        { const int d = pc >> 5, c = pc & 31; LAS v2u* dst = (LAS v2u*)(Vs + d * AT_VP2 + c * 16); dst[0] = (v2u){cv[k_].x, cv[k_].y}; dst[1] = (v2u){cv[k_].z, cv[k_].w}; } } } while (0)
    v4u rk[5], rv[5], ck[4], cv[4];
    int u = F.bid;
    if (u < NU) { bool isc; int b, hkv, n0; AT_DECODE(u, isc, b, hkv, n0); if (!isc) AT_LOAD1(b, hkv, n0); }
    for (; u < NU; u += F.G) {
        bool isc; int b, hkv, n0; AT_DECODE(u, isc, b, hkv, n0);
        const size_t qrow = isc ? ((size_t)TL + (size_t)b * 256 + n0 + 32 * th + r) : ((size_t)b * 4096 + n0 + 32 * th + r);
        bf16x8 qf[4];
#pragma unroll
        for (int s = 0; s < 4; ++s) qf[s] = *(const bf16x8*)(QKV + qrow * 768 + (hkv * 4 + g) * 64 + 16 * s + 8 * h);
        float m = sinkp[hkv * 4 + g], l = (h == 0) ? 1.0f : 0.0f;
        f32x16 o0, o1;
#pragma unroll
        for (int i = 0; i < 16; ++i) { o0[i] = 0.f; o1[i] = 0.f; }
        __syncthreads();
        if (!isc) AT_STORE1();
        AT_LOAD2(b, hkv);
        if (!isc) {
            __syncthreads();
            const int qi = n0 + 32 * th + r;
#pragma unroll 1
            for (int t = 0; t < 9; ++t) { const int klb = 32 * th + 32 * t, kj0 = n0 - 128 + klb;
                if (t >= 1 && t <= 7 && kj0 >= 0 && kj0 + 31 < SEQ) attn_tile<false>(Ks, Vs, AT_VP1, klb, qf, o0, o1, m, l, r, h, 0, 0);
                else attn_tile<true>(Ks, Vs, AT_VP1, klb, qf, o0, o1, m, l, r, h, kj0, qi); }
            __syncthreads();
        }
        AT_STORE2();
        { const int un = u + F.G; if (un < NU) { bool iscn; int bn, hkvn, n0n; AT_DECODE(un, iscn, bn, hkvn, n0n); if (!iscn) AT_LOAD1(bn, hkvn, n0n); } }
        __syncthreads();
#pragma unroll 1
        for (int t = 0; t < 8; ++t) attn_tile<false>(Ks, Vs, AT_VP2, 32 * t, qf, o0, o1, m, l, r, h, 0, 0);
        const float inv = 1.0f / (l + __shfl_xor(l, 32));
        bf16* orow = MIX + qrow * D + 512 + (hkv * 4 + g) * 64 + 4 * h;
#pragma unroll
        for (int q4 = 0; q4 < 4; ++q4) {
            v2u w0; w0.x = pk_bf16(o0[4 * q4 + 0] * inv, o0[4 * q4 + 1] * inv); w0.y = pk_bf16(o0[4 * q4 + 2] * inv, o0[4 * q4 + 3] * inv); *(v2u*)(orow + 8 * q4) = w0;
            v2u w1; w1.x = pk_bf16(o1[4 * q4 + 0] * inv, o1[4 * q4 + 1] * inv); w1.y = pk_bf16(o1[4 * q4 + 2] * inv, o1[4 * q4 + 3] * inv); *(v2u*)(orow + 32 + 8 * q4) = w1;
        }
    }
#undef AT_DECODE
#undef AT_LOAD1
#undef AT_STORE1
#undef AT_LOAD2
#undef AT_STORE2
    __syncthreads();
}
PHASE_FN ph_outproj(PP pp, int layer) {
    FRAME();
    const int li = layer >> 1; const bool odd = (layer & 1) != 0;
    const int TR = (layer == DEPTH - 1) ? TL : T;
    const char* W = odd ? (const char*)(ws + WS_OD + li * OD_STRIDE + OD_WOUT) : (const char*)(ws + WS_EV + li * EV_STRIDE + EV_WOUT);
    float* XC = (float*)(ws + WS_XC); float* out = (float*)pp->out;
    const float* xl_src = (layer == 0) ? PIN(I_X) : out; const float* xc_src = (layer == 0) ? PIN(I_CTX) : XC;
    const float* modl = (const float*)(ws + WS_MOD) + (size_t)layer * 17 * 6144;
    SchedResid S{F.G, F.bid, (TR / 256) * 4, (const char*)(ws + WS_BIG + BIG_MIX), (size_t)256 * D * 2, W, (size_t)256 * D * 2, xl_src, xc_src, out, XC, modl + 2048};
    pg8::EpiResidLN E{PIN(I_LNG) + (size_t)(layer * 2) * D, PIN(I_LNB) + (size_t)(layer * 2) * D, 2048, 1024, (bf16*)(ws + WS_H), F.ctl + CW_LN + (layer * 2) * LN_SITE_WORDS,
                      (unsigned long long*)(ws + WS_XS), F.ctl + 2, F.lds + LDS_LNTAB};
    pg8::gemm_phase<pg8::EpiResidLN, SchedResid, true, true>(F.lds, F.tid, pg8::Dims{D, D, D}, S, E);
}
PHASE_FN ph_e6(PP pp, int layer) {
    FRAME();
    unsigned char* evw = ws + WS_EV + (layer >> 1) * EV_STRIDE;
    SchedStd S{22, (T / 256) * 22, F.G, F.bid, (const char*)(ws + WS_H), (const char*)(evw + EV_W13), (char*)(ws + WS_BIG + BIG_HID), (size_t)256 * D * 2, (size_t)256 * D * 2, (size_t)256 * FFH * 2, (size_t)128 * 2, FFH, 1 << 30};
    pg8::gemm_phase<pg8::EpiSwiGLU, SchedStd, true, true>(F.lds, F.tid, pg8::Dims{D, D, D}, S, pg8::EpiSwiGLU{});
}
PHASE_FN ph_e7(PP pp, int layer) {
    FRAME();
    unsigned char* evw = ws + WS_EV + (layer >> 1) * EV_STRIDE;
    float* XC = (float*)(ws + WS_XC); float* out = (float*)pp->out;
    const float* modl = (const float*)(ws + WS_MOD) + (size_t)layer * 17 * 6144;
    SchedResid S{F.G, F.bid, (T / 256) * 4, (const char*)(ws + WS_BIG + BIG_HID), (size_t)256 * FFH * 2, (const char*)(evw + EV_W2), (size_t)256 * FFH * 2, out, XC, out, XC, modl + 5120};
    pg8::EpiResidLN E{PIN(I_LNG) + (size_t)(layer * 2 + 1) * D, PIN(I_LNB) + (size_t)(layer * 2 + 1) * D, 17 * 6144 + 1024 - 5120, 17 * 6144 - 5120, (bf16*)(ws + WS_H), F.ctl + CW_LN + (layer * 2 + 1) * LN_SITE_WORDS,
                      (unsigned long long*)(ws + WS_XS), F.ctl + 2, F.lds + LDS_LNTAB};
    pg8::gemm_phase<pg8::EpiResidLN, SchedResid, true, true>(F.lds, F.tid, pg8::Dims{FFH, FFH, FFH}, S, E);
}

PHASE_FN ph_o1(PP pp, int layer) {
    FRAME();
    unsigned char* odw = ws + WS_OD + (layer >> 1) * OD_STRIDE;
    SchedStd S{6, (T / 256) * 6, F.G, F.bid, (const char*)(ws + WS_H), (const char*)(odw + OD_WIN), (char*)(ws + WS_BIG + BIG_P), (size_t)256 * D * 2, (size_t)256 * D * 2, (size_t)256 * 1536 * 2, (size_t)256 * 2, 1536, 2};
    pg8::gemm_phase<pg8::EpiStore, SchedStd, true, true>(F.lds, F.tid, pg8::Dims{D, D, D}, S, pg8::EpiStore{});
}
PHASE_FN ph_o2_s5a(PP pp, int layer) {
    FRAME();
    const int li = layer >> 1;
    SchedS5A S{F.G, F.bid, (const char*)(ws + WS_BIG + BIG_P), (const char*)(ws + WS_S5M + (size_t)li * 32 * S5M_STRIDE), (char*)(ws + WS_H + 68 * MiB), (char*)(ws + WS_H)};
    pg8::gemm_phase<pg8::EpiStore, SchedS5A, true, true, pg8::AMapS5>(F.lds, F.tid, pg8::Dims{256, 0, 256}, S, pg8::EpiStore{}, pg8::AMapS5{});
}
PHASE_FN ph_o2_scan(PP pp, int layer) {
    FRAME();
    const int li = layer >> 1;
    if (F.tid < 256) {
        const int t = F.bid * 256 + F.tid;
        if (t < NBATCH * 32 * 2 * 64) {
            const int pl = t & 63, d = (t >> 6) & 1, g = (t >> 7) & 31, b = t >> 12;
            const int sidx = ((li * 2 + d) * 32 + g);
            const float are = PIN(I_A_RE)[sidx * 64 + pl], aim = PIN(I_A_IM)[sidx * 64 + pl], dt = expf(PIN(I_LOG_DT)[sidx]);
            const float mag = expf(16.0f * are * dt); float sn, cn; sincosf(16.0f * aim * dt, &sn, &cn);
            const float lre = mag * cn, lim = mag * sn;
            unsigned* HB = (unsigned*)(ws + WS_H) + (g * 256 + d * 128 + pl * 2) / 2;
            float cre = 0.f, cim = 0.f;
#define S5_CROW(k_) ((k_) < 16 ? (4096 + b * 16 + (d ? 15 - (k_) : (k_))) : (b * 256 + (d ? 255 - ((k_) - 16) : ((k_) - 16))))
            unsigned wn[8];
#pragma unroll
            for (int j = 0; j < 8; ++j) wn[j] = HB[(size_t)S5_CROW(j) * 4096];
            for (int k0 = 0; k0 < 272; k0 += 8) {
                unsigned w[8];
#pragma unroll
                for (int j = 0; j < 8; ++j) w[j] = wn[j];
                if (k0 + 8 < 272) {
#pragma unroll
                    for (int j = 0; j < 8; ++j) wn[j] = HB[(size_t)S5_CROW(k0 + 8 + j) * 4096]; }
#pragma unroll
                for (int j = 0; j < 8; ++j) { HB[(size_t)S5_CROW(k0 + j) * 4096] = cvt_pk_bf16(cre, cim);
                    const float sr = bflo(w[j]), si = bfhi(w[j]); const float nr = lre * cre - lim * cim + sr, ni = lre * cim + lim * cre + si; cre = nr; cim = ni; }
            }
#undef S5_CROW
        }
    }
}
PHASE_FN ph_o3(PP pp, int layer) {
    FRAME();
    const int li = layer >> 1;
    SchedS5B S{F.G, F.bid, (const char*)(ws + WS_H), (const char*)(ws + WS_S5M + (size_t)li * 32 * S5M_STRIDE + 256 * 1024), (const char*)(ws + WS_H + 68 * MiB), (char*)(ws + WS_BIG + BIG_P)};
    pg8::gemm_phase<pg8::EpiS5B, SchedS5B, true, true>(F.lds, F.tid, pg8::Dims{256, 8192, 256}, S, pg8::EpiS5B{});
}
PHASE_FN ph_o2_gmlp(PP pp, int layer) {
    FRAME();
    const int li = layer >> 1; const int TR = (layer == DEPTH - 1) ? TL : T;
    const bf16* P = (const bf16*)(ws + WS_BIG + BIG_P); bf16* MIX = (bf16*)(ws + WS_BIG + BIG_MIX);
    constexpr int GP = 272;
    LAS unsigned char* Vt = F.lds;
    LAS unsigned char* Wt = F.lds + 128 * GP;
    LAS f32x2* stt = (LAS f32x2*)(F.lds + 2 * 128 * GP);
    const float* ws_w = PIN(I_WS) + (size_t)li * 4 * 128 * 128; const float* bs = PIN(I_BS) + (size_t)li * 4 * 128;
    const int r = F.lane & 31, hh = F.lane >> 5, et = F.wave >> 1, it0 = (F.wave & 1) * 2;
    const int nunits = (TR / 128) * 4;
    for (int u = F.bid; u < nunits; u += F.G) {
        const int ch = u >> 2, h = u & 3; const size_t row0 = (size_t)ch * 128;
        v4u srow[16]; f32x4 wq[4][2]; v4u vq[4];
#pragma unroll
        for (int t = 0; t < 16; ++t) srow[t] = *(const v4u*)(P + (row0 + F.wave * 16 + t) * 1536 + 1024 + F.lane * 8);
#pragma unroll
        for (int k = 0; k < 4; ++k) { const int pc = F.tid + k * NTHREADS; const int i = pc >> 4, j8 = (pc & 15) * 8; const float* wp = ws_w + (size_t)h * 16384 + i * 128 + j8; wq[k][0] = *(const f32x4*)wp; wq[k][1] = *(const f32x4*)(wp + 4);
            const int eg = pc >> 7, j = pc & 127; vq[k] = *(const v4u*)(P + (row0 + j) * 1536 + 1024 + h * 128 + eg * 8); }
        __syncthreads();
#pragma unroll
        for (int t = 0; t < 16; ++t) { const int j = F.wave * 16 + t; const v4u w = srow[t];
            const float f[8] = {bflo(w.x), bfhi(w.x), bflo(w.y), bfhi(w.y), bflo(w.z), bfhi(w.z), bflo(w.w), bfhi(w.w)};
            float sm = 0.f;
#pragma unroll
            for (int q = 0; q < 8; ++q) sm += f[q];
            const float mu = wave_sum(sm) * (1.f / 512.f); float qv = 0.f;
#pragma unroll
            for (int q = 0; q < 8; ++q) qv += (f[q] - mu) * (f[q] - mu);
            const float rs = rsqrtf(wave_sum(qv) * (1.f / 512.f) + LN_EPS);
            if (F.lane == 0) stt[j] = (f32x2){mu, rs}; }
#pragma unroll
        for (int k = 0; k < 4; ++k) { const int pc = F.tid + k * NTHREADS; const int i = pc >> 4, j8 = (pc & 15) * 8; const f32x4 a = wq[k][0], b = wq[k][1];
            v4u o; o.x = cvt_pk_bf16(a[0], a[1]); o.y = cvt_pk_bf16(a[2], a[3]); o.z = cvt_pk_bf16(b[0], b[1]); o.w = cvt_pk_bf16(b[2], b[3]);
            *(LAS v4u*)(Wt + i * GP + j8 * 2) = o; }
        __syncthreads();
#pragma unroll
        for (int k = 0; k < 4; ++k) { const int pc = F.tid + k * NTHREADS; const int eg = pc >> 7, j = pc & 127; const v4u w = vq[k];
            const f32x2 ms = stt[j];
            const float f[8] = {bflo(w.x), bfhi(w.x), bflo(w.y), bfhi(w.y), bflo(w.z), bfhi(w.z), bflo(w.w), bfhi(w.w)};
#pragma unroll
            for (int q = 0; q < 8; q += 2) { const unsigned pkd = cvt_pk_bf16((f[q] - ms.x) * ms.y, (f[q + 1] - ms.x) * ms.y);
                *(LAS unsigned short*)(Vt + (eg * 8 + q) * GP + j * 2) = (unsigned short)(pkd & 0xffffu); *(LAS unsigned short*)(Vt + (eg * 8 + q + 1) * GP + j * 2) = (unsigned short)(pkd >> 16); } }
        __syncthreads();
        f32x16 acc0, acc1;
#pragma unroll
        for (int q = 0; q < 16; ++q) { acc0[q] = 0.f; acc1[q] = 0.f; }
#pragma unroll
        for (int sk = 0; sk < 8; ++sk) {
            const bf16x8 a = *(const LAS bf16x8*)(Vt + (et * 32 + r) * GP + (16 * sk + 8 * hh) * 2);
            const bf16x8 b0 = *(const LAS bf16x8*)(Wt + (it0 * 32 + r) * GP + (16 * sk + 8 * hh) * 2), b1 = *(const LAS bf16x8*)(Wt + ((it0 + 1) * 32 + r) * GP + (16 * sk + 8 * hh) * 2);
            acc0 = __builtin_amdgcn_mfma_f32_32x32x16_bf16(a, b0, acc0, 0, 0, 0); acc1 = __builtin_amdgcn_mfma_f32_32x32x16_bf16(a, b1, acc1, 0, 0, 0);
        }
#pragma unroll
        for (int t = 0; t < 2; ++t) { const int i = (it0 + t) * 32 + r; const float bb = bs[h * 128 + i];
            const bf16* up = P + (row0 + i) * 1536 + 512 + h * 128 + et * 32 + 4 * hh; bf16* op = MIX + (row0 + i) * D + 512 + h * 128 + et * 32 + 4 * hh;
#pragma unroll
            for (int q4 = 0; q4 < 4; ++q4) { const v2u uw = *(const v2u*)(up + 8 * q4);
                const float a0 = (t ? acc1[4 * q4 + 0] : acc0[4 * q4 + 0]) + bb, a1 = (t ? acc1[4 * q4 + 1] : acc0[4 * q4 + 1]) + bb, a2 = (t ? acc1[4 * q4 + 2] : acc0[4 * q4 + 2]) + bb, a3 = (t ? acc1[4 * q4 + 3] : acc0[4 * q4 + 3]) + bb;
                v2u o; o.x = cvt_pk_bf16(bflo(uw.x) * a0, bfhi(uw.x) * a1); o.y = cvt_pk_bf16(bflo(uw.y) * a2, bfhi(uw.y) * a3);
                *(v2u*)(op + 8 * q4) = o; } }
    }
    __syncthreads();
}
PHASE_FN ph_o4(PP pp, int layer) {
    FRAME();
    const int li = layer >> 1;
    unsigned char* odw = ws + WS_OD + li * OD_STRIDE;
    SchedGlu S{F.G, F.bid, (const char*)(ws + WS_BIG + BIG_P), (const char*)(odw + OD_WGLU), (char*)(ws + WS_BIG + BIG_MIX), PIN(I_BGLU) + (size_t)li * 512};
    pg8::gemm_phase<pg8::EpiGLU, SchedGlu, true, true>(F.lds, F.tid, pg8::Dims{512, 1536, 512}, S, pg8::EpiGLU{});
}
PHASE_FN ph_o6(PP pp, int layer) {
    FRAME();
    const int li = layer >> 1; const int TR = (layer == DEPTH - 1) ? TL : T;
    const bf16* Hb = (const bf16*)(ws + WS_H);
    int* tokE = (int*)(ws + WS_TOK); int* tokS0 = tokE + T; int* tokS1 = tokS0 + T; float* tokG0 = (float*)(tokS1 + T);
    unsigned* ecnt = F.ctl + CW_CNT + li * 64;
    LAS float* wr_s = (LAS float*)F.lds;
    LAS unsigned* lcnt = (LAS unsigned*)(F.lds + 32768);
    const float* rw = PIN(I_ROUTER) + (size_t)li * D * 8;
    __syncthreads();
    for (int e = F.tid; e < D * 8; e += NTHREADS) wr_s[e] = rw[e];
    if (F.tid < 16) lcnt[F.tid] = 0u;
    __syncthreads();
    for (int r = F.gw; r < TR; r += F.NGW) {
        const v4u* src = (const v4u*)(Hb + (size_t)r * D) + 2 * F.lane;
        const v4u a = src[0], b = src[1];
        const float hv[16] = {bflo(a.x), bfhi(a.x), bflo(a.y), bfhi(a.y), bflo(a.z), bfhi(a.z), bflo(a.w), bfhi(a.w), bflo(b.x), bfhi(b.x), bflo(b.y), bfhi(b.y), bflo(b.z), bfhi(b.z), bflo(b.w), bfhi(b.w)};
        float lg[8];
#pragma unroll
        for (int e = 0; e < 8; ++e) lg[e] = 0.f;
#pragma unroll
        for (int q = 0; q < 16; ++q) { const int col = 16 * F.lane + q; const f32x4 w0 = *(const LAS f32x4*)(wr_s + col * 8), w1 = *(const LAS f32x4*)(wr_s + col * 8 + 4);
            lg[0] += hv[q] * w0[0]; lg[1] += hv[q] * w0[1]; lg[2] += hv[q] * w0[2]; lg[3] += hv[q] * w0[3]; lg[4] += hv[q] * w1[0]; lg[5] += hv[q] * w1[1]; lg[6] += hv[q] * w1[2]; lg[7] += hv[q] * w1[3]; }
#pragma unroll
        for (int e = 0; e < 8; ++e) lg[e] = wave_sum(lg[e]);
        if (F.lane == 0) {
            int e0 = 0; float v0 = lg[0];
#pragma unroll
            for (int e = 1; e < 8; ++e) if (lg[e] > v0) { v0 = lg[e]; e0 = e; }
            int e1 = -1; float v1 = -3.0e38f;
#pragma unroll
            for (int e = 0; e < 8; ++e) if (e != e0 && lg[e] > v1) { v1 = lg[e]; e1 = e; }
            const float w0 = 1.0f / (1.0f + __expf(v1 - v0));
            const int s0 = (int)__hip_atomic_fetch_add(lcnt + e0, 1u, __ATOMIC_RELAXED, __HIP_MEMORY_SCOPE_WORKGROUP), s1 = (int)__hip_atomic_fetch_add(lcnt + e1, 1u, __ATOMIC_RELAXED, __HIP_MEMORY_SCOPE_WORKGROUP);
            tokE[r] = e0 | (e1 << 8); tokS0[r] = s0; tokS1[r] = s1; tokG0[r] = w0;
        }
    }
    __syncthreads();
    if (F.tid < 8) lcnt[8 + F.tid] = atomicAdd(ecnt + F.tid, lcnt[F.tid]);
    VM_WAIT();
    __syncthreads();
    { const int r = F.gw + F.lane * F.NGW;
      if (r < TR) { const int ee = tokE[r]; tokS0[r] += (int)lcnt[8 + (ee & 255)]; tokS1[r] += (int)lcnt[8 + (ee >> 8)]; } }
    __syncthreads();
}
PHASE_FN ph_o7(PP pp, int layer) {
    FRAME();
    const int li = layer >> 1; const int TR = (layer == DEPTH - 1) ? TL : T;
    const bf16* Hb = (const bf16*)(ws + WS_H); unsigned char* HSQ = ws + WS_BIG + BIG_HSQ;
    int* tokE = (int*)(ws + WS_TOK); int* tokS0 = tokE + T; int* tokS1 = tokS0 + T; int* tokP0 = tokS1 + 2 * T; int* tokP1 = tokP0 + T;
    unsigned* ecnt = F.ctl + CW_CNT + li * 64;
    int roff[8]; { int acc = 0;
#pragma unroll
        for (int e = 0; e < 8; ++e) { roff[e] = acc * 256; acc += (__builtin_amdgcn_readfirstlane((int)__hip_atomic_load(ecnt + e, __ATOMIC_RELAXED, __HIP_MEMORY_SCOPE_AGENT)) + 255) >> 8; } }
    for (int ra = F.gw; ra < TR; ra += 2 * F.NGW) {
        const int rb = ra + F.NGW;
        const int ea = tokE[ra], eb = tokE[rb]; int pa0 = tokS0[ra], pa1 = tokS1[ra], pb0 = tokS0[rb], pb1 = tokS1[rb];
        const v4u* sa = (const v4u*)(Hb + (size_t)ra * D) + 2 * F.lane; const v4u* sb = (const v4u*)(Hb + (size_t)rb * D) + 2 * F.lane;
        const v4u a0 = sa[0], a1 = sa[1], b0 = sb[0], b1 = sb[1];
#pragma unroll
        for (int e = 0; e < 8; ++e) { pa0 += (e == (ea & 255)) ? roff[e] : 0; pa1 += (e == (ea >> 8)) ? roff[e] : 0; pb0 += (e == (eb & 255)) ? roff[e] : 0; pb1 += (e == (eb >> 8)) ? roff[e] : 0; }
        v4u qa, qb;
        qa.x = pk_fp8x4(bflo(a0.x) * Q_H, bfhi(a0.x) * Q_H, bflo(a0.y) * Q_H, bfhi(a0.y) * Q_H); qa.y = pk_fp8x4(bflo(a0.z) * Q_H, bfhi(a0.z) * Q_H, bflo(a0.w) * Q_H, bfhi(a0.w) * Q_H);
        qa.z = pk_fp8x4(bflo(a1.x) * Q_H, bfhi(a1.x) * Q_H, bflo(a1.y) * Q_H, bfhi(a1.y) * Q_H); qa.w = pk_fp8x4(bflo(a1.z) * Q_H, bfhi(a1.z) * Q_H, bflo(a1.w) * Q_H, bfhi(a1.w) * Q_H);
        qb.x = pk_fp8x4(bflo(b0.x) * Q_H, bfhi(b0.x) * Q_H, bflo(b0.y) * Q_H, bfhi(b0.y) * Q_H); qb.y = pk_fp8x4(bflo(b0.z) * Q_H, bfhi(b0.z) * Q_H, bflo(b0.w) * Q_H, bfhi(b0.w) * Q_H);
        qb.z = pk_fp8x4(bflo(b1.x) * Q_H, bfhi(b1.x) * Q_H, bflo(b1.y) * Q_H, bfhi(b1.y) * Q_H); qb.w = pk_fp8x4(bflo(b1.z) * Q_H, bfhi(b1.z) * Q_H, bflo(b1.w) * Q_H, bfhi(b1.w) * Q_H);
        *((v4u*)(HSQ + (size_t)pa0 * D) + F.lane) = qa; *((v4u*)(HSQ + (size_t)pa1 * D) + F.lane) = qa;
        *((v4u*)(HSQ + (size_t)pb0 * D) + F.lane) = qb; *((v4u*)(HSQ + (size_t)pb1 * D) + F.lane) = qb;
        if (F.lane == 0) { tokP0[ra] = pa0; tokP1[ra] = pa1; tokP0[rb] = pb0; tokP1[rb] = pb1; }
    }
}
PHASE_FN ph_moe_up(PP pp, int layer, int chn) {
    FRAME();
    const int li = layer >> 1; unsigned char* odw = ws + WS_OD + li * OD_STRIDE; unsigned* ecnt = F.ctl + CW_CNT + li * 64;
    SchedMoeUp S; S.G = F.G; S.c = F.bid; S.rt0 = chn * MOE_CHUNK_TILES; S.HS = (const char*)(ws + WS_BIG + BIG_HSQ); S.W = (const char*)(odw + OD_MW13); S.HID = (char*)(ws + WS_H);
    { int acc = 0; S.toff[0] = 0;
#pragma unroll
        for (int e = 0; e < 8; ++e) { acc += (__builtin_amdgcn_readfirstlane((int)__hip_atomic_load(ecnt + e, __ATOMIC_RELAXED, __HIP_MEMORY_SCOPE_AGENT)) + 255) >> 8; S.toff[e + 1] = acc; } }
    int nt_ = S.toff[8] - S.rt0; nt_ = nt_ < 0 ? 0 : (nt_ > MOE_CHUNK_TILES ? MOE_CHUNK_TILES : nt_); S.nUnits = nt_ * 28;
    pg8::gemm_phase<pg8::EpiSwiGLU8, SchedMoeUp, true, true, pg8::AMapStd, true>(F.lds, F.tid, pg8::Dims{D, D, D}, S, pg8::EpiSwiGLU8{});
}
PHASE_FN ph_moe_down(PP pp, int layer, int chn) {
    FRAME();
    const int li = layer >> 1; unsigned char* odw = ws + WS_OD + li * OD_STRIDE; unsigned* ecnt = F.ctl + CW_CNT + li * 64;
    SchedMoeDown S; S.G = F.G; S.c = F.bid; S.rt0 = chn * MOE_CHUNK_TILES; S.HID = (const char*)(ws + WS_H); S.W = (const char*)(odw + OD_MW2); S.Y = (char*)(ws + WS_BIG + BIG_Y);
    { int acc = 0; S.toff[0] = 0;
#pragma unroll
        for (int e = 0; e < 8; ++e) { acc += (__builtin_amdgcn_readfirstlane((int)__hip_atomic_load(ecnt + e, __ATOMIC_RELAXED, __HIP_MEMORY_SCOPE_AGENT)) + 255) >> 8; S.toff[e + 1] = acc; } }
    int nt_ = S.toff[8] - S.rt0; nt_ = nt_ < 0 ? 0 : (nt_ > MOE_CHUNK_TILES ? MOE_CHUNK_TILES : nt_); S.nUnits = nt_ * 4;
    pg8::gemm_phase<pg8::EpiStoreQ, SchedMoeDown, true, true, pg8::AMapStd, true>(F.lds, F.tid, pg8::Dims{EH, EH, EH}, S, pg8::EpiStoreQ{});
}
PHASE_FN ph_o9(PP pp, int layer) {
    FRAME();
    const int TR = (layer == DEPTH - 1) ? TL : T; const bool last = layer == DEPTH - 1;
    float* XC = (float*)(ws + WS_XC); float* out = (float*)pp->out; bf16* Hb = (bf16*)(ws + WS_H); const bf16* HS = (const bf16*)(ws + WS_BIG + BIG_Y);
    const float* modl = (const float*)(ws + WS_MOD) + (size_t)layer * 17 * 6144;
    const float* modn = (const float*)(ws + WS_MOD) + (size_t)(last ? layer : layer + 1) * 17 * 6144;
    const float* lng1 = PIN(I_LNG) + (size_t)(layer * 2 + 1) * D; const float* lnb1 = PIN(I_LNB) + (size_t)(layer * 2 + 1) * D;
    const int* tokE = (const int*)(ws + WS_TOK); const float* tokG0 = (const float*)(tokE + 3 * T); const int* tokP0 = tokE + 4 * T; const int* tokP1 = tokP0 + T;
    f32x4 gg9[4], bb9[4];
#pragma unroll
    for (int j = 0; j < 4; ++j) { gg9[j] = *(const f32x4*)(lng1 + 256 * j + 4 * F.lane); bb9[j] = *(const f32x4*)(lnb1 + 256 * j + 4 * F.lane); }
    for (int ra = F.gw; ra < TR; ra += 2 * F.NGW) {
        const int rb = ra + F.NGW; const int rr[2] = {ra, rb};
        int p0[2], p1[2]; float w0[2]; float* xr[2]; int mrow[2];
#pragma unroll
        for (int k = 0; k < 2; ++k) { const int r = rr[k]; const bool isc = r >= TL; xr[k] = isc ? XC + (size_t)(r - TL) * D : out + (size_t)r * D; mrow[k] = isc ? 16 : (r >> 12); p0[k] = tokP0[r]; p1[k] = tokP1[r]; w0[k] = tokG0[r]; }
        f32x4 v[2][4]; v2u ya[2][4], yb[2][4];
#pragma unroll
        for (int k = 0; k < 2; ++k) { row_load(xr[k], F.lane, v[k]); const bf16* y0 = HS + (size_t)p0[k] * D; const bf16* y1 = HS + (size_t)p1[k] * D;
#pragma unroll
            for (int j = 0; j < 4; ++j) { ya[k][j] = *(const v2u*)(y0 + 256 * j + 4 * F.lane); yb[k][j] = *(const v2u*)(y1 + 256 * j + 4 * F.lane); } }
#pragma unroll
        for (int k = 0; k < 2; ++k) { const float wa = w0[k], wb = 1.0f - wa; const float* g2 = modl + (size_t)mrow[k] * 6144 + 5120;
#pragma unroll
            for (int j = 0; j < 4; ++j) { const v2u a = ya[k][j], b = yb[k][j]; const f32x4 gg = *(const f32x4*)(g2 + 256 * j + 4 * F.lane);
                f32x4 f; f[0] = wa * bflo(a.x) + wb * bflo(b.x); f[1] = wa * bfhi(a.x) + wb * bfhi(b.x); f[2] = wa * bflo(a.y) + wb * bflo(b.y); f[3] = wa * bfhi(a.y) + wb * bfhi(b.y);
                v[k][j] = v[k][j] * ALPHA + gg * f; }
            row_ln_pre(v[k], gg9, bb9); row_store(xr[k], F.lane, v[k]);
            if (!last) { f32x4 h[4]; const float* m = modn + (size_t)mrow[k] * 6144; row_modulate(h, v[k], m + 1024, m, F.lane); row_store_bf16(Hb + (size_t)rr[k] * D, F.lane, h); } }
    }
}

#if MK_SPLIT
#define PHASE_END() do { ++ph; } while (0)
#else
#define PHASE_END() do { if (ph >= lo && ph + 1 < hi) grid_bar(pp); ++ph; } while (0)
#endif
#define PHASE_ON() (ph >= lo && ph < hi)
static __device__ __forceinline__ void even_layer(PP pp, const int layer, const int lo, const int hi, int& ph) {
    if (PHASE_ON()) ph_e1(pp, layer);
    PHASE_END();
    if (PHASE_ON()) { ph_e2_fft(pp); ph_e2_rope(pp); }
    PHASE_END();
    if (PHASE_ON()) { ph_e2_dft(pp); ph_e3_attn(pp, layer); }
    PHASE_END();
    if (PHASE_ON()) ph_outproj(pp, layer);
    PHASE_END();
    if (PHASE_ON()) ph_e6(pp, layer);
    PHASE_END();
    if (PHASE_ON()) ph_e7(pp, layer);
    PHASE_END();
}
static __device__ __forceinline__ void odd_layer(PP pp, const int layer, const int lo, const int hi, int& ph) {
    if (PHASE_ON()) ph_o1(pp, layer);
    PHASE_END();
    if (PHASE_ON()) { ph_o2_s5a(pp, layer); ph_o2_gmlp(pp, layer); }
    PHASE_END();
    if (PHASE_ON()) ph_o2_scan(pp, layer);
    PHASE_END();
    if (PHASE_ON()) ph_o3(pp, layer);
    PHASE_END();
    if (PHASE_ON()) ph_o4(pp, layer);
    PHASE_END();
    if (PHASE_ON()) ph_outproj(pp, layer);
    PHASE_END();
    if (PHASE_ON()) ph_o6(pp, layer);
    PHASE_END();
    if (PHASE_ON()) ph_o7(pp, layer);
    PHASE_END();
#define MOE_CHUNK(chn) do { if (PHASE_ON()) ph_moe_up(pp, layer, chn); PHASE_END(); if (PHASE_ON()) ph_moe_down(pp, layer, chn); PHASE_END(); } while (0)
    static_assert(MOE_NCHUNK == 5, "the chunk sites are written out: no loop around GEMM phase sites");
    MOE_CHUNK(0); MOE_CHUNK(1); MOE_CHUNK(2); MOE_CHUNK(3); MOE_CHUNK(4);
#undef MOE_CHUNK
    if (PHASE_ON()) ph_o9(pp, layer);
    PHASE_END();
}
constexpr int N_PHASES = 2 + 2 * (6 + 9 + 2 * MOE_NCHUNK);
__global__ void __launch_bounds__(NTHREADS, 2) fwd_kernel(Params p_unused) {
    DECL_LDS;
    PP pp = (PP)__builtin_amdgcn_kernarg_segment_ptr();
    {
        LAS unsigned char* lds = (LAS unsigned char*)lds_raw;
        for (int u = threadIdx.x; u < (LDS_BYTES - LDS_RING) / 4; u += NTHREADS) ((LAS unsigned*)(lds + LDS_RING))[u] = 0u;
        __syncthreads();
#if !MK_SPLIT
        (void)xcd_barrier_post((unsigned*)((unsigned char*)pp->ws + WS_CTL) + CW_BAR, (volatile LAS unsigned*)(lds + LDS_MISC) + 8);
#endif
    }
#if MK_SPLIT
    const int lo = pp->ph_lo, hi = pp->ph_hi;
#else
    constexpr int lo = 0, hi = N_PHASES;
#endif
    int ph = 0;

    if (PHASE_ON()) { ph_fold(pp); ph_mod(pp); ph_s5mat(pp); ph_cvt(pp); ph_dftmat(pp); }
    PHASE_END();
    if (PHASE_ON()) ph_pro_b(pp);
    PHASE_END();
    even_layer(pp, 0, lo, hi, ph);
    odd_layer(pp, 1, lo, hi, ph);
    even_layer(pp, 2, lo, hi, ph);
    odd_layer(pp, 3, lo, hi, ph);
}

extern "C" void kernel_launch(void* const* d_in, const int* in_sizes, int n_in, void* d_out, int out_size, void* d_ws, size_t ws_size, hipStream_t stream) {
    static int grid = 0;
    if (grid == 0) {
        if (n_in != 32 || out_size != TL * D || ws_size < WS_END) { fprintf(stderr, "kernel_launch: unexpected shapes (n_in %d, out %d, ws %zu < %zu)\n", n_in, out_size, ws_size, (size_t)WS_END); grid = -1; return; }
        int dev = 0, cus = 0, per_cu = 0;
        if (hipGetDevice(&dev) != hipSuccess || hipDeviceGetAttribute(&cus, hipDeviceAttributeMultiprocessorCount, dev) != hipSuccess) { grid = -1; return; }
        if (hipFuncSetAttribute((const void*)fwd_kernel, hipFuncAttributeMaxDynamicSharedMemorySize, LDS_BYTES) != hipSuccess) { fprintf(stderr, "kernel_launch: hipFuncSetAttribute failed\n"); grid = -1; return; }
        if (hipOccupancyMaxActiveBlocksPerMultiprocessor(&per_cu, (const void*)fwd_kernel, NTHREADS, LDS_BYTES) != hipSuccess || per_cu < 1) { fprintf(stderr, "kernel_launch: occupancy query says %d\n", per_cu); }
        (void)hipGetLastError();
        grid = cus;
    }
    if (grid < 0) return;
    (void)in_sizes;
    (void)hipMemsetAsync((char*)d_ws + WS_CTL, 0, CTL_ZERO_BYTES, stream);
    Params p{};
    for (int i = 0; i < 32; ++i) p.in[i] = (const float*)d_in[i];
    p.out = (float*)d_out; p.ws = (unsigned char*)d_ws;
#if MK_SPLIT
    for (int ph = 0; ph < N_PHASES; ++ph) { p.ph_lo = ph; p.ph_hi = ph + 1; hipLaunchKernelGGL(fwd_kernel, dim3(grid), dim3(NTHREADS), LDS_BYTES, stream, p); }
#else
    p.ph_lo = 0; p.ph_hi = N_PHASES;
    hipLaunchKernelGGL(fwd_kernel, dim3(grid), dim3(NTHREADS), LDS_BYTES, stream, p);
#endif
}
```

```cpp
#include <hip/hip_runtime.h>
#include <cstdio>
#include <cstdint>

#ifndef MK_SPLIT
#define MK_SPLIT 0
#endif

#define GAS __attribute__((address_space(1)))
#define LAS __attribute__((address_space(3)))
typedef unsigned short bf16;
typedef unsigned v4u __attribute__((ext_vector_type(4)));
typedef unsigned v2u __attribute__((ext_vector_type(2)));
typedef float f32x4 __attribute__((ext_vector_type(4)));
typedef float f32x2 __attribute__((ext_vector_type(2)));
typedef short bf16x8 __attribute__((ext_vector_type(8)));

constexpr int D = 1024, NBATCH = 16, SEQ = 4096, NCTX = 256, DEPTH = 4;
constexpr int TL = NBATCH * SEQ, TC = NBATCH * NCTX, T = TL + TC;
constexpr int FFH = 2816, EH = 3584, NEXP = 8;
constexpr int MOE_CHUNK_TILES = 128, MOE_NCHUNK = 5;
constexpr float Q_H = 16.f, Q_W = 1024.f, Q_HID = 8.f;
constexpr float ALPHA = 1.6817928305074290860622509524664f;
constexpr float LN_EPS = 1e-5f;

constexpr size_t MiB = (size_t)1 << 20;
constexpr size_t WS_CTL = 0, CTL_ZERO_BYTES = 1 * MiB;
constexpr size_t WS_MOD = 1 * MiB;
constexpr size_t WS_TOK = 3 * MiB;
constexpr size_t WS_F256 = 21 * MiB;
constexpr size_t WS_FD = 22 * MiB;
constexpr size_t WS_EV = 86 * MiB, EV_STRIDE = 22 * MiB;
constexpr size_t EV_WQKV = 0, EV_WPQ = 3 * MiB / 2, EV_WOUT = 7 * MiB / 2, EV_W13 = 11 * MiB / 2, EV_W2 = 33 * MiB / 2;
constexpr size_t WS_OD = 130 * MiB, OD_STRIDE = 90 * MiB;
constexpr size_t OD_WIN = 0, OD_WGLU = 3 * MiB, OD_WOUT = 7 * MiB / 2, OD_MW13 = 11 * MiB / 2  , OD_MW2 = 62 * MiB  ;
constexpr size_t WS_H = 310 * MiB;
constexpr size_t WS_BIG = 446 * MiB;
constexpr size_t BIG_PQT = 0, BIG_PQTC = 128 * MiB, BIG_QKV = 136 * MiB, BIG_MIX = 238 * MiB, BIG_VT = 374 * MiB, BIG_HID = 0, BIG_P = 0  , BIG_UG = 136 * MiB  , BIG_Y = 0, BIG_HSQ = 276 * MiB;
constexpr size_t WS_S5M = 862 * MiB, S5M_STRIDE = 384 * 1024;
constexpr size_t WS_XB = 890 * MiB;
constexpr size_t WS_END = 1026 * MiB;
constexpr int CW_BAR = 4096, CW_CNT = 16384, CW_LN = 32768, LN_SITE_WORDS = 272 * 16;
constexpr size_t WS_XS = 886 * MiB;

#define LDS_WAIT() asm volatile("s_waitcnt lgkmcnt(0)" ::: "memory")
#define VM_WAIT() asm volatile("s_waitcnt vmcnt(0)" ::: "memory")
__device__ __forceinline__ unsigned cvt_pk_bf16(float lo, float hi) { unsigned r; asm volatile("v_cvt_pk_bf16_f32 %0, %1, %2" : "=v"(r) : "v"(lo), "v"(hi)); return r; }
__device__ __forceinline__ float bflo(unsigned w) { return __uint_as_float(w << 16); }
__device__ __forceinline__ float bfhi(unsigned w) { return __uint_as_float(w & 0xffff0000u); }
__device__ __forceinline__ float bf2f(bf16 b) { return __uint_as_float(((unsigned)b) << 16); }
__device__ __forceinline__ bf16 f2bf(float f) { return (bf16)(cvt_pk_bf16(f, 0.f) & 0xffffu); }
__device__ __forceinline__ unsigned pk_fp8x4(float a, float b, float c, float d) {
    a = __builtin_amdgcn_fmed3f(a, -448.f, 448.f); b = __builtin_amdgcn_fmed3f(b, -448.f, 448.f); c = __builtin_amdgcn_fmed3f(c, -448.f, 448.f); d = __builtin_amdgcn_fmed3f(d, -448.f, 448.f);
    int w = 0; w = __builtin_amdgcn_cvt_pk_fp8_f32(a, b, w, false); w = __builtin_amdgcn_cvt_pk_fp8_f32(c, d, w, true); return (unsigned)w; }
__device__ __forceinline__ float wave_sum(float v) {
#pragma unroll
    for (int o = 1; o < 64; o <<= 1) v += __shfl_xor(v, o);
    return v;
}
__device__ __forceinline__ float wave_max(float v) {
#pragma unroll
    for (int o = 1; o < 64; o <<= 1) v = fmaxf(v, __shfl_xor(v, o));
    return v;
}
__device__ __forceinline__ float sigmoid_f(float x) { return __builtin_amdgcn_rcpf(1.f + __builtin_amdgcn_exp2f(-1.4426950408889634f * x)); }
__device__ __forceinline__ float silu_f(float x) { return x * sigmoid_f(x); }
__device__ __forceinline__ f32x2 gelu_tanh_2(f32x2 x) { const f32x2 p = (x * x) * -0.10294324f + -2.3022082f; const f32x2 t = x * p;
    const f32x2 d = (f32x2){__builtin_amdgcn_exp2f(t[0]), __builtin_amdgcn_exp2f(t[1])} + 1.0f; return x * (f32x2){__builtin_amdgcn_rcpf(d[0]), __builtin_amdgcn_rcpf(d[1])}; }
__device__ __forceinline__ f32x2 sigmoid_2(f32x2 x) { const f32x2 t = x * -1.4426950408889634f; const f32x2 d = (f32x2){__builtin_amdgcn_exp2f(t[0]), __builtin_amdgcn_exp2f(t[1])} + 1.0f; return (f32x2){__builtin_amdgcn_rcpf(d[0]), __builtin_amdgcn_rcpf(d[1])}; }
__device__ __forceinline__ float gelu_tanh_f(float x) { const float z = x * (0.7978845608028654f + 0.035677408136300125f * x * x); return x * __builtin_amdgcn_rcpf(1.f + __builtin_amdgcn_exp2f(-2.8853900817779268f * z)); }

#define XB_TMO      128
#define XB_XCNT(j)  (256  + 64 * (j))
#define XB_XSUB(j)  (1280 + 64 * (j))
#define XB_XGEN(j)  (2304 + 64 * (j))
#define XB_TOP      3328
#define XB_TOPGEN   3392
#define XCD_BAR_WORDS 3456
#define XB_SPIN_CAP (1u << 25)
__device__ __forceinline__ unsigned xb_ld(unsigned* p)              { return __hip_atomic_load(p, __ATOMIC_RELAXED, __HIP_MEMORY_SCOPE_AGENT); }
__device__ __forceinline__ unsigned xb_add(unsigned* p, unsigned v) { return __hip_atomic_fetch_add(p, v, __ATOMIC_RELAXED, __HIP_MEMORY_SCOPE_AGENT); }
__device__ __forceinline__ unsigned xb_xcc_id() { return (unsigned)__builtin_amdgcn_s_getreg((3 << 11) | 20) & 0xFu; }
#define XB_SPIN(cond, bar) do { unsigned _sp = 0; while (cond) { __builtin_amdgcn_s_sleep(1); \
    if ((++_sp & 255u) == 0u) { if (xb_ld(&(bar)[XB_TMO])) break; if (_sp > XB_SPIN_CAP) { atomicAdd(&(bar)[XB_TMO], 1u); break; } } } } while (0)
struct XcdBarrier { unsigned* bar; unsigned x; volatile LAS unsigned* st; };
__device__ __forceinline__ XcdBarrier xcd_barrier_post(unsigned* bar, volatile LAS unsigned* st) {
    XcdBarrier b; b.bar = bar; b.x = xb_xcc_id(); b.st = st;
    if (threadIdx.x == 0) (void)xb_add(&bar[XB_XCNT(b.x)], 1u);
    return b;
}
__device__ __forceinline__ void xcd_barrier_complete(unsigned* bar, unsigned x, unsigned& nloc, unsigned& nx) {
    const unsigned G = gridDim.x * gridDim.y * gridDim.z;
    unsigned sum, cnt, mine, sp = 0u;
    for (;;) {
        sum = 0u; cnt = 0u; mine = 0u;
#pragma unroll
        for (unsigned j = 0; j < 16; ++j) { const unsigned c = xb_ld(&bar[XB_XCNT(j)]); sum += c; cnt += (c > 0u) ? 1u : 0u; mine = (j == x) ? c : mine; }
        if (sum == G) break;
        __builtin_amdgcn_s_sleep(1);
        if ((++sp & 255u) == 0u) { if (xb_ld(&bar[XB_TMO])) break; if (sp > XB_SPIN_CAP) { atomicAdd(&bar[XB_TMO], 1u); break; } }
    }
    nloc = mine > 0u ? mine : 1u; nx = cnt > 0u ? cnt : 1u;
}
__device__ __forceinline__ void xcd_barrier(const XcdBarrier& b) {
    asm volatile("s_waitcnt vmcnt(0)" ::: "memory");
    __syncthreads();
    if (threadIdx.x == 0) {
        unsigned* bar = b.bar;
        __builtin_amdgcn_s_waitcnt(0);
        unsigned nloc = b.st[0], nx = b.st[1];
        if (nloc == 0u) { xcd_barrier_complete(bar, b.x, nloc, nx); b.st[0] = nloc; b.st[1] = nx; }
        const unsigned old = xb_add(&bar[XB_XSUB(b.x)], 1u);
        const unsigned gen = old / nloc;
        if (old + 1u == (gen + 1u) * nloc) {
            __builtin_amdgcn_fence(__ATOMIC_RELEASE, "agent");
            asm volatile("s_waitcnt vmcnt(0)" ::: "memory");
            const unsigned og = xb_add(&bar[XB_TOP], 1u);
            const unsigned tg = og / nx;
            if (og + 1u == (tg + 1u) * nx) xb_add(&bar[XB_TOPGEN], 1u);
            else XB_SPIN(xb_ld(&bar[XB_TOPGEN]) == tg, bar);
            __builtin_amdgcn_fence(__ATOMIC_ACQUIRE, "agent");
            xb_add(&bar[XB_XGEN(b.x)], 1u);
            asm volatile("s_waitcnt vmcnt(0)" ::: "memory");
        } else {
            XB_SPIN(xb_ld(&bar[XB_XGEN(b.x)]) == gen, bar);
            __builtin_amdgcn_fence(__ATOMIC_ACQUIRE, "agent");
            asm volatile("s_waitcnt vmcnt(0)" ::: "memory");
        }
    }
    __syncthreads();
}

namespace pg8 {
constexpr int BM = 256, BK = 64, HALF = 128, HTB = HALF * BK * 2, STAGE_BYTES = 8 * HTB;
__host__ __device__ __forceinline__ int lds_byte(int r, int c) { const int st = (r >> 4) * 2 + (c >> 5), rr = r & 15, cc = c & 31, ob = rr * 64 + cc * 2; return st * 1024 + (ob ^ (((ob >> 9) & 1) << 5)); }
__host__ __device__ __forceinline__ void stage_rc(int b, int& R, int& C) { const int st = b / 1024, sb = b % 1024, swz = sb ^ (((sb >> 9) & 1) << 5); R = (st >> 1) * 16 + swz / 64; C = (st & 1) * 32 + (swz % 64) / 2; }
__host__ __device__ __forceinline__ int perm32(int rho) { const int n = rho >> 4, i = rho & 15; return 8 * (i >> 2) + 4 * n + (i & 3); }

struct Unit { const char* a; const char* b; char* o; const char* p0; const char* p1; int ldo; int x0; };
struct Dims { int K, lda, ldb; };
typedef int v4i __attribute__((ext_vector_type(4)));
typedef int v8i __attribute__((ext_vector_type(8)));
struct AMapStd { int ldab = 0;   __device__ __forceinline__ unsigned voff(int R, int C) const { return (unsigned)(R * ldab + C * 2); } __device__ __forceinline__ size_t kstep() const { return 128; } __device__ __forceinline__ size_t hs() const { return (size_t)HALF * ldab; } };
struct AMapGLU { __device__ __forceinline__ unsigned voff(int R, int C) const { return (unsigned)(R * 32 + (C >> 4) * (T * 32) + (C & 15) * 2); } __device__ __forceinline__ size_t kstep() const { return (size_t)4 * T * 32; } __device__ __forceinline__ size_t hs() const { return (size_t)HALF * 32; } };
struct AMapHid { __device__ __forceinline__ unsigned voff(int R, int C) const { return (unsigned)(((C * 2) >> 5) * 8192 + R * 32 + ((C * 2) & 31)); } __device__ __forceinline__ size_t kstep() const { return 32768; } __device__ __forceinline__ size_t hs() const { return (size_t)HALF * 32; } };
struct AMapS5 { __device__ __forceinline__ unsigned voff(int R, int C) const { return (unsigned)(R * 49152 + (C >> 4) * 3072 + (C & 15) * 2); } __device__ __forceinline__ size_t kstep() const { return 12288; } __device__ __forceinline__ size_t hs() const { return (size_t)HALF * 49152; } };

__device__ __forceinline__ const char* uni_ptr(const char* p) {
    const unsigned long long v = (unsigned long long)p; const unsigned lo = __builtin_amdgcn_readfirstlane((unsigned)v), hi = __builtin_amdgcn_readfirstlane((unsigned)(v >> 32));
    return (const char*)(((unsigned long long)hi << 32) | lo); }
template <class Epi, class Sched, bool ALIGN_EPI = false, bool SP2 = false, class AMap = AMapStd, bool FP8 = false, bool PIN = true>
__device__ __forceinline__ void gemm_phase(LAS unsigned char* lds, const int tid, const Dims g, const Sched& S, const Epi& E, const AMap am_in = AMap{}) {
    constexpr int ES = FP8 ? 1 : 2;
    AMap am = am_in; if constexpr (__is_same(AMap, AMapStd)) am.ldab = g.lda * ES;
    const int wid = __builtin_amdgcn_readfirstlane(tid >> 6), lane = tid & 63, wr = wid >> 2, wc = wid & 3, fr = lane & 15, fq = lane >> 4;
    const int K = g.K, nt = (K * (FP8 ? 1 : 2)) / 128;
    unsigned voffA, voffB;
    { int R, C; stage_rc(tid * 16, R, C); const int Rb = Epi::PERM ? ((R & ~31) + perm32(R & 31)) : R;
        voffA = am.voff(R, C); voffB = (unsigned)(Rb * g.ldb * ES + C * 2); }
    const size_t d64voffA = am.voff(64, 0), d64voffB = (size_t)64 * g.ldb * ES;
    const size_t kstep = (size_t)(BK * 2), kstepA = am.kstep();
    const size_t hsA = am.hs(), hsB = (size_t)HALF * g.ldb * ES;
    const unsigned ldsw = (unsigned)wid * 1024u;
    const int aoff = lds_byte(wr * 64 + fr, fq * 8), boff = lds_byte(wc * 32 + fr, fq * 8);
#define PG8_SA(b, h) (((b) * 2 + (h)) * HTB)
#define PG8_SB(b, h) ((4 + (b) * 2 + (h)) * HTB)
#define PG8_STAGE(bufoff, gbase, voff) do { unsigned _vo = (voff); asm volatile("" : "+v"(_vo));   \
        const char* _g0 = (const char*)(gbase); if constexpr (PIN) asm volatile("" : "+s"(_g0)); const char* _g1 = _g0 + d64##voff; if constexpr (PIN) asm volatile("" : "+s"(_g1));   \
        __builtin_amdgcn_global_load_lds((const unsigned*)(_g0 + _vo), (LAS unsigned*)(lds + (bufoff) + ldsw), 16, 0, 0); \
        __builtin_amdgcn_global_load_lds((const unsigned*)(_g1 + _vo), (LAS unsigned*)(lds + (bufoff) + ldsw + 8192), 16, 0, 0); } while (0)
#define PG8_LD8(p) __builtin_shufflevector(*(const LAS v4i*)(p), *(const LAS v4i*)((p) + 1024), 0, 1, 2, 3, 4, 5, 6, 7)
#define PG8_LDA(dst, b, h) do { if constexpr (FP8) { _Pragma("unroll") for (int m = 0; m < 4; ++m) dst##8[m] = PG8_LD8(lds + PG8_SA(b, h) + aoff + m * 2048); } \
        else { _Pragma("unroll") for (int m = 0; m < 4; ++m) _Pragma("unroll") for (int k = 0; k < 2; ++k) dst[m][k] = *(const LAS bf16x8*)(lds + PG8_SA(b, h) + aoff + m * 2048 + k * 1024); } } while (0)
#define PG8_LDB(dst, b, h) do { if constexpr (FP8) { _Pragma("unroll") for (int n = 0; n < 2; ++n) dst##8[n] = PG8_LD8(lds + PG8_SB(b, h) + boff + n * 2048); } \
        else { _Pragma("unroll") for (int n = 0; n < 2; ++n) _Pragma("unroll") for (int k = 0; k < 2; ++k) dst[n][k] = *(const LAS bf16x8*)(lds + PG8_SB(b, h) + boff + n * 2048 + k * 1024); } } while (0)
#define PG8_MMA(ai, bj, At, Bt, ZC) do { __builtin_amdgcn_s_setprio(1); \
        if constexpr (FP8) { _Pragma("unroll") for (int m = 0; m < 4; ++m) _Pragma("unroll") for (int n = 0; n < 2; ++n) \
            acc[ai][bj][m][n] = __builtin_amdgcn_mfma_scale_f32_16x16x128_f8f6f4(Bt##8[n], At##8[m], (ZC) ? (f32x4){0.f, 0.f, 0.f, 0.f} : acc[ai][bj][m][n], 0, 0, 0, 0, 0, 0); } \
        else { _Pragma("unroll") for (int m = 0; m < 4; ++m) _Pragma("unroll") for (int n = 0; n < 2; ++n) _Pragma("unroll") for (int k = 0; k < 2; ++k) \
            acc[ai][bj][m][n] = __builtin_amdgcn_mfma_f32_16x16x32_bf16(Bt[n][k], At[m][k], ((ZC) && k == 0) ? (f32x4){0.f, 0.f, 0.f, 0.f} : acc[ai][bj][m][n], 0, 0, 0); } \
        __builtin_amdgcn_s_setprio(0); } while (0)
#define PG8_WAIT_V(n) asm volatile("s_waitcnt vmcnt(" #n ")" ::: "memory")
#define PG8_WAIT_L(n) asm volatile("s_waitcnt lgkmcnt(" #n ")" ::: "memory")
#define PG8_BAR __builtin_amdgcn_s_barrier()
#define PG8_SCHED __builtin_amdgcn_sched_barrier(0)
    int ui = 0;
    const char* cA; const char* cB;
    { Unit u0; if (!S.next(0, u0)) return; cA = uni_ptr(u0.a); cB = uni_ptr(u0.b); }
    f32x4 acc[2][2][4][2];
    bf16x8 At[4][2], B0[2][2], B1[2][2];
    v8i At8[4], B08[2], B18[2];
    if constexpr (SP2) {
        PG8_STAGE(PG8_SB(0, 0), cB, voffB); PG8_STAGE(PG8_SB(0, 1), cB + hsB, voffB); PG8_STAGE(PG8_SA(0, 0), cA, voffA); PG8_STAGE(PG8_SA(0, 1), cA + hsA, voffA);
        if (wr == 1) PG8_BAR;
        PG8_WAIT_V(2); PG8_BAR;
        PG8_STAGE(PG8_SB(1, 0), cB + kstep, voffB); PG8_STAGE(PG8_SA(1, 0), cA + kstepA, voffA); PG8_STAGE(PG8_SB(1, 1), cB + hsB + kstep, voffB);
        PG8_WAIT_V(6); PG8_BAR;
    } else {
        PG8_STAGE(PG8_SB(0, 0), cB, voffB); PG8_STAGE(PG8_SA(0, 0), cA, voffA); PG8_STAGE(PG8_SB(0, 1), cB + hsB, voffB); PG8_STAGE(PG8_SA(0, 1), cA + hsA, voffA);
        if (wr == 1) PG8_BAR;
        PG8_WAIT_V(4); PG8_BAR;
        PG8_STAGE(PG8_SB(1, 0), cB + kstep, voffB); PG8_STAGE(PG8_SA(1, 0), cA + kstepA, voffA); PG8_STAGE(PG8_SB(1, 1), cB + hsB + kstep, voffB);
        PG8_WAIT_V(6); PG8_BAR;
    }
    for (;;) {
        const char* nA = cA; const char* nB = cB; bool has_next;
        { Unit un; has_next = S.next(ui + 1, un); if (has_next) { nA = uni_ptr(un.a); nB = uni_ptr(un.b); } }
#define PG8_ITER(ZF) do { \
            const bool last = (t == nt - 2); \
            const char* a1 = cA + (size_t)(t + 1) * kstepA; \
            const char* a2 = last ? nA : cA + (size_t)(t + 2) * kstepA; const char* b2 = last ? nB : cB + (size_t)(t + 2) * kstep; \
            const char* a3 = a2 + kstepA; const char* b3 = b2 + kstep; \
            if constexpr (SP2) { \
            PG8_LDB(B0, 0, 0); PG8_LDB(B1, 0, 1); PG8_SCHED; PG8_LDA(At, 0, 0); PG8_STAGE(PG8_SA(1, 1), a1 + hsA, voffA); \
            PG8_WAIT_V(8); PG8_WAIT_L(0); PG8_BAR; PG8_MMA(0, 0, At, B0, ZF); PG8_MMA(0, 1, At, B1, ZF); PG8_BAR; PG8_SCHED; \
            PG8_LDA(At, 0, 1); PG8_STAGE(PG8_SB(0, 0), b2, voffB); PG8_STAGE(PG8_SB(0, 1), b2 + hsB, voffB); PG8_STAGE(PG8_SA(0, 0), a2, voffA); \
            PG8_WAIT_V(8); PG8_WAIT_L(0); PG8_BAR; PG8_MMA(1, 0, At, B0, ZF); PG8_MMA(1, 1, At, B1, ZF); PG8_BAR; PG8_SCHED; \
            PG8_LDB(B0, 1, 0); PG8_LDB(B1, 1, 1); PG8_SCHED; PG8_LDA(At, 1, 0); PG8_STAGE(PG8_SA(0, 1), a2 + hsA, voffA); \
            PG8_WAIT_V(8); PG8_WAIT_L(0); PG8_BAR; PG8_MMA(0, 0, At, B0, false); PG8_MMA(0, 1, At, B1, false); PG8_BAR; PG8_SCHED; \
            PG8_LDA(At, 1, 1); PG8_STAGE(PG8_SB(1, 0), b3, voffB); PG8_STAGE(PG8_SB(1, 1), b3 + hsB, voffB); PG8_STAGE(PG8_SA(1, 0), a3, voffA); \
            PG8_WAIT_V(8); PG8_WAIT_L(0); PG8_BAR; PG8_MMA(1, 0, At, B0, false); PG8_MMA(1, 1, At, B1, false); PG8_BAR; PG8_SCHED; \
            } else { \
            PG8_LDB(B0, 0, 0); PG8_SCHED; PG8_LDA(At, 0, 0); PG8_STAGE(PG8_SA(1, 1), a1 + hsA, voffA); \
            PG8_WAIT_L(8); PG8_BAR; PG8_WAIT_L(0); PG8_MMA(0, 0, At, B0, ZF); PG8_BAR; PG8_SCHED; \
            PG8_LDB(B1, 0, 1); PG8_STAGE(PG8_SB(0, 0), b2, voffB); \
            PG8_BAR; PG8_WAIT_L(0); PG8_MMA(0, 1, At, B1, ZF); PG8_BAR; \
            PG8_LDA(At, 0, 1); PG8_STAGE(PG8_SA(0, 0), a2, voffA); \
            PG8_BAR; PG8_WAIT_L(0); PG8_MMA(1, 0, At, B0, ZF); PG8_BAR; PG8_SCHED; \
            PG8_STAGE(PG8_SB(0, 1), b2 + hsB, voffB); \
            PG8_WAIT_V(6); PG8_BAR; PG8_MMA(1, 1, At, B1, ZF); PG8_BAR; \
            PG8_LDB(B0, 1, 0); PG8_SCHED; PG8_LDA(At, 1, 0); PG8_STAGE(PG8_SA(0, 1), a2 + hsA, voffA); \
            PG8_WAIT_L(8); PG8_BAR; PG8_WAIT_L(0); PG8_MMA(0, 0, At, B0, false); PG8_BAR; PG8_SCHED; \
            PG8_LDB(B1, 1, 1); PG8_STAGE(PG8_SB(1, 0), b3, voffB); \
            PG8_BAR; PG8_WAIT_L(0); PG8_MMA(0, 1, At, B1, false); PG8_BAR; \
            PG8_LDA(At, 1, 1); PG8_STAGE(PG8_SA(1, 0), a3, voffA); \
            PG8_BAR; PG8_WAIT_L(0); PG8_MMA(1, 0, At, B0, false); PG8_BAR; PG8_SCHED; \
            PG8_STAGE(PG8_SB(1, 1), b3 + hsB, voffB); \
            PG8_WAIT_V(6); PG8_BAR; PG8_MMA(1, 1, At, B1, false); PG8_BAR; \
            } \
        } while (0)
        { const int t = 0; PG8_ITER(true); }
#pragma unroll 1
        for (int t = 2; t < nt; t += 2) { PG8_ITER(false); }
#undef PG8_ITER
        if constexpr (ALIGN_EPI) { if (wr == 0) PG8_BAR; }
        { Unit uc; (void)S.next(ui, uc); E(acc, uc, wid); }
        if (!has_next) break;
        cA = nA; cB = nB; ++ui;
        if constexpr (ALIGN_EPI) { if (wr == 1) PG8_BAR; }
    }
    PG8_WAIT_V(0);
    if constexpr (!ALIGN_EPI) { if (wr == 0) PG8_BAR; }
    PG8_BAR;
#undef PG8_SA
#undef PG8_SB
#undef PG8_STAGE
#undef PG8_LDA
#undef PG8_LDB
#undef PG8_MMA
#undef PG8_LD8
#undef PG8_WAIT_V
#undef PG8_WAIT_L
#undef PG8_BAR
#undef PG8_SCHED
}

struct EpiStore {
    static constexpr bool PERM = true;
    __device__ __forceinline__ void operator()(const f32x4 (&acc)[2][2][4][2], const Unit& u, const int wid) const {
        int lane_; asm volatile("v_mbcnt_lo_u32_b32 %0, -1, 0\n\tv_mbcnt_hi_u32_b32 %0, -1, %0" : "=v"(lane_));
        const int wr = wid >> 2, wc = wid & 3, fr = lane_ & 15, fq = lane_ >> 4;
        bf16* base = (bf16*)u.o; int row0 = wr * 64 + fr, col0 = wc * 32 + 8 * fq; asm volatile("" : "+v"(row0), "+v"(col0)); const bool act = u.x0 == 1, gm = u.x0 == 2;
#pragma unroll
        for (int ai = 0; ai < 2; ++ai)
#pragma unroll
            for (int m = 0; m < 4; ++m) { const int r_ = row0 + ai * HALF + m * 16; bf16* rowp = base + (size_t)r_ * u.ldo + col0;
#pragma unroll
                for (int bj = 0; bj < 2; ++bj) { f32x4 v0 = acc[ai][bj][m][0], v1 = acc[ai][bj][m][1];
                    if (act) {
#pragma unroll
                        for (int j = 0; j < 4; j += 2) { const f32x2 a = gelu_tanh_2((f32x2){v0[j], v0[j + 1]}), b = gelu_tanh_2((f32x2){v1[j], v1[j + 1]}); v0[j] = a[0]; v0[j + 1] = a[1]; v1[j] = b[0]; v1[j + 1] = b[1]; } }
                    v4u w; w.x = cvt_pk_bf16(v0[0], v0[1]); w.y = cvt_pk_bf16(v0[2], v0[3]); w.z = cvt_pk_bf16(v1[0], v1[1]); w.w = cvt_pk_bf16(v1[2], v1[3]);
                    if (gm) { const int c_ = col0 + bj * HALF; *(v4u*)(base + ((size_t)(c_ >> 4) * T + r_) * 16 + (c_ & 15)) = w; }
                    else *(v4u*)(rowp + bj * HALF) = w; } }
    }
};
struct EpiSwiGLU {
    static constexpr bool PERM = true;
    __device__ __forceinline__ void operator()(const f32x4 (&acc)[2][2][4][2], const Unit& u, const int wid) const {
        int lane_; asm volatile("v_mbcnt_lo_u32_b32 %0, -1, 0\n\tv_mbcnt_hi_u32_b32 %0, -1, %0" : "=v"(lane_));
        const int wr = wid >> 2, wc = wid & 3, fr = lane_ & 15, fq = lane_ >> 4;
        bf16* base = (bf16*)u.o; int row0 = wr * 64 + fr, col0 = wc * 32 + 8 * fq; asm volatile("" : "+v"(row0), "+v"(col0));
#pragma unroll
        for (int ai = 0; ai < 2; ++ai)
#pragma unroll
            for (int m = 0; m < 4; ++m) { bf16* rowp = base + (size_t)(row0 + ai * HALF + m * 16) * u.ldo + col0;
                f32x4 h0, h1;
#pragma unroll
                for (int j = 0; j < 4; ++j) { const float g0 = acc[ai][0][m][0][j], g1 = acc[ai][0][m][1][j];
                    h0[j] = (g0 * acc[ai][1][m][0][j]) * __builtin_amdgcn_rcpf(1.f + __builtin_amdgcn_exp2f(g0 * -1.4426950408889634f));
                    h1[j] = (g1 * acc[ai][1][m][1][j]) * __builtin_amdgcn_rcpf(1.f + __builtin_amdgcn_exp2f(g1 * -1.4426950408889634f)); }
                v4u w; w.x = cvt_pk_bf16(h0[0], h0[1]); w.y = cvt_pk_bf16(h0[2], h0[3]); w.z = cvt_pk_bf16(h1[0], h1[1]); w.w = cvt_pk_bf16(h1[2], h1[3]);
                *(v4u*)rowp = w; }
    }
};
template <bool DENSE>
struct EpiSwiGLU8T {
    static constexpr bool PERM = true;
    __device__ __forceinline__ void operator()(const f32x4 (&acc)[2][2][4][2], const Unit& u, const int wid) const {
        int lane_; asm volatile("v_mbcnt_lo_u32_b32 %0, -1, 0\n\tv_mbcnt_hi_u32_b32 %0, -1, %0" : "=v"(lane_));
        const int wr = wid >> 2, wc = wid & 3, fr = lane_ & 15, fq = lane_ >> 4;
        unsigned char* base = (unsigned char*)u.o; int row0 = wr * 64 + fr, col0 = wc * 32 + 8 * fq; asm volatile("" : "+v"(row0), "+v"(col0));
        constexpr float SA = DENSE ? 1.0f : 1.0f / (Q_H * Q_W);
        constexpr float C1 = -1.4426950408889634f * SA, KK = 1.0f / (SA * SA * Q_HID), C0 = DENSE ? -3.0f : 25.0f;
        static_assert(Q_HID == 8.f && Q_H * Q_W == 16384.f, "C0 = log2(1 / (SA^2 Q_HID))");
#pragma unroll
        for (int ai = 0; ai < 2; ++ai)
#pragma unroll
            for (int m = 0; m < 4; ++m) { unsigned char* rowp = base + wc * 8192 + (row0 + ai * HALF + m * 16) * 32 + 8 * fq;
                f32x2 o[2][2];
#pragma unroll
                for (int n = 0; n < 2; ++n)
#pragma unroll
                    for (int jp = 0; jp < 2; ++jp) {
                        const f32x2 g = (f32x2){acc[ai][0][m][n][2 * jp], acc[ai][0][m][n][2 * jp + 1]}, uu = (f32x2){acc[ai][1][m][n][2 * jp], acc[ai][1][m][n][2 * jp + 1]};
                        const f32x2 t = g * C1 + C0;
                        const f32x2 sden = (f32x2){__builtin_amdgcn_exp2f(t[0]), __builtin_amdgcn_exp2f(t[1])} + KK;
                        const f32x2 rr = (f32x2){__builtin_amdgcn_rcpf(sden[0]), __builtin_amdgcn_rcpf(sden[1])};
                        o[n][jp] = (g * uu) * rr; }
                v2u w; w.x = pk_fp8x4(o[0][0][0], o[0][0][1], o[0][1][0], o[0][1][1]); w.y = pk_fp8x4(o[1][0][0], o[1][0][1], o[1][1][0], o[1][1][1]);
                *(v2u*)rowp = w; }
    }
};
typedef EpiSwiGLU8T<false> EpiSwiGLU8;
typedef EpiSwiGLU8T<true> EpiSwiGLU8D;
struct EpiStoreQ {
    static constexpr bool PERM = true;
    __device__ __forceinline__ void operator()(const f32x4 (&acc)[2][2][4][2], const Unit& u, const int wid) const {
        int lane_; asm volatile("v_mbcnt_lo_u32_b32 %0, -1, 0\n\tv_mbcnt_hi_u32_b32 %0, -1, %0" : "=v"(lane_));
        const int wr = wid >> 2, wc = wid & 3, fr = lane_ & 15, fq = lane_ >> 4;
        bf16* base = (bf16*)u.o; int row0 = wr * 64 + fr, col0 = wc * 32 + 8 * fq; asm volatile("" : "+v"(row0), "+v"(col0));
        constexpr float SA = 1.0f / (Q_HID * Q_W);
#pragma unroll
        for (int ai = 0; ai < 2; ++ai)
#pragma unroll
            for (int m = 0; m < 4; ++m) { bf16* rowp = base + (size_t)(row0 + ai * HALF + m * 16) * u.ldo + col0;
#pragma unroll
                for (int bj = 0; bj < 2; ++bj) { const f32x4 v0 = acc[ai][bj][m][0] * SA, v1 = acc[ai][bj][m][1] * SA;
                    v4u w; w.x = cvt_pk_bf16(v0[0], v0[1]); w.y = cvt_pk_bf16(v0[2], v0[3]); w.z = cvt_pk_bf16(v1[0], v1[1]); w.w = cvt_pk_bf16(v1[2], v1[3]);
                    *(v4u*)(rowp + bj * HALF) = w; } }
    }
};
struct EpiResid {
    static constexpr bool PERM = false;
    __device__ __forceinline__ void operator()(const f32x4 (&acc)[2][2][4][2], const Unit& u, const int wid) const {
        int lane_; asm volatile("v_mbcnt_lo_u32_b32 %0, -1, 0\n\tv_mbcnt_hi_u32_b32 %0, -1, %0" : "=v"(lane_));
        const int wr = wid >> 2, wc = wid & 3, fr = lane_ & 15, fq = lane_ >> 4;
        const float* xs = (const float*)u.p0; float* zo = (float*)u.o; const float* gv = (const float*)u.p1;
        int row0 = wr * 64 + fr, col0 = wc * 32 + 4 * fq; asm volatile("" : "+v"(row0), "+v"(col0));
#pragma unroll
        for (int ai = 0; ai < 2; ++ai)
#pragma unroll
            for (int m = 0; m < 4; ++m) { const size_t off = (size_t)(row0 + ai * HALF + m * 16) * D + col0;
#pragma unroll
                for (int bj = 0; bj < 2; ++bj)
#pragma unroll
                    for (int n = 0; n < 2; ++n) { const f32x4 xv = *(const f32x4*)(xs + off + bj * HALF + n * 16); const f32x4 gvv = *(const f32x4*)(gv + col0 + bj * HALF + n * 16);
                        *(f32x4*)(zo + off + bj * HALF + n * 16) = xv * ALPHA + gvv * acc[ai][bj][m][n]; }
                asm volatile("" ::: "memory"); }
    }
};
struct EpiResidLN {
    static constexpr bool PERM = true;
    const float* lng; const float* lnb; int sc_delta, sh_delta; bf16* H; unsigned* cnt; unsigned long long* xs; unsigned* tmo; LAS unsigned char* tab; float dq; bool h8;
    __device__ __forceinline__ void operator()(f32x4 (&acc)[2][2][4][2], const Unit& u, const int wid) const {
        int lane_; asm volatile("v_mbcnt_lo_u32_b32 %0, -1, 0\n\tv_mbcnt_hi_u32_b32 %0, -1, %0" : "=v"(lane_));
        const int wr = wid >> 2, wc = wid & 3, fr = lane_ & 15, fq = lane_ >> 4, pm = u.x0 >> 2, pn = u.x0 & 3;
        const bf16* xsrc = (const bf16*)u.p0; bf16* xo = (bf16*)u.o; const float* gv = (const float*)u.p1;
        int row0 = wr * 64 + fr, col0 = wc * 32 + 8 * fq; asm volatile("" : "+v"(row0), "+v"(col0));
        LAS f32x2* Pt = (LAS f32x2*)tab; LAS f32x2* St = (LAS f32x2*)(tab + 8192);
        f32x4 gg[2][2];
#pragma unroll
        for (int bj = 0; bj < 2; ++bj)
#pragma unroll
            for (int n = 0; n < 2; ++n) gg[bj][n] = *(const f32x4*)(gv + col0 + bj * HALF + n * 4) * dq;
#pragma unroll
        for (int ai = 0; ai < 2; ++ai) {
            v4u xw[1][4][2];
#pragma unroll
            for (int m = 0; m < 4; ++m)
#pragma unroll
                for (int bj = 0; bj < 2; ++bj) xw[0][m][bj] = *(const v4u*)(xsrc + (size_t)(row0 + ai * HALF + m * 16) * D + col0 + bj * HALF);
#pragma unroll
            for (int m = 0; m < 4; ++m) { float sm = 0.f, sq = 0.f;
#pragma unroll
                for (int bj = 0; bj < 2; ++bj) { const v4u w_ = xw[0][m][bj];
                    const f32x4 x0 = (f32x4){bflo(w_.x), bfhi(w_.x), bflo(w_.y), bfhi(w_.y)}, x1 = (f32x4){bflo(w_.z), bfhi(w_.z), bflo(w_.w), bfhi(w_.w)};
                    const f32x4 z0 = x0 * ALPHA + gg[bj][0] * acc[ai][bj][m][0], z1 = x1 * ALPHA + gg[bj][1] * acc[ai][bj][m][1]; acc[ai][bj][m][0] = z0; acc[ai][bj][m][1] = z1;
                    sm += ((z0[0] + z0[1]) + (z0[2] + z0[3])) + ((z1[0] + z1[1]) + (z1[2] + z1[3]));
                    sq += ((z0[0] * z0[0] + z0[1] * z0[1]) + (z0[2] * z0[2] + z0[3] * z0[3])) + ((z1[0] * z1[0] + z1[1] * z1[1]) + (z1[2] * z1[2] + z1[3] * z1[3])); }
                sm += __shfl_xor(sm, 16); sm += __shfl_xor(sm, 32); sq += __shfl_xor(sq, 16); sq += __shfl_xor(sq, 32);
                if (fq == 0) Pt[(ai * HALF + wr * 64 + m * 16 + fr) * 4 + wc] = (f32x2){sm, sq}; }
            asm volatile("" ::: "memory"); }
        const float* lg = lng + pn * 256; const float* lb = lnb + pn * 256; const float* scv = gv + sc_delta; const float* shv = gv + sh_delta;
        f32x4 g4[2][2], b4[2][2], s4[2][2], t4[2][2];
#pragma unroll
        for (int bj = 0; bj < 2; ++bj)
#pragma unroll
            for (int n = 0; n < 2; ++n) { const int c = col0 + bj * HALF + n * 4; g4[bj][n] = *(const f32x4*)(lg + c); b4[bj][n] = *(const f32x4*)(lb + c); s4[bj][n] = *(const f32x4*)(scv + c); t4[bj][n] = *(const f32x4*)(shv + c); }
        asm volatile("s_waitcnt lgkmcnt(0)" ::: "memory"); __builtin_amdgcn_s_barrier(); asm volatile("" ::: "memory");
        const int trow = wid * 64 + lane_;
        if (wid < 4) {
            const f32x2 a = Pt[trow * 4 + 0], b = Pt[trow * 4 + 1], c = Pt[trow * 4 + 2], d = Pt[trow * 4 + 3];
            const float ts = (a.x + b.x) + (c.x + d.x), tq = (a.y + b.y) + (c.y + d.y);
            __hip_atomic_store(xs + ((size_t)pm * 256 + trow) * 4 + pn, ((unsigned long long)__float_as_uint(tq) << 32) | __float_as_uint(ts), __ATOMIC_RELAXED, __HIP_MEMORY_SCOPE_AGENT);
            asm volatile("s_waitcnt vmcnt(0)" ::: "memory");
            if (lane_ == 0) __hip_atomic_fetch_add(cnt + pm * 16, 1u, __ATOMIC_RELAXED, __HIP_MEMORY_SCOPE_AGENT);
        }
        if (wid == 0) {
            unsigned sp = 0;
            while ((unsigned)__builtin_amdgcn_readfirstlane(__hip_atomic_load(cnt + pm * 16, __ATOMIC_RELAXED, __HIP_MEMORY_SCOPE_AGENT)) < 16u) {
                __builtin_amdgcn_s_sleep(1);
                if ((++sp & 1023u) == 0u && (sp > (1u << 24) || __hip_atomic_load(tmo, __ATOMIC_RELAXED, __HIP_MEMORY_SCOPE_AGENT) != 0u)) { if (lane_ == 0) __hip_atomic_store(tmo, 1u, __ATOMIC_RELAXED, __HIP_MEMORY_SCOPE_AGENT); break; } }
            __builtin_amdgcn_fence(__ATOMIC_ACQUIRE, "agent");
        }
        asm volatile("s_waitcnt vmcnt(0) lgkmcnt(0)" ::: "memory"); __builtin_amdgcn_s_barrier(); asm volatile("" ::: "memory");
        if (wid < 4) {
            const unsigned long long* sl = xs + ((size_t)pm * 256 + trow) * 4; float ts = 0.f, tq = 0.f;
#pragma unroll
            for (int t = 0; t < 4; ++t) { const unsigned long long w = __hip_atomic_load(sl + t, __ATOMIC_RELAXED, __HIP_MEMORY_SCOPE_AGENT); ts += __uint_as_float((unsigned)w); tq += __uint_as_float((unsigned)(w >> 32)); }
            const float mean = ts * (1.f / D), var = fmaxf(tq * (1.f / D) - mean * mean, 0.f);
            St[trow] = (f32x2){mean, rsqrtf(var + LN_EPS)};
        }
        asm volatile("s_waitcnt vmcnt(0) lgkmcnt(0)" ::: "memory"); __builtin_amdgcn_s_barrier(); asm volatile("" ::: "memory");
        bf16* hb = h8 ? (bf16*)((unsigned char*)H + ((size_t)pm * 256) * D + pn * 256) : H + ((size_t)pm * 256) * D + pn * 256;
#pragma unroll
        for (int bj = 0; bj < 2; ++bj)
#pragma unroll
            for (int n = 0; n < 2; ++n) s4[bj][n] = s4[bj][n] + 1.0f;
#pragma unroll
        for (int ai = 0; ai < 2; ++ai)
#pragma unroll
            for (int m = 0; m < 4; ++m) { const int r = row0 + ai * HALF + m * 16; const f32x2 ms = St[r]; const size_t off = (size_t)r * D + col0;
#pragma unroll
                for (int bj = 0; bj < 2; ++bj) {
                    const f32x4 xa = (acc[ai][bj][m][0] - ms.x) * ms.y * g4[bj][0] + b4[bj][0], xc_ = (acc[ai][bj][m][1] - ms.x) * ms.y * g4[bj][1] + b4[bj][1];
                    v4u wx; wx.x = cvt_pk_bf16(xa[0], xa[1]); wx.y = cvt_pk_bf16(xa[2], xa[3]); wx.z = cvt_pk_bf16(xc_[0], xc_[1]); wx.w = cvt_pk_bf16(xc_[2], xc_[3]);
                    *(v4u*)(xo + off + bj * HALF) = wx;
                    const f32x4 ha = xa * s4[bj][0] + t4[bj][0], hc = xc_ * s4[bj][1] + t4[bj][1];
                    if (h8) { v2u w8; w8.x = pk_fp8x4(ha[0] * Q_H, ha[1] * Q_H, ha[2] * Q_H, ha[3] * Q_H); w8.y = pk_fp8x4(hc[0] * Q_H, hc[1] * Q_H, hc[2] * Q_H, hc[3] * Q_H);
                        *(v2u*)((unsigned char*)hb + off + bj * HALF) = w8; }
                    else { v4u wh; wh.x = cvt_pk_bf16(ha[0], ha[1]); wh.y = cvt_pk_bf16(ha[2], ha[3]); wh.z = cvt_pk_bf16(hc[0], hc[1]); wh.w = cvt_pk_bf16(hc[2], hc[3]);
                        *(v4u*)(hb + off + bj * HALF) = wh; } } }
    }
};
struct EpiGLU {
    static constexpr bool PERM = true, PREFETCH = false;
    __device__ __forceinline__ void operator()(const f32x4 (&acc)[2][2][4][2], const Unit& u, const int wid) const {
        int lane_; asm volatile("v_mbcnt_lo_u32_b32 %0, -1, 0\n\tv_mbcnt_hi_u32_b32 %0, -1, %0" : "=v"(lane_));
        const int wr = wid >> 2, wc = wid & 3, fr = lane_ & 15, fq = lane_ >> 4;
        bf16* base = (bf16*)u.o; const bf16* gp = (const bf16*)u.p0; const float* bias = (const float*)u.p1;
        int row0 = wr * 64 + fr, col0 = wc * 32 + 8 * fq; asm volatile("" : "+v"(row0), "+v"(col0));
        v4u gwv[2][4][2]; f32x4 bv[2][2];
#pragma unroll
        for (int ai = 0; ai < 2; ++ai)
#pragma unroll
            for (int m = 0; m < 4; ++m)
#pragma unroll
                for (int bj = 0; bj < 2; ++bj) { const int c_ = col0 + bj * HALF; gwv[ai][m][bj] = *(const v4u*)(gp + ((size_t)(c_ >> 4) * T + (row0 + ai * HALF + m * 16)) * 16 + (c_ & 15)); }
#pragma unroll
        for (int bj = 0; bj < 2; ++bj) { bv[bj][0] = *(const f32x4*)(bias + col0 + bj * HALF); bv[bj][1] = *(const f32x4*)(bias + col0 + bj * HALF + 4); }
#pragma unroll
        for (int ai = 0; ai < 2; ++ai)
#pragma unroll
            for (int m = 0; m < 4; ++m) { const int r = row0 + ai * HALF + m * 16;
#pragma unroll
                for (int bj = 0; bj < 2; ++bj) { const v4u gw = gwv[ai][m][bj];
                    const f32x4 a0 = acc[ai][bj][m][0] + bv[bj][0], a1 = acc[ai][bj][m][1] + bv[bj][1];
                    const f32x2 p0 = (f32x2){bflo(gw.x), bfhi(gw.x)} * sigmoid_2((f32x2){a0[0], a0[1]}), p1 = (f32x2){bflo(gw.y), bfhi(gw.y)} * sigmoid_2((f32x2){a0[2], a0[3]});
                    const f32x2 p2 = (f32x2){bflo(gw.z), bfhi(gw.z)} * sigmoid_2((f32x2){a1[0], a1[1]}), p3 = (f32x2){bflo(gw.w), bfhi(gw.w)} * sigmoid_2((f32x2){a1[2], a1[3]});
                    v4u w; w.x = cvt_pk_bf16(p0[0], p0[1]); w.y = cvt_pk_bf16(p1[0], p1[1]); w.z = cvt_pk_bf16(p2[0], p2[1]); w.w = cvt_pk_bf16(p3[0], p3[1]);
                    *(v4u*)(base + (size_t)r * u.ldo + col0 + bj * HALF) = w; } }
    }
};
struct EpiS5B {
    static constexpr bool PERM = true, PREFETCH = false;
    __device__ __forceinline__ void operator()(const f32x4 (&acc)[2][2][4][2], const Unit& u, const int wid) const {
        int lane_; asm volatile("v_mbcnt_lo_u32_b32 %0, -1, 0\n\tv_mbcnt_hi_u32_b32 %0, -1, %0" : "=v"(lane_));
        const int wr = wid >> 2, wc = wid & 3, fr = lane_ & 15, fq = lane_ >> 4;
        bf16* base = (bf16*)u.o; const bf16* y1 = (const bf16*)u.p0;
        int row0 = wr * 64 + fr, col0 = wc * 32 + 8 * fq; asm volatile("" : "+v"(row0), "+v"(col0));
        v4u yw[2][4][2];
#pragma unroll
        for (int ai = 0; ai < 2; ++ai)
#pragma unroll
            for (int m = 0; m < 4; ++m)
#pragma unroll
                for (int bj = 0; bj < 2; ++bj) yw[ai][m][bj] = *(const v4u*)(y1 + (size_t)(row0 + ai * HALF + m * 16) * 256 + col0 + bj * HALF);
#pragma unroll
        for (int ai = 0; ai < 2; ++ai)
#pragma unroll
            for (int m = 0; m < 4; ++m) { const int r = row0 + ai * HALF + m * 16;
#pragma unroll
                for (int bj = 0; bj < 2; ++bj) { const int c = col0 + bj * HALF; const v4u w_ = yw[ai][m][bj];
                    const f32x4 a0 = acc[ai][bj][m][0], a1 = acc[ai][bj][m][1];
                    const f32x2 p0 = gelu_tanh_2((f32x2){a0[0], a0[1]} + (f32x2){bflo(w_.x), bfhi(w_.x)}), p1 = gelu_tanh_2((f32x2){a0[2], a0[3]} + (f32x2){bflo(w_.y), bfhi(w_.y)});
                    const f32x2 p2 = gelu_tanh_2((f32x2){a1[0], a1[1]} + (f32x2){bflo(w_.z), bfhi(w_.z)}), p3 = gelu_tanh_2((f32x2){a1[2], a1[3]} + (f32x2){bflo(w_.w), bfhi(w_.w)});
                    v4u w; w.x = cvt_pk_bf16(p0[0], p0[1]); w.y = cvt_pk_bf16(p1[0], p1[1]); w.z = cvt_pk_bf16(p2[0], p2[1]); w.w = cvt_pk_bf16(p3[0], p3[1]);
                    *(v4u*)(base + (size_t)r * 256 + c) = w; } }
    }
};
}

struct Params { const float* in[32]; float* out; unsigned char* ws; int ph_lo, ph_hi; };
enum { I_X = 0, I_C, I_CTX, I_CCTX, I_WMOD, I_BMOD, I_LNG, I_LNB, I_EV_WIN, I_EV_WOUT, I_EV_SINK, I_EV_W1, I_EV_W3, I_EV_W2, I_OD_WIN, I_A_RE, I_A_IM, I_LOG_DT,
       I_B_RE, I_B_IM, I_C_RE, I_C_IM, I_SSM_D, I_WGLU, I_BGLU, I_WS, I_BS, I_OD_WOUT, I_ROUTER, I_MW1, I_MW3, I_MW2 };

constexpr int LDS_RING = 131072, LDS_MISC = LDS_RING + 320, LDS_LNTAB = LDS_RING + 1024, LDS_BYTES = 147456;
constexpr int NWAVES = 8, NTHREADS = 512;

struct Frame {
    LAS unsigned char* lds;
    int tid, lane, wave, G, bid, gw, NGW;
    unsigned char* ws;
    unsigned* ctl;
};

using pg8::Unit;
__device__ __forceinline__ void xcd_rows(int c, int nM, int& r0, int& cnt) { const int x = c & 7, base = nM >> 3, extra = nM & 7; cnt = base + (x < extra ? 1 : 0); r0 = x * base + (x < extra ? x : extra); }
__device__ __forceinline__ void grp_unit(int q, int cnt, int nN, int RG, int& row_local, int& pn) {
    const int gfull = RG * nN, rg = q / gfull, rem = q - rg * gfull; int rows_here = cnt - rg * RG; rows_here = rows_here < RG ? rows_here : RG;
    pn = rem / rows_here; row_local = rg * RG + (rem - pn * rows_here);
}
__device__ __forceinline__ bool xcd_unit(int i, int G, int c, int nM, int nN, int RG, int& pm, int& pn) {
    int r0, cnt; xcd_rows(c, nM, r0, cnt); const int q = i * (G >> 3) + (c >> 3); if (q >= cnt * nN) return false;
    int rl; grp_unit(q, cnt, nN, RG, rl, pn); pm = r0 + rl; return true;
}
struct SchedStd {
    int nN, nUnits, G, c; const char* A; const char* B; char* O; size_t aStep, bStep, oRow, oCol; int ldo, act_from;
    __device__ __forceinline__ bool next(int i, Unit& u) const {
        int pm, pn; if (!xcd_unit(i, G, c, nUnits / nN, nN, 4, pm, pn)) return false;
        u.a = A + (size_t)pm * aStep; u.b = B + (size_t)pn * bStep; u.o = O + (size_t)pm * oRow + (size_t)pn * oCol; u.p0 = nullptr; u.p1 = nullptr; u.ldo = ldo; u.x0 = (pn >= act_from) ? 1 : 0; return true;
    }
};
struct SchedEvIn {
    int G, c; const char* H; const char* Wqkv; const char* Wpq; char* QKV; char* PQT; char* PQTC;
    __device__ __forceinline__ bool next(int i, Unit& u) const {
        u.p0 = nullptr; u.p1 = nullptr; u.x0 = 0;
        int r0, cnt; xcd_rows(c, T / 256, r0, cnt);
        int q = i * (G >> 3) + (c >> 3);
        if (q < cnt * 3) { int rl, pn; grp_unit(q, cnt, 3, 4, rl, pn); const int pm = r0 + rl;
            u.a = H + (size_t)pm * 256 * D * 2; u.b = Wqkv + (size_t)pn * 256 * D * 2; u.o = QKV + ((size_t)pm * 256 * 768 + pn * 256) * 2; u.ldo = 768; return true; }
        q -= cnt * 3; if (q >= cnt * 4) return false;
        int rl, pm; grp_unit(q, cnt, 4, 4, rl, pm); const int tt = r0 + rl, isq = pm >> 1, ch0 = (pm & 1) * 256;
        u.a = Wpq + (size_t)pm * 256 * D * 2; u.b = H + (size_t)tt * 256 * D * 2;
        if (tt < TL / 256) { const int b = tt >> 4, n0 = (tt & 15) * 256; u.o = PQT + ((((size_t)b * 512 + ch0) * 2 + isq) * 4096 + n0) * 2; u.ldo = 8192; }
        else { const int b = tt - TL / 256; u.o = PQTC + (((size_t)b * 512 + ch0) * 2 + isq) * 256 * 2; u.ldo = 512; }
        return true;
    }
};
struct SchedDft {
    int G, c; const char* FDm; const char* VB; const char* F2; const char* PQTC; char* MIX;
    __device__ __forceinline__ bool next(int i, Unit& u) const {
        int L = i * G + c; u.p0 = nullptr; u.p1 = nullptr; u.x0 = 0;
        if (L < 512) { const int b = L >> 5, pn = L & 31, k2 = pn >> 1, ch0 = (pn & 1) * 256;
            u.a = FDm; u.b = VB + ((((size_t)b * 16 + k2) * 512 + ch0) * 512) * 2; u.o = MIX + ((((size_t)b * 4096 + k2) * D) + ch0) * 2; u.ldo = 16 * D; return true; }
        L -= 512; if (L >= 32) return false;
        const int b = L >> 1, pn = L & 1;
        u.a = F2; u.b = PQTC + ((size_t)b * 512 + pn * 256) * 512 * 2; u.o = MIX + (((size_t)TL + (size_t)b * 256) * D + pn * 256) * 2; u.ldo = D; return true;
    }
};
struct SchedResid {
    int G, c, nUnits; const char* A; size_t aStep; const char* W; size_t bStep; bf16* xb; const float* gate;
    __device__ __forceinline__ bool next(int i, Unit& u) const {
        int pm, pn; if (!xcd_unit(i, G, c, nUnits >> 2, 4, 1, pm, pn)) return false;
        const int L = pm * 4 + pn;
        u.a = A + (size_t)pm * aStep; u.b = W + (size_t)pn * bStep;
        const bool isc = pm >= TL / 256; const int mrow = isc ? 16 : (pm >> 4);
        const size_t off = ((size_t)pm * 256 * D + pn * 256);
        u.p0 = (const char*)(xb + off); u.o = (char*)(xb + off); u.p1 = (const char*)(gate + (size_t)mrow * 6144 + pn * 256); u.ldo = D; u.x0 = L; return true;
    }
};
struct SchedO1 {
    int G, c; const char* H; const char* W; char* Pp; char* UG;
    __device__ __forceinline__ bool next(int i, Unit& u) const {
        int pm, pn; if (!xcd_unit(i, G, c, T / 256, 6, 4, pm, pn)) return false;
        u.a = H + (size_t)pm * 256 * D * 2; u.b = W + (size_t)pn * 256 * D * 2; u.p0 = nullptr; u.p1 = nullptr;
        if (pn < 2) { u.o = UG + (((size_t)(pn * 16) * T + (size_t)pm * 256) * 16) * 2; u.ldo = 0; u.x0 = 2; }
        else { u.o = Pp + ((size_t)pm * 256 * D + (pn - 2) * 256) * 2; u.ldo = D; u.x0 = 1; }
        return true;
    }
};
struct SchedGlu {
    int G, c; const char* UG; const char* W; char* MIX; const float* bias;
    __device__ __forceinline__ bool next(int i, Unit& u) const {
        const int L = i * G + c; if (L >= (T / 256) * 2) return false;
        const int pm = L >> 1, pn = L & 1;
        u.a = UG + (size_t)pm * 256 * 32; u.b = W + (size_t)pn * 256 * 512 * 2; u.o = MIX + ((size_t)pm * 256 * D + pn * 256) * 2;
        u.p0 = UG + (((size_t)(pn * 16) * T + (size_t)pm * 256) * 16) * 2; u.p1 = (const char*)(bias + pn * 256); u.ldo = D; u.x0 = 0; return true;
    }
};
struct SchedS5A {
    int G, c; const char* UG; const char* WA; char* Y1; char* HB;
    __device__ __forceinline__ bool next(int i, Unit& u) const {
        const int L = i * G + c; if (L >= 32 * 34) return false;
        const int g = L / 34, rem = L - g * 34, pm = rem >> 1, pn = rem & 1;
        const size_t toff = (((size_t)g * 4352 + (size_t)pm * 256) * 256) * 2;
        u.a = UG + toff; u.b = WA + (size_t)g * S5M_STRIDE + (size_t)pn * 256 * 256 * 2;
        u.o = (pn ? HB : Y1) + toff; u.p0 = nullptr; u.p1 = nullptr; u.ldo = 256; u.x0 = 0; return true;
    }
};
struct SchedS5B {
    int G, c; const char* HB; const char* CL; const char* Y1; char* UG;
    __device__ __forceinline__ bool next(int i, Unit& u) const {
        const int L = i * G + c; if (L >= 32 * 17) return false;
        const int g = L / 17, pm = L - g * 17;
        const size_t toff = (((size_t)g * 4352 + (size_t)pm * 256) * 256) * 2;
        u.a = HB + toff; u.b = CL + (size_t)g * S5M_STRIDE; u.p0 = Y1 + toff; u.o = UG + toff; u.p1 = nullptr; u.ldo = 256; u.x0 = 0; return true;
    }
};
struct SchedMoeUp {
    int G, c, nUnits, rt0; int toff[9]; const char* HS; const char* W; char* HID;
    __device__ __forceinline__ bool next(int i, Unit& u) const {
        int rl, pn; if (!xcd_unit(i, G, c, nUnits / 28, 28, 4, rl, pn)) return false;
        const int rt = rt0 + rl; int e = 0;
#pragma unroll
        for (int k = 1; k < 8; ++k) e += (rt >= toff[k]) ? 1 : 0;
        u.a = HS + (size_t)rt * 256 * D; u.b = W + ((size_t)e * 7168 + pn * 256) * D; u.o = HID + ((size_t)rl * 28 + pn) * 32768;
        u.p0 = nullptr; u.p1 = nullptr; u.ldo = EH; u.x0 = 0; return true;
    }
};
struct SchedMoeDown {
    int G, c, nUnits, rt0; int toff[9]; const char* HID; const char* W; char* Y;
    __device__ __forceinline__ bool next(int i, Unit& u) const {
        int rl, pn; if (!xcd_unit(i, G, c, nUnits >> 2, 4, 8, rl, pn)) return false;
        const int rt = rt0 + rl; int e = 0;
#pragma unroll
        for (int k = 1; k < 8; ++k) e += (rt >= toff[k]) ? 1 : 0;
        u.a = HID + (size_t)rl * 28 * 32768; u.b = W + ((size_t)e * 1024 + pn * 256) * EH; u.o = Y + ((size_t)rt * 256 * D + pn * 256) * 2;
        u.p0 = nullptr; u.p1 = nullptr; u.ldo = D; u.x0 = 0; return true;
    }
};

constexpr int CVT_ITEMS = 2 * 5120 + 2 * 1408 + 2 * 8 * 3 * 1792;
constexpr int CVT_W2_0 = 2 * 3712 + 2 * 1408;
constexpr int CVT_MOE0 = 2 * 5120 + 2 * 1408, CVT_MOE_LI = 8 * 3 * 1792;
struct CvtDesc { const float* src; unsigned char* dst; int ldn, ldk; };
template <class PPtr>
__device__ __forceinline__ CvtDesc cvt_decode(PPtr pp, unsigned char* ws, int r) {
    constexpr int EV_ITEMS = 384 + 512 + 2 * 1408;
    constexpr int ODS_ITEMS = 768 + 128 + 512;
    constexpr int EXP_ITEMS = 3 * 1792, MOE_ITEMS = 8 * EXP_ITEMS;
    int idx, ldn, N, ldk, es = 2, mode = 0, roff = 0; size_t soff, doff;
    if (r < 2 * EV_ITEMS) { const int li = r / EV_ITEMS; r -= li * EV_ITEMS; const size_t base = WS_EV + (size_t)li * EV_STRIDE;
        if (r < 384) { idx = I_EV_WIN; soff = (size_t)li * D * 1280 + 512; ldn = 1280; N = 768; doff = base + EV_WQKV; ldk = D; }
        else if (r < 896) { r -= 384; idx = I_EV_WOUT; soff = (size_t)li * D * D; ldn = D; N = D; doff = base + EV_WOUT; ldk = D; }
        else if (r < 2304) { r -= 896; idx = I_EV_W1; soff = (size_t)li * D * FFH; ldn = FFH; N = FFH; doff = base + EV_W13; ldk = D; mode = 1; }
        else { r -= 2304; idx = I_EV_W3; soff = (size_t)li * D * FFH; ldn = FFH; N = FFH; doff = base + EV_W13; ldk = D; mode = 1; roff = 128; } }
    else if (r < 2 * EV_ITEMS + 2 * ODS_ITEMS) { r -= 2 * EV_ITEMS; const int li = r / ODS_ITEMS; r -= li * ODS_ITEMS; const size_t base = WS_OD + (size_t)li * OD_STRIDE;
        if (r < 768) { idx = I_OD_WIN; soff = (size_t)li * D * 1536; ldn = 1536; N = 1536; doff = base + OD_WIN; ldk = D; }
        else if (r < 896) { r -= 768; idx = I_WGLU; soff = (size_t)li * 512 * 512; ldn = 512; N = 512; doff = base + OD_WGLU; ldk = 512; }
        else { r -= 896; idx = I_OD_WOUT; soff = (size_t)li * D * D; ldn = D; N = D; doff = base + OD_WOUT; ldk = D; } }
    else if (r < CVT_MOE0) { r -= CVT_W2_0; const int li = r / 1408; r -= li * 1408; es = 1;
        idx = I_EV_W2; soff = (size_t)li * FFH * D; ldn = D; N = D; doff = WS_EV + (size_t)li * EV_STRIDE + EV_W2; ldk = FFH; }
    else { r -= CVT_MOE0; const int li = r / MOE_ITEMS; r -= li * MOE_ITEMS; const int e = r / EXP_ITEMS; r -= e * EXP_ITEMS; const size_t base = WS_OD + (size_t)li * OD_STRIDE;
        const size_t we = (size_t)li * NEXP + e; es = 1;
        if (r < 1792) { idx = I_MW1; soff = we * D * EH; ldn = EH; N = EH; doff = base + OD_MW13 + (size_t)e * 7168 * D; ldk = D; mode = 1; }
        else if (r < 3584) { r -= 1792; idx = I_MW3; soff = we * D * EH; ldn = EH; N = EH; doff = base + OD_MW13 + (size_t)e * 7168 * D; ldk = D; mode = 1; roff = 128; }
        else { r -= 3584; idx = I_MW2; soff = we * EH * D; ldn = D; N = D; doff = base + OD_MW2 + (size_t)e * D * EH; ldk = EH; } }
    const int nblk = N / 32, kb = r / nblk, nb = r - kb * nblk, n0 = nb * 32, k0 = kb * 64;
    const int drow0 = mode ? ((n0 >> 7) * 256 + (n0 & 127) + roff) : (roff + n0);
    CvtDesc d; d.src = (const float*)pp->in[idx] + soff + (size_t)k0 * ldn + n0; d.dst = ws + doff + ((size_t)drow0 * ldk + k0) * es; d.ldn = ldn; d.ldk = ldk; return d;
}
__device__ __forceinline__ void cvt_load(const CvtDesc& d, int lane, f32x4 (&v)[8]) {
    const float* q = d.src + (size_t)(lane >> 3) * d.ldn + (lane & 7) * 4;
#pragma unroll
    for (int j = 0; j < 8; ++j) v[j] = *(const f32x4*)(q + (size_t)(8 * j) * d.ldn);
}
template <bool FP8>
__device__ __forceinline__ void cvt_finish(const CvtDesc& d, const f32x4 (&v)[8], LAS float* scr, int lane) {
    constexpr float qs = FP8 ? Q_W : 1.0f;
    { LAS float* q = scr + (lane >> 3) * 33 + (lane & 7) * 4;
#pragma unroll
      for (int j = 0; j < 8; ++j) { q[(8 * j) * 33 + 0] = v[j][0] * qs; q[(8 * j) * 33 + 1] = v[j][1] * qs; q[(8 * j) * 33 + 2] = v[j][2] * qs; q[(8 * j) * 33 + 3] = v[j][3] * qs; } }
    LDS_WAIT(); asm volatile("" ::: "memory");
    const int c = lane & 7;
#pragma unroll
    for (int j = 0; j < 4; ++j) { const int n = (lane >> 3) + 8 * j; const LAS float* sp = scr + (8 * c) * 33 + n;
        if constexpr (FP8) { v2u o; o.x = pk_fp8x4(sp[0 * 33], sp[1 * 33], sp[2 * 33], sp[3 * 33]); o.y = pk_fp8x4(sp[4 * 33], sp[5 * 33], sp[6 * 33], sp[7 * 33]);
            *(v2u*)(d.dst + (size_t)n * d.ldk + 8 * c) = o; }
        else { v4u o; o.x = cvt_pk_bf16(sp[0 * 33], sp[1 * 33]); o.y = cvt_pk_bf16(sp[2 * 33], sp[3 * 33]); o.z = cvt_pk_bf16(sp[4 * 33], sp[5 * 33]); o.w = cvt_pk_bf16(sp[6 * 33], sp[7 * 33]);
            *(v4u*)(d.dst + ((size_t)n * d.ldk + 8 * c) * 2) = o; } }
    LDS_WAIT(); asm volatile("" ::: "memory");
}
template <bool FP8, class PPtr>
__device__ __forceinline__ void cvt_range(PPtr pp, unsigned char* ws, int first, int end, int stride, LAS float* scr, int lane) {
    if (first >= end) return;
    CvtDesc d = cvt_decode(pp, ws, first); f32x4 v[8]; cvt_load(d, lane, v);
    for (int it = first; it < end; it += stride) {
        int nx = it + stride; nx = nx < end ? nx : it;
        const CvtDesc dn = cvt_decode(pp, ws, nx); f32x4 vn[8]; cvt_load(dn, lane, vn);
        cvt_finish<FP8>(d, v, scr, lane);
        d = dn;
#pragma unroll
        for (int j = 0; j < 8; ++j) v[j] = vn[j];
    }
}

__device__ __forceinline__ void fold_unit(const Params& p, Frame& F, int unit) {
    const int li = unit >> 6, g = (unit >> 4) & 3, k0 = (unit & 15) * 64;
    LAS float* tile = (LAS float*)F.lds;
    LAS float* trig = tile + 64 * 129;
    const float* W = p.in[I_EV_WIN] + (size_t)li * D * 1280;
    for (int e = F.tid; e < 64 * 128; e += NTHREADS) { const int k = e >> 7, c = e & 127; tile[k * 129 + c] = W[(size_t)(k0 + k) * 1280 + g * 128 + c]; }
    if (F.tid < 128) { float s, c; sincospif((float)F.tid / 64.0f, &s, &c); trig[F.tid] = c * 0.08838834764831845f; trig[128 + F.tid] = s * 0.08838834764831845f; }
    __syncthreads();
    bf16* WT = (bf16*)(p.ws + WS_EV + li * EV_STRIDE + EV_WPQ);
    const int k = F.lane, mg = F.wave;
    for (int mm = 0; mm < 16; ++mm) { const int m = mg * 16 + mm; float sp = 0.f, sq = 0.f;
        for (int c = 0; c < 128; ++c) { const float w = tile[k * 129 + c]; const int ph = (m * c) & 127; sp += w * trig[ph]; sq += w * trig[128 + ph]; }
        WT[(size_t)(g * 128 + m) * D + k0 + k] = f2bf(sp); WT[(size_t)(512 + g * 128 + m) * D + k0 + k] = f2bf(sq); }
    __syncthreads();
}

__device__ __forceinline__ void row_load(const float* row, int lane, f32x4 (&v)[4]) {
#pragma unroll
    for (int j = 0; j < 4; ++j) v[j] = *(const f32x4*)(row + 256 * j + 4 * lane);
}
__device__ __forceinline__ void row_load_bf16(const bf16* row, int lane, f32x4 (&v)[4]) {
#pragma unroll
    for (int j = 0; j < 4; ++j) { const v2u w = *(const v2u*)(row + 256 * j + 4 * lane); v[j] = (f32x4){bflo(w.x), bfhi(w.x), bflo(w.y), bfhi(w.y)}; }
}
__device__ __forceinline__ void row_store(float* row, int lane, const f32x4 (&v)[4]) {
#pragma unroll
    for (int j = 0; j < 4; ++j) *(f32x4*)(row + 256 * j + 4 * lane) = v[j];
}
__device__ __forceinline__ void row_store_bf16(bf16* row, int lane, const f32x4 (&v)[4]) {
#pragma unroll
    for (int j = 0; j < 4; ++j) { v2u w; w.x = cvt_pk_bf16(v[j][0], v[j][1]); w.y = cvt_pk_bf16(v[j][2], v[j][3]); *(v2u*)(row + 256 * j + 4 * lane) = w; }
}
__device__ __forceinline__ void row_layernorm(f32x4 (&v)[4], const float* g, const float* b, int lane) {
    float s = 0.f;
#pragma unroll
    for (int j = 0; j < 4; ++j) s += (v[j][0] + v[j][1]) + (v[j][2] + v[j][3]);
    const float mean = wave_sum(s) * (1.f / D); float q = 0.f;
#pragma unroll
    for (int j = 0; j < 4; ++j) { v[j] = v[j] - mean; q += (v[j][0] * v[j][0] + v[j][1] * v[j][1]) + (v[j][2] * v[j][2] + v[j][3] * v[j][3]); }
    const float rstd = rsqrtf(wave_sum(q) * (1.f / D) + LN_EPS);
#pragma unroll
    for (int j = 0; j < 4; ++j) { const f32x4 gg = *(const f32x4*)(g + 256 * j + 4 * lane), bb = *(const f32x4*)(b + 256 * j + 4 * lane); v[j] = v[j] * rstd * gg + bb; }
}
__device__ __forceinline__ void row_modulate(f32x4 (&h)[4], const f32x4 (&v)[4], const float* sc, const float* sh, int lane) {
#pragma unroll
    for (int j = 0; j < 4; ++j) { const f32x4 s = *(const f32x4*)(sc + 256 * j + 4 * lane), t = *(const f32x4*)(sh + 256 * j + 4 * lane); h[j] = v[j] * (s + 1.0f) + t; }
}

__device__ __forceinline__ void row_ln_pre(f32x4 (&v)[4], const f32x4 (&gg)[4], const f32x4 (&bb)[4]) {
    float s = 0.f;
#pragma unroll
    for (int j = 0; j < 4; ++j) s += (v[j][0] + v[j][1]) + (v[j][2] + v[j][3]);
    const float mean = wave_sum(s) * (1.f / D); float q = 0.f;
#pragma unroll
    for (int j = 0; j < 4; ++j) { v[j] = v[j] - mean; q += (v[j][0] * v[j][0] + v[j][1] * v[j][1]) + (v[j][2] * v[j][2] + v[j][3] * v[j][3]); }
    const float rstd = rsqrtf(wave_sum(q) * (1.f / D) + LN_EPS);
#pragma unroll
    for (int j = 0; j < 4; ++j) v[j] = v[j] * rstd * gg[j] + bb[j];
}
__device__ __forceinline__ void row_load_mod(const float* sc, const float* sh, int lane, f32x4 (&s)[4], f32x4 (&t)[4]) {
#pragma unroll
    for (int j = 0; j < 4; ++j) { s[j] = *(const f32x4*)(sc + 256 * j + 4 * lane); t[j] = *(const f32x4*)(sh + 256 * j + 4 * lane); }
}
typedef const __attribute__((address_space(4))) Params* PP;
#define PIN(i) ((const float*)pp->in[i])
#define DECL_LDS extern __shared__ __attribute__((aligned(16))) unsigned char lds_raw[]
#define PHASE_FN static __device__ __forceinline__ void

__device__ __forceinline__ Frame make_frame(PP pp, unsigned char* lds_generic) {
    Frame F;
    F.lds = (LAS unsigned char*)lds_generic;
    { int t_ = threadIdx.x; asm volatile("" : "+v"(t_)); F.tid = t_; }
    F.lane = F.tid & 63; F.wave = __builtin_amdgcn_readfirstlane(F.tid >> 6);
    F.G = gridDim.x; F.bid = blockIdx.x; F.gw = F.bid * NWAVES + F.wave; F.NGW = F.G * NWAVES;
    F.ws = (unsigned char*)pp->ws; F.ctl = (unsigned*)(F.ws + WS_CTL);
    return F;
}
#define FRAME() DECL_LDS; asm volatile("" : "+s"(pp)); Frame F = make_frame(pp, lds_raw); unsigned char* ws = F.ws; (void)ws

PHASE_FN grid_bar(PP pp) {
    FRAME();
    XcdBarrier bar; bar.bar = F.ctl + CW_BAR; bar.x = xb_xcc_id(); bar.st = (volatile LAS unsigned*)(F.lds + LDS_MISC) + 8;
    xcd_barrier(bar);
}

static __device__ __forceinline__ void ln_pass(const Frame& F, float* out, float* XC, bf16* Hb, const float* lng, const float* lnb, const float* modv, const int sc_off, const int sh_off, const int TR) {
    f32x4 gg[4], bb[4];
#pragma unroll
    for (int j = 0; j < 4; ++j) { gg[j] = *(const f32x4*)(lng + 256 * j + 4 * F.lane); bb[j] = *(const f32x4*)(lnb + 256 * j + 4 * F.lane); }
    for (int r0 = F.gw; r0 < TR; r0 += 2 * F.NGW) {
        const int r1 = r0 + F.NGW; const bool two = r1 < TR;
        const bool c0 = r0 >= TL, c1 = r1 >= TL;
        float* x0 = c0 ? XC + (size_t)(r0 - TL) * D : out + (size_t)r0 * D; float* x1 = two ? (c1 ? XC + (size_t)(r1 - TL) * D : out + (size_t)r1 * D) : x0;
        const float* m0 = modv + (size_t)(c0 ? 16 : (r0 >> 12)) * 6144; const float* m1 = modv + (size_t)((two && !c1) ? (r1 >> 12) : 16) * 6144;
        f32x4 v0[4], v1[4], s0[4], t0[4], s1[4], t1[4];
        row_load(x0, F.lane, v0); row_load(x1, F.lane, v1);
        row_load_mod(m0 + sc_off, m0 + sh_off, F.lane, s0, t0); row_load_mod(m1 + sc_off, m1 + sh_off, F.lane, s1, t1);
        row_ln_pre(v0, gg, bb); row_ln_pre(v1, gg, bb);
        row_store(x0, F.lane, v0);
#pragma unroll
        for (int j = 0; j < 4; ++j) s0[j] = v0[j] * (s0[j] + 1.0f) + t0[j];
        row_store_bf16(Hb + (size_t)r0 * D, F.lane, s0);
        if (two) { row_store(x1, F.lane, v1);
#pragma unroll
            for (int j = 0; j < 4; ++j) s1[j] = v1[j] * (s1[j] + 1.0f) + t1[j];
            row_store_bf16(Hb + (size_t)r1 * D, F.lane, s1); }
    }
}
PHASE_FN ph_fold(PP pp) {
    FRAME();
    Params p; p.ws = ws; p.in[I_EV_WIN] = PIN(I_EV_WIN);
    for (int u = (F.G >= 256 ? F.bid - 128 : F.bid); u < 128; u += F.G) if (u >= 0) fold_unit(p, F, u);
}
PHASE_FN ph_mod(PP pp) {
    FRAME();
    float* MOD = (float*)(ws + WS_MOD);
    LAS float* sc = (LAS float*)F.lds;
    LAS float* part = sc + 17 * D;
    const float* cin = PIN(I_C); const float* ccin = PIN(I_CCTX);
    __syncthreads();
    for (int e = F.tid; e < 17 * D; e += NTHREADS) { const int r = e >> 10, k = e & 1023; const float v = (r < 16) ? cin[r * D + k] : ccin[k]; sc[e] = silu_f(v); }
    __syncthreads();
    for (int task = F.bid; task < DEPTH * 48; task += F.G) {
        const int l = task / 48, j0 = (task - l * 48) * 128;
        const float* W = PIN(I_WMOD) + ((size_t)l * D + F.wave * 128) * 6144 + j0 + 2 * F.lane;
        f32x2 acc[17];
#pragma unroll
        for (int r = 0; r < 17; ++r) acc[r] = (f32x2){0.f, 0.f};
        for (int k0 = 0; k0 < 128; k0 += 16) {
            f32x2 w[16];
#pragma unroll
            for (int q = 0; q < 16; ++q) w[q] = *(const f32x2*)(W + (size_t)(k0 + q) * 6144);
#pragma unroll
            for (int q4 = 0; q4 < 4; ++q4)
#pragma unroll
                for (int r = 0; r < 17; ++r) { const f32x4 sv = *(const LAS f32x4*)(sc + r * D + F.wave * 128 + k0 + 4 * q4);
                    acc[r] += (w[4 * q4] * sv[0] + w[4 * q4 + 1] * sv[1]) + (w[4 * q4 + 2] * sv[2] + w[4 * q4 + 3] * sv[3]); }
        }
        if (F.wave >= 4) {
#pragma unroll
            for (int r = 0; r < 17; ++r) *(LAS f32x2*)(part + ((F.wave - 4) * 17 + r) * 128 + 2 * F.lane) = acc[r]; }
        __syncthreads();
        if (F.wave < 4) {
#pragma unroll
            for (int r = 0; r < 17; ++r) { LAS f32x2* q = (LAS f32x2*)(part + (F.wave * 17 + r) * 128 + 2 * F.lane); *q = *q + acc[r]; } }
        __syncthreads();
        for (int o = F.tid; o < 17 * 128; o += NTHREADS) { const int r = o >> 7, j = o & 127; float v = PIN(I_BMOD)[l * 6144 + j0 + j];
#pragma unroll
            for (int w4 = 0; w4 < 4; ++w4) v += part[(w4 * 17 + r) * 128 + j];
            MOD[((size_t)l * 17 + r) * 6144 + j0 + j] = v; }
        __syncthreads();
    }
}
PHASE_FN ph_cvt(PP pp) {
    FRAME();
    Params p; p.ws = ws;
    p.in[I_EV_WIN] = PIN(I_EV_WIN); p.in[I_EV_WOUT] = PIN(I_EV_WOUT); p.in[I_EV_W1] = PIN(I_EV_W1); p.in[I_EV_W3] = PIN(I_EV_W3); p.in[I_EV_W2] = PIN(I_EV_W2);
    p.in[I_OD_WIN] = PIN(I_OD_WIN); p.in[I_WGLU] = PIN(I_WGLU); p.in[I_OD_WOUT] = PIN(I_OD_WOUT); p.in[I_MW1] = PIN(I_MW1); p.in[I_MW3] = PIN(I_MW3); p.in[I_MW2] = PIN(I_MW2);
    LAS float* scr = (LAS float*)(F.lds + F.wave * 16384);
    cvt_range<false>(pp, ws, F.gw, CVT_W2_0, F.NGW, scr, F.lane);
    cvt_range<true>(pp, ws, CVT_W2_0 + F.gw, CVT_MOE0, F.NGW, scr, F.lane);
}
PHASE_FN ph_dftmat(PP pp) {
    FRAME();
    bf16* FDm = (bf16*)(ws + WS_FD); bf16* F2 = (bf16*)(ws + WS_F256);
    for (int it = F.bid * NTHREADS + F.tid; it < 2 * 256 * 64; it += F.G * NTHREADS) {
        const int which = it >> 14, k = (it >> 6) & 255, n0 = (it & 63) * 8; const bool isq = n0 >= 256; const int nb = n0 & 255;
        float v[8];
#pragma unroll
        for (int j = 0; j < 8; ++j) { const int phs = (k * (nb + j)) & 255; float sn, cs; sincospif((float)phs * (1.0f / 128.0f), &sn, &cs);
            v[j] = which ? (isq ? -sn * (1.f / 16.f) : cs * (1.f / 16.f)) : (isq ? sn * (1.f / 64.f) : cs * (1.f / 64.f)); }
        v4u w; w.x = cvt_pk_bf16(v[0], v[1]); w.y = cvt_pk_bf16(v[2], v[3]); w.z = cvt_pk_bf16(v[4], v[5]); w.w = cvt_pk_bf16(v[6], v[7]);
        *(v4u*)((which ? F2 : FDm) + (size_t)k * 512 + n0) = w;
    }
}
PHASE_FN ph_s5mat(PP pp) {
    FRAME();
    LAS float* lam = (LAS float*)F.lds;
    LAS float* bb = lam + 2 * 64 * 17 * 2;
    LAS float* cc = bb + 2 * 64 * 16 * 2;
    LAS float* kt = cc + 2 * 16 * 64 * 2;
    for (int unit = (F.G >= 256 ? F.bid - 64 : F.bid); unit < 64; unit += F.G) {
        if (unit < 0) continue;
        const int li = unit >> 5, g = unit & 31;
        __syncthreads();
        if (F.tid < 128) { const int d = F.tid >> 6, pl = F.tid & 63; const int sidx = ((li * 2 + d) * 32 + g);
            const float are = PIN(I_A_RE)[sidx * 64 + pl], aim = PIN(I_A_IM)[sidx * 64 + pl], dt = expf(PIN(I_LOG_DT)[sidx]);
            for (int e = 0; e <= 16; ++e) { const float mag = expf(are * dt * (float)e); float sn, cn; sincosf(aim * dt * (float)e, &sn, &cn); lam[((d * 64 + pl) * 17 + e) * 2] = mag * cn; lam[((d * 64 + pl) * 17 + e) * 2 + 1] = mag * sn; } }
        __syncthreads();
        for (int e = F.tid; e < 2048; e += NTHREADS) { const int d = e >> 10, pl = (e >> 4) & 63, sp = e & 15; const int sidx = ((li * 2 + d) * 32 + g);
            const float are = PIN(I_A_RE)[sidx * 64 + pl], aim = PIN(I_A_IM)[sidx * 64 + pl];
            const float lre = lam[((d * 64 + pl) * 17 + 1) * 2], lim = lam[((d * 64 + pl) * 17 + 1) * 2 + 1];
            const float den = 1.0f / (are * are + aim * aim);
            const float fre = ((lre - 1.0f) * are + lim * aim) * den, fim = (lim * are - (lre - 1.0f) * aim) * den;
            const float br = PIN(I_B_RE)[((size_t)sidx * 64 + pl) * 16 + sp], bi = PIN(I_B_IM)[((size_t)sidx * 64 + pl) * 16 + sp];
            bb[e * 2] = fre * br - fim * bi; bb[e * 2 + 1] = fre * bi + fim * br; }
        for (int e = F.tid; e < 2048; e += NTHREADS) { const int d = e >> 10, sq = (e >> 6) & 15, pl = e & 63; const int sidx = ((li * 2 + d) * 32 + g);
            cc[e * 2] = PIN(I_C_RE)[((size_t)sidx * 16 + sq) * 64 + pl]; cc[e * 2 + 1] = PIN(I_C_IM)[((size_t)sidx * 16 + sq) * 64 + pl]; }
        __syncthreads();
        for (int e = F.tid; e < 8192; e += NTHREADS) { const int d = e >> 12, tau = (e >> 8) & 15, sq = (e >> 4) & 15, sp = e & 15; float acc = 0.f;
            for (int pl = 0; pl < 64; ++pl) { const float cr = cc[((d * 16 + sq) * 64 + pl) * 2], ci = cc[((d * 16 + sq) * 64 + pl) * 2 + 1];
                const float lr = lam[((d * 64 + pl) * 17 + tau) * 2], lj = lam[((d * 64 + pl) * 17 + tau) * 2 + 1];
                const float br = bb[((d * 64 + pl) * 16 + sp) * 2], bi = bb[((d * 64 + pl) * 16 + sp) * 2 + 1];
                const float tr = cr * lr - ci * lj, ti = cr * lj + ci * lr;
                acc += tr * br - ti * bi; }
            kt[e] = acc; }
        __syncthreads();
        bf16* WA = (bf16*)(ws + WS_S5M + (size_t)unit * S5M_STRIDE); bf16* CLm = WA + 512 * 256;
        const float* dsk = PIN(I_SSM_D) + (size_t)li * 512 + g * 16;
        for (int it = F.tid; it < 8192; it += NTHREADS) { const int row = it >> 5, c0 = (it & 31) * 8;
            float v[8];
            { const int i = row >> 4, sq = row & 15, j = c0 >> 4, sp0 = c0 & 15;
#pragma unroll
              for (int q = 0; q < 8; ++q) { const int sp = sp0 + q; float a = 0.f; if (i >= j) a += kt[((0 * 16 + (i - j)) * 16 + sq) * 16 + sp]; if (j >= i) a += kt[((1 * 16 + (j - i)) * 16 + sq) * 16 + sp]; if (i == j && sq == sp) a += dsk[sq]; v[q] = a; }
              v4u w; w.x = cvt_pk_bf16(v[0], v[1]); w.y = cvt_pk_bf16(v[2], v[3]); w.z = cvt_pk_bf16(v[4], v[5]); w.w = cvt_pk_bf16(v[6], v[7]); *(v4u*)(WA + (size_t)row * 256 + c0) = w; }
            { const int d = row >> 7, pl = (row >> 1) & 63, ri = row & 1, j = c0 >> 4, sp0 = c0 & 15, e = d ? j : 15 - j;
              const float lr = lam[((d * 64 + pl) * 17 + e) * 2], lj = lam[((d * 64 + pl) * 17 + e) * 2 + 1];
#pragma unroll
              for (int q = 0; q < 8; ++q) { const float br = bb[((d * 64 + pl) * 16 + sp0 + q) * 2], bi = bb[((d * 64 + pl) * 16 + sp0 + q) * 2 + 1]; v[q] = ri ? (lr * bi + lj * br) : (lr * br - lj * bi); }
              v4u w; w.x = cvt_pk_bf16(v[0], v[1]); w.y = cvt_pk_bf16(v[2], v[3]); w.z = cvt_pk_bf16(v[4], v[5]); w.w = cvt_pk_bf16(v[6], v[7]); *(v4u*)(WA + (size_t)(256 + row) * 256 + c0) = w; }
            { const int i = row >> 4, sq = row & 15, d = c0 >> 7, pl0 = (c0 >> 1) & 63, e = d ? 16 - i : i + 1;
#pragma unroll
              for (int q = 0; q < 4; ++q) { const int pl = pl0 + q; const float cr = cc[((d * 16 + sq) * 64 + pl) * 2], ci = cc[((d * 16 + sq) * 64 + pl) * 2 + 1];
                  const float lr = lam[((d * 64 + pl) * 17 + e) * 2], lj = lam[((d * 64 + pl) * 17 + e) * 2 + 1];
                  v[2 * q] = cr * lr - ci * lj; v[2 * q + 1] = -(cr * lj + ci * lr); }
              v4u w; w.x = cvt_pk_bf16(v[0], v[1]); w.y = cvt_pk_bf16(v[2], v[3]); w.z = cvt_pk_bf16(v[4], v[5]); w.w = cvt_pk_bf16(v[6], v[7]); *(v4u*)(CLm + (size_t)row * 256 + c0) = w; }
        }
    }
    __syncthreads();
}
PHASE_FN ph_pro_b(PP pp) {
    FRAME();
    const float* MOD = (const float*)(ws + WS_MOD); bf16* Hb = (bf16*)(ws + WS_H); bf16* XB = (bf16*)(ws + WS_XB);
    const float* xin = PIN(I_X); const float* cin = PIN(I_CTX);
    static_assert(T % (2 * 256 * NWAVES) == 0 && TL % (2 * 256 * NWAVES) == 0, "row pairs");
    for (int r0 = F.gw; r0 < T; r0 += 2 * F.NGW) {
        const int r1 = r0 + F.NGW; const bool c0 = r0 >= TL, c1 = r1 >= TL;
        const float* x0 = c0 ? cin + (size_t)(r0 - TL) * D : xin + (size_t)r0 * D; const float* x1 = c1 ? cin + (size_t)(r1 - TL) * D : xin + (size_t)r1 * D;
        const float* m0 = MOD + (size_t)(c0 ? 16 : (r0 >> 12)) * 6144; const float* m1 = MOD + (size_t)(c1 ? 16 : (r1 >> 12)) * 6144;
        f32x4 v0[4], v1[4], s0[4], t0[4], s1[4], t1[4];
        row_load(x0, F.lane, v0); row_load(x1, F.lane, v1); row_load_mod(m0 + 1024, m0, F.lane, s0, t0); row_load_mod(m1 + 1024, m1, F.lane, s1, t1);
        row_store_bf16(XB + (size_t)r0 * D, F.lane, v0); row_store_bf16(XB + (size_t)r1 * D, F.lane, v1);
#pragma unroll
        for (int j = 0; j < 4; ++j) { s0[j] = v0[j] * (s0[j] + 1.0f) + t0[j]; s1[j] = v1[j] * (s1[j] + 1.0f) + t1[j]; }
        row_store_bf16(Hb + (size_t)r0 * D, F.lane, s0); row_store_bf16(Hb + (size_t)r1 * D, F.lane, s1);
    }
}

PHASE_FN ph_e1(PP pp, int layer) {
    FRAME();
    unsigned char* evw = ws + WS_EV + (layer >> 1) * EV_STRIDE; unsigned char* BIG = ws + WS_BIG;
    SchedEvIn S{F.G, F.bid, (const char*)(ws + WS_H), (const char*)(evw + EV_WQKV), (const char*)(evw + EV_WPQ), (char*)(BIG + BIG_QKV), (char*)(BIG + BIG_PQT), (char*)(BIG + BIG_PQTC)};
    pg8::gemm_phase<pg8::EpiStore, SchedEvIn, true, true>(F.lds, F.tid, pg8::Dims{D, D, D}, S, pg8::EpiStore{});
}
template <class TT> struct cfT { TT r, i; };
typedef cfT<float> cf;
template <class TT, class WW> __device__ __forceinline__ cfT<TT> cmul(cfT<TT> a, WW wr, WW wi) { return cfT<TT>{a.r * wr - a.i * wi, a.r * wi + a.i * wr}; }
template <class TT> __device__ __forceinline__ void radix4(cfT<TT> x0, cfT<TT> x1, cfT<TT> x2, cfT<TT> x3, cfT<TT>& y0, cfT<TT>& y1, cfT<TT>& y2, cfT<TT>& y3) {
    const cfT<TT> s02{x0.r + x2.r, x0.i + x2.i}, d02{x0.r - x2.r, x0.i - x2.i}, s13{x1.r + x3.r, x1.i + x3.i}, d13{x1.r - x3.r, x1.i - x3.i};
    y0 = cfT<TT>{s02.r + s13.r, s02.i + s13.i}; y2 = cfT<TT>{s02.r - s13.r, s02.i - s13.i}; y1 = cfT<TT>{d02.r + d13.i, d02.i - d13.r}; y3 = cfT<TT>{d02.r - d13.i, d02.i + d13.r};
}
template <class TT> __device__ __forceinline__ void fft16(cfT<TT> (&x)[16]) {
    constexpr float C1 = 0.92387953251128674f, S1 = 0.38268343236508977f, C2 = 0.70710678118654752f;
    cfT<TT> A[4][4];
#pragma unroll
    for (int b = 0; b < 4; ++b) radix4(x[b], x[4 + b], x[8 + b], x[12 + b], A[b][0], A[b][1], A[b][2], A[b][3]);
    A[1][1] = cmul(A[1][1], C1, -S1); A[1][2] = cmul(A[1][2], C2, -C2); A[1][3] = cmul(A[1][3], S1, -C1);
    A[2][1] = cmul(A[2][1], C2, -C2); A[2][2] = cfT<TT>{A[2][2].i, -A[2][2].r}; A[2][3] = cmul(A[2][3], -C2, -C2);
    A[3][1] = cmul(A[3][1], S1, -C1); A[3][2] = cmul(A[3][2], -C2, -C2); A[3][3] = cmul(A[3][3], -C1, S1);
#pragma unroll
    for (int c = 0; c < 4; ++c) radix4(A[0][c], A[1][c], A[2][c], A[3][c], x[c], x[c + 4], x[c + 8], x[c + 12]);
}
PHASE_FN ph_e2_fft(PP pp) {
    FRAME();
    const bf16* PQT = (const bf16*)(ws + WS_BIG + BIG_PQT); bf16* VB = (bf16*)(ws + WS_H);
    for (int it = F.bid * NTHREADS + F.tid; it < NBATCH * 512 * 128; it += F.G * NTHREADS) {
        const int n1 = (it & 127) * 2, ch = (it >> 7) & 511, b = it >> 16;
        const bf16* pp_ = PQT + ((size_t)(b * 512 + ch) * 2) * 4096 + n1; const bf16* qq_ = pp_ + 4096;
        unsigned pw[16], qw[16];
#pragma unroll
        for (int n2 = 0; n2 < 16; ++n2) { pw[n2] = *(const unsigned*)(pp_ + 256 * n2); qw[n2] = *(const unsigned*)(qq_ + 256 * n2); }
        unsigned ore[16], oim[16];
        {
            cfT<f32x2> x[16];
#pragma unroll
            for (int n2 = 0; n2 < 16; ++n2) { x[n2].r = (f32x2){bflo(pw[n2]), bfhi(pw[n2])}; x[n2].i = -(f32x2){bflo(qw[n2]), bfhi(qw[n2])}; }
            fft16(x);
            float sn0, cs0, sn1, cs1; sincospif((float)n1 * (1.0f / 2048.0f), &sn0, &cs0); sincospif((float)(n1 + 1) * (1.0f / 2048.0f), &sn1, &cs1);
            const f32x2 cs = (f32x2){cs0, cs1}, msn = -(f32x2){sn0, sn1};
            cfT<f32x2> wk{cs, msn};
#pragma unroll
            for (int k2 = 1; k2 < 16; ++k2) { x[k2] = cmul(x[k2], wk.r, wk.i); wk = cmul(wk, cs, msn); }
#pragma unroll
            for (int k2 = 0; k2 < 16; ++k2) { ore[k2] = cvt_pk_bf16(x[k2].r[0], x[k2].r[1]); oim[k2] = cvt_pk_bf16(x[k2].i[0], x[k2].i[1]); }
        }
#pragma unroll
        for (int k2 = 0; k2 < 16; ++k2) { bf16* dst = VB + (((size_t)b * 16 + k2) * 512 + ch) * 512 + n1; *(unsigned*)dst = ore[k2]; *(unsigned*)(dst + 256) = oim[k2]; }
    }
}
PHASE_FN ph_e2_dft(PP pp) {
    FRAME();
    unsigned char* BIG = ws + WS_BIG;
    SchedDft S{F.G, F.bid, (const char*)(ws + WS_FD), (const char*)(ws + WS_H), (const char*)(ws + WS_F256), (const char*)(BIG + BIG_PQTC), (char*)(BIG + BIG_MIX)};
    pg8::gemm_phase<pg8::EpiStore, SchedDft, true, true>(F.lds, F.tid, pg8::Dims{512, 512, 512}, S, pg8::EpiStore{});
}
PHASE_FN ph_e2_rope(PP pp) {
    FRAME();
    bf16* QKV = (bf16*)(ws + WS_BIG + BIG_QKV);
    LAS f32x2* cs = (LAS f32x2*)F.lds;
    __syncthreads();
    for (int e = F.tid; e < 1024; e += NTHREADS) { const int pos = e >> 4, i = e & 15; const float inv = powf(10000.0f, -(float)i / 16.0f); float s, c; sincosf((float)pos * inv, &s, &c); cs[e] = (f32x2){c, s}; }
    __syncthreads();
    for (int it = F.bid * NTHREADS + F.tid; it < TL * 10; it += F.G * NTHREADS) {
        const int r = it / 10, hh = it - r * 10, n = r & 4095;
        v4u* base = (v4u*)(QKV + (size_t)r * 768 + hh * 64);
        v4u v[8];
#pragma unroll
        for (int k = 0; k < 8; ++k) v[k] = base[k];
#pragma unroll
        for (int ax = 0; ax < 2; ++ax) { const int pos = ax ? (n & 63) : (n >> 6);
#pragma unroll
            for (int k = 0; k < 2; ++k) { unsigned* a = (unsigned*)&v[4 * ax + k]; unsigned* b = (unsigned*)&v[4 * ax + 2 + k];
#pragma unroll
                for (int q = 0; q < 4; ++q) { const f32x2 t0 = cs[pos * 16 + 8 * k + 2 * q], t1 = cs[pos * 16 + 8 * k + 2 * q + 1];
                    const float x1l = bflo(a[q]), x1h = bfhi(a[q]), x2l = bflo(b[q]), x2h = bfhi(b[q]);
                    a[q] = cvt_pk_bf16(x1l * t0.x - x2l * t0.y, x1h * t1.x - x2h * t1.y); b[q] = cvt_pk_bf16(x1l * t0.y + x2l * t0.x, x1h * t1.y + x2h * t1.x); } } }
#pragma unroll
        for (int k = 0; k < 8; ++k) base[k] = v[k];
    }
    bf16* VT = (bf16*)(ws + WS_BIG + BIG_VT);
    for (int it = F.bid * NTHREADS + F.tid; it < NBATCH * 2 * 544 * 64; it += F.G * NTHREADS) {
        const int d = it & 63, kg = (it >> 6) % 544, bh = (it >> 6) / 544, b = bh >> 1, hkv = bh & 1;
        const int key0 = kg * 8; const size_t row0 = (key0 < 256) ? ((size_t)TL + (size_t)b * 256 + key0) : ((size_t)b * 4096 + (key0 - 256));
        const bf16* src = QKV + row0 * 768 + 640 + hkv * 64 + d;
        unsigned short v[8];
#pragma unroll
        for (int j = 0; j < 8; ++j) v[j] = src[(size_t)j * 768];
        v4u w; w.x = v[0] | ((unsigned)v[1] << 16); w.y = v[2] | ((unsigned)v[3] << 16); w.z = v[4] | ((unsigned)v[5] << 16); w.w = v[6] | ((unsigned)v[7] << 16);
        *(v4u*)(VT + ((size_t)bh * 64 + d) * 4352 + key0) = w;
    }
    __syncthreads();
}
typedef float f32x16 __attribute__((ext_vector_type(16)));
typedef __bf16 bf16x2v __attribute__((ext_vector_type(2)));
__device__ __forceinline__ unsigned pk_bf16(float a, float b) { const bf16x2v t = __builtin_convertvector((f32x2){a, b}, bf16x2v); return __builtin_bit_cast(unsigned, t); }
constexpr int AT_KP = 144, AT_VP1 = 648, AT_VP2 = 520, AT_VOFF = 320 * AT_KP;
template <bool MASKED>
__device__ __forceinline__ void attn_tile(const LAS unsigned char* Ks, const LAS unsigned char* Vs, const int vpitch, const int kl_base, const bf16x8 (&qf)[4], f32x16& o0, f32x16& o1, float& m, float& l,
                                          const int r, const int h, const int kj0, const int qi) {
    f32x16 x;
#pragma unroll
    for (int i = 0; i < 16; ++i) x[i] = 0.f;
#pragma unroll
    for (int s = 0; s < 4; ++s) { const bf16x8 kf = *(const LAS bf16x8*)(Ks + (kl_base + r) * AT_KP + (16 * s + 8 * h) * 2); x = __builtin_amdgcn_mfma_f32_32x32x16_bf16(kf, qf[s], x, 0, 0, 0); }
    constexpr float CS = 0.125f * 1.4426950408889634f;
    float sc[16]; float mt = -1e30f;
#pragma unroll
    for (int i = 0; i < 16; ++i) { float v = x[i];
        if (MASKED) { const int kj = kj0 + (i & 3) + 8 * (i >> 2) + 4 * h; const bool ok = (kj >= 0) && (kj < SEQ) && (kj - qi <= 128) && (qi - kj <= 128); v = ok ? v : -1e30f; }
        sc[i] = v; mt = fmaxf(mt, v); }
    mt = fmaxf(mt, __shfl_xor(mt, 32));
    const float mn = fmaxf(m, mt * CS), alpha = __builtin_amdgcn_exp2f(m - mn); m = mn;
    f32x2 ps2 = (f32x2){0.f, 0.f};
#pragma unroll
    for (int i = 0; i < 16; i += 2) { const f32x2 t = (f32x2){sc[i], sc[i + 1]} * CS - mn; const f32x2 p = (f32x2){__builtin_amdgcn_exp2f(t[0]), __builtin_amdgcn_exp2f(t[1])}; sc[i] = p[0]; sc[i + 1] = p[1]; ps2 += p; }
    l = l * alpha + (ps2[0] + ps2[1]);
    if (__any(alpha != 1.0f)) { o0 = o0 * alpha; o1 = o1 * alpha; }
#pragma unroll
    for (int s2 = 0; s2 < 2; ++s2) {
        v4u pw; pw.x = pk_bf16(sc[8 * s2 + 0], sc[8 * s2 + 1]); pw.y = pk_bf16(sc[8 * s2 + 2], sc[8 * s2 + 3]); pw.z = pk_bf16(sc[8 * s2 + 4], sc[8 * s2 + 5]); pw.w = pk_bf16(sc[8 * s2 + 6], sc[8 * s2 + 7]);
        const bf16x8 pk = __builtin_bit_cast(bf16x8, pw);
        { const LAS unsigned char* vp = Vs + r * vpitch + (kl_base + 16 * s2 + 4 * h) * 2; const v2u lo = *(const LAS v2u*)vp, hi = *(const LAS v2u*)(vp + 16);
          v4u vw; vw.x = lo.x; vw.y = lo.y; vw.z = hi.x; vw.w = hi.y; o0 = __builtin_amdgcn_mfma_f32_32x32x16_bf16(__builtin_bit_cast(bf16x8, vw), pk, o0, 0, 0, 0); }
        { const LAS unsigned char* vp = Vs + (32 + r) * vpitch + (kl_base + 16 * s2 + 4 * h) * 2; const v2u lo = *(const LAS v2u*)vp, hi = *(const LAS v2u*)(vp + 16);
          v4u vw; vw.x = lo.x; vw.y = lo.y; vw.z = hi.x; vw.w = hi.y; o1 = __builtin_amdgcn_mfma_f32_32x32x16_bf16(__builtin_bit_cast(bf16x8, vw), pk, o1, 0, 0, 0); }
    }
}
template <bool MASKED>
__device__ __forceinline__ void attn_tile2(const LAS unsigned char* Ks, const LAS unsigned char* Vs, const int vpitch, const int kl_base, const bf16x8 (&qf)[4], f32x16& o0, f32x16& o1, float& m, float& l,
                                           const int r, const int h, const int kj0, const int qi) {
    f32x16 xa, xb;
#pragma unroll
    for (int i = 0; i < 16; ++i) { xa[i] = 0.f; xb[i] = 0.f; }
#pragma unroll
    for (int s = 0; s < 4; ++s) { const bf16x8 ka = *(const LAS bf16x8*)(Ks + (kl_base + r) * AT_KP + (16 * s + 8 * h) * 2), kb = *(const LAS bf16x8*)(Ks + (kl_base + 32 + r) * AT_KP + (16 * s + 8 * h) * 2);
        xa = __builtin_amdgcn_mfma_f32_32x32x16_bf16(ka, qf[s], xa, 0, 0, 0); xb = __builtin_amdgcn_mfma_f32_32x32x16_bf16(kb, qf[s], xb, 0, 0, 0); }
    constexpr float CS = 0.125f * 1.4426950408889634f;
    float sc[32]; float mt = -1e30f;
#pragma unroll
    for (int i = 0; i < 32; ++i) { float v = (i < 16) ? xa[i & 15] : xb[i & 15];
        if (MASKED) { const int kj = kj0 + 32 * (i >> 4) + (i & 3) + 8 * ((i & 15) >> 2) + 4 * h; const bool ok = (kj >= 0) && (kj < SEQ) && (kj - qi <= 128) && (qi - kj <= 128); v = ok ? v : -1e30f; }
        sc[i] = v; mt = fmaxf(mt, v); }
    mt = fmaxf(mt, __shfl_xor(mt, 32));
    const float mn = fmaxf(m, mt * CS), alpha = __builtin_amdgcn_exp2f(m - mn); m = mn;
    f32x2 ps2 = (f32x2){0.f, 0.f};
#pragma unroll
    for (int i = 0; i < 32; i += 2) { const f32x2 t = (f32x2){sc[i], sc[i + 1]} * CS - mn; const f32x2 p = (f32x2){__builtin_amdgcn_exp2f(t[0]), __builtin_amdgcn_exp2f(t[1])}; sc[i] = p[0]; sc[i + 1] = p[1]; ps2 += p; }
    l = l * alpha + (ps2[0] + ps2[1]);
    if (__any(alpha != 1.0f)) { o0 = o0 * alpha; o1 = o1 * alpha; }
#pragma unroll
    for (int tt = 0; tt < 2; ++tt)
#pragma unroll
        for (int s2 = 0; s2 < 2; ++s2) { const int b = 16 * tt + 8 * s2;
            v4u pw; pw.x = pk_bf16(sc[b + 0], sc[b + 1]); pw.y = pk_bf16(sc[b + 2], sc[b + 3]); pw.z = pk_bf16(sc[b + 4], sc[b + 5]); pw.w = pk_bf16(sc[b + 6], sc[b + 7]);
            const bf16x8 pk = __builtin_bit_cast(bf16x8, pw);
            { const LAS unsigned char* vp = Vs + r * vpitch + (kl_base + 32 * tt + 16 * s2 + 4 * h) * 2; const v2u lo = *(const LAS v2u*)vp, hi = *(const LAS v2u*)(vp + 16);
              v4u vw; vw.x = lo.x; vw.y = lo.y; vw.z = hi.x; vw.w = hi.y; o0 = __builtin_amdgcn_mfma_f32_32x32x16_bf16(__builtin_bit_cast(bf16x8, vw), pk, o0, 0, 0, 0); }
            { const LAS unsigned char* vp = Vs + (32 + r) * vpitch + (kl_base + 32 * tt + 16 * s2 + 4 * h) * 2; const v2u lo = *(const LAS v2u*)vp, hi = *(const LAS v2u*)(vp + 16);
              v4u vw; vw.x = lo.x; vw.y = lo.y; vw.z = hi.x; vw.w = hi.y; o1 = __builtin_amdgcn_mfma_f32_32x32x16_bf16(__builtin_bit_cast(bf16x8, vw), pk, o1, 0, 0, 0); }
        }
}
PHASE_FN ph_e3_attn(PP pp, int layer) {
    FRAME();
    const bf16* QKV = (const bf16*)(ws + WS_BIG + BIG_QKV); bf16* MIX = (bf16*)(ws + WS_BIG + BIG_MIX); const bf16* VT = (const bf16*)(ws + WS_BIG + BIG_VT);
    const float* sinkp = PIN(I_EV_SINK) + (layer >> 1) * 8;
    LAS unsigned char* Ks = F.lds; LAS unsigned char* Vs = F.lds + AT_VOFF;
    const int r = F.lane & 31, h = F.lane >> 5, g = F.wave >> 1, th = F.wave & 1;
    constexpr int NU = 2048 + 128;
#define AT_DECODE(u_, isc_, b_, hkv_, n0_) do { isc_ = (u_) >= 2048; if (!isc_) { b_ = (u_) >> 7; hkv_ = ((u_) >> 6) & 1; n0_ = ((u_) & 63) * 64; } else { const int v_ = (u_) - 2048; b_ = v_ >> 3; hkv_ = (v_ >> 2) & 1; n0_ = (v_ & 3) * 64; } } while (0)
#define AT_LOAD1(b_, hkv_, n0_) do { int tl_ = F.tid; asm volatile("" : "+v"(tl_));   _Pragma("unroll") for (int k_ = 0; k_ < 5; ++k_) { const int pc = tl_ + k_ * NTHREADS; \
        { const int kl = pc >> 3, c8 = pc & 7, kj = (n0_) - 128 + kl; rk[k_] = (v4u){0u, 0u, 0u, 0u}; if (kj >= 0 && kj < SEQ) rk[k_] = *(const v4u*)(QKV + ((size_t)(b_) * 4096 + kj) * 768 + 512 + (hkv_) * 64 + c8 * 8); } \
        { const int d = pc / 40, c = pc - d * 40, kj = (n0_) - 128 + c * 8; rv[k_] = (v4u){0u, 0u, 0u, 0u}; if (kj >= 0 && kj < SEQ) rv[k_] = *(const v4u*)(VT + ((size_t)((b_) * 2 + (hkv_)) * 64 + d) * 4352 + 256 + kj); } } } while (0)
#define AT_STORE1() do { int tl_ = F.tid; asm volatile("" : "+v"(tl_));   _Pragma("unroll") for (int k_ = 0; k_ < 5; ++k_) { const int pc = tl_ + k_ * NTHREADS; \
        { const int kl = pc >> 3, c8 = pc & 7; *(LAS v4u*)(Ks + kl * AT_KP + c8 * 16) = rk[k_]; } \
        { const int d = pc / 40, c = pc - d * 40; LAS v2u* dst = (LAS v2u*)(Vs + d * AT_VP1 + c * 16); dst[0] = (v2u){rv[k_].x, rv[k_].y}; dst[1] = (v2u){rv[k_].z, rv[k_].w}; } } } while (0)
#define AT_LOAD2(b_, hkv_) do { int tl_ = F.tid; asm volatile("" : "+v"(tl_));   _Pragma("unroll") for (int k_ = 0; k_ < 4; ++k_) { const int pc = tl_ + k_ * NTHREADS; \
        { const int j = pc >> 3, c8 = pc & 7; ck[k_] = *(const v4u*)(QKV + ((size_t)TL + (size_t)(b_) * 256 + j) * 768 + 512 + (hkv_) * 64 + c8 * 8); } \
        { const int d = pc >> 5, c = pc & 31; cv[k_] = *(const v4u*)(VT + ((size_t)((b_) * 2 + (hkv_)) * 64 + d) * 4352 + c * 8); } } } while (0)
#define AT_STORE2() do { int tl_ = F.tid; asm volatile("" : "+v"(tl_));   _Pragma("unroll") for (int k_ = 0; k_ < 4; ++k_) { const int pc = tl_ + k_ * NTHREADS; \
        { const int j = pc >> 3, c8 = pc & 7; *(LAS v4u*)(Ks + j * AT_KP + c8 * 16) = ck[k_]; } \
        { const int d = pc >> 5, c = pc & 31; LAS v2u* dst = (LAS v2u*)(Vs + d * AT_VP2 + c * 16); dst[0] = (v2u){cv[k_].x, cv[k_].y}; dst[1] = (v2u){cv[k_].z, cv[k_].w}; } } } while (0)
    v4u rk[5], rv[5], ck[4], cv[4];
    int u = F.G - 1 - F.bid;
    if (u < NU) { bool isc; int b, hkv, n0; AT_DECODE(u, isc, b, hkv, n0); if (!isc) AT_LOAD1(b, hkv, n0); }
    for (; u < NU; u += F.G) {
        bool isc; int b, hkv, n0; AT_DECODE(u, isc, b, hkv, n0);
        const size_t qrow = isc ? ((size_t)TL + (size_t)b * 256 + n0 + 32 * th + r) : ((size_t)b * 4096 + n0 + 32 * th + r);
        bf16x8 qf[4];
#pragma unroll
        for (int s = 0; s < 4; ++s) qf[s] = *(const bf16x8*)(QKV + qrow * 768 + (hkv * 4 + g) * 64 + 16 * s + 8 * h);
        float m = sinkp[hkv * 4 + g] * 1.4426950408889634f, l = (h == 0) ? 1.0f : 0.0f;
        f32x16 o0, o1;
#pragma unroll
        for (int i = 0; i < 16; ++i) { o0[i] = 0.f; o1[i] = 0.f; }
        __syncthreads();
        if (!isc) AT_STORE1();
        AT_LOAD2(b, hkv);
        if (!isc) {
            __syncthreads();
            const int qi = n0 + 32 * th + r;
#pragma unroll 1
            for (int t = 0; t < 8; t += 2) { const int klb = 32 * th + 32 * t, kj0 = n0 - 128 + klb;
                if (t >= 2 && kj0 >= 0 && kj0 + 63 < SEQ) attn_tile2<false>(Ks, Vs, AT_VP1, klb, qf, o0, o1, m, l, r, h, 0, 0);
                else { attn_tile<true>(Ks, Vs, AT_VP1, klb, qf, o0, o1, m, l, r, h, kj0, qi); attn_tile<true>(Ks, Vs, AT_VP1, klb + 32, qf, o0, o1, m, l, r, h, kj0 + 32, qi); } }
            { const int klb = 32 * th + 256, kj0 = n0 - 128 + klb; attn_tile<true>(Ks, Vs, AT_VP1, klb, qf, o0, o1, m, l, r, h, kj0, qi); }
            __syncthreads();
        }
        AT_STORE2();
        { const int un = u + F.G; if (un < NU) { bool iscn; int bn, hkvn, n0n; AT_DECODE(un, iscn, bn, hkvn, n0n); if (!iscn) AT_LOAD1(bn, hkvn, n0n); } }
        __syncthreads();
#pragma unroll 1
        for (int t = 0; t < 8; t += 2) attn_tile2<false>(Ks, Vs, AT_VP2, 32 * t, qf, o0, o1, m, l, r, h, 0, 0);
        const float inv = 1.0f / (l + __shfl_xor(l, 32));
        bf16* orow = MIX + qrow * D + 512 + (hkv * 4 + g) * 64 + 4 * h;
#pragma unroll
        for (int q4 = 0; q4 < 4; ++q4) {
            v2u w0; w0.x = pk_bf16(o0[4 * q4 + 0] * inv, o0[4 * q4 + 1] * inv); w0.y = pk_bf16(o0[4 * q4 + 2] * inv, o0[4 * q4 + 3] * inv); *(v2u*)(orow + 8 * q4) = w0;
            v2u w1; w1.x = pk_bf16(o1[4 * q4 + 0] * inv, o1[4 * q4 + 1] * inv); w1.y = pk_bf16(o1[4 * q4 + 2] * inv, o1[4 * q4 + 3] * inv); *(v2u*)(orow + 32 + 8 * q4) = w1;
        }
    }
#undef AT_DECODE
#undef AT_LOAD1
#undef AT_STORE1
#undef AT_LOAD2
#undef AT_STORE2
    __syncthreads();
}
PHASE_FN ph_outproj(PP pp, int layer) {
    FRAME();
    const int li = layer >> 1; const bool odd = (layer & 1) != 0;
    const int TR = (layer == DEPTH - 1) ? TL : T;
    const char* W = odd ? (const char*)(ws + WS_OD + li * OD_STRIDE + OD_WOUT) : (const char*)(ws + WS_EV + li * EV_STRIDE + EV_WOUT);
    const float* modl = (const float*)(ws + WS_MOD) + (size_t)layer * 17 * 6144;
    SchedResid S{F.G, F.bid, (TR / 256) * 4, (const char*)(ws + WS_BIG + BIG_MIX), (size_t)256 * D * 2, W, (size_t)256 * D * 2, (bf16*)(ws + WS_XB), modl + 2048};
    pg8::EpiResidLN E{PIN(I_LNG) + (size_t)(layer * 2) * D, PIN(I_LNB) + (size_t)(layer * 2) * D, 2048, 1024, (bf16*)(ws + WS_H), F.ctl + CW_LN + (layer * 2) * LN_SITE_WORDS,
                      (unsigned long long*)(ws + WS_XS), F.ctl + 2, F.lds + LDS_LNTAB, 1.0f, false};
    pg8::gemm_phase<pg8::EpiResidLN, SchedResid, true, true>(F.lds, F.tid, pg8::Dims{D, D, D}, S, E);
}
PHASE_FN ph_e6(PP pp, int layer) {
    FRAME();
    unsigned char* evw = ws + WS_EV + (layer >> 1) * EV_STRIDE;
    SchedStd S{22, (T / 256) * 22, F.G, F.bid, (const char*)(ws + WS_H), (const char*)(evw + EV_W13), (char*)(ws + WS_BIG + BIG_HID), (size_t)256 * D * 2, (size_t)256 * D * 2, (size_t)22 * 32768, (size_t)32768, FFH, 1 << 30};
    pg8::gemm_phase<pg8::EpiSwiGLU8D, SchedStd, true, true>(F.lds, F.tid, pg8::Dims{D, D, D}, S, pg8::EpiSwiGLU8D{});
}
PHASE_FN ph_e7(PP pp, int layer) {
    FRAME();
    unsigned char* evw = ws + WS_EV + (layer >> 1) * EV_STRIDE;
    const float* modl = (const float*)(ws + WS_MOD) + (size_t)layer * 17 * 6144;
    SchedResid S{F.G, F.bid, (T / 256) * 4, (const char*)(ws + WS_BIG + BIG_HID), (size_t)22 * 32768, (const char*)(evw + EV_W2), (size_t)256 * FFH, (bf16*)(ws + WS_XB), modl + 5120};
    pg8::EpiResidLN E{PIN(I_LNG) + (size_t)(layer * 2 + 1) * D, PIN(I_LNB) + (size_t)(layer * 2 + 1) * D, 17 * 6144 + 1024 - 5120, 17 * 6144 - 5120, (bf16*)(ws + WS_H), F.ctl + CW_LN + (layer * 2 + 1) * LN_SITE_WORDS,
                      (unsigned long long*)(ws + WS_XS), F.ctl + 2, F.lds + LDS_LNTAB, 1.0f / (Q_HID * Q_W), false};
    pg8::gemm_phase<pg8::EpiResidLN, SchedResid, true, true, pg8::AMapHid, true>(F.lds, F.tid, pg8::Dims{FFH, FFH, FFH}, S, E, pg8::AMapHid{});
}

PHASE_FN ph_o1(PP pp, int layer) {
    FRAME();
    unsigned char* odw = ws + WS_OD + (layer >> 1) * OD_STRIDE;
    SchedO1 S{F.G, F.bid, (const char*)(ws + WS_H), (const char*)(odw + OD_WIN), (char*)(ws + WS_BIG + BIG_P), (char*)(ws + WS_BIG + BIG_UG)};
    pg8::gemm_phase<pg8::EpiStore, SchedO1, true, true>(F.lds, F.tid, pg8::Dims{D, D, D}, S, pg8::EpiStore{});
}
PHASE_FN ph_o2_s5a(PP pp, int layer) {
    FRAME();
    const int li = layer >> 1;
    SchedS5A S{F.G, F.bid, (const char*)(ws + WS_BIG + BIG_UG), (const char*)(ws + WS_S5M + (size_t)li * 32 * S5M_STRIDE), (char*)(ws + WS_H + 68 * MiB), (char*)(ws + WS_H)};
    pg8::gemm_phase<pg8::EpiStore, SchedS5A, true, true, pg8::AMapStd, false, false>(F.lds, F.tid, pg8::Dims{256, 256, 256}, S, pg8::EpiStore{});
}
PHASE_FN ph_o2_scan(PP pp, int layer) {
    FRAME();
    const int li = layer >> 1;
    if (F.tid >= 256) {
        Params p; p.ws = ws; p.in[I_MW1] = PIN(I_MW1); p.in[I_MW3] = PIN(I_MW3); p.in[I_MW2] = PIN(I_MW2);
        p.in[I_EV_WIN] = nullptr; p.in[I_EV_WOUT] = nullptr; p.in[I_EV_W1] = nullptr; p.in[I_EV_W3] = nullptr; p.in[I_EV_W2] = nullptr; p.in[I_OD_WIN] = nullptr; p.in[I_WGLU] = nullptr; p.in[I_OD_WOUT] = nullptr;
        LAS float* scr = (LAS float*)(F.lds + F.wave * 16384);
        cvt_range<true>(pp, ws, CVT_MOE0 + li * CVT_MOE_LI + F.bid * 4 + (F.wave - 4), CVT_MOE0 + (li + 1) * CVT_MOE_LI, F.G * 4, scr, F.lane);
    }
    if (F.tid < 256) {
        const int t = F.bid * 256 + F.tid;
        if (t < NBATCH * 32 * 2 * 64) {
            const int pl = t & 63, d = (t >> 6) & 1, g = (t >> 7) & 31, b = t >> 12;
            const int sidx = ((li * 2 + d) * 32 + g);
            const float are = PIN(I_A_RE)[sidx * 64 + pl], aim = PIN(I_A_IM)[sidx * 64 + pl], dt = expf(PIN(I_LOG_DT)[sidx]);
            const float mag = expf(16.0f * are * dt); float sn, cn; sincosf(16.0f * aim * dt, &sn, &cn);
            const float lre = mag * cn, lim = mag * sn;
            unsigned* HB = (unsigned*)(ws + WS_H) + (size_t)g * 4352 * 128 + d * 64 + pl;
            float cre = 0.f, cim = 0.f;
#define S5_CROW(k_) ((k_) < 16 ? (4096 + b * 16 + (d ? 15 - (k_) : (k_))) : (b * 256 + (d ? 255 - ((k_) - 16) : ((k_) - 16))))
            unsigned wn[8];
#pragma unroll
            for (int j = 0; j < 8; ++j) wn[j] = HB[(size_t)S5_CROW(j) * 128];
            for (int k0 = 0; k0 < 272; k0 += 8) {
                unsigned w[8];
#pragma unroll
                for (int j = 0; j < 8; ++j) w[j] = wn[j];
                if (k0 + 8 < 272) {
#pragma unroll
                    for (int j = 0; j < 8; ++j) wn[j] = HB[(size_t)S5_CROW(k0 + 8 + j) * 128]; }
#pragma unroll
                for (int j = 0; j < 8; ++j) { HB[(size_t)S5_CROW(k0 + j) * 128] = cvt_pk_bf16(cre, cim);
                    const float sr = bflo(w[j]), si = bfhi(w[j]); const float nr = lre * cre - lim * cim + sr, ni = lre * cim + lim * cre + si; cre = nr; cim = ni; }
            }
#undef S5_CROW
        }
    }
}
PHASE_FN ph_o3(PP pp, int layer) {
    FRAME();
    const int li = layer >> 1;
    SchedS5B S{F.G, F.bid, (const char*)(ws + WS_H), (const char*)(ws + WS_S5M + (size_t)li * 32 * S5M_STRIDE + 256 * 1024), (const char*)(ws + WS_H + 68 * MiB), (char*)(ws + WS_BIG + BIG_UG)};
    pg8::gemm_phase<pg8::EpiS5B, SchedS5B, true, true, pg8::AMapStd, false, false>(F.lds, F.tid, pg8::Dims{256, 256, 256}, S, pg8::EpiS5B{});
}
PHASE_FN ph_o2_gmlp(PP pp, int layer) {
    FRAME();
    const int li = layer >> 1; const int TR = (layer == DEPTH - 1) ? TL : T;
    const bf16* P = (const bf16*)(ws + WS_BIG + BIG_P); bf16* MIX = (bf16*)(ws + WS_BIG + BIG_MIX);
    constexpr int GP = 272;
    LAS unsigned char* Vt = F.lds;
    LAS unsigned char* Wt = F.lds + 128 * GP;
    LAS f32x2* stt = (LAS f32x2*)(F.lds + 2 * 128 * GP);
    LAS unsigned char* Ut = F.lds + 2 * 128 * GP + 1024;
    const float* ws_w = PIN(I_WS) + (size_t)li * 4 * 128 * 128; const float* bs = PIN(I_BS) + (size_t)li * 4 * 128;
    const int r = F.lane & 31, hh = F.lane >> 5, et = F.wave >> 1, it0 = (F.wave & 1) * 2;
    const int nunits = (TR / 128) * 4;
    const bool wfix = (F.G & 3) == 0;
#define GM_LOADW(h_) do { _Pragma("unroll") for (int k = 0; k < 4; ++k) { const int pc = F.tid + k * NTHREADS; const int i = pc >> 4, j8 = (pc & 15) * 8; const float* wp = ws_w + (size_t)(h_) * 16384 + i * 128 + j8; \
        const f32x4 a = *(const f32x4*)wp, b = *(const f32x4*)(wp + 4); v4u o; o.x = cvt_pk_bf16(a[0], a[1]); o.y = cvt_pk_bf16(a[2], a[3]); o.z = cvt_pk_bf16(b[0], b[1]); o.w = cvt_pk_bf16(b[2], b[3]); \
        *(LAS v4u*)(Wt + i * GP + j8 * 2) = o; } } while (0)
#define GM_LOAD(u_) do { const int ch_ = (u_) >> 2, h_ = (u_) & 3; const size_t r0_ = (size_t)ch_ * 128; \
        _Pragma("unroll") for (int t = 0; t < 16; ++t) srow[t] = *(const v4u*)(P + (r0_ + F.wave * 16 + t) * D + 512 + F.lane * 8); \
        _Pragma("unroll") for (int k = 0; k < 4; ++k) { const int pc = F.tid + k * NTHREADS; const int eg = pc >> 7, j = pc & 127; vq[k] = *(const v4u*)(P + (r0_ + j) * D + 512 + h_ * 128 + eg * 8); \
            uq[k] = *(const v4u*)(P + (r0_ + (pc >> 4)) * D + h_ * 128 + (pc & 15) * 8); } } while (0)
    v4u srow[16], vq[4], uq[4];
    __syncthreads();
    const int ub = F.G - 1 - F.bid;
    if (wfix && ub < nunits) GM_LOADW(ub & 3);
    if (ub < nunits) GM_LOAD(ub);
    for (int u = ub; u < nunits; u += F.G) {
        const int ch = u >> 2, h = u & 3; const size_t row0 = (size_t)ch * 128;
        __syncthreads();
        { float vals[32];
#pragma unroll
          for (int t = 0; t < 16; ++t) { const v4u w = srow[t];
              const float f[8] = {bflo(w.x), bfhi(w.x), bflo(w.y), bfhi(w.y), bflo(w.z), bfhi(w.z), bflo(w.w), bfhi(w.w)};
              float sm = 0.f, sq = 0.f;
#pragma unroll
              for (int q = 0; q < 8; ++q) { sm += f[q]; sq += f[q] * f[q]; }
              vals[t] = sm; vals[16 + t] = sq; }
#pragma unroll
          for (int step = 0; step < 5; ++step) { const int M = 32 >> step, n2 = 16 >> step; const bool up = (F.lane & M) != 0;
#pragma unroll
              for (int i = 0; i < n2; ++i) { const float keep = up ? vals[i + n2] : vals[i], send = up ? vals[i] : vals[i + n2]; vals[i] = keep + __shfl_xor(send, M); } }
          const float tot = vals[0] + __shfl_xor(vals[0], 1);
          const float oth = __shfl_xor(tot, 32);
          if (F.lane < 32 && (F.lane & 1) == 0) { const float mu = tot * (1.f / 512.f), var = fmaxf(oth * (1.f / 512.f) - mu * mu, 0.f); stt[F.wave * 16 + (F.lane >> 1)] = (f32x2){mu, rsqrtf(var + LN_EPS)}; } }
        if (!wfix) GM_LOADW(h);
#pragma unroll
        for (int k = 0; k < 4; ++k) { const int pc = F.tid + k * NTHREADS; *(LAS v4u*)(Ut + (pc >> 4) * GP + (pc & 15) * 16) = uq[k]; }
        __syncthreads();
#pragma unroll
        for (int k = 0; k < 4; ++k) { const int pc = F.tid + k * NTHREADS; const int eg = pc >> 7, j = pc & 127; const v4u w = vq[k];
            const f32x2 ms = stt[j];
            const float f[8] = {bflo(w.x), bfhi(w.x), bflo(w.y), bfhi(w.y), bflo(w.z), bfhi(w.z), bflo(w.w), bfhi(w.w)};
#pragma unroll
            for (int q = 0; q < 8; q += 2) { const unsigned pkd = cvt_pk_bf16((f[q] - ms.x) * ms.y, (f[q + 1] - ms.x) * ms.y);
                *(LAS unsigned short*)(Vt + (eg * 8 + q) * GP + j * 2) = (unsigned short)(pkd & 0xffffu); *(LAS unsigned short*)(Vt + (eg * 8 + q + 1) * GP + j * 2) = (unsigned short)(pkd >> 16); } }
        if (u + F.G < nunits) GM_LOAD(u + F.G);
        __syncthreads();
        f32x16 acc0, acc1;
#pragma unroll
        for (int q = 0; q < 16; ++q) { acc0[q] = 0.f; acc1[q] = 0.f; }
#pragma unroll
        for (int sk = 0; sk < 8; ++sk) {
            const bf16x8 a = *(const LAS bf16x8*)(Vt + (et * 32 + r) * GP + (16 * sk + 8 * hh) * 2);
            const bf16x8 b0 = *(const LAS bf16x8*)(Wt + (it0 * 32 + r) * GP + (16 * sk + 8 * hh) * 2), b1 = *(const LAS bf16x8*)(Wt + ((it0 + 1) * 32 + r) * GP + (16 * sk + 8 * hh) * 2);
            acc0 = __builtin_amdgcn_mfma_f32_32x32x16_bf16(a, b0, acc0, 0, 0, 0); acc1 = __builtin_amdgcn_mfma_f32_32x32x16_bf16(a, b1, acc1, 0, 0, 0);
        }
#pragma unroll
        for (int t = 0; t < 2; ++t) { const int i = (it0 + t) * 32 + r; const float bb = bs[h * 128 + i];
            LAS unsigned char* up = Ut + i * GP + (et * 32 + 4 * hh) * 2;
#pragma unroll
            for (int q4 = 0; q4 < 4; ++q4) { const v2u uw = *(const LAS v2u*)(up + 16 * q4);
                const float a0 = (t ? acc1[4 * q4 + 0] : acc0[4 * q4 + 0]) + bb, a1 = (t ? acc1[4 * q4 + 1] : acc0[4 * q4 + 1]) + bb, a2 = (t ? acc1[4 * q4 + 2] : acc0[4 * q4 + 2]) + bb, a3 = (t ? acc1[4 * q4 + 3] : acc0[4 * q4 + 3]) + bb;
                v2u o; o.x = cvt_pk_bf16(bflo(uw.x) * a0, bfhi(uw.x) * a1); o.y = cvt_pk_bf16(bflo(uw.y) * a2, bfhi(uw.y) * a3);
                *(LAS v2u*)(up + 16 * q4) = o; } }
        __syncthreads();
#pragma unroll
        for (int k = 0; k < 4; ++k) { const int pc = F.tid + k * NTHREADS; *(v4u*)(MIX + (row0 + (pc >> 4)) * D + 512 + h * 128 + (pc & 15) * 8) = *(const LAS v4u*)(Ut + (pc >> 4) * GP + (pc & 15) * 16); }
    }
    __syncthreads();
#undef GM_LOAD
#undef GM_LOADW
}
PHASE_FN ph_o4(PP pp, int layer) {
    FRAME();
    const int li = layer >> 1;
    unsigned char* odw = ws + WS_OD + li * OD_STRIDE;
    SchedGlu S{F.G, F.bid, (const char*)(ws + WS_BIG + BIG_UG), (const char*)(odw + OD_WGLU), (char*)(ws + WS_BIG + BIG_MIX), PIN(I_BGLU) + (size_t)li * 512};
    pg8::gemm_phase<pg8::EpiGLU, SchedGlu, true, true, pg8::AMapGLU>(F.lds, F.tid, pg8::Dims{512, 0, 512}, S, pg8::EpiGLU{}, pg8::AMapGLU{});
}
PHASE_FN ph_o6(PP pp, int layer) {
    FRAME();
    const int li = layer >> 1; const int TR = (layer == DEPTH - 1) ? TL : T;
    const bf16* Hb = (const bf16*)(ws + WS_H);
    int* tokE = (int*)(ws + WS_TOK); int* tokS0 = tokE + T; int* tokS1 = tokS0 + T; float* tokG0 = (float*)(tokS1 + T);
    unsigned* ecnt = F.ctl + CW_CNT + li * 64;
    LAS float* wr_s = (LAS float*)F.lds;
    LAS unsigned* lcnt = (LAS unsigned*)(F.lds + 32768);
    const float* rw = PIN(I_ROUTER) + (size_t)li * D * 8;
    __syncthreads();
    for (int e = F.tid; e < D * 8; e += NTHREADS) { const int col = e >> 3, ex = e & 7; wr_s[(((col & 15) * 2 + (ex >> 2)) * 64 + (col >> 4)) * 4 + (ex & 3)] = rw[e]; }
    if (F.tid < 16) lcnt[F.tid] = 0u;
    __syncthreads();
    v4u qa[3], qb[3];
#pragma unroll
    for (int k = 0; k < 3; ++k) { const int rk = F.gw + k * F.NGW; qa[k] = (v4u){0u, 0u, 0u, 0u}; qb[k] = qa[k];
        if (rk < TR) { const v4u* src = (const v4u*)(Hb + (size_t)rk * D) + 2 * F.lane; qa[k] = src[0]; qb[k] = src[1]; } }
    for (int r = F.gw; r < TR; r += F.NGW) {
        const v4u a = qa[0], b = qb[0];
        qa[0] = qa[1]; qb[0] = qb[1]; qa[1] = qa[2]; qb[1] = qb[2];
        { const int rn = r + 3 * F.NGW; if (rn < TR) { const v4u* src = (const v4u*)(Hb + (size_t)rn * D) + 2 * F.lane; qa[2] = src[0]; qb[2] = src[1]; } }
        const float hv[16] = {bflo(a.x), bfhi(a.x), bflo(a.y), bfhi(a.y), bflo(a.z), bfhi(a.z), bflo(a.w), bfhi(a.w), bflo(b.x), bfhi(b.x), bflo(b.y), bfhi(b.y), bflo(b.z), bfhi(b.z), bflo(b.w), bfhi(b.w)};
        float lg[8];
#pragma unroll
        for (int e = 0; e < 8; ++e) lg[e] = 0.f;
#pragma unroll
        for (int q = 0; q < 16; ++q) { const f32x4 w0 = *(const LAS f32x4*)(wr_s + ((q * 2 + 0) * 64 + F.lane) * 4), w1 = *(const LAS f32x4*)(wr_s + ((q * 2 + 1) * 64 + F.lane) * 4);
            lg[0] += hv[q] * w0[0]; lg[1] += hv[q] * w0[1]; lg[2] += hv[q] * w0[2]; lg[3] += hv[q] * w0[3]; lg[4] += hv[q] * w1[0]; lg[5] += hv[q] * w1[1]; lg[6] += hv[q] * w1[2]; lg[7] += hv[q] * w1[3]; }
#pragma unroll
        for (int step = 0; step < 3; ++step) { const int M = 32 >> step, n2 = 4 >> step; const bool up = (F.lane & M) != 0;
#pragma unroll
            for (int i = 0; i < n2; ++i) { const float keep = up ? lg[i + n2] : lg[i], send = up ? lg[i] : lg[i + n2]; lg[i] = keep + __shfl_xor(send, M); } }
        { float t = lg[0]; t += __shfl_xor(t, 4); t += __shfl_xor(t, 2); t += __shfl_xor(t, 1);
#pragma unroll
          for (int e = 0; e < 8; ++e) lg[e] = __uint_as_float((unsigned)__builtin_amdgcn_readlane((int)__float_as_uint(t), 8 * e)); }
        if (F.lane == 0) {
            int e0 = 0; float v0 = lg[0];
#pragma unroll
            for (int e = 1; e < 8; ++e) if (lg[e] > v0) { v0 = lg[e]; e0 = e; }
            int e1 = -1; float v1 = -3.0e38f;
#pragma unroll
            for (int e = 0; e < 8; ++e) if (e != e0 && lg[e] > v1) { v1 = lg[e]; e1 = e; }
            const float w0 = 1.0f / (1.0f + __expf(v1 - v0));
            const int s0 = (int)__hip_atomic_fetch_add(lcnt + e0, 1u, __ATOMIC_RELAXED, __HIP_MEMORY_SCOPE_WORKGROUP), s1 = (int)__hip_atomic_fetch_add(lcnt + e1, 1u, __ATOMIC_RELAXED, __HIP_MEMORY_SCOPE_WORKGROUP);
            tokE[r] = e0 | (e1 << 8); tokS0[r] = s0; tokS1[r] = s1; tokG0[r] = w0;
        }
    }
    __syncthreads();
    if (F.tid < 8) lcnt[8 + F.tid] = atomicAdd(ecnt + F.tid, lcnt[F.tid]);
    VM_WAIT();
    __syncthreads();
    { const int r = F.gw + F.lane * F.NGW;
      if (r < TR) { const int ee = tokE[r]; tokS0[r] += (int)lcnt[8 + (ee & 255)]; tokS1[r] += (int)lcnt[8 + (ee >> 8)]; } }
    __syncthreads();
}
PHASE_FN ph_o7(PP pp, int layer) {
    FRAME();
    const int li = layer >> 1; const int TR = (layer == DEPTH - 1) ? TL : T;
    const bf16* Hb = (const bf16*)(ws + WS_H); unsigned char* HSQ = ws + WS_BIG + BIG_HSQ;
    int* tokE = (int*)(ws + WS_TOK); int* tokS0 = tokE + T; int* tokS1 = tokS0 + T; int* tokP0 = tokS1 + 2 * T; int* tokP1 = tokP0 + T;
    unsigned* ecnt = F.ctl + CW_CNT + li * 64;
    int roff[8]; { int acc = 0;
#pragma unroll
        for (int e = 0; e < 8; ++e) { roff[e] = acc * 256; acc += (__builtin_amdgcn_readfirstlane((int)__hip_atomic_load(ecnt + e, __ATOMIC_RELAXED, __HIP_MEMORY_SCOPE_AGENT)) + 255) >> 8; } }
    for (int ra = F.gw; ra < TR; ra += 2 * F.NGW) {
        const int rb = ra + F.NGW;
        const int ea = tokE[ra], eb = tokE[rb]; int pa0 = tokS0[ra], pa1 = tokS1[ra], pb0 = tokS0[rb], pb1 = tokS1[rb];
        const v4u* sa = (const v4u*)(Hb + (size_t)ra * D) + 2 * F.lane; const v4u* sb = (const v4u*)(Hb + (size_t)rb * D) + 2 * F.lane;
        const v4u a0 = sa[0], a1 = sa[1], b0 = sb[0], b1 = sb[1];
#pragma unroll
        for (int e = 0; e < 8; ++e) { pa0 += (e == (ea & 255)) ? roff[e] : 0; pa1 += (e == (ea >> 8)) ? roff[e] : 0; pb0 += (e == (eb & 255)) ? roff[e] : 0; pb1 += (e == (eb >> 8)) ? roff[e] : 0; }
        v4u qa, qb;
        qa.x = pk_fp8x4(bflo(a0.x) * Q_H, bfhi(a0.x) * Q_H, bflo(a0.y) * Q_H, bfhi(a0.y) * Q_H); qa.y = pk_fp8x4(bflo(a0.z) * Q_H, bfhi(a0.z) * Q_H, bflo(a0.w) * Q_H, bfhi(a0.w) * Q_H);
        qa.z = pk_fp8x4(bflo(a1.x) * Q_H, bfhi(a1.x) * Q_H, bflo(a1.y) * Q_H, bfhi(a1.y) * Q_H); qa.w = pk_fp8x4(bflo(a1.z) * Q_H, bfhi(a1.z) * Q_H, bflo(a1.w) * Q_H, bfhi(a1.w) * Q_H);
        qb.x = pk_fp8x4(bflo(b0.x) * Q_H, bfhi(b0.x) * Q_H, bflo(b0.y) * Q_H, bfhi(b0.y) * Q_H); qb.y = pk_fp8x4(bflo(b0.z) * Q_H, bfhi(b0.z) * Q_H, bflo(b0.w) * Q_H, bfhi(b0.w) * Q_H);
        qb.z = pk_fp8x4(bflo(b1.x) * Q_H, bfhi(b1.x) * Q_H, bflo(b1.y) * Q_H, bfhi(b1.y) * Q_H); qb.w = pk_fp8x4(bflo(b1.z) * Q_H, bfhi(b1.z) * Q_H, bflo(b1.w) * Q_H, bfhi(b1.w) * Q_H);
        *((v4u*)(HSQ + (size_t)pa0 * D) + F.lane) = qa; *((v4u*)(HSQ + (size_t)pa1 * D) + F.lane) = qa;
        *((v4u*)(HSQ + (size_t)pb0 * D) + F.lane) = qb; *((v4u*)(HSQ + (size_t)pb1 * D) + F.lane) = qb;
        if (F.lane == 0) { tokP0[ra] = pa0; tokP1[ra] = pa1; tokP0[rb] = pb0; tokP1[rb] = pb1; }
    }
}
PHASE_FN ph_moe_up(PP pp, int layer, int chn) {
    FRAME();
    const int li = layer >> 1; unsigned char* odw = ws + WS_OD + li * OD_STRIDE; unsigned* ecnt = F.ctl + CW_CNT + li * 64;
    SchedMoeUp S; S.G = F.G; S.c = F.bid; S.rt0 = chn * MOE_CHUNK_TILES; S.HS = (const char*)(ws + WS_BIG + BIG_HSQ); S.W = (const char*)(odw + OD_MW13); S.HID = (char*)(ws + WS_H);
    { int acc = 0; S.toff[0] = 0;
#pragma unroll
        for (int e = 0; e < 8; ++e) { acc += (__builtin_amdgcn_readfirstlane((int)__hip_atomic_load(ecnt + e, __ATOMIC_RELAXED, __HIP_MEMORY_SCOPE_AGENT)) + 255) >> 8; S.toff[e + 1] = acc; } }
    int nt_ = S.toff[8] - S.rt0; nt_ = nt_ < 0 ? 0 : (nt_ > MOE_CHUNK_TILES ? MOE_CHUNK_TILES : nt_); S.nUnits = nt_ * 28;
    pg8::gemm_phase<pg8::EpiSwiGLU8, SchedMoeUp, true, true, pg8::AMapStd, true>(F.lds, F.tid, pg8::Dims{D, D, D}, S, pg8::EpiSwiGLU8{});
}
PHASE_FN ph_moe_down(PP pp, int layer, int chn) {
    FRAME();
    const int li = layer >> 1; unsigned char* odw = ws + WS_OD + li * OD_STRIDE; unsigned* ecnt = F.ctl + CW_CNT + li * 64;
    SchedMoeDown S; S.G = F.G; S.c = F.bid; S.rt0 = chn * MOE_CHUNK_TILES; S.HID = (const char*)(ws + WS_H); S.W = (const char*)(odw + OD_MW2); S.Y = (char*)(ws + WS_BIG + BIG_Y);
    { int acc = 0; S.toff[0] = 0;
#pragma unroll
        for (int e = 0; e < 8; ++e) { acc += (__builtin_amdgcn_readfirstlane((int)__hip_atomic_load(ecnt + e, __ATOMIC_RELAXED, __HIP_MEMORY_SCOPE_AGENT)) + 255) >> 8; S.toff[e + 1] = acc; } }
    int nt_ = S.toff[8] - S.rt0; nt_ = nt_ < 0 ? 0 : (nt_ > MOE_CHUNK_TILES ? MOE_CHUNK_TILES : nt_); S.nUnits = nt_ * 4;
    pg8::gemm_phase<pg8::EpiStoreQ, SchedMoeDown, true, true, pg8::AMapHid, true>(F.lds, F.tid, pg8::Dims{EH, EH, EH}, S, pg8::EpiStoreQ{}, pg8::AMapHid{});
}
PHASE_FN ph_o9(PP pp, int layer) {
    FRAME();
    const int TR = (layer == DEPTH - 1) ? TL : T; const bool last = layer == DEPTH - 1;
    bf16* XB = (bf16*)(ws + WS_XB); float* out = (float*)pp->out; bf16* Hb = (bf16*)(ws + WS_H); const bf16* HS = (const bf16*)(ws + WS_BIG + BIG_Y);
    const float* modl = (const float*)(ws + WS_MOD) + (size_t)layer * 17 * 6144;
    const float* modn = (const float*)(ws + WS_MOD) + (size_t)(last ? layer : layer + 1) * 17 * 6144;
    const float* lng1 = PIN(I_LNG) + (size_t)(layer * 2 + 1) * D; const float* lnb1 = PIN(I_LNB) + (size_t)(layer * 2 + 1) * D;
    const int* tokE = (const int*)(ws + WS_TOK); const float* tokG0 = (const float*)(tokE + 3 * T); const int* tokP0 = tokE + 4 * T; const int* tokP1 = tokP0 + T;
    f32x4 gg9[4], bb9[4];
#pragma unroll
    for (int j = 0; j < 4; ++j) { gg9[j] = *(const f32x4*)(lng1 + 256 * j + 4 * F.lane); bb9[j] = *(const f32x4*)(lnb1 + 256 * j + 4 * F.lane); }
    for (int ra = F.gw; ra < TR; ra += 2 * F.NGW) {
        const int rb = ra + F.NGW; const int rr[2] = {ra, rb};
        int p0[2], p1[2]; float w0[2]; int mrow[2];
#pragma unroll
        for (int k = 0; k < 2; ++k) { const int r = rr[k]; const bool isc = r >= TL; mrow[k] = isc ? 16 : (r >> 12); p0[k] = tokP0[r]; p1[k] = tokP1[r]; w0[k] = tokG0[r]; }
        f32x4 v[2][4]; v2u ya[2][4], yb[2][4];
#pragma unroll
        for (int k = 0; k < 2; ++k) { row_load_bf16(XB + (size_t)rr[k] * D, F.lane, v[k]); const bf16* y0 = HS + (size_t)p0[k] * D; const bf16* y1 = HS + (size_t)p1[k] * D;
#pragma unroll
            for (int j = 0; j < 4; ++j) { ya[k][j] = *(const v2u*)(y0 + 256 * j + 4 * F.lane); yb[k][j] = *(const v2u*)(y1 + 256 * j + 4 * F.lane); } }
#pragma unroll
        for (int k = 0; k < 2; ++k) { const float wa = w0[k], wb = 1.0f - wa; const float* g2 = modl + (size_t)mrow[k] * 6144 + 5120;
#pragma unroll
            for (int j = 0; j < 4; ++j) { const v2u a = ya[k][j], b = yb[k][j]; const f32x4 gg = *(const f32x4*)(g2 + 256 * j + 4 * F.lane);
                f32x4 f; f[0] = wa * bflo(a.x) + wb * bflo(b.x); f[1] = wa * bfhi(a.x) + wb * bfhi(b.x); f[2] = wa * bflo(a.y) + wb * bflo(b.y); f[3] = wa * bfhi(a.y) + wb * bfhi(b.y);
                v[k][j] = v[k][j] * ALPHA + gg * f; }
            row_ln_pre(v[k], gg9, bb9);
            if (last) row_store(out + (size_t)rr[k] * D, F.lane, v[k]); else row_store_bf16(XB + (size_t)rr[k] * D, F.lane, v[k]);
            if (!last) { f32x4 h[4]; const float* m = modn + (size_t)mrow[k] * 6144; row_modulate(h, v[k], m + 1024, m, F.lane); row_store_bf16(Hb + (size_t)rr[k] * D, F.lane, h); } }
    }
}

#if MK_SPLIT
#define PHASE_END() do { ++ph; } while (0)
#else
#define PHASE_END() do { if (ph >= lo && ph + 1 < hi) grid_bar(pp); ++ph; } while (0)
#endif
#define PHASE_ON() (ph >= lo && ph < hi)
static __device__ __forceinline__ void even_layer(PP pp, const int layer, const int lo, const int hi, int& ph) {
    if (PHASE_ON()) ph_e1(pp, layer);
    PHASE_END();
    if (PHASE_ON()) { ph_e2_fft(pp); ph_e2_rope(pp); }
    PHASE_END();
    if (PHASE_ON()) { ph_e2_dft(pp); ph_e3_attn(pp, layer); }
    PHASE_END();
    if (PHASE_ON()) ph_outproj(pp, layer);
    PHASE_END();
    if (PHASE_ON()) ph_e6(pp, layer);
    PHASE_END();
    if (PHASE_ON()) ph_e7(pp, layer);
    PHASE_END();
}
static __device__ __forceinline__ void odd_layer(PP pp, const int layer, const int lo, const int hi, int& ph) {
    if (PHASE_ON()) ph_o1(pp, layer);
    PHASE_END();
    if (PHASE_ON()) { ph_o2_s5a(pp, layer); ph_o2_gmlp(pp, layer); }
    PHASE_END();
    if (PHASE_ON()) ph_o2_scan(pp, layer);
    PHASE_END();
    if (PHASE_ON()) ph_o3(pp, layer);
    PHASE_END();
    if (PHASE_ON()) ph_o4(pp, layer);
    PHASE_END();
    if (PHASE_ON()) ph_outproj(pp, layer);
    PHASE_END();
    if (PHASE_ON()) ph_o6(pp, layer);
    PHASE_END();
    if (PHASE_ON()) ph_o7(pp, layer);
    PHASE_END();
#define MOE_CHUNK(chn) do { if (PHASE_ON()) ph_moe_up(pp, layer, chn); PHASE_END(); if (PHASE_ON()) ph_moe_down(pp, layer, chn); PHASE_END(); } while (0)
    static_assert(MOE_NCHUNK == 5, "the chunk sites are written out: no loop around GEMM phase sites");
    MOE_CHUNK(0); MOE_CHUNK(1); MOE_CHUNK(2); MOE_CHUNK(3); MOE_CHUNK(4);
#undef MOE_CHUNK
    if (PHASE_ON()) ph_o9(pp, layer);
    PHASE_END();
}
constexpr int N_PHASES = 2 + 2 * (6 + 9 + 2 * MOE_NCHUNK);
__global__ void __launch_bounds__(NTHREADS, 2) fwd_kernel(Params p_unused) {
    DECL_LDS;
    PP pp = (PP)__builtin_amdgcn_kernarg_segment_ptr();
    {
        LAS unsigned char* lds = (LAS unsigned char*)lds_raw;
        for (int u = threadIdx.x; u < (LDS_BYTES - LDS_RING) / 4; u += NTHREADS) ((LAS unsigned*)(lds + LDS_RING))[u] = 0u;
        __syncthreads();
#if !MK_SPLIT
        (void)xcd_barrier_post((unsigned*)((unsigned char*)pp->ws + WS_CTL) + CW_BAR, (volatile LAS unsigned*)(lds + LDS_MISC) + 8);
#endif
    }
#if MK_SPLIT
    const int lo = pp->ph_lo, hi = pp->ph_hi;
#else
    constexpr int lo = 0, hi = N_PHASES;
#endif
    int ph = 0;

    if (PHASE_ON()) ph_mod(pp);
    PHASE_END();
    if (PHASE_ON()) { ph_fold(pp); ph_s5mat(pp); ph_pro_b(pp); ph_cvt(pp); ph_dftmat(pp); }
    PHASE_END();
    even_layer(pp, 0, lo, hi, ph);
    odd_layer(pp, 1, lo, hi, ph);
    even_layer(pp, 2, lo, hi, ph);
    odd_layer(pp, 3, lo, hi, ph);
}

extern "C" void kernel_launch(void* const* d_in, const int* in_sizes, int n_in, void* d_out, int out_size, void* d_ws, size_t ws_size, hipStream_t stream) {
    static int grid = 0;
    if (grid == 0) {
        if (n_in != 32 || out_size != TL * D || ws_size < WS_END) { fprintf(stderr, "kernel_launch: unexpected shapes (n_in %d, out %d, ws %zu < %zu)\n", n_in, out_size, ws_size, (size_t)WS_END); grid = -1; return; }
        int dev = 0, cus = 0, per_cu = 0;
        if (hipGetDevice(&dev) != hipSuccess || hipDeviceGetAttribute(&cus, hipDeviceAttributeMultiprocessorCount, dev) != hipSuccess) { grid = -1; return; }
        if (hipFuncSetAttribute((const void*)fwd_kernel, hipFuncAttributeMaxDynamicSharedMemorySize, LDS_BYTES) != hipSuccess) { fprintf(stderr, "kernel_launch: hipFuncSetAttribute failed\n"); grid = -1; return; }
        if (hipOccupancyMaxActiveBlocksPerMultiprocessor(&per_cu, (const void*)fwd_kernel, NTHREADS, LDS_BYTES) != hipSuccess || per_cu < 1) { fprintf(stderr, "kernel_launch: occupancy query says %d\n", per_cu); }
        (void)hipGetLastError();
        grid = cus;
    }
    if (grid < 0) return;
    (void)in_sizes;
    (void)hipMemsetAsync((char*)d_ws + WS_CTL, 0, CTL_ZERO_BYTES, stream);
    Params p{};
    for (int i = 0; i < 32; ++i) p.in[i] = (const float*)d_in[i];
    p.out = (float*)d_out; p.ws = (unsigned char*)d_ws;
#if MK_SPLIT
    for (int ph = 0; ph < N_PHASES; ++ph) { p.ph_lo = ph; p.ph_hi = ph + 1; hipLaunchKernelGGL(fwd_kernel, dim3(grid), dim3(NTHREADS), LDS_BYTES, stream, p); }
#else
    p.ph_lo = 0; p.ph_hi = N_PHASES;
    hipLaunchKernelGGL(fwd_kernel, dim3(grid), dim3(NTHREADS), LDS_BYTES, stream, p);
#endif
}
```

```cpp
#include <hip/hip_runtime.h>
#include <cstdio>
#include <cstdint>

#ifndef MK_SPLIT
#define MK_SPLIT 0
#endif

#define GAS __attribute__((address_space(1)))
#define LAS __attribute__((address_space(3)))
typedef unsigned short bf16;
typedef unsigned v4u __attribute__((ext_vector_type(4)));
typedef unsigned v2u __attribute__((ext_vector_type(2)));
typedef float f32x4 __attribute__((ext_vector_type(4)));
typedef float f32x2 __attribute__((ext_vector_type(2)));
typedef short bf16x8 __attribute__((ext_vector_type(8)));

constexpr int D = 1024, NBATCH = 16, SEQ = 4096, NCTX = 256, DEPTH = 4;
constexpr int TL = NBATCH * SEQ, TC = NBATCH * NCTX, T = TL + TC;
constexpr int FFH = 2816, EH = 3584, NEXP = 8;
constexpr int MOE_CHUNK_TILES = 128, MOE_NCHUNK = 5;
constexpr float Q_H = 16.f, Q_W = 1024.f, Q_HID = 8.f;
constexpr float ALPHA = 1.6817928305074290860622509524664f;
constexpr float LN_EPS = 1e-5f;

constexpr size_t MiB = (size_t)1 << 20;
constexpr size_t WS_CTL = 0, CTL_ZERO_BYTES = 1 * MiB;
constexpr size_t WS_MOD = 1 * MiB;
constexpr size_t WS_TOK = 3 * MiB;
constexpr size_t WS_F256 = 21 * MiB;
constexpr size_t WS_FD = 22 * MiB;
constexpr size_t WS_EV = 86 * MiB, EV_STRIDE = 22 * MiB;
constexpr size_t EV_WQKV = 0, EV_WPQ = 3 * MiB / 2, EV_WOUT = 7 * MiB / 2, EV_W13 = 11 * MiB / 2, EV_W2 = 33 * MiB / 2;
constexpr size_t WS_OD = 130 * MiB, OD_STRIDE = 90 * MiB;
constexpr size_t OD_WIN = 0, OD_WGLU = 3 * MiB, OD_WOUT = 7 * MiB / 2, OD_MW13 = 11 * MiB / 2  , OD_MW2 = 62 * MiB  ;
constexpr size_t WS_H = 310 * MiB;
constexpr size_t WS_BIG = 446 * MiB;
constexpr size_t BIG_PQT = 0, BIG_PQTC = 128 * MiB, BIG_QKV = 136 * MiB, BIG_MIX = 238 * MiB, BIG_VT = 374 * MiB, BIG_HID = 0, BIG_P = 0  , BIG_UG = 136 * MiB  , BIG_Y = 0, BIG_HSQ = 276 * MiB;
constexpr size_t WS_S5M = 862 * MiB, S5M_STRIDE = 384 * 1024;
constexpr size_t WS_XB = 890 * MiB;
constexpr size_t WS_END = 1026 * MiB;
constexpr int CW_BAR = 4096, CW_CNT = 16384, CW_LN = 32768, LN_SITE_WORDS = 272 * 16;
constexpr size_t WS_XS = 886 * MiB;

#define LDS_WAIT() asm volatile("s_waitcnt lgkmcnt(0)" ::: "memory")
#define VM_WAIT() asm volatile("s_waitcnt vmcnt(0)" ::: "memory")
__device__ __forceinline__ unsigned cvt_pk_bf16(float lo, float hi) { unsigned r; asm volatile("v_cvt_pk_bf16_f32 %0, %1, %2" : "=v"(r) : "v"(lo), "v"(hi)); return r; }
__device__ __forceinline__ float bflo(unsigned w) { return __uint_as_float(w << 16); }
__device__ __forceinline__ float bfhi(unsigned w) { return __uint_as_float(w & 0xffff0000u); }
__device__ __forceinline__ float bf2f(bf16 b) { return __uint_as_float(((unsigned)b) << 16); }
__device__ __forceinline__ bf16 f2bf(float f) { return (bf16)(cvt_pk_bf16(f, 0.f) & 0xffffu); }
__device__ __forceinline__ unsigned pk_fp8x4(float a, float b, float c, float d) {
    a = __builtin_amdgcn_fmed3f(a, -448.f, 448.f); b = __builtin_amdgcn_fmed3f(b, -448.f, 448.f); c = __builtin_amdgcn_fmed3f(c, -448.f, 448.f); d = __builtin_amdgcn_fmed3f(d, -448.f, 448.f);
    int w = 0; w = __builtin_amdgcn_cvt_pk_fp8_f32(a, b, w, false); w = __builtin_amdgcn_cvt_pk_fp8_f32(c, d, w, true); return (unsigned)w; }
__device__ __forceinline__ float wave_sum(float v) {
#pragma unroll
    for (int o = 1; o < 64; o <<= 1) v += __shfl_xor(v, o);
    return v;
}
__device__ __forceinline__ float wave_max(float v) {
#pragma unroll
    for (int o = 1; o < 64; o <<= 1) v = fmaxf(v, __shfl_xor(v, o));
    return v;
}
__device__ __forceinline__ float sigmoid_f(float x) { return __builtin_amdgcn_rcpf(1.f + __builtin_amdgcn_exp2f(-1.4426950408889634f * x)); }
__device__ __forceinline__ float silu_f(float x) { return x * sigmoid_f(x); }
__device__ __forceinline__ f32x2 gelu_tanh_2(f32x2 x) { const f32x2 p = (x * x) * -0.10294324f + -2.3022082f; const f32x2 t = x * p;
    const f32x2 d = (f32x2){__builtin_amdgcn_exp2f(t[0]), __builtin_amdgcn_exp2f(t[1])} + 1.0f; return x * (f32x2){__builtin_amdgcn_rcpf(d[0]), __builtin_amdgcn_rcpf(d[1])}; }
__device__ __forceinline__ f32x2 sigmoid_2(f32x2 x) { const f32x2 t = x * -1.4426950408889634f; const f32x2 d = (f32x2){__builtin_amdgcn_exp2f(t[0]), __builtin_amdgcn_exp2f(t[1])} + 1.0f; return (f32x2){__builtin_amdgcn_rcpf(d[0]), __builtin_amdgcn_rcpf(d[1])}; }
__device__ __forceinline__ float gelu_tanh_f(float x) { const float z = x * (0.7978845608028654f + 0.035677408136300125f * x * x); return x * __builtin_amdgcn_rcpf(1.f + __builtin_amdgcn_exp2f(-2.8853900817779268f * z)); }

#define XB_TMO      128
#define XB_XCNT(j)  (256  + 64 * (j))
#define XB_XSUB(j)  (1280 + 64 * (j))
#define XB_XGEN(j)  (2304 + 64 * (j))
#define XB_TOP      3328
#define XB_TOPGEN   3392
#define XCD_BAR_WORDS 3456
#define XB_SPIN_CAP (1u << 25)
__device__ __forceinline__ unsigned xb_ld(unsigned* p)              { return __hip_atomic_load(p, __ATOMIC_RELAXED, __HIP_MEMORY_SCOPE_AGENT); }
__device__ __forceinline__ unsigned xb_add(unsigned* p, unsigned v) { return __hip_atomic_fetch_add(p, v, __ATOMIC_RELAXED, __HIP_MEMORY_SCOPE_AGENT); }
__device__ __forceinline__ unsigned xb_xcc_id() { return (unsigned)__builtin_amdgcn_s_getreg((3 << 11) | 20) & 0xFu; }
#define XB_SPIN(cond, bar) do { unsigned _sp = 0; while (cond) { __builtin_amdgcn_s_sleep(1); \
    if ((++_sp & 255u) == 0u) { if (xb_ld(&(bar)[XB_TMO])) break; if (_sp > XB_SPIN_CAP) { atomicAdd(&(bar)[XB_TMO], 1u); break; } } } } while (0)
struct XcdBarrier { unsigned* bar; unsigned x; volatile LAS unsigned* st; };
__device__ __forceinline__ XcdBarrier xcd_barrier_post(unsigned* bar, volatile LAS unsigned* st) {
    XcdBarrier b; b.bar = bar; b.x = xb_xcc_id(); b.st = st;
    if (threadIdx.x == 0) (void)xb_add(&bar[XB_XCNT(b.x)], 1u);
    return b;
}
__device__ __forceinline__ void xcd_barrier_complete(unsigned* bar, unsigned x, unsigned& nloc, unsigned& nx) {
    const unsigned G = gridDim.x * gridDim.y * gridDim.z;
    unsigned sum, cnt, mine, sp = 0u;
    for (;;) {
        sum = 0u; cnt = 0u; mine = 0u;
#pragma unroll
        for (unsigned j = 0; j < 16; ++j) { const unsigned c = xb_ld(&bar[XB_XCNT(j)]); sum += c; cnt += (c > 0u) ? 1u : 0u; mine = (j == x) ? c : mine; }
        if (sum == G) break;
        __builtin_amdgcn_s_sleep(1);
        if ((++sp & 255u) == 0u) { if (xb_ld(&bar[XB_TMO])) break; if (sp > XB_SPIN_CAP) { atomicAdd(&bar[XB_TMO], 1u); break; } }
    }
    nloc = mine > 0u ? mine : 1u; nx = cnt > 0u ? cnt : 1u;
}
__device__ __forceinline__ void xcd_barrier(const XcdBarrier& b) {
    asm volatile("s_waitcnt vmcnt(0)" ::: "memory");
    __syncthreads();
    if (threadIdx.x == 0) {
        unsigned* bar = b.bar;
        __builtin_amdgcn_s_waitcnt(0);
        unsigned nloc = b.st[0], nx = b.st[1];
        if (nloc == 0u) { xcd_barrier_complete(bar, b.x, nloc, nx); b.st[0] = nloc; b.st[1] = nx; }
        const unsigned old = xb_add(&bar[XB_XSUB(b.x)], 1u);
        const unsigned gen = old / nloc;
        if (old + 1u == (gen + 1u) * nloc) {
            __builtin_amdgcn_fence(__ATOMIC_RELEASE, "agent");
            asm volatile("s_waitcnt vmcnt(0)" ::: "memory");
            const unsigned og = xb_add(&bar[XB_TOP], 1u);
            const unsigned tg = og / nx;
            if (og + 1u == (tg + 1u) * nx) xb_add(&bar[XB_TOPGEN], 1u);
            else XB_SPIN(xb_ld(&bar[XB_TOPGEN]) == tg, bar);
            __builtin_amdgcn_fence(__ATOMIC_ACQUIRE, "agent");
            xb_add(&bar[XB_XGEN(b.x)], 1u);
            asm volatile("s_waitcnt vmcnt(0)" ::: "memory");
        } else {
            XB_SPIN(xb_ld(&bar[XB_XGEN(b.x)]) == gen, bar);
            __builtin_amdgcn_fence(__ATOMIC_ACQUIRE, "agent");
            asm volatile("s_waitcnt vmcnt(0)" ::: "memory");
        }
    }
    __syncthreads();
}

namespace pg8 {
constexpr int BM = 256, BK = 64, HALF = 128, HTB = HALF * BK * 2, STAGE_BYTES = 8 * HTB;
__host__ __device__ __forceinline__ int lds_byte(int r, int c) { const int st = (r >> 4) * 2 + (c >> 5), rr = r & 15, cc = c & 31, ob = rr * 64 + cc * 2; return st * 1024 + (ob ^ (((ob >> 9) & 1) << 5)); }
__host__ __device__ __forceinline__ void stage_rc(int b, int& R, int& C) { const int st = b / 1024, sb = b % 1024, swz = sb ^ (((sb >> 9) & 1) << 5); R = (st >> 1) * 16 + swz / 64; C = (st & 1) * 32 + (swz % 64) / 2; }
__host__ __device__ __forceinline__ int perm32(int rho) { const int n = rho >> 4, i = rho & 15; return 8 * (i >> 2) + 4 * n + (i & 3); }

struct Unit { const char* a; const char* b; char* o; const char* p0; const char* p1; int ldo; int x0; };
struct Dims { int K, lda, ldb; };
typedef int v4i __attribute__((ext_vector_type(4)));
typedef int v8i __attribute__((ext_vector_type(8)));
struct AMapStd { int ldab = 0;   __device__ __forceinline__ unsigned voff(int R, int C) const { return (unsigned)(R * ldab + C * 2); } __device__ __forceinline__ size_t kstep() const { return 128; } __device__ __forceinline__ size_t hs() const { return (size_t)HALF * ldab; } };
struct AMapGLU { __device__ __forceinline__ unsigned voff(int R, int C) const { return (unsigned)(R * 32 + (C >> 4) * (T * 32) + (C & 15) * 2); } __device__ __forceinline__ size_t kstep() const { return (size_t)4 * T * 32; } __device__ __forceinline__ size_t hs() const { return (size_t)HALF * 32; } };
struct AMapHid { __device__ __forceinline__ unsigned voff(int R, int C) const { return (unsigned)(((C * 2) >> 5) * 8192 + R * 32 + ((C * 2) & 31)); } __device__ __forceinline__ size_t kstep() const { return 32768; } __device__ __forceinline__ size_t hs() const { return (size_t)HALF * 32; } };
struct AMapS5 { __device__ __forceinline__ unsigned voff(int R, int C) const { return (unsigned)(R * 49152 + (C >> 4) * 3072 + (C & 15) * 2); } __device__ __forceinline__ size_t kstep() const { return 12288; } __device__ __forceinline__ size_t hs() const { return (size_t)HALF * 49152; } };

__device__ __forceinline__ const char* uni_ptr(const char* p) {
    const unsigned long long v = (unsigned long long)p; const unsigned lo = __builtin_amdgcn_readfirstlane((unsigned)v), hi = __builtin_amdgcn_readfirstlane((unsigned)(v >> 32));
    return (const char*)(((unsigned long long)hi << 32) | lo); }
template <class Epi, class Sched, bool ALIGN_EPI = false, bool SP2 = false, class AMap = AMapStd, bool FP8 = false, bool PIN = true>
__device__ __forceinline__ void gemm_phase(LAS unsigned char* lds, const int tid, const Dims g, const Sched& S, const Epi& E, const AMap am_in = AMap{}) {
    constexpr int ES = FP8 ? 1 : 2;
    AMap am = am_in; if constexpr (__is_same(AMap, AMapStd)) am.ldab = g.lda * ES;
    const int wid = __builtin_amdgcn_readfirstlane(tid >> 6), lane = tid & 63, wr = wid >> 2, wc = wid & 3, fr = lane & 15, fq = lane >> 4;
    const int K = g.K, nt = (K * (FP8 ? 1 : 2)) / 128;
    unsigned voffA, voffB;
    { int R, C; stage_rc(tid * 16, R, C); const int Rb = Epi::PERM ? ((R & ~31) + perm32(R & 31)) : R;
        voffA = am.voff(R, C); voffB = (unsigned)(Rb * g.ldb * ES + C * 2); }
    const size_t d64voffA = am.voff(64, 0), d64voffB = (size_t)64 * g.ldb * ES;
    const size_t kstep = (size_t)(BK * 2), kstepA = am.kstep();
    const size_t hsA = am.hs(), hsB = (size_t)HALF * g.ldb * ES;
    const unsigned ldsw = (unsigned)wid * 1024u;
    const int aoff = lds_byte(wr * 64 + fr, fq * 8), boff = lds_byte(wc * 32 + fr, fq * 8);
#define PG8_SA(b, h) (((b) * 2 + (h)) * HTB)
#define PG8_SB(b, h) ((4 + (b) * 2 + (h)) * HTB)
#define PG8_STAGE(bufoff, gbase, voff) do { unsigned _vo = (voff); asm volatile("" : "+v"(_vo));   \
        const char* _g0 = (const char*)(gbase); if constexpr (PIN) asm volatile("" : "+s"(_g0)); const char* _g1 = _g0 + d64##voff; if constexpr (PIN) asm volatile("" : "+s"(_g1));   \
        __builtin_amdgcn_global_load_lds((const unsigned*)(_g0 + _vo), (LAS unsigned*)(lds + (bufoff) + ldsw), 16, 0, 0); \
        __builtin_amdgcn_global_load_lds((const unsigned*)(_g1 + _vo), (LAS unsigned*)(lds + (bufoff) + ldsw + 8192), 16, 0, 0); } while (0)
#define PG8_LD8(p) __builtin_shufflevector(*(const LAS v4i*)(p), *(const LAS v4i*)((p) + 1024), 0, 1, 2, 3, 4, 5, 6, 7)
#define PG8_LDA(dst, b, h) do { if constexpr (FP8) { _Pragma("unroll") for (int m = 0; m < 4; ++m) dst##8[m] = PG8_LD8(lds + PG8_SA(b, h) + aoff + m * 2048); } \
        else { _Pragma("unroll") for (int m = 0; m < 4; ++m) _Pragma("unroll") for (int k = 0; k < 2; ++k) dst[m][k] = *(const LAS bf16x8*)(lds + PG8_SA(b, h) + aoff + m * 2048 + k * 1024); } } while (0)
#define PG8_LDB(dst, b, h) do { if constexpr (FP8) { _Pragma("unroll") for (int n = 0; n < 2; ++n) dst##8[n] = PG8_LD8(lds + PG8_SB(b, h) + boff + n * 2048); } \
        else { _Pragma("unroll") for (int n = 0; n < 2; ++n) _Pragma("unroll") for (int k = 0; k < 2; ++k) dst[n][k] = *(const LAS bf16x8*)(lds + PG8_SB(b, h) + boff + n * 2048 + k * 1024); } } while (0)
#define PG8_MMA(ai, bj, At, Bt, ZC) do { __builtin_amdgcn_s_setprio(1); \
        if constexpr (FP8) { _Pragma("unroll") for (int m = 0; m < 4; ++m) _Pragma("unroll") for (int n = 0; n < 2; ++n) \
            acc[ai][bj][m][n] = __builtin_amdgcn_mfma_scale_f32_16x16x128_f8f6f4(Bt##8[n], At##8[m], (ZC) ? (f32x4){0.f, 0.f, 0.f, 0.f} : acc[ai][bj][m][n], 0, 0, 0, 0, 0, 0); } \
        else { _Pragma("unroll") for (int m = 0; m < 4; ++m) _Pragma("unroll") for (int n = 0; n < 2; ++n) _Pragma("unroll") for (int k = 0; k < 2; ++k) \
            acc[ai][bj][m][n] = __builtin_amdgcn_mfma_f32_16x16x32_bf16(Bt[n][k], At[m][k], ((ZC) && k == 0) ? (f32x4){0.f, 0.f, 0.f, 0.f} : acc[ai][bj][m][n], 0, 0, 0); } \
        __builtin_amdgcn_s_setprio(0); } while (0)
#define PG8_WAIT_V(n) asm volatile("s_waitcnt vmcnt(" #n ")" ::: "memory")
#define PG8_WAIT_L(n) asm volatile("s_waitcnt lgkmcnt(" #n ")" ::: "memory")
#define PG8_BAR __builtin_amdgcn_s_barrier()
#define PG8_SCHED __builtin_amdgcn_sched_barrier(0)
    int ui = 0;
    const char* cA; const char* cB;
    { Unit u0; if (!S.next(0, u0)) return; cA = uni_ptr(u0.a); cB = uni_ptr(u0.b); }
    f32x4 acc[2][2][4][2];
    bf16x8 At[4][2], B0[2][2], B1[2][2];
    v8i At8[4], B08[2], B18[2];
    if constexpr (SP2) {
        PG8_STAGE(PG8_SB(0, 0), cB, voffB); PG8_STAGE(PG8_SB(0, 1), cB + hsB, voffB); PG8_STAGE(PG8_SA(0, 0), cA, voffA); PG8_STAGE(PG8_SA(0, 1), cA + hsA, voffA);
        if (wr == 1) PG8_BAR;
        PG8_WAIT_V(2); PG8_BAR;
        PG8_STAGE(PG8_SB(1, 0), cB + kstep, voffB); PG8_STAGE(PG8_SA(1, 0), cA + kstepA, voffA); PG8_STAGE(PG8_SB(1, 1), cB + hsB + kstep, voffB);
        PG8_WAIT_V(6); PG8_BAR;
    } else {
        PG8_STAGE(PG8_SB(0, 0), cB, voffB); PG8_STAGE(PG8_SA(0, 0), cA, voffA); PG8_STAGE(PG8_SB(0, 1), cB + hsB, voffB); PG8_STAGE(PG8_SA(0, 1), cA + hsA, voffA);
        if (wr == 1) PG8_BAR;
        PG8_WAIT_V(4); PG8_BAR;
        PG8_STAGE(PG8_SB(1, 0), cB + kstep, voffB); PG8_STAGE(PG8_SA(1, 0), cA + kstepA, voffA); PG8_STAGE(PG8_SB(1, 1), cB + hsB + kstep, voffB);
        PG8_WAIT_V(6); PG8_BAR;
    }
    for (;;) {
        const char* nA = cA; const char* nB = cB; bool has_next;
        { Unit un; has_next = S.next(ui + 1, un); if (has_next) { nA = uni_ptr(un.a); nB = uni_ptr(un.b); } }
#define PG8_ITER(ZF) do { \
            const bool last = (t == nt - 2); \
            const char* a1 = cA + (size_t)(t + 1) * kstepA; \
            const char* a2 = last ? nA : cA + (size_t)(t + 2) * kstepA; const char* b2 = last ? nB : cB + (size_t)(t + 2) * kstep; \
            const char* a3 = a2 + kstepA; const char* b3 = b2 + kstep; \
            if constexpr (SP2) { \
            PG8_LDB(B0, 0, 0); PG8_LDB(B1, 0, 1); PG8_SCHED; PG8_LDA(At, 0, 0); PG8_STAGE(PG8_SA(1, 1), a1 + hsA, voffA); \
            PG8_WAIT_V(8); PG8_WAIT_L(0); PG8_BAR; PG8_MMA(0, 0, At, B0, ZF); PG8_MMA(0, 1, At, B1, ZF); PG8_BAR; PG8_SCHED; \
            PG8_LDA(At, 0, 1); PG8_STAGE(PG8_SB(0, 0), b2, voffB); PG8_STAGE(PG8_SB(0, 1), b2 + hsB, voffB); PG8_STAGE(PG8_SA(0, 0), a2, voffA); \
            PG8_WAIT_V(8); PG8_WAIT_L(0); PG8_BAR; PG8_MMA(1, 0, At, B0, ZF); PG8_MMA(1, 1, At, B1, ZF); PG8_BAR; PG8_SCHED; \
            PG8_LDB(B0, 1, 0); PG8_LDB(B1, 1, 1); PG8_SCHED; PG8_LDA(At, 1, 0); PG8_STAGE(PG8_SA(0, 1), a2 + hsA, voffA); \
            PG8_WAIT_V(8); PG8_WAIT_L(0); PG8_BAR; PG8_MMA(0, 0, At, B0, false); PG8_MMA(0, 1, At, B1, false); PG8_BAR; PG8_SCHED; \
            PG8_LDA(At, 1, 1); PG8_STAGE(PG8_SB(1, 0), b3, voffB); PG8_STAGE(PG8_SB(1, 1), b3 + hsB, voffB); PG8_STAGE(PG8_SA(1, 0), a3, voffA); \
            PG8_WAIT_V(8); PG8_WAIT_L(0); PG8_BAR; PG8_MMA(1, 0, At, B0, false); PG8_MMA(1, 1, At, B1, false); PG8_BAR; PG8_SCHED; \
            } else { \
            PG8_LDB(B0, 0, 0); PG8_SCHED; PG8_LDA(At, 0, 0); PG8_STAGE(PG8_SA(1, 1), a1 + hsA, voffA); \
            PG8_WAIT_L(8); PG8_BAR; PG8_WAIT_L(0); PG8_MMA(0, 0, At, B0, ZF); PG8_BAR; PG8_SCHED; \
            PG8_LDB(B1, 0, 1); PG8_STAGE(PG8_SB(0, 0), b2, voffB); \
            PG8_BAR; PG8_WAIT_L(0); PG8_MMA(0, 1, At, B1, ZF); PG8_BAR; \
            PG8_LDA(At, 0, 1); PG8_STAGE(PG8_SA(0, 0), a2, voffA); \
            PG8_BAR; PG8_WAIT_L(0); PG8_MMA(1, 0, At, B0, ZF); PG8_BAR; PG8_SCHED; \
            PG8_STAGE(PG8_SB(0, 1), b2 + hsB, voffB); \
            PG8_WAIT_V(6); PG8_BAR; PG8_MMA(1, 1, At, B1, ZF); PG8_BAR; \
            PG8_LDB(B0, 1, 0); PG8_SCHED; PG8_LDA(At, 1, 0); PG8_STAGE(PG8_SA(0, 1), a2 + hsA, voffA); \
            PG8_WAIT_L(8); PG8_BAR; PG8_WAIT_L(0); PG8_MMA(0, 0, At, B0, false); PG8_BAR; PG8_SCHED; \
            PG8_LDB(B1, 1, 1); PG8_STAGE(PG8_SB(1, 0), b3, voffB); \
            PG8_BAR; PG8_WAIT_L(0); PG8_MMA(0, 1, At, B1, false); PG8_BAR; \
            PG8_LDA(At, 1, 1); PG8_STAGE(PG8_SA(1, 0), a3, voffA); \
            PG8_BAR; PG8_WAIT_L(0); PG8_MMA(1, 0, At, B0, false); PG8_BAR; PG8_SCHED; \
            PG8_STAGE(PG8_SB(1, 1), b3 + hsB, voffB); \
            PG8_WAIT_V(6); PG8_BAR; PG8_MMA(1, 1, At, B1, false); PG8_BAR; \
            } \
        } while (0)
        { const int t = 0; PG8_ITER(true); }
#pragma unroll 1
        for (int t = 2; t < nt; t += 2) { PG8_ITER(false); }
#undef PG8_ITER
        if constexpr (ALIGN_EPI) { if (wr == 0) PG8_BAR; }
        { Unit uc; (void)S.next(ui, uc); E(acc, uc, wid); }
        if (!has_next) break;
        cA = nA; cB = nB; ++ui;
        if constexpr (ALIGN_EPI) { if (wr == 1) PG8_BAR; }
    }
    PG8_WAIT_V(0);
    if constexpr (!ALIGN_EPI) { if (wr == 0) PG8_BAR; }
    PG8_BAR;
#undef PG8_SA
#undef PG8_SB
#undef PG8_STAGE
#undef PG8_LDA
#undef PG8_LDB
#undef PG8_MMA
#undef PG8_LD8
#undef PG8_WAIT_V
#undef PG8_WAIT_L
#undef PG8_BAR
#undef PG8_SCHED
}

struct EpiStore {
    static constexpr bool PERM = true;
    __device__ __forceinline__ void operator()(const f32x4 (&acc)[2][2][4][2], const Unit& u, const int wid) const {
        int lane_; asm volatile("v_mbcnt_lo_u32_b32 %0, -1, 0\n\tv_mbcnt_hi_u32_b32 %0, -1, %0" : "=v"(lane_));
        const int wr = wid >> 2, wc = wid & 3, fr = lane_ & 15, fq = lane_ >> 4;
        bf16* base = (bf16*)u.o; int row0 = wr * 64 + fr, col0 = wc * 32 + 8 * fq; asm volatile("" : "+v"(row0), "+v"(col0)); const bool act = u.x0 == 1, gm = u.x0 == 2;
#pragma unroll
        for (int ai = 0; ai < 2; ++ai)
#pragma unroll
            for (int m = 0; m < 4; ++m) { const int r_ = row0 + ai * HALF + m * 16; bf16* rowp = base + (size_t)r_ * u.ldo + col0;
#pragma unroll
                for (int bj = 0; bj < 2; ++bj) { f32x4 v0 = acc[ai][bj][m][0], v1 = acc[ai][bj][m][1];
                    if (act) {
#pragma unroll
                        for (int j = 0; j < 4; j += 2) { const f32x2 a = gelu_tanh_2((f32x2){v0[j], v0[j + 1]}), b = gelu_tanh_2((f32x2){v1[j], v1[j + 1]}); v0[j] = a[0]; v0[j + 1] = a[1]; v1[j] = b[0]; v1[j + 1] = b[1]; } }
                    v4u w; w.x = cvt_pk_bf16(v0[0], v0[1]); w.y = cvt_pk_bf16(v0[2], v0[3]); w.z = cvt_pk_bf16(v1[0], v1[1]); w.w = cvt_pk_bf16(v1[2], v1[3]);
                    if (gm) { const int c_ = col0 + bj * HALF; *(v4u*)(base + ((size_t)(c_ >> 4) * T + r_) * 16 + (c_ & 15)) = w; }
                    else *(v4u*)(rowp + bj * HALF) = w; } }
    }
};
struct EpiSwiGLU {
    static constexpr bool PERM = true;
    __device__ __forceinline__ void operator()(const f32x4 (&acc)[2][2][4][2], const Unit& u, const int wid) const {
        int lane_; asm volatile("v_mbcnt_lo_u32_b32 %0, -1, 0\n\tv_mbcnt_hi_u32_b32 %0, -1, %0" : "=v"(lane_));
        const int wr = wid >> 2, wc = wid & 3, fr = lane_ & 15, fq = lane_ >> 4;
        bf16* base = (bf16*)u.o; int row0 = wr * 64 + fr, col0 = wc * 32 + 8 * fq; asm volatile("" : "+v"(row0), "+v"(col0));
#pragma unroll
        for (int ai = 0; ai < 2; ++ai)
#pragma unroll
            for (int m = 0; m < 4; ++m) { bf16* rowp = base + (size_t)(row0 + ai * HALF + m * 16) * u.ldo + col0;
                f32x4 h0, h1;
#pragma unroll
                for (int j = 0; j < 4; ++j) { const float g0 = acc[ai][0][m][0][j], g1 = acc[ai][0][m][1][j];
                    h0[j] = (g0 * acc[ai][1][m][0][j]) * __builtin_amdgcn_rcpf(1.f + __builtin_amdgcn_exp2f(g0 * -1.4426950408889634f));
                    h1[j] = (g1 * acc[ai][1][m][1][j]) * __builtin_amdgcn_rcpf(1.f + __builtin_amdgcn_exp2f(g1 * -1.4426950408889634f)); }
                v4u w; w.x = cvt_pk_bf16(h0[0], h0[1]); w.y = cvt_pk_bf16(h0[2], h0[3]); w.z = cvt_pk_bf16(h1[0], h1[1]); w.w = cvt_pk_bf16(h1[2], h1[3]);
                *(v4u*)rowp = w; }
    }
};
template <bool DENSE>
struct EpiSwiGLU8T {
    static constexpr bool PERM = true;
    __device__ __forceinline__ void operator()(const f32x4 (&acc)[2][2][4][2], const Unit& u, const int wid) const {
        int lane_; asm volatile("v_mbcnt_lo_u32_b32 %0, -1, 0\n\tv_mbcnt_hi_u32_b32 %0, -1, %0" : "=v"(lane_));
        const int wr = wid >> 2, wc = wid & 3, fr = lane_ & 15, fq = lane_ >> 4;
        unsigned char* base = (unsigned char*)u.o; int row0 = wr * 64 + fr, col0 = wc * 32 + 8 * fq; asm volatile("" : "+v"(row0), "+v"(col0));
        constexpr float SA = DENSE ? 1.0f : 1.0f / (Q_H * Q_W);
        constexpr float C1 = -1.4426950408889634f * SA, KK = 1.0f / (SA * SA * Q_HID), C0 = DENSE ? -3.0f : 25.0f;
        static_assert(Q_HID == 8.f && Q_H * Q_W == 16384.f, "C0 = log2(1 / (SA^2 Q_HID))");
#pragma unroll
        for (int ai = 0; ai < 2; ++ai)
#pragma unroll
            for (int m = 0; m < 4; ++m) { unsigned char* rowp = base + wc * 8192 + (row0 + ai * HALF + m * 16) * 32 + 8 * fq;
                f32x2 o[2][2];
#pragma unroll
                for (int n = 0; n < 2; ++n)
#pragma unroll
                    for (int jp = 0; jp < 2; ++jp) {
                        const f32x2 g = (f32x2){acc[ai][0][m][n][2 * jp], acc[ai][0][m][n][2 * jp + 1]}, uu = (f32x2){acc[ai][1][m][n][2 * jp], acc[ai][1][m][n][2 * jp + 1]};
                        const f32x2 t = g * C1 + C0;
                        const f32x2 sden = (f32x2){__builtin_amdgcn_exp2f(t[0]), __builtin_amdgcn_exp2f(t[1])} + KK;
                        const f32x2 rr = (f32x2){__builtin_amdgcn_rcpf(sden[0]), __builtin_amdgcn_rcpf(sden[1])};
                        o[n][jp] = (g * uu) * rr; }
                v2u w; w.x = pk_fp8x4(o[0][0][0], o[0][0][1], o[0][1][0], o[0][1][1]); w.y = pk_fp8x4(o[1][0][0], o[1][0][1], o[1][1][0], o[1][1][1]);
                *(v2u*)rowp = w; }
    }
};
typedef EpiSwiGLU8T<false> EpiSwiGLU8;
typedef EpiSwiGLU8T<true> EpiSwiGLU8D;
struct EpiStoreQ {
    static constexpr bool PERM = true;
    __device__ __forceinline__ void operator()(const f32x4 (&acc)[2][2][4][2], const Unit& u, const int wid) const {
        int lane_; asm volatile("v_mbcnt_lo_u32_b32 %0, -1, 0\n\tv_mbcnt_hi_u32_b32 %0, -1, %0" : "=v"(lane_));
        const int wr = wid >> 2, wc = wid & 3, fr = lane_ & 15, fq = lane_ >> 4;
        bf16* base = (bf16*)u.o; int row0 = wr * 64 + fr, col0 = wc * 32 + 8 * fq; asm volatile("" : "+v"(row0), "+v"(col0));
        constexpr float SA = 1.0f / (Q_HID * Q_W);
#pragma unroll
        for (int ai = 0; ai < 2; ++ai)
#pragma unroll
            for (int m = 0; m < 4; ++m) { bf16* rowp = base + (size_t)(row0 + ai * HALF + m * 16) * u.ldo + col0;
#pragma unroll
                for (int bj = 0; bj < 2; ++bj) { const f32x4 v0 = acc[ai][bj][m][0] * SA, v1 = acc[ai][bj][m][1] * SA;
                    v4u w; w.x = cvt_pk_bf16(v0[0], v0[1]); w.y = cvt_pk_bf16(v0[2], v0[3]); w.z = cvt_pk_bf16(v1[0], v1[1]); w.w = cvt_pk_bf16(v1[2], v1[3]);
                    *(v4u*)(rowp + bj * HALF) = w; } }
    }
};
struct EpiResid {
    static constexpr bool PERM = false;
    __device__ __forceinline__ void operator()(const f32x4 (&acc)[2][2][4][2], const Unit& u, const int wid) const {
        int lane_; asm volatile("v_mbcnt_lo_u32_b32 %0, -1, 0\n\tv_mbcnt_hi_u32_b32 %0, -1, %0" : "=v"(lane_));
        const int wr = wid >> 2, wc = wid & 3, fr = lane_ & 15, fq = lane_ >> 4;
        const float* xs = (const float*)u.p0; float* zo = (float*)u.o; const float* gv = (const float*)u.p1;
        int row0 = wr * 64 + fr, col0 = wc * 32 + 4 * fq; asm volatile("" : "+v"(row0), "+v"(col0));
#pragma unroll
        for (int ai = 0; ai < 2; ++ai)
#pragma unroll
            for (int m = 0; m < 4; ++m) { const size_t off = (size_t)(row0 + ai * HALF + m * 16) * D + col0;
#pragma unroll
                for (int bj = 0; bj < 2; ++bj)
#pragma unroll
                    for (int n = 0; n < 2; ++n) { const f32x4 xv = *(const f32x4*)(xs + off + bj * HALF + n * 16); const f32x4 gvv = *(const f32x4*)(gv + col0 + bj * HALF + n * 16);
                        *(f32x4*)(zo + off + bj * HALF + n * 16) = xv * ALPHA + gvv * acc[ai][bj][m][n]; }
                asm volatile("" ::: "memory"); }
    }
};
struct EpiResidLN {
    static constexpr bool PERM = true;
    const float* lng; const float* lnb; int sc_delta, sh_delta; bf16* H; unsigned* cnt; unsigned long long* xs; unsigned* tmo; LAS unsigned char* tab; float dq; bool h8;
    __device__ __forceinline__ void operator()(f32x4 (&acc)[2][2][4][2], const Unit& u, const int wid) const {
        int lane_; asm volatile("v_mbcnt_lo_u32_b32 %0, -1, 0\n\tv_mbcnt_hi_u32_b32 %0, -1, %0" : "=v"(lane_));
        const int wr = wid >> 2, wc = wid & 3, fr = lane_ & 15, fq = lane_ >> 4, pm = u.x0 >> 2, pn = u.x0 & 3;
        const bf16* xsrc = (const bf16*)u.p0; bf16* xo = (bf16*)u.o; const float* gv = (const float*)u.p1;
        int row0 = wr * 64 + fr, col0 = wc * 32 + 8 * fq; asm volatile("" : "+v"(row0), "+v"(col0));
        LAS f32x2* Pt = (LAS f32x2*)tab; LAS f32x2* St = (LAS f32x2*)(tab + 8192);
        f32x4 gg[2][2];
#pragma unroll
        for (int bj = 0; bj < 2; ++bj)
#pragma unroll
            for (int n = 0; n < 2; ++n) gg[bj][n] = *(const f32x4*)(gv + col0 + bj * HALF + n * 4) * dq;
#pragma unroll
        for (int ai = 0; ai < 2; ++ai) {
            v4u xw[1][4][2];
#pragma unroll
            for (int m = 0; m < 4; ++m)
#pragma unroll
                for (int bj = 0; bj < 2; ++bj) xw[0][m][bj] = *(const v4u*)(xsrc + (size_t)(row0 + ai * HALF + m * 16) * D + col0 + bj * HALF);
#pragma unroll
            for (int m = 0; m < 4; ++m) { float sm = 0.f, sq = 0.f;
#pragma unroll
                for (int bj = 0; bj < 2; ++bj) { const v4u w_ = xw[0][m][bj];
                    const f32x4 x0 = (f32x4){bflo(w_.x), bfhi(w_.x), bflo(w_.y), bfhi(w_.y)}, x1 = (f32x4){bflo(w_.z), bfhi(w_.z), bflo(w_.w), bfhi(w_.w)};
                    const f32x4 z0 = x0 * ALPHA + gg[bj][0] * acc[ai][bj][m][0], z1 = x1 * ALPHA + gg[bj][1] * acc[ai][bj][m][1]; acc[ai][bj][m][0] = z0; acc[ai][bj][m][1] = z1;
                    sm += ((z0[0] + z0[1]) + (z0[2] + z0[3])) + ((z1[0] + z1[1]) + (z1[2] + z1[3]));
                    sq += ((z0[0] * z0[0] + z0[1] * z0[1]) + (z0[2] * z0[2] + z0[3] * z0[3])) + ((z1[0] * z1[0] + z1[1] * z1[1]) + (z1[2] * z1[2] + z1[3] * z1[3])); }
                sm += __shfl_xor(sm, 16); sm += __shfl_xor(sm, 32); sq += __shfl_xor(sq, 16); sq += __shfl_xor(sq, 32);
                if (fq == 0) Pt[(ai * HALF + wr * 64 + m * 16 + fr) * 4 + wc] = (f32x2){sm, sq}; }
            asm volatile("" ::: "memory"); }
        const float* lg = lng + pn * 256; const float* lb = lnb + pn * 256; const float* scv = gv + sc_delta; const float* shv = gv + sh_delta;
        f32x4 g4[2][2], b4[2][2], s4[2][2], t4[2][2];
#pragma unroll
        for (int bj = 0; bj < 2; ++bj)
#pragma unroll
            for (int n = 0; n < 2; ++n) { const int c = col0 + bj * HALF + n * 4; g4[bj][n] = *(const f32x4*)(lg + c); b4[bj][n] = *(const f32x4*)(lb + c); s4[bj][n] = *(const f32x4*)(scv + c); t4[bj][n] = *(const f32x4*)(shv + c); }
        asm volatile("s_waitcnt lgkmcnt(0)" ::: "memory"); __builtin_amdgcn_s_barrier(); asm volatile("" ::: "memory");
        const int trow = wid * 64 + lane_;
        if (wid < 4) {
            const f32x2 a = Pt[trow * 4 + 0], b = Pt[trow * 4 + 1], c = Pt[trow * 4 + 2], d = Pt[trow * 4 + 3];
            const float ts = (a.x + b.x) + (c.x + d.x), tq = (a.y + b.y) + (c.y + d.y);
            __hip_atomic_store(xs + ((size_t)pm * 256 + trow) * 4 + pn, ((unsigned long long)__float_as_uint(tq) << 32) | __float_as_uint(ts), __ATOMIC_RELAXED, __HIP_MEMORY_SCOPE_AGENT);
            asm volatile("s_waitcnt vmcnt(0)" ::: "memory");
            if (lane_ == 0) __hip_atomic_fetch_add(cnt + pm * 16, 1u, __ATOMIC_RELAXED, __HIP_MEMORY_SCOPE_AGENT);
        }
        if (wid == 0) {
            unsigned sp = 0;
            while ((unsigned)__builtin_amdgcn_readfirstlane(__hip_atomic_load(cnt + pm * 16, __ATOMIC_RELAXED, __HIP_MEMORY_SCOPE_AGENT)) < 16u) {
                __builtin_amdgcn_s_sleep(1);
                if ((++sp & 1023u) == 0u && (sp > (1u << 24) || __hip_atomic_load(tmo, __ATOMIC_RELAXED, __HIP_MEMORY_SCOPE_AGENT) != 0u)) { if (lane_ == 0) __hip_atomic_store(tmo, 1u, __ATOMIC_RELAXED, __HIP_MEMORY_SCOPE_AGENT); break; } }
            __builtin_amdgcn_fence(__ATOMIC_ACQUIRE, "agent");
        }
        asm volatile("s_waitcnt vmcnt(0) lgkmcnt(0)" ::: "memory"); __builtin_amdgcn_s_barrier(); asm volatile("" ::: "memory");
        if (wid < 4) {
            const unsigned long long* sl = xs + ((size_t)pm * 256 + trow) * 4; float ts = 0.f, tq = 0.f;
#pragma unroll
            for (int t = 0; t < 4; ++t) { const unsigned long long w = __hip_atomic_load(sl + t, __ATOMIC_RELAXED, __HIP_MEMORY_SCOPE_AGENT); ts += __uint_as_float((unsigned)w); tq += __uint_as_float((unsigned)(w >> 32)); }
            const float mean = ts * (1.f / D), var = fmaxf(tq * (1.f / D) - mean * mean, 0.f);
            St[trow] = (f32x2){mean, rsqrtf(var + LN_EPS)};
        }
        asm volatile("s_waitcnt vmcnt(0) lgkmcnt(0)" ::: "memory"); __builtin_amdgcn_s_barrier(); asm volatile("" ::: "memory");
        bf16* hb = h8 ? (bf16*)((unsigned char*)H + ((size_t)pm * 256) * D + pn * 256) : H + ((size_t)pm * 256) * D + pn * 256;
#pragma unroll
        for (int bj = 0; bj < 2; ++bj)
#pragma unroll
            for (int n = 0; n < 2; ++n) s4[bj][n] = s4[bj][n] + 1.0f;
#pragma unroll
        for (int ai = 0; ai < 2; ++ai)
#pragma unroll
            for (int m = 0; m < 4; ++m) { const int r = row0 + ai * HALF + m * 16; const f32x2 ms = St[r]; const size_t off = (size_t)r * D + col0;
#pragma unroll
                for (int bj = 0; bj < 2; ++bj) {
                    const f32x4 xa = (acc[ai][bj][m][0] - ms.x) * ms.y * g4[bj][0] + b4[bj][0], xc_ = (acc[ai][bj][m][1] - ms.x) * ms.y * g4[bj][1] + b4[bj][1];
                    v4u wx; wx.x = cvt_pk_bf16(xa[0], xa[1]); wx.y = cvt_pk_bf16(xa[2], xa[3]); wx.z = cvt_pk_bf16(xc_[0], xc_[1]); wx.w = cvt_pk_bf16(xc_[2], xc_[3]);
                    *(v4u*)(xo + off + bj * HALF) = wx;
                    const f32x4 ha = xa * s4[bj][0] + t4[bj][0], hc = xc_ * s4[bj][1] + t4[bj][1];
                    if (h8) { v2u w8; w8.x = pk_fp8x4(ha[0] * Q_H, ha[1] * Q_H, ha[2] * Q_H, ha[3] * Q_H); w8.y = pk_fp8x4(hc[0] * Q_H, hc[1] * Q_H, hc[2] * Q_H, hc[3] * Q_H);
                        *(v2u*)((unsigned char*)hb + off + bj * HALF) = w8; }
                    else { v4u wh; wh.x = cvt_pk_bf16(ha[0], ha[1]); wh.y = cvt_pk_bf16(ha[2], ha[3]); wh.z = cvt_pk_bf16(hc[0], hc[1]); wh.w = cvt_pk_bf16(hc[2], hc[3]);
                        *(v4u*)(hb + off + bj * HALF) = wh; } } }
    }
};
struct EpiGLU {
    static constexpr bool PERM = true, PREFETCH = false;
    __device__ __forceinline__ void operator()(const f32x4 (&acc)[2][2][4][2], const Unit& u, const int wid) const {
        int lane_; asm volatile("v_mbcnt_lo_u32_b32 %0, -1, 0\n\tv_mbcnt_hi_u32_b32 %0, -1, %0" : "=v"(lane_));
        const int wr = wid >> 2, wc = wid & 3, fr = lane_ & 15, fq = lane_ >> 4;
        bf16* base = (bf16*)u.o; const bf16* gp = (const bf16*)u.p0; const float* bias = (const float*)u.p1;
        int row0 = wr * 64 + fr, col0 = wc * 32 + 8 * fq; asm volatile("" : "+v"(row0), "+v"(col0));
        v4u gwv[2][4][2]; f32x4 bv[2][2];
#pragma unroll
        for (int ai = 0; ai < 2; ++ai)
#pragma unroll
            for (int m = 0; m < 4; ++m)
#pragma unroll
                for (int bj = 0; bj < 2; ++bj) { const int c_ = col0 + bj * HALF; gwv[ai][m][bj] = *(const v4u*)(gp + ((size_t)(c_ >> 4) * T + (row0 + ai * HALF + m * 16)) * 16 + (c_ & 15)); }
#pragma unroll
        for (int bj = 0; bj < 2; ++bj) { bv[bj][0] = *(const f32x4*)(bias + col0 + bj * HALF); bv[bj][1] = *(const f32x4*)(bias + col0 + bj * HALF + 4); }
#pragma unroll
        for (int ai = 0; ai < 2; ++ai)
#pragma unroll
            for (int m = 0; m < 4; ++m) { const int r = row0 + ai * HALF + m * 16;
#pragma unroll
                for (int bj = 0; bj < 2; ++bj) { const v4u gw = gwv[ai][m][bj];
                    const f32x4 a0 = acc[ai][bj][m][0] + bv[bj][0], a1 = acc[ai][bj][m][1] + bv[bj][1];
                    const f32x2 p0 = (f32x2){bflo(gw.x), bfhi(gw.x)} * sigmoid_2((f32x2){a0[0], a0[1]}), p1 = (f32x2){bflo(gw.y), bfhi(gw.y)} * sigmoid_2((f32x2){a0[2], a0[3]});
                    const f32x2 p2 = (f32x2){bflo(gw.z), bfhi(gw.z)} * sigmoid_2((f32x2){a1[0], a1[1]}), p3 = (f32x2){bflo(gw.w), bfhi(gw.w)} * sigmoid_2((f32x2){a1[2], a1[3]});
                    v4u w; w.x = cvt_pk_bf16(p0[0], p0[1]); w.y = cvt_pk_bf16(p1[0], p1[1]); w.z = cvt_pk_bf16(p2[0], p2[1]); w.w = cvt_pk_bf16(p3[0], p3[1]);
                    *(v4u*)(base + (size_t)r * u.ldo + col0 + bj * HALF) = w; } }
    }
};
struct EpiS5B {
    static constexpr bool PERM = true, PREFETCH = false;
    __device__ __forceinline__ void operator()(const f32x4 (&acc)[2][2][4][2], const Unit& u, const int wid) const {
        int lane_; asm volatile("v_mbcnt_lo_u32_b32 %0, -1, 0\n\tv_mbcnt_hi_u32_b32 %0, -1, %0" : "=v"(lane_));
        const int wr = wid >> 2, wc = wid & 3, fr = lane_ & 15, fq = lane_ >> 4;
        bf16* base = (bf16*)u.o; const bf16* y1 = (const bf16*)u.p0;
        int row0 = wr * 64 + fr, col0 = wc * 32 + 8 * fq; asm volatile("" : "+v"(row0), "+v"(col0));
        v4u yw[2][4][2];
#pragma unroll
        for (int ai = 0; ai < 2; ++ai)
#pragma unroll
            for (int m = 0; m < 4; ++m)
#pragma unroll
                for (int bj = 0; bj < 2; ++bj) yw[ai][m][bj] = *(const v4u*)(y1 + (size_t)(row0 + ai * HALF + m * 16) * 256 + col0 + bj * HALF);
#pragma unroll
        for (int ai = 0; ai < 2; ++ai)
#pragma unroll
            for (int m = 0; m < 4; ++m) { const int r = row0 + ai * HALF + m * 16;
#pragma unroll
                for (int bj = 0; bj < 2; ++bj) { const int c = col0 + bj * HALF; const v4u w_ = yw[ai][m][bj];
                    const f32x4 a0 = acc[ai][bj][m][0], a1 = acc[ai][bj][m][1];
                    const f32x2 p0 = gelu_tanh_2((f32x2){a0[0], a0[1]} + (f32x2){bflo(w_.x), bfhi(w_.x)}), p1 = gelu_tanh_2((f32x2){a0[2], a0[3]} + (f32x2){bflo(w_.y), bfhi(w_.y)});
                    const f32x2 p2 = gelu_tanh_2((f32x2){a1[0], a1[1]} + (f32x2){bflo(w_.z), bfhi(w_.z)}), p3 = gelu_tanh_2((f32x2){a1[2], a1[3]} + (f32x2){bflo(w_.w), bfhi(w_.w)});
                    v4u w; w.x = cvt_pk_bf16(p0[0], p0[1]); w.y = cvt_pk_bf16(p1[0], p1[1]); w.z = cvt_pk_bf16(p2[0], p2[1]); w.w = cvt_pk_bf16(p3[0], p3[1]);
                    *(v4u*)(base + (size_t)r * 256 + c) = w; } }
    }
};
}

struct Params { const float* in[32]; float* out; unsigned char* ws; int ph_lo, ph_hi; };
enum { I_X = 0, I_C, I_CTX, I_CCTX, I_WMOD, I_BMOD, I_LNG, I_LNB, I_EV_WIN, I_EV_WOUT, I_EV_SINK, I_EV_W1, I_EV_W3, I_EV_W2, I_OD_WIN, I_A_RE, I_A_IM, I_LOG_DT,
       I_B_RE, I_B_IM, I_C_RE, I_C_IM, I_SSM_D, I_WGLU, I_BGLU, I_WS, I_BS, I_OD_WOUT, I_ROUTER, I_MW1, I_MW3, I_MW2 };

constexpr int LDS_RING = 131072, LDS_MISC = LDS_RING + 320, LDS_LNTAB = LDS_RING + 1024, LDS_BYTES = 147456;
constexpr int NWAVES = 8, NTHREADS = 512;

struct Frame {
    LAS unsigned char* lds;
    int tid, lane, wave, G, bid, gw, NGW;
    unsigned char* ws;
    unsigned* ctl;
};

using pg8::Unit;
__device__ __forceinline__ void xcd_rows(int c, int nM, int& r0, int& cnt) { const int x = c & 7, base = nM >> 3, extra = nM & 7; cnt = base + (x < extra ? 1 : 0); r0 = x * base + (x < extra ? x : extra); }
__device__ __forceinline__ void grp_unit(int q, int cnt, int nN, int RG, int& row_local, int& pn) {
    const int gfull = RG * nN, rg = q / gfull, rem = q - rg * gfull; int rows_here = cnt - rg * RG; rows_here = rows_here < RG ? rows_here : RG;
    pn = rem / rows_here; row_local = rg * RG + (rem - pn * rows_here);
}
__device__ __forceinline__ bool xcd_unit(int i, int G, int c, int nM, int nN, int RG, int& pm, int& pn) {
    int r0, cnt; xcd_rows(c, nM, r0, cnt); const int q = i * (G >> 3) + (c >> 3); if (q >= cnt * nN) return false;
    int rl; grp_unit(q, cnt, nN, RG, rl, pn); pm = r0 + rl; return true;
}
struct SchedStd {
    int nN, nUnits, G, c; const char* A; const char* B; char* O; size_t aStep, bStep, oRow, oCol; int ldo, act_from;
    __device__ __forceinline__ bool next(int i, Unit& u) const {
        int pm, pn; if (!xcd_unit(i, G, c, nUnits / nN, nN, 4, pm, pn)) return false;
        u.a = A + (size_t)pm * aStep; u.b = B + (size_t)pn * bStep; u.o = O + (size_t)pm * oRow + (size_t)pn * oCol; u.p0 = nullptr; u.p1 = nullptr; u.ldo = ldo; u.x0 = (pn >= act_from) ? 1 : 0; return true;
    }
};
struct SchedEvIn {
    int G, c; const char* H; const char* Wqkv; const char* Wpq; char* QKV; char* PQT; char* PQTC;
    __device__ __forceinline__ bool next(int i, Unit& u) const {
        u.p0 = nullptr; u.p1 = nullptr; u.x0 = 0;
        int r0, cnt; xcd_rows(c, T / 256, r0, cnt);
        int q = i * (G >> 3) + (c >> 3);
        if (q < cnt * 3) { int rl, pn; grp_unit(q, cnt, 3, 4, rl, pn); const int pm = r0 + rl;
            u.a = H + (size_t)pm * 256 * D * 2; u.b = Wqkv + (size_t)pn * 256 * D * 2; u.o = QKV + ((size_t)pm * 256 * 768 + pn * 256) * 2; u.ldo = 768; return true; }
        q -= cnt * 3; if (q >= cnt * 4) return false;
        int rl, pm; grp_unit(q, cnt, 4, 4, rl, pm); const int tt = r0 + rl, isq = pm >> 1, ch0 = (pm & 1) * 256;
        u.a = Wpq + (size_t)pm * 256 * D * 2; u.b = H + (size_t)tt * 256 * D * 2;
        if (tt < TL / 256) { const int b = tt >> 4, n0 = (tt & 15) * 256; u.o = PQT + ((((size_t)b * 512 + ch0) * 2 + isq) * 4096 + n0) * 2; u.ldo = 8192; }
        else { const int b = tt - TL / 256; u.o = PQTC + (((size_t)b * 512 + ch0) * 2 + isq) * 256 * 2; u.ldo = 512; }
        return true;
    }
};
struct SchedDft {
    int G, c; const char* FDm; const char* VB; const char* F2; const char* PQTC; char* MIX;
    __device__ __forceinline__ bool next(int i, Unit& u) const {
        int L = i * G + c; u.p0 = nullptr; u.p1 = nullptr; u.x0 = 0;
        if (L < 512) { const int b = L >> 5, pn = L & 31, k2 = pn >> 1, ch0 = (pn & 1) * 256;
            u.a = FDm; u.b = VB + ((((size_t)b * 16 + k2) * 512 + ch0) * 512) * 2; u.o = MIX + ((((size_t)b * 4096 + k2) * D) + ch0) * 2; u.ldo = 16 * D; return true; }
        L -= 512; if (L >= 32) return false;
        const int b = L >> 1, pn = L & 1;
        u.a = F2; u.b = PQTC + ((size_t)b * 512 + pn * 256) * 512 * 2; u.o = MIX + (((size_t)TL + (size_t)b * 256) * D + pn * 256) * 2; u.ldo = D; return true;
    }
};
struct SchedResid {
    int G, c, nUnits; const char* A; size_t aStep; const char* W; size_t bStep; bf16* xb; const float* gate;
    __device__ __forceinline__ bool next(int i, Unit& u) const {
        int pm, pn; if (!xcd_unit(i, G, c, nUnits >> 2, 4, 1, pm, pn)) return false;
        const int L = pm * 4 + pn;
        u.a = A + (size_t)pm * aStep; u.b = W + (size_t)pn * bStep;
        const bool isc = pm >= TL / 256; const int mrow = isc ? 16 : (pm >> 4);
        const size_t off = ((size_t)pm * 256 * D + pn * 256);
        u.p0 = (const char*)(xb + off); u.o = (char*)(xb + off); u.p1 = (const char*)(gate + (size_t)mrow * 6144 + pn * 256); u.ldo = D; u.x0 = L; return true;
    }
};
struct SchedO1 {
    int G, c; const char* H; const char* W; char* Pp; char* UG;
    __device__ __forceinline__ bool next(int i, Unit& u) const {
        int pm, pn; if (!xcd_unit(i, G, c, T / 256, 6, 4, pm, pn)) return false;
        u.a = H + (size_t)pm * 256 * D * 2; u.b = W + (size_t)pn * 256 * D * 2; u.p0 = nullptr; u.p1 = nullptr;
        if (pn < 2) { u.o = UG + (((size_t)(pn * 16) * T + (size_t)pm * 256) * 16) * 2; u.ldo = 0; u.x0 = 2; }
        else { u.o = Pp + ((size_t)pm * 256 * D + (pn - 2) * 256) * 2; u.ldo = D; u.x0 = 1; }
        return true;
    }
};
struct SchedGlu {
    int G, c; const char* UG; const char* W; char* MIX; const float* bias;
    __device__ __forceinline__ bool next(int i, Unit& u) const {
        const int L = i * G + c; if (L >= (T / 256) * 2) return false;
        const int pm = L >> 1, pn = L & 1;
        u.a = UG + (size_t)pm * 256 * 32; u.b = W + (size_t)pn * 256 * 512 * 2; u.o = MIX + ((size_t)pm * 256 * D + pn * 256) * 2;
        u.p0 = UG + (((size_t)(pn * 16) * T + (size_t)pm * 256) * 16) * 2; u.p1 = (const char*)(bias + pn * 256); u.ldo = D; u.x0 = 0; return true;
    }
};
struct SchedS5A {
    int G, c; const char* UG; const char* WA; char* Y1; char* HB;
    __device__ __forceinline__ bool next(int i, Unit& u) const {
        const int L = i * G + c; if (L >= 32 * 34) return false;
        const int g = L / 34, rem = L - g * 34, pm = rem >> 1, pn = rem & 1;
        const size_t toff = (((size_t)g * 4352 + (size_t)pm * 256) * 256) * 2;
        u.a = UG + toff; u.b = WA + (size_t)g * S5M_STRIDE + (size_t)pn * 256 * 256 * 2;
        u.o = (pn ? HB : Y1) + toff; u.p0 = nullptr; u.p1 = nullptr; u.ldo = 256; u.x0 = 0; return true;
    }
};
struct SchedS5B {
    int G, c; const char* HB; const char* CL; const char* Y1; char* UG;
    __device__ __forceinline__ bool next(int i, Unit& u) const {
        const int L = i * G + c; if (L >= 32 * 17) return false;
        const int g = L / 17, pm = L - g * 17;
        const size_t toff = (((size_t)g * 4352 + (size_t)pm * 256) * 256) * 2;
        u.a = HB + toff; u.b = CL + (size_t)g * S5M_STRIDE; u.p0 = Y1 + toff; u.o = UG + toff; u.p1 = nullptr; u.ldo = 256; u.x0 = 0; return true;
    }
};
struct SchedMoeUp {
    int G, c, nUnits, rt0; int toff[9]; const char* HS; const char* W; char* HID;
    __device__ __forceinline__ bool next(int i, Unit& u) const {
        int rl, pn; if (!xcd_unit(i, G, c, nUnits / 28, 28, 4, rl, pn)) return false;
        const int rt = rt0 + rl; int e = 0;
#pragma unroll
        for (int k = 1; k < 8; ++k) e += (rt >= toff[k]) ? 1 : 0;
        u.a = HS + (size_t)rt * 256 * D; u.b = W + ((size_t)e * 7168 + pn * 256) * D; u.o = HID + ((size_t)rl * 28 + pn) * 32768;
        u.p0 = nullptr; u.p1 = nullptr; u.ldo = EH; u.x0 = 0; return true;
    }
};
struct SchedMoeDown {
    int G, c, nUnits, rt0; int toff[9]; const char* HID; const char* W; char* Y;
    __device__ __forceinline__ bool next(int i, Unit& u) const {
        int rl, pn; if (!xcd_unit(i, G, c, nUnits >> 2, 4, 8, rl, pn)) return false;
        const int rt = rt0 + rl; int e = 0;
#pragma unroll
        for (int k = 1; k < 8; ++k) e += (rt >= toff[k]) ? 1 : 0;
        u.a = HID + (size_t)rl * 28 * 32768; u.b = W + ((size_t)e * 1024 + pn * 256) * EH; u.o = Y + ((size_t)rt * 256 * D + pn * 256) * 2;
        u.p0 = nullptr; u.p1 = nullptr; u.ldo = D; u.x0 = 0; return true;
    }
};

constexpr int CVT_ITEMS = 2 * 5120 + 2 * 1408 + 2 * 8 * 3 * 1792;
constexpr int CVT_W2_0 = 2 * 896 + 2 * 1408;
constexpr int CVT_MOE0 = 2 * 5120 + 2 * 1408, CVT_MOE_LI = 8 * 3 * 1792;
struct CvtDesc { const float* src; unsigned char* dst; int ldn, ldk; };
template <class PPtr>
__device__ __forceinline__ CvtDesc cvt_decode(PPtr pp, unsigned char* ws, int r) {
    constexpr int EV_ITEMS = 384 + 512;
    constexpr int ODS_ITEMS = 768 + 128 + 512;
    constexpr int EXP_ITEMS = 3 * 1792, MOE_ITEMS = 8 * EXP_ITEMS;
    int idx, ldn, N, ldk, es = 2, mode = 0, roff = 0; size_t soff, doff;
    if (r < 2 * EV_ITEMS) { const int li = r / EV_ITEMS; r -= li * EV_ITEMS; const size_t base = WS_EV + (size_t)li * EV_STRIDE;
        if (r < 384) { idx = I_EV_WIN; soff = (size_t)li * D * 1280 + 512; ldn = 1280; N = 768; doff = base + EV_WQKV; ldk = D; }
        else { r -= 384; idx = I_EV_WOUT; soff = (size_t)li * D * D; ldn = D; N = D; doff = base + EV_WOUT; ldk = D; } }
    else if (r < 2 * EV_ITEMS + 2 * ODS_ITEMS) { r -= 2 * EV_ITEMS; const int li = r / ODS_ITEMS; r -= li * ODS_ITEMS; const size_t base = WS_OD + (size_t)li * OD_STRIDE;
        if (r < 768) { idx = I_OD_WIN; soff = (size_t)li * D * 1536; ldn = 1536; N = 1536; doff = base + OD_WIN; ldk = D; }
        else if (r < 896) { r -= 768; idx = I_WGLU; soff = (size_t)li * 512 * 512; ldn = 512; N = 512; doff = base + OD_WGLU; ldk = 512; }
        else { r -= 896; idx = I_OD_WOUT; soff = (size_t)li * D * D; ldn = D; N = D; doff = base + OD_WOUT; ldk = D; } }
    else if (r < CVT_MOE0) { r -= CVT_W2_0; const int li = r / 4224; r -= li * 4224; es = 1; const size_t base = WS_EV + (size_t)li * EV_STRIDE;
        if (r < 1408) { idx = I_EV_W1; soff = (size_t)li * D * FFH; ldn = FFH; N = FFH; doff = base + EV_W13; ldk = D; mode = 1; }
        else if (r < 2816) { r -= 1408; idx = I_EV_W3; soff = (size_t)li * D * FFH; ldn = FFH; N = FFH; doff = base + EV_W13; ldk = D; mode = 1; roff = 128; }
        else { r -= 2816; idx = I_EV_W2; soff = (size_t)li * FFH * D; ldn = D; N = D; doff = base + EV_W2; ldk = FFH; } }
    else { r -= CVT_MOE0; const int li = r / MOE_ITEMS; r -= li * MOE_ITEMS; const int e = r / EXP_ITEMS; r -= e * EXP_ITEMS; const size_t base = WS_OD + (size_t)li * OD_STRIDE;
        const size_t we = (size_t)li * NEXP + e; es = 1;
        if (r < 1792) { idx = I_MW1; soff = we * D * EH; ldn = EH; N = EH; doff = base + OD_MW13 + (size_t)e * 7168 * D; ldk = D; mode = 1; }
        else if (r < 3584) { r -= 1792; idx = I_MW3; soff = we * D * EH; ldn = EH; N = EH; doff = base + OD_MW13 + (size_t)e * 7168 * D; ldk = D; mode = 1; roff = 128; }
        else { r -= 3584; idx = I_MW2; soff = we * EH * D; ldn = D; N = D; doff = base + OD_MW2 + (size_t)e * D * EH; ldk = EH; } }
    const int nblk = N / 32, kb = r / nblk, nb = r - kb * nblk, n0 = nb * 32, k0 = kb * 64;
    const int drow0 = mode ? ((n0 >> 7) * 256 + (n0 & 127) + roff) : (roff + n0);
    CvtDesc d; d.src = (const float*)pp->in[idx] + soff + (size_t)k0 * ldn + n0; d.dst = ws + doff + ((size_t)drow0 * ldk + k0) * es; d.ldn = ldn; d.ldk = ldk; return d;
}
__device__ __forceinline__ void cvt_load(const CvtDesc& d, int lane, f32x4 (&v)[8]) {
    const float* q = d.src + (size_t)(lane >> 3) * d.ldn + (lane & 7) * 4;
#pragma unroll
    for (int j = 0; j < 8; ++j) v[j] = *(const f32x4*)(q + (size_t)(8 * j) * d.ldn);
}
template <bool FP8>
__device__ __forceinline__ void cvt_finish(const CvtDesc& d, const f32x4 (&v)[8], LAS float* scr, int lane) {
    constexpr float qs = FP8 ? Q_W : 1.0f;
    { LAS float* q = scr + (lane >> 3) * 33 + (lane & 7) * 4;
#pragma unroll
      for (int j = 0; j < 8; ++j) { q[(8 * j) * 33 + 0] = v[j][0] * qs; q[(8 * j) * 33 + 1] = v[j][1] * qs; q[(8 * j) * 33 + 2] = v[j][2] * qs; q[(8 * j) * 33 + 3] = v[j][3] * qs; } }
    LDS_WAIT(); asm volatile("" ::: "memory");
    const int c = lane & 7;
#pragma unroll
    for (int j = 0; j < 4; ++j) { const int n = (lane >> 3) + 8 * j; const LAS float* sp = scr + (8 * c) * 33 + n;
        if constexpr (FP8) { v2u o; o.x = pk_fp8x4(sp[0 * 33], sp[1 * 33], sp[2 * 33], sp[3 * 33]); o.y = pk_fp8x4(sp[4 * 33], sp[5 * 33], sp[6 * 33], sp[7 * 33]);
            *(v2u*)(d.dst + (size_t)n * d.ldk + 8 * c) = o; }
        else { v4u o; o.x = cvt_pk_bf16(sp[0 * 33], sp[1 * 33]); o.y = cvt_pk_bf16(sp[2 * 33], sp[3 * 33]); o.z = cvt_pk_bf16(sp[4 * 33], sp[5 * 33]); o.w = cvt_pk_bf16(sp[6 * 33], sp[7 * 33]);
            *(v4u*)(d.dst + ((size_t)n * d.ldk + 8 * c) * 2) = o; } }
    LDS_WAIT(); asm volatile("" ::: "memory");
}
template <bool FP8, class PPtr>
__device__ __forceinline__ void cvt_range(PPtr pp, unsigned char* ws, int first, int end, int stride, LAS float* scr, int lane) {
    if (first >= end) return;
    CvtDesc d = cvt_decode(pp, ws, first); f32x4 v[8]; cvt_load(d, lane, v);
    for (int it = first; it < end; it += stride) {
        int nx = it + stride; nx = nx < end ? nx : it;
        const CvtDesc dn = cvt_decode(pp, ws, nx); f32x4 vn[8]; cvt_load(dn, lane, vn);
        cvt_finish<FP8>(d, v, scr, lane);
        d = dn;
#pragma unroll
        for (int j = 0; j < 8; ++j) v[j] = vn[j];
    }
}

__device__ __forceinline__ void fold_unit(const Params& p, Frame& F, int unit) {
    const int li = unit >> 6, g = (unit >> 4) & 3, k0 = (unit & 15) * 64;
    LAS float* tile = (LAS float*)F.lds;
    LAS float* trig = tile + 64 * 129;
    const float* W = p.in[I_EV_WIN] + (size_t)li * D * 1280;
    for (int e = F.tid; e < 64 * 128; e += NTHREADS) { const int k = e >> 7, c = e & 127; tile[k * 129 + c] = W[(size_t)(k0 + k) * 1280 + g * 128 + c]; }
    if (F.tid < 128) { float s, c; sincospif((float)F.tid / 64.0f, &s, &c); trig[F.tid] = c * 0.08838834764831845f; trig[128 + F.tid] = s * 0.08838834764831845f; }
    __syncthreads();
    bf16* WT = (bf16*)(p.ws + WS_EV + li * EV_STRIDE + EV_WPQ);
    const int k = F.lane, mg = F.wave;
    for (int mm = 0; mm < 16; ++mm) { const int m = mg * 16 + mm; float sp = 0.f, sq = 0.f;
        for (int c = 0; c < 128; ++c) { const float w = tile[k * 129 + c]; const int ph = (m * c) & 127; sp += w * trig[ph]; sq += w * trig[128 + ph]; }
        WT[(size_t)(g * 128 + m) * D + k0 + k] = f2bf(sp); WT[(size_t)(512 + g * 128 + m) * D + k0 + k] = f2bf(sq); }
    __syncthreads();
}

__device__ __forceinline__ void row_load(const float* row, int lane, f32x4 (&v)[4]) {
#pragma unroll
    for (int j = 0; j < 4; ++j) v[j] = *(const f32x4*)(row + 256 * j + 4 * lane);
}
__device__ __forceinline__ void row_load_bf16(const bf16* row, int lane, f32x4 (&v)[4]) {
#pragma unroll
    for (int j = 0; j < 4; ++j) { const v2u w = *(const v2u*)(row + 256 * j + 4 * lane); v[j] = (f32x4){bflo(w.x), bfhi(w.x), bflo(w.y), bfhi(w.y)}; }
}
__device__ __forceinline__ void row_store(float* row, int lane, const f32x4 (&v)[4]) {
#pragma unroll
    for (int j = 0; j < 4; ++j) *(f32x4*)(row + 256 * j + 4 * lane) = v[j];
}
__device__ __forceinline__ void row_store_bf16(bf16* row, int lane, const f32x4 (&v)[4]) {
#pragma unroll
    for (int j = 0; j < 4; ++j) { v2u w; w.x = cvt_pk_bf16(v[j][0], v[j][1]); w.y = cvt_pk_bf16(v[j][2], v[j][3]); *(v2u*)(row + 256 * j + 4 * lane) = w; }
}
__device__ __forceinline__ void row_layernorm(f32x4 (&v)[4], const float* g, const float* b, int lane) {
    float s = 0.f;
#pragma unroll
    for (int j = 0; j < 4; ++j) s += (v[j][0] + v[j][1]) + (v[j][2] + v[j][3]);
    const float mean = wave_sum(s) * (1.f / D); float q = 0.f;
#pragma unroll
    for (int j = 0; j < 4; ++j) { v[j] = v[j] - mean; q += (v[j][0] * v[j][0] + v[j][1] * v[j][1]) + (v[j][2] * v[j][2] + v[j][3] * v[j][3]); }
    const float rstd = rsqrtf(wave_sum(q) * (1.f / D) + LN_EPS);
#pragma unroll
    for (int j = 0; j < 4; ++j) { const f32x4 gg = *(const f32x4*)(g + 256 * j + 4 * lane), bb = *(const f32x4*)(b + 256 * j + 4 * lane); v[j] = v[j] * rstd * gg + bb; }
}
__device__ __forceinline__ void row_modulate(f32x4 (&h)[4], const f32x4 (&v)[4], const float* sc, const float* sh, int lane) {
#pragma unroll
    for (int j = 0; j < 4; ++j) { const f32x4 s = *(const f32x4*)(sc + 256 * j + 4 * lane), t = *(const f32x4*)(sh + 256 * j + 4 * lane); h[j] = v[j] * (s + 1.0f) + t; }
}

__device__ __forceinline__ void row_ln_pre(f32x4 (&v)[4], const f32x4 (&gg)[4], const f32x4 (&bb)[4]) {
    float s = 0.f;
#pragma unroll
    for (int j = 0; j < 4; ++j) s += (v[j][0] + v[j][1]) + (v[j][2] + v[j][3]);
    const float mean = wave_sum(s) * (1.f / D); float q = 0.f;
#pragma unroll
    for (int j = 0; j < 4; ++j) { v[j] = v[j] - mean; q += (v[j][0] * v[j][0] + v[j][1] * v[j][1]) + (v[j][2] * v[j][2] + v[j][3] * v[j][3]); }
    const float rstd = rsqrtf(wave_sum(q) * (1.f / D) + LN_EPS);
#pragma unroll
    for (int j = 0; j < 4; ++j) v[j] = v[j] * rstd * gg[j] + bb[j];
}
__device__ __forceinline__ void row_load_mod(const float* sc, const float* sh, int lane, f32x4 (&s)[4], f32x4 (&t)[4]) {
#pragma unroll
    for (int j = 0; j < 4; ++j) { s[j] = *(const f32x4*)(sc + 256 * j + 4 * lane); t[j] = *(const f32x4*)(sh + 256 * j + 4 * lane); }
}
typedef const __attribute__((address_space(4))) Params* PP;
#define PIN(i) ((const float*)pp->in[i])
#define DECL_LDS extern __shared__ __attribute__((aligned(16))) unsigned char lds_raw[]
#define PHASE_FN static __device__ __forceinline__ void

__device__ __forceinline__ Frame make_frame(PP pp, unsigned char* lds_generic) {
    Frame F;
    F.lds = (LAS unsigned char*)lds_generic;
    { int t_ = threadIdx.x; asm volatile("" : "+v"(t_)); F.tid = t_; }
    F.lane = F.tid & 63; F.wave = __builtin_amdgcn_readfirstlane(F.tid >> 6);
    F.G = gridDim.x; F.bid = blockIdx.x; F.gw = F.bid * NWAVES + F.wave; F.NGW = F.G * NWAVES;
    F.ws = (unsigned char*)pp->ws; F.ctl = (unsigned*)(F.ws + WS_CTL);
    return F;
}
#define FRAME() DECL_LDS; asm volatile("" : "+s"(pp)); Frame F = make_frame(pp, lds_raw); unsigned char* ws = F.ws; (void)ws

PHASE_FN grid_bar(PP pp) {
    FRAME();
    XcdBarrier bar; bar.bar = F.ctl + CW_BAR; bar.x = xb_xcc_id(); bar.st = (volatile LAS unsigned*)(F.lds + LDS_MISC) + 8;
    xcd_barrier(bar);
}

static __device__ __forceinline__ void ln_pass(const Frame& F, float* out, float* XC, bf16* Hb, const float* lng, const float* lnb, const float* modv, const int sc_off, const int sh_off, const int TR) {
    f32x4 gg[4], bb[4];
#pragma unroll
    for (int j = 0; j < 4; ++j) { gg[j] = *(const f32x4*)(lng + 256 * j + 4 * F.lane); bb[j] = *(const f32x4*)(lnb + 256 * j + 4 * F.lane); }
    for (int r0 = F.gw; r0 < TR; r0 += 2 * F.NGW) {
        const int r1 = r0 + F.NGW; const bool two = r1 < TR;
        const bool c0 = r0 >= TL, c1 = r1 >= TL;
        float* x0 = c0 ? XC + (size_t)(r0 - TL) * D : out + (size_t)r0 * D; float* x1 = two ? (c1 ? XC + (size_t)(r1 - TL) * D : out + (size_t)r1 * D) : x0;
        const float* m0 = modv + (size_t)(c0 ? 16 : (r0 >> 12)) * 6144; const float* m1 = modv + (size_t)((two && !c1) ? (r1 >> 12) : 16) * 6144;
        f32x4 v0[4], v1[4], s0[4], t0[4], s1[4], t1[4];
        row_load(x0, F.lane, v0); row_load(x1, F.lane, v1);
        row_load_mod(m0 + sc_off, m0 + sh_off, F.lane, s0, t0); row_load_mod(m1 + sc_off, m1 + sh_off, F.lane, s1, t1);
        row_ln_pre(v0, gg, bb); row_ln_pre(v1, gg, bb);
        row_store(x0, F.lane, v0);
#pragma unroll
        for (int j = 0; j < 4; ++j) s0[j] = v0[j] * (s0[j] + 1.0f) + t0[j];
        row_store_bf16(Hb + (size_t)r0 * D, F.lane, s0);
        if (two) { row_store(x1, F.lane, v1);
#pragma unroll
            for (int j = 0; j < 4; ++j) s1[j] = v1[j] * (s1[j] + 1.0f) + t1[j];
            row_store_bf16(Hb + (size_t)r1 * D, F.lane, s1); }
    }
}
PHASE_FN ph_fold(PP pp) {
    FRAME();
    Params p; p.ws = ws; p.in[I_EV_WIN] = PIN(I_EV_WIN);
    for (int u = (F.G >= 256 ? F.bid - 128 : F.bid); u < 128; u += F.G) if (u >= 0) fold_unit(p, F, u);
}
PHASE_FN ph_mod(PP pp) {
    FRAME();
    float* MOD = (float*)(ws + WS_MOD);
    LAS float* sc = (LAS float*)F.lds;
    LAS float* part = sc + 17 * D;
    const float* cin = PIN(I_C); const float* ccin = PIN(I_CCTX);
    __syncthreads();
    for (int e = F.tid; e < 17 * D; e += NTHREADS) { const int r = e >> 10, k = e & 1023; const float v = (r < 16) ? cin[r * D + k] : ccin[k]; sc[e] = silu_f(v); }
    __syncthreads();
    for (int task = F.bid; task < DEPTH * 48; task += F.G) {
        const int l = task / 48, j0 = (task - l * 48) * 128;
        const float* W = PIN(I_WMOD) + ((size_t)l * D + F.wave * 128) * 6144 + j0 + 2 * F.lane;
        f32x2 acc[17];
#pragma unroll
        for (int r = 0; r < 17; ++r) acc[r] = (f32x2){0.f, 0.f};
        for (int k0 = 0; k0 < 128; k0 += 16) {
            f32x2 w[16];
#pragma unroll
            for (int q = 0; q < 16; ++q) w[q] = *(const f32x2*)(W + (size_t)(k0 + q) * 6144);
#pragma unroll
            for (int q4 = 0; q4 < 4; ++q4)
#pragma unroll
                for (int r = 0; r < 17; ++r) { const f32x4 sv = *(const LAS f32x4*)(sc + r * D + F.wave * 128 + k0 + 4 * q4);
                    acc[r] += (w[4 * q4] * sv[0] + w[4 * q4 + 1] * sv[1]) + (w[4 * q4 + 2] * sv[2] + w[4 * q4 + 3] * sv[3]); }
        }
        if (F.wave >= 4) {
#pragma unroll
            for (int r = 0; r < 17; ++r) *(LAS f32x2*)(part + ((F.wave - 4) * 17 + r) * 128 + 2 * F.lane) = acc[r]; }
        __syncthreads();
        if (F.wave < 4) {
#pragma unroll
            for (int r = 0; r < 17; ++r) { LAS f32x2* q = (LAS f32x2*)(part + (F.wave * 17 + r) * 128 + 2 * F.lane); *q = *q + acc[r]; } }
        __syncthreads();
        for (int o = F.tid; o < 17 * 128; o += NTHREADS) { const int r = o >> 7, j = o & 127; float v = PIN(I_BMOD)[l * 6144 + j0 + j];
#pragma unroll
            for (int w4 = 0; w4 < 4; ++w4) v += part[(w4 * 17 + r) * 128 + j];
            MOD[((size_t)l * 17 + r) * 6144 + j0 + j] = v; }
        __syncthreads();
    }
}
PHASE_FN ph_cvt(PP pp) {
    FRAME();
    Params p; p.ws = ws;
    p.in[I_EV_WIN] = PIN(I_EV_WIN); p.in[I_EV_WOUT] = PIN(I_EV_WOUT); p.in[I_EV_W1] = PIN(I_EV_W1); p.in[I_EV_W3] = PIN(I_EV_W3); p.in[I_EV_W2] = PIN(I_EV_W2);
    p.in[I_OD_WIN] = PIN(I_OD_WIN); p.in[I_WGLU] = PIN(I_WGLU); p.in[I_OD_WOUT] = PIN(I_OD_WOUT); p.in[I_MW1] = PIN(I_MW1); p.in[I_MW3] = PIN(I_MW3); p.in[I_MW2] = PIN(I_MW2);
    LAS float* scr = (LAS float*)(F.lds + F.wave * 16384);
    cvt_range<false>(pp, ws, F.gw, CVT_W2_0, F.NGW, scr, F.lane);
    cvt_range<true>(pp, ws, CVT_W2_0 + F.gw, CVT_MOE0, F.NGW, scr, F.lane);
}
PHASE_FN ph_dftmat(PP pp) {
    FRAME();
    bf16* FDm = (bf16*)(ws + WS_FD); bf16* F2 = (bf16*)(ws + WS_F256);
    for (int it = F.bid * NTHREADS + F.tid; it < 2 * 256 * 64; it += F.G * NTHREADS) {
        const int which = it >> 14, k = (it >> 6) & 255, n0 = (it & 63) * 8; const bool isq = n0 >= 256; const int nb = n0 & 255;
        float v[8];
#pragma unroll
        for (int j = 0; j < 8; ++j) { const int phs = (k * (nb + j)) & 255; float sn, cs; sincospif((float)phs * (1.0f / 128.0f), &sn, &cs);
            v[j] = which ? (isq ? -sn * (1.f / 16.f) : cs * (1.f / 16.f)) : (isq ? sn * (1.f / 64.f) : cs * (1.f / 64.f)); }
        v4u w; w.x = cvt_pk_bf16(v[0], v[1]); w.y = cvt_pk_bf16(v[2], v[3]); w.z = cvt_pk_bf16(v[4], v[5]); w.w = cvt_pk_bf16(v[6], v[7]);
        *(v4u*)((which ? F2 : FDm) + (size_t)k * 512 + n0) = w;
    }
}
PHASE_FN ph_s5mat(PP pp) {
    FRAME();
    LAS float* lam = (LAS float*)F.lds;
    LAS float* bb = lam + 2 * 64 * 17 * 2;
    LAS float* cc = bb + 2 * 64 * 16 * 2;
    LAS float* kt = cc + 2 * 16 * 64 * 2;
    for (int unit = (F.G >= 256 ? F.bid - 64 : F.bid); unit < 64; unit += F.G) {
        if (unit < 0) continue;
        const int li = unit >> 5, g = unit & 31;
        __syncthreads();
        if (F.tid < 128) { const int d = F.tid >> 6, pl = F.tid & 63; const int sidx = ((li * 2 + d) * 32 + g);
            const float are = PIN(I_A_RE)[sidx * 64 + pl], aim = PIN(I_A_IM)[sidx * 64 + pl], dt = expf(PIN(I_LOG_DT)[sidx]);
            for (int e = 0; e <= 16; ++e) { const float mag = expf(are * dt * (float)e); float sn, cn; sincosf(aim * dt * (float)e, &sn, &cn); lam[((d * 64 + pl) * 17 + e) * 2] = mag * cn; lam[((d * 64 + pl) * 17 + e) * 2 + 1] = mag * sn; } }
        __syncthreads();
        for (int e = F.tid; e < 2048; e += NTHREADS) { const int d = e >> 10, pl = (e >> 4) & 63, sp = e & 15; const int sidx = ((li * 2 + d) * 32 + g);
            const float are = PIN(I_A_RE)[sidx * 64 + pl], aim = PIN(I_A_IM)[sidx * 64 + pl];
            const float lre = lam[((d * 64 + pl) * 17 + 1) * 2], lim = lam[((d * 64 + pl) * 17 + 1) * 2 + 1];
            const float den = 1.0f / (are * are + aim * aim);
            const float fre = ((lre - 1.0f) * are + lim * aim) * den, fim = (lim * are - (lre - 1.0f) * aim) * den;
            const float br = PIN(I_B_RE)[((size_t)sidx * 64 + pl) * 16 + sp], bi = PIN(I_B_IM)[((size_t)sidx * 64 + pl) * 16 + sp];
            bb[e * 2] = fre * br - fim * bi; bb[e * 2 + 1] = fre * bi + fim * br; }
        for (int e = F.tid; e < 2048; e += NTHREADS) { const int d = e >> 10, sq = (e >> 6) & 15, pl = e & 63; const int sidx = ((li * 2 + d) * 32 + g);
            cc[e * 2] = PIN(I_C_RE)[((size_t)sidx * 16 + sq) * 64 + pl]; cc[e * 2 + 1] = PIN(I_C_IM)[((size_t)sidx * 16 + sq) * 64 + pl]; }
        __syncthreads();
        for (int e = F.tid; e < 8192; e += NTHREADS) { const int d = e >> 12, tau = (e >> 8) & 15, sq = (e >> 4) & 15, sp = e & 15; float acc = 0.f;
            for (int pl = 0; pl < 64; ++pl) { const float cr = cc[((d * 16 + sq) * 64 + pl) * 2], ci = cc[((d * 16 + sq) * 64 + pl) * 2 + 1];
                const float lr = lam[((d * 64 + pl) * 17 + tau) * 2], lj = lam[((d * 64 + pl) * 17 + tau) * 2 + 1];
                const float br = bb[((d * 64 + pl) * 16 + sp) * 2], bi = bb[((d * 64 + pl) * 16 + sp) * 2 + 1];
                const float tr = cr * lr - ci * lj, ti = cr * lj + ci * lr;
                acc += tr * br - ti * bi; }
            kt[e] = acc; }
        __syncthreads();
        bf16* WA = (bf16*)(ws + WS_S5M + (size_t)unit * S5M_STRIDE); bf16* CLm = WA + 512 * 256;
        const float* dsk = PIN(I_SSM_D) + (size_t)li * 512 + g * 16;
        for (int it = F.tid; it < 8192; it += NTHREADS) { const int row = it >> 5, c0 = (it & 31) * 8;
            float v[8];
            { const int i = row >> 4, sq = row & 15, j = c0 >> 4, sp0 = c0 & 15;
#pragma unroll
              for (int q = 0; q < 8; ++q) { const int sp = sp0 + q; float a = 0.f; if (i >= j) a += kt[((0 * 16 + (i - j)) * 16 + sq) * 16 + sp]; if (j >= i) a += kt[((1 * 16 + (j - i)) * 16 + sq) * 16 + sp]; if (i == j && sq == sp) a += dsk[sq]; v[q] = a; }
              v4u w; w.x = cvt_pk_bf16(v[0], v[1]); w.y = cvt_pk_bf16(v[2], v[3]); w.z = cvt_pk_bf16(v[4], v[5]); w.w = cvt_pk_bf16(v[6], v[7]); *(v4u*)(WA + (size_t)row * 256 + c0) = w; }
            { const int d = row >> 7, pl = (row >> 1) & 63, ri = row & 1, j = c0 >> 4, sp0 = c0 & 15, e = d ? j : 15 - j;
              const float lr = lam[((d * 64 + pl) * 17 + e) * 2], lj = lam[((d * 64 + pl) * 17 + e) * 2 + 1];
#pragma unroll
              for (int q = 0; q < 8; ++q) { const float br = bb[((d * 64 + pl) * 16 + sp0 + q) * 2], bi = bb[((d * 64 + pl) * 16 + sp0 + q) * 2 + 1]; v[q] = ri ? (lr * bi + lj * br) : (lr * br - lj * bi); }
              v4u w; w.x = cvt_pk_bf16(v[0], v[1]); w.y = cvt_pk_bf16(v[2], v[3]); w.z = cvt_pk_bf16(v[4], v[5]); w.w = cvt_pk_bf16(v[6], v[7]); *(v4u*)(WA + (size_t)(256 + row) * 256 + c0) = w; }
            { const int i = row >> 4, sq = row & 15, d = c0 >> 7, pl0 = (c0 >> 1) & 63, e = d ? 16 - i : i + 1;
#pragma unroll
              for (int q = 0; q < 4; ++q) { const int pl = pl0 + q; const float cr = cc[((d * 16 + sq) * 64 + pl) * 2], ci = cc[((d * 16 + sq) * 64 + pl) * 2 + 1];
                  const float lr = lam[((d * 64 + pl) * 17 + e) * 2], lj = lam[((d * 64 + pl) * 17 + e) * 2 + 1];
                  v[2 * q] = cr * lr - ci * lj; v[2 * q + 1] = -(cr * lj + ci * lr); }
              v4u w; w.x = cvt_pk_bf16(v[0], v[1]); w.y = cvt_pk_bf16(v[2], v[3]); w.z = cvt_pk_bf16(v[4], v[5]); w.w = cvt_pk_bf16(v[6], v[7]); *(v4u*)(CLm + (size_t)row * 256 + c0) = w; }
        }
    }
    __syncthreads();
}
PHASE_FN ph_pro_b(PP pp) {
    FRAME();
    const float* MOD = (const float*)(ws + WS_MOD); bf16* Hb = (bf16*)(ws + WS_H); bf16* XB = (bf16*)(ws + WS_XB);
    const float* xin = PIN(I_X); const float* cin = PIN(I_CTX);
    static_assert(T % (2 * 256 * NWAVES) == 0 && TL % (2 * 256 * NWAVES) == 0, "row pairs");
    for (int r0 = F.gw; r0 < T; r0 += 2 * F.NGW) {
        const int r1 = r0 + F.NGW; const bool c0 = r0 >= TL, c1 = r1 >= TL;
        const float* x0 = c0 ? cin + (size_t)(r0 - TL) * D : xin + (size_t)r0 * D; const float* x1 = c1 ? cin + (size_t)(r1 - TL) * D : xin + (size_t)r1 * D;
        const float* m0 = MOD + (size_t)(c0 ? 16 : (r0 >> 12)) * 6144; const float* m1 = MOD + (size_t)(c1 ? 16 : (r1 >> 12)) * 6144;
        f32x4 v0[4], v1[4], s0[4], t0[4], s1[4], t1[4];
        row_load(x0, F.lane, v0); row_load(x1, F.lane, v1); row_load_mod(m0 + 1024, m0, F.lane, s0, t0); row_load_mod(m1 + 1024, m1, F.lane, s1, t1);
        row_store_bf16(XB + (size_t)r0 * D, F.lane, v0); row_store_bf16(XB + (size_t)r1 * D, F.lane, v1);
#pragma unroll
        for (int j = 0; j < 4; ++j) { s0[j] = v0[j] * (s0[j] + 1.0f) + t0[j]; s1[j] = v1[j] * (s1[j] + 1.0f) + t1[j]; }
        row_store_bf16(Hb + (size_t)r0 * D, F.lane, s0); row_store_bf16(Hb + (size_t)r1 * D, F.lane, s1);
    }
}

PHASE_FN ph_e1(PP pp, int layer) {
    FRAME();
    unsigned char* evw = ws + WS_EV + (layer >> 1) * EV_STRIDE; unsigned char* BIG = ws + WS_BIG;
    SchedEvIn S{F.G, F.bid, (const char*)(ws + WS_H), (const char*)(evw + EV_WQKV), (const char*)(evw + EV_WPQ), (char*)(BIG + BIG_QKV), (char*)(BIG + BIG_PQT), (char*)(BIG + BIG_PQTC)};
    pg8::gemm_phase<pg8::EpiStore, SchedEvIn, true, true>(F.lds, F.tid, pg8::Dims{D, D, D}, S, pg8::EpiStore{});
}
template <class TT> struct cfT { TT r, i; };
typedef cfT<float> cf;
template <class TT, class WW> __device__ __forceinline__ cfT<TT> cmul(cfT<TT> a, WW wr, WW wi) { return cfT<TT>{a.r * wr - a.i * wi, a.r * wi + a.i * wr}; }
template <class TT> __device__ __forceinline__ void radix4(cfT<TT> x0, cfT<TT> x1, cfT<TT> x2, cfT<TT> x3, cfT<TT>& y0, cfT<TT>& y1, cfT<TT>& y2, cfT<TT>& y3) {
    const cfT<TT> s02{x0.r + x2.r, x0.i + x2.i}, d02{x0.r - x2.r, x0.i - x2.i}, s13{x1.r + x3.r, x1.i + x3.i}, d13{x1.r - x3.r, x1.i - x3.i};
    y0 = cfT<TT>{s02.r + s13.r, s02.i + s13.i}; y2 = cfT<TT>{s02.r - s13.r, s02.i - s13.i}; y1 = cfT<TT>{d02.r + d13.i, d02.i - d13.r}; y3 = cfT<TT>{d02.r - d13.i, d02.i + d13.r};
}
template <class TT> __device__ __forceinline__ void fft16(cfT<TT> (&x)[16]) {
    constexpr float C1 = 0.92387953251128674f, S1 = 0.38268343236508977f, C2 = 0.70710678118654752f;
    cfT<TT> A[4][4];
#pragma unroll
    for (int b = 0; b < 4; ++b) radix4(x[b], x[4 + b], x[8 + b], x[12 + b], A[b][0], A[b][1], A[b][2], A[b][3]);
    A[1][1] = cmul(A[1][1], C1, -S1); A[1][2] = cmul(A[1][2], C2, -C2); A[1][3] = cmul(A[1][3], S1, -C1);
    A[2][1] = cmul(A[2][1], C2, -C2); A[2][2] = cfT<TT>{A[2][2].i, -A[2][2].r}; A[2][3] = cmul(A[2][3], -C2, -C2);
    A[3][1] = cmul(A[3][1], S1, -C1); A[3][2] = cmul(A[3][2], -C2, -C2); A[3][3] = cmul(A[3][3], -C1, S1);
#pragma unroll
    for (int c = 0; c < 4; ++c) radix4(A[0][c], A[1][c], A[2][c], A[3][c], x[c], x[c + 4], x[c + 8], x[c + 12]);
}
PHASE_FN ph_e2_fft(PP pp) {
    FRAME();
    const bf16* PQT = (const bf16*)(ws + WS_BIG + BIG_PQT); bf16* VB = (bf16*)(ws + WS_H);
    for (int it = F.bid * NTHREADS + F.tid; it < NBATCH * 512 * 128; it += F.G * NTHREADS) {
        const int n1 = (it & 127) * 2, ch = (it >> 7) & 511, b = it >> 16;
        const bf16* pp_ = PQT + ((size_t)(b * 512 + ch) * 2) * 4096 + n1; const bf16* qq_ = pp_ + 4096;
        unsigned pw[16], qw[16];
#pragma unroll
        for (int n2 = 0; n2 < 16; ++n2) { pw[n2] = *(const unsigned*)(pp_ + 256 * n2); qw[n2] = *(const unsigned*)(qq_ + 256 * n2); }
        unsigned ore[16], oim[16];
        {
            cfT<f32x2> x[16];
#pragma unroll
            for (int n2 = 0; n2 < 16; ++n2) { x[n2].r = (f32x2){bflo(pw[n2]), bfhi(pw[n2])}; x[n2].i = -(f32x2){bflo(qw[n2]), bfhi(qw[n2])}; }
            fft16(x);
            float sn0, cs0, sn1, cs1; sincospif((float)n1 * (1.0f / 2048.0f), &sn0, &cs0); sincospif((float)(n1 + 1) * (1.0f / 2048.0f), &sn1, &cs1);
            const f32x2 cs = (f32x2){cs0, cs1}, msn = -(f32x2){sn0, sn1};
            cfT<f32x2> wk{cs, msn};
#pragma unroll
            for (int k2 = 1; k2 < 16; ++k2) { x[k2] = cmul(x[k2], wk.r, wk.i); wk = cmul(wk, cs, msn); }
#pragma unroll
            for (int k2 = 0; k2 < 16; ++k2) { ore[k2] = cvt_pk_bf16(x[k2].r[0], x[k2].r[1]); oim[k2] = cvt_pk_bf16(x[k2].i[0], x[k2].i[1]); }
        }
#pragma unroll
        for (int k2 = 0; k2 < 16; ++k2) { bf16* dst = VB + (((size_t)b * 16 + k2) * 512 + ch) * 512 + n1; *(unsigned*)dst = ore[k2]; *(unsigned*)(dst + 256) = oim[k2]; }
    }
}
PHASE_FN ph_e2_dft(PP pp) {
    FRAME();
    unsigned char* BIG = ws + WS_BIG;
    SchedDft S{F.G, F.bid, (const char*)(ws + WS_FD), (const char*)(ws + WS_H), (const char*)(ws + WS_F256), (const char*)(BIG + BIG_PQTC), (char*)(BIG + BIG_MIX)};
    pg8::gemm_phase<pg8::EpiStore, SchedDft, true, true>(F.lds, F.tid, pg8::Dims{512, 512, 512}, S, pg8::EpiStore{});
}
PHASE_FN ph_e2_rope(PP pp) {
    FRAME();
    bf16* QKV = (bf16*)(ws + WS_BIG + BIG_QKV);
    LAS f32x2* cs = (LAS f32x2*)F.lds;
    __syncthreads();
    for (int e = F.tid; e < 1024; e += NTHREADS) { const int pos = e >> 4, i = e & 15; const float inv = powf(10000.0f, -(float)i / 16.0f); float s, c; sincosf((float)pos * inv, &s, &c); cs[e] = (f32x2){c, s}; }
    __syncthreads();
    for (int it = F.bid * NTHREADS + F.tid; it < TL * 10; it += F.G * NTHREADS) {
        const int r = it / 10, hh = it - r * 10, n = r & 4095;
        v4u* base = (v4u*)(QKV + (size_t)r * 768 + hh * 64);
        v4u v[8];
#pragma unroll
        for (int k = 0; k < 8; ++k) v[k] = base[k];
#pragma unroll
        for (int ax = 0; ax < 2; ++ax) { const int pos = ax ? (n & 63) : (n >> 6);
#pragma unroll
            for (int k = 0; k < 2; ++k) { unsigned* a = (unsigned*)&v[4 * ax + k]; unsigned* b = (unsigned*)&v[4 * ax + 2 + k];
#pragma unroll
                for (int q = 0; q < 4; ++q) { const f32x2 t0 = cs[pos * 16 + 8 * k + 2 * q], t1 = cs[pos * 16 + 8 * k + 2 * q + 1];
                    const float x1l = bflo(a[q]), x1h = bfhi(a[q]), x2l = bflo(b[q]), x2h = bfhi(b[q]);
                    a[q] = cvt_pk_bf16(x1l * t0.x - x2l * t0.y, x1h * t1.x - x2h * t1.y); b[q] = cvt_pk_bf16(x1l * t0.y + x2l * t0.x, x1h * t1.y + x2h * t1.x); } } }
#pragma unroll
        for (int k = 0; k < 8; ++k) base[k] = v[k];
    }
    bf16* VT = (bf16*)(ws + WS_BIG + BIG_VT);
    for (int it = F.bid * NTHREADS + F.tid; it < NBATCH * 2 * 544 * 64; it += F.G * NTHREADS) {
        const int d = it & 63, kg = (it >> 6) % 544, bh = (it >> 6) / 544, b = bh >> 1, hkv = bh & 1;
        const int key0 = kg * 8; const size_t row0 = (key0 < 256) ? ((size_t)TL + (size_t)b * 256 + key0) : ((size_t)b * 4096 + (key0 - 256));
        const bf16* src = QKV + row0 * 768 + 640 + hkv * 64 + d;
        unsigned short v[8];
#pragma unroll
        for (int j = 0; j < 8; ++j) v[j] = src[(size_t)j * 768];
        v4u w; w.x = v[0] | ((unsigned)v[1] << 16); w.y = v[2] | ((unsigned)v[3] << 16); w.z = v[4] | ((unsigned)v[5] << 16); w.w = v[6] | ((unsigned)v[7] << 16);
        *(v4u*)(VT + ((size_t)bh * 64 + d) * 4352 + key0) = w;
    }
    __syncthreads();
}
typedef float f32x16 __attribute__((ext_vector_type(16)));
typedef __bf16 bf16x2v __attribute__((ext_vector_type(2)));
__device__ __forceinline__ unsigned pk_bf16(float a, float b) { const bf16x2v t = __builtin_convertvector((f32x2){a, b}, bf16x2v); return __builtin_bit_cast(unsigned, t); }
constexpr int AT_KP = 144, AT_VP1 = 648, AT_VP2 = 520, AT_VOFF = 320 * AT_KP;
template <bool MASKED>
__device__ __forceinline__ void attn_tile(const LAS unsigned char* Ks, const LAS unsigned char* Vs, const int vpitch, const int kl_base, const bf16x8 (&qf)[4], f32x16& o0, f32x16& o1, float& m, float& l,
                                          const int r, const int h, const int kj0, const int qi) {
    f32x16 x;
#pragma unroll
    for (int i = 0; i < 16; ++i) x[i] = 0.f;
#pragma unroll
    for (int s = 0; s < 4; ++s) { const bf16x8 kf = *(const LAS bf16x8*)(Ks + (kl_base + r) * AT_KP + (16 * s + 8 * h) * 2); x = __builtin_amdgcn_mfma_f32_32x32x16_bf16(kf, qf[s], x, 0, 0, 0); }
    constexpr float CS = 0.125f * 1.4426950408889634f;
    float sc[16]; float mt = -1e30f;
#pragma unroll
    for (int i = 0; i < 16; ++i) { float v = x[i];
        if (MASKED) { const int kj = kj0 + (i & 3) + 8 * (i >> 2) + 4 * h; const bool ok = (kj >= 0) && (kj < SEQ) && (kj - qi <= 128) && (qi - kj <= 128); v = ok ? v : -1e30f; }
        sc[i] = v; mt = fmaxf(mt, v); }
    mt = fmaxf(mt, __shfl_xor(mt, 32));
    { const float pm = mt * CS;
      if (!__all(pm - m <= 8.0f)) { const float mn = fmaxf(m, pm), alpha = __builtin_amdgcn_exp2f(m - mn); m = mn; l *= alpha; o0 = o0 * alpha; o1 = o1 * alpha; } }
    f32x2 ps2 = (f32x2){0.f, 0.f};
#pragma unroll
    for (int i = 0; i < 16; i += 2) { const f32x2 t = (f32x2){sc[i], sc[i + 1]} * CS - m; const f32x2 p = (f32x2){__builtin_amdgcn_exp2f(t[0]), __builtin_amdgcn_exp2f(t[1])}; sc[i] = p[0]; sc[i + 1] = p[1]; ps2 += p; }
    l += ps2[0] + ps2[1];
#pragma unroll
    for (int s2 = 0; s2 < 2; ++s2) {
        v4u pw; pw.x = pk_bf16(sc[8 * s2 + 0], sc[8 * s2 + 1]); pw.y = pk_bf16(sc[8 * s2 + 2], sc[8 * s2 + 3]); pw.z = pk_bf16(sc[8 * s2 + 4], sc[8 * s2 + 5]); pw.w = pk_bf16(sc[8 * s2 + 6], sc[8 * s2 + 7]);
        const bf16x8 pk = __builtin_bit_cast(bf16x8, pw);
        { const LAS unsigned char* vp = Vs + r * vpitch + (kl_base + 16 * s2 + 4 * h) * 2; const v2u lo = *(const LAS v2u*)vp, hi = *(const LAS v2u*)(vp + 16);
          v4u vw; vw.x = lo.x; vw.y = lo.y; vw.z = hi.x; vw.w = hi.y; o0 = __builtin_amdgcn_mfma_f32_32x32x16_bf16(__builtin_bit_cast(bf16x8, vw), pk, o0, 0, 0, 0); }
        { const LAS unsigned char* vp = Vs + (32 + r) * vpitch + (kl_base + 16 * s2 + 4 * h) * 2; const v2u lo = *(const LAS v2u*)vp, hi = *(const LAS v2u*)(vp + 16);
          v4u vw; vw.x = lo.x; vw.y = lo.y; vw.z = hi.x; vw.w = hi.y; o1 = __builtin_amdgcn_mfma_f32_32x32x16_bf16(__builtin_bit_cast(bf16x8, vw), pk, o1, 0, 0, 0); }
    }
}
template <bool MASKED>
__device__ __forceinline__ void attn_tile2(const LAS unsigned char* Ks, const LAS unsigned char* Vs, const int vpitch, const int kl_base, const bf16x8 (&qf)[4], f32x16& o0, f32x16& o1, float& m, float& l,
                                           const int r, const int h, const int kj0, const int qi) {
    f32x16 xa, xb;
#pragma unroll
    for (int i = 0; i < 16; ++i) { xa[i] = 0.f; xb[i] = 0.f; }
#pragma unroll
    for (int s = 0; s < 4; ++s) { const bf16x8 ka = *(const LAS bf16x8*)(Ks + (kl_base + r) * AT_KP + (16 * s + 8 * h) * 2), kb = *(const LAS bf16x8*)(Ks + (kl_base + 32 + r) * AT_KP + (16 * s + 8 * h) * 2);
        xa = __builtin_amdgcn_mfma_f32_32x32x16_bf16(ka, qf[s], xa, 0, 0, 0); xb = __builtin_amdgcn_mfma_f32_32x32x16_bf16(kb, qf[s], xb, 0, 0, 0); }
    constexpr float CS = 0.125f * 1.4426950408889634f;
    float sc[32]; float mt = -1e30f;
#pragma unroll
    for (int i = 0; i < 32; ++i) { float v = (i < 16) ? xa[i & 15] : xb[i & 15];
        if (MASKED) { const int kj = kj0 + 32 * (i >> 4) + (i & 3) + 8 * ((i & 15) >> 2) + 4 * h; const bool ok = (kj >= 0) && (kj < SEQ) && (kj - qi <= 128) && (qi - kj <= 128); v = ok ? v : -1e30f; }
        sc[i] = v; mt = fmaxf(mt, v); }
    mt = fmaxf(mt, __shfl_xor(mt, 32));
    { const float pm = mt * CS;
      if (!__all(pm - m <= 8.0f)) { const float mn = fmaxf(m, pm), alpha = __builtin_amdgcn_exp2f(m - mn); m = mn; l *= alpha; o0 = o0 * alpha; o1 = o1 * alpha; } }
    f32x2 ps2 = (f32x2){0.f, 0.f};
#pragma unroll
    for (int i = 0; i < 32; i += 2) { const f32x2 t = (f32x2){sc[i], sc[i + 1]} * CS - m; const f32x2 p = (f32x2){__builtin_amdgcn_exp2f(t[0]), __builtin_amdgcn_exp2f(t[1])}; sc[i] = p[0]; sc[i + 1] = p[1]; ps2 += p; }
    l += ps2[0] + ps2[1];
#pragma unroll
    for (int tt = 0; tt < 2; ++tt)
#pragma unroll
        for (int s2 = 0; s2 < 2; ++s2) { const int b = 16 * tt + 8 * s2;
            v4u pw; pw.x = pk_bf16(sc[b + 0], sc[b + 1]); pw.y = pk_bf16(sc[b + 2], sc[b + 3]); pw.z = pk_bf16(sc[b + 4], sc[b + 5]); pw.w = pk_bf16(sc[b + 6], sc[b + 7]);
            const bf16x8 pk = __builtin_bit_cast(bf16x8, pw);
            { const LAS unsigned char* vp = Vs + r * vpitch + (kl_base + 32 * tt + 16 * s2 + 4 * h) * 2; const v2u lo = *(const LAS v2u*)vp, hi = *(const LAS v2u*)(vp + 16);
              v4u vw; vw.x = lo.x; vw.y = lo.y; vw.z = hi.x; vw.w = hi.y; o0 = __builtin_amdgcn_mfma_f32_32x32x16_bf16(__builtin_bit_cast(bf16x8, vw), pk, o0, 0, 0, 0); }
            { const LAS unsigned char* vp = Vs + (32 + r) * vpitch + (kl_base + 32 * tt + 16 * s2 + 4 * h) * 2; const v2u lo = *(const LAS v2u*)vp, hi = *(const LAS v2u*)(vp + 16);
              v4u vw; vw.x = lo.x; vw.y = lo.y; vw.z = hi.x; vw.w = hi.y; o1 = __builtin_amdgcn_mfma_f32_32x32x16_bf16(__builtin_bit_cast(bf16x8, vw), pk, o1, 0, 0, 0); }
        }
}
PHASE_FN ph_e3_attn(PP pp, int layer) {
    FRAME();
    const bf16* QKV = (const bf16*)(ws + WS_BIG + BIG_QKV); bf16* MIX = (bf16*)(ws + WS_BIG + BIG_MIX); const bf16* VT = (const bf16*)(ws + WS_BIG + BIG_VT);
    const float* sinkp = PIN(I_EV_SINK) + (layer >> 1) * 8;
    LAS unsigned char* Ks = F.lds; LAS unsigned char* Vs = F.lds + AT_VOFF;
    const int r = F.lane & 31, h = F.lane >> 5, g = F.wave >> 1, th = F.wave & 1;
    constexpr int NU = 2048 + 128;
#define AT_DECODE(u_, isc_, b_, hkv_, n0_) do { isc_ = (u_) >= 2048; if (!isc_) { b_ = (u_) >> 7; hkv_ = ((u_) >> 6) & 1; n0_ = ((u_) & 63) * 64; } else { const int v_ = (u_) - 2048; b_ = v_ >> 3; hkv_ = (v_ >> 2) & 1; n0_ = (v_ & 3) * 64; } } while (0)
#define AT_LOAD1(b_, hkv_, n0_) do { int tl_ = F.tid; asm volatile("" : "+v"(tl_));   _Pragma("unroll") for (int k_ = 0; k_ < 5; ++k_) { const int pc = tl_ + k_ * NTHREADS; \
        { const int kl = pc >> 3, c8 = pc & 7, kj = (n0_) - 128 + kl; rk[k_] = (v4u){0u, 0u, 0u, 0u}; if (kj >= 0 && kj < SEQ) rk[k_] = *(const v4u*)(QKV + ((size_t)(b_) * 4096 + kj) * 768 + 512 + (hkv_) * 64 + c8 * 8); } \
        { const int d = pc / 40, c = pc - d * 40, kj = (n0_) - 128 + c * 8; rv[k_] = (v4u){0u, 0u, 0u, 0u}; if (kj >= 0 && kj < SEQ) rv[k_] = *(const v4u*)(VT + ((size_t)((b_) * 2 + (hkv_)) * 64 + d) * 4352 + 256 + kj); } } } while (0)
#define AT_STORE1() do { int tl_ = F.tid; asm volatile("" : "+v"(tl_));   _Pragma("unroll") for (int k_ = 0; k_ < 5; ++k_) { const int pc = tl_ + k_ * NTHREADS; \
        { const int kl = pc >> 3, c8 = pc & 7; *(LAS v4u*)(Ks + kl * AT_KP + c8 * 16) = rk[k_]; } \
        { const int d = pc / 40, c = pc - d * 40; LAS v2u* dst = (LAS v2u*)(Vs + d * AT_VP1 + c * 16); dst[0] = (v2u){rv[k_].x, rv[k_].y}; dst[1] = (v2u){rv[k_].z, rv[k_].w}; } } } while (0)
#define AT_LOAD2(b_, hkv_) do { int tl_ = F.tid; asm volatile("" : "+v"(tl_));   _Pragma("unroll") for (int k_ = 0; k_ < 4; ++k_) { const int pc = tl_ + k_ * NTHREADS; \
        { const int j = pc >> 3, c8 = pc & 7; ck[k_] = *(const v4u*)(QKV + ((size_t)TL + (size_t)(b_) * 256 + j) * 768 + 512 + (hkv_) * 64 + c8 * 8); } \
        { const int d = pc >> 5, c = pc & 31; cv[k_] = *(const v4u*)(VT + ((size_t)((b_) * 2 + (hkv_)) * 64 + d) * 4352 + c * 8); } } } while (0)
#define AT_STORE2() do { int tl_ = F.tid; asm volatile("" : "+v"(tl_));   _Pragma("unroll") for (int k_ = 0; k_ < 4; ++k_) { const int pc = tl_ + k_ * NTHREADS; \
        { const int j = pc >> 3, c8 = pc & 7; *(LAS v4u*)(Ks + j * AT_KP + c8 * 16) = ck[k_]; } \
        { const int d = pc >> 5, c = pc & 31; LAS v2u* dst = (LAS v2u*)(Vs + d * AT_VP2 + c * 16); dst[0] = (v2u){cv[k_].x, cv[k_].y}; dst[1] = (v2u){cv[k_].z, cv[k_].w}; } } } while (0)
    v4u rk[5], rv[5], ck[4], cv[4];
    int u = F.G - 1 - F.bid;
    if (u < NU) { bool isc; int b, hkv, n0; AT_DECODE(u, isc, b, hkv, n0); if (!isc) AT_LOAD1(b, hkv, n0); }
    for (; u < NU; u += F.G) {
        bool isc; int b, hkv, n0; AT_DECODE(u, isc, b, hkv, n0);
        const size_t qrow = isc ? ((size_t)TL + (size_t)b * 256 + n0 + 32 * th + r) : ((size_t)b * 4096 + n0 + 32 * th + r);
        bf16x8 qf[4];
#pragma unroll
        for (int s = 0; s < 4; ++s) qf[s] = *(const bf16x8*)(QKV + qrow * 768 + (hkv * 4 + g) * 64 + 16 * s + 8 * h);
        float m = sinkp[hkv * 4 + g] * 1.4426950408889634f, l = (h == 0) ? 1.0f : 0.0f;
        f32x16 o0, o1;
#pragma unroll
        for (int i = 0; i < 16; ++i) { o0[i] = 0.f; o1[i] = 0.f; }
        __syncthreads();
        if (!isc) AT_STORE1();
        AT_LOAD2(b, hkv);
        if (!isc) {
            __syncthreads();
            const int qi = n0 + 32 * th + r;
#pragma unroll 1
            for (int t = 0; t < 8; t += 2) { const int klb = 32 * th + 32 * t, kj0 = n0 - 128 + klb;
                if (t >= 2 && kj0 >= 0 && kj0 + 63 < SEQ) attn_tile2<false>(Ks, Vs, AT_VP1, klb, qf, o0, o1, m, l, r, h, 0, 0);
                else { attn_tile<true>(Ks, Vs, AT_VP1, klb, qf, o0, o1, m, l, r, h, kj0, qi); attn_tile<true>(Ks, Vs, AT_VP1, klb + 32, qf, o0, o1, m, l, r, h, kj0 + 32, qi); } }
            { const int klb = 32 * th + 256, kj0 = n0 - 128 + klb; attn_tile<true>(Ks, Vs, AT_VP1, klb, qf, o0, o1, m, l, r, h, kj0, qi); }
            __syncthreads();
        }
        AT_STORE2();
        { const int un = u + F.G; if (un < NU) { bool iscn; int bn, hkvn, n0n; AT_DECODE(un, iscn, bn, hkvn, n0n); if (!iscn) AT_LOAD1(bn, hkvn, n0n); } }
        __syncthreads();
#pragma unroll 1
        for (int t = 0; t < 8; t += 2) attn_tile2<false>(Ks, Vs, AT_VP2, 32 * t, qf, o0, o1, m, l, r, h, 0, 0);
        const float inv = 1.0f / (l + __shfl_xor(l, 32));
        bf16* orow = MIX + qrow * D + 512 + (hkv * 4 + g) * 64 + 4 * h;
#pragma unroll
        for (int q4 = 0; q4 < 4; ++q4) {
            v2u w0; w0.x = pk_bf16(o0[4 * q4 + 0] * inv, o0[4 * q4 + 1] * inv); w0.y = pk_bf16(o0[4 * q4 + 2] * inv, o0[4 * q4 + 3] * inv); *(v2u*)(orow + 8 * q4) = w0;
            v2u w1; w1.x = pk_bf16(o1[4 * q4 + 0] * inv, o1[4 * q4 + 1] * inv); w1.y = pk_bf16(o1[4 * q4 + 2] * inv, o1[4 * q4 + 3] * inv); *(v2u*)(orow + 32 + 8 * q4) = w1;
        }
    }
#undef AT_DECODE
#undef AT_LOAD1
#undef AT_STORE1
#undef AT_LOAD2
#undef AT_STORE2
    __syncthreads();
}
PHASE_FN ph_outproj(PP pp, int layer) {
    FRAME();
    const int li = layer >> 1; const bool odd = (layer & 1) != 0;
    const int TR = (layer == DEPTH - 1) ? TL : T;
    const char* W = odd ? (const char*)(ws + WS_OD + li * OD_STRIDE + OD_WOUT) : (const char*)(ws + WS_EV + li * EV_STRIDE + EV_WOUT);
    const float* modl = (const float*)(ws + WS_MOD) + (size_t)layer * 17 * 6144;
    SchedResid S{F.G, F.bid, (TR / 256) * 4, (const char*)(ws + WS_BIG + BIG_MIX), (size_t)256 * D * 2, W, (size_t)256 * D * 2, (bf16*)(ws + WS_XB), modl + 2048};
    pg8::EpiResidLN E{PIN(I_LNG) + (size_t)(layer * 2) * D, PIN(I_LNB) + (size_t)(layer * 2) * D, 2048, 1024, (bf16*)(ws + WS_H), F.ctl + CW_LN + (layer * 2) * LN_SITE_WORDS,
                      (unsigned long long*)(ws + WS_XS), F.ctl + 2, F.lds + LDS_LNTAB, 1.0f, !odd};
    pg8::gemm_phase<pg8::EpiResidLN, SchedResid, true, true>(F.lds, F.tid, pg8::Dims{D, D, D}, S, E);
}
PHASE_FN ph_e6(PP pp, int layer) {
    FRAME();
    unsigned char* evw = ws + WS_EV + (layer >> 1) * EV_STRIDE;
    SchedStd S{22, (T / 256) * 22, F.G, F.bid, (const char*)(ws + WS_H), (const char*)(evw + EV_W13), (char*)(ws + WS_BIG + BIG_HID), (size_t)256 * D, (size_t)256 * D, (size_t)22 * 32768, (size_t)32768, FFH, 1 << 30};
    pg8::gemm_phase<pg8::EpiSwiGLU8, SchedStd, true, true, pg8::AMapStd, true>(F.lds, F.tid, pg8::Dims{D, D, D}, S, pg8::EpiSwiGLU8{});
}
PHASE_FN ph_e7(PP pp, int layer) {
    FRAME();
    unsigned char* evw = ws + WS_EV + (layer >> 1) * EV_STRIDE;
    const float* modl = (const float*)(ws + WS_MOD) + (size_t)layer * 17 * 6144;
    SchedResid S{F.G, F.bid, (T / 256) * 4, (const char*)(ws + WS_BIG + BIG_HID), (size_t)22 * 32768, (const char*)(evw + EV_W2), (size_t)256 * FFH, (bf16*)(ws + WS_XB), modl + 5120};
    pg8::EpiResidLN E{PIN(I_LNG) + (size_t)(layer * 2 + 1) * D, PIN(I_LNB) + (size_t)(layer * 2 + 1) * D, 17 * 6144 + 1024 - 5120, 17 * 6144 - 5120, (bf16*)(ws + WS_H), F.ctl + CW_LN + (layer * 2 + 1) * LN_SITE_WORDS,
                      (unsigned long long*)(ws + WS_XS), F.ctl + 2, F.lds + LDS_LNTAB, 1.0f / (Q_HID * Q_W), false};
    pg8::gemm_phase<pg8::EpiResidLN, SchedResid, true, true, pg8::AMapHid, true>(F.lds, F.tid, pg8::Dims{FFH, FFH, FFH}, S, E, pg8::AMapHid{});
}

PHASE_FN ph_o1(PP pp, int layer) {
    FRAME();
    unsigned char* odw = ws + WS_OD + (layer >> 1) * OD_STRIDE;
    SchedO1 S{F.G, F.bid, (const char*)(ws + WS_H), (const char*)(odw + OD_WIN), (char*)(ws + WS_BIG + BIG_P), (char*)(ws + WS_BIG + BIG_UG)};
    pg8::gemm_phase<pg8::EpiStore, SchedO1, true, true>(F.lds, F.tid, pg8::Dims{D, D, D}, S, pg8::EpiStore{});
}
PHASE_FN ph_o2_s5a(PP pp, int layer) {
    FRAME();
    const int li = layer >> 1;
    SchedS5A S{F.G, F.bid, (const char*)(ws + WS_BIG + BIG_UG), (const char*)(ws + WS_S5M + (size_t)li * 32 * S5M_STRIDE), (char*)(ws + WS_H + 68 * MiB), (char*)(ws + WS_H)};
    pg8::gemm_phase<pg8::EpiStore, SchedS5A, true, true, pg8::AMapStd, false, false>(F.lds, F.tid, pg8::Dims{256, 256, 256}, S, pg8::EpiStore{});
}
PHASE_FN ph_o2_scan(PP pp, int layer) {
    FRAME();
    const int li = layer >> 1;
    if (F.tid >= 256) {
        Params p; p.ws = ws; p.in[I_MW1] = PIN(I_MW1); p.in[I_MW3] = PIN(I_MW3); p.in[I_MW2] = PIN(I_MW2);
        p.in[I_EV_WIN] = nullptr; p.in[I_EV_WOUT] = nullptr; p.in[I_EV_W1] = nullptr; p.in[I_EV_W3] = nullptr; p.in[I_EV_W2] = nullptr; p.in[I_OD_WIN] = nullptr; p.in[I_WGLU] = nullptr; p.in[I_OD_WOUT] = nullptr;
        LAS float* scr = (LAS float*)(F.lds + F.wave * 16384);
        cvt_range<true>(pp, ws, CVT_MOE0 + li * CVT_MOE_LI + F.bid * 4 + (F.wave - 4), CVT_MOE0 + (li + 1) * CVT_MOE_LI, F.G * 4, scr, F.lane);
    }
    if (F.tid < 256) {
        const int t = F.bid * 256 + F.tid;
        if (t < NBATCH * 32 * 2 * 64) {
            const int pl = t & 63, d = (t >> 6) & 1, g = (t >> 7) & 31, b = t >> 12;
            const int sidx = ((li * 2 + d) * 32 + g);
            const float are = PIN(I_A_RE)[sidx * 64 + pl], aim = PIN(I_A_IM)[sidx * 64 + pl], dt = expf(PIN(I_LOG_DT)[sidx]);
            const float mag = expf(16.0f * are * dt); float sn, cn; sincosf(16.0f * aim * dt, &sn, &cn);
            const float lre = mag * cn, lim = mag * sn;
            unsigned* HB = (unsigned*)(ws + WS_H) + (size_t)g * 4352 * 128 + d * 64 + pl;
            float cre = 0.f, cim = 0.f;
#define S5_CROW(k_) ((k_) < 16 ? (4096 + b * 16 + (d ? 15 - (k_) : (k_))) : (b * 256 + (d ? 255 - ((k_) - 16) : ((k_) - 16))))
            unsigned wn[8];
#pragma unroll
            for (int j = 0; j < 8; ++j) wn[j] = HB[(size_t)S5_CROW(j) * 128];
            for (int k0 = 0; k0 < 272; k0 += 8) {
                unsigned w[8];
#pragma unroll
                for (int j = 0; j < 8; ++j) w[j] = wn[j];
                if (k0 + 8 < 272) {
#pragma unroll
                    for (int j = 0; j < 8; ++j) wn[j] = HB[(size_t)S5_CROW(k0 + 8 + j) * 128]; }
#pragma unroll
                for (int j = 0; j < 8; ++j) { HB[(size_t)S5_CROW(k0 + j) * 128] = cvt_pk_bf16(cre, cim);
                    const float sr = bflo(w[j]), si = bfhi(w[j]); const float nr = lre * cre - lim * cim + sr, ni = lre * cim + lim * cre + si; cre = nr; cim = ni; }
            }
#undef S5_CROW
        }
    }
}
PHASE_FN ph_o3(PP pp, int layer) {
    FRAME();
    const int li = layer >> 1;
    SchedS5B S{F.G, F.bid, (const char*)(ws + WS_H), (const char*)(ws + WS_S5M + (size_t)li * 32 * S5M_STRIDE + 256 * 1024), (const char*)(ws + WS_H + 68 * MiB), (char*)(ws + WS_BIG + BIG_UG)};
    pg8::gemm_phase<pg8::EpiS5B, SchedS5B, true, true, pg8::AMapStd, false, false>(F.lds, F.tid, pg8::Dims{256, 256, 256}, S, pg8::EpiS5B{});
}
PHASE_FN ph_o2_gmlp(PP pp, int layer) {
    FRAME();
    const int li = layer >> 1; const int TR = (layer == DEPTH - 1) ? TL : T;
    const bf16* P = (const bf16*)(ws + WS_BIG + BIG_P); bf16* MIX = (bf16*)(ws + WS_BIG + BIG_MIX);
    constexpr int GP = 272;
    LAS unsigned char* Vt = F.lds;
    LAS unsigned char* Wt = F.lds + 128 * GP;
    LAS f32x2* stt = (LAS f32x2*)(F.lds + 2 * 128 * GP);
    LAS unsigned char* Ut = F.lds + 2 * 128 * GP + 1024;
    const float* ws_w = PIN(I_WS) + (size_t)li * 4 * 128 * 128; const float* bs = PIN(I_BS) + (size_t)li * 4 * 128;
    const int r = F.lane & 31, hh = F.lane >> 5, et = F.wave >> 1, it0 = (F.wave & 1) * 2;
    const int nunits = (TR / 128) * 4;
    const bool wfix = (F.G & 3) == 0;
#define GM_LOADW(h_) do { _Pragma("unroll") for (int k = 0; k < 4; ++k) { const int pc = F.tid + k * NTHREADS; const int i = pc >> 4, j8 = (pc & 15) * 8; const float* wp = ws_w + (size_t)(h_) * 16384 + i * 128 + j8; \
        const f32x4 a = *(const f32x4*)wp, b = *(const f32x4*)(wp + 4); v4u o; o.x = cvt_pk_bf16(a[0], a[1]); o.y = cvt_pk_bf16(a[2], a[3]); o.z = cvt_pk_bf16(b[0], b[1]); o.w = cvt_pk_bf16(b[2], b[3]); \
        *(LAS v4u*)(Wt + i * GP + j8 * 2) = o; } } while (0)
#define GM_LOAD(u_) do { const int ch_ = (u_) >> 2, h_ = (u_) & 3; const size_t r0_ = (size_t)ch_ * 128; \
        _Pragma("unroll") for (int t = 0; t < 16; ++t) srow[t] = *(const v4u*)(P + (r0_ + F.wave * 16 + t) * D + 512 + F.lane * 8); \
        _Pragma("unroll") for (int k = 0; k < 4; ++k) { const int pc = F.tid + k * NTHREADS; const int eg = pc >> 7, j = pc & 127; vq[k] = *(const v4u*)(P + (r0_ + j) * D + 512 + h_ * 128 + eg * 8); \
            uq[k] = *(const v4u*)(P + (r0_ + (pc >> 4)) * D + h_ * 128 + (pc & 15) * 8); } } while (0)
    v4u srow[16], vq[4], uq[4];
    __syncthreads();
    const int ub = F.G - 1 - F.bid;
    if (wfix && ub < nunits) GM_LOADW(ub & 3);
    if (ub < nunits) GM_LOAD(ub);
    for (int u = ub; u < nunits; u += F.G) {
        const int ch = u >> 2, h = u & 3; const size_t row0 = (size_t)ch * 128;
        __syncthreads();
        { float vals[32];
#pragma unroll
          for (int t = 0; t < 16; ++t) { const v4u w = srow[t];
              const float f[8] = {bflo(w.x), bfhi(w.x), bflo(w.y), bfhi(w.y), bflo(w.z), bfhi(w.z), bflo(w.w), bfhi(w.w)};
              float sm = 0.f, sq = 0.f;
#pragma unroll
              for (int q = 0; q < 8; ++q) { sm += f[q]; sq += f[q] * f[q]; }
              vals[t] = sm; vals[16 + t] = sq; }
#pragma unroll
          for (int step = 0; step < 5; ++step) { const int M = 32 >> step, n2 = 16 >> step; const bool up = (F.lane & M) != 0;
#pragma unroll
              for (int i = 0; i < n2; ++i) { const float keep = up ? vals[i + n2] : vals[i], send = up ? vals[i] : vals[i + n2]; vals[i] = keep + __shfl_xor(send, M); } }
          const float tot = vals[0] + __shfl_xor(vals[0], 1);
          const float oth = __shfl_xor(tot, 32);
          if (F.lane < 32 && (F.lane & 1) == 0) { const float mu = tot * (1.f / 512.f), var = fmaxf(oth * (1.f / 512.f) - mu * mu, 0.f); stt[F.wave * 16 + (F.lane >> 1)] = (f32x2){mu, rsqrtf(var + LN_EPS)}; } }
        if (!wfix) GM_LOADW(h);
#pragma unroll
        for (int k = 0; k < 4; ++k) { const int pc = F.tid + k * NTHREADS; *(LAS v4u*)(Ut + (pc >> 4) * GP + (pc & 15) * 16) = uq[k]; }
        __syncthreads();
#pragma unroll
        for (int k = 0; k < 4; ++k) { const int pc = F.tid + k * NTHREADS; const int eg = pc >> 7, j = pc & 127; const v4u w = vq[k];
            const f32x2 ms = stt[j];
            const float f[8] = {bflo(w.x), bfhi(w.x), bflo(w.y), bfhi(w.y), bflo(w.z), bfhi(w.z), bflo(w.w), bfhi(w.w)};
#pragma unroll
            for (int q = 0; q < 8; q += 2) { const unsigned pkd = cvt_pk_bf16((f[q] - ms.x) * ms.y, (f[q + 1] - ms.x) * ms.y);
                *(LAS unsigned short*)(Vt + (eg * 8 + q) * GP + j * 2) = (unsigned short)(pkd & 0xffffu); *(LAS unsigned short*)(Vt + (eg * 8 + q + 1) * GP + j * 2) = (unsigned short)(pkd >> 16); } }
        if (u + F.G < nunits) GM_LOAD(u + F.G);
        __syncthreads();
        f32x16 acc0, acc1;
#pragma unroll
        for (int q = 0; q < 16; ++q) { acc0[q] = 0.f; acc1[q] = 0.f; }
#pragma unroll
        for (int sk = 0; sk < 8; ++sk) {
            const bf16x8 a = *(const LAS bf16x8*)(Vt + (et * 32 + r) * GP + (16 * sk + 8 * hh) * 2);
            const bf16x8 b0 = *(const LAS bf16x8*)(Wt + (it0 * 32 + r) * GP + (16 * sk + 8 * hh) * 2), b1 = *(const LAS bf16x8*)(Wt + ((it0 + 1) * 32 + r) * GP + (16 * sk + 8 * hh) * 2);
            acc0 = __builtin_amdgcn_mfma_f32_32x32x16_bf16(a, b0, acc0, 0, 0, 0); acc1 = __builtin_amdgcn_mfma_f32_32x32x16_bf16(a, b1, acc1, 0, 0, 0);
        }
#pragma unroll
        for (int t = 0; t < 2; ++t) { const int i = (it0 + t) * 32 + r; const float bb = bs[h * 128 + i];
            LAS unsigned char* up = Ut + i * GP + (et * 32 + 4 * hh) * 2;
#pragma unroll
            for (int q4 = 0; q4 < 4; ++q4) { const v2u uw = *(const LAS v2u*)(up + 16 * q4);
                const float a0 = (t ? acc1[4 * q4 + 0] : acc0[4 * q4 + 0]) + bb, a1 = (t ? acc1[4 * q4 + 1] : acc0[4 * q4 + 1]) + bb, a2 = (t ? acc1[4 * q4 + 2] : acc0[4 * q4 + 2]) + bb, a3 = (t ? acc1[4 * q4 + 3] : acc0[4 * q4 + 3]) + bb;
                v2u o; o.x = cvt_pk_bf16(bflo(uw.x) * a0, bfhi(uw.x) * a1); o.y = cvt_pk_bf16(bflo(uw.y) * a2, bfhi(uw.y) * a3);
                *(LAS v2u*)(up + 16 * q4) = o; } }
        __syncthreads();
#pragma unroll
        for (int k = 0; k < 4; ++k) { const int pc = F.tid + k * NTHREADS; *(v4u*)(MIX + (row0 + (pc >> 4)) * D + 512 + h * 128 + (pc & 15) * 8) = *(const LAS v4u*)(Ut + (pc >> 4) * GP + (pc & 15) * 16); }
    }
    __syncthreads();
#undef GM_LOAD
#undef GM_LOADW
}
PHASE_FN ph_o4(PP pp, int layer) {
    FRAME();
    const int li = layer >> 1;
    unsigned char* odw = ws + WS_OD + li * OD_STRIDE;
    SchedGlu S{F.G, F.bid, (const char*)(ws + WS_BIG + BIG_UG), (const char*)(odw + OD_WGLU), (char*)(ws + WS_BIG + BIG_MIX), PIN(I_BGLU) + (size_t)li * 512};
    pg8::gemm_phase<pg8::EpiGLU, SchedGlu, true, true, pg8::AMapGLU>(F.lds, F.tid, pg8::Dims{512, 0, 512}, S, pg8::EpiGLU{}, pg8::AMapGLU{});
}
PHASE_FN ph_o6(PP pp, int layer) {
    FRAME();
    const int li = layer >> 1; const int TR = (layer == DEPTH - 1) ? TL : T;
    const bf16* Hb = (const bf16*)(ws + WS_H);
    int* tokE = (int*)(ws + WS_TOK); int* tokS0 = tokE + T; int* tokS1 = tokS0 + T; float* tokG0 = (float*)(tokS1 + T);
    unsigned* ecnt = F.ctl + CW_CNT + li * 64;
    LAS float* wr_s = (LAS float*)F.lds;
    LAS unsigned* lcnt = (LAS unsigned*)(F.lds + 32768);
    const float* rw = PIN(I_ROUTER) + (size_t)li * D * 8;
    __syncthreads();
    for (int e = F.tid; e < D * 8; e += NTHREADS) { const int col = e >> 3, ex = e & 7; wr_s[(((col & 15) * 2 + (ex >> 2)) * 64 + (col >> 4)) * 4 + (ex & 3)] = rw[e]; }
    if (F.tid < 16) lcnt[F.tid] = 0u;
    __syncthreads();
    v4u qa[3], qb[3];
#pragma unroll
    for (int k = 0; k < 3; ++k) { const int rk = F.gw + k * F.NGW; qa[k] = (v4u){0u, 0u, 0u, 0u}; qb[k] = qa[k];
        if (rk < TR) { const v4u* src = (const v4u*)(Hb + (size_t)rk * D) + 2 * F.lane; qa[k] = src[0]; qb[k] = src[1]; } }
    for (int r = F.gw; r < TR; r += F.NGW) {
        const v4u a = qa[0], b = qb[0];
        qa[0] = qa[1]; qb[0] = qb[1]; qa[1] = qa[2]; qb[1] = qb[2];
        { const int rn = r + 3 * F.NGW; if (rn < TR) { const v4u* src = (const v4u*)(Hb + (size_t)rn * D) + 2 * F.lane; qa[2] = src[0]; qb[2] = src[1]; } }
        const float hv[16] = {bflo(a.x), bfhi(a.x), bflo(a.y), bfhi(a.y), bflo(a.z), bfhi(a.z), bflo(a.w), bfhi(a.w), bflo(b.x), bfhi(b.x), bflo(b.y), bfhi(b.y), bflo(b.z), bfhi(b.z), bflo(b.w), bfhi(b.w)};
        float lg[8];
#pragma unroll
        for (int e = 0; e < 8; ++e) lg[e] = 0.f;
#pragma unroll
        for (int q = 0; q < 16; ++q) { const f32x4 w0 = *(const LAS f32x4*)(wr_s + ((q * 2 + 0) * 64 + F.lane) * 4), w1 = *(const LAS f32x4*)(wr_s + ((q * 2 + 1) * 64 + F.lane) * 4);
            lg[0] += hv[q] * w0[0]; lg[1] += hv[q] * w0[1]; lg[2] += hv[q] * w0[2]; lg[3] += hv[q] * w0[3]; lg[4] += hv[q] * w1[0]; lg[5] += hv[q] * w1[1]; lg[6] += hv[q] * w1[2]; lg[7] += hv[q] * w1[3]; }
#pragma unroll
        for (int step = 0; step < 3; ++step) { const int M = 32 >> step, n2 = 4 >> step; const bool up = (F.lane & M) != 0;
#pragma unroll
            for (int i = 0; i < n2; ++i) { const float keep = up ? lg[i + n2] : lg[i], send = up ? lg[i] : lg[i + n2]; lg[i] = keep + __shfl_xor(send, M); } }
        { float t = lg[0]; t += __shfl_xor(t, 4); t += __shfl_xor(t, 2); t += __shfl_xor(t, 1);
#pragma unroll
          for (int e = 0; e < 8; ++e) lg[e] = __uint_as_float((unsigned)__builtin_amdgcn_readlane((int)__float_as_uint(t), 8 * e)); }
        if (F.lane == 0) {
            int e0 = 0; float v0 = lg[0];
#pragma unroll
            for (int e = 1; e < 8; ++e) if (lg[e] > v0) { v0 = lg[e]; e0 = e; }
            int e1 = -1; float v1 = -3.0e38f;
#pragma unroll
            for (int e = 0; e < 8; ++e) if (e != e0 && lg[e] > v1) { v1 = lg[e]; e1 = e; }
            const float w0 = 1.0f / (1.0f + __expf(v1 - v0));
            const int s0 = (int)__hip_atomic_fetch_add(lcnt + e0, 1u, __ATOMIC_RELAXED, __HIP_MEMORY_SCOPE_WORKGROUP), s1 = (int)__hip_atomic_fetch_add(lcnt + e1, 1u, __ATOMIC_RELAXED, __HIP_MEMORY_SCOPE_WORKGROUP);
            tokE[r] = e0 | (e1 << 8); tokS0[r] = s0; tokS1[r] = s1; tokG0[r] = w0;
        }
    }
    __syncthreads();
    if (F.tid < 8) lcnt[8 + F.tid] = atomicAdd(ecnt + F.tid, lcnt[F.tid]);
    VM_WAIT();
    __syncthreads();
    { const int r = F.gw + F.lane * F.NGW;
      if (r < TR) { const int ee = tokE[r]; tokS0[r] += (int)lcnt[8 + (ee & 255)]; tokS1[r] += (int)lcnt[8 + (ee >> 8)]; } }
    __syncthreads();
}
PHASE_FN ph_o7(PP pp, int layer) {
    FRAME();
    const int li = layer >> 1; const int TR = (layer == DEPTH - 1) ? TL : T;
    const bf16* Hb = (const bf16*)(ws + WS_H); unsigned char* HSQ = ws + WS_BIG + BIG_HSQ;
    int* tokE = (int*)(ws + WS_TOK); int* tokS0 = tokE + T; int* tokS1 = tokS0 + T; int* tokP0 = tokS1 + 2 * T; int* tokP1 = tokP0 + T;
    unsigned* ecnt = F.ctl + CW_CNT + li * 64;
    int roff[8]; { int acc = 0;
#pragma unroll
        for (int e = 0; e < 8; ++e) { roff[e] = acc * 256; acc += (__builtin_amdgcn_readfirstlane((int)__hip_atomic_load(ecnt + e, __ATOMIC_RELAXED, __HIP_MEMORY_SCOPE_AGENT)) + 255) >> 8; } }
    for (int ra = F.gw; ra < TR; ra += 2 * F.NGW) {
        const int rb = ra + F.NGW;
        const int ea = tokE[ra], eb = tokE[rb]; int pa0 = tokS0[ra], pa1 = tokS1[ra], pb0 = tokS0[rb], pb1 = tokS1[rb];
        const v4u* sa = (const v4u*)(Hb + (size_t)ra * D) + 2 * F.lane; const v4u* sb = (const v4u*)(Hb + (size_t)rb * D) + 2 * F.lane;
        const v4u a0 = sa[0], a1 = sa[1], b0 = sb[0], b1 = sb[1];
#pragma unroll
        for (int e = 0; e < 8; ++e) { pa0 += (e == (ea & 255)) ? roff[e] : 0; pa1 += (e == (ea >> 8)) ? roff[e] : 0; pb0 += (e == (eb & 255)) ? roff[e] : 0; pb1 += (e == (eb >> 8)) ? roff[e] : 0; }
        v4u qa, qb;
        qa.x = pk_fp8x4(bflo(a0.x) * Q_H, bfhi(a0.x) * Q_H, bflo(a0.y) * Q_H, bfhi(a0.y) * Q_H); qa.y = pk_fp8x4(bflo(a0.z) * Q_H, bfhi(a0.z) * Q_H, bflo(a0.w) * Q_H, bfhi(a0.w) * Q_H);
        qa.z = pk_fp8x4(bflo(a1.x) * Q_H, bfhi(a1.x) * Q_H, bflo(a1.y) * Q_H, bfhi(a1.y) * Q_H); qa.w = pk_fp8x4(bflo(a1.z) * Q_H, bfhi(a1.z) * Q_H, bflo(a1.w) * Q_H, bfhi(a1.w) * Q_H);
        qb.x = pk_fp8x4(bflo(b0.x) * Q_H, bfhi(b0.x) * Q_H, bflo(b0.y) * Q_H, bfhi(b0.y) * Q_H); qb.y = pk_fp8x4(bflo(b0.z) * Q_H, bfhi(b0.z) * Q_H, bflo(b0.w) * Q_H, bfhi(b0.w) * Q_H);
        qb.z = pk_fp8x4(bflo(b1.x) * Q_H, bfhi(b1.x) * Q_H, bflo(b1.y) * Q_H, bfhi(b1.y) * Q_H); qb.w = pk_fp8x4(bflo(b1.z) * Q_H, bfhi(b1.z) * Q_H, bflo(b1.w) * Q_H, bfhi(b1.w) * Q_H);
        *((v4u*)(HSQ + (size_t)pa0 * D) + F.lane) = qa; *((v4u*)(HSQ + (size_t)pa1 * D) + F.lane) = qa;
        *((v4u*)(HSQ + (size_t)pb0 * D) + F.lane) = qb; *((v4u*)(HSQ + (size_t)pb1 * D) + F.lane) = qb;
        if (F.lane == 0) { tokP0[ra] = pa0; tokP1[ra] = pa1; tokP0[rb] = pb0; tokP1[rb] = pb1; }
    }
}
PHASE_FN ph_moe_up(PP pp, int layer, int chn) {
    FRAME();
    const int li = layer >> 1; unsigned char* odw = ws + WS_OD + li * OD_STRIDE; unsigned* ecnt = F.ctl + CW_CNT + li * 64;
    SchedMoeUp S; S.G = F.G; S.c = F.bid; S.rt0 = chn * MOE_CHUNK_TILES; S.HS = (const char*)(ws + WS_BIG + BIG_HSQ); S.W = (const char*)(odw + OD_MW13); S.HID = (char*)(ws + WS_H);
    { int acc = 0; S.toff[0] = 0;
#pragma unroll
        for (int e = 0; e < 8; ++e) { acc += (__builtin_amdgcn_readfirstlane((int)__hip_atomic_load(ecnt + e, __ATOMIC_RELAXED, __HIP_MEMORY_SCOPE_AGENT)) + 255) >> 8; S.toff[e + 1] = acc; } }
    int nt_ = S.toff[8] - S.rt0; nt_ = nt_ < 0 ? 0 : (nt_ > MOE_CHUNK_TILES ? MOE_CHUNK_TILES : nt_); S.nUnits = nt_ * 28;
    pg8::gemm_phase<pg8::EpiSwiGLU8, SchedMoeUp, true, true, pg8::AMapStd, true>(F.lds, F.tid, pg8::Dims{D, D, D}, S, pg8::EpiSwiGLU8{});
}
PHASE_FN ph_moe_down(PP pp, int layer, int chn) {
    FRAME();
    const int li = layer >> 1; unsigned char* odw = ws + WS_OD + li * OD_STRIDE; unsigned* ecnt = F.ctl + CW_CNT + li * 64;
    SchedMoeDown S; S.G = F.G; S.c = F.bid; S.rt0 = chn * MOE_CHUNK_TILES; S.HID = (const char*)(ws + WS_H); S.W = (const char*)(odw + OD_MW2); S.Y = (char*)(ws + WS_BIG + BIG_Y);
    { int acc = 0; S.toff[0] = 0;
#pragma unroll
        for (int e = 0; e < 8; ++e) { acc += (__builtin_amdgcn_readfirstlane((int)__hip_atomic_load(ecnt + e, __ATOMIC_RELAXED, __HIP_MEMORY_SCOPE_AGENT)) + 255) >> 8; S.toff[e + 1] = acc; } }
    int nt_ = S.toff[8] - S.rt0; nt_ = nt_ < 0 ? 0 : (nt_ > MOE_CHUNK_TILES ? MOE_CHUNK_TILES : nt_); S.nUnits = nt_ * 4;
    pg8::gemm_phase<pg8::EpiStoreQ, SchedMoeDown, true, true, pg8::AMapHid, true>(F.lds, F.tid, pg8::Dims{EH, EH, EH}, S, pg8::EpiStoreQ{}, pg8::AMapHid{});
}
PHASE_FN ph_o9(PP pp, int layer) {
    FRAME();
    const int TR = (layer == DEPTH - 1) ? TL : T; const bool last = layer == DEPTH - 1;
    bf16* XB = (bf16*)(ws + WS_XB); float* out = (float*)pp->out; bf16* Hb = (bf16*)(ws + WS_H); const bf16* HS = (const bf16*)(ws + WS_BIG + BIG_Y);
    const float* modl = (const float*)(ws + WS_MOD) + (size_t)layer * 17 * 6144;
    const float* modn = (const float*)(ws + WS_MOD) + (size_t)(last ? layer : layer + 1) * 17 * 6144;
    const float* lng1 = PIN(I_LNG) + (size_t)(layer * 2 + 1) * D; const float* lnb1 = PIN(I_LNB) + (size_t)(layer * 2 + 1) * D;
    const int* tokE = (const int*)(ws + WS_TOK); const float* tokG0 = (const float*)(tokE + 3 * T); const int* tokP0 = tokE + 4 * T; const int* tokP1 = tokP0 + T;
    f32x4 gg9[4], bb9[4];
#pragma unroll
    for (int j = 0; j < 4; ++j) { gg9[j] = *(const f32x4*)(lng1 + 256 * j + 4 * F.lane); bb9[j] = *(const f32x4*)(lnb1 + 256 * j + 4 * F.lane); }
    for (int ra = F.gw; ra < TR; ra += 2 * F.NGW) {
        const int rb = ra + F.NGW; const int rr[2] = {ra, rb};
        int p0[2], p1[2]; float w0[2]; int mrow[2];
#pragma unroll
        for (int k = 0; k < 2; ++k) { const int r = rr[k]; const bool isc = r >= TL; mrow[k] = isc ? 16 : (r >> 12); p0[k] = tokP0[r]; p1[k] = tokP1[r]; w0[k] = tokG0[r]; }
        f32x4 v[2][4]; v2u ya[2][4], yb[2][4];
#pragma unroll
        for (int k = 0; k < 2; ++k) { row_load_bf16(XB + (size_t)rr[k] * D, F.lane, v[k]); const bf16* y0 = HS + (size_t)p0[k] * D; const bf16* y1 = HS + (size_t)p1[k] * D;
#pragma unroll
            for (int j = 0; j < 4; ++j) { ya[k][j] = *(const v2u*)(y0 + 256 * j + 4 * F.lane); yb[k][j] = *(const v2u*)(y1 + 256 * j + 4 * F.lane); } }
#pragma unroll
        for (int k = 0; k < 2; ++k) { const float wa = w0[k], wb = 1.0f - wa; const float* g2 = modl + (size_t)mrow[k] * 6144 + 5120;
#pragma unroll
            for (int j = 0; j < 4; ++j) { const v2u a = ya[k][j], b = yb[k][j]; const f32x4 gg = *(const f32x4*)(g2 + 256 * j + 4 * F.lane);
                f32x4 f; f[0] = wa * bflo(a.x) + wb * bflo(b.x); f[1] = wa * bfhi(a.x) + wb * bfhi(b.x); f[2] = wa * bflo(a.y) + wb * bflo(b.y); f[3] = wa * bfhi(a.y) + wb * bfhi(b.y);
                v[k][j] = v[k][j] * ALPHA + gg * f; }
            row_ln_pre(v[k], gg9, bb9);
            if (last) row_store(out + (size_t)rr[k] * D, F.lane, v[k]); else row_store_bf16(XB + (size_t)rr[k] * D, F.lane, v[k]);
            if (!last) { f32x4 h[4]; const float* m = modn + (size_t)mrow[k] * 6144; row_modulate(h, v[k], m + 1024, m, F.lane); row_store_bf16(Hb + (size_t)rr[k] * D, F.lane, h); } }
    }
}

#if MK_SPLIT
#define PHASE_END() do { ++ph; } while (0)
#else
#define PHASE_END() do { if (ph >= lo && ph + 1 < hi) grid_bar(pp); ++ph; } while (0)
#endif
#define PHASE_ON() (ph >= lo && ph < hi)
static __device__ __forceinline__ void even_layer(PP pp, const int layer, const int lo, const int hi, int& ph) {
    if (PHASE_ON()) ph_e1(pp, layer);
    PHASE_END();
    if (PHASE_ON()) { ph_e2_fft(pp); ph_e2_rope(pp); }
    PHASE_END();
    if (PHASE_ON()) { ph_e2_dft(pp); ph_e3_attn(pp, layer); }
    PHASE_END();
    if (PHASE_ON()) ph_outproj(pp, layer);
    PHASE_END();
    if (PHASE_ON()) ph_e6(pp, layer);
    PHASE_END();
    if (PHASE_ON()) ph_e7(pp, layer);
    PHASE_END();
}
static __device__ __forceinline__ void odd_layer(PP pp, const int layer, const int lo, const int hi, int& ph) {
    if (PHASE_ON()) ph_o1(pp, layer);
    PHASE_END();
    if (PHASE_ON()) { ph_o2_s5a(pp, layer); ph_o2_gmlp(pp, layer); }
    PHASE_END();
    if (PHASE_ON()) ph_o2_scan(pp, layer);
    PHASE_END();
    if (PHASE_ON()) ph_o3(pp, layer);
    PHASE_END();
    if (PHASE_ON()) ph_o4(pp, layer);
    PHASE_END();
    if (PHASE_ON()) ph_outproj(pp, layer);
    PHASE_END();
    if (PHASE_ON()) ph_o6(pp, layer);
    PHASE_END();
    if (PHASE_ON()) ph_o7(pp, layer);
    PHASE_END();
#define MOE_CHUNK(chn) do { if (PHASE_ON()) ph_moe_up(pp, layer, chn); PHASE_END(); if (PHASE_ON()) ph_moe_down(pp, layer, chn); PHASE_END(); } while (0)
    static_assert(MOE_NCHUNK == 5, "the chunk sites are written out: no loop around GEMM phase sites");
    MOE_CHUNK(0); MOE_CHUNK(1); MOE_CHUNK(2); MOE_CHUNK(3); MOE_CHUNK(4);
#undef MOE_CHUNK
    if (PHASE_ON()) ph_o9(pp, layer);
    PHASE_END();
}
constexpr int N_PHASES = 2 + 2 * (6 + 9 + 2 * MOE_NCHUNK);
__global__ void __launch_bounds__(NTHREADS, 2) fwd_kernel(Params p_unused) {
    DECL_LDS;
    PP pp = (PP)__builtin_amdgcn_kernarg_segment_ptr();
    {
        LAS unsigned char* lds = (LAS unsigned char*)lds_raw;
        for (int u = threadIdx.x; u < (LDS_BYTES - LDS_RING) / 4; u += NTHREADS) ((LAS unsigned*)(lds + LDS_RING))[u] = 0u;
        __syncthreads();
#if !MK_SPLIT
        (void)xcd_barrier_post((unsigned*)((unsigned char*)pp->ws + WS_CTL) + CW_BAR, (volatile LAS unsigned*)(lds + LDS_MISC) + 8);
#endif
    }
#if MK_SPLIT
    const int lo = pp->ph_lo, hi = pp->ph_hi;
#else
    constexpr int lo = 0, hi = N_PHASES;
#endif
    int ph = 0;

    if (PHASE_ON()) ph_mod(pp);
    PHASE_END();
    if (PHASE_ON()) { ph_fold(pp); ph_s5mat(pp); ph_pro_b(pp); ph_cvt(pp); ph_dftmat(pp); }
    PHASE_END();
    even_layer(pp, 0, lo, hi, ph);
    odd_layer(pp, 1, lo, hi, ph);
    even_layer(pp, 2, lo, hi, ph);
    odd_layer(pp, 3, lo, hi, ph);
}

extern "C" void kernel_launch(void* const* d_in, const int* in_sizes, int n_in, void* d_out, int out_size, void* d_ws, size_t ws_size, hipStream_t stream) {
    static int grid = 0;
    if (grid == 0) {
        if (n_in != 32 || out_size != TL * D || ws_size < WS_END) { fprintf(stderr, "kernel_launch: unexpected shapes (n_in %d, out %d, ws %zu < %zu)\n", n_in, out_size, ws_size, (size_t)WS_END); grid = -1; return; }
        int dev = 0, cus = 0, per_cu = 0;
        if (hipGetDevice(&dev) != hipSuccess || hipDeviceGetAttribute(&cus, hipDeviceAttributeMultiprocessorCount, dev) != hipSuccess) { grid = -1; return; }
        if (hipFuncSetAttribute((const void*)fwd_kernel, hipFuncAttributeMaxDynamicSharedMemorySize, LDS_BYTES) != hipSuccess) { fprintf(stderr, "kernel_launch: hipFuncSetAttribute failed\n"); grid = -1; return; }
        if (hipOccupancyMaxActiveBlocksPerMultiprocessor(&per_cu, (const void*)fwd_kernel, NTHREADS, LDS_BYTES) != hipSuccess || per_cu < 1) { fprintf(stderr, "kernel_launch: occupancy query says %d\n", per_cu); }
        (void)hipGetLastError();
        grid = cus;
    }
    if (grid < 0) return;
    (void)in_sizes;
    (void)hipMemsetAsync((char*)d_ws + WS_CTL, 0, CTL_ZERO_BYTES, stream);
    Params p{};
    for (int i = 0; i < 32; ++i) p.in[i] = (const float*)d_in[i];
    p.out = (float*)d_out; p.ws = (unsigned char*)d_ws;
#if MK_SPLIT
    for (int ph = 0; ph < N_PHASES; ++ph) { p.ph_lo = ph; p.ph_hi = ph + 1; hipLaunchKernelGGL(fwd_kernel, dim3(grid), dim3(NTHREADS), LDS_BYTES, stream, p); }
#else
    p.ph_lo = 0; p.ph_hi = N_PHASES;
    hipLaunchKernelGGL(fwd_kernel, dim3(grid), dim3(NTHREADS), LDS_BYTES, stream, p);
#endif
}
```

```cpp
#include <hip/hip_runtime.h>
#include <cstdio>
#include <cstdint>

#ifndef MK_SPLIT
#define MK_SPLIT 0
#endif

#define GAS __attribute__((address_space(1)))
#define LAS __attribute__((address_space(3)))
typedef unsigned short bf16;
typedef unsigned v4u __attribute__((ext_vector_type(4)));
typedef unsigned v2u __attribute__((ext_vector_type(2)));
typedef float f32x4 __attribute__((ext_vector_type(4)));
typedef float f32x2 __attribute__((ext_vector_type(2)));
typedef short bf16x8 __attribute__((ext_vector_type(8)));

constexpr int D = 1024, NBATCH = 16, SEQ = 4096, NCTX = 256, DEPTH = 4;
constexpr int TL = NBATCH * SEQ, TC = NBATCH * NCTX, T = TL + TC;
constexpr int FFH = 2816, EH = 3584, NEXP = 8;
constexpr int MOE_CHUNK_TILES = 128, MOE_NCHUNK = 5;
constexpr float Q_H = 16.f, Q_W = 1024.f, Q_HID = 8.f;
constexpr float ALPHA = 1.6817928305074290860622509524664f;
constexpr float LN_EPS = 1e-5f;

constexpr size_t MiB = (size_t)1 << 20;
constexpr size_t WS_CTL = 0, CTL_ZERO_BYTES = 1 * MiB;
constexpr size_t WS_MOD = 1 * MiB;
constexpr size_t WS_TOK = 3 * MiB;
constexpr size_t WS_F256 = 21 * MiB;
constexpr size_t WS_FD = 22 * MiB;
constexpr size_t WS_EV = 86 * MiB, EV_STRIDE = 22 * MiB;
constexpr size_t EV_WQKV = 0, EV_WPQ = 3 * MiB / 2, EV_WOUT = 7 * MiB / 2, EV_W13 = 11 * MiB / 2, EV_W2 = 33 * MiB / 2;
constexpr size_t WS_OD = 130 * MiB, OD_STRIDE = 90 * MiB;
constexpr size_t OD_WIN = 0, OD_WGLU = 3 * MiB, OD_WOUT = 7 * MiB / 2, OD_MW13 = 11 * MiB / 2  , OD_MW2 = 62 * MiB  ;
constexpr size_t WS_H = 310 * MiB;
constexpr size_t WS_BIG = 446 * MiB;
constexpr size_t BIG_PQT = 0, BIG_PQTC = 128 * MiB, BIG_QKV = 136 * MiB, BIG_MIX = 238 * MiB, BIG_VT = 374 * MiB, BIG_HID = 0, BIG_P = 0  , BIG_UG = 136 * MiB  , BIG_Y = 0, BIG_HSQ = 276 * MiB;
constexpr size_t WS_S5M = 862 * MiB, S5M_STRIDE = 384 * 1024;
constexpr size_t WS_XB = 890 * MiB;
constexpr size_t WS_END = 1026 * MiB;
constexpr int CW_BAR = 4096, CW_CNT = 16384, CW_LN = 32768, LN_SITE_WORDS = 272 * 16;
constexpr size_t WS_XS = 886 * MiB;

#define LDS_WAIT() asm volatile("s_waitcnt lgkmcnt(0)" ::: "memory")
#define VM_WAIT() asm volatile("s_waitcnt vmcnt(0)" ::: "memory")
__device__ __forceinline__ unsigned cvt_pk_bf16(float lo, float hi) { unsigned r; asm volatile("v_cvt_pk_bf16_f32 %0, %1, %2" : "=v"(r) : "v"(lo), "v"(hi)); return r; }
__device__ __forceinline__ float bflo(unsigned w) { return __uint_as_float(w << 16); }
__device__ __forceinline__ float bfhi(unsigned w) { return __uint_as_float(w & 0xffff0000u); }
__device__ __forceinline__ float bf2f(bf16 b) { return __uint_as_float(((unsigned)b) << 16); }
__device__ __forceinline__ bf16 f2bf(float f) { return (bf16)(cvt_pk_bf16(f, 0.f) & 0xffffu); }
__device__ __forceinline__ unsigned pk_fp8x4(float a, float b, float c, float d) {
    a = __builtin_amdgcn_fmed3f(a, -448.f, 448.f); b = __builtin_amdgcn_fmed3f(b, -448.f, 448.f); c = __builtin_amdgcn_fmed3f(c, -448.f, 448.f); d = __builtin_amdgcn_fmed3f(d, -448.f, 448.f);
    int w = 0; w = __builtin_amdgcn_cvt_pk_fp8_f32(a, b, w, false); w = __builtin_amdgcn_cvt_pk_fp8_f32(c, d, w, true); return (unsigned)w; }
__device__ __forceinline__ float wave_sum(float v) {
#pragma unroll
    for (int o = 1; o < 64; o <<= 1) v += __shfl_xor(v, o);
    return v;
}
__device__ __forceinline__ float wave_max(float v) {
#pragma unroll
    for (int o = 1; o < 64; o <<= 1) v = fmaxf(v, __shfl_xor(v, o));
    return v;
}
__device__ __forceinline__ float sigmoid_f(float x) { return __builtin_amdgcn_rcpf(1.f + __builtin_amdgcn_exp2f(-1.4426950408889634f * x)); }
__device__ __forceinline__ float silu_f(float x) { return x * sigmoid_f(x); }
__device__ __forceinline__ f32x2 gelu_tanh_2(f32x2 x) { const f32x2 p = (x * x) * -0.10294324f + -2.3022082f; const f32x2 t = x * p;
    const f32x2 d = (f32x2){__builtin_amdgcn_exp2f(t[0]), __builtin_amdgcn_exp2f(t[1])} + 1.0f; return x * (f32x2){__builtin_amdgcn_rcpf(d[0]), __builtin_amdgcn_rcpf(d[1])}; }
__device__ __forceinline__ f32x2 sigmoid_2(f32x2 x) { const f32x2 t = x * -1.4426950408889634f; const f32x2 d = (f32x2){__builtin_amdgcn_exp2f(t[0]), __builtin_amdgcn_exp2f(t[1])} + 1.0f; return (f32x2){__builtin_amdgcn_rcpf(d[0]), __builtin_amdgcn_rcpf(d[1])}; }
__device__ __forceinline__ float gelu_tanh_f(float x) { const float z = x * (0.7978845608028654f + 0.035677408136300125f * x * x); return x * __builtin_amdgcn_rcpf(1.f + __builtin_amdgcn_exp2f(-2.8853900817779268f * z)); }

#define XB_TMO      128
#define XB_XCNT(j)  (256  + 64 * (j))
#define XB_XSUB(j)  (1280 + 64 * (j))
#define XB_XGEN(j)  (2304 + 64 * (j))
#define XB_TOP      3328
#define XB_TOPGEN   3392
#define XCD_BAR_WORDS 3456
#define XB_SPIN_CAP (1u << 25)
__device__ __forceinline__ unsigned xb_ld(unsigned* p)              { return __hip_atomic_load(p, __ATOMIC_RELAXED, __HIP_MEMORY_SCOPE_AGENT); }
__device__ __forceinline__ unsigned xb_add(unsigned* p, unsigned v) { return __hip_atomic_fetch_add(p, v, __ATOMIC_RELAXED, __HIP_MEMORY_SCOPE_AGENT); }
__device__ __forceinline__ unsigned xb_xcc_id() { return (unsigned)__builtin_amdgcn_s_getreg((3 << 11) | 20) & 0xFu; }
#define XB_SPIN(cond, bar) do { unsigned _sp = 0; while (cond) { __builtin_amdgcn_s_sleep(1); \
    if ((++_sp & 255u) == 0u) { if (xb_ld(&(bar)[XB_TMO])) break; if (_sp > XB_SPIN_CAP) { atomicAdd(&(bar)[XB_TMO], 1u); break; } } } } while (0)
struct XcdBarrier { unsigned* bar; unsigned x; volatile LAS unsigned* st; };
__device__ __forceinline__ XcdBarrier xcd_barrier_post(unsigned* bar, volatile LAS unsigned* st) {
    XcdBarrier b; b.bar = bar; b.x = xb_xcc_id(); b.st = st;
    if (threadIdx.x == 0) (void)xb_add(&bar[XB_XCNT(b.x)], 1u);
    return b;
}
__device__ __forceinline__ void xcd_barrier_complete(unsigned* bar, unsigned x, unsigned& nloc, unsigned& nx) {
    const unsigned G = gridDim.x * gridDim.y * gridDim.z;
    unsigned sum, cnt, mine, sp = 0u;
    for (;;) {
        sum = 0u; cnt = 0u; mine = 0u;
#pragma unroll
        for (unsigned j = 0; j < 16; ++j) { const unsigned c = xb_ld(&bar[XB_XCNT(j)]); sum += c; cnt += (c > 0u) ? 1u : 0u; mine = (j == x) ? c : mine; }
        if (sum == G) break;
        __builtin_amdgcn_s_sleep(1);
        if ((++sp & 255u) == 0u) { if (xb_ld(&bar[XB_TMO])) break; if (sp > XB_SPIN_CAP) { atomicAdd(&bar[XB_TMO], 1u); break; } }
    }
    nloc = mine > 0u ? mine : 1u; nx = cnt > 0u ? cnt : 1u;
}
__device__ __forceinline__ void xcd_barrier(const XcdBarrier& b) {
    asm volatile("s_waitcnt vmcnt(0)" ::: "memory");
    __syncthreads();
    if (threadIdx.x == 0) {
        unsigned* bar = b.bar;
        __builtin_amdgcn_s_waitcnt(0);
        unsigned nloc = b.st[0], nx = b.st[1];
        if (nloc == 0u) { xcd_barrier_complete(bar, b.x, nloc, nx); b.st[0] = nloc; b.st[1] = nx; }
        const unsigned old = xb_add(&bar[XB_XSUB(b.x)], 1u);
        const unsigned gen = old / nloc;
        if (old + 1u == (gen + 1u) * nloc) {
            __builtin_amdgcn_fence(__ATOMIC_RELEASE, "agent");
            asm volatile("s_waitcnt vmcnt(0)" ::: "memory");
            const unsigned og = xb_add(&bar[XB_TOP], 1u);
            const unsigned tg = og / nx;
            if (og + 1u == (tg + 1u) * nx) xb_add(&bar[XB_TOPGEN], 1u);
            else XB_SPIN(xb_ld(&bar[XB_TOPGEN]) == tg, bar);
            __builtin_amdgcn_fence(__ATOMIC_ACQUIRE, "agent");
            xb_add(&bar[XB_XGEN(b.x)], 1u);
            asm volatile("s_waitcnt vmcnt(0)" ::: "memory");
        } else {
            XB_SPIN(xb_ld(&bar[XB_XGEN(b.x)]) == gen, bar);
            __builtin_amdgcn_fence(__ATOMIC_ACQUIRE, "agent");
            asm volatile("s_waitcnt vmcnt(0)" ::: "memory");
        }
    }
    __syncthreads();
}

namespace pg8 {
constexpr int BM = 256, BK = 64, HALF = 128, HTB = HALF * BK * 2, STAGE_BYTES = 8 * HTB;
__host__ __device__ __forceinline__ int lds_byte(int r, int c) { const int st = (r >> 4) * 2 + (c >> 5), rr = r & 15, cc = c & 31, ob = rr * 64 + cc * 2; return st * 1024 + (ob ^ (((ob >> 9) & 1) << 5)); }
__host__ __device__ __forceinline__ void stage_rc(int b, int& R, int& C) { const int st = b / 1024, sb = b % 1024, swz = sb ^ (((sb >> 9) & 1) << 5); R = (st >> 1) * 16 + swz / 64; C = (st & 1) * 32 + (swz % 64) / 2; }
__host__ __device__ __forceinline__ int perm32(int rho) { const int n = rho >> 4, i = rho & 15; return 8 * (i >> 2) + 4 * n + (i & 3); }

struct Unit { const char* a; const char* b; char* o; const char* p0; const char* p1; int ldo; int x0; };
struct Dims { int K, lda, ldb; };
typedef int v4i __attribute__((ext_vector_type(4)));
typedef int v8i __attribute__((ext_vector_type(8)));
struct AMapStd { int ldab = 0;   __device__ __forceinline__ unsigned voff(int R, int C) const { return (unsigned)(R * ldab + C * 2); } __device__ __forceinline__ size_t kstep() const { return 128; } __device__ __forceinline__ size_t hs() const { return (size_t)HALF * ldab; } };
struct AMapGLU { __device__ __forceinline__ unsigned voff(int R, int C) const { return (unsigned)(R * 32 + (C >> 4) * (T * 32) + (C & 15) * 2); } __device__ __forceinline__ size_t kstep() const { return (size_t)4 * T * 32; } __device__ __forceinline__ size_t hs() const { return (size_t)HALF * 32; } };
struct AMapHid { __device__ __forceinline__ unsigned voff(int R, int C) const { return (unsigned)(((C * 2) >> 5) * 8192 + R * 32 + ((C * 2) & 31)); } __device__ __forceinline__ size_t kstep() const { return 32768; } __device__ __forceinline__ size_t hs() const { return (size_t)HALF * 32; } };
struct AMapS5 { __device__ __forceinline__ unsigned voff(int R, int C) const { return (unsigned)(R * 49152 + (C >> 4) * 3072 + (C & 15) * 2); } __device__ __forceinline__ size_t kstep() const { return 12288; } __device__ __forceinline__ size_t hs() const { return (size_t)HALF * 49152; } };

__device__ __forceinline__ const char* uni_ptr(const char* p) {
    const unsigned long long v = (unsigned long long)p; const unsigned lo = __builtin_amdgcn_readfirstlane((unsigned)v), hi = __builtin_amdgcn_readfirstlane((unsigned)(v >> 32));
    return (const char*)(((unsigned long long)hi << 32) | lo); }
template <class Epi, class Sched, bool ALIGN_EPI = false, bool SP2 = false, class AMap = AMapStd, bool FP8 = false, bool PIN = true>
__device__ __forceinline__ void gemm_phase(LAS unsigned char* lds, const int tid, const Dims g, const Sched& S, const Epi& E, const AMap am_in = AMap{}) {
    constexpr int ES = FP8 ? 1 : 2;
    AMap am = am_in; if constexpr (__is_same(AMap, AMapStd)) am.ldab = g.lda * ES;
    const int wid = __builtin_amdgcn_readfirstlane(tid >> 6), lane = tid & 63, wr = wid >> 2, wc = wid & 3, fr = lane & 15, fq = lane >> 4;
    const int K = g.K, nt = (K * (FP8 ? 1 : 2)) / 128;
    unsigned voffA, voffB;
    { int R, C; stage_rc(tid * 16, R, C); const int Rb = Epi::PERM ? ((R & ~31) + perm32(R & 31)) : R;
        voffA = am.voff(R, C); voffB = (unsigned)(Rb * g.ldb * ES + C * 2); }
    const size_t d64voffA = am.voff(64, 0), d64voffB = (size_t)64 * g.ldb * ES;
    const size_t kstep = (size_t)(BK * 2), kstepA = am.kstep();
    const size_t hsA = am.hs(), hsB = (size_t)HALF * g.ldb * ES;
    const unsigned ldsw = (unsigned)wid * 1024u;
    const int aoff = lds_byte(wr * 64 + fr, fq * 8), boff = lds_byte(wc * 32 + fr, fq * 8);
#define PG8_SA(b, h) (((b) * 2 + (h)) * HTB)
#define PG8_SB(b, h) ((4 + (b) * 2 + (h)) * HTB)
#define PG8_STAGE(bufoff, gbase, voff) do { unsigned _vo = (voff); asm volatile("" : "+v"(_vo));   \
        const char* _g0 = (const char*)(gbase); if constexpr (PIN) asm volatile("" : "+s"(_g0)); const char* _g1 = _g0 + d64##voff; if constexpr (PIN) asm volatile("" : "+s"(_g1));   \
        __builtin_amdgcn_global_load_lds((const unsigned*)(_g0 + _vo), (LAS unsigned*)(lds + (bufoff) + ldsw), 16, 0, 0); \
        __builtin_amdgcn_global_load_lds((const unsigned*)(_g1 + _vo), (LAS unsigned*)(lds + (bufoff) + ldsw + 8192), 16, 0, 0); } while (0)
#define PG8_LD8(p) __builtin_shufflevector(*(const LAS v4i*)(p), *(const LAS v4i*)((p) + 1024), 0, 1, 2, 3, 4, 5, 6, 7)
#define PG8_LDA(dst, b, h) do { if constexpr (FP8) { _Pragma("unroll") for (int m = 0; m < 4; ++m) dst##8[m] = PG8_LD8(lds + PG8_SA(b, h) + aoff + m * 2048); } \
        else { _Pragma("unroll") for (int m = 0; m < 4; ++m) _Pragma("unroll") for (int k = 0; k < 2; ++k) dst[m][k] = *(const LAS bf16x8*)(lds + PG8_SA(b, h) + aoff + m * 2048 + k * 1024); } } while (0)
#define PG8_LDB(dst, b, h) do { if constexpr (FP8) { _Pragma("unroll") for (int n = 0; n < 2; ++n) dst##8[n] = PG8_LD8(lds + PG8_SB(b, h) + boff + n * 2048); } \
        else { _Pragma("unroll") for (int n = 0; n < 2; ++n) _Pragma("unroll") for (int k = 0; k < 2; ++k) dst[n][k] = *(const LAS bf16x8*)(lds + PG8_SB(b, h) + boff + n * 2048 + k * 1024); } } while (0)
#define PG8_MMA(ai, bj, At, Bt, ZC) do { __builtin_amdgcn_s_setprio(1); \
        if constexpr (FP8) { _Pragma("unroll") for (int m = 0; m < 4; ++m) _Pragma("unroll") for (int n = 0; n < 2; ++n) \
            acc[ai][bj][m][n] = __builtin_amdgcn_mfma_scale_f32_16x16x128_f8f6f4(Bt##8[n], At##8[m], (ZC) ? (f32x4){0.f, 0.f, 0.f, 0.f} : acc[ai][bj][m][n], 0, 0, 0, 0, 0, 0); } \
        else { _Pragma("unroll") for (int m = 0; m < 4; ++m) _Pragma("unroll") for (int n = 0; n < 2; ++n) _Pragma("unroll") for (int k = 0; k < 2; ++k) \
            acc[ai][bj][m][n] = __builtin_amdgcn_mfma_f32_16x16x32_bf16(Bt[n][k], At[m][k], ((ZC) && k == 0) ? (f32x4){0.f, 0.f, 0.f, 0.f} : acc[ai][bj][m][n], 0, 0, 0); } \
        __builtin_amdgcn_s_setprio(0); } while (0)
#define PG8_WAIT_V(n) asm volatile("s_waitcnt vmcnt(" #n ")" ::: "memory")
#define PG8_WAIT_L(n) asm volatile("s_waitcnt lgkmcnt(" #n ")" ::: "memory")
#define PG8_BAR __builtin_amdgcn_s_barrier()
#define PG8_SCHED __builtin_amdgcn_sched_barrier(0)
    int ui = 0;
    const char* cA; const char* cB;
    { Unit u0; if (!S.next(0, u0)) return; cA = uni_ptr(u0.a); cB = uni_ptr(u0.b); }
    f32x4 acc[2][2][4][2];
    bf16x8 At[4][2], B0[2][2], B1[2][2];
    v8i At8[4], B08[2], B18[2];
    if constexpr (SP2) {
        PG8_STAGE(PG8_SB(0, 0), cB, voffB); PG8_STAGE(PG8_SB(0, 1), cB + hsB, voffB); PG8_STAGE(PG8_SA(0, 0), cA, voffA); PG8_STAGE(PG8_SA(0, 1), cA + hsA, voffA);
        if (wr == 1) PG8_BAR;
        PG8_WAIT_V(2); PG8_BAR;
        PG8_STAGE(PG8_SB(1, 0), cB + kstep, voffB); PG8_STAGE(PG8_SA(1, 0), cA + kstepA, voffA); PG8_STAGE(PG8_SB(1, 1), cB + hsB + kstep, voffB);
        PG8_WAIT_V(6); PG8_BAR;
    } else {
        PG8_STAGE(PG8_SB(0, 0), cB, voffB); PG8_STAGE(PG8_SA(0, 0), cA, voffA); PG8_STAGE(PG8_SB(0, 1), cB + hsB, voffB); PG8_STAGE(PG8_SA(0, 1), cA + hsA, voffA);
        if (wr == 1) PG8_BAR;
        PG8_WAIT_V(4); PG8_BAR;
        PG8_STAGE(PG8_SB(1, 0), cB + kstep, voffB); PG8_STAGE(PG8_SA(1, 0), cA + kstepA, voffA); PG8_STAGE(PG8_SB(1, 1), cB + hsB + kstep, voffB);
        PG8_WAIT_V(6); PG8_BAR;
    }
    for (;;) {
        const char* nA = cA; const char* nB = cB; bool has_next;
        { Unit un; has_next = S.next(ui + 1, un); if (has_next) { nA = uni_ptr(un.a); nB = uni_ptr(un.b); } }
#define PG8_ITER(ZF) do { \
            const bool last = (t == nt - 2); \
            const char* a1 = cA + (size_t)(t + 1) * kstepA; \
            const char* a2 = last ? nA : cA + (size_t)(t + 2) * kstepA; const char* b2 = last ? nB : cB + (size_t)(t + 2) * kstep; \
            const char* a3 = a2 + kstepA; const char* b3 = b2 + kstep; \
            if constexpr (SP2) { \
            PG8_LDB(B0, 0, 0); PG8_LDB(B1, 0, 1); PG8_SCHED; PG8_LDA(At, 0, 0); PG8_STAGE(PG8_SA(1, 1), a1 + hsA, voffA); \
            PG8_WAIT_V(8); PG8_WAIT_L(0); PG8_BAR; PG8_MMA(0, 0, At, B0, ZF); PG8_MMA(0, 1, At, B1, ZF); PG8_BAR; PG8_SCHED; \
            PG8_LDA(At, 0, 1); PG8_STAGE(PG8_SB(0, 0), b2, voffB); PG8_STAGE(PG8_SB(0, 1), b2 + hsB, voffB); PG8_STAGE(PG8_SA(0, 0), a2, voffA); \
            PG8_WAIT_V(8); PG8_WAIT_L(0); PG8_BAR; PG8_MMA(1, 0, At, B0, ZF); PG8_MMA(1, 1, At, B1, ZF); PG8_BAR; PG8_SCHED; \
            PG8_LDB(B0, 1, 0); PG8_LDB(B1, 1, 1); PG8_SCHED; PG8_LDA(At, 1, 0); PG8_STAGE(PG8_SA(0, 1), a2 + hsA, voffA); \
            PG8_WAIT_V(8); PG8_WAIT_L(0); PG8_BAR; PG8_MMA(0, 0, At, B0, false); PG8_MMA(0, 1, At, B1, false); PG8_BAR; PG8_SCHED; \
            PG8_LDA(At, 1, 1); PG8_STAGE(PG8_SB(1, 0), b3, voffB); PG8_STAGE(PG8_SB(1, 1), b3 + hsB, voffB); PG8_STAGE(PG8_SA(1, 0), a3, voffA); \
            PG8_WAIT_V(8); PG8_WAIT_L(0); PG8_BAR; PG8_MMA(1, 0, At, B0, false); PG8_MMA(1, 1, At, B1, false); PG8_BAR; PG8_SCHED; \
            } else { \
            PG8_LDB(B0, 0, 0); PG8_SCHED; PG8_LDA(At, 0, 0); PG8_STAGE(PG8_SA(1, 1), a1 + hsA, voffA); \
            PG8_WAIT_L(8); PG8_BAR; PG8_WAIT_L(0); PG8_MMA(0, 0, At, B0, ZF); PG8_BAR; PG8_SCHED; \
            PG8_LDB(B1, 0, 1); PG8_STAGE(PG8_SB(0, 0), b2, voffB); \
            PG8_BAR; PG8_WAIT_L(0); PG8_MMA(0, 1, At, B1, ZF); PG8_BAR; \
            PG8_LDA(At, 0, 1); PG8_STAGE(PG8_SA(0, 0), a2, voffA); \
            PG8_BAR; PG8_WAIT_L(0); PG8_MMA(1, 0, At, B0, ZF); PG8_BAR; PG8_SCHED; \
            PG8_STAGE(PG8_SB(0, 1), b2 + hsB, voffB); \
            PG8_WAIT_V(6); PG8_BAR; PG8_MMA(1, 1, At, B1, ZF); PG8_BAR; \
            PG8_LDB(B0, 1, 0); PG8_SCHED; PG8_LDA(At, 1, 0); PG8_STAGE(PG8_SA(0, 1), a2 + hsA, voffA); \
            PG8_WAIT_L(8); PG8_BAR; PG8_WAIT_L(0); PG8_MMA(0, 0, At, B0, false); PG8_BAR; PG8_SCHED; \
            PG8_LDB(B1, 1, 1); PG8_STAGE(PG8_SB(1, 0), b3, voffB); \
            PG8_BAR; PG8_WAIT_L(0); PG8_MMA(0, 1, At, B1, false); PG8_BAR; \
            PG8_LDA(At, 1, 1); PG8_STAGE(PG8_SA(1, 0), a3, voffA); \
            PG8_BAR; PG8_WAIT_L(0); PG8_MMA(1, 0, At, B0, false); PG8_BAR; PG8_SCHED; \
            PG8_STAGE(PG8_SB(1, 1), b3 + hsB, voffB); \
            PG8_WAIT_V(6); PG8_BAR; PG8_MMA(1, 1, At, B1, false); PG8_BAR; \
            } \
        } while (0)
        { const int t = 0; PG8_ITER(true); }
#pragma unroll 1
        for (int t = 2; t < nt; t += 2) { PG8_ITER(false); }
#undef PG8_ITER
        if constexpr (ALIGN_EPI) { if (wr == 0) PG8_BAR; }
        { Unit uc; (void)S.next(ui, uc); E(acc, uc, wid); }
        if (!has_next) break;
        cA = nA; cB = nB; ++ui;
        if constexpr (ALIGN_EPI) { if (wr == 1) PG8_BAR; }
    }
    PG8_WAIT_V(0);
    if constexpr (!ALIGN_EPI) { if (wr == 0) PG8_BAR; }
    PG8_BAR;
#undef PG8_SA
#undef PG8_SB
#undef PG8_STAGE
#undef PG8_LDA
#undef PG8_LDB
#undef PG8_MMA
#undef PG8_LD8
#undef PG8_WAIT_V
#undef PG8_WAIT_L
#undef PG8_BAR
#undef PG8_SCHED
}

struct EpiStore {
    static constexpr bool PERM = true;
    __device__ __forceinline__ void operator()(const f32x4 (&acc)[2][2][4][2], const Unit& u, const int wid) const {
        int lane_; asm volatile("v_mbcnt_lo_u32_b32 %0, -1, 0\n\tv_mbcnt_hi_u32_b32 %0, -1, %0" : "=v"(lane_));
        const int wr = wid >> 2, wc = wid & 3, fr = lane_ & 15, fq = lane_ >> 4;
        bf16* base = (bf16*)u.o; int row0 = wr * 64 + fr, col0 = wc * 32 + 8 * fq; asm volatile("" : "+v"(row0), "+v"(col0)); const bool act = u.x0 == 1, gm = u.x0 == 2;
#pragma unroll
        for (int ai = 0; ai < 2; ++ai)
#pragma unroll
            for (int m = 0; m < 4; ++m) { const int r_ = row0 + ai * HALF + m * 16; bf16* rowp = base + (size_t)r_ * u.ldo + col0;
#pragma unroll
                for (int bj = 0; bj < 2; ++bj) { f32x4 v0 = acc[ai][bj][m][0], v1 = acc[ai][bj][m][1];
                    if (act) {
#pragma unroll
                        for (int j = 0; j < 4; j += 2) { const f32x2 a = gelu_tanh_2((f32x2){v0[j], v0[j + 1]}), b = gelu_tanh_2((f32x2){v1[j], v1[j + 1]}); v0[j] = a[0]; v0[j + 1] = a[1]; v1[j] = b[0]; v1[j + 1] = b[1]; } }
                    v4u w; w.x = cvt_pk_bf16(v0[0], v0[1]); w.y = cvt_pk_bf16(v0[2], v0[3]); w.z = cvt_pk_bf16(v1[0], v1[1]); w.w = cvt_pk_bf16(v1[2], v1[3]);
                    if (gm) { const int c_ = col0 + bj * HALF; *(v4u*)(base + ((size_t)(c_ >> 4) * T + r_) * 16 + (c_ & 15)) = w; }
                    else *(v4u*)(rowp + bj * HALF) = w; } }
    }
};
struct EpiSwiGLU {
    static constexpr bool PERM = true;
    __device__ __forceinline__ void operator()(const f32x4 (&acc)[2][2][4][2], const Unit& u, const int wid) const {
        int lane_; asm volatile("v_mbcnt_lo_u32_b32 %0, -1, 0\n\tv_mbcnt_hi_u32_b32 %0, -1, %0" : "=v"(lane_));
        const int wr = wid >> 2, wc = wid & 3, fr = lane_ & 15, fq = lane_ >> 4;
        bf16* base = (bf16*)u.o; int row0 = wr * 64 + fr, col0 = wc * 32 + 8 * fq; asm volatile("" : "+v"(row0), "+v"(col0));
#pragma unroll
        for (int ai = 0; ai < 2; ++ai)
#pragma unroll
            for (int m = 0; m < 4; ++m) { bf16* rowp = base + (size_t)(row0 + ai * HALF + m * 16) * u.ldo + col0;
                f32x4 h0, h1;
#pragma unroll
                for (int j = 0; j < 4; ++j) { const float g0 = acc[ai][0][m][0][j], g1 = acc[ai][0][m][1][j];
                    h0[j] = (g0 * acc[ai][1][m][0][j]) * __builtin_amdgcn_rcpf(1.f + __builtin_amdgcn_exp2f(g0 * -1.4426950408889634f));
                    h1[j] = (g1 * acc[ai][1][m][1][j]) * __builtin_amdgcn_rcpf(1.f + __builtin_amdgcn_exp2f(g1 * -1.4426950408889634f)); }
                v4u w; w.x = cvt_pk_bf16(h0[0], h0[1]); w.y = cvt_pk_bf16(h0[2], h0[3]); w.z = cvt_pk_bf16(h1[0], h1[1]); w.w = cvt_pk_bf16(h1[2], h1[3]);
                *(v4u*)rowp = w; }
    }
};
template <bool DENSE>
struct EpiSwiGLU8T {
    static constexpr bool PERM = true;
    __device__ __forceinline__ void operator()(const f32x4 (&acc)[2][2][4][2], const Unit& u, const int wid) const {
        int lane_; asm volatile("v_mbcnt_lo_u32_b32 %0, -1, 0\n\tv_mbcnt_hi_u32_b32 %0, -1, %0" : "=v"(lane_));
        const int wr = wid >> 2, wc = wid & 3, fr = lane_ & 15, fq = lane_ >> 4;
        unsigned char* base = (unsigned char*)u.o; int row0 = wr * 64 + fr, col0 = wc * 32 + 8 * fq; asm volatile("" : "+v"(row0), "+v"(col0));
        constexpr float SA = DENSE ? 1.0f : 1.0f / (Q_H * Q_W);
        constexpr float C1 = -1.4426950408889634f * SA, KK = 1.0f / (SA * SA * Q_HID), C0 = DENSE ? -3.0f : 25.0f;
        static_assert(Q_HID == 8.f && Q_H * Q_W == 16384.f, "C0 = log2(1 / (SA^2 Q_HID))");
#pragma unroll
        for (int ai = 0; ai < 2; ++ai)
#pragma unroll
            for (int m = 0; m < 4; ++m) { unsigned char* rowp = base + wc * 8192 + (row0 + ai * HALF + m * 16) * 32 + 8 * fq;
                f32x2 o[2][2];
#pragma unroll
                for (int n = 0; n < 2; ++n)
#pragma unroll
                    for (int jp = 0; jp < 2; ++jp) {
                        const f32x2 g = (f32x2){acc[ai][0][m][n][2 * jp], acc[ai][0][m][n][2 * jp + 1]}, uu = (f32x2){acc[ai][1][m][n][2 * jp], acc[ai][1][m][n][2 * jp + 1]};
                        const f32x2 t = g * C1 + C0;
                        const f32x2 sden = (f32x2){__builtin_amdgcn_exp2f(t[0]), __builtin_amdgcn_exp2f(t[1])} + KK;
                        const f32x2 rr = (f32x2){__builtin_amdgcn_rcpf(sden[0]), __builtin_amdgcn_rcpf(sden[1])};
                        o[n][jp] = (g * uu) * rr; }
                v2u w; w.x = pk_fp8x4(o[0][0][0], o[0][0][1], o[0][1][0], o[0][1][1]); w.y = pk_fp8x4(o[1][0][0], o[1][0][1], o[1][1][0], o[1][1][1]);
                *(v2u*)rowp = w; }
    }
};
typedef EpiSwiGLU8T<false> EpiSwiGLU8;
typedef EpiSwiGLU8T<true> EpiSwiGLU8D;
struct EpiStoreQ {
    static constexpr bool PERM = true;
    __device__ __forceinline__ void operator()(const f32x4 (&acc)[2][2][4][2], const Unit& u, const int wid) const {
        int lane_; asm volatile("v_mbcnt_lo_u32_b32 %0, -1, 0\n\tv_mbcnt_hi_u32_b32 %0, -1, %0" : "=v"(lane_));
        const int wr = wid >> 2, wc = wid & 3, fr = lane_ & 15, fq = lane_ >> 4;
        bf16* base = (bf16*)u.o; int row0 = wr * 64 + fr, col0 = wc * 32 + 8 * fq; asm volatile("" : "+v"(row0), "+v"(col0));
        constexpr float SA = 1.0f / (Q_HID * Q_W);
#pragma unroll
        for (int ai = 0; ai < 2; ++ai)
#pragma unroll
            for (int m = 0; m < 4; ++m) { bf16* rowp = base + (size_t)(row0 + ai * HALF + m * 16) * u.ldo + col0;
#pragma unroll
                for (int bj = 0; bj < 2; ++bj) { const f32x4 v0 = acc[ai][bj][m][0] * SA, v1 = acc[ai][bj][m][1] * SA;
                    v4u w; w.x = cvt_pk_bf16(v0[0], v0[1]); w.y = cvt_pk_bf16(v0[2], v0[3]); w.z = cvt_pk_bf16(v1[0], v1[1]); w.w = cvt_pk_bf16(v1[2], v1[3]);
                    *(v4u*)(rowp + bj * HALF) = w; } }
    }
};
struct EpiResid {
    static constexpr bool PERM = false;
    __device__ __forceinline__ void operator()(const f32x4 (&acc)[2][2][4][2], const Unit& u, const int wid) const {
        int lane_; asm volatile("v_mbcnt_lo_u32_b32 %0, -1, 0\n\tv_mbcnt_hi_u32_b32 %0, -1, %0" : "=v"(lane_));
        const int wr = wid >> 2, wc = wid & 3, fr = lane_ & 15, fq = lane_ >> 4;
        const float* xs = (const float*)u.p0; float* zo = (float*)u.o; const float* gv = (const float*)u.p1;
        int row0 = wr * 64 + fr, col0 = wc * 32 + 4 * fq; asm volatile("" : "+v"(row0), "+v"(col0));
#pragma unroll
        for (int ai = 0; ai < 2; ++ai)
#pragma unroll
            for (int m = 0; m < 4; ++m) { const size_t off = (size_t)(row0 + ai * HALF + m * 16) * D + col0;
#pragma unroll
                for (int bj = 0; bj < 2; ++bj)
#pragma unroll
                    for (int n = 0; n < 2; ++n) { const f32x4 xv = *(const f32x4*)(xs + off + bj * HALF + n * 16); const f32x4 gvv = *(const f32x4*)(gv + col0 + bj * HALF + n * 16);
                        *(f32x4*)(zo + off + bj * HALF + n * 16) = xv * ALPHA + gvv * acc[ai][bj][m][n]; }
                asm volatile("" ::: "memory"); }
    }
};
struct EpiResidLN {
    static constexpr bool PERM = true;
    const float* lng; const float* lnb; int sc_delta, sh_delta; bf16* H; unsigned* cnt; unsigned long long* xs; unsigned* tmo; LAS unsigned char* tab; float dq; bool h8;
    __device__ __forceinline__ void operator()(f32x4 (&acc)[2][2][4][2], const Unit& u, const int wid) const {
        int lane_; asm volatile("v_mbcnt_lo_u32_b32 %0, -1, 0\n\tv_mbcnt_hi_u32_b32 %0, -1, %0" : "=v"(lane_));
        const int wr = wid >> 2, wc = wid & 3, fr = lane_ & 15, fq = lane_ >> 4, pm = u.x0 >> 2, pn = u.x0 & 3;
        const bf16* xsrc = (const bf16*)u.p0; bf16* xo = (bf16*)u.o; const float* gv = (const float*)u.p1;
        int row0 = wr * 64 + fr, col0 = wc * 32 + 8 * fq; asm volatile("" : "+v"(row0), "+v"(col0));
        LAS f32x2* Pt = (LAS f32x2*)tab; LAS f32x2* St = (LAS f32x2*)(tab + 8192);
        f32x4 gg[2][2];
#pragma unroll
        for (int bj = 0; bj < 2; ++bj)
#pragma unroll
            for (int n = 0; n < 2; ++n) gg[bj][n] = *(const f32x4*)(gv + col0 + bj * HALF + n * 4) * dq;
#pragma unroll
        for (int ai = 0; ai < 2; ++ai) {
            v4u xw[1][4][2];
#pragma unroll
            for (int m = 0; m < 4; ++m)
#pragma unroll
                for (int bj = 0; bj < 2; ++bj) xw[0][m][bj] = *(const v4u*)(xsrc + (size_t)(row0 + ai * HALF + m * 16) * D + col0 + bj * HALF);
#pragma unroll
            for (int m = 0; m < 4; ++m) { float sm = 0.f, sq = 0.f;
#pragma unroll
                for (int bj = 0; bj < 2; ++bj) { const v4u w_ = xw[0][m][bj];
                    const f32x4 x0 = (f32x4){bflo(w_.x), bfhi(w_.x), bflo(w_.y), bfhi(w_.y)}, x1 = (f32x4){bflo(w_.z), bfhi(w_.z), bflo(w_.w), bfhi(w_.w)};
                    const f32x4 z0 = x0 * ALPHA + gg[bj][0] * acc[ai][bj][m][0], z1 = x1 * ALPHA + gg[bj][1] * acc[ai][bj][m][1]; acc[ai][bj][m][0] = z0; acc[ai][bj][m][1] = z1;
                    sm += ((z0[0] + z0[1]) + (z0[2] + z0[3])) + ((z1[0] + z1[1]) + (z1[2] + z1[3]));
                    sq += ((z0[0] * z0[0] + z0[1] * z0[1]) + (z0[2] * z0[2] + z0[3] * z0[3])) + ((z1[0] * z1[0] + z1[1] * z1[1]) + (z1[2] * z1[2] + z1[3] * z1[3])); }
                sm += __shfl_xor(sm, 16); sm += __shfl_xor(sm, 32); sq += __shfl_xor(sq, 16); sq += __shfl_xor(sq, 32);
                if (fq == 0) Pt[(ai * HALF + wr * 64 + m * 16 + fr) * 4 + wc] = (f32x2){sm, sq}; }
            asm volatile("" ::: "memory"); }
        const float* lg = lng + pn * 256; const float* lb = lnb + pn * 256; const float* scv = gv + sc_delta; const float* shv = gv + sh_delta;
        f32x4 g4[2][2], b4[2][2], s4[2][2], t4[2][2];
#pragma unroll
        for (int bj = 0; bj < 2; ++bj)
#pragma unroll
            for (int n = 0; n < 2; ++n) { const int c = col0 + bj * HALF + n * 4; g4[bj][n] = *(const f32x4*)(lg + c); b4[bj][n] = *(const f32x4*)(lb + c); s4[bj][n] = *(const f32x4*)(scv + c); t4[bj][n] = *(const f32x4*)(shv + c); }
        asm volatile("s_waitcnt lgkmcnt(0)" ::: "memory"); __builtin_amdgcn_s_barrier(); asm volatile("" ::: "memory");
        const int trow = wid * 64 + lane_;
        if (wid < 4) {
            const f32x2 a = Pt[trow * 4 + 0], b = Pt[trow * 4 + 1], c = Pt[trow * 4 + 2], d = Pt[trow * 4 + 3];
            const float ts = (a.x + b.x) + (c.x + d.x), tq = (a.y + b.y) + (c.y + d.y);
            __hip_atomic_store(xs + ((size_t)pm * 256 + trow) * 4 + pn, ((unsigned long long)__float_as_uint(tq) << 32) | __float_as_uint(ts), __ATOMIC_RELAXED, __HIP_MEMORY_SCOPE_AGENT);
            asm volatile("s_waitcnt vmcnt(0)" ::: "memory");
            if (lane_ == 0) __hip_atomic_fetch_add(cnt + pm * 16, 1u, __ATOMIC_RELAXED, __HIP_MEMORY_SCOPE_AGENT);
        }
        if (wid == 0) {
            unsigned sp = 0;
            while ((unsigned)__builtin_amdgcn_readfirstlane(__hip_atomic_load(cnt + pm * 16, __ATOMIC_RELAXED, __HIP_MEMORY_SCOPE_AGENT)) < 16u) {
                __builtin_amdgcn_s_sleep(1);
                if ((++sp & 1023u) == 0u && (sp > (1u << 24) || __hip_atomic_load(tmo, __ATOMIC_RELAXED, __HIP_MEMORY_SCOPE_AGENT) != 0u)) { if (lane_ == 0) __hip_atomic_store(tmo, 1u, __ATOMIC_RELAXED, __HIP_MEMORY_SCOPE_AGENT); break; } }
            __builtin_amdgcn_fence(__ATOMIC_ACQUIRE, "agent");
        }
        asm volatile("s_waitcnt vmcnt(0) lgkmcnt(0)" ::: "memory"); __builtin_amdgcn_s_barrier(); asm volatile("" ::: "memory");
        if (wid < 4) {
            const unsigned long long* sl = xs + ((size_t)pm * 256 + trow) * 4; float ts = 0.f, tq = 0.f;
#pragma unroll
            for (int t = 0; t < 4; ++t) { const unsigned long long w = __hip_atomic_load(sl + t, __ATOMIC_RELAXED, __HIP_MEMORY_SCOPE_AGENT); ts += __uint_as_float((unsigned)w); tq += __uint_as_float((unsigned)(w >> 32)); }
            const float mean = ts * (1.f / D), var = fmaxf(tq * (1.f / D) - mean * mean, 0.f);
            St[trow] = (f32x2){mean, rsqrtf(var + LN_EPS)};
        }
        asm volatile("s_waitcnt vmcnt(0) lgkmcnt(0)" ::: "memory"); __builtin_amdgcn_s_barrier(); asm volatile("" ::: "memory");
        bf16* hb = h8 ? (bf16*)((unsigned char*)H + ((size_t)pm * 256) * D + pn * 256) : H + ((size_t)pm * 256) * D + pn * 256;
#pragma unroll
        for (int bj = 0; bj < 2; ++bj)
#pragma unroll
            for (int n = 0; n < 2; ++n) s4[bj][n] = s4[bj][n] + 1.0f;
#pragma unroll
        for (int ai = 0; ai < 2; ++ai)
#pragma unroll
            for (int m = 0; m < 4; ++m) { const int r = row0 + ai * HALF + m * 16; const f32x2 ms = St[r]; const size_t off = (size_t)r * D + col0;
#pragma unroll
                for (int bj = 0; bj < 2; ++bj) {
                    const f32x4 xa = (acc[ai][bj][m][0] - ms.x) * ms.y * g4[bj][0] + b4[bj][0], xc_ = (acc[ai][bj][m][1] - ms.x) * ms.y * g4[bj][1] + b4[bj][1];
                    v4u wx; wx.x = cvt_pk_bf16(xa[0], xa[1]); wx.y = cvt_pk_bf16(xa[2], xa[3]); wx.z = cvt_pk_bf16(xc_[0], xc_[1]); wx.w = cvt_pk_bf16(xc_[2], xc_[3]);
                    *(v4u*)(xo + off + bj * HALF) = wx;
                    const f32x4 ha = xa * s4[bj][0] + t4[bj][0], hc = xc_ * s4[bj][1] + t4[bj][1];
                    if (h8) { v2u w8; w8.x = pk_fp8x4(ha[0] * Q_H, ha[1] * Q_H, ha[2] * Q_H, ha[3] * Q_H); w8.y = pk_fp8x4(hc[0] * Q_H, hc[1] * Q_H, hc[2] * Q_H, hc[3] * Q_H);
                        *(v2u*)((unsigned char*)hb + off + bj * HALF) = w8; }
                    else { v4u wh; wh.x = cvt_pk_bf16(ha[0], ha[1]); wh.y = cvt_pk_bf16(ha[2], ha[3]); wh.z = cvt_pk_bf16(hc[0], hc[1]); wh.w = cvt_pk_bf16(hc[2], hc[3]);
                        *(v4u*)(hb + off + bj * HALF) = wh; } } }
    }
};
struct EpiGLU {
    static constexpr bool PERM = true, PREFETCH = false;
    __device__ __forceinline__ void operator()(const f32x4 (&acc)[2][2][4][2], const Unit& u, const int wid) const {
        int lane_; asm volatile("v_mbcnt_lo_u32_b32 %0, -1, 0\n\tv_mbcnt_hi_u32_b32 %0, -1, %0" : "=v"(lane_));
        const int wr = wid >> 2, wc = wid & 3, fr = lane_ & 15, fq = lane_ >> 4;
        bf16* base = (bf16*)u.o; const bf16* gp = (const bf16*)u.p0; const float* bias = (const float*)u.p1;
        int row0 = wr * 64 + fr, col0 = wc * 32 + 8 * fq; asm volatile("" : "+v"(row0), "+v"(col0));
        v4u gwv[2][4][2]; f32x4 bv[2][2];
#pragma unroll
        for (int ai = 0; ai < 2; ++ai)
#pragma unroll
            for (int m = 0; m < 4; ++m)
#pragma unroll
                for (int bj = 0; bj < 2; ++bj) { const int c_ = col0 + bj * HALF; gwv[ai][m][bj] = *(const v4u*)(gp + ((size_t)(c_ >> 4) * T + (row0 + ai * HALF + m * 16)) * 16 + (c_ & 15)); }
#pragma unroll
        for (int bj = 0; bj < 2; ++bj) { bv[bj][0] = *(const f32x4*)(bias + col0 + bj * HALF); bv[bj][1] = *(const f32x4*)(bias + col0 + bj * HALF + 4); }
#pragma unroll
        for (int ai = 0; ai < 2; ++ai)
#pragma unroll
            for (int m = 0; m < 4; ++m) { const int r = row0 + ai * HALF + m * 16;
#pragma unroll
                for (int bj = 0; bj < 2; ++bj) { const v4u gw = gwv[ai][m][bj];
                    const f32x4 a0 = acc[ai][bj][m][0] + bv[bj][0], a1 = acc[ai][bj][m][1] + bv[bj][1];
                    const f32x2 p0 = (f32x2){bflo(gw.x), bfhi(gw.x)} * sigmoid_2((f32x2){a0[0], a0[1]}), p1 = (f32x2){bflo(gw.y), bfhi(gw.y)} * sigmoid_2((f32x2){a0[2], a0[3]});
                    const f32x2 p2 = (f32x2){bflo(gw.z), bfhi(gw.z)} * sigmoid_2((f32x2){a1[0], a1[1]}), p3 = (f32x2){bflo(gw.w), bfhi(gw.w)} * sigmoid_2((f32x2){a1[2], a1[3]});
                    v4u w; w.x = cvt_pk_bf16(p0[0], p0[1]); w.y = cvt_pk_bf16(p1[0], p1[1]); w.z = cvt_pk_bf16(p2[0], p2[1]); w.w = cvt_pk_bf16(p3[0], p3[1]);
                    *(v4u*)(base + (size_t)r * u.ldo + col0 + bj * HALF) = w; } }
    }
};
struct EpiS5B {
    static constexpr bool PERM = true, PREFETCH = false;
    __device__ __forceinline__ void operator()(const f32x4 (&acc)[2][2][4][2], const Unit& u, const int wid) const {
        int lane_; asm volatile("v_mbcnt_lo_u32_b32 %0, -1, 0\n\tv_mbcnt_hi_u32_b32 %0, -1, %0" : "=v"(lane_));
        const int wr = wid >> 2, wc = wid & 3, fr = lane_ & 15, fq = lane_ >> 4;
        bf16* base = (bf16*)u.o; const bf16* y1 = (const bf16*)u.p0;
        int row0 = wr * 64 + fr, col0 = wc * 32 + 8 * fq; asm volatile("" : "+v"(row0), "+v"(col0));
        v4u yw[2][4][2];
#pragma unroll
        for (int ai = 0; ai < 2; ++ai)
#pragma unroll
            for (int m = 0; m < 4; ++m)
#pragma unroll
                for (int bj = 0; bj < 2; ++bj) yw[ai][m][bj] = *(const v4u*)(y1 + (size_t)(row0 + ai * HALF + m * 16) * 256 + col0 + bj * HALF);
#pragma unroll
        for (int ai = 0; ai < 2; ++ai)
#pragma unroll
            for (int m = 0; m < 4; ++m) { const int r = row0 + ai * HALF + m * 16;
#pragma unroll
                for (int bj = 0; bj < 2; ++bj) { const int c = col0 + bj * HALF; const v4u w_ = yw[ai][m][bj];
                    const f32x4 a0 = acc[ai][bj][m][0], a1 = acc[ai][bj][m][1];
                    const f32x2 p0 = gelu_tanh_2((f32x2){a0[0], a0[1]} + (f32x2){bflo(w_.x), bfhi(w_.x)}), p1 = gelu_tanh_2((f32x2){a0[2], a0[3]} + (f32x2){bflo(w_.y), bfhi(w_.y)});
                    const f32x2 p2 = gelu_tanh_2((f32x2){a1[0], a1[1]} + (f32x2){bflo(w_.z), bfhi(w_.z)}), p3 = gelu_tanh_2((f32x2){a1[2], a1[3]} + (f32x2){bflo(w_.w), bfhi(w_.w)});
                    v4u w; w.x = cvt_pk_bf16(p0[0], p0[1]); w.y = cvt_pk_bf16(p1[0], p1[1]); w.z = cvt_pk_bf16(p2[0], p2[1]); w.w = cvt_pk_bf16(p3[0], p3[1]);
                    *(v4u*)(base + (size_t)r * 256 + c) = w; } }
    }
};
}

struct Params { const float* in[32]; float* out; unsigned char* ws; int ph_lo, ph_hi; };
enum { I_X = 0, I_C, I_CTX, I_CCTX, I_WMOD, I_BMOD, I_LNG, I_LNB, I_EV_WIN, I_EV_WOUT, I_EV_SINK, I_EV_W1, I_EV_W3, I_EV_W2, I_OD_WIN, I_A_RE, I_A_IM, I_LOG_DT,
       I_B_RE, I_B_IM, I_C_RE, I_C_IM, I_SSM_D, I_WGLU, I_BGLU, I_WS, I_BS, I_OD_WOUT, I_ROUTER, I_MW1, I_MW3, I_MW2 };

constexpr int LDS_RING = 131072, LDS_MISC = LDS_RING + 320, LDS_LNTAB = LDS_RING + 1024, LDS_BYTES = 147456;
constexpr int NWAVES = 8, NTHREADS = 512;

struct Frame {
    LAS unsigned char* lds;
    int tid, lane, wave, G, bid, gw, NGW;
    unsigned char* ws;
    unsigned* ctl;
};

using pg8::Unit;
__device__ __forceinline__ void xcd_rows(int c, int nM, int& r0, int& cnt) { const int x = c & 7, base = nM >> 3, extra = nM & 7; cnt = base + (x < extra ? 1 : 0); r0 = x * base + (x < extra ? x : extra); }
__device__ __forceinline__ void grp_unit(int q, int cnt, int nN, int RG, int& row_local, int& pn) {
    const int gfull = RG * nN, rg = q / gfull, rem = q - rg * gfull; int rows_here = cnt - rg * RG; rows_here = rows_here < RG ? rows_here : RG;
    pn = rem / rows_here; row_local = rg * RG + (rem - pn * rows_here);
}
__device__ __forceinline__ bool xcd_unit(int i, int G, int c, int nM, int nN, int RG, int& pm, int& pn) {
    int r0, cnt; xcd_rows(c, nM, r0, cnt); const int q = i * (G >> 3) + (c >> 3); if (q >= cnt * nN) return false;
    int rl; grp_unit(q, cnt, nN, RG, rl, pn); pm = r0 + rl; return true;
}
struct SchedStd {
    int nN, nUnits, G, c; const char* A; const char* B; char* O; size_t aStep, bStep, oRow, oCol; int ldo, act_from;
    __device__ __forceinline__ bool next(int i, Unit& u) const {
        int pm, pn; if (!xcd_unit(i, G, c, nUnits / nN, nN, 4, pm, pn)) return false;
        u.a = A + (size_t)pm * aStep; u.b = B + (size_t)pn * bStep; u.o = O + (size_t)pm * oRow + (size_t)pn * oCol; u.p0 = nullptr; u.p1 = nullptr; u.ldo = ldo; u.x0 = (pn >= act_from) ? 1 : 0; return true;
    }
};
struct SchedEvIn {
    int G, c; const char* H; const char* Wqkv; const char* Wpq; char* QKV; char* PQT; char* PQTC;
    __device__ __forceinline__ bool next(int i, Unit& u) const {
        u.p0 = nullptr; u.p1 = nullptr; u.x0 = 0;
        int r0, cnt; xcd_rows(c, T / 256, r0, cnt);
        int q = i * (G >> 3) + (c >> 3);
        if (q < cnt * 3) { int rl, pn; grp_unit(q, cnt, 3, 4, rl, pn); const int pm = r0 + rl;
            u.a = H + (size_t)pm * 256 * D * 2; u.b = Wqkv + (size_t)pn * 256 * D * 2; u.o = QKV + ((size_t)pm * 256 * 768 + pn * 256) * 2; u.ldo = 768; return true; }
        q -= cnt * 3; if (q >= cnt * 4) return false;
        int rl, pm; grp_unit(q, cnt, 4, 4, rl, pm); const int tt = r0 + rl, isq = pm >> 1, ch0 = (pm & 1) * 256;
        u.a = Wpq + (size_t)pm * 256 * D * 2; u.b = H + (size_t)tt * 256 * D * 2;
        if (tt < TL / 256) { const int b = tt >> 4, n0 = (tt & 15) * 256; u.o = PQT + ((((size_t)b * 512 + ch0) * 2 + isq) * 4096 + n0) * 2; u.ldo = 8192; }
        else { const int b = tt - TL / 256; u.o = PQTC + (((size_t)b * 512 + ch0) * 2 + isq) * 256 * 2; u.ldo = 512; }
        return true;
    }
};
struct SchedDft {
    int G, c; const char* FDm; const char* VB; const char* F2; const char* PQTC; char* MIX;
    __device__ __forceinline__ bool next(int i, Unit& u) const {
        int L = i * G + c; u.p0 = nullptr; u.p1 = nullptr; u.x0 = 0;
        if (L < 512) { const int b = L >> 5, pn = L & 31, k2 = pn >> 1, ch0 = (pn & 1) * 256;
            u.a = FDm; u.b = VB + ((((size_t)b * 16 + k2) * 512 + ch0) * 512) * 2; u.o = MIX + ((((size_t)b * 4096 + k2) * D) + ch0) * 2; u.ldo = 16 * D; return true; }
        L -= 512; if (L >= 32) return false;
        const int b = L >> 1, pn = L & 1;
        u.a = F2; u.b = PQTC + ((size_t)b * 512 + pn * 256) * 512 * 2; u.o = MIX + (((size_t)TL + (size_t)b * 256) * D + pn * 256) * 2; u.ldo = D; return true;
    }
};
struct SchedResid {
    int G, c, nUnits; const char* A; size_t aStep; const char* W; size_t bStep; bf16* xb; const float* gate;
    __device__ __forceinline__ bool next(int i, Unit& u) const {
        int pm, pn; if (!xcd_unit(i, G, c, nUnits >> 2, 4, 1, pm, pn)) return false;
        const int L = pm * 4 + pn;
        u.a = A + (size_t)pm * aStep; u.b = W + (size_t)pn * bStep;
        const bool isc = pm >= TL / 256; const int mrow = isc ? 16 : (pm >> 4);
        const size_t off = ((size_t)pm * 256 * D + pn * 256);
        u.p0 = (const char*)(xb + off); u.o = (char*)(xb + off); u.p1 = (const char*)(gate + (size_t)mrow * 6144 + pn * 256); u.ldo = D; u.x0 = L; return true;
    }
};
struct SchedO1 {
    int G, c; const char* H; const char* W; char* Pp; char* UG;
    __device__ __forceinline__ bool next(int i, Unit& u) const {
        int pm, pn; if (!xcd_unit(i, G, c, T / 256, 6, 4, pm, pn)) return false;
        u.a = H + (size_t)pm * 256 * D * 2; u.b = W + (size_t)pn * 256 * D * 2; u.p0 = nullptr; u.p1 = nullptr;
        if (pn < 2) { u.o = UG + (((size_t)(pn * 16) * T + (size_t)pm * 256) * 16) * 2; u.ldo = 0; u.x0 = 2; }
        else { u.o = Pp + ((size_t)pm * 256 * D + (pn - 2) * 256) * 2; u.ldo = D; u.x0 = 1; }
        return true;
    }
};
struct SchedGlu {
    int G, c; const char* UG; const char* W; char* MIX; const float* bias;
    __device__ __forceinline__ bool next(int i, Unit& u) const {
        const int L = i * G + c; if (L >= (T / 256) * 2) return false;
        const int pm = L >> 1, pn = L & 1;
        u.a = UG + (size_t)pm * 256 * 32; u.b = W + (size_t)pn * 256 * 512 * 2; u.o = MIX + ((size_t)pm * 256 * D + pn * 256) * 2;
        u.p0 = UG + (((size_t)(pn * 16) * T + (size_t)pm * 256) * 16) * 2; u.p1 = (const char*)(bias + pn * 256); u.ldo = D; u.x0 = 0; return true;
    }
};
struct SchedS5A {
    int G, c; const char* UG; const char* WA; char* Y1; char* HB;
    __device__ __forceinline__ bool next(int i, Unit& u) const {
        const int L = i * G + c; if (L >= 32 * 34) return false;
        const int g = L / 34, rem = L - g * 34, pm = rem >> 1, pn = rem & 1;
        const size_t toff = (((size_t)g * 4352 + (size_t)pm * 256) * 256) * 2;
        u.a = UG + toff; u.b = WA + (size_t)g * S5M_STRIDE + (size_t)pn * 256 * 256 * 2;
        u.o = (pn ? HB : Y1) + toff; u.p0 = nullptr; u.p1 = nullptr; u.ldo = 256; u.x0 = 0; return true;
    }
};
struct SchedS5B {
    int G, c; const char* HB; const char* CL; const char* Y1; char* UG;
    __device__ __forceinline__ bool next(int i, Unit& u) const {
        const int L = i * G + c; if (L >= 32 * 17) return false;
        const int g = L / 17, pm = L - g * 17;
        const size_t toff = (((size_t)g * 4352 + (size_t)pm * 256) * 256) * 2;
        u.a = HB + toff; u.b = CL + (size_t)g * S5M_STRIDE; u.p0 = Y1 + toff; u.o = UG + toff; u.p1 = nullptr; u.ldo = 256; u.x0 = 0; return true;
    }
};
struct SchedMoeUp {
    int G, c, nUnits, rt0; int toff[9]; const char* HS; const char* W; char* HID;
    __device__ __forceinline__ bool next(int i, Unit& u) const {
        int rl, pn; if (!xcd_unit(i, G, c, nUnits / 28, 28, 8, rl, pn)) return false;
        const int rt = rt0 + rl; int e = 0;
#pragma unroll
        for (int k = 1; k < 8; ++k) e += (rt >= toff[k]) ? 1 : 0;
        u.a = HS + (size_t)rt * 256 * D; u.b = W + ((size_t)e * 7168 + pn * 256) * D; u.o = HID + ((size_t)rl * 28 + pn) * 32768;
        u.p0 = nullptr; u.p1 = nullptr; u.ldo = EH; u.x0 = 0; return true;
    }
};
struct SchedMoeDown {
    int G, c, nUnits, rt0; int toff[9]; const char* HID; const char* W; char* Y;
    __device__ __forceinline__ bool next(int i, Unit& u) const {
        int rl, pn; if (!xcd_unit(i, G, c, nUnits >> 2, 4, 8, rl, pn)) return false;
        const int rt = rt0 + rl; int e = 0;
#pragma unroll
        for (int k = 1; k < 8; ++k) e += (rt >= toff[k]) ? 1 : 0;
        u.a = HID + (size_t)rl * 28 * 32768; u.b = W + ((size_t)e * 1024 + pn * 256) * EH; u.o = Y + ((size_t)rt * 256 * D + pn * 256) * 2;
        u.p0 = nullptr; u.p1 = nullptr; u.ldo = D; u.x0 = 0; return true;
    }
};

constexpr int CVT_ITEMS = 2 * 5120 + 2 * 1408 + 2 * 8 * 3 * 1792;
constexpr int CVT_W2_0 = 2 * 896 + 2 * 1408;
constexpr int CVT_MOE0 = 2 * 5120 + 2 * 1408, CVT_MOE_LI = 8 * 3 * 1792;
struct CvtDesc { const float* src; unsigned char* dst; int ldn, ldk; };
template <class PPtr>
__device__ __forceinline__ CvtDesc cvt_decode(PPtr pp, unsigned char* ws, int r) {
    constexpr int EV_ITEMS = 384 + 512;
    constexpr int ODS_ITEMS = 768 + 128 + 512;
    constexpr int EXP_ITEMS = 3 * 1792, MOE_ITEMS = 8 * EXP_ITEMS;
    int idx, ldn, N, ldk, es = 2, mode = 0, roff = 0; size_t soff, doff;
    if (r < 2 * EV_ITEMS) { const int li = r / EV_ITEMS; r -= li * EV_ITEMS; const size_t base = WS_EV + (size_t)li * EV_STRIDE;
        if (r < 384) { idx = I_EV_WIN; soff = (size_t)li * D * 1280 + 512; ldn = 1280; N = 768; doff = base + EV_WQKV; ldk = D; }
        else { r -= 384; idx = I_EV_WOUT; soff = (size_t)li * D * D; ldn = D; N = D; doff = base + EV_WOUT; ldk = D; } }
    else if (r < 2 * EV_ITEMS + 2 * ODS_ITEMS) { r -= 2 * EV_ITEMS; const int li = r / ODS_ITEMS; r -= li * ODS_ITEMS; const size_t base = WS_OD + (size_t)li * OD_STRIDE;
        if (r < 768) { idx = I_OD_WIN; soff = (size_t)li * D * 1536; ldn = 1536; N = 1536; doff = base + OD_WIN; ldk = D; }
        else if (r < 896) { r -= 768; idx = I_WGLU; soff = (size_t)li * 512 * 512; ldn = 512; N = 512; doff = base + OD_WGLU; ldk = 512; }
        else { r -= 896; idx = I_OD_WOUT; soff = (size_t)li * D * D; ldn = D; N = D; doff = base + OD_WOUT; ldk = D; } }
    else if (r < CVT_MOE0) { r -= CVT_W2_0; const int li = r / 4224; r -= li * 4224; es = 1; const size_t base = WS_EV + (size_t)li * EV_STRIDE;
        if (r < 1408) { idx = I_EV_W1; soff = (size_t)li * D * FFH; ldn = FFH; N = FFH; doff = base + EV_W13; ldk = D; mode = 1; }
        else if (r < 2816) { r -= 1408; idx = I_EV_W3; soff = (size_t)li * D * FFH; ldn = FFH; N = FFH; doff = base + EV_W13; ldk = D; mode = 1; roff = 128; }
        else { r -= 2816; idx = I_EV_W2; soff = (size_t)li * FFH * D; ldn = D; N = D; doff = base + EV_W2; ldk = FFH; } }
    else { r -= CVT_MOE0; const int li = r / MOE_ITEMS; r -= li * MOE_ITEMS; const int e = r / EXP_ITEMS; r -= e * EXP_ITEMS; const size_t base = WS_OD + (size_t)li * OD_STRIDE;
        const size_t we = (size_t)li * NEXP + e; es = 1;
        if (r < 1792) { idx = I_MW1; soff = we * D * EH; ldn = EH; N = EH; doff = base + OD_MW13 + (size_t)e * 7168 * D; ldk = D; mode = 1; }
        else if (r < 3584) { r -= 1792; idx = I_MW3; soff = we * D * EH; ldn = EH; N = EH; doff = base + OD_MW13 + (size_t)e * 7168 * D; ldk = D; mode = 1; roff = 128; }
        else { r -= 3584; idx = I_MW2; soff = we * EH * D; ldn = D; N = D; doff = base + OD_MW2 + (size_t)e * D * EH; ldk = EH; } }
    const int nblk = N / 32, kb = r / nblk, nb = r - kb * nblk, n0 = nb * 32, k0 = kb * 64;
    const int drow0 = mode ? ((n0 >> 7) * 256 + (n0 & 127) + roff) : (roff + n0);
    CvtDesc d; d.src = (const float*)pp->in[idx] + soff + (size_t)k0 * ldn + n0; d.dst = ws + doff + ((size_t)drow0 * ldk + k0) * es; d.ldn = ldn; d.ldk = ldk; return d;
}
__device__ __forceinline__ void cvt_load(const CvtDesc& d, int lane, f32x4 (&v)[8]) {
    const float* q = d.src + (size_t)(lane >> 3) * d.ldn + (lane & 7) * 4;
#pragma unroll
    for (int j = 0; j < 8; ++j) v[j] = *(const f32x4*)(q + (size_t)(8 * j) * d.ldn);
}
template <bool FP8>
__device__ __forceinline__ void cvt_finish(const CvtDesc& d, const f32x4 (&v)[8], LAS float* scr, int lane) {
    constexpr float qs = FP8 ? Q_W : 1.0f;
    { LAS float* q = scr + (lane >> 3) * 33 + (lane & 7) * 4;
#pragma unroll
      for (int j = 0; j < 8; ++j) { q[(8 * j) * 33 + 0] = v[j][0] * qs; q[(8 * j) * 33 + 1] = v[j][1] * qs; q[(8 * j) * 33 + 2] = v[j][2] * qs; q[(8 * j) * 33 + 3] = v[j][3] * qs; } }
    LDS_WAIT(); asm volatile("" ::: "memory");
    const int c = lane & 7;
#pragma unroll
    for (int j = 0; j < 4; ++j) { const int n = (lane >> 3) + 8 * j; const LAS float* sp = scr + (8 * c) * 33 + n;
        if constexpr (FP8) { v2u o; o.x = pk_fp8x4(sp[0 * 33], sp[1 * 33], sp[2 * 33], sp[3 * 33]); o.y = pk_fp8x4(sp[4 * 33], sp[5 * 33], sp[6 * 33], sp[7 * 33]);
            *(v2u*)(d.dst + (size_t)n * d.ldk + 8 * c) = o; }
        else { v4u o; o.x = cvt_pk_bf16(sp[0 * 33], sp[1 * 33]); o.y = cvt_pk_bf16(sp[2 * 33], sp[3 * 33]); o.z = cvt_pk_bf16(sp[4 * 33], sp[5 * 33]); o.w = cvt_pk_bf16(sp[6 * 33], sp[7 * 33]);
            *(v4u*)(d.dst + ((size_t)n * d.ldk + 8 * c) * 2) = o; } }
    LDS_WAIT(); asm volatile("" ::: "memory");
}
template <bool FP8, class PPtr>
__device__ __forceinline__ void cvt_range(PPtr pp, unsigned char* ws, int first, int end, int stride, LAS float* scr, int lane) {
    if (first >= end) return;
    CvtDesc d = cvt_decode(pp, ws, first); f32x4 v[8]; cvt_load(d, lane, v);
    for (int it = first; it < end; it += stride) {
        int nx = it + stride; nx = nx < end ? nx : it;
        const CvtDesc dn = cvt_decode(pp, ws, nx); f32x4 vn[8]; cvt_load(dn, lane, vn);
        cvt_finish<FP8>(d, v, scr, lane);
        d = dn;
#pragma unroll
        for (int j = 0; j < 8; ++j) v[j] = vn[j];
    }
}

__device__ __forceinline__ void fold_unit(const Params& p, Frame& F, int unit) {
    const int li = unit >> 6, g = (unit >> 4) & 3, k0 = (unit & 15) * 64;
    LAS float* tile = (LAS float*)F.lds;
    LAS float* trig = tile + 64 * 129;
    const float* W = p.in[I_EV_WIN] + (size_t)li * D * 1280;
    for (int e = F.tid; e < 64 * 128; e += NTHREADS) { const int k = e >> 7, c = e & 127; tile[k * 129 + c] = W[(size_t)(k0 + k) * 1280 + g * 128 + c]; }
    if (F.tid < 128) { float s, c; sincospif((float)F.tid / 64.0f, &s, &c); trig[F.tid] = c * 0.08838834764831845f; trig[128 + F.tid] = s * 0.08838834764831845f; }
    __syncthreads();
    bf16* WT = (bf16*)(p.ws + WS_EV + li * EV_STRIDE + EV_WPQ);
    const int k = F.lane, mg = F.wave;
    for (int mm = 0; mm < 16; ++mm) { const int m = mg * 16 + mm; float sp = 0.f, sq = 0.f;
        for (int c = 0; c < 128; ++c) { const float w = tile[k * 129 + c]; const int ph = (m * c) & 127; sp += w * trig[ph]; sq += w * trig[128 + ph]; }
        WT[(size_t)(g * 128 + m) * D + k0 + k] = f2bf(sp); WT[(size_t)(512 + g * 128 + m) * D + k0 + k] = f2bf(sq); }
    __syncthreads();
}

__device__ __forceinline__ void row_load(const float* row, int lane, f32x4 (&v)[4]) {
#pragma unroll
    for (int j = 0; j < 4; ++j) v[j] = *(const f32x4*)(row + 256 * j + 4 * lane);
}
__device__ __forceinline__ void row_load_bf16(const bf16* row, int lane, f32x4 (&v)[4]) {
#pragma unroll
    for (int j = 0; j < 4; ++j) { const v2u w = *(const v2u*)(row + 256 * j + 4 * lane); v[j] = (f32x4){bflo(w.x), bfhi(w.x), bflo(w.y), bfhi(w.y)}; }
}
__device__ __forceinline__ void row_store(float* row, int lane, const f32x4 (&v)[4]) {
#pragma unroll
    for (int j = 0; j < 4; ++j) *(f32x4*)(row + 256 * j + 4 * lane) = v[j];
}
__device__ __forceinline__ void row_store_bf16(bf16* row, int lane, const f32x4 (&v)[4]) {
#pragma unroll
    for (int j = 0; j < 4; ++j) { v2u w; w.x = cvt_pk_bf16(v[j][0], v[j][1]); w.y = cvt_pk_bf16(v[j][2], v[j][3]); *(v2u*)(row + 256 * j + 4 * lane) = w; }
}
__device__ __forceinline__ void row_layernorm(f32x4 (&v)[4], const float* g, const float* b, int lane) {
    float s = 0.f;
#pragma unroll
    for (int j = 0; j < 4; ++j) s += (v[j][0] + v[j][1]) + (v[j][2] + v[j][3]);
    const float mean = wave_sum(s) * (1.f / D); float q = 0.f;
#pragma unroll
    for (int j = 0; j < 4; ++j) { v[j] = v[j] - mean; q += (v[j][0] * v[j][0] + v[j][1] * v[j][1]) + (v[j][2] * v[j][2] + v[j][3] * v[j][3]); }
    const float rstd = rsqrtf(wave_sum(q) * (1.f / D) + LN_EPS);
#pragma unroll
    for (int j = 0; j < 4; ++j) { const f32x4 gg = *(const f32x4*)(g + 256 * j + 4 * lane), bb = *(const f32x4*)(b + 256 * j + 4 * lane); v[j] = v[j] * rstd * gg + bb; }
}
__device__ __forceinline__ void row_modulate(f32x4 (&h)[4], const f32x4 (&v)[4], const float* sc, const float* sh, int lane) {
#pragma unroll
    for (int j = 0; j < 4; ++j) { const f32x4 s = *(const f32x4*)(sc + 256 * j + 4 * lane), t = *(const f32x4*)(sh + 256 * j + 4 * lane); h[j] = v[j] * (s + 1.0f) + t; }
}

__device__ __forceinline__ void row_ln_pre(f32x4 (&v)[4], const f32x4 (&gg)[4], const f32x4 (&bb)[4]) {
    float s = 0.f;
#pragma unroll
    for (int j = 0; j < 4; ++j) s += (v[j][0] + v[j][1]) + (v[j][2] + v[j][3]);
    const float mean = wave_sum(s) * (1.f / D); float q = 0.f;
#pragma unroll
    for (int j = 0; j < 4; ++j) { v[j] = v[j] - mean; q += (v[j][0] * v[j][0] + v[j][1] * v[j][1]) + (v[j][2] * v[j][2] + v[j][3] * v[j][3]); }
    const float rstd = rsqrtf(wave_sum(q) * (1.f / D) + LN_EPS);
#pragma unroll
    for (int j = 0; j < 4; ++j) v[j] = v[j] * rstd * gg[j] + bb[j];
}
__device__ __forceinline__ void row_load_mod(const float* sc, const float* sh, int lane, f32x4 (&s)[4], f32x4 (&t)[4]) {
#pragma unroll
    for (int j = 0; j < 4; ++j) { s[j] = *(const f32x4*)(sc + 256 * j + 4 * lane); t[j] = *(const f32x4*)(sh + 256 * j + 4 * lane); }
}
typedef const __attribute__((address_space(4))) Params* PP;
#define PIN(i) ((const float*)pp->in[i])
#define DECL_LDS extern __shared__ __attribute__((aligned(16))) unsigned char lds_raw[]
#define PHASE_FN static __device__ __forceinline__ void

__device__ __forceinline__ Frame make_frame(PP pp, unsigned char* lds_generic) {
    Frame F;
    F.lds = (LAS unsigned char*)lds_generic;
    { int t_ = threadIdx.x; asm volatile("" : "+v"(t_)); F.tid = t_; }
    F.lane = F.tid & 63; F.wave = __builtin_amdgcn_readfirstlane(F.tid >> 6);
    F.G = gridDim.x; F.bid = blockIdx.x; F.gw = F.bid * NWAVES + F.wave; F.NGW = F.G * NWAVES;
    F.ws = (unsigned char*)pp->ws; F.ctl = (unsigned*)(F.ws + WS_CTL);
    return F;
}
#define FRAME() DECL_LDS; asm volatile("" : "+s"(pp)); Frame F = make_frame(pp, lds_raw); unsigned char* ws = F.ws; (void)ws

PHASE_FN grid_bar(PP pp) {
    FRAME();
    XcdBarrier bar; bar.bar = F.ctl + CW_BAR; bar.x = xb_xcc_id(); bar.st = (volatile LAS unsigned*)(F.lds + LDS_MISC) + 8;
    xcd_barrier(bar);
}

static __device__ __forceinline__ void ln_pass(const Frame& F, float* out, float* XC, bf16* Hb, const float* lng, const float* lnb, const float* modv, const int sc_off, const int sh_off, const int TR) {
    f32x4 gg[4], bb[4];
#pragma unroll
    for (int j = 0; j < 4; ++j) { gg[j] = *(const f32x4*)(lng + 256 * j + 4 * F.lane); bb[j] = *(const f32x4*)(lnb + 256 * j + 4 * F.lane); }
    for (int r0 = F.gw; r0 < TR; r0 += 2 * F.NGW) {
        const int r1 = r0 + F.NGW; const bool two = r1 < TR;
        const bool c0 = r0 >= TL, c1 = r1 >= TL;
        float* x0 = c0 ? XC + (size_t)(r0 - TL) * D : out + (size_t)r0 * D; float* x1 = two ? (c1 ? XC + (size_t)(r1 - TL) * D : out + (size_t)r1 * D) : x0;
        const float* m0 = modv + (size_t)(c0 ? 16 : (r0 >> 12)) * 6144; const float* m1 = modv + (size_t)((two && !c1) ? (r1 >> 12) : 16) * 6144;
        f32x4 v0[4], v1[4], s0[4], t0[4], s1[4], t1[4];
        row_load(x0, F.lane, v0); row_load(x1, F.lane, v1);
        row_load_mod(m0 + sc_off, m0 + sh_off, F.lane, s0, t0); row_load_mod(m1 + sc_off, m1 + sh_off, F.lane, s1, t1);
        row_ln_pre(v0, gg, bb); row_ln_pre(v1, gg, bb);
        row_store(x0, F.lane, v0);
#pragma unroll
        for (int j = 0; j < 4; ++j) s0[j] = v0[j] * (s0[j] + 1.0f) + t0[j];
        row_store_bf16(Hb + (size_t)r0 * D, F.lane, s0);
        if (two) { row_store(x1, F.lane, v1);
#pragma unroll
            for (int j = 0; j < 4; ++j) s1[j] = v1[j] * (s1[j] + 1.0f) + t1[j];
            row_store_bf16(Hb + (size_t)r1 * D, F.lane, s1); }
    }
}
PHASE_FN ph_fold(PP pp) {
    FRAME();
    Params p; p.ws = ws; p.in[I_EV_WIN] = PIN(I_EV_WIN);
    for (int u = (F.G >= 256 ? F.bid - 128 : F.bid); u < 128; u += F.G) if (u >= 0) fold_unit(p, F, u);
}
PHASE_FN ph_mod(PP pp) {
    FRAME();
    float* MOD = (float*)(ws + WS_MOD);
    LAS float* sc = (LAS float*)F.lds;
    LAS float* part = sc + 17 * D;
    const float* cin = PIN(I_C); const float* ccin = PIN(I_CCTX);
    __syncthreads();
    for (int e = F.tid; e < 17 * D; e += NTHREADS) { const int r = e >> 10, k = e & 1023; const float v = (r < 16) ? cin[r * D + k] : ccin[k]; sc[e] = silu_f(v); }
    __syncthreads();
    for (int task = F.bid; task < DEPTH * 48; task += F.G) {
        const int l = task / 48, j0 = (task - l * 48) * 128;
        const float* W = PIN(I_WMOD) + ((size_t)l * D + F.wave * 128) * 6144 + j0 + 2 * F.lane;
        f32x2 acc[17];
#pragma unroll
        for (int r = 0; r < 17; ++r) acc[r] = (f32x2){0.f, 0.f};
        for (int k0 = 0; k0 < 128; k0 += 16) {
            f32x2 w[16];
#pragma unroll
            for (int q = 0; q < 16; ++q) w[q] = *(const f32x2*)(W + (size_t)(k0 + q) * 6144);
#pragma unroll
            for (int q4 = 0; q4 < 4; ++q4)
#pragma unroll
                for (int r = 0; r < 17; ++r) { const f32x4 sv = *(const LAS f32x4*)(sc + r * D + F.wave * 128 + k0 + 4 * q4);
                    acc[r] += (w[4 * q4] * sv[0] + w[4 * q4 + 1] * sv[1]) + (w[4 * q4 + 2] * sv[2] + w[4 * q4 + 3] * sv[3]); }
        }
        if (F.wave >= 4) {
#pragma unroll
            for (int r = 0; r < 17; ++r) *(LAS f32x2*)(part + ((F.wave - 4) * 17 + r) * 128 + 2 * F.lane) = acc[r]; }
        __syncthreads();
        if (F.wave < 4) {
#pragma unroll
            for (int r = 0; r < 17; ++r) { LAS f32x2* q = (LAS f32x2*)(part + (F.wave * 17 + r) * 128 + 2 * F.lane); *q = *q + acc[r]; } }
        __syncthreads();
        for (int o = F.tid; o < 17 * 128; o += NTHREADS) { const int r = o >> 7, j = o & 127; float v = PIN(I_BMOD)[l * 6144 + j0 + j];
#pragma unroll
            for (int w4 = 0; w4 < 4; ++w4) v += part[(w4 * 17 + r) * 128 + j];
            MOD[((size_t)l * 17 + r) * 6144 + j0 + j] = v; }
        __syncthreads();
    }
}
PHASE_FN ph_cvt(PP pp) {
    FRAME();
    Params p; p.ws = ws;
    p.in[I_EV_WIN] = PIN(I_EV_WIN); p.in[I_EV_WOUT] = PIN(I_EV_WOUT); p.in[I_EV_W1] = PIN(I_EV_W1); p.in[I_EV_W3] = PIN(I_EV_W3); p.in[I_EV_W2] = PIN(I_EV_W2);
    p.in[I_OD_WIN] = PIN(I_OD_WIN); p.in[I_WGLU] = PIN(I_WGLU); p.in[I_OD_WOUT] = PIN(I_OD_WOUT); p.in[I_MW1] = PIN(I_MW1); p.in[I_MW3] = PIN(I_MW3); p.in[I_MW2] = PIN(I_MW2);
    LAS float* scr = (LAS float*)(F.lds + F.wave * 16384);
    cvt_range<false>(pp, ws, F.gw, CVT_W2_0, F.NGW, scr, F.lane);
    cvt_range<true>(pp, ws, CVT_W2_0 + F.gw, CVT_MOE0, F.NGW, scr, F.lane);
}
PHASE_FN ph_dftmat(PP pp) {
    FRAME();
    bf16* FDm = (bf16*)(ws + WS_FD); bf16* F2 = (bf16*)(ws + WS_F256);
    for (int it = F.bid * NTHREADS + F.tid; it < 2 * 256 * 64; it += F.G * NTHREADS) {
        const int which = it >> 14, k = (it >> 6) & 255, n0 = (it & 63) * 8; const bool isq = n0 >= 256; const int nb = n0 & 255;
        float v[8];
#pragma unroll
        for (int j = 0; j < 8; ++j) { const int phs = (k * (nb + j)) & 255; float sn, cs; sincospif((float)phs * (1.0f / 128.0f), &sn, &cs);
            v[j] = which ? (isq ? -sn * (1.f / 16.f) : cs * (1.f / 16.f)) : (isq ? sn * (1.f / 64.f) : cs * (1.f / 64.f)); }
        v4u w; w.x = cvt_pk_bf16(v[0], v[1]); w.y = cvt_pk_bf16(v[2], v[3]); w.z = cvt_pk_bf16(v[4], v[5]); w.w = cvt_pk_bf16(v[6], v[7]);
        *(v4u*)((which ? F2 : FDm) + (size_t)k * 512 + n0) = w;
    }
}
PHASE_FN ph_s5mat(PP pp) {
    FRAME();
    LAS float* lam = (LAS float*)F.lds;
    LAS float* bb = lam + 2 * 64 * 17 * 2;
    LAS float* cc = bb + 2 * 64 * 16 * 2;
    LAS float* kt = cc + 2 * 16 * 64 * 2;
    for (int unit = (F.G >= 256 ? F.bid - 64 : F.bid); unit < 64; unit += F.G) {
        if (unit < 0) continue;
        const int li = unit >> 5, g = unit & 31;
        __syncthreads();
        if (F.tid < 128) { const int d = F.tid >> 6, pl = F.tid & 63; const int sidx = ((li * 2 + d) * 32 + g);
            const float are = PIN(I_A_RE)[sidx * 64 + pl], aim = PIN(I_A_IM)[sidx * 64 + pl], dt = expf(PIN(I_LOG_DT)[sidx]);
            for (int e = 0; e <= 16; ++e) { const float mag = expf(are * dt * (float)e); float sn, cn; sincosf(aim * dt * (float)e, &sn, &cn); lam[((d * 64 + pl) * 17 + e) * 2] = mag * cn; lam[((d * 64 + pl) * 17 + e) * 2 + 1] = mag * sn; } }
        __syncthreads();
        for (int e = F.tid; e < 2048; e += NTHREADS) { const int d = e >> 10, pl = (e >> 4) & 63, sp = e & 15; const int sidx = ((li * 2 + d) * 32 + g);
            const float are = PIN(I_A_RE)[sidx * 64 + pl], aim = PIN(I_A_IM)[sidx * 64 + pl];
            const float lre = lam[((d * 64 + pl) * 17 + 1) * 2], lim = lam[((d * 64 + pl) * 17 + 1) * 2 + 1];
            const float den = 1.0f / (are * are + aim * aim);
            const float fre = ((lre - 1.0f) * are + lim * aim) * den, fim = (lim * are - (lre - 1.0f) * aim) * den;
            const float br = PIN(I_B_RE)[((size_t)sidx * 64 + pl) * 16 + sp], bi = PIN(I_B_IM)[((size_t)sidx * 64 + pl) * 16 + sp];
            bb[e * 2] = fre * br - fim * bi; bb[e * 2 + 1] = fre * bi + fim * br; }
        for (int e = F.tid; e < 2048; e += NTHREADS) { const int d = e >> 10, sq = (e >> 6) & 15, pl = e & 63; const int sidx = ((li * 2 + d) * 32 + g);
            cc[e * 2] = PIN(I_C_RE)[((size_t)sidx * 16 + sq) * 64 + pl]; cc[e * 2 + 1] = PIN(I_C_IM)[((size_t)sidx * 16 + sq) * 64 + pl]; }
        __syncthreads();
        for (int e = F.tid; e < 8192; e += NTHREADS) { const int d = e >> 12, tau = (e >> 8) & 15, sq = (e >> 4) & 15, sp = e & 15; float acc = 0.f;
            for (int pl = 0; pl < 64; ++pl) { const float cr = cc[((d * 16 + sq) * 64 + pl) * 2], ci = cc[((d * 16 + sq) * 64 + pl) * 2 + 1];
                const float lr = lam[((d * 64 + pl) * 17 + tau) * 2], lj = lam[((d * 64 + pl) * 17 + tau) * 2 + 1];
                const float br = bb[((d * 64 + pl) * 16 + sp) * 2], bi = bb[((d * 64 + pl) * 16 + sp) * 2 + 1];
                const float tr = cr * lr - ci * lj, ti = cr * lj + ci * lr;
                acc += tr * br - ti * bi; }
            kt[e] = acc; }
        __syncthreads();
        bf16* WA = (bf16*)(ws + WS_S5M + (size_t)unit * S5M_STRIDE); bf16* CLm = WA + 512 * 256;
        const float* dsk = PIN(I_SSM_D) + (size_t)li * 512 + g * 16;
        for (int it = F.tid; it < 8192; it += NTHREADS) { const int row = it >> 5, c0 = (it & 31) * 8;
            float v[8];
            { const int i = row >> 4, sq = row & 15, j = c0 >> 4, sp0 = c0 & 15;
#pragma unroll
              for (int q = 0; q < 8; ++q) { const int sp = sp0 + q; float a = 0.f; if (i >= j) a += kt[((0 * 16 + (i - j)) * 16 + sq) * 16 + sp]; if (j >= i) a += kt[((1 * 16 + (j - i)) * 16 + sq) * 16 + sp]; if (i == j && sq == sp) a += dsk[sq]; v[q] = a; }
              v4u w; w.x = cvt_pk_bf16(v[0], v[1]); w.y = cvt_pk_bf16(v[2], v[3]); w.z = cvt_pk_bf16(v[4], v[5]); w.w = cvt_pk_bf16(v[6], v[7]); *(v4u*)(WA + (size_t)row * 256 + c0) = w; }
            { const int d = row >> 7, pl = (row >> 1) & 63, ri = row & 1, j = c0 >> 4, sp0 = c0 & 15, e = d ? j : 15 - j;
              const float lr = lam[((d * 64 + pl) * 17 + e) * 2], lj = lam[((d * 64 + pl) * 17 + e) * 2 + 1];
#pragma unroll
              for (int q = 0; q < 8; ++q) { const float br = bb[((d * 64 + pl) * 16 + sp0 + q) * 2], bi = bb[((d * 64 + pl) * 16 + sp0 + q) * 2 + 1]; v[q] = ri ? (lr * bi + lj * br) : (lr * br - lj * bi); }
              v4u w; w.x = cvt_pk_bf16(v[0], v[1]); w.y = cvt_pk_bf16(v[2], v[3]); w.z = cvt_pk_bf16(v[4], v[5]); w.w = cvt_pk_bf16(v[6], v[7]); *(v4u*)(WA + (size_t)(256 + row) * 256 + c0) = w; }
            { const int i = row >> 4, sq = row & 15, d = c0 >> 7, pl0 = (c0 >> 1) & 63, e = d ? 16 - i : i + 1;
#pragma unroll
              for (int q = 0; q < 4; ++q) { const int pl = pl0 + q; const float cr = cc[((d * 16 + sq) * 64 + pl) * 2], ci = cc[((d * 16 + sq) * 64 + pl) * 2 + 1];
                  const float lr = lam[((d * 64 + pl) * 17 + e) * 2], lj = lam[((d * 64 + pl) * 17 + e) * 2 + 1];
                  v[2 * q] = cr * lr - ci * lj; v[2 * q + 1] = -(cr * lj + ci * lr); }
              v4u w; w.x = cvt_pk_bf16(v[0], v[1]); w.y = cvt_pk_bf16(v[2], v[3]); w.z = cvt_pk_bf16(v[4], v[5]); w.w = cvt_pk_bf16(v[6], v[7]); *(v4u*)(CLm + (size_t)row * 256 + c0) = w; }
        }
    }
    __syncthreads();
}
PHASE_FN ph_pro_b(PP pp) {
    FRAME();
    const float* MOD = (const float*)(ws + WS_MOD); bf16* Hb = (bf16*)(ws + WS_H); bf16* XB = (bf16*)(ws + WS_XB);
    const float* xin = PIN(I_X); const float* cin = PIN(I_CTX);
    static_assert(T % (2 * 256 * NWAVES) == 0 && TL % (2 * 256 * NWAVES) == 0, "row pairs");
    for (int r0 = F.gw; r0 < T; r0 += 2 * F.NGW) {
        const int r1 = r0 + F.NGW; const bool c0 = r0 >= TL, c1 = r1 >= TL;
        const float* x0 = c0 ? cin + (size_t)(r0 - TL) * D : xin + (size_t)r0 * D; const float* x1 = c1 ? cin + (size_t)(r1 - TL) * D : xin + (size_t)r1 * D;
        const float* m0 = MOD + (size_t)(c0 ? 16 : (r0 >> 12)) * 6144; const float* m1 = MOD + (size_t)(c1 ? 16 : (r1 >> 12)) * 6144;
        f32x4 v0[4], v1[4], s0[4], t0[4], s1[4], t1[4];
        row_load(x0, F.lane, v0); row_load(x1, F.lane, v1); row_load_mod(m0 + 1024, m0, F.lane, s0, t0); row_load_mod(m1 + 1024, m1, F.lane, s1, t1);
        row_store_bf16(XB + (size_t)r0 * D, F.lane, v0); row_store_bf16(XB + (size_t)r1 * D, F.lane, v1);
#pragma unroll
        for (int j = 0; j < 4; ++j) { s0[j] = v0[j] * (s0[j] + 1.0f) + t0[j]; s1[j] = v1[j] * (s1[j] + 1.0f) + t1[j]; }
        row_store_bf16(Hb + (size_t)r0 * D, F.lane, s0); row_store_bf16(Hb + (size_t)r1 * D, F.lane, s1);
    }
}

PHASE_FN ph_e1(PP pp, int layer) {
    FRAME();
    unsigned char* evw = ws + WS_EV + (layer >> 1) * EV_STRIDE; unsigned char* BIG = ws + WS_BIG;
    SchedEvIn S{F.G, F.bid, (const char*)(ws + WS_H), (const char*)(evw + EV_WQKV), (const char*)(evw + EV_WPQ), (char*)(BIG + BIG_QKV), (char*)(BIG + BIG_PQT), (char*)(BIG + BIG_PQTC)};
    pg8::gemm_phase<pg8::EpiStore, SchedEvIn, true, true>(F.lds, F.tid, pg8::Dims{D, D, D}, S, pg8::EpiStore{});
}
template <class TT> struct cfT { TT r, i; };
typedef cfT<float> cf;
template <class TT, class WW> __device__ __forceinline__ cfT<TT> cmul(cfT<TT> a, WW wr, WW wi) { return cfT<TT>{a.r * wr - a.i * wi, a.r * wi + a.i * wr}; }
template <class TT> __device__ __forceinline__ void radix4(cfT<TT> x0, cfT<TT> x1, cfT<TT> x2, cfT<TT> x3, cfT<TT>& y0, cfT<TT>& y1, cfT<TT>& y2, cfT<TT>& y3) {
    const cfT<TT> s02{x0.r + x2.r, x0.i + x2.i}, d02{x0.r - x2.r, x0.i - x2.i}, s13{x1.r + x3.r, x1.i + x3.i}, d13{x1.r - x3.r, x1.i - x3.i};
    y0 = cfT<TT>{s02.r + s13.r, s02.i + s13.i}; y2 = cfT<TT>{s02.r - s13.r, s02.i - s13.i}; y1 = cfT<TT>{d02.r + d13.i, d02.i - d13.r}; y3 = cfT<TT>{d02.r - d13.i, d02.i + d13.r};
}
template <class TT> __device__ __forceinline__ void fft16(cfT<TT> (&x)[16]) {
    constexpr float C1 = 0.92387953251128674f, S1 = 0.38268343236508977f, C2 = 0.70710678118654752f;
    cfT<TT> A[4][4];
#pragma unroll
    for (int b = 0; b < 4; ++b) radix4(x[b], x[4 + b], x[8 + b], x[12 + b], A[b][0], A[b][1], A[b][2], A[b][3]);
    A[1][1] = cmul(A[1][1], C1, -S1); A[1][2] = cmul(A[1][2], C2, -C2); A[1][3] = cmul(A[1][3], S1, -C1);
    A[2][1] = cmul(A[2][1], C2, -C2); A[2][2] = cfT<TT>{A[2][2].i, -A[2][2].r}; A[2][3] = cmul(A[2][3], -C2, -C2);
    A[3][1] = cmul(A[3][1], S1, -C1); A[3][2] = cmul(A[3][2], -C2, -C2); A[3][3] = cmul(A[3][3], -C1, S1);
#pragma unroll
    for (int c = 0; c < 4; ++c) radix4(A[0][c], A[1][c], A[2][c], A[3][c], x[c], x[c + 4], x[c + 8], x[c + 12]);
}
PHASE_FN ph_e2_fft(PP pp) {
    FRAME();
    const bf16* PQT = (const bf16*)(ws + WS_BIG + BIG_PQT); bf16* VB = (bf16*)(ws + WS_H);
    for (int it = F.bid * NTHREADS + F.tid; it < NBATCH * 512 * 128; it += F.G * NTHREADS) {
        const int n1 = (it & 127) * 2, ch = (it >> 7) & 511, b = it >> 16;
        const bf16* pp_ = PQT + ((size_t)(b * 512 + ch) * 2) * 4096 + n1; const bf16* qq_ = pp_ + 4096;
        unsigned pw[16], qw[16];
#pragma unroll
        for (int n2 = 0; n2 < 16; ++n2) { pw[n2] = *(const unsigned*)(pp_ + 256 * n2); qw[n2] = *(const unsigned*)(qq_ + 256 * n2); }
        unsigned ore[16], oim[16];
        {
            cfT<f32x2> x[16];
#pragma unroll
            for (int n2 = 0; n2 < 16; ++n2) { x[n2].r = (f32x2){bflo(pw[n2]), bfhi(pw[n2])}; x[n2].i = -(f32x2){bflo(qw[n2]), bfhi(qw[n2])}; }
            fft16(x);
            float sn0, cs0, sn1, cs1; sincospif((float)n1 * (1.0f / 2048.0f), &sn0, &cs0); sincospif((float)(n1 + 1) * (1.0f / 2048.0f), &sn1, &cs1);
            const f32x2 cs = (f32x2){cs0, cs1}, msn = -(f32x2){sn0, sn1};
            cfT<f32x2> wk{cs, msn};
#pragma unroll
            for (int k2 = 1; k2 < 16; ++k2) { x[k2] = cmul(x[k2], wk.r, wk.i); wk = cmul(wk, cs, msn); }
#pragma unroll
            for (int k2 = 0; k2 < 16; ++k2) { ore[k2] = cvt_pk_bf16(x[k2].r[0], x[k2].r[1]); oim[k2] = cvt_pk_bf16(x[k2].i[0], x[k2].i[1]); }
        }
#pragma unroll
        for (int k2 = 0; k2 < 16; ++k2) { bf16* dst = VB + (((size_t)b * 16 + k2) * 512 + ch) * 512 + n1; *(unsigned*)dst = ore[k2]; *(unsigned*)(dst + 256) = oim[k2]; }
    }
}
PHASE_FN ph_e2_dft(PP pp) {
    FRAME();
    unsigned char* BIG = ws + WS_BIG;
    SchedDft S{F.G, F.bid, (const char*)(ws + WS_FD), (const char*)(ws + WS_H), (const char*)(ws + WS_F256), (const char*)(BIG + BIG_PQTC), (char*)(BIG + BIG_MIX)};
    pg8::gemm_phase<pg8::EpiStore, SchedDft, true, true>(F.lds, F.tid, pg8::Dims{512, 512, 512}, S, pg8::EpiStore{});
}
PHASE_FN ph_e2_rope(PP pp) {
    FRAME();
    bf16* QKV = (bf16*)(ws + WS_BIG + BIG_QKV);
    LAS f32x2* cs = (LAS f32x2*)F.lds;
    __syncthreads();
    for (int e = F.tid; e < 1024; e += NTHREADS) { const int pos = e >> 4, i = e & 15; const float inv = powf(10000.0f, -(float)i / 16.0f); float s, c; sincosf((float)pos * inv, &s, &c); cs[e] = (f32x2){c, s}; }
    __syncthreads();
    for (int it = F.bid * NTHREADS + F.tid; it < TL * 10; it += F.G * NTHREADS) {
        const int r = it / 10, hh = it - r * 10, n = r & 4095;
        v4u* base = (v4u*)(QKV + (size_t)r * 768 + hh * 64);
        v4u v[8];
#pragma unroll
        for (int k = 0; k < 8; ++k) v[k] = base[k];
#pragma unroll
        for (int ax = 0; ax < 2; ++ax) { const int pos = ax ? (n & 63) : (n >> 6);
#pragma unroll
            for (int k = 0; k < 2; ++k) { unsigned* a = (unsigned*)&v[4 * ax + k]; unsigned* b = (unsigned*)&v[4 * ax + 2 + k];
#pragma unroll
                for (int q = 0; q < 4; ++q) { const f32x2 t0 = cs[pos * 16 + 8 * k + 2 * q], t1 = cs[pos * 16 + 8 * k + 2 * q + 1];
                    const float x1l = bflo(a[q]), x1h = bfhi(a[q]), x2l = bflo(b[q]), x2h = bfhi(b[q]);
                    a[q] = cvt_pk_bf16(x1l * t0.x - x2l * t0.y, x1h * t1.x - x2h * t1.y); b[q] = cvt_pk_bf16(x1l * t0.y + x2l * t0.x, x1h * t1.y + x2h * t1.x); } } }
#pragma unroll
        for (int k = 0; k < 8; ++k) base[k] = v[k];
    }
    bf16* VT = (bf16*)(ws + WS_BIG + BIG_VT);
    for (int it = F.bid * NTHREADS + F.tid; it < NBATCH * 2 * 544 * 64; it += F.G * NTHREADS) {
        const int d = it & 63, kg = (it >> 6) % 544, bh = (it >> 6) / 544, b = bh >> 1, hkv = bh & 1;
        const int key0 = kg * 8; const size_t row0 = (key0 < 256) ? ((size_t)TL + (size_t)b * 256 + key0) : ((size_t)b * 4096 + (key0 - 256));
        const bf16* src = QKV + row0 * 768 + 640 + hkv * 64 + d;
        unsigned short v[8];
#pragma unroll
        for (int j = 0; j < 8; ++j) v[j] = src[(size_t)j * 768];
        v4u w; w.x = v[0] | ((unsigned)v[1] << 16); w.y = v[2] | ((unsigned)v[3] << 16); w.z = v[4] | ((unsigned)v[5] << 16); w.w = v[6] | ((unsigned)v[7] << 16);
        *(v4u*)(VT + ((size_t)bh * 64 + d) * 4352 + key0) = w;
    }
    __syncthreads();
}
typedef float f32x16 __attribute__((ext_vector_type(16)));
typedef __bf16 bf16x2v __attribute__((ext_vector_type(2)));
__device__ __forceinline__ unsigned pk_bf16(float a, float b) { const bf16x2v t = __builtin_convertvector((f32x2){a, b}, bf16x2v); return __builtin_bit_cast(unsigned, t); }
constexpr int AT_KP = 144, AT_VP1 = 648, AT_VP2 = 520, AT_VOFF = 320 * AT_KP;
template <bool MASKED>
__device__ __forceinline__ void attn_tile(const LAS unsigned char* Ks, const LAS unsigned char* Vs, const int vpitch, const int kl_base, const bf16x8 (&qf)[4], f32x16& o0, f32x16& o1, float& m, float& l,
                                          const int r, const int h, const int kj0, const int qi) {
    f32x16 x;
#pragma unroll
    for (int i = 0; i < 16; ++i) x[i] = 0.f;
#pragma unroll
    for (int s = 0; s < 4; ++s) { const bf16x8 kf = *(const LAS bf16x8*)(Ks + (kl_base + r) * AT_KP + (16 * s + 8 * h) * 2); x = __builtin_amdgcn_mfma_f32_32x32x16_bf16(kf, qf[s], x, 0, 0, 0); }
    constexpr float CS = 0.125f * 1.4426950408889634f;
    float sc[16]; float mt = -1e30f;
#pragma unroll
    for (int i = 0; i < 16; ++i) { float v = x[i];
        if (MASKED) { const int kj = kj0 + (i & 3) + 8 * (i >> 2) + 4 * h; const bool ok = (kj >= 0) && (kj < SEQ) && (kj - qi <= 128) && (qi - kj <= 128); v = ok ? v : -1e30f; }
        sc[i] = v; mt = fmaxf(mt, v); }
    mt = fmaxf(mt, __shfl_xor(mt, 32));
    const float mn = fmaxf(m, mt * CS), alpha = __builtin_amdgcn_exp2f(m - mn); m = mn;
    f32x2 ps2 = (f32x2){0.f, 0.f};
#pragma unroll
    for (int i = 0; i < 16; i += 2) { const f32x2 t = (f32x2){sc[i], sc[i + 1]} * CS - mn; const f32x2 p = (f32x2){__builtin_amdgcn_exp2f(t[0]), __builtin_amdgcn_exp2f(t[1])}; sc[i] = p[0]; sc[i + 1] = p[1]; ps2 += p; }
    l = l * alpha + (ps2[0] + ps2[1]);
    if (__any(alpha != 1.0f)) { o0 = o0 * alpha; o1 = o1 * alpha; }
#pragma unroll
    for (int s2 = 0; s2 < 2; ++s2) {
        v4u pw; pw.x = pk_bf16(sc[8 * s2 + 0], sc[8 * s2 + 1]); pw.y = pk_bf16(sc[8 * s2 + 2], sc[8 * s2 + 3]); pw.z = pk_bf16(sc[8 * s2 + 4], sc[8 * s2 + 5]); pw.w = pk_bf16(sc[8 * s2 + 6], sc[8 * s2 + 7]);
        const bf16x8 pk = __builtin_bit_cast(bf16x8, pw);
        { const LAS unsigned char* vp = Vs + r * vpitch + (kl_base + 16 * s2 + 4 * h) * 2; const v2u lo = *(const LAS v2u*)vp, hi = *(const LAS v2u*)(vp + 16);
          v4u vw; vw.x = lo.x; vw.y = lo.y; vw.z = hi.x; vw.w = hi.y; o0 = __builtin_amdgcn_mfma_f32_32x32x16_bf16(__builtin_bit_cast(bf16x8, vw), pk, o0, 0, 0, 0); }
        { const LAS unsigned char* vp = Vs + (32 + r) * vpitch + (kl_base + 16 * s2 + 4 * h) * 2; const v2u lo = *(const LAS v2u*)vp, hi = *(const LAS v2u*)(vp + 16);
          v4u vw; vw.x = lo.x; vw.y = lo.y; vw.z = hi.x; vw.w = hi.y; o1 = __builtin_amdgcn_mfma_f32_32x32x16_bf16(__builtin_bit_cast(bf16x8, vw), pk, o1, 0, 0, 0); }
    }
}
template <bool MASKED>
__device__ __forceinline__ void attn_tile2(const LAS unsigned char* Ks, const LAS unsigned char* Vs, const int vpitch, const int kl_base, const bf16x8 (&qf)[4], f32x16& o0, f32x16& o1, float& m, float& l,
                                           const int r, const int h, const int kj0, const int qi) {
    f32x16 xa, xb;
#pragma unroll
    for (int i = 0; i < 16; ++i) { xa[i] = 0.f; xb[i] = 0.f; }
#pragma unroll
    for (int s = 0; s < 4; ++s) { const bf16x8 ka = *(const LAS bf16x8*)(Ks + (kl_base + r) * AT_KP + (16 * s + 8 * h) * 2), kb = *(const LAS bf16x8*)(Ks + (kl_base + 32 + r) * AT_KP + (16 * s + 8 * h) * 2);
        xa = __builtin_amdgcn_mfma_f32_32x32x16_bf16(ka, qf[s], xa, 0, 0, 0); xb = __builtin_amdgcn_mfma_f32_32x32x16_bf16(kb, qf[s], xb, 0, 0, 0); }
    constexpr float CS = 0.125f * 1.4426950408889634f;
    float sc[32]; float mt = -1e30f;
#pragma unroll
    for (int i = 0; i < 32; ++i) { float v = (i < 16) ? xa[i & 15] : xb[i & 15];
        if (MASKED) { const int kj = kj0 + 32 * (i >> 4) + (i & 3) + 8 * ((i & 15) >> 2) + 4 * h; const bool ok = (kj >= 0) && (kj < SEQ) && (kj - qi <= 128) && (qi - kj <= 128); v = ok ? v : -1e30f; }
        sc[i] = v; mt = fmaxf(mt, v); }
    mt = fmaxf(mt, __shfl_xor(mt, 32));
    const float mn = fmaxf(m, mt * CS), alpha = __builtin_amdgcn_exp2f(m - mn); m = mn;
    f32x2 ps2 = (f32x2){0.f, 0.f};
#pragma unroll
    for (int i = 0; i < 32; i += 2) { const f32x2 t = (f32x2){sc[i], sc[i + 1]} * CS - mn; const f32x2 p = (f32x2){__builtin_amdgcn_exp2f(t[0]), __builtin_amdgcn_exp2f(t[1])}; sc[i] = p[0]; sc[i + 1] = p[1]; ps2 += p; }
    l = l * alpha + (ps2[0] + ps2[1]);
    if (__any(alpha != 1.0f)) { o0 = o0 * alpha; o1 = o1 * alpha; }
#pragma unroll
    for (int tt = 0; tt < 2; ++tt)
#pragma unroll
        for (int s2 = 0; s2 < 2; ++s2) { const int b = 16 * tt + 8 * s2;
            v4u pw; pw.x = pk_bf16(sc[b + 0], sc[b + 1]); pw.y = pk_bf16(sc[b + 2], sc[b + 3]); pw.z = pk_bf16(sc[b + 4], sc[b + 5]); pw.w = pk_bf16(sc[b + 6], sc[b + 7]);
            const bf16x8 pk = __builtin_bit_cast(bf16x8, pw);
            { const LAS unsigned char* vp = Vs + r * vpitch + (kl_base + 32 * tt + 16 * s2 + 4 * h) * 2; const v2u lo = *(const LAS v2u*)vp, hi = *(const LAS v2u*)(vp + 16);
              v4u vw; vw.x = lo.x; vw.y = lo.y; vw.z = hi.x; vw.w = hi.y; o0 = __builtin_amdgcn_mfma_f32_32x32x16_bf16(__builtin_bit_cast(bf16x8, vw), pk, o0, 0, 0, 0); }
            { const LAS unsigned char* vp = Vs + (32 + r) * vpitch + (kl_base + 32 * tt + 16 * s2 + 4 * h) * 2; const v2u lo = *(const LAS v2u*)vp, hi = *(const LAS v2u*)(vp + 16);
              v4u vw; vw.x = lo.x; vw.y = lo.y; vw.z = hi.x; vw.w = hi.y; o1 = __builtin_amdgcn_mfma_f32_32x32x16_bf16(__builtin_bit_cast(bf16x8, vw), pk, o1, 0, 0, 0); }
        }
}
PHASE_FN ph_e3_attn(PP pp, int layer) {
    FRAME();
    const bf16* QKV = (const bf16*)(ws + WS_BIG + BIG_QKV); bf16* MIX = (bf16*)(ws + WS_BIG + BIG_MIX); const bf16* VT = (const bf16*)(ws + WS_BIG + BIG_VT);
    const float* sinkp = PIN(I_EV_SINK) + (layer >> 1) * 8;
    LAS unsigned char* Ks = F.lds; LAS unsigned char* Vs = F.lds + AT_VOFF;
    const int r = F.lane & 31, h = F.lane >> 5, g = F.wave >> 1, th = F.wave & 1;
    constexpr int NU = 2048 + 128;
#define AT_DECODE(u_, isc_, b_, hkv_, n0_) do { isc_ = (u_) >= 2048; if (!isc_) { b_ = (u_) >> 7; hkv_ = ((u_) >> 6) & 1; n0_ = ((u_) & 63) * 64; } else { const int v_ = (u_) - 2048; b_ = v_ >> 3; hkv_ = (v_ >> 2) & 1; n0_ = (v_ & 3) * 64; } } while (0)
#define AT_LOAD1(b_, hkv_, n0_) do { int tl_ = F.tid; asm volatile("" : "+v"(tl_));   _Pragma("unroll") for (int k_ = 0; k_ < 5; ++k_) { const int pc = tl_ + k_ * NTHREADS; \
        { const int kl = pc >> 3, c8 = pc & 7, kj = (n0_) - 128 + kl; rk[k_] = (v4u){0u, 0u, 0u, 0u}; if (kj >= 0 && kj < SEQ) rk[k_] = *(const v4u*)(QKV + ((size_t)(b_) * 4096 + kj) * 768 + 512 + (hkv_) * 64 + c8 * 8); } \
        { const int d = pc / 40, c = pc - d * 40, kj = (n0_) - 128 + c * 8; rv[k_] = (v4u){0u, 0u, 0u, 0u}; if (kj >= 0 && kj < SEQ) rv[k_] = *(const v4u*)(VT + ((size_t)((b_) * 2 + (hkv_)) * 64 + d) * 4352 + 256 + kj); } } } while (0)
#define AT_STORE1() do { int tl_ = F.tid; asm volatile("" : "+v"(tl_));   _Pragma("unroll") for (int k_ = 0; k_ < 5; ++k_) { const int pc = tl_ + k_ * NTHREADS; \
        { const int kl = pc >> 3, c8 = pc & 7; *(LAS v4u*)(Ks + kl * AT_KP + c8 * 16) = rk[k_]; } \
        { const int d = pc / 40, c = pc - d * 40; LAS v2u* dst = (LAS v2u*)(Vs + d * AT_VP1 + c * 16); dst[0] = (v2u){rv[k_].x, rv[k_].y}; dst[1] = (v2u){rv[k_].z, rv[k_].w}; } } } while (0)
#define AT_LOAD2(b_, hkv_) do { int tl_ = F.tid; asm volatile("" : "+v"(tl_));   _Pragma("unroll") for (int k_ = 0; k_ < 4; ++k_) { const int pc = tl_ + k_ * NTHREADS; \
        { const int j = pc >> 3, c8 = pc & 7; ck[k_] = *(const v4u*)(QKV + ((size_t)TL + (size_t)(b_) * 256 + j) * 768 + 512 + (hkv_) * 64 + c8 * 8); } \
        { const int d = pc >> 5, c = pc & 31; cv[k_] = *(const v4u*)(VT + ((size_t)((b_) * 2 + (hkv_)) * 64 + d) * 4352 + c * 8); } } } while (0)
#define AT_STORE2() do { int tl_ = F.tid; asm volatile("" : "+v"(tl_));   _Pragma("unroll") for (int k_ = 0; k_ < 4; ++k_) { const int pc = tl_ + k_ * NTHREADS; \
        { const int j = pc >> 3, c8 = pc & 7; *(LAS v4u*)(Ks + j * AT_KP + c8 * 16) = ck[k_]; } \
        { const int d = pc >> 5, c = pc & 31; LAS v2u* dst = (LAS v2u*)(Vs + d * AT_VP2 + c * 16); dst[0] = (v2u){cv[k_].x, cv[k_].y}; dst[1] = (v2u){cv[k_].z, cv[k_].w}; } } } while (0)
    v4u rk[5], rv[5], ck[4], cv[4];
    int u = F.G - 1 - F.bid;
    if (u < NU) { bool isc; int b, hkv, n0; AT_DECODE(u, isc, b, hkv, n0); if (!isc) AT_LOAD1(b, hkv, n0); }
    for (; u < NU; u += F.G) {
        bool isc; int b, hkv, n0; AT_DECODE(u, isc, b, hkv, n0);
        const size_t qrow = isc ? ((size_t)TL + (size_t)b * 256 + n0 + 32 * th + r) : ((size_t)b * 4096 + n0 + 32 * th + r);
        bf16x8 qf[4];
#pragma unroll
        for (int s = 0; s < 4; ++s) qf[s] = *(const bf16x8*)(QKV + qrow * 768 + (hkv * 4 + g) * 64 + 16 * s + 8 * h);
        float m = sinkp[hkv * 4 + g] * 1.4426950408889634f, l = (h == 0) ? 1.0f : 0.0f;
        f32x16 o0, o1;
#pragma unroll
        for (int i = 0; i < 16; ++i) { o0[i] = 0.f; o1[i] = 0.f; }
        __syncthreads();
        if (!isc) AT_STORE1();
        AT_LOAD2(b, hkv);
        if (!isc) {
            __syncthreads();
            const int qi = n0 + 32 * th + r;
#pragma unroll 1
            for (int t = 0; t < 8; t += 2) { const int klb = 32 * th + 32 * t, kj0 = n0 - 128 + klb;
                if (t >= 2 && kj0 >= 0 && kj0 + 63 < SEQ) attn_tile2<false>(Ks, Vs, AT_VP1, klb, qf, o0, o1, m, l, r, h, 0, 0);
                else { attn_tile<true>(Ks, Vs, AT_VP1, klb, qf, o0, o1, m, l, r, h, kj0, qi); attn_tile<true>(Ks, Vs, AT_VP1, klb + 32, qf, o0, o1, m, l, r, h, kj0 + 32, qi); } }
            { const int klb = 32 * th + 256, kj0 = n0 - 128 + klb; attn_tile<true>(Ks, Vs, AT_VP1, klb, qf, o0, o1, m, l, r, h, kj0, qi); }
            __syncthreads();
        }
        AT_STORE2();
        { const int un = u + F.G; if (un < NU) { bool iscn; int bn, hkvn, n0n; AT_DECODE(un, iscn, bn, hkvn, n0n); if (!iscn) AT_LOAD1(bn, hkvn, n0n); } }
        __syncthreads();
#pragma unroll 1
        for (int t = 0; t < 8; t += 2) attn_tile2<false>(Ks, Vs, AT_VP2, 32 * t, qf, o0, o1, m, l, r, h, 0, 0);
        const float inv = 1.0f / (l + __shfl_xor(l, 32));
        bf16* orow = MIX + qrow * D + 512 + (hkv * 4 + g) * 64 + 4 * h;
#pragma unroll
        for (int q4 = 0; q4 < 4; ++q4) {
            v2u w0; w0.x = pk_bf16(o0[4 * q4 + 0] * inv, o0[4 * q4 + 1] * inv); w0.y = pk_bf16(o0[4 * q4 + 2] * inv, o0[4 * q4 + 3] * inv); *(v2u*)(orow + 8 * q4) = w0;
            v2u w1; w1.x = pk_bf16(o1[4 * q4 + 0] * inv, o1[4 * q4 + 1] * inv); w1.y = pk_bf16(o1[4 * q4 + 2] * inv, o1[4 * q4 + 3] * inv); *(v2u*)(orow + 32 + 8 * q4) = w1;
        }
    }
#undef AT_DECODE
#undef AT_LOAD1
#undef AT_STORE1
#undef AT_LOAD2
#undef AT_STORE2
    __syncthreads();
}
PHASE_FN ph_outproj(PP pp, int layer) {
    FRAME();
    const int li = layer >> 1; const bool odd = (layer & 1) != 0;
    const int TR = (layer == DEPTH - 1) ? TL : T;
    const char* W = odd ? (const char*)(ws + WS_OD + li * OD_STRIDE + OD_WOUT) : (const char*)(ws + WS_EV + li * EV_STRIDE + EV_WOUT);
    const float* modl = (const float*)(ws + WS_MOD) + (size_t)layer * 17 * 6144;
    SchedResid S{F.G, F.bid, (TR / 256) * 4, (const char*)(ws + WS_BIG + BIG_MIX), (size_t)256 * D * 2, W, (size_t)256 * D * 2, (bf16*)(ws + WS_XB), modl + 2048};
    pg8::EpiResidLN E{PIN(I_LNG) + (size_t)(layer * 2) * D, PIN(I_LNB) + (size_t)(layer * 2) * D, 2048, 1024, (bf16*)(ws + WS_H), F.ctl + CW_LN + (layer * 2) * LN_SITE_WORDS,
                      (unsigned long long*)(ws + WS_XS), F.ctl + 2, F.lds + LDS_LNTAB, 1.0f, !odd};
    pg8::gemm_phase<pg8::EpiResidLN, SchedResid, true, true>(F.lds, F.tid, pg8::Dims{D, D, D}, S, E);
}
PHASE_FN ph_e6(PP pp, int layer) {
    FRAME();
    unsigned char* evw = ws + WS_EV + (layer >> 1) * EV_STRIDE;
    SchedStd S{22, (T / 256) * 22, F.G, F.bid, (const char*)(ws + WS_H), (const char*)(evw + EV_W13), (char*)(ws + WS_BIG + BIG_HID), (size_t)256 * D, (size_t)256 * D, (size_t)22 * 32768, (size_t)32768, FFH, 1 << 30};
    pg8::gemm_phase<pg8::EpiSwiGLU8, SchedStd, true, true, pg8::AMapStd, true>(F.lds, F.tid, pg8::Dims{D, D, D}, S, pg8::EpiSwiGLU8{});
}
PHASE_FN ph_e7(PP pp, int layer) {
    FRAME();
    unsigned char* evw = ws + WS_EV + (layer >> 1) * EV_STRIDE;
    const float* modl = (const float*)(ws + WS_MOD) + (size_t)layer * 17 * 6144;
    SchedResid S{F.G, F.bid, (T / 256) * 4, (const char*)(ws + WS_BIG + BIG_HID), (size_t)22 * 32768, (const char*)(evw + EV_W2), (size_t)256 * FFH, (bf16*)(ws + WS_XB), modl + 5120};
    pg8::EpiResidLN E{PIN(I_LNG) + (size_t)(layer * 2 + 1) * D, PIN(I_LNB) + (size_t)(layer * 2 + 1) * D, 17 * 6144 + 1024 - 5120, 17 * 6144 - 5120, (bf16*)(ws + WS_H), F.ctl + CW_LN + (layer * 2 + 1) * LN_SITE_WORDS,
                      (unsigned long long*)(ws + WS_XS), F.ctl + 2, F.lds + LDS_LNTAB, 1.0f / (Q_HID * Q_W), false};
    pg8::gemm_phase<pg8::EpiResidLN, SchedResid, true, true, pg8::AMapHid, true>(F.lds, F.tid, pg8::Dims{FFH, FFH, FFH}, S, E, pg8::AMapHid{});
}

PHASE_FN ph_o1(PP pp, int layer) {
    FRAME();
    unsigned char* odw = ws + WS_OD + (layer >> 1) * OD_STRIDE;
    SchedO1 S{F.G, F.bid, (const char*)(ws + WS_H), (const char*)(odw + OD_WIN), (char*)(ws + WS_BIG + BIG_P), (char*)(ws + WS_BIG + BIG_UG)};
    pg8::gemm_phase<pg8::EpiStore, SchedO1, true, true>(F.lds, F.tid, pg8::Dims{D, D, D}, S, pg8::EpiStore{});
}
PHASE_FN ph_o2_s5a(PP pp, int layer) {
    FRAME();
    const int li = layer >> 1;
    SchedS5A S{F.G, F.bid, (const char*)(ws + WS_BIG + BIG_UG), (const char*)(ws + WS_S5M + (size_t)li * 32 * S5M_STRIDE), (char*)(ws + WS_H + 68 * MiB), (char*)(ws + WS_H)};
    pg8::gemm_phase<pg8::EpiStore, SchedS5A, true, true, pg8::AMapStd, false, false>(F.lds, F.tid, pg8::Dims{256, 256, 256}, S, pg8::EpiStore{});
}
PHASE_FN ph_o2_scan(PP pp, int layer) {
    FRAME();
    const int li = layer >> 1;
    if (F.tid >= 256) {
        Params p; p.ws = ws; p.in[I_MW1] = PIN(I_MW1); p.in[I_MW3] = PIN(I_MW3); p.in[I_MW2] = PIN(I_MW2);
        p.in[I_EV_WIN] = nullptr; p.in[I_EV_WOUT] = nullptr; p.in[I_EV_W1] = nullptr; p.in[I_EV_W3] = nullptr; p.in[I_EV_W2] = nullptr; p.in[I_OD_WIN] = nullptr; p.in[I_WGLU] = nullptr; p.in[I_OD_WOUT] = nullptr;
        LAS float* scr = (LAS float*)(F.lds + F.wave * 16384);
        cvt_range<true>(pp, ws, CVT_MOE0 + li * CVT_MOE_LI + F.bid * 4 + (F.wave - 4), CVT_MOE0 + (li + 1) * CVT_MOE_LI, F.G * 4, scr, F.lane);
    }
    if (F.tid < 256) {
        const int t = F.bid * 256 + F.tid;
        if (t < NBATCH * 32 * 2 * 64) {
            const int pl = t & 63, d = (t >> 6) & 1, g = (t >> 7) & 31, b = t >> 12;
            const int sidx = ((li * 2 + d) * 32 + g);
            const float are = PIN(I_A_RE)[sidx * 64 + pl], aim = PIN(I_A_IM)[sidx * 64 + pl], dt = expf(PIN(I_LOG_DT)[sidx]);
            const float mag = expf(16.0f * are * dt); float sn, cn; sincosf(16.0f * aim * dt, &sn, &cn);
            const float lre = mag * cn, lim = mag * sn;
            unsigned* HB = (unsigned*)(ws + WS_H) + (size_t)g * 4352 * 128 + d * 64 + pl;
            float cre = 0.f, cim = 0.f;
#define S5_CROW(k_) ((k_) < 16 ? (4096 + b * 16 + (d ? 15 - (k_) : (k_))) : (b * 256 + (d ? 255 - ((k_) - 16) : ((k_) - 16))))
            unsigned wn[8];
#pragma unroll
            for (int j = 0; j < 8; ++j) wn[j] = HB[(size_t)S5_CROW(j) * 128];
            for (int k0 = 0; k0 < 272; k0 += 8) {
                unsigned w[8];
#pragma unroll
                for (int j = 0; j < 8; ++j) w[j] = wn[j];
                if (k0 + 8 < 272) {
#pragma unroll
                    for (int j = 0; j < 8; ++j) wn[j] = HB[(size_t)S5_CROW(k0 + 8 + j) * 128]; }
#pragma unroll
                for (int j = 0; j < 8; ++j) { HB[(size_t)S5_CROW(k0 + j) * 128] = cvt_pk_bf16(cre, cim);
                    const float sr = bflo(w[j]), si = bfhi(w[j]); const float nr = lre * cre - lim * cim + sr, ni = lre * cim + lim * cre + si; cre = nr; cim = ni; }
            }
#undef S5_CROW
        }
    }
}
PHASE_FN ph_o3(PP pp, int layer) {
    FRAME();
    const int li = layer >> 1;
    SchedS5B S{F.G, F.bid, (const char*)(ws + WS_H), (const char*)(ws + WS_S5M + (size_t)li * 32 * S5M_STRIDE + 256 * 1024), (const char*)(ws + WS_H + 68 * MiB), (char*)(ws + WS_BIG + BIG_UG)};
    pg8::gemm_phase<pg8::EpiS5B, SchedS5B, true, true, pg8::AMapStd, false, false>(F.lds, F.tid, pg8::Dims{256, 256, 256}, S, pg8::EpiS5B{});
}
PHASE_FN ph_o2_gmlp(PP pp, int layer) {
    FRAME();
    const int li = layer >> 1; const int TR = (layer == DEPTH - 1) ? TL : T;
    const bf16* P = (const bf16*)(ws + WS_BIG + BIG_P); bf16* MIX = (bf16*)(ws + WS_BIG + BIG_MIX);
    constexpr int GP = 272;
    LAS unsigned char* Vt = F.lds;
    LAS unsigned char* Wt = F.lds + 128 * GP;
    LAS f32x2* stt = (LAS f32x2*)(F.lds + 2 * 128 * GP);
    LAS unsigned char* Ut = F.lds + 2 * 128 * GP + 1024;
    const float* ws_w = PIN(I_WS) + (size_t)li * 4 * 128 * 128; const float* bs = PIN(I_BS) + (size_t)li * 4 * 128;
    const int r = F.lane & 31, hh = F.lane >> 5, et = F.wave >> 1, it0 = (F.wave & 1) * 2;
    const int nunits = (TR / 128) * 4;
    const bool wfix = (F.G & 3) == 0;
#define GM_LOADW(h_) do { _Pragma("unroll") for (int k = 0; k < 4; ++k) { const int pc = F.tid + k * NTHREADS; const int i = pc >> 4, j8 = (pc & 15) * 8; const float* wp = ws_w + (size_t)(h_) * 16384 + i * 128 + j8; \
        const f32x4 a = *(const f32x4*)wp, b = *(const f32x4*)(wp + 4); v4u o; o.x = cvt_pk_bf16(a[0], a[1]); o.y = cvt_pk_bf16(a[2], a[3]); o.z = cvt_pk_bf16(b[0], b[1]); o.w = cvt_pk_bf16(b[2], b[3]); \
        *(LAS v4u*)(Wt + i * GP + j8 * 2) = o; } } while (0)
#define GM_LOAD(u_) do { const int ch_ = (u_) >> 2, h_ = (u_) & 3; const size_t r0_ = (size_t)ch_ * 128; \
        _Pragma("unroll") for (int t = 0; t < 16; ++t) srow[t] = *(const v4u*)(P + (r0_ + F.wave * 16 + t) * D + 512 + F.lane * 8); \
        _Pragma("unroll") for (int k = 0; k < 4; ++k) { const int pc = F.tid + k * NTHREADS; const int eg = pc >> 7, j = pc & 127; vq[k] = *(const v4u*)(P + (r0_ + j) * D + 512 + h_ * 128 + eg * 8); \
            uq[k] = *(const v4u*)(P + (r0_ + (pc >> 4)) * D + h_ * 128 + (pc & 15) * 8); } } while (0)
    v4u srow[16], vq[4], uq[4];
    __syncthreads();
    const int ub = F.G - 1 - F.bid;
    if (wfix && ub < nunits) GM_LOADW(ub & 3);
    if (ub < nunits) GM_LOAD(ub);
    for (int u = ub; u < nunits; u += F.G) {
        const int ch = u >> 2, h = u & 3; const size_t row0 = (size_t)ch * 128;
        __syncthreads();
        { float vals[32];
#pragma unroll
          for (int t = 0; t < 16; ++t) { const v4u w = srow[t];
              const float f[8] = {bflo(w.x), bfhi(w.x), bflo(w.y), bfhi(w.y), bflo(w.z), bfhi(w.z), bflo(w.w), bfhi(w.w)};
              float sm = 0.f, sq = 0.f;
#pragma unroll
              for (int q = 0; q < 8; ++q) { sm += f[q]; sq += f[q] * f[q]; }
              vals[t] = sm; vals[16 + t] = sq; }
#pragma unroll
          for (int step = 0; step < 5; ++step) { const int M = 32 >> step, n2 = 16 >> step; const bool up = (F.lane & M) != 0;
#pragma unroll
              for (int i = 0; i < n2; ++i) { const float keep = up ? vals[i + n2] : vals[i], send = up ? vals[i] : vals[i + n2]; vals[i] = keep + __shfl_xor(send, M); } }
          const float tot = vals[0] + __shfl_xor(vals[0], 1);
          const float oth = __shfl_xor(tot, 32);
          if (F.lane < 32 && (F.lane & 1) == 0) { const float mu = tot * (1.f / 512.f), var = fmaxf(oth * (1.f / 512.f) - mu * mu, 0.f); stt[F.wave * 16 + (F.lane >> 1)] = (f32x2){mu, rsqrtf(var + LN_EPS)}; } }
        if (!wfix) GM_LOADW(h);
#pragma unroll
        for (int k = 0; k < 4; ++k) { const int pc = F.tid + k * NTHREADS; *(LAS v4u*)(Ut + (pc >> 4) * GP + (pc & 15) * 16) = uq[k]; }
        __syncthreads();
#pragma unroll
        for (int k = 0; k < 4; ++k) { const int pc = F.tid + k * NTHREADS; const int eg = pc >> 7, j = pc & 127; const v4u w = vq[k];
            const f32x2 ms = stt[j];
            const float f[8] = {bflo(w.x), bfhi(w.x), bflo(w.y), bfhi(w.y), bflo(w.z), bfhi(w.z), bflo(w.w), bfhi(w.w)};
#pragma unroll
            for (int q = 0; q < 8; q += 2) { const unsigned pkd = cvt_pk_bf16((f[q] - ms.x) * ms.y, (f[q + 1] - ms.x) * ms.y);
                *(LAS unsigned short*)(Vt + (eg * 8 + q) * GP + j * 2) = (unsigned short)(pkd & 0xffffu); *(LAS unsigned short*)(Vt + (eg * 8 + q + 1) * GP + j * 2) = (unsigned short)(pkd >> 16); } }
        if (u + F.G < nunits) GM_LOAD(u + F.G);
        __syncthreads();
        f32x16 acc0, acc1;
#pragma unroll
        for (int q = 0; q < 16; ++q) { acc0[q] = 0.f; acc1[q] = 0.f; }
#pragma unroll
        for (int sk = 0; sk < 8; ++sk) {
            const bf16x8 a = *(const LAS bf16x8*)(Vt + (et * 32 + r) * GP + (16 * sk + 8 * hh) * 2);
            const bf16x8 b0 = *(const LAS bf16x8*)(Wt + (it0 * 32 + r) * GP + (16 * sk + 8 * hh) * 2), b1 = *(const LAS bf16x8*)(Wt + ((it0 + 1) * 32 + r) * GP + (16 * sk + 8 * hh) * 2);
            acc0 = __builtin_amdgcn_mfma_f32_32x32x16_bf16(a, b0, acc0, 0, 0, 0); acc1 = __builtin_amdgcn_mfma_f32_32x32x16_bf16(a, b1, acc1, 0, 0, 0);
        }
#pragma unroll
        for (int t = 0; t < 2; ++t) { const int i = (it0 + t) * 32 + r; const float bb = bs[h * 128 + i];
            LAS unsigned char* up = Ut + i * GP + (et * 32 + 4 * hh) * 2;
#pragma unroll
            for (int q4 = 0; q4 < 4; ++q4) { const v2u uw = *(const LAS v2u*)(up + 16 * q4);
                const float a0 = (t ? acc1[4 * q4 + 0] : acc0[4 * q4 + 0]) + bb, a1 = (t ? acc1[4 * q4 + 1] : acc0[4 * q4 + 1]) + bb, a2 = (t ? acc1[4 * q4 + 2] : acc0[4 * q4 + 2]) + bb, a3 = (t ? acc1[4 * q4 + 3] : acc0[4 * q4 + 3]) + bb;
                v2u o; o.x = cvt_pk_bf16(bflo(uw.x) * a0, bfhi(uw.x) * a1); o.y = cvt_pk_bf16(bflo(uw.y) * a2, bfhi(uw.y) * a3);
                *(LAS v2u*)(up + 16 * q4) = o; } }
        __syncthreads();
#pragma unroll
        for (int k = 0; k < 4; ++k) { const int pc = F.tid + k * NTHREADS; *(v4u*)(MIX + (row0 + (pc >> 4)) * D + 512 + h * 128 + (pc & 15) * 8) = *(const LAS v4u*)(Ut + (pc >> 4) * GP + (pc & 15) * 16); }
    }
    __syncthreads();
#undef GM_LOAD
#undef GM_LOADW
}
PHASE_FN ph_o4(PP pp, int layer) {
    FRAME();
    const int li = layer >> 1;
    unsigned char* odw = ws + WS_OD + li * OD_STRIDE;
    SchedGlu S{F.G, F.bid, (const char*)(ws + WS_BIG + BIG_UG), (const char*)(odw + OD_WGLU), (char*)(ws + WS_BIG + BIG_MIX), PIN(I_BGLU) + (size_t)li * 512};
    pg8::gemm_phase<pg8::EpiGLU, SchedGlu, true, true, pg8::AMapGLU>(F.lds, F.tid, pg8::Dims{512, 0, 512}, S, pg8::EpiGLU{}, pg8::AMapGLU{});
}
PHASE_FN ph_o6(PP pp, int layer) {
    FRAME();
    const int li = layer >> 1; const int TR = (layer == DEPTH - 1) ? TL : T;
    const bf16* Hb = (const bf16*)(ws + WS_H);
    int* tokE = (int*)(ws + WS_TOK); int* tokS0 = tokE + T; int* tokS1 = tokS0 + T; float* tokG0 = (float*)(tokS1 + T);
    unsigned* ecnt = F.ctl + CW_CNT + li * 64;
    LAS float* wr_s = (LAS float*)F.lds;
    LAS unsigned* lcnt = (LAS unsigned*)(F.lds + 32768);
    const float* rw = PIN(I_ROUTER) + (size_t)li * D * 8;
    __syncthreads();
    for (int e = F.tid; e < D * 8; e += NTHREADS) { const int col = e >> 3, ex = e & 7; wr_s[(((col & 15) * 2 + (ex >> 2)) * 64 + (col >> 4)) * 4 + (ex & 3)] = rw[e]; }
    if (F.tid < 16) lcnt[F.tid] = 0u;
    __syncthreads();
    v4u qa[3], qb[3];
#pragma unroll
    for (int k = 0; k < 3; ++k) { const int rk = F.gw + k * F.NGW; qa[k] = (v4u){0u, 0u, 0u, 0u}; qb[k] = qa[k];
        if (rk < TR) { const v4u* src = (const v4u*)(Hb + (size_t)rk * D) + 2 * F.lane; qa[k] = src[0]; qb[k] = src[1]; } }
    for (int r = F.gw; r < TR; r += F.NGW) {
        const v4u a = qa[0], b = qb[0];
        qa[0] = qa[1]; qb[0] = qb[1]; qa[1] = qa[2]; qb[1] = qb[2];
        { const int rn = r + 3 * F.NGW; if (rn < TR) { const v4u* src = (const v4u*)(Hb + (size_t)rn * D) + 2 * F.lane; qa[2] = src[0]; qb[2] = src[1]; } }
        const float hv[16] = {bflo(a.x), bfhi(a.x), bflo(a.y), bfhi(a.y), bflo(a.z), bfhi(a.z), bflo(a.w), bfhi(a.w), bflo(b.x), bfhi(b.x), bflo(b.y), bfhi(b.y), bflo(b.z), bfhi(b.z), bflo(b.w), bfhi(b.w)};
        float lg[8];
#pragma unroll
        for (int e = 0; e < 8; ++e) lg[e] = 0.f;
#pragma unroll
        for (int q = 0; q < 16; ++q) { const f32x4 w0 = *(const LAS f32x4*)(wr_s + ((q * 2 + 0) * 64 + F.lane) * 4), w1 = *(const LAS f32x4*)(wr_s + ((q * 2 + 1) * 64 + F.lane) * 4);
            lg[0] += hv[q] * w0[0]; lg[1] += hv[q] * w0[1]; lg[2] += hv[q] * w0[2]; lg[3] += hv[q] * w0[3]; lg[4] += hv[q] * w1[0]; lg[5] += hv[q] * w1[1]; lg[6] += hv[q] * w1[2]; lg[7] += hv[q] * w1[3]; }
#pragma unroll
        for (int step = 0; step < 3; ++step) { const int M = 32 >> step, n2 = 4 >> step; const bool up = (F.lane & M) != 0;
#pragma unroll
            for (int i = 0; i < n2; ++i) { const float keep = up ? lg[i + n2] : lg[i], send = up ? lg[i] : lg[i + n2]; lg[i] = keep + __shfl_xor(send, M); } }
        { float t = lg[0]; t += __shfl_xor(t, 4); t += __shfl_xor(t, 2); t += __shfl_xor(t, 1);
#pragma unroll
          for (int e = 0; e < 8; ++e) lg[e] = __uint_as_float((unsigned)__builtin_amdgcn_readlane((int)__float_as_uint(t), 8 * e)); }
        if (F.lane == 0) {
            int e0 = 0; float v0 = lg[0];
#pragma unroll
            for (int e = 1; e < 8; ++e) if (lg[e] > v0) { v0 = lg[e]; e0 = e; }
            int e1 = -1; float v1 = -3.0e38f;
#pragma unroll
            for (int e = 0; e < 8; ++e) if (e != e0 && lg[e] > v1) { v1 = lg[e]; e1 = e; }
            const float w0 = 1.0f / (1.0f + __expf(v1 - v0));
            const int s0 = (int)__hip_atomic_fetch_add(lcnt + e0, 1u, __ATOMIC_RELAXED, __HIP_MEMORY_SCOPE_WORKGROUP), s1 = (int)__hip_atomic_fetch_add(lcnt + e1, 1u, __ATOMIC_RELAXED, __HIP_MEMORY_SCOPE_WORKGROUP);
            tokE[r] = e0 | (e1 << 8); tokS0[r] = s0; tokS1[r] = s1; tokG0[r] = w0;
        }
    }
    __syncthreads();
    if (F.tid < 8) lcnt[8 + F.tid] = atomicAdd(ecnt + F.tid, lcnt[F.tid]);
    VM_WAIT();
    __syncthreads();
    { const int r = F.gw + F.lane * F.NGW;
      if (r < TR) { const int ee = tokE[r]; tokS0[r] += (int)lcnt[8 + (ee & 255)]; tokS1[r] += (int)lcnt[8 + (ee >> 8)]; } }
    __syncthreads();
}
PHASE_FN ph_o7(PP pp, int layer) {
    FRAME();
    const int li = layer >> 1; const int TR = (layer == DEPTH - 1) ? TL : T;
    const bf16* Hb = (const bf16*)(ws + WS_H); unsigned char* HSQ = ws + WS_BIG + BIG_HSQ;
    int* tokE = (int*)(ws + WS_TOK); int* tokS0 = tokE + T; int* tokS1 = tokS0 + T; int* tokP0 = tokS1 + 2 * T; int* tokP1 = tokP0 + T;
    unsigned* ecnt = F.ctl + CW_CNT + li * 64;
    int roff[8]; { int acc = 0;
#pragma unroll
        for (int e = 0; e < 8; ++e) { roff[e] = acc * 256; acc += (__builtin_amdgcn_readfirstlane((int)__hip_atomic_load(ecnt + e, __ATOMIC_RELAXED, __HIP_MEMORY_SCOPE_AGENT)) + 255) >> 8; } }
    for (int ra = F.gw; ra < TR; ra += 2 * F.NGW) {
        const int rb = ra + F.NGW;
        const int ea = tokE[ra], eb = tokE[rb]; int pa0 = tokS0[ra], pa1 = tokS1[ra], pb0 = tokS0[rb], pb1 = tokS1[rb];
        const v4u* sa = (const v4u*)(Hb + (size_t)ra * D) + 2 * F.lane; const v4u* sb = (const v4u*)(Hb + (size_t)rb * D) + 2 * F.lane;
        const v4u a0 = sa[0], a1 = sa[1], b0 = sb[0], b1 = sb[1];
#pragma unroll
        for (int e = 0; e < 8; ++e) { pa0 += (e == (ea & 255)) ? roff[e] : 0; pa1 += (e == (ea >> 8)) ? roff[e] : 0; pb0 += (e == (eb & 255)) ? roff[e] : 0; pb1 += (e == (eb >> 8)) ? roff[e] : 0; }
        v4u qa, qb;
        qa.x = pk_fp8x4(bflo(a0.x) * Q_H, bfhi(a0.x) * Q_H, bflo(a0.y) * Q_H, bfhi(a0.y) * Q_H); qa.y = pk_fp8x4(bflo(a0.z) * Q_H, bfhi(a0.z) * Q_H, bflo(a0.w) * Q_H, bfhi(a0.w) * Q_H);
        qa.z = pk_fp8x4(bflo(a1.x) * Q_H, bfhi(a1.x) * Q_H, bflo(a1.y) * Q_H, bfhi(a1.y) * Q_H); qa.w = pk_fp8x4(bflo(a1.z) * Q_H, bfhi(a1.z) * Q_H, bflo(a1.w) * Q_H, bfhi(a1.w) * Q_H);
        qb.x = pk_fp8x4(bflo(b0.x) * Q_H, bfhi(b0.x) * Q_H, bflo(b0.y) * Q_H, bfhi(b0.y) * Q_H); qb.y = pk_fp8x4(bflo(b0.z) * Q_H, bfhi(b0.z) * Q_H, bflo(b0.w) * Q_H, bfhi(b0.w) * Q_H);
        qb.z = pk_fp8x4(bflo(b1.x) * Q_H, bfhi(b1.x) * Q_H, bflo(b1.y) * Q_H, bfhi(b1.y) * Q_H); qb.w = pk_fp8x4(bflo(b1.z) * Q_H, bfhi(b1.z) * Q_H, bflo(b1.w) * Q_H, bfhi(b1.w) * Q_H);
        *((v4u*)(HSQ + (size_t)pa0 * D) + F.lane) = qa; *((v4u*)(HSQ + (size_t)pa1 * D) + F.lane) = qa;
        *((v4u*)(HSQ + (size_t)pb0 * D) + F.lane) = qb; *((v4u*)(HSQ + (size_t)pb1 * D) + F.lane) = qb;
        if (F.lane == 0) { tokP0[ra] = pa0; tokP1[ra] = pa1; tokP0[rb] = pb0; tokP1[rb] = pb1; }
    }
}
PHASE_FN ph_moe_up(PP pp, int layer, int chn) {
    FRAME();
    const int li = layer >> 1; unsigned char* odw = ws + WS_OD + li * OD_STRIDE; unsigned* ecnt = F.ctl + CW_CNT + li * 64;
    SchedMoeUp S; S.G = F.G; S.c = F.bid; S.rt0 = chn * MOE_CHUNK_TILES; S.HS = (const char*)(ws + WS_BIG + BIG_HSQ); S.W = (const char*)(odw + OD_MW13); S.HID = (char*)(ws + WS_H);
    { int acc = 0; S.toff[0] = 0;
#pragma unroll
        for (int e = 0; e < 8; ++e) { acc += (__builtin_amdgcn_readfirstlane((int)__hip_atomic_load(ecnt + e, __ATOMIC_RELAXED, __HIP_MEMORY_SCOPE_AGENT)) + 255) >> 8; S.toff[e + 1] = acc; } }
    int nt_ = S.toff[8] - S.rt0; nt_ = nt_ < 0 ? 0 : (nt_ > MOE_CHUNK_TILES ? MOE_CHUNK_TILES : nt_); S.nUnits = nt_ * 28;
    pg8::gemm_phase<pg8::EpiSwiGLU8, SchedMoeUp, true, true, pg8::AMapStd, true>(F.lds, F.tid, pg8::Dims{D, D, D}, S, pg8::EpiSwiGLU8{});
}
PHASE_FN ph_moe_down(PP pp, int layer, int chn) {
    FRAME();
    const int li = layer >> 1; unsigned char* odw = ws + WS_OD + li * OD_STRIDE; unsigned* ecnt = F.ctl + CW_CNT + li * 64;
    SchedMoeDown S; S.G = F.G; S.c = F.bid; S.rt0 = chn * MOE_CHUNK_TILES; S.HID = (const char*)(ws + WS_H); S.W = (const char*)(odw + OD_MW2); S.Y = (char*)(ws + WS_BIG + BIG_Y);
    { int acc = 0; S.toff[0] = 0;
#pragma unroll
        for (int e = 0; e < 8; ++e) { acc += (__builtin_amdgcn_readfirstlane((int)__hip_atomic_load(ecnt + e, __ATOMIC_RELAXED, __HIP_MEMORY_SCOPE_AGENT)) + 255) >> 8; S.toff[e + 1] = acc; } }
    int nt_ = S.toff[8] - S.rt0; nt_ = nt_ < 0 ? 0 : (nt_ > MOE_CHUNK_TILES ? MOE_CHUNK_TILES : nt_); S.nUnits = nt_ * 4;
    pg8::gemm_phase<pg8::EpiStoreQ, SchedMoeDown, true, true, pg8::AMapHid, true>(F.lds, F.tid, pg8::Dims{EH, EH, EH}, S, pg8::EpiStoreQ{}, pg8::AMapHid{});
}
PHASE_FN ph_o9(PP pp, int layer) {
    FRAME();
    const int TR = (layer == DEPTH - 1) ? TL : T; const bool last = layer == DEPTH - 1;
    bf16* XB = (bf16*)(ws + WS_XB); float* out = (float*)pp->out; bf16* Hb = (bf16*)(ws + WS_H); const bf16* HS = (const bf16*)(ws + WS_BIG + BIG_Y);
    const float* modl = (const float*)(ws + WS_MOD) + (size_t)layer * 17 * 6144;
    const float* modn = (const float*)(ws + WS_MOD) + (size_t)(last ? layer : layer + 1) * 17 * 6144;
    const float* lng1 = PIN(I_LNG) + (size_t)(layer * 2 + 1) * D; const float* lnb1 = PIN(I_LNB) + (size_t)(layer * 2 + 1) * D;
    const int* tokE = (const int*)(ws + WS_TOK); const float* tokG0 = (const float*)(tokE + 3 * T); const int* tokP0 = tokE + 4 * T; const int* tokP1 = tokP0 + T;
    f32x4 gg9[4], bb9[4];
#pragma unroll
    for (int j = 0; j < 4; ++j) { gg9[j] = *(const f32x4*)(lng1 + 256 * j + 4 * F.lane); bb9[j] = *(const f32x4*)(lnb1 + 256 * j + 4 * F.lane); }
    for (int ra = F.gw; ra < TR; ra += 2 * F.NGW) {
        const int rb = ra + F.NGW; const int rr[2] = {ra, rb};
        int p0[2], p1[2]; float w0[2]; int mrow[2];
#pragma unroll
        for (int k = 0; k < 2; ++k) { const int r = rr[k]; const bool isc = r >= TL; mrow[k] = isc ? 16 : (r >> 12); p0[k] = tokP0[r]; p1[k] = tokP1[r]; w0[k] = tokG0[r]; }
        f32x4 v[2][4]; v2u ya[2][4], yb[2][4];
#pragma unroll
        for (int k = 0; k < 2; ++k) { row_load_bf16(XB + (size_t)rr[k] * D, F.lane, v[k]); const bf16* y0 = HS + (size_t)p0[k] * D; const bf16* y1 = HS + (size_t)p1[k] * D;
#pragma unroll
            for (int j = 0; j < 4; ++j) { ya[k][j] = *(const v2u*)(y0 + 256 * j + 4 * F.lane); yb[k][j] = *(const v2u*)(y1 + 256 * j + 4 * F.lane); } }
#pragma unroll
        for (int k = 0; k < 2; ++k) { const float wa = w0[k], wb = 1.0f - wa; const float* g2 = modl + (size_t)mrow[k] * 6144 + 5120;
#pragma unroll
            for (int j = 0; j < 4; ++j) { const v2u a = ya[k][j], b = yb[k][j]; const f32x4 gg = *(const f32x4*)(g2 + 256 * j + 4 * F.lane);
                f32x4 f; f[0] = wa * bflo(a.x) + wb * bflo(b.x); f[1] = wa * bfhi(a.x) + wb * bfhi(b.x); f[2] = wa * bflo(a.y) + wb * bflo(b.y); f[3] = wa * bfhi(a.y) + wb * bfhi(b.y);
                v[k][j] = v[k][j] * ALPHA + gg * f; }
            row_ln_pre(v[k], gg9, bb9);
            if (last) row_store(out + (size_t)rr[k] * D, F.lane, v[k]); else row_store_bf16(XB + (size_t)rr[k] * D, F.lane, v[k]);
            if (!last) { f32x4 h[4]; const float* m = modn + (size_t)mrow[k] * 6144; row_modulate(h, v[k], m + 1024, m, F.lane); row_store_bf16(Hb + (size_t)rr[k] * D, F.lane, h); } }
    }
}

#if MK_SPLIT
#define PHASE_END() do { ++ph; } while (0)
#else
#define PHASE_END() do { if (ph >= lo && ph + 1 < hi) grid_bar(pp); ++ph; } while (0)
#endif
#define PHASE_ON() (ph >= lo && ph < hi)
static __device__ __forceinline__ void even_layer(PP pp, const int layer, const int lo, const int hi, int& ph) {
    if (PHASE_ON()) ph_e1(pp, layer);
    PHASE_END();
    if (PHASE_ON()) { ph_e2_fft(pp); ph_e2_rope(pp); }
    PHASE_END();
    if (PHASE_ON()) { ph_e2_dft(pp); ph_e3_attn(pp, layer); }
    PHASE_END();
    if (PHASE_ON()) ph_outproj(pp, layer);
    PHASE_END();
    if (PHASE_ON()) ph_e6(pp, layer);
    PHASE_END();
    if (PHASE_ON()) ph_e7(pp, layer);
    PHASE_END();
}
static __device__ __forceinline__ void odd_layer(PP pp, const int layer, const int lo, const int hi, int& ph) {
    if (PHASE_ON()) ph_o1(pp, layer);
    PHASE_END();
    if (PHASE_ON()) { ph_o2_s5a(pp, layer); ph_o2_gmlp(pp, layer); }
    PHASE_END();
    if (PHASE_ON()) ph_o2_scan(pp, layer);
    PHASE_END();
    if (PHASE_ON()) ph_o3(pp, layer);
    PHASE_END();
    if (PHASE_ON()) ph_o4(pp, layer);
    PHASE_END();
    if (PHASE_ON()) ph_outproj(pp, layer);
    PHASE_END();
    if (PHASE_ON()) ph_o6(pp, layer);
    PHASE_END();
    if (PHASE_ON()) ph_o7(pp, layer);
    PHASE_END();
#define MOE_CHUNK(chn) do { if (PHASE_ON()) ph_moe_up(pp, layer, chn); PHASE_END(); if (PHASE_ON()) ph_moe_down(pp, layer, chn); PHASE_END(); } while (0)
    static_assert(MOE_NCHUNK == 5, "the chunk sites are written out: no loop around GEMM phase sites");
    MOE_CHUNK(0); MOE_CHUNK(1); MOE_CHUNK(2); MOE_CHUNK(3); MOE_CHUNK(4);
#undef MOE_CHUNK
    if (PHASE_ON()) ph_o9(pp, layer);
    PHASE_END();
}
constexpr int N_PHASES = 2 + 2 * (6 + 9 + 2 * MOE_NCHUNK);
__global__ void __launch_bounds__(NTHREADS, 2) fwd_kernel(Params p_unused) {
    DECL_LDS;
    PP pp = (PP)__builtin_amdgcn_kernarg_segment_ptr();
    {
        LAS unsigned char* lds = (LAS unsigned char*)lds_raw;
        for (int u = threadIdx.x; u < (LDS_BYTES - LDS_RING) / 4; u += NTHREADS) ((LAS unsigned*)(lds + LDS_RING))[u] = 0u;
        __syncthreads();
#if !MK_SPLIT
        (void)xcd_barrier_post((unsigned*)((unsigned char*)pp->ws + WS_CTL) + CW_BAR, (volatile LAS unsigned*)(lds + LDS_MISC) + 8);
#endif
    }
#if MK_SPLIT
    const int lo = pp->ph_lo, hi = pp->ph_hi;
#else
    constexpr int lo = 0, hi = N_PHASES;
#endif
    int ph = 0;

    if (PHASE_ON()) ph_mod(pp);
    PHASE_END();
    if (PHASE_ON()) { ph_fold(pp); ph_s5mat(pp); ph_pro_b(pp); ph_cvt(pp); ph_dftmat(pp); }
    PHASE_END();
    even_layer(pp, 0, lo, hi, ph);
    odd_layer(pp, 1, lo, hi, ph);
    even_layer(pp, 2, lo, hi, ph);
    odd_layer(pp, 3, lo, hi, ph);
}

extern "C" void kernel_launch(void* const* d_in, const int* in_sizes, int n_in, void* d_out, int out_size, void* d_ws, size_t ws_size, hipStream_t stream) {
    static int grid = 0;
    if (grid == 0) {
        if (n_in != 32 || out_size != TL * D || ws_size < WS_END) { fprintf(stderr, "kernel_launch: unexpected shapes (n_in %d, out %d, ws %zu < %zu)\n", n_in, out_size, ws_size, (size_t)WS_END); grid = -1; return; }
        int dev = 0, cus = 0, per_cu = 0;
        if (hipGetDevice(&dev) != hipSuccess || hipDeviceGetAttribute(&cus, hipDeviceAttributeMultiprocessorCount, dev) != hipSuccess) { grid = -1; return; }
        if (hipFuncSetAttribute((const void*)fwd_kernel, hipFuncAttributeMaxDynamicSharedMemorySize, LDS_BYTES) != hipSuccess) { fprintf(stderr, "kernel_launch: hipFuncSetAttribute failed\n"); grid = -1; return; }
        if (hipOccupancyMaxActiveBlocksPerMultiprocessor(&per_cu, (const void*)fwd_kernel, NTHREADS, LDS_BYTES) != hipSuccess || per_cu < 1) { fprintf(stderr, "kernel_launch: occupancy query says %d\n", per_cu); }
        (void)hipGetLastError();
        grid = cus;
    }
    if (grid < 0) return;
    (void)in_sizes;
    (void)hipMemsetAsync((char*)d_ws + WS_CTL, 0, CTL_ZERO_BYTES, stream);
    Params p{};
    for (int i = 0; i < 32; ++i) p.in[i] = (const float*)d_in[i];
    p.out = (float*)d_out; p.ws = (unsigned char*)d_ws;
#if MK_SPLIT
    for (int ph = 0; ph < N_PHASES; ++ph) { p.ph_lo = ph; p.ph_hi = ph + 1; hipLaunchKernelGGL(fwd_kernel, dim3(grid), dim3(NTHREADS), LDS_BYTES, stream, p); }
#else
    p.ph_lo = 0; p.ph_hi = N_PHASES;
    hipLaunchKernelGGL(fwd_kernel, dim3(grid), dim3(NTHREADS), LDS_BYTES, stream, p);
#endif
}
```
